# Optimizing an MI355X kernel written in HIP

```python
import math
import jax, jax.numpy as jnp
from jax import lax
import numpy as np

D_MODEL = 1024
BATCH = 8
SEQ = 2048
DEPTH = 1

SSM_GROUP = 16
SSM_GROUPS = 32
SSM_WIDTH = SSM_GROUP * SSM_GROUPS
SSM_STATE = 64
SSM_DT_MIN = 1e-3
SSM_DT_MAX = 1e-1
ATT_HEADS = 8
HEAD_DIM = 64
ATT_WIDTH = ATT_HEADS * HEAD_DIM
MOBA_BLOCK = 256
MOBA_TOPK = 3
ATT_Q_CHUNK = 32
REL_BUCKETS = 32
REL_MAX_DIST = 128
PEER_HEADS = 8
PEER_NKEYS = 128
PEER_EXPERTS = PEER_NKEYS * PEER_NKEYS
PEER_QDIM = 256
PEER_TOPK = 16
PEER_TOK_CHUNK = 128
RMS_EPS = 1e-6
NEG = -1e30
IN_WIDTHS = (SSM_WIDTH, ATT_WIDTH, ATT_WIDTH, ATT_WIDTH, D_MODEL, D_MODEL)
IN_COLS = sum(IN_WIDTHS)
IN_SPLITS = tuple(int(s) for s in np.cumsum(IN_WIDTHS)[:-1])

kernel_name = "hybrid_s5_moba_peer_block"


def rms_norm(x, g):
    xf = x.astype(jnp.float32)
    y = xf * lax.rsqrt(jnp.mean(xf * xf, axis=-1, keepdims=True) + RMS_EPS)
    return (y * g.astype(jnp.float32)).astype(x.dtype)


def _ssm_combine(c1, c2):
    a1, b1 = c1
    a2, b2 = c2
    return a1 * a2, a2 * b1 + b2


def s5_branch(u, a_re, a_im, log_dt, b_re, b_im, c_re, c_im, d_skip, w_glu, b_glu):
    f32 = jnp.float32
    bsz, seq, _ = u.shape
    uf = u.astype(f32).reshape(bsz, seq, SSM_GROUPS, SSM_GROUP)
    lam = lax.complex(a_re.astype(f32), a_im.astype(f32))
    dt = jnp.exp(log_dt.astype(f32))[:, None]
    lam_bar = jnp.exp(lam * dt)
    bmat = lax.complex(b_re.astype(f32), b_im.astype(f32))
    b_bar = ((lam_bar - 1.0) / lam)[..., None] * bmat
    cmat = lax.complex(c_re.astype(f32), c_im.astype(f32))
    bu = jnp.einsum('gph,blgh->blgp', b_bar, uf)
    a = jnp.broadcast_to(lam_bar, bu.shape)
    _, states = lax.associative_scan(_ssm_combine, (a, bu), axis=1)
    y = jnp.einsum('ghp,blgp->blgh', cmat, states).real + d_skip.astype(f32) * uf
    y = jax.nn.gelu(y.reshape(bsz, seq, SSM_WIDTH)).astype(u.dtype)
    return y * jax.nn.sigmoid(y @ w_glu + b_glu)


def t5_bucket(rel):
    n = jnp.maximum(rel, 0)
    max_exact = REL_BUCKETS // 2
    nf = jnp.maximum(n, 1).astype(jnp.float32)
    large = max_exact + (jnp.log(nf / max_exact) / math.log(REL_MAX_DIST / max_exact)
                         * (REL_BUCKETS - max_exact)).astype(jnp.int32)
    large = jnp.clip(large, 0, REL_BUCKETS - 1)
    return jnp.where(n < max_exact, n, large)


def moba_branch(q, k, v, rel_bias):
    f32 = jnp.float32
    bsz, seq, _ = q.shape
    nb = -(-seq // MOBA_BLOCK)
    lp = nb * MOBA_BLOCK

    def heads(t):
        t = t.reshape(bsz, seq, ATT_HEADS, HEAD_DIM).transpose(0, 2, 1, 3)
        return jnp.pad(t, ((0, 0), (0, 0), (0, lp - seq), (0, 0)))

    qh, kh, vh = heads(q), heads(k), heads(v)
    kb = kh.reshape(bsz, ATT_HEADS, nb, MOBA_BLOCK, HEAD_DIM)
    vb = vh.reshape(bsz, ATT_HEADS, nb, MOBA_BLOCK, HEAD_DIM)

    kmean = jnp.mean(kb.astype(f32), axis=3)
    gate = jnp.einsum('bhqd,bhnd->bhqn', qh.astype(f32), kmean)
    qblk = jnp.arange(lp) // MOBA_BLOCK
    past = jnp.arange(nb)[None, :] < qblk[:, None]
    gate = jnp.where(past, gate, -jnp.inf)
    topk = min(MOBA_TOPK, nb)
    _, sel = lax.top_k(gate, topk)

    n_chunks = lp // ATT_Q_CHUNK
    qc = qh.reshape(bsz, ATT_HEADS, n_chunks, ATT_Q_CHUNK, HEAD_DIM).transpose(2, 0, 1, 3, 4)
    selc = sel.reshape(bsz, ATT_HEADS, n_chunks, ATT_Q_CHUNK, topk).transpose(2, 0, 1, 3, 4)
    starts = jnp.arange(n_chunks, dtype=jnp.int32) * ATT_Q_CHUNK

    bi = jnp.arange(bsz)[:, None, None, None]
    hi = jnp.arange(ATT_HEADS)[None, :, None, None]
    hi5 = hi[..., None]
    table = rel_bias.astype(f32).T
    offs = jnp.arange(MOBA_BLOCK)
    scale = HEAD_DIM ** -0.5

    def step(args):
        q_c, sel_c, start = args
        qp = start + jnp.arange(ATT_Q_CHUNK)
        own = start // MOBA_BLOCK
        q_f = q_c.astype(f32)
        k_sel = kb[bi, hi, sel_c].astype(f32)
        v_sel = vb[bi, hi, sel_c].astype(f32)
        kpos_sel = sel_c[..., None] * MOBA_BLOCK + offs
        bias_sel = table[hi5, t5_bucket(qp[:, None, None] - kpos_sel)]
        s_sel = jnp.einsum('bhqd,bhqskd->bhqsk', q_f, k_sel) * scale + bias_sel
        s_sel = jnp.where((sel_c < own)[..., None], s_sel, NEG)
        k_own = lax.dynamic_index_in_dim(kb, own, axis=2, keepdims=False).astype(f32)
        v_own = lax.dynamic_index_in_dim(vb, own, axis=2, keepdims=False).astype(f32)
        rel_own = qp[:, None] - (own * MOBA_BLOCK + offs)[None, :]
        s_own = jnp.einsum('bhqd,bhkd->bhqk', q_f, k_own) * scale + table[:, t5_bucket(rel_own)]
        s_own = jnp.where(rel_own >= 0, s_own, NEG)
        s = jnp.concatenate([s_sel.reshape(bsz, ATT_HEADS, ATT_Q_CHUNK, topk * MOBA_BLOCK), s_own], axis=-1)
        p = jax.nn.softmax(s, axis=-1)
        p_sel = p[..., :topk * MOBA_BLOCK].reshape(bsz, ATT_HEADS, ATT_Q_CHUNK, topk, MOBA_BLOCK)
        p_own = p[..., topk * MOBA_BLOCK:]
        o = (jnp.einsum('bhqsk,bhqskd->bhqd', p_sel, v_sel)
             + jnp.einsum('bhqk,bhkd->bhqd', p_own, v_own))
        return o.astype(q_c.dtype)

    out = lax.map(step, (qc, selc, starts))
    out = out.transpose(1, 2, 0, 3, 4).reshape(bsz, ATT_HEADS, lp, HEAD_DIM)[:, :, :seq]
    return out.transpose(0, 2, 1, 3).reshape(bsz, seq, ATT_WIDTH)


def peer_ffn(h, w_q, sub_k1, sub_k2, u_emb, v_emb):
    f32 = jnp.float32
    bsz, seq, d = h.shape
    t = h.reshape(-1, d)
    n_tok = t.shape[0]
    half = PEER_QDIM // 2
    q = (t @ w_q).astype(f32).reshape(n_tok, PEER_HEADS, 2, half)
    s1 = jnp.einsum('thd,kd->thk', q[:, :, 0], sub_k1.astype(f32))
    s2 = jnp.einsum('thd,kd->thk', q[:, :, 1], sub_k2.astype(f32))
    v1, i1 = lax.top_k(s1, PEER_TOPK)
    v2, i2 = lax.top_k(s2, PEER_TOPK)
    n_cand = PEER_TOPK * PEER_TOPK
    cand = (v1[..., :, None] + v2[..., None, :]).reshape(n_tok, PEER_HEADS, n_cand)
    cand_idx = (i1[..., :, None] * PEER_NKEYS + i2[..., None, :]).reshape(n_tok, PEER_HEADS, n_cand)
    best, pos = lax.top_k(cand, PEER_TOPK)
    expert = jnp.take_along_axis(cand_idx, pos, axis=-1)
    gate = jax.nn.softmax(best, axis=-1)

    n_chunks = n_tok // PEER_TOK_CHUNK

    def step(args):
        t_c, e_c, g_c = args
        u_sel = jnp.take(u_emb, e_c, axis=0).astype(f32)
        act = jax.nn.gelu(jnp.einsum('cd,chkd->chk', t_c.astype(f32), u_sel))
        v_sel = jnp.take(v_emb, e_c, axis=0).astype(f32)
        return jnp.einsum('chk,chkd->cd', g_c * act, v_sel).astype(t_c.dtype)

    y = lax.map(step, (t.reshape(n_chunks, PEER_TOK_CHUNK, d),
                       expert.reshape(n_chunks, PEER_TOK_CHUNK, PEER_HEADS, PEER_TOPK),
                       gate.reshape(n_chunks, PEER_TOK_CHUNK, PEER_HEADS, PEER_TOPK)))
    return y.reshape(bsz, seq, d)


def setup_inputs(seed: int = 0) -> dict:
    key = jax.random.key(seed)
    ks = jax.random.split(key, 26)
    f32 = jnp.float32

    def nrm(k, shape, s):
        return jax.random.normal(k, shape, f32) * s

    G, P, H = SSM_GROUPS, SSM_STATE, SSM_GROUP
    n_idx = jnp.arange(SSM_STATE, dtype=f32)
    return {
        "x": nrm(ks[0], (BATCH, SEQ, D_MODEL), 1.0),
        "norm1_g": 1.0 + nrm(ks[1], (DEPTH, D_MODEL), 0.05),
        "w_in": nrm(ks[2], (DEPTH, D_MODEL, IN_COLS), D_MODEL ** -0.5),
        "ssm_a_re": -0.5 + nrm(ks[3], (DEPTH, G, P), 0.01),
        "ssm_a_im": math.pi * n_idx + nrm(ks[4], (DEPTH, G, P), 0.01),
        "ssm_log_dt": jax.random.uniform(ks[5], (DEPTH, G), f32, math.log(SSM_DT_MIN), math.log(SSM_DT_MAX)),
        "ssm_b_re": nrm(ks[6], (DEPTH, G, P, H), (2 * H) ** -0.5),
        "ssm_b_im": nrm(ks[7], (DEPTH, G, P, H), (2 * H) ** -0.5),
        "ssm_c_re": nrm(ks[8], (DEPTH, G, H, P), (2 * P) ** -0.5),
        "ssm_c_im": nrm(ks[9], (DEPTH, G, H, P), (2 * P) ** -0.5),
        "ssm_d": nrm(ks[10], (DEPTH, G, H), 1.0),
        "ssm_w_glu": nrm(ks[11], (DEPTH, SSM_WIDTH, SSM_WIDTH), SSM_WIDTH ** -0.5),
        "ssm_b_glu": nrm(ks[12], (DEPTH, SSM_WIDTH), 0.01),
        "w_up_ssm": nrm(ks[13], (DEPTH, SSM_WIDTH, D_MODEL), SSM_WIDTH ** -0.5),
        "w_up_att": nrm(ks[14], (DEPTH, ATT_WIDTH, D_MODEL), ATT_WIDTH ** -0.5),
        "rel_bias": nrm(ks[15], (REL_BUCKETS, ATT_HEADS), 0.5),
        "w_out": nrm(ks[16], (DEPTH, D_MODEL, D_MODEL), D_MODEL ** -0.5),
        "norm2_g": 1.0 + nrm(ks[17], (DEPTH, D_MODEL), 0.05),
        "peer_w_q": nrm(ks[18], (DEPTH, D_MODEL, PEER_HEADS * PEER_QDIM), D_MODEL ** -0.5),
        "peer_sub_k1": nrm(ks[19], (DEPTH, PEER_NKEYS, PEER_QDIM // 2), (PEER_QDIM // 2) ** -0.5),
        "peer_sub_k2": nrm(ks[20], (DEPTH, PEER_NKEYS, PEER_QDIM // 2), (PEER_QDIM // 2) ** -0.5),
        "peer_u": nrm(ks[21], (DEPTH, PEER_EXPERTS, D_MODEL), D_MODEL ** -0.5),
        "peer_v": nrm(ks[22], (DEPTH, PEER_EXPERTS, D_MODEL), PEER_HEADS ** -0.5),
        "final_g": 1.0 + nrm(ks[23], (D_MODEL,), 0.05),
    }


def reference(x, norm1_g, w_in, ssm_a_re, ssm_a_im, ssm_log_dt, ssm_b_re, ssm_b_im, ssm_c_re, ssm_c_im,
              ssm_d, ssm_w_glu, ssm_b_glu, w_up_ssm, w_up_att, rel_bias, w_out, norm2_g, peer_w_q,
              peer_sub_k1, peer_sub_k2, peer_u, peer_v, final_g):
    for l in range(DEPTH):
        h = rms_norm(x, norm1_g[l])
        z = h @ w_in[l]
        u_ssm, q, k, v, g_a, g_b = jnp.split(z, IN_SPLITS, axis=-1)
        y_a = s5_branch(u_ssm, ssm_a_re[l], ssm_a_im[l], ssm_log_dt[l], ssm_b_re[l], ssm_b_im[l],
                        ssm_c_re[l], ssm_c_im[l], ssm_d[l], ssm_w_glu[l], ssm_b_glu[l])
        y_b = moba_branch(q, k, v, rel_bias)
        merged = (jax.nn.sigmoid(g_a) * (y_a @ w_up_ssm[l])
                  + jax.nn.sigmoid(g_b) * (y_b @ w_up_att[l]))
        x = x + merged @ w_out[l]
        x = x + peer_ffn(rms_norm(x, norm2_g[l]), peer_w_q[l], peer_sub_k1[l], peer_sub_k2[l],
                         peer_u[l], peer_v[l])
    return rms_norm(x, final_g)
```

```cpp
#include <hip/hip_runtime.h>
#include <hip/hip_bf16.h>
#include <cstdio>
#include <cstdint>
#include <cmath>

#ifndef MK_N_LAUNCHES
#define MK_N_LAUNCHES 1
#endif

namespace pg8 {
#define PG8_LAS __attribute__((address_space(3)))
typedef unsigned short bf16_t;
typedef short bf16x8 __attribute__((ext_vector_type(8)));
typedef float f32x4 __attribute__((ext_vector_type(4)));
typedef unsigned u32x4 __attribute__((ext_vector_type(4)));
constexpr int BM = 256, BK = 64, HALF = 128, HTB = HALF * BK * 2, STAGE_BYTES = 8 * HTB, NXCD = 8, WGM = 8;

__host__ __device__ __forceinline__ int lds_byte(int r, int c) { const int st = (r >> 4) * 2 + (c >> 5), rr = r & 15, cc = c & 31, ob = rr * 64 + cc * 2; return st * 1024 + (ob ^ (((ob >> 9) & 1) << 5)); }
__host__ __device__ __forceinline__ void stage_rc(int b, int& R, int& C) { const int st = b / 1024, sb = b % 1024, swz = sb ^ (((sb >> 9) & 1) << 5); R = (st >> 1) * 16 + swz / 64; C = (st & 1) * 32 + (swz % 64) / 2; }
__host__ __device__ __forceinline__ int perm32(int rho) { const int n = rho >> 4, i = rho & 15; return 8 * (i >> 2) + 4 * n + (i & 3); }

struct Unit { int pm, pn, w; };
struct Gemm { const bf16_t* A; const bf16_t* Bt; int M, N, K, lda, ldb, rpg; size_t bgs; const bf16_t* A2 = nullptr; const bf16_t* Bt2 = nullptr; };

struct StaticOrder {
    int nM, nN, nwg, G, c;
    __host__ __device__ __forceinline__ void init(int M, int N, int G_, int c_) { nM = M / BM; nN = N / BM; nwg = nM * nN; G = G_; c = c_; }
    __host__ __device__ __forceinline__ bool next(int i, Unit& u) const {
        const long L = (long)i * G + c; if (L >= nwg) return false;
        int wgid = (int)L; { const int q = nwg / NXCD, r = nwg % NXCD, xcd = wgid % NXCD, off = wgid / NXCD; wgid = (xcd < r ? xcd * (q + 1) : r * (q + 1) + (xcd - r) * q) + off; }
        const int nig = WGM * nN, gid = wgid / nig, fm = gid * WGM, gsz = (nM - fm) < WGM ? (nM - fm) : WGM;
        u.pm = fm + ((wgid % nig) % gsz); u.pn = (wgid % nig) / gsz; u.w = 0; return true;
    }
};

__device__ __forceinline__ unsigned cvt_pk_bf16(float lo, float hi) { unsigned r; asm volatile("v_cvt_pk_bf16_f32 %0, %1, %2" : "=v"(r) : "v"(lo), "v"(hi)); return r; }
__device__ __forceinline__ float bf_lo(unsigned w) { return __uint_as_float(w << 16); }
__device__ __forceinline__ float bf_hi(unsigned w) { return __uint_as_float(w & 0xffff0000u); }
__device__ __forceinline__ float sigmoid_f(float x) { return __builtin_amdgcn_rcpf(1.0f + __builtin_amdgcn_exp2f(-1.4426950409f * x)); }
__device__ __forceinline__ float gelu_tanh(float x) { const float u = x + 0.044715f * x * x * x; return x * __builtin_amdgcn_rcpf(1.0f + __builtin_amdgcn_exp2f(-2.3022081985f * u)); }

template <class Epi, class Sched, bool ALIGN_EPI>
__device__ __forceinline__ void gemm_phase(PG8_LAS unsigned char* lds, const Gemm g, const Sched& S, const Epi& E) {
    int tid = threadIdx.x; asm volatile("" : "+v"(tid));
    const int wid = __builtin_amdgcn_readfirstlane(tid >> 6), lane = tid & 63, wr = wid >> 2, wc = wid & 3, fr = lane & 15, fq = lane >> 4;
    const int K = g.K, nt = K / BK;
    unsigned voffA[2], voffB[2];
#pragma unroll
    for (int i = 0; i < 2; ++i) { int R, C; stage_rc(tid * 16 + i * 8192, R, C); const int Rb = Epi::PERM ? ((R & ~31) + perm32(R & 31)) : R;
        voffA[i] = (unsigned)(R * g.lda + C) * 2u; voffB[i] = (unsigned)(Rb * g.ldb + C) * 2u; }
    const size_t kstep = (size_t)(BK * 2);
    const size_t hstepA = (size_t)HALF * g.lda * 2, hstepB = (size_t)HALF * g.ldb * 2;
    const size_t tstepA = 2 * hstepA, tstepB = 2 * hstepB;
    const unsigned ldsw = (unsigned)wid * 1024u;
    const int aoff = lds_byte(wr * 64 + fr, fq * 8), boff = lds_byte(wc * 32 + fr, fq * 8);
#define PG8_SA(b, h) (((b) * 2 + (h)) * HTB)
#define PG8_SB(b, h) ((4 + (b) * 2 + (h)) * HTB)
#define PG8_STAGE(bufoff, gbase, voff) do { _Pragma("unroll") for (int _i = 0; _i < 2; ++_i) \
        __builtin_amdgcn_global_load_lds((const unsigned*)((const char*)(gbase) + (voff)[_i]), (PG8_LAS unsigned*)(lds + (bufoff) + ldsw + _i * 8192), 16, 0, 0); } while (0)
#define PG8_LDA(dst, b, h) do { _Pragma("unroll") for (int m = 0; m < 4; ++m) _Pragma("unroll") for (int k = 0; k < 2; ++k) dst[m][k] = *(const PG8_LAS bf16x8*)(lds + PG8_SA(b, h) + aoff + m * 2048 + k * 1024); } while (0)
#define PG8_LDB(dst, b, h) do { _Pragma("unroll") for (int n = 0; n < 2; ++n) _Pragma("unroll") for (int k = 0; k < 2; ++k) dst[n][k] = *(const PG8_LAS bf16x8*)(lds + PG8_SB(b, h) + boff + n * 2048 + k * 1024); } while (0)
#define PG8_MMA(ai, bj, At, Bt) do { __builtin_amdgcn_s_setprio(1); _Pragma("unroll") for (int m = 0; m < 4; ++m) _Pragma("unroll") for (int n = 0; n < 2; ++n) _Pragma("unroll") for (int k = 0; k < 2; ++k) \
        acc[ai][bj][m][n] = __builtin_amdgcn_mfma_f32_16x16x32_bf16(Bt[n][k], At[m][k], acc[ai][bj][m][n], 0, 0, 0); __builtin_amdgcn_s_setprio(0); } while (0)
#define PG8_WAIT_V(n) asm volatile("s_waitcnt vmcnt(" #n ")" ::: "memory")
#define PG8_WAIT_L(n) asm volatile("s_waitcnt lgkmcnt(" #n ")" ::: "memory")
#define PG8_BAR __builtin_amdgcn_s_barrier()
#define PG8_SCHED __builtin_amdgcn_sched_barrier(0)
    Unit cur, nxt; int ui = 0;
    if (!S.next(0, cur)) return;
    f32x4 acc[2][2][4][2];
#pragma unroll
    for (int a = 0; a < 2; ++a)
#pragma unroll
        for (int b = 0; b < 2; ++b)
#pragma unroll
            for (int m = 0; m < 4; ++m)
#pragma unroll
                for (int n = 0; n < 2; ++n) acc[a][b][m][n] = (f32x4){0.f, 0.f, 0.f, 0.f};
    bf16x8 At[4][2], B0[2][2], B1[2][2];
    const char* cA = (const char*)(cur.w ? g.A2 : g.A) + (size_t)cur.pm * tstepA;
    const char* cB = (const char*)(cur.w ? g.Bt2 : g.Bt) + (size_t)(cur.pm / g.rpg) * g.bgs * 2 + (size_t)cur.pn * tstepB;
    PG8_STAGE(PG8_SB(0, 0), cB, voffB); PG8_STAGE(PG8_SB(0, 1), cB + hstepB, voffB); PG8_STAGE(PG8_SA(0, 0), cA, voffA); PG8_STAGE(PG8_SA(0, 1), cA + hstepA, voffA);
    if (wr == 1) PG8_BAR;
    PG8_WAIT_V(2); PG8_BAR;
    PG8_STAGE(PG8_SB(1, 0), cB + kstep, voffB); PG8_STAGE(PG8_SA(1, 0), cA + kstep, voffA); PG8_STAGE(PG8_SB(1, 1), cB + hstepB + kstep, voffB);
    PG8_WAIT_V(6); PG8_BAR;
    for (;;) {
        const bool has_next = S.next(ui + 1, nxt);
        const char* nA = has_next ? (const char*)(nxt.w ? g.A2 : g.A) + (size_t)nxt.pm * tstepA : cA;
        const char* nB = has_next ? (const char*)(nxt.w ? g.Bt2 : g.Bt) + (size_t)(nxt.pm / g.rpg) * g.bgs * 2 + (size_t)nxt.pn * tstepB : cB;
        for (int t = 0; t < nt; t += 2) {
            const bool last = (t == nt - 2);
            const char* a1 = cA + (size_t)(t + 1) * kstep;
            const char* a2 = last ? nA : cA + (size_t)(t + 2) * kstep; const char* b2 = last ? nB : cB + (size_t)(t + 2) * kstep;
            const char* a3 = a2 + kstep; const char* b3 = b2 + kstep;
            PG8_LDB(B0, 0, 0); PG8_LDB(B1, 0, 1); PG8_SCHED; PG8_LDA(At, 0, 0); PG8_STAGE(PG8_SA(1, 1), a1 + hstepA, voffA);
            PG8_WAIT_V(8); PG8_WAIT_L(0); PG8_BAR; PG8_MMA(0, 0, At, B0); PG8_MMA(0, 1, At, B1); PG8_BAR; PG8_SCHED;
            PG8_LDA(At, 0, 1); PG8_STAGE(PG8_SB(0, 0), b2, voffB); PG8_STAGE(PG8_SB(0, 1), b2 + hstepB, voffB); PG8_STAGE(PG8_SA(0, 0), a2, voffA);
            PG8_WAIT_V(8); PG8_WAIT_L(0); PG8_BAR; PG8_MMA(1, 0, At, B0); PG8_MMA(1, 1, At, B1); PG8_BAR; PG8_SCHED;
            PG8_LDB(B0, 1, 0); PG8_LDB(B1, 1, 1); PG8_SCHED; PG8_LDA(At, 1, 0); PG8_STAGE(PG8_SA(0, 1), a2 + hstepA, voffA);
            PG8_WAIT_V(8); PG8_WAIT_L(0); PG8_BAR; PG8_MMA(0, 0, At, B0); PG8_MMA(0, 1, At, B1); PG8_BAR; PG8_SCHED;
            PG8_LDA(At, 1, 1); PG8_STAGE(PG8_SB(1, 0), b3, voffB); PG8_STAGE(PG8_SB(1, 1), b3 + hstepB, voffB); PG8_STAGE(PG8_SA(1, 0), a3, voffA);
            PG8_WAIT_V(8); PG8_WAIT_L(0); PG8_BAR; PG8_MMA(1, 0, At, B0); PG8_MMA(1, 1, At, B1); PG8_BAR; PG8_SCHED;
        }
        if constexpr (ALIGN_EPI) { if (wr == 0) PG8_BAR; }
        E(acc, cur, wr, wc, fr, fq);
        if (!has_next) break;
#pragma unroll
        for (int a = 0; a < 2; ++a)
#pragma unroll
            for (int b = 0; b < 2; ++b)
#pragma unroll
                for (int m = 0; m < 4; ++m)
#pragma unroll
                    for (int n = 0; n < 2; ++n) acc[a][b][m][n] = (f32x4){0.f, 0.f, 0.f, 0.f};
        cur = nxt; cA = nA; cB = nB; ++ui;
        if constexpr (ALIGN_EPI) { if (wr == 1) PG8_BAR; }
    }
    PG8_WAIT_V(0);
    if constexpr (!ALIGN_EPI) { if (wr == 0) PG8_BAR; }
    PG8_BAR;
#undef PG8_SA
#undef PG8_SB
#undef PG8_STAGE
#undef PG8_LDA
#undef PG8_LDB
#undef PG8_MMA
#undef PG8_WAIT_V
#undef PG8_WAIT_L
#undef PG8_BAR
#undef PG8_SCHED
}
}
namespace attn_body {
using bf16=__hip_bfloat16;
using bf16x8=__attribute__((ext_vector_type(8)))short;
using s16x4=__attribute__((ext_vector_type(4)))short;
using f32x16=__attribute__((ext_vector_type(16)))float;
using f32x4v=__attribute__((ext_vector_type(4)))float;
using u32x4=__attribute__((ext_vector_type(4)))unsigned;
constexpr int BATCH=8,NHEAD=8,SEQ=2048,D=64,DM=NHEAD*D;
constexpr int NW=8,QBLK=32,QB=QBLK*NW,KVBLK=64,NQB=SEQ/QB;
__device__ __forceinline__ int crow(int r,int hi){return (r&3)+8*(r>>2)+4*hi;}
#define SBAR() __builtin_amdgcn_sched_barrier(0)
__device__ __forceinline__ void cmask(f32x16&p0,f32x16&p1,int jb,int qrel,int hi){
  const float NEG=-INFINITY; int kb=64*jb+4*hi;
  #pragma unroll
  for(int r=0;r<16;++r){int kv=kb+(r&3)+8*(r>>2); if(kv>qrel)p0[r]=NEG; if(kv+32>qrel)p1[r]=NEG;}
}
typedef __attribute__((address_space(3))) const float* lds_cfptr;
__device__ __forceinline__ void biasadd(f32x16&p0,f32x16&p1,int jb,int qrel,int hi,lds_cfptr bt){
  const int base=qrel-64*jb-4*hi;
  #pragma unroll
  for(int r4=0;r4<16;r4+=4){
    #pragma unroll
    for(int r=r4;r<r4+4;++r){int rel=base-((r&3)+8*(r>>2)); int i0=min(max(rel,0),127), i1=min(max(rel-32,0),127); p0[r]+=bt[i0]; p1[r]+=bt[i1];}
    asm volatile("s_waitcnt lgkmcnt(0)":"+v"(p0),"+v"(p1)::"memory"); }
}

constexpr int NSLOT=3, SLOTB=8192;
constexpr int LDS_K=0, LDS_V=NSLOT*SLOTB, LDS_WS=2*NSLOT*SLOTB, LDS_OST=LDS_WS+NW*64*4, LDS_KM=LDS_OST+NW*4096, LDS_BT=LDS_KM+7*64*4, LDS_BYTES=LDS_BT+128*4;
constexpr float C2=0.125f*1.4426950408889634f;
__device__ __forceinline__ void glds16(const void*gsrc,unsigned lds_dst){unsigned keep;
  asm volatile("s_mov_b32 %0, m0\n\ts_mov_b32 m0, %2\n\ts_nop 0\n\tglobal_load_lds_dwordx4 %1, off\n\ts_mov_b32 m0, %0":"=&s"(keep):"v"(gsrc),"s"(lds_dst):"memory");}
__device__ __forceinline__ float max3f(float a,float b,float c){float r;asm("v_max3_f32 %0, %1, %2, %3":"=v"(r):"v"(a),"v"(b),"v"(c));return r;}
__device__ __forceinline__ float max2f(float a,float b){float r;asm("v_max_f32_e32 %0, %1, %2":"=v"(r):"v"(a),"v"(b));return r;}
__device__ __forceinline__ float fadd_s(float a,float b){float r;asm("v_add_f32_e32 %0, %1, %2":"=v"(r):"v"(a),"v"(b));return r;}
__device__ __forceinline__ float fsub_s(float a,float b){float r;asm("v_sub_f32_e32 %0, %1, %2":"=v"(r):"v"(a),"v"(b));return r;}
typedef float f32x2_t __attribute__((ext_vector_type(2))); typedef __bf16 bf16x2_t __attribute__((ext_vector_type(2)));
__device__ __forceinline__ unsigned cvtpk_s(float lo,float hi){f32x2_t v={lo,hi};bf16x2_t b=__builtin_convertvector(v,bf16x2_t);return __builtin_bit_cast(unsigned,b);}
#define WAIT_BAR(N) asm volatile("s_waitcnt vmcnt(" #N ") lgkmcnt(0)\n\ts_barrier":::"memory")

__device__ __forceinline__ void qkt(f32x16&p0,f32x16&p1,const char*Kslot,const bf16x8*qr,int r32,int hi){
  const char*kb=Kslot+hi*1024+r32*16;
  #pragma unroll
  for(int d0=0;d0<4;++d0){
    const bf16x8 b0=*reinterpret_cast<const bf16x8*>(kb+d0*2048);
    const bf16x8 b1=*reinterpret_cast<const bf16x8*>(kb+d0*2048+512);
    if(d0==0){p0=__builtin_amdgcn_mfma_f32_32x32x16_bf16(b0,qr[0],(f32x16){},0,0,0);p1=__builtin_amdgcn_mfma_f32_32x32x16_bf16(b1,qr[0],(f32x16){},0,0,0);}
    else{p0=__builtin_amdgcn_mfma_f32_32x32x16_bf16(b0,qr[d0],p0,0,0,0);p1=__builtin_amdgcn_mfma_f32_32x32x16_bf16(b1,qr[d0],p1,0,0,0);}}
}
typedef __attribute__((address_space(3))) const char* lds_cptr;
typedef short v4i16_t __attribute__((ext_vector_type(4)));
__device__ __forceinline__ void kload8(bf16x8*kf,lds_cptr kp){
  kf[0]=*(const __attribute__((address_space(3))) bf16x8*)(kp);      kf[1]=*(const __attribute__((address_space(3))) bf16x8*)(kp+512);
  kf[2]=*(const __attribute__((address_space(3))) bf16x8*)(kp+2048); kf[3]=*(const __attribute__((address_space(3))) bf16x8*)(kp+2560);
  kf[4]=*(const __attribute__((address_space(3))) bf16x8*)(kp+4096); kf[5]=*(const __attribute__((address_space(3))) bf16x8*)(kp+4608);
  kf[6]=*(const __attribute__((address_space(3))) bf16x8*)(kp+6144); kf[7]=*(const __attribute__((address_space(3))) bf16x8*)(kp+6656);
}
__device__ __forceinline__ void kload2(bf16x8*kf,lds_cptr kp,int j){ kf[2*j]=*(const __attribute__((address_space(3))) bf16x8*)(kp+j*2048); kf[2*j+1]=*(const __attribute__((address_space(3))) bf16x8*)(kp+j*2048+512); }
__device__ __forceinline__ s16x4 vtr(lds_cptr p){ return __builtin_bit_cast(s16x4,__builtin_amdgcn_ds_read_tr16_b64_v4i16((__attribute__((address_space(3))) v4i16_t*)p)); }
__device__ __forceinline__ float rowmax(const f32x16&p0,const f32x16&p1){
  float a=max3f(p0[0],p0[1],p1[0]),b=max3f(p0[2],p0[3],p1[1]);a=max3f(a,p1[2],p1[3]);
  #pragma unroll
  for(int r=4;r<16;r+=4){a=max3f(a,p0[r],p0[r+1]);b=max3f(b,p0[r+2],p0[r+3]);a=max3f(a,p1[r],p1[r+1]);b=max3f(b,p1[r+2],p1[r+3]);}
  const float m=max2f(a,b);
  auto rr=__builtin_amdgcn_permlane32_swap(__float_as_uint(m),__float_as_uint(m),false,false);
  return max2f(__uint_as_float(rr[0]),__uint_as_float(rr[1]));
}
__device__ __forceinline__ void pv(f32x16*o,int vb,bf16x8 pa0,bf16x8 pa1,bf16x8 pa2,bf16x8 pa3){
  #pragma unroll
  for(int d0=0;d0<2;++d0){s16x4 lo[4],hi[4];
    #pragma unroll
    for(int ks=0;ks<4;++ks){
      asm volatile("ds_read_b64_tr_b16 %0,%1 offset:%c2":"=&v"(lo[ks]):"v"(vb),"i"(d0*4096+ks*1024):"memory");
      asm volatile("ds_read_b64_tr_b16 %0,%1 offset:%c2":"=&v"(hi[ks]):"v"(vb),"i"(d0*4096+ks*1024+512):"memory");}
    asm volatile("s_waitcnt lgkmcnt(0)":::"memory");SBAR();
    #define PK(k) (bf16x8){lo[k][0],lo[k][1],lo[k][2],lo[k][3],hi[k][0],hi[k][1],hi[k][2],hi[k][3]}
    o[d0]=__builtin_amdgcn_mfma_f32_32x32x16_bf16(pa0,PK(0),o[d0],0,0,0);
    o[d0]=__builtin_amdgcn_mfma_f32_32x32x16_bf16(pa1,PK(1),o[d0],0,0,0);
    o[d0]=__builtin_amdgcn_mfma_f32_32x32x16_bf16(pa2,PK(2),o[d0],0,0,0);
    o[d0]=__builtin_amdgcn_mfma_f32_32x32x16_bf16(pa3,PK(3),o[d0],0,0,0);
    #undef PK
  }
}

#ifndef ATTN_STORE16
#define ATTN_STORE16(p,v) (*(u32x4*)(p)=(v))
#endif
template<int THRL> __device__ __forceinline__ void attn_unit(int b,int h,int qb,const bf16*Q,const bf16*__restrict__ K,const bf16*__restrict__ V,bf16*O,char*shm,const float*kpart,const float*btab){
  int tid=threadIdx.x; asm volatile("":"+v"(tid));
  const int lane=tid&63,r32=lane&31,hi=lane>>5; const int wid=__builtin_amdgcn_readfirstlane(tid>>6);
  const long rowbase=(long)b*SEQ; const int q0=qb*QB;
  const bf16*Qw=Q+(rowbase+q0+wid*QBLK)*DM+h*D;
  const bf16*Kh=K+rowbase*DM+h*D,*Vh=V+rowbase*DM+h*D;
  const unsigned lds0=(unsigned)(uintptr_t)shm;
  float*wsf=(float*)(shm+LDS_WS)+wid*64;
  const bf16*ksrc=Kh+(long)lane*DM+wid*8;
  const bf16*vsrc=Vh+(long)(16*(wid&3)+(lane>>2))*DM+(wid>>2)*32+(lane&3)*8;
  const unsigned kdst=lds0+LDS_K+wid*1024, vdst=lds0+LDS_V+wid*1024;
  #define DMA_K(t,slot) glds16(ksrc+(long)(t)*KVBLK*DM,(unsigned)__builtin_amdgcn_readfirstlane(kdst+(slot)))
  #define DMA_V(t,slot) glds16(vsrc+(long)(t)*KVBLK*DM,(unsigned)__builtin_amdgcn_readfirstlane(vdst+(slot)))
  const int vb0=(int)(lds0+LDS_V)+((lane>>4)&1)*32+(lane&3)*8+(4*hi+((lane&15)>>2))*64;
  const char*Kbase=shm+LDS_K; bf16x8 kf[8];
  const lds_cptr shm3=(lds_cptr)shm; const lds_cptr kp0=shm3+LDS_K+hi*1024+r32*16; const lds_cptr vp0=shm3+LDS_V+((lane>>4)&1)*32+(lane&3)*8+(4*hi+((lane&15)>>2))*64;
  const lds_cfptr btl=(lds_cfptr)(shm3+LDS_BT);
  const int NT=(q0+QB)/KVBLK;
  DMA_K(0,0);DMA_V(0,0);DMA_K(1,SLOTB);
  bf16x8 qr[4];
  #pragma unroll
  for(int d0=0;d0<4;++d0)qr[d0]=*reinterpret_cast<const bf16x8*>(&Qw[(long)r32*DM+d0*16+hi*8]);
  { float*km=(float*)(shm+LDS_KM); float*bt=(float*)(shm+LDS_BT); int tq=tid; asm volatile("":"+v"(tq));
    if(tq<448){const int j=tq>>6,d=tq&63; float v=0.f; if(j<qb&&qb>3){const float*kp=kpart+((size_t)((b*NQB+j)*2)*512)+h*D+d; v=(kp[0]+kp[512])*(1.0f/256.0f);} km[tq]=v;}
    else if(tq<448+64){const int i=tq-448; bt[i]=btab[h*128+i]; bt[64+i]=btab[h*128+64+i];} }
  float mhat=0.f,l_reg=0.f;f32x16 o[2];o[0]=f32x16{};o[1]=f32x16{};f32x16 negu=f32x16{};
  const int qrel=wid*QBLK+r32;
  #define CMASK(P0,P1,t) do{int jb_=(t)-(NT-4);   \
    if(jb_>=-2 && 32*wid+31-64*jb_>=0 && 32*wid-64*jb_-63<=112)biasadd(P0,P1,jb_,qrel,hi,btl); if(jb_>=0 && 64*jb_+63>32*wid)cmask(P0,P1,jb_,qrel,hi);}while(0)
  bool resc=false;
  #define START(P0,P1,t) do{ float rm=rowmax(P0,P1); resc=false; const float nv_=MASKADD(t); rm=fadd_s(rm,nv_); \
    { const float dl=__builtin_fmaxf(rm,-1.0e4f); mhat=fadd_s(mhat,dl); const float cc_=fsub_s(nv_,dl); \
      _Pragma("unroll") for(int r=0;r<16;++r){P0[r]=fadd_s(P0[r],cc_);P1[r]=fadd_s(P1[r],cc_);} } \
    _Pragma("unroll") for(int r=0;r<16;++r)P0[r]=__builtin_amdgcn_exp2f(P0[r]); }while(0)
  #define RESC() do{ if(resc){ asm volatile("s_waitcnt lgkmcnt(0)":::"memory"); \
      _Pragma("unroll") for(int d_=0;d_<2;++d_) _Pragma("unroll") for(int r=0;r<16;++r)o[d_][r]*=wsf[crow(r,hi)]; } }while(0)
  f32x16 pA0,pA1,pB0,pB1;
  int sl_prev=0,sl_cur=0,sl_next=SLOTB;
  #define ROT() do{sl_prev=sl_cur;sl_cur=sl_next;sl_next=(sl_next==(NSLOT-1)*SLOTB)?0:sl_next+SLOTB;}while(0)
  DMA_K(2,2*SLOTB);
  WAIT_BAR(3);
  unsigned selbits=(1u<<qb)-1u;
  if(qb>3){ selbits=0u;
    const __attribute__((address_space(3))) float* km3=(const __attribute__((address_space(3))) float*)(shm3+LDS_KM);
    float qf[32];
    #pragma unroll
    for(int d0=0;d0<4;++d0){
      #pragma unroll
      for(int i=0;i<8;++i) qf[d0*8+i]=__uint_as_float(((unsigned)(unsigned short)qr[d0][i])<<16);}
    float gj[7];
    #pragma unroll
    for(int j=0;j<7;++j){ float s=0.f;
      if(j<qb){
        #pragma unroll
        for(int d0=0;d0<4;++d0){ const f32x4v k0=*(const __attribute__((address_space(3))) f32x4v*)(km3+j*64+d0*16+hi*8); const f32x4v k1=*(const __attribute__((address_space(3))) f32x4v*)(km3+j*64+d0*16+hi*8+4);
          s+=qf[d0*8+0]*k0[0]+qf[d0*8+1]*k0[1]+qf[d0*8+2]*k0[2]+qf[d0*8+3]*k0[3]+qf[d0*8+4]*k1[0]+qf[d0*8+5]*k1[1]+qf[d0*8+6]*k1[2]+qf[d0*8+7]*k1[3]; }
        auto rr=__builtin_amdgcn_permlane32_swap(__float_as_uint(s),__float_as_uint(s),false,false); s=__uint_as_float(rr[0])+__uint_as_float(rr[1]); }
      gj[j]=s; }
    #pragma unroll
    for(int j=0;j<7;++j){ int rank=0;
      #pragma unroll
      for(int k=0;k<7;++k){ if(k!=j){ const bool beats=(k<j)?(gj[k]>=gj[j]):(gj[k]>gj[j]); rank+=(k<qb&&beats)?1:0; } }
      if(j<qb&&rank<3)selbits|=(1u<<j); }
  }
  #define MASKADD(t) ((((t)>>2)<qb && !((selbits>>((t)>>2))&1u))?-1.0e30f:0.0f)
  qkt(pA0,pA1,Kbase,qr,r32,hi);asm volatile("s_nop 15\n\ts_nop 7":"+v"(pA0),"+v"(pA1));CMASK(pA0,pA1,0);
  START(pA0,pA1,0);
  _Pragma("unroll") for(int r=0;r<16;++r)pA1[r]=__builtin_amdgcn_exp2f(pA1[r]);
  WAIT_BAR(0);
  DMA_K(3,0);DMA_V(1,SLOTB);
  ROT();
  kload8(kf,kp0+sl_cur);
  WAIT_BAR(2);
  s16x4 vlo[8],vhi[8]; u32x4 pw0,pw1,pw2,pw3;
  #define PKW(P,B) cvtpk_s(P[B],P[B+1])
  #define PAF(k) __builtin_bit_cast(bf16x8,pw##k)
  #define VFR(i) (bf16x8){vlo[i][0],vlo[i][1],vlo[i][2],vlo[i][3],vhi[i][0],vhi[i][1],vhi[i][2],vhi[i][3]}
  #define PIN(x) asm volatile("":"+v"(x))
  #define MX3(a,b,c) __builtin_fmaxf(__builtin_fmaxf((a),(b)),(c))
  #define GAPA(MF,A0,A1,A2,A3,W0,W1,PW) do{ MF; sacc+=A0; sacc+=A1; sacc+=A2; sacc+=A3; PIN(sacc); W0; W1; PIN(PW); SBAR(); }while(0)
  #define EX(v) __builtin_amdgcn_exp2f(v)
  #define GAPB(MF,X,B) do{ MF; X[B]=EX(X[B]); X[B+1]=EX(X[B+1]); X[B+2]=EX(X[B+2]); X[B+3]=EX(X[B+3]); PIN(X); SBAR(); }while(0)
  #define VRD(i) do{ vlo[i]=vtr(vp_+(((i)>>2)*4096+((i)&3)*1024)); vhi[i]=vtr(vp_+(((i)>>2)*4096+((i)&3)*1024+512)); }while(0)
  #define KRD(G,j) do{ if(G){ kload2(kf,kp0+sl_next,j); SBAR(); } }while(0)
  #define STEP(C0,C1,P0,P1,t,GK,GV,GL) do{ { const float nv0_=MASKADD(t)-mhat; _Pragma("unroll") for(int r=0;r<16;++r)negu[r]=nv0_; asm volatile("":"+v"(negu)); } SBAR(); \
    const lds_cptr vp_=vp0+sl_prev; \
    VRD(0); SBAR(); float sacc=(P0[0]+P0[1]); \
    GAPA(C0=__builtin_amdgcn_mfma_f32_32x32x16_bf16(kf[0],qr[0],negu,0,0,0), P0[2],P0[3],P0[4],P0[5],     pw0[0]=PKW(P0,0), pw0[1]=PKW(P0,2), pw0); \
    VRD(4); SBAR(); GAPA(C1=__builtin_amdgcn_mfma_f32_32x32x16_bf16(kf[1],qr[0],negu,0,0,0), P0[6],P0[7],P0[8],P0[9],     pw0[2]=PKW(P0,4), pw0[3]=PKW(P0,6), pw0); \
    VRD(1); SBAR(); GAPA(C0=__builtin_amdgcn_mfma_f32_32x32x16_bf16(kf[2],qr[1],C0,0,0,0),   P0[10],P0[11],P0[12],P0[13], pw1[0]=PKW(P0,8), pw1[1]=PKW(P0,10), pw1); \
    VRD(5); SBAR(); GAPA(C1=__builtin_amdgcn_mfma_f32_32x32x16_bf16(kf[3],qr[1],C1,0,0,0),   P0[14],P0[15],P1[0],P1[1],   pw1[2]=PKW(P0,12),pw1[3]=PKW(P0,14), pw1); \
    VRD(2); SBAR(); GAPA(C0=__builtin_amdgcn_mfma_f32_32x32x16_bf16(kf[4],qr[2],C0,0,0,0),   P1[2],P1[3],P1[4],P1[5],     pw2[0]=PKW(P1,0), pw2[1]=PKW(P1,2), pw2); \
    VRD(6); SBAR(); GAPA(C1=__builtin_amdgcn_mfma_f32_32x32x16_bf16(kf[5],qr[2],C1,0,0,0),   P1[6],P1[7],P1[8],P1[9],     pw2[2]=PKW(P1,4), pw2[3]=PKW(P1,6), pw2); \
    VRD(3); SBAR(); GAPA(C0=__builtin_amdgcn_mfma_f32_32x32x16_bf16(kf[6],qr[3],C0,0,0,0),   P1[10],P1[11],P1[12],P1[13], pw3[0]=PKW(P1,8), pw3[1]=PKW(P1,10), pw3); \
    VRD(7); SBAR(); GAPA(C1=__builtin_amdgcn_mfma_f32_32x32x16_bf16(kf[7],qr[3],C1,0,0,0),   P1[14],P1[15],0.f,0.f,       pw3[2]=PKW(P1,12),pw3[3]=PKW(P1,14), pw3); \
    l_reg+=sacc; \
    if(GK){DMA_K((t)+3,sl_cur);} if(GV){DMA_V((t)+1,sl_next);} \
    CMASK(C0,C1,t); \
    { float a=MX3(C0[0],C0[1],C1[0]),b=MX3(C0[2],C0[3],C1[1]); a=MX3(a,C1[2],C1[3]); \
      _Pragma("unroll") for(int r=4;r<16;r+=4){a=MX3(a,C0[r],C0[r+1]);b=MX3(b,C0[r+2],C0[r+3]);a=MX3(a,C1[r],C1[r+1]);b=MX3(b,C1[r+2],C1[r+3]);} \
      float rm=__builtin_fmaxf(a,b); { auto rr=__builtin_amdgcn_permlane32_swap(__float_as_uint(rm),__float_as_uint(rm),false,false); rm=__builtin_fmaxf(__uint_as_float(rr[0]),__uint_as_float(rr[1])); } \
      resc=false; \
      if(__builtin_expect(__any(rm>(float)THRL),0)){ const float dl=__builtin_fmaxf(rm,0.f); mhat+=dl; \
        _Pragma("unroll") for(int r=0;r<16;++r){C0[r]-=dl;C1[r]-=dl;} \
        const float f=__builtin_amdgcn_exp2f(-dl); l_reg*=f; if(hi==0)wsf[r32]=f; resc=true; } } \
    SBAR(); \
    GAPB(o[0]=__builtin_amdgcn_mfma_f32_32x32x16_bf16(PAF(0),VFR(0),o[0],0,0,0), C0,0); \
    GAPB(o[1]=__builtin_amdgcn_mfma_f32_32x32x16_bf16(PAF(0),VFR(4),o[1],0,0,0), C0,4); \
    KRD(GL,0); GAPB(o[0]=__builtin_amdgcn_mfma_f32_32x32x16_bf16(PAF(1),VFR(1),o[0],0,0,0), C0,8); \
    KRD(GL,1); GAPB(o[1]=__builtin_amdgcn_mfma_f32_32x32x16_bf16(PAF(1),VFR(5),o[1],0,0,0), C0,12); \
    KRD(GL,2); GAPB(o[0]=__builtin_amdgcn_mfma_f32_32x32x16_bf16(PAF(2),VFR(2),o[0],0,0,0), C1,0); \
    KRD(GL,3); GAPB(o[1]=__builtin_amdgcn_mfma_f32_32x32x16_bf16(PAF(2),VFR(6),o[1],0,0,0), C1,4); \
    GAPB(o[0]=__builtin_amdgcn_mfma_f32_32x32x16_bf16(PAF(3),VFR(3),o[0],0,0,0), C1,8); \
    GAPB(o[1]=__builtin_amdgcn_mfma_f32_32x32x16_bf16(PAF(3),VFR(7),o[1],0,0,0), C1,12); \
    }while(0)
  int t=1;
  #undef CMASK
  #define CMASK(P0,P1,t) do{}while(0)
  for(;t+7<NT;t+=2){
    STEP(pB0,pB1,pA0,pA1,t,true,true,true);     WAIT_BAR(2); RESC(); ROT();
    STEP(pA0,pA1,pB0,pB1,t+1,true,true,true);   WAIT_BAR(2); RESC(); ROT();
  }
  #undef CMASK
  #define CMASK(P0,P1,t) do{int jb_=(t)-(NT-4);   \
    if(jb_>=-2 && 32*wid+31-64*jb_>=0 && 32*wid-64*jb_-63<=112)biasadd(P0,P1,jb_,qrel,hi,btl); if(jb_>=0 && 64*jb_+63>32*wid)cmask(P0,P1,jb_,qrel,hi);}while(0)
  #define ENDW(tt) do{ if((tt)+3<NT){WAIT_BAR(2);} else if((tt)+2<NT){WAIT_BAR(1);} else {WAIT_BAR(0);} }while(0)
  for(;t+1<NT;t+=2){
    STEP(pB0,pB1,pA0,pA1,t,(t+3<NT),(t+1<NT),(t+1<NT));       ENDW(t);   RESC(); ROT();
    STEP(pA0,pA1,pB0,pB1,t+1,(t+4<NT),(t+2<NT),(t+2<NT));     ENDW(t+1); RESC(); ROT();
  }
  STEP(pB0,pB1,pA0,pA1,NT-1,false,false,false); RESC();
  { float sacc=pB0[0]+pB0[1]; _Pragma("unroll") for(int r=2;r<16;++r)sacc+=pB0[r]; _Pragma("unroll") for(int r=0;r<16;++r)sacc+=pB1[r]; l_reg+=sacc;
    pw0=(u32x4){PKW(pB0,0),PKW(pB0,2),PKW(pB0,4),PKW(pB0,6)};pw1=(u32x4){PKW(pB0,8),PKW(pB0,10),PKW(pB0,12),PKW(pB0,14)};pw2=(u32x4){PKW(pB1,0),PKW(pB1,2),PKW(pB1,4),PKW(pB1,6)};pw3=(u32x4){PKW(pB1,8),PKW(pB1,10),PKW(pB1,12),PKW(pB1,14)};
    SBAR(); pv(o,vb0+sl_cur,PAF(0),PAF(1),PAF(2),PAF(3)); }
  #undef PKW
  #undef PAF
  #undef VFR
  #undef PIN
  #undef MX3
  #undef GAPA
  #undef GAPB
  #undef EX
  #undef VRD
  #undef KRD
  #undef STEP
  #undef ENDW
  #undef MASKADD
  {auto rr=__builtin_amdgcn_permlane32_swap(__float_as_uint(l_reg),__float_as_uint(l_reg),false,false);l_reg=__uint_as_float(rr[0])+__uint_as_float(rr[1]);}
  if(hi==0)wsf[32+r32]=l_reg;asm volatile("s_waitcnt lgkmcnt(0)":::"memory");
  float rli[16];
  #pragma unroll
  for(int r=0;r<16;++r)rli[r]=__builtin_amdgcn_rcpf(wsf[32+crow(r,hi)]);
  bf16*Ow=O+(rowbase+q0+wid*QBLK)*DM+h*D;
  { bf16*stg=(bf16*)(shm+LDS_OST)+wid*2048;
    #pragma unroll
    for(int r=0;r<16;++r){const int orow=crow(r,hi);
      #pragma unroll
      for(int d0=0;d0<2;++d0)stg[orow*64+d0*32+r32]=__float2bfloat16(o[d0][r]*rli[r]);}
    asm volatile("s_waitcnt lgkmcnt(0)":::"memory");
    #pragma unroll
    for(int i=0;i<4;++i){const int row=i*8+(lane>>3),ch=lane&7; const u32x4 v=*(const u32x4*)(stg+row*64+ch*8); ATTN_STORE16(Ow+(long)row*DM+ch*8,v);} }
  asm volatile("s_waitcnt lgkmcnt(0)\n\ts_barrier":::"memory");
  #undef DMA_K
  #undef DMA_V
  #undef CMASK
  #undef START
  #undef RESC
  #undef ROT
}
constexpr int ATTN_LDS_BYTES=LDS_BYTES;
#undef SBAR
#undef WAIT_BAR
}
constexpr int NWAVES = 8;
constexpr int PER_PHASE = 10;
constexpr int N_LAUNCHES = MK_N_LAUNCHES;

constexpr int BATCH = 8, SEQ = 2048, DMODEL = 1024, MTOK = BATCH * SEQ;
constexpr int INCOLS = 4096, SSMW = 512, NGRP = 32, CH = 32  , NCHUNK = SEQ / CH  , APK = 640  ;
constexpr int PQ = 2048, NEXP = 16384;
constexpr float RMS_EPS = 1e-6f;

constexpr size_t MiB = 1u << 20;
constexpr size_t WS_CTL = 0, CTL_ZERO_BYTES = 64 * 1024;
constexpr size_t WS_BIAS = 1 * MiB;
constexpr size_t WS_PW32 = 1 * MiB + 64 * 1024;
constexpr size_t WS_KPART = 1 * MiB + 128 * 1024;
constexpr size_t WS_KG = 2 * MiB;
constexpr size_t WS_SSQ1 = 3 * MiB;
constexpr size_t WS_WIN = 6 * MiB, WS_WQ = 14 * MiB, WS_WOUT = 18 * MiB, WS_WUS = 20 * MiB, WS_WUA = 21 * MiB, WS_WGLU = 22 * MiB, WS_KS = 22 * MiB + 512 * 1024;
constexpr size_t WS_WE = 23 * MiB;
constexpr size_t WS_BP = 32 * MiB;
constexpr size_t WS_AP = 52 * MiB;
constexpr size_t WS_E = 72 * MiB;
constexpr size_t WS_H = 80 * MiB;
constexpr size_t WS_YPRE = 80 * MiB, WS_YA = 96 * MiB, WS_XG = 80 * MiB;
constexpr size_t WS_Z = 96 * MiB, ZSTRIDE_B = 16 * MiB;
constexpr size_t WS_MRG = 128 * MiB;
constexpr size_t WS_PQ = 160 * MiB;
constexpr size_t WS_IDS = 224 * MiB, WS_GTS = 232 * MiB;
constexpr size_t WS_U16 = 32 * MiB, WS_V16 = 240 * MiB;
constexpr size_t WS_YB = 224 * MiB;
constexpr size_t WS_WPK = 128 * MiB, WS_RSTD1 = 4 * MiB, WS_Y16 = 160 * MiB;
constexpr size_t WS_END = 256 * MiB;
constexpr int CW_BAR = 1024;

constexpr int RING_OFF = 0, RING_BYTES = 131072;
constexpr int LDSCTL_OFF = RING_BYTES, MISC_OFF = LDSCTL_OFF + 320;
constexpr int LDS_BYTES = 147456;

#define GAS __attribute__((address_space(1)))
#define LAS __attribute__((address_space(3)))
typedef unsigned short bf16;
typedef unsigned v4u __attribute__((ext_vector_type(4)));
typedef float f32x4 __attribute__((ext_vector_type(4)));
typedef short bf16x8 __attribute__((ext_vector_type(8)));
typedef float f32x16 __attribute__((ext_vector_type(16)));
typedef __bf16 bf16x2_t __attribute__((ext_vector_type(2)));
typedef _Float16 h2_t __attribute__((ext_vector_type(2)));
typedef GAS unsigned gu32;
#define RLX_AGENT __ATOMIC_RELAXED, __HIP_MEMORY_SCOPE_AGENT
#define LDS_WAIT() asm volatile("s_waitcnt lgkmcnt(0)" ::: "memory")
#define VM_WAIT() asm volatile("s_waitcnt vmcnt(0)" ::: "memory")
__device__ __forceinline__ unsigned f2bf(float f) { unsigned u = __builtin_bit_cast(unsigned, f); return (u + 0x7fffu + ((u >> 16) & 1u)) >> 16; }
__device__ __forceinline__ unsigned pk2(float lo, float hi) { return f2bf(lo) | (f2bf(hi) << 16); }
using pg8::cvt_pk_bf16; using pg8::bf_lo; using pg8::bf_hi; using pg8::sigmoid_f; using pg8::gelu_tanh;

#define XB_TMO      128
#define XB_XCNT(j)  (256  + 64 * (j))
#define XB_XSUB(j)  (1280 + 64 * (j))
#define XB_XGEN(j)  (2304 + 64 * (j))
#define XB_TOP      3328
#define XB_TOPGEN   3392
#define XCD_BAR_WORDS 3456
#define XB_SPIN_CAP (1u << 18)
__device__ __forceinline__ unsigned xb_ld(unsigned* p)              { return __hip_atomic_load(p, __ATOMIC_RELAXED, __HIP_MEMORY_SCOPE_AGENT); }
__device__ __forceinline__ unsigned xb_add(unsigned* p, unsigned v) { return __hip_atomic_fetch_add(p, v, __ATOMIC_RELAXED, __HIP_MEMORY_SCOPE_AGENT); }
__device__ __forceinline__ unsigned xb_xcc_id() { return (unsigned)__builtin_amdgcn_s_getreg((3 << 11) | 20) & 0xFu; }
#define XB_SPIN(cond, bar) do { unsigned _sp = 0; while (cond) { __builtin_amdgcn_s_sleep(1); \
    if ((++_sp & 255u) == 0u) { if (xb_ld(&(bar)[XB_TMO])) break; if (_sp > XB_SPIN_CAP) { atomicAdd(&(bar)[XB_TMO], 1u); break; } } } } while (0)
struct XcdBarrier { unsigned* bar; unsigned x; volatile LAS unsigned* st; };
__device__ __forceinline__ XcdBarrier xcd_barrier_post(unsigned* bar, volatile LAS unsigned* st) {
    XcdBarrier b; b.bar = bar; b.x = xb_xcc_id(); b.st = st;
    if (threadIdx.x == 0) (void)xb_add(&bar[XB_XCNT(b.x)], 1u);
    return b;
}
__device__ __forceinline__ void xcd_barrier_complete(unsigned* bar, unsigned x, unsigned& nloc, unsigned& nx) {
    const unsigned G = gridDim.x * gridDim.y * gridDim.z;
    unsigned sum, cnt, mine, sp = 0u;
    for (;;) {
        sum = 0u; cnt = 0u; mine = 0u;
#pragma unroll
        for (unsigned j = 0; j < 16; ++j) { const unsigned c = xb_ld(&bar[XB_XCNT(j)]); sum += c; cnt += (c > 0u) ? 1u : 0u; mine = (j == x) ? c : mine; }
        if (sum == G) break;
        __builtin_amdgcn_s_sleep(1);
        if ((++sp & 255u) == 0u) { if (xb_ld(&bar[XB_TMO])) break; if (sp > XB_SPIN_CAP) { atomicAdd(&bar[XB_TMO], 1u); break; } }
    }
    nloc = mine > 0u ? mine : 1u; nx = cnt > 0u ? cnt : 1u;
}
__device__ __forceinline__ void xcd_barrier(const XcdBarrier& b) {
    asm volatile("s_waitcnt vmcnt(0)" ::: "memory");
    __syncthreads();
    if (threadIdx.x == 0) {
        unsigned* bar = b.bar;
        __builtin_amdgcn_s_waitcnt(0);
        unsigned nloc = b.st[0], nx = b.st[1];
        if (nloc == 0u) { xcd_barrier_complete(bar, b.x, nloc, nx); b.st[0] = nloc; b.st[1] = nx; }
        const unsigned old = xb_add(&bar[XB_XSUB(b.x)], 1u);
        const unsigned gen = old / nloc;
        if (old + 1u == (gen + 1u) * nloc) {
            __builtin_amdgcn_fence(__ATOMIC_RELEASE, "agent");
            asm volatile("s_waitcnt vmcnt(0)" ::: "memory");
            const unsigned og = xb_add(&bar[XB_TOP], 1u);
            const unsigned tg = og / nx;
            if (og + 1u == (tg + 1u) * nx) xb_add(&bar[XB_TOPGEN], 1u);
            else XB_SPIN(xb_ld(&bar[XB_TOPGEN]) == tg, bar);
            __builtin_amdgcn_fence(__ATOMIC_ACQUIRE, "agent");
            xb_add(&bar[XB_XGEN(b.x)], 1u);
            asm volatile("s_waitcnt vmcnt(0)" ::: "memory");
        } else {
            XB_SPIN(xb_ld(&bar[XB_XGEN(b.x)]) == gen, bar);
            __builtin_amdgcn_fence(__ATOMIC_ACQUIRE, "agent");
            asm volatile("s_waitcnt vmcnt(0)" ::: "memory");
        }
    }
    __syncthreads();
}

__device__ __forceinline__ float wave_sum(float v) {
#pragma unroll
    for (int o = 1; o < 64; o <<= 1) v += __shfl_xor(v, o);
    return v;
}

namespace pg8 {
struct EpiIn {
    static constexpr bool PERM = true;
    bf16_t* zbase; bf16_t* AP; float* kpart;
    __device__ __forceinline__ void operator()(const f32x4 (&acc)[2][2][4][2], const Unit& u, int wr, int wc, int fr, int fq) const {
        const int t = u.pn >> 1, colt = (u.pn & 1) * 256;
        const int row0 = u.pm * BM + wr * 64 + fr, col0 = colt + wc * 32 + 8 * fq;
        if (t == 0) {
#pragma unroll
            for (int ai = 0; ai < 2; ++ai)
#pragma unroll
                for (int m = 0; m < 4; ++m) { const int r = row0 + ai * HALF + m * 16, b = r >> 11, l = r & 2047;
#pragma unroll
                    for (int bj = 0; bj < 2; ++bj) { const int c = col0 + bj * HALF, g = c >> 4, hi0 = c & 15;
                        const f32x4 v0 = acc[ai][bj][m][0], v1 = acc[ai][bj][m][1];
                        u32x4 w; w.x = cvt_pk_bf16(v0[0], v0[1]); w.y = cvt_pk_bf16(v0[2], v0[3]); w.z = cvt_pk_bf16(v1[0], v1[1]); w.w = cvt_pk_bf16(v1[2], v1[3]);
                        *(u32x4*)(AP + (size_t)(g * 512 + b * 64 + (l >> 5)) * 640 + (l & 31) * 16 + hi0) = w; } }
        } else {
            bf16_t* base = zbase + (size_t)t * (16u * 1024u * 1024u / 2u);
            const float sc = (t == 1) ? 0.125f * 1.4426950408889634f : 1.0f;
#pragma unroll
            for (int ai = 0; ai < 2; ++ai)
#pragma unroll
                for (int m = 0; m < 4; ++m) { bf16_t* rowp = base + (size_t)(row0 + ai * HALF + m * 16) * 512 + col0;
#pragma unroll
                    for (int bj = 0; bj < 2; ++bj) { f32x4 v0 = acc[ai][bj][m][0], v1 = acc[ai][bj][m][1];
                        if (t >= 4) {
#pragma unroll
                            for (int e = 0; e < 4; ++e) { v0[e] = sigmoid_f(v0[e]); v1[e] = sigmoid_f(v1[e]); }
                        } else { v0 = v0 * sc; v1 = v1 * sc; }
                        u32x4 w; w.x = cvt_pk_bf16(v0[0], v0[1]); w.y = cvt_pk_bf16(v0[2], v0[3]); w.z = cvt_pk_bf16(v1[0], v1[1]); w.w = cvt_pk_bf16(v1[2], v1[3]);
                        *(u32x4*)(rowp + bj * HALF) = w; } }
            if (t == 2) {
#pragma unroll
                for (int bj = 0; bj < 2; ++bj)
#pragma unroll
                    for (int n = 0; n < 2; ++n) { f32x4 s = (f32x4){0.f, 0.f, 0.f, 0.f};
#pragma unroll
                        for (int ai = 0; ai < 2; ++ai)
#pragma unroll
                            for (int m = 0; m < 4; ++m) s += acc[ai][bj][m][n];
#pragma unroll
                        for (int e = 0; e < 4; ++e) { float x = s[e]; x += __shfl_xor(x, 1); x += __shfl_xor(x, 2); x += __shfl_xor(x, 4); x += __shfl_xor(x, 8); s[e] = x; }
                        if (fr == 0) *(f32x4*)(kpart + (size_t)(u.pm * 2 + wr) * 512 + col0 + bj * HALF + 4 * n) = s; }
            }
        }
    }
};
struct EpiE {
    static constexpr bool PERM = false;
    float* E;
    __device__ __forceinline__ void operator()(const f32x4 (&acc)[2][2][4][2], const Unit& u, int wr, int wc, int fr, int fq) const {
        const int row0 = u.pm * BM + wr * 64 + fr, col0 = wc * 32 + 4 * fq;
#pragma unroll
        for (int ai = 0; ai < 2; ++ai)
#pragma unroll
            for (int m = 0; m < 4; ++m) { float* rowp = E + (size_t)(row0 + ai * HALF + m * 16) * 128 + col0;
#pragma unroll
                for (int n = 0; n < 2; ++n) *(f32x4*)(rowp + n * 16) = acc[ai][0][m][n]; }
    }
};
struct EpiY {
    static constexpr bool PERM = true;
    bf16_t* Y;
    __device__ __forceinline__ void operator()(const f32x4 (&acc)[2][2][4][2], const Unit& u, int wr, int wc, int fr, int fq) const {
        const int row0 = u.pm * BM + wr * 64 + fr, col0 = u.pn * BM + wc * 32 + 8 * fq;
#pragma unroll
        for (int ai = 0; ai < 2; ++ai)
#pragma unroll
            for (int m = 0; m < 4; ++m) { const int r = row0 + ai * HALF + m * 16, g = r >> 9, b = (r >> 6) & 7, c = r & 63;
#pragma unroll
                for (int bj = 0; bj < 2; ++bj) { const int cc = col0 + bj * HALF, j = cc >> 4, ho0 = cc & 15;
                    f32x4 v0 = acc[ai][bj][m][0], v1 = acc[ai][bj][m][1];
#pragma unroll
                    for (int e = 0; e < 4; ++e) { v0[e] = gelu_tanh(v0[e]); v1[e] = gelu_tanh(v1[e]); }
                    u32x4 w; w.x = cvt_pk_bf16(v0[0], v0[1]); w.y = cvt_pk_bf16(v0[2], v0[3]); w.z = cvt_pk_bf16(v1[0], v1[1]); w.w = cvt_pk_bf16(v1[2], v1[3]);
                    *(u32x4*)(Y + (size_t)(b * 2048 + c * 32 + j) * 512 + g * 16 + ho0) = w; } }
    }
};
struct EpiGlu {
    static constexpr bool PERM = true;
    const bf16_t* Yp; bf16_t* Ya; const float* bias;
    __device__ __forceinline__ void operator()(const f32x4 (&acc)[2][2][4][2], const Unit& u, int wr, int wc, int fr, int fq) const {
        const int row0 = u.pm * BM + wr * 64 + fr, col0 = u.pn * BM + wc * 32 + 8 * fq;
        f32x4 bv[2][2];
#pragma unroll
        for (int bj = 0; bj < 2; ++bj)
#pragma unroll
            for (int n = 0; n < 2; ++n) bv[bj][n] = *(const f32x4*)(bias + col0 + bj * HALF + 4 * n);
#pragma unroll
        for (int ai = 0; ai < 2; ++ai)
#pragma unroll
            for (int m = 0; m < 4; ++m) { const size_t off = (size_t)(row0 + ai * HALF + m * 16) * 512 + col0;
#pragma unroll
                for (int bj = 0; bj < 2; ++bj) { const f32x4 z0 = acc[ai][bj][m][0] + bv[bj][0], z1 = acc[ai][bj][m][1] + bv[bj][1];
                    const u32x4 y = *(const u32x4*)(Yp + off + bj * HALF);
                    u32x4 w; w.x = cvt_pk_bf16(bf_lo(y.x) * sigmoid_f(z0[0]), bf_hi(y.x) * sigmoid_f(z0[1])); w.y = cvt_pk_bf16(bf_lo(y.y) * sigmoid_f(z0[2]), bf_hi(y.y) * sigmoid_f(z0[3]));
                    w.z = cvt_pk_bf16(bf_lo(y.z) * sigmoid_f(z1[0]), bf_hi(y.z) * sigmoid_f(z1[1])); w.w = cvt_pk_bf16(bf_lo(y.w) * sigmoid_f(z1[2]), bf_hi(y.w) * sigmoid_f(z1[3]));
                    *(u32x4*)(Ya + off + bj * HALF) = w; } }
    }
};
template <int ADD> struct EpiMrg {
    static constexpr bool PERM = true;
    const bf16_t* G0; bf16_t* Mrg;
    __device__ __forceinline__ void operator()(const f32x4 (&acc)[2][2][4][2], const Unit& u, int wr, int wc, int fr, int fq) const {
        const int row0 = u.pm * BM + wr * 64 + fr, cin = wc * 32 + 8 * fq;
        const bf16_t* gb = G0 + (size_t)(u.pn >> 1) * (16u * 1024u * 1024u / 2u) + (u.pn & 1) * 256 + cin;
#pragma unroll
        for (int ai = 0; ai < 2; ++ai)
#pragma unroll
            for (int m = 0; m < 4; ++m) { const int r = row0 + ai * HALF + m * 16;
#pragma unroll
                for (int bj = 0; bj < 2; ++bj) {
#if defined(ABL_NO_SSM) || defined(ABL_NO_ATT)
#if defined(ABL_NO_SSM)
                    constexpr bool kill = (ADD == 0);
#else
                    constexpr bool kill = (ADD == 1);
#endif
                    const f32x4 a0 = kill ? (f32x4){0.f, 0.f, 0.f, 0.f} : acc[ai][bj][m][0], a1 = kill ? (f32x4){0.f, 0.f, 0.f, 0.f} : acc[ai][bj][m][1];
#else
                    const f32x4 a0 = acc[ai][bj][m][0], a1 = acc[ai][bj][m][1];
#endif
                    const u32x4 gt = *(const u32x4*)(gb + (size_t)r * 512 + bj * HALF);
                    bf16_t* mp = Mrg + (size_t)r * 1024 + u.pn * BM + cin + bj * HALF;
                    float o[8] = { bf_lo(gt.x) * a0[0], bf_hi(gt.x) * a0[1], bf_lo(gt.y) * a0[2], bf_hi(gt.y) * a0[3], bf_lo(gt.z) * a1[0], bf_hi(gt.z) * a1[1], bf_lo(gt.w) * a1[2], bf_hi(gt.w) * a1[3] };
                    if (ADD) { const u32x4 p = *(const u32x4*)mp; o[0] += bf_lo(p.x); o[1] += bf_hi(p.x); o[2] += bf_lo(p.y); o[3] += bf_hi(p.y); o[4] += bf_lo(p.z); o[5] += bf_hi(p.z); o[6] += bf_lo(p.w); o[7] += bf_hi(p.w); }
                    u32x4 w; w.x = cvt_pk_bf16(o[0], o[1]); w.y = cvt_pk_bf16(o[2], o[3]); w.z = cvt_pk_bf16(o[4], o[5]); w.w = cvt_pk_bf16(o[6], o[7]);
                    *(u32x4*)mp = w; } }
    }
};
struct EpiMrgDual {
    static constexpr bool PERM = true;
    EpiMrg<0> a; EpiMrg<1> b;
    __device__ __forceinline__ void operator()(const f32x4 (&acc)[2][2][4][2], const Unit& u, int wr, int wc, int fr, int fq) const { if (u.w == 0) a(acc, u, wr, wc, fr, fq); else b(acc, u, wr, wc, fr, fq); }
};
struct EpiX1 {
    static constexpr bool PERM = true;
    const float* X; float* X1; bf16_t* XG; const float* g2; float* ssq;
    __device__ __forceinline__ void operator()(const f32x4 (&acc)[2][2][4][2], const Unit& u, int wr, int wc, int fr, int fq) const {
        const int row0 = u.pm * BM + wr * 64 + fr, col0 = u.pn * BM + wc * 32 + 8 * fq;
        f32x4 gv[2][2];
#pragma unroll
        for (int bj = 0; bj < 2; ++bj)
#pragma unroll
            for (int n = 0; n < 2; ++n) gv[bj][n] = *(const f32x4*)(g2 + col0 + bj * HALF + 4 * n);
#pragma unroll
        for (int ai = 0; ai < 2; ++ai)
#pragma unroll
            for (int m = 0; m < 4; ++m) { const int r = row0 + ai * HALF + m * 16; const size_t off = (size_t)r * 1024 + col0; float s = 0.f;
#pragma unroll
                for (int bj = 0; bj < 2; ++bj) {
                    #ifdef ABL_NO_MIX
                    const f32x4 x0 = *(const f32x4*)(X + off + bj * HALF), x1 = *(const f32x4*)(X + off + bj * HALF + 4);
#else
                    const f32x4 x0 = *(const f32x4*)(X + off + bj * HALF) + acc[ai][bj][m][0], x1 = *(const f32x4*)(X + off + bj * HALF + 4) + acc[ai][bj][m][1];
#endif
                    *(f32x4*)(X1 + off + bj * HALF) = x0; *(f32x4*)(X1 + off + bj * HALF + 4) = x1;
                    s += (x0[0] * x0[0] + x0[1] * x0[1]) + (x0[2] * x0[2] + x0[3] * x0[3]) + (x1[0] * x1[0] + x1[1] * x1[1]) + (x1[2] * x1[2] + x1[3] * x1[3]);
                    const f32x4 a = x0 * gv[bj][0], b = x1 * gv[bj][1];
                    u32x4 w; w.x = cvt_pk_bf16(a[0], a[1]); w.y = cvt_pk_bf16(a[2], a[3]); w.z = cvt_pk_bf16(b[0], b[1]); w.w = cvt_pk_bf16(b[2], b[3]);
                    *(u32x4*)(XG + off + bj * HALF) = w; }
                s += __shfl_xor(s, 16); s += __shfl_xor(s, 32);
                if (fq == 0) ssq[(size_t)r * 16 + u.pn * 4 + wc] = s; }
    }
};
struct EpiPlain {
    static constexpr bool PERM = true;
    bf16_t* O; int ldc;
    __device__ __forceinline__ void operator()(const f32x4 (&acc)[2][2][4][2], const Unit& u, int wr, int wc, int fr, int fq) const {
        const int row0 = u.pm * BM + wr * 64 + fr, col0 = u.pn * BM + wc * 32 + 8 * fq;
#pragma unroll
        for (int ai = 0; ai < 2; ++ai)
#pragma unroll
            for (int m = 0; m < 4; ++m) { bf16_t* rowp = O + (size_t)(row0 + ai * HALF + m * 16) * ldc + col0;
#pragma unroll
                for (int bj = 0; bj < 2; ++bj) { const f32x4 v0 = acc[ai][bj][m][0], v1 = acc[ai][bj][m][1];
                    u32x4 w; w.x = cvt_pk_bf16(v0[0], v0[1]); w.y = cvt_pk_bf16(v0[2], v0[3]); w.z = cvt_pk_bf16(v1[0], v1[1]); w.w = cvt_pk_bf16(v1[2], v1[3]);
                    *(u32x4*)(rowp + bj * HALF) = w; } }
    }
};
}
struct Frame {
    LAS unsigned char* lds;
    int tid, lane, wave, vcu, G;
};

__device__ __forceinline__ void p0_transpose_item(const float* W, int K, int N, bf16* WT, LAS float* scr, int item, int lane) {
    const int nblk = N / 32, kb = item / nblk, nb = item % nblk, k0 = 64 * kb, n0 = 32 * nb;
    float wv[32];
#pragma unroll
    for (int i = 0; i < 32; ++i) { const int kk = 2 * i + (lane >> 5); wv[i] = W[(size_t)(k0 + kk) * N + n0 + (lane & 31)]; }
#pragma unroll
    for (int i = 0; i < 32; ++i) { const int kk = 2 * i + (lane >> 5); scr[kk * 33 + (lane & 31)] = wv[i]; }
    LDS_WAIT(); asm volatile("" ::: "memory");
    const int c = lane & 7;
#pragma unroll
    for (int j = 0; j < 4; ++j) { const int n = (lane >> 3) + 8 * j; const LAS float* s = scr + (8 * c) * 33 + n;
        v4u o; o.x = pk2(s[0 * 33], s[1 * 33]); o.y = pk2(s[2 * 33], s[3 * 33]); o.z = pk2(s[4 * 33], s[5 * 33]); o.w = pk2(s[6 * 33], s[7 * 33]);
        *(GAS v4u*)(WT + (size_t)(n0 + n) * K + k0 + 8 * c) = o; }
    LDS_WAIT(); asm volatile("" ::: "memory");
}
__device__ __forceinline__ void rms_row_to_bf16(const float* xrow, const float* g, bf16* orow, int lane) {
    const GAS f32x4* xr = (const GAS f32x4*)xrow + lane; const GAS f32x4* gr = (const GAS f32x4*)g + lane;
    f32x4 v[4]; float s = 0.f;
#pragma unroll
    for (int j = 0; j < 4; ++j) { v[j] = xr[64 * j]; s += (v[j].x * v[j].x + v[j].y * v[j].y) + (v[j].z * v[j].z + v[j].w * v[j].w); }
    const float rstd = 1.0f / sqrtf(wave_sum(s) * (1.f / DMODEL) + RMS_EPS);
    GAS unsigned long long* o8 = (GAS unsigned long long*)orow + lane;
#pragma unroll
    for (int j = 0; j < 4; ++j) { const f32x4 gg = gr[64 * j];
        o8[64 * j] = (unsigned long long)pk2(v[j].x * rstd * gg.x, v[j].y * rstd * gg.y) | ((unsigned long long)pk2(v[j].z * rstd * gg.z, v[j].w * rstd * gg.w) << 32); }
}
__device__ __forceinline__ void rms_rows4_to_bf16(const float* x, const float* g, bf16* out, int m, int stride, int lane) {
    f32x4 v[4][4];
#pragma unroll
    for (int k = 0; k < 4; ++k) { const int mm = (m + k * stride < MTOK) ? m + k * stride : m; const GAS f32x4* xr = (const GAS f32x4*)(x + (size_t)mm * DMODEL) + lane;
#pragma unroll
        for (int j = 0; j < 4; ++j) v[k][j] = xr[64 * j]; }
    const GAS f32x4* gr = (const GAS f32x4*)g + lane; f32x4 gg[4];
#pragma unroll
    for (int j = 0; j < 4; ++j) gg[j] = gr[64 * j];
#pragma unroll
    for (int k = 0; k < 4; ++k) { if (m + k * stride >= MTOK) break; float s = 0.f;
#pragma unroll
        for (int j = 0; j < 4; ++j) s += (v[k][j].x * v[k][j].x + v[k][j].y * v[k][j].y) + (v[k][j].z * v[k][j].z + v[k][j].w * v[k][j].w);
        const float rstd = 1.0f / sqrtf(wave_sum(s) * (1.f / DMODEL) + RMS_EPS);
        GAS unsigned long long* o8 = (GAS unsigned long long*)(out + (size_t)(m + k * stride) * DMODEL) + lane;
#pragma unroll
        for (int j = 0; j < 4; ++j) o8[64 * j] = (unsigned long long)pk2(v[k][j].x * rstd * gg[j].x, v[k][j].y * rstd * gg[j].y) | ((unsigned long long)pk2(v[k][j].z * rstd * gg[j].z, v[k][j].w * rstd * gg[j].w) << 32); }
}
struct cpx { float r, i; };
__device__ __forceinline__ cpx cmul(cpx a, cpx b) { return cpx{a.r * b.r - a.i * b.i, a.r * b.i + a.i * b.r}; }
__device__ __forceinline__ cpx cpow_(float ar, float ai, float dt, int n) { const float e = expf(ar * dt * (float)n); const float ang = ai * dt * (float)n; return cpx{e * cosf(ang), e * sinf(ang)}; }
__device__ __forceinline__ void ssm_table_task(int g, int j, int lane, LAS float* scr, const float* a_re, const float* a_im, const float* log_dt, const float* b_re, const float* b_im,
                                               const float* c_re, const float* c_im, float* Kg, bf16* WE, bf16* BP, float* pw32) {
    const int p = lane;
    const float dt = expf(log_dt[g]), ar = a_re[g * 64 + p], ai = a_im[g * 64 + p];
#define pw(n) cpow_(ar, ai, dt, (n))
    const cpx lb = pw(1);
    const float den = ar * ar + ai * ai;
    const cpx coef = cpx{((lb.r - 1.f) * ar + lb.i * ai) / den, (lb.i * ar - (lb.r - 1.f) * ai) / den};
    const cpx pj = pw(j), pe = pw(31 - j), pv = pw(j + 1);
    unsigned wer[8], wei[8];
#pragma unroll
    for (int h2 = 0; h2 < 8; ++h2) { float er[2], ei[2];
#pragma unroll
        for (int q = 0; q < 2; ++q) { const int hi = 2 * h2 + q;
            const cpx bb = cmul(coef, cpx{b_re[(g * 64 + p) * 16 + hi], b_im[(g * 64 + p) * 16 + hi]});
            const cpx w = cmul(pj, bb); scr[(p * 16 + hi) * 2] = w.r; scr[(p * 16 + hi) * 2 + 1] = w.i;
            const cpx e = cmul(pe, bb); er[q] = e.r; ei[q] = e.i; }
        wer[h2] = pk2(er[0], er[1]); wei[h2] = pk2(ei[0], ei[1]); }
    { bf16* w0 = WE + ((size_t)(g * 256 + p) * 512 + j * 16); bf16* w1 = WE + ((size_t)(g * 256 + 64 + p) * 512 + j * 16);
      *(GAS v4u*)w0 = (v4u){wer[0], wer[1], wer[2], wer[3]}; *(GAS v4u*)(w0 + 8) = (v4u){wer[4], wer[5], wer[6], wer[7]};
      *(GAS v4u*)w1 = (v4u){wei[0], wei[1], wei[2], wei[3]}; *(GAS v4u*)(w1 + 8) = (v4u){wei[4], wei[5], wei[6], wei[7]};
      bf16* z0 = WE + ((size_t)(g * 256 + 128 + p) * 512 + j * 16); bf16* z1 = WE + ((size_t)(g * 256 + 192 + p) * 512 + j * 16); const v4u z = (v4u){0u, 0u, 0u, 0u};
      *(GAS v4u*)z0 = z; *(GAS v4u*)(z0 + 8) = z; *(GAS v4u*)z1 = z; *(GAS v4u*)(z1 + 8) = z; }
#pragma unroll 4
    for (int ho = 0; ho < 16; ++ho) { const cpx cv = cmul(cpx{c_re[(g * 16 + ho) * 64 + p], c_im[(g * 16 + ho) * 64 + p]}, pv);
        bf16* row = BP + ((size_t)(g * 512 + j * 16 + ho) * APK + 512);
        row[p] = (bf16)f2bf(cv.r); row[64 + p] = (bf16)f2bf(-cv.i); }
    if (j == 0) { const cpx p32 = pw(32); pw32[g * 128 + p] = p32.r; pw32[g * 128 + 64 + p] = p32.i; }
    LDS_WAIT(); asm volatile("" ::: "memory");
    { const int ho = lane >> 2, h4 = (lane & 3) * 4; float a0 = 0.f, a1 = 0.f, a2 = 0.f, a3 = 0.f;
      const float* cr = c_re + (g * 16 + ho) * 64; const float* ci = c_im + (g * 16 + ho) * 64;
#pragma unroll 4
      for (int pp = 0; pp < 64; ++pp) { const float r_ = cr[pp], i_ = ci[pp]; const LAS float* w = scr + (pp * 16 + h4) * 2;
          a0 += r_ * w[0] - i_ * w[1]; a1 += r_ * w[2] - i_ * w[3]; a2 += r_ * w[4] - i_ * w[5]; a3 += r_ * w[6] - i_ * w[7]; }
      *(GAS f32x4*)(Kg + ((size_t)(g * 32 + j) * 256 + ho * 16 + h4)) = (f32x4){a0, a1, a2, a3}; }
    LDS_WAIT(); asm volatile("" ::: "memory");
#undef pw
}

__device__ __forceinline__ float vmaxf(float a, float b) { float r; asm("v_max_f32_e32 %0, %1, %2" : "=v"(r) : "v"(a), "v"(b)); return r; }
__device__ __forceinline__ float vminf(float a, float b) { float r; asm("v_min_f32_e32 %0, %1, %2" : "=v"(r) : "v"(a), "v"(b)); return r; }
__device__ __forceinline__ float selhi(float lo, float hi) { float r; asm("v_cndmask_b32_e64 %0, %1, %2, %3" : "=v"(r) : "v"(lo), "v"(hi), "s"(0xFFFFFFFF00000000ull)); return r; }
#define CE_DESC(a, b) do { const float hi_ = vmaxf(a, b), lo_ = vminf(a, b); a = hi_; b = lo_; } while (0)
__device__ __forceinline__ void sort16_desc(float (&v)[16]) {
#pragma unroll
    for (int k = 2; k <= 16; k <<= 1)
#pragma unroll
        for (int j = k >> 1; j > 0; j >>= 1)
#pragma unroll
            for (int i = 0; i < 16; ++i) { const int l = i ^ j; if (l > i) { if ((i & k) == 0) CE_DESC(v[i], v[l]); else CE_DESC(v[l], v[i]); } }
}
__device__ __forceinline__ void bitonic_merge16_desc(float (&v)[16]) {
#pragma unroll
    for (int j = 8; j > 0; j >>= 1)
#pragma unroll
        for (int i = 0; i < 16; ++i) { const int l = i ^ j; if (l > i) CE_DESC(v[i], v[l]); }
}
__device__ __forceinline__ void merge_top16(float (&a)[16], const float (&b)[16]) {
#pragma unroll
    for (int i = 0; i < 16; ++i) a[i] = vmaxf(a[i], b[15 - i]);
    bitonic_merge16_desc(a);
}
__device__ __forceinline__ void merge_partner_top16(float (&a)[16]) {
    float p[16];
#pragma unroll
    for (int i = 0; i < 16; ++i) { const unsigned x = __float_as_uint(a[15 - i]); auto rr = __builtin_amdgcn_permlane32_swap(x, x, false, false); p[i] = selhi(__uint_as_float(rr[1]), __uint_as_float(rr[0])); }
#pragma unroll
    for (int i = 0; i < 16; ++i) a[i] = vmaxf(a[i], p[i]);
    bitonic_merge16_desc(a);
}
__device__ __forceinline__ void topk_half(int half, const bf16x8 (&qf)[8], int r32, int hi, const LAS unsigned char* ksl, float (&top)[16]) {
#pragma unroll 1
    for (int kt = 0; kt < 4; ++kt) {
        f32x16 acc = f32x16{};
        const int row = half * 128 + kt * 32 + r32; const LAS unsigned char* rp = ksl + row * 256; const int sw = row & 15;
#pragma unroll
        for (int ks = 0; ks < 8; ++ks) { const bf16x8 a = *(const LAS bf16x8*)(rp + (((2 * ks + hi) ^ sw) << 4));
            acc = __builtin_amdgcn_mfma_f32_32x32x16_bf16(a, qf[ks], acc, 0, 0, 0); }
        float grp[16];
#pragma unroll
        for (int r = 0; r < 16; ++r) { const unsigned key = (unsigned)(kt * 32 + (r & 3) + 8 * (r >> 2)) + 4u * (unsigned)hi; grp[r] = __uint_as_float((__float_as_uint(acc[r]) & ~127u) | key); }
        sort16_desc(grp);
        if (kt == 0) {
#pragma unroll
            for (int i = 0; i < 16; ++i) top[i] = grp[i];
        } else merge_top16(top, grp);
    }
    merge_partner_top16(top);
}
__device__ __forceinline__ void topk_task(int tt, int hd, int lane, LAS unsigned char* scr, const bf16* PQb, const LAS unsigned char* ksl, const float* ssq1, int* ids, float* gts, float* rstd1) {
    const int r32 = lane & 31, hi = lane >> 5; const bool hib = hi != 0;
    const int token = tt * 32 + r32;
    float v0_[16], v1_[16];
    bf16x8 qf0[8], qf1[8];
#pragma unroll
    for (int ks = 0; ks < 8; ++ks) { qf0[ks] = *(const GAS bf16x8*)(PQb + (size_t)token * PQ + hd * 256 + ks * 16 + hi * 8); qf1[ks] = *(const GAS bf16x8*)(PQb + (size_t)token * PQ + hd * 256 + 128 + ks * 16 + hi * 8); }
    topk_half(0, qf0, r32, hi, ksl, v0_);
    topk_half(1, qf1, r32, hi, ksl, v1_);
#define v_SEL(h, i) ((h) ? v1_[i] : v0_[i])
    LAS unsigned char* slot = scr + lane * 32;
    { v4u d0, d1;
#define PK4(h, k) ((__float_as_uint(v_SEL(h, 4 * (k))) & 127u) | ((__float_as_uint(v_SEL(h, 4 * (k) + 1)) & 127u) << 8) | ((__float_as_uint(v_SEL(h, 4 * (k) + 2)) & 127u) << 16) | ((__float_as_uint(v_SEL(h, 4 * (k) + 3)) & 127u) << 24))
      d0 = (v4u){PK4(0, 0), PK4(0, 1), PK4(0, 2), PK4(0, 3)}; d1 = (v4u){PK4(1, 0), PK4(1, 1), PK4(1, 2), PK4(1, 3)};
#undef PK4
      *(LAS v4u*)slot = d0; *(LAS v4u*)(slot + 16) = d1; }
    float a[16], b[16];
#pragma unroll
    for (int i = 0; i < 16; ++i) { a[i] = selhi(v0_[i], v1_[i]); b[i] = selhi(v1_[i], v0_[i]); }
    const unsigned obit = (unsigned)hi << 8;
#define CAND(i, j) __uint_as_float((__float_as_uint(a[i] + b[j]) & ~511u) | obit | (unsigned)(((i) << 4) | (j)))
    const float NEGBIG = -3.0e38f;
    float g0[16], g1[16];
#pragma unroll
    for (int j = 1; j < 16; ++j) g0[j - 1] = CAND(0, j);
    g0[15] = CAND(1, 2);
    g1[0] = CAND(1, 3); g1[1] = CAND(1, 4); g1[2] = CAND(1, 5); g1[3] = CAND(1, 6); g1[4] = CAND(1, 7); g1[5] = CAND(2, 3); g1[6] = CAND(2, 4);
    { const float c0 = CAND(0, 0), c1 = CAND(1, 1), c2 = CAND(2, 2), c3 = CAND(3, 3);
      g1[7] = selhi(c0, NEGBIG); g1[8] = selhi(c1, NEGBIG); g1[9] = selhi(c2, NEGBIG); g1[10] = selhi(c3, NEGBIG); }
#pragma unroll
    for (int i = 11; i < 16; ++i) g1[i] = NEGBIG;
#undef CAND
    sort16_desc(g0); sort16_desc(g1); merge_top16(g0, g1); merge_partner_top16(g0);
    float rstd;
    { const GAS f32x4* sp = (const GAS f32x4*)(ssq1 + (size_t)token * 16); const f32x4 s0 = sp[0], s1 = sp[1], s2 = sp[2], s3 = sp[3];
      const float ss = ((s0.x + s0.y) + (s0.z + s0.w)) + ((s1.x + s1.y) + (s1.z + s1.w)) + ((s2.x + s2.y) + (s2.z + s2.w)) + ((s3.x + s3.y) + (s3.z + s3.w));
      rstd = 1.0f / sqrtf(ss * (1.f / DMODEL) + RMS_EPS); }
    if (hd == 0 && !hib) rstd1[token] = rstd;
    float ex[16], esum = 0.f; const float sc = rstd * 1.4426950409f;
#pragma unroll
    for (int k = 0; k < 16; ++k) { ex[k] = __builtin_amdgcn_exp2f((g0[k] - g0[0]) * sc); esum += ex[k]; }
    const float inv = 1.0f / esum;
    int eid[8]; float gv[8];
#pragma unroll
    for (int k = 0; k < 8; ++k) { const float wv = selhi(g0[k], g0[8 + k]); const float ev = selhi(ex[k], ex[8 + k]);
        const unsigned tag = __float_as_uint(wv) & 511u, o = tag >> 8, i = (tag >> 4) & 15u, j = tag & 15u; const unsigned i1 = o ? j : i, i2 = o ? i : j;
        const unsigned k1 = slot[i1], k2 = slot[16 + i2];
        eid[k] = (int)(k1 * 128u + k2); gv[k] = ev * inv; }
    { int* ip = ids + (size_t)token * 128 + hd * 16 + 8 * hi; float* gp = gts + (size_t)token * 128 + hd * 16 + 8 * hi;
      *(GAS v4u*)ip = (v4u){(unsigned)eid[0], (unsigned)eid[1], (unsigned)eid[2], (unsigned)eid[3]}; *(GAS v4u*)(ip + 4) = (v4u){(unsigned)eid[4], (unsigned)eid[5], (unsigned)eid[6], (unsigned)eid[7]};
      *(GAS f32x4*)gp = (f32x4){gv[0], gv[1], gv[2], gv[3]}; *(GAS f32x4*)(gp + 4) = (f32x4){gv[4], gv[5], gv[6], gv[7]}; }
    LDS_WAIT(); asm volatile("" ::: "memory");
}


__device__ __forceinline__ float dot2bf(unsigned a, unsigned b, float c) { return __builtin_amdgcn_fdot2_f32_bf16(__builtin_bit_cast(bf16x2_t, a), __builtin_bit_cast(bf16x2_t, b), c, false); }
__device__ __forceinline__ h2_t fma_h2(unsigned v, h2_t w, h2_t acc) { return __builtin_elementwise_fma(__builtin_bit_cast(h2_t, v), w, acc); }
__device__ __forceinline__ unsigned fp8lo_bf(unsigned w, float sc) { return __builtin_bit_cast(unsigned, __builtin_amdgcn_cvt_scalef32_pk_bf16_fp8((int)w, sc, false)); }
__device__ __forceinline__ unsigned fp8hi_bf(unsigned w, float sc) { return __builtin_bit_cast(unsigned, __builtin_amdgcn_cvt_scalef32_pk_bf16_fp8((int)w, sc, true)); }
__device__ __forceinline__ h2_t fp8lo_h(unsigned w, float sc) { return __builtin_amdgcn_cvt_scalef32_pk_f16_fp8((int)w, sc, false); }
__device__ __forceinline__ h2_t fp8hi_h(unsigned w, float sc) { return __builtin_amdgcn_cvt_scalef32_pk_f16_fp8((int)w, sc, true); }
__device__ __forceinline__ unsigned pack_fp8x4(float a, float b, float c, float d) { int w = __builtin_amdgcn_cvt_pk_fp8_f32(a, b, 0, false); w = __builtin_amdgcn_cvt_pk_fp8_f32(c, d, w, true); return (unsigned)w; }
constexpr float U8_SCALE = 32.0f, V8_SCALE = 4.0f;
constexpr int PA_CAP = 464;
struct StepA { v4u R[8]; unsigned ent; float g, rs; bool valid; };
__device__ __forceinline__ int pa_tok(unsigned tl, int tb, int nwg) { return ((tl < 4u) ? tb : nwg) + (int)(tl & 3u); }
__device__ __forceinline__ void pa_issue(StepA& S, int s, int n, int lane, const LAS unsigned* list, const unsigned char* U8, const float* gts, const float* rstd1, int tb, int nwg) {
    const int idx = s * 8 + (lane >> 3); S.valid = idx < n; S.ent = list[S.valid ? idx : 0];
    const unsigned ex = S.ent & 0x3fffu, slot = (S.ent >> 14) & 127u, tl = S.ent >> 21;
    const unsigned char* p = U8 + (size_t)ex * 1024 + (lane & 7) * 16;
#pragma unroll
    for (int i = 0; i < 8; ++i) S.R[i] = *(const GAS v4u*)(p + i * 128);
    const int t = pa_tok(tl, tb, nwg); S.g = gts[(size_t)t * 128 + slot]; S.rs = rstd1[t];
}
__device__ __forceinline__ void pa_compute(const StepA& S, int lane, const LAS unsigned char* xl, unsigned* wpk, int tb, int nwg) {
    const unsigned ex = S.ent & 0x3fffu, slot = (S.ent >> 14) & 127u, tl = S.ent >> 21;
    const LAS unsigned char* xp = xl + tl * 2048 + (lane & 7) * 32;
    float a0 = 0.f, a1 = 0.f; const float sc = 1.0f / U8_SCALE;
#pragma unroll
    for (int i = 0; i < 8; ++i) { const v4u x0 = *(const LAS v4u*)(xp + i * 256), x1 = *(const LAS v4u*)(xp + i * 256 + 16); const v4u u = S.R[i];
        const unsigned ux = u.x, uy = u.y, uz = u.z, uw = u.w;
        a0 = dot2bf(fp8lo_bf(ux, sc), x0.x, a0); a1 = dot2bf(fp8hi_bf(ux, sc), x0.y, a1); a0 = dot2bf(fp8lo_bf(uy, sc), x0.z, a0); a1 = dot2bf(fp8hi_bf(uy, sc), x0.w, a1);
        a0 = dot2bf(fp8lo_bf(uz, sc), x1.x, a0); a1 = dot2bf(fp8hi_bf(uz, sc), x1.y, a1); a0 = dot2bf(fp8lo_bf(uw, sc), x1.z, a0); a1 = dot2bf(fp8hi_bf(uw, sc), x1.w, a1); }
    float d = a0 + a1;
    d += __builtin_bit_cast(float, __builtin_amdgcn_update_dpp(0, __builtin_bit_cast(int, d), 0xB1, 0xF, 0xF, true));
    d += __builtin_bit_cast(float, __builtin_amdgcn_update_dpp(0, __builtin_bit_cast(int, d), 0x4E, 0xF, 0xF, true));
    d += __builtin_bit_cast(float, __builtin_amdgcn_update_dpp(0, __builtin_bit_cast(int, d), 0x141, 0xF, 0xF, true));
    if ((lane & 7) == 0 && S.valid) { const int t = pa_tok(tl, tb, nwg); const _Float16 wh = (_Float16)(S.g * gelu_tanh(d * S.rs));
        wpk[(size_t)t * 128 + slot] = ((unsigned)__builtin_bit_cast(unsigned short, wh) << 16) | ex; }
}
__device__ __forceinline__ void pa_flush(int n, int lane, const LAS unsigned* list, const LAS unsigned char* xl, const unsigned char* U16, const float* gts, const float* rstd1, unsigned* wpk, int tb, int nwg) {
    if (n == 0) return;
    LDS_WAIT(); asm volatile("" ::: "memory");
    const int steps = (n + 7) >> 3;
    StepA A, B;
    pa_issue(A, 0, n, lane, list, U16, gts, rstd1, tb, nwg);
    for (int s = 0; s < steps; s += 2) {
        if (s + 1 < steps) pa_issue(B, s + 1, n, lane, list, U16, gts, rstd1, tb, nwg);
        pa_compute(A, lane, xl, wpk, tb, nwg);
        if (s + 2 < steps) pa_issue(A, s + 2, n, lane, list, U16, gts, rstd1, tb, nwg);
        if (s + 1 < steps) pa_compute(B, lane, xl, wpk, tb, nwg);
    }
    LDS_WAIT(); asm volatile("" ::: "memory");
}
__device__ __forceinline__ void peer_a_phase(int lane, int wave, int G, int vcu, const bf16* XG, const unsigned char* U16, const int* ids, const float* gts, const float* rstd1, unsigned* wpk, LAS unsigned char* lds, int emask) {
    (void)emask;
    LAS unsigned char* xl = lds + RING_OFF + wave * 16384;
    LAS unsigned* list = (LAS unsigned*)(lds + MISC_OFF + 128 + wave * (PA_CAP * 4));
    for (int tile0 = vcu; tile0 < MTOK / 32; tile0 += 2 * G) {
        const int tile1 = tile0 + G; const bool has1 = tile1 < MTOK / 32;
        const int tb = tile0 * 32 + wave * 4, nwg = (has1 ? tile1 : tile0) * 32 + wave * 4;
        int id0[8], id1[8];
#pragma unroll
        for (int k = 0; k < 8; ++k) { const bool ok = (k < 4) || has1; const int tc = pa_tok((unsigned)k, tb, nwg);
            const v4u xa = *(const GAS v4u*)(XG + (size_t)tc * 1024 + 8 * lane), xb = *(const GAS v4u*)(XG + (size_t)tc * 1024 + 512 + 8 * lane);
            *(LAS v4u*)(xl + k * 2048 + lane * 16) = xa; *(LAS v4u*)(xl + k * 2048 + 1024 + lane * 16) = xb;
            id0[k] = ok ? ids[(size_t)tc * 128 + lane] : -1; id1[k] = ok ? ids[(size_t)tc * 128 + 64 + lane] : -1; }
        for (int part = 0; part < 8; ++part) {
            int n = 0;
#pragma unroll
            for (int k = 0; k < 8; ++k) {
                { const bool sel = (id0[k] >> 11) == part; const unsigned long long m = __ballot(sel);
                  const int pos = n + (int)__builtin_amdgcn_mbcnt_hi((unsigned)(m >> 32), __builtin_amdgcn_mbcnt_lo((unsigned)m, 0u));
                  if (sel) list[pos] = ((unsigned)k << 21) | ((unsigned)lane << 14) | (unsigned)id0[k]; n += __builtin_popcountll(m); }
                { const bool sel = (id1[k] >> 11) == part; const unsigned long long m = __ballot(sel);
                  const int pos = n + (int)__builtin_amdgcn_mbcnt_hi((unsigned)(m >> 32), __builtin_amdgcn_mbcnt_lo((unsigned)m, 0u));
                  if (sel) list[pos] = ((unsigned)k << 21) | ((unsigned)(64 + lane) << 14) | (unsigned)id1[k]; n += __builtin_popcountll(m); }
                if (n > PA_CAP - 128) { pa_flush(n, lane, list, xl, U16, gts, rstd1, wpk, tb, nwg); n = 0; }
            }
            pa_flush(n, lane, list, xl, U16, gts, rstd1, wpk, tb, nwg);
        }
    }
}
__device__ __forceinline__ void final_token(int t, int lane, const unsigned short* Y16, float* X1, const float* fg) {
    GAS f32x4* xp = (GAS f32x4*)(X1 + (size_t)t * 1024 + 8 * lane);
    f32x4 x0 = xp[0], x1 = xp[1], x2 = xp[128], x3 = xp[129];
    const v4u ya = *(const GAS v4u*)(Y16 + (size_t)t * 1024 + 8 * lane), yb = *(const GAS v4u*)(Y16 + (size_t)t * 1024 + 512 + 8 * lane);
    const unsigned yw[8] = {ya.x, ya.y, ya.z, ya.w, yb.x, yb.y, yb.z, yb.w};
    float y[16];
#pragma unroll
    for (int i = 0; i < 8; ++i) { const unsigned w = yw[i]; const h2_t h = __builtin_bit_cast(h2_t, w); y[2 * i] = (float)h[0]; y[2 * i + 1] = (float)h[1]; }
    x0 += (f32x4){y[0], y[1], y[2], y[3]}; x1 += (f32x4){y[4], y[5], y[6], y[7]}; x2 += (f32x4){y[8], y[9], y[10], y[11]}; x3 += (f32x4){y[12], y[13], y[14], y[15]};
    float ss = (x0.x * x0.x + x0.y * x0.y) + (x0.z * x0.z + x0.w * x0.w) + (x1.x * x1.x + x1.y * x1.y) + (x1.z * x1.z + x1.w * x1.w)
             + (x2.x * x2.x + x2.y * x2.y) + (x2.z * x2.z + x2.w * x2.w) + (x3.x * x3.x + x3.y * x3.y) + (x3.z * x3.z + x3.w * x3.w);
    const float rstd2 = 1.0f / sqrtf(wave_sum(ss) * (1.f / DMODEL) + RMS_EPS);
    const GAS f32x4* gp = (const GAS f32x4*)(fg + 8 * lane);
    xp[0] = x0 * rstd2 * gp[0]; xp[1] = x1 * rstd2 * gp[1]; xp[128] = x2 * rstd2 * gp[128]; xp[129] = x3 * rstd2 * gp[129];
}
#ifndef REP_0
#define REP_0 1
#endif
#ifndef REP_1
#define REP_1 1
#endif
#ifndef REP_2
#define REP_2 1
#endif
#ifndef REP_3
#define REP_3 1
#endif
#ifndef REP_4
#define REP_4 1
#endif
#ifndef REP_5
#define REP_5 1
#endif
#ifndef REP_6
#define REP_6 1
#endif
#ifndef REP_7
#define REP_7 1
#endif
#ifndef REP_8
#define REP_8 1
#endif
#ifndef REP_9
#define REP_9 1
#endif
#ifndef REP_10
#define REP_10 1
#endif
#ifndef REP_11
#define REP_11 1
#endif
struct PkB { v4u p[4]; };
__device__ __forceinline__ PkB peer_b_load(int t, int lane, const unsigned* wpk) { PkB k;
#pragma unroll
    for (int q = 0; q < 4; ++q) k.p[q] = *(const GAS v4u*)(wpk + (size_t)t * 128 + (lane >> 3) * 16 + q * 4);
    return k; }
__device__ __forceinline__ void peer_b_rows(v4u (&v)[16], const PkB& k, const unsigned char* vbase) {
#pragma unroll
    for (int q = 0; q < 4; ++q) { const unsigned pw[4] = {k.p[q].x, k.p[q].y, k.p[q].z, k.p[q].w};
#pragma unroll
        for (int r = 0; r < 4; ++r) v[q * 4 + r] = *(const GAS v4u*)(vbase + (size_t)(pw[r] & 0xffffu) * 128); }
}
__device__ __forceinline__ void peer_b_sum(const v4u (&v)[16], const PkB& k, int lane, unsigned short* yout) {
    h2_t acc[8]; const float sc = 1.0f / V8_SCALE;
#pragma unroll
    for (int i = 0; i < 8; ++i) acc[i] = (h2_t){(_Float16)0.f, (_Float16)0.f};
#pragma unroll
    for (int q = 0; q < 4; ++q) { const unsigned pw[4] = {k.p[q].x, k.p[q].y, k.p[q].z, k.p[q].w};
#pragma unroll
        for (int r = 0; r < 4; ++r) { const unsigned p = pw[r], wb = (p & 0xffff0000u) | (p >> 16); const h2_t w2 = __builtin_bit_cast(h2_t, wb); const v4u x = v[q * 4 + r];
            const unsigned xx = x.x, xy = x.y, xz = x.z, xw = x.w;
            acc[0] = __builtin_elementwise_fma(fp8lo_h(xx, sc), w2, acc[0]); acc[1] = __builtin_elementwise_fma(fp8hi_h(xx, sc), w2, acc[1]);
            acc[2] = __builtin_elementwise_fma(fp8lo_h(xy, sc), w2, acc[2]); acc[3] = __builtin_elementwise_fma(fp8hi_h(xy, sc), w2, acc[3]);
            acc[4] = __builtin_elementwise_fma(fp8lo_h(xz, sc), w2, acc[4]); acc[5] = __builtin_elementwise_fma(fp8hi_h(xz, sc), w2, acc[5]);
            acc[6] = __builtin_elementwise_fma(fp8lo_h(xw, sc), w2, acc[6]); acc[7] = __builtin_elementwise_fma(fp8hi_h(xw, sc), w2, acc[7]); } }
#pragma unroll
    for (int o = 8; o < 64; o <<= 1)
#pragma unroll
        for (int i = 0; i < 8; ++i) { const unsigned u = __builtin_bit_cast(unsigned, acc[i]); const unsigned ou = (unsigned)__shfl_xor((int)u, o); acc[i] = acc[i] + __builtin_bit_cast(h2_t, ou); }
    if (lane < 8) { *(GAS v4u*)yout = (v4u){__builtin_bit_cast(unsigned, acc[0]), __builtin_bit_cast(unsigned, acc[1]), __builtin_bit_cast(unsigned, acc[2]), __builtin_bit_cast(unsigned, acc[3])};
                    *(GAS v4u*)(yout + 8) = (v4u){__builtin_bit_cast(unsigned, acc[4]), __builtin_bit_cast(unsigned, acc[5]), __builtin_bit_cast(unsigned, acc[6]), __builtin_bit_cast(unsigned, acc[7])}; }
}
__device__ __forceinline__ void peer_b_phase(int lane, int wave, int G, int vcu, const unsigned char* V8s, const unsigned* wpk, unsigned short* Y16, float* X1, const float* fg) {
    const int c16 = (lane & 7) * 16;
    for (int tile0 = vcu; tile0 < MTOK / 32; tile0 += 2 * G) {
        const int tile1 = tile0 + G; const bool has1 = tile1 < MTOK / 32;
        const int tb = tile0 * 32 + wave * 4, nwg = (has1 ? tile1 : tile0) * 32 + wave * 4;
        const int nst = has1 ? 4 : 2;
        for (int sl = 0; sl < 8; ++sl) {
            const unsigned char* vbase = V8s + (size_t)sl * NEXP * 128 + c16;
            PkB kA = peer_b_load(pa_tok(0u, tb, nwg), lane, wpk), kB = peer_b_load(pa_tok(1u, tb, nwg), lane, wpk);
            for (int st = 0; st < nst; ++st) {
                const int tA = pa_tok((unsigned)(2 * st), tb, nwg), tB = pa_tok((unsigned)(2 * st + 1), tb, nwg);
                const unsigned kn = (st + 1 < nst) ? (unsigned)(2 * st + 2) : (unsigned)(2 * st);
                const PkB nA = peer_b_load(pa_tok(kn, tb, nwg), lane, wpk), nB = peer_b_load(pa_tok(kn + 1u, tb, nwg), lane, wpk);
                v4u vA[16], vB[16];
                peer_b_rows(vA, kA, vbase); peer_b_rows(vB, kB, vbase);
                peer_b_sum(vA, kA, lane, Y16 + (size_t)tA * 1024 + sl * 128 + c16);
                peer_b_sum(vB, kB, lane, Y16 + (size_t)tB * 1024 + sl * 128 + c16);
                kA = nA; kB = nB;
            }
        }
        asm volatile("s_waitcnt vmcnt(0)" ::: "memory");
        for (int k = 0; k < 2 * nst; ++k) final_token(pa_tok((unsigned)k, tb, nwg), lane, Y16, X1, fg);
    }
}
template <int NR> __device__ __forceinline__ void convert_expert_rows(const float* table, int ex, int stride, bool isv, int lane, unsigned char* U8, unsigned char* V8) {
    f32x4 r[NR][4]; const float sc = isv ? V8_SCALE : U8_SCALE;
#pragma unroll
    for (int k = 0; k < NR; ++k) { const int e = ex + k * stride; const float* src = table + (size_t)(e < NEXP ? e : ex) * 1024 + 16 * lane;
#pragma unroll
        for (int q = 0; q < 4; ++q) r[k][q] = *(const GAS f32x4*)(src + 4 * q); }
#pragma unroll
    for (int k = 0; k < NR; ++k) { const int e = ex + k * stride; if (e < NEXP) {
        const f32x4 a = r[k][0] * sc, b = r[k][1] * sc, c = r[k][2] * sc, d = r[k][3] * sc;
        const v4u o = (v4u){pack_fp8x4(a.x, a.y, a.z, a.w), pack_fp8x4(b.x, b.y, b.z, b.w), pack_fp8x4(c.x, c.y, c.z, c.w), pack_fp8x4(d.x, d.y, d.z, d.w)};
        if (!isv) *(GAS v4u*)(U8 + (size_t)e * 1024 + 16 * lane) = o;
        else *(GAS v4u*)(V8 + ((size_t)(lane >> 3) * NEXP + e) * 128 + (lane & 7) * 16) = o; } }
}
struct OnePanel { int pm, n; __device__ __forceinline__ bool next(int i, pg8::Unit& u) const { if (i >= n) return false; u.pm = pm; u.pn = i; u.w = 0; return true; } };
struct DualOrder { pg8::StaticOrder S; __device__ __forceinline__ bool next(int i, pg8::Unit& u) const { if (!S.next(i >> 1, u)) return false; u.w = i & 1; return true; } };
struct Args { const float* in[24]; float* out; unsigned char* ws; int ph_lo, ph_hi, li, pad; };
__global__ void __launch_bounds__(NWAVES * 64, 2) mk_fwd(Args args) {
    extern __shared__ __attribute__((aligned(16))) unsigned char lds[];
    Frame F;
    F.lds = (LAS unsigned char*)lds;
    volatile LAS unsigned* MISC = (volatile LAS unsigned*)(F.lds + MISC_OFF);
    F.tid = threadIdx.x; F.lane = F.tid & 63; F.wave = __builtin_amdgcn_readfirstlane(F.tid >> 6);
    F.G = gridDim.x; { const int bx = blockIdx.x; F.vcu = (F.G % 8 == 0) ? (bx % 8) * (F.G / 8) + bx / 8 : bx; }
    unsigned char* ws = args.ws;
    gu32* ctl = (gu32*)(ws + WS_CTL);
    for (int u = F.tid; u < (LDS_BYTES - LDSCTL_OFF) / 4; u += NWAVES * 64) ((LAS unsigned*)(F.lds + LDSCTL_OFF))[u] = 0u;
    __syncthreads();
    XcdBarrier bar; bar.bar = (unsigned*)(ctl + CW_BAR); bar.x = 0; bar.st = nullptr;
    if (N_LAUNCHES != PER_PHASE) bar = xcd_barrier_post((unsigned*)(ctl + CW_BAR), MISC + 8);
#define GRID_BAR() do { if (N_LAUNCHES != PER_PHASE) xcd_barrier(bar); } while (0)
    const int lo = args.ph_lo, hi = args.ph_hi;
#ifndef PH_MASK
#define PH_MASK 0xFFFF
#endif
#define IN(k) ((((PH_MASK) >> (k)) & 1) && lo <= (k) && (k) < hi)
#define BOTH(k) (IN(k) && IN((k) + 1))
    const int gw = F.vcu * NWAVES + F.wave, NGW = F.G * NWAVES;
    const int gtid = F.vcu * (NWAVES * 64) + F.tid, NTHR = F.G * NWAVES * 64;
    const float* x = args.in[0];
    bf16* Win_t = (bf16*)(ws + WS_WIN); bf16* Wq_t = (bf16*)(ws + WS_WQ); bf16* Wout_t = (bf16*)(ws + WS_WOUT); bf16* Wus_t = (bf16*)(ws + WS_WUS); bf16* Wua_t = (bf16*)(ws + WS_WUA);
    bf16* Wglu_t = (bf16*)(ws + WS_WGLU); bf16* KSb = (bf16*)(ws + WS_KS); bf16* WE = (bf16*)(ws + WS_WE); bf16* BP = (bf16*)(ws + WS_BP); bf16* AP = (bf16*)(ws + WS_AP);
    float* Eb = (float*)(ws + WS_E); bf16* Hb = (bf16*)(ws + WS_H); bf16* Ypre = (bf16*)(ws + WS_YPRE); bf16* Ya = (bf16*)(ws + WS_YA); bf16* XG = (bf16*)(ws + WS_XG);
    bf16* Zb = (bf16*)(ws + WS_Z); bf16* Qb = (bf16*)(ws + WS_Z + 1 * ZSTRIDE_B); bf16* Kb = (bf16*)(ws + WS_Z + 2 * ZSTRIDE_B); bf16* Vb = (bf16*)(ws + WS_Z + 3 * ZSTRIDE_B);
    bf16* GA = (bf16*)(ws + WS_Z + 4 * ZSTRIDE_B); bf16* GB = (bf16*)(ws + WS_Z + 6 * ZSTRIDE_B);
    bf16* Yb = (bf16*)(ws + WS_YB); bf16* Mrg = (bf16*)(ws + WS_MRG); bf16* PQb = (bf16*)(ws + WS_PQ); int* ids = (int*)(ws + WS_IDS); float* gts = (float*)(ws + WS_GTS);
    unsigned char* U8 = ws + WS_U16; unsigned char* V8 = ws + WS_V16; unsigned* wpk = (unsigned*)(ws + WS_WPK); float* rstd1 = (float*)(ws + WS_RSTD1); unsigned short* Y16 = (unsigned short*)(ws + WS_Y16);
    float* biasT = (float*)(ws + WS_BIAS); float* pw32 = (float*)(ws + WS_PW32); float* kpart = (float*)(ws + WS_KPART); float* Kg = (float*)(ws + WS_KG); float* ssq1 = (float*)(ws + WS_SSQ1);

    if (IN(0)) for (int rep_ = 0; rep_ < REP_0; ++rep_) {
        LAS float* scr = (LAS float*)(F.lds + RING_OFF + F.wave * 16384);
        constexpr int I_IN = (1024 / 64) * (4096 / 32), I_GLU = (512 / 64) * (512 / 32), I_UP = (512 / 64) * (1024 / 32), I_OUT = (1024 / 64) * (1024 / 32), I_Q = (1024 / 64) * (2048 / 32);
        constexpr int NITEMS = I_IN + I_GLU + 2 * I_UP + I_OUT + I_Q;
        for (int it = gw; it < NITEMS; it += NGW) {
            int r = it;
            if (r < I_IN) { p0_transpose_item(args.in[2], 1024, 4096, Win_t, scr, r, F.lane); continue; } r -= I_IN;
            if (r < I_GLU) { p0_transpose_item(args.in[11], 512, 512, Wglu_t, scr, r, F.lane); continue; } r -= I_GLU;
            if (r < I_UP) { p0_transpose_item(args.in[13], 512, 1024, Wus_t, scr, r, F.lane); continue; } r -= I_UP;
            if (r < I_UP) { p0_transpose_item(args.in[14], 512, 1024, Wua_t, scr, r, F.lane); continue; } r -= I_UP;
            if (r < I_OUT) { p0_transpose_item(args.in[16], 1024, 1024, Wout_t, scr, r, F.lane); continue; } r -= I_OUT;
            p0_transpose_item(args.in[18], 1024, 2048, Wq_t, scr, r, F.lane);
        }
        for (int it = gw; it < NGRP * CH; it += NGW)
            ssm_table_task(it >> 5, it & 31, F.lane, scr, args.in[3], args.in[4], args.in[5], args.in[6], args.in[7], args.in[8], args.in[9], Kg, WE, BP, pw32);
        for (int m = gw; m < MTOK; m += NGW * 4) rms_rows4_to_bf16(x, args.in[1], Hb, m, NGW, F.lane);
        for (int it = gw; it < 64; it += NGW) { const float* src = (it < 32 ? args.in[19] : args.in[20]) + (size_t)(it & 31) * 512 + 8 * F.lane;
            const f32x4 a = *(const GAS f32x4*)src, b = *(const GAS f32x4*)(src + 4);
            *(GAS v4u*)(KSb + (size_t)it * 512 + 8 * F.lane) = (v4u){pk2(a.x, a.y), pk2(a.z, a.w), pk2(b.x, b.y), pk2(b.z, b.w)}; }
        if (gw == 0) { for (int i = F.lane; i < 8 * 128; i += 64) { const int h = i >> 7, rel = i & 127; int bk;
                if (rel < 16) bk = rel; else { const float lg = logf((float)rel / 16.0f) / 2.0794415416798357f * 16.0f; bk = 16 + (int)lg; bk = bk < 0 ? 0 : (bk > 31 ? 31 : bk); }
                biasT[i] = (args.in[15][bk * 8 + h] - args.in[15][31 * 8 + h]) * 1.4426950408889634f; } }
        if (BOTH(0)) GRID_BAR();
    }

    if (IN(1)) for (int rep_ = 0; rep_ < REP_1; ++rep_) {
        const float* Dsk = args.in[10];
        for (int i0 = gtid; i0 < NGRP * 512 * 64; i0 += NTHR * 4) {
            f32x4 ka[4], kb[4];
#pragma unroll
            for (int q = 0; q < 4; ++q) { const int i = i0 + q * NTHR; const int ic = (i < NGRP * 512 * 64) ? i : i0; const int g = ic >> 15, m = (ic >> 6) & 511, k8 = ic & 63, j = m >> 4, ho = m & 15, jp = k8 >> 1, hi0 = (k8 & 1) * 8;
                const int lag = (jp <= j) ? j - jp : 0; const float* kp = Kg + ((size_t)(g * 32 + lag) * 256 + ho * 16 + hi0); ka[q] = *(const GAS f32x4*)kp; kb[q] = *(const GAS f32x4*)(kp + 4); }
#pragma unroll
            for (int q = 0; q < 4; ++q) { const int i = i0 + q * NTHR; if (i >= NGRP * 512 * 64) break; const int g = i >> 15, m = (i >> 6) & 511, k8 = i & 63, j = m >> 4, ho = m & 15, jp = k8 >> 1, hi0 = (k8 & 1) * 8;
                v4u o = (v4u){0u, 0u, 0u, 0u};
                if (jp <= j) { f32x4 a = ka[q], b = kb[q];
                    if (jp == j && (ho >> 3) == (hi0 >> 3)) { const float dv = Dsk[g * 16 + ho]; const int e = ho & 7;
                        a.x += (e == 0) ? dv : 0.f; a.y += (e == 1) ? dv : 0.f; a.z += (e == 2) ? dv : 0.f; a.w += (e == 3) ? dv : 0.f;
                        b.x += (e == 4) ? dv : 0.f; b.y += (e == 5) ? dv : 0.f; b.z += (e == 6) ? dv : 0.f; b.w += (e == 7) ? dv : 0.f; }
                    o = (v4u){pk2(a.x, a.y), pk2(a.z, a.w), pk2(b.x, b.y), pk2(b.z, b.w)}; }
                *(GAS v4u*)(BP + ((size_t)(g * 512 + m) * APK + k8 * 8)) = o; } }
        pg8::Gemm g{Hb, Win_t, MTOK, INCOLS, 1024, 1024, 1024, 1 << 30, 0};
        pg8::StaticOrder S; S.init(MTOK, INCOLS, F.G, (int)blockIdx.x);
        pg8::EpiIn E{Zb, AP, kpart};
        pg8::gemm_phase<pg8::EpiIn, pg8::StaticOrder, true>(F.lds + RING_OFF, g, S, E);
        if (BOTH(1)) GRID_BAR();
    }

    if (IN(2)) for (int rep_ = 0; rep_ < REP_2; ++rep_) {
        const int bx = (int)blockIdx.x;
        const bool shared = F.G < 4;
        const int nS = shared ? F.G : (F.G >= 256 ? 64 : F.G / 4), nA = shared ? F.G : F.G - nS;
        const bool inS = shared || bx < nS, inA = shared || bx >= nS; const int aidx = shared ? bx : bx - nS;
        if (inS) {
#pragma unroll 1
            for (int pm = bx; pm < MTOK / 256; pm += nS) {
                { pg8::Gemm g1{AP, WE, MTOK, 256, 512, APK, 512, 2, (size_t)256 * 512}; OnePanel S1{pm, 1}; pg8::EpiE E1{Eb};
                  pg8::gemm_phase<pg8::EpiE, OnePanel, true>(F.lds + RING_OFF, g1, S1, E1); }
                VM_WAIT(); __syncthreads();
                if (F.tid < 256) { const int gb = (pm >> 1) * 8 + (pm & 1) * 4 + (F.tid >> 6), g_ = gb >> 3, p = F.tid & 63; const size_t row0 = (size_t)gb * 64;
                    const float mr = pw32[g_ * 128 + p], mi = pw32[g_ * 128 + 64 + p]; float sr = 0.f, si = 0.f;
#pragma unroll 1
                    for (int c0 = 0; c0 < NCHUNK; c0 += 32) { float er[32], ei[32];
#pragma unroll
                        for (int c = 0; c < 32; ++c) { er[c] = Eb[(row0 + c0 + c) * 128 + p]; ei[c] = Eb[(row0 + c0 + c) * 128 + 64 + p]; }
#pragma unroll
                        for (int c = 0; c < 32; ++c) { bf16* ap = AP + (row0 + c0 + c) * APK + 512; ap[p] = (bf16)f2bf(sr); ap[64 + p] = (bf16)f2bf(si);
                            const float nr = mr * sr - mi * si + er[c], ni = mr * si + mi * sr + ei[c]; sr = nr; si = ni; } } }
                VM_WAIT(); __syncthreads();
                { pg8::Gemm g{AP, BP, MTOK, 512, APK, APK, APK, 2, (size_t)512 * APK}; OnePanel S3{pm, 2}; pg8::EpiY E{Ypre};
                  pg8::gemm_phase<pg8::EpiY, OnePanel, true>(F.lds + RING_OFF, g, S3, E); }
            }
        }
        if (inA) {
            static_assert(attn_body::ATTN_LDS_BYTES <= RING_BYTES, "attention LDS");
#pragma unroll 1
            for (int a = aidx; a < 192; a += nA) { const int ty = a >> 6, bh = a & 63;
#pragma unroll 1
                for (int i = 0; i < 4; ++i) { const int qb = (ty == 0) ? (i == 0 ? 7 : (i == 1 ? 2 : (i == 2 ? 0 : -1))) : (ty == 1) ? (i == 0 ? 6 : (i == 1 ? 4 : -1)) : (i == 0 ? 5 : (i == 1 ? 3 : (i == 2 ? 1 : -1)));
                    if (qb < 0) break;
                    attn_body::attn_unit<8>(bh >> 3, bh & 7, qb, (const attn_body::bf16*)Qb, (const attn_body::bf16*)Kb, (const attn_body::bf16*)Vb, (attn_body::bf16*)Yb, (char*)lds + RING_OFF, kpart, biasT); } }
        }
        if (BOTH(2)) GRID_BAR();
    }

    if (IN(3)) for (int rep_ = 0; rep_ < REP_3; ++rep_) {
        pg8::Gemm g{Ypre, Wglu_t, MTOK, 512, 512, 512, 512, 1 << 30, 0};
        pg8::StaticOrder S; S.init(MTOK, 512, F.G, (int)blockIdx.x);
        pg8::EpiGlu E{Ypre, Ya, args.in[12]};
        pg8::gemm_phase<pg8::EpiGlu, pg8::StaticOrder, true>(F.lds + RING_OFF, g, S, E);
        { const int nun = (MTOK / 256) * (512 / 256);
          const int nconv = (F.G > nun) ? F.G - nun : F.G, cidx = (F.G > nun) ? (int)blockIdx.x - nun : (int)blockIdx.x;
          if (cidx >= 0) for (int ex = cidx * NWAVES + F.wave; ex < 2 * NEXP; ex += nconv * NWAVES * 4) { const bool isv = ex >= NEXP; convert_expert_rows<4>(isv ? args.in[22] : args.in[21], isv ? ex - NEXP : ex, nconv * NWAVES, isv, F.lane, U8, V8); } }
        if (BOTH(3)) GRID_BAR();
    }

    if (IN(4)) for (int rep_ = 0; rep_ < REP_4; ++rep_) {
        pg8::Gemm g{Ya, Wus_t, MTOK, 1024, 512, 512, 512, 1 << 30, 0, Yb, Wua_t};
        DualOrder S; S.S.init(MTOK, 1024, F.G, (int)blockIdx.x);
        pg8::EpiMrgDual E{pg8::EpiMrg<0>{GA, Mrg}, pg8::EpiMrg<1>{GB, Mrg}};
        pg8::gemm_phase<pg8::EpiMrgDual, DualOrder, true>(F.lds + RING_OFF, g, S, E);
        if (BOTH(4)) GRID_BAR();
    }

    if (IN(5)) for (int rep_ = 0; rep_ < REP_5; ++rep_) {
        pg8::Gemm g{Mrg, Wout_t, MTOK, 1024, 1024, 1024, 1024, 1 << 30, 0}; pg8::StaticOrder S; S.init(MTOK, 1024, F.G, (int)blockIdx.x);
        pg8::EpiX1 E{x, args.out, XG, args.in[17], ssq1};
        pg8::gemm_phase<pg8::EpiX1, pg8::StaticOrder, true>(F.lds + RING_OFF, g, S, E);
        if (BOTH(5)) GRID_BAR();
    }

    if (IN(6)) for (int rep_ = 0; rep_ < REP_6; ++rep_) {
        pg8::Gemm g{XG, Wq_t, MTOK, PQ, 1024, 1024, 1024, 1 << 30, 0}; pg8::StaticOrder S; S.init(MTOK, PQ, F.G, (int)blockIdx.x);
        pg8::EpiPlain E{PQb, PQ};
        pg8::gemm_phase<pg8::EpiPlain, pg8::StaticOrder, true>(F.lds + RING_OFF, g, S, E);
        if (BOTH(6)) GRID_BAR();
    }

    if (IN(7)) for (int rep_ = 0; rep_ < REP_7; ++rep_) {
        LAS unsigned char* scr = F.lds + RING_OFF + F.wave * 2048;
        LAS unsigned char* ksl = F.lds + RING_OFF + 16384;
        for (int c = F.tid; c < 256 * 16; c += NWAVES * 64) { const int row = c >> 4, ch = c & 15; *(LAS v4u*)(ksl + row * 256 + ((ch ^ (row & 15)) << 4)) = *(const GAS v4u*)(KSb + row * 128 + ch * 8); }
        __syncthreads();
        for (int it = gw; it < (MTOK / 32) * 8; it += NGW) topk_task(it >> 3, it & 7, F.lane, scr, PQb, ksl, ssq1, ids, gts, rstd1);
        if (BOTH(7)) { VM_WAIT(); __syncthreads(); }
    }

    if (IN(8)) for (int rep_ = 0; rep_ < REP_8; ++rep_) {
        peer_a_phase(F.lane, F.wave, F.G, F.vcu, XG, U8, ids, gts, rstd1, wpk, F.lds, 0xffff);
        if (BOTH(8)) { VM_WAIT(); __syncthreads(); }
    }
    if (IN(9)) for (int rep_ = 0; rep_ < REP_9; ++rep_) {
        peer_b_phase(F.lane, F.wave, F.G, F.vcu, V8, wpk, Y16, args.out, args.in[23]);
    }
#undef IN
#undef BOTH
#undef GRID_BAR
}

extern "C" void kernel_launch(void* const* d_in, const int* in_sizes, int n_in, void* d_out, int out_size, void* d_ws, size_t ws_size, hipStream_t stream) {
    static int grid = 0;
    if (grid == 0) {
        if (n_in != 24 || in_sizes[0] != MTOK * DMODEL || out_size != MTOK * DMODEL || ws_size < WS_END) { fprintf(stderr, "kernel_launch: unexpected shapes (n_in %d, in0 %d, out %d, ws %zu); nothing launched\n", n_in, n_in > 0 ? in_sizes[0] : -1, out_size, ws_size); grid = -1; return; }
        int dev = 0, cus = 0, per_cu = 0;
        if (hipGetDevice(&dev) != hipSuccess || hipDeviceGetAttribute(&cus, hipDeviceAttributeMultiprocessorCount, dev) != hipSuccess) { grid = -1; return; }
        if (hipFuncSetAttribute((const void*)mk_fwd, hipFuncAttributeMaxDynamicSharedMemorySize, LDS_BYTES) != hipSuccess) { fprintf(stderr, "kernel_launch: hipFuncSetAttribute failed\n"); grid = -1; return; }
        if (hipOccupancyMaxActiveBlocksPerMultiprocessor(&per_cu, (const void*)mk_fwd, NWAVES * 64, LDS_BYTES) != hipSuccess || per_cu < 1) { fprintf(stderr, "kernel_launch: occupancy query says %d blocks per CU\n", per_cu); }
        (void)hipGetLastError();
        grid = cus;
    }
    if (grid < 0) return;
    if (N_LAUNCHES != PER_PHASE) { if (hipMemsetAsync((char*)d_ws + WS_CTL, 0, CTL_ZERO_BYTES, stream) != hipSuccess) return; }
    Args a{};
    for (int i = 0; i < 24; ++i) a.in[i] = (const float*)d_in[i];
    a.out = (float*)d_out; a.ws = (unsigned char*)d_ws; a.pad = 0;
    if (N_LAUNCHES == PER_PHASE) {
        for (int li = 0; li < PER_PHASE; ++li) { a.ph_lo = li; a.ph_hi = li + 1; a.li = li; hipLaunchKernelGGL(mk_fwd, dim3(grid), dim3(NWAVES * 64), LDS_BYTES, stream, a); }
    } else {
        a.ph_lo = 0; a.ph_hi = PER_PHASE; a.li = 0;
        hipLaunchKernelGGL(mk_fwd, dim3(grid), dim3(NWAVES * 64), LDS_BYTES, stream, a);
    }
}
```

```cpp
#include <hip/hip_runtime.h>
#include <hip/hip_bf16.h>
#include <cstdio>
#include <cstdint>
#include <cmath>

#ifndef MK_N_LAUNCHES
#define MK_N_LAUNCHES 1
#endif

namespace pg8 {
#define PG8_LAS __attribute__((address_space(3)))
typedef unsigned short bf16_t;
typedef short bf16x8 __attribute__((ext_vector_type(8)));
typedef float f32x4 __attribute__((ext_vector_type(4)));
typedef unsigned u32x4 __attribute__((ext_vector_type(4)));
constexpr int BM = 256, BK = 64, HALF = 128, HTB = HALF * BK * 2, STAGE_BYTES = 8 * HTB, NXCD = 8, WGM = 8;

__host__ __device__ __forceinline__ int lds_byte(int r, int c) { const int st = (r >> 4) * 2 + (c >> 5), rr = r & 15, cc = c & 31, ob = rr * 64 + cc * 2; return st * 1024 + (ob ^ (((ob >> 9) & 1) << 5)); }
__host__ __device__ __forceinline__ void stage_rc(int b, int& R, int& C) { const int st = b / 1024, sb = b % 1024, swz = sb ^ (((sb >> 9) & 1) << 5); R = (st >> 1) * 16 + swz / 64; C = (st & 1) * 32 + (swz % 64) / 2; }
__host__ __device__ __forceinline__ int perm32(int rho) { const int n = rho >> 4, i = rho & 15; return 8 * (i >> 2) + 4 * n + (i & 3); }

struct Unit { int pm, pn, w; };
struct Gemm { const bf16_t* A; const bf16_t* Bt; int M, N, K, lda, ldb, rpg; size_t bgs; const bf16_t* A2 = nullptr; const bf16_t* Bt2 = nullptr; };

struct StaticOrder {
    int nM, nN, nwg, G, c;
    __host__ __device__ __forceinline__ void init(int M, int N, int G_, int c_) { nM = M / BM; nN = N / BM; nwg = nM * nN; G = G_; c = c_; }
    __host__ __device__ __forceinline__ bool next(int i, Unit& u) const {
        const long L = (long)i * G + c; if (L >= nwg) return false;
        int wgid = (int)L; { const int q = nwg / NXCD, r = nwg % NXCD, xcd = wgid % NXCD, off = wgid / NXCD; wgid = (xcd < r ? xcd * (q + 1) : r * (q + 1) + (xcd - r) * q) + off; }
        const int nig = WGM * nN, gid = wgid / nig, fm = gid * WGM, gsz = (nM - fm) < WGM ? (nM - fm) : WGM;
        u.pm = fm + ((wgid % nig) % gsz); u.pn = (wgid % nig) / gsz; u.w = 0; return true;
    }
};

__device__ __forceinline__ unsigned cvt_pk_bf16(float lo, float hi) { unsigned r; asm volatile("v_cvt_pk_bf16_f32 %0, %1, %2" : "=v"(r) : "v"(lo), "v"(hi)); return r; }
__device__ __forceinline__ float bf_lo(unsigned w) { return __uint_as_float(w << 16); }
__device__ __forceinline__ float bf_hi(unsigned w) { return __uint_as_float(w & 0xffff0000u); }
__device__ __forceinline__ float sigmoid_f(float x) { return __builtin_amdgcn_rcpf(1.0f + __builtin_amdgcn_exp2f(-1.4426950409f * x)); }
__device__ __forceinline__ float gelu_tanh(float x) { const float u = x + 0.044715f * x * x * x; return x * __builtin_amdgcn_rcpf(1.0f + __builtin_amdgcn_exp2f(-2.3022081985f * u)); }

template <class Epi, class Sched, bool ALIGN_EPI>
__device__ __forceinline__ void gemm_phase(PG8_LAS unsigned char* lds, const Gemm g, const Sched& S, const Epi& E) {
    int tid = threadIdx.x; asm volatile("" : "+v"(tid));
    const int wid = __builtin_amdgcn_readfirstlane(tid >> 6), lane = tid & 63, wr = wid >> 2, wc = wid & 3, fr = lane & 15, fq = lane >> 4;
    const int K = g.K, nt = K / BK;
    unsigned voffA[2], voffB[2];
#pragma unroll
    for (int i = 0; i < 2; ++i) { int R, C; stage_rc(tid * 16 + i * 8192, R, C); const int Rb = Epi::PERM ? ((R & ~31) + perm32(R & 31)) : R;
        voffA[i] = (unsigned)(R * g.lda + C) * 2u; voffB[i] = (unsigned)(Rb * g.ldb + C) * 2u; }
    const size_t kstep = (size_t)(BK * 2);
    const size_t hstepA = (size_t)HALF * g.lda * 2, hstepB = (size_t)HALF * g.ldb * 2;
    const size_t tstepA = 2 * hstepA, tstepB = 2 * hstepB;
    const unsigned ldsw = (unsigned)wid * 1024u;
    const int aoff = lds_byte(wr * 64 + fr, fq * 8), boff = lds_byte(wc * 32 + fr, fq * 8);
#define PG8_SA(b, h) (((b) * 2 + (h)) * HTB)
#define PG8_SB(b, h) ((4 + (b) * 2 + (h)) * HTB)
#define PG8_STAGE(bufoff, gbase, voff) do { _Pragma("unroll") for (int _i = 0; _i < 2; ++_i) \
        __builtin_amdgcn_global_load_lds((const unsigned*)((const char*)(gbase) + (voff)[_i]), (PG8_LAS unsigned*)(lds + (bufoff) + ldsw + _i * 8192), 16, 0, 0); } while (0)
#define PG8_LDA(dst, b, h) do { _Pragma("unroll") for (int m = 0; m < 4; ++m) _Pragma("unroll") for (int k = 0; k < 2; ++k) dst[m][k] = *(const PG8_LAS bf16x8*)(lds + PG8_SA(b, h) + aoff + m * 2048 + k * 1024); } while (0)
#define PG8_LDB(dst, b, h) do { _Pragma("unroll") for (int n = 0; n < 2; ++n) _Pragma("unroll") for (int k = 0; k < 2; ++k) dst[n][k] = *(const PG8_LAS bf16x8*)(lds + PG8_SB(b, h) + boff + n * 2048 + k * 1024); } while (0)
#define PG8_MMA(ai, bj, At, Bt) do { __builtin_amdgcn_s_setprio(1); _Pragma("unroll") for (int m = 0; m < 4; ++m) _Pragma("unroll") for (int n = 0; n < 2; ++n) _Pragma("unroll") for (int k = 0; k < 2; ++k) \
        acc[ai][bj][m][n] = __builtin_amdgcn_mfma_f32_16x16x32_bf16(Bt[n][k], At[m][k], acc[ai][bj][m][n], 0, 0, 0); __builtin_amdgcn_s_setprio(0); } while (0)
#define PG8_WAIT_V(n) asm volatile("s_waitcnt vmcnt(" #n ")" ::: "memory")
#define PG8_WAIT_L(n) asm volatile("s_waitcnt lgkmcnt(" #n ")" ::: "memory")
#define PG8_BAR __builtin_amdgcn_s_barrier()
#define PG8_SCHED __builtin_amdgcn_sched_barrier(0)
    Unit cur, nxt; int ui = 0;
    if (!S.next(0, cur)) return;
    f32x4 acc[2][2][4][2];
#pragma unroll
    for (int a = 0; a < 2; ++a)
#pragma unroll
        for (int b = 0; b < 2; ++b)
#pragma unroll
            for (int m = 0; m < 4; ++m)
#pragma unroll
                for (int n = 0; n < 2; ++n) acc[a][b][m][n] = (f32x4){0.f, 0.f, 0.f, 0.f};
    bf16x8 At[4][2], B0[2][2], B1[2][2];
    const char* cA = (const char*)(cur.w ? g.A2 : g.A) + (size_t)cur.pm * tstepA;
    const char* cB = (const char*)(cur.w ? g.Bt2 : g.Bt) + (size_t)(cur.pm / g.rpg) * g.bgs * 2 + (size_t)cur.pn * tstepB;
    PG8_STAGE(PG8_SB(0, 0), cB, voffB); PG8_STAGE(PG8_SB(0, 1), cB + hstepB, voffB); PG8_STAGE(PG8_SA(0, 0), cA, voffA); PG8_STAGE(PG8_SA(0, 1), cA + hstepA, voffA);
    if (wr == 1) PG8_BAR;
    PG8_WAIT_V(2); PG8_BAR;
    PG8_STAGE(PG8_SB(1, 0), cB + kstep, voffB); PG8_STAGE(PG8_SA(1, 0), cA + kstep, voffA); PG8_STAGE(PG8_SB(1, 1), cB + hstepB + kstep, voffB);
    PG8_WAIT_V(6); PG8_BAR;
    for (;;) {
        const bool has_next = S.next(ui + 1, nxt);
        const char* nA = has_next ? (const char*)(nxt.w ? g.A2 : g.A) + (size_t)nxt.pm * tstepA : cA;
        const char* nB = has_next ? (const char*)(nxt.w ? g.Bt2 : g.Bt) + (size_t)(nxt.pm / g.rpg) * g.bgs * 2 + (size_t)nxt.pn * tstepB : cB;
        for (int t = 0; t < nt; t += 2) {
            const bool last = (t == nt - 2);
            const char* a1 = cA + (size_t)(t + 1) * kstep;
            const char* a2 = last ? nA : cA + (size_t)(t + 2) * kstep; const char* b2 = last ? nB : cB + (size_t)(t + 2) * kstep;
            const char* a3 = a2 + kstep; const char* b3 = b2 + kstep;
            PG8_LDB(B0, 0, 0); PG8_LDB(B1, 0, 1); PG8_SCHED; PG8_LDA(At, 0, 0); PG8_STAGE(PG8_SA(1, 1), a1 + hstepA, voffA);
            PG8_WAIT_V(8); PG8_WAIT_L(0); PG8_BAR; PG8_MMA(0, 0, At, B0); PG8_MMA(0, 1, At, B1); PG8_BAR; PG8_SCHED;
            PG8_LDA(At, 0, 1); PG8_STAGE(PG8_SB(0, 0), b2, voffB); PG8_STAGE(PG8_SB(0, 1), b2 + hstepB, voffB); PG8_STAGE(PG8_SA(0, 0), a2, voffA);
            PG8_WAIT_V(8); PG8_WAIT_L(0); PG8_BAR; PG8_MMA(1, 0, At, B0); PG8_MMA(1, 1, At, B1); PG8_BAR; PG8_SCHED;
            PG8_LDB(B0, 1, 0); PG8_LDB(B1, 1, 1); PG8_SCHED; PG8_LDA(At, 1, 0); PG8_STAGE(PG8_SA(0, 1), a2 + hstepA, voffA);
            PG8_WAIT_V(8); PG8_WAIT_L(0); PG8_BAR; PG8_MMA(0, 0, At, B0); PG8_MMA(0, 1, At, B1); PG8_BAR; PG8_SCHED;
            PG8_LDA(At, 1, 1); PG8_STAGE(PG8_SB(1, 0), b3, voffB); PG8_STAGE(PG8_SB(1, 1), b3 + hstepB, voffB); PG8_STAGE(PG8_SA(1, 0), a3, voffA);
            PG8_WAIT_V(8); PG8_WAIT_L(0); PG8_BAR; PG8_MMA(1, 0, At, B0); PG8_MMA(1, 1, At, B1); PG8_BAR; PG8_SCHED;
        }
        if constexpr (ALIGN_EPI) { if (wr == 0) PG8_BAR; }
        E(acc, cur, wr, wc, fr, fq);
        if (!has_next) break;
#pragma unroll
        for (int a = 0; a < 2; ++a)
#pragma unroll
            for (int b = 0; b < 2; ++b)
#pragma unroll
                for (int m = 0; m < 4; ++m)
#pragma unroll
                    for (int n = 0; n < 2; ++n) acc[a][b][m][n] = (f32x4){0.f, 0.f, 0.f, 0.f};
        cur = nxt; cA = nA; cB = nB; ++ui;
        if constexpr (ALIGN_EPI) { if (wr == 1) PG8_BAR; }
    }
    PG8_WAIT_V(0);
    if constexpr (!ALIGN_EPI) { if (wr == 0) PG8_BAR; }
    PG8_BAR;
#undef PG8_SA
#undef PG8_SB
#undef PG8_STAGE
#undef PG8_LDA
#undef PG8_LDB
#undef PG8_MMA
#undef PG8_WAIT_V
#undef PG8_WAIT_L
#undef PG8_BAR
#undef PG8_SCHED
}
}
namespace attn_body {
using bf16=__hip_bfloat16;
using bf16x8=__attribute__((ext_vector_type(8)))short;
using s16x4=__attribute__((ext_vector_type(4)))short;
using f32x16=__attribute__((ext_vector_type(16)))float;
using f32x4v=__attribute__((ext_vector_type(4)))float;
using u32x4=__attribute__((ext_vector_type(4)))unsigned;
constexpr int BATCH=8,NHEAD=8,SEQ=2048,D=64,DM=NHEAD*D;
constexpr int NW=8,QBLK=32,QB=QBLK*NW,KVBLK=64,NQB=SEQ/QB;
__device__ __forceinline__ int crow(int r,int hi){return (r&3)+8*(r>>2)+4*hi;}
#define SBAR() __builtin_amdgcn_sched_barrier(0)
__device__ __forceinline__ void cmask(f32x16&p0,f32x16&p1,int jb,int qrel,int hi){
  const float NEG=-INFINITY; int kb=64*jb+4*hi;
  #pragma unroll
  for(int r=0;r<16;++r){int kv=kb+(r&3)+8*(r>>2); if(kv>qrel)p0[r]=NEG; if(kv+32>qrel)p1[r]=NEG;}
}
typedef __attribute__((address_space(3))) const float* lds_cfptr;
__device__ __forceinline__ void biasadd(f32x16&p0,f32x16&p1,int jb,int qrel,int hi,lds_cfptr bt){
  const int base=qrel-64*jb-4*hi;
  #pragma unroll
  for(int r4=0;r4<16;r4+=4){
    #pragma unroll
    for(int r=r4;r<r4+4;++r){int rel=base-((r&3)+8*(r>>2)); int i0=min(max(rel,0),127), i1=min(max(rel-32,0),127); p0[r]+=bt[i0]; p1[r]+=bt[i1];}
    asm volatile("s_waitcnt lgkmcnt(0)":"+v"(p0),"+v"(p1)::"memory"); }
}

constexpr int NSLOT=3, SLOTB=8192;
constexpr int LDS_K=0, LDS_V=NSLOT*SLOTB, LDS_WS=2*NSLOT*SLOTB, LDS_OST=LDS_WS+NW*64*4, LDS_KM=LDS_OST+NW*4096, LDS_BT=LDS_KM+7*64*4, LDS_BYTES=LDS_BT+128*4;
constexpr float C2=0.125f*1.4426950408889634f;
__device__ __forceinline__ void glds16(const void*gsrc,unsigned lds_dst){unsigned keep;
  asm volatile("s_mov_b32 %0, m0\n\ts_mov_b32 m0, %2\n\ts_nop 0\n\tglobal_load_lds_dwordx4 %1, off\n\ts_mov_b32 m0, %0":"=&s"(keep):"v"(gsrc),"s"(lds_dst):"memory");}
__device__ __forceinline__ float max3f(float a,float b,float c){float r;asm("v_max3_f32 %0, %1, %2, %3":"=v"(r):"v"(a),"v"(b),"v"(c));return r;}
__device__ __forceinline__ float max2f(float a,float b){float r;asm("v_max_f32_e32 %0, %1, %2":"=v"(r):"v"(a),"v"(b));return r;}
__device__ __forceinline__ float fadd_s(float a,float b){float r;asm("v_add_f32_e32 %0, %1, %2":"=v"(r):"v"(a),"v"(b));return r;}
__device__ __forceinline__ float fsub_s(float a,float b){float r;asm("v_sub_f32_e32 %0, %1, %2":"=v"(r):"v"(a),"v"(b));return r;}
typedef float f32x2_t __attribute__((ext_vector_type(2))); typedef __bf16 bf16x2_t __attribute__((ext_vector_type(2)));
__device__ __forceinline__ unsigned cvtpk_s(float lo,float hi){f32x2_t v={lo,hi};bf16x2_t b=__builtin_convertvector(v,bf16x2_t);return __builtin_bit_cast(unsigned,b);}
#define WAIT_BAR(N) asm volatile("s_waitcnt vmcnt(" #N ") lgkmcnt(0)\n\ts_barrier":::"memory")

__device__ __forceinline__ void qkt(f32x16&p0,f32x16&p1,const char*Kslot,const bf16x8*qr,int r32,int hi){
  const char*kb=Kslot+hi*1024+r32*16;
  #pragma unroll
  for(int d0=0;d0<4;++d0){
    const bf16x8 b0=*reinterpret_cast<const bf16x8*>(kb+d0*2048);
    const bf16x8 b1=*reinterpret_cast<const bf16x8*>(kb+d0*2048+512);
    if(d0==0){p0=__builtin_amdgcn_mfma_f32_32x32x16_bf16(b0,qr[0],(f32x16){},0,0,0);p1=__builtin_amdgcn_mfma_f32_32x32x16_bf16(b1,qr[0],(f32x16){},0,0,0);}
    else{p0=__builtin_amdgcn_mfma_f32_32x32x16_bf16(b0,qr[d0],p0,0,0,0);p1=__builtin_amdgcn_mfma_f32_32x32x16_bf16(b1,qr[d0],p1,0,0,0);}}
}
typedef __attribute__((address_space(3))) const char* lds_cptr;
typedef short v4i16_t __attribute__((ext_vector_type(4)));
__device__ __forceinline__ void kload8(bf16x8*kf,lds_cptr kp){
  kf[0]=*(const __attribute__((address_space(3))) bf16x8*)(kp);      kf[1]=*(const __attribute__((address_space(3))) bf16x8*)(kp+512);
  kf[2]=*(const __attribute__((address_space(3))) bf16x8*)(kp+2048); kf[3]=*(const __attribute__((address_space(3))) bf16x8*)(kp+2560);
  kf[4]=*(const __attribute__((address_space(3))) bf16x8*)(kp+4096); kf[5]=*(const __attribute__((address_space(3))) bf16x8*)(kp+4608);
  kf[6]=*(const __attribute__((address_space(3))) bf16x8*)(kp+6144); kf[7]=*(const __attribute__((address_space(3))) bf16x8*)(kp+6656);
}
__device__ __forceinline__ void kload2(bf16x8*kf,lds_cptr kp,int j){ kf[2*j]=*(const __attribute__((address_space(3))) bf16x8*)(kp+j*2048); kf[2*j+1]=*(const __attribute__((address_space(3))) bf16x8*)(kp+j*2048+512); }
__device__ __forceinline__ s16x4 vtr(lds_cptr p){ return __builtin_bit_cast(s16x4,__builtin_amdgcn_ds_read_tr16_b64_v4i16((__attribute__((address_space(3))) v4i16_t*)p)); }
__device__ __forceinline__ float rowmax(const f32x16&p0,const f32x16&p1){
  float a=max3f(p0[0],p0[1],p1[0]),b=max3f(p0[2],p0[3],p1[1]);a=max3f(a,p1[2],p1[3]);
  #pragma unroll
  for(int r=4;r<16;r+=4){a=max3f(a,p0[r],p0[r+1]);b=max3f(b,p0[r+2],p0[r+3]);a=max3f(a,p1[r],p1[r+1]);b=max3f(b,p1[r+2],p1[r+3]);}
  const float m=max2f(a,b);
  auto rr=__builtin_amdgcn_permlane32_swap(__float_as_uint(m),__float_as_uint(m),false,false);
  return max2f(__uint_as_float(rr[0]),__uint_as_float(rr[1]));
}
__device__ __forceinline__ void pv(f32x16*o,int vb,bf16x8 pa0,bf16x8 pa1,bf16x8 pa2,bf16x8 pa3){
  #pragma unroll
  for(int d0=0;d0<2;++d0){s16x4 lo[4],hi[4];
    #pragma unroll
    for(int ks=0;ks<4;++ks){
      asm volatile("ds_read_b64_tr_b16 %0,%1 offset:%c2":"=&v"(lo[ks]):"v"(vb),"i"(d0*4096+ks*1024):"memory");
      asm volatile("ds_read_b64_tr_b16 %0,%1 offset:%c2":"=&v"(hi[ks]):"v"(vb),"i"(d0*4096+ks*1024+512):"memory");}
    asm volatile("s_waitcnt lgkmcnt(0)":::"memory");SBAR();
    #define PK(k) (bf16x8){lo[k][0],lo[k][1],lo[k][2],lo[k][3],hi[k][0],hi[k][1],hi[k][2],hi[k][3]}
    o[d0]=__builtin_amdgcn_mfma_f32_32x32x16_bf16(pa0,PK(0),o[d0],0,0,0);
    o[d0]=__builtin_amdgcn_mfma_f32_32x32x16_bf16(pa1,PK(1),o[d0],0,0,0);
    o[d0]=__builtin_amdgcn_mfma_f32_32x32x16_bf16(pa2,PK(2),o[d0],0,0,0);
    o[d0]=__builtin_amdgcn_mfma_f32_32x32x16_bf16(pa3,PK(3),o[d0],0,0,0);
    #undef PK
  }
}

#ifndef ATTN_STORE16
#define ATTN_STORE16(p,v) (*(u32x4*)(p)=(v))
#endif
template<int THRL> __device__ __forceinline__ void attn_unit(int b,int h,int qb,const bf16*Q,const bf16*__restrict__ K,const bf16*__restrict__ V,bf16*O,char*shm,const float*kpart,const float*btab){
  int tid=threadIdx.x; asm volatile("":"+v"(tid));
  const int lane=tid&63,r32=lane&31,hi=lane>>5; const int wid=__builtin_amdgcn_readfirstlane(tid>>6);
  const long rowbase=(long)b*SEQ; const int q0=qb*QB;
  const bf16*Qw=Q+(rowbase+q0+wid*QBLK)*DM+h*D;
  const bf16*Kh=K+rowbase*DM+h*D,*Vh=V+rowbase*DM+h*D;
  const unsigned lds0=(unsigned)(uintptr_t)shm;
  float*wsf=(float*)(shm+LDS_WS)+wid*64;
  const bf16*ksrc=Kh+(long)lane*DM+wid*8;
  const bf16*vsrc=Vh+(long)(16*(wid&3)+(lane>>2))*DM+(wid>>2)*32+(lane&3)*8;
  const unsigned kdst=lds0+LDS_K+wid*1024, vdst=lds0+LDS_V+wid*1024;
  #define DMA_K(t,slot) glds16(ksrc+(long)(t)*KVBLK*DM,(unsigned)__builtin_amdgcn_readfirstlane(kdst+(slot)))
  #define DMA_V(t,slot) glds16(vsrc+(long)(t)*KVBLK*DM,(unsigned)__builtin_amdgcn_readfirstlane(vdst+(slot)))
  const int vb0=(int)(lds0+LDS_V)+((lane>>4)&1)*32+(lane&3)*8+(4*hi+((lane&15)>>2))*64;
  const char*Kbase=shm+LDS_K; bf16x8 kf[8];
  const lds_cptr shm3=(lds_cptr)shm; const lds_cptr kp0=shm3+LDS_K+hi*1024+r32*16; const lds_cptr vp0=shm3+LDS_V+((lane>>4)&1)*32+(lane&3)*8+(4*hi+((lane&15)>>2))*64;
  const lds_cfptr btl=(lds_cfptr)(shm3+LDS_BT);
  const int NT=(q0+QB)/KVBLK;
  DMA_K(0,0);DMA_V(0,0);DMA_K(1,SLOTB);
  bf16x8 qr[4];
  #pragma unroll
  for(int d0=0;d0<4;++d0)qr[d0]=*reinterpret_cast<const bf16x8*>(&Qw[(long)r32*DM+d0*16+hi*8]);
  { float*km=(float*)(shm+LDS_KM); float*bt=(float*)(shm+LDS_BT); int tq=tid; asm volatile("":"+v"(tq));
    if(tq<448){const int j=tq>>6,d=tq&63; float v=0.f; if(j<qb&&qb>3){const float*kp=kpart+((size_t)((b*NQB+j)*2)*512)+h*D+d; v=(kp[0]+kp[512])*(1.0f/256.0f);} km[tq]=v;}
    else if(tq<448+64){const int i=tq-448; bt[i]=btab[h*128+i]; bt[64+i]=btab[h*128+64+i];} }
  float mhat=0.f,l_reg=0.f;f32x16 o[2];o[0]=f32x16{};o[1]=f32x16{};
  const int qrel=wid*QBLK+r32;
  #define CMASK(P0,P1,t) do{int jb_=(t)-(NT-4);   \
    if(jb_>=-2 && 32*wid+31-64*jb_>=0 && 32*wid-64*jb_-63<=112)biasadd(P0,P1,jb_,qrel,hi,btl); if(jb_>=0 && 64*jb_+63>32*wid)cmask(P0,P1,jb_,qrel,hi);}while(0)
  bool resc=false;
  #define START(P0,P1,t) do{ float rm=rowmax(P0,P1); resc=false; const float nv_=MASKADD(t); rm=fadd_s(rm,nv_); \
    { const float dl=__builtin_fmaxf(rm,-1.0e4f); mhat=fadd_s(mhat,dl); const float cc_=fsub_s(nv_,dl); \
      _Pragma("unroll") for(int r=0;r<16;++r){P0[r]=fadd_s(P0[r],cc_);P1[r]=fadd_s(P1[r],cc_);} } \
    _Pragma("unroll") for(int r=0;r<16;++r)P0[r]=__builtin_amdgcn_exp2f(P0[r]); }while(0)
  #define RESC() do{ if(resc){ asm volatile("s_waitcnt lgkmcnt(0)":::"memory"); \
      _Pragma("unroll") for(int d_=0;d_<2;++d_) _Pragma("unroll") for(int r=0;r<16;++r)o[d_][r]*=wsf[crow(r,hi)]; } }while(0)
  f32x16 pA0,pA1,pB0,pB1;
  int sl_prev=0,sl_cur=0,sl_next=SLOTB;
  #define ROT() do{sl_prev=sl_cur;sl_cur=sl_next;sl_next=(sl_next==(NSLOT-1)*SLOTB)?0:sl_next+SLOTB;}while(0)
  DMA_K(2,2*SLOTB);
  WAIT_BAR(3);
  unsigned selbits=(1u<<qb)-1u;
  if(qb>3){ selbits=0u;
    const __attribute__((address_space(3))) float* km3=(const __attribute__((address_space(3))) float*)(shm3+LDS_KM);
    float qf[32];
    #pragma unroll
    for(int d0=0;d0<4;++d0){
      #pragma unroll
      for(int i=0;i<8;++i) qf[d0*8+i]=__uint_as_float(((unsigned)(unsigned short)qr[d0][i])<<16);}
    float gj[7];
    #pragma unroll
    for(int j=0;j<7;++j){ float s=0.f;
      if(j<qb){
        #pragma unroll
        for(int d0=0;d0<4;++d0){ const f32x4v k0=*(const __attribute__((address_space(3))) f32x4v*)(km3+j*64+d0*16+hi*8); const f32x4v k1=*(const __attribute__((address_space(3))) f32x4v*)(km3+j*64+d0*16+hi*8+4);
          s+=qf[d0*8+0]*k0[0]+qf[d0*8+1]*k0[1]+qf[d0*8+2]*k0[2]+qf[d0*8+3]*k0[3]+qf[d0*8+4]*k1[0]+qf[d0*8+5]*k1[1]+qf[d0*8+6]*k1[2]+qf[d0*8+7]*k1[3]; }
        auto rr=__builtin_amdgcn_permlane32_swap(__float_as_uint(s),__float_as_uint(s),false,false); s=__uint_as_float(rr[0])+__uint_as_float(rr[1]); }
      gj[j]=s; }
    #pragma unroll
    for(int j=0;j<7;++j){ int rank=0;
      #pragma unroll
      for(int k=0;k<7;++k){ if(k!=j){ const bool beats=(k<j)?(gj[k]>=gj[j]):(gj[k]>gj[j]); rank+=(k<qb&&beats)?1:0; } }
      if(j<qb&&rank<3)selbits|=(1u<<j); }
  }
  #define MASKADD(t) ((((t)>>2)<qb && !((selbits>>((t)>>2))&1u))?-1.0e30f:0.0f)
  qkt(pA0,pA1,Kbase,qr,r32,hi);asm volatile("s_nop 15\n\ts_nop 7":"+v"(pA0),"+v"(pA1));CMASK(pA0,pA1,0);
  START(pA0,pA1,0);
  _Pragma("unroll") for(int r=0;r<16;++r)pA1[r]=__builtin_amdgcn_exp2f(pA1[r]);
  WAIT_BAR(0);
  DMA_K(3,0);DMA_V(1,SLOTB);
  ROT();
  kload8(kf,kp0+sl_cur);
  WAIT_BAR(2);
  s16x4 vlo[8],vhi[8]; u32x4 pw0,pw1,pw2,pw3;
  #define PKW(P,B) cvtpk_s(P[B],P[B+1])
  #define PAF(k) __builtin_bit_cast(bf16x8,pw##k)
  #define VFR(i) (bf16x8){vlo[i][0],vlo[i][1],vlo[i][2],vlo[i][3],vhi[i][0],vhi[i][1],vhi[i][2],vhi[i][3]}
  #define PIN(x) asm volatile("":"+v"(x))
  #define MX3(a,b,c) __builtin_fmaxf(__builtin_fmaxf((a),(b)),(c))
  #define GAPA(MF,A0,A1,A2,A3,W0,W1,PW) do{ MF; sacc+=A0; sacc+=A1; sacc+=A2; sacc+=A3; PIN(sacc); W0; W1; PIN(PW); SBAR(); }while(0)
  #define EX(v) __builtin_amdgcn_exp2f(v)
  #define GAPB(MF,X,B) do{ MF; X[B]=EX(X[B]); X[B+1]=EX(X[B+1]); X[B+2]=EX(X[B+2]); X[B+3]=EX(X[B+3]); PIN(X); SBAR(); }while(0)
  #define VRD(i) do{ vlo[i]=vtr(vp_+(((i)>>2)*4096+((i)&3)*1024)); vhi[i]=vtr(vp_+(((i)>>2)*4096+((i)&3)*1024+512)); }while(0)
  #define KRD(G,j) do{ if(G){ kload2(kf,kp0+sl_next,j); SBAR(); } }while(0)
  #define STEP(C0,C1,P0,P1,t,GK,GV,GL) do{ SBAR(); \
    const lds_cptr vp_=vp0+sl_prev; \
    VRD(0); SBAR(); float sacc=(P0[0]+P0[1]); \
    GAPA(C0=__builtin_amdgcn_mfma_f32_32x32x16_bf16(kf[0],qr[0],(f32x16){},0,0,0), P0[2],P0[3],P0[4],P0[5],     pw0[0]=PKW(P0,0), pw0[1]=PKW(P0,2), pw0); \
    VRD(4); SBAR(); GAPA(C1=__builtin_amdgcn_mfma_f32_32x32x16_bf16(kf[1],qr[0],(f32x16){},0,0,0), P0[6],P0[7],P0[8],P0[9],     pw0[2]=PKW(P0,4), pw0[3]=PKW(P0,6), pw0); \
    VRD(1); SBAR(); GAPA(C0=__builtin_amdgcn_mfma_f32_32x32x16_bf16(kf[2],qr[1],C0,0,0,0),   P0[10],P0[11],P0[12],P0[13], pw1[0]=PKW(P0,8), pw1[1]=PKW(P0,10), pw1); \
    VRD(5); SBAR(); GAPA(C1=__builtin_amdgcn_mfma_f32_32x32x16_bf16(kf[3],qr[1],C1,0,0,0),   P0[14],P0[15],P1[0],P1[1],   pw1[2]=PKW(P0,12),pw1[3]=PKW(P0,14), pw1); \
    VRD(2); SBAR(); GAPA(C0=__builtin_amdgcn_mfma_f32_32x32x16_bf16(kf[4],qr[2],C0,0,0,0),   P1[2],P1[3],P1[4],P1[5],     pw2[0]=PKW(P1,0), pw2[1]=PKW(P1,2), pw2); \
    VRD(6); SBAR(); GAPA(C1=__builtin_amdgcn_mfma_f32_32x32x16_bf16(kf[5],qr[2],C1,0,0,0),   P1[6],P1[7],P1[8],P1[9],     pw2[2]=PKW(P1,4), pw2[3]=PKW(P1,6), pw2); \
    VRD(3); SBAR(); GAPA(C0=__builtin_amdgcn_mfma_f32_32x32x16_bf16(kf[6],qr[3],C0,0,0,0),   P1[10],P1[11],P1[12],P1[13], pw3[0]=PKW(P1,8), pw3[1]=PKW(P1,10), pw3); \
    VRD(7); SBAR(); GAPA(C1=__builtin_amdgcn_mfma_f32_32x32x16_bf16(kf[7],qr[3],C1,0,0,0),   P1[14],P1[15],0.f,0.f,       pw3[2]=PKW(P1,12),pw3[3]=PKW(P1,14), pw3); \
    l_reg+=sacc; \
    if(GK){DMA_K((t)+3,sl_cur);} if(GV){DMA_V((t)+1,sl_next);} \
    CMASK(C0,C1,t); \
    { float a=MX3(C0[0],C0[1],C1[0]),b=MX3(C0[2],C0[3],C1[1]); a=MX3(a,C1[2],C1[3]); \
      _Pragma("unroll") for(int r=4;r<16;r+=4){a=MX3(a,C0[r],C0[r+1]);b=MX3(b,C0[r+2],C0[r+3]);a=MX3(a,C1[r],C1[r+1]);b=MX3(b,C1[r+2],C1[r+3]);} \
      float rm=__builtin_fmaxf(a,b); { auto rr=__builtin_amdgcn_permlane32_swap(__float_as_uint(rm),__float_as_uint(rm),false,false); rm=__builtin_fmaxf(__uint_as_float(rr[0]),__uint_as_float(rr[1])); } \
      const float nv_=MASKADD(t)-mhat; rm+=nv_; float cc_=nv_; \
      resc=false; \
      if(__builtin_expect(__any(rm>(float)THRL),0)){ const float dl=__builtin_fmaxf(rm,0.f); mhat+=dl; cc_-=dl; \
        const float f=__builtin_amdgcn_exp2f(-dl); l_reg*=f; if(hi==0)wsf[r32]=f; resc=true; } \
      _Pragma("unroll") for(int r=0;r<16;++r){C0[r]+=cc_;C1[r]+=cc_;} } \
    SBAR(); \
    GAPB(o[0]=__builtin_amdgcn_mfma_f32_32x32x16_bf16(PAF(0),VFR(0),o[0],0,0,0), C0,0); \
    GAPB(o[1]=__builtin_amdgcn_mfma_f32_32x32x16_bf16(PAF(0),VFR(4),o[1],0,0,0), C0,4); \
    KRD(GL,0); GAPB(o[0]=__builtin_amdgcn_mfma_f32_32x32x16_bf16(PAF(1),VFR(1),o[0],0,0,0), C0,8); \
    KRD(GL,1); GAPB(o[1]=__builtin_amdgcn_mfma_f32_32x32x16_bf16(PAF(1),VFR(5),o[1],0,0,0), C0,12); \
    KRD(GL,2); GAPB(o[0]=__builtin_amdgcn_mfma_f32_32x32x16_bf16(PAF(2),VFR(2),o[0],0,0,0), C1,0); \
    KRD(GL,3); GAPB(o[1]=__builtin_amdgcn_mfma_f32_32x32x16_bf16(PAF(2),VFR(6),o[1],0,0,0), C1,4); \
    GAPB(o[0]=__builtin_amdgcn_mfma_f32_32x32x16_bf16(PAF(3),VFR(3),o[0],0,0,0), C1,8); \
    GAPB(o[1]=__builtin_amdgcn_mfma_f32_32x32x16_bf16(PAF(3),VFR(7),o[1],0,0,0), C1,12); \
    }while(0)
  int t=1;
  #undef CMASK
  #define CMASK(P0,P1,t) do{}while(0)
  for(;t+7<NT;t+=2){
    STEP(pB0,pB1,pA0,pA1,t,true,true,true);     WAIT_BAR(2); RESC(); ROT();
    STEP(pA0,pA1,pB0,pB1,t+1,true,true,true);   WAIT_BAR(2); RESC(); ROT();
  }
  #undef CMASK
  #define CMASK(P0,P1,t) do{int jb_=(t)-(NT-4);   \
    if(jb_>=-2 && 32*wid+31-64*jb_>=0 && 32*wid-64*jb_-63<=112)biasadd(P0,P1,jb_,qrel,hi,btl); if(jb_>=0 && 64*jb_+63>32*wid)cmask(P0,P1,jb_,qrel,hi);}while(0)
  #define ENDW(tt) do{ if((tt)+3<NT){WAIT_BAR(2);} else if((tt)+2<NT){WAIT_BAR(1);} else {WAIT_BAR(0);} }while(0)
  for(;t+1<NT;t+=2){
    STEP(pB0,pB1,pA0,pA1,t,(t+3<NT),(t+1<NT),(t+1<NT));       ENDW(t);   RESC(); ROT();
    STEP(pA0,pA1,pB0,pB1,t+1,(t+4<NT),(t+2<NT),(t+2<NT));     ENDW(t+1); RESC(); ROT();
  }
  STEP(pB0,pB1,pA0,pA1,NT-1,false,false,false); RESC();
  { float sacc=pB0[0]+pB0[1]; _Pragma("unroll") for(int r=2;r<16;++r)sacc+=pB0[r]; _Pragma("unroll") for(int r=0;r<16;++r)sacc+=pB1[r]; l_reg+=sacc;
    pw0=(u32x4){PKW(pB0,0),PKW(pB0,2),PKW(pB0,4),PKW(pB0,6)};pw1=(u32x4){PKW(pB0,8),PKW(pB0,10),PKW(pB0,12),PKW(pB0,14)};pw2=(u32x4){PKW(pB1,0),PKW(pB1,2),PKW(pB1,4),PKW(pB1,6)};pw3=(u32x4){PKW(pB1,8),PKW(pB1,10),PKW(pB1,12),PKW(pB1,14)};
    SBAR(); pv(o,vb0+sl_cur,PAF(0),PAF(1),PAF(2),PAF(3)); }
  #undef PKW
  #undef PAF
  #undef VFR
  #undef PIN
  #undef MX3
  #undef GAPA
  #undef GAPB
  #undef EX
  #undef VRD
  #undef KRD
  #undef STEP
  #undef ENDW
  #undef MASKADD
  {auto rr=__builtin_amdgcn_permlane32_swap(__float_as_uint(l_reg),__float_as_uint(l_reg),false,false);l_reg=__uint_as_float(rr[0])+__uint_as_float(rr[1]);}
  if(hi==0)wsf[32+r32]=l_reg;asm volatile("s_waitcnt lgkmcnt(0)":::"memory");
  float rli[16];
  #pragma unroll
  for(int r=0;r<16;++r)rli[r]=__builtin_amdgcn_rcpf(wsf[32+crow(r,hi)]);
  bf16*Ow=O+(rowbase+q0+wid*QBLK)*DM+h*D;
  { bf16*stg=(bf16*)(shm+LDS_OST)+wid*2048;
    #pragma unroll
    for(int r=0;r<16;++r){const int orow=crow(r,hi);
      #pragma unroll
      for(int d0=0;d0<2;++d0)stg[orow*64+d0*32+r32]=__float2bfloat16(o[d0][r]*rli[r]);}
    asm volatile("s_waitcnt lgkmcnt(0)":::"memory");
    #pragma unroll
    for(int i=0;i<4;++i){const int row=i*8+(lane>>3),ch=lane&7; const u32x4 v=*(const u32x4*)(stg+row*64+ch*8); ATTN_STORE16(Ow+(long)row*DM+ch*8,v);} }
  asm volatile("s_waitcnt lgkmcnt(0)\n\ts_barrier":::"memory");
  #undef DMA_K
  #undef DMA_V
  #undef CMASK
  #undef START
  #undef RESC
  #undef ROT
}
constexpr int ATTN_LDS_BYTES=LDS_BYTES;
#undef SBAR
#undef WAIT_BAR
}
constexpr int NWAVES = 8;
constexpr int PER_PHASE = 10;
constexpr int N_LAUNCHES = MK_N_LAUNCHES;

constexpr int BATCH = 8, SEQ = 2048, DMODEL = 1024, MTOK = BATCH * SEQ;
constexpr int INCOLS = 4096, SSMW = 512, NGRP = 32, CH = 32  , NCHUNK = SEQ / CH  , APK = 640  ;
constexpr int PQ = 2048, NEXP = 16384;
constexpr float RMS_EPS = 1e-6f;

constexpr size_t MiB = 1u << 20;
constexpr size_t WS_CTL = 0, CTL_ZERO_BYTES = 64 * 1024;
constexpr size_t WS_BIAS = 1 * MiB;
constexpr size_t WS_PW32 = 1 * MiB + 64 * 1024;
constexpr size_t WS_KPART = 1 * MiB + 128 * 1024;
constexpr size_t WS_KG = 2 * MiB;
constexpr size_t WS_SSQ1 = 3 * MiB;
constexpr size_t WS_WIN = 6 * MiB, WS_WQ = 14 * MiB, WS_WOUT = 18 * MiB, WS_WUS = 20 * MiB, WS_WUA = 21 * MiB, WS_WGLU = 22 * MiB, WS_KS = 22 * MiB + 512 * 1024;
constexpr size_t WS_WE = 23 * MiB;
constexpr size_t WS_BP = 32 * MiB;
constexpr size_t WS_AP = 52 * MiB;
constexpr size_t WS_E = 72 * MiB;
constexpr size_t WS_H = 80 * MiB;
constexpr size_t WS_YPRE = 80 * MiB, WS_YA = 96 * MiB, WS_XG = 80 * MiB;
constexpr size_t WS_Z = 96 * MiB, ZSTRIDE_B = 16 * MiB;
constexpr size_t WS_MRG = 128 * MiB;
constexpr size_t WS_PQ = 160 * MiB;
constexpr size_t WS_IDS = 224 * MiB, WS_GTS = 232 * MiB;
constexpr size_t WS_U16 = 32 * MiB, WS_V16 = 240 * MiB;
constexpr size_t WS_YB = 224 * MiB;
constexpr size_t WS_WPK = 128 * MiB, WS_RSTD1 = 4 * MiB, WS_Y16 = 160 * MiB;
constexpr size_t WS_END = 256 * MiB;
constexpr int CW_BAR = 1024;

constexpr int RING_OFF = 0, RING_BYTES = 131072;
constexpr int LDSCTL_OFF = RING_BYTES, MISC_OFF = LDSCTL_OFF + 320;
constexpr int LDS_BYTES = 147456;

#define GAS __attribute__((address_space(1)))
#define LAS __attribute__((address_space(3)))
typedef unsigned short bf16;
typedef unsigned v4u __attribute__((ext_vector_type(4)));
typedef float f32x4 __attribute__((ext_vector_type(4)));
typedef short bf16x8 __attribute__((ext_vector_type(8)));
typedef float f32x16 __attribute__((ext_vector_type(16)));
typedef __bf16 bf16x2_t __attribute__((ext_vector_type(2)));
typedef _Float16 h2_t __attribute__((ext_vector_type(2)));
typedef GAS unsigned gu32;
#define RLX_AGENT __ATOMIC_RELAXED, __HIP_MEMORY_SCOPE_AGENT
#define LDS_WAIT() asm volatile("s_waitcnt lgkmcnt(0)" ::: "memory")
#define VM_WAIT() asm volatile("s_waitcnt vmcnt(0)" ::: "memory")
__device__ __forceinline__ unsigned f2bf(float f) { unsigned u = __builtin_bit_cast(unsigned, f); return (u + 0x7fffu + ((u >> 16) & 1u)) >> 16; }
__device__ __forceinline__ unsigned pk2(float lo, float hi) { return f2bf(lo) | (f2bf(hi) << 16); }
using pg8::cvt_pk_bf16; using pg8::bf_lo; using pg8::bf_hi; using pg8::sigmoid_f; using pg8::gelu_tanh;

#define XB_TMO      128
#define XB_XCNT(j)  (256  + 64 * (j))
#define XB_XSUB(j)  (1280 + 64 * (j))
#define XB_XGEN(j)  (2304 + 64 * (j))
#define XB_TOP      3328
#define XB_TOPGEN   3392
#define XCD_BAR_WORDS 3456
#define XB_SPIN_CAP (1u << 18)
__device__ __forceinline__ unsigned xb_ld(unsigned* p)              { return __hip_atomic_load(p, __ATOMIC_RELAXED, __HIP_MEMORY_SCOPE_AGENT); }
__device__ __forceinline__ unsigned xb_add(unsigned* p, unsigned v) { return __hip_atomic_fetch_add(p, v, __ATOMIC_RELAXED, __HIP_MEMORY_SCOPE_AGENT); }
__device__ __forceinline__ unsigned xb_xcc_id() { return (unsigned)__builtin_amdgcn_s_getreg((3 << 11) | 20) & 0xFu; }
#define XB_SPIN(cond, bar) do { unsigned _sp = 0; while (cond) { __builtin_amdgcn_s_sleep(1); \
    if ((++_sp & 255u) == 0u) { if (xb_ld(&(bar)[XB_TMO])) break; if (_sp > XB_SPIN_CAP) { atomicAdd(&(bar)[XB_TMO], 1u); break; } } } } while (0)
struct XcdBarrier { unsigned* bar; unsigned x; volatile LAS unsigned* st; };
__device__ __forceinline__ XcdBarrier xcd_barrier_post(unsigned* bar, volatile LAS unsigned* st) {
    XcdBarrier b; b.bar = bar; b.x = xb_xcc_id(); b.st = st;
    if (threadIdx.x == 0) (void)xb_add(&bar[XB_XCNT(b.x)], 1u);
    return b;
}
__device__ __forceinline__ void xcd_barrier_complete(unsigned* bar, unsigned x, unsigned& nloc, unsigned& nx) {
    const unsigned G = gridDim.x * gridDim.y * gridDim.z;
    unsigned sum, cnt, mine, sp = 0u;
    for (;;) {
        sum = 0u; cnt = 0u; mine = 0u;
#pragma unroll
        for (unsigned j = 0; j < 16; ++j) { const unsigned c = xb_ld(&bar[XB_XCNT(j)]); sum += c; cnt += (c > 0u) ? 1u : 0u; mine = (j == x) ? c : mine; }
        if (sum == G) break;
        __builtin_amdgcn_s_sleep(1);
        if ((++sp & 255u) == 0u) { if (xb_ld(&bar[XB_TMO])) break; if (sp > XB_SPIN_CAP) { atomicAdd(&bar[XB_TMO], 1u); break; } }
    }
    nloc = mine > 0u ? mine : 1u; nx = cnt > 0u ? cnt : 1u;
}
__device__ __forceinline__ void xcd_barrier(const XcdBarrier& b) {
    asm volatile("s_waitcnt vmcnt(0)" ::: "memory");
    __syncthreads();
    if (threadIdx.x == 0) {
        unsigned* bar = b.bar;
        __builtin_amdgcn_s_waitcnt(0);
        unsigned nloc = b.st[0], nx = b.st[1];
        if (nloc == 0u) { xcd_barrier_complete(bar, b.x, nloc, nx); b.st[0] = nloc; b.st[1] = nx; }
        const unsigned old = xb_add(&bar[XB_XSUB(b.x)], 1u);
        const unsigned gen = old / nloc;
        if (old + 1u == (gen + 1u) * nloc) {
            __builtin_amdgcn_fence(__ATOMIC_RELEASE, "agent");
            asm volatile("s_waitcnt vmcnt(0)" ::: "memory");
            const unsigned og = xb_add(&bar[XB_TOP], 1u);
            const unsigned tg = og / nx;
            if (og + 1u == (tg + 1u) * nx) xb_add(&bar[XB_TOPGEN], 1u);
            else XB_SPIN(xb_ld(&bar[XB_TOPGEN]) == tg, bar);
            __builtin_amdgcn_fence(__ATOMIC_ACQUIRE, "agent");
            xb_add(&bar[XB_XGEN(b.x)], 1u);
            asm volatile("s_waitcnt vmcnt(0)" ::: "memory");
        } else {
            XB_SPIN(xb_ld(&bar[XB_XGEN(b.x)]) == gen, bar);
            __builtin_amdgcn_fence(__ATOMIC_ACQUIRE, "agent");
            asm volatile("s_waitcnt vmcnt(0)" ::: "memory");
        }
    }
    __syncthreads();
}

__device__ __forceinline__ float wave_sum(float v) {
#pragma unroll
    for (int o = 1; o < 64; o <<= 1) v += __shfl_xor(v, o);
    return v;
}

namespace pg8 {
struct EpiIn {
    static constexpr bool PERM = true;
    bf16_t* zbase; bf16_t* AP; float* kpart;
    __device__ __forceinline__ void operator()(const f32x4 (&acc)[2][2][4][2], const Unit& u, int wr, int wc, int fr, int fq) const {
        const int t = u.pn >> 1, colt = (u.pn & 1) * 256;
        const int row0 = u.pm * BM + wr * 64 + fr, col0 = colt + wc * 32 + 8 * fq;
        if (t == 0) {
#pragma unroll
            for (int ai = 0; ai < 2; ++ai)
#pragma unroll
                for (int m = 0; m < 4; ++m) { const int r = row0 + ai * HALF + m * 16, b = r >> 11, l = r & 2047;
#pragma unroll
                    for (int bj = 0; bj < 2; ++bj) { const int c = col0 + bj * HALF, g = c >> 4, hi0 = c & 15;
                        const f32x4 v0 = acc[ai][bj][m][0], v1 = acc[ai][bj][m][1];
                        u32x4 w; w.x = cvt_pk_bf16(v0[0], v0[1]); w.y = cvt_pk_bf16(v0[2], v0[3]); w.z = cvt_pk_bf16(v1[0], v1[1]); w.w = cvt_pk_bf16(v1[2], v1[3]);
                        *(u32x4*)(AP + (size_t)(g * 512 + b * 64 + (l >> 5)) * 640 + (l & 31) * 16 + hi0) = w; } }
        } else {
            bf16_t* base = zbase + (size_t)t * (16u * 1024u * 1024u / 2u);
            const float sc = (t == 1) ? 0.125f * 1.4426950408889634f : 1.0f;
#pragma unroll
            for (int ai = 0; ai < 2; ++ai)
#pragma unroll
                for (int m = 0; m < 4; ++m) { bf16_t* rowp = base + (size_t)(row0 + ai * HALF + m * 16) * 512 + col0;
#pragma unroll
                    for (int bj = 0; bj < 2; ++bj) { f32x4 v0 = acc[ai][bj][m][0], v1 = acc[ai][bj][m][1];
                        if (t >= 4) {
#pragma unroll
                            for (int e = 0; e < 4; ++e) { v0[e] = sigmoid_f(v0[e]); v1[e] = sigmoid_f(v1[e]); }
                        } else { v0 = v0 * sc; v1 = v1 * sc; }
                        u32x4 w; w.x = cvt_pk_bf16(v0[0], v0[1]); w.y = cvt_pk_bf16(v0[2], v0[3]); w.z = cvt_pk_bf16(v1[0], v1[1]); w.w = cvt_pk_bf16(v1[2], v1[3]);
                        *(u32x4*)(rowp + bj * HALF) = w; } }
            if (t == 2) {
#pragma unroll
                for (int bj = 0; bj < 2; ++bj)
#pragma unroll
                    for (int n = 0; n < 2; ++n) { f32x4 s = (f32x4){0.f, 0.f, 0.f, 0.f};
#pragma unroll
                        for (int ai = 0; ai < 2; ++ai)
#pragma unroll
                            for (int m = 0; m < 4; ++m) s += acc[ai][bj][m][n];
#pragma unroll
                        for (int e = 0; e < 4; ++e) { float x = s[e]; x += __shfl_xor(x, 1); x += __shfl_xor(x, 2); x += __shfl_xor(x, 4); x += __shfl_xor(x, 8); s[e] = x; }
                        if (fr == 0) *(f32x4*)(kpart + (size_t)(u.pm * 2 + wr) * 512 + col0 + bj * HALF + 4 * n) = s; }
            }
        }
    }
};
struct EpiE {
    static constexpr bool PERM = false;
    float* E;
    __device__ __forceinline__ void operator()(const f32x4 (&acc)[2][2][4][2], const Unit& u, int wr, int wc, int fr, int fq) const {
        const int row0 = u.pm * BM + wr * 64 + fr, col0 = wc * 32 + 4 * fq;
#pragma unroll
        for (int ai = 0; ai < 2; ++ai)
#pragma unroll
            for (int m = 0; m < 4; ++m) { float* rowp = E + (size_t)(row0 + ai * HALF + m * 16) * 128 + col0;
#pragma unroll
                for (int n = 0; n < 2; ++n) *(f32x4*)(rowp + n * 16) = acc[ai][0][m][n]; }
    }
};
struct EpiY {
    static constexpr bool PERM = true;
    bf16_t* Y;
    __device__ __forceinline__ void operator()(const f32x4 (&acc)[2][2][4][2], const Unit& u, int wr, int wc, int fr, int fq) const {
        const int row0 = u.pm * BM + wr * 64 + fr, col0 = u.pn * BM + wc * 32 + 8 * fq;
#pragma unroll
        for (int ai = 0; ai < 2; ++ai)
#pragma unroll
            for (int m = 0; m < 4; ++m) { const int r = row0 + ai * HALF + m * 16, g = r >> 9, b = (r >> 6) & 7, c = r & 63;
#pragma unroll
                for (int bj = 0; bj < 2; ++bj) { const int cc = col0 + bj * HALF, j = cc >> 4, ho0 = cc & 15;
                    f32x4 v0 = acc[ai][bj][m][0], v1 = acc[ai][bj][m][1];
#pragma unroll
                    for (int e = 0; e < 4; ++e) { v0[e] = gelu_tanh(v0[e]); v1[e] = gelu_tanh(v1[e]); }
                    u32x4 w; w.x = cvt_pk_bf16(v0[0], v0[1]); w.y = cvt_pk_bf16(v0[2], v0[3]); w.z = cvt_pk_bf16(v1[0], v1[1]); w.w = cvt_pk_bf16(v1[2], v1[3]);
                    *(u32x4*)(Y + (size_t)(b * 2048 + c * 32 + j) * 512 + g * 16 + ho0) = w; } }
    }
};
struct EpiGlu {
    static constexpr bool PERM = true;
    const bf16_t* Yp; bf16_t* Ya; const float* bias;
    __device__ __forceinline__ void operator()(const f32x4 (&acc)[2][2][4][2], const Unit& u, int wr, int wc, int fr, int fq) const {
        const int row0 = u.pm * BM + wr * 64 + fr, col0 = u.pn * BM + wc * 32 + 8 * fq;
        f32x4 bv[2][2];
#pragma unroll
        for (int bj = 0; bj < 2; ++bj)
#pragma unroll
            for (int n = 0; n < 2; ++n) bv[bj][n] = *(const f32x4*)(bias + col0 + bj * HALF + 4 * n);
#pragma unroll
        for (int ai = 0; ai < 2; ++ai)
#pragma unroll
            for (int m = 0; m < 4; ++m) { const size_t off = (size_t)(row0 + ai * HALF + m * 16) * 512 + col0;
#pragma unroll
                for (int bj = 0; bj < 2; ++bj) { const f32x4 z0 = acc[ai][bj][m][0] + bv[bj][0], z1 = acc[ai][bj][m][1] + bv[bj][1];
                    const u32x4 y = *(const u32x4*)(Yp + off + bj * HALF);
                    u32x4 w; w.x = cvt_pk_bf16(bf_lo(y.x) * sigmoid_f(z0[0]), bf_hi(y.x) * sigmoid_f(z0[1])); w.y = cvt_pk_bf16(bf_lo(y.y) * sigmoid_f(z0[2]), bf_hi(y.y) * sigmoid_f(z0[3]));
                    w.z = cvt_pk_bf16(bf_lo(y.z) * sigmoid_f(z1[0]), bf_hi(y.z) * sigmoid_f(z1[1])); w.w = cvt_pk_bf16(bf_lo(y.w) * sigmoid_f(z1[2]), bf_hi(y.w) * sigmoid_f(z1[3]));
                    *(u32x4*)(Ya + off + bj * HALF) = w; } }
    }
};
template <int ADD> struct EpiMrg {
    static constexpr bool PERM = true;
    const bf16_t* G0; bf16_t* Mrg;
    __device__ __forceinline__ void operator()(const f32x4 (&acc)[2][2][4][2], const Unit& u, int wr, int wc, int fr, int fq) const {
        const int row0 = u.pm * BM + wr * 64 + fr, cin = wc * 32 + 8 * fq;
        const bf16_t* gb = G0 + (size_t)(u.pn >> 1) * (16u * 1024u * 1024u / 2u) + (u.pn & 1) * 256 + cin;
#pragma unroll
        for (int ai = 0; ai < 2; ++ai)
#pragma unroll
            for (int m = 0; m < 4; ++m) { const int r = row0 + ai * HALF + m * 16;
#pragma unroll
                for (int bj = 0; bj < 2; ++bj) {
#if defined(ABL_NO_SSM) || defined(ABL_NO_ATT)
#if defined(ABL_NO_SSM)
                    constexpr bool kill = (ADD == 0);
#else
                    constexpr bool kill = (ADD == 1);
#endif
                    const f32x4 a0 = kill ? (f32x4){0.f, 0.f, 0.f, 0.f} : acc[ai][bj][m][0], a1 = kill ? (f32x4){0.f, 0.f, 0.f, 0.f} : acc[ai][bj][m][1];
#else
                    const f32x4 a0 = acc[ai][bj][m][0], a1 = acc[ai][bj][m][1];
#endif
                    const u32x4 gt = *(const u32x4*)(gb + (size_t)r * 512 + bj * HALF);
                    bf16_t* mp = Mrg + (size_t)r * 1024 + u.pn * BM + cin + bj * HALF;
                    float o[8] = { bf_lo(gt.x) * a0[0], bf_hi(gt.x) * a0[1], bf_lo(gt.y) * a0[2], bf_hi(gt.y) * a0[3], bf_lo(gt.z) * a1[0], bf_hi(gt.z) * a1[1], bf_lo(gt.w) * a1[2], bf_hi(gt.w) * a1[3] };
                    if (ADD) { const u32x4 p = *(const u32x4*)mp; o[0] += bf_lo(p.x); o[1] += bf_hi(p.x); o[2] += bf_lo(p.y); o[3] += bf_hi(p.y); o[4] += bf_lo(p.z); o[5] += bf_hi(p.z); o[6] += bf_lo(p.w); o[7] += bf_hi(p.w); }
                    u32x4 w; w.x = cvt_pk_bf16(o[0], o[1]); w.y = cvt_pk_bf16(o[2], o[3]); w.z = cvt_pk_bf16(o[4], o[5]); w.w = cvt_pk_bf16(o[6], o[7]);
                    *(u32x4*)mp = w; } }
    }
};
struct EpiMrgDual {
    static constexpr bool PERM = true;
    EpiMrg<0> a; EpiMrg<1> b;
    __device__ __forceinline__ void operator()(const f32x4 (&acc)[2][2][4][2], const Unit& u, int wr, int wc, int fr, int fq) const { if (u.w == 0) a(acc, u, wr, wc, fr, fq); else b(acc, u, wr, wc, fr, fq); }
};
struct EpiX1 {
    static constexpr bool PERM = true;
    const float* X; float* X1; bf16_t* XG; const float* g2; float* ssq;
    __device__ __forceinline__ void operator()(const f32x4 (&acc)[2][2][4][2], const Unit& u, int wr, int wc, int fr, int fq) const {
        const int row0 = u.pm * BM + wr * 64 + fr, col0 = u.pn * BM + wc * 32 + 8 * fq;
        f32x4 gv[2][2];
#pragma unroll
        for (int bj = 0; bj < 2; ++bj)
#pragma unroll
            for (int n = 0; n < 2; ++n) gv[bj][n] = *(const f32x4*)(g2 + col0 + bj * HALF + 4 * n);
#pragma unroll
        for (int ai = 0; ai < 2; ++ai)
#pragma unroll
            for (int m = 0; m < 4; ++m) { const int r = row0 + ai * HALF + m * 16; const size_t off = (size_t)r * 1024 + col0; float s = 0.f;
#pragma unroll
                for (int bj = 0; bj < 2; ++bj) {
                    #ifdef ABL_NO_MIX
                    const f32x4 x0 = *(const f32x4*)(X + off + bj * HALF), x1 = *(const f32x4*)(X + off + bj * HALF + 4);
#else
                    const f32x4 x0 = *(const f32x4*)(X + off + bj * HALF) + acc[ai][bj][m][0], x1 = *(const f32x4*)(X + off + bj * HALF + 4) + acc[ai][bj][m][1];
#endif
                    *(f32x4*)(X1 + off + bj * HALF) = x0; *(f32x4*)(X1 + off + bj * HALF + 4) = x1;
                    s += (x0[0] * x0[0] + x0[1] * x0[1]) + (x0[2] * x0[2] + x0[3] * x0[3]) + (x1[0] * x1[0] + x1[1] * x1[1]) + (x1[2] * x1[2] + x1[3] * x1[3]);
                    const f32x4 a = x0 * gv[bj][0], b = x1 * gv[bj][1];
                    u32x4 w; w.x = cvt_pk_bf16(a[0], a[1]); w.y = cvt_pk_bf16(a[2], a[3]); w.z = cvt_pk_bf16(b[0], b[1]); w.w = cvt_pk_bf16(b[2], b[3]);
                    *(u32x4*)(XG + off + bj * HALF) = w; }
                s += __shfl_xor(s, 16); s += __shfl_xor(s, 32);
                if (fq == 0) ssq[(size_t)r * 16 + u.pn * 4 + wc] = s; }
    }
};
struct EpiPlain {
    static constexpr bool PERM = true;
    bf16_t* O; int ldc;
    __device__ __forceinline__ void operator()(const f32x4 (&acc)[2][2][4][2], const Unit& u, int wr, int wc, int fr, int fq) const {
        const int row0 = u.pm * BM + wr * 64 + fr, col0 = u.pn * BM + wc * 32 + 8 * fq;
#pragma unroll
        for (int ai = 0; ai < 2; ++ai)
#pragma unroll
            for (int m = 0; m < 4; ++m) { bf16_t* rowp = O + (size_t)(row0 + ai * HALF + m * 16) * ldc + col0;
#pragma unroll
                for (int bj = 0; bj < 2; ++bj) { const f32x4 v0 = acc[ai][bj][m][0], v1 = acc[ai][bj][m][1];
                    u32x4 w; w.x = cvt_pk_bf16(v0[0], v0[1]); w.y = cvt_pk_bf16(v0[2], v0[3]); w.z = cvt_pk_bf16(v1[0], v1[1]); w.w = cvt_pk_bf16(v1[2], v1[3]);
                    *(u32x4*)(rowp + bj * HALF) = w; } }
    }
};
}
struct Frame {
    LAS unsigned char* lds;
    int tid, lane, wave, vcu, G;
};

__device__ __forceinline__ void p0_transpose_item(const float* W, int K, int N, bf16* WT, LAS float* scr, int item, int lane) {
    const int nblk = N / 32, kb = item / nblk, nb = item % nblk, k0 = 64 * kb, n0 = 32 * nb;
    float wv[32];
#pragma unroll
    for (int i = 0; i < 32; ++i) { const int kk = 2 * i + (lane >> 5); wv[i] = W[(size_t)(k0 + kk) * N + n0 + (lane & 31)]; }
#pragma unroll
    for (int i = 0; i < 32; ++i) { const int kk = 2 * i + (lane >> 5); scr[kk * 33 + (lane & 31)] = wv[i]; }
    LDS_WAIT(); asm volatile("" ::: "memory");
    const int c = lane & 7;
#pragma unroll
    for (int j = 0; j < 4; ++j) { const int n = (lane >> 3) + 8 * j; const LAS float* s = scr + (8 * c) * 33 + n;
        v4u o; o.x = pk2(s[0 * 33], s[1 * 33]); o.y = pk2(s[2 * 33], s[3 * 33]); o.z = pk2(s[4 * 33], s[5 * 33]); o.w = pk2(s[6 * 33], s[7 * 33]);
        *(GAS v4u*)(WT + (size_t)(n0 + n) * K + k0 + 8 * c) = o; }
    LDS_WAIT(); asm volatile("" ::: "memory");
}
__device__ __forceinline__ void rms_row_to_bf16(const float* xrow, const float* g, bf16* orow, int lane) {
    const GAS f32x4* xr = (const GAS f32x4*)xrow + lane; const GAS f32x4* gr = (const GAS f32x4*)g + lane;
    f32x4 v[4]; float s = 0.f;
#pragma unroll
    for (int j = 0; j < 4; ++j) { v[j] = xr[64 * j]; s += (v[j].x * v[j].x + v[j].y * v[j].y) + (v[j].z * v[j].z + v[j].w * v[j].w); }
    const float rstd = 1.0f / sqrtf(wave_sum(s) * (1.f / DMODEL) + RMS_EPS);
    GAS unsigned long long* o8 = (GAS unsigned long long*)orow + lane;
#pragma unroll
    for (int j = 0; j < 4; ++j) { const f32x4 gg = gr[64 * j];
        o8[64 * j] = (unsigned long long)pk2(v[j].x * rstd * gg.x, v[j].y * rstd * gg.y) | ((unsigned long long)pk2(v[j].z * rstd * gg.z, v[j].w * rstd * gg.w) << 32); }
}
__device__ __forceinline__ void rms_rows4_to_bf16(const float* x, const float* g, bf16* out, int m, int stride, int lane) {
    f32x4 v[4][4];
#pragma unroll
    for (int k = 0; k < 4; ++k) { const int mm = (m + k * stride < MTOK) ? m + k * stride : m; const GAS f32x4* xr = (const GAS f32x4*)(x + (size_t)mm * DMODEL) + lane;
#pragma unroll
        for (int j = 0; j < 4; ++j) v[k][j] = xr[64 * j]; }
    const GAS f32x4* gr = (const GAS f32x4*)g + lane; f32x4 gg[4];
#pragma unroll
    for (int j = 0; j < 4; ++j) gg[j] = gr[64 * j];
#pragma unroll
    for (int k = 0; k < 4; ++k) { if (m + k * stride >= MTOK) break; float s = 0.f;
#pragma unroll
        for (int j = 0; j < 4; ++j) s += (v[k][j].x * v[k][j].x + v[k][j].y * v[k][j].y) + (v[k][j].z * v[k][j].z + v[k][j].w * v[k][j].w);
        const float rstd = 1.0f / sqrtf(wave_sum(s) * (1.f / DMODEL) + RMS_EPS);
        GAS unsigned long long* o8 = (GAS unsigned long long*)(out + (size_t)(m + k * stride) * DMODEL) + lane;
#pragma unroll
        for (int j = 0; j < 4; ++j) o8[64 * j] = (unsigned long long)pk2(v[k][j].x * rstd * gg[j].x, v[k][j].y * rstd * gg[j].y) | ((unsigned long long)pk2(v[k][j].z * rstd * gg[j].z, v[k][j].w * rstd * gg[j].w) << 32); }
}
struct cpx { float r, i; };
__device__ __forceinline__ cpx cmul(cpx a, cpx b) { return cpx{a.r * b.r - a.i * b.i, a.r * b.i + a.i * b.r}; }
__device__ __forceinline__ cpx cpow_(float ar, float ai, float dt, int n) { const float e = expf(ar * dt * (float)n); const float ang = ai * dt * (float)n; return cpx{e * cosf(ang), e * sinf(ang)}; }
__device__ __forceinline__ void ssm_table_task(int g, int j, int lane, LAS float* scr, const float* a_re, const float* a_im, const float* log_dt, const float* b_re, const float* b_im,
                                               const float* c_re, const float* c_im, float* Kg, bf16* WE, bf16* BP, float* pw32) {
    const int p = lane;
    const float dt = expf(log_dt[g]), ar = a_re[g * 64 + p], ai = a_im[g * 64 + p];
#define pw(n) cpow_(ar, ai, dt, (n))
    const cpx lb = pw(1);
    const float den = ar * ar + ai * ai;
    const cpx coef = cpx{((lb.r - 1.f) * ar + lb.i * ai) / den, (lb.i * ar - (lb.r - 1.f) * ai) / den};
    const cpx pj = pw(j), pe = pw(31 - j), pv = pw(j + 1);
    unsigned wer[8], wei[8];
#pragma unroll
    for (int h2 = 0; h2 < 8; ++h2) { float er[2], ei[2];
#pragma unroll
        for (int q = 0; q < 2; ++q) { const int hi = 2 * h2 + q;
            const cpx bb = cmul(coef, cpx{b_re[(g * 64 + p) * 16 + hi], b_im[(g * 64 + p) * 16 + hi]});
            const cpx w = cmul(pj, bb); scr[(p * 16 + hi) * 2] = w.r; scr[(p * 16 + hi) * 2 + 1] = w.i;
            const cpx e = cmul(pe, bb); er[q] = e.r; ei[q] = e.i; }
        wer[h2] = pk2(er[0], er[1]); wei[h2] = pk2(ei[0], ei[1]); }
    { bf16* w0 = WE + ((size_t)(g * 256 + p) * 512 + j * 16); bf16* w1 = WE + ((size_t)(g * 256 + 64 + p) * 512 + j * 16);
      *(GAS v4u*)w0 = (v4u){wer[0], wer[1], wer[2], wer[3]}; *(GAS v4u*)(w0 + 8) = (v4u){wer[4], wer[5], wer[6], wer[7]};
      *(GAS v4u*)w1 = (v4u){wei[0], wei[1], wei[2], wei[3]}; *(GAS v4u*)(w1 + 8) = (v4u){wei[4], wei[5], wei[6], wei[7]};
      bf16* z0 = WE + ((size_t)(g * 256 + 128 + p) * 512 + j * 16); bf16* z1 = WE + ((size_t)(g * 256 + 192 + p) * 512 + j * 16); const v4u z = (v4u){0u, 0u, 0u, 0u};
      *(GAS v4u*)z0 = z; *(GAS v4u*)(z0 + 8) = z; *(GAS v4u*)z1 = z; *(GAS v4u*)(z1 + 8) = z; }
#pragma unroll 4
    for (int ho = 0; ho < 16; ++ho) { const cpx cv = cmul(cpx{c_re[(g * 16 + ho) * 64 + p], c_im[(g * 16 + ho) * 64 + p]}, pv);
        bf16* row = BP + ((size_t)(g * 512 + j * 16 + ho) * APK + 512);
        row[p] = (bf16)f2bf(cv.r); row[64 + p] = (bf16)f2bf(-cv.i); }
    if (j == 0) { const cpx p32 = pw(32); pw32[g * 128 + p] = p32.r; pw32[g * 128 + 64 + p] = p32.i; }
    LDS_WAIT(); asm volatile("" ::: "memory");
    { const int ho = lane >> 2, h4 = (lane & 3) * 4; float a0 = 0.f, a1 = 0.f, a2 = 0.f, a3 = 0.f;
      const float* cr = c_re + (g * 16 + ho) * 64; const float* ci = c_im + (g * 16 + ho) * 64;
#pragma unroll 4
      for (int pp = 0; pp < 64; ++pp) { const float r_ = cr[pp], i_ = ci[pp]; const LAS float* w = scr + (pp * 16 + h4) * 2;
          a0 += r_ * w[0] - i_ * w[1]; a1 += r_ * w[2] - i_ * w[3]; a2 += r_ * w[4] - i_ * w[5]; a3 += r_ * w[6] - i_ * w[7]; }
      *(GAS f32x4*)(Kg + ((size_t)(g * 32 + j) * 256 + ho * 16 + h4)) = (f32x4){a0, a1, a2, a3}; }
    LDS_WAIT(); asm volatile("" ::: "memory");
#undef pw
}

__device__ __forceinline__ float vmaxf(float a, float b) { float r; asm("v_max_f32_e32 %0, %1, %2" : "=v"(r) : "v"(a), "v"(b)); return r; }
__device__ __forceinline__ float vminf(float a, float b) { float r; asm("v_min_f32_e32 %0, %1, %2" : "=v"(r) : "v"(a), "v"(b)); return r; }
__device__ __forceinline__ float selhi(float lo, float hi) { float r; asm("v_cndmask_b32_e64 %0, %1, %2, %3" : "=v"(r) : "v"(lo), "v"(hi), "s"(0xFFFFFFFF00000000ull)); return r; }
#define CE_DESC(a, b) do { const float hi_ = vmaxf(a, b), lo_ = vminf(a, b); a = hi_; b = lo_; } while (0)
__device__ __forceinline__ void sort16_desc(float (&v)[16]) {
#pragma unroll
    for (int k = 2; k <= 16; k <<= 1)
#pragma unroll
        for (int j = k >> 1; j > 0; j >>= 1)
#pragma unroll
            for (int i = 0; i < 16; ++i) { const int l = i ^ j; if (l > i) { if ((i & k) == 0) CE_DESC(v[i], v[l]); else CE_DESC(v[l], v[i]); } }
}
__device__ __forceinline__ void bitonic_merge16_desc(float (&v)[16]) {
#pragma unroll
    for (int j = 8; j > 0; j >>= 1)
#pragma unroll
        for (int i = 0; i < 16; ++i) { const int l = i ^ j; if (l > i) CE_DESC(v[i], v[l]); }
}
__device__ __forceinline__ void merge_top16(float (&a)[16], const float (&b)[16]) {
#pragma unroll
    for (int i = 0; i < 16; ++i) a[i] = vmaxf(a[i], b[15 - i]);
    bitonic_merge16_desc(a);
}
__device__ __forceinline__ void merge_partner_top16(float (&a)[16]) {
    float p[16];
#pragma unroll
    for (int i = 0; i < 16; ++i) { const unsigned x = __float_as_uint(a[15 - i]); auto rr = __builtin_amdgcn_permlane32_swap(x, x, false, false); p[i] = selhi(__uint_as_float(rr[1]), __uint_as_float(rr[0])); }
#pragma unroll
    for (int i = 0; i < 16; ++i) a[i] = vmaxf(a[i], p[i]);
    bitonic_merge16_desc(a);
}
__device__ __forceinline__ void topk_half(int half, const bf16x8 (&qf)[8], int r32, int hi, const LAS unsigned char* ksl, float (&top)[16]) {
#pragma unroll 1
    for (int kt = 0; kt < 4; ++kt) {
        f32x16 acc = f32x16{};
        const int row = half * 128 + kt * 32 + r32; const LAS unsigned char* rp = ksl + row * 256; const int sw = row & 15;
#pragma unroll
        for (int ks = 0; ks < 8; ++ks) { const bf16x8 a = *(const LAS bf16x8*)(rp + (((2 * ks + hi) ^ sw) << 4));
            acc = __builtin_amdgcn_mfma_f32_32x32x16_bf16(a, qf[ks], acc, 0, 0, 0); }
        float grp[16];
#pragma unroll
        for (int r = 0; r < 16; ++r) { const unsigned key = (unsigned)(kt * 32 + (r & 3) + 8 * (r >> 2)) + 4u * (unsigned)hi; grp[r] = __uint_as_float((__float_as_uint(acc[r]) & ~127u) | key); }
        sort16_desc(grp);
        if (kt == 0) {
#pragma unroll
            for (int i = 0; i < 16; ++i) top[i] = grp[i];
        } else merge_top16(top, grp);
    }
    merge_partner_top16(top);
}
__device__ __forceinline__ void topk_task(int tt, int hd, int lane, LAS unsigned char* scr, const bf16* PQb, const LAS unsigned char* ksl, const float* ssq1, int* ids, float* gts, float* rstd1) {
    const int r32 = lane & 31, hi = lane >> 5; const bool hib = hi != 0;
    const int token = tt * 32 + r32;
    float v0_[16], v1_[16];
    bf16x8 qf0[8], qf1[8];
#pragma unroll
    for (int ks = 0; ks < 8; ++ks) { qf0[ks] = *(const GAS bf16x8*)(PQb + (size_t)token * PQ + hd * 256 + ks * 16 + hi * 8); qf1[ks] = *(const GAS bf16x8*)(PQb + (size_t)token * PQ + hd * 256 + 128 + ks * 16 + hi * 8); }
    topk_half(0, qf0, r32, hi, ksl, v0_);
    topk_half(1, qf1, r32, hi, ksl, v1_);
#define v_SEL(h, i) ((h) ? v1_[i] : v0_[i])
    LAS unsigned char* slot = scr + lane * 32;
    { v4u d0, d1;
#define PK4(h, k) ((__float_as_uint(v_SEL(h, 4 * (k))) & 127u) | ((__float_as_uint(v_SEL(h, 4 * (k) + 1)) & 127u) << 8) | ((__float_as_uint(v_SEL(h, 4 * (k) + 2)) & 127u) << 16) | ((__float_as_uint(v_SEL(h, 4 * (k) + 3)) & 127u) << 24))
      d0 = (v4u){PK4(0, 0), PK4(0, 1), PK4(0, 2), PK4(0, 3)}; d1 = (v4u){PK4(1, 0), PK4(1, 1), PK4(1, 2), PK4(1, 3)};
#undef PK4
      *(LAS v4u*)slot = d0; *(LAS v4u*)(slot + 16) = d1; }
    float a[16], b[16];
#pragma unroll
    for (int i = 0; i < 16; ++i) { a[i] = selhi(v0_[i], v1_[i]); b[i] = selhi(v1_[i], v0_[i]); }
    const unsigned obit = (unsigned)hi << 8;
#define CAND(i, j) __uint_as_float((__float_as_uint(a[i] + b[j]) & ~511u) | obit | (unsigned)(((i) << 4) | (j)))
    const float NEGBIG = -3.0e38f;
    float g0[16], g1[16];
#pragma unroll
    for (int j = 1; j < 16; ++j) g0[j - 1] = CAND(0, j);
    g0[15] = CAND(1, 2);
    g1[0] = CAND(1, 3); g1[1] = CAND(1, 4); g1[2] = CAND(1, 5); g1[3] = CAND(1, 6); g1[4] = CAND(1, 7); g1[5] = CAND(2, 3); g1[6] = CAND(2, 4);
    { const float c0 = CAND(0, 0), c1 = CAND(1, 1), c2 = CAND(2, 2), c3 = CAND(3, 3);
      g1[7] = selhi(c0, NEGBIG); g1[8] = selhi(c1, NEGBIG); g1[9] = selhi(c2, NEGBIG); g1[10] = selhi(c3, NEGBIG); }
#pragma unroll
    for (int i = 11; i < 16; ++i) g1[i] = NEGBIG;
#undef CAND
    sort16_desc(g0); sort16_desc(g1); merge_top16(g0, g1); merge_partner_top16(g0);
    float rstd;
    { const GAS f32x4* sp = (const GAS f32x4*)(ssq1 + (size_t)token * 16); const f32x4 s0 = sp[0], s1 = sp[1], s2 = sp[2], s3 = sp[3];
      const float ss = ((s0.x + s0.y) + (s0.z + s0.w)) + ((s1.x + s1.y) + (s1.z + s1.w)) + ((s2.x + s2.y) + (s2.z + s2.w)) + ((s3.x + s3.y) + (s3.z + s3.w));
      rstd = 1.0f / sqrtf(ss * (1.f / DMODEL) + RMS_EPS); }
    if (hd == 0 && !hib) rstd1[token] = rstd;
    float ex[16], esum = 0.f; const float sc = rstd * 1.4426950409f;
#pragma unroll
    for (int k = 0; k < 16; ++k) { ex[k] = __builtin_amdgcn_exp2f((g0[k] - g0[0]) * sc); esum += ex[k]; }
    const float inv = 1.0f / esum;
    int eid[8]; float gv[8];
#pragma unroll
    for (int k = 0; k < 8; ++k) { const float wv = selhi(g0[k], g0[8 + k]); const float ev = selhi(ex[k], ex[8 + k]);
        const unsigned tag = __float_as_uint(wv) & 511u, o = tag >> 8, i = (tag >> 4) & 15u, j = tag & 15u; const unsigned i1 = o ? j : i, i2 = o ? i : j;
        const unsigned k1 = slot[i1], k2 = slot[16 + i2];
        eid[k] = (int)(k1 * 128u + k2); gv[k] = ev * inv; }
    { int* ip = ids + (size_t)token * 128 + hd * 16 + 8 * hi; float* gp = gts + (size_t)token * 128 + hd * 16 + 8 * hi;
      *(GAS v4u*)ip = (v4u){(unsigned)eid[0], (unsigned)eid[1], (unsigned)eid[2], (unsigned)eid[3]}; *(GAS v4u*)(ip + 4) = (v4u){(unsigned)eid[4], (unsigned)eid[5], (unsigned)eid[6], (unsigned)eid[7]};
      *(GAS f32x4*)gp = (f32x4){gv[0], gv[1], gv[2], gv[3]}; *(GAS f32x4*)(gp + 4) = (f32x4){gv[4], gv[5], gv[6], gv[7]}; }
    LDS_WAIT(); asm volatile("" ::: "memory");
}


__device__ __forceinline__ float dot2bf(unsigned a, unsigned b, float c) { return __builtin_amdgcn_fdot2_f32_bf16(__builtin_bit_cast(bf16x2_t, a), __builtin_bit_cast(bf16x2_t, b), c, false); }
__device__ __forceinline__ h2_t fma_h2(unsigned v, h2_t w, h2_t acc) { return __builtin_elementwise_fma(__builtin_bit_cast(h2_t, v), w, acc); }
__device__ __forceinline__ unsigned fp8lo_bf(unsigned w, float sc) { return __builtin_bit_cast(unsigned, __builtin_amdgcn_cvt_scalef32_pk_bf16_fp8((int)w, sc, false)); }
__device__ __forceinline__ unsigned fp8hi_bf(unsigned w, float sc) { return __builtin_bit_cast(unsigned, __builtin_amdgcn_cvt_scalef32_pk_bf16_fp8((int)w, sc, true)); }
__device__ __forceinline__ h2_t fp8lo_h(unsigned w, float sc) { return __builtin_amdgcn_cvt_scalef32_pk_f16_fp8((int)w, sc, false); }
__device__ __forceinline__ h2_t fp8hi_h(unsigned w, float sc) { return __builtin_amdgcn_cvt_scalef32_pk_f16_fp8((int)w, sc, true); }
__device__ __forceinline__ unsigned pack_fp8x4(float a, float b, float c, float d) { int w = __builtin_amdgcn_cvt_pk_fp8_f32(a, b, 0, false); w = __builtin_amdgcn_cvt_pk_fp8_f32(c, d, w, true); return (unsigned)w; }
constexpr float U8_SCALE = 32.0f, V8_SCALE = 4.0f;
constexpr int PA_CAP = 464;
struct StepA { v4u R[8]; unsigned ent; float g, rs; bool valid; };
__device__ __forceinline__ int pa_tok(unsigned tl, int tb, int nwg) { return ((tl < 4u) ? tb : nwg) + (int)(tl & 3u); }
__device__ __forceinline__ void pa_issue(StepA& S, int s, int n, int lane, const LAS unsigned* list, const unsigned char* U8, const float* gts, const float* rstd1, int tb, int nwg) {
    const int idx = s * 8 + (lane >> 3); S.valid = idx < n; S.ent = list[S.valid ? idx : 0];
    const unsigned ex = S.ent & 0x3fffu, slot = (S.ent >> 14) & 127u, tl = S.ent >> 21;
    const unsigned char* p = U8 + (size_t)ex * 1024 + (lane & 7) * 16;
#pragma unroll
    for (int i = 0; i < 8; ++i) S.R[i] = *(const GAS v4u*)(p + i * 128);
    const int t = pa_tok(tl, tb, nwg); S.g = gts[(size_t)t * 128 + slot]; S.rs = rstd1[t];
}
__device__ __forceinline__ void pa_compute(const StepA& S, int lane, const LAS unsigned char* xl, unsigned* wpk, int tb, int nwg) {
    const unsigned ex = S.ent & 0x3fffu, slot = (S.ent >> 14) & 127u, tl = S.ent >> 21;
    const LAS unsigned char* xp = xl + tl * 2048 + (lane & 7) * 32;
    float a0 = 0.f, a1 = 0.f; const float sc = 1.0f / U8_SCALE;
#pragma unroll
    for (int i = 0; i < 8; ++i) { const v4u x0 = *(const LAS v4u*)(xp + i * 256), x1 = *(const LAS v4u*)(xp + i * 256 + 16); const v4u u = S.R[i];
        const unsigned ux = u.x, uy = u.y, uz = u.z, uw = u.w;
        a0 = dot2bf(fp8lo_bf(ux, sc), x0.x, a0); a1 = dot2bf(fp8hi_bf(ux, sc), x0.y, a1); a0 = dot2bf(fp8lo_bf(uy, sc), x0.z, a0); a1 = dot2bf(fp8hi_bf(uy, sc), x0.w, a1);
        a0 = dot2bf(fp8lo_bf(uz, sc), x1.x, a0); a1 = dot2bf(fp8hi_bf(uz, sc), x1.y, a1); a0 = dot2bf(fp8lo_bf(uw, sc), x1.z, a0); a1 = dot2bf(fp8hi_bf(uw, sc), x1.w, a1); }
    float d = a0 + a1;
    d += __builtin_bit_cast(float, __builtin_amdgcn_update_dpp(0, __builtin_bit_cast(int, d), 0xB1, 0xF, 0xF, true));
    d += __builtin_bit_cast(float, __builtin_amdgcn_update_dpp(0, __builtin_bit_cast(int, d), 0x4E, 0xF, 0xF, true));
    d += __builtin_bit_cast(float, __builtin_amdgcn_update_dpp(0, __builtin_bit_cast(int, d), 0x141, 0xF, 0xF, true));
    if ((lane & 7) == 0 && S.valid) { const int t = pa_tok(tl, tb, nwg); const _Float16 wh = (_Float16)(S.g * gelu_tanh(d * S.rs));
        wpk[(size_t)t * 128 + slot] = ((unsigned)__builtin_bit_cast(unsigned short, wh) << 16) | ex; }
}
__device__ __forceinline__ void pa_flush(int n, int lane, const LAS unsigned* list, const LAS unsigned char* xl, const unsigned char* U16, const float* gts, const float* rstd1, unsigned* wpk, int tb, int nwg) {
    if (n == 0) return;
    LDS_WAIT(); asm volatile("" ::: "memory");
    const int steps = (n + 7) >> 3;
    StepA A, B, C, D;
    for (int s = 0; s < steps; s += 4) {
        pa_issue(A, s, n, lane, list, U16, gts, rstd1, tb, nwg);
        if (s + 1 < steps) pa_issue(B, s + 1, n, lane, list, U16, gts, rstd1, tb, nwg);
        if (s + 2 < steps) pa_issue(C, s + 2, n, lane, list, U16, gts, rstd1, tb, nwg);
        if (s + 3 < steps) pa_issue(D, s + 3, n, lane, list, U16, gts, rstd1, tb, nwg);
        pa_compute(A, lane, xl, wpk, tb, nwg);
        if (s + 1 < steps) pa_compute(B, lane, xl, wpk, tb, nwg);
        if (s + 2 < steps) pa_compute(C, lane, xl, wpk, tb, nwg);
        if (s + 3 < steps) pa_compute(D, lane, xl, wpk, tb, nwg);
    }
    LDS_WAIT(); asm volatile("" ::: "memory");
}
__device__ __forceinline__ void peer_a_phase(int lane, int wave, int G, int vcu, const bf16* XG, const unsigned char* U16, const int* ids, const float* gts, const float* rstd1, unsigned* wpk, LAS unsigned char* lds, int emask) {
    (void)emask;
    LAS unsigned char* xl = lds + RING_OFF + wave * 16384;
    LAS unsigned* list = (LAS unsigned*)(lds + MISC_OFF + 128 + wave * (PA_CAP * 4));
    for (int tile0 = vcu; tile0 < MTOK / 32; tile0 += 2 * G) {
        const int tile1 = tile0 + G; const bool has1 = tile1 < MTOK / 32;
        const int tb = tile0 * 32 + wave * 4, nwg = (has1 ? tile1 : tile0) * 32 + wave * 4;
        int id0[8], id1[8];
#pragma unroll
        for (int k = 0; k < 8; ++k) { const bool ok = (k < 4) || has1; const int tc = pa_tok((unsigned)k, tb, nwg);
            const v4u xa = *(const GAS v4u*)(XG + (size_t)tc * 1024 + 8 * lane), xb = *(const GAS v4u*)(XG + (size_t)tc * 1024 + 512 + 8 * lane);
            *(LAS v4u*)(xl + k * 2048 + lane * 16) = xa; *(LAS v4u*)(xl + k * 2048 + 1024 + lane * 16) = xb;
            id0[k] = ok ? ids[(size_t)tc * 128 + lane] : -1; id1[k] = ok ? ids[(size_t)tc * 128 + 64 + lane] : -1; }
        for (int part = 0; part < 8; ++part) {
            int n = 0;
#pragma unroll
            for (int k = 0; k < 8; ++k) {
                { const bool sel = (id0[k] >> 11) == part; const unsigned long long m = __ballot(sel);
                  const int pos = n + (int)__builtin_amdgcn_mbcnt_hi((unsigned)(m >> 32), __builtin_amdgcn_mbcnt_lo((unsigned)m, 0u));
                  if (sel) list[pos] = ((unsigned)k << 21) | ((unsigned)lane << 14) | (unsigned)id0[k]; n += __builtin_popcountll(m); }
                { const bool sel = (id1[k] >> 11) == part; const unsigned long long m = __ballot(sel);
                  const int pos = n + (int)__builtin_amdgcn_mbcnt_hi((unsigned)(m >> 32), __builtin_amdgcn_mbcnt_lo((unsigned)m, 0u));
                  if (sel) list[pos] = ((unsigned)k << 21) | ((unsigned)(64 + lane) << 14) | (unsigned)id1[k]; n += __builtin_popcountll(m); }
                if (n > PA_CAP - 128) { pa_flush(n, lane, list, xl, U16, gts, rstd1, wpk, tb, nwg); n = 0; }
            }
            pa_flush(n, lane, list, xl, U16, gts, rstd1, wpk, tb, nwg);
        }
    }
}
__device__ __forceinline__ void final_token(int t, int lane, const unsigned short* Y16, float* X1, const float* fg) {
    GAS f32x4* xp = (GAS f32x4*)(X1 + (size_t)t * 1024 + 8 * lane);
    f32x4 x0 = xp[0], x1 = xp[1], x2 = xp[128], x3 = xp[129];
    const v4u ya = *(const GAS v4u*)(Y16 + (size_t)t * 1024 + 8 * lane), yb = *(const GAS v4u*)(Y16 + (size_t)t * 1024 + 512 + 8 * lane);
    const unsigned yw[8] = {ya.x, ya.y, ya.z, ya.w, yb.x, yb.y, yb.z, yb.w};
    float y[16];
#pragma unroll
    for (int i = 0; i < 8; ++i) { const unsigned w = yw[i]; const h2_t h = __builtin_bit_cast(h2_t, w); y[2 * i] = (float)h[0]; y[2 * i + 1] = (float)h[1]; }
    x0 += (f32x4){y[0], y[1], y[2], y[3]}; x1 += (f32x4){y[4], y[5], y[6], y[7]}; x2 += (f32x4){y[8], y[9], y[10], y[11]}; x3 += (f32x4){y[12], y[13], y[14], y[15]};
    float ss = (x0.x * x0.x + x0.y * x0.y) + (x0.z * x0.z + x0.w * x0.w) + (x1.x * x1.x + x1.y * x1.y) + (x1.z * x1.z + x1.w * x1.w)
             + (x2.x * x2.x + x2.y * x2.y) + (x2.z * x2.z + x2.w * x2.w) + (x3.x * x3.x + x3.y * x3.y) + (x3.z * x3.z + x3.w * x3.w);
    const float rstd2 = 1.0f / sqrtf(wave_sum(ss) * (1.f / DMODEL) + RMS_EPS);
    const GAS f32x4* gp = (const GAS f32x4*)(fg + 8 * lane);
    xp[0] = x0 * rstd2 * gp[0]; xp[1] = x1 * rstd2 * gp[1]; xp[128] = x2 * rstd2 * gp[128]; xp[129] = x3 * rstd2 * gp[129];
}
#ifndef REP_0
#define REP_0 1
#endif
#ifndef REP_1
#define REP_1 1
#endif
#ifndef REP_2
#define REP_2 1
#endif
#ifndef REP_3
#define REP_3 1
#endif
#ifndef REP_4
#define REP_4 1
#endif
#ifndef REP_5
#define REP_5 1
#endif
#ifndef REP_6
#define REP_6 1
#endif
#ifndef REP_7
#define REP_7 1
#endif
#ifndef REP_8
#define REP_8 1
#endif
#ifndef REP_9
#define REP_9 1
#endif
#ifndef REP_10
#define REP_10 1
#endif
#ifndef REP_11
#define REP_11 1
#endif
struct PkB { v4u p[4]; };
__device__ __forceinline__ PkB peer_b_load(int t, int lane, const unsigned* wpk) { PkB k;
#pragma unroll
    for (int q = 0; q < 4; ++q) k.p[q] = *(const GAS v4u*)(wpk + (size_t)t * 128 + (lane >> 3) * 16 + q * 4);
    return k; }
__device__ __forceinline__ void peer_b_rows(v4u (&v)[16], const PkB& k, const unsigned char* vbase) {
#pragma unroll
    for (int q = 0; q < 4; ++q) { const unsigned pw[4] = {k.p[q].x, k.p[q].y, k.p[q].z, k.p[q].w};
#pragma unroll
        for (int r = 0; r < 4; ++r) v[q * 4 + r] = *(const GAS v4u*)(vbase + (size_t)(pw[r] & 0xffffu) * 128); }
}
__device__ __forceinline__ void peer_b_sum(const v4u (&v)[16], const PkB& k, int lane, unsigned short* yout) {
    h2_t acc[8]; const float sc = 1.0f / V8_SCALE;
#pragma unroll
    for (int i = 0; i < 8; ++i) acc[i] = (h2_t){(_Float16)0.f, (_Float16)0.f};
#pragma unroll
    for (int q = 0; q < 4; ++q) { const unsigned pw[4] = {k.p[q].x, k.p[q].y, k.p[q].z, k.p[q].w};
#pragma unroll
        for (int r = 0; r < 4; ++r) { const unsigned p = pw[r], wb = (p & 0xffff0000u) | (p >> 16); const h2_t w2 = __builtin_bit_cast(h2_t, wb); const v4u x = v[q * 4 + r];
            const unsigned xx = x.x, xy = x.y, xz = x.z, xw = x.w;
            acc[0] = __builtin_elementwise_fma(fp8lo_h(xx, sc), w2, acc[0]); acc[1] = __builtin_elementwise_fma(fp8hi_h(xx, sc), w2, acc[1]);
            acc[2] = __builtin_elementwise_fma(fp8lo_h(xy, sc), w2, acc[2]); acc[3] = __builtin_elementwise_fma(fp8hi_h(xy, sc), w2, acc[3]);
            acc[4] = __builtin_elementwise_fma(fp8lo_h(xz, sc), w2, acc[4]); acc[5] = __builtin_elementwise_fma(fp8hi_h(xz, sc), w2, acc[5]);
            acc[6] = __builtin_elementwise_fma(fp8lo_h(xw, sc), w2, acc[6]); acc[7] = __builtin_elementwise_fma(fp8hi_h(xw, sc), w2, acc[7]); } }
#pragma unroll
    for (int o = 8; o < 64; o <<= 1)
#pragma unroll
        for (int i = 0; i < 8; ++i) { const unsigned u = __builtin_bit_cast(unsigned, acc[i]); const unsigned ou = (unsigned)__shfl_xor((int)u, o); acc[i] = acc[i] + __builtin_bit_cast(h2_t, ou); }
    if (lane < 8) { *(GAS v4u*)yout = (v4u){__builtin_bit_cast(unsigned, acc[0]), __builtin_bit_cast(unsigned, acc[1]), __builtin_bit_cast(unsigned, acc[2]), __builtin_bit_cast(unsigned, acc[3])};
                    *(GAS v4u*)(yout + 8) = (v4u){__builtin_bit_cast(unsigned, acc[4]), __builtin_bit_cast(unsigned, acc[5]), __builtin_bit_cast(unsigned, acc[6]), __builtin_bit_cast(unsigned, acc[7])}; }
}
__device__ __forceinline__ void peer_b_phase(int lane, int wave, int G, int vcu, const unsigned char* V8s, const unsigned* wpk, unsigned short* Y16, float* X1, const float* fg) {
    const int c16 = (lane & 7) * 16;
    for (int tile0 = vcu; tile0 < MTOK / 32; tile0 += 2 * G) {
        const int tile1 = tile0 + G; const bool has1 = tile1 < MTOK / 32;
        const int tb = tile0 * 32 + wave * 4, nwg = (has1 ? tile1 : tile0) * 32 + wave * 4;
        const int nst = has1 ? 4 : 2;
        for (int sl = 0; sl < 8; ++sl) {
            const unsigned char* vbase = V8s + (size_t)sl * NEXP * 128 + c16;
            PkB kA = peer_b_load(pa_tok(0u, tb, nwg), lane, wpk), kB = peer_b_load(pa_tok(1u, tb, nwg), lane, wpk);
            for (int st = 0; st < nst; ++st) {
                const int tA = pa_tok((unsigned)(2 * st), tb, nwg), tB = pa_tok((unsigned)(2 * st + 1), tb, nwg);
                const unsigned kn = (st + 1 < nst) ? (unsigned)(2 * st + 2) : (unsigned)(2 * st);
                const PkB nA = peer_b_load(pa_tok(kn, tb, nwg), lane, wpk), nB = peer_b_load(pa_tok(kn + 1u, tb, nwg), lane, wpk);
                v4u vA[16], vB[16];
                peer_b_rows(vA, kA, vbase); peer_b_rows(vB, kB, vbase);
                peer_b_sum(vA, kA, lane, Y16 + (size_t)tA * 1024 + sl * 128 + c16);
                peer_b_sum(vB, kB, lane, Y16 + (size_t)tB * 1024 + sl * 128 + c16);
                kA = nA; kB = nB;
            }
        }
        asm volatile("s_waitcnt vmcnt(0)" ::: "memory");
        for (int k = 0; k < 2 * nst; ++k) final_token(pa_tok((unsigned)k, tb, nwg), lane, Y16, X1, fg);
    }
}
template <int NR> __device__ __forceinline__ void convert_expert_rows(const float* table, int ex, int stride, bool isv, int lane, unsigned char* U8, unsigned char* V8) {
    f32x4 r[NR][4]; const float sc = isv ? V8_SCALE : U8_SCALE;
#pragma unroll
    for (int k = 0; k < NR; ++k) { const int e = ex + k * stride; const float* src = table + (size_t)(e < NEXP ? e : ex) * 1024 + 16 * lane;
#pragma unroll
        for (int q = 0; q < 4; ++q) r[k][q] = *(const GAS f32x4*)(src + 4 * q); }
#pragma unroll
    for (int k = 0; k < NR; ++k) { const int e = ex + k * stride; if (e < NEXP) {
        const f32x4 a = r[k][0] * sc, b = r[k][1] * sc, c = r[k][2] * sc, d = r[k][3] * sc;
        const v4u o = (v4u){pack_fp8x4(a.x, a.y, a.z, a.w), pack_fp8x4(b.x, b.y, b.z, b.w), pack_fp8x4(c.x, c.y, c.z, c.w), pack_fp8x4(d.x, d.y, d.z, d.w)};
        if (!isv) *(GAS v4u*)(U8 + (size_t)e * 1024 + 16 * lane) = o;
        else *(GAS v4u*)(V8 + ((size_t)(lane >> 3) * NEXP + e) * 128 + (lane & 7) * 16) = o; } }
}
struct OnePanel { int pm, n; __device__ __forceinline__ bool next(int i, pg8::Unit& u) const { if (i >= n) return false; u.pm = pm; u.pn = i; u.w = 0; return true; } };
struct DualOrder { pg8::StaticOrder S; __device__ __forceinline__ bool next(int i, pg8::Unit& u) const { if (!S.next(i >> 1, u)) return false; u.w = i & 1; return true; } };
struct Args { const float* in[24]; float* out; unsigned char* ws; int ph_lo, ph_hi, li, pad; };
__global__ void __launch_bounds__(NWAVES * 64, 2) mk_fwd(Args args) {
    extern __shared__ __attribute__((aligned(16))) unsigned char lds[];
    Frame F;
    F.lds = (LAS unsigned char*)lds;
    volatile LAS unsigned* MISC = (volatile LAS unsigned*)(F.lds + MISC_OFF);
    F.tid = threadIdx.x; F.lane = F.tid & 63; F.wave = __builtin_amdgcn_readfirstlane(F.tid >> 6);
    F.G = gridDim.x; { const int bx = blockIdx.x; F.vcu = (F.G % 8 == 0) ? (bx % 8) * (F.G / 8) + bx / 8 : bx; }
    unsigned char* ws = args.ws;
    gu32* ctl = (gu32*)(ws + WS_CTL);
    for (int u = F.tid; u < (LDS_BYTES - LDSCTL_OFF) / 4; u += NWAVES * 64) ((LAS unsigned*)(F.lds + LDSCTL_OFF))[u] = 0u;
    __syncthreads();
    XcdBarrier bar; bar.bar = (unsigned*)(ctl + CW_BAR); bar.x = 0; bar.st = nullptr;
    if (N_LAUNCHES != PER_PHASE) bar = xcd_barrier_post((unsigned*)(ctl + CW_BAR), MISC + 8);
#define GRID_BAR() do { if (N_LAUNCHES != PER_PHASE) xcd_barrier(bar); } while (0)
    const int lo = args.ph_lo, hi = args.ph_hi;
#ifndef PH_MASK
#define PH_MASK 0xFFFF
#endif
#define IN(k) ((((PH_MASK) >> (k)) & 1) && lo <= (k) && (k) < hi)
#define BOTH(k) (IN(k) && IN((k) + 1))
    const int gw = F.vcu * NWAVES + F.wave, NGW = F.G * NWAVES;
    const int gtid = F.vcu * (NWAVES * 64) + F.tid, NTHR = F.G * NWAVES * 64;
    const float* x = args.in[0];
    bf16* Win_t = (bf16*)(ws + WS_WIN); bf16* Wq_t = (bf16*)(ws + WS_WQ); bf16* Wout_t = (bf16*)(ws + WS_WOUT); bf16* Wus_t = (bf16*)(ws + WS_WUS); bf16* Wua_t = (bf16*)(ws + WS_WUA);
    bf16* Wglu_t = (bf16*)(ws + WS_WGLU); bf16* KSb = (bf16*)(ws + WS_KS); bf16* WE = (bf16*)(ws + WS_WE); bf16* BP = (bf16*)(ws + WS_BP); bf16* AP = (bf16*)(ws + WS_AP);
    float* Eb = (float*)(ws + WS_E); bf16* Hb = (bf16*)(ws + WS_H); bf16* Ypre = (bf16*)(ws + WS_YPRE); bf16* Ya = (bf16*)(ws + WS_YA); bf16* XG = (bf16*)(ws + WS_XG);
    bf16* Zb = (bf16*)(ws + WS_Z); bf16* Qb = (bf16*)(ws + WS_Z + 1 * ZSTRIDE_B); bf16* Kb = (bf16*)(ws + WS_Z + 2 * ZSTRIDE_B); bf16* Vb = (bf16*)(ws + WS_Z + 3 * ZSTRIDE_B);
    bf16* GA = (bf16*)(ws + WS_Z + 4 * ZSTRIDE_B); bf16* GB = (bf16*)(ws + WS_Z + 6 * ZSTRIDE_B);
    bf16* Yb = (bf16*)(ws + WS_YB); bf16* Mrg = (bf16*)(ws + WS_MRG); bf16* PQb = (bf16*)(ws + WS_PQ); int* ids = (int*)(ws + WS_IDS); float* gts = (float*)(ws + WS_GTS);
    unsigned char* U8 = ws + WS_U16; unsigned char* V8 = ws + WS_V16; unsigned* wpk = (unsigned*)(ws + WS_WPK); float* rstd1 = (float*)(ws + WS_RSTD1); unsigned short* Y16 = (unsigned short*)(ws + WS_Y16);
    float* biasT = (float*)(ws + WS_BIAS); float* pw32 = (float*)(ws + WS_PW32); float* kpart = (float*)(ws + WS_KPART); float* Kg = (float*)(ws + WS_KG); float* ssq1 = (float*)(ws + WS_SSQ1);

    if (IN(0)) for (int rep_ = 0; rep_ < REP_0; ++rep_) {
        LAS float* scr = (LAS float*)(F.lds + RING_OFF + F.wave * 16384);
        constexpr int I_IN = (1024 / 64) * (4096 / 32), I_GLU = (512 / 64) * (512 / 32), I_UP = (512 / 64) * (1024 / 32), I_OUT = (1024 / 64) * (1024 / 32), I_Q = (1024 / 64) * (2048 / 32);
        constexpr int NITEMS = I_IN + I_GLU + 2 * I_UP + I_OUT + I_Q;
        for (int it = gw; it < NITEMS; it += NGW) {
            int r = it;
            if (r < I_IN) { p0_transpose_item(args.in[2], 1024, 4096, Win_t, scr, r, F.lane); continue; } r -= I_IN;
            if (r < I_GLU) { p0_transpose_item(args.in[11], 512, 512, Wglu_t, scr, r, F.lane); continue; } r -= I_GLU;
            if (r < I_UP) { p0_transpose_item(args.in[13], 512, 1024, Wus_t, scr, r, F.lane); continue; } r -= I_UP;
            if (r < I_UP) { p0_transpose_item(args.in[14], 512, 1024, Wua_t, scr, r, F.lane); continue; } r -= I_UP;
            if (r < I_OUT) { p0_transpose_item(args.in[16], 1024, 1024, Wout_t, scr, r, F.lane); continue; } r -= I_OUT;
            p0_transpose_item(args.in[18], 1024, 2048, Wq_t, scr, r, F.lane);
        }
        for (int it = gw; it < NGRP * CH; it += NGW)
            ssm_table_task(it >> 5, it & 31, F.lane, scr, args.in[3], args.in[4], args.in[5], args.in[6], args.in[7], args.in[8], args.in[9], Kg, WE, BP, pw32);
        for (int m = gw; m < MTOK; m += NGW * 4) rms_rows4_to_bf16(x, args.in[1], Hb, m, NGW, F.lane);
        for (int it = gw; it < 64; it += NGW) { const float* src = (it < 32 ? args.in[19] : args.in[20]) + (size_t)(it & 31) * 512 + 8 * F.lane;
            const f32x4 a = *(const GAS f32x4*)src, b = *(const GAS f32x4*)(src + 4);
            *(GAS v4u*)(KSb + (size_t)it * 512 + 8 * F.lane) = (v4u){pk2(a.x, a.y), pk2(a.z, a.w), pk2(b.x, b.y), pk2(b.z, b.w)}; }
        if (gw == 0) { for (int i = F.lane; i < 8 * 128; i += 64) { const int h = i >> 7, rel = i & 127; int bk;
                if (rel < 16) bk = rel; else { const float lg = logf((float)rel / 16.0f) / 2.0794415416798357f * 16.0f; bk = 16 + (int)lg; bk = bk < 0 ? 0 : (bk > 31 ? 31 : bk); }
                biasT[i] = (args.in[15][bk * 8 + h] - args.in[15][31 * 8 + h]) * 1.4426950408889634f; } }
        if (BOTH(0)) GRID_BAR();
    }

    if (IN(1)) for (int rep_ = 0; rep_ < REP_1; ++rep_) {
        const float* Dsk = args.in[10];
        for (int i0 = gtid; i0 < NGRP * 512 * 64; i0 += NTHR * 4) {
            f32x4 ka[4], kb[4];
#pragma unroll
            for (int q = 0; q < 4; ++q) { const int i = i0 + q * NTHR; const int ic = (i < NGRP * 512 * 64) ? i : i0; const int g = ic >> 15, m = (ic >> 6) & 511, k8 = ic & 63, j = m >> 4, ho = m & 15, jp = k8 >> 1, hi0 = (k8 & 1) * 8;
                const int lag = (jp <= j) ? j - jp : 0; const float* kp = Kg + ((size_t)(g * 32 + lag) * 256 + ho * 16 + hi0); ka[q] = *(const GAS f32x4*)kp; kb[q] = *(const GAS f32x4*)(kp + 4); }
#pragma unroll
            for (int q = 0; q < 4; ++q) { const int i = i0 + q * NTHR; if (i >= NGRP * 512 * 64) break; const int g = i >> 15, m = (i >> 6) & 511, k8 = i & 63, j = m >> 4, ho = m & 15, jp = k8 >> 1, hi0 = (k8 & 1) * 8;
                v4u o = (v4u){0u, 0u, 0u, 0u};
                if (jp <= j) { f32x4 a = ka[q], b = kb[q];
                    if (jp == j && (ho >> 3) == (hi0 >> 3)) { const float dv = Dsk[g * 16 + ho]; const int e = ho & 7;
                        a.x += (e == 0) ? dv : 0.f; a.y += (e == 1) ? dv : 0.f; a.z += (e == 2) ? dv : 0.f; a.w += (e == 3) ? dv : 0.f;
                        b.x += (e == 4) ? dv : 0.f; b.y += (e == 5) ? dv : 0.f; b.z += (e == 6) ? dv : 0.f; b.w += (e == 7) ? dv : 0.f; }
                    o = (v4u){pk2(a.x, a.y), pk2(a.z, a.w), pk2(b.x, b.y), pk2(b.z, b.w)}; }
                *(GAS v4u*)(BP + ((size_t)(g * 512 + m) * APK + k8 * 8)) = o; } }
        pg8::Gemm g{Hb, Win_t, MTOK, INCOLS, 1024, 1024, 1024, 1 << 30, 0};
        pg8::StaticOrder S; S.init(MTOK, INCOLS, F.G, (int)blockIdx.x);
        pg8::EpiIn E{Zb, AP, kpart};
        pg8::gemm_phase<pg8::EpiIn, pg8::StaticOrder, true>(F.lds + RING_OFF, g, S, E);
        if (BOTH(1)) GRID_BAR();
    }

    if (IN(2)) for (int rep_ = 0; rep_ < REP_2; ++rep_) {
        const int bx = (int)blockIdx.x;
        const bool shared = F.G < 4;
        const int nS = shared ? F.G : (F.G >= 256 ? 64 : F.G / 4), nA = shared ? F.G : F.G - nS;
        const bool inS = shared || bx < nS, inA = shared || bx >= nS; const int aidx = shared ? bx : bx - nS;
        if (inS) {
#pragma unroll 1
            for (int pm = bx; pm < MTOK / 256; pm += nS) {
                { pg8::Gemm g1{AP, WE, MTOK, 256, 512, APK, 512, 2, (size_t)256 * 512}; OnePanel S1{pm, 1}; pg8::EpiE E1{Eb};
                  pg8::gemm_phase<pg8::EpiE, OnePanel, true>(F.lds + RING_OFF, g1, S1, E1); }
                VM_WAIT(); __syncthreads();
                if (F.tid < 256) { const int gb = (pm >> 1) * 8 + (pm & 1) * 4 + (F.tid >> 6), g_ = gb >> 3, p = F.tid & 63; const size_t row0 = (size_t)gb * 64;
                    const float mr = pw32[g_ * 128 + p], mi = pw32[g_ * 128 + 64 + p]; float sr = 0.f, si = 0.f;
#pragma unroll 1
                    for (int c0 = 0; c0 < NCHUNK; c0 += 32) { float er[32], ei[32];
#pragma unroll
                        for (int c = 0; c < 32; ++c) { er[c] = Eb[(row0 + c0 + c) * 128 + p]; ei[c] = Eb[(row0 + c0 + c) * 128 + 64 + p]; }
#pragma unroll
                        for (int c = 0; c < 32; ++c) { bf16* ap = AP + (row0 + c0 + c) * APK + 512; ap[p] = (bf16)f2bf(sr); ap[64 + p] = (bf16)f2bf(si);
                            const float nr = mr * sr - mi * si + er[c], ni = mr * si + mi * sr + ei[c]; sr = nr; si = ni; } } }
                VM_WAIT(); __syncthreads();
                { pg8::Gemm g{AP, BP, MTOK, 512, APK, APK, APK, 2, (size_t)512 * APK}; OnePanel S3{pm, 2}; pg8::EpiY E{Ypre};
                  pg8::gemm_phase<pg8::EpiY, OnePanel, true>(F.lds + RING_OFF, g, S3, E); }
            }
        }
        if (inA) {
            static_assert(attn_body::ATTN_LDS_BYTES <= RING_BYTES, "attention LDS");
#pragma unroll 1
            for (int a = aidx; a < 192; a += nA) { const int ty = a >> 6, bh = a & 63;
#pragma unroll 1
                for (int i = 0; i < 4; ++i) { const int qb = (ty == 0) ? (i == 0 ? 7 : (i == 1 ? 2 : (i == 2 ? 0 : -1))) : (ty == 1) ? (i == 0 ? 6 : (i == 1 ? 4 : -1)) : (i == 0 ? 5 : (i == 1 ? 3 : (i == 2 ? 1 : -1)));
                    if (qb < 0) break;
                    attn_body::attn_unit<8>(bh >> 3, bh & 7, qb, (const attn_body::bf16*)Qb, (const attn_body::bf16*)Kb, (const attn_body::bf16*)Vb, (attn_body::bf16*)Yb, (char*)lds + RING_OFF, kpart, biasT); } }
        }
        if (BOTH(2)) GRID_BAR();
    }

    if (IN(3)) for (int rep_ = 0; rep_ < REP_3; ++rep_) {
        pg8::Gemm g{Ypre, Wglu_t, MTOK, 512, 512, 512, 512, 1 << 30, 0};
        pg8::StaticOrder S; S.init(MTOK, 512, F.G, (int)blockIdx.x);
        pg8::EpiGlu E{Ypre, Ya, args.in[12]};
        pg8::gemm_phase<pg8::EpiGlu, pg8::StaticOrder, true>(F.lds + RING_OFF, g, S, E);
        { const int nun = (MTOK / 256) * (512 / 256);
          const int nconv = (F.G > nun) ? F.G - nun : F.G, cidx = (F.G > nun) ? (int)blockIdx.x - nun : (int)blockIdx.x;
          if (cidx >= 0) for (int ex = cidx * NWAVES + F.wave; ex < 2 * NEXP; ex += nconv * NWAVES * 4) { const bool isv = ex >= NEXP; convert_expert_rows<4>(isv ? args.in[22] : args.in[21], isv ? ex - NEXP : ex, nconv * NWAVES, isv, F.lane, U8, V8); } }
        if (BOTH(3)) GRID_BAR();
    }

    if (IN(4)) for (int rep_ = 0; rep_ < REP_4; ++rep_) {
        pg8::Gemm g{Ya, Wus_t, MTOK, 1024, 512, 512, 512, 1 << 30, 0, Yb, Wua_t};
        DualOrder S; S.S.init(MTOK, 1024, F.G, (int)blockIdx.x);
        pg8::EpiMrgDual E{pg8::EpiMrg<0>{GA, Mrg}, pg8::EpiMrg<1>{GB, Mrg}};
        pg8::gemm_phase<pg8::EpiMrgDual, DualOrder, true>(F.lds + RING_OFF, g, S, E);
        if (BOTH(4)) GRID_BAR();
    }

    if (IN(5)) for (int rep_ = 0; rep_ < REP_5; ++rep_) {
        pg8::Gemm g{Mrg, Wout_t, MTOK, 1024, 1024, 1024, 1024, 1 << 30, 0}; pg8::StaticOrder S; S.init(MTOK, 1024, F.G, (int)blockIdx.x);
        pg8::EpiX1 E{x, args.out, XG, args.in[17], ssq1};
        pg8::gemm_phase<pg8::EpiX1, pg8::StaticOrder, true>(F.lds + RING_OFF, g, S, E);
        if (BOTH(5)) GRID_BAR();
    }

    if (IN(6)) for (int rep_ = 0; rep_ < REP_6; ++rep_) {
        pg8::Gemm g{XG, Wq_t, MTOK, PQ, 1024, 1024, 1024, 1 << 30, 0}; pg8::StaticOrder S; S.init(MTOK, PQ, F.G, (int)blockIdx.x);
        pg8::EpiPlain E{PQb, PQ};
        pg8::gemm_phase<pg8::EpiPlain, pg8::StaticOrder, true>(F.lds + RING_OFF, g, S, E);
        if (BOTH(6)) GRID_BAR();
    }

    if (IN(7)) for (int rep_ = 0; rep_ < REP_7; ++rep_) {
        LAS unsigned char* scr = F.lds + RING_OFF + F.wave * 2048;
        LAS unsigned char* ksl = F.lds + RING_OFF + 16384;
        for (int c = F.tid; c < 256 * 16; c += NWAVES * 64) { const int row = c >> 4, ch = c & 15; *(LAS v4u*)(ksl + row * 256 + ((ch ^ (row & 15)) << 4)) = *(const GAS v4u*)(KSb + row * 128 + ch * 8); }
        __syncthreads();
        for (int it = gw; it < (MTOK / 32) * 8; it += NGW) topk_task(it >> 3, it & 7, F.lane, scr, PQb, ksl, ssq1, ids, gts, rstd1);
        if (BOTH(7)) { VM_WAIT(); __syncthreads(); }
    }

    if (IN(8)) for (int rep_ = 0; rep_ < REP_8; ++rep_) {
        peer_a_phase(F.lane, F.wave, F.G, F.vcu, XG, U8, ids, gts, rstd1, wpk, F.lds, 0xffff);
        if (BOTH(8)) { VM_WAIT(); __syncthreads(); }
    }
    if (IN(9)) for (int rep_ = 0; rep_ < REP_9; ++rep_) {
        peer_b_phase(F.lane, F.wave, F.G, F.vcu, V8, wpk, Y16, args.out, args.in[23]);
    }
#undef IN
#undef BOTH
#undef GRID_BAR
}

extern "C" void kernel_launch(void* const* d_in, const int* in_sizes, int n_in, void* d_out, int out_size, void* d_ws, size_t ws_size, hipStream_t stream) {
    static int grid = 0;
    if (grid == 0) {
        if (n_in != 24 || in_sizes[0] != MTOK * DMODEL || out_size != MTOK * DMODEL || ws_size < WS_END) { fprintf(stderr, "kernel_launch: unexpected shapes (n_in %d, in0 %d, out %d, ws %zu); nothing launched\n", n_in, n_in > 0 ? in_sizes[0] : -1, out_size, ws_size); grid = -1; return; }
        int dev = 0, cus = 0, per_cu = 0;
        if (hipGetDevice(&dev) != hipSuccess || hipDeviceGetAttribute(&cus, hipDeviceAttributeMultiprocessorCount, dev) != hipSuccess) { grid = -1; return; }
        if (hipFuncSetAttribute((const void*)mk_fwd, hipFuncAttributeMaxDynamicSharedMemorySize, LDS_BYTES) != hipSuccess) { fprintf(stderr, "kernel_launch: hipFuncSetAttribute failed\n"); grid = -1; return; }
        if (hipOccupancyMaxActiveBlocksPerMultiprocessor(&per_cu, (const void*)mk_fwd, NWAVES * 64, LDS_BYTES) != hipSuccess || per_cu < 1) { fprintf(stderr, "kernel_launch: occupancy query says %d blocks per CU\n", per_cu); }
        (void)hipGetLastError();
        grid = cus;
    }
    if (grid < 0) return;
    if (N_LAUNCHES != PER_PHASE) { if (hipMemsetAsync((char*)d_ws + WS_CTL, 0, CTL_ZERO_BYTES, stream) != hipSuccess) return; }
    Args a{};
    for (int i = 0; i < 24; ++i) a.in[i] = (const float*)d_in[i];
    a.out = (float*)d_out; a.ws = (unsigned char*)d_ws; a.pad = 0;
    if (N_LAUNCHES == PER_PHASE) {
        for (int li = 0; li < PER_PHASE; ++li) { a.ph_lo = li; a.ph_hi = li + 1; a.li = li; hipLaunchKernelGGL(mk_fwd, dim3(grid), dim3(NWAVES * 64), LDS_BYTES, stream, a); }
    } else {
        a.ph_lo = 0; a.ph_hi = PER_PHASE; a.li = 0;
        hipLaunchKernelGGL(mk_fwd, dim3(grid), dim3(NWAVES * 64), LDS_BYTES, stream, a);
    }
}
```

```cpp
#include <hip/hip_runtime.h>
#include <hip/hip_bf16.h>
#include <cstdio>
#include <cstdint>
#include <cmath>

#ifndef MK_N_LAUNCHES
#define MK_N_LAUNCHES 1
#endif

namespace pg8 {
#define PG8_LAS __attribute__((address_space(3)))
typedef unsigned short bf16_t;
typedef short bf16x8 __attribute__((ext_vector_type(8)));
typedef float f32x4 __attribute__((ext_vector_type(4)));
typedef unsigned u32x4 __attribute__((ext_vector_type(4)));
constexpr int BM = 256, BK = 64, HALF = 128, HTB = HALF * BK * 2, STAGE_BYTES = 8 * HTB, NXCD = 8, WGM = 8;

__host__ __device__ __forceinline__ int lds_byte(int r, int c) { const int st = (r >> 4) * 2 + (c >> 5), rr = r & 15, cc = c & 31, ob = rr * 64 + cc * 2; return st * 1024 + (ob ^ (((ob >> 9) & 1) << 5)); }
__host__ __device__ __forceinline__ void stage_rc(int b, int& R, int& C) { const int st = b / 1024, sb = b % 1024, swz = sb ^ (((sb >> 9) & 1) << 5); R = (st >> 1) * 16 + swz / 64; C = (st & 1) * 32 + (swz % 64) / 2; }
__host__ __device__ __forceinline__ int perm32(int rho) { const int n = rho >> 4, i = rho & 15; return 8 * (i >> 2) + 4 * n + (i & 3); }

struct Unit { int pm, pn, w; };
struct Gemm { const bf16_t* A; const bf16_t* Bt; int M, N, K, lda, ldb, rpg; size_t bgs; const bf16_t* A2 = nullptr; const bf16_t* Bt2 = nullptr; };

struct StaticOrder {
    int nM, nN, nwg, G, c;
    __host__ __device__ __forceinline__ void init(int M, int N, int G_, int c_) { nM = M / BM; nN = N / BM; nwg = nM * nN; G = G_; c = c_; }
    __host__ __device__ __forceinline__ bool next(int i, Unit& u) const {
        const long L = (long)i * G + c; if (L >= nwg) return false;
        int wgid = (int)L; { const int q = nwg / NXCD, r = nwg % NXCD, xcd = wgid % NXCD, off = wgid / NXCD; wgid = (xcd < r ? xcd * (q + 1) : r * (q + 1) + (xcd - r) * q) + off; }
        const int nig = WGM * nN, gid = wgid / nig, fm = gid * WGM, gsz = (nM - fm) < WGM ? (nM - fm) : WGM;
        u.pm = fm + ((wgid % nig) % gsz); u.pn = (wgid % nig) / gsz; u.w = 0; return true;
    }
};

__device__ __forceinline__ unsigned cvt_pk_bf16(float lo, float hi) { unsigned r; asm volatile("v_cvt_pk_bf16_f32 %0, %1, %2" : "=v"(r) : "v"(lo), "v"(hi)); return r; }
__device__ __forceinline__ float bf_lo(unsigned w) { return __uint_as_float(w << 16); }
__device__ __forceinline__ float bf_hi(unsigned w) { return __uint_as_float(w & 0xffff0000u); }
__device__ __forceinline__ float sigmoid_f(float x) { return __builtin_amdgcn_rcpf(1.0f + __builtin_amdgcn_exp2f(-1.4426950409f * x)); }
__device__ __forceinline__ float gelu_tanh(float x) { const float u = x + 0.044715f * x * x * x; return x * __builtin_amdgcn_rcpf(1.0f + __builtin_amdgcn_exp2f(-2.3022081985f * u)); }

template <class Epi, class Sched, bool ALIGN_EPI>
__device__ __forceinline__ void gemm_phase(PG8_LAS unsigned char* lds, const Gemm g, const Sched& S, const Epi& E) {
    int tid = threadIdx.x; asm volatile("" : "+v"(tid));
    const int wid = __builtin_amdgcn_readfirstlane(tid >> 6), lane = tid & 63, wr = wid >> 2, wc = wid & 3, fr = lane & 15, fq = lane >> 4;
    const int K = g.K, nt = K / BK;
    unsigned voffA[2], voffB[2];
#pragma unroll
    for (int i = 0; i < 2; ++i) { int R, C; stage_rc(tid * 16 + i * 8192, R, C); const int Rb = Epi::PERM ? ((R & ~31) + perm32(R & 31)) : R;
        voffA[i] = (unsigned)(R * g.lda + C) * 2u; voffB[i] = (unsigned)(Rb * g.ldb + C) * 2u; }
    const size_t kstep = (size_t)(BK * 2);
    const size_t hstepA = (size_t)HALF * g.lda * 2, hstepB = (size_t)HALF * g.ldb * 2;
    const size_t tstepA = 2 * hstepA, tstepB = 2 * hstepB;
    const unsigned ldsw = (unsigned)wid * 1024u;
    const int aoff = lds_byte(wr * 64 + fr, fq * 8), boff = lds_byte(wc * 32 + fr, fq * 8);
#define PG8_SA(b, h) (((b) * 2 + (h)) * HTB)
#define PG8_SB(b, h) ((4 + (b) * 2 + (h)) * HTB)
#define PG8_STAGE(bufoff, gbase, voff) do { _Pragma("unroll") for (int _i = 0; _i < 2; ++_i) \
        __builtin_amdgcn_global_load_lds((const unsigned*)((const char*)(gbase) + (voff)[_i]), (PG8_LAS unsigned*)(lds + (bufoff) + ldsw + _i * 8192), 16, 0, 0); } while (0)
#define PG8_LDA(dst, b, h) do { _Pragma("unroll") for (int m = 0; m < 4; ++m) _Pragma("unroll") for (int k = 0; k < 2; ++k) dst[m][k] = *(const PG8_LAS bf16x8*)(lds + PG8_SA(b, h) + aoff + m * 2048 + k * 1024); } while (0)
#define PG8_LDB(dst, b, h) do { _Pragma("unroll") for (int n = 0; n < 2; ++n) _Pragma("unroll") for (int k = 0; k < 2; ++k) dst[n][k] = *(const PG8_LAS bf16x8*)(lds + PG8_SB(b, h) + boff + n * 2048 + k * 1024); } while (0)
#define PG8_MMA(ai, bj, At, Bt) do { __builtin_amdgcn_s_setprio(1); _Pragma("unroll") for (int m = 0; m < 4; ++m) _Pragma("unroll") for (int n = 0; n < 2; ++n) _Pragma("unroll") for (int k = 0; k < 2; ++k) \
        acc[ai][bj][m][n] = __builtin_amdgcn_mfma_f32_16x16x32_bf16(Bt[n][k], At[m][k], acc[ai][bj][m][n], 0, 0, 0); __builtin_amdgcn_s_setprio(0); } while (0)
#define PG8_WAIT_V(n) asm volatile("s_waitcnt vmcnt(" #n ")" ::: "memory")
#define PG8_WAIT_L(n) asm volatile("s_waitcnt lgkmcnt(" #n ")" ::: "memory")
#define PG8_BAR __builtin_amdgcn_s_barrier()
#define PG8_SCHED __builtin_amdgcn_sched_barrier(0)
    Unit cur, nxt; int ui = 0;
    if (!S.next(0, cur)) return;
    f32x4 acc[2][2][4][2];
#pragma unroll
    for (int a = 0; a < 2; ++a)
#pragma unroll
        for (int b = 0; b < 2; ++b)
#pragma unroll
            for (int m = 0; m < 4; ++m)
#pragma unroll
                for (int n = 0; n < 2; ++n) acc[a][b][m][n] = (f32x4){0.f, 0.f, 0.f, 0.f};
    bf16x8 At[4][2], B0[2][2], B1[2][2];
    const char* cA = (const char*)(cur.w ? g.A2 : g.A) + (size_t)cur.pm * tstepA;
    const char* cB = (const char*)(cur.w ? g.Bt2 : g.Bt) + (size_t)(cur.pm / g.rpg) * g.bgs * 2 + (size_t)cur.pn * tstepB;
    PG8_STAGE(PG8_SB(0, 0), cB, voffB); PG8_STAGE(PG8_SB(0, 1), cB + hstepB, voffB); PG8_STAGE(PG8_SA(0, 0), cA, voffA); PG8_STAGE(PG8_SA(0, 1), cA + hstepA, voffA);
    if (wr == 1) PG8_BAR;
    PG8_WAIT_V(2); PG8_BAR;
    PG8_STAGE(PG8_SB(1, 0), cB + kstep, voffB); PG8_STAGE(PG8_SA(1, 0), cA + kstep, voffA); PG8_STAGE(PG8_SB(1, 1), cB + hstepB + kstep, voffB);
    PG8_WAIT_V(6); PG8_BAR;
    for (;;) {
        const bool has_next = S.next(ui + 1, nxt);
        const char* nA = has_next ? (const char*)(nxt.w ? g.A2 : g.A) + (size_t)nxt.pm * tstepA : cA;
        const char* nB = has_next ? (const char*)(nxt.w ? g.Bt2 : g.Bt) + (size_t)(nxt.pm / g.rpg) * g.bgs * 2 + (size_t)nxt.pn * tstepB : cB;
        for (int t = 0; t < nt; t += 2) {
            const bool last = (t == nt - 2);
            const char* a1 = cA + (size_t)(t + 1) * kstep;
            const char* a2 = last ? nA : cA + (size_t)(t + 2) * kstep; const char* b2 = last ? nB : cB + (size_t)(t + 2) * kstep;
            const char* a3 = a2 + kstep; const char* b3 = b2 + kstep;
            PG8_LDB(B0, 0, 0); PG8_LDB(B1, 0, 1); PG8_SCHED; PG8_LDA(At, 0, 0); PG8_STAGE(PG8_SA(1, 1), a1 + hstepA, voffA);
            PG8_WAIT_V(8); PG8_WAIT_L(0); PG8_BAR; PG8_MMA(0, 0, At, B0); PG8_MMA(0, 1, At, B1); PG8_BAR; PG8_SCHED;
            PG8_LDA(At, 0, 1); PG8_STAGE(PG8_SB(0, 0), b2, voffB); PG8_STAGE(PG8_SB(0, 1), b2 + hstepB, voffB); PG8_STAGE(PG8_SA(0, 0), a2, voffA);
            PG8_WAIT_V(8); PG8_WAIT_L(0); PG8_BAR; PG8_MMA(1, 0, At, B0); PG8_MMA(1, 1, At, B1); PG8_BAR; PG8_SCHED;
            PG8_LDB(B0, 1, 0); PG8_LDB(B1, 1, 1); PG8_SCHED; PG8_LDA(At, 1, 0); PG8_STAGE(PG8_SA(0, 1), a2 + hstepA, voffA);
            PG8_WAIT_V(8); PG8_WAIT_L(0); PG8_BAR; PG8_MMA(0, 0, At, B0); PG8_MMA(0, 1, At, B1); PG8_BAR; PG8_SCHED;
            PG8_LDA(At, 1, 1); PG8_STAGE(PG8_SB(1, 0), b3, voffB); PG8_STAGE(PG8_SB(1, 1), b3 + hstepB, voffB); PG8_STAGE(PG8_SA(1, 0), a3, voffA);
            PG8_WAIT_V(8); PG8_WAIT_L(0); PG8_BAR; PG8_MMA(1, 0, At, B0); PG8_MMA(1, 1, At, B1); PG8_BAR; PG8_SCHED;
        }
        if constexpr (ALIGN_EPI) { if (wr == 0) PG8_BAR; }
        E(acc, cur, wr, wc, fr, fq);
        if (!has_next) break;
#pragma unroll
        for (int a = 0; a < 2; ++a)
#pragma unroll
            for (int b = 0; b < 2; ++b)
#pragma unroll
                for (int m = 0; m < 4; ++m)
#pragma unroll
                    for (int n = 0; n < 2; ++n) acc[a][b][m][n] = (f32x4){0.f, 0.f, 0.f, 0.f};
        cur = nxt; cA = nA; cB = nB; ++ui;
        if constexpr (ALIGN_EPI) { if (wr == 1) PG8_BAR; }
    }
    PG8_WAIT_V(0);
    if constexpr (!ALIGN_EPI) { if (wr == 0) PG8_BAR; }
    PG8_BAR;
#undef PG8_SA
#undef PG8_SB
#undef PG8_STAGE
#undef PG8_LDA
#undef PG8_LDB
#undef PG8_MMA
#undef PG8_WAIT_V
#undef PG8_WAIT_L
#undef PG8_BAR
#undef PG8_SCHED
}
}
namespace attn_body {
using bf16=__hip_bfloat16;
using bf16x8=__attribute__((ext_vector_type(8)))short;
using s16x4=__attribute__((ext_vector_type(4)))short;
using f32x16=__attribute__((ext_vector_type(16)))float;
using f32x4v=__attribute__((ext_vector_type(4)))float;
using u32x4=__attribute__((ext_vector_type(4)))unsigned;
constexpr int BATCH=8,NHEAD=8,SEQ=2048,D=64,DM=NHEAD*D;
constexpr int NW=8,QBLK=32,QB=QBLK*NW,KVBLK=64,NQB=SEQ/QB;
__device__ __forceinline__ int crow(int r,int hi){return (r&3)+8*(r>>2)+4*hi;}
#define SBAR() __builtin_amdgcn_sched_barrier(0)
__device__ __forceinline__ void cmask(f32x16&p0,f32x16&p1,int jb,int qrel,int hi){
  const float NEG=-INFINITY; int kb=64*jb+4*hi;
  #pragma unroll
  for(int r=0;r<16;++r){int kv=kb+(r&3)+8*(r>>2); if(kv>qrel)p0[r]=NEG; if(kv+32>qrel)p1[r]=NEG;}
}
typedef __attribute__((address_space(3))) const float* lds_cfptr;
__device__ __forceinline__ void biasadd(f32x16&p0,f32x16&p1,int jb,int qrel,int hi,lds_cfptr bt){
  const int base=qrel-64*jb-4*hi;
  #pragma unroll
  for(int r4=0;r4<16;r4+=4){
    #pragma unroll
    for(int r=r4;r<r4+4;++r){int rel=base-((r&3)+8*(r>>2)); int i0=min(max(rel,0),127), i1=min(max(rel-32,0),127); p0[r]+=bt[i0]; p1[r]+=bt[i1];}
    asm volatile("s_waitcnt lgkmcnt(0)":"+v"(p0),"+v"(p1)::"memory"); }
}

constexpr int NSLOT=3, SLOTB=8192;
constexpr int LDS_K=0, LDS_V=NSLOT*SLOTB, LDS_WS=2*NSLOT*SLOTB, LDS_OST=LDS_WS+NW*64*4, LDS_KM=LDS_OST+NW*4096, LDS_BT=LDS_KM+7*64*4, LDS_BYTES=LDS_BT+128*4;
constexpr float C2=0.125f*1.4426950408889634f;
__device__ __forceinline__ void glds16(const void*gsrc,unsigned lds_dst){unsigned keep;
  asm volatile("s_mov_b32 %0, m0\n\ts_mov_b32 m0, %2\n\ts_nop 0\n\tglobal_load_lds_dwordx4 %1, off\n\ts_mov_b32 m0, %0":"=&s"(keep):"v"(gsrc),"s"(lds_dst):"memory");}
__device__ __forceinline__ float max3f(float a,float b,float c){float r;asm("v_max3_f32 %0, %1, %2, %3":"=v"(r):"v"(a),"v"(b),"v"(c));return r;}
__device__ __forceinline__ float max2f(float a,float b){float r;asm("v_max_f32_e32 %0, %1, %2":"=v"(r):"v"(a),"v"(b));return r;}
__device__ __forceinline__ float fadd_s(float a,float b){float r;asm("v_add_f32_e32 %0, %1, %2":"=v"(r):"v"(a),"v"(b));return r;}
__device__ __forceinline__ float fsub_s(float a,float b){float r;asm("v_sub_f32_e32 %0, %1, %2":"=v"(r):"v"(a),"v"(b));return r;}
typedef float f32x2_t __attribute__((ext_vector_type(2))); typedef __bf16 bf16x2_t __attribute__((ext_vector_type(2)));
__device__ __forceinline__ unsigned cvtpk_s(float lo,float hi){f32x2_t v={lo,hi};bf16x2_t b=__builtin_convertvector(v,bf16x2_t);return __builtin_bit_cast(unsigned,b);}
#define WAIT_BAR(N) asm volatile("s_waitcnt vmcnt(" #N ") lgkmcnt(0)\n\ts_barrier":::"memory")

__device__ __forceinline__ void qkt(f32x16&p0,f32x16&p1,const char*Kslot,const bf16x8*qr,int r32,int hi){
  const char*kb=Kslot+hi*1024+r32*16;
  #pragma unroll
  for(int d0=0;d0<4;++d0){
    const bf16x8 b0=*reinterpret_cast<const bf16x8*>(kb+d0*2048);
    const bf16x8 b1=*reinterpret_cast<const bf16x8*>(kb+d0*2048+512);
    if(d0==0){p0=__builtin_amdgcn_mfma_f32_32x32x16_bf16(b0,qr[0],(f32x16){},0,0,0);p1=__builtin_amdgcn_mfma_f32_32x32x16_bf16(b1,qr[0],(f32x16){},0,0,0);}
    else{p0=__builtin_amdgcn_mfma_f32_32x32x16_bf16(b0,qr[d0],p0,0,0,0);p1=__builtin_amdgcn_mfma_f32_32x32x16_bf16(b1,qr[d0],p1,0,0,0);}}
}
typedef __attribute__((address_space(3))) const char* lds_cptr;
typedef short v4i16_t __attribute__((ext_vector_type(4)));
__device__ __forceinline__ void kload8(bf16x8*kf,lds_cptr kp){
  kf[0]=*(const __attribute__((address_space(3))) bf16x8*)(kp);      kf[1]=*(const __attribute__((address_space(3))) bf16x8*)(kp+512);
  kf[2]=*(const __attribute__((address_space(3))) bf16x8*)(kp+2048); kf[3]=*(const __attribute__((address_space(3))) bf16x8*)(kp+2560);
  kf[4]=*(const __attribute__((address_space(3))) bf16x8*)(kp+4096); kf[5]=*(const __attribute__((address_space(3))) bf16x8*)(kp+4608);
  kf[6]=*(const __attribute__((address_space(3))) bf16x8*)(kp+6144); kf[7]=*(const __attribute__((address_space(3))) bf16x8*)(kp+6656);
}
__device__ __forceinline__ void kload2(bf16x8*kf,lds_cptr kp,int j){ kf[2*j]=*(const __attribute__((address_space(3))) bf16x8*)(kp+j*2048); kf[2*j+1]=*(const __attribute__((address_space(3))) bf16x8*)(kp+j*2048+512); }
__device__ __forceinline__ s16x4 vtr(lds_cptr p){ return __builtin_bit_cast(s16x4,__builtin_amdgcn_ds_read_tr16_b64_v4i16((__attribute__((address_space(3))) v4i16_t*)p)); }
__device__ __forceinline__ float rowmax(const f32x16&p0,const f32x16&p1){
  float a=max3f(p0[0],p0[1],p1[0]),b=max3f(p0[2],p0[3],p1[1]);a=max3f(a,p1[2],p1[3]);
  #pragma unroll
  for(int r=4;r<16;r+=4){a=max3f(a,p0[r],p0[r+1]);b=max3f(b,p0[r+2],p0[r+3]);a=max3f(a,p1[r],p1[r+1]);b=max3f(b,p1[r+2],p1[r+3]);}
  const float m=max2f(a,b);
  auto rr=__builtin_amdgcn_permlane32_swap(__float_as_uint(m),__float_as_uint(m),false,false);
  return max2f(__uint_as_float(rr[0]),__uint_as_float(rr[1]));
}
__device__ __forceinline__ void pv(f32x16*o,int vb,bf16x8 pa0,bf16x8 pa1,bf16x8 pa2,bf16x8 pa3){
  #pragma unroll
  for(int d0=0;d0<2;++d0){s16x4 lo[4],hi[4];
    #pragma unroll
    for(int ks=0;ks<4;++ks){
      asm volatile("ds_read_b64_tr_b16 %0,%1 offset:%c2":"=&v"(lo[ks]):"v"(vb),"i"(d0*4096+ks*1024):"memory");
      asm volatile("ds_read_b64_tr_b16 %0,%1 offset:%c2":"=&v"(hi[ks]):"v"(vb),"i"(d0*4096+ks*1024+512):"memory");}
    asm volatile("s_waitcnt lgkmcnt(0)":::"memory");SBAR();
    #define PK(k) (bf16x8){lo[k][0],lo[k][1],lo[k][2],lo[k][3],hi[k][0],hi[k][1],hi[k][2],hi[k][3]}
    o[d0]=__builtin_amdgcn_mfma_f32_32x32x16_bf16(pa0,PK(0),o[d0],0,0,0);
    o[d0]=__builtin_amdgcn_mfma_f32_32x32x16_bf16(pa1,PK(1),o[d0],0,0,0);
    o[d0]=__builtin_amdgcn_mfma_f32_32x32x16_bf16(pa2,PK(2),o[d0],0,0,0);
    o[d0]=__builtin_amdgcn_mfma_f32_32x32x16_bf16(pa3,PK(3),o[d0],0,0,0);
    #undef PK
  }
}

#ifndef ATTN_STORE16
#define ATTN_STORE16(p,v) (*(u32x4*)(p)=(v))
#endif
template<int THRL> __device__ __forceinline__ void attn_unit(int b,int h,int qb,const bf16*Q,const bf16*__restrict__ K,const bf16*__restrict__ V,bf16*O,char*shm,const float*kpart,const float*btab){
  int tid=threadIdx.x; asm volatile("":"+v"(tid));
  const int lane=tid&63,r32=lane&31,hi=lane>>5; const int wid=__builtin_amdgcn_readfirstlane(tid>>6);
  const long rowbase=(long)b*SEQ; const int q0=qb*QB;
  const bf16*Qw=Q+(rowbase+q0+wid*QBLK)*DM+h*D;
  const bf16*Kh=K+rowbase*DM+h*D,*Vh=V+rowbase*DM+h*D;
  const unsigned lds0=(unsigned)(uintptr_t)shm;
  float*wsf=(float*)(shm+LDS_WS)+wid*64;
  const bf16*ksrc=Kh+(long)lane*DM+wid*8;
  const bf16*vsrc=Vh+(long)(16*(wid&3)+(lane>>2))*DM+(wid>>2)*32+(lane&3)*8;
  const unsigned kdst=lds0+LDS_K+wid*1024, vdst=lds0+LDS_V+wid*1024;
  #define DMA_K(t,slot) glds16(ksrc+(long)(t)*KVBLK*DM,(unsigned)__builtin_amdgcn_readfirstlane(kdst+(slot)))
  #define DMA_V(t,slot) glds16(vsrc+(long)(t)*KVBLK*DM,(unsigned)__builtin_amdgcn_readfirstlane(vdst+(slot)))
  const int vb0=(int)(lds0+LDS_V)+((lane>>4)&1)*32+(lane&3)*8+(4*hi+((lane&15)>>2))*64;
  const char*Kbase=shm+LDS_K; bf16x8 kf[8];
  const lds_cptr shm3=(lds_cptr)shm; const lds_cptr kp0=shm3+LDS_K+hi*1024+r32*16; const lds_cptr vp0=shm3+LDS_V+((lane>>4)&1)*32+(lane&3)*8+(4*hi+((lane&15)>>2))*64;
  const lds_cfptr btl=(lds_cfptr)(shm3+LDS_BT);
  const int NT=(q0+QB)/KVBLK;
  DMA_K(0,0);DMA_V(0,0);DMA_K(1,SLOTB);
  bf16x8 qr[4];
  #pragma unroll
  for(int d0=0;d0<4;++d0)qr[d0]=*reinterpret_cast<const bf16x8*>(&Qw[(long)r32*DM+d0*16+hi*8]);
  { float*km=(float*)(shm+LDS_KM); float*bt=(float*)(shm+LDS_BT); int tq=tid; asm volatile("":"+v"(tq));
    if(tq<448){const int j=tq>>6,d=tq&63; float v=0.f; if(j<qb&&qb>3){const float*kp=kpart+((size_t)((b*NQB+j)*2)*512)+h*D+d; v=(kp[0]+kp[512])*(1.0f/256.0f);} km[tq]=v;}
    else if(tq<448+64){const int i=tq-448; bt[i]=btab[h*128+i]; bt[64+i]=btab[h*128+64+i];} }
  float mhat=0.f,l_reg=0.f;f32x16 o[2];o[0]=f32x16{};o[1]=f32x16{};
  const int qrel=wid*QBLK+r32;
  #define CMASK(P0,P1,t) do{int jb_=(t)-(NT-4);   \
    if(jb_>=-2 && 32*wid+31-64*jb_>=0 && 32*wid-64*jb_-63<=112)biasadd(P0,P1,jb_,qrel,hi,btl); if(jb_>=0 && 64*jb_+63>32*wid)cmask(P0,P1,jb_,qrel,hi);}while(0)
  bool resc=false;
  #define START(P0,P1,t) do{ float rm=rowmax(P0,P1); resc=false; const float nv_=MASKADD(t); rm=fadd_s(rm,nv_); \
    { const float dl=__builtin_fmaxf(rm,-1.0e4f); mhat=fadd_s(mhat,dl); const float cc_=fsub_s(nv_,dl); \
      _Pragma("unroll") for(int r=0;r<16;++r){P0[r]=fadd_s(P0[r],cc_);P1[r]=fadd_s(P1[r],cc_);} } \
    _Pragma("unroll") for(int r=0;r<16;++r)P0[r]=__builtin_amdgcn_exp2f(P0[r]); }while(0)
  #define RESC() do{ if(resc){ asm volatile("s_waitcnt lgkmcnt(0)":::"memory"); \
      _Pragma("unroll") for(int d_=0;d_<2;++d_) _Pragma("unroll") for(int r=0;r<16;++r)o[d_][r]*=wsf[crow(r,hi)]; } }while(0)
  f32x16 pA0,pA1,pB0,pB1;
  int sl_prev=0,sl_cur=0,sl_next=SLOTB;
  #define ROT() do{sl_prev=sl_cur;sl_cur=sl_next;sl_next=(sl_next==(NSLOT-1)*SLOTB)?0:sl_next+SLOTB;}while(0)
  DMA_K(2,2*SLOTB);
  WAIT_BAR(3);
  unsigned selbits=(1u<<qb)-1u;
  if(qb>3){ selbits=0u;
    const __attribute__((address_space(3))) float* km3=(const __attribute__((address_space(3))) float*)(shm3+LDS_KM);
    float qf[32];
    #pragma unroll
    for(int d0=0;d0<4;++d0){
      #pragma unroll
      for(int i=0;i<8;++i) qf[d0*8+i]=__uint_as_float(((unsigned)(unsigned short)qr[d0][i])<<16);}
    float gj[7];
    #pragma unroll
    for(int j=0;j<7;++j){ float s=0.f;
      if(j<qb){
        #pragma unroll
        for(int d0=0;d0<4;++d0){ const f32x4v k0=*(const __attribute__((address_space(3))) f32x4v*)(km3+j*64+d0*16+hi*8); const f32x4v k1=*(const __attribute__((address_space(3))) f32x4v*)(km3+j*64+d0*16+hi*8+4);
          s+=qf[d0*8+0]*k0[0]+qf[d0*8+1]*k0[1]+qf[d0*8+2]*k0[2]+qf[d0*8+3]*k0[3]+qf[d0*8+4]*k1[0]+qf[d0*8+5]*k1[1]+qf[d0*8+6]*k1[2]+qf[d0*8+7]*k1[3]; }
        auto rr=__builtin_amdgcn_permlane32_swap(__float_as_uint(s),__float_as_uint(s),false,false); s=__uint_as_float(rr[0])+__uint_as_float(rr[1]); }
      gj[j]=s; }
    #pragma unroll
    for(int j=0;j<7;++j){ int rank=0;
      #pragma unroll
      for(int k=0;k<7;++k){ if(k!=j){ const bool beats=(k<j)?(gj[k]>=gj[j]):(gj[k]>gj[j]); rank+=(k<qb&&beats)?1:0; } }
      if(j<qb&&rank<3)selbits|=(1u<<j); }
  }
  #define MASKADD(t) ((((t)>>2)<qb && !((selbits>>((t)>>2))&1u))?-1.0e30f:0.0f)
  qkt(pA0,pA1,Kbase,qr,r32,hi);asm volatile("s_nop 15\n\ts_nop 7":"+v"(pA0),"+v"(pA1));CMASK(pA0,pA1,0);
  START(pA0,pA1,0);
  _Pragma("unroll") for(int r=0;r<16;++r)pA1[r]=__builtin_amdgcn_exp2f(pA1[r]);
  WAIT_BAR(0);
  DMA_K(3,0);DMA_V(1,SLOTB);
  ROT();
  kload8(kf,kp0+sl_cur);
  WAIT_BAR(2);
  s16x4 vlo[8],vhi[8]; u32x4 pw0,pw1,pw2,pw3;
  #define PKW(P,B) cvtpk_s(P[B],P[B+1])
  #define PAF(k) __builtin_bit_cast(bf16x8,pw##k)
  #define VFR(i) (bf16x8){vlo[i][0],vlo[i][1],vlo[i][2],vlo[i][3],vhi[i][0],vhi[i][1],vhi[i][2],vhi[i][3]}
  #define PIN(x) asm volatile("":"+v"(x))
  #define MX3(a,b,c) __builtin_fmaxf(__builtin_fmaxf((a),(b)),(c))
  #define GAPA(MF,A0,A1,A2,A3,W0,W1,PW) do{ MF; sacc+=A0; sacc+=A1; sacc+=A2; sacc+=A3; PIN(sacc); W0; W1; PIN(PW); SBAR(); }while(0)
  #define EX(v) __builtin_amdgcn_exp2f(v)
  #define GAPB(MF,X,B) do{ MF; X[B]=EX(X[B]); X[B+1]=EX(X[B+1]); X[B+2]=EX(X[B+2]); X[B+3]=EX(X[B+3]); PIN(X); SBAR(); }while(0)
  #define VRD(i) do{ vlo[i]=vtr(vp_+(((i)>>2)*4096+((i)&3)*1024)); vhi[i]=vtr(vp_+(((i)>>2)*4096+((i)&3)*1024+512)); }while(0)
  #define KRD(G,j) do{ if(G){ kload2(kf,kp0+sl_next,j); SBAR(); } }while(0)
  #define STEP(C0,C1,P0,P1,t,GK,GV,GL) do{ SBAR(); \
    const lds_cptr vp_=vp0+sl_prev; \
    VRD(0); SBAR(); float sacc=(P0[0]+P0[1]); \
    GAPA(C0=__builtin_amdgcn_mfma_f32_32x32x16_bf16(kf[0],qr[0],(f32x16){},0,0,0), P0[2],P0[3],P0[4],P0[5],     pw0[0]=PKW(P0,0), pw0[1]=PKW(P0,2), pw0); \
    VRD(4); SBAR(); GAPA(C1=__builtin_amdgcn_mfma_f32_32x32x16_bf16(kf[1],qr[0],(f32x16){},0,0,0), P0[6],P0[7],P0[8],P0[9],     pw0[2]=PKW(P0,4), pw0[3]=PKW(P0,6), pw0); \
    VRD(1); SBAR(); GAPA(C0=__builtin_amdgcn_mfma_f32_32x32x16_bf16(kf[2],qr[1],C0,0,0,0),   P0[10],P0[11],P0[12],P0[13], pw1[0]=PKW(P0,8), pw1[1]=PKW(P0,10), pw1); \
    VRD(5); SBAR(); GAPA(C1=__builtin_amdgcn_mfma_f32_32x32x16_bf16(kf[3],qr[1],C1,0,0,0),   P0[14],P0[15],P1[0],P1[1],   pw1[2]=PKW(P0,12),pw1[3]=PKW(P0,14), pw1); \
    VRD(2); SBAR(); GAPA(C0=__builtin_amdgcn_mfma_f32_32x32x16_bf16(kf[4],qr[2],C0,0,0,0),   P1[2],P1[3],P1[4],P1[5],     pw2[0]=PKW(P1,0), pw2[1]=PKW(P1,2), pw2); \
    VRD(6); SBAR(); GAPA(C1=__builtin_amdgcn_mfma_f32_32x32x16_bf16(kf[5],qr[2],C1,0,0,0),   P1[6],P1[7],P1[8],P1[9],     pw2[2]=PKW(P1,4), pw2[3]=PKW(P1,6), pw2); \
    VRD(3); SBAR(); GAPA(C0=__builtin_amdgcn_mfma_f32_32x32x16_bf16(kf[6],qr[3],C0,0,0,0),   P1[10],P1[11],P1[12],P1[13], pw3[0]=PKW(P1,8), pw3[1]=PKW(P1,10), pw3); \
    VRD(7); SBAR(); GAPA(C1=__builtin_amdgcn_mfma_f32_32x32x16_bf16(kf[7],qr[3],C1,0,0,0),   P1[14],P1[15],0.f,0.f,       pw3[2]=PKW(P1,12),pw3[3]=PKW(P1,14), pw3); \
    l_reg+=sacc; \
    if(GK){DMA_K((t)+3,sl_cur);} if(GV){DMA_V((t)+1,sl_next);} \
    CMASK(C0,C1,t); \
    { float a=MX3(C0[0],C0[1],C1[0]),b=MX3(C0[2],C0[3],C1[1]); a=MX3(a,C1[2],C1[3]); \
      _Pragma("unroll") for(int r=4;r<16;r+=4){a=MX3(a,C0[r],C0[r+1]);b=MX3(b,C0[r+2],C0[r+3]);a=MX3(a,C1[r],C1[r+1]);b=MX3(b,C1[r+2],C1[r+3]);} \
      float rm=__builtin_fmaxf(a,b); { auto rr=__builtin_amdgcn_permlane32_swap(__float_as_uint(rm),__float_as_uint(rm),false,false); rm=__builtin_fmaxf(__uint_as_float(rr[0]),__uint_as_float(rr[1])); } \
      const float nv_=MASKADD(t)-mhat; rm+=nv_; float cc_=nv_; \
      resc=false; \
      if(__builtin_expect(__any(rm>(float)THRL),0)){ const float dl=__builtin_fmaxf(rm,0.f); mhat+=dl; cc_-=dl; \
        const float f=__builtin_amdgcn_exp2f(-dl); l_reg*=f; if(hi==0)wsf[r32]=f; resc=true; } \
      _Pragma("unroll") for(int r=0;r<16;++r){C0[r]+=cc_;C1[r]+=cc_;} } \
    SBAR(); \
    GAPB(o[0]=__builtin_amdgcn_mfma_f32_32x32x16_bf16(PAF(0),VFR(0),o[0],0,0,0), C0,0); \
    GAPB(o[1]=__builtin_amdgcn_mfma_f32_32x32x16_bf16(PAF(0),VFR(4),o[1],0,0,0), C0,4); \
    KRD(GL,0); GAPB(o[0]=__builtin_amdgcn_mfma_f32_32x32x16_bf16(PAF(1),VFR(1),o[0],0,0,0), C0,8); \
    KRD(GL,1); GAPB(o[1]=__builtin_amdgcn_mfma_f32_32x32x16_bf16(PAF(1),VFR(5),o[1],0,0,0), C0,12); \
    KRD(GL,2); GAPB(o[0]=__builtin_amdgcn_mfma_f32_32x32x16_bf16(PAF(2),VFR(2),o[0],0,0,0), C1,0); \
    KRD(GL,3); GAPB(o[1]=__builtin_amdgcn_mfma_f32_32x32x16_bf16(PAF(2),VFR(6),o[1],0,0,0), C1,4); \
    GAPB(o[0]=__builtin_amdgcn_mfma_f32_32x32x16_bf16(PAF(3),VFR(3),o[0],0,0,0), C1,8); \
    GAPB(o[1]=__builtin_amdgcn_mfma_f32_32x32x16_bf16(PAF(3),VFR(7),o[1],0,0,0), C1,12); \
    }while(0)
  int t=1;
  #undef CMASK
  #define CMASK(P0,P1,t) do{}while(0)
  for(;t+7<NT;t+=2){
    STEP(pB0,pB1,pA0,pA1,t,true,true,true);     WAIT_BAR(2); RESC(); ROT();
    STEP(pA0,pA1,pB0,pB1,t+1,true,true,true);   WAIT_BAR(2); RESC(); ROT();
  }
  #undef CMASK
  #define CMASK(P0,P1,t) do{int jb_=(t)-(NT-4);   \
    if(jb_>=-2 && 32*wid+31-64*jb_>=0 && 32*wid-64*jb_-63<=112)biasadd(P0,P1,jb_,qrel,hi,btl); if(jb_>=0 && 64*jb_+63>32*wid)cmask(P0,P1,jb_,qrel,hi);}while(0)
  #define ENDW(tt) do{ if((tt)+3<NT){WAIT_BAR(2);} else if((tt)+2<NT){WAIT_BAR(1);} else {WAIT_BAR(0);} }while(0)
  for(;t+1<NT;t+=2){
    STEP(pB0,pB1,pA0,pA1,t,(t+3<NT),(t+1<NT),(t+1<NT));       ENDW(t);   RESC(); ROT();
    STEP(pA0,pA1,pB0,pB1,t+1,(t+4<NT),(t+2<NT),(t+2<NT));     ENDW(t+1); RESC(); ROT();
  }
  STEP(pB0,pB1,pA0,pA1,NT-1,false,false,false); RESC();
  { float sacc=pB0[0]+pB0[1]; _Pragma("unroll") for(int r=2;r<16;++r)sacc+=pB0[r]; _Pragma("unroll") for(int r=0;r<16;++r)sacc+=pB1[r]; l_reg+=sacc;
    pw0=(u32x4){PKW(pB0,0),PKW(pB0,2),PKW(pB0,4),PKW(pB0,6)};pw1=(u32x4){PKW(pB0,8),PKW(pB0,10),PKW(pB0,12),PKW(pB0,14)};pw2=(u32x4){PKW(pB1,0),PKW(pB1,2),PKW(pB1,4),PKW(pB1,6)};pw3=(u32x4){PKW(pB1,8),PKW(pB1,10),PKW(pB1,12),PKW(pB1,14)};
    SBAR(); pv(o,vb0+sl_cur,PAF(0),PAF(1),PAF(2),PAF(3)); }
  #undef PKW
  #undef PAF
  #undef VFR
  #undef PIN
  #undef MX3
  #undef GAPA
  #undef GAPB
  #undef EX
  #undef VRD
  #undef KRD
  #undef STEP
  #undef ENDW
  #undef MASKADD
  {auto rr=__builtin_amdgcn_permlane32_swap(__float_as_uint(l_reg),__float_as_uint(l_reg),false,false);l_reg=__uint_as_float(rr[0])+__uint_as_float(rr[1]);}
  if(hi==0)wsf[32+r32]=l_reg;asm volatile("s_waitcnt lgkmcnt(0)":::"memory");
  float rli[16];
  #pragma unroll
  for(int r=0;r<16;++r)rli[r]=__builtin_amdgcn_rcpf(wsf[32+crow(r,hi)]);
  bf16*Ow=O+(rowbase+q0+wid*QBLK)*DM+h*D;
  { bf16*stg=(bf16*)(shm+LDS_OST)+wid*2048;
    #pragma unroll
    for(int r=0;r<16;++r){const int orow=crow(r,hi);
      #pragma unroll
      for(int d0=0;d0<2;++d0)stg[orow*64+d0*32+r32]=__float2bfloat16(o[d0][r]*rli[r]);}
    asm volatile("s_waitcnt lgkmcnt(0)":::"memory");
    #pragma unroll
    for(int i=0;i<4;++i){const int row=i*8+(lane>>3),ch=lane&7; const u32x4 v=*(const u32x4*)(stg+row*64+ch*8); ATTN_STORE16(Ow+(long)row*DM+ch*8,v);} }
  asm volatile("s_waitcnt lgkmcnt(0)\n\ts_barrier":::"memory");
  #undef DMA_K
  #undef DMA_V
  #undef CMASK
  #undef START
  #undef RESC
  #undef ROT
}
constexpr int ATTN_LDS_BYTES=LDS_BYTES;
#undef SBAR
#undef WAIT_BAR
}
constexpr int NWAVES = 8;
constexpr int PER_PHASE = 10;
constexpr int N_LAUNCHES = MK_N_LAUNCHES;

constexpr int BATCH = 8, SEQ = 2048, DMODEL = 1024, MTOK = BATCH * SEQ;
constexpr int INCOLS = 4096, SSMW = 512, NGRP = 32, CH = 32  , NCHUNK = SEQ / CH  , APK = 640  ;
constexpr int PQ = 2048, NEXP = 16384;
constexpr float RMS_EPS = 1e-6f;

constexpr size_t MiB = 1u << 20;
constexpr size_t WS_CTL = 0, CTL_ZERO_BYTES = 64 * 1024;
constexpr size_t WS_BIAS = 1 * MiB;
constexpr size_t WS_PW32 = 1 * MiB + 64 * 1024;
constexpr size_t WS_KPART = 1 * MiB + 128 * 1024;
constexpr size_t WS_KG = 2 * MiB;
constexpr size_t WS_SSQ1 = 3 * MiB;
constexpr size_t WS_WIN = 6 * MiB, WS_WQ = 14 * MiB, WS_WOUT = 18 * MiB, WS_WUS = 20 * MiB, WS_WUA = 21 * MiB, WS_WGLU = 22 * MiB, WS_KS = 22 * MiB + 512 * 1024;
constexpr size_t WS_WE = 23 * MiB;
constexpr size_t WS_BP = 32 * MiB;
constexpr size_t WS_AP = 52 * MiB;
constexpr size_t WS_E = 72 * MiB;
constexpr size_t WS_H = 80 * MiB;
constexpr size_t WS_YPRE = 80 * MiB, WS_YA = 96 * MiB, WS_XG = 80 * MiB;
constexpr size_t WS_Z = 96 * MiB, ZSTRIDE_B = 16 * MiB;
constexpr size_t WS_MRG = 128 * MiB;
constexpr size_t WS_PQ = 160 * MiB;
constexpr size_t WS_IDS = 224 * MiB, WS_GTS = 232 * MiB;
constexpr size_t WS_U16 = 32 * MiB, WS_V16 = 240 * MiB;
constexpr size_t WS_YB = 224 * MiB;
constexpr size_t WS_WPK = 128 * MiB, WS_RSTD1 = 4 * MiB, WS_Y16 = 160 * MiB;
constexpr size_t WS_END = 256 * MiB;
constexpr int CW_BAR = 1024;

constexpr int RING_OFF = 0, RING_BYTES = 131072;
constexpr int LDSCTL_OFF = RING_BYTES, MISC_OFF = LDSCTL_OFF + 320;
constexpr int LDS_BYTES = 147456;

#define GAS __attribute__((address_space(1)))
#define LAS __attribute__((address_space(3)))
typedef unsigned short bf16;
typedef unsigned v4u __attribute__((ext_vector_type(4)));
typedef float f32x4 __attribute__((ext_vector_type(4)));
typedef short bf16x8 __attribute__((ext_vector_type(8)));
typedef float f32x16 __attribute__((ext_vector_type(16)));
typedef __bf16 bf16x2_t __attribute__((ext_vector_type(2)));
typedef _Float16 h2_t __attribute__((ext_vector_type(2)));
typedef GAS unsigned gu32;
#define RLX_AGENT __ATOMIC_RELAXED, __HIP_MEMORY_SCOPE_AGENT
#define LDS_WAIT() asm volatile("s_waitcnt lgkmcnt(0)" ::: "memory")
#define VM_WAIT() asm volatile("s_waitcnt vmcnt(0)" ::: "memory")
__device__ __forceinline__ unsigned f2bf(float f) { unsigned u = __builtin_bit_cast(unsigned, f); return (u + 0x7fffu + ((u >> 16) & 1u)) >> 16; }
__device__ __forceinline__ unsigned pk2(float lo, float hi) { return f2bf(lo) | (f2bf(hi) << 16); }
using pg8::cvt_pk_bf16; using pg8::bf_lo; using pg8::bf_hi; using pg8::sigmoid_f; using pg8::gelu_tanh;

#define XB_TMO      128
#define XB_XCNT(j)  (256  + 64 * (j))
#define XB_XSUB(j)  (1280 + 64 * (j))
#define XB_XGEN(j)  (2304 + 64 * (j))
#define XB_TOP      3328
#define XB_TOPGEN   3392
#define XCD_BAR_WORDS 3456
#define XB_SPIN_CAP (1u << 18)
__device__ __forceinline__ unsigned xb_ld(unsigned* p)              { return __hip_atomic_load(p, __ATOMIC_RELAXED, __HIP_MEMORY_SCOPE_AGENT); }
__device__ __forceinline__ unsigned xb_add(unsigned* p, unsigned v) { return __hip_atomic_fetch_add(p, v, __ATOMIC_RELAXED, __HIP_MEMORY_SCOPE_AGENT); }
__device__ __forceinline__ unsigned xb_xcc_id() { return (unsigned)__builtin_amdgcn_s_getreg((3 << 11) | 20) & 0xFu; }
#define XB_SPIN(cond, bar) do { unsigned _sp = 0; while (cond) { __builtin_amdgcn_s_sleep(1); \
    if ((++_sp & 255u) == 0u) { if (xb_ld(&(bar)[XB_TMO])) break; if (_sp > XB_SPIN_CAP) { atomicAdd(&(bar)[XB_TMO], 1u); break; } } } } while (0)
struct XcdBarrier { unsigned* bar; unsigned x; volatile LAS unsigned* st; };
__device__ __forceinline__ XcdBarrier xcd_barrier_post(unsigned* bar, volatile LAS unsigned* st) {
    XcdBarrier b; b.bar = bar; b.x = xb_xcc_id(); b.st = st;
    if (threadIdx.x == 0) (void)xb_add(&bar[XB_XCNT(b.x)], 1u);
    return b;
}
__device__ __forceinline__ void xcd_barrier_complete(unsigned* bar, unsigned x, unsigned& nloc, unsigned& nx) {
    const unsigned G = gridDim.x * gridDim.y * gridDim.z;
    unsigned sum, cnt, mine, sp = 0u;
    for (;;) {
        sum = 0u; cnt = 0u; mine = 0u;
#pragma unroll
        for (unsigned j = 0; j < 16; ++j) { const unsigned c = xb_ld(&bar[XB_XCNT(j)]); sum += c; cnt += (c > 0u) ? 1u : 0u; mine = (j == x) ? c : mine; }
        if (sum == G) break;
        __builtin_amdgcn_s_sleep(1);
        if ((++sp & 255u) == 0u) { if (xb_ld(&bar[XB_TMO])) break; if (sp > XB_SPIN_CAP) { atomicAdd(&bar[XB_TMO], 1u); break; } }
    }
    nloc = mine > 0u ? mine : 1u; nx = cnt > 0u ? cnt : 1u;
}
__device__ __forceinline__ void xcd_barrier(const XcdBarrier& b) {
    asm volatile("s_waitcnt vmcnt(0)" ::: "memory");
    __syncthreads();
    if (threadIdx.x == 0) {
        unsigned* bar = b.bar;
        __builtin_amdgcn_s_waitcnt(0);
        unsigned nloc = b.st[0], nx = b.st[1];
        if (nloc == 0u) { xcd_barrier_complete(bar, b.x, nloc, nx); b.st[0] = nloc; b.st[1] = nx; }
        const unsigned old = xb_add(&bar[XB_XSUB(b.x)], 1u);
        const unsigned gen = old / nloc;
        if (old + 1u == (gen + 1u) * nloc) {
            __builtin_amdgcn_fence(__ATOMIC_RELEASE, "agent");
            asm volatile("s_waitcnt vmcnt(0)" ::: "memory");
            const unsigned og = xb_add(&bar[XB_TOP], 1u);
            const unsigned tg = og / nx;
            if (og + 1u == (tg + 1u) * nx) xb_add(&bar[XB_TOPGEN], 1u);
            else XB_SPIN(xb_ld(&bar[XB_TOPGEN]) == tg, bar);
            __builtin_amdgcn_fence(__ATOMIC_ACQUIRE, "agent");
            xb_add(&bar[XB_XGEN(b.x)], 1u);
            asm volatile("s_waitcnt vmcnt(0)" ::: "memory");
        } else {
            XB_SPIN(xb_ld(&bar[XB_XGEN(b.x)]) == gen, bar);
            __builtin_amdgcn_fence(__ATOMIC_ACQUIRE, "agent");
            asm volatile("s_waitcnt vmcnt(0)" ::: "memory");
        }
    }
    __syncthreads();
}

__device__ __forceinline__ float wave_sum(float v) {
#pragma unroll
    for (int o = 1; o < 64; o <<= 1) v += __shfl_xor(v, o);
    return v;
}

namespace pg8 {
struct EpiIn {
    static constexpr bool PERM = true;
    bf16_t* zbase; bf16_t* AP; float* kpart;
    __device__ __forceinline__ void operator()(const f32x4 (&acc)[2][2][4][2], const Unit& u, int wr, int wc, int fr, int fq) const {
        const int t = u.pn >> 1, colt = (u.pn & 1) * 256;
        const int row0 = u.pm * BM + wr * 64 + fr, col0 = colt + wc * 32 + 8 * fq;
        if (t == 0) {
#pragma unroll
            for (int ai = 0; ai < 2; ++ai)
#pragma unroll
                for (int m = 0; m < 4; ++m) { const int r = row0 + ai * HALF + m * 16, b = r >> 11, l = r & 2047;
#pragma unroll
                    for (int bj = 0; bj < 2; ++bj) { const int c = col0 + bj * HALF, g = c >> 4, hi0 = c & 15;
                        const f32x4 v0 = acc[ai][bj][m][0], v1 = acc[ai][bj][m][1];
                        u32x4 w; w.x = cvt_pk_bf16(v0[0], v0[1]); w.y = cvt_pk_bf16(v0[2], v0[3]); w.z = cvt_pk_bf16(v1[0], v1[1]); w.w = cvt_pk_bf16(v1[2], v1[3]);
                        *(u32x4*)(AP + (size_t)(g * 512 + b * 64 + (l >> 5)) * 640 + (l & 31) * 16 + hi0) = w; } }
        } else {
            bf16_t* base = zbase + (size_t)t * (16u * 1024u * 1024u / 2u);
            const float sc = (t == 1) ? 0.125f * 1.4426950408889634f : 1.0f;
#pragma unroll
            for (int ai = 0; ai < 2; ++ai)
#pragma unroll
                for (int m = 0; m < 4; ++m) { bf16_t* rowp = base + (size_t)(row0 + ai * HALF + m * 16) * 512 + col0;
#pragma unroll
                    for (int bj = 0; bj < 2; ++bj) { f32x4 v0 = acc[ai][bj][m][0], v1 = acc[ai][bj][m][1];
                        if (t >= 4) {
#pragma unroll
                            for (int e = 0; e < 4; ++e) { v0[e] = sigmoid_f(v0[e]); v1[e] = sigmoid_f(v1[e]); }
                        } else { v0 = v0 * sc; v1 = v1 * sc; }
                        u32x4 w; w.x = cvt_pk_bf16(v0[0], v0[1]); w.y = cvt_pk_bf16(v0[2], v0[3]); w.z = cvt_pk_bf16(v1[0], v1[1]); w.w = cvt_pk_bf16(v1[2], v1[3]);
                        *(u32x4*)(rowp + bj * HALF) = w; } }
            if (t == 2) {
#pragma unroll
                for (int bj = 0; bj < 2; ++bj)
#pragma unroll
                    for (int n = 0; n < 2; ++n) { f32x4 s = (f32x4){0.f, 0.f, 0.f, 0.f};
#pragma unroll
                        for (int ai = 0; ai < 2; ++ai)
#pragma unroll
                            for (int m = 0; m < 4; ++m) s += acc[ai][bj][m][n];
#pragma unroll
                        for (int e = 0; e < 4; ++e) { float x = s[e]; x += __shfl_xor(x, 1); x += __shfl_xor(x, 2); x += __shfl_xor(x, 4); x += __shfl_xor(x, 8); s[e] = x; }
                        if (fr == 0) *(f32x4*)(kpart + (size_t)(u.pm * 2 + wr) * 512 + col0 + bj * HALF + 4 * n) = s; }
            }
        }
    }
};
struct EpiE {
    static constexpr bool PERM = false;
    float* E;
    __device__ __forceinline__ void operator()(const f32x4 (&acc)[2][2][4][2], const Unit& u, int wr, int wc, int fr, int fq) const {
        const int row0 = u.pm * BM + wr * 64 + fr, col0 = wc * 32 + 4 * fq;
#pragma unroll
        for (int ai = 0; ai < 2; ++ai)
#pragma unroll
            for (int m = 0; m < 4; ++m) { float* rowp = E + (size_t)(row0 + ai * HALF + m * 16) * 128 + col0;
#pragma unroll
                for (int n = 0; n < 2; ++n) *(f32x4*)(rowp + n * 16) = acc[ai][0][m][n]; }
    }
};
struct EpiY {
    static constexpr bool PERM = true;
    bf16_t* Y;
    __device__ __forceinline__ void operator()(const f32x4 (&acc)[2][2][4][2], const Unit& u, int wr, int wc, int fr, int fq) const {
        const int row0 = u.pm * BM + wr * 64 + fr, col0 = u.pn * BM + wc * 32 + 8 * fq;
#pragma unroll
        for (int ai = 0; ai < 2; ++ai)
#pragma unroll
            for (int m = 0; m < 4; ++m) { const int r = row0 + ai * HALF + m * 16, g = r >> 9, b = (r >> 6) & 7, c = r & 63;
#pragma unroll
                for (int bj = 0; bj < 2; ++bj) { const int cc = col0 + bj * HALF, j = cc >> 4, ho0 = cc & 15;
                    f32x4 v0 = acc[ai][bj][m][0], v1 = acc[ai][bj][m][1];
#pragma unroll
                    for (int e = 0; e < 4; ++e) { v0[e] = gelu_tanh(v0[e]); v1[e] = gelu_tanh(v1[e]); }
                    u32x4 w; w.x = cvt_pk_bf16(v0[0], v0[1]); w.y = cvt_pk_bf16(v0[2], v0[3]); w.z = cvt_pk_bf16(v1[0], v1[1]); w.w = cvt_pk_bf16(v1[2], v1[3]);
                    *(u32x4*)(Y + (size_t)(b * 2048 + c * 32 + j) * 512 + g * 16 + ho0) = w; } }
    }
};
struct EpiGlu {
    static constexpr bool PERM = true;
    const bf16_t* Yp; bf16_t* Ya; const float* bias;
    __device__ __forceinline__ void operator()(const f32x4 (&acc)[2][2][4][2], const Unit& u, int wr, int wc, int fr, int fq) const {
        const int row0 = u.pm * BM + wr * 64 + fr, col0 = u.pn * BM + wc * 32 + 8 * fq;
        f32x4 bv[2][2];
#pragma unroll
        for (int bj = 0; bj < 2; ++bj)
#pragma unroll
            for (int n = 0; n < 2; ++n) bv[bj][n] = *(const f32x4*)(bias + col0 + bj * HALF + 4 * n);
#pragma unroll
        for (int ai = 0; ai < 2; ++ai)
#pragma unroll
            for (int m = 0; m < 4; ++m) { const size_t off = (size_t)(row0 + ai * HALF + m * 16) * 512 + col0;
#pragma unroll
                for (int bj = 0; bj < 2; ++bj) { const f32x4 z0 = acc[ai][bj][m][0] + bv[bj][0], z1 = acc[ai][bj][m][1] + bv[bj][1];
                    const u32x4 y = *(const u32x4*)(Yp + off + bj * HALF);
                    u32x4 w; w.x = cvt_pk_bf16(bf_lo(y.x) * sigmoid_f(z0[0]), bf_hi(y.x) * sigmoid_f(z0[1])); w.y = cvt_pk_bf16(bf_lo(y.y) * sigmoid_f(z0[2]), bf_hi(y.y) * sigmoid_f(z0[3]));
                    w.z = cvt_pk_bf16(bf_lo(y.z) * sigmoid_f(z1[0]), bf_hi(y.z) * sigmoid_f(z1[1])); w.w = cvt_pk_bf16(bf_lo(y.w) * sigmoid_f(z1[2]), bf_hi(y.w) * sigmoid_f(z1[3]));
                    *(u32x4*)(Ya + off + bj * HALF) = w; } }
    }
};
template <int ADD> struct EpiMrg {
    static constexpr bool PERM = true;
    const bf16_t* G0; bf16_t* Mrg;
    __device__ __forceinline__ void operator()(const f32x4 (&acc)[2][2][4][2], const Unit& u, int wr, int wc, int fr, int fq) const {
        const int row0 = u.pm * BM + wr * 64 + fr, cin = wc * 32 + 8 * fq;
        const bf16_t* gb = G0 + (size_t)(u.pn >> 1) * (16u * 1024u * 1024u / 2u) + (u.pn & 1) * 256 + cin;
#pragma unroll
        for (int ai = 0; ai < 2; ++ai)
#pragma unroll
            for (int m = 0; m < 4; ++m) { const int r = row0 + ai * HALF + m * 16;
#pragma unroll
                for (int bj = 0; bj < 2; ++bj) {
#if defined(ABL_NO_SSM) || defined(ABL_NO_ATT)
#if defined(ABL_NO_SSM)
                    constexpr bool kill = (ADD == 0);
#else
                    constexpr bool kill = (ADD == 1);
#endif
                    const f32x4 a0 = kill ? (f32x4){0.f, 0.f, 0.f, 0.f} : acc[ai][bj][m][0], a1 = kill ? (f32x4){0.f, 0.f, 0.f, 0.f} : acc[ai][bj][m][1];
#else
                    const f32x4 a0 = acc[ai][bj][m][0], a1 = acc[ai][bj][m][1];
#endif
                    const u32x4 gt = *(const u32x4*)(gb + (size_t)r * 512 + bj * HALF);
                    bf16_t* mp = Mrg + (size_t)r * 1024 + u.pn * BM + cin + bj * HALF;
                    float o[8] = { bf_lo(gt.x) * a0[0], bf_hi(gt.x) * a0[1], bf_lo(gt.y) * a0[2], bf_hi(gt.y) * a0[3], bf_lo(gt.z) * a1[0], bf_hi(gt.z) * a1[1], bf_lo(gt.w) * a1[2], bf_hi(gt.w) * a1[3] };
                    if (ADD) { const u32x4 p = *(const u32x4*)mp; o[0] += bf_lo(p.x); o[1] += bf_hi(p.x); o[2] += bf_lo(p.y); o[3] += bf_hi(p.y); o[4] += bf_lo(p.z); o[5] += bf_hi(p.z); o[6] += bf_lo(p.w); o[7] += bf_hi(p.w); }
                    u32x4 w; w.x = cvt_pk_bf16(o[0], o[1]); w.y = cvt_pk_bf16(o[2], o[3]); w.z = cvt_pk_bf16(o[4], o[5]); w.w = cvt_pk_bf16(o[6], o[7]);
                    *(u32x4*)mp = w; } }
    }
};
struct EpiMrgDual {
    static constexpr bool PERM = true;
    EpiMrg<0> a; EpiMrg<1> b;
    __device__ __forceinline__ void operator()(const f32x4 (&acc)[2][2][4][2], const Unit& u, int wr, int wc, int fr, int fq) const { if (u.w == 0) a(acc, u, wr, wc, fr, fq); else b(acc, u, wr, wc, fr, fq); }
};
struct EpiX1 {
    static constexpr bool PERM = true;
    const float* X; float* X1; bf16_t* XG; const float* g2; float* ssq;
    __device__ __forceinline__ void operator()(const f32x4 (&acc)[2][2][4][2], const Unit& u, int wr, int wc, int fr, int fq) const {
        const int row0 = u.pm * BM + wr * 64 + fr, col0 = u.pn * BM + wc * 32 + 8 * fq;
        f32x4 gv[2][2];
#pragma unroll
        for (int bj = 0; bj < 2; ++bj)
#pragma unroll
            for (int n = 0; n < 2; ++n) gv[bj][n] = *(const f32x4*)(g2 + col0 + bj * HALF + 4 * n);
#pragma unroll
        for (int ai = 0; ai < 2; ++ai)
#pragma unroll
            for (int m = 0; m < 4; ++m) { const int r = row0 + ai * HALF + m * 16; const size_t off = (size_t)r * 1024 + col0; float s = 0.f;
#pragma unroll
                for (int bj = 0; bj < 2; ++bj) {
                    #ifdef ABL_NO_MIX
                    const f32x4 x0 = *(const f32x4*)(X + off + bj * HALF), x1 = *(const f32x4*)(X + off + bj * HALF + 4);
#else
                    const f32x4 x0 = *(const f32x4*)(X + off + bj * HALF) + acc[ai][bj][m][0], x1 = *(const f32x4*)(X + off + bj * HALF + 4) + acc[ai][bj][m][1];
#endif
                    *(f32x4*)(X1 + off + bj * HALF) = x0; *(f32x4*)(X1 + off + bj * HALF + 4) = x1;
                    s += (x0[0] * x0[0] + x0[1] * x0[1]) + (x0[2] * x0[2] + x0[3] * x0[3]) + (x1[0] * x1[0] + x1[1] * x1[1]) + (x1[2] * x1[2] + x1[3] * x1[3]);
                    const f32x4 a = x0 * gv[bj][0], b = x1 * gv[bj][1];
                    u32x4 w; w.x = cvt_pk_bf16(a[0], a[1]); w.y = cvt_pk_bf16(a[2], a[3]); w.z = cvt_pk_bf16(b[0], b[1]); w.w = cvt_pk_bf16(b[2], b[3]);
                    *(u32x4*)(XG + off + bj * HALF) = w; }
                s += __shfl_xor(s, 16); s += __shfl_xor(s, 32);
                if (fq == 0) ssq[(size_t)r * 16 + u.pn * 4 + wc] = s; }
    }
};
struct EpiPlain {
    static constexpr bool PERM = true;
    bf16_t* O; int ldc;
    __device__ __forceinline__ void operator()(const f32x4 (&acc)[2][2][4][2], const Unit& u, int wr, int wc, int fr, int fq) const {
        const int row0 = u.pm * BM + wr * 64 + fr, col0 = u.pn * BM + wc * 32 + 8 * fq;
#pragma unroll
        for (int ai = 0; ai < 2; ++ai)
#pragma unroll
            for (int m = 0; m < 4; ++m) { bf16_t* rowp = O + (size_t)(row0 + ai * HALF + m * 16) * ldc + col0;
#pragma unroll
                for (int bj = 0; bj < 2; ++bj) { const f32x4 v0 = acc[ai][bj][m][0], v1 = acc[ai][bj][m][1];
                    u32x4 w; w.x = cvt_pk_bf16(v0[0], v0[1]); w.y = cvt_pk_bf16(v0[2], v0[3]); w.z = cvt_pk_bf16(v1[0], v1[1]); w.w = cvt_pk_bf16(v1[2], v1[3]);
                    *(u32x4*)(rowp + bj * HALF) = w; } }
    }
};
}
struct Frame {
    LAS unsigned char* lds;
    int tid, lane, wave, vcu, G;
};

__device__ __forceinline__ void p0_transpose_item(const float* W, int K, int N, bf16* WT, LAS float* scr, int item, int lane) {
    const int nblk = N / 32, kb = item / nblk, nb = item % nblk, k0 = 64 * kb, n0 = 32 * nb;
    float wv[32];
#pragma unroll
    for (int i = 0; i < 32; ++i) { const int kk = 2 * i + (lane >> 5); wv[i] = W[(size_t)(k0 + kk) * N + n0 + (lane & 31)]; }
#pragma unroll
    for (int i = 0; i < 32; ++i) { const int kk = 2 * i + (lane >> 5); scr[kk * 33 + (lane & 31)] = wv[i]; }
    LDS_WAIT(); asm volatile("" ::: "memory");
    const int c = lane & 7;
#pragma unroll
    for (int j = 0; j < 4; ++j) { const int n = (lane >> 3) + 8 * j; const LAS float* s = scr + (8 * c) * 33 + n;
        v4u o; o.x = pk2(s[0 * 33], s[1 * 33]); o.y = pk2(s[2 * 33], s[3 * 33]); o.z = pk2(s[4 * 33], s[5 * 33]); o.w = pk2(s[6 * 33], s[7 * 33]);
        *(GAS v4u*)(WT + (size_t)(n0 + n) * K + k0 + 8 * c) = o; }
    LDS_WAIT(); asm volatile("" ::: "memory");
}
__device__ __forceinline__ void rms_row_to_bf16(const float* xrow, const float* g, bf16* orow, int lane) {
    const GAS f32x4* xr = (const GAS f32x4*)xrow + lane; const GAS f32x4* gr = (const GAS f32x4*)g + lane;
    f32x4 v[4]; float s = 0.f;
#pragma unroll
    for (int j = 0; j < 4; ++j) { v[j] = xr[64 * j]; s += (v[j].x * v[j].x + v[j].y * v[j].y) + (v[j].z * v[j].z + v[j].w * v[j].w); }
    const float rstd = 1.0f / sqrtf(wave_sum(s) * (1.f / DMODEL) + RMS_EPS);
    GAS unsigned long long* o8 = (GAS unsigned long long*)orow + lane;
#pragma unroll
    for (int j = 0; j < 4; ++j) { const f32x4 gg = gr[64 * j];
        o8[64 * j] = (unsigned long long)pk2(v[j].x * rstd * gg.x, v[j].y * rstd * gg.y) | ((unsigned long long)pk2(v[j].z * rstd * gg.z, v[j].w * rstd * gg.w) << 32); }
}
__device__ __forceinline__ void rms_rows4_to_bf16(const float* x, const float* g, bf16* out, int m, int stride, int lane) {
    f32x4 v[4][4];
#pragma unroll
    for (int k = 0; k < 4; ++k) { const int mm = (m + k * stride < MTOK) ? m + k * stride : m; const GAS f32x4* xr = (const GAS f32x4*)(x + (size_t)mm * DMODEL) + lane;
#pragma unroll
        for (int j = 0; j < 4; ++j) v[k][j] = xr[64 * j]; }
    const GAS f32x4* gr = (const GAS f32x4*)g + lane; f32x4 gg[4];
#pragma unroll
    for (int j = 0; j < 4; ++j) gg[j] = gr[64 * j];
#pragma unroll
    for (int k = 0; k < 4; ++k) { if (m + k * stride >= MTOK) break; float s = 0.f;
#pragma unroll
        for (int j = 0; j < 4; ++j) s += (v[k][j].x * v[k][j].x + v[k][j].y * v[k][j].y) + (v[k][j].z * v[k][j].z + v[k][j].w * v[k][j].w);
        const float rstd = 1.0f / sqrtf(wave_sum(s) * (1.f / DMODEL) + RMS_EPS);
        GAS unsigned long long* o8 = (GAS unsigned long long*)(out + (size_t)(m + k * stride) * DMODEL) + lane;
#pragma unroll
        for (int j = 0; j < 4; ++j) o8[64 * j] = (unsigned long long)pk2(v[k][j].x * rstd * gg[j].x, v[k][j].y * rstd * gg[j].y) | ((unsigned long long)pk2(v[k][j].z * rstd * gg[j].z, v[k][j].w * rstd * gg[j].w) << 32); }
}
struct cpx { float r, i; };
__device__ __forceinline__ cpx cmul(cpx a, cpx b) { return cpx{a.r * b.r - a.i * b.i, a.r * b.i + a.i * b.r}; }
__device__ __forceinline__ cpx cpow_(float ar, float ai, float dt, int n) { const float e = expf(ar * dt * (float)n); const float ang = ai * dt * (float)n; return cpx{e * cosf(ang), e * sinf(ang)}; }
__device__ __forceinline__ void ssm_table_task(int g, int j, int lane, LAS float* scr, const float* a_re, const float* a_im, const float* log_dt, const float* b_re, const float* b_im,
                                               const float* c_re, const float* c_im, float* Kg, bf16* WE, bf16* BP, float* pw32) {
    const int p = lane;
    const float dt = expf(log_dt[g]), ar = a_re[g * 64 + p], ai = a_im[g * 64 + p];
#define pw(n) cpow_(ar, ai, dt, (n))
    const cpx lb = pw(1);
    const float den = ar * ar + ai * ai;
    const cpx coef = cpx{((lb.r - 1.f) * ar + lb.i * ai) / den, (lb.i * ar - (lb.r - 1.f) * ai) / den};
    const cpx pj = pw(j), pe = pw(31 - j), pv = pw(j + 1);
    unsigned wer[8], wei[8];
#pragma unroll
    for (int h2 = 0; h2 < 8; ++h2) { float er[2], ei[2];
#pragma unroll
        for (int q = 0; q < 2; ++q) { const int hi = 2 * h2 + q;
            const cpx bb = cmul(coef, cpx{b_re[(g * 64 + p) * 16 + hi], b_im[(g * 64 + p) * 16 + hi]});
            const cpx w = cmul(pj, bb); scr[(p * 16 + hi) * 2] = w.r; scr[(p * 16 + hi) * 2 + 1] = w.i;
            const cpx e = cmul(pe, bb); er[q] = e.r; ei[q] = e.i; }
        wer[h2] = pk2(er[0], er[1]); wei[h2] = pk2(ei[0], ei[1]); }
    { bf16* w0 = WE + ((size_t)(g * 256 + p) * 512 + j * 16); bf16* w1 = WE + ((size_t)(g * 256 + 64 + p) * 512 + j * 16);
      *(GAS v4u*)w0 = (v4u){wer[0], wer[1], wer[2], wer[3]}; *(GAS v4u*)(w0 + 8) = (v4u){wer[4], wer[5], wer[6], wer[7]};
      *(GAS v4u*)w1 = (v4u){wei[0], wei[1], wei[2], wei[3]}; *(GAS v4u*)(w1 + 8) = (v4u){wei[4], wei[5], wei[6], wei[7]};
      bf16* z0 = WE + ((size_t)(g * 256 + 128 + p) * 512 + j * 16); bf16* z1 = WE + ((size_t)(g * 256 + 192 + p) * 512 + j * 16); const v4u z = (v4u){0u, 0u, 0u, 0u};
      *(GAS v4u*)z0 = z; *(GAS v4u*)(z0 + 8) = z; *(GAS v4u*)z1 = z; *(GAS v4u*)(z1 + 8) = z; }
#pragma unroll 4
    for (int ho = 0; ho < 16; ++ho) { const cpx cv = cmul(cpx{c_re[(g * 16 + ho) * 64 + p], c_im[(g * 16 + ho) * 64 + p]}, pv);
        bf16* row = BP + ((size_t)(g * 512 + j * 16 + ho) * APK + 512);
        row[p] = (bf16)f2bf(cv.r); row[64 + p] = (bf16)f2bf(-cv.i); }
    if (j == 0) { const cpx p32 = pw(32); pw32[g * 128 + p] = p32.r; pw32[g * 128 + 64 + p] = p32.i; }
    LDS_WAIT(); asm volatile("" ::: "memory");
    { const int ho = lane >> 2, h4 = (lane & 3) * 4; float a0 = 0.f, a1 = 0.f, a2 = 0.f, a3 = 0.f;
      const float* cr = c_re + (g * 16 + ho) * 64; const float* ci = c_im + (g * 16 + ho) * 64;
#pragma unroll 4
      for (int pp = 0; pp < 64; ++pp) { const float r_ = cr[pp], i_ = ci[pp]; const LAS float* w = scr + (pp * 16 + h4) * 2;
          a0 += r_ * w[0] - i_ * w[1]; a1 += r_ * w[2] - i_ * w[3]; a2 += r_ * w[4] - i_ * w[5]; a3 += r_ * w[6] - i_ * w[7]; }
      *(GAS f32x4*)(Kg + ((size_t)(g * 32 + j) * 256 + ho * 16 + h4)) = (f32x4){a0, a1, a2, a3}; }
    LDS_WAIT(); asm volatile("" ::: "memory");
#undef pw
}

__device__ __forceinline__ float vmaxf(float a, float b) { float r; asm("v_max_f32_e32 %0, %1, %2" : "=v"(r) : "v"(a), "v"(b)); return r; }
__device__ __forceinline__ float vminf(float a, float b) { float r; asm("v_min_f32_e32 %0, %1, %2" : "=v"(r) : "v"(a), "v"(b)); return r; }
__device__ __forceinline__ float selhi(float lo, float hi) { float r; asm("v_cndmask_b32_e64 %0, %1, %2, %3" : "=v"(r) : "v"(lo), "v"(hi), "s"(0xFFFFFFFF00000000ull)); return r; }
#define CE_DESC(a, b) do { const float hi_ = vmaxf(a, b), lo_ = vminf(a, b); a = hi_; b = lo_; } while (0)
__device__ __forceinline__ void sort16_desc(float (&v)[16]) {
#pragma unroll
    for (int k = 2; k <= 16; k <<= 1)
#pragma unroll
        for (int j = k >> 1; j > 0; j >>= 1)
#pragma unroll
            for (int i = 0; i < 16; ++i) { const int l = i ^ j; if (l > i) { if ((i & k) == 0) CE_DESC(v[i], v[l]); else CE_DESC(v[l], v[i]); } }
}
__device__ __forceinline__ void bitonic_merge16_desc(float (&v)[16]) {
#pragma unroll
    for (int j = 8; j > 0; j >>= 1)
#pragma unroll
        for (int i = 0; i < 16; ++i) { const int l = i ^ j; if (l > i) CE_DESC(v[i], v[l]); }
}
__device__ __forceinline__ void merge_top16(float (&a)[16], const float (&b)[16]) {
#pragma unroll
    for (int i = 0; i < 16; ++i) a[i] = vmaxf(a[i], b[15 - i]);
    bitonic_merge16_desc(a);
}
__device__ __forceinline__ void merge_partner_top16(float (&a)[16]) {
    float p[16];
#pragma unroll
    for (int i = 0; i < 16; ++i) { const unsigned x = __float_as_uint(a[15 - i]); auto rr = __builtin_amdgcn_permlane32_swap(x, x, false, false); p[i] = selhi(__uint_as_float(rr[1]), __uint_as_float(rr[0])); }
#pragma unroll
    for (int i = 0; i < 16; ++i) a[i] = vmaxf(a[i], p[i]);
    bitonic_merge16_desc(a);
}
__device__ __forceinline__ void topk_half(int half, const bf16x8 (&qf)[8], int r32, int hi, const LAS unsigned char* ksl, float (&top)[16]) {
#pragma unroll 1
    for (int kt = 0; kt < 4; ++kt) {
        f32x16 acc = f32x16{};
        const int row = half * 128 + kt * 32 + r32; const LAS unsigned char* rp = ksl + row * 256; const int sw = row & 15;
#pragma unroll
        for (int ks = 0; ks < 8; ++ks) { const bf16x8 a = *(const LAS bf16x8*)(rp + (((2 * ks + hi) ^ sw) << 4));
            acc = __builtin_amdgcn_mfma_f32_32x32x16_bf16(a, qf[ks], acc, 0, 0, 0); }
        float grp[16];
#pragma unroll
        for (int r = 0; r < 16; ++r) { const unsigned key = (unsigned)(kt * 32 + (r & 3) + 8 * (r >> 2)) + 4u * (unsigned)hi; grp[r] = __uint_as_float((__float_as_uint(acc[r]) & ~127u) | key); }
        sort16_desc(grp);
        if (kt == 0) {
#pragma unroll
            for (int i = 0; i < 16; ++i) top[i] = grp[i];
        } else merge_top16(top, grp);
    }
    merge_partner_top16(top);
}
__device__ __forceinline__ void topk_task(int tt, int hd, int lane, LAS unsigned char* scr, const bf16* PQb, const LAS unsigned char* ksl, const float* ssq1, int* ids, float* gts, float* rstd1) {
    const int r32 = lane & 31, hi = lane >> 5; const bool hib = hi != 0;
    const int token = tt * 32 + r32;
    float v0_[16], v1_[16];
    bf16x8 qf0[8], qf1[8];
#pragma unroll
    for (int ks = 0; ks < 8; ++ks) { qf0[ks] = *(const GAS bf16x8*)(PQb + (size_t)token * PQ + hd * 256 + ks * 16 + hi * 8); qf1[ks] = *(const GAS bf16x8*)(PQb + (size_t)token * PQ + hd * 256 + 128 + ks * 16 + hi * 8); }
    topk_half(0, qf0, r32, hi, ksl, v0_);
    topk_half(1, qf1, r32, hi, ksl, v1_);
#define v_SEL(h, i) ((h) ? v1_[i] : v0_[i])
    LAS unsigned char* slot = scr + lane * 32;
    { v4u d0, d1;
#define PK4(h, k) ((__float_as_uint(v_SEL(h, 4 * (k))) & 127u) | ((__float_as_uint(v_SEL(h, 4 * (k) + 1)) & 127u) << 8) | ((__float_as_uint(v_SEL(h, 4 * (k) + 2)) & 127u) << 16) | ((__float_as_uint(v_SEL(h, 4 * (k) + 3)) & 127u) << 24))
      d0 = (v4u){PK4(0, 0), PK4(0, 1), PK4(0, 2), PK4(0, 3)}; d1 = (v4u){PK4(1, 0), PK4(1, 1), PK4(1, 2), PK4(1, 3)};
#undef PK4
      *(LAS v4u*)slot = d0; *(LAS v4u*)(slot + 16) = d1; }
    float a[16], b[16];
#pragma unroll
    for (int i = 0; i < 16; ++i) { a[i] = selhi(v0_[i], v1_[i]); b[i] = selhi(v1_[i], v0_[i]); }
    const unsigned obit = (unsigned)hi << 8;
#define CAND(i, j) __uint_as_float((__float_as_uint(a[i] + b[j]) & ~511u) | obit | (unsigned)(((i) << 4) | (j)))
    const float NEGBIG = -3.0e38f;
    float g0[16], g1[16];
#pragma unroll
    for (int j = 1; j < 16; ++j) g0[j - 1] = CAND(0, j);
    g0[15] = CAND(1, 2);
    g1[0] = CAND(1, 3); g1[1] = CAND(1, 4); g1[2] = CAND(1, 5); g1[3] = CAND(1, 6); g1[4] = CAND(1, 7); g1[5] = CAND(2, 3); g1[6] = CAND(2, 4);
    { const float c0 = CAND(0, 0), c1 = CAND(1, 1), c2 = CAND(2, 2), c3 = CAND(3, 3);
      g1[7] = selhi(c0, NEGBIG); g1[8] = selhi(c1, NEGBIG); g1[9] = selhi(c2, NEGBIG); g1[10] = selhi(c3, NEGBIG); }
#pragma unroll
    for (int i = 11; i < 16; ++i) g1[i] = NEGBIG;
#undef CAND
    sort16_desc(g0); sort16_desc(g1); merge_top16(g0, g1); merge_partner_top16(g0);
    float rstd;
    { const GAS f32x4* sp = (const GAS f32x4*)(ssq1 + (size_t)token * 16); const f32x4 s0 = sp[0], s1 = sp[1], s2 = sp[2], s3 = sp[3];
      const float ss = ((s0.x + s0.y) + (s0.z + s0.w)) + ((s1.x + s1.y) + (s1.z + s1.w)) + ((s2.x + s2.y) + (s2.z + s2.w)) + ((s3.x + s3.y) + (s3.z + s3.w));
      rstd = 1.0f / sqrtf(ss * (1.f / DMODEL) + RMS_EPS); }
    if (hd == 0 && !hib) rstd1[token] = rstd;
    float ex[16], esum = 0.f; const float sc = rstd * 1.4426950409f;
#pragma unroll
    for (int k = 0; k < 16; ++k) { ex[k] = __builtin_amdgcn_exp2f((g0[k] - g0[0]) * sc); esum += ex[k]; }
    const float inv = 1.0f / esum;
    int eid[8]; float gv[8];
#pragma unroll
    for (int k = 0; k < 8; ++k) { const float wv = selhi(g0[k], g0[8 + k]); const float ev = selhi(ex[k], ex[8 + k]);
        const unsigned tag = __float_as_uint(wv) & 511u, o = tag >> 8, i = (tag >> 4) & 15u, j = tag & 15u; const unsigned i1 = o ? j : i, i2 = o ? i : j;
        const unsigned k1 = slot[i1], k2 = slot[16 + i2];
        eid[k] = (int)(k1 * 128u + k2); gv[k] = ev * inv; }
    { int* ip = ids + (size_t)token * 128 + hd * 16 + 8 * hi; float* gp = gts + (size_t)token * 128 + hd * 16 + 8 * hi;
      *(GAS v4u*)ip = (v4u){(unsigned)eid[0], (unsigned)eid[1], (unsigned)eid[2], (unsigned)eid[3]}; *(GAS v4u*)(ip + 4) = (v4u){(unsigned)eid[4], (unsigned)eid[5], (unsigned)eid[6], (unsigned)eid[7]};
      *(GAS f32x4*)gp = (f32x4){gv[0], gv[1], gv[2], gv[3]}; *(GAS f32x4*)(gp + 4) = (f32x4){gv[4], gv[5], gv[6], gv[7]}; }
    LDS_WAIT(); asm volatile("" ::: "memory");
}


__device__ __forceinline__ float dot2bf(unsigned a, unsigned b, float c) { return __builtin_amdgcn_fdot2_f32_bf16(__builtin_bit_cast(bf16x2_t, a), __builtin_bit_cast(bf16x2_t, b), c, false); }
__device__ __forceinline__ h2_t fma_h2(unsigned v, h2_t w, h2_t acc) { return __builtin_elementwise_fma(__builtin_bit_cast(h2_t, v), w, acc); }
__device__ __forceinline__ unsigned fp8lo_bf(unsigned w, float sc) { return __builtin_bit_cast(unsigned, __builtin_amdgcn_cvt_scalef32_pk_bf16_fp8((int)w, sc, false)); }
__device__ __forceinline__ unsigned fp8hi_bf(unsigned w, float sc) { return __builtin_bit_cast(unsigned, __builtin_amdgcn_cvt_scalef32_pk_bf16_fp8((int)w, sc, true)); }
__device__ __forceinline__ h2_t fp8lo_h(unsigned w, float sc) { return __builtin_amdgcn_cvt_scalef32_pk_f16_fp8((int)w, sc, false); }
__device__ __forceinline__ h2_t fp8hi_h(unsigned w, float sc) { return __builtin_amdgcn_cvt_scalef32_pk_f16_fp8((int)w, sc, true); }
__device__ __forceinline__ unsigned pack_fp8x4(float a, float b, float c, float d) { int w = __builtin_amdgcn_cvt_pk_fp8_f32(a, b, 0, false); w = __builtin_amdgcn_cvt_pk_fp8_f32(c, d, w, true); return (unsigned)w; }
constexpr float U8_SCALE = 32.0f, V8_SCALE = 4.0f;
constexpr int PA_CAP = 464;
constexpr float X8_SCALE = 8.0f;
typedef int v8i_t __attribute__((ext_vector_type(8)));
typedef unsigned v2u __attribute__((ext_vector_type(2)));
struct TokB { v8i_t b[8]; };
struct RowsA { const unsigned char* p0; const unsigned char* p1; };
__device__ __forceinline__ int pa_tok(unsigned tl, int tb, int nwg) { return ((tl < 4u) ? tb : nwg) + (int)(tl & 3u); }
__device__ __forceinline__ RowsA pa_rows(int b, int n, int lane, const LAS unsigned* list, const unsigned char* U8) {
    const int i0 = b * 16 + (lane >> 3), r8 = lane >> 3, ps = lane & 7;
    const unsigned e0 = list[i0 < n ? i0 : 0], e1 = list[i0 + 8 < n ? i0 + 8 : 0];
    RowsA R; R.p0 = U8 + (size_t)(e0 & 0x3fffu) * 1024 + ((ps ^ r8) * 16); R.p1 = U8 + (size_t)(e1 & 0x3fffu) * 1024 + ((ps ^ r8 ^ 1) * 16);
    return R;
}
__device__ __forceinline__ void pa_dma(const RowsA& R, int c, LAS unsigned char* slot) {
#pragma unroll
    for (int ll = 0; ll < 2; ++ll) {
        __builtin_amdgcn_global_load_lds((const unsigned*)(R.p0 + (2 * c + ll) * 128), (LAS unsigned*)(slot + (ll * 2) * 1024), 16, 0, 0);
        __builtin_amdgcn_global_load_lds((const unsigned*)(R.p1 + (2 * c + ll) * 128), (LAS unsigned*)(slot + (ll * 2 + 1) * 1024), 16, 0, 0); }
}
#define PA_VWAIT(n) asm volatile("s_waitcnt vmcnt(" #n ")" ::: "memory")
__device__ __forceinline__ void pa_mma(f32x4& acc0, f32x4& acc1, const TokB& X, int c, const LAS unsigned char* slot, int roff) {
    const v4u a0 = *(const LAS v4u*)(slot + roff), a1 = *(const LAS v4u*)(slot + (roff ^ 16)), a2 = *(const LAS v4u*)(slot + 2048 + roff), a3 = *(const LAS v4u*)(slot + 2048 + (roff ^ 16));
    LDS_WAIT(); asm volatile("" ::: "memory");
    acc0 = __builtin_amdgcn_mfma_scale_f32_16x16x128_f8f6f4((v8i_t){(int)a0.x, (int)a0.y, (int)a0.z, (int)a0.w, (int)a1.x, (int)a1.y, (int)a1.z, (int)a1.w}, X.b[2 * c], acc0, 0, 0, 0, 0, 0, 0);
    acc1 = __builtin_amdgcn_mfma_scale_f32_16x16x128_f8f6f4((v8i_t){(int)a2.x, (int)a2.y, (int)a2.z, (int)a2.w, (int)a3.x, (int)a3.y, (int)a3.z, (int)a3.w}, X.b[2 * c + 1], acc1, 0, 0, 0, 0, 0, 0);
}
__device__ __forceinline__ void pa_flush(int n, const TokB& X, int lane, const LAS unsigned* list, const LAS float* gl, LAS unsigned char* ring, const unsigned char* U8, unsigned* wpk, int tb, int nwg) {
    if (n == 0) return;
    LDS_WAIT(); asm volatile("" ::: "memory");
    const int nb = (n + 15) >> 4;
    const int r = lane & 15, g = lane >> 4, roff = (r >> 3) * 1024 + (r & 7) * 128 + (((2 * g) ^ (r & 7) ^ (r >> 3)) * 16);
    int si = 0, sc = 0;
#define PA_NEXT(s) s = (s == 8192) ? 0 : s + 4096
    RowsA cur = pa_rows(0, n, lane, list, U8), nxt = cur;
    pa_dma(cur, 0, ring + si); PA_NEXT(si); pa_dma(cur, 1, ring + si); PA_NEXT(si);
    for (int b = 0; b < nb; ++b) {
        const bool more = b + 1 < nb;
        f32x4 acc0 = {0.f, 0.f, 0.f, 0.f}, acc1 = {0.f, 0.f, 0.f, 0.f};
        pa_dma(cur, 2, ring + si); PA_NEXT(si); PA_VWAIT(8); pa_mma(acc0, acc1, X, 0, ring + sc, roff); PA_NEXT(sc);
        pa_dma(cur, 3, ring + si); PA_NEXT(si); PA_VWAIT(8); pa_mma(acc0, acc1, X, 1, ring + sc, roff); PA_NEXT(sc);
        if (more) { nxt = pa_rows(b + 1, n, lane, list, U8); pa_dma(nxt, 0, ring + si); PA_NEXT(si); PA_VWAIT(8); } else PA_VWAIT(4);
        pa_mma(acc0, acc1, X, 2, ring + sc, roff); PA_NEXT(sc);
        if (more) { pa_dma(nxt, 1, ring + si); PA_NEXT(si); PA_VWAIT(8); } else PA_VWAIT(0);
        pa_mma(acc0, acc1, X, 3, ring + sc, roff); PA_NEXT(sc);
        cur = nxt;
        const f32x4 acc = acc0 + acc1;
        const int i0 = b * 16 + g * 4; const v4u e4 = *(const LAS v4u*)(list + i0);
        const unsigned en[4] = {e4.x, e4.y, e4.z, e4.w}; const float av[4] = {acc.x, acc.y, acc.z, acc.w};
#pragma unroll
        for (int i = 0; i < 4; ++i) { const unsigned ent = en[i], tl = ent >> 21, slot = (ent >> 14) & 127u;
            if (i0 + i < n && tl == (unsigned)r) { const int t = pa_tok(tl, tb, nwg);
                const _Float16 wh = (_Float16)(gl[tl * 128 + slot] * gelu_tanh(av[i] * (1.0f / (U8_SCALE * X8_SCALE))));
                wpk[(size_t)t * 128 + slot] = ((unsigned)__builtin_bit_cast(unsigned short, wh) << 16) | (ent & 0x3fffu); } }
    }
    LDS_WAIT(); asm volatile("" ::: "memory");
}
__device__ __forceinline__ void peer_a_phase(int lane, int wave, int G, int vcu, const bf16* XG, const unsigned char* U8, const int* ids, const float* gts, const float* rstd1, unsigned* wpk, LAS unsigned char* lds, int emask) {
    (void)emask;
    LAS unsigned char* ring = lds + RING_OFF + wave * 16384;
    LAS float* gl = (LAS float*)(ring + 12288);
    LAS unsigned* list = (LAS unsigned*)(lds + MISC_OFF + 128 + wave * (PA_CAP * 4));
    for (int tile0 = vcu; tile0 < MTOK / 32; tile0 += 2 * G) {
        const int tile1 = tile0 + G; const bool has1 = tile1 < MTOK / 32;
        const int tb = tile0 * 32 + wave * 4, nwg = (has1 ? tile1 : tile0) * 32 + wave * 4;
        int id0[8], id1[8];
#pragma unroll
        for (int k = 0; k < 8; ++k) { const bool ok = (k < 4) || has1; const int tc = pa_tok((unsigned)k, tb, nwg);
            const v4u xa = *(const GAS v4u*)(XG + (size_t)tc * 1024 + 8 * lane), xb = *(const GAS v4u*)(XG + (size_t)tc * 1024 + 512 + 8 * lane);
            const float rs = rstd1[tc] * X8_SCALE;
            const unsigned wa[4] = {xa.x, xa.y, xa.z, xa.w}, wb[4] = {xb.x, xb.y, xb.z, xb.w};
            float fa[8], fb[8];
#pragma unroll
            for (int i = 0; i < 4; ++i) { fa[2 * i] = __uint_as_float(wa[i] << 16) * rs; fa[2 * i + 1] = __uint_as_float(wa[i] & 0xffff0000u) * rs;
                                          fb[2 * i] = __uint_as_float(wb[i] << 16) * rs; fb[2 * i + 1] = __uint_as_float(wb[i] & 0xffff0000u) * rs; }
            *(LAS v2u*)(ring + k * 1024 + lane * 8) = (v2u){pack_fp8x4(fa[0], fa[1], fa[2], fa[3]), pack_fp8x4(fa[4], fa[5], fa[6], fa[7])};
            *(LAS v2u*)(ring + k * 1024 + 512 + lane * 8) = (v2u){pack_fp8x4(fb[0], fb[1], fb[2], fb[3]), pack_fp8x4(fb[4], fb[5], fb[6], fb[7])};
            gl[k * 128 + lane] = gts[(size_t)tc * 128 + lane]; gl[k * 128 + 64 + lane] = gts[(size_t)tc * 128 + 64 + lane];
            id0[k] = ok ? ids[(size_t)tc * 128 + lane] : -1; id1[k] = ok ? ids[(size_t)tc * 128 + 64 + lane] : -1; }
        LDS_WAIT(); asm volatile("" ::: "memory");
        TokB X;
#pragma unroll
        for (int m = 0; m < 8; ++m) { const LAS unsigned char* xp = ring + (lane & 7) * 1024 + m * 128 + (lane >> 4) * 32;
            const v4u lo = *(const LAS v4u*)xp, hi = *(const LAS v4u*)(xp + 16);
            X.b[m] = (v8i_t){(int)lo.x, (int)lo.y, (int)lo.z, (int)lo.w, (int)hi.x, (int)hi.y, (int)hi.z, (int)hi.w}; }
        LDS_WAIT(); asm volatile("" ::: "memory");
        for (int part = 0; part < 8; ++part) {
            int n = 0;
#pragma unroll
            for (int k = 0; k < 8; ++k) {
                { const bool sel = (id0[k] >> 11) == part; const unsigned long long m = __ballot(sel);
                  const int pos = n + (int)__builtin_amdgcn_mbcnt_hi((unsigned)(m >> 32), __builtin_amdgcn_mbcnt_lo((unsigned)m, 0u));
                  if (sel) list[pos] = ((unsigned)k << 21) | ((unsigned)lane << 14) | (unsigned)id0[k]; n += __builtin_popcountll(m); }
                { const bool sel = (id1[k] >> 11) == part; const unsigned long long m = __ballot(sel);
                  const int pos = n + (int)__builtin_amdgcn_mbcnt_hi((unsigned)(m >> 32), __builtin_amdgcn_mbcnt_lo((unsigned)m, 0u));
                  if (sel) list[pos] = ((unsigned)k << 21) | ((unsigned)(64 + lane) << 14) | (unsigned)id1[k]; n += __builtin_popcountll(m); }
                if (n > PA_CAP - 128) { pa_flush(n, X, lane, list, gl, ring, U8, wpk, tb, nwg); n = 0; }
            }
            pa_flush(n, X, lane, list, gl, ring, U8, wpk, tb, nwg);
        }
    }
}
__device__ __forceinline__ void final_token(int t, int lane, const unsigned short* Y16, float* X1, const float* fg) {
    GAS f32x4* xp = (GAS f32x4*)(X1 + (size_t)t * 1024 + 8 * lane);
    f32x4 x0 = xp[0], x1 = xp[1], x2 = xp[128], x3 = xp[129];
    const v4u ya = *(const GAS v4u*)(Y16 + (size_t)t * 1024 + 8 * lane), yb = *(const GAS v4u*)(Y16 + (size_t)t * 1024 + 512 + 8 * lane);
    const unsigned yw[8] = {ya.x, ya.y, ya.z, ya.w, yb.x, yb.y, yb.z, yb.w};
    float y[16];
#pragma unroll
    for (int i = 0; i < 8; ++i) { const unsigned w = yw[i]; const h2_t h = __builtin_bit_cast(h2_t, w); y[2 * i] = (float)h[0]; y[2 * i + 1] = (float)h[1]; }
    x0 += (f32x4){y[0], y[1], y[2], y[3]}; x1 += (f32x4){y[4], y[5], y[6], y[7]}; x2 += (f32x4){y[8], y[9], y[10], y[11]}; x3 += (f32x4){y[12], y[13], y[14], y[15]};
    float ss = (x0.x * x0.x + x0.y * x0.y) + (x0.z * x0.z + x0.w * x0.w) + (x1.x * x1.x + x1.y * x1.y) + (x1.z * x1.z + x1.w * x1.w)
             + (x2.x * x2.x + x2.y * x2.y) + (x2.z * x2.z + x2.w * x2.w) + (x3.x * x3.x + x3.y * x3.y) + (x3.z * x3.z + x3.w * x3.w);
    const float rstd2 = 1.0f / sqrtf(wave_sum(ss) * (1.f / DMODEL) + RMS_EPS);
    const GAS f32x4* gp = (const GAS f32x4*)(fg + 8 * lane);
    xp[0] = x0 * rstd2 * gp[0]; xp[1] = x1 * rstd2 * gp[1]; xp[128] = x2 * rstd2 * gp[128]; xp[129] = x3 * rstd2 * gp[129];
}
#ifndef REP_0
#define REP_0 1
#endif
#ifndef REP_1
#define REP_1 1
#endif
#ifndef REP_2
#define REP_2 1
#endif
#ifndef REP_3
#define REP_3 1
#endif
#ifndef REP_4
#define REP_4 1
#endif
#ifndef REP_5
#define REP_5 1
#endif
#ifndef REP_6
#define REP_6 1
#endif
#ifndef REP_7
#define REP_7 1
#endif
#ifndef REP_8
#define REP_8 1
#endif
#ifndef REP_9
#define REP_9 1
#endif
#ifndef REP_10
#define REP_10 1
#endif
#ifndef REP_11
#define REP_11 1
#endif
struct PkB { v4u p[4]; };
__device__ __forceinline__ PkB peer_b_load(int t, int lane, const unsigned* wpk) { PkB k;
#pragma unroll
    for (int q = 0; q < 4; ++q) k.p[q] = *(const GAS v4u*)(wpk + (size_t)t * 128 + (lane >> 3) * 16 + q * 4);
    return k; }
__device__ __forceinline__ void peer_b_rows(v4u (&v)[16], const PkB& k, const unsigned char* vbase) {
#pragma unroll
    for (int q = 0; q < 4; ++q) { const unsigned pw[4] = {k.p[q].x, k.p[q].y, k.p[q].z, k.p[q].w};
#pragma unroll
        for (int r = 0; r < 4; ++r) v[q * 4 + r] = *(const GAS v4u*)(vbase + (size_t)(pw[r] & 0xffffu) * 128); }
}
__device__ __forceinline__ void peer_b_sum(const v4u (&v)[16], const PkB& k, int lane, unsigned short* yout) {
    h2_t acc[8]; const float sc = 1.0f / V8_SCALE;
#pragma unroll
    for (int i = 0; i < 8; ++i) acc[i] = (h2_t){(_Float16)0.f, (_Float16)0.f};
#pragma unroll
    for (int q = 0; q < 4; ++q) { const unsigned pw[4] = {k.p[q].x, k.p[q].y, k.p[q].z, k.p[q].w};
#pragma unroll
        for (int r = 0; r < 4; ++r) { const unsigned p = pw[r], wb = (p & 0xffff0000u) | (p >> 16); const h2_t w2 = __builtin_bit_cast(h2_t, wb); const v4u x = v[q * 4 + r];
            const unsigned xx = x.x, xy = x.y, xz = x.z, xw = x.w;
            acc[0] = __builtin_elementwise_fma(fp8lo_h(xx, sc), w2, acc[0]); acc[1] = __builtin_elementwise_fma(fp8hi_h(xx, sc), w2, acc[1]);
            acc[2] = __builtin_elementwise_fma(fp8lo_h(xy, sc), w2, acc[2]); acc[3] = __builtin_elementwise_fma(fp8hi_h(xy, sc), w2, acc[3]);
            acc[4] = __builtin_elementwise_fma(fp8lo_h(xz, sc), w2, acc[4]); acc[5] = __builtin_elementwise_fma(fp8hi_h(xz, sc), w2, acc[5]);
            acc[6] = __builtin_elementwise_fma(fp8lo_h(xw, sc), w2, acc[6]); acc[7] = __builtin_elementwise_fma(fp8hi_h(xw, sc), w2, acc[7]); } }
#pragma unroll
    for (int o = 8; o < 64; o <<= 1)
#pragma unroll
        for (int i = 0; i < 8; ++i) { const unsigned u = __builtin_bit_cast(unsigned, acc[i]); const unsigned ou = (unsigned)__shfl_xor((int)u, o); acc[i] = acc[i] + __builtin_bit_cast(h2_t, ou); }
    if (lane < 8) { *(GAS v4u*)yout = (v4u){__builtin_bit_cast(unsigned, acc[0]), __builtin_bit_cast(unsigned, acc[1]), __builtin_bit_cast(unsigned, acc[2]), __builtin_bit_cast(unsigned, acc[3])};
                    *(GAS v4u*)(yout + 8) = (v4u){__builtin_bit_cast(unsigned, acc[4]), __builtin_bit_cast(unsigned, acc[5]), __builtin_bit_cast(unsigned, acc[6]), __builtin_bit_cast(unsigned, acc[7])}; }
}
__device__ __forceinline__ void peer_b_phase(int lane, int wave, int G, int vcu, const unsigned char* V8s, const unsigned* wpk, unsigned short* Y16, float* X1, const float* fg) {
    const int c16 = (lane & 7) * 16;
    for (int tile0 = vcu; tile0 < MTOK / 32; tile0 += 2 * G) {
        const int tile1 = tile0 + G; const bool has1 = tile1 < MTOK / 32;
        const int tb = tile0 * 32 + wave * 4, nwg = (has1 ? tile1 : tile0) * 32 + wave * 4;
        const int nst = has1 ? 4 : 2;
        for (int sl = 0; sl < 8; ++sl) {
            const unsigned char* vbase = V8s + (size_t)sl * NEXP * 128 + c16;
            PkB kA = peer_b_load(pa_tok(0u, tb, nwg), lane, wpk), kB = peer_b_load(pa_tok(1u, tb, nwg), lane, wpk);
            for (int st = 0; st < nst; ++st) {
                const int tA = pa_tok((unsigned)(2 * st), tb, nwg), tB = pa_tok((unsigned)(2 * st + 1), tb, nwg);
                const unsigned kn = (st + 1 < nst) ? (unsigned)(2 * st + 2) : (unsigned)(2 * st);
                const PkB nA = peer_b_load(pa_tok(kn, tb, nwg), lane, wpk), nB = peer_b_load(pa_tok(kn + 1u, tb, nwg), lane, wpk);
                v4u vA[16], vB[16];
                peer_b_rows(vA, kA, vbase); peer_b_rows(vB, kB, vbase);
                peer_b_sum(vA, kA, lane, Y16 + (size_t)tA * 1024 + sl * 128 + c16);
                peer_b_sum(vB, kB, lane, Y16 + (size_t)tB * 1024 + sl * 128 + c16);
                kA = nA; kB = nB;
            }
        }
        asm volatile("s_waitcnt vmcnt(0)" ::: "memory");
        for (int k = 0; k < 2 * nst; ++k) final_token(pa_tok((unsigned)k, tb, nwg), lane, Y16, X1, fg);
    }
}
template <int NR> __device__ __forceinline__ void convert_expert_rows(const float* table, int ex, int stride, bool isv, int lane, unsigned char* U8, unsigned char* V8) {
    f32x4 r[NR][4]; const float sc = isv ? V8_SCALE : U8_SCALE;
#pragma unroll
    for (int k = 0; k < NR; ++k) { const int e = ex + k * stride; const float* src = table + (size_t)(e < NEXP ? e : ex) * 1024 + 16 * lane;
#pragma unroll
        for (int q = 0; q < 4; ++q) r[k][q] = *(const GAS f32x4*)(src + 4 * q); }
#pragma unroll
    for (int k = 0; k < NR; ++k) { const int e = ex + k * stride; if (e < NEXP) {
        const f32x4 a = r[k][0] * sc, b = r[k][1] * sc, c = r[k][2] * sc, d = r[k][3] * sc;
        const v4u o = (v4u){pack_fp8x4(a.x, a.y, a.z, a.w), pack_fp8x4(b.x, b.y, b.z, b.w), pack_fp8x4(c.x, c.y, c.z, c.w), pack_fp8x4(d.x, d.y, d.z, d.w)};
        if (!isv) *(GAS v4u*)(U8 + (size_t)e * 1024 + 16 * lane) = o;
        else *(GAS v4u*)(V8 + ((size_t)(lane >> 3) * NEXP + e) * 128 + (lane & 7) * 16) = o; } }
}
struct OnePanel { int pm, n; __device__ __forceinline__ bool next(int i, pg8::Unit& u) const { if (i >= n) return false; u.pm = pm; u.pn = i; u.w = 0; return true; } };
struct DualOrder { pg8::StaticOrder S; __device__ __forceinline__ bool next(int i, pg8::Unit& u) const { if (!S.next(i >> 1, u)) return false; u.w = i & 1; return true; } };
struct Args { const float* in[24]; float* out; unsigned char* ws; int ph_lo, ph_hi, li, pad; };
__global__ void __launch_bounds__(NWAVES * 64, 2) mk_fwd(Args args) {
    extern __shared__ __attribute__((aligned(16))) unsigned char lds[];
    Frame F;
    F.lds = (LAS unsigned char*)lds;
    volatile LAS unsigned* MISC = (volatile LAS unsigned*)(F.lds + MISC_OFF);
    F.tid = threadIdx.x; F.lane = F.tid & 63; F.wave = __builtin_amdgcn_readfirstlane(F.tid >> 6);
    F.G = gridDim.x; { const int bx = blockIdx.x; F.vcu = (F.G % 8 == 0) ? (bx % 8) * (F.G / 8) + bx / 8 : bx; }
    unsigned char* ws = args.ws;
    gu32* ctl = (gu32*)(ws + WS_CTL);
    for (int u = F.tid; u < (LDS_BYTES - LDSCTL_OFF) / 4; u += NWAVES * 64) ((LAS unsigned*)(F.lds + LDSCTL_OFF))[u] = 0u;
    __syncthreads();
    XcdBarrier bar; bar.bar = (unsigned*)(ctl + CW_BAR); bar.x = 0; bar.st = nullptr;
    if (N_LAUNCHES != PER_PHASE) bar = xcd_barrier_post((unsigned*)(ctl + CW_BAR), MISC + 8);
#define GRID_BAR() do { if (N_LAUNCHES != PER_PHASE) xcd_barrier(bar); } while (0)
    const int lo = args.ph_lo, hi = args.ph_hi;
#ifndef PH_MASK
#define PH_MASK 0xFFFF
#endif
#define IN(k) ((((PH_MASK) >> (k)) & 1) && lo <= (k) && (k) < hi)
#define BOTH(k) (IN(k) && IN((k) + 1))
    const int gw = F.vcu * NWAVES + F.wave, NGW = F.G * NWAVES;
    const int gtid = F.vcu * (NWAVES * 64) + F.tid, NTHR = F.G * NWAVES * 64;
    const float* x = args.in[0];
    bf16* Win_t = (bf16*)(ws + WS_WIN); bf16* Wq_t = (bf16*)(ws + WS_WQ); bf16* Wout_t = (bf16*)(ws + WS_WOUT); bf16* Wus_t = (bf16*)(ws + WS_WUS); bf16* Wua_t = (bf16*)(ws + WS_WUA);
    bf16* Wglu_t = (bf16*)(ws + WS_WGLU); bf16* KSb = (bf16*)(ws + WS_KS); bf16* WE = (bf16*)(ws + WS_WE); bf16* BP = (bf16*)(ws + WS_BP); bf16* AP = (bf16*)(ws + WS_AP);
    float* Eb = (float*)(ws + WS_E); bf16* Hb = (bf16*)(ws + WS_H); bf16* Ypre = (bf16*)(ws + WS_YPRE); bf16* Ya = (bf16*)(ws + WS_YA); bf16* XG = (bf16*)(ws + WS_XG);
    bf16* Zb = (bf16*)(ws + WS_Z); bf16* Qb = (bf16*)(ws + WS_Z + 1 * ZSTRIDE_B); bf16* Kb = (bf16*)(ws + WS_Z + 2 * ZSTRIDE_B); bf16* Vb = (bf16*)(ws + WS_Z + 3 * ZSTRIDE_B);
    bf16* GA = (bf16*)(ws + WS_Z + 4 * ZSTRIDE_B); bf16* GB = (bf16*)(ws + WS_Z + 6 * ZSTRIDE_B);
    bf16* Yb = (bf16*)(ws + WS_YB); bf16* Mrg = (bf16*)(ws + WS_MRG); bf16* PQb = (bf16*)(ws + WS_PQ); int* ids = (int*)(ws + WS_IDS); float* gts = (float*)(ws + WS_GTS);
    unsigned char* U8 = ws + WS_U16; unsigned char* V8 = ws + WS_V16; unsigned* wpk = (unsigned*)(ws + WS_WPK); float* rstd1 = (float*)(ws + WS_RSTD1); unsigned short* Y16 = (unsigned short*)(ws + WS_Y16);
    float* biasT = (float*)(ws + WS_BIAS); float* pw32 = (float*)(ws + WS_PW32); float* kpart = (float*)(ws + WS_KPART); float* Kg = (float*)(ws + WS_KG); float* ssq1 = (float*)(ws + WS_SSQ1);

    if (IN(0)) for (int rep_ = 0; rep_ < REP_0; ++rep_) {
        LAS float* scr = (LAS float*)(F.lds + RING_OFF + F.wave * 16384);
        constexpr int I_IN = (1024 / 64) * (4096 / 32), I_GLU = (512 / 64) * (512 / 32), I_UP = (512 / 64) * (1024 / 32), I_OUT = (1024 / 64) * (1024 / 32), I_Q = (1024 / 64) * (2048 / 32);
        constexpr int NITEMS = I_IN + I_GLU + 2 * I_UP + I_OUT + I_Q;
        for (int it = gw; it < NITEMS; it += NGW) {
            int r = it;
            if (r < I_IN) { p0_transpose_item(args.in[2], 1024, 4096, Win_t, scr, r, F.lane); continue; } r -= I_IN;
            if (r < I_GLU) { p0_transpose_item(args.in[11], 512, 512, Wglu_t, scr, r, F.lane); continue; } r -= I_GLU;
            if (r < I_UP) { p0_transpose_item(args.in[13], 512, 1024, Wus_t, scr, r, F.lane); continue; } r -= I_UP;
            if (r < I_UP) { p0_transpose_item(args.in[14], 512, 1024, Wua_t, scr, r, F.lane); continue; } r -= I_UP;
            if (r < I_OUT) { p0_transpose_item(args.in[16], 1024, 1024, Wout_t, scr, r, F.lane); continue; } r -= I_OUT;
            p0_transpose_item(args.in[18], 1024, 2048, Wq_t, scr, r, F.lane);
        }
        for (int it = gw; it < NGRP * CH; it += NGW)
            ssm_table_task(it >> 5, it & 31, F.lane, scr, args.in[3], args.in[4], args.in[5], args.in[6], args.in[7], args.in[8], args.in[9], Kg, WE, BP, pw32);
        for (int m = gw; m < MTOK; m += NGW * 4) rms_rows4_to_bf16(x, args.in[1], Hb, m, NGW, F.lane);
        for (int it = gw; it < 64; it += NGW) { const float* src = (it < 32 ? args.in[19] : args.in[20]) + (size_t)(it & 31) * 512 + 8 * F.lane;
            const f32x4 a = *(const GAS f32x4*)src, b = *(const GAS f32x4*)(src + 4);
            *(GAS v4u*)(KSb + (size_t)it * 512 + 8 * F.lane) = (v4u){pk2(a.x, a.y), pk2(a.z, a.w), pk2(b.x, b.y), pk2(b.z, b.w)}; }
        if (gw == 0) { for (int i = F.lane; i < 8 * 128; i += 64) { const int h = i >> 7, rel = i & 127; int bk;
                if (rel < 16) bk = rel; else { const float lg = logf((float)rel / 16.0f) / 2.0794415416798357f * 16.0f; bk = 16 + (int)lg; bk = bk < 0 ? 0 : (bk > 31 ? 31 : bk); }
                biasT[i] = (args.in[15][bk * 8 + h] - args.in[15][31 * 8 + h]) * 1.4426950408889634f; } }
        if (BOTH(0)) GRID_BAR();
    }

    if (IN(1)) for (int rep_ = 0; rep_ < REP_1; ++rep_) {
        const float* Dsk = args.in[10];
        for (int i0 = gtid; i0 < NGRP * 512 * 64; i0 += NTHR * 4) {
            f32x4 ka[4], kb[4];
#pragma unroll
            for (int q = 0; q < 4; ++q) { const int i = i0 + q * NTHR; const int ic = (i < NGRP * 512 * 64) ? i : i0; const int g = ic >> 15, m = (ic >> 6) & 511, k8 = ic & 63, j = m >> 4, ho = m & 15, jp = k8 >> 1, hi0 = (k8 & 1) * 8;
                const int lag = (jp <= j) ? j - jp : 0; const float* kp = Kg + ((size_t)(g * 32 + lag) * 256 + ho * 16 + hi0); ka[q] = *(const GAS f32x4*)kp; kb[q] = *(const GAS f32x4*)(kp + 4); }
#pragma unroll
            for (int q = 0; q < 4; ++q) { const int i = i0 + q * NTHR; if (i >= NGRP * 512 * 64) break; const int g = i >> 15, m = (i >> 6) & 511, k8 = i & 63, j = m >> 4, ho = m & 15, jp = k8 >> 1, hi0 = (k8 & 1) * 8;
                v4u o = (v4u){0u, 0u, 0u, 0u};
                if (jp <= j) { f32x4 a = ka[q], b = kb[q];
                    if (jp == j && (ho >> 3) == (hi0 >> 3)) { const float dv = Dsk[g * 16 + ho]; const int e = ho & 7;
                        a.x += (e == 0) ? dv : 0.f; a.y += (e == 1) ? dv : 0.f; a.z += (e == 2) ? dv : 0.f; a.w += (e == 3) ? dv : 0.f;
                        b.x += (e == 4) ? dv : 0.f; b.y += (e == 5) ? dv : 0.f; b.z += (e == 6) ? dv : 0.f; b.w += (e == 7) ? dv : 0.f; }
                    o = (v4u){pk2(a.x, a.y), pk2(a.z, a.w), pk2(b.x, b.y), pk2(b.z, b.w)}; }
                *(GAS v4u*)(BP + ((size_t)(g * 512 + m) * APK + k8 * 8)) = o; } }
        pg8::Gemm g{Hb, Win_t, MTOK, INCOLS, 1024, 1024, 1024, 1 << 30, 0};
        pg8::StaticOrder S; S.init(MTOK, INCOLS, F.G, (int)blockIdx.x);
        pg8::EpiIn E{Zb, AP, kpart};
        pg8::gemm_phase<pg8::EpiIn, pg8::StaticOrder, true>(F.lds + RING_OFF, g, S, E);
        if (BOTH(1)) GRID_BAR();
    }

    if (IN(2)) for (int rep_ = 0; rep_ < REP_2; ++rep_) {
        const int bx = (int)blockIdx.x;
        const bool shared = F.G < 4;
        const int nS = shared ? F.G : (F.G >= 256 ? 64 : F.G / 4), nA = shared ? F.G : F.G - nS;
        const bool inS = shared || bx < nS, inA = shared || bx >= nS; const int aidx = shared ? bx : bx - nS;
        if (inS) {
#pragma unroll 1
            for (int pm = bx; pm < MTOK / 256; pm += nS) {
                { pg8::Gemm g1{AP, WE, MTOK, 256, 512, APK, 512, 2, (size_t)256 * 512}; OnePanel S1{pm, 1}; pg8::EpiE E1{Eb};
                  pg8::gemm_phase<pg8::EpiE, OnePanel, true>(F.lds + RING_OFF, g1, S1, E1); }
                VM_WAIT(); __syncthreads();
                if (F.tid < 256) { const int gb = (pm >> 1) * 8 + (pm & 1) * 4 + (F.tid >> 6), g_ = gb >> 3, p = F.tid & 63; const size_t row0 = (size_t)gb * 64;
                    const float mr = pw32[g_ * 128 + p], mi = pw32[g_ * 128 + 64 + p]; float sr = 0.f, si = 0.f;
#pragma unroll 1
                    for (int c0 = 0; c0 < NCHUNK; c0 += 32) { float er[32], ei[32];
#pragma unroll
                        for (int c = 0; c < 32; ++c) { er[c] = Eb[(row0 + c0 + c) * 128 + p]; ei[c] = Eb[(row0 + c0 + c) * 128 + 64 + p]; }
#pragma unroll
                        for (int c = 0; c < 32; ++c) { bf16* ap = AP + (row0 + c0 + c) * APK + 512; ap[p] = (bf16)f2bf(sr); ap[64 + p] = (bf16)f2bf(si);
                            const float nr = mr * sr - mi * si + er[c], ni = mr * si + mi * sr + ei[c]; sr = nr; si = ni; } } }
                VM_WAIT(); __syncthreads();
                { pg8::Gemm g{AP, BP, MTOK, 512, APK, APK, APK, 2, (size_t)512 * APK}; OnePanel S3{pm, 2}; pg8::EpiY E{Ypre};
                  pg8::gemm_phase<pg8::EpiY, OnePanel, true>(F.lds + RING_OFF, g, S3, E); }
            }
        }
        if (inA) {
            static_assert(attn_body::ATTN_LDS_BYTES <= RING_BYTES, "attention LDS");
#pragma unroll 1
            for (int a = aidx; a < 192; a += nA) { const int ty = a >> 6, bh = a & 63;
#pragma unroll 1
                for (int i = 0; i < 4; ++i) { const int qb = (ty == 0) ? (i == 0 ? 7 : (i == 1 ? 2 : (i == 2 ? 0 : -1))) : (ty == 1) ? (i == 0 ? 6 : (i == 1 ? 4 : -1)) : (i == 0 ? 5 : (i == 1 ? 3 : (i == 2 ? 1 : -1)));
                    if (qb < 0) break;
                    attn_body::attn_unit<8>(bh >> 3, bh & 7, qb, (const attn_body::bf16*)Qb, (const attn_body::bf16*)Kb, (const attn_body::bf16*)Vb, (attn_body::bf16*)Yb, (char*)lds + RING_OFF, kpart, biasT); } }
        }
        if (BOTH(2)) GRID_BAR();
    }

    if (IN(3)) for (int rep_ = 0; rep_ < REP_3; ++rep_) {
        pg8::Gemm g{Ypre, Wglu_t, MTOK, 512, 512, 512, 512, 1 << 30, 0};
        pg8::StaticOrder S; S.init(MTOK, 512, F.G, (int)blockIdx.x);
        pg8::EpiGlu E{Ypre, Ya, args.in[12]};
        pg8::gemm_phase<pg8::EpiGlu, pg8::StaticOrder, true>(F.lds + RING_OFF, g, S, E);
        { const int nun = (MTOK / 256) * (512 / 256);
          const int nconv = (F.G > nun) ? F.G - nun : F.G, cidx = (F.G > nun) ? (int)blockIdx.x - nun : (int)blockIdx.x;
          if (cidx >= 0) for (int ex = cidx * NWAVES + F.wave; ex < 2 * NEXP; ex += nconv * NWAVES * 4) { const bool isv = ex >= NEXP; convert_expert_rows<4>(isv ? args.in[22] : args.in[21], isv ? ex - NEXP : ex, nconv * NWAVES, isv, F.lane, U8, V8); } }
        if (BOTH(3)) GRID_BAR();
    }

    if (IN(4)) for (int rep_ = 0; rep_ < REP_4; ++rep_) {
        pg8::Gemm g{Ya, Wus_t, MTOK, 1024, 512, 512, 512, 1 << 30, 0, Yb, Wua_t};
        DualOrder S; S.S.init(MTOK, 1024, F.G, (int)blockIdx.x);
        pg8::EpiMrgDual E{pg8::EpiMrg<0>{GA, Mrg}, pg8::EpiMrg<1>{GB, Mrg}};
        pg8::gemm_phase<pg8::EpiMrgDual, DualOrder, true>(F.lds + RING_OFF, g, S, E);
        if (BOTH(4)) GRID_BAR();
    }

    if (IN(5)) for (int rep_ = 0; rep_ < REP_5; ++rep_) {
        pg8::Gemm g{Mrg, Wout_t, MTOK, 1024, 1024, 1024, 1024, 1 << 30, 0}; pg8::StaticOrder S; S.init(MTOK, 1024, F.G, (int)blockIdx.x);
        pg8::EpiX1 E{x, args.out, XG, args.in[17], ssq1};
        pg8::gemm_phase<pg8::EpiX1, pg8::StaticOrder, true>(F.lds + RING_OFF, g, S, E);
        if (BOTH(5)) GRID_BAR();
    }

    if (IN(6)) for (int rep_ = 0; rep_ < REP_6; ++rep_) {
        pg8::Gemm g{XG, Wq_t, MTOK, PQ, 1024, 1024, 1024, 1 << 30, 0}; pg8::StaticOrder S; S.init(MTOK, PQ, F.G, (int)blockIdx.x);
        pg8::EpiPlain E{PQb, PQ};
        pg8::gemm_phase<pg8::EpiPlain, pg8::StaticOrder, true>(F.lds + RING_OFF, g, S, E);
        if (BOTH(6)) GRID_BAR();
    }

    if (IN(7)) for (int rep_ = 0; rep_ < REP_7; ++rep_) {
        LAS unsigned char* scr = F.lds + RING_OFF + F.wave * 2048;
        LAS unsigned char* ksl = F.lds + RING_OFF + 16384;
        for (int c = F.tid; c < 256 * 16; c += NWAVES * 64) { const int row = c >> 4, ch = c & 15; *(LAS v4u*)(ksl + row * 256 + ((ch ^ (row & 15)) << 4)) = *(const GAS v4u*)(KSb + row * 128 + ch * 8); }
        __syncthreads();
        for (int it = gw; it < (MTOK / 32) * 8; it += NGW) topk_task(it >> 3, it & 7, F.lane, scr, PQb, ksl, ssq1, ids, gts, rstd1);
        if (BOTH(7)) { VM_WAIT(); __syncthreads(); }
    }

    if (IN(8)) for (int rep_ = 0; rep_ < REP_8; ++rep_) {
        peer_a_phase(F.lane, F.wave, F.G, F.vcu, XG, U8, ids, gts, rstd1, wpk, F.lds, 0xffff);
        if (BOTH(8)) { VM_WAIT(); __syncthreads(); }
    }
    if (IN(9)) for (int rep_ = 0; rep_ < REP_9; ++rep_) {
        peer_b_phase(F.lane, F.wave, F.G, F.vcu, V8, wpk, Y16, args.out, args.in[23]);
    }
#undef IN
#undef BOTH
#undef GRID_BAR
}

extern "C" void kernel_launch(void* const* d_in, const int* in_sizes, int n_in, void* d_out, int out_size, void* d_ws, size_t ws_size, hipStream_t stream) {
    static int grid = 0;
    if (grid == 0) {
        if (n_in != 24 || in_sizes[0] != MTOK * DMODEL || out_size != MTOK * DMODEL || ws_size < WS_END) { fprintf(stderr, "kernel_launch: unexpected shapes (n_in %d, in0 %d, out %d, ws %zu); nothing launched\n", n_in, n_in > 0 ? in_sizes[0] : -1, out_size, ws_size); grid = -1; return; }
        int dev = 0, cus = 0, per_cu = 0;
        if (hipGetDevice(&dev) != hipSuccess || hipDeviceGetAttribute(&cus, hipDeviceAttributeMultiprocessorCount, dev) != hipSuccess) { grid = -1; return; }
        if (hipFuncSetAttribute((const void*)mk_fwd, hipFuncAttributeMaxDynamicSharedMemorySize, LDS_BYTES) != hipSuccess) { fprintf(stderr, "kernel_launch: hipFuncSetAttribute failed\n"); grid = -1; return; }
        if (hipOccupancyMaxActiveBlocksPerMultiprocessor(&per_cu, (const void*)mk_fwd, NWAVES * 64, LDS_BYTES) != hipSuccess || per_cu < 1) { fprintf(stderr, "kernel_launch: occupancy query says %d blocks per CU\n", per_cu); }
        (void)hipGetLastError();
        grid = cus;
    }
    if (grid < 0) return;
    if (N_LAUNCHES != PER_PHASE) { if (hipMemsetAsync((char*)d_ws + WS_CTL, 0, CTL_ZERO_BYTES, stream) != hipSuccess) return; }
    Args a{};
    for (int i = 0; i < 24; ++i) a.in[i] = (const float*)d_in[i];
    a.out = (float*)d_out; a.ws = (unsigned char*)d_ws; a.pad = 0;
    if (N_LAUNCHES == PER_PHASE) {
        for (int li = 0; li < PER_PHASE; ++li) { a.ph_lo = li; a.ph_hi = li + 1; a.li = li; hipLaunchKernelGGL(mk_fwd, dim3(grid), dim3(NWAVES * 64), LDS_BYTES, stream, a); }
    } else {
        a.ph_lo = 0; a.ph_hi = PER_PHASE; a.li = 0;
        hipLaunchKernelGGL(mk_fwd, dim3(grid), dim3(NWAVES * 64), LDS_BYTES, stream, a);
    }
}
```

```cpp
#include <hip/hip_runtime.h>
#include <hip/hip_bf16.h>
#include <cstdio>
#include <cstdint>
#include <cmath>

#ifndef MK_N_LAUNCHES
#define MK_N_LAUNCHES 1
#endif

namespace pg8 {
#define PG8_LAS __attribute__((address_space(3)))
typedef unsigned short bf16_t;
typedef short bf16x8 __attribute__((ext_vector_type(8)));
typedef float f32x4 __attribute__((ext_vector_type(4)));
typedef unsigned u32x4 __attribute__((ext_vector_type(4)));
constexpr int BM = 256, BK = 64, HALF = 128, HTB = HALF * BK * 2, STAGE_BYTES = 8 * HTB, NXCD = 8, WGM = 8;

__host__ __device__ __forceinline__ int lds_byte(int r, int c) { const int st = (r >> 4) * 2 + (c >> 5), rr = r & 15, cc = c & 31, ob = rr * 64 + cc * 2; return st * 1024 + (ob ^ (((ob >> 9) & 1) << 5)); }
__host__ __device__ __forceinline__ void stage_rc(int b, int& R, int& C) { const int st = b / 1024, sb = b % 1024, swz = sb ^ (((sb >> 9) & 1) << 5); R = (st >> 1) * 16 + swz / 64; C = (st & 1) * 32 + (swz % 64) / 2; }
__host__ __device__ __forceinline__ int perm32(int rho) { const int n = rho >> 4, i = rho & 15; return 8 * (i >> 2) + 4 * n + (i & 3); }

struct Unit { int pm, pn, w; };
struct Gemm { const bf16_t* A; const bf16_t* Bt; int M, N, K, lda, ldb, rpg; size_t bgs; const bf16_t* A2 = nullptr; const bf16_t* Bt2 = nullptr; };

struct StaticOrder {
    int nM, nN, nwg, G, c;
    __host__ __device__ __forceinline__ void init(int M, int N, int G_, int c_) { nM = M / BM; nN = N / BM; nwg = nM * nN; G = G_; c = c_; }
    __host__ __device__ __forceinline__ bool next(int i, Unit& u) const {
        const long L = (long)i * G + c; if (L >= nwg) return false;
        int wgid = (int)L; { const int q = nwg / NXCD, r = nwg % NXCD, xcd = wgid % NXCD, off = wgid / NXCD; wgid = (xcd < r ? xcd * (q + 1) : r * (q + 1) + (xcd - r) * q) + off; }
        const int nig = WGM * nN, gid = wgid / nig, fm = gid * WGM, gsz = (nM - fm) < WGM ? (nM - fm) : WGM;
        u.pm = fm + ((wgid % nig) % gsz); u.pn = (wgid % nig) / gsz; u.w = 0; return true;
    }
};

__device__ __forceinline__ unsigned cvt_pk_bf16(float lo, float hi) { unsigned r; asm volatile("v_cvt_pk_bf16_f32 %0, %1, %2" : "=v"(r) : "v"(lo), "v"(hi)); return r; }
__device__ __forceinline__ float bf_lo(unsigned w) { return __uint_as_float(w << 16); }
__device__ __forceinline__ float bf_hi(unsigned w) { return __uint_as_float(w & 0xffff0000u); }
__device__ __forceinline__ float sigmoid_f(float x) { return __builtin_amdgcn_rcpf(1.0f + __builtin_amdgcn_exp2f(-1.4426950409f * x)); }
__device__ __forceinline__ float gelu_tanh(float x) { const float u = x + 0.044715f * x * x * x; return x * __builtin_amdgcn_rcpf(1.0f + __builtin_amdgcn_exp2f(-2.3022081985f * u)); }

template <class Epi, class Sched, bool ALIGN_EPI>
__device__ __forceinline__ void gemm_phase(PG8_LAS unsigned char* lds, const Gemm g, const Sched& S, const Epi& E) {
    int tid = threadIdx.x; asm volatile("" : "+v"(tid));
    const int wid = __builtin_amdgcn_readfirstlane(tid >> 6), lane = tid & 63, wr = wid >> 2, wc = wid & 3, fr = lane & 15, fq = lane >> 4;
    const int K = g.K, nt = K / BK;
    unsigned voffA[2], voffB[2];
#pragma unroll
    for (int i = 0; i < 2; ++i) { int R, C; stage_rc(tid * 16 + i * 8192, R, C); const int Rb = Epi::PERM ? ((R & ~31) + perm32(R & 31)) : R;
        voffA[i] = (unsigned)(R * g.lda + C) * 2u; voffB[i] = (unsigned)(Rb * g.ldb + C) * 2u; }
    const size_t kstep = (size_t)(BK * 2);
    const size_t hstepA = (size_t)HALF * g.lda * 2, hstepB = (size_t)HALF * g.ldb * 2;
    const size_t tstepA = 2 * hstepA, tstepB = 2 * hstepB;
    const unsigned ldsw = (unsigned)wid * 1024u;
    const int aoff = lds_byte(wr * 64 + fr, fq * 8), boff = lds_byte(wc * 32 + fr, fq * 8);
#define PG8_SA(b, h) (((b) * 2 + (h)) * HTB)
#define PG8_SB(b, h) ((4 + (b) * 2 + (h)) * HTB)
#define PG8_STAGE(bufoff, gbase, voff) do { _Pragma("unroll") for (int _i = 0; _i < 2; ++_i) \
        __builtin_amdgcn_global_load_lds((const unsigned*)((const char*)(gbase) + (voff)[_i]), (PG8_LAS unsigned*)(lds + (bufoff) + ldsw + _i * 8192), 16, 0, 0); } while (0)
#define PG8_LDA(dst, b, h) do { _Pragma("unroll") for (int m = 0; m < 4; ++m) _Pragma("unroll") for (int k = 0; k < 2; ++k) dst[m][k] = *(const PG8_LAS bf16x8*)(lds + PG8_SA(b, h) + aoff + m * 2048 + k * 1024); } while (0)
#define PG8_LDB(dst, b, h) do { _Pragma("unroll") for (int n = 0; n < 2; ++n) _Pragma("unroll") for (int k = 0; k < 2; ++k) dst[n][k] = *(const PG8_LAS bf16x8*)(lds + PG8_SB(b, h) + boff + n * 2048 + k * 1024); } while (0)
#define PG8_MMA(ai, bj, At, Bt) do { __builtin_amdgcn_s_setprio(1); _Pragma("unroll") for (int m = 0; m < 4; ++m) _Pragma("unroll") for (int n = 0; n < 2; ++n) _Pragma("unroll") for (int k = 0; k < 2; ++k) \
        acc[ai][bj][m][n] = __builtin_amdgcn_mfma_f32_16x16x32_bf16(Bt[n][k], At[m][k], acc[ai][bj][m][n], 0, 0, 0); __builtin_amdgcn_s_setprio(0); } while (0)
#define PG8_WAIT_V(n) asm volatile("s_waitcnt vmcnt(" #n ")" ::: "memory")
#define PG8_WAIT_L(n) asm volatile("s_waitcnt lgkmcnt(" #n ")" ::: "memory")
#define PG8_BAR __builtin_amdgcn_s_barrier()
#define PG8_SCHED __builtin_amdgcn_sched_barrier(0)
    Unit cur, nxt; int ui = 0;
    if (!S.next(0, cur)) return;
    f32x4 acc[2][2][4][2];
#pragma unroll
    for (int a = 0; a < 2; ++a)
#pragma unroll
        for (int b = 0; b < 2; ++b)
#pragma unroll
            for (int m = 0; m < 4; ++m)
#pragma unroll
                for (int n = 0; n < 2; ++n) acc[a][b][m][n] = (f32x4){0.f, 0.f, 0.f, 0.f};
    bf16x8 At[4][2], B0[2][2], B1[2][2];
    const char* cA = (const char*)(cur.w ? g.A2 : g.A) + (size_t)cur.pm * tstepA;
    const char* cB = (const char*)(cur.w ? g.Bt2 : g.Bt) + (size_t)(cur.pm / g.rpg) * g.bgs * 2 + (size_t)cur.pn * tstepB;
    PG8_STAGE(PG8_SB(0, 0), cB, voffB); PG8_STAGE(PG8_SB(0, 1), cB + hstepB, voffB); PG8_STAGE(PG8_SA(0, 0), cA, voffA); PG8_STAGE(PG8_SA(0, 1), cA + hstepA, voffA);
    if (wr == 1) PG8_BAR;
    PG8_WAIT_V(2); PG8_BAR;
    PG8_STAGE(PG8_SB(1, 0), cB + kstep, voffB); PG8_STAGE(PG8_SA(1, 0), cA + kstep, voffA); PG8_STAGE(PG8_SB(1, 1), cB + hstepB + kstep, voffB);
    PG8_WAIT_V(6); PG8_BAR;
    for (;;) {
        const bool has_next = S.next(ui + 1, nxt);
        const char* nA = has_next ? (const char*)(nxt.w ? g.A2 : g.A) + (size_t)nxt.pm * tstepA : cA;
        const char* nB = has_next ? (const char*)(nxt.w ? g.Bt2 : g.Bt) + (size_t)(nxt.pm / g.rpg) * g.bgs * 2 + (size_t)nxt.pn * tstepB : cB;
        for (int t = 0; t < nt; t += 2) {
            const bool last = (t == nt - 2);
            const char* a1 = cA + (size_t)(t + 1) * kstep;
            const char* a2 = last ? nA : cA + (size_t)(t + 2) * kstep; const char* b2 = last ? nB : cB + (size_t)(t + 2) * kstep;
            const char* a3 = a2 + kstep; const char* b3 = b2 + kstep;
            PG8_LDB(B0, 0, 0); PG8_LDB(B1, 0, 1); PG8_SCHED; PG8_LDA(At, 0, 0); PG8_STAGE(PG8_SA(1, 1), a1 + hstepA, voffA);
            PG8_WAIT_V(8); PG8_WAIT_L(0); PG8_BAR; PG8_MMA(0, 0, At, B0); PG8_MMA(0, 1, At, B1); PG8_BAR; PG8_SCHED;
            PG8_LDA(At, 0, 1); PG8_STAGE(PG8_SB(0, 0), b2, voffB); PG8_STAGE(PG8_SB(0, 1), b2 + hstepB, voffB); PG8_STAGE(PG8_SA(0, 0), a2, voffA);
            PG8_WAIT_V(8); PG8_WAIT_L(0); PG8_BAR; PG8_MMA(1, 0, At, B0); PG8_MMA(1, 1, At, B1); PG8_BAR; PG8_SCHED;
            PG8_LDB(B0, 1, 0); PG8_LDB(B1, 1, 1); PG8_SCHED; PG8_LDA(At, 1, 0); PG8_STAGE(PG8_SA(0, 1), a2 + hstepA, voffA);
            PG8_WAIT_V(8); PG8_WAIT_L(0); PG8_BAR; PG8_MMA(0, 0, At, B0); PG8_MMA(0, 1, At, B1); PG8_BAR; PG8_SCHED;
            PG8_LDA(At, 1, 1); PG8_STAGE(PG8_SB(1, 0), b3, voffB); PG8_STAGE(PG8_SB(1, 1), b3 + hstepB, voffB); PG8_STAGE(PG8_SA(1, 0), a3, voffA);
            PG8_WAIT_V(8); PG8_WAIT_L(0); PG8_BAR; PG8_MMA(1, 0, At, B0); PG8_MMA(1, 1, At, B1); PG8_BAR; PG8_SCHED;
        }
        if constexpr (ALIGN_EPI) { if (wr == 0) PG8_BAR; }
        E(acc, cur, wr, wc, fr, fq);
        if (!has_next) break;
#pragma unroll
        for (int a = 0; a < 2; ++a)
#pragma unroll
            for (int b = 0; b < 2; ++b)
#pragma unroll
                for (int m = 0; m < 4; ++m)
#pragma unroll
                    for (int n = 0; n < 2; ++n) acc[a][b][m][n] = (f32x4){0.f, 0.f, 0.f, 0.f};
        cur = nxt; cA = nA; cB = nB; ++ui;
        if constexpr (ALIGN_EPI) { if (wr == 1) PG8_BAR; }
    }
    PG8_WAIT_V(0);
    if constexpr (!ALIGN_EPI) { if (wr == 0) PG8_BAR; }
    PG8_BAR;
#undef PG8_SA
#undef PG8_SB
#undef PG8_STAGE
#undef PG8_LDA
#undef PG8_LDB
#undef PG8_MMA
#undef PG8_WAIT_V
#undef PG8_WAIT_L
#undef PG8_BAR
#undef PG8_SCHED
}
}
namespace attn_body {
using bf16=__hip_bfloat16;
using bf16x8=__attribute__((ext_vector_type(8)))short;
using s16x4=__attribute__((ext_vector_type(4)))short;
using f32x16=__attribute__((ext_vector_type(16)))float;
using f32x4v=__attribute__((ext_vector_type(4)))float;
using u32x4=__attribute__((ext_vector_type(4)))unsigned;
constexpr int BATCH=8,NHEAD=8,SEQ=2048,D=64,DM=NHEAD*D;
constexpr int NW=8,QBLK=32,QB=QBLK*NW,KVBLK=64,NQB=SEQ/QB;
__device__ __forceinline__ int crow(int r,int hi){return (r&3)+8*(r>>2)+4*hi;}
#define SBAR() __builtin_amdgcn_sched_barrier(0)
__device__ __forceinline__ void cmask(f32x16&p0,f32x16&p1,int jb,int qrel,int hi){
  const float NEG=-INFINITY; int kb=64*jb+4*hi;
  #pragma unroll
  for(int r=0;r<16;++r){int kv=kb+(r&3)+8*(r>>2); if(kv>qrel)p0[r]=NEG; if(kv+32>qrel)p1[r]=NEG;}
}
typedef __attribute__((address_space(3))) const float* lds_cfptr;
__device__ __forceinline__ void biasadd(f32x16&p0,f32x16&p1,int jb,int qrel,int hi,lds_cfptr bt){
  const int base=qrel-64*jb-4*hi;
  #pragma unroll
  for(int r4=0;r4<16;r4+=4){
    #pragma unroll
    for(int r=r4;r<r4+4;++r){int rel=base-((r&3)+8*(r>>2)); int i0=min(max(rel,0),127), i1=min(max(rel-32,0),127); p0[r]+=bt[i0]; p1[r]+=bt[i1];}
    asm volatile("s_waitcnt lgkmcnt(0)":"+v"(p0),"+v"(p1)::"memory"); }
}

constexpr int NSLOT=3, SLOTB=8192;
constexpr int LDS_K=0, LDS_V=NSLOT*SLOTB, LDS_WS=2*NSLOT*SLOTB, LDS_OST=LDS_WS+NW*64*4, LDS_KM=LDS_OST+NW*4096, LDS_BT=LDS_KM+7*64*4, LDS_BYTES=LDS_BT+128*4;
constexpr float C2=0.125f*1.4426950408889634f;
__device__ __forceinline__ void glds16(const void*gsrc,unsigned lds_dst){unsigned keep;
  asm volatile("s_mov_b32 %0, m0\n\ts_mov_b32 m0, %2\n\ts_nop 0\n\tglobal_load_lds_dwordx4 %1, off\n\ts_mov_b32 m0, %0":"=&s"(keep):"v"(gsrc),"s"(lds_dst):"memory");}
__device__ __forceinline__ float max3f(float a,float b,float c){float r;asm("v_max3_f32 %0, %1, %2, %3":"=v"(r):"v"(a),"v"(b),"v"(c));return r;}
__device__ __forceinline__ float max2f(float a,float b){float r;asm("v_max_f32_e32 %0, %1, %2":"=v"(r):"v"(a),"v"(b));return r;}
__device__ __forceinline__ float fadd_s(float a,float b){float r;asm("v_add_f32_e32 %0, %1, %2":"=v"(r):"v"(a),"v"(b));return r;}
__device__ __forceinline__ float fsub_s(float a,float b){float r;asm("v_sub_f32_e32 %0, %1, %2":"=v"(r):"v"(a),"v"(b));return r;}
typedef float f32x2_t __attribute__((ext_vector_type(2))); typedef __bf16 bf16x2_t __attribute__((ext_vector_type(2)));
__device__ __forceinline__ unsigned cvtpk_s(float lo,float hi){f32x2_t v={lo,hi};bf16x2_t b=__builtin_convertvector(v,bf16x2_t);return __builtin_bit_cast(unsigned,b);}
#define WAIT_BAR(N) asm volatile("s_waitcnt vmcnt(" #N ") lgkmcnt(0)\n\ts_barrier":::"memory")

__device__ __forceinline__ void qkt(f32x16&p0,f32x16&p1,const char*Kslot,const bf16x8*qr,int r32,int hi){
  const char*kb=Kslot+hi*1024+r32*16;
  #pragma unroll
  for(int d0=0;d0<4;++d0){
    const bf16x8 b0=*reinterpret_cast<const bf16x8*>(kb+d0*2048);
    const bf16x8 b1=*reinterpret_cast<const bf16x8*>(kb+d0*2048+512);
    if(d0==0){p0=__builtin_amdgcn_mfma_f32_32x32x16_bf16(b0,qr[0],(f32x16){},0,0,0);p1=__builtin_amdgcn_mfma_f32_32x32x16_bf16(b1,qr[0],(f32x16){},0,0,0);}
    else{p0=__builtin_amdgcn_mfma_f32_32x32x16_bf16(b0,qr[d0],p0,0,0,0);p1=__builtin_amdgcn_mfma_f32_32x32x16_bf16(b1,qr[d0],p1,0,0,0);}}
}
typedef __attribute__((address_space(3))) const char* lds_cptr;
typedef short v4i16_t __attribute__((ext_vector_type(4)));
__device__ __forceinline__ void kload8(bf16x8*kf,lds_cptr kp){
  kf[0]=*(const __attribute__((address_space(3))) bf16x8*)(kp);      kf[1]=*(const __attribute__((address_space(3))) bf16x8*)(kp+512);
  kf[2]=*(const __attribute__((address_space(3))) bf16x8*)(kp+2048); kf[3]=*(const __attribute__((address_space(3))) bf16x8*)(kp+2560);
  kf[4]=*(const __attribute__((address_space(3))) bf16x8*)(kp+4096); kf[5]=*(const __attribute__((address_space(3))) bf16x8*)(kp+4608);
  kf[6]=*(const __attribute__((address_space(3))) bf16x8*)(kp+6144); kf[7]=*(const __attribute__((address_space(3))) bf16x8*)(kp+6656);
}
__device__ __forceinline__ void kload2(bf16x8*kf,lds_cptr kp,int j){ kf[2*j]=*(const __attribute__((address_space(3))) bf16x8*)(kp+j*2048); kf[2*j+1]=*(const __attribute__((address_space(3))) bf16x8*)(kp+j*2048+512); }
__device__ __forceinline__ s16x4 vtr(lds_cptr p){ return __builtin_bit_cast(s16x4,__builtin_amdgcn_ds_read_tr16_b64_v4i16((__attribute__((address_space(3))) v4i16_t*)p)); }
__device__ __forceinline__ float rowmax(const f32x16&p0,const f32x16&p1){
  float a=max3f(p0[0],p0[1],p1[0]),b=max3f(p0[2],p0[3],p1[1]);a=max3f(a,p1[2],p1[3]);
  #pragma unroll
  for(int r=4;r<16;r+=4){a=max3f(a,p0[r],p0[r+1]);b=max3f(b,p0[r+2],p0[r+3]);a=max3f(a,p1[r],p1[r+1]);b=max3f(b,p1[r+2],p1[r+3]);}
  const float m=max2f(a,b);
  auto rr=__builtin_amdgcn_permlane32_swap(__float_as_uint(m),__float_as_uint(m),false,false);
  return max2f(__uint_as_float(rr[0]),__uint_as_float(rr[1]));
}
__device__ __forceinline__ void pv(f32x16*o,int vb,bf16x8 pa0,bf16x8 pa1,bf16x8 pa2,bf16x8 pa3){
  #pragma unroll
  for(int d0=0;d0<2;++d0){s16x4 lo[4],hi[4];
    #pragma unroll
    for(int ks=0;ks<4;++ks){
      asm volatile("ds_read_b64_tr_b16 %0,%1 offset:%c2":"=&v"(lo[ks]):"v"(vb),"i"(d0*4096+ks*1024):"memory");
      asm volatile("ds_read_b64_tr_b16 %0,%1 offset:%c2":"=&v"(hi[ks]):"v"(vb),"i"(d0*4096+ks*1024+512):"memory");}
    asm volatile("s_waitcnt lgkmcnt(0)":::"memory");SBAR();
    #define PK(k) (bf16x8){lo[k][0],lo[k][1],lo[k][2],lo[k][3],hi[k][0],hi[k][1],hi[k][2],hi[k][3]}
    o[d0]=__builtin_amdgcn_mfma_f32_32x32x16_bf16(pa0,PK(0),o[d0],0,0,0);
    o[d0]=__builtin_amdgcn_mfma_f32_32x32x16_bf16(pa1,PK(1),o[d0],0,0,0);
    o[d0]=__builtin_amdgcn_mfma_f32_32x32x16_bf16(pa2,PK(2),o[d0],0,0,0);
    o[d0]=__builtin_amdgcn_mfma_f32_32x32x16_bf16(pa3,PK(3),o[d0],0,0,0);
    #undef PK
  }
}

#ifndef ATTN_STORE16
#define ATTN_STORE16(p,v) (*(u32x4*)(p)=(v))
#endif
template<int THRL> __device__ __forceinline__ void attn_unit(int b,int h,int qb,const bf16*Q,const bf16*__restrict__ K,const bf16*__restrict__ V,bf16*O,char*shm,const float*kpart,const float*btab){
  int tid=threadIdx.x; asm volatile("":"+v"(tid));
  const int lane=tid&63,r32=lane&31,hi=lane>>5; const int wid=__builtin_amdgcn_readfirstlane(tid>>6);
  const long rowbase=(long)b*SEQ; const int q0=qb*QB;
  const bf16*Qw=Q+(rowbase+q0+wid*QBLK)*DM+h*D;
  const bf16*Kh=K+rowbase*DM+h*D,*Vh=V+rowbase*DM+h*D;
  const unsigned lds0=(unsigned)(uintptr_t)shm;
  float*wsf=(float*)(shm+LDS_WS)+wid*64;
  const bf16*ksrc=Kh+(long)lane*DM+wid*8;
  const bf16*vsrc=Vh+(long)(16*(wid&3)+(lane>>2))*DM+(wid>>2)*32+(lane&3)*8;
  const unsigned kdst=lds0+LDS_K+wid*1024, vdst=lds0+LDS_V+wid*1024;
  #define DMA_K(t,slot) glds16(ksrc+(long)(t)*KVBLK*DM,(unsigned)__builtin_amdgcn_readfirstlane(kdst+(slot)))
  #define DMA_V(t,slot) glds16(vsrc+(long)(t)*KVBLK*DM,(unsigned)__builtin_amdgcn_readfirstlane(vdst+(slot)))
  const int vb0=(int)(lds0+LDS_V)+((lane>>4)&1)*32+(lane&3)*8+(4*hi+((lane&15)>>2))*64;
  const char*Kbase=shm+LDS_K; bf16x8 kf[8];
  const lds_cptr shm3=(lds_cptr)shm; const lds_cptr kp0=shm3+LDS_K+hi*1024+r32*16; const lds_cptr vp0=shm3+LDS_V+((lane>>4)&1)*32+(lane&3)*8+(4*hi+((lane&15)>>2))*64;
  const lds_cfptr btl=(lds_cfptr)(shm3+LDS_BT);
  const int NT=(q0+QB)/KVBLK;
  DMA_K(0,0);DMA_V(0,0);DMA_K(1,SLOTB);
  bf16x8 qr[4];
  #pragma unroll
  for(int d0=0;d0<4;++d0)qr[d0]=*reinterpret_cast<const bf16x8*>(&Qw[(long)r32*DM+d0*16+hi*8]);
  { float*km=(float*)(shm+LDS_KM); float*bt=(float*)(shm+LDS_BT); int tq=tid; asm volatile("":"+v"(tq));
    if(tq<448){const int j=tq>>6,d=tq&63; float v=0.f; if(j<qb&&qb>3){const float*kp=kpart+((size_t)((b*NQB+j)*2)*512)+h*D+d; v=(kp[0]+kp[512])*(1.0f/256.0f);} km[tq]=v;}
    else if(tq<448+64){const int i=tq-448; bt[i]=btab[h*128+i]; bt[64+i]=btab[h*128+64+i];} }
  float mhat=0.f,l_reg=0.f;f32x16 o[2];o[0]=f32x16{};o[1]=f32x16{};
  const int qrel=wid*QBLK+r32;
  #define CMASK(P0,P1,t) do{int jb_=(t)-(NT-4);   \
    if(jb_>=-2 && 32*wid+31-64*jb_>=0 && 32*wid-64*jb_-63<=112)biasadd(P0,P1,jb_,qrel,hi,btl); if(jb_>=0 && 64*jb_+63>32*wid)cmask(P0,P1,jb_,qrel,hi);}while(0)
  bool resc=false;
  #define START(P0,P1,t) do{ float rm=rowmax(P0,P1); resc=false; const float nv_=MASKADD(t); rm=fadd_s(rm,nv_); \
    { const float dl=__builtin_fmaxf(rm,-1.0e4f); mhat=fadd_s(mhat,dl); const float cc_=fsub_s(nv_,dl); \
      _Pragma("unroll") for(int r=0;r<16;++r){P0[r]=fadd_s(P0[r],cc_);P1[r]=fadd_s(P1[r],cc_);} } \
    _Pragma("unroll") for(int r=0;r<16;++r)P0[r]=__builtin_amdgcn_exp2f(P0[r]); }while(0)
  #define RESC() do{ if(resc){ asm volatile("s_waitcnt lgkmcnt(0)":::"memory"); \
      _Pragma("unroll") for(int d_=0;d_<2;++d_) _Pragma("unroll") for(int r=0;r<16;++r)o[d_][r]*=wsf[crow(r,hi)]; } }while(0)
  f32x16 pA0,pA1,pB0,pB1;
  int sl_prev=0,sl_cur=0,sl_next=SLOTB;
  #define ROT() do{sl_prev=sl_cur;sl_cur=sl_next;sl_next=(sl_next==(NSLOT-1)*SLOTB)?0:sl_next+SLOTB;}while(0)
  DMA_K(2,2*SLOTB);
  WAIT_BAR(3);
  unsigned selbits=(1u<<qb)-1u;
  if(qb>3){ selbits=0u;
    const __attribute__((address_space(3))) float* km3=(const __attribute__((address_space(3))) float*)(shm3+LDS_KM);
    float qf[32];
    #pragma unroll
    for(int d0=0;d0<4;++d0){
      #pragma unroll
      for(int i=0;i<8;++i) qf[d0*8+i]=__uint_as_float(((unsigned)(unsigned short)qr[d0][i])<<16);}
    float gj[7];
    #pragma unroll
    for(int j=0;j<7;++j){ float s=0.f;
      if(j<qb){
        #pragma unroll
        for(int d0=0;d0<4;++d0){ const f32x4v k0=*(const __attribute__((address_space(3))) f32x4v*)(km3+j*64+d0*16+hi*8); const f32x4v k1=*(const __attribute__((address_space(3))) f32x4v*)(km3+j*64+d0*16+hi*8+4);
          s+=qf[d0*8+0]*k0[0]+qf[d0*8+1]*k0[1]+qf[d0*8+2]*k0[2]+qf[d0*8+3]*k0[3]+qf[d0*8+4]*k1[0]+qf[d0*8+5]*k1[1]+qf[d0*8+6]*k1[2]+qf[d0*8+7]*k1[3]; }
        auto rr=__builtin_amdgcn_permlane32_swap(__float_as_uint(s),__float_as_uint(s),false,false); s=__uint_as_float(rr[0])+__uint_as_float(rr[1]); }
      gj[j]=s; }
    #pragma unroll
    for(int j=0;j<7;++j){ int rank=0;
      #pragma unroll
      for(int k=0;k<7;++k){ if(k!=j){ const bool beats=(k<j)?(gj[k]>=gj[j]):(gj[k]>gj[j]); rank+=(k<qb&&beats)?1:0; } }
      if(j<qb&&rank<3)selbits|=(1u<<j); }
  }
  #define MASKADD(t) ((((t)>>2)<qb && !((selbits>>((t)>>2))&1u))?-1.0e30f:0.0f)
  qkt(pA0,pA1,Kbase,qr,r32,hi);asm volatile("s_nop 15\n\ts_nop 7":"+v"(pA0),"+v"(pA1));CMASK(pA0,pA1,0);
  START(pA0,pA1,0);
  _Pragma("unroll") for(int r=0;r<16;++r)pA1[r]=__builtin_amdgcn_exp2f(pA1[r]);
  WAIT_BAR(0);
  DMA_K(3,0);DMA_V(1,SLOTB);
  ROT();
  kload8(kf,kp0+sl_cur);
  WAIT_BAR(2);
  s16x4 vlo[8],vhi[8]; u32x4 pw0,pw1,pw2,pw3;
  #define PKW(P,B) cvtpk_s(P[B],P[B+1])
  #define PAF(k) __builtin_bit_cast(bf16x8,pw##k)
  #define VFR(i) (bf16x8){vlo[i][0],vlo[i][1],vlo[i][2],vlo[i][3],vhi[i][0],vhi[i][1],vhi[i][2],vhi[i][3]}
  #define PIN(x) asm volatile("":"+v"(x))
  #define MX3(a,b,c) __builtin_fmaxf(__builtin_fmaxf((a),(b)),(c))
  #define GAPA(MF,A0,A1,A2,A3,W0,W1,PW) do{ MF; sacc+=A0; sacc+=A1; sacc+=A2; sacc+=A3; PIN(sacc); W0; W1; PIN(PW); SBAR(); }while(0)
  #define EX(v) __builtin_amdgcn_exp2f(v)
  #define GAPB(MF,X,B) do{ MF; X[B]=EX(X[B]); X[B+1]=EX(X[B+1]); X[B+2]=EX(X[B+2]); X[B+3]=EX(X[B+3]); PIN(X); SBAR(); }while(0)
  #define VRD(i) do{ vlo[i]=vtr(vp_+(((i)>>2)*4096+((i)&3)*1024)); vhi[i]=vtr(vp_+(((i)>>2)*4096+((i)&3)*1024+512)); }while(0)
  #define KRD(G,j) do{ if(G){ kload2(kf,kp0+sl_next,j); SBAR(); } }while(0)
  #define STEP(C0,C1,P0,P1,t,GK,GV,GL) do{ SBAR(); \
    const lds_cptr vp_=vp0+sl_prev; \
    VRD(0); SBAR(); float sacc=(P0[0]+P0[1]); \
    GAPA(C0=__builtin_amdgcn_mfma_f32_32x32x16_bf16(kf[0],qr[0],(f32x16){},0,0,0), P0[2],P0[3],P0[4],P0[5],     pw0[0]=PKW(P0,0), pw0[1]=PKW(P0,2), pw0); \
    VRD(4); SBAR(); GAPA(C1=__builtin_amdgcn_mfma_f32_32x32x16_bf16(kf[1],qr[0],(f32x16){},0,0,0), P0[6],P0[7],P0[8],P0[9],     pw0[2]=PKW(P0,4), pw0[3]=PKW(P0,6), pw0); \
    VRD(1); SBAR(); GAPA(C0=__builtin_amdgcn_mfma_f32_32x32x16_bf16(kf[2],qr[1],C0,0,0,0),   P0[10],P0[11],P0[12],P0[13], pw1[0]=PKW(P0,8), pw1[1]=PKW(P0,10), pw1); \
    VRD(5); SBAR(); GAPA(C1=__builtin_amdgcn_mfma_f32_32x32x16_bf16(kf[3],qr[1],C1,0,0,0),   P0[14],P0[15],P1[0],P1[1],   pw1[2]=PKW(P0,12),pw1[3]=PKW(P0,14), pw1); \
    VRD(2); SBAR(); GAPA(C0=__builtin_amdgcn_mfma_f32_32x32x16_bf16(kf[4],qr[2],C0,0,0,0),   P1[2],P1[3],P1[4],P1[5],     pw2[0]=PKW(P1,0), pw2[1]=PKW(P1,2), pw2); \
    VRD(6); SBAR(); GAPA(C1=__builtin_amdgcn_mfma_f32_32x32x16_bf16(kf[5],qr[2],C1,0,0,0),   P1[6],P1[7],P1[8],P1[9],     pw2[2]=PKW(P1,4), pw2[3]=PKW(P1,6), pw2); \
    VRD(3); SBAR(); GAPA(C0=__builtin_amdgcn_mfma_f32_32x32x16_bf16(kf[6],qr[3],C0,0,0,0),   P1[10],P1[11],P1[12],P1[13], pw3[0]=PKW(P1,8), pw3[1]=PKW(P1,10), pw3); \
    VRD(7); SBAR(); GAPA(C1=__builtin_amdgcn_mfma_f32_32x32x16_bf16(kf[7],qr[3],C1,0,0,0),   P1[14],P1[15],0.f,0.f,       pw3[2]=PKW(P1,12),pw3[3]=PKW(P1,14), pw3); \
    l_reg+=sacc; \
    if(GK){DMA_K((t)+3,sl_cur);} if(GV){DMA_V((t)+1,sl_next);} \
    CMASK(C0,C1,t); \
    { float a=MX3(C0[0],C0[1],C1[0]),b=MX3(C0[2],C0[3],C1[1]); a=MX3(a,C1[2],C1[3]); \
      _Pragma("unroll") for(int r=4;r<16;r+=4){a=MX3(a,C0[r],C0[r+1]);b=MX3(b,C0[r+2],C0[r+3]);a=MX3(a,C1[r],C1[r+1]);b=MX3(b,C1[r+2],C1[r+3]);} \
      float rm=__builtin_fmaxf(a,b); { auto rr=__builtin_amdgcn_permlane32_swap(__float_as_uint(rm),__float_as_uint(rm),false,false); rm=__builtin_fmaxf(__uint_as_float(rr[0]),__uint_as_float(rr[1])); } \
      const float nv_=MASKADD(t)-mhat; rm+=nv_; float cc_=nv_; \
      resc=false; \
      if(__builtin_expect(__any(rm>(float)THRL),0)){ const float dl=__builtin_fmaxf(rm,0.f); mhat+=dl; cc_-=dl; \
        const float f=__builtin_amdgcn_exp2f(-dl); l_reg*=f; if(hi==0)wsf[r32]=f; resc=true; } \
      _Pragma("unroll") for(int r=0;r<16;++r){C0[r]+=cc_;C1[r]+=cc_;} } \
    SBAR(); \
    GAPB(o[0]=__builtin_amdgcn_mfma_f32_32x32x16_bf16(PAF(0),VFR(0),o[0],0,0,0), C0,0); \
    GAPB(o[1]=__builtin_amdgcn_mfma_f32_32x32x16_bf16(PAF(0),VFR(4),o[1],0,0,0), C0,4); \
    KRD(GL,0); GAPB(o[0]=__builtin_amdgcn_mfma_f32_32x32x16_bf16(PAF(1),VFR(1),o[0],0,0,0), C0,8); \
    KRD(GL,1); GAPB(o[1]=__builtin_amdgcn_mfma_f32_32x32x16_bf16(PAF(1),VFR(5),o[1],0,0,0), C0,12); \
    KRD(GL,2); GAPB(o[0]=__builtin_amdgcn_mfma_f32_32x32x16_bf16(PAF(2),VFR(2),o[0],0,0,0), C1,0); \
    KRD(GL,3); GAPB(o[1]=__builtin_amdgcn_mfma_f32_32x32x16_bf16(PAF(2),VFR(6),o[1],0,0,0), C1,4); \
    GAPB(o[0]=__builtin_amdgcn_mfma_f32_32x32x16_bf16(PAF(3),VFR(3),o[0],0,0,0), C1,8); \
    GAPB(o[1]=__builtin_amdgcn_mfma_f32_32x32x16_bf16(PAF(3),VFR(7),o[1],0,0,0), C1,12); \
    }while(0)
  int t=1;
  #undef CMASK
  #define CMASK(P0,P1,t) do{}while(0)
  for(;t+7<NT;t+=2){
    STEP(pB0,pB1,pA0,pA1,t,true,true,true);     WAIT_BAR(2); RESC(); ROT();
    STEP(pA0,pA1,pB0,pB1,t+1,true,true,true);   WAIT_BAR(2); RESC(); ROT();
  }
  #undef CMASK
  #define CMASK(P0,P1,t) do{int jb_=(t)-(NT-4);   \
    if(jb_>=-2 && 32*wid+31-64*jb_>=0 && 32*wid-64*jb_-63<=112)biasadd(P0,P1,jb_,qrel,hi,btl); if(jb_>=0 && 64*jb_+63>32*wid)cmask(P0,P1,jb_,qrel,hi);}while(0)
  #define ENDW(tt) do{ if((tt)+3<NT){WAIT_BAR(2);} else if((tt)+2<NT){WAIT_BAR(1);} else {WAIT_BAR(0);} }while(0)
  for(;t+1<NT;t+=2){
    STEP(pB0,pB1,pA0,pA1,t,(t+3<NT),(t+1<NT),(t+1<NT));       ENDW(t);   RESC(); ROT();
    STEP(pA0,pA1,pB0,pB1,t+1,(t+4<NT),(t+2<NT),(t+2<NT));     ENDW(t+1); RESC(); ROT();
  }
  STEP(pB0,pB1,pA0,pA1,NT-1,false,false,false); RESC();
  { float sacc=pB0[0]+pB0[1]; _Pragma("unroll") for(int r=2;r<16;++r)sacc+=pB0[r]; _Pragma("unroll") for(int r=0;r<16;++r)sacc+=pB1[r]; l_reg+=sacc;
    pw0=(u32x4){PKW(pB0,0),PKW(pB0,2),PKW(pB0,4),PKW(pB0,6)};pw1=(u32x4){PKW(pB0,8),PKW(pB0,10),PKW(pB0,12),PKW(pB0,14)};pw2=(u32x4){PKW(pB1,0),PKW(pB1,2),PKW(pB1,4),PKW(pB1,6)};pw3=(u32x4){PKW(pB1,8),PKW(pB1,10),PKW(pB1,12),PKW(pB1,14)};
    SBAR(); pv(o,vb0+sl_cur,PAF(0),PAF(1),PAF(2),PAF(3)); }
  #undef PKW
  #undef PAF
  #undef VFR
  #undef PIN
  #undef MX3
  #undef GAPA
  #undef GAPB
  #undef EX
  #undef VRD
  #undef KRD
  #undef STEP
  #undef ENDW
  #undef MASKADD
  {auto rr=__builtin_amdgcn_permlane32_swap(__float_as_uint(l_reg),__float_as_uint(l_reg),false,false);l_reg=__uint_as_float(rr[0])+__uint_as_float(rr[1]);}
  if(hi==0)wsf[32+r32]=l_reg;asm volatile("s_waitcnt lgkmcnt(0)":::"memory");
  float rli[16];
  #pragma unroll
  for(int r=0;r<16;++r)rli[r]=__builtin_amdgcn_rcpf(wsf[32+crow(r,hi)]);
  bf16*Ow=O+(rowbase+q0+wid*QBLK)*DM+h*D;
  { bf16*stg=(bf16*)(shm+LDS_OST)+wid*2048;
    #pragma unroll
    for(int r=0;r<16;++r){const int orow=crow(r,hi);
      #pragma unroll
      for(int d0=0;d0<2;++d0)stg[orow*64+d0*32+r32]=__float2bfloat16(o[d0][r]*rli[r]);}
    asm volatile("s_waitcnt lgkmcnt(0)":::"memory");
    #pragma unroll
    for(int i=0;i<4;++i){const int row=i*8+(lane>>3),ch=lane&7; const u32x4 v=*(const u32x4*)(stg+row*64+ch*8); ATTN_STORE16(Ow+(long)row*DM+ch*8,v);} }
  asm volatile("s_waitcnt lgkmcnt(0)\n\ts_barrier":::"memory");
  #undef DMA_K
  #undef DMA_V
  #undef CMASK
  #undef START
  #undef RESC
  #undef ROT
}
constexpr int ATTN_LDS_BYTES=LDS_BYTES;
#undef SBAR
#undef WAIT_BAR
}
constexpr int NWAVES = 8;
constexpr int PER_PHASE = 10;
constexpr int N_LAUNCHES = MK_N_LAUNCHES;

constexpr int BATCH = 8, SEQ = 2048, DMODEL = 1024, MTOK = BATCH * SEQ;
constexpr int INCOLS = 4096, SSMW = 512, NGRP = 32, CH = 32  , NCHUNK = SEQ / CH  , APK = 640  ;
constexpr int PQ = 2048, NEXP = 16384;
constexpr float RMS_EPS = 1e-6f;

constexpr size_t MiB = 1u << 20;
constexpr size_t WS_CTL = 0, CTL_ZERO_BYTES = 64 * 1024;
constexpr size_t WS_BIAS = 1 * MiB;
constexpr size_t WS_PW32 = 1 * MiB + 64 * 1024;
constexpr size_t WS_KPART = 1 * MiB + 128 * 1024;
constexpr size_t WS_KG = 2 * MiB;
constexpr size_t WS_SSQ1 = 3 * MiB;
constexpr size_t WS_WIN = 6 * MiB, WS_WQ = 14 * MiB, WS_WOUT = 18 * MiB, WS_WUS = 20 * MiB, WS_WUA = 21 * MiB, WS_WGLU = 22 * MiB, WS_KS = 22 * MiB + 512 * 1024;
constexpr size_t WS_WE = 23 * MiB;
constexpr size_t WS_BP = 32 * MiB;
constexpr size_t WS_AP = 52 * MiB;
constexpr size_t WS_E = 72 * MiB;
constexpr size_t WS_H = 80 * MiB;
constexpr size_t WS_YPRE = 80 * MiB, WS_YA = 96 * MiB, WS_XG = 80 * MiB;
constexpr size_t WS_Z = 96 * MiB, ZSTRIDE_B = 16 * MiB;
constexpr size_t WS_MRG = 128 * MiB;
constexpr size_t WS_PQ = 160 * MiB;
constexpr size_t WS_IDS = 224 * MiB, WS_GTS = 232 * MiB;
constexpr size_t WS_U16 = 32 * MiB, WS_V16 = 240 * MiB;
constexpr size_t WS_YB = 224 * MiB;
constexpr size_t WS_WPK = 128 * MiB, WS_RSTD1 = 4 * MiB, WS_Y16 = 160 * MiB;
constexpr size_t WS_END = 256 * MiB;
constexpr int CW_BAR = 1024;

constexpr int RING_OFF = 0, RING_BYTES = 131072;
constexpr int LDSCTL_OFF = RING_BYTES, MISC_OFF = LDSCTL_OFF + 320;
constexpr int LDS_BYTES = 147456;

#define GAS __attribute__((address_space(1)))
#define LAS __attribute__((address_space(3)))
typedef unsigned short bf16;
typedef unsigned v4u __attribute__((ext_vector_type(4)));
typedef float f32x4 __attribute__((ext_vector_type(4)));
typedef short bf16x8 __attribute__((ext_vector_type(8)));
typedef float f32x16 __attribute__((ext_vector_type(16)));
typedef __bf16 bf16x2_t __attribute__((ext_vector_type(2)));
typedef _Float16 h2_t __attribute__((ext_vector_type(2)));
typedef GAS unsigned gu32;
#define RLX_AGENT __ATOMIC_RELAXED, __HIP_MEMORY_SCOPE_AGENT
#define LDS_WAIT() asm volatile("s_waitcnt lgkmcnt(0)" ::: "memory")
#define VM_WAIT() asm volatile("s_waitcnt vmcnt(0)" ::: "memory")
__device__ __forceinline__ unsigned f2bf(float f) { unsigned u = __builtin_bit_cast(unsigned, f); return (u + 0x7fffu + ((u >> 16) & 1u)) >> 16; }
__device__ __forceinline__ unsigned pk2(float lo, float hi) { return f2bf(lo) | (f2bf(hi) << 16); }
using pg8::cvt_pk_bf16; using pg8::bf_lo; using pg8::bf_hi; using pg8::sigmoid_f; using pg8::gelu_tanh;

#define XB_TMO      128
#define XB_XCNT(j)  (256  + 64 * (j))
#define XB_XSUB(j)  (1280 + 64 * (j))
#define XB_XGEN(j)  (2304 + 64 * (j))
#define XB_TOP      3328
#define XB_TOPGEN   3392
#define XCD_BAR_WORDS 3456
#define XB_SPIN_CAP (1u << 18)
__device__ __forceinline__ unsigned xb_ld(unsigned* p)              { return __hip_atomic_load(p, __ATOMIC_RELAXED, __HIP_MEMORY_SCOPE_AGENT); }
__device__ __forceinline__ unsigned xb_add(unsigned* p, unsigned v) { return __hip_atomic_fetch_add(p, v, __ATOMIC_RELAXED, __HIP_MEMORY_SCOPE_AGENT); }
__device__ __forceinline__ unsigned xb_xcc_id() { return (unsigned)__builtin_amdgcn_s_getreg((3 << 11) | 20) & 0xFu; }
#define XB_SPIN(cond, bar) do { unsigned _sp = 0; while (cond) { __builtin_amdgcn_s_sleep(1); \
    if ((++_sp & 255u) == 0u) { if (xb_ld(&(bar)[XB_TMO])) break; if (_sp > XB_SPIN_CAP) { atomicAdd(&(bar)[XB_TMO], 1u); break; } } } } while (0)
struct XcdBarrier { unsigned* bar; unsigned x; volatile LAS unsigned* st; };
__device__ __forceinline__ XcdBarrier xcd_barrier_post(unsigned* bar, volatile LAS unsigned* st) {
    XcdBarrier b; b.bar = bar; b.x = xb_xcc_id(); b.st = st;
    if (threadIdx.x == 0) (void)xb_add(&bar[XB_XCNT(b.x)], 1u);
    return b;
}
__device__ __forceinline__ void xcd_barrier_complete(unsigned* bar, unsigned x, unsigned& nloc, unsigned& nx) {
    const unsigned G = gridDim.x * gridDim.y * gridDim.z;
    unsigned sum, cnt, mine, sp = 0u;
    for (;;) {
        sum = 0u; cnt = 0u; mine = 0u;
#pragma unroll
        for (unsigned j = 0; j < 16; ++j) { const unsigned c = xb_ld(&bar[XB_XCNT(j)]); sum += c; cnt += (c > 0u) ? 1u : 0u; mine = (j == x) ? c : mine; }
        if (sum == G) break;
        __builtin_amdgcn_s_sleep(1);
        if ((++sp & 255u) == 0u) { if (xb_ld(&bar[XB_TMO])) break; if (sp > XB_SPIN_CAP) { atomicAdd(&bar[XB_TMO], 1u); break; } }
    }
    nloc = mine > 0u ? mine : 1u; nx = cnt > 0u ? cnt : 1u;
}
__device__ __forceinline__ void xcd_barrier(const XcdBarrier& b) {
    asm volatile("s_waitcnt vmcnt(0)" ::: "memory");
    __syncthreads();
    if (threadIdx.x == 0) {
        unsigned* bar = b.bar;
        __builtin_amdgcn_s_waitcnt(0);
        unsigned nloc = b.st[0], nx = b.st[1];
        if (nloc == 0u) { xcd_barrier_complete(bar, b.x, nloc, nx); b.st[0] = nloc; b.st[1] = nx; }
        const unsigned old = xb_add(&bar[XB_XSUB(b.x)], 1u);
        const unsigned gen = old / nloc;
        if (old + 1u == (gen + 1u) * nloc) {
            __builtin_amdgcn_fence(__ATOMIC_RELEASE, "agent");
            asm volatile("s_waitcnt vmcnt(0)" ::: "memory");
            const unsigned og = xb_add(&bar[XB_TOP], 1u);
            const unsigned tg = og / nx;
            if (og + 1u == (tg + 1u) * nx) xb_add(&bar[XB_TOPGEN], 1u);
            else XB_SPIN(xb_ld(&bar[XB_TOPGEN]) == tg, bar);
            __builtin_amdgcn_fence(__ATOMIC_ACQUIRE, "agent");
            xb_add(&bar[XB_XGEN(b.x)], 1u);
            asm volatile("s_waitcnt vmcnt(0)" ::: "memory");
        } else {
            XB_SPIN(xb_ld(&bar[XB_XGEN(b.x)]) == gen, bar);
            __builtin_amdgcn_fence(__ATOMIC_ACQUIRE, "agent");
            asm volatile("s_waitcnt vmcnt(0)" ::: "memory");
        }
    }
    __syncthreads();
}

__device__ __forceinline__ float wave_sum(float v) {
#pragma unroll
    for (int o = 1; o < 64; o <<= 1) v += __shfl_xor(v, o);
    return v;
}

namespace pg8 {
struct EpiIn {
    static constexpr bool PERM = true;
    bf16_t* zbase; bf16_t* AP; float* kpart;
    __device__ __forceinline__ void operator()(const f32x4 (&acc)[2][2][4][2], const Unit& u, int wr, int wc, int fr, int fq) const {
        const int t = u.pn >> 1, colt = (u.pn & 1) * 256;
        const int row0 = u.pm * BM + wr * 64 + fr, col0 = colt + wc * 32 + 8 * fq;
        if (t == 0) {
#pragma unroll
            for (int ai = 0; ai < 2; ++ai)
#pragma unroll
                for (int m = 0; m < 4; ++m) { const int r = row0 + ai * HALF + m * 16, b = r >> 11, l = r & 2047;
#pragma unroll
                    for (int bj = 0; bj < 2; ++bj) { const int c = col0 + bj * HALF, g = c >> 4, hi0 = c & 15;
                        const f32x4 v0 = acc[ai][bj][m][0], v1 = acc[ai][bj][m][1];
                        u32x4 w; w.x = cvt_pk_bf16(v0[0], v0[1]); w.y = cvt_pk_bf16(v0[2], v0[3]); w.z = cvt_pk_bf16(v1[0], v1[1]); w.w = cvt_pk_bf16(v1[2], v1[3]);
                        *(u32x4*)(AP + (size_t)(g * 512 + b * 64 + (l >> 5)) * 640 + (l & 31) * 16 + hi0) = w; } }
        } else {
            bf16_t* base = zbase + (size_t)t * (16u * 1024u * 1024u / 2u);
            const float sc = (t == 1) ? 0.125f * 1.4426950408889634f : 1.0f;
#pragma unroll
            for (int ai = 0; ai < 2; ++ai)
#pragma unroll
                for (int m = 0; m < 4; ++m) { bf16_t* rowp = base + (size_t)(row0 + ai * HALF + m * 16) * 512 + col0;
#pragma unroll
                    for (int bj = 0; bj < 2; ++bj) { f32x4 v0 = acc[ai][bj][m][0], v1 = acc[ai][bj][m][1];
                        if (t >= 4) {
#pragma unroll
                            for (int e = 0; e < 4; ++e) { v0[e] = sigmoid_f(v0[e]); v1[e] = sigmoid_f(v1[e]); }
                        } else { v0 = v0 * sc; v1 = v1 * sc; }
                        u32x4 w; w.x = cvt_pk_bf16(v0[0], v0[1]); w.y = cvt_pk_bf16(v0[2], v0[3]); w.z = cvt_pk_bf16(v1[0], v1[1]); w.w = cvt_pk_bf16(v1[2], v1[3]);
                        *(u32x4*)(rowp + bj * HALF) = w; } }
            if (t == 2) {
#pragma unroll
                for (int bj = 0; bj < 2; ++bj)
#pragma unroll
                    for (int n = 0; n < 2; ++n) { f32x4 s = (f32x4){0.f, 0.f, 0.f, 0.f};
#pragma unroll
                        for (int ai = 0; ai < 2; ++ai)
#pragma unroll
                            for (int m = 0; m < 4; ++m) s += acc[ai][bj][m][n];
#pragma unroll
                        for (int e = 0; e < 4; ++e) { float x = s[e]; x += __shfl_xor(x, 1); x += __shfl_xor(x, 2); x += __shfl_xor(x, 4); x += __shfl_xor(x, 8); s[e] = x; }
                        if (fr == 0) *(f32x4*)(kpart + (size_t)(u.pm * 2 + wr) * 512 + col0 + bj * HALF + 4 * n) = s; }
            }
        }
    }
};
struct EpiE {
    static constexpr bool PERM = false;
    float* E;
    __device__ __forceinline__ void operator()(const f32x4 (&acc)[2][2][4][2], const Unit& u, int wr, int wc, int fr, int fq) const {
        const int row0 = u.pm * BM + wr * 64 + fr, col0 = wc * 32 + 4 * fq;
#pragma unroll
        for (int ai = 0; ai < 2; ++ai)
#pragma unroll
            for (int m = 0; m < 4; ++m) { float* rowp = E + (size_t)(row0 + ai * HALF + m * 16) * 128 + col0;
#pragma unroll
                for (int n = 0; n < 2; ++n) *(f32x4*)(rowp + n * 16) = acc[ai][0][m][n]; }
    }
};
struct EpiY {
    static constexpr bool PERM = true;
    bf16_t* Y;
    __device__ __forceinline__ void operator()(const f32x4 (&acc)[2][2][4][2], const Unit& u, int wr, int wc, int fr, int fq) const {
        const int row0 = u.pm * BM + wr * 64 + fr, col0 = u.pn * BM + wc * 32 + 8 * fq;
#pragma unroll
        for (int ai = 0; ai < 2; ++ai)
#pragma unroll
            for (int m = 0; m < 4; ++m) { const int r = row0 + ai * HALF + m * 16, g = r >> 9, b = (r >> 6) & 7, c = r & 63;
#pragma unroll
                for (int bj = 0; bj < 2; ++bj) { const int cc = col0 + bj * HALF, j = cc >> 4, ho0 = cc & 15;
                    f32x4 v0 = acc[ai][bj][m][0], v1 = acc[ai][bj][m][1];
#pragma unroll
                    for (int e = 0; e < 4; ++e) { v0[e] = gelu_tanh(v0[e]); v1[e] = gelu_tanh(v1[e]); }
                    u32x4 w; w.x = cvt_pk_bf16(v0[0], v0[1]); w.y = cvt_pk_bf16(v0[2], v0[3]); w.z = cvt_pk_bf16(v1[0], v1[1]); w.w = cvt_pk_bf16(v1[2], v1[3]);
                    *(u32x4*)(Y + (size_t)(b * 2048 + c * 32 + j) * 512 + g * 16 + ho0) = w; } }
    }
};
struct EpiGlu {
    static constexpr bool PERM = true;
    const bf16_t* Yp; bf16_t* Ya; const float* bias;
    __device__ __forceinline__ void operator()(const f32x4 (&acc)[2][2][4][2], const Unit& u, int wr, int wc, int fr, int fq) const {
        const int row0 = u.pm * BM + wr * 64 + fr, col0 = u.pn * BM + wc * 32 + 8 * fq;
        f32x4 bv[2][2];
#pragma unroll
        for (int bj = 0; bj < 2; ++bj)
#pragma unroll
            for (int n = 0; n < 2; ++n) bv[bj][n] = *(const f32x4*)(bias + col0 + bj * HALF + 4 * n);
#pragma unroll
        for (int ai = 0; ai < 2; ++ai)
#pragma unroll
            for (int m = 0; m < 4; ++m) { const size_t off = (size_t)(row0 + ai * HALF + m * 16) * 512 + col0;
#pragma unroll
                for (int bj = 0; bj < 2; ++bj) { const f32x4 z0 = acc[ai][bj][m][0] + bv[bj][0], z1 = acc[ai][bj][m][1] + bv[bj][1];
                    const u32x4 y = *(const u32x4*)(Yp + off + bj * HALF);
                    u32x4 w; w.x = cvt_pk_bf16(bf_lo(y.x) * sigmoid_f(z0[0]), bf_hi(y.x) * sigmoid_f(z0[1])); w.y = cvt_pk_bf16(bf_lo(y.y) * sigmoid_f(z0[2]), bf_hi(y.y) * sigmoid_f(z0[3]));
                    w.z = cvt_pk_bf16(bf_lo(y.z) * sigmoid_f(z1[0]), bf_hi(y.z) * sigmoid_f(z1[1])); w.w = cvt_pk_bf16(bf_lo(y.w) * sigmoid_f(z1[2]), bf_hi(y.w) * sigmoid_f(z1[3]));
                    *(u32x4*)(Ya + off + bj * HALF) = w; } }
    }
};
template <int ADD> struct EpiMrg {
    static constexpr bool PERM = true;
    const bf16_t* G0; bf16_t* Mrg;
    __device__ __forceinline__ void operator()(const f32x4 (&acc)[2][2][4][2], const Unit& u, int wr, int wc, int fr, int fq) const {
        const int row0 = u.pm * BM + wr * 64 + fr, cin = wc * 32 + 8 * fq;
        const bf16_t* gb = G0 + (size_t)(u.pn >> 1) * (16u * 1024u * 1024u / 2u) + (u.pn & 1) * 256 + cin;
#pragma unroll
        for (int ai = 0; ai < 2; ++ai)
#pragma unroll
            for (int m = 0; m < 4; ++m) { const int r = row0 + ai * HALF + m * 16;
#pragma unroll
                for (int bj = 0; bj < 2; ++bj) {
#if defined(ABL_NO_SSM) || defined(ABL_NO_ATT)
#if defined(ABL_NO_SSM)
                    constexpr bool kill = (ADD == 0);
#else
                    constexpr bool kill = (ADD == 1);
#endif
                    const f32x4 a0 = kill ? (f32x4){0.f, 0.f, 0.f, 0.f} : acc[ai][bj][m][0], a1 = kill ? (f32x4){0.f, 0.f, 0.f, 0.f} : acc[ai][bj][m][1];
#else
                    const f32x4 a0 = acc[ai][bj][m][0], a1 = acc[ai][bj][m][1];
#endif
                    const u32x4 gt = *(const u32x4*)(gb + (size_t)r * 512 + bj * HALF);
                    bf16_t* mp = Mrg + (size_t)r * 1024 + u.pn * BM + cin + bj * HALF;
                    float o[8] = { bf_lo(gt.x) * a0[0], bf_hi(gt.x) * a0[1], bf_lo(gt.y) * a0[2], bf_hi(gt.y) * a0[3], bf_lo(gt.z) * a1[0], bf_hi(gt.z) * a1[1], bf_lo(gt.w) * a1[2], bf_hi(gt.w) * a1[3] };
                    if (ADD) { const u32x4 p = *(const u32x4*)mp; o[0] += bf_lo(p.x); o[1] += bf_hi(p.x); o[2] += bf_lo(p.y); o[3] += bf_hi(p.y); o[4] += bf_lo(p.z); o[5] += bf_hi(p.z); o[6] += bf_lo(p.w); o[7] += bf_hi(p.w); }
                    u32x4 w; w.x = cvt_pk_bf16(o[0], o[1]); w.y = cvt_pk_bf16(o[2], o[3]); w.z = cvt_pk_bf16(o[4], o[5]); w.w = cvt_pk_bf16(o[6], o[7]);
                    *(u32x4*)mp = w; } }
    }
};
struct EpiMrgDual {
    static constexpr bool PERM = true;
    EpiMrg<0> a; EpiMrg<1> b;
    __device__ __forceinline__ void operator()(const f32x4 (&acc)[2][2][4][2], const Unit& u, int wr, int wc, int fr, int fq) const { if (u.w == 0) a(acc, u, wr, wc, fr, fq); else b(acc, u, wr, wc, fr, fq); }
};
struct EpiX1 {
    static constexpr bool PERM = true;
    const float* X; float* X1; bf16_t* XG; const float* g2; float* ssq;
    __device__ __forceinline__ void operator()(const f32x4 (&acc)[2][2][4][2], const Unit& u, int wr, int wc, int fr, int fq) const {
        const int row0 = u.pm * BM + wr * 64 + fr, col0 = u.pn * BM + wc * 32 + 8 * fq;
        f32x4 gv[2][2];
#pragma unroll
        for (int bj = 0; bj < 2; ++bj)
#pragma unroll
            for (int n = 0; n < 2; ++n) gv[bj][n] = *(const f32x4*)(g2 + col0 + bj * HALF + 4 * n);
#pragma unroll
        for (int ai = 0; ai < 2; ++ai)
#pragma unroll
            for (int m = 0; m < 4; ++m) { const int r = row0 + ai * HALF + m * 16; const size_t off = (size_t)r * 1024 + col0; float s = 0.f;
#pragma unroll
                for (int bj = 0; bj < 2; ++bj) {
                    #ifdef ABL_NO_MIX
                    const f32x4 x0 = *(const f32x4*)(X + off + bj * HALF), x1 = *(const f32x4*)(X + off + bj * HALF + 4);
#else
                    const f32x4 x0 = *(const f32x4*)(X + off + bj * HALF) + acc[ai][bj][m][0], x1 = *(const f32x4*)(X + off + bj * HALF + 4) + acc[ai][bj][m][1];
#endif
                    *(f32x4*)(X1 + off + bj * HALF) = x0; *(f32x4*)(X1 + off + bj * HALF + 4) = x1;
                    s += (x0[0] * x0[0] + x0[1] * x0[1]) + (x0[2] * x0[2] + x0[3] * x0[3]) + (x1[0] * x1[0] + x1[1] * x1[1]) + (x1[2] * x1[2] + x1[3] * x1[3]);
                    const f32x4 a = x0 * gv[bj][0], b = x1 * gv[bj][1];
                    u32x4 w; w.x = cvt_pk_bf16(a[0], a[1]); w.y = cvt_pk_bf16(a[2], a[3]); w.z = cvt_pk_bf16(b[0], b[1]); w.w = cvt_pk_bf16(b[2], b[3]);
                    *(u32x4*)(XG + off + bj * HALF) = w; }
                s += __shfl_xor(s, 16); s += __shfl_xor(s, 32);
                if (fq == 0) ssq[(size_t)r * 16 + u.pn * 4 + wc] = s; }
    }
};
struct EpiPlain {
    static constexpr bool PERM = true;
    bf16_t* O; int ldc;
    __device__ __forceinline__ void operator()(const f32x4 (&acc)[2][2][4][2], const Unit& u, int wr, int wc, int fr, int fq) const {
        const int row0 = u.pm * BM + wr * 64 + fr, col0 = u.pn * BM + wc * 32 + 8 * fq;
#pragma unroll
        for (int ai = 0; ai < 2; ++ai)
#pragma unroll
            for (int m = 0; m < 4; ++m) { bf16_t* rowp = O + (size_t)(row0 + ai * HALF + m * 16) * ldc + col0;
#pragma unroll
                for (int bj = 0; bj < 2; ++bj) { const f32x4 v0 = acc[ai][bj][m][0], v1 = acc[ai][bj][m][1];
                    u32x4 w; w.x = cvt_pk_bf16(v0[0], v0[1]); w.y = cvt_pk_bf16(v0[2], v0[3]); w.z = cvt_pk_bf16(v1[0], v1[1]); w.w = cvt_pk_bf16(v1[2], v1[3]);
                    *(u32x4*)(rowp + bj * HALF) = w; } }
    }
};
}
struct Frame {
    LAS unsigned char* lds;
    int tid, lane, wave, vcu, G;
};

__device__ __forceinline__ void p0_transpose_item(const float* W, int K, int N, bf16* WT, LAS float* scr, int item, int lane) {
    const int nblk = N / 32, kb = item / nblk, nb = item % nblk, k0 = 64 * kb, n0 = 32 * nb;
    float wv[32];
#pragma unroll
    for (int i = 0; i < 32; ++i) { const int kk = 2 * i + (lane >> 5); wv[i] = W[(size_t)(k0 + kk) * N + n0 + (lane & 31)]; }
#pragma unroll
    for (int i = 0; i < 32; ++i) { const int kk = 2 * i + (lane >> 5); scr[kk * 33 + (lane & 31)] = wv[i]; }
    LDS_WAIT(); asm volatile("" ::: "memory");
    const int c = lane & 7;
#pragma unroll
    for (int j = 0; j < 4; ++j) { const int n = (lane >> 3) + 8 * j; const LAS float* s = scr + (8 * c) * 33 + n;
        v4u o; o.x = pk2(s[0 * 33], s[1 * 33]); o.y = pk2(s[2 * 33], s[3 * 33]); o.z = pk2(s[4 * 33], s[5 * 33]); o.w = pk2(s[6 * 33], s[7 * 33]);
        *(GAS v4u*)(WT + (size_t)(n0 + n) * K + k0 + 8 * c) = o; }
    LDS_WAIT(); asm volatile("" ::: "memory");
}
__device__ __forceinline__ void rms_row_to_bf16(const float* xrow, const float* g, bf16* orow, int lane) {
    const GAS f32x4* xr = (const GAS f32x4*)xrow + lane; const GAS f32x4* gr = (const GAS f32x4*)g + lane;
    f32x4 v[4]; float s = 0.f;
#pragma unroll
    for (int j = 0; j < 4; ++j) { v[j] = xr[64 * j]; s += (v[j].x * v[j].x + v[j].y * v[j].y) + (v[j].z * v[j].z + v[j].w * v[j].w); }
    const float rstd = 1.0f / sqrtf(wave_sum(s) * (1.f / DMODEL) + RMS_EPS);
    GAS unsigned long long* o8 = (GAS unsigned long long*)orow + lane;
#pragma unroll
    for (int j = 0; j < 4; ++j) { const f32x4 gg = gr[64 * j];
        o8[64 * j] = (unsigned long long)pk2(v[j].x * rstd * gg.x, v[j].y * rstd * gg.y) | ((unsigned long long)pk2(v[j].z * rstd * gg.z, v[j].w * rstd * gg.w) << 32); }
}
__device__ __forceinline__ void rms_rows4_to_bf16(const float* x, const float* g, bf16* out, int m, int stride, int lane) {
    f32x4 v[4][4];
#pragma unroll
    for (int k = 0; k < 4; ++k) { const int mm = (m + k * stride < MTOK) ? m + k * stride : m; const GAS f32x4* xr = (const GAS f32x4*)(x + (size_t)mm * DMODEL) + lane;
#pragma unroll
        for (int j = 0; j < 4; ++j) v[k][j] = xr[64 * j]; }
    const GAS f32x4* gr = (const GAS f32x4*)g + lane; f32x4 gg[4];
#pragma unroll
    for (int j = 0; j < 4; ++j) gg[j] = gr[64 * j];
#pragma unroll
    for (int k = 0; k < 4; ++k) { if (m + k * stride >= MTOK) break; float s = 0.f;
#pragma unroll
        for (int j = 0; j < 4; ++j) s += (v[k][j].x * v[k][j].x + v[k][j].y * v[k][j].y) + (v[k][j].z * v[k][j].z + v[k][j].w * v[k][j].w);
        const float rstd = 1.0f / sqrtf(wave_sum(s) * (1.f / DMODEL) + RMS_EPS);
        GAS unsigned long long* o8 = (GAS unsigned long long*)(out + (size_t)(m + k * stride) * DMODEL) + lane;
#pragma unroll
        for (int j = 0; j < 4; ++j) o8[64 * j] = (unsigned long long)pk2(v[k][j].x * rstd * gg[j].x, v[k][j].y * rstd * gg[j].y) | ((unsigned long long)pk2(v[k][j].z * rstd * gg[j].z, v[k][j].w * rstd * gg[j].w) << 32); }
}
struct cpx { float r, i; };
__device__ __forceinline__ cpx cmul(cpx a, cpx b) { return cpx{a.r * b.r - a.i * b.i, a.r * b.i + a.i * b.r}; }
__device__ __forceinline__ cpx cpow_(float ar, float ai, float dt, int n) { const float e = expf(ar * dt * (float)n); const float ang = ai * dt * (float)n; return cpx{e * cosf(ang), e * sinf(ang)}; }
__device__ __forceinline__ void ssm_table_task(int g, int j, int lane, LAS float* scr, const float* a_re, const float* a_im, const float* log_dt, const float* b_re, const float* b_im,
                                               const float* c_re, const float* c_im, float* Kg, bf16* WE, bf16* BP, float* pw32) {
    const int p = lane;
    const float dt = expf(log_dt[g]), ar = a_re[g * 64 + p], ai = a_im[g * 64 + p];
#define pw(n) cpow_(ar, ai, dt, (n))
    const cpx lb = pw(1);
    const float den = ar * ar + ai * ai;
    const cpx coef = cpx{((lb.r - 1.f) * ar + lb.i * ai) / den, (lb.i * ar - (lb.r - 1.f) * ai) / den};
    const cpx pj = pw(j), pe = pw(31 - j), pv = pw(j + 1);
    unsigned wer[8], wei[8];
#pragma unroll
    for (int h2 = 0; h2 < 8; ++h2) { float er[2], ei[2];
#pragma unroll
        for (int q = 0; q < 2; ++q) { const int hi = 2 * h2 + q;
            const cpx bb = cmul(coef, cpx{b_re[(g * 64 + p) * 16 + hi], b_im[(g * 64 + p) * 16 + hi]});
            const cpx w = cmul(pj, bb); scr[(p * 16 + hi) * 2] = w.r; scr[(p * 16 + hi) * 2 + 1] = w.i;
            const cpx e = cmul(pe, bb); er[q] = e.r; ei[q] = e.i; }
        wer[h2] = pk2(er[0], er[1]); wei[h2] = pk2(ei[0], ei[1]); }
    { bf16* w0 = WE + ((size_t)(g * 256 + p) * 512 + j * 16); bf16* w1 = WE + ((size_t)(g * 256 + 64 + p) * 512 + j * 16);
      *(GAS v4u*)w0 = (v4u){wer[0], wer[1], wer[2], wer[3]}; *(GAS v4u*)(w0 + 8) = (v4u){wer[4], wer[5], wer[6], wer[7]};
      *(GAS v4u*)w1 = (v4u){wei[0], wei[1], wei[2], wei[3]}; *(GAS v4u*)(w1 + 8) = (v4u){wei[4], wei[5], wei[6], wei[7]};
      bf16* z0 = WE + ((size_t)(g * 256 + 128 + p) * 512 + j * 16); bf16* z1 = WE + ((size_t)(g * 256 + 192 + p) * 512 + j * 16); const v4u z = (v4u){0u, 0u, 0u, 0u};
      *(GAS v4u*)z0 = z; *(GAS v4u*)(z0 + 8) = z; *(GAS v4u*)z1 = z; *(GAS v4u*)(z1 + 8) = z; }
#pragma unroll 4
    for (int ho = 0; ho < 16; ++ho) { const cpx cv = cmul(cpx{c_re[(g * 16 + ho) * 64 + p], c_im[(g * 16 + ho) * 64 + p]}, pv);
        bf16* row = BP + ((size_t)(g * 512 + j * 16 + ho) * APK + 512);
        row[p] = (bf16)f2bf(cv.r); row[64 + p] = (bf16)f2bf(-cv.i); }
    if (j == 0) { const cpx p32 = pw(32); pw32[g * 128 + p] = p32.r; pw32[g * 128 + 64 + p] = p32.i; }
    LDS_WAIT(); asm volatile("" ::: "memory");
    { const int ho = lane >> 2, h4 = (lane & 3) * 4; float a0 = 0.f, a1 = 0.f, a2 = 0.f, a3 = 0.f;
      const float* cr = c_re + (g * 16 + ho) * 64; const float* ci = c_im + (g * 16 + ho) * 64;
#pragma unroll 4
      for (int pp = 0; pp < 64; ++pp) { const float r_ = cr[pp], i_ = ci[pp]; const LAS float* w = scr + (pp * 16 + h4) * 2;
          a0 += r_ * w[0] - i_ * w[1]; a1 += r_ * w[2] - i_ * w[3]; a2 += r_ * w[4] - i_ * w[5]; a3 += r_ * w[6] - i_ * w[7]; }
      *(GAS f32x4*)(Kg + ((size_t)(g * 32 + j) * 256 + ho * 16 + h4)) = (f32x4){a0, a1, a2, a3}; }
    LDS_WAIT(); asm volatile("" ::: "memory");
#undef pw
}

__device__ __forceinline__ float vmaxf(float a, float b) { float r; asm("v_max_f32_e32 %0, %1, %2" : "=v"(r) : "v"(a), "v"(b)); return r; }
__device__ __forceinline__ float vminf(float a, float b) { float r; asm("v_min_f32_e32 %0, %1, %2" : "=v"(r) : "v"(a), "v"(b)); return r; }
__device__ __forceinline__ float selhi(float lo, float hi) { float r; asm("v_cndmask_b32_e64 %0, %1, %2, %3" : "=v"(r) : "v"(lo), "v"(hi), "s"(0xFFFFFFFF00000000ull)); return r; }
#define CE_DESC(a, b) do { const float hi_ = vmaxf(a, b), lo_ = vminf(a, b); a = hi_; b = lo_; } while (0)
__device__ __forceinline__ void sort16_desc(float (&v)[16]) {
#pragma unroll
    for (int k = 2; k <= 16; k <<= 1)
#pragma unroll
        for (int j = k >> 1; j > 0; j >>= 1)
#pragma unroll
            for (int i = 0; i < 16; ++i) { const int l = i ^ j; if (l > i) { if ((i & k) == 0) CE_DESC(v[i], v[l]); else CE_DESC(v[l], v[i]); } }
}
__device__ __forceinline__ void bitonic_merge16_desc(float (&v)[16]) {
#pragma unroll
    for (int j = 8; j > 0; j >>= 1)
#pragma unroll
        for (int i = 0; i < 16; ++i) { const int l = i ^ j; if (l > i) CE_DESC(v[i], v[l]); }
}
__device__ __forceinline__ void merge_top16(float (&a)[16], const float (&b)[16]) {
#pragma unroll
    for (int i = 0; i < 16; ++i) a[i] = vmaxf(a[i], b[15 - i]);
    bitonic_merge16_desc(a);
}
__device__ __forceinline__ void merge_partner_top16(float (&a)[16]) {
    float p[16];
#pragma unroll
    for (int i = 0; i < 16; ++i) { const unsigned x = __float_as_uint(a[15 - i]); auto rr = __builtin_amdgcn_permlane32_swap(x, x, false, false); p[i] = selhi(__uint_as_float(rr[1]), __uint_as_float(rr[0])); }
#pragma unroll
    for (int i = 0; i < 16; ++i) a[i] = vmaxf(a[i], p[i]);
    bitonic_merge16_desc(a);
}
__device__ __forceinline__ void topk_half(int half, const bf16x8 (&qf)[8], int r32, int hi, const LAS unsigned char* ksl, float (&top)[16]) {
#pragma unroll 1
    for (int kt = 0; kt < 4; ++kt) {
        f32x16 acc = f32x16{};
        const int row = half * 128 + kt * 32 + r32; const LAS unsigned char* rp = ksl + row * 256; const int sw = row & 15;
#pragma unroll
        for (int ks = 0; ks < 8; ++ks) { const bf16x8 a = *(const LAS bf16x8*)(rp + (((2 * ks + hi) ^ sw) << 4));
            acc = __builtin_amdgcn_mfma_f32_32x32x16_bf16(a, qf[ks], acc, 0, 0, 0); }
        float grp[16];
#pragma unroll
        for (int r = 0; r < 16; ++r) { const unsigned key = (unsigned)(kt * 32 + (r & 3) + 8 * (r >> 2)) + 4u * (unsigned)hi; grp[r] = __uint_as_float((__float_as_uint(acc[r]) & ~127u) | key); }
        sort16_desc(grp);
        if (kt == 0) {
#pragma unroll
            for (int i = 0; i < 16; ++i) top[i] = grp[i];
        } else merge_top16(top, grp);
    }
    merge_partner_top16(top);
}
__device__ __forceinline__ void topk_task(int tt, int hd, int lane, LAS unsigned char* scr, const bf16* PQb, const LAS unsigned char* ksl, const float* ssq1, int* ids, float* gts, float* rstd1) {
    const int r32 = lane & 31, hi = lane >> 5; const bool hib = hi != 0;
    const int token = tt * 32 + r32;
    float v0_[16], v1_[16];
    bf16x8 qf0[8], qf1[8];
#pragma unroll
    for (int ks = 0; ks < 8; ++ks) { qf0[ks] = *(const GAS bf16x8*)(PQb + (size_t)token * PQ + hd * 256 + ks * 16 + hi * 8); qf1[ks] = *(const GAS bf16x8*)(PQb + (size_t)token * PQ + hd * 256 + 128 + ks * 16 + hi * 8); }
    topk_half(0, qf0, r32, hi, ksl, v0_);
    topk_half(1, qf1, r32, hi, ksl, v1_);
#define v_SEL(h, i) ((h) ? v1_[i] : v0_[i])
    LAS unsigned char* slot = scr + lane * 32;
    { v4u d0, d1;
#define PK4(h, k) ((__float_as_uint(v_SEL(h, 4 * (k))) & 127u) | ((__float_as_uint(v_SEL(h, 4 * (k) + 1)) & 127u) << 8) | ((__float_as_uint(v_SEL(h, 4 * (k) + 2)) & 127u) << 16) | ((__float_as_uint(v_SEL(h, 4 * (k) + 3)) & 127u) << 24))
      d0 = (v4u){PK4(0, 0), PK4(0, 1), PK4(0, 2), PK4(0, 3)}; d1 = (v4u){PK4(1, 0), PK4(1, 1), PK4(1, 2), PK4(1, 3)};
#undef PK4
      *(LAS v4u*)slot = d0; *(LAS v4u*)(slot + 16) = d1; }
    float a[16], b[16];
#pragma unroll
    for (int i = 0; i < 16; ++i) { a[i] = selhi(v0_[i], v1_[i]); b[i] = selhi(v1_[i], v0_[i]); }
    const unsigned obit = (unsigned)hi << 8;
#define CAND(i, j) __uint_as_float((__float_as_uint(a[i] + b[j]) & ~511u) | obit | (unsigned)(((i) << 4) | (j)))
    const float NEGBIG = -3.0e38f;
    float g0[16], g1[16];
#pragma unroll
    for (int j = 1; j < 16; ++j) g0[j - 1] = CAND(0, j);
    g0[15] = CAND(1, 2);
    g1[0] = CAND(1, 3); g1[1] = CAND(1, 4); g1[2] = CAND(1, 5); g1[3] = CAND(1, 6); g1[4] = CAND(1, 7); g1[5] = CAND(2, 3); g1[6] = CAND(2, 4);
    { const float c0 = CAND(0, 0), c1 = CAND(1, 1), c2 = CAND(2, 2), c3 = CAND(3, 3);
      g1[7] = selhi(c0, NEGBIG); g1[8] = selhi(c1, NEGBIG); g1[9] = selhi(c2, NEGBIG); g1[10] = selhi(c3, NEGBIG); }
#pragma unroll
    for (int i = 11; i < 16; ++i) g1[i] = NEGBIG;
#undef CAND
    sort16_desc(g0); sort16_desc(g1); merge_top16(g0, g1); merge_partner_top16(g0);
    float rstd;
    { const GAS f32x4* sp = (const GAS f32x4*)(ssq1 + (size_t)token * 16); const f32x4 s0 = sp[0], s1 = sp[1], s2 = sp[2], s3 = sp[3];
      const float ss = ((s0.x + s0.y) + (s0.z + s0.w)) + ((s1.x + s1.y) + (s1.z + s1.w)) + ((s2.x + s2.y) + (s2.z + s2.w)) + ((s3.x + s3.y) + (s3.z + s3.w));
      rstd = 1.0f / sqrtf(ss * (1.f / DMODEL) + RMS_EPS); }
    if (hd == 0 && !hib) rstd1[token] = rstd;
    float ex[16], esum = 0.f; const float sc = rstd * 1.4426950409f;
#pragma unroll
    for (int k = 0; k < 16; ++k) { ex[k] = __builtin_amdgcn_exp2f((g0[k] - g0[0]) * sc); esum += ex[k]; }
    const float inv = 1.0f / esum;
    int eid[8]; float gv[8];
#pragma unroll
    for (int k = 0; k < 8; ++k) { const float wv = selhi(g0[k], g0[8 + k]); const float ev = selhi(ex[k], ex[8 + k]);
        const unsigned tag = __float_as_uint(wv) & 511u, o = tag >> 8, i = (tag >> 4) & 15u, j = tag & 15u; const unsigned i1 = o ? j : i, i2 = o ? i : j;
        const unsigned k1 = slot[i1], k2 = slot[16 + i2];
        eid[k] = (int)(k1 * 128u + k2); gv[k] = ev * inv; }
    { int* ip = ids + (size_t)token * 128 + hd * 16 + 8 * hi; float* gp = gts + (size_t)token * 128 + hd * 16 + 8 * hi;
      *(GAS v4u*)ip = (v4u){(unsigned)eid[0], (unsigned)eid[1], (unsigned)eid[2], (unsigned)eid[3]}; *(GAS v4u*)(ip + 4) = (v4u){(unsigned)eid[4], (unsigned)eid[5], (unsigned)eid[6], (unsigned)eid[7]};
      *(GAS f32x4*)gp = (f32x4){gv[0], gv[1], gv[2], gv[3]}; *(GAS f32x4*)(gp + 4) = (f32x4){gv[4], gv[5], gv[6], gv[7]}; }
    LDS_WAIT(); asm volatile("" ::: "memory");
}


__device__ __forceinline__ float dot2bf(unsigned a, unsigned b, float c) { return __builtin_amdgcn_fdot2_f32_bf16(__builtin_bit_cast(bf16x2_t, a), __builtin_bit_cast(bf16x2_t, b), c, false); }
__device__ __forceinline__ h2_t fma_h2(unsigned v, h2_t w, h2_t acc) { return __builtin_elementwise_fma(__builtin_bit_cast(h2_t, v), w, acc); }
__device__ __forceinline__ unsigned fp8lo_bf(unsigned w, float sc) { return __builtin_bit_cast(unsigned, __builtin_amdgcn_cvt_scalef32_pk_bf16_fp8((int)w, sc, false)); }
__device__ __forceinline__ unsigned fp8hi_bf(unsigned w, float sc) { return __builtin_bit_cast(unsigned, __builtin_amdgcn_cvt_scalef32_pk_bf16_fp8((int)w, sc, true)); }
__device__ __forceinline__ h2_t fp8lo_h(unsigned w, float sc) { return __builtin_amdgcn_cvt_scalef32_pk_f16_fp8((int)w, sc, false); }
__device__ __forceinline__ h2_t fp8hi_h(unsigned w, float sc) { return __builtin_amdgcn_cvt_scalef32_pk_f16_fp8((int)w, sc, true); }
__device__ __forceinline__ unsigned pack_fp8x4(float a, float b, float c, float d) { int w = __builtin_amdgcn_cvt_pk_fp8_f32(a, b, 0, false); w = __builtin_amdgcn_cvt_pk_fp8_f32(c, d, w, true); return (unsigned)w; }
constexpr float U8_SCALE = 64.0f, V8_SCALE = 4.0f;
constexpr int PA_CAP = 464;
constexpr float X8_SCALE = 2.0f;
typedef int v8i_t __attribute__((ext_vector_type(8)));
typedef _Float16 v32h_t __attribute__((ext_vector_type(32)));
typedef unsigned v6u_t __attribute__((ext_vector_type(6)));
typedef unsigned v2u __attribute__((ext_vector_type(2)));
struct TokB { v8i_t b[8]; };
struct RowsA { const unsigned char* p0; const unsigned char* p1; };
__device__ __forceinline__ int pa_tok(unsigned tl, int tb, int nwg) { return ((tl < 4u) ? tb : nwg) + (int)(tl & 3u); }
__device__ __forceinline__ RowsA pa_rows(int b, int n, int lane, const LAS unsigned* list, const unsigned char* U6) {
    const int i0 = b * 16 + (lane >> 3), r8 = lane >> 3, ps = lane & 7;
    const unsigned e0 = list[i0 < n ? i0 : 0], e1 = list[i0 + 8 < n ? i0 + 8 : 0];
    RowsA R; R.p0 = U6 + (size_t)(e0 & 0x3fffu) * 768 + ((ps ^ r8) * 16); R.p1 = U6 + (size_t)(e1 & 0x3fffu) * 768 + ((ps ^ r8 ^ 1) * 16);
    return R;
}
__device__ __forceinline__ void pa_dma(const RowsA& R, int j, LAS unsigned char* ring) {
    __builtin_amdgcn_global_load_lds((const unsigned*)(R.p0 + j * 128), (LAS unsigned*)(ring + j * 2048), 16, 0, 0);
    __builtin_amdgcn_global_load_lds((const unsigned*)(R.p1 + j * 128), (LAS unsigned*)(ring + j * 2048 + 1024), 16, 0, 0);
}
#define PA_VWAIT(n) asm volatile("s_waitcnt vmcnt(" #n ")" ::: "memory")
__device__ __forceinline__ int pa_uoff(int u, int r) { return (u >> 4) * 2048 + (r >> 3) * 1024 + (r & 7) * 128 + ((((u >> 1) & 7) ^ (r & 7) ^ (r >> 3)) << 4) + (u & 1) * 8; }
__device__ __forceinline__ f32x4 pa_mma(f32x4 acc, const TokB& X, int m, const LAS unsigned char* ring, int r, int g) {
    const int u = 12 * m + 3 * g;
    const v2u d0 = *(const LAS v2u*)(ring + pa_uoff(u, r)), d1 = *(const LAS v2u*)(ring + pa_uoff(u + 1, r)), d2 = *(const LAS v2u*)(ring + pa_uoff(u + 2, r));
    LDS_WAIT(); asm volatile("" ::: "memory");
    return __builtin_amdgcn_mfma_scale_f32_16x16x128_f8f6f4((v8i_t){(int)d0.x, (int)d0.y, (int)d1.x, (int)d1.y, (int)d2.x, (int)d2.y, 0, 0}, X.b[m], acc, 2, 2, 0, 0, 0, 0);
}
__device__ __forceinline__ void pa_flush(int n, const TokB& X, int lane, const LAS unsigned* list, LAS unsigned* gl, LAS unsigned char* ring, const unsigned char* U6, unsigned* wpk, int tb, int nwg) {
    if (n == 0) return;
    LDS_WAIT(); asm volatile("" ::: "memory");
    const int nb = (n + 15) >> 4;
    const int r = lane & 15, g = lane >> 4;
    RowsA cur = pa_rows(0, n, lane, list, U6), nxt = cur;
#pragma unroll
    for (int j = 0; j < 6; ++j) pa_dma(cur, j, ring);
    for (int b = 0; b < nb; ++b) {
        f32x4 acc0 = {0.f, 0.f, 0.f, 0.f}, acc1 = {0.f, 0.f, 0.f, 0.f};
        if (b + 1 < nb) {
            nxt = pa_rows(b + 1, n, lane, list, U6);
            PA_VWAIT(10); acc0 = pa_mma(acc0, X, 0, ring, r, g);
            PA_VWAIT(8);  acc1 = pa_mma(acc1, X, 1, ring, r, g); pa_dma(nxt, 0, ring);
            PA_VWAIT(8);  acc0 = pa_mma(acc0, X, 2, ring, r, g); pa_dma(nxt, 1, ring);
                          acc1 = pa_mma(acc1, X, 3, ring, r, g); pa_dma(nxt, 2, ring);
            PA_VWAIT(10); acc0 = pa_mma(acc0, X, 4, ring, r, g);
            PA_VWAIT(8);  acc1 = pa_mma(acc1, X, 5, ring, r, g); pa_dma(nxt, 3, ring);
            PA_VWAIT(8);  acc0 = pa_mma(acc0, X, 6, ring, r, g); pa_dma(nxt, 4, ring);
                          acc1 = pa_mma(acc1, X, 7, ring, r, g); pa_dma(nxt, 5, ring);
            cur = nxt;
        } else {
            PA_VWAIT(0);
#pragma unroll
            for (int m = 0; m < 8; m += 2) { acc0 = pa_mma(acc0, X, m, ring, r, g); acc1 = pa_mma(acc1, X, m + 1, ring, r, g); }
        }
        const f32x4 acc = acc0 + acc1;
        const int i0 = b * 16 + g * 4; const v4u e4 = *(const LAS v4u*)(list + i0);
        const unsigned en[4] = {e4.x, e4.y, e4.z, e4.w}; const float av[4] = {acc.x, acc.y, acc.z, acc.w};
#pragma unroll
        for (int i = 0; i < 4; ++i) { const unsigned ent = en[i], tl = ent >> 21, slot = (ent >> 14) & 127u;
            if (i0 + i < n && tl == (unsigned)r) { const int t = pa_tok(tl, tb, nwg);
                const _Float16 wh = (_Float16)(__uint_as_float(gl[tl * 128 + slot]) * gelu_tanh(av[i] * (1.0f / (U8_SCALE * X8_SCALE))));
                wpk[(size_t)t * 128 + slot] = ((unsigned)__builtin_bit_cast(unsigned short, wh) << 16) | (ent & 0x3fffu); } }
    }
    LDS_WAIT(); asm volatile("" ::: "memory");
}
__device__ __forceinline__ void peer_a_phase(int lane, int wave, int G, int vcu, const bf16* XG, const unsigned char* U6, const int* ids, const float* gts, const float* rstd1, unsigned* wpk, LAS unsigned char* lds, int emask) {
    (void)emask;
    LAS unsigned char* ring = lds + RING_OFF + wave * 16384;
    LAS unsigned* gl = (LAS unsigned*)(ring + 12288);
    LAS unsigned* list = (LAS unsigned*)(lds + MISC_OFF + 128 + wave * (PA_CAP * 4));
    for (int tile0 = vcu; tile0 < MTOK / 32; tile0 += 2 * G) {
        const int tile1 = tile0 + G; const bool has1 = tile1 < MTOK / 32;
        const int tb = tile0 * 32 + wave * 4, nwg = (has1 ? tile1 : tile0) * 32 + wave * 4;
        int id0[8], id1[8];
#pragma unroll
        for (int k = 0; k < 8; ++k) { const bool ok = (k < 4) || has1; const int tc = pa_tok((unsigned)k, tb, nwg);
            gl[k * 128 + lane] = __float_as_uint(gts[(size_t)tc * 128 + lane]); gl[k * 128 + 64 + lane] = __float_as_uint(gts[(size_t)tc * 128 + 64 + lane]);
            id0[k] = ok ? ids[(size_t)tc * 128 + lane] : -1; id1[k] = ok ? ids[(size_t)tc * 128 + 64 + lane] : -1; }
#pragma unroll
        for (int p = 0; p < 4; ++p) { const int k = 2 * p + (lane >> 5), tc = pa_tok((unsigned)k, tb, nwg);
            typedef float v16f_t __attribute__((ext_vector_type(16)));
            const GAS v4u* xs = (const GAS v4u*)(XG + (size_t)tc * 1024 + 32 * (lane & 31));
            const v4u x0 = xs[0], x1 = xs[1], x2 = xs[2], x3 = xs[3];
            const float rs = rstd1[tc] * X8_SCALE;
            const unsigned w[16] = {x0.x, x0.y, x0.z, x0.w, x1.x, x1.y, x1.z, x1.w, x2.x, x2.y, x2.z, x2.w, x3.x, x3.y, x3.z, x3.w};
            float f[32];
#pragma unroll
            for (int i = 0; i < 16; ++i) { f[2 * i] = __uint_as_float(w[i] << 16) * rs; f[2 * i + 1] = __uint_as_float(w[i] & 0xffff0000u) * rs; }
            const v16f_t lo16 = {f[0], f[1], f[2], f[3], f[4], f[5], f[6], f[7], f[8], f[9], f[10], f[11], f[12], f[13], f[14], f[15]},
                         hi16 = {f[16], f[17], f[18], f[19], f[20], f[21], f[22], f[23], f[24], f[25], f[26], f[27], f[28], f[29], f[30], f[31]};
            v6u_t p6; asm volatile("s_nop 1\n\tv_cvt_scalef32_2xpk16_fp6_f32 %0, %1, %2, 1.0" : "=&v"(p6) : "v"(lo16), "v"(hi16));
            LAS v2u* dst = (LAS v2u*)(ring + k * 768 + 24 * (lane & 31)); dst[0] = (v2u){p6[0], p6[1]}; dst[1] = (v2u){p6[2], p6[3]}; dst[2] = (v2u){p6[4], p6[5]}; }
        LDS_WAIT(); asm volatile("" ::: "memory");
        TokB X;
#pragma unroll
        for (int m = 0; m < 8; ++m) { const LAS v2u* xp = (const LAS v2u*)(ring + (lane & 7) * 768 + m * 96 + (lane >> 4) * 24);
            const v2u d0 = xp[0], d1 = xp[1], d2 = xp[2];
            X.b[m] = (v8i_t){(int)d0.x, (int)d0.y, (int)d1.x, (int)d1.y, (int)d2.x, (int)d2.y, 0, 0}; }
        LDS_WAIT(); asm volatile("" ::: "memory");
        for (int part = 0; part < 8; ++part) {
            int n = 0;
#pragma unroll
            for (int k = 0; k < 8; ++k) {
                { const bool sel = (id0[k] >> 11) == part; const unsigned long long m = __ballot(sel);
                  const int pos = n + (int)__builtin_amdgcn_mbcnt_hi((unsigned)(m >> 32), __builtin_amdgcn_mbcnt_lo((unsigned)m, 0u));
                  if (sel) list[pos] = ((unsigned)k << 21) | ((unsigned)lane << 14) | (unsigned)id0[k]; n += __builtin_popcountll(m); }
                { const bool sel = (id1[k] >> 11) == part; const unsigned long long m = __ballot(sel);
                  const int pos = n + (int)__builtin_amdgcn_mbcnt_hi((unsigned)(m >> 32), __builtin_amdgcn_mbcnt_lo((unsigned)m, 0u));
                  if (sel) list[pos] = ((unsigned)k << 21) | ((unsigned)(64 + lane) << 14) | (unsigned)id1[k]; n += __builtin_popcountll(m); }
                if (n > PA_CAP - 128) { pa_flush(n, X, lane, list, gl, ring, U6, wpk, tb, nwg); n = 0; }
            }
            pa_flush(n, X, lane, list, gl, ring, U6, wpk, tb, nwg);
        }
    }
}
__device__ __forceinline__ void final_token(int t, int lane, const unsigned short* Y16, float* X1, const float* fg) {
    GAS f32x4* xp = (GAS f32x4*)(X1 + (size_t)t * 1024 + 8 * lane);
    f32x4 x0 = xp[0], x1 = xp[1], x2 = xp[128], x3 = xp[129];
    const v4u ya = *(const GAS v4u*)(Y16 + (size_t)t * 1024 + 8 * lane), yb = *(const GAS v4u*)(Y16 + (size_t)t * 1024 + 512 + 8 * lane);
    const unsigned yw[8] = {ya.x, ya.y, ya.z, ya.w, yb.x, yb.y, yb.z, yb.w};
    float y[16];
#pragma unroll
    for (int i = 0; i < 8; ++i) { const unsigned w = yw[i]; const h2_t h = __builtin_bit_cast(h2_t, w); y[2 * i] = (float)h[0]; y[2 * i + 1] = (float)h[1]; }
    x0 += (f32x4){y[0], y[1], y[2], y[3]}; x1 += (f32x4){y[4], y[5], y[6], y[7]}; x2 += (f32x4){y[8], y[9], y[10], y[11]}; x3 += (f32x4){y[12], y[13], y[14], y[15]};
    float ss = (x0.x * x0.x + x0.y * x0.y) + (x0.z * x0.z + x0.w * x0.w) + (x1.x * x1.x + x1.y * x1.y) + (x1.z * x1.z + x1.w * x1.w)
             + (x2.x * x2.x + x2.y * x2.y) + (x2.z * x2.z + x2.w * x2.w) + (x3.x * x3.x + x3.y * x3.y) + (x3.z * x3.z + x3.w * x3.w);
    const float rstd2 = 1.0f / sqrtf(wave_sum(ss) * (1.f / DMODEL) + RMS_EPS);
    const GAS f32x4* gp = (const GAS f32x4*)(fg + 8 * lane);
    xp[0] = x0 * rstd2 * gp[0]; xp[1] = x1 * rstd2 * gp[1]; xp[128] = x2 * rstd2 * gp[128]; xp[129] = x3 * rstd2 * gp[129];
}
#ifndef REP_0
#define REP_0 1
#endif
#ifndef REP_1
#define REP_1 1
#endif
#ifndef REP_2
#define REP_2 1
#endif
#ifndef REP_3
#define REP_3 1
#endif
#ifndef REP_4
#define REP_4 1
#endif
#ifndef REP_5
#define REP_5 1
#endif
#ifndef REP_6
#define REP_6 1
#endif
#ifndef REP_7
#define REP_7 1
#endif
#ifndef REP_8
#define REP_8 1
#endif
#ifndef REP_9
#define REP_9 1
#endif
#ifndef REP_10
#define REP_10 1
#endif
#ifndef REP_11
#define REP_11 1
#endif
struct PkB { v4u p[4]; };
__device__ __forceinline__ PkB peer_b_load(int t, int lane, const unsigned* wpk) { PkB k;
#pragma unroll
    for (int q = 0; q < 4; ++q) k.p[q] = *(const GAS v4u*)(wpk + (size_t)t * 128 + (lane >> 3) * 16 + q * 4);
    return k; }
__device__ __forceinline__ void peer_b_rows(v4u (&v)[16], const PkB& k, const unsigned char* vbase) {
#pragma unroll
    for (int q = 0; q < 4; ++q) { const unsigned pw[4] = {k.p[q].x, k.p[q].y, k.p[q].z, k.p[q].w};
#pragma unroll
        for (int r = 0; r < 4; ++r) v[q * 4 + r] = *(const GAS v4u*)(vbase + (size_t)(pw[r] & 0xffffu) * 128); }
}
__device__ __forceinline__ void peer_b_sum(const v4u (&v)[16], const PkB& k, int lane, unsigned short* yout) {
    h2_t acc[8]; const float sc = 1.0f / V8_SCALE;
#pragma unroll
    for (int i = 0; i < 8; ++i) acc[i] = (h2_t){(_Float16)0.f, (_Float16)0.f};
#pragma unroll
    for (int q = 0; q < 4; ++q) { const unsigned pw[4] = {k.p[q].x, k.p[q].y, k.p[q].z, k.p[q].w};
#pragma unroll
        for (int r = 0; r < 4; ++r) { const unsigned p = pw[r], wb = (p & 0xffff0000u) | (p >> 16); const h2_t w2 = __builtin_bit_cast(h2_t, wb); const v4u x = v[q * 4 + r];
            const unsigned xx = x.x, xy = x.y, xz = x.z, xw = x.w;
            acc[0] = __builtin_elementwise_fma(fp8lo_h(xx, sc), w2, acc[0]); acc[1] = __builtin_elementwise_fma(fp8hi_h(xx, sc), w2, acc[1]);
            acc[2] = __builtin_elementwise_fma(fp8lo_h(xy, sc), w2, acc[2]); acc[3] = __builtin_elementwise_fma(fp8hi_h(xy, sc), w2, acc[3]);
            acc[4] = __builtin_elementwise_fma(fp8lo_h(xz, sc), w2, acc[4]); acc[5] = __builtin_elementwise_fma(fp8hi_h(xz, sc), w2, acc[5]);
            acc[6] = __builtin_elementwise_fma(fp8lo_h(xw, sc), w2, acc[6]); acc[7] = __builtin_elementwise_fma(fp8hi_h(xw, sc), w2, acc[7]); } }
#pragma unroll
    for (int o = 8; o < 64; o <<= 1)
#pragma unroll
        for (int i = 0; i < 8; ++i) { const unsigned u = __builtin_bit_cast(unsigned, acc[i]); const unsigned ou = (unsigned)__shfl_xor((int)u, o); acc[i] = acc[i] + __builtin_bit_cast(h2_t, ou); }
    if (lane < 8) { *(GAS v4u*)yout = (v4u){__builtin_bit_cast(unsigned, acc[0]), __builtin_bit_cast(unsigned, acc[1]), __builtin_bit_cast(unsigned, acc[2]), __builtin_bit_cast(unsigned, acc[3])};
                    *(GAS v4u*)(yout + 8) = (v4u){__builtin_bit_cast(unsigned, acc[4]), __builtin_bit_cast(unsigned, acc[5]), __builtin_bit_cast(unsigned, acc[6]), __builtin_bit_cast(unsigned, acc[7])}; }
}
__device__ __forceinline__ void peer_b_phase(int lane, int wave, int G, int vcu, const unsigned char* V8s, const unsigned* wpk, unsigned short* Y16, float* X1, const float* fg) {
    const int c16 = (lane & 7) * 16;
    for (int tile0 = vcu; tile0 < MTOK / 32; tile0 += 2 * G) {
        const int tile1 = tile0 + G; const bool has1 = tile1 < MTOK / 32;
        const int tb = tile0 * 32 + wave * 4, nwg = (has1 ? tile1 : tile0) * 32 + wave * 4;
        const int nst = has1 ? 4 : 2;
        for (int sl = 0; sl < 8; ++sl) {
            const unsigned char* vbase = V8s + (size_t)sl * NEXP * 128 + c16;
            PkB kA = peer_b_load(pa_tok(0u, tb, nwg), lane, wpk), kB = peer_b_load(pa_tok(1u, tb, nwg), lane, wpk);
            for (int st = 0; st < nst; ++st) {
                const int tA = pa_tok((unsigned)(2 * st), tb, nwg), tB = pa_tok((unsigned)(2 * st + 1), tb, nwg);
                const unsigned kn = (st + 1 < nst) ? (unsigned)(2 * st + 2) : (unsigned)(2 * st);
                const PkB nA = peer_b_load(pa_tok(kn, tb, nwg), lane, wpk), nB = peer_b_load(pa_tok(kn + 1u, tb, nwg), lane, wpk);
                v4u vA[16], vB[16];
                peer_b_rows(vA, kA, vbase); peer_b_rows(vB, kB, vbase);
                peer_b_sum(vA, kA, lane, Y16 + (size_t)tA * 1024 + sl * 128 + c16);
                peer_b_sum(vB, kB, lane, Y16 + (size_t)tB * 1024 + sl * 128 + c16);
                kA = nA; kB = nB;
            }
        }
        asm volatile("s_waitcnt vmcnt(0)" ::: "memory");
        for (int k = 0; k < 2 * nst; ++k) final_token(pa_tok((unsigned)k, tb, nwg), lane, Y16, X1, fg);
    }
}
template <int NR> __device__ __forceinline__ void convert_expert_rows(const float* table, int ex, int stride, bool isv, int lane, unsigned char* U8, unsigned char* V8) {
    if (!isv) {
        typedef float v16f_t __attribute__((ext_vector_type(16)));
        f32x4 q[NR / 2][8];
#pragma unroll
        for (int k = 0; k < NR / 2; ++k) { const int e = ex + (2 * k + (lane >> 5)) * stride; const float* src = table + (size_t)(e < NEXP ? e : ex) * 1024 + 32 * (lane & 31);
#pragma unroll
            for (int j = 0; j < 8; ++j) q[k][j] = *(const GAS f32x4*)(src + 4 * j); }
#pragma unroll
        for (int k = 0; k < NR / 2; ++k) { const int e = ex + (2 * k + (lane >> 5)) * stride; if (e < NEXP) {
            float f[32];
#pragma unroll
            for (int j = 0; j < 8; ++j) { const f32x4 t = q[k][j] * U8_SCALE; f[4 * j] = t.x; f[4 * j + 1] = t.y; f[4 * j + 2] = t.z; f[4 * j + 3] = t.w; }
            const v16f_t lo16 = {f[0], f[1], f[2], f[3], f[4], f[5], f[6], f[7], f[8], f[9], f[10], f[11], f[12], f[13], f[14], f[15]},
                         hi16 = {f[16], f[17], f[18], f[19], f[20], f[21], f[22], f[23], f[24], f[25], f[26], f[27], f[28], f[29], f[30], f[31]};
            v6u_t p6; asm volatile("s_nop 1\n\tv_cvt_scalef32_2xpk16_fp6_f32 %0, %1, %2, 1.0" : "=&v"(p6) : "v"(lo16), "v"(hi16));
            GAS v2u* dst = (GAS v2u*)(U8 + (size_t)e * 768 + 24 * (lane & 31)); dst[0] = (v2u){p6[0], p6[1]}; dst[1] = (v2u){p6[2], p6[3]}; dst[2] = (v2u){p6[4], p6[5]}; } }
        return;
    }
    f32x4 r[NR][4]; const float sc = V8_SCALE;
#pragma unroll
    for (int k = 0; k < NR; ++k) { const int e = ex + k * stride; const float* src = table + (size_t)(e < NEXP ? e : ex) * 1024 + 16 * lane;
#pragma unroll
        for (int q = 0; q < 4; ++q) r[k][q] = *(const GAS f32x4*)(src + 4 * q); }
#pragma unroll
    for (int k = 0; k < NR; ++k) { const int e = ex + k * stride; if (e < NEXP) {
        const f32x4 a = r[k][0] * sc, b = r[k][1] * sc, c = r[k][2] * sc, d = r[k][3] * sc;
        *(GAS v4u*)(V8 + ((size_t)(lane >> 3) * NEXP + e) * 128 + (lane & 7) * 16) = (v4u){pack_fp8x4(a.x, a.y, a.z, a.w), pack_fp8x4(b.x, b.y, b.z, b.w), pack_fp8x4(c.x, c.y, c.z, c.w), pack_fp8x4(d.x, d.y, d.z, d.w)}; } }
}
struct OnePanel { int pm, n; __device__ __forceinline__ bool next(int i, pg8::Unit& u) const { if (i >= n) return false; u.pm = pm; u.pn = i; u.w = 0; return true; } };
struct DualOrder { pg8::StaticOrder S; __device__ __forceinline__ bool next(int i, pg8::Unit& u) const { if (!S.next(i >> 1, u)) return false; u.w = i & 1; return true; } };
struct Args { const float* in[24]; float* out; unsigned char* ws; int ph_lo, ph_hi, li, pad; };
__global__ void __launch_bounds__(NWAVES * 64, 2) mk_fwd(Args args) {
    extern __shared__ __attribute__((aligned(16))) unsigned char lds[];
    Frame F;
    F.lds = (LAS unsigned char*)lds;
    volatile LAS unsigned* MISC = (volatile LAS unsigned*)(F.lds + MISC_OFF);
    F.tid = threadIdx.x; F.lane = F.tid & 63; F.wave = __builtin_amdgcn_readfirstlane(F.tid >> 6);
    F.G = gridDim.x; { const int bx = blockIdx.x; F.vcu = (F.G % 8 == 0) ? (bx % 8) * (F.G / 8) + bx / 8 : bx; }
    unsigned char* ws = args.ws;
    gu32* ctl = (gu32*)(ws + WS_CTL);
    for (int u = F.tid; u < (LDS_BYTES - LDSCTL_OFF) / 4; u += NWAVES * 64) ((LAS unsigned*)(F.lds + LDSCTL_OFF))[u] = 0u;
    __syncthreads();
    XcdBarrier bar; bar.bar = (unsigned*)(ctl + CW_BAR); bar.x = 0; bar.st = nullptr;
    if (N_LAUNCHES != PER_PHASE) bar = xcd_barrier_post((unsigned*)(ctl + CW_BAR), MISC + 8);
#define GRID_BAR() do { if (N_LAUNCHES != PER_PHASE) xcd_barrier(bar); } while (0)
    const int lo = args.ph_lo, hi = args.ph_hi;
#ifndef PH_MASK
#define PH_MASK 0xFFFF
#endif
#define IN(k) ((((PH_MASK) >> (k)) & 1) && lo <= (k) && (k) < hi)
#define BOTH(k) (IN(k) && IN((k) + 1))
    const int gw = F.vcu * NWAVES + F.wave, NGW = F.G * NWAVES;
    const int gtid = F.vcu * (NWAVES * 64) + F.tid, NTHR = F.G * NWAVES * 64;
    const float* x = args.in[0];
    bf16* Win_t = (bf16*)(ws + WS_WIN); bf16* Wq_t = (bf16*)(ws + WS_WQ); bf16* Wout_t = (bf16*)(ws + WS_WOUT); bf16* Wus_t = (bf16*)(ws + WS_WUS); bf16* Wua_t = (bf16*)(ws + WS_WUA);
    bf16* Wglu_t = (bf16*)(ws + WS_WGLU); bf16* KSb = (bf16*)(ws + WS_KS); bf16* WE = (bf16*)(ws + WS_WE); bf16* BP = (bf16*)(ws + WS_BP); bf16* AP = (bf16*)(ws + WS_AP);
    float* Eb = (float*)(ws + WS_E); bf16* Hb = (bf16*)(ws + WS_H); bf16* Ypre = (bf16*)(ws + WS_YPRE); bf16* Ya = (bf16*)(ws + WS_YA); bf16* XG = (bf16*)(ws + WS_XG);
    bf16* Zb = (bf16*)(ws + WS_Z); bf16* Qb = (bf16*)(ws + WS_Z + 1 * ZSTRIDE_B); bf16* Kb = (bf16*)(ws + WS_Z + 2 * ZSTRIDE_B); bf16* Vb = (bf16*)(ws + WS_Z + 3 * ZSTRIDE_B);
    bf16* GA = (bf16*)(ws + WS_Z + 4 * ZSTRIDE_B); bf16* GB = (bf16*)(ws + WS_Z + 6 * ZSTRIDE_B);
    bf16* Yb = (bf16*)(ws + WS_YB); bf16* Mrg = (bf16*)(ws + WS_MRG); bf16* PQb = (bf16*)(ws + WS_PQ); int* ids = (int*)(ws + WS_IDS); float* gts = (float*)(ws + WS_GTS);
    unsigned char* U8 = ws + WS_U16; unsigned char* V8 = ws + WS_V16; unsigned* wpk = (unsigned*)(ws + WS_WPK); float* rstd1 = (float*)(ws + WS_RSTD1); unsigned short* Y16 = (unsigned short*)(ws + WS_Y16);
    float* biasT = (float*)(ws + WS_BIAS); float* pw32 = (float*)(ws + WS_PW32); float* kpart = (float*)(ws + WS_KPART); float* Kg = (float*)(ws + WS_KG); float* ssq1 = (float*)(ws + WS_SSQ1);

    if (IN(0)) for (int rep_ = 0; rep_ < REP_0; ++rep_) {
        LAS float* scr = (LAS float*)(F.lds + RING_OFF + F.wave * 16384);
        constexpr int I_IN = (1024 / 64) * (4096 / 32), I_GLU = (512 / 64) * (512 / 32), I_UP = (512 / 64) * (1024 / 32), I_OUT = (1024 / 64) * (1024 / 32), I_Q = (1024 / 64) * (2048 / 32);
        constexpr int NITEMS = I_IN + I_GLU + 2 * I_UP + I_OUT + I_Q;
        for (int it = gw; it < NITEMS; it += NGW) {
            int r = it;
            if (r < I_IN) { p0_transpose_item(args.in[2], 1024, 4096, Win_t, scr, r, F.lane); continue; } r -= I_IN;
            if (r < I_GLU) { p0_transpose_item(args.in[11], 512, 512, Wglu_t, scr, r, F.lane); continue; } r -= I_GLU;
            if (r < I_UP) { p0_transpose_item(args.in[13], 512, 1024, Wus_t, scr, r, F.lane); continue; } r -= I_UP;
            if (r < I_UP) { p0_transpose_item(args.in[14], 512, 1024, Wua_t, scr, r, F.lane); continue; } r -= I_UP;
            if (r < I_OUT) { p0_transpose_item(args.in[16], 1024, 1024, Wout_t, scr, r, F.lane); continue; } r -= I_OUT;
            p0_transpose_item(args.in[18], 1024, 2048, Wq_t, scr, r, F.lane);
        }
        for (int it = gw; it < NGRP * CH; it += NGW)
            ssm_table_task(it >> 5, it & 31, F.lane, scr, args.in[3], args.in[4], args.in[5], args.in[6], args.in[7], args.in[8], args.in[9], Kg, WE, BP, pw32);
        for (int m = gw; m < MTOK; m += NGW * 4) rms_rows4_to_bf16(x, args.in[1], Hb, m, NGW, F.lane);
        for (int it = gw; it < 64; it += NGW) { const float* src = (it < 32 ? args.in[19] : args.in[20]) + (size_t)(it & 31) * 512 + 8 * F.lane;
            const f32x4 a = *(const GAS f32x4*)src, b = *(const GAS f32x4*)(src + 4);
            *(GAS v4u*)(KSb + (size_t)it * 512 + 8 * F.lane) = (v4u){pk2(a.x, a.y), pk2(a.z, a.w), pk2(b.x, b.y), pk2(b.z, b.w)}; }
        if (gw == 0) { for (int i = F.lane; i < 8 * 128; i += 64) { const int h = i >> 7, rel = i & 127; int bk;
                if (rel < 16) bk = rel; else { const float lg = logf((float)rel / 16.0f) / 2.0794415416798357f * 16.0f; bk = 16 + (int)lg; bk = bk < 0 ? 0 : (bk > 31 ? 31 : bk); }
                biasT[i] = (args.in[15][bk * 8 + h] - args.in[15][31 * 8 + h]) * 1.4426950408889634f; } }
        if (BOTH(0)) GRID_BAR();
    }

    if (IN(1)) for (int rep_ = 0; rep_ < REP_1; ++rep_) {
        const float* Dsk = args.in[10];
        for (int i0 = gtid; i0 < NGRP * 512 * 64; i0 += NTHR * 4) {
            f32x4 ka[4], kb[4];
#pragma unroll
            for (int q = 0; q < 4; ++q) { const int i = i0 + q * NTHR; const int ic = (i < NGRP * 512 * 64) ? i : i0; const int g = ic >> 15, m = (ic >> 6) & 511, k8 = ic & 63, j = m >> 4, ho = m & 15, jp = k8 >> 1, hi0 = (k8 & 1) * 8;
                const int lag = (jp <= j) ? j - jp : 0; const float* kp = Kg + ((size_t)(g * 32 + lag) * 256 + ho * 16 + hi0); ka[q] = *(const GAS f32x4*)kp; kb[q] = *(const GAS f32x4*)(kp + 4); }
#pragma unroll
            for (int q = 0; q < 4; ++q) { const int i = i0 + q * NTHR; if (i >= NGRP * 512 * 64) break; const int g = i >> 15, m = (i >> 6) & 511, k8 = i & 63, j = m >> 4, ho = m & 15, jp = k8 >> 1, hi0 = (k8 & 1) * 8;
                v4u o = (v4u){0u, 0u, 0u, 0u};
                if (jp <= j) { f32x4 a = ka[q], b = kb[q];
                    if (jp == j && (ho >> 3) == (hi0 >> 3)) { const float dv = Dsk[g * 16 + ho]; const int e = ho & 7;
                        a.x += (e == 0) ? dv : 0.f; a.y += (e == 1) ? dv : 0.f; a.z += (e == 2) ? dv : 0.f; a.w += (e == 3) ? dv : 0.f;
                        b.x += (e == 4) ? dv : 0.f; b.y += (e == 5) ? dv : 0.f; b.z += (e == 6) ? dv : 0.f; b.w += (e == 7) ? dv : 0.f; }
                    o = (v4u){pk2(a.x, a.y), pk2(a.z, a.w), pk2(b.x, b.y), pk2(b.z, b.w)}; }
                *(GAS v4u*)(BP + ((size_t)(g * 512 + m) * APK + k8 * 8)) = o; } }
        pg8::Gemm g{Hb, Win_t, MTOK, INCOLS, 1024, 1024, 1024, 1 << 30, 0};
        pg8::StaticOrder S; S.init(MTOK, INCOLS, F.G, (int)blockIdx.x);
        pg8::EpiIn E{Zb, AP, kpart};
        pg8::gemm_phase<pg8::EpiIn, pg8::StaticOrder, true>(F.lds + RING_OFF, g, S, E);
        if (BOTH(1)) GRID_BAR();
    }

    if (IN(2)) for (int rep_ = 0; rep_ < REP_2; ++rep_) {
        const int bx = (int)blockIdx.x;
        const bool shared = F.G < 4;
        const int nS = shared ? F.G : (F.G >= 256 ? 64 : F.G / 4), nA = shared ? F.G : F.G - nS;
        const bool inS = shared || bx < nS, inA = shared || bx >= nS; const int aidx = shared ? bx : bx - nS;
        if (inS) {
#pragma unroll 1
            for (int pm = bx; pm < MTOK / 256; pm += nS) {
                { pg8::Gemm g1{AP, WE, MTOK, 256, 512, APK, 512, 2, (size_t)256 * 512}; OnePanel S1{pm, 1}; pg8::EpiE E1{Eb};
                  pg8::gemm_phase<pg8::EpiE, OnePanel, true>(F.lds + RING_OFF, g1, S1, E1); }
                VM_WAIT(); __syncthreads();
                if (F.tid < 256) { const int gb = (pm >> 1) * 8 + (pm & 1) * 4 + (F.tid >> 6), g_ = gb >> 3, p = F.tid & 63; const size_t row0 = (size_t)gb * 64;
                    const float mr = pw32[g_ * 128 + p], mi = pw32[g_ * 128 + 64 + p]; float sr = 0.f, si = 0.f;
#pragma unroll 1
                    for (int c0 = 0; c0 < NCHUNK; c0 += 32) { float er[32], ei[32];
#pragma unroll
                        for (int c = 0; c < 32; ++c) { er[c] = Eb[(row0 + c0 + c) * 128 + p]; ei[c] = Eb[(row0 + c0 + c) * 128 + 64 + p]; }
#pragma unroll
                        for (int c = 0; c < 32; ++c) { bf16* ap = AP + (row0 + c0 + c) * APK + 512; ap[p] = (bf16)f2bf(sr); ap[64 + p] = (bf16)f2bf(si);
                            const float nr = mr * sr - mi * si + er[c], ni = mr * si + mi * sr + ei[c]; sr = nr; si = ni; } } }
                VM_WAIT(); __syncthreads();
                { pg8::Gemm g{AP, BP, MTOK, 512, APK, APK, APK, 2, (size_t)512 * APK}; OnePanel S3{pm, 2}; pg8::EpiY E{Ypre};
                  pg8::gemm_phase<pg8::EpiY, OnePanel, true>(F.lds + RING_OFF, g, S3, E); }
            }
        }
        if (inA) {
            static_assert(attn_body::ATTN_LDS_BYTES <= RING_BYTES, "attention LDS");
#pragma unroll 1
            for (int a = aidx; a < 192; a += nA) { const int ty = a >> 6, bh = a & 63;
#pragma unroll 1
                for (int i = 0; i < 4; ++i) { const int qb = (ty == 0) ? (i == 0 ? 7 : (i == 1 ? 2 : (i == 2 ? 0 : -1))) : (ty == 1) ? (i == 0 ? 6 : (i == 1 ? 4 : -1)) : (i == 0 ? 5 : (i == 1 ? 3 : (i == 2 ? 1 : -1)));
                    if (qb < 0) break;
                    attn_body::attn_unit<8>(bh >> 3, bh & 7, qb, (const attn_body::bf16*)Qb, (const attn_body::bf16*)Kb, (const attn_body::bf16*)Vb, (attn_body::bf16*)Yb, (char*)lds + RING_OFF, kpart, biasT); } }
        }
        if (BOTH(2)) GRID_BAR();
    }

    if (IN(3)) for (int rep_ = 0; rep_ < REP_3; ++rep_) {
        pg8::Gemm g{Ypre, Wglu_t, MTOK, 512, 512, 512, 512, 1 << 30, 0};
        pg8::StaticOrder S; S.init(MTOK, 512, F.G, (int)blockIdx.x);
        pg8::EpiGlu E{Ypre, Ya, args.in[12]};
        pg8::gemm_phase<pg8::EpiGlu, pg8::StaticOrder, true>(F.lds + RING_OFF, g, S, E);
        { const int nun = (MTOK / 256) * (512 / 256);
          const int nconv = (F.G > nun) ? F.G - nun : F.G, cidx = (F.G > nun) ? (int)blockIdx.x - nun : (int)blockIdx.x;
          if (cidx >= 0) for (int ex = cidx * NWAVES + F.wave; ex < 2 * NEXP; ex += nconv * NWAVES * 4) { const bool isv = ex >= NEXP; convert_expert_rows<4>(isv ? args.in[22] : args.in[21], isv ? ex - NEXP : ex, nconv * NWAVES, isv, F.lane, U8, V8); } }
        if (BOTH(3)) GRID_BAR();
    }

    if (IN(4)) for (int rep_ = 0; rep_ < REP_4; ++rep_) {
        pg8::Gemm g{Ya, Wus_t, MTOK, 1024, 512, 512, 512, 1 << 30, 0, Yb, Wua_t};
        DualOrder S; S.S.init(MTOK, 1024, F.G, (int)blockIdx.x);
        pg8::EpiMrgDual E{pg8::EpiMrg<0>{GA, Mrg}, pg8::EpiMrg<1>{GB, Mrg}};
        pg8::gemm_phase<pg8::EpiMrgDual, DualOrder, true>(F.lds + RING_OFF, g, S, E);
        if (BOTH(4)) GRID_BAR();
    }

    if (IN(5)) for (int rep_ = 0; rep_ < REP_5; ++rep_) {
        pg8::Gemm g{Mrg, Wout_t, MTOK, 1024, 1024, 1024, 1024, 1 << 30, 0}; pg8::StaticOrder S; S.init(MTOK, 1024, F.G, (int)blockIdx.x);
        pg8::EpiX1 E{x, args.out, XG, args.in[17], ssq1};
        pg8::gemm_phase<pg8::EpiX1, pg8::StaticOrder, true>(F.lds + RING_OFF, g, S, E);
        if (BOTH(5)) GRID_BAR();
    }

    if (IN(6)) for (int rep_ = 0; rep_ < REP_6; ++rep_) {
        pg8::Gemm g{XG, Wq_t, MTOK, PQ, 1024, 1024, 1024, 1 << 30, 0}; pg8::StaticOrder S; S.init(MTOK, PQ, F.G, (int)blockIdx.x);
        pg8::EpiPlain E{PQb, PQ};
        pg8::gemm_phase<pg8::EpiPlain, pg8::StaticOrder, true>(F.lds + RING_OFF, g, S, E);
        if (BOTH(6)) GRID_BAR();
    }

    if (IN(7)) for (int rep_ = 0; rep_ < REP_7; ++rep_) {
        LAS unsigned char* scr = F.lds + RING_OFF + F.wave * 2048;
        LAS unsigned char* ksl = F.lds + RING_OFF + 16384;
        for (int c = F.tid; c < 256 * 16; c += NWAVES * 64) { const int row = c >> 4, ch = c & 15; *(LAS v4u*)(ksl + row * 256 + ((ch ^ (row & 15)) << 4)) = *(const GAS v4u*)(KSb + row * 128 + ch * 8); }
        __syncthreads();
        for (int it = gw; it < (MTOK / 32) * 8; it += NGW) topk_task(it >> 3, it & 7, F.lane, scr, PQb, ksl, ssq1, ids, gts, rstd1);
        if (BOTH(7)) { VM_WAIT(); __syncthreads(); }
    }

    if (IN(8)) for (int rep_ = 0; rep_ < REP_8; ++rep_) {
        peer_a_phase(F.lane, F.wave, F.G, F.vcu, XG, U8, ids, gts, rstd1, wpk, F.lds, 0xffff);
        if (BOTH(8)) { VM_WAIT(); __syncthreads(); }
    }
    if (IN(9)) for (int rep_ = 0; rep_ < REP_9; ++rep_) {
        peer_b_phase(F.lane, F.wave, F.G, F.vcu, V8, wpk, Y16, args.out, args.in[23]);
    }
#undef IN
#undef BOTH
#undef GRID_BAR
}

extern "C" void kernel_launch(void* const* d_in, const int* in_sizes, int n_in, void* d_out, int out_size, void* d_ws, size_t ws_size, hipStream_t stream) {
    static int grid = 0;
    if (grid == 0) {
        if (n_in != 24 || in_sizes[0] != MTOK * DMODEL || out_size != MTOK * DMODEL || ws_size < WS_END) { fprintf(stderr, "kernel_launch: unexpected shapes (n_in %d, in0 %d, out %d, ws %zu); nothing launched\n", n_in, n_in > 0 ? in_sizes[0] : -1, out_size, ws_size); grid = -1; return; }
        int dev = 0, cus = 0, per_cu = 0;
        if (hipGetDevice(&dev) != hipSuccess || hipDeviceGetAttribute(&cus, hipDeviceAttributeMultiprocessorCount, dev) != hipSuccess) { grid = -1; return; }
        if (hipFuncSetAttribute((const void*)mk_fwd, hipFuncAttributeMaxDynamicSharedMemorySize, LDS_BYTES) != hipSuccess) { fprintf(stderr, "kernel_launch: hipFuncSetAttribute failed\n"); grid = -1; return; }
        if (hipOccupancyMaxActiveBlocksPerMultiprocessor(&per_cu, (const void*)mk_fwd, NWAVES * 64, LDS_BYTES) != hipSuccess || per_cu < 1) { fprintf(stderr, "kernel_launch: occupancy query says %d blocks per CU\n", per_cu); }
        (void)hipGetLastError();
        grid = cus;
    }
    if (grid < 0) return;
    if (N_LAUNCHES != PER_PHASE) { if (hipMemsetAsync((char*)d_ws + WS_CTL, 0, CTL_ZERO_BYTES, stream) != hipSuccess) return; }
    Args a{};
    for (int i = 0; i < 24; ++i) a.in[i] = (const float*)d_in[i];
    a.out = (float*)d_out; a.ws = (unsigned char*)d_ws; a.pad = 0;
    if (N_LAUNCHES == PER_PHASE) {
        for (int li = 0; li < PER_PHASE; ++li) { a.ph_lo = li; a.ph_hi = li + 1; a.li = li; hipLaunchKernelGGL(mk_fwd, dim3(grid), dim3(NWAVES * 64), LDS_BYTES, stream, a); }
    } else {
        a.ph_lo = 0; a.ph_hi = PER_PHASE; a.li = 0;
        hipLaunchKernelGGL(mk_fwd, dim3(grid), dim3(NWAVES * 64), LDS_BYTES, stream, a);
    }
}
```

```cpp
#include <hip/hip_runtime.h>
#include <hip/hip_bf16.h>
#include <cstdio>
#include <cstdint>
#include <cmath>

#ifndef MK_N_LAUNCHES
#define MK_N_LAUNCHES 1
#endif

namespace pg8 {
#define PG8_LAS __attribute__((address_space(3)))
typedef unsigned short bf16_t;
typedef short bf16x8 __attribute__((ext_vector_type(8)));
typedef float f32x4 __attribute__((ext_vector_type(4)));
typedef unsigned u32x4 __attribute__((ext_vector_type(4)));
constexpr int BM = 256, BK = 64, HALF = 128, HTB = HALF * BK * 2, STAGE_BYTES = 8 * HTB, NXCD = 8, WGM = 8;

__host__ __device__ __forceinline__ int lds_byte(int r, int c) { const int st = (r >> 4) * 2 + (c >> 5), rr = r & 15, cc = c & 31, ob = rr * 64 + cc * 2; return st * 1024 + (ob ^ (((ob >> 9) & 1) << 5)); }
__host__ __device__ __forceinline__ void stage_rc(int b, int& R, int& C) { const int st = b / 1024, sb = b % 1024, swz = sb ^ (((sb >> 9) & 1) << 5); R = (st >> 1) * 16 + swz / 64; C = (st & 1) * 32 + (swz % 64) / 2; }
__host__ __device__ __forceinline__ int perm32(int rho) { const int n = rho >> 4, i = rho & 15; return 8 * (i >> 2) + 4 * n + (i & 3); }

struct Unit { int pm, pn, w; };
struct Gemm { const bf16_t* A; const bf16_t* Bt; int M, N, K, lda, ldb, rpg; size_t bgs; const bf16_t* A2 = nullptr; const bf16_t* Bt2 = nullptr; };

struct StaticOrder {
    int nM, nN, nwg, G, c;
    __host__ __device__ __forceinline__ void init(int M, int N, int G_, int c_) { nM = M / BM; nN = N / BM; nwg = nM * nN; G = G_; c = c_; }
    __host__ __device__ __forceinline__ bool next(int i, Unit& u) const {
        const long L = (long)i * G + c; if (L >= nwg) return false;
        int wgid = (int)L; { const int q = nwg / NXCD, r = nwg % NXCD, xcd = wgid % NXCD, off = wgid / NXCD; wgid = (xcd < r ? xcd * (q + 1) : r * (q + 1) + (xcd - r) * q) + off; }
        const int nig = WGM * nN, gid = wgid / nig, fm = gid * WGM, gsz = (nM - fm) < WGM ? (nM - fm) : WGM;
        u.pm = fm + ((wgid % nig) % gsz); u.pn = (wgid % nig) / gsz; u.w = 0; return true;
    }
};

__device__ __forceinline__ unsigned cvt_pk_bf16(float lo, float hi) { unsigned r; asm volatile("v_cvt_pk_bf16_f32 %0, %1, %2" : "=v"(r) : "v"(lo), "v"(hi)); return r; }
__device__ __forceinline__ float bf_lo(unsigned w) { return __uint_as_float(w << 16); }
__device__ __forceinline__ float bf_hi(unsigned w) { return __uint_as_float(w & 0xffff0000u); }
__device__ __forceinline__ float sigmoid_f(float x) { return __builtin_amdgcn_rcpf(1.0f + __builtin_amdgcn_exp2f(-1.4426950409f * x)); }
__device__ __forceinline__ float gelu_tanh(float x) { const float u = x + 0.044715f * x * x * x; return x * __builtin_amdgcn_rcpf(1.0f + __builtin_amdgcn_exp2f(-2.3022081985f * u)); }

template <class Epi, class Sched, bool ALIGN_EPI>
__device__ __forceinline__ void gemm_phase(PG8_LAS unsigned char* lds, const Gemm g, const Sched& S, const Epi& E) {
    int tid = threadIdx.x; asm volatile("" : "+v"(tid));
    const int wid = __builtin_amdgcn_readfirstlane(tid >> 6), lane = tid & 63, wr = wid >> 2, wc = wid & 3, fr = lane & 15, fq = lane >> 4;
    const int K = g.K, nt = K / BK;
    unsigned voffA[2], voffB[2];
#pragma unroll
    for (int i = 0; i < 2; ++i) { int R, C; stage_rc(tid * 16 + i * 8192, R, C); const int Rb = Epi::PERM ? ((R & ~31) + perm32(R & 31)) : R;
        voffA[i] = (unsigned)(R * g.lda + C) * 2u; voffB[i] = (unsigned)(Rb * g.ldb + C) * 2u; }
    const size_t kstep = (size_t)(BK * 2);
    const size_t hstepA = (size_t)HALF * g.lda * 2, hstepB = (size_t)HALF * g.ldb * 2;
    const size_t tstepA = 2 * hstepA, tstepB = 2 * hstepB;
    const unsigned ldsw = (unsigned)wid * 1024u;
    const int aoff = lds_byte(wr * 64 + fr, fq * 8), boff = lds_byte(wc * 32 + fr, fq * 8);
#define PG8_SA(b, h) (((b) * 2 + (h)) * HTB)
#define PG8_SB(b, h) ((4 + (b) * 2 + (h)) * HTB)
#define PG8_STAGE(bufoff, gbase, voff) do { _Pragma("unroll") for (int _i = 0; _i < 2; ++_i) \
        __builtin_amdgcn_global_load_lds((const unsigned*)((const char*)(gbase) + (voff)[_i]), (PG8_LAS unsigned*)(lds + (bufoff) + ldsw + _i * 8192), 16, 0, 0); } while (0)
#define PG8_LDA(dst, b, h) do { _Pragma("unroll") for (int m = 0; m < 4; ++m) _Pragma("unroll") for (int k = 0; k < 2; ++k) dst[m][k] = *(const PG8_LAS bf16x8*)(lds + PG8_SA(b, h) + aoff + m * 2048 + k * 1024); } while (0)
#define PG8_LDB(dst, b, h) do { _Pragma("unroll") for (int n = 0; n < 2; ++n) _Pragma("unroll") for (int k = 0; k < 2; ++k) dst[n][k] = *(const PG8_LAS bf16x8*)(lds + PG8_SB(b, h) + boff + n * 2048 + k * 1024); } while (0)
#define PG8_MMA(ai, bj, At, Bt) do { __builtin_amdgcn_s_setprio(1); _Pragma("unroll") for (int m = 0; m < 4; ++m) _Pragma("unroll") for (int n = 0; n < 2; ++n) _Pragma("unroll") for (int k = 0; k < 2; ++k) \
        acc[ai][bj][m][n] = __builtin_amdgcn_mfma_f32_16x16x32_bf16(Bt[n][k], At[m][k], acc[ai][bj][m][n], 0, 0, 0); __builtin_amdgcn_s_setprio(0); } while (0)
#define PG8_WAIT_V(n) asm volatile("s_waitcnt vmcnt(" #n ")" ::: "memory")
#define PG8_WAIT_L(n) asm volatile("s_waitcnt lgkmcnt(" #n ")" ::: "memory")
#define PG8_BAR __builtin_amdgcn_s_barrier()
#define PG8_SCHED __builtin_amdgcn_sched_barrier(0)
    Unit cur, nxt; int ui = 0;
    if (!S.next(0, cur)) return;
    f32x4 acc[2][2][4][2];
#pragma unroll
    for (int a = 0; a < 2; ++a)
#pragma unroll
        for (int b = 0; b < 2; ++b)
#pragma unroll
            for (int m = 0; m < 4; ++m)
#pragma unroll
                for (int n = 0; n < 2; ++n) acc[a][b][m][n] = (f32x4){0.f, 0.f, 0.f, 0.f};
    bf16x8 At[4][2], B0[2][2], B1[2][2];
    const char* cA = (const char*)(cur.w ? g.A2 : g.A) + (size_t)cur.pm * tstepA;
    const char* cB = (const char*)(cur.w ? g.Bt2 : g.Bt) + (size_t)(cur.pm / g.rpg) * g.bgs * 2 + (size_t)cur.pn * tstepB;
    PG8_STAGE(PG8_SB(0, 0), cB, voffB); PG8_STAGE(PG8_SB(0, 1), cB + hstepB, voffB); PG8_STAGE(PG8_SA(0, 0), cA, voffA); PG8_STAGE(PG8_SA(0, 1), cA + hstepA, voffA);
    if (wr == 1) PG8_BAR;
    PG8_WAIT_V(2); PG8_BAR;
    PG8_STAGE(PG8_SB(1, 0), cB + kstep, voffB); PG8_STAGE(PG8_SA(1, 0), cA + kstep, voffA); PG8_STAGE(PG8_SB(1, 1), cB + hstepB + kstep, voffB);
    PG8_WAIT_V(6); PG8_BAR;
    for (;;) {
        const bool has_next = S.next(ui + 1, nxt);
        const char* nA = has_next ? (const char*)(nxt.w ? g.A2 : g.A) + (size_t)nxt.pm * tstepA : cA;
        const char* nB = has_next ? (const char*)(nxt.w ? g.Bt2 : g.Bt) + (size_t)(nxt.pm / g.rpg) * g.bgs * 2 + (size_t)nxt.pn * tstepB : cB;
        for (int t = 0; t < nt; t += 2) {
            const bool last = (t == nt - 2);
            const char* a1 = cA + (size_t)(t + 1) * kstep;
            const char* a2 = last ? nA : cA + (size_t)(t + 2) * kstep; const char* b2 = last ? nB : cB + (size_t)(t + 2) * kstep;
            const char* a3 = a2 + kstep; const char* b3 = b2 + kstep;
            PG8_LDB(B0, 0, 0); PG8_LDB(B1, 0, 1); PG8_SCHED; PG8_LDA(At, 0, 0); PG8_STAGE(PG8_SA(1, 1), a1 + hstepA, voffA);
            PG8_WAIT_V(8); PG8_WAIT_L(0); PG8_BAR; PG8_MMA(0, 0, At, B0); PG8_MMA(0, 1, At, B1); PG8_BAR; PG8_SCHED;
            PG8_LDA(At, 0, 1); PG8_STAGE(PG8_SB(0, 0), b2, voffB); PG8_STAGE(PG8_SB(0, 1), b2 + hstepB, voffB); PG8_STAGE(PG8_SA(0, 0), a2, voffA);
            PG8_WAIT_V(8); PG8_WAIT_L(0); PG8_BAR; PG8_MMA(1, 0, At, B0); PG8_MMA(1, 1, At, B1); PG8_BAR; PG8_SCHED;
            PG8_LDB(B0, 1, 0); PG8_LDB(B1, 1, 1); PG8_SCHED; PG8_LDA(At, 1, 0); PG8_STAGE(PG8_SA(0, 1), a2 + hstepA, voffA);
            PG8_WAIT_V(8); PG8_WAIT_L(0); PG8_BAR; PG8_MMA(0, 0, At, B0); PG8_MMA(0, 1, At, B1); PG8_BAR; PG8_SCHED;
            PG8_LDA(At, 1, 1); PG8_STAGE(PG8_SB(1, 0), b3, voffB); PG8_STAGE(PG8_SB(1, 1), b3 + hstepB, voffB); PG8_STAGE(PG8_SA(1, 0), a3, voffA);
            PG8_WAIT_V(8); PG8_WAIT_L(0); PG8_BAR; PG8_MMA(1, 0, At, B0); PG8_MMA(1, 1, At, B1); PG8_BAR; PG8_SCHED;
        }
        if constexpr (ALIGN_EPI) { if (wr == 0) PG8_BAR; }
        E(acc, cur, wr, wc, fr, fq);
        if (!has_next) break;
#pragma unroll
        for (int a = 0; a < 2; ++a)
#pragma unroll
            for (int b = 0; b < 2; ++b)
#pragma unroll
                for (int m = 0; m < 4; ++m)
#pragma unroll
                    for (int n = 0; n < 2; ++n) acc[a][b][m][n] = (f32x4){0.f, 0.f, 0.f, 0.f};
        cur = nxt; cA = nA; cB = nB; ++ui;
        if constexpr (ALIGN_EPI) { if (wr == 1) PG8_BAR; }
    }
    PG8_WAIT_V(0);
    if constexpr (!ALIGN_EPI) { if (wr == 0) PG8_BAR; }
    PG8_BAR;
#undef PG8_SA
#undef PG8_SB
#undef PG8_STAGE
#undef PG8_LDA
#undef PG8_LDB
#undef PG8_MMA
#undef PG8_WAIT_V
#undef PG8_WAIT_L
#undef PG8_BAR
#undef PG8_SCHED
}
}
namespace attn_body {
using bf16=__hip_bfloat16;
using bf16x8=__attribute__((ext_vector_type(8)))short;
using s16x4=__attribute__((ext_vector_type(4)))short;
using f32x16=__attribute__((ext_vector_type(16)))float;
using f32x4v=__attribute__((ext_vector_type(4)))float;
using u32x4=__attribute__((ext_vector_type(4)))unsigned;
constexpr int BATCH=8,NHEAD=8,SEQ=2048,D=64,DM=NHEAD*D;
constexpr int NW=8,QBLK=32,QB=QBLK*NW,KVBLK=64,NQB=SEQ/QB;
__device__ __forceinline__ int crow(int r,int hi){return (r&3)+8*(r>>2)+4*hi;}
#define SBAR() __builtin_amdgcn_sched_barrier(0)
__device__ __forceinline__ void cmask(f32x16&p0,f32x16&p1,int jb,int qrel,int hi){
  const float NEG=-INFINITY; int kb=64*jb+4*hi;
  #pragma unroll
  for(int r=0;r<16;++r){int kv=kb+(r&3)+8*(r>>2); if(kv>qrel)p0[r]=NEG; if(kv+32>qrel)p1[r]=NEG;}
}
typedef __attribute__((address_space(3))) const float* lds_cfptr;
__device__ __forceinline__ void biasadd(f32x16&p0,f32x16&p1,int jb,int qrel,int hi,lds_cfptr bt){
  const int base=qrel-64*jb-4*hi;
  #pragma unroll
  for(int r4=0;r4<16;r4+=4){
    #pragma unroll
    for(int r=r4;r<r4+4;++r){int rel=base-((r&3)+8*(r>>2)); int i0=min(max(rel,0),127), i1=min(max(rel-32,0),127); p0[r]+=bt[i0]; p1[r]+=bt[i1];}
    asm volatile("s_waitcnt lgkmcnt(0)":"+v"(p0),"+v"(p1)::"memory"); }
}

constexpr int NSLOT=3, SLOTB=8192;
constexpr int LDS_K=0, LDS_V=NSLOT*SLOTB, LDS_WS=2*NSLOT*SLOTB, LDS_OST=LDS_WS+NW*64*4, LDS_KM=LDS_OST+NW*4096, LDS_BT=LDS_KM+7*64*4, LDS_BYTES=LDS_BT+128*4;
constexpr float C2=0.125f*1.4426950408889634f;
__device__ __forceinline__ void glds16(const void*gsrc,unsigned lds_dst){unsigned keep;
  asm volatile("s_mov_b32 %0, m0\n\ts_mov_b32 m0, %2\n\ts_nop 0\n\tglobal_load_lds_dwordx4 %1, off\n\ts_mov_b32 m0, %0":"=&s"(keep):"v"(gsrc),"s"(lds_dst):"memory");}
__device__ __forceinline__ float max3f(float a,float b,float c){float r;asm("v_max3_f32 %0, %1, %2, %3":"=v"(r):"v"(a),"v"(b),"v"(c));return r;}
__device__ __forceinline__ float max2f(float a,float b){float r;asm("v_max_f32_e32 %0, %1, %2":"=v"(r):"v"(a),"v"(b));return r;}
__device__ __forceinline__ float fadd_s(float a,float b){float r;asm("v_add_f32_e32 %0, %1, %2":"=v"(r):"v"(a),"v"(b));return r;}
__device__ __forceinline__ float fsub_s(float a,float b){float r;asm("v_sub_f32_e32 %0, %1, %2":"=v"(r):"v"(a),"v"(b));return r;}
typedef float f32x2_t __attribute__((ext_vector_type(2))); typedef __bf16 bf16x2_t __attribute__((ext_vector_type(2)));
__device__ __forceinline__ unsigned cvtpk_s(float lo,float hi){f32x2_t v={lo,hi};bf16x2_t b=__builtin_convertvector(v,bf16x2_t);return __builtin_bit_cast(unsigned,b);}
#define WAIT_BAR(N) asm volatile("s_waitcnt vmcnt(" #N ") lgkmcnt(0)\n\ts_barrier":::"memory")

__device__ __forceinline__ void qkt(f32x16&p0,f32x16&p1,const char*Kslot,const bf16x8*qr,int r32,int hi){
  const char*kb=Kslot+hi*1024+r32*16;
  #pragma unroll
  for(int d0=0;d0<4;++d0){
    const bf16x8 b0=*reinterpret_cast<const bf16x8*>(kb+d0*2048);
    const bf16x8 b1=*reinterpret_cast<const bf16x8*>(kb+d0*2048+512);
    if(d0==0){p0=__builtin_amdgcn_mfma_f32_32x32x16_bf16(b0,qr[0],(f32x16){},0,0,0);p1=__builtin_amdgcn_mfma_f32_32x32x16_bf16(b1,qr[0],(f32x16){},0,0,0);}
    else{p0=__builtin_amdgcn_mfma_f32_32x32x16_bf16(b0,qr[d0],p0,0,0,0);p1=__builtin_amdgcn_mfma_f32_32x32x16_bf16(b1,qr[d0],p1,0,0,0);}}
}
typedef __attribute__((address_space(3))) const char* lds_cptr;
typedef short v4i16_t __attribute__((ext_vector_type(4)));
__device__ __forceinline__ void kload8(bf16x8*kf,lds_cptr kp){
  kf[0]=*(const __attribute__((address_space(3))) bf16x8*)(kp);      kf[1]=*(const __attribute__((address_space(3))) bf16x8*)(kp+512);
  kf[2]=*(const __attribute__((address_space(3))) bf16x8*)(kp+2048); kf[3]=*(const __attribute__((address_space(3))) bf16x8*)(kp+2560);
  kf[4]=*(const __attribute__((address_space(3))) bf16x8*)(kp+4096); kf[5]=*(const __attribute__((address_space(3))) bf16x8*)(kp+4608);
  kf[6]=*(const __attribute__((address_space(3))) bf16x8*)(kp+6144); kf[7]=*(const __attribute__((address_space(3))) bf16x8*)(kp+6656);
}
__device__ __forceinline__ void kload2(bf16x8*kf,lds_cptr kp,int j){ kf[2*j]=*(const __attribute__((address_space(3))) bf16x8*)(kp+j*2048); kf[2*j+1]=*(const __attribute__((address_space(3))) bf16x8*)(kp+j*2048+512); }
__device__ __forceinline__ s16x4 vtr(lds_cptr p){ return __builtin_bit_cast(s16x4,__builtin_amdgcn_ds_read_tr16_b64_v4i16((__attribute__((address_space(3))) v4i16_t*)p)); }
__device__ __forceinline__ float rowmax(const f32x16&p0,const f32x16&p1){
  float a=max3f(p0[0],p0[1],p1[0]),b=max3f(p0[2],p0[3],p1[1]);a=max3f(a,p1[2],p1[3]);
  #pragma unroll
  for(int r=4;r<16;r+=4){a=max3f(a,p0[r],p0[r+1]);b=max3f(b,p0[r+2],p0[r+3]);a=max3f(a,p1[r],p1[r+1]);b=max3f(b,p1[r+2],p1[r+3]);}
  const float m=max2f(a,b);
  auto rr=__builtin_amdgcn_permlane32_swap(__float_as_uint(m),__float_as_uint(m),false,false);
  return max2f(__uint_as_float(rr[0]),__uint_as_float(rr[1]));
}
__device__ __forceinline__ void pv(f32x16*o,int vb,bf16x8 pa0,bf16x8 pa1,bf16x8 pa2,bf16x8 pa3){
  #pragma unroll
  for(int d0=0;d0<2;++d0){s16x4 lo[4],hi[4];
    #pragma unroll
    for(int ks=0;ks<4;++ks){
      asm volatile("ds_read_b64_tr_b16 %0,%1 offset:%c2":"=&v"(lo[ks]):"v"(vb),"i"(d0*4096+ks*1024):"memory");
      asm volatile("ds_read_b64_tr_b16 %0,%1 offset:%c2":"=&v"(hi[ks]):"v"(vb),"i"(d0*4096+ks*1024+512):"memory");}
    asm volatile("s_waitcnt lgkmcnt(0)":::"memory");SBAR();
    #define PK(k) (bf16x8){lo[k][0],lo[k][1],lo[k][2],lo[k][3],hi[k][0],hi[k][1],hi[k][2],hi[k][3]}
    o[d0]=__builtin_amdgcn_mfma_f32_32x32x16_bf16(pa0,PK(0),o[d0],0,0,0);
    o[d0]=__builtin_amdgcn_mfma_f32_32x32x16_bf16(pa1,PK(1),o[d0],0,0,0);
    o[d0]=__builtin_amdgcn_mfma_f32_32x32x16_bf16(pa2,PK(2),o[d0],0,0,0);
    o[d0]=__builtin_amdgcn_mfma_f32_32x32x16_bf16(pa3,PK(3),o[d0],0,0,0);
    #undef PK
  }
}

#ifndef ATTN_STORE16
#define ATTN_STORE16(p,v) (*(u32x4*)(p)=(v))
#endif
template<int THRL> __device__ __forceinline__ void attn_unit(int b,int h,int qb,const bf16*Q,const bf16*__restrict__ K,const bf16*__restrict__ V,bf16*O,char*shm,const float*kpart,const float*btab){
  int tid=threadIdx.x; asm volatile("":"+v"(tid));
  const int lane=tid&63,r32=lane&31,hi=lane>>5; const int wid=__builtin_amdgcn_readfirstlane(tid>>6);
  const long rowbase=(long)b*SEQ; const int q0=qb*QB;
  const bf16*Qw=Q+(rowbase+q0+wid*QBLK)*DM+h*D;
  const bf16*Kh=K+rowbase*DM+h*D,*Vh=V+rowbase*DM+h*D;
  const unsigned lds0=(unsigned)(uintptr_t)shm;
  float*wsf=(float*)(shm+LDS_WS)+wid*64;
  const bf16*ksrc=Kh+(long)lane*DM+wid*8;
  const bf16*vsrc=Vh+(long)(16*(wid&3)+(lane>>2))*DM+(wid>>2)*32+(lane&3)*8;
  const unsigned kdst=lds0+LDS_K+wid*1024, vdst=lds0+LDS_V+wid*1024;
  #define DMA_K(t,slot) glds16(ksrc+(long)(t)*KVBLK*DM,(unsigned)__builtin_amdgcn_readfirstlane(kdst+(slot)))
  #define DMA_V(t,slot) glds16(vsrc+(long)(t)*KVBLK*DM,(unsigned)__builtin_amdgcn_readfirstlane(vdst+(slot)))
  const int vb0=(int)(lds0+LDS_V)+((lane>>4)&1)*32+(lane&3)*8+(4*hi+((lane&15)>>2))*64;
  const char*Kbase=shm+LDS_K; bf16x8 kf[8];
  const lds_cptr shm3=(lds_cptr)shm; const lds_cptr kp0=shm3+LDS_K+hi*1024+r32*16; const lds_cptr vp0=shm3+LDS_V+((lane>>4)&1)*32+(lane&3)*8+(4*hi+((lane&15)>>2))*64;
  const lds_cfptr btl=(lds_cfptr)(shm3+LDS_BT);
  const int NT=(q0+QB)/KVBLK;
  DMA_K(0,0);DMA_V(0,0);DMA_K(1,SLOTB);
  bf16x8 qr[4];
  #pragma unroll
  for(int d0=0;d0<4;++d0)qr[d0]=*reinterpret_cast<const bf16x8*>(&Qw[(long)r32*DM+d0*16+hi*8]);
  { float*km=(float*)(shm+LDS_KM); float*bt=(float*)(shm+LDS_BT); int tq=tid; asm volatile("":"+v"(tq));
    if(tq<448){const int j=tq>>6,d=tq&63; float v=0.f; if(j<qb&&qb>3){const float*kp=kpart+((size_t)((b*NQB+j)*2)*512)+h*D+d; v=(kp[0]+kp[512])*(1.0f/256.0f);} km[tq]=v;}
    else if(tq<448+64){const int i=tq-448; bt[i]=btab[h*128+i]; bt[64+i]=btab[h*128+64+i];} }
  float mhat=0.f,l_reg=0.f;f32x16 o[2];o[0]=f32x16{};o[1]=f32x16{};
  const int qrel=wid*QBLK+r32;
  #define CMASK(P0,P1,t) do{int jb_=(t)-(NT-4);   \
    if(jb_>=-2 && 32*wid+31-64*jb_>=0 && 32*wid-64*jb_-63<=112)biasadd(P0,P1,jb_,qrel,hi,btl); if(jb_>=0 && 64*jb_+63>32*wid)cmask(P0,P1,jb_,qrel,hi);}while(0)
  bool resc=false;
  #define START(P0,P1,t) do{ float rm=rowmax(P0,P1); resc=false; const float nv_=MASKADD(t); rm=fadd_s(rm,nv_); \
    { const float dl=__builtin_fmaxf(rm,-1.0e4f); mhat=fadd_s(mhat,dl); const float cc_=fsub_s(nv_,dl); \
      _Pragma("unroll") for(int r=0;r<16;++r){P0[r]=fadd_s(P0[r],cc_);P1[r]=fadd_s(P1[r],cc_);} } \
    _Pragma("unroll") for(int r=0;r<16;++r)P0[r]=__builtin_amdgcn_exp2f(P0[r]); }while(0)
  #define RESC() do{ if(resc){ asm volatile("s_waitcnt lgkmcnt(0)":::"memory"); \
      _Pragma("unroll") for(int d_=0;d_<2;++d_) _Pragma("unroll") for(int r=0;r<16;++r)o[d_][r]*=wsf[crow(r,hi)]; } }while(0)
  f32x16 pA0,pA1,pB0,pB1;
  int sl_prev=0,sl_cur=0,sl_next=SLOTB;
  #define ROT() do{sl_prev=sl_cur;sl_cur=sl_next;sl_next=(sl_next==(NSLOT-1)*SLOTB)?0:sl_next+SLOTB;}while(0)
  DMA_K(2,2*SLOTB);
  WAIT_BAR(3);
  unsigned selbits=(1u<<qb)-1u;
  if(qb>3){ selbits=0u;
    const __attribute__((address_space(3))) float* km3=(const __attribute__((address_space(3))) float*)(shm3+LDS_KM);
    float qf[32];
    #pragma unroll
    for(int d0=0;d0<4;++d0){
      #pragma unroll
      for(int i=0;i<8;++i) qf[d0*8+i]=__uint_as_float(((unsigned)(unsigned short)qr[d0][i])<<16);}
    float gj[7];
    #pragma unroll
    for(int j=0;j<7;++j){ float s=0.f;
      if(j<qb){
        #pragma unroll
        for(int d0=0;d0<4;++d0){ const f32x4v k0=*(const __attribute__((address_space(3))) f32x4v*)(km3+j*64+d0*16+hi*8); const f32x4v k1=*(const __attribute__((address_space(3))) f32x4v*)(km3+j*64+d0*16+hi*8+4);
          s+=qf[d0*8+0]*k0[0]+qf[d0*8+1]*k0[1]+qf[d0*8+2]*k0[2]+qf[d0*8+3]*k0[3]+qf[d0*8+4]*k1[0]+qf[d0*8+5]*k1[1]+qf[d0*8+6]*k1[2]+qf[d0*8+7]*k1[3]; }
        auto rr=__builtin_amdgcn_permlane32_swap(__float_as_uint(s),__float_as_uint(s),false,false); s=__uint_as_float(rr[0])+__uint_as_float(rr[1]); }
      gj[j]=s; }
    #pragma unroll
    for(int j=0;j<7;++j){ int rank=0;
      #pragma unroll
      for(int k=0;k<7;++k){ if(k!=j){ const bool beats=(k<j)?(gj[k]>=gj[j]):(gj[k]>gj[j]); rank+=(k<qb&&beats)?1:0; } }
      if(j<qb&&rank<3)selbits|=(1u<<j); }
  }
  #define MASKADD(t) ((((t)>>2)<qb && !((selbits>>((t)>>2))&1u))?-1.0e30f:0.0f)
  qkt(pA0,pA1,Kbase,qr,r32,hi);asm volatile("s_nop 15\n\ts_nop 7":"+v"(pA0),"+v"(pA1));CMASK(pA0,pA1,0);
  START(pA0,pA1,0);
  _Pragma("unroll") for(int r=0;r<16;++r)pA1[r]=__builtin_amdgcn_exp2f(pA1[r]);
  WAIT_BAR(0);
  DMA_K(3,0);DMA_V(1,SLOTB);
  ROT();
  kload8(kf,kp0+sl_cur);
  WAIT_BAR(2);
  s16x4 vlo[8],vhi[8]; u32x4 pw0,pw1,pw2,pw3;
  #define PKW(P,B) cvtpk_s(P[B],P[B+1])
  #define PAF(k) __builtin_bit_cast(bf16x8,pw##k)
  #define VFR(i) (bf16x8){vlo[i][0],vlo[i][1],vlo[i][2],vlo[i][3],vhi[i][0],vhi[i][1],vhi[i][2],vhi[i][3]}
  #define PIN(x) asm volatile("":"+v"(x))
  #define MX3(a,b,c) __builtin_fmaxf(__builtin_fmaxf((a),(b)),(c))
  #define GAPA(MF,A0,A1,A2,A3,W0,W1,PW) do{ MF; sacc+=A0; sacc+=A1; sacc+=A2; sacc+=A3; PIN(sacc); W0; W1; PIN(PW); SBAR(); }while(0)
  #define EX(v) __builtin_amdgcn_exp2f(v)
  #define GAPB(MF,X,B) do{ MF; X[B]=EX(X[B]); X[B+1]=EX(X[B+1]); X[B+2]=EX(X[B+2]); X[B+3]=EX(X[B+3]); PIN(X); SBAR(); }while(0)
  #define VRD(i) do{ vlo[i]=vtr(vp_+(((i)>>2)*4096+((i)&3)*1024)); vhi[i]=vtr(vp_+(((i)>>2)*4096+((i)&3)*1024+512)); }while(0)
  #define KRD(G,j) do{ if(G){ kload2(kf,kp0+sl_next,j); SBAR(); } }while(0)
  #define STEP(C0,C1,P0,P1,t,GK,GV,GL) do{ SBAR(); \
    const lds_cptr vp_=vp0+sl_prev; \
    VRD(0); SBAR(); float sacc=(P0[0]+P0[1]); \
    GAPA(C0=__builtin_amdgcn_mfma_f32_32x32x16_bf16(kf[0],qr[0],(f32x16){},0,0,0), P0[2],P0[3],P0[4],P0[5],     pw0[0]=PKW(P0,0), pw0[1]=PKW(P0,2), pw0); \
    VRD(4); SBAR(); GAPA(C1=__builtin_amdgcn_mfma_f32_32x32x16_bf16(kf[1],qr[0],(f32x16){},0,0,0), P0[6],P0[7],P0[8],P0[9],     pw0[2]=PKW(P0,4), pw0[3]=PKW(P0,6), pw0); \
    VRD(1); SBAR(); GAPA(C0=__builtin_amdgcn_mfma_f32_32x32x16_bf16(kf[2],qr[1],C0,0,0,0),   P0[10],P0[11],P0[12],P0[13], pw1[0]=PKW(P0,8), pw1[1]=PKW(P0,10), pw1); \
    VRD(5); SBAR(); GAPA(C1=__builtin_amdgcn_mfma_f32_32x32x16_bf16(kf[3],qr[1],C1,0,0,0),   P0[14],P0[15],P1[0],P1[1],   pw1[2]=PKW(P0,12),pw1[3]=PKW(P0,14), pw1); \
    VRD(2); SBAR(); GAPA(C0=__builtin_amdgcn_mfma_f32_32x32x16_bf16(kf[4],qr[2],C0,0,0,0),   P1[2],P1[3],P1[4],P1[5],     pw2[0]=PKW(P1,0), pw2[1]=PKW(P1,2), pw2); \
    VRD(6); SBAR(); GAPA(C1=__builtin_amdgcn_mfma_f32_32x32x16_bf16(kf[5],qr[2],C1,0,0,0),   P1[6],P1[7],P1[8],P1[9],     pw2[2]=PKW(P1,4), pw2[3]=PKW(P1,6), pw2); \
    VRD(3); SBAR(); GAPA(C0=__builtin_amdgcn_mfma_f32_32x32x16_bf16(kf[6],qr[3],C0,0,0,0),   P1[10],P1[11],P1[12],P1[13], pw3[0]=PKW(P1,8), pw3[1]=PKW(P1,10), pw3); \
    VRD(7); SBAR(); GAPA(C1=__builtin_amdgcn_mfma_f32_32x32x16_bf16(kf[7],qr[3],C1,0,0,0),   P1[14],P1[15],0.f,0.f,       pw3[2]=PKW(P1,12),pw3[3]=PKW(P1,14), pw3); \
    l_reg+=sacc; \
    if(GK){DMA_K((t)+3,sl_cur);} if(GV){DMA_V((t)+1,sl_next);} \
    CMASK(C0,C1,t); \
    { float a=MX3(C0[0],C0[1],C1[0]),b=MX3(C0[2],C0[3],C1[1]); a=MX3(a,C1[2],C1[3]); \
      _Pragma("unroll") for(int r=4;r<16;r+=4){a=MX3(a,C0[r],C0[r+1]);b=MX3(b,C0[r+2],C0[r+3]);a=MX3(a,C1[r],C1[r+1]);b=MX3(b,C1[r+2],C1[r+3]);} \
      float rm=__builtin_fmaxf(a,b); { auto rr=__builtin_amdgcn_permlane32_swap(__float_as_uint(rm),__float_as_uint(rm),false,false); rm=__builtin_fmaxf(__uint_as_float(rr[0]),__uint_as_float(rr[1])); } \
      const float nv_=MASKADD(t)-mhat; rm+=nv_; float cc_=nv_; \
      resc=false; \
      if(__builtin_expect(__any(rm>(float)THRL),0)){ const float dl=__builtin_fmaxf(rm,0.f); mhat+=dl; cc_-=dl; \
        const float f=__builtin_amdgcn_exp2f(-dl); l_reg*=f; if(hi==0)wsf[r32]=f; resc=true; } \
      _Pragma("unroll") for(int r=0;r<16;++r){C0[r]+=cc_;C1[r]+=cc_;} } \
    SBAR(); \
    GAPB(o[0]=__builtin_amdgcn_mfma_f32_32x32x16_bf16(PAF(0),VFR(0),o[0],0,0,0), C0,0); \
    GAPB(o[1]=__builtin_amdgcn_mfma_f32_32x32x16_bf16(PAF(0),VFR(4),o[1],0,0,0), C0,4); \
    KRD(GL,0); GAPB(o[0]=__builtin_amdgcn_mfma_f32_32x32x16_bf16(PAF(1),VFR(1),o[0],0,0,0), C0,8); \
    KRD(GL,1); GAPB(o[1]=__builtin_amdgcn_mfma_f32_32x32x16_bf16(PAF(1),VFR(5),o[1],0,0,0), C0,12); \
    KRD(GL,2); GAPB(o[0]=__builtin_amdgcn_mfma_f32_32x32x16_bf16(PAF(2),VFR(2),o[0],0,0,0), C1,0); \
    KRD(GL,3); GAPB(o[1]=__builtin_amdgcn_mfma_f32_32x32x16_bf16(PAF(2),VFR(6),o[1],0,0,0), C1,4); \
    GAPB(o[0]=__builtin_amdgcn_mfma_f32_32x32x16_bf16(PAF(3),VFR(3),o[0],0,0,0), C1,8); \
    GAPB(o[1]=__builtin_amdgcn_mfma_f32_32x32x16_bf16(PAF(3),VFR(7),o[1],0,0,0), C1,12); \
    }while(0)
  int t=1;
  #undef CMASK
  #define CMASK(P0,P1,t) do{}while(0)
  for(;t+7<NT;t+=2){
    STEP(pB0,pB1,pA0,pA1,t,true,true,true);     WAIT_BAR(2); RESC(); ROT();
    STEP(pA0,pA1,pB0,pB1,t+1,true,true,true);   WAIT_BAR(2); RESC(); ROT();
  }
  #undef CMASK
  #define CMASK(P0,P1,t) do{int jb_=(t)-(NT-4);   \
    if(jb_>=-2 && 32*wid+31-64*jb_>=0 && 32*wid-64*jb_-63<=112)biasadd(P0,P1,jb_,qrel,hi,btl); if(jb_>=0 && 64*jb_+63>32*wid)cmask(P0,P1,jb_,qrel,hi);}while(0)
  #define ENDW(tt) do{ if((tt)+3<NT){WAIT_BAR(2);} else if((tt)+2<NT){WAIT_BAR(1);} else {WAIT_BAR(0);} }while(0)
  for(;t+1<NT;t+=2){
    STEP(pB0,pB1,pA0,pA1,t,(t+3<NT),(t+1<NT),(t+1<NT));       ENDW(t);   RESC(); ROT();
    STEP(pA0,pA1,pB0,pB1,t+1,(t+4<NT),(t+2<NT),(t+2<NT));     ENDW(t+1); RESC(); ROT();
  }
  STEP(pB0,pB1,pA0,pA1,NT-1,false,false,false); RESC();
  { float sacc=pB0[0]+pB0[1]; _Pragma("unroll") for(int r=2;r<16;++r)sacc+=pB0[r]; _Pragma("unroll") for(int r=0;r<16;++r)sacc+=pB1[r]; l_reg+=sacc;
    pw0=(u32x4){PKW(pB0,0),PKW(pB0,2),PKW(pB0,4),PKW(pB0,6)};pw1=(u32x4){PKW(pB0,8),PKW(pB0,10),PKW(pB0,12),PKW(pB0,14)};pw2=(u32x4){PKW(pB1,0),PKW(pB1,2),PKW(pB1,4),PKW(pB1,6)};pw3=(u32x4){PKW(pB1,8),PKW(pB1,10),PKW(pB1,12),PKW(pB1,14)};
    SBAR(); pv(o,vb0+sl_cur,PAF(0),PAF(1),PAF(2),PAF(3)); }
  #undef PKW
  #undef PAF
  #undef VFR
  #undef PIN
  #undef MX3
  #undef GAPA
  #undef GAPB
  #undef EX
  #undef VRD
  #undef KRD
  #undef STEP
  #undef ENDW
  #undef MASKADD
  {auto rr=__builtin_amdgcn_permlane32_swap(__float_as_uint(l_reg),__float_as_uint(l_reg),false,false);l_reg=__uint_as_float(rr[0])+__uint_as_float(rr[1]);}
  if(hi==0)wsf[32+r32]=l_reg;asm volatile("s_waitcnt lgkmcnt(0)":::"memory");
  float rli[16];
  #pragma unroll
  for(int r=0;r<16;++r)rli[r]=__builtin_amdgcn_rcpf(wsf[32+crow(r,hi)]);
  bf16*Ow=O+(rowbase+q0+wid*QBLK)*DM+h*D;
  { bf16*stg=(bf16*)(shm+LDS_OST)+wid*2048;
    #pragma unroll
    for(int r=0;r<16;++r){const int orow=crow(r,hi);
      #pragma unroll
      for(int d0=0;d0<2;++d0)stg[orow*64+d0*32+r32]=__float2bfloat16(o[d0][r]*rli[r]);}
    asm volatile("s_waitcnt lgkmcnt(0)":::"memory");
    #pragma unroll
    for(int i=0;i<4;++i){const int row=i*8+(lane>>3),ch=lane&7; const u32x4 v=*(const u32x4*)(stg+row*64+ch*8); ATTN_STORE16(Ow+(long)row*DM+ch*8,v);} }
  asm volatile("s_waitcnt lgkmcnt(0)\n\ts_barrier":::"memory");
  #undef DMA_K
  #undef DMA_V
  #undef CMASK
  #undef START
  #undef RESC
  #undef ROT
}
constexpr int ATTN_LDS_BYTES=LDS_BYTES;
#undef SBAR
#undef WAIT_BAR
}
constexpr int NWAVES = 8;
constexpr int PER_PHASE = 10;
constexpr int N_LAUNCHES = MK_N_LAUNCHES;

constexpr int BATCH = 8, SEQ = 2048, DMODEL = 1024, MTOK = BATCH * SEQ;
constexpr int INCOLS = 4096, SSMW = 512, NGRP = 32, CH = 32  , NCHUNK = SEQ / CH  , APK = 640  ;
constexpr int PQ = 2048, NEXP = 16384;
constexpr float RMS_EPS = 1e-6f;

constexpr size_t MiB = 1u << 20;
constexpr size_t WS_CTL = 0, CTL_ZERO_BYTES = 64 * 1024;
constexpr size_t WS_BIAS = 1 * MiB;
constexpr size_t WS_PW32 = 1 * MiB + 64 * 1024;
constexpr size_t WS_KPART = 1 * MiB + 128 * 1024;
constexpr size_t WS_KG = 2 * MiB;
constexpr size_t WS_SSQ1 = 3 * MiB;
constexpr size_t WS_WIN = 6 * MiB, WS_WQ = 14 * MiB, WS_WOUT = 18 * MiB, WS_WUS = 20 * MiB, WS_WUA = 21 * MiB, WS_WGLU = 22 * MiB, WS_KS = 22 * MiB + 512 * 1024;
constexpr size_t WS_WE = 23 * MiB;
constexpr size_t WS_BP = 32 * MiB;
constexpr size_t WS_AP = 52 * MiB;
constexpr size_t WS_E = 72 * MiB;
constexpr size_t WS_H = 80 * MiB;
constexpr size_t WS_YPRE = 80 * MiB, WS_YA = 96 * MiB, WS_XG = 80 * MiB;
constexpr size_t WS_Z = 96 * MiB, ZSTRIDE_B = 16 * MiB;
constexpr size_t WS_MRG = 128 * MiB;
constexpr size_t WS_PQ = 160 * MiB;
constexpr size_t WS_IDS = 224 * MiB, WS_GTS = 232 * MiB;
constexpr size_t WS_U16 = 32 * MiB, WS_V16 = 240 * MiB;
constexpr size_t WS_YB = 224 * MiB;
constexpr size_t WS_WPK = 128 * MiB, WS_RSTD1 = 4 * MiB, WS_Y16 = 160 * MiB;
constexpr size_t WS_END = 256 * MiB;
constexpr int CW_BAR = 1024;

constexpr int RING_OFF = 0, RING_BYTES = 131072;
constexpr int LDSCTL_OFF = RING_BYTES, MISC_OFF = LDSCTL_OFF + 320;
constexpr int LDS_BYTES = 147456;

#define GAS __attribute__((address_space(1)))
#define LAS __attribute__((address_space(3)))
typedef unsigned short bf16;
typedef unsigned v4u __attribute__((ext_vector_type(4)));
typedef float f32x4 __attribute__((ext_vector_type(4)));
typedef short bf16x8 __attribute__((ext_vector_type(8)));
typedef float f32x16 __attribute__((ext_vector_type(16)));
typedef __bf16 bf16x2_t __attribute__((ext_vector_type(2)));
typedef _Float16 h2_t __attribute__((ext_vector_type(2)));
typedef GAS unsigned gu32;
#define RLX_AGENT __ATOMIC_RELAXED, __HIP_MEMORY_SCOPE_AGENT
#define LDS_WAIT() asm volatile("s_waitcnt lgkmcnt(0)" ::: "memory")
#define VM_WAIT() asm volatile("s_waitcnt vmcnt(0)" ::: "memory")
__device__ __forceinline__ unsigned f2bf(float f) { unsigned u = __builtin_bit_cast(unsigned, f); return (u + 0x7fffu + ((u >> 16) & 1u)) >> 16; }
__device__ __forceinline__ unsigned pk2(float lo, float hi) { return f2bf(lo) | (f2bf(hi) << 16); }
using pg8::cvt_pk_bf16; using pg8::bf_lo; using pg8::bf_hi; using pg8::sigmoid_f; using pg8::gelu_tanh;

#define XB_TMO      128
#define XB_XCNT(j)  (256  + 64 * (j))
#define XB_XSUB(j)  (1280 + 64 * (j))
#define XB_XGEN(j)  (2304 + 64 * (j))
#define XB_TOP      3328
#define XB_TOPGEN   3392
#define XCD_BAR_WORDS 3456
#define XB_SPIN_CAP (1u << 18)
__device__ __forceinline__ unsigned xb_ld(unsigned* p)              { return __hip_atomic_load(p, __ATOMIC_RELAXED, __HIP_MEMORY_SCOPE_AGENT); }
__device__ __forceinline__ unsigned xb_add(unsigned* p, unsigned v) { return __hip_atomic_fetch_add(p, v, __ATOMIC_RELAXED, __HIP_MEMORY_SCOPE_AGENT); }
__device__ __forceinline__ unsigned xb_xcc_id() { return (unsigned)__builtin_amdgcn_s_getreg((3 << 11) | 20) & 0xFu; }
#define XB_SPIN(cond, bar) do { unsigned _sp = 0; while (cond) { __builtin_amdgcn_s_sleep(1); \
    if ((++_sp & 255u) == 0u) { if (xb_ld(&(bar)[XB_TMO])) break; if (_sp > XB_SPIN_CAP) { atomicAdd(&(bar)[XB_TMO], 1u); break; } } } } while (0)
struct XcdBarrier { unsigned* bar; unsigned x; volatile LAS unsigned* st; };
__device__ __forceinline__ XcdBarrier xcd_barrier_post(unsigned* bar, volatile LAS unsigned* st) {
    XcdBarrier b; b.bar = bar; b.x = xb_xcc_id(); b.st = st;
    if (threadIdx.x == 0) (void)xb_add(&bar[XB_XCNT(b.x)], 1u);
    return b;
}
__device__ __forceinline__ void xcd_barrier_complete(unsigned* bar, unsigned x, unsigned& nloc, unsigned& nx) {
    const unsigned G = gridDim.x * gridDim.y * gridDim.z;
    unsigned sum, cnt, mine, sp = 0u;
    for (;;) {
        sum = 0u; cnt = 0u; mine = 0u;
#pragma unroll
        for (unsigned j = 0; j < 16; ++j) { const unsigned c = xb_ld(&bar[XB_XCNT(j)]); sum += c; cnt += (c > 0u) ? 1u : 0u; mine = (j == x) ? c : mine; }
        if (sum == G) break;
        __builtin_amdgcn_s_sleep(1);
        if ((++sp & 255u) == 0u) { if (xb_ld(&bar[XB_TMO])) break; if (sp > XB_SPIN_CAP) { atomicAdd(&bar[XB_TMO], 1u); break; } }
    }
    nloc = mine > 0u ? mine : 1u; nx = cnt > 0u ? cnt : 1u;
}
__device__ __forceinline__ void xcd_barrier(const XcdBarrier& b) {
    asm volatile("s_waitcnt vmcnt(0)" ::: "memory");
    __syncthreads();
    if (threadIdx.x == 0) {
        unsigned* bar = b.bar;
        __builtin_amdgcn_s_waitcnt(0);
        unsigned nloc = b.st[0], nx = b.st[1];
        if (nloc == 0u) { xcd_barrier_complete(bar, b.x, nloc, nx); b.st[0] = nloc; b.st[1] = nx; }
        const unsigned old = xb_add(&bar[XB_XSUB(b.x)], 1u);
        const unsigned gen = old / nloc;
        if (old + 1u == (gen + 1u) * nloc) {
            __builtin_amdgcn_fence(__ATOMIC_RELEASE, "agent");
            asm volatile("s_waitcnt vmcnt(0)" ::: "memory");
            const unsigned og = xb_add(&bar[XB_TOP], 1u);
            const unsigned tg = og / nx;
            if (og + 1u == (tg + 1u) * nx) xb_add(&bar[XB_TOPGEN], 1u);
            else XB_SPIN(xb_ld(&bar[XB_TOPGEN]) == tg, bar);
            __builtin_amdgcn_fence(__ATOMIC_ACQUIRE, "agent");
            xb_add(&bar[XB_XGEN(b.x)], 1u);
            asm volatile("s_waitcnt vmcnt(0)" ::: "memory");
        } else {
            XB_SPIN(xb_ld(&bar[XB_XGEN(b.x)]) == gen, bar);
            __builtin_amdgcn_fence(__ATOMIC_ACQUIRE, "agent");
            asm volatile("s_waitcnt vmcnt(0)" ::: "memory");
        }
    }
    __syncthreads();
}

__device__ __forceinline__ float wave_sum(float v) {
#pragma unroll
    for (int o = 1; o < 64; o <<= 1) v += __shfl_xor(v, o);
    return v;
}

namespace pg8 {
struct EpiIn {
    static constexpr bool PERM = true;
    bf16_t* zbase; bf16_t* AP; float* kpart;
    __device__ __forceinline__ void operator()(const f32x4 (&acc)[2][2][4][2], const Unit& u, int wr, int wc, int fr, int fq) const {
        const int t = u.pn >> 1, colt = (u.pn & 1) * 256;
        const int row0 = u.pm * BM + wr * 64 + fr, col0 = colt + wc * 32 + 8 * fq;
        if (t == 0) {
#pragma unroll
            for (int ai = 0; ai < 2; ++ai)
#pragma unroll
                for (int m = 0; m < 4; ++m) { const int r = row0 + ai * HALF + m * 16, b = r >> 11, l = r & 2047;
#pragma unroll
                    for (int bj = 0; bj < 2; ++bj) { const int c = col0 + bj * HALF, g = c >> 4, hi0 = c & 15;
                        const f32x4 v0 = acc[ai][bj][m][0], v1 = acc[ai][bj][m][1];
                        u32x4 w; w.x = cvt_pk_bf16(v0[0], v0[1]); w.y = cvt_pk_bf16(v0[2], v0[3]); w.z = cvt_pk_bf16(v1[0], v1[1]); w.w = cvt_pk_bf16(v1[2], v1[3]);
                        *(u32x4*)(AP + (size_t)(g * 512 + b * 64 + (l >> 5)) * 640 + (l & 31) * 16 + hi0) = w; } }
        } else {
            bf16_t* base = zbase + (size_t)t * (16u * 1024u * 1024u / 2u);
            const float sc = (t == 1) ? 0.125f * 1.4426950408889634f : 1.0f;
#pragma unroll
            for (int ai = 0; ai < 2; ++ai)
#pragma unroll
                for (int m = 0; m < 4; ++m) { bf16_t* rowp = base + (size_t)(row0 + ai * HALF + m * 16) * 512 + col0;
#pragma unroll
                    for (int bj = 0; bj < 2; ++bj) { f32x4 v0 = acc[ai][bj][m][0], v1 = acc[ai][bj][m][1];
                        if (t >= 4) {
#pragma unroll
                            for (int e = 0; e < 4; ++e) { v0[e] = sigmoid_f(v0[e]); v1[e] = sigmoid_f(v1[e]); }
                        } else { v0 = v0 * sc; v1 = v1 * sc; }
                        u32x4 w; w.x = cvt_pk_bf16(v0[0], v0[1]); w.y = cvt_pk_bf16(v0[2], v0[3]); w.z = cvt_pk_bf16(v1[0], v1[1]); w.w = cvt_pk_bf16(v1[2], v1[3]);
                        *(u32x4*)(rowp + bj * HALF) = w; } }
            if (t == 2) {
#pragma unroll
                for (int bj = 0; bj < 2; ++bj)
#pragma unroll
                    for (int n = 0; n < 2; ++n) { f32x4 s = (f32x4){0.f, 0.f, 0.f, 0.f};
#pragma unroll
                        for (int ai = 0; ai < 2; ++ai)
#pragma unroll
                            for (int m = 0; m < 4; ++m) s += acc[ai][bj][m][n];
#pragma unroll
                        for (int e = 0; e < 4; ++e) { float x = s[e]; x += __shfl_xor(x, 1); x += __shfl_xor(x, 2); x += __shfl_xor(x, 4); x += __shfl_xor(x, 8); s[e] = x; }
                        if (fr == 0) *(f32x4*)(kpart + (size_t)(u.pm * 2 + wr) * 512 + col0 + bj * HALF + 4 * n) = s; }
            }
        }
    }
};
struct EpiE {
    static constexpr bool PERM = false;
    float* E;
    __device__ __forceinline__ void operator()(const f32x4 (&acc)[2][2][4][2], const Unit& u, int wr, int wc, int fr, int fq) const {
        const int row0 = u.pm * BM + wr * 64 + fr, col0 = wc * 32 + 4 * fq;
#pragma unroll
        for (int ai = 0; ai < 2; ++ai)
#pragma unroll
            for (int m = 0; m < 4; ++m) { float* rowp = E + (size_t)(row0 + ai * HALF + m * 16) * 128 + col0;
#pragma unroll
                for (int n = 0; n < 2; ++n) *(f32x4*)(rowp + n * 16) = acc[ai][0][m][n]; }
    }
};
struct EpiY {
    static constexpr bool PERM = true;
    bf16_t* Y;
    __device__ __forceinline__ void operator()(const f32x4 (&acc)[2][2][4][2], const Unit& u, int wr, int wc, int fr, int fq) const {
        const int row0 = u.pm * BM + wr * 64 + fr, col0 = u.pn * BM + wc * 32 + 8 * fq;
#pragma unroll
        for (int ai = 0; ai < 2; ++ai)
#pragma unroll
            for (int m = 0; m < 4; ++m) { const int r = row0 + ai * HALF + m * 16, g = r >> 9, b = (r >> 6) & 7, c = r & 63;
#pragma unroll
                for (int bj = 0; bj < 2; ++bj) { const int cc = col0 + bj * HALF, j = cc >> 4, ho0 = cc & 15;
                    f32x4 v0 = acc[ai][bj][m][0], v1 = acc[ai][bj][m][1];
#pragma unroll
                    for (int e = 0; e < 4; ++e) { v0[e] = gelu_tanh(v0[e]); v1[e] = gelu_tanh(v1[e]); }
                    u32x4 w; w.x = cvt_pk_bf16(v0[0], v0[1]); w.y = cvt_pk_bf16(v0[2], v0[3]); w.z = cvt_pk_bf16(v1[0], v1[1]); w.w = cvt_pk_bf16(v1[2], v1[3]);
                    *(u32x4*)(Y + (size_t)(b * 2048 + c * 32 + j) * 512 + g * 16 + ho0) = w; } }
    }
};
struct EpiGlu {
    static constexpr bool PERM = true;
    const bf16_t* Yp; bf16_t* Ya; const float* bias;
    __device__ __forceinline__ void operator()(const f32x4 (&acc)[2][2][4][2], const Unit& u, int wr, int wc, int fr, int fq) const {
        const int row0 = u.pm * BM + wr * 64 + fr, col0 = u.pn * BM + wc * 32 + 8 * fq;
        f32x4 bv[2][2];
#pragma unroll
        for (int bj = 0; bj < 2; ++bj)
#pragma unroll
            for (int n = 0; n < 2; ++n) bv[bj][n] = *(const f32x4*)(bias + col0 + bj * HALF + 4 * n);
#pragma unroll
        for (int ai = 0; ai < 2; ++ai)
#pragma unroll
            for (int m = 0; m < 4; ++m) { const size_t off = (size_t)(row0 + ai * HALF + m * 16) * 512 + col0;
#pragma unroll
                for (int bj = 0; bj < 2; ++bj) { const f32x4 z0 = acc[ai][bj][m][0] + bv[bj][0], z1 = acc[ai][bj][m][1] + bv[bj][1];
                    const u32x4 y = *(const u32x4*)(Yp + off + bj * HALF);
                    u32x4 w; w.x = cvt_pk_bf16(bf_lo(y.x) * sigmoid_f(z0[0]), bf_hi(y.x) * sigmoid_f(z0[1])); w.y = cvt_pk_bf16(bf_lo(y.y) * sigmoid_f(z0[2]), bf_hi(y.y) * sigmoid_f(z0[3]));
                    w.z = cvt_pk_bf16(bf_lo(y.z) * sigmoid_f(z1[0]), bf_hi(y.z) * sigmoid_f(z1[1])); w.w = cvt_pk_bf16(bf_lo(y.w) * sigmoid_f(z1[2]), bf_hi(y.w) * sigmoid_f(z1[3]));
                    *(u32x4*)(Ya + off + bj * HALF) = w; } }
    }
};
template <int ADD> struct EpiMrg {
    static constexpr bool PERM = true;
    const bf16_t* G0; bf16_t* Mrg;
    __device__ __forceinline__ void operator()(const f32x4 (&acc)[2][2][4][2], const Unit& u, int wr, int wc, int fr, int fq) const {
        const int row0 = u.pm * BM + wr * 64 + fr, cin = wc * 32 + 8 * fq;
        const bf16_t* gb = G0 + (size_t)(u.pn >> 1) * (16u * 1024u * 1024u / 2u) + (u.pn & 1) * 256 + cin;
#pragma unroll
        for (int ai = 0; ai < 2; ++ai)
#pragma unroll
            for (int m = 0; m < 4; ++m) { const int r = row0 + ai * HALF + m * 16;
#pragma unroll
                for (int bj = 0; bj < 2; ++bj) {
#if defined(ABL_NO_SSM) || defined(ABL_NO_ATT)
#if defined(ABL_NO_SSM)
                    constexpr bool kill = (ADD == 0);
#else
                    constexpr bool kill = (ADD == 1);
#endif
                    const f32x4 a0 = kill ? (f32x4){0.f, 0.f, 0.f, 0.f} : acc[ai][bj][m][0], a1 = kill ? (f32x4){0.f, 0.f, 0.f, 0.f} : acc[ai][bj][m][1];
#else
                    const f32x4 a0 = acc[ai][bj][m][0], a1 = acc[ai][bj][m][1];
#endif
                    const u32x4 gt = *(const u32x4*)(gb + (size_t)r * 512 + bj * HALF);
                    bf16_t* mp = Mrg + (size_t)r * 1024 + u.pn * BM + cin + bj * HALF;
                    float o[8] = { bf_lo(gt.x) * a0[0], bf_hi(gt.x) * a0[1], bf_lo(gt.y) * a0[2], bf_hi(gt.y) * a0[3], bf_lo(gt.z) * a1[0], bf_hi(gt.z) * a1[1], bf_lo(gt.w) * a1[2], bf_hi(gt.w) * a1[3] };
                    if (ADD) { const u32x4 p = *(const u32x4*)mp; o[0] += bf_lo(p.x); o[1] += bf_hi(p.x); o[2] += bf_lo(p.y); o[3] += bf_hi(p.y); o[4] += bf_lo(p.z); o[5] += bf_hi(p.z); o[6] += bf_lo(p.w); o[7] += bf_hi(p.w); }
                    u32x4 w; w.x = cvt_pk_bf16(o[0], o[1]); w.y = cvt_pk_bf16(o[2], o[3]); w.z = cvt_pk_bf16(o[4], o[5]); w.w = cvt_pk_bf16(o[6], o[7]);
                    *(u32x4*)mp = w; } }
    }
};
struct EpiMrgDual {
    static constexpr bool PERM = true;
    EpiMrg<0> a; EpiMrg<1> b;
    __device__ __forceinline__ void operator()(const f32x4 (&acc)[2][2][4][2], const Unit& u, int wr, int wc, int fr, int fq) const { if (u.w == 0) a(acc, u, wr, wc, fr, fq); else b(acc, u, wr, wc, fr, fq); }
};
struct EpiX1 {
    static constexpr bool PERM = true;
    const float* X; float* X1; bf16_t* XG; const float* g2; float* ssq;
    __device__ __forceinline__ void operator()(const f32x4 (&acc)[2][2][4][2], const Unit& u, int wr, int wc, int fr, int fq) const {
        const int row0 = u.pm * BM + wr * 64 + fr, col0 = u.pn * BM + wc * 32 + 8 * fq;
        f32x4 gv[2][2];
#pragma unroll
        for (int bj = 0; bj < 2; ++bj)
#pragma unroll
            for (int n = 0; n < 2; ++n) gv[bj][n] = *(const f32x4*)(g2 + col0 + bj * HALF + 4 * n);
#pragma unroll
        for (int ai = 0; ai < 2; ++ai)
#pragma unroll
            for (int m = 0; m < 4; ++m) { const int r = row0 + ai * HALF + m * 16; const size_t off = (size_t)r * 1024 + col0; float s = 0.f;
#pragma unroll
                for (int bj = 0; bj < 2; ++bj) {
                    #ifdef ABL_NO_MIX
                    const f32x4 x0 = *(const f32x4*)(X + off + bj * HALF), x1 = *(const f32x4*)(X + off + bj * HALF + 4);
#else
                    const f32x4 x0 = *(const f32x4*)(X + off + bj * HALF) + acc[ai][bj][m][0], x1 = *(const f32x4*)(X + off + bj * HALF + 4) + acc[ai][bj][m][1];
#endif
                    *(f32x4*)(X1 + off + bj * HALF) = x0; *(f32x4*)(X1 + off + bj * HALF + 4) = x1;
                    s += (x0[0] * x0[0] + x0[1] * x0[1]) + (x0[2] * x0[2] + x0[3] * x0[3]) + (x1[0] * x1[0] + x1[1] * x1[1]) + (x1[2] * x1[2] + x1[3] * x1[3]);
                    const f32x4 a = x0 * gv[bj][0], b = x1 * gv[bj][1];
                    u32x4 w; w.x = cvt_pk_bf16(a[0], a[1]); w.y = cvt_pk_bf16(a[2], a[3]); w.z = cvt_pk_bf16(b[0], b[1]); w.w = cvt_pk_bf16(b[2], b[3]);
                    *(u32x4*)(XG + off + bj * HALF) = w; }
                s += __shfl_xor(s, 16); s += __shfl_xor(s, 32);
                if (fq == 0) ssq[(size_t)r * 16 + u.pn * 4 + wc] = s; }
    }
};
struct EpiPlain {
    static constexpr bool PERM = true;
    bf16_t* O; int ldc;
    __device__ __forceinline__ void operator()(const f32x4 (&acc)[2][2][4][2], const Unit& u, int wr, int wc, int fr, int fq) const {
        const int row0 = u.pm * BM + wr * 64 + fr, col0 = u.pn * BM + wc * 32 + 8 * fq;
#pragma unroll
        for (int ai = 0; ai < 2; ++ai)
#pragma unroll
            for (int m = 0; m < 4; ++m) { bf16_t* rowp = O + (size_t)(row0 + ai * HALF + m * 16) * ldc + col0;
#pragma unroll
                for (int bj = 0; bj < 2; ++bj) { const f32x4 v0 = acc[ai][bj][m][0], v1 = acc[ai][bj][m][1];
                    u32x4 w; w.x = cvt_pk_bf16(v0[0], v0[1]); w.y = cvt_pk_bf16(v0[2], v0[3]); w.z = cvt_pk_bf16(v1[0], v1[1]); w.w = cvt_pk_bf16(v1[2], v1[3]);
                    *(u32x4*)(rowp + bj * HALF) = w; } }
    }
};
}
struct Frame {
    LAS unsigned char* lds;
    int tid, lane, wave, vcu, G;
};

__device__ __forceinline__ void p0_transpose_item(const float* W, int K, int N, bf16* WT, LAS float* scr, int item, int lane) {
    const int nblk = N / 32, kb = item / nblk, nb = item % nblk, k0 = 64 * kb, n0 = 32 * nb;
    float wv[32];
#pragma unroll
    for (int i = 0; i < 32; ++i) { const int kk = 2 * i + (lane >> 5); wv[i] = W[(size_t)(k0 + kk) * N + n0 + (lane & 31)]; }
#pragma unroll
    for (int i = 0; i < 32; ++i) { const int kk = 2 * i + (lane >> 5); scr[kk * 33 + (lane & 31)] = wv[i]; }
    LDS_WAIT(); asm volatile("" ::: "memory");
    const int c = lane & 7;
#pragma unroll
    for (int j = 0; j < 4; ++j) { const int n = (lane >> 3) + 8 * j; const LAS float* s = scr + (8 * c) * 33 + n;
        v4u o; o.x = pk2(s[0 * 33], s[1 * 33]); o.y = pk2(s[2 * 33], s[3 * 33]); o.z = pk2(s[4 * 33], s[5 * 33]); o.w = pk2(s[6 * 33], s[7 * 33]);
        *(GAS v4u*)(WT + (size_t)(n0 + n) * K + k0 + 8 * c) = o; }
    LDS_WAIT(); asm volatile("" ::: "memory");
}
__device__ __forceinline__ void rms_row_to_bf16(const float* xrow, const float* g, bf16* orow, int lane) {
    const GAS f32x4* xr = (const GAS f32x4*)xrow + lane; const GAS f32x4* gr = (const GAS f32x4*)g + lane;
    f32x4 v[4]; float s = 0.f;
#pragma unroll
    for (int j = 0; j < 4; ++j) { v[j] = xr[64 * j]; s += (v[j].x * v[j].x + v[j].y * v[j].y) + (v[j].z * v[j].z + v[j].w * v[j].w); }
    const float rstd = 1.0f / sqrtf(wave_sum(s) * (1.f / DMODEL) + RMS_EPS);
    GAS unsigned long long* o8 = (GAS unsigned long long*)orow + lane;
#pragma unroll
    for (int j = 0; j < 4; ++j) { const f32x4 gg = gr[64 * j];
        o8[64 * j] = (unsigned long long)pk2(v[j].x * rstd * gg.x, v[j].y * rstd * gg.y) | ((unsigned long long)pk2(v[j].z * rstd * gg.z, v[j].w * rstd * gg.w) << 32); }
}
__device__ __forceinline__ void rms_rows4_to_bf16(const float* x, const float* g, bf16* out, int m, int stride, int lane) {
    f32x4 v[4][4];
#pragma unroll
    for (int k = 0; k < 4; ++k) { const int mm = (m + k * stride < MTOK) ? m + k * stride : m; const GAS f32x4* xr = (const GAS f32x4*)(x + (size_t)mm * DMODEL) + lane;
#pragma unroll
        for (int j = 0; j < 4; ++j) v[k][j] = xr[64 * j]; }
    const GAS f32x4* gr = (const GAS f32x4*)g + lane; f32x4 gg[4];
#pragma unroll
    for (int j = 0; j < 4; ++j) gg[j] = gr[64 * j];
#pragma unroll
    for (int k = 0; k < 4; ++k) { if (m + k * stride >= MTOK) break; float s = 0.f;
#pragma unroll
        for (int j = 0; j < 4; ++j) s += (v[k][j].x * v[k][j].x + v[k][j].y * v[k][j].y) + (v[k][j].z * v[k][j].z + v[k][j].w * v[k][j].w);
        const float rstd = 1.0f / sqrtf(wave_sum(s) * (1.f / DMODEL) + RMS_EPS);
        GAS unsigned long long* o8 = (GAS unsigned long long*)(out + (size_t)(m + k * stride) * DMODEL) + lane;
#pragma unroll
        for (int j = 0; j < 4; ++j) o8[64 * j] = (unsigned long long)pk2(v[k][j].x * rstd * gg[j].x, v[k][j].y * rstd * gg[j].y) | ((unsigned long long)pk2(v[k][j].z * rstd * gg[j].z, v[k][j].w * rstd * gg[j].w) << 32); }
}
struct cpx { float r, i; };
__device__ __forceinline__ cpx cmul(cpx a, cpx b) { return cpx{a.r * b.r - a.i * b.i, a.r * b.i + a.i * b.r}; }
__device__ __forceinline__ cpx cpow_(float ar, float ai, float dt, int n) { const float e = expf(ar * dt * (float)n); const float ang = ai * dt * (float)n; return cpx{e * cosf(ang), e * sinf(ang)}; }
__device__ __forceinline__ void ssm_table_task(int g, int j, int lane, LAS float* scr, const float* a_re, const float* a_im, const float* log_dt, const float* b_re, const float* b_im,
                                               const float* c_re, const float* c_im, float* Kg, bf16* WE, bf16* BP, float* pw32) {
    const int p = lane;
    const float dt = expf(log_dt[g]), ar = a_re[g * 64 + p], ai = a_im[g * 64 + p];
#define pw(n) cpow_(ar, ai, dt, (n))
    const cpx lb = pw(1);
    const float den = ar * ar + ai * ai;
    const cpx coef = cpx{((lb.r - 1.f) * ar + lb.i * ai) / den, (lb.i * ar - (lb.r - 1.f) * ai) / den};
    const cpx pj = pw(j), pe = pw(31 - j), pv = pw(j + 1);
    unsigned wer[8], wei[8];
#pragma unroll
    for (int h2 = 0; h2 < 8; ++h2) { float er[2], ei[2];
#pragma unroll
        for (int q = 0; q < 2; ++q) { const int hi = 2 * h2 + q;
            const cpx bb = cmul(coef, cpx{b_re[(g * 64 + p) * 16 + hi], b_im[(g * 64 + p) * 16 + hi]});
            const cpx w = cmul(pj, bb); scr[(p * 16 + hi) * 2] = w.r; scr[(p * 16 + hi) * 2 + 1] = w.i;
            const cpx e = cmul(pe, bb); er[q] = e.r; ei[q] = e.i; }
        wer[h2] = pk2(er[0], er[1]); wei[h2] = pk2(ei[0], ei[1]); }
    { bf16* w0 = WE + ((size_t)(g * 256 + p) * 512 + j * 16); bf16* w1 = WE + ((size_t)(g * 256 + 64 + p) * 512 + j * 16);
      *(GAS v4u*)w0 = (v4u){wer[0], wer[1], wer[2], wer[3]}; *(GAS v4u*)(w0 + 8) = (v4u){wer[4], wer[5], wer[6], wer[7]};
      *(GAS v4u*)w1 = (v4u){wei[0], wei[1], wei[2], wei[3]}; *(GAS v4u*)(w1 + 8) = (v4u){wei[4], wei[5], wei[6], wei[7]};
      bf16* z0 = WE + ((size_t)(g * 256 + 128 + p) * 512 + j * 16); bf16* z1 = WE + ((size_t)(g * 256 + 192 + p) * 512 + j * 16); const v4u z = (v4u){0u, 0u, 0u, 0u};
      *(GAS v4u*)z0 = z; *(GAS v4u*)(z0 + 8) = z; *(GAS v4u*)z1 = z; *(GAS v4u*)(z1 + 8) = z; }
#pragma unroll 4
    for (int ho = 0; ho < 16; ++ho) { const cpx cv = cmul(cpx{c_re[(g * 16 + ho) * 64 + p], c_im[(g * 16 + ho) * 64 + p]}, pv);
        bf16* row = BP + ((size_t)(g * 512 + j * 16 + ho) * APK + 512);
        row[p] = (bf16)f2bf(cv.r); row[64 + p] = (bf16)f2bf(-cv.i); }
    if (j == 0) { const cpx p32 = pw(32); pw32[g * 128 + p] = p32.r; pw32[g * 128 + 64 + p] = p32.i; }
    LDS_WAIT(); asm volatile("" ::: "memory");
    { const int ho = lane >> 2, h4 = (lane & 3) * 4; float a0 = 0.f, a1 = 0.f, a2 = 0.f, a3 = 0.f;
      const float* cr = c_re + (g * 16 + ho) * 64; const float* ci = c_im + (g * 16 + ho) * 64;
#pragma unroll 4
      for (int pp = 0; pp < 64; ++pp) { const float r_ = cr[pp], i_ = ci[pp]; const LAS float* w = scr + (pp * 16 + h4) * 2;
          a0 += r_ * w[0] - i_ * w[1]; a1 += r_ * w[2] - i_ * w[3]; a2 += r_ * w[4] - i_ * w[5]; a3 += r_ * w[6] - i_ * w[7]; }
      *(GAS f32x4*)(Kg + ((size_t)(g * 32 + j) * 256 + ho * 16 + h4)) = (f32x4){a0, a1, a2, a3}; }
    LDS_WAIT(); asm volatile("" ::: "memory");
#undef pw
}

__device__ __forceinline__ float vmaxf(float a, float b) { float r; asm("v_max_f32_e32 %0, %1, %2" : "=v"(r) : "v"(a), "v"(b)); return r; }
__device__ __forceinline__ float vminf(float a, float b) { float r; asm("v_min_f32_e32 %0, %1, %2" : "=v"(r) : "v"(a), "v"(b)); return r; }
__device__ __forceinline__ float selhi(float lo, float hi) { float r; asm("v_cndmask_b32_e64 %0, %1, %2, %3" : "=v"(r) : "v"(lo), "v"(hi), "s"(0xFFFFFFFF00000000ull)); return r; }
#define CE_DESC(a, b) do { const float hi_ = vmaxf(a, b), lo_ = vminf(a, b); a = hi_; b = lo_; } while (0)
__device__ __forceinline__ void sort16_desc(float (&v)[16]) {
#pragma unroll
    for (int k = 2; k <= 16; k <<= 1)
#pragma unroll
        for (int j = k >> 1; j > 0; j >>= 1)
#pragma unroll
            for (int i = 0; i < 16; ++i) { const int l = i ^ j; if (l > i) { if ((i & k) == 0) CE_DESC(v[i], v[l]); else CE_DESC(v[l], v[i]); } }
}
__device__ __forceinline__ void bitonic_merge16_desc(float (&v)[16]) {
#pragma unroll
    for (int j = 8; j > 0; j >>= 1)
#pragma unroll
        for (int i = 0; i < 16; ++i) { const int l = i ^ j; if (l > i) CE_DESC(v[i], v[l]); }
}
__device__ __forceinline__ void merge_top16(float (&a)[16], const float (&b)[16]) {
#pragma unroll
    for (int i = 0; i < 16; ++i) a[i] = vmaxf(a[i], b[15 - i]);
    bitonic_merge16_desc(a);
}
__device__ __forceinline__ void merge_partner_top16(float (&a)[16]) {
    float p[16];
#pragma unroll
    for (int i = 0; i < 16; ++i) { const unsigned x = __float_as_uint(a[15 - i]); auto rr = __builtin_amdgcn_permlane32_swap(x, x, false, false); p[i] = selhi(__uint_as_float(rr[1]), __uint_as_float(rr[0])); }
#pragma unroll
    for (int i = 0; i < 16; ++i) a[i] = vmaxf(a[i], p[i]);
    bitonic_merge16_desc(a);
}
__device__ __forceinline__ void topk_half(int half, const bf16x8 (&qf)[8], int r32, int hi, const LAS unsigned char* ksl, float (&top)[16]) {
#pragma unroll 1
    for (int kt = 0; kt < 4; ++kt) {
        f32x16 acc = f32x16{};
        const int row = half * 128 + kt * 32 + r32; const LAS unsigned char* rp = ksl + row * 256; const int sw = row & 15;
#pragma unroll
        for (int ks = 0; ks < 8; ++ks) { const bf16x8 a = *(const LAS bf16x8*)(rp + (((2 * ks + hi) ^ sw) << 4));
            acc = __builtin_amdgcn_mfma_f32_32x32x16_bf16(a, qf[ks], acc, 0, 0, 0); }
        float grp[16];
#pragma unroll
        for (int r = 0; r < 16; ++r) { const unsigned key = (unsigned)(kt * 32 + (r & 3) + 8 * (r >> 2)) + 4u * (unsigned)hi; grp[r] = __uint_as_float((__float_as_uint(acc[r]) & ~127u) | key); }
        sort16_desc(grp);
        if (kt == 0) {
#pragma unroll
            for (int i = 0; i < 16; ++i) top[i] = grp[i];
        } else merge_top16(top, grp);
    }
    merge_partner_top16(top);
}
__device__ __forceinline__ void topk_task(int tt, int hd, int lane, LAS unsigned char* scr, const bf16* PQb, const LAS unsigned char* ksl, const float* ssq1, int* ids, float* gts, float* rstd1) {
    const int r32 = lane & 31, hi = lane >> 5; const bool hib = hi != 0;
    const int token = tt * 32 + r32;
    float v0_[16], v1_[16];
    bf16x8 qf0[8], qf1[8];
#pragma unroll
    for (int ks = 0; ks < 8; ++ks) { qf0[ks] = *(const GAS bf16x8*)(PQb + (size_t)token * PQ + hd * 256 + ks * 16 + hi * 8); qf1[ks] = *(const GAS bf16x8*)(PQb + (size_t)token * PQ + hd * 256 + 128 + ks * 16 + hi * 8); }
    topk_half(0, qf0, r32, hi, ksl, v0_);
    topk_half(1, qf1, r32, hi, ksl, v1_);
#define v_SEL(h, i) ((h) ? v1_[i] : v0_[i])
    LAS unsigned char* slot = scr + lane * 32;
    { v4u d0, d1;
#define PK4(h, k) ((__float_as_uint(v_SEL(h, 4 * (k))) & 127u) | ((__float_as_uint(v_SEL(h, 4 * (k) + 1)) & 127u) << 8) | ((__float_as_uint(v_SEL(h, 4 * (k) + 2)) & 127u) << 16) | ((__float_as_uint(v_SEL(h, 4 * (k) + 3)) & 127u) << 24))
      d0 = (v4u){PK4(0, 0), PK4(0, 1), PK4(0, 2), PK4(0, 3)}; d1 = (v4u){PK4(1, 0), PK4(1, 1), PK4(1, 2), PK4(1, 3)};
#undef PK4
      *(LAS v4u*)slot = d0; *(LAS v4u*)(slot + 16) = d1; }
    float a[16], b[16];
#pragma unroll
    for (int i = 0; i < 16; ++i) { a[i] = selhi(v0_[i], v1_[i]); b[i] = selhi(v1_[i], v0_[i]); }
    const unsigned obit = (unsigned)hi << 8;
#define CAND(i, j) __uint_as_float((__float_as_uint(a[i] + b[j]) & ~511u) | obit | (unsigned)(((i) << 4) | (j)))
    const float NEGBIG = -3.0e38f;
    float g0[16], g1[16];
#pragma unroll
    for (int j = 1; j < 16; ++j) g0[j - 1] = CAND(0, j);
    g0[15] = CAND(1, 2);
    g1[0] = CAND(1, 3); g1[1] = CAND(1, 4); g1[2] = CAND(1, 5); g1[3] = CAND(1, 6); g1[4] = CAND(1, 7); g1[5] = CAND(2, 3); g1[6] = CAND(2, 4);
    { const float c0 = CAND(0, 0), c1 = CAND(1, 1), c2 = CAND(2, 2), c3 = CAND(3, 3);
      g1[7] = selhi(c0, NEGBIG); g1[8] = selhi(c1, NEGBIG); g1[9] = selhi(c2, NEGBIG); g1[10] = selhi(c3, NEGBIG); }
#pragma unroll
    for (int i = 11; i < 16; ++i) g1[i] = NEGBIG;
#undef CAND
    sort16_desc(g0); sort16_desc(g1); merge_top16(g0, g1); merge_partner_top16(g0);
    float rstd;
    { const GAS f32x4* sp = (const GAS f32x4*)(ssq1 + (size_t)token * 16); const f32x4 s0 = sp[0], s1 = sp[1], s2 = sp[2], s3 = sp[3];
      const float ss = ((s0.x + s0.y) + (s0.z + s0.w)) + ((s1.x + s1.y) + (s1.z + s1.w)) + ((s2.x + s2.y) + (s2.z + s2.w)) + ((s3.x + s3.y) + (s3.z + s3.w));
      rstd = 1.0f / sqrtf(ss * (1.f / DMODEL) + RMS_EPS); }
    if (hd == 0 && !hib) rstd1[token] = rstd;
    float ex[16], esum = 0.f; const float sc = rstd * 1.4426950409f;
#pragma unroll
    for (int k = 0; k < 16; ++k) { ex[k] = __builtin_amdgcn_exp2f((g0[k] - g0[0]) * sc); esum += ex[k]; }
    const float inv = 1.0f / esum;
    int eid[8]; float gv[8];
#pragma unroll
    for (int k = 0; k < 8; ++k) { const float wv = selhi(g0[k], g0[8 + k]); const float ev = selhi(ex[k], ex[8 + k]);
        const unsigned tag = __float_as_uint(wv) & 511u, o = tag >> 8, i = (tag >> 4) & 15u, j = tag & 15u; const unsigned i1 = o ? j : i, i2 = o ? i : j;
        const unsigned k1 = slot[i1], k2 = slot[16 + i2];
        eid[k] = (int)(k1 * 128u + k2); gv[k] = ev * inv; }
    { int* ip = ids + (size_t)token * 128 + hd * 16 + 8 * hi; float* gp = gts + (size_t)token * 128 + hd * 16 + 8 * hi;
      *(GAS v4u*)ip = (v4u){(unsigned)eid[0], (unsigned)eid[1], (unsigned)eid[2], (unsigned)eid[3]}; *(GAS v4u*)(ip + 4) = (v4u){(unsigned)eid[4], (unsigned)eid[5], (unsigned)eid[6], (unsigned)eid[7]};
      *(GAS f32x4*)gp = (f32x4){gv[0], gv[1], gv[2], gv[3]}; *(GAS f32x4*)(gp + 4) = (f32x4){gv[4], gv[5], gv[6], gv[7]}; }
    LDS_WAIT(); asm volatile("" ::: "memory");
}


__device__ __forceinline__ float dot2bf(unsigned a, unsigned b, float c) { return __builtin_amdgcn_fdot2_f32_bf16(__builtin_bit_cast(bf16x2_t, a), __builtin_bit_cast(bf16x2_t, b), c, false); }
__device__ __forceinline__ h2_t fma_h2(unsigned v, h2_t w, h2_t acc) { return __builtin_elementwise_fma(__builtin_bit_cast(h2_t, v), w, acc); }
__device__ __forceinline__ unsigned fp8lo_bf(unsigned w, float sc) { return __builtin_bit_cast(unsigned, __builtin_amdgcn_cvt_scalef32_pk_bf16_fp8((int)w, sc, false)); }
__device__ __forceinline__ unsigned fp8hi_bf(unsigned w, float sc) { return __builtin_bit_cast(unsigned, __builtin_amdgcn_cvt_scalef32_pk_bf16_fp8((int)w, sc, true)); }
__device__ __forceinline__ h2_t fp8lo_h(unsigned w, float sc) { return __builtin_amdgcn_cvt_scalef32_pk_f16_fp8((int)w, sc, false); }
__device__ __forceinline__ h2_t fp8hi_h(unsigned w, float sc) { return __builtin_amdgcn_cvt_scalef32_pk_f16_fp8((int)w, sc, true); }
__device__ __forceinline__ unsigned pack_fp8x4(float a, float b, float c, float d) { int w = __builtin_amdgcn_cvt_pk_fp8_f32(a, b, 0, false); w = __builtin_amdgcn_cvt_pk_fp8_f32(c, d, w, true); return (unsigned)w; }
constexpr size_t V6B_OFF = 8u << 20;
constexpr float U8_SCALE = 64.0f, V8_SCALE = 5.656854f;
constexpr int PA_CAP = 464;
constexpr float X8_SCALE = 2.0f;
typedef int v8i_t __attribute__((ext_vector_type(8)));
typedef _Float16 v32h_t __attribute__((ext_vector_type(32)));
typedef unsigned v6u_t __attribute__((ext_vector_type(6)));
typedef unsigned v2u __attribute__((ext_vector_type(2)));
struct TokB { v8i_t b[8]; };
struct RowsA { const unsigned char* p0; const unsigned char* p1; };
__device__ __forceinline__ int pa_tok(unsigned tl, int tb, int nwg) { return ((tl < 4u) ? tb : nwg) + (int)(tl & 3u); }
__device__ __forceinline__ RowsA pa_rows(int b, int n, int lane, const LAS unsigned* list, const unsigned char* U6) {
    const int i0 = b * 16 + (lane >> 3), r8 = lane >> 3, ps = lane & 7;
    const unsigned e0 = list[i0 < n ? i0 : 0], e1 = list[i0 + 8 < n ? i0 + 8 : 0];
    RowsA R; R.p0 = U6 + (size_t)(e0 & 0x3fffu) * 768 + ((ps ^ r8) * 16); R.p1 = U6 + (size_t)(e1 & 0x3fffu) * 768 + ((ps ^ r8 ^ 1) * 16);
    return R;
}
template <int J> __device__ __forceinline__ void pa_dma(const RowsA& R, LAS unsigned char* ring) {
    __builtin_amdgcn_global_load_lds((const unsigned*)R.p0, (LAS unsigned*)(ring + J * (2048 - 128)), 16, J * 128, 0);
    __builtin_amdgcn_global_load_lds((const unsigned*)R.p1, (LAS unsigned*)(ring + J * (2048 - 128) + 1024), 16, J * 128, 0);
}
#define PA_VWAIT(n) asm volatile("s_waitcnt vmcnt(" #n ")" ::: "memory")
#define PA_LWAIT(n) asm volatile("s_waitcnt lgkmcnt(" #n ")" ::: "memory")
__device__ __forceinline__ int pa_uoff(int u, int r) { return (u >> 4) * 2048 + (r >> 3) * 1024 + (r & 7) * 128 + ((((u >> 1) & 7) ^ (r & 7) ^ (r >> 3)) << 4) + (u & 1) * 8; }
struct OpA { v2u d0, d1, d2; };
__device__ __forceinline__ OpA pa_rd(int m, const LAS unsigned char* ring, int r, int g) { const int u = 12 * m + 3 * g; OpA a;
    a.d0 = *(const LAS v2u*)(ring + pa_uoff(u, r)); a.d1 = *(const LAS v2u*)(ring + pa_uoff(u + 1, r)); a.d2 = *(const LAS v2u*)(ring + pa_uoff(u + 2, r)); return a; }
__device__ __forceinline__ f32x4 pa_mm(f32x4 acc, const OpA& a, const TokB& X, int m) {
    return __builtin_amdgcn_mfma_scale_f32_16x16x128_f8f6f4((v8i_t){(int)a.d0.x, (int)a.d0.y, (int)a.d1.x, (int)a.d1.y, (int)a.d2.x, (int)a.d2.y, 0, 0}, X.b[m], acc, 2, 2, 0, 0, 0, 0);
}
__device__ __forceinline__ void pa_flush(int n, const TokB& X, int lane, const LAS unsigned* list, const LAS unsigned* gl, LAS unsigned char* ring, const unsigned char* U6, unsigned* wpk, int tb, int nwg) {
    if (n == 0) return;
    LDS_WAIT(); asm volatile("" ::: "memory");
    const int nb = (n + 15) >> 4;
    const int r = lane & 15, g = lane >> 4;
    RowsA cur = pa_rows(0, n, lane, list, U6), nxt = cur;
    pa_dma<0>(cur, ring); pa_dma<1>(cur, ring); pa_dma<2>(cur, ring); pa_dma<3>(cur, ring); pa_dma<4>(cur, ring); pa_dma<5>(cur, ring);
    for (int b = 0; b < nb; ++b) {
        f32x4 acc0 = {0.f, 0.f, 0.f, 0.f}, acc1 = {0.f, 0.f, 0.f, 0.f};
        OpA A0, A1;
        if (b + 1 < nb) {
            nxt = pa_rows(b + 1, n, lane, list, U6);
            PA_VWAIT(10); A0 = pa_rd(0, ring, r, g);
            PA_VWAIT(8);  A1 = pa_rd(1, ring, r, g); PA_LWAIT(3); acc0 = pa_mm(acc0, A0, X, 0);
            PA_VWAIT(6);  A0 = pa_rd(2, ring, r, g); PA_LWAIT(3); acc1 = pa_mm(acc1, A1, X, 1); pa_dma<0>(nxt, ring);
                          A1 = pa_rd(3, ring, r, g); PA_LWAIT(3); acc0 = pa_mm(acc0, A0, X, 2); pa_dma<1>(nxt, ring);
            PA_VWAIT(8);  A0 = pa_rd(4, ring, r, g); PA_LWAIT(3); acc1 = pa_mm(acc1, A1, X, 3); pa_dma<2>(nxt, ring);
            PA_VWAIT(8);  A1 = pa_rd(5, ring, r, g); PA_LWAIT(3); acc0 = pa_mm(acc0, A0, X, 4);
            PA_VWAIT(6);  A0 = pa_rd(6, ring, r, g); PA_LWAIT(3); acc1 = pa_mm(acc1, A1, X, 5); pa_dma<3>(nxt, ring);
                          A1 = pa_rd(7, ring, r, g); PA_LWAIT(3); acc0 = pa_mm(acc0, A0, X, 6); pa_dma<4>(nxt, ring);
                                                     PA_LWAIT(0); acc1 = pa_mm(acc1, A1, X, 7); pa_dma<5>(nxt, ring);
            cur = nxt;
        } else {
            PA_VWAIT(0);
            A0 = pa_rd(0, ring, r, g);
#pragma unroll
            for (int m = 0; m < 8; m += 2) { A1 = pa_rd(m + 1, ring, r, g); PA_LWAIT(3); acc0 = pa_mm(acc0, A0, X, m);
                if (m + 2 < 8) { A0 = pa_rd(m + 2, ring, r, g); PA_LWAIT(3); } else PA_LWAIT(0);
                acc1 = pa_mm(acc1, A1, X, m + 1); }
        }
        const f32x4 acc = acc0 + acc1;
        const int idx = b * 16 + r; const unsigned ent = list[idx], tl = ent >> 21, slot = (ent >> 14) & 127u;
        const int src = (int)((((unsigned)r >> 2) * 16u + tl) << 2);
        const float v0 = __int_as_float(__builtin_amdgcn_ds_bpermute(src, __float_as_int(acc.x))), v1 = __int_as_float(__builtin_amdgcn_ds_bpermute(src, __float_as_int(acc.y)));
        const float v2 = __int_as_float(__builtin_amdgcn_ds_bpermute(src, __float_as_int(acc.z))), v3 = __int_as_float(__builtin_amdgcn_ds_bpermute(src, __float_as_int(acc.w)));
        const float dv = (r & 2) ? ((r & 1) ? v3 : v2) : ((r & 1) ? v1 : v0);
        if (lane < 16 && idx < n) { const int t = pa_tok(tl, tb, nwg);
            const _Float16 wh = (_Float16)(__uint_as_float(gl[tl * 128 + slot]) * (1.0f / V8_SCALE) * gelu_tanh(dv * (1.0f / (U8_SCALE * X8_SCALE))));
            wpk[(size_t)t * 128 + slot] = ((unsigned)__builtin_bit_cast(unsigned short, wh) << 16) | (ent & 0x3fffu); }
    }
    LDS_WAIT(); asm volatile("" ::: "memory");
}
__device__ __forceinline__ void peer_a_phase(int lane, int wave, int G, int vcu, const bf16* XG, const unsigned char* U6, const int* ids, const float* gts, const float* rstd1, unsigned* wpk, LAS unsigned char* lds, int emask) {
    (void)emask;
    LAS unsigned char* ring = lds + RING_OFF + wave * 16384;
    LAS unsigned* gl = (LAS unsigned*)(ring + 12288);
    LAS unsigned* list = (LAS unsigned*)(lds + MISC_OFF + 128 + wave * (PA_CAP * 4));
    for (int tile0 = vcu; tile0 < MTOK / 32; tile0 += 2 * G) {
        const int tile1 = tile0 + G; const bool has1 = tile1 < MTOK / 32;
        const int tb = tile0 * 32 + wave * 4, nwg = (has1 ? tile1 : tile0) * 32 + wave * 4;
        int id0[8], id1[8];
#pragma unroll
        for (int k = 0; k < 8; ++k) { const bool ok = (k < 4) || has1; const int tc = pa_tok((unsigned)k, tb, nwg);
            gl[k * 128 + lane] = __float_as_uint(gts[(size_t)tc * 128 + lane]); gl[k * 128 + 64 + lane] = __float_as_uint(gts[(size_t)tc * 128 + 64 + lane]);
            id0[k] = ok ? ids[(size_t)tc * 128 + lane] : -1; id1[k] = ok ? ids[(size_t)tc * 128 + 64 + lane] : -1; }
#pragma unroll
        for (int p = 0; p < 4; ++p) { const int k = 2 * p + (lane >> 5), tc = pa_tok((unsigned)k, tb, nwg);
            typedef float v16f_t __attribute__((ext_vector_type(16)));
            const GAS v4u* xs = (const GAS v4u*)(XG + (size_t)tc * 1024 + 32 * (lane & 31));
            const v4u x0 = xs[0], x1 = xs[1], x2 = xs[2], x3 = xs[3];
            const float rs = rstd1[tc] * X8_SCALE;
            const unsigned w[16] = {x0.x, x0.y, x0.z, x0.w, x1.x, x1.y, x1.z, x1.w, x2.x, x2.y, x2.z, x2.w, x3.x, x3.y, x3.z, x3.w};
            float f[32];
#pragma unroll
            for (int i = 0; i < 16; ++i) { f[2 * i] = __uint_as_float(w[i] << 16) * rs; f[2 * i + 1] = __uint_as_float(w[i] & 0xffff0000u) * rs; }
            const v16f_t lo16 = {f[0], f[1], f[2], f[3], f[4], f[5], f[6], f[7], f[8], f[9], f[10], f[11], f[12], f[13], f[14], f[15]},
                         hi16 = {f[16], f[17], f[18], f[19], f[20], f[21], f[22], f[23], f[24], f[25], f[26], f[27], f[28], f[29], f[30], f[31]};
            v6u_t p6; asm volatile("s_nop 1\n\tv_cvt_scalef32_2xpk16_fp6_f32 %0, %1, %2, 1.0" : "=&v"(p6) : "v"(lo16), "v"(hi16));
            LAS v2u* dst = (LAS v2u*)(ring + k * 768 + 24 * (lane & 31)); dst[0] = (v2u){p6[0], p6[1]}; dst[1] = (v2u){p6[2], p6[3]}; dst[2] = (v2u){p6[4], p6[5]}; }
        LDS_WAIT(); asm volatile("" ::: "memory");
        TokB X;
#pragma unroll
        for (int m = 0; m < 8; ++m) { const LAS v2u* xp = (const LAS v2u*)(ring + (lane & 7) * 768 + m * 96 + (lane >> 4) * 24);
            const v2u d0 = xp[0], d1 = xp[1], d2 = xp[2];
            X.b[m] = (v8i_t){(int)d0.x, (int)d0.y, (int)d1.x, (int)d1.y, (int)d2.x, (int)d2.y, 0, 0}; }
        LDS_WAIT(); asm volatile("" ::: "memory");
        for (int part = 0; part < 8; ++part) {
            int n = 0;
#pragma unroll
            for (int k = 0; k < 8; ++k) {
                { const bool sel = (id0[k] >> 11) == part; const unsigned long long m = __ballot(sel);
                  const int pos = n + (int)__builtin_amdgcn_mbcnt_hi((unsigned)(m >> 32), __builtin_amdgcn_mbcnt_lo((unsigned)m, 0u));
                  if (sel) list[pos] = ((unsigned)k << 21) | ((unsigned)lane << 14) | (unsigned)id0[k]; n += __builtin_popcountll(m); }
                { const bool sel = (id1[k] >> 11) == part; const unsigned long long m = __ballot(sel);
                  const int pos = n + (int)__builtin_amdgcn_mbcnt_hi((unsigned)(m >> 32), __builtin_amdgcn_mbcnt_lo((unsigned)m, 0u));
                  if (sel) list[pos] = ((unsigned)k << 21) | ((unsigned)(64 + lane) << 14) | (unsigned)id1[k]; n += __builtin_popcountll(m); }
                if (n > PA_CAP - 128) { pa_flush(n, X, lane, list, gl, ring, U6, wpk, tb, nwg); n = 0; }
            }
            pa_flush(n, X, lane, list, gl, ring, U6, wpk, tb, nwg);
        }
    }
}
__device__ __forceinline__ void final_token(int t, int lane, const unsigned short* Y16, float* X1, const float* fg) {
    GAS f32x4* xp = (GAS f32x4*)(X1 + (size_t)t * 1024 + 8 * lane);
    f32x4 x0 = xp[0], x1 = xp[1], x2 = xp[128], x3 = xp[129];
    const v4u ya = *(const GAS v4u*)(Y16 + (size_t)t * 1024 + 8 * lane), yb = *(const GAS v4u*)(Y16 + (size_t)t * 1024 + 512 + 8 * lane);
    const unsigned yw[8] = {ya.x, ya.y, ya.z, ya.w, yb.x, yb.y, yb.z, yb.w};
    float y[16];
#pragma unroll
    for (int i = 0; i < 8; ++i) { const unsigned w = yw[i]; const h2_t h = __builtin_bit_cast(h2_t, w); y[2 * i] = (float)h[0]; y[2 * i + 1] = (float)h[1]; }
    x0 += (f32x4){y[0], y[1], y[2], y[3]}; x1 += (f32x4){y[4], y[5], y[6], y[7]}; x2 += (f32x4){y[8], y[9], y[10], y[11]}; x3 += (f32x4){y[12], y[13], y[14], y[15]};
    float ss = (x0.x * x0.x + x0.y * x0.y) + (x0.z * x0.z + x0.w * x0.w) + (x1.x * x1.x + x1.y * x1.y) + (x1.z * x1.z + x1.w * x1.w)
             + (x2.x * x2.x + x2.y * x2.y) + (x2.z * x2.z + x2.w * x2.w) + (x3.x * x3.x + x3.y * x3.y) + (x3.z * x3.z + x3.w * x3.w);
    const float rstd2 = 1.0f / sqrtf(wave_sum(ss) * (1.f / DMODEL) + RMS_EPS);
    const GAS f32x4* gp = (const GAS f32x4*)(fg + 8 * lane);
    xp[0] = x0 * rstd2 * gp[0]; xp[1] = x1 * rstd2 * gp[1]; xp[128] = x2 * rstd2 * gp[128]; xp[129] = x3 * rstd2 * gp[129];
}
#ifndef REP_0
#define REP_0 1
#endif
#ifndef REP_1
#define REP_1 1
#endif
#ifndef REP_2
#define REP_2 1
#endif
#ifndef REP_3
#define REP_3 1
#endif
#ifndef REP_4
#define REP_4 1
#endif
#ifndef REP_5
#define REP_5 1
#endif
#ifndef REP_6
#define REP_6 1
#endif
#ifndef REP_7
#define REP_7 1
#endif
#ifndef REP_8
#define REP_8 1
#endif
#ifndef REP_9
#define REP_9 1
#endif
#ifndef REP_10
#define REP_10 1
#endif
#ifndef REP_11
#define REP_11 1
#endif
__device__ __forceinline__ void pb_rows(v4u* Ra, v2u* Rb, const v4u w, const unsigned char* vbase, size_t vboff) {
    const unsigned pw[4] = {w.x, w.y, w.z, w.w};
#pragma unroll
    for (int i = 0; i < 4; ++i) { const size_t e = pw[i] & 0xffffu; Ra[i] = *(const GAS v4u*)(vbase + e * 128); Rb[i] = *(const GAS v2u*)(vbase + vboff + e * 64); }
}
__device__ __forceinline__ void pb_fma(h2_t (&acc)[16], const v4u* Ra, const v2u* Rb, const v4u w) {
    const unsigned pw[4] = {w.x, w.y, w.z, w.w};
#pragma unroll
    for (int i = 0; i < 4; ++i) { const unsigned p = pw[i], wb = (p & 0xffff0000u) | (p >> 16); const h2_t w2 = __builtin_bit_cast(h2_t, wb);
        const v4u ra = Ra[i]; const v2u rb = Rb[i]; const v6u_t x6 = {ra.x, ra.y, ra.z, ra.w, rb.x, rb.y};
        v32h_t h; asm("v_cvt_scalef32_pk32_f16_fp6 %0, %1, 1.0" : "=&v"(h) : "v"(x6));
#pragma unroll
        for (int j = 0; j < 16; ++j) { const h2_t hv = {h[2 * j], h[2 * j + 1]}; acc[j] = __builtin_elementwise_fma(hv, w2, acc[j]); } }
}
__device__ __forceinline__ void peer_b_phase(int lane, int wave, int G, int vcu, const unsigned char* V6s, const unsigned* wpk, unsigned short* Y16, float* X1, const float* fg) {
    const int k = lane >> 3, q = lane & 7;
    for (int tile0 = vcu; tile0 < MTOK / 32; tile0 += 2 * G) {
        const int tile1 = tile0 + G; const bool has1 = tile1 < MTOK / 32;
        const int tb = tile0 * 32 + wave * 4, nwg = (has1 ? tile1 : tile0) * 32 + wave * 4;
        const int t = pa_tok((unsigned)k, tb, nwg);
        const unsigned* wrow = wpk + (size_t)t * 128;
        for (int sl = 0; sl < 4; ++sl) {
            const unsigned char* vbase = V6s + (size_t)sl * NEXP * 128 + q * 16;
            const size_t vboff = V6B_OFF + (size_t)sl * NEXP * 64 + q * 8 - ((size_t)sl * NEXP * 128 + q * 16);
            h2_t acc[16];
#pragma unroll
            for (int j = 0; j < 16; ++j) acc[j] = (h2_t){(_Float16)0.f, (_Float16)0.f};
            v4u W[6], Ra[16]; v2u Rb[16];
#pragma unroll
            for (int u = 0; u < 6; ++u) W[u] = *(const GAS v4u*)(wrow + 4 * u);
#pragma unroll
            for (int u = 0; u < 4; ++u) pb_rows(Ra + 4 * u, Rb + 4 * u, W[u], vbase, vboff);
#pragma unroll
            for (int u = 0; u < 32; ++u) {
                pb_fma(acc, Ra + 4 * (u & 3), Rb + 4 * (u & 3), W[u % 6]);
                if (u + 4 < 32) pb_rows(Ra + 4 * (u & 3), Rb + 4 * (u & 3), W[(u + 4) % 6], vbase, vboff);
                if (u + 6 < 32) W[u % 6] = *(const GAS v4u*)(wrow + 4 * (u + 6));
            }
            GAS v4u* yout = (GAS v4u*)(Y16 + (size_t)t * 1024 + sl * 256 + q * 32);
#pragma unroll
            for (int j = 0; j < 4; ++j) yout[j] = (v4u){__builtin_bit_cast(unsigned, acc[4 * j]), __builtin_bit_cast(unsigned, acc[4 * j + 1]), __builtin_bit_cast(unsigned, acc[4 * j + 2]), __builtin_bit_cast(unsigned, acc[4 * j + 3])};
        }
        asm volatile("s_waitcnt vmcnt(0)" ::: "memory");
        for (int kk = 0; kk < (has1 ? 8 : 4); ++kk) final_token(pa_tok((unsigned)kk, tb, nwg), lane, Y16, X1, fg);
    }
}
template <int NR> __device__ __forceinline__ void convert_expert_rows(const float* table, int ex, int stride, bool isv, int lane, unsigned char* U8, unsigned char* V8) {
    if (!isv) {
        typedef float v16f_t __attribute__((ext_vector_type(16)));
        f32x4 q[NR / 2][8];
#pragma unroll
        for (int k = 0; k < NR / 2; ++k) { const int e = ex + (2 * k + (lane >> 5)) * stride; const float* src = table + (size_t)(e < NEXP ? e : ex) * 1024 + 32 * (lane & 31);
#pragma unroll
            for (int j = 0; j < 8; ++j) q[k][j] = *(const GAS f32x4*)(src + 4 * j); }
#pragma unroll
        for (int k = 0; k < NR / 2; ++k) { const int e = ex + (2 * k + (lane >> 5)) * stride; if (e < NEXP) {
            float f[32];
#pragma unroll
            for (int j = 0; j < 8; ++j) { const f32x4 t = q[k][j] * U8_SCALE; f[4 * j] = t.x; f[4 * j + 1] = t.y; f[4 * j + 2] = t.z; f[4 * j + 3] = t.w; }
            const v16f_t lo16 = {f[0], f[1], f[2], f[3], f[4], f[5], f[6], f[7], f[8], f[9], f[10], f[11], f[12], f[13], f[14], f[15]},
                         hi16 = {f[16], f[17], f[18], f[19], f[20], f[21], f[22], f[23], f[24], f[25], f[26], f[27], f[28], f[29], f[30], f[31]};
            v6u_t p6; asm volatile("s_nop 1\n\tv_cvt_scalef32_2xpk16_fp6_f32 %0, %1, %2, 1.0" : "=&v"(p6) : "v"(lo16), "v"(hi16));
            GAS v2u* dst = (GAS v2u*)(U8 + (size_t)e * 768 + 24 * (lane & 31)); dst[0] = (v2u){p6[0], p6[1]}; dst[1] = (v2u){p6[2], p6[3]}; dst[2] = (v2u){p6[4], p6[5]}; } }
        return;
    }
    {
        f32x4 q[NR / 2][8];
#pragma unroll
        for (int k = 0; k < NR / 2; ++k) { const int e = ex + (2 * k + (lane >> 5)) * stride; const float* src = table + (size_t)(e < NEXP ? e : ex) * 1024 + 32 * (lane & 31);
#pragma unroll
            for (int j = 0; j < 8; ++j) q[k][j] = *(const GAS f32x4*)(src + 4 * j); }
#pragma unroll
        for (int k = 0; k < NR / 2; ++k) { const int e = ex + (2 * k + (lane >> 5)) * stride; if (e < NEXP) {
            v32h_t h;
#pragma unroll
            for (int j = 0; j < 8; ++j) { const f32x4 t = q[k][j] * V8_SCALE; h[4 * j] = (_Float16)t.x; h[4 * j + 1] = (_Float16)t.y; h[4 * j + 2] = (_Float16)t.z; h[4 * j + 3] = (_Float16)t.w; }
            v6u_t p6; asm volatile("s_nop 1\n\tv_cvt_scalef32_pk32_fp6_f16 %0, %1, 1.0" : "=&v"(p6) : "v"(h));
            const size_t ro = (size_t)((lane & 31) >> 3) * NEXP + e;
            *(GAS v4u*)(V8 + ro * 128 + (lane & 7) * 16) = (v4u){p6[0], p6[1], p6[2], p6[3]}; *(GAS v2u*)(V8 + V6B_OFF + ro * 64 + (lane & 7) * 8) = (v2u){p6[4], p6[5]}; } }
    }
}
struct OnePanel { int pm, n; __device__ __forceinline__ bool next(int i, pg8::Unit& u) const { if (i >= n) return false; u.pm = pm; u.pn = i; u.w = 0; return true; } };
struct DualOrder { pg8::StaticOrder S; __device__ __forceinline__ bool next(int i, pg8::Unit& u) const { if (!S.next(i >> 1, u)) return false; u.w = i & 1; return true; } };
struct Args { const float* in[24]; float* out; unsigned char* ws; int ph_lo, ph_hi, li, pad; };
__global__ void __launch_bounds__(NWAVES * 64, 2) mk_fwd(Args args) {
    extern __shared__ __attribute__((aligned(16))) unsigned char lds[];
    Frame F;
    F.lds = (LAS unsigned char*)lds;
    volatile LAS unsigned* MISC = (volatile LAS unsigned*)(F.lds + MISC_OFF);
    F.tid = threadIdx.x; F.lane = F.tid & 63; F.wave = __builtin_amdgcn_readfirstlane(F.tid >> 6);
    F.G = gridDim.x; { const int bx = blockIdx.x; F.vcu = (F.G % 8 == 0) ? (bx % 8) * (F.G / 8) + bx / 8 : bx; }
    unsigned char* ws = args.ws;
    gu32* ctl = (gu32*)(ws + WS_CTL);
    for (int u = F.tid; u < (LDS_BYTES - LDSCTL_OFF) / 4; u += NWAVES * 64) ((LAS unsigned*)(F.lds + LDSCTL_OFF))[u] = 0u;
    __syncthreads();
    XcdBarrier bar; bar.bar = (unsigned*)(ctl + CW_BAR); bar.x = 0; bar.st = nullptr;
    if (N_LAUNCHES != PER_PHASE) bar = xcd_barrier_post((unsigned*)(ctl + CW_BAR), MISC + 8);
#define GRID_BAR() do { if (N_LAUNCHES != PER_PHASE) xcd_barrier(bar); } while (0)
    const int lo = args.ph_lo, hi = args.ph_hi;
#ifndef PH_MASK
#define PH_MASK 0xFFFF
#endif
#define IN(k) ((((PH_MASK) >> (k)) & 1) && lo <= (k) && (k) < hi)
#define BOTH(k) (IN(k) && IN((k) + 1))
    const int gw = F.vcu * NWAVES + F.wave, NGW = F.G * NWAVES;
    const int gtid = F.vcu * (NWAVES * 64) + F.tid, NTHR = F.G * NWAVES * 64;
    const float* x = args.in[0];
    bf16* Win_t = (bf16*)(ws + WS_WIN); bf16* Wq_t = (bf16*)(ws + WS_WQ); bf16* Wout_t = (bf16*)(ws + WS_WOUT); bf16* Wus_t = (bf16*)(ws + WS_WUS); bf16* Wua_t = (bf16*)(ws + WS_WUA);
    bf16* Wglu_t = (bf16*)(ws + WS_WGLU); bf16* KSb = (bf16*)(ws + WS_KS); bf16* WE = (bf16*)(ws + WS_WE); bf16* BP = (bf16*)(ws + WS_BP); bf16* AP = (bf16*)(ws + WS_AP);
    float* Eb = (float*)(ws + WS_E); bf16* Hb = (bf16*)(ws + WS_H); bf16* Ypre = (bf16*)(ws + WS_YPRE); bf16* Ya = (bf16*)(ws + WS_YA); bf16* XG = (bf16*)(ws + WS_XG);
    bf16* Zb = (bf16*)(ws + WS_Z); bf16* Qb = (bf16*)(ws + WS_Z + 1 * ZSTRIDE_B); bf16* Kb = (bf16*)(ws + WS_Z + 2 * ZSTRIDE_B); bf16* Vb = (bf16*)(ws + WS_Z + 3 * ZSTRIDE_B);
    bf16* GA = (bf16*)(ws + WS_Z + 4 * ZSTRIDE_B); bf16* GB = (bf16*)(ws + WS_Z + 6 * ZSTRIDE_B);
    bf16* Yb = (bf16*)(ws + WS_YB); bf16* Mrg = (bf16*)(ws + WS_MRG); bf16* PQb = (bf16*)(ws + WS_PQ); int* ids = (int*)(ws + WS_IDS); float* gts = (float*)(ws + WS_GTS);
    unsigned char* U8 = ws + WS_U16; unsigned char* V8 = ws + WS_V16; unsigned* wpk = (unsigned*)(ws + WS_WPK); float* rstd1 = (float*)(ws + WS_RSTD1); unsigned short* Y16 = (unsigned short*)(ws + WS_Y16);
    float* biasT = (float*)(ws + WS_BIAS); float* pw32 = (float*)(ws + WS_PW32); float* kpart = (float*)(ws + WS_KPART); float* Kg = (float*)(ws + WS_KG); float* ssq1 = (float*)(ws + WS_SSQ1);

    if (IN(0)) for (int rep_ = 0; rep_ < REP_0; ++rep_) {
        LAS float* scr = (LAS float*)(F.lds + RING_OFF + F.wave * 16384);
        constexpr int I_IN = (1024 / 64) * (4096 / 32), I_GLU = (512 / 64) * (512 / 32), I_UP = (512 / 64) * (1024 / 32), I_OUT = (1024 / 64) * (1024 / 32), I_Q = (1024 / 64) * (2048 / 32);
        constexpr int NITEMS = I_IN + I_GLU + 2 * I_UP + I_OUT + I_Q;
        for (int it = gw; it < NITEMS; it += NGW) {
            int r = it;
            if (r < I_IN) { p0_transpose_item(args.in[2], 1024, 4096, Win_t, scr, r, F.lane); continue; } r -= I_IN;
            if (r < I_GLU) { p0_transpose_item(args.in[11], 512, 512, Wglu_t, scr, r, F.lane); continue; } r -= I_GLU;
            if (r < I_UP) { p0_transpose_item(args.in[13], 512, 1024, Wus_t, scr, r, F.lane); continue; } r -= I_UP;
            if (r < I_UP) { p0_transpose_item(args.in[14], 512, 1024, Wua_t, scr, r, F.lane); continue; } r -= I_UP;
            if (r < I_OUT) { p0_transpose_item(args.in[16], 1024, 1024, Wout_t, scr, r, F.lane); continue; } r -= I_OUT;
            p0_transpose_item(args.in[18], 1024, 2048, Wq_t, scr, r, F.lane);
        }
        for (int it = gw; it < NGRP * CH; it += NGW)
            ssm_table_task(it >> 5, it & 31, F.lane, scr, args.in[3], args.in[4], args.in[5], args.in[6], args.in[7], args.in[8], args.in[9], Kg, WE, BP, pw32);
        for (int m = gw; m < MTOK; m += NGW * 4) rms_rows4_to_bf16(x, args.in[1], Hb, m, NGW, F.lane);
        for (int it = gw; it < 64; it += NGW) { const float* src = (it < 32 ? args.in[19] : args.in[20]) + (size_t)(it & 31) * 512 + 8 * F.lane;
            const f32x4 a = *(const GAS f32x4*)src, b = *(const GAS f32x4*)(src + 4);
            *(GAS v4u*)(KSb + (size_t)it * 512 + 8 * F.lane) = (v4u){pk2(a.x, a.y), pk2(a.z, a.w), pk2(b.x, b.y), pk2(b.z, b.w)}; }
        if (gw == 0) { for (int i = F.lane; i < 8 * 128; i += 64) { const int h = i >> 7, rel = i & 127; int bk;
                if (rel < 16) bk = rel; else { const float lg = logf((float)rel / 16.0f) / 2.0794415416798357f * 16.0f; bk = 16 + (int)lg; bk = bk < 0 ? 0 : (bk > 31 ? 31 : bk); }
                biasT[i] = (args.in[15][bk * 8 + h] - args.in[15][31 * 8 + h]) * 1.4426950408889634f; } }
        if (BOTH(0)) GRID_BAR();
    }

    if (IN(1)) for (int rep_ = 0; rep_ < REP_1; ++rep_) {
        const float* Dsk = args.in[10];
        for (int i0 = gtid; i0 < NGRP * 512 * 64; i0 += NTHR * 4) {
            f32x4 ka[4], kb[4];
#pragma unroll
            for (int q = 0; q < 4; ++q) { const int i = i0 + q * NTHR; const int ic = (i < NGRP * 512 * 64) ? i : i0; const int g = ic >> 15, m = (ic >> 6) & 511, k8 = ic & 63, j = m >> 4, ho = m & 15, jp = k8 >> 1, hi0 = (k8 & 1) * 8;
                const int lag = (jp <= j) ? j - jp : 0; const float* kp = Kg + ((size_t)(g * 32 + lag) * 256 + ho * 16 + hi0); ka[q] = *(const GAS f32x4*)kp; kb[q] = *(const GAS f32x4*)(kp + 4); }
#pragma unroll
            for (int q = 0; q < 4; ++q) { const int i = i0 + q * NTHR; if (i >= NGRP * 512 * 64) break; const int g = i >> 15, m = (i >> 6) & 511, k8 = i & 63, j = m >> 4, ho = m & 15, jp = k8 >> 1, hi0 = (k8 & 1) * 8;
                v4u o = (v4u){0u, 0u, 0u, 0u};
                if (jp <= j) { f32x4 a = ka[q], b = kb[q];
                    if (jp == j && (ho >> 3) == (hi0 >> 3)) { const float dv = Dsk[g * 16 + ho]; const int e = ho & 7;
                        a.x += (e == 0) ? dv : 0.f; a.y += (e == 1) ? dv : 0.f; a.z += (e == 2) ? dv : 0.f; a.w += (e == 3) ? dv : 0.f;
                        b.x += (e == 4) ? dv : 0.f; b.y += (e == 5) ? dv : 0.f; b.z += (e == 6) ? dv : 0.f; b.w += (e == 7) ? dv : 0.f; }
                    o = (v4u){pk2(a.x, a.y), pk2(a.z, a.w), pk2(b.x, b.y), pk2(b.z, b.w)}; }
                *(GAS v4u*)(BP + ((size_t)(g * 512 + m) * APK + k8 * 8)) = o; } }
        pg8::Gemm g{Hb, Win_t, MTOK, INCOLS, 1024, 1024, 1024, 1 << 30, 0};
        pg8::StaticOrder S; S.init(MTOK, INCOLS, F.G, (int)blockIdx.x);
        pg8::EpiIn E{Zb, AP, kpart};
        pg8::gemm_phase<pg8::EpiIn, pg8::StaticOrder, true>(F.lds + RING_OFF, g, S, E);
        if (BOTH(1)) GRID_BAR();
    }

    if (IN(2)) for (int rep_ = 0; rep_ < REP_2; ++rep_) {
        const int bx = (int)blockIdx.x;
        const bool shared = F.G < 4;
        const int nS = shared ? F.G : (F.G >= 256 ? 64 : F.G / 4), nA = shared ? F.G : F.G - nS;
        const bool inS = shared || bx < nS, inA = shared || bx >= nS; const int aidx = shared ? bx : bx - nS;
        if (inS) {
#pragma unroll 1
            for (int pm = bx; pm < MTOK / 256; pm += nS) {
                { pg8::Gemm g1{AP, WE, MTOK, 256, 512, APK, 512, 2, (size_t)256 * 512}; OnePanel S1{pm, 1}; pg8::EpiE E1{Eb};
                  pg8::gemm_phase<pg8::EpiE, OnePanel, true>(F.lds + RING_OFF, g1, S1, E1); }
                VM_WAIT(); __syncthreads();
                if (F.tid < 256) { const int gb = (pm >> 1) * 8 + (pm & 1) * 4 + (F.tid >> 6), g_ = gb >> 3, p = F.tid & 63; const size_t row0 = (size_t)gb * 64;
                    const float mr = pw32[g_ * 128 + p], mi = pw32[g_ * 128 + 64 + p]; float sr = 0.f, si = 0.f;
#pragma unroll 1
                    for (int c0 = 0; c0 < NCHUNK; c0 += 32) { float er[32], ei[32];
#pragma unroll
                        for (int c = 0; c < 32; ++c) { er[c] = Eb[(row0 + c0 + c) * 128 + p]; ei[c] = Eb[(row0 + c0 + c) * 128 + 64 + p]; }
#pragma unroll
                        for (int c = 0; c < 32; ++c) { bf16* ap = AP + (row0 + c0 + c) * APK + 512; ap[p] = (bf16)f2bf(sr); ap[64 + p] = (bf16)f2bf(si);
                            const float nr = mr * sr - mi * si + er[c], ni = mr * si + mi * sr + ei[c]; sr = nr; si = ni; } } }
                VM_WAIT(); __syncthreads();
                { pg8::Gemm g{AP, BP, MTOK, 512, APK, APK, APK, 2, (size_t)512 * APK}; OnePanel S3{pm, 2}; pg8::EpiY E{Ypre};
                  pg8::gemm_phase<pg8::EpiY, OnePanel, true>(F.lds + RING_OFF, g, S3, E); }
            }
        }
        if (inA) {
            static_assert(attn_body::ATTN_LDS_BYTES <= RING_BYTES, "attention LDS");
#pragma unroll 1
            for (int a = aidx; a < 192; a += nA) { const int ty = a >> 6, bh = a & 63;
#pragma unroll 1
                for (int i = 0; i < 4; ++i) { const int qb = (ty == 0) ? (i == 0 ? 7 : (i == 1 ? 2 : (i == 2 ? 0 : -1))) : (ty == 1) ? (i == 0 ? 6 : (i == 1 ? 4 : -1)) : (i == 0 ? 5 : (i == 1 ? 3 : (i == 2 ? 1 : -1)));
                    if (qb < 0) break;
                    attn_body::attn_unit<8>(bh >> 3, bh & 7, qb, (const attn_body::bf16*)Qb, (const attn_body::bf16*)Kb, (const attn_body::bf16*)Vb, (attn_body::bf16*)Yb, (char*)lds + RING_OFF, kpart, biasT); } }
        }
        if (BOTH(2)) GRID_BAR();
    }

    if (IN(3)) for (int rep_ = 0; rep_ < REP_3; ++rep_) {
        pg8::Gemm g{Ypre, Wglu_t, MTOK, 512, 512, 512, 512, 1 << 30, 0};
        pg8::StaticOrder S; S.init(MTOK, 512, F.G, (int)blockIdx.x);
        pg8::EpiGlu E{Ypre, Ya, args.in[12]};
        pg8::gemm_phase<pg8::EpiGlu, pg8::StaticOrder, true>(F.lds + RING_OFF, g, S, E);
        { const int nun = (MTOK / 256) * (512 / 256);
          const int nconv = (F.G > nun) ? F.G - nun : F.G, cidx = (F.G > nun) ? (int)blockIdx.x - nun : (int)blockIdx.x;
          if (cidx >= 0) for (int ex = cidx * NWAVES + F.wave; ex < 2 * NEXP; ex += nconv * NWAVES * 4) { const bool isv = ex >= NEXP; convert_expert_rows<4>(isv ? args.in[22] : args.in[21], isv ? ex - NEXP : ex, nconv * NWAVES, isv, F.lane, U8, V8); } }
        if (BOTH(3)) GRID_BAR();
    }

    if (IN(4)) for (int rep_ = 0; rep_ < REP_4; ++rep_) {
        pg8::Gemm g{Ya, Wus_t, MTOK, 1024, 512, 512, 512, 1 << 30, 0, Yb, Wua_t};
        DualOrder S; S.S.init(MTOK, 1024, F.G, (int)blockIdx.x);
        pg8::EpiMrgDual E{pg8::EpiMrg<0>{GA, Mrg}, pg8::EpiMrg<1>{GB, Mrg}};
        pg8::gemm_phase<pg8::EpiMrgDual, DualOrder, true>(F.lds + RING_OFF, g, S, E);
        if (BOTH(4)) GRID_BAR();
    }

    if (IN(5)) for (int rep_ = 0; rep_ < REP_5; ++rep_) {
        pg8::Gemm g{Mrg, Wout_t, MTOK, 1024, 1024, 1024, 1024, 1 << 30, 0}; pg8::StaticOrder S; S.init(MTOK, 1024, F.G, (int)blockIdx.x);
        pg8::EpiX1 E{x, args.out, XG, args.in[17], ssq1};
        pg8::gemm_phase<pg8::EpiX1, pg8::StaticOrder, true>(F.lds + RING_OFF, g, S, E);
        if (BOTH(5)) GRID_BAR();
    }

    if (IN(6)) for (int rep_ = 0; rep_ < REP_6; ++rep_) {
        pg8::Gemm g{XG, Wq_t, MTOK, PQ, 1024, 1024, 1024, 1 << 30, 0}; pg8::StaticOrder S; S.init(MTOK, PQ, F.G, (int)blockIdx.x);
        pg8::EpiPlain E{PQb, PQ};
        pg8::gemm_phase<pg8::EpiPlain, pg8::StaticOrder, true>(F.lds + RING_OFF, g, S, E);
        if (BOTH(6)) GRID_BAR();
    }

    if (IN(7)) for (int rep_ = 0; rep_ < REP_7; ++rep_) {
        LAS unsigned char* scr = F.lds + RING_OFF + F.wave * 2048;
        LAS unsigned char* ksl = F.lds + RING_OFF + 16384;
        for (int c = F.tid; c < 256 * 16; c += NWAVES * 64) { const int row = c >> 4, ch = c & 15; *(LAS v4u*)(ksl + row * 256 + ((ch ^ (row & 15)) << 4)) = *(const GAS v4u*)(KSb + row * 128 + ch * 8); }
        __syncthreads();
        for (int it = gw; it < (MTOK / 32) * 8; it += NGW) topk_task(it >> 3, it & 7, F.lane, scr, PQb, ksl, ssq1, ids, gts, rstd1);
        if (BOTH(7)) { VM_WAIT(); __syncthreads(); }
    }

    if (IN(8)) for (int rep_ = 0; rep_ < REP_8; ++rep_) {
        peer_a_phase(F.lane, F.wave, F.G, F.vcu, XG, U8, ids, gts, rstd1, wpk, F.lds, 0xffff);
        if (BOTH(8)) { VM_WAIT(); __syncthreads(); }
    }
    if (IN(9)) for (int rep_ = 0; rep_ < REP_9; ++rep_) {
        peer_b_phase(F.lane, F.wave, F.G, F.vcu, V8, wpk, Y16, args.out, args.in[23]);
    }
#undef IN
#undef BOTH
#undef GRID_BAR
}

extern "C" void kernel_launch(void* const* d_in, const int* in_sizes, int n_in, void* d_out, int out_size, void* d_ws, size_t ws_size, hipStream_t stream) {
    static int grid = 0;
    if (grid == 0) {
        if (n_in != 24 || in_sizes[0] != MTOK * DMODEL || out_size != MTOK * DMODEL || ws_size < WS_END) { fprintf(stderr, "kernel_launch: unexpected shapes (n_in %d, in0 %d, out %d, ws %zu); nothing launched\n", n_in, n_in > 0 ? in_sizes[0] : -1, out_size, ws_size); grid = -1; return; }
        int dev = 0, cus = 0, per_cu = 0;
        if (hipGetDevice(&dev) != hipSuccess || hipDeviceGetAttribute(&cus, hipDeviceAttributeMultiprocessorCount, dev) != hipSuccess) { grid = -1; return; }
        if (hipFuncSetAttribute((const void*)mk_fwd, hipFuncAttributeMaxDynamicSharedMemorySize, LDS_BYTES) != hipSuccess) { fprintf(stderr, "kernel_launch: hipFuncSetAttribute failed\n"); grid = -1; return; }
        if (hipOccupancyMaxActiveBlocksPerMultiprocessor(&per_cu, (const void*)mk_fwd, NWAVES * 64, LDS_BYTES) != hipSuccess || per_cu < 1) { fprintf(stderr, "kernel_launch: occupancy query says %d blocks per CU\n", per_cu); }
        (void)hipGetLastError();
        grid = cus;
    }
    if (grid < 0) return;
    if (N_LAUNCHES != PER_PHASE) { if (hipMemsetAsync((char*)d_ws + WS_CTL, 0, CTL_ZERO_BYTES, stream) != hipSuccess) return; }
    Args a{};
    for (int i = 0; i < 24; ++i) a.in[i] = (const float*)d_in[i];
    a.out = (float*)d_out; a.ws = (unsigned char*)d_ws; a.pad = 0;
    if (N_LAUNCHES == PER_PHASE) {
        for (int li = 0; li < PER_PHASE; ++li) { a.ph_lo = li; a.ph_hi = li + 1; a.li = li; hipLaunchKernelGGL(mk_fwd, dim3(grid), dim3(NWAVES * 64), LDS_BYTES, stream, a); }
    } else {
        a.ph_lo = 0; a.ph_hi = PER_PHASE; a.li = 0;
        hipLaunchKernelGGL(mk_fwd, dim3(grid), dim3(NWAVES * 64), LDS_BYTES, stream, a);
    }
}
```

```cpp
#include <hip/hip_runtime.h>
#include <hip/hip_bf16.h>
#include <cstdio>
#include <cstdint>
#include <cmath>

#ifndef MK_N_LAUNCHES
#define MK_N_LAUNCHES 1
#endif

namespace pg8 {
#define PG8_LAS __attribute__((address_space(3)))
typedef unsigned short bf16_t;
typedef short bf16x8 __attribute__((ext_vector_type(8)));
typedef float f32x4 __attribute__((ext_vector_type(4)));
typedef unsigned u32x4 __attribute__((ext_vector_type(4)));
constexpr int BM = 256, BK = 64, HALF = 128, HTB = HALF * BK * 2, STAGE_BYTES = 8 * HTB, NXCD = 8, WGM = 8;

__host__ __device__ __forceinline__ int lds_byte(int r, int c) { const int st = (r >> 4) * 2 + (c >> 5), rr = r & 15, cc = c & 31, ob = rr * 64 + cc * 2; return st * 1024 + (ob ^ (((ob >> 9) & 1) << 5)); }
__host__ __device__ __forceinline__ void stage_rc(int b, int& R, int& C) { const int st = b / 1024, sb = b % 1024, swz = sb ^ (((sb >> 9) & 1) << 5); R = (st >> 1) * 16 + swz / 64; C = (st & 1) * 32 + (swz % 64) / 2; }
__host__ __device__ __forceinline__ int perm32(int rho) { const int n = rho >> 4, i = rho & 15; return 8 * (i >> 2) + 4 * n + (i & 3); }

struct Unit { int pm, pn, w; };
struct Gemm { const bf16_t* A; const bf16_t* Bt; int M, N, K, lda, ldb, rpg; size_t bgs; const bf16_t* A2 = nullptr; const bf16_t* Bt2 = nullptr; };

struct StaticOrder {
    int nM, nN, nwg, G, c;
    __host__ __device__ __forceinline__ void init(int M, int N, int G_, int c_) { nM = M / BM; nN = N / BM; nwg = nM * nN; G = G_; c = c_; }
    __host__ __device__ __forceinline__ bool next(int i, Unit& u) const {
        const long L = (long)i * G + c; if (L >= nwg) return false;
        int wgid = (int)L; { const int q = nwg / NXCD, r = nwg % NXCD, xcd = wgid % NXCD, off = wgid / NXCD; wgid = (xcd < r ? xcd * (q + 1) : r * (q + 1) + (xcd - r) * q) + off; }
        const int nig = WGM * nN, gid = wgid / nig, fm = gid * WGM, gsz = (nM - fm) < WGM ? (nM - fm) : WGM;
        u.pm = fm + ((wgid % nig) % gsz); u.pn = (wgid % nig) / gsz; u.w = 0; return true;
    }
};

__device__ __forceinline__ unsigned cvt_pk_bf16(float lo, float hi) { unsigned r; asm volatile("v_cvt_pk_bf16_f32 %0, %1, %2" : "=v"(r) : "v"(lo), "v"(hi)); return r; }
__device__ __forceinline__ float bf_lo(unsigned w) { return __uint_as_float(w << 16); }
__device__ __forceinline__ float bf_hi(unsigned w) { return __uint_as_float(w & 0xffff0000u); }
__device__ __forceinline__ float sigmoid_f(float x) { return __builtin_amdgcn_rcpf(1.0f + __builtin_amdgcn_exp2f(-1.4426950409f * x)); }
__device__ __forceinline__ float gelu_tanh(float x) { const float u = x + 0.044715f * x * x * x; return x * __builtin_amdgcn_rcpf(1.0f + __builtin_amdgcn_exp2f(-2.3022081985f * u)); }

template <class Epi, class Sched, bool ALIGN_EPI>
__device__ __forceinline__ void gemm_phase(PG8_LAS unsigned char* lds, const Gemm g, const Sched& S, const Epi& E) {
    int tid = threadIdx.x; asm volatile("" : "+v"(tid));
    const int wid = __builtin_amdgcn_readfirstlane(tid >> 6), lane = tid & 63, wr = wid >> 2, wc = wid & 3, fr = lane & 15, fq = lane >> 4;
    const int K = g.K, nt = K / BK;
    unsigned voffA[2], voffB[2];
#pragma unroll
    for (int i = 0; i < 2; ++i) { int R, C; stage_rc(tid * 16 + i * 8192, R, C); const int Rb = Epi::PERM ? ((R & ~31) + perm32(R & 31)) : R;
        voffA[i] = (unsigned)(R * g.lda + C) * 2u; voffB[i] = (unsigned)(Rb * g.ldb + C) * 2u; }
    const size_t kstep = (size_t)(BK * 2);
    const size_t hstepA = (size_t)HALF * g.lda * 2, hstepB = (size_t)HALF * g.ldb * 2;
    const size_t tstepA = 2 * hstepA, tstepB = 2 * hstepB;
    const unsigned ldsw = (unsigned)wid * 1024u;
    const int aoff = lds_byte(wr * 64 + fr, fq * 8), boff = lds_byte(wc * 32 + fr, fq * 8);
#define PG8_SA(b, h) (((b) * 2 + (h)) * HTB)
#define PG8_SB(b, h) ((4 + (b) * 2 + (h)) * HTB)
#define PG8_STAGE(bufoff, gbase, voff) do { _Pragma("unroll") for (int _i = 0; _i < 2; ++_i) \
        __builtin_amdgcn_global_load_lds((const unsigned*)((const char*)(gbase) + (voff)[_i]), (PG8_LAS unsigned*)(lds + (bufoff) + ldsw + _i * 8192), 16, 0, 0); } while (0)
#define PG8_LDA(dst, b, h) do { _Pragma("unroll") for (int m = 0; m < 4; ++m) _Pragma("unroll") for (int k = 0; k < 2; ++k) dst[m][k] = *(const PG8_LAS bf16x8*)(lds + PG8_SA(b, h) + aoff + m * 2048 + k * 1024); } while (0)
#define PG8_LDB(dst, b, h) do { _Pragma("unroll") for (int n = 0; n < 2; ++n) _Pragma("unroll") for (int k = 0; k < 2; ++k) dst[n][k] = *(const PG8_LAS bf16x8*)(lds + PG8_SB(b, h) + boff + n * 2048 + k * 1024); } while (0)
#define PG8_MMA(ai, bj, At, Bt) do { __builtin_amdgcn_s_setprio(1); _Pragma("unroll") for (int m = 0; m < 4; ++m) _Pragma("unroll") for (int n = 0; n < 2; ++n) _Pragma("unroll") for (int k = 0; k < 2; ++k) \
        acc[ai][bj][m][n] = __builtin_amdgcn_mfma_f32_16x16x32_bf16(Bt[n][k], At[m][k], acc[ai][bj][m][n], 0, 0, 0); __builtin_amdgcn_s_setprio(0); } while (0)
#define PG8_WAIT_V(n) asm volatile("s_waitcnt vmcnt(" #n ")" ::: "memory")
#define PG8_WAIT_L(n) asm volatile("s_waitcnt lgkmcnt(" #n ")" ::: "memory")
#define PG8_BAR __builtin_amdgcn_s_barrier()
#define PG8_SCHED __builtin_amdgcn_sched_barrier(0)
    Unit cur, nxt; int ui = 0;
    if (!S.next(0, cur)) return;
    f32x4 acc[2][2][4][2];
#pragma unroll
    for (int a = 0; a < 2; ++a)
#pragma unroll
        for (int b = 0; b < 2; ++b)
#pragma unroll
            for (int m = 0; m < 4; ++m)
#pragma unroll
                for (int n = 0; n < 2; ++n) acc[a][b][m][n] = (f32x4){0.f, 0.f, 0.f, 0.f};
    bf16x8 At[4][2], B0[2][2], B1[2][2];
    const char* cA = (const char*)(cur.w ? g.A2 : g.A) + (size_t)cur.pm * tstepA;
    const char* cB = (const char*)(cur.w ? g.Bt2 : g.Bt) + (size_t)(cur.pm / g.rpg) * g.bgs * 2 + (size_t)cur.pn * tstepB;
    PG8_STAGE(PG8_SB(0, 0), cB, voffB); PG8_STAGE(PG8_SB(0, 1), cB + hstepB, voffB); PG8_STAGE(PG8_SA(0, 0), cA, voffA); PG8_STAGE(PG8_SA(0, 1), cA + hstepA, voffA);
    if (wr == 1) PG8_BAR;
    PG8_WAIT_V(2); PG8_BAR;
    PG8_STAGE(PG8_SB(1, 0), cB + kstep, voffB); PG8_STAGE(PG8_SA(1, 0), cA + kstep, voffA); PG8_STAGE(PG8_SB(1, 1), cB + hstepB + kstep, voffB);
    PG8_WAIT_V(6); PG8_BAR;
    for (;;) {
        const bool has_next = S.next(ui + 1, nxt);
        const char* nA = has_next ? (const char*)(nxt.w ? g.A2 : g.A) + (size_t)nxt.pm * tstepA : cA;
        const char* nB = has_next ? (const char*)(nxt.w ? g.Bt2 : g.Bt) + (size_t)(nxt.pm / g.rpg) * g.bgs * 2 + (size_t)nxt.pn * tstepB : cB;
        for (int t = 0; t < nt; t += 2) {
            const bool last = (t == nt - 2);
            const char* a1 = cA + (size_t)(t + 1) * kstep;
            const char* a2 = last ? nA : cA + (size_t)(t + 2) * kstep; const char* b2 = last ? nB : cB + (size_t)(t + 2) * kstep;
            const char* a3 = a2 + kstep; const char* b3 = b2 + kstep;
            PG8_LDB(B0, 0, 0); PG8_LDB(B1, 0, 1); PG8_SCHED; PG8_LDA(At, 0, 0); PG8_STAGE(PG8_SA(1, 1), a1 + hstepA, voffA);
            PG8_WAIT_V(8); PG8_WAIT_L(0); PG8_BAR; PG8_MMA(0, 0, At, B0); PG8_MMA(0, 1, At, B1); PG8_BAR; PG8_SCHED;
            PG8_LDA(At, 0, 1); PG8_STAGE(PG8_SB(0, 0), b2, voffB); PG8_STAGE(PG8_SB(0, 1), b2 + hstepB, voffB); PG8_STAGE(PG8_SA(0, 0), a2, voffA);
            PG8_WAIT_V(8); PG8_WAIT_L(0); PG8_BAR; PG8_MMA(1, 0, At, B0); PG8_MMA(1, 1, At, B1); PG8_BAR; PG8_SCHED;
            PG8_LDB(B0, 1, 0); PG8_LDB(B1, 1, 1); PG8_SCHED; PG8_LDA(At, 1, 0); PG8_STAGE(PG8_SA(0, 1), a2 + hstepA, voffA);
            PG8_WAIT_V(8); PG8_WAIT_L(0); PG8_BAR; PG8_MMA(0, 0, At, B0); PG8_MMA(0, 1, At, B1); PG8_BAR; PG8_SCHED;
            PG8_LDA(At, 1, 1); PG8_STAGE(PG8_SB(1, 0), b3, voffB); PG8_STAGE(PG8_SB(1, 1), b3 + hstepB, voffB); PG8_STAGE(PG8_SA(1, 0), a3, voffA);
            PG8_WAIT_V(8); PG8_WAIT_L(0); PG8_BAR; PG8_MMA(1, 0, At, B0); PG8_MMA(1, 1, At, B1); PG8_BAR; PG8_SCHED;
        }
        if constexpr (ALIGN_EPI) { if (wr == 0) PG8_BAR; }
        E(acc, cur, wr, wc, fr, fq);
        if (!has_next) break;
#pragma unroll
        for (int a = 0; a < 2; ++a)
#pragma unroll
            for (int b = 0; b < 2; ++b)
#pragma unroll
                for (int m = 0; m < 4; ++m)
#pragma unroll
                    for (int n = 0; n < 2; ++n) acc[a][b][m][n] = (f32x4){0.f, 0.f, 0.f, 0.f};
        cur = nxt; cA = nA; cB = nB; ++ui;
        if constexpr (ALIGN_EPI) { if (wr == 1) PG8_BAR; }
    }
    PG8_WAIT_V(0);
    if constexpr (!ALIGN_EPI) { if (wr == 0) PG8_BAR; }
    PG8_BAR;
#undef PG8_SA
#undef PG8_SB
#undef PG8_STAGE
#undef PG8_LDA
#undef PG8_LDB
#undef PG8_MMA
#undef PG8_WAIT_V
#undef PG8_WAIT_L
#undef PG8_BAR
#undef PG8_SCHED
}
}
namespace attn_body {
using bf16=__hip_bfloat16;
using bf16x8=__attribute__((ext_vector_type(8)))short;
using s16x4=__attribute__((ext_vector_type(4)))short;
using f32x16=__attribute__((ext_vector_type(16)))float;
using f32x4v=__attribute__((ext_vector_type(4)))float;
using u32x4=__attribute__((ext_vector_type(4)))unsigned;
constexpr int BATCH=8,NHEAD=8,SEQ=2048,D=64,DM=NHEAD*D;
constexpr int NW=8,QBLK=32,QB=QBLK*NW,KVBLK=64,NQB=SEQ/QB;
__device__ __forceinline__ int crow(int r,int hi){return (r&3)+8*(r>>2)+4*hi;}
#define SBAR() __builtin_amdgcn_sched_barrier(0)
__device__ __forceinline__ void cmask(f32x16&p0,f32x16&p1,int jb,int qrel,int hi){
  const float NEG=-INFINITY; int kb=64*jb+4*hi;
  #pragma unroll
  for(int r=0;r<16;++r){int kv=kb+(r&3)+8*(r>>2); if(kv>qrel)p0[r]=NEG; if(kv+32>qrel)p1[r]=NEG;}
}
typedef __attribute__((address_space(3))) const float* lds_cfptr;
__device__ __forceinline__ void biasadd(f32x16&p0,f32x16&p1,int jb,int qrel,int hi,lds_cfptr bt){
  const int base=qrel-64*jb-4*hi;
  #pragma unroll
  for(int r4=0;r4<16;r4+=4){
    #pragma unroll
    for(int r=r4;r<r4+4;++r){int rel=base-((r&3)+8*(r>>2)); int i0=min(max(rel,0),127), i1=min(max(rel-32,0),127); p0[r]+=bt[i0]; p1[r]+=bt[i1];}
    asm volatile("s_waitcnt lgkmcnt(0)":"+v"(p0),"+v"(p1)::"memory"); }
}

constexpr int NSLOT=3, SLOTB=8192;
constexpr int LDS_K=0, LDS_V=NSLOT*SLOTB, LDS_WS=2*NSLOT*SLOTB, LDS_OST=LDS_WS+NW*64*4, LDS_KM=LDS_OST+NW*4096, LDS_BT=LDS_KM+7*64*4, LDS_BYTES=LDS_BT+128*4;
constexpr float C2=0.125f*1.4426950408889634f;
__device__ __forceinline__ void glds16(const void*gsrc,unsigned lds_dst){unsigned keep;
  asm volatile("s_mov_b32 %0, m0\n\ts_mov_b32 m0, %2\n\ts_nop 0\n\tglobal_load_lds_dwordx4 %1, off\n\ts_mov_b32 m0, %0":"=&s"(keep):"v"(gsrc),"s"(lds_dst):"memory");}
__device__ __forceinline__ float max3f(float a,float b,float c){float r;asm("v_max3_f32 %0, %1, %2, %3":"=v"(r):"v"(a),"v"(b),"v"(c));return r;}
__device__ __forceinline__ float max2f(float a,float b){float r;asm("v_max_f32_e32 %0, %1, %2":"=v"(r):"v"(a),"v"(b));return r;}
__device__ __forceinline__ float fadd_s(float a,float b){float r;asm("v_add_f32_e32 %0, %1, %2":"=v"(r):"v"(a),"v"(b));return r;}
__device__ __forceinline__ float fsub_s(float a,float b){float r;asm("v_sub_f32_e32 %0, %1, %2":"=v"(r):"v"(a),"v"(b));return r;}
typedef float f32x2_t __attribute__((ext_vector_type(2))); typedef __bf16 bf16x2_t __attribute__((ext_vector_type(2)));
__device__ __forceinline__ unsigned cvtpk_s(float lo,float hi){f32x2_t v={lo,hi};bf16x2_t b=__builtin_convertvector(v,bf16x2_t);return __builtin_bit_cast(unsigned,b);}
#define WAIT_BAR(N) asm volatile("s_waitcnt vmcnt(" #N ") lgkmcnt(0)\n\ts_barrier":::"memory")

__device__ __forceinline__ void qkt(f32x16&p0,f32x16&p1,const char*Kslot,const bf16x8*qr,int r32,int hi){
  const char*kb=Kslot+hi*1024+r32*16;
  #pragma unroll
  for(int d0=0;d0<4;++d0){
    const bf16x8 b0=*reinterpret_cast<const bf16x8*>(kb+d0*2048);
    const bf16x8 b1=*reinterpret_cast<const bf16x8*>(kb+d0*2048+512);
    if(d0==0){p0=__builtin_amdgcn_mfma_f32_32x32x16_bf16(b0,qr[0],(f32x16){},0,0,0);p1=__builtin_amdgcn_mfma_f32_32x32x16_bf16(b1,qr[0],(f32x16){},0,0,0);}
    else{p0=__builtin_amdgcn_mfma_f32_32x32x16_bf16(b0,qr[d0],p0,0,0,0);p1=__builtin_amdgcn_mfma_f32_32x32x16_bf16(b1,qr[d0],p1,0,0,0);}}
}
typedef __attribute__((address_space(3))) const char* lds_cptr;
typedef short v4i16_t __attribute__((ext_vector_type(4)));
__device__ __forceinline__ void kload8(bf16x8*kf,lds_cptr kp){
  kf[0]=*(const __attribute__((address_space(3))) bf16x8*)(kp);      kf[1]=*(const __attribute__((address_space(3))) bf16x8*)(kp+512);
  kf[2]=*(const __attribute__((address_space(3))) bf16x8*)(kp+2048); kf[3]=*(const __attribute__((address_space(3))) bf16x8*)(kp+2560);
  kf[4]=*(const __attribute__((address_space(3))) bf16x8*)(kp+4096); kf[5]=*(const __attribute__((address_space(3))) bf16x8*)(kp+4608);
  kf[6]=*(const __attribute__((address_space(3))) bf16x8*)(kp+6144); kf[7]=*(const __attribute__((address_space(3))) bf16x8*)(kp+6656);
}
__device__ __forceinline__ void kload2(bf16x8*kf,lds_cptr kp,int j){ kf[2*j]=*(const __attribute__((address_space(3))) bf16x8*)(kp+j*2048); kf[2*j+1]=*(const __attribute__((address_space(3))) bf16x8*)(kp+j*2048+512); }
__device__ __forceinline__ s16x4 vtr(lds_cptr p){ return __builtin_bit_cast(s16x4,__builtin_amdgcn_ds_read_tr16_b64_v4i16((__attribute__((address_space(3))) v4i16_t*)p)); }
__device__ __forceinline__ float rowmax(const f32x16&p0,const f32x16&p1){
  float a=max3f(p0[0],p0[1],p1[0]),b=max3f(p0[2],p0[3],p1[1]);a=max3f(a,p1[2],p1[3]);
  #pragma unroll
  for(int r=4;r<16;r+=4){a=max3f(a,p0[r],p0[r+1]);b=max3f(b,p0[r+2],p0[r+3]);a=max3f(a,p1[r],p1[r+1]);b=max3f(b,p1[r+2],p1[r+3]);}
  const float m=max2f(a,b);
  auto rr=__builtin_amdgcn_permlane32_swap(__float_as_uint(m),__float_as_uint(m),false,false);
  return max2f(__uint_as_float(rr[0]),__uint_as_float(rr[1]));
}
__device__ __forceinline__ void pv(f32x16*o,int vb,bf16x8 pa0,bf16x8 pa1,bf16x8 pa2,bf16x8 pa3){
  #pragma unroll
  for(int d0=0;d0<2;++d0){s16x4 lo[4],hi[4];
    #pragma unroll
    for(int ks=0;ks<4;++ks){
      asm volatile("ds_read_b64_tr_b16 %0,%1 offset:%c2":"=&v"(lo[ks]):"v"(vb),"i"(d0*4096+ks*1024):"memory");
      asm volatile("ds_read_b64_tr_b16 %0,%1 offset:%c2":"=&v"(hi[ks]):"v"(vb),"i"(d0*4096+ks*1024+512):"memory");}
    asm volatile("s_waitcnt lgkmcnt(0)":::"memory");SBAR();
    #define PK(k) (bf16x8){lo[k][0],lo[k][1],lo[k][2],lo[k][3],hi[k][0],hi[k][1],hi[k][2],hi[k][3]}
    o[d0]=__builtin_amdgcn_mfma_f32_32x32x16_bf16(pa0,PK(0),o[d0],0,0,0);
    o[d0]=__builtin_amdgcn_mfma_f32_32x32x16_bf16(pa1,PK(1),o[d0],0,0,0);
    o[d0]=__builtin_amdgcn_mfma_f32_32x32x16_bf16(pa2,PK(2),o[d0],0,0,0);
    o[d0]=__builtin_amdgcn_mfma_f32_32x32x16_bf16(pa3,PK(3),o[d0],0,0,0);
    #undef PK
  }
}

#ifndef ATTN_STORE16
#define ATTN_STORE16(p,v) (*(u32x4*)(p)=(v))
#endif
template<int THRL> __device__ __forceinline__ void attn_unit(int b,int h,int qb,const bf16*Q,const bf16*__restrict__ K,const bf16*__restrict__ V,bf16*O,char*shm,const float*kpart,const float*btab){
  int tid=threadIdx.x; asm volatile("":"+v"(tid));
  const int lane=tid&63,r32=lane&31,hi=lane>>5; const int wid=__builtin_amdgcn_readfirstlane(tid>>6);
  const long rowbase=(long)b*SEQ; const int q0=qb*QB;
  const bf16*Qw=Q+(rowbase+q0+wid*QBLK)*DM+h*D;
  const bf16*Kh=K+rowbase*DM+h*D,*Vh=V+rowbase*DM+h*D;
  const unsigned lds0=(unsigned)(uintptr_t)shm;
  float*wsf=(float*)(shm+LDS_WS)+wid*64;
  const bf16*ksrc=Kh+(long)lane*DM+wid*8;
  const bf16*vsrc=Vh+(long)(16*(wid&3)+(lane>>2))*DM+(wid>>2)*32+(lane&3)*8;
  const unsigned kdst=lds0+LDS_K+wid*1024, vdst=lds0+LDS_V+wid*1024;
  #define DMA_K(t,slot) glds16(ksrc+(long)(t)*KVBLK*DM,(unsigned)__builtin_amdgcn_readfirstlane(kdst+(slot)))
  #define DMA_V(t,slot) glds16(vsrc+(long)(t)*KVBLK*DM,(unsigned)__builtin_amdgcn_readfirstlane(vdst+(slot)))
  const int vb0=(int)(lds0+LDS_V)+((lane>>4)&1)*32+(lane&3)*8+(4*hi+((lane&15)>>2))*64;
  const char*Kbase=shm+LDS_K; bf16x8 kf[8];
  const lds_cptr shm3=(lds_cptr)shm; const lds_cptr kp0=shm3+LDS_K+hi*1024+r32*16; const lds_cptr vp0=shm3+LDS_V+((lane>>4)&1)*32+(lane&3)*8+(4*hi+((lane&15)>>2))*64;
  const lds_cfptr btl=(lds_cfptr)(shm3+LDS_BT);
  const int NT=(q0+QB)/KVBLK;
  DMA_K(0,0);DMA_V(0,0);DMA_K(1,SLOTB);
  bf16x8 qr[4];
  #pragma unroll
  for(int d0=0;d0<4;++d0)qr[d0]=*reinterpret_cast<const bf16x8*>(&Qw[(long)r32*DM+d0*16+hi*8]);
  { float*km=(float*)(shm+LDS_KM); float*bt=(float*)(shm+LDS_BT); int tq=tid; asm volatile("":"+v"(tq));
    if(tq<448){const int j=tq>>6,d=tq&63; float v=0.f; if(j<qb&&qb>3){const float*kp=kpart+((size_t)((b*NQB+j)*2)*512)+h*D+d; v=(kp[0]+kp[512])*(1.0f/256.0f);} km[tq]=v;}
    else if(tq<448+64){const int i=tq-448; bt[i]=btab[h*128+i]; bt[64+i]=btab[h*128+64+i];} }
  float mhat=0.f,l_reg=0.f;f32x16 o[2];o[0]=f32x16{};o[1]=f32x16{};
  const int qrel=wid*QBLK+r32;
  #define CMASK(P0,P1,t) do{int jb_=(t)-(NT-4);   \
    if(jb_>=-2 && 32*wid+31-64*jb_>=0 && 32*wid-64*jb_-63<=112)biasadd(P0,P1,jb_,qrel,hi,btl); if(jb_>=0 && 64*jb_+63>32*wid)cmask(P0,P1,jb_,qrel,hi);}while(0)
  bool resc=false;
  #define START(P0,P1,t) do{ float rm=rowmax(P0,P1); resc=false; const float nv_=MASKADD(t); rm=fadd_s(rm,nv_); \
    { const float dl=__builtin_fmaxf(rm,-1.0e4f); mhat=fadd_s(mhat,dl); const float cc_=fsub_s(nv_,dl); \
      _Pragma("unroll") for(int r=0;r<16;++r){P0[r]=fadd_s(P0[r],cc_);P1[r]=fadd_s(P1[r],cc_);} } \
    _Pragma("unroll") for(int r=0;r<16;++r)P0[r]=__builtin_amdgcn_exp2f(P0[r]); }while(0)
  #define RESC() do{ if(resc){ asm volatile("s_waitcnt lgkmcnt(0)":::"memory"); \
      _Pragma("unroll") for(int d_=0;d_<2;++d_) _Pragma("unroll") for(int r=0;r<16;++r)o[d_][r]*=wsf[crow(r,hi)]; } }while(0)
  f32x16 pA0,pA1,pB0,pB1;
  int sl_prev=0,sl_cur=0,sl_next=SLOTB;
  #define ROT() do{sl_prev=sl_cur;sl_cur=sl_next;sl_next=(sl_next==(NSLOT-1)*SLOTB)?0:sl_next+SLOTB;}while(0)
  DMA_K(2,2*SLOTB);
  WAIT_BAR(3);
  unsigned selbits=(1u<<qb)-1u;
  if(qb>3){ selbits=0u;
    const __attribute__((address_space(3))) float* km3=(const __attribute__((address_space(3))) float*)(shm3+LDS_KM);
    float qf[32];
    #pragma unroll
    for(int d0=0;d0<4;++d0){
      #pragma unroll
      for(int i=0;i<8;++i) qf[d0*8+i]=__uint_as_float(((unsigned)(unsigned short)qr[d0][i])<<16);}
    float gj[7];
    #pragma unroll
    for(int j=0;j<7;++j){ float s=0.f;
      if(j<qb){
        #pragma unroll
        for(int d0=0;d0<4;++d0){ const f32x4v k0=*(const __attribute__((address_space(3))) f32x4v*)(km3+j*64+d0*16+hi*8); const f32x4v k1=*(const __attribute__((address_space(3))) f32x4v*)(km3+j*64+d0*16+hi*8+4);
          s+=qf[d0*8+0]*k0[0]+qf[d0*8+1]*k0[1]+qf[d0*8+2]*k0[2]+qf[d0*8+3]*k0[3]+qf[d0*8+4]*k1[0]+qf[d0*8+5]*k1[1]+qf[d0*8+6]*k1[2]+qf[d0*8+7]*k1[3]; }
        auto rr=__builtin_amdgcn_permlane32_swap(__float_as_uint(s),__float_as_uint(s),false,false); s=__uint_as_float(rr[0])+__uint_as_float(rr[1]); }
      gj[j]=s; }
    #pragma unroll
    for(int j=0;j<7;++j){ int rank=0;
      #pragma unroll
      for(int k=0;k<7;++k){ if(k!=j){ const bool beats=(k<j)?(gj[k]>=gj[j]):(gj[k]>gj[j]); rank+=(k<qb&&beats)?1:0; } }
      if(j<qb&&rank<3)selbits|=(1u<<j); }
  }
  #define MASKADD(t) ((((t)>>2)<qb && !((selbits>>((t)>>2))&1u))?-1.0e30f:0.0f)
  qkt(pA0,pA1,Kbase,qr,r32,hi);asm volatile("s_nop 15\n\ts_nop 7":"+v"(pA0),"+v"(pA1));CMASK(pA0,pA1,0);
  START(pA0,pA1,0);
  _Pragma("unroll") for(int r=0;r<16;++r)pA1[r]=__builtin_amdgcn_exp2f(pA1[r]);
  WAIT_BAR(0);
  DMA_K(3,0);DMA_V(1,SLOTB);
  ROT();
  kload8(kf,kp0+sl_cur);
  WAIT_BAR(2);
  s16x4 vlo[8],vhi[8]; u32x4 pw0,pw1,pw2,pw3;
  #define PKW(P,B) cvtpk_s(P[B],P[B+1])
  #define PAF(k) __builtin_bit_cast(bf16x8,pw##k)
  #define VFR(i) (bf16x8){vlo[i][0],vlo[i][1],vlo[i][2],vlo[i][3],vhi[i][0],vhi[i][1],vhi[i][2],vhi[i][3]}
  #define PIN(x) asm volatile("":"+v"(x))
  #define MX3(a,b,c) __builtin_fmaxf(__builtin_fmaxf((a),(b)),(c))
  #define GAPA(MF,A0,A1,A2,A3,W0,W1,PW) do{ MF; sacc+=A0; sacc+=A1; sacc+=A2; sacc+=A3; PIN(sacc); W0; W1; PIN(PW); SBAR(); }while(0)
  #define EX(v) __builtin_amdgcn_exp2f(v)
  #define GAPB(MF,X,B) do{ MF; X[B]=EX(X[B]); X[B+1]=EX(X[B+1]); X[B+2]=EX(X[B+2]); X[B+3]=EX(X[B+3]); PIN(X); SBAR(); }while(0)
  #define VRD(i) do{ vlo[i]=vtr(vp_+(((i)>>2)*4096+((i)&3)*1024)); vhi[i]=vtr(vp_+(((i)>>2)*4096+((i)&3)*1024+512)); }while(0)
  #define KRD(G,j) do{ if(G){ kload2(kf,kp0+sl_next,j); SBAR(); } }while(0)
  #define STEP(C0,C1,P0,P1,t,GK,GV,GL) do{ SBAR(); \
    const lds_cptr vp_=vp0+sl_prev; \
    VRD(0); SBAR(); float sacc=(P0[0]+P0[1]); \
    GAPA(C0=__builtin_amdgcn_mfma_f32_32x32x16_bf16(kf[0],qr[0],(f32x16){},0,0,0), P0[2],P0[3],P0[4],P0[5],     pw0[0]=PKW(P0,0), pw0[1]=PKW(P0,2), pw0); \
    VRD(4); SBAR(); GAPA(C1=__builtin_amdgcn_mfma_f32_32x32x16_bf16(kf[1],qr[0],(f32x16){},0,0,0), P0[6],P0[7],P0[8],P0[9],     pw0[2]=PKW(P0,4), pw0[3]=PKW(P0,6), pw0); \
    VRD(1); SBAR(); GAPA(C0=__builtin_amdgcn_mfma_f32_32x32x16_bf16(kf[2],qr[1],C0,0,0,0),   P0[10],P0[11],P0[12],P0[13], pw1[0]=PKW(P0,8), pw1[1]=PKW(P0,10), pw1); \
    VRD(5); SBAR(); GAPA(C1=__builtin_amdgcn_mfma_f32_32x32x16_bf16(kf[3],qr[1],C1,0,0,0),   P0[14],P0[15],P1[0],P1[1],   pw1[2]=PKW(P0,12),pw1[3]=PKW(P0,14), pw1); \
    VRD(2); SBAR(); GAPA(C0=__builtin_amdgcn_mfma_f32_32x32x16_bf16(kf[4],qr[2],C0,0,0,0),   P1[2],P1[3],P1[4],P1[5],     pw2[0]=PKW(P1,0), pw2[1]=PKW(P1,2), pw2); \
    VRD(6); SBAR(); GAPA(C1=__builtin_amdgcn_mfma_f32_32x32x16_bf16(kf[5],qr[2],C1,0,0,0),   P1[6],P1[7],P1[8],P1[9],     pw2[2]=PKW(P1,4), pw2[3]=PKW(P1,6), pw2); \
    VRD(3); SBAR(); GAPA(C0=__builtin_amdgcn_mfma_f32_32x32x16_bf16(kf[6],qr[3],C0,0,0,0),   P1[10],P1[11],P1[12],P1[13], pw3[0]=PKW(P1,8), pw3[1]=PKW(P1,10), pw3); \
    VRD(7); SBAR(); GAPA(C1=__builtin_amdgcn_mfma_f32_32x32x16_bf16(kf[7],qr[3],C1,0,0,0),   P1[14],P1[15],0.f,0.f,       pw3[2]=PKW(P1,12),pw3[3]=PKW(P1,14), pw3); \
    l_reg+=sacc; \
    if(GK){DMA_K((t)+3,sl_cur);} if(GV){DMA_V((t)+1,sl_next);} \
    CMASK(C0,C1,t); \
    { float a=MX3(C0[0],C0[1],C1[0]),b=MX3(C0[2],C0[3],C1[1]); a=MX3(a,C1[2],C1[3]); \
      _Pragma("unroll") for(int r=4;r<16;r+=4){a=MX3(a,C0[r],C0[r+1]);b=MX3(b,C0[r+2],C0[r+3]);a=MX3(a,C1[r],C1[r+1]);b=MX3(b,C1[r+2],C1[r+3]);} \
      float rm=__builtin_fmaxf(a,b); { auto rr=__builtin_amdgcn_permlane32_swap(__float_as_uint(rm),__float_as_uint(rm),false,false); rm=__builtin_fmaxf(__uint_as_float(rr[0]),__uint_as_float(rr[1])); } \
      const float nv_=MASKADD(t)-mhat; rm+=nv_; float cc_=nv_; \
      resc=false; \
      if(__builtin_expect(__any(rm>(float)THRL),0)){ const float dl=__builtin_fmaxf(rm,0.f); mhat+=dl; cc_-=dl; \
        const float f=__builtin_amdgcn_exp2f(-dl); l_reg*=f; if(hi==0)wsf[r32]=f; resc=true; } \
      _Pragma("unroll") for(int r=0;r<16;++r){C0[r]+=cc_;C1[r]+=cc_;} } \
    SBAR(); \
    GAPB(o[0]=__builtin_amdgcn_mfma_f32_32x32x16_bf16(PAF(0),VFR(0),o[0],0,0,0), C0,0); \
    GAPB(o[1]=__builtin_amdgcn_mfma_f32_32x32x16_bf16(PAF(0),VFR(4),o[1],0,0,0), C0,4); \
    KRD(GL,0); GAPB(o[0]=__builtin_amdgcn_mfma_f32_32x32x16_bf16(PAF(1),VFR(1),o[0],0,0,0), C0,8); \
    KRD(GL,1); GAPB(o[1]=__builtin_amdgcn_mfma_f32_32x32x16_bf16(PAF(1),VFR(5),o[1],0,0,0), C0,12); \
    KRD(GL,2); GAPB(o[0]=__builtin_amdgcn_mfma_f32_32x32x16_bf16(PAF(2),VFR(2),o[0],0,0,0), C1,0); \
    KRD(GL,3); GAPB(o[1]=__builtin_amdgcn_mfma_f32_32x32x16_bf16(PAF(2),VFR(6),o[1],0,0,0), C1,4); \
    GAPB(o[0]=__builtin_amdgcn_mfma_f32_32x32x16_bf16(PAF(3),VFR(3),o[0],0,0,0), C1,8); \
    GAPB(o[1]=__builtin_amdgcn_mfma_f32_32x32x16_bf16(PAF(3),VFR(7),o[1],0,0,0), C1,12); \
    }while(0)
  int t=1;
  #undef CMASK
  #define CMASK(P0,P1,t) do{}while(0)
  for(;t+7<NT;t+=2){
    STEP(pB0,pB1,pA0,pA1,t,true,true,true);     WAIT_BAR(2); RESC(); ROT();
    STEP(pA0,pA1,pB0,pB1,t+1,true,true,true);   WAIT_BAR(2); RESC(); ROT();
  }
  #undef CMASK
  #define CMASK(P0,P1,t) do{int jb_=(t)-(NT-4);   \
    if(jb_>=-2 && 32*wid+31-64*jb_>=0 && 32*wid-64*jb_-63<=112)biasadd(P0,P1,jb_,qrel,hi,btl); if(jb_>=0 && 64*jb_+63>32*wid)cmask(P0,P1,jb_,qrel,hi);}while(0)
  #define ENDW(tt) do{ if((tt)+3<NT){WAIT_BAR(2);} else if((tt)+2<NT){WAIT_BAR(1);} else {WAIT_BAR(0);} }while(0)
  for(;t+1<NT;t+=2){
    STEP(pB0,pB1,pA0,pA1,t,(t+3<NT),(t+1<NT),(t+1<NT));       ENDW(t);   RESC(); ROT();
    STEP(pA0,pA1,pB0,pB1,t+1,(t+4<NT),(t+2<NT),(t+2<NT));     ENDW(t+1); RESC(); ROT();
  }
  STEP(pB0,pB1,pA0,pA1,NT-1,false,false,false); RESC();
  { float sacc=pB0[0]+pB0[1]; _Pragma("unroll") for(int r=2;r<16;++r)sacc+=pB0[r]; _Pragma("unroll") for(int r=0;r<16;++r)sacc+=pB1[r]; l_reg+=sacc;
    pw0=(u32x4){PKW(pB0,0),PKW(pB0,2),PKW(pB0,4),PKW(pB0,6)};pw1=(u32x4){PKW(pB0,8),PKW(pB0,10),PKW(pB0,12),PKW(pB0,14)};pw2=(u32x4){PKW(pB1,0),PKW(pB1,2),PKW(pB1,4),PKW(pB1,6)};pw3=(u32x4){PKW(pB1,8),PKW(pB1,10),PKW(pB1,12),PKW(pB1,14)};
    SBAR(); pv(o,vb0+sl_cur,PAF(0),PAF(1),PAF(2),PAF(3)); }
  #undef PKW
  #undef PAF
  #undef VFR
  #undef PIN
  #undef MX3
  #undef GAPA
  #undef GAPB
  #undef EX
  #undef VRD
  #undef KRD
  #undef STEP
  #undef ENDW
  #undef MASKADD
  {auto rr=__builtin_amdgcn_permlane32_swap(__float_as_uint(l_reg),__float_as_uint(l_reg),false,false);l_reg=__uint_as_float(rr[0])+__uint_as_float(rr[1]);}
  if(hi==0)wsf[32+r32]=l_reg;asm volatile("s_waitcnt lgkmcnt(0)":::"memory");
  float rli[16];
  #pragma unroll
  for(int r=0;r<16;++r)rli[r]=__builtin_amdgcn_rcpf(wsf[32+crow(r,hi)]);
  bf16*Ow=O+(rowbase+q0+wid*QBLK)*DM+h*D;
  { bf16*stg=(bf16*)(shm+LDS_OST)+wid*2048;
    #pragma unroll
    for(int r=0;r<16;++r){const int orow=crow(r,hi);
      #pragma unroll
      for(int d0=0;d0<2;++d0)stg[orow*64+d0*32+r32]=__float2bfloat16(o[d0][r]*rli[r]);}
    asm volatile("s_waitcnt lgkmcnt(0)":::"memory");
    #pragma unroll
    for(int i=0;i<4;++i){const int row=i*8+(lane>>3),ch=lane&7; const u32x4 v=*(const u32x4*)(stg+row*64+ch*8); ATTN_STORE16(Ow+(long)row*DM+ch*8,v);} }
  asm volatile("s_waitcnt lgkmcnt(0)\n\ts_barrier":::"memory");
  #undef DMA_K
  #undef DMA_V
  #undef CMASK
  #undef START
  #undef RESC
  #undef ROT
}
constexpr int ATTN_LDS_BYTES=LDS_BYTES;
#undef SBAR
#undef WAIT_BAR
}
constexpr int NWAVES = 8;
constexpr int PER_PHASE = 10;
constexpr int N_LAUNCHES = MK_N_LAUNCHES;

constexpr int BATCH = 8, SEQ = 2048, DMODEL = 1024, MTOK = BATCH * SEQ;
constexpr int INCOLS = 4096, SSMW = 512, NGRP = 32, CH = 32  , NCHUNK = SEQ / CH  , APK = 640  ;
constexpr int PQ = 2048, NEXP = 16384;
constexpr float RMS_EPS = 1e-6f;

constexpr size_t MiB = 1u << 20;
constexpr size_t WS_CTL = 0, CTL_ZERO_BYTES = 64 * 1024;
constexpr size_t WS_BIAS = 1 * MiB;
constexpr size_t WS_PW32 = 1 * MiB + 64 * 1024;
constexpr size_t WS_KPART = 1 * MiB + 128 * 1024;
constexpr size_t WS_KG = 2 * MiB;
constexpr size_t WS_SSQ1 = 3 * MiB;
constexpr size_t WS_WIN = 6 * MiB, WS_WQ = 14 * MiB, WS_WOUT = 18 * MiB, WS_WUS = 20 * MiB, WS_WUA = 21 * MiB, WS_WGLU = 22 * MiB, WS_KS = 22 * MiB + 512 * 1024;
constexpr size_t WS_WE = 23 * MiB;
constexpr size_t WS_BP = 32 * MiB;
constexpr size_t WS_AP = 52 * MiB;
constexpr size_t WS_E = 72 * MiB;
constexpr size_t WS_H = 80 * MiB;
constexpr size_t WS_YPRE = 80 * MiB, WS_YA = 96 * MiB, WS_XG = 80 * MiB;
constexpr size_t WS_Z = 96 * MiB, ZSTRIDE_B = 16 * MiB;
constexpr size_t WS_MRG = 128 * MiB;
constexpr size_t WS_PQ = 160 * MiB;
constexpr size_t WS_IDS = 224 * MiB, WS_GTS = 232 * MiB;
constexpr size_t WS_U16 = 32 * MiB, WS_V16 = 240 * MiB;
constexpr size_t WS_YB = 224 * MiB;
constexpr size_t WS_WPK = 128 * MiB, WS_RSTD1 = 4 * MiB, WS_Y16 = 160 * MiB;
constexpr size_t WS_END = 256 * MiB;
constexpr int CW_BAR = 1024;

constexpr int RING_OFF = 0, RING_BYTES = 131072;
constexpr int LDSCTL_OFF = RING_BYTES, MISC_OFF = LDSCTL_OFF + 320;
constexpr int LDS_BYTES = 147456;

#define GAS __attribute__((address_space(1)))
#define LAS __attribute__((address_space(3)))
typedef unsigned short bf16;
typedef unsigned v4u __attribute__((ext_vector_type(4)));
typedef float f32x4 __attribute__((ext_vector_type(4)));
typedef short bf16x8 __attribute__((ext_vector_type(8)));
typedef float f32x16 __attribute__((ext_vector_type(16)));
typedef __bf16 bf16x2_t __attribute__((ext_vector_type(2)));
typedef _Float16 h2_t __attribute__((ext_vector_type(2)));
typedef GAS unsigned gu32;
#define RLX_AGENT __ATOMIC_RELAXED, __HIP_MEMORY_SCOPE_AGENT
#define LDS_WAIT() asm volatile("s_waitcnt lgkmcnt(0)" ::: "memory")
#define VM_WAIT() asm volatile("s_waitcnt vmcnt(0)" ::: "memory")
__device__ __forceinline__ unsigned f2bf(float f) { unsigned u = __builtin_bit_cast(unsigned, f); return (u + 0x7fffu + ((u >> 16) & 1u)) >> 16; }
__device__ __forceinline__ unsigned pk2(float lo, float hi) { return f2bf(lo) | (f2bf(hi) << 16); }
using pg8::cvt_pk_bf16; using pg8::bf_lo; using pg8::bf_hi; using pg8::sigmoid_f; using pg8::gelu_tanh;

#define XB_TMO      128
#define XB_XCNT(j)  (256  + 64 * (j))
#define XB_XSUB(j)  (1280 + 64 * (j))
#define XB_XGEN(j)  (2304 + 64 * (j))
#define XB_TOP      3328
#define XB_TOPGEN   3392
#define XCD_BAR_WORDS 3456
#define XB_SPIN_CAP (1u << 18)
__device__ __forceinline__ unsigned xb_ld(unsigned* p)              { return __hip_atomic_load(p, __ATOMIC_RELAXED, __HIP_MEMORY_SCOPE_AGENT); }
__device__ __forceinline__ unsigned xb_add(unsigned* p, unsigned v) { return __hip_atomic_fetch_add(p, v, __ATOMIC_RELAXED, __HIP_MEMORY_SCOPE_AGENT); }
__device__ __forceinline__ unsigned xb_xcc_id() { return (unsigned)__builtin_amdgcn_s_getreg((3 << 11) | 20) & 0xFu; }
#define XB_SPIN(cond, bar) do { unsigned _sp = 0; while (cond) { __builtin_amdgcn_s_sleep(1); \
    if ((++_sp & 255u) == 0u) { if (xb_ld(&(bar)[XB_TMO])) break; if (_sp > XB_SPIN_CAP) { atomicAdd(&(bar)[XB_TMO], 1u); break; } } } } while (0)
struct XcdBarrier { unsigned* bar; unsigned x; volatile LAS unsigned* st; };
__device__ __forceinline__ XcdBarrier xcd_barrier_post(unsigned* bar, volatile LAS unsigned* st) {
    XcdBarrier b; b.bar = bar; b.x = xb_xcc_id(); b.st = st;
    if (threadIdx.x == 0) (void)xb_add(&bar[XB_XCNT(b.x)], 1u);
    return b;
}
__device__ __forceinline__ void xcd_barrier_complete(unsigned* bar, unsigned x, unsigned& nloc, unsigned& nx) {
    const unsigned G = gridDim.x * gridDim.y * gridDim.z;
    unsigned sum, cnt, mine, sp = 0u;
    for (;;) {
        sum = 0u; cnt = 0u; mine = 0u;
#pragma unroll
        for (unsigned j = 0; j < 16; ++j) { const unsigned c = xb_ld(&bar[XB_XCNT(j)]); sum += c; cnt += (c > 0u) ? 1u : 0u; mine = (j == x) ? c : mine; }
        if (sum == G) break;
        __builtin_amdgcn_s_sleep(1);
        if ((++sp & 255u) == 0u) { if (xb_ld(&bar[XB_TMO])) break; if (sp > XB_SPIN_CAP) { atomicAdd(&bar[XB_TMO], 1u); break; } }
    }
    nloc = mine > 0u ? mine : 1u; nx = cnt > 0u ? cnt : 1u;
}
__device__ __forceinline__ void xcd_barrier(const XcdBarrier& b) {
    asm volatile("s_waitcnt vmcnt(0)" ::: "memory");
    __syncthreads();
    if (threadIdx.x == 0) {
        unsigned* bar = b.bar;
        __builtin_amdgcn_s_waitcnt(0);
        unsigned nloc = b.st[0], nx = b.st[1];
        if (nloc == 0u) { xcd_barrier_complete(bar, b.x, nloc, nx); b.st[0] = nloc; b.st[1] = nx; }
        const unsigned old = xb_add(&bar[XB_XSUB(b.x)], 1u);
        const unsigned gen = old / nloc;
        if (old + 1u == (gen + 1u) * nloc) {
            __builtin_amdgcn_fence(__ATOMIC_RELEASE, "agent");
            asm volatile("s_waitcnt vmcnt(0)" ::: "memory");
            const unsigned og = xb_add(&bar[XB_TOP], 1u);
            const unsigned tg = og / nx;
            if (og + 1u == (tg + 1u) * nx) xb_add(&bar[XB_TOPGEN], 1u);
            else XB_SPIN(xb_ld(&bar[XB_TOPGEN]) == tg, bar);
            __builtin_amdgcn_fence(__ATOMIC_ACQUIRE, "agent");
            xb_add(&bar[XB_XGEN(b.x)], 1u);
            asm volatile("s_waitcnt vmcnt(0)" ::: "memory");
        } else {
            XB_SPIN(xb_ld(&bar[XB_XGEN(b.x)]) == gen, bar);
            __builtin_amdgcn_fence(__ATOMIC_ACQUIRE, "agent");
            asm volatile("s_waitcnt vmcnt(0)" ::: "memory");
        }
    }
    __syncthreads();
}

__device__ __forceinline__ float wave_sum(float v) {
#pragma unroll
    for (int o = 1; o < 64; o <<= 1) v += __shfl_xor(v, o);
    return v;
}

namespace pg8 {
struct EpiIn {
    static constexpr bool PERM = true;
    bf16_t* zbase; bf16_t* AP; float* kpart;
    __device__ __forceinline__ void operator()(const f32x4 (&acc)[2][2][4][2], const Unit& u, int wr, int wc, int fr, int fq) const {
        const int t = u.pn >> 1, colt = (u.pn & 1) * 256;
        const int row0 = u.pm * BM + wr * 64 + fr, col0 = colt + wc * 32 + 8 * fq;
        if (t == 0) {
#pragma unroll
            for (int ai = 0; ai < 2; ++ai)
#pragma unroll
                for (int m = 0; m < 4; ++m) { const int r = row0 + ai * HALF + m * 16, b = r >> 11, l = r & 2047;
#pragma unroll
                    for (int bj = 0; bj < 2; ++bj) { const int c = col0 + bj * HALF, g = c >> 4, hi0 = c & 15;
                        const f32x4 v0 = acc[ai][bj][m][0], v1 = acc[ai][bj][m][1];
                        u32x4 w; w.x = cvt_pk_bf16(v0[0], v0[1]); w.y = cvt_pk_bf16(v0[2], v0[3]); w.z = cvt_pk_bf16(v1[0], v1[1]); w.w = cvt_pk_bf16(v1[2], v1[3]);
                        *(u32x4*)(AP + (size_t)(g * 512 + b * 64 + (l >> 5)) * 640 + (l & 31) * 16 + hi0) = w; } }
        } else {
            bf16_t* base = zbase + (size_t)t * (16u * 1024u * 1024u / 2u);
            const float sc = (t == 1) ? 0.125f * 1.4426950408889634f : 1.0f;
#pragma unroll
            for (int ai = 0; ai < 2; ++ai)
#pragma unroll
                for (int m = 0; m < 4; ++m) { bf16_t* rowp = base + (size_t)(row0 + ai * HALF + m * 16) * 512 + col0;
#pragma unroll
                    for (int bj = 0; bj < 2; ++bj) { f32x4 v0 = acc[ai][bj][m][0], v1 = acc[ai][bj][m][1];
                        if (t >= 4) {
#pragma unroll
                            for (int e = 0; e < 4; ++e) { v0[e] = sigmoid_f(v0[e]); v1[e] = sigmoid_f(v1[e]); }
                        } else { v0 = v0 * sc; v1 = v1 * sc; }
                        u32x4 w; w.x = cvt_pk_bf16(v0[0], v0[1]); w.y = cvt_pk_bf16(v0[2], v0[3]); w.z = cvt_pk_bf16(v1[0], v1[1]); w.w = cvt_pk_bf16(v1[2], v1[3]);
                        *(u32x4*)(rowp + bj * HALF) = w; } }
            if (t == 2) {
#pragma unroll
                for (int bj = 0; bj < 2; ++bj)
#pragma unroll
                    for (int n = 0; n < 2; ++n) { f32x4 s = (f32x4){0.f, 0.f, 0.f, 0.f};
#pragma unroll
                        for (int ai = 0; ai < 2; ++ai)
#pragma unroll
                            for (int m = 0; m < 4; ++m) s += acc[ai][bj][m][n];
#pragma unroll
                        for (int e = 0; e < 4; ++e) { float x = s[e]; x += __shfl_xor(x, 1); x += __shfl_xor(x, 2); x += __shfl_xor(x, 4); x += __shfl_xor(x, 8); s[e] = x; }
                        if (fr == 0) *(f32x4*)(kpart + (size_t)(u.pm * 2 + wr) * 512 + col0 + bj * HALF + 4 * n) = s; }
            }
        }
    }
};
struct EpiE {
    static constexpr bool PERM = false;
    float* E;
    __device__ __forceinline__ void operator()(const f32x4 (&acc)[2][2][4][2], const Unit& u, int wr, int wc, int fr, int fq) const {
        const int row0 = u.pm * BM + wr * 64 + fr, col0 = wc * 32 + 4 * fq;
#pragma unroll
        for (int ai = 0; ai < 2; ++ai)
#pragma unroll
            for (int m = 0; m < 4; ++m) { float* rowp = E + (size_t)(row0 + ai * HALF + m * 16) * 128 + col0;
#pragma unroll
                for (int n = 0; n < 2; ++n) *(f32x4*)(rowp + n * 16) = acc[ai][0][m][n]; }
    }
};
struct EpiY {
    static constexpr bool PERM = true;
    bf16_t* Y;
    __device__ __forceinline__ void operator()(const f32x4 (&acc)[2][2][4][2], const Unit& u, int wr, int wc, int fr, int fq) const {
        const int row0 = u.pm * BM + wr * 64 + fr, col0 = u.pn * BM + wc * 32 + 8 * fq;
#pragma unroll
        for (int ai = 0; ai < 2; ++ai)
#pragma unroll
            for (int m = 0; m < 4; ++m) { const int r = row0 + ai * HALF + m * 16, g = r >> 9, b = (r >> 6) & 7, c = r & 63;
#pragma unroll
                for (int bj = 0; bj < 2; ++bj) { const int cc = col0 + bj * HALF, j = cc >> 4, ho0 = cc & 15;
                    f32x4 v0 = acc[ai][bj][m][0], v1 = acc[ai][bj][m][1];
#pragma unroll
                    for (int e = 0; e < 4; ++e) { v0[e] = gelu_tanh(v0[e]); v1[e] = gelu_tanh(v1[e]); }
                    u32x4 w; w.x = cvt_pk_bf16(v0[0], v0[1]); w.y = cvt_pk_bf16(v0[2], v0[3]); w.z = cvt_pk_bf16(v1[0], v1[1]); w.w = cvt_pk_bf16(v1[2], v1[3]);
                    *(u32x4*)(Y + (size_t)(b * 2048 + c * 32 + j) * 512 + g * 16 + ho0) = w; } }
    }
};
struct EpiGlu {
    static constexpr bool PERM = true;
    const bf16_t* Yp; bf16_t* Ya; const float* bias;
    __device__ __forceinline__ void operator()(const f32x4 (&acc)[2][2][4][2], const Unit& u, int wr, int wc, int fr, int fq) const {
        const int row0 = u.pm * BM + wr * 64 + fr, col0 = u.pn * BM + wc * 32 + 8 * fq;
        f32x4 bv[2][2];
#pragma unroll
        for (int bj = 0; bj < 2; ++bj)
#pragma unroll
            for (int n = 0; n < 2; ++n) bv[bj][n] = *(const f32x4*)(bias + col0 + bj * HALF + 4 * n);
#pragma unroll
        for (int ai = 0; ai < 2; ++ai)
#pragma unroll
            for (int m = 0; m < 4; ++m) { const size_t off = (size_t)(row0 + ai * HALF + m * 16) * 512 + col0;
#pragma unroll
                for (int bj = 0; bj < 2; ++bj) { const f32x4 z0 = acc[ai][bj][m][0] + bv[bj][0], z1 = acc[ai][bj][m][1] + bv[bj][1];
                    const u32x4 y = *(const u32x4*)(Yp + off + bj * HALF);
                    u32x4 w; w.x = cvt_pk_bf16(bf_lo(y.x) * sigmoid_f(z0[0]), bf_hi(y.x) * sigmoid_f(z0[1])); w.y = cvt_pk_bf16(bf_lo(y.y) * sigmoid_f(z0[2]), bf_hi(y.y) * sigmoid_f(z0[3]));
                    w.z = cvt_pk_bf16(bf_lo(y.z) * sigmoid_f(z1[0]), bf_hi(y.z) * sigmoid_f(z1[1])); w.w = cvt_pk_bf16(bf_lo(y.w) * sigmoid_f(z1[2]), bf_hi(y.w) * sigmoid_f(z1[3]));
                    *(u32x4*)(Ya + off + bj * HALF) = w; } }
    }
};
template <int ADD> struct EpiMrg {
    static constexpr bool PERM = true;
    const bf16_t* G0; bf16_t* Mrg;
    __device__ __forceinline__ void operator()(const f32x4 (&acc)[2][2][4][2], const Unit& u, int wr, int wc, int fr, int fq) const {
        const int row0 = u.pm * BM + wr * 64 + fr, cin = wc * 32 + 8 * fq;
        const bf16_t* gb = G0 + (size_t)(u.pn >> 1) * (16u * 1024u * 1024u / 2u) + (u.pn & 1) * 256 + cin;
#pragma unroll
        for (int ai = 0; ai < 2; ++ai)
#pragma unroll
            for (int m = 0; m < 4; ++m) { const int r = row0 + ai * HALF + m * 16;
#pragma unroll
                for (int bj = 0; bj < 2; ++bj) {
#if defined(ABL_NO_SSM) || defined(ABL_NO_ATT)
#if defined(ABL_NO_SSM)
                    constexpr bool kill = (ADD == 0);
#else
                    constexpr bool kill = (ADD == 1);
#endif
                    const f32x4 a0 = kill ? (f32x4){0.f, 0.f, 0.f, 0.f} : acc[ai][bj][m][0], a1 = kill ? (f32x4){0.f, 0.f, 0.f, 0.f} : acc[ai][bj][m][1];
#else
                    const f32x4 a0 = acc[ai][bj][m][0], a1 = acc[ai][bj][m][1];
#endif
                    const u32x4 gt = *(const u32x4*)(gb + (size_t)r * 512 + bj * HALF);
                    bf16_t* mp = Mrg + (size_t)r * 1024 + u.pn * BM + cin + bj * HALF;
                    float o[8] = { bf_lo(gt.x) * a0[0], bf_hi(gt.x) * a0[1], bf_lo(gt.y) * a0[2], bf_hi(gt.y) * a0[3], bf_lo(gt.z) * a1[0], bf_hi(gt.z) * a1[1], bf_lo(gt.w) * a1[2], bf_hi(gt.w) * a1[3] };
                    if (ADD) { const u32x4 p = *(const u32x4*)mp; o[0] += bf_lo(p.x); o[1] += bf_hi(p.x); o[2] += bf_lo(p.y); o[3] += bf_hi(p.y); o[4] += bf_lo(p.z); o[5] += bf_hi(p.z); o[6] += bf_lo(p.w); o[7] += bf_hi(p.w); }
                    u32x4 w; w.x = cvt_pk_bf16(o[0], o[1]); w.y = cvt_pk_bf16(o[2], o[3]); w.z = cvt_pk_bf16(o[4], o[5]); w.w = cvt_pk_bf16(o[6], o[7]);
                    *(u32x4*)mp = w; } }
    }
};
struct EpiMrgDual {
    static constexpr bool PERM = true;
    EpiMrg<0> a; EpiMrg<1> b;
    __device__ __forceinline__ void operator()(const f32x4 (&acc)[2][2][4][2], const Unit& u, int wr, int wc, int fr, int fq) const { if (u.w == 0) a(acc, u, wr, wc, fr, fq); else b(acc, u, wr, wc, fr, fq); }
};
struct EpiX1 {
    static constexpr bool PERM = true;
    const float* X; float* X1; bf16_t* XG; const float* g2; float* ssq;
    __device__ __forceinline__ void operator()(const f32x4 (&acc)[2][2][4][2], const Unit& u, int wr, int wc, int fr, int fq) const {
        const int row0 = u.pm * BM + wr * 64 + fr, col0 = u.pn * BM + wc * 32 + 8 * fq;
        f32x4 gv[2][2];
#pragma unroll
        for (int bj = 0; bj < 2; ++bj)
#pragma unroll
            for (int n = 0; n < 2; ++n) gv[bj][n] = *(const f32x4*)(g2 + col0 + bj * HALF + 4 * n);
#pragma unroll
        for (int ai = 0; ai < 2; ++ai)
#pragma unroll
            for (int m = 0; m < 4; ++m) { const int r = row0 + ai * HALF + m * 16; const size_t off = (size_t)r * 1024 + col0; float s = 0.f;
#pragma unroll
                for (int bj = 0; bj < 2; ++bj) {
                    #ifdef ABL_NO_MIX
                    const f32x4 x0 = *(const f32x4*)(X + off + bj * HALF), x1 = *(const f32x4*)(X + off + bj * HALF + 4);
#else
                    const f32x4 x0 = *(const f32x4*)(X + off + bj * HALF) + acc[ai][bj][m][0], x1 = *(const f32x4*)(X + off + bj * HALF + 4) + acc[ai][bj][m][1];
#endif
                    *(f32x4*)(X1 + off + bj * HALF) = x0; *(f32x4*)(X1 + off + bj * HALF + 4) = x1;
                    s += (x0[0] * x0[0] + x0[1] * x0[1]) + (x0[2] * x0[2] + x0[3] * x0[3]) + (x1[0] * x1[0] + x1[1] * x1[1]) + (x1[2] * x1[2] + x1[3] * x1[3]);
                    const f32x4 a = x0 * gv[bj][0], b = x1 * gv[bj][1];
                    u32x4 w; w.x = cvt_pk_bf16(a[0], a[1]); w.y = cvt_pk_bf16(a[2], a[3]); w.z = cvt_pk_bf16(b[0], b[1]); w.w = cvt_pk_bf16(b[2], b[3]);
                    *(u32x4*)(XG + off + bj * HALF) = w; }
                s += __shfl_xor(s, 16); s += __shfl_xor(s, 32);
                if (fq == 0) ssq[(size_t)r * 16 + u.pn * 4 + wc] = s; }
    }
};
struct EpiPlain {
    static constexpr bool PERM = true;
    bf16_t* O; int ldc;
    __device__ __forceinline__ void operator()(const f32x4 (&acc)[2][2][4][2], const Unit& u, int wr, int wc, int fr, int fq) const {
        const int row0 = u.pm * BM + wr * 64 + fr, col0 = u.pn * BM + wc * 32 + 8 * fq;
#pragma unroll
        for (int ai = 0; ai < 2; ++ai)
#pragma unroll
            for (int m = 0; m < 4; ++m) { bf16_t* rowp = O + (size_t)(row0 + ai * HALF + m * 16) * ldc + col0;
#pragma unroll
                for (int bj = 0; bj < 2; ++bj) { const f32x4 v0 = acc[ai][bj][m][0], v1 = acc[ai][bj][m][1];
                    u32x4 w; w.x = cvt_pk_bf16(v0[0], v0[1]); w.y = cvt_pk_bf16(v0[2], v0[3]); w.z = cvt_pk_bf16(v1[0], v1[1]); w.w = cvt_pk_bf16(v1[2], v1[3]);
                    *(u32x4*)(rowp + bj * HALF) = w; } }
    }
};
}
struct Frame {
    LAS unsigned char* lds;
    int tid, lane, wave, vcu, G;
};

__device__ __forceinline__ void p0_transpose_item(const float* W, int K, int N, bf16* WT, LAS float* scr, int item, int lane) {
    const int nblk = N / 32, kb = item / nblk, nb = item % nblk, k0 = 64 * kb, n0 = 32 * nb;
    float wv[32];
#pragma unroll
    for (int i = 0; i < 32; ++i) { const int kk = 2 * i + (lane >> 5); wv[i] = W[(size_t)(k0 + kk) * N + n0 + (lane & 31)]; }
#pragma unroll
    for (int i = 0; i < 32; ++i) { const int kk = 2 * i + (lane >> 5); scr[kk * 33 + (lane & 31)] = wv[i]; }
    LDS_WAIT(); asm volatile("" ::: "memory");
    const int c = lane & 7;
#pragma unroll
    for (int j = 0; j < 4; ++j) { const int n = (lane >> 3) + 8 * j; const LAS float* s = scr + (8 * c) * 33 + n;
        v4u o; o.x = pk2(s[0 * 33], s[1 * 33]); o.y = pk2(s[2 * 33], s[3 * 33]); o.z = pk2(s[4 * 33], s[5 * 33]); o.w = pk2(s[6 * 33], s[7 * 33]);
        *(GAS v4u*)(WT + (size_t)(n0 + n) * K + k0 + 8 * c) = o; }
    LDS_WAIT(); asm volatile("" ::: "memory");
}
__device__ __forceinline__ void rms_row_to_bf16(const float* xrow, const float* g, bf16* orow, int lane) {
    const GAS f32x4* xr = (const GAS f32x4*)xrow + lane; const GAS f32x4* gr = (const GAS f32x4*)g + lane;
    f32x4 v[4]; float s = 0.f;
#pragma unroll
    for (int j = 0; j < 4; ++j) { v[j] = xr[64 * j]; s += (v[j].x * v[j].x + v[j].y * v[j].y) + (v[j].z * v[j].z + v[j].w * v[j].w); }
    const float rstd = 1.0f / sqrtf(wave_sum(s) * (1.f / DMODEL) + RMS_EPS);
    GAS unsigned long long* o8 = (GAS unsigned long long*)orow + lane;
#pragma unroll
    for (int j = 0; j < 4; ++j) { const f32x4 gg = gr[64 * j];
        o8[64 * j] = (unsigned long long)pk2(v[j].x * rstd * gg.x, v[j].y * rstd * gg.y) | ((unsigned long long)pk2(v[j].z * rstd * gg.z, v[j].w * rstd * gg.w) << 32); }
}
__device__ __forceinline__ void rms_rows4_to_bf16(const float* x, const float* g, bf16* out, int m, int stride, int lane) {
    f32x4 v[4][4];
#pragma unroll
    for (int k = 0; k < 4; ++k) { const int mm = (m + k * stride < MTOK) ? m + k * stride : m; const GAS f32x4* xr = (const GAS f32x4*)(x + (size_t)mm * DMODEL) + lane;
#pragma unroll
        for (int j = 0; j < 4; ++j) v[k][j] = xr[64 * j]; }
    const GAS f32x4* gr = (const GAS f32x4*)g + lane; f32x4 gg[4];
#pragma unroll
    for (int j = 0; j < 4; ++j) gg[j] = gr[64 * j];
#pragma unroll
    for (int k = 0; k < 4; ++k) { if (m + k * stride >= MTOK) break; float s = 0.f;
#pragma unroll
        for (int j = 0; j < 4; ++j) s += (v[k][j].x * v[k][j].x + v[k][j].y * v[k][j].y) + (v[k][j].z * v[k][j].z + v[k][j].w * v[k][j].w);
        const float rstd = 1.0f / sqrtf(wave_sum(s) * (1.f / DMODEL) + RMS_EPS);
        GAS unsigned long long* o8 = (GAS unsigned long long*)(out + (size_t)(m + k * stride) * DMODEL) + lane;
#pragma unroll
        for (int j = 0; j < 4; ++j) o8[64 * j] = (unsigned long long)pk2(v[k][j].x * rstd * gg[j].x, v[k][j].y * rstd * gg[j].y) | ((unsigned long long)pk2(v[k][j].z * rstd * gg[j].z, v[k][j].w * rstd * gg[j].w) << 32); }
}
struct cpx { float r, i; };
__device__ __forceinline__ cpx cmul(cpx a, cpx b) { return cpx{a.r * b.r - a.i * b.i, a.r * b.i + a.i * b.r}; }
__device__ __forceinline__ cpx cpow_(float ar, float ai, float dt, int n) { const float e = expf(ar * dt * (float)n); const float ang = ai * dt * (float)n; return cpx{e * cosf(ang), e * sinf(ang)}; }
__device__ __forceinline__ void ssm_table_task(int g, int j, int lane, LAS float* scr, const float* a_re, const float* a_im, const float* log_dt, const float* b_re, const float* b_im,
                                               const float* c_re, const float* c_im, float* Kg, bf16* WE, bf16* BP, float* pw32) {
    const int p = lane;
    const float dt = expf(log_dt[g]), ar = a_re[g * 64 + p], ai = a_im[g * 64 + p];
#define pw(n) cpow_(ar, ai, dt, (n))
    const cpx lb = pw(1);
    const float den = ar * ar + ai * ai;
    const cpx coef = cpx{((lb.r - 1.f) * ar + lb.i * ai) / den, (lb.i * ar - (lb.r - 1.f) * ai) / den};
    const cpx pj = pw(j), pe = pw(31 - j), pv = pw(j + 1);
    unsigned wer[8], wei[8];
#pragma unroll
    for (int h2 = 0; h2 < 8; ++h2) { float er[2], ei[2];
#pragma unroll
        for (int q = 0; q < 2; ++q) { const int hi = 2 * h2 + q;
            const cpx bb = cmul(coef, cpx{b_re[(g * 64 + p) * 16 + hi], b_im[(g * 64 + p) * 16 + hi]});
            const cpx w = cmul(pj, bb); scr[(p * 16 + hi) * 2] = w.r; scr[(p * 16 + hi) * 2 + 1] = w.i;
            const cpx e = cmul(pe, bb); er[q] = e.r; ei[q] = e.i; }
        wer[h2] = pk2(er[0], er[1]); wei[h2] = pk2(ei[0], ei[1]); }
    { bf16* w0 = WE + ((size_t)(g * 256 + p) * 512 + j * 16); bf16* w1 = WE + ((size_t)(g * 256 + 64 + p) * 512 + j * 16);
      *(GAS v4u*)w0 = (v4u){wer[0], wer[1], wer[2], wer[3]}; *(GAS v4u*)(w0 + 8) = (v4u){wer[4], wer[5], wer[6], wer[7]};
      *(GAS v4u*)w1 = (v4u){wei[0], wei[1], wei[2], wei[3]}; *(GAS v4u*)(w1 + 8) = (v4u){wei[4], wei[5], wei[6], wei[7]};
      bf16* z0 = WE + ((size_t)(g * 256 + 128 + p) * 512 + j * 16); bf16* z1 = WE + ((size_t)(g * 256 + 192 + p) * 512 + j * 16); const v4u z = (v4u){0u, 0u, 0u, 0u};
      *(GAS v4u*)z0 = z; *(GAS v4u*)(z0 + 8) = z; *(GAS v4u*)z1 = z; *(GAS v4u*)(z1 + 8) = z; }
#pragma unroll 4
    for (int ho = 0; ho < 16; ++ho) { const cpx cv = cmul(cpx{c_re[(g * 16 + ho) * 64 + p], c_im[(g * 16 + ho) * 64 + p]}, pv);
        bf16* row = BP + ((size_t)(g * 512 + j * 16 + ho) * APK + 512);
        row[p] = (bf16)f2bf(cv.r); row[64 + p] = (bf16)f2bf(-cv.i); }
    if (j == 0) { const cpx p32 = pw(32); pw32[g * 128 + p] = p32.r; pw32[g * 128 + 64 + p] = p32.i; }
    LDS_WAIT(); asm volatile("" ::: "memory");
    { const int ho = lane >> 2, h4 = (lane & 3) * 4; float a0 = 0.f, a1 = 0.f, a2 = 0.f, a3 = 0.f;
      const float* cr = c_re + (g * 16 + ho) * 64; const float* ci = c_im + (g * 16 + ho) * 64;
#pragma unroll 4
      for (int pp = 0; pp < 64; ++pp) { const float r_ = cr[pp], i_ = ci[pp]; const LAS float* w = scr + (pp * 16 + h4) * 2;
          a0 += r_ * w[0] - i_ * w[1]; a1 += r_ * w[2] - i_ * w[3]; a2 += r_ * w[4] - i_ * w[5]; a3 += r_ * w[6] - i_ * w[7]; }
      *(GAS f32x4*)(Kg + ((size_t)(g * 32 + j) * 256 + ho * 16 + h4)) = (f32x4){a0, a1, a2, a3}; }
    LDS_WAIT(); asm volatile("" ::: "memory");
#undef pw
}

__device__ __forceinline__ float vmaxf(float a, float b) { float r; asm("v_max_f32_e32 %0, %1, %2" : "=v"(r) : "v"(a), "v"(b)); return r; }
__device__ __forceinline__ float vminf(float a, float b) { float r; asm("v_min_f32_e32 %0, %1, %2" : "=v"(r) : "v"(a), "v"(b)); return r; }
__device__ __forceinline__ float selhi(float lo, float hi) { float r; asm("v_cndmask_b32_e64 %0, %1, %2, %3" : "=v"(r) : "v"(lo), "v"(hi), "s"(0xFFFFFFFF00000000ull)); return r; }
#define CE_DESC(a, b) do { const float hi_ = vmaxf(a, b), lo_ = vminf(a, b); a = hi_; b = lo_; } while (0)
__device__ __forceinline__ void sort16_desc(float (&v)[16]) {
#pragma unroll
    for (int k = 2; k <= 16; k <<= 1)
#pragma unroll
        for (int j = k >> 1; j > 0; j >>= 1)
#pragma unroll
            for (int i = 0; i < 16; ++i) { const int l = i ^ j; if (l > i) { if ((i & k) == 0) CE_DESC(v[i], v[l]); else CE_DESC(v[l], v[i]); } }
}
__device__ __forceinline__ void bitonic_merge16_desc(float (&v)[16]) {
#pragma unroll
    for (int j = 8; j > 0; j >>= 1)
#pragma unroll
        for (int i = 0; i < 16; ++i) { const int l = i ^ j; if (l > i) CE_DESC(v[i], v[l]); }
}
__device__ __forceinline__ void merge_top16(float (&a)[16], const float (&b)[16]) {
#pragma unroll
    for (int i = 0; i < 16; ++i) a[i] = vmaxf(a[i], b[15 - i]);
    bitonic_merge16_desc(a);
}
__device__ __forceinline__ void merge_partner_top16(float (&a)[16]) {
    float p[16];
#pragma unroll
    for (int i = 0; i < 16; ++i) { const unsigned x = __float_as_uint(a[15 - i]); auto rr = __builtin_amdgcn_permlane32_swap(x, x, false, false); p[i] = selhi(__uint_as_float(rr[1]), __uint_as_float(rr[0])); }
#pragma unroll
    for (int i = 0; i < 16; ++i) a[i] = vmaxf(a[i], p[i]);
    bitonic_merge16_desc(a);
}
__device__ __forceinline__ void topk_half(int half, const bf16x8 (&qf)[8], int r32, int hi, const LAS unsigned char* ksl, float (&top)[16]) {
#pragma unroll 1
    for (int kt = 0; kt < 4; ++kt) {
        f32x16 acc = f32x16{};
        const int row = half * 128 + kt * 32 + r32; const LAS unsigned char* rp = ksl + row * 256; const int sw = row & 15;
#pragma unroll
        for (int ks = 0; ks < 8; ++ks) { const bf16x8 a = *(const LAS bf16x8*)(rp + (((2 * ks + hi) ^ sw) << 4));
            acc = __builtin_amdgcn_mfma_f32_32x32x16_bf16(a, qf[ks], acc, 0, 0, 0); }
        float grp[16];
#pragma unroll
        for (int r = 0; r < 16; ++r) { const unsigned key = (unsigned)(kt * 32 + (r & 3) + 8 * (r >> 2)) + 4u * (unsigned)hi; grp[r] = __uint_as_float((__float_as_uint(acc[r]) & ~127u) | key); }
        sort16_desc(grp);
        if (kt == 0) {
#pragma unroll
            for (int i = 0; i < 16; ++i) top[i] = grp[i];
        } else merge_top16(top, grp);
    }
    merge_partner_top16(top);
}
__device__ __forceinline__ void topk_task(int tt, int hd, int lane, LAS unsigned char* scr, const bf16* PQb, const LAS unsigned char* ksl, const float* ssq1, int* ids, float* gts, float* rstd1) {
    const int r32 = lane & 31, hi = lane >> 5; const bool hib = hi != 0;
    const int token = tt * 32 + r32;
    float v0_[16], v1_[16];
    bf16x8 qf0[8], qf1[8];
#pragma unroll
    for (int ks = 0; ks < 8; ++ks) { qf0[ks] = *(const GAS bf16x8*)(PQb + (size_t)token * PQ + hd * 256 + ks * 16 + hi * 8); qf1[ks] = *(const GAS bf16x8*)(PQb + (size_t)token * PQ + hd * 256 + 128 + ks * 16 + hi * 8); }
    topk_half(0, qf0, r32, hi, ksl, v0_);
    topk_half(1, qf1, r32, hi, ksl, v1_);
#define v_SEL(h, i) ((h) ? v1_[i] : v0_[i])
    LAS unsigned char* slot = scr + lane * 32;
    { v4u d0, d1;
#define PK4(h, k) ((__float_as_uint(v_SEL(h, 4 * (k))) & 127u) | ((__float_as_uint(v_SEL(h, 4 * (k) + 1)) & 127u) << 8) | ((__float_as_uint(v_SEL(h, 4 * (k) + 2)) & 127u) << 16) | ((__float_as_uint(v_SEL(h, 4 * (k) + 3)) & 127u) << 24))
      d0 = (v4u){PK4(0, 0), PK4(0, 1), PK4(0, 2), PK4(0, 3)}; d1 = (v4u){PK4(1, 0), PK4(1, 1), PK4(1, 2), PK4(1, 3)};
#undef PK4
      *(LAS v4u*)slot = d0; *(LAS v4u*)(slot + 16) = d1; }
    float a[16], b[16];
#pragma unroll
    for (int i = 0; i < 16; ++i) { a[i] = selhi(v0_[i], v1_[i]); b[i] = selhi(v1_[i], v0_[i]); }
    const unsigned obit = (unsigned)hi << 8;
#define CAND(i, j) __uint_as_float((__float_as_uint(a[i] + b[j]) & ~511u) | obit | (unsigned)(((i) << 4) | (j)))
    const float NEGBIG = -3.0e38f;
    float g0[16], g1[16];
#pragma unroll
    for (int j = 1; j < 16; ++j) g0[j - 1] = CAND(0, j);
    g0[15] = CAND(1, 2);
    g1[0] = CAND(1, 3); g1[1] = CAND(1, 4); g1[2] = CAND(1, 5); g1[3] = CAND(1, 6); g1[4] = CAND(1, 7); g1[5] = CAND(2, 3); g1[6] = CAND(2, 4);
    { const float c0 = CAND(0, 0), c1 = CAND(1, 1), c2 = CAND(2, 2), c3 = CAND(3, 3);
      g1[7] = selhi(c0, NEGBIG); g1[8] = selhi(c1, NEGBIG); g1[9] = selhi(c2, NEGBIG); g1[10] = selhi(c3, NEGBIG); }
#pragma unroll
    for (int i = 11; i < 16; ++i) g1[i] = NEGBIG;
#undef CAND
    sort16_desc(g0); sort16_desc(g1); merge_top16(g0, g1); merge_partner_top16(g0);
    float rstd;
    { const GAS f32x4* sp = (const GAS f32x4*)(ssq1 + (size_t)token * 16); const f32x4 s0 = sp[0], s1 = sp[1], s2 = sp[2], s3 = sp[3];
      const float ss = ((s0.x + s0.y) + (s0.z + s0.w)) + ((s1.x + s1.y) + (s1.z + s1.w)) + ((s2.x + s2.y) + (s2.z + s2.w)) + ((s3.x + s3.y) + (s3.z + s3.w));
      rstd = 1.0f / sqrtf(ss * (1.f / DMODEL) + RMS_EPS); }
    if (hd == 0 && !hib) rstd1[token] = rstd;
    float ex[16], esum = 0.f; const float sc = rstd * 1.4426950409f;
#pragma unroll
    for (int k = 0; k < 16; ++k) { ex[k] = __builtin_amdgcn_exp2f((g0[k] - g0[0]) * sc); esum += ex[k]; }
    const float inv = 1.0f / esum;
    int eid[8]; float gv[8];
#pragma unroll
    for (int k = 0; k < 8; ++k) { const float wv = selhi(g0[k], g0[8 + k]); const float ev = selhi(ex[k], ex[8 + k]);
        const unsigned tag = __float_as_uint(wv) & 511u, o = tag >> 8, i = (tag >> 4) & 15u, j = tag & 15u; const unsigned i1 = o ? j : i, i2 = o ? i : j;
        const unsigned k1 = slot[i1], k2 = slot[16 + i2];
        eid[k] = (int)(k1 * 128u + k2); gv[k] = ev * inv; }
    { int* ip = ids + (size_t)token * 128 + hd * 16 + 8 * hi; float* gp = gts + (size_t)token * 128 + hd * 16 + 8 * hi;
      *(GAS v4u*)ip = (v4u){(unsigned)eid[0], (unsigned)eid[1], (unsigned)eid[2], (unsigned)eid[3]}; *(GAS v4u*)(ip + 4) = (v4u){(unsigned)eid[4], (unsigned)eid[5], (unsigned)eid[6], (unsigned)eid[7]};
      *(GAS f32x4*)gp = (f32x4){gv[0], gv[1], gv[2], gv[3]}; *(GAS f32x4*)(gp + 4) = (f32x4){gv[4], gv[5], gv[6], gv[7]}; }
    LDS_WAIT(); asm volatile("" ::: "memory");
}


__device__ __forceinline__ float dot2bf(unsigned a, unsigned b, float c) { return __builtin_amdgcn_fdot2_f32_bf16(__builtin_bit_cast(bf16x2_t, a), __builtin_bit_cast(bf16x2_t, b), c, false); }
__device__ __forceinline__ h2_t fma_h2(unsigned v, h2_t w, h2_t acc) { return __builtin_elementwise_fma(__builtin_bit_cast(h2_t, v), w, acc); }
__device__ __forceinline__ unsigned fp8lo_bf(unsigned w, float sc) { return __builtin_bit_cast(unsigned, __builtin_amdgcn_cvt_scalef32_pk_bf16_fp8((int)w, sc, false)); }
__device__ __forceinline__ unsigned fp8hi_bf(unsigned w, float sc) { return __builtin_bit_cast(unsigned, __builtin_amdgcn_cvt_scalef32_pk_bf16_fp8((int)w, sc, true)); }
__device__ __forceinline__ h2_t fp8lo_h(unsigned w, float sc) { return __builtin_amdgcn_cvt_scalef32_pk_f16_fp8((int)w, sc, false); }
__device__ __forceinline__ h2_t fp8hi_h(unsigned w, float sc) { return __builtin_amdgcn_cvt_scalef32_pk_f16_fp8((int)w, sc, true); }
__device__ __forceinline__ unsigned pack_fp8x4(float a, float b, float c, float d) { int w = __builtin_amdgcn_cvt_pk_fp8_f32(a, b, 0, false); w = __builtin_amdgcn_cvt_pk_fp8_f32(c, d, w, true); return (unsigned)w; }
constexpr size_t V6B_OFF = 8u << 20;
constexpr float U8_SCALE = 64.0f, V8_SCALE = 5.656854f;
constexpr int PA_CAP = 456;
constexpr float X8_SCALE = 2.0f;
typedef int v8i_t __attribute__((ext_vector_type(8)));
typedef _Float16 v32h_t __attribute__((ext_vector_type(32)));
typedef unsigned v6u_t __attribute__((ext_vector_type(6)));
typedef unsigned v2u __attribute__((ext_vector_type(2)));
struct TokB { v8i_t b[8]; };
struct RowsA { const unsigned char* p0; const unsigned char* p1; };
__device__ __forceinline__ int pa_tok(unsigned tl, int tb, int nwg) { return ((tl < 4u) ? tb : nwg) + (int)(tl & 3u); }
__device__ __forceinline__ RowsA pa_rows(int b, int n, int lane, const LAS unsigned* list, const unsigned char* U6) {
    const int i0 = b * 16 + (lane >> 3), r8 = lane >> 3, ps = lane & 7;
    const unsigned e0 = list[i0 < n ? i0 : 0], e1 = list[i0 + 8 < n ? i0 + 8 : 0];
    RowsA R; R.p0 = U6 + (size_t)(e0 & 0x3fffu) * 768 + ((ps ^ r8) * 16); R.p1 = U6 + (size_t)(e1 & 0x3fffu) * 768 + ((ps ^ r8 ^ 1) * 16);
    return R;
}
template <int J> __device__ __forceinline__ void pa_dma(const RowsA& R, LAS unsigned char* ring) {
    __builtin_amdgcn_global_load_lds((const unsigned*)R.p0, (LAS unsigned*)(ring + J * (2048 - 128)), 16, J * 128, 0);
    __builtin_amdgcn_global_load_lds((const unsigned*)R.p1, (LAS unsigned*)(ring + J * (2048 - 128) + 1024), 16, J * 128, 0);
}
#define PA_VWAIT(n) asm volatile("s_waitcnt vmcnt(" #n ")" ::: "memory")
#define PA_LWAIT(n) asm volatile("s_waitcnt lgkmcnt(" #n ")" ::: "memory")
__device__ __forceinline__ int pa_uoff(int u, int r) { return (u >> 4) * 2048 + (r >> 3) * 1024 + (r & 7) * 128 + ((((u >> 1) & 7) ^ (r & 7) ^ (r >> 3)) << 4) + (u & 1) * 8; }
struct OpA { v2u d0, d1, d2; };
__device__ __forceinline__ OpA pa_rd(int m, const LAS unsigned char* ring, int r, int g) { const int u = 12 * m + 3 * g; OpA a;
    a.d0 = *(const LAS v2u*)(ring + pa_uoff(u, r)); a.d1 = *(const LAS v2u*)(ring + pa_uoff(u + 1, r)); a.d2 = *(const LAS v2u*)(ring + pa_uoff(u + 2, r)); return a; }
__device__ __forceinline__ f32x4 pa_mm(f32x4 acc, const OpA& a, const TokB& X, int m) {
    return __builtin_amdgcn_mfma_scale_f32_16x16x128_f8f6f4((v8i_t){(int)a.d0.x, (int)a.d0.y, (int)a.d1.x, (int)a.d1.y, (int)a.d2.x, (int)a.d2.y, 0, 0}, X.b[m], acc, 2, 2, 0, 0, 0, 0);
}
__device__ __forceinline__ void pa_flush(int n, const TokB& X, int lane, LAS unsigned* list, const LAS unsigned* gl, LAS unsigned char* ring, const unsigned char* U6, unsigned* wpk, int tb, int nwg) {
    if (n == 0) return;
    LDS_WAIT(); asm volatile("" ::: "memory");
    const int nb = (n + 15) >> 4;
    const int r = lane & 15, g = lane >> 4;
    RowsA cur = pa_rows(0, n, lane, list, U6), nxt = cur;
    pa_dma<0>(cur, ring); pa_dma<1>(cur, ring); pa_dma<2>(cur, ring); pa_dma<3>(cur, ring); pa_dma<4>(cur, ring); pa_dma<5>(cur, ring);
    for (int b = 0; b < nb; ++b) {
        f32x4 acc0 = {0.f, 0.f, 0.f, 0.f}, acc1 = {0.f, 0.f, 0.f, 0.f};
        OpA A0, A1;
        if (b + 1 < nb) {
            nxt = pa_rows(b + 1, n, lane, list, U6);
            PA_VWAIT(10); A0 = pa_rd(0, ring, r, g);
            PA_VWAIT(8);  A1 = pa_rd(1, ring, r, g); PA_LWAIT(3); acc0 = pa_mm(acc0, A0, X, 0);
            PA_VWAIT(6);  A0 = pa_rd(2, ring, r, g); PA_LWAIT(3); acc1 = pa_mm(acc1, A1, X, 1); pa_dma<0>(nxt, ring);
                          A1 = pa_rd(3, ring, r, g); PA_LWAIT(3); acc0 = pa_mm(acc0, A0, X, 2); pa_dma<1>(nxt, ring);
            PA_VWAIT(8);  A0 = pa_rd(4, ring, r, g); PA_LWAIT(3); acc1 = pa_mm(acc1, A1, X, 3); pa_dma<2>(nxt, ring);
            PA_VWAIT(8);  A1 = pa_rd(5, ring, r, g); PA_LWAIT(3); acc0 = pa_mm(acc0, A0, X, 4);
            PA_VWAIT(6);  A0 = pa_rd(6, ring, r, g); PA_LWAIT(3); acc1 = pa_mm(acc1, A1, X, 5); pa_dma<3>(nxt, ring);
                          A1 = pa_rd(7, ring, r, g); PA_LWAIT(3); acc0 = pa_mm(acc0, A0, X, 6); pa_dma<4>(nxt, ring);
                                                     PA_LWAIT(0); acc1 = pa_mm(acc1, A1, X, 7); pa_dma<5>(nxt, ring);
            cur = nxt;
        } else {
            PA_VWAIT(0);
            A0 = pa_rd(0, ring, r, g);
#pragma unroll
            for (int m = 0; m < 8; m += 2) { A1 = pa_rd(m + 1, ring, r, g); PA_LWAIT(3); acc0 = pa_mm(acc0, A0, X, m);
                if (m + 2 < 8) { A0 = pa_rd(m + 2, ring, r, g); PA_LWAIT(3); } else PA_LWAIT(0);
                acc1 = pa_mm(acc1, A1, X, m + 1); }
        }
        const f32x4 acc = acc0 + acc1;
        const int idx = b * 16 + r; const unsigned ent = list[idx], tl = ent >> 21, slot = (ent >> 14) & 127u;
        const int src = (int)((((unsigned)r >> 2) * 16u + tl) << 2);
        const float v0 = __int_as_float(__builtin_amdgcn_ds_bpermute(src, __float_as_int(acc.x))), v1 = __int_as_float(__builtin_amdgcn_ds_bpermute(src, __float_as_int(acc.y)));
        const float v2 = __int_as_float(__builtin_amdgcn_ds_bpermute(src, __float_as_int(acc.z))), v3 = __int_as_float(__builtin_amdgcn_ds_bpermute(src, __float_as_int(acc.w)));
        const float dv = (r & 2) ? ((r & 1) ? v3 : v2) : ((r & 1) ? v1 : v0);
        if (lane < 16 && idx < n) { const int t = pa_tok(tl, tb, nwg);
            const _Float16 wh = (_Float16)(__uint_as_float(gl[tl * 128 + slot]) * (1.0f / V8_SCALE) * gelu_tanh(dv * (1.0f / (U8_SCALE * X8_SCALE))));
            const unsigned pos = __hip_atomic_fetch_add((LAS unsigned*)(list + PA_CAP) + tl, 1u, __ATOMIC_RELAXED, __HIP_MEMORY_SCOPE_WAVEFRONT);
            wpk[(size_t)t * 128 + pos] = ((unsigned)__builtin_bit_cast(unsigned short, wh) << 16) | (ent & 0x3fffu); }
    }
    LDS_WAIT(); asm volatile("" ::: "memory");
}
__device__ __forceinline__ void peer_a_phase(int lane, int wave, int G, int vcu, const bf16* XG, const unsigned char* U6, const int* ids, const float* gts, const float* rstd1, unsigned* wpk, LAS unsigned char* lds, int emask) {
    (void)emask;
    LAS unsigned char* ring = lds + RING_OFF + wave * 16384;
    LAS unsigned* gl = (LAS unsigned*)(ring + 12288);
    LAS unsigned* list = (LAS unsigned*)(lds + MISC_OFF + 128 + wave * (464 * 4));
    for (int tile0 = vcu; tile0 < MTOK / 32; tile0 += 2 * G) {
        const int tile1 = tile0 + G; const bool has1 = tile1 < MTOK / 32;
        const int tb = tile0 * 32 + wave * 4, nwg = (has1 ? tile1 : tile0) * 32 + wave * 4;
        int id0[8], id1[8];
        if (lane < 8) list[PA_CAP + lane] = 0u;
#pragma unroll
        for (int k = 0; k < 8; ++k) { const bool ok = (k < 4) || has1; const int tc = pa_tok((unsigned)k, tb, nwg);
            gl[k * 128 + lane] = __float_as_uint(gts[(size_t)tc * 128 + lane]); gl[k * 128 + 64 + lane] = __float_as_uint(gts[(size_t)tc * 128 + 64 + lane]);
            id0[k] = ok ? ids[(size_t)tc * 128 + lane] : -1; id1[k] = ok ? ids[(size_t)tc * 128 + 64 + lane] : -1; }
#pragma unroll
        for (int p = 0; p < 4; ++p) { const int k = 2 * p + (lane >> 5), tc = pa_tok((unsigned)k, tb, nwg);
            typedef float v16f_t __attribute__((ext_vector_type(16)));
            const GAS v4u* xs = (const GAS v4u*)(XG + (size_t)tc * 1024 + 32 * (lane & 31));
            const v4u x0 = xs[0], x1 = xs[1], x2 = xs[2], x3 = xs[3];
            const float rs = rstd1[tc] * X8_SCALE;
            const unsigned w[16] = {x0.x, x0.y, x0.z, x0.w, x1.x, x1.y, x1.z, x1.w, x2.x, x2.y, x2.z, x2.w, x3.x, x3.y, x3.z, x3.w};
            float f[32];
#pragma unroll
            for (int i = 0; i < 16; ++i) { f[2 * i] = __uint_as_float(w[i] << 16) * rs; f[2 * i + 1] = __uint_as_float(w[i] & 0xffff0000u) * rs; }
            const v16f_t lo16 = {f[0], f[1], f[2], f[3], f[4], f[5], f[6], f[7], f[8], f[9], f[10], f[11], f[12], f[13], f[14], f[15]},
                         hi16 = {f[16], f[17], f[18], f[19], f[20], f[21], f[22], f[23], f[24], f[25], f[26], f[27], f[28], f[29], f[30], f[31]};
            v6u_t p6; asm volatile("s_nop 1\n\tv_cvt_scalef32_2xpk16_fp6_f32 %0, %1, %2, 1.0" : "=&v"(p6) : "v"(lo16), "v"(hi16));
            LAS v2u* dst = (LAS v2u*)(ring + k * 768 + 24 * (lane & 31)); dst[0] = (v2u){p6[0], p6[1]}; dst[1] = (v2u){p6[2], p6[3]}; dst[2] = (v2u){p6[4], p6[5]}; }
        LDS_WAIT(); asm volatile("" ::: "memory");
        TokB X;
#pragma unroll
        for (int m = 0; m < 8; ++m) { const LAS v2u* xp = (const LAS v2u*)(ring + (lane & 7) * 768 + m * 96 + (lane >> 4) * 24);
            const v2u d0 = xp[0], d1 = xp[1], d2 = xp[2];
            X.b[m] = (v8i_t){(int)d0.x, (int)d0.y, (int)d1.x, (int)d1.y, (int)d2.x, (int)d2.y, 0, 0}; }
        LDS_WAIT(); asm volatile("" ::: "memory");
        int n = 0;
        for (int part = 0; part < 8; ++part) {
#pragma unroll
            for (int k = 0; k < 8; ++k) {
                { const bool sel = (id0[k] >> 11) == part; const unsigned long long m = __ballot(sel);
                  const int pos = n + (int)__builtin_amdgcn_mbcnt_hi((unsigned)(m >> 32), __builtin_amdgcn_mbcnt_lo((unsigned)m, 0u));
                  if (sel) list[pos] = ((unsigned)k << 21) | ((unsigned)lane << 14) | (unsigned)id0[k]; n += __builtin_popcountll(m); }
                { const bool sel = (id1[k] >> 11) == part; const unsigned long long m = __ballot(sel);
                  const int pos = n + (int)__builtin_amdgcn_mbcnt_hi((unsigned)(m >> 32), __builtin_amdgcn_mbcnt_lo((unsigned)m, 0u));
                  if (sel) list[pos] = ((unsigned)k << 21) | ((unsigned)(64 + lane) << 14) | (unsigned)id1[k]; n += __builtin_popcountll(m); }
                if (n > PA_CAP - 128) { pa_flush(n, X, lane, list, gl, ring, U6, wpk, tb, nwg); n = 0; }
            }
        }
        pa_flush(n, X, lane, list, gl, ring, U6, wpk, tb, nwg);
    }
}
__device__ __forceinline__ void final_token(int t, int lane, const unsigned short* Y16, float* X1, const float* fg) {
    GAS f32x4* xp = (GAS f32x4*)(X1 + (size_t)t * 1024 + 8 * lane);
    f32x4 x0 = xp[0], x1 = xp[1], x2 = xp[128], x3 = xp[129];
    const v4u ya = *(const GAS v4u*)(Y16 + (size_t)t * 1024 + 8 * lane), yb = *(const GAS v4u*)(Y16 + (size_t)t * 1024 + 512 + 8 * lane);
    const unsigned yw[8] = {ya.x, ya.y, ya.z, ya.w, yb.x, yb.y, yb.z, yb.w};
    float y[16];
#pragma unroll
    for (int i = 0; i < 8; ++i) { const unsigned w = yw[i]; const h2_t h = __builtin_bit_cast(h2_t, w); y[2 * i] = (float)h[0]; y[2 * i + 1] = (float)h[1]; }
    x0 += (f32x4){y[0], y[1], y[2], y[3]}; x1 += (f32x4){y[4], y[5], y[6], y[7]}; x2 += (f32x4){y[8], y[9], y[10], y[11]}; x3 += (f32x4){y[12], y[13], y[14], y[15]};
    float ss = (x0.x * x0.x + x0.y * x0.y) + (x0.z * x0.z + x0.w * x0.w) + (x1.x * x1.x + x1.y * x1.y) + (x1.z * x1.z + x1.w * x1.w)
             + (x2.x * x2.x + x2.y * x2.y) + (x2.z * x2.z + x2.w * x2.w) + (x3.x * x3.x + x3.y * x3.y) + (x3.z * x3.z + x3.w * x3.w);
    const float rstd2 = 1.0f / sqrtf(wave_sum(ss) * (1.f / DMODEL) + RMS_EPS);
    const GAS f32x4* gp = (const GAS f32x4*)(fg + 8 * lane);
    xp[0] = x0 * rstd2 * gp[0]; xp[1] = x1 * rstd2 * gp[1]; xp[128] = x2 * rstd2 * gp[128]; xp[129] = x3 * rstd2 * gp[129];
}
#ifndef REP_0
#define REP_0 1
#endif
#ifndef REP_1
#define REP_1 1
#endif
#ifndef REP_2
#define REP_2 1
#endif
#ifndef REP_3
#define REP_3 1
#endif
#ifndef REP_4
#define REP_4 1
#endif
#ifndef REP_5
#define REP_5 1
#endif
#ifndef REP_6
#define REP_6 1
#endif
#ifndef REP_7
#define REP_7 1
#endif
#ifndef REP_8
#define REP_8 1
#endif
#ifndef REP_9
#define REP_9 1
#endif
#ifndef REP_10
#define REP_10 1
#endif
#ifndef REP_11
#define REP_11 1
#endif
__device__ __forceinline__ void pb_rows(v4u* Ra, v2u* Rb, const v4u w, const unsigned char* vbase, size_t vboff) {
    const unsigned pw[4] = {w.x, w.y, w.z, w.w};
#pragma unroll
    for (int i = 0; i < 4; ++i) { const size_t e = pw[i] & 0xffffu; Ra[i] = *(const GAS v4u*)(vbase + e * 256); Rb[i] = *(const GAS v2u*)(vbase + vboff + e * 128); }
}
__device__ __forceinline__ void pb_fma(h2_t (&acc)[16], const v4u* Ra, const v2u* Rb, const v4u w) {
    const unsigned pw[4] = {w.x, w.y, w.z, w.w};
#pragma unroll
    for (int i = 0; i < 4; ++i) { const unsigned p = pw[i], wb = (p & 0xffff0000u) | (p >> 16); const h2_t w2 = __builtin_bit_cast(h2_t, wb);
        const v4u ra = Ra[i]; const v2u rb = Rb[i]; const v6u_t x6 = {ra.x, ra.y, ra.z, ra.w, rb.x, rb.y};
        v32h_t h; asm("v_cvt_scalef32_pk32_f16_fp6 %0, %1, 1.0" : "=&v"(h) : "v"(x6));
#pragma unroll
        for (int j = 0; j < 16; ++j) { const h2_t hv = {h[2 * j], h[2 * j + 1]}; acc[j] = __builtin_elementwise_fma(hv, w2, acc[j]); } }
}
__device__ __forceinline__ void peer_b_phase(int lane, int wave, int G, int vcu, const unsigned char* V6s, const unsigned* wpk, unsigned short* Y16, float* X1, const float* fg, bool fin) {
    const int q = lane & 15;
    for (int tile0 = vcu; tile0 < MTOK / 32; tile0 += 2 * G) {
        const int tile1 = tile0 + G; const bool has1 = tile1 < MTOK / 32;
        const int tb = tile0 * 32 + wave * 4, nwg = (has1 ? tile1 : tile0) * 32 + wave * 4;
        for (int pass = 0; pass < 4; ++pass) { const int hc = pass >> 1, k = (lane >> 4) + 4 * (pass & 1);
            const int t = pa_tok((unsigned)k, tb, nwg);
            const unsigned* wrow = wpk + (size_t)t * 128;
            const unsigned char* vbase = V6s + (size_t)hc * NEXP * 256 + q * 16;
            const size_t vboff = V6B_OFF + (size_t)hc * NEXP * 128 + q * 8 - ((size_t)hc * NEXP * 256 + q * 16);
            h2_t acc[16];
#pragma unroll
            for (int j = 0; j < 16; ++j) acc[j] = (h2_t){(_Float16)0.f, (_Float16)0.f};
            v4u W[6], Ra[16]; v2u Rb[16];
#pragma unroll
            for (int u = 0; u < 6; ++u) W[u] = *(const GAS v4u*)(wrow + 4 * u);
#pragma unroll
            for (int u = 0; u < 4; ++u) pb_rows(Ra + 4 * u, Rb + 4 * u, W[u], vbase, vboff);
#pragma unroll
            for (int u = 0; u < 32; ++u) {
                pb_fma(acc, Ra + 4 * (u & 3), Rb + 4 * (u & 3), W[u % 6]);
                if (u + 4 < 32) pb_rows(Ra + 4 * (u & 3), Rb + 4 * (u & 3), W[(u + 4) % 6], vbase, vboff);
                if (u + 6 < 32) W[u % 6] = *(const GAS v4u*)(wrow + 4 * (u + 6));
            }
            GAS v4u* yout = (GAS v4u*)(Y16 + (size_t)t * 1024 + hc * 512 + q * 32);
#pragma unroll
            for (int j = 0; j < 4; ++j) yout[j] = (v4u){__builtin_bit_cast(unsigned, acc[4 * j]), __builtin_bit_cast(unsigned, acc[4 * j + 1]), __builtin_bit_cast(unsigned, acc[4 * j + 2]), __builtin_bit_cast(unsigned, acc[4 * j + 3])};
        }
        asm volatile("s_waitcnt vmcnt(0)" ::: "memory");
        if (fin) for (int kk = 0; kk < (has1 ? 8 : 4); ++kk) final_token(pa_tok((unsigned)kk, tb, nwg), lane, Y16, X1, fg);
    }
}
template <int NR> __device__ __forceinline__ void convert_expert_rows(const float* table, int ex, int stride, bool isv, int lane, unsigned char* U8, unsigned char* V8) {
    if (!isv) {
        typedef float v16f_t __attribute__((ext_vector_type(16)));
        f32x4 q[NR / 2][8];
#pragma unroll
        for (int k = 0; k < NR / 2; ++k) { const int e = ex + (2 * k + (lane >> 5)) * stride; const float* src = table + (size_t)(e < NEXP ? e : ex) * 1024 + 32 * (lane & 31);
#pragma unroll
            for (int j = 0; j < 8; ++j) q[k][j] = *(const GAS f32x4*)(src + 4 * j); }
#pragma unroll
        for (int k = 0; k < NR / 2; ++k) { const int e = ex + (2 * k + (lane >> 5)) * stride; if (e < NEXP) {
            float f[32];
#pragma unroll
            for (int j = 0; j < 8; ++j) { const f32x4 t = q[k][j] * U8_SCALE; f[4 * j] = t.x; f[4 * j + 1] = t.y; f[4 * j + 2] = t.z; f[4 * j + 3] = t.w; }
            const v16f_t lo16 = {f[0], f[1], f[2], f[3], f[4], f[5], f[6], f[7], f[8], f[9], f[10], f[11], f[12], f[13], f[14], f[15]},
                         hi16 = {f[16], f[17], f[18], f[19], f[20], f[21], f[22], f[23], f[24], f[25], f[26], f[27], f[28], f[29], f[30], f[31]};
            v6u_t p6; asm volatile("s_nop 1\n\tv_cvt_scalef32_2xpk16_fp6_f32 %0, %1, %2, 1.0" : "=&v"(p6) : "v"(lo16), "v"(hi16));
            GAS v2u* dst = (GAS v2u*)(U8 + (size_t)e * 768 + 24 * (lane & 31)); dst[0] = (v2u){p6[0], p6[1]}; dst[1] = (v2u){p6[2], p6[3]}; dst[2] = (v2u){p6[4], p6[5]}; } }
        return;
    }
    {
        f32x4 q[NR / 2][8];
#pragma unroll
        for (int k = 0; k < NR / 2; ++k) { const int e = ex + (2 * k + (lane >> 5)) * stride; const float* src = table + (size_t)(e < NEXP ? e : ex) * 1024 + 32 * (lane & 31);
#pragma unroll
            for (int j = 0; j < 8; ++j) q[k][j] = *(const GAS f32x4*)(src + 4 * j); }
#pragma unroll
        for (int k = 0; k < NR / 2; ++k) { const int e = ex + (2 * k + (lane >> 5)) * stride; if (e < NEXP) {
            v32h_t h;
#pragma unroll
            for (int j = 0; j < 8; ++j) { const f32x4 t = q[k][j] * V8_SCALE; h[4 * j] = (_Float16)t.x; h[4 * j + 1] = (_Float16)t.y; h[4 * j + 2] = (_Float16)t.z; h[4 * j + 3] = (_Float16)t.w; }
            v6u_t p6; asm volatile("s_nop 1\n\tv_cvt_scalef32_pk32_fp6_f16 %0, %1, 1.0" : "=&v"(p6) : "v"(h));
            const size_t ro = (size_t)((lane & 31) >> 4) * NEXP + e;
            *(GAS v4u*)(V8 + ro * 256 + (lane & 15) * 16) = (v4u){p6[0], p6[1], p6[2], p6[3]}; *(GAS v2u*)(V8 + V6B_OFF + ro * 128 + (lane & 15) * 8) = (v2u){p6[4], p6[5]}; } }
    }
}
struct OnePanel { int pm, n; __device__ __forceinline__ bool next(int i, pg8::Unit& u) const { if (i >= n) return false; u.pm = pm; u.pn = i; u.w = 0; return true; } };
struct DualOrder { pg8::StaticOrder S; __device__ __forceinline__ bool next(int i, pg8::Unit& u) const { if (!S.next(i >> 1, u)) return false; u.w = i & 1; return true; } };
struct Args { const float* in[24]; float* out; unsigned char* ws; int ph_lo, ph_hi, li, pad; };
__global__ void __launch_bounds__(NWAVES * 64, 2) mk_fwd(Args args) {
    extern __shared__ __attribute__((aligned(16))) unsigned char lds[];
    Frame F;
    F.lds = (LAS unsigned char*)lds;
    volatile LAS unsigned* MISC = (volatile LAS unsigned*)(F.lds + MISC_OFF);
    F.tid = threadIdx.x; F.lane = F.tid & 63; F.wave = __builtin_amdgcn_readfirstlane(F.tid >> 6);
    F.G = gridDim.x; { const int bx = blockIdx.x; F.vcu = (F.G % 8 == 0) ? (bx % 8) * (F.G / 8) + bx / 8 : bx; }
    unsigned char* ws = args.ws;
    gu32* ctl = (gu32*)(ws + WS_CTL);
    for (int u = F.tid; u < (LDS_BYTES - LDSCTL_OFF) / 4; u += NWAVES * 64) ((LAS unsigned*)(F.lds + LDSCTL_OFF))[u] = 0u;
    __syncthreads();
    XcdBarrier bar; bar.bar = (unsigned*)(ctl + CW_BAR); bar.x = 0; bar.st = nullptr;
    if (N_LAUNCHES != PER_PHASE) bar = xcd_barrier_post((unsigned*)(ctl + CW_BAR), MISC + 8);
#define GRID_BAR() do { if (N_LAUNCHES != PER_PHASE) xcd_barrier(bar); } while (0)
    const int lo = args.ph_lo, hi = args.ph_hi;
#ifndef PH_MASK
#define PH_MASK 0xFFFF
#endif
#define IN(k) ((((PH_MASK) >> (k)) & 1) && lo <= (k) && (k) < hi)
#define BOTH(k) (IN(k) && IN((k) + 1))
    const int gw = F.vcu * NWAVES + F.wave, NGW = F.G * NWAVES;
    const int gtid = F.vcu * (NWAVES * 64) + F.tid, NTHR = F.G * NWAVES * 64;
    const float* x = args.in[0];
    bf16* Win_t = (bf16*)(ws + WS_WIN); bf16* Wq_t = (bf16*)(ws + WS_WQ); bf16* Wout_t = (bf16*)(ws + WS_WOUT); bf16* Wus_t = (bf16*)(ws + WS_WUS); bf16* Wua_t = (bf16*)(ws + WS_WUA);
    bf16* Wglu_t = (bf16*)(ws + WS_WGLU); bf16* KSb = (bf16*)(ws + WS_KS); bf16* WE = (bf16*)(ws + WS_WE); bf16* BP = (bf16*)(ws + WS_BP); bf16* AP = (bf16*)(ws + WS_AP);
    float* Eb = (float*)(ws + WS_E); bf16* Hb = (bf16*)(ws + WS_H); bf16* Ypre = (bf16*)(ws + WS_YPRE); bf16* Ya = (bf16*)(ws + WS_YA); bf16* XG = (bf16*)(ws + WS_XG);
    bf16* Zb = (bf16*)(ws + WS_Z); bf16* Qb = (bf16*)(ws + WS_Z + 1 * ZSTRIDE_B); bf16* Kb = (bf16*)(ws + WS_Z + 2 * ZSTRIDE_B); bf16* Vb = (bf16*)(ws + WS_Z + 3 * ZSTRIDE_B);
    bf16* GA = (bf16*)(ws + WS_Z + 4 * ZSTRIDE_B); bf16* GB = (bf16*)(ws + WS_Z + 6 * ZSTRIDE_B);
    bf16* Yb = (bf16*)(ws + WS_YB); bf16* Mrg = (bf16*)(ws + WS_MRG); bf16* PQb = (bf16*)(ws + WS_PQ); int* ids = (int*)(ws + WS_IDS); float* gts = (float*)(ws + WS_GTS);
    unsigned char* U8 = ws + WS_U16; unsigned char* V8 = ws + WS_V16; unsigned* wpk = (unsigned*)(ws + WS_WPK); float* rstd1 = (float*)(ws + WS_RSTD1); unsigned short* Y16 = (unsigned short*)(ws + WS_Y16);
    float* biasT = (float*)(ws + WS_BIAS); float* pw32 = (float*)(ws + WS_PW32); float* kpart = (float*)(ws + WS_KPART); float* Kg = (float*)(ws + WS_KG); float* ssq1 = (float*)(ws + WS_SSQ1);

    if (IN(0)) for (int rep_ = 0; rep_ < REP_0; ++rep_) {
        LAS float* scr = (LAS float*)(F.lds + RING_OFF + F.wave * 16384);
        constexpr int I_IN = (1024 / 64) * (4096 / 32), I_GLU = (512 / 64) * (512 / 32), I_UP = (512 / 64) * (1024 / 32), I_OUT = (1024 / 64) * (1024 / 32), I_Q = (1024 / 64) * (2048 / 32);
        constexpr int NITEMS = I_IN + I_GLU + 2 * I_UP + I_OUT + I_Q;
        for (int it = gw; it < NITEMS; it += NGW) {
            int r = it;
            if (r < I_IN) { p0_transpose_item(args.in[2], 1024, 4096, Win_t, scr, r, F.lane); continue; } r -= I_IN;
            if (r < I_GLU) { p0_transpose_item(args.in[11], 512, 512, Wglu_t, scr, r, F.lane); continue; } r -= I_GLU;
            if (r < I_UP) { p0_transpose_item(args.in[13], 512, 1024, Wus_t, scr, r, F.lane); continue; } r -= I_UP;
            if (r < I_UP) { p0_transpose_item(args.in[14], 512, 1024, Wua_t, scr, r, F.lane); continue; } r -= I_UP;
            if (r < I_OUT) { p0_transpose_item(args.in[16], 1024, 1024, Wout_t, scr, r, F.lane); continue; } r -= I_OUT;
            p0_transpose_item(args.in[18], 1024, 2048, Wq_t, scr, r, F.lane);
        }
        for (int it = gw; it < NGRP * CH; it += NGW)
            ssm_table_task(it >> 5, it & 31, F.lane, scr, args.in[3], args.in[4], args.in[5], args.in[6], args.in[7], args.in[8], args.in[9], Kg, WE, BP, pw32);
        for (int m = gw; m < MTOK; m += NGW * 4) rms_rows4_to_bf16(x, args.in[1], Hb, m, NGW, F.lane);
        for (int it = gw; it < 64; it += NGW) { const float* src = (it < 32 ? args.in[19] : args.in[20]) + (size_t)(it & 31) * 512 + 8 * F.lane;
            const f32x4 a = *(const GAS f32x4*)src, b = *(const GAS f32x4*)(src + 4);
            *(GAS v4u*)(KSb + (size_t)it * 512 + 8 * F.lane) = (v4u){pk2(a.x, a.y), pk2(a.z, a.w), pk2(b.x, b.y), pk2(b.z, b.w)}; }
        if (gw == 0) { for (int i = F.lane; i < 8 * 128; i += 64) { const int h = i >> 7, rel = i & 127; int bk;
                if (rel < 16) bk = rel; else { const float lg = logf((float)rel / 16.0f) / 2.0794415416798357f * 16.0f; bk = 16 + (int)lg; bk = bk < 0 ? 0 : (bk > 31 ? 31 : bk); }
                biasT[i] = (args.in[15][bk * 8 + h] - args.in[15][31 * 8 + h]) * 1.4426950408889634f; } }
        if (BOTH(0)) GRID_BAR();
    }

    if (IN(1)) for (int rep_ = 0; rep_ < REP_1; ++rep_) {
        const float* Dsk = args.in[10];
        for (int i0 = gtid; i0 < NGRP * 512 * 64; i0 += NTHR * 4) {
            f32x4 ka[4], kb[4];
#pragma unroll
            for (int q = 0; q < 4; ++q) { const int i = i0 + q * NTHR; const int ic = (i < NGRP * 512 * 64) ? i : i0; const int g = ic >> 15, m = (ic >> 6) & 511, k8 = ic & 63, j = m >> 4, ho = m & 15, jp = k8 >> 1, hi0 = (k8 & 1) * 8;
                const int lag = (jp <= j) ? j - jp : 0; const float* kp = Kg + ((size_t)(g * 32 + lag) * 256 + ho * 16 + hi0); ka[q] = *(const GAS f32x4*)kp; kb[q] = *(const GAS f32x4*)(kp + 4); }
#pragma unroll
            for (int q = 0; q < 4; ++q) { const int i = i0 + q * NTHR; if (i >= NGRP * 512 * 64) break; const int g = i >> 15, m = (i >> 6) & 511, k8 = i & 63, j = m >> 4, ho = m & 15, jp = k8 >> 1, hi0 = (k8 & 1) * 8;
                v4u o = (v4u){0u, 0u, 0u, 0u};
                if (jp <= j) { f32x4 a = ka[q], b = kb[q];
                    if (jp == j && (ho >> 3) == (hi0 >> 3)) { const float dv = Dsk[g * 16 + ho]; const int e = ho & 7;
                        a.x += (e == 0) ? dv : 0.f; a.y += (e == 1) ? dv : 0.f; a.z += (e == 2) ? dv : 0.f; a.w += (e == 3) ? dv : 0.f;
                        b.x += (e == 4) ? dv : 0.f; b.y += (e == 5) ? dv : 0.f; b.z += (e == 6) ? dv : 0.f; b.w += (e == 7) ? dv : 0.f; }
                    o = (v4u){pk2(a.x, a.y), pk2(a.z, a.w), pk2(b.x, b.y), pk2(b.z, b.w)}; }
                *(GAS v4u*)(BP + ((size_t)(g * 512 + m) * APK + k8 * 8)) = o; } }
        pg8::Gemm g{Hb, Win_t, MTOK, INCOLS, 1024, 1024, 1024, 1 << 30, 0};
        pg8::StaticOrder S; S.init(MTOK, INCOLS, F.G, (int)blockIdx.x);
        pg8::EpiIn E{Zb, AP, kpart};
        pg8::gemm_phase<pg8::EpiIn, pg8::StaticOrder, true>(F.lds + RING_OFF, g, S, E);
        if (BOTH(1)) GRID_BAR();
    }

    if (IN(2)) for (int rep_ = 0; rep_ < REP_2; ++rep_) {
        const int bx = (int)blockIdx.x;
        const bool shared = F.G < 4;
        const int nS = shared ? F.G : (F.G >= 256 ? 64 : F.G / 4), nA = shared ? F.G : F.G - nS;
        const bool inS = shared || bx < nS, inA = shared || bx >= nS; const int aidx = shared ? bx : bx - nS;
        if (inS) {
#pragma unroll 1
            for (int pm = bx; pm < MTOK / 256; pm += nS) {
                { pg8::Gemm g1{AP, WE, MTOK, 256, 512, APK, 512, 2, (size_t)256 * 512}; OnePanel S1{pm, 1}; pg8::EpiE E1{Eb};
                  pg8::gemm_phase<pg8::EpiE, OnePanel, true>(F.lds + RING_OFF, g1, S1, E1); }
                VM_WAIT(); __syncthreads();
                if (F.tid < 256) { const int gb = (pm >> 1) * 8 + (pm & 1) * 4 + (F.tid >> 6), g_ = gb >> 3, p = F.tid & 63; const size_t row0 = (size_t)gb * 64;
                    const float mr = pw32[g_ * 128 + p], mi = pw32[g_ * 128 + 64 + p]; float sr = 0.f, si = 0.f;
#pragma unroll 1
                    for (int c0 = 0; c0 < NCHUNK; c0 += 32) { float er[32], ei[32];
#pragma unroll
                        for (int c = 0; c < 32; ++c) { er[c] = Eb[(row0 + c0 + c) * 128 + p]; ei[c] = Eb[(row0 + c0 + c) * 128 + 64 + p]; }
#pragma unroll
                        for (int c = 0; c < 32; ++c) { bf16* ap = AP + (row0 + c0 + c) * APK + 512; ap[p] = (bf16)f2bf(sr); ap[64 + p] = (bf16)f2bf(si);
                            const float nr = mr * sr - mi * si + er[c], ni = mr * si + mi * sr + ei[c]; sr = nr; si = ni; } } }
                VM_WAIT(); __syncthreads();
                { pg8::Gemm g{AP, BP, MTOK, 512, APK, APK, APK, 2, (size_t)512 * APK}; OnePanel S3{pm, 2}; pg8::EpiY E{Ypre};
                  pg8::gemm_phase<pg8::EpiY, OnePanel, true>(F.lds + RING_OFF, g, S3, E); }
            }
        }
        if (inA) {
            static_assert(attn_body::ATTN_LDS_BYTES <= RING_BYTES, "attention LDS");
#pragma unroll 1
            for (int a = aidx; a < 192; a += nA) { const int ty = a >> 6, bh = a & 63;
#pragma unroll 1
                for (int i = 0; i < 4; ++i) { const int qb = (ty == 0) ? (i == 0 ? 7 : (i == 1 ? 2 : (i == 2 ? 0 : -1))) : (ty == 1) ? (i == 0 ? 6 : (i == 1 ? 4 : -1)) : (i == 0 ? 5 : (i == 1 ? 3 : (i == 2 ? 1 : -1)));
                    if (qb < 0) break;
                    attn_body::attn_unit<8>(bh >> 3, bh & 7, qb, (const attn_body::bf16*)Qb, (const attn_body::bf16*)Kb, (const attn_body::bf16*)Vb, (attn_body::bf16*)Yb, (char*)lds + RING_OFF, kpart, biasT); } }
        }
        if (BOTH(2)) GRID_BAR();
    }

    if (IN(3)) for (int rep_ = 0; rep_ < REP_3; ++rep_) {
        pg8::Gemm g{Ypre, Wglu_t, MTOK, 512, 512, 512, 512, 1 << 30, 0};
        pg8::StaticOrder S; S.init(MTOK, 512, F.G, (int)blockIdx.x);
        pg8::EpiGlu E{Ypre, Ya, args.in[12]};
        pg8::gemm_phase<pg8::EpiGlu, pg8::StaticOrder, true>(F.lds + RING_OFF, g, S, E);
        { const int nun = (MTOK / 256) * (512 / 256);
          const int nconv = (F.G > nun) ? F.G - nun : F.G, cidx = (F.G > nun) ? (int)blockIdx.x - nun : (int)blockIdx.x;
          if (cidx >= 0) for (int ex = cidx * NWAVES + F.wave; ex < 2 * NEXP; ex += nconv * NWAVES * 4) { const bool isv = ex >= NEXP; convert_expert_rows<4>(isv ? args.in[22] : args.in[21], isv ? ex - NEXP : ex, nconv * NWAVES, isv, F.lane, U8, V8); } }
        if (BOTH(3)) GRID_BAR();
    }

    if (IN(4)) for (int rep_ = 0; rep_ < REP_4; ++rep_) {
        pg8::Gemm g{Ya, Wus_t, MTOK, 1024, 512, 512, 512, 1 << 30, 0, Yb, Wua_t};
        DualOrder S; S.S.init(MTOK, 1024, F.G, (int)blockIdx.x);
        pg8::EpiMrgDual E{pg8::EpiMrg<0>{GA, Mrg}, pg8::EpiMrg<1>{GB, Mrg}};
        pg8::gemm_phase<pg8::EpiMrgDual, DualOrder, true>(F.lds + RING_OFF, g, S, E);
        if (BOTH(4)) GRID_BAR();
    }

    if (IN(5)) for (int rep_ = 0; rep_ < REP_5; ++rep_) {
        pg8::Gemm g{Mrg, Wout_t, MTOK, 1024, 1024, 1024, 1024, 1 << 30, 0}; pg8::StaticOrder S; S.init(MTOK, 1024, F.G, (int)blockIdx.x);
        pg8::EpiX1 E{x, args.out, XG, args.in[17], ssq1};
        pg8::gemm_phase<pg8::EpiX1, pg8::StaticOrder, true>(F.lds + RING_OFF, g, S, E);
        if (BOTH(5)) GRID_BAR();
    }

    if (IN(6)) for (int rep_ = 0; rep_ < REP_6; ++rep_) {
        pg8::Gemm g{XG, Wq_t, MTOK, PQ, 1024, 1024, 1024, 1 << 30, 0}; pg8::StaticOrder S; S.init(MTOK, PQ, F.G, (int)blockIdx.x);
        pg8::EpiPlain E{PQb, PQ};
        pg8::gemm_phase<pg8::EpiPlain, pg8::StaticOrder, true>(F.lds + RING_OFF, g, S, E);
        if (BOTH(6)) GRID_BAR();
    }

    if (IN(7)) for (int rep_ = 0; rep_ < REP_7; ++rep_) {
        LAS unsigned char* scr = F.lds + RING_OFF + F.wave * 2048;
        LAS unsigned char* ksl = F.lds + RING_OFF + 16384;
        for (int c = F.tid; c < 256 * 16; c += NWAVES * 64) { const int row = c >> 4, ch = c & 15; *(LAS v4u*)(ksl + row * 256 + ((ch ^ (row & 15)) << 4)) = *(const GAS v4u*)(KSb + row * 128 + ch * 8); }
        __syncthreads();
        for (int it = gw; it < (MTOK / 32) * 8; it += NGW) topk_task(it >> 3, it & 7, F.lane, scr, PQb, ksl, ssq1, ids, gts, rstd1);
        if (BOTH(7)) { VM_WAIT(); __syncthreads(); }
    }

    if (IN(8)) for (int rep_ = 0; rep_ < REP_8; ++rep_) {
        peer_a_phase(F.lane, F.wave, F.G, F.vcu, XG, U8, ids, gts, rstd1, wpk, F.lds, 0xffff);
        if (BOTH(8)) { VM_WAIT(); __syncthreads(); }
    }
    if (IN(9)) for (int rep_ = 0; rep_ < REP_9; ++rep_) {
        peer_b_phase(F.lane, F.wave, F.G, F.vcu, V8, wpk, Y16, args.out, args.in[23], rep_ == REP_9 - 1);
    }
#undef IN
#undef BOTH
#undef GRID_BAR
}

extern "C" void kernel_launch(void* const* d_in, const int* in_sizes, int n_in, void* d_out, int out_size, void* d_ws, size_t ws_size, hipStream_t stream) {
    static int grid = 0;
    if (grid == 0) {
        if (n_in != 24 || in_sizes[0] != MTOK * DMODEL || out_size != MTOK * DMODEL || ws_size < WS_END) { fprintf(stderr, "kernel_launch: unexpected shapes (n_in %d, in0 %d, out %d, ws %zu); nothing launched\n", n_in, n_in > 0 ? in_sizes[0] : -1, out_size, ws_size); grid = -1; return; }
        int dev = 0, cus = 0, per_cu = 0;
        if (hipGetDevice(&dev) != hipSuccess || hipDeviceGetAttribute(&cus, hipDeviceAttributeMultiprocessorCount, dev) != hipSuccess) { grid = -1; return; }
        if (hipFuncSetAttribute((const void*)mk_fwd, hipFuncAttributeMaxDynamicSharedMemorySize, LDS_BYTES) != hipSuccess) { fprintf(stderr, "kernel_launch: hipFuncSetAttribute failed\n"); grid = -1; return; }
        if (hipOccupancyMaxActiveBlocksPerMultiprocessor(&per_cu, (const void*)mk_fwd, NWAVES * 64, LDS_BYTES) != hipSuccess || per_cu < 1) { fprintf(stderr, "kernel_launch: occupancy query says %d blocks per CU\n", per_cu); }
        (void)hipGetLastError();
        grid = cus;
    }
    if (grid < 0) return;
    if (N_LAUNCHES != PER_PHASE) { if (hipMemsetAsync((char*)d_ws + WS_CTL, 0, CTL_ZERO_BYTES, stream) != hipSuccess) return; }
    Args a{};
    for (int i = 0; i < 24; ++i) a.in[i] = (const float*)d_in[i];
    a.out = (float*)d_out; a.ws = (unsigned char*)d_ws; a.pad = 0;
    if (N_LAUNCHES == PER_PHASE) {
        for (int li = 0; li < PER_PHASE; ++li) { a.ph_lo = li; a.ph_hi = li + 1; a.li = li; hipLaunchKernelGGL(mk_fwd, dim3(grid), dim3(NWAVES * 64), LDS_BYTES, stream, a); }
    } else {
        a.ph_lo = 0; a.ph_hi = PER_PHASE; a.li = 0;
        hipLaunchKernelGGL(mk_fwd, dim3(grid), dim3(NWAVES * 64), LDS_BYTES, stream, a);
    }
}
```

```cpp
#include <hip/hip_runtime.h>
#include <hip/hip_bf16.h>
#include <cstdio>
#include <cstdint>
#include <cmath>

#ifndef MK_N_LAUNCHES
#define MK_N_LAUNCHES 1
#endif

namespace pg8 {
#define PG8_LAS __attribute__((address_space(3)))
typedef unsigned short bf16_t;
typedef short bf16x8 __attribute__((ext_vector_type(8)));
typedef float f32x4 __attribute__((ext_vector_type(4)));
typedef unsigned u32x4 __attribute__((ext_vector_type(4)));
constexpr int BM = 256, BK = 64, HALF = 128, HTB = HALF * BK * 2, STAGE_BYTES = 8 * HTB, NXCD = 8, WGM = 8;

__host__ __device__ __forceinline__ int lds_byte(int r, int c) { const int st = (r >> 4) * 2 + (c >> 5), rr = r & 15, cc = c & 31, ob = rr * 64 + cc * 2; return st * 1024 + (ob ^ (((ob >> 9) & 1) << 5)); }
__host__ __device__ __forceinline__ void stage_rc(int b, int& R, int& C) { const int st = b / 1024, sb = b % 1024, swz = sb ^ (((sb >> 9) & 1) << 5); R = (st >> 1) * 16 + swz / 64; C = (st & 1) * 32 + (swz % 64) / 2; }
__host__ __device__ __forceinline__ int perm32(int rho) { const int n = rho >> 4, i = rho & 15; return 8 * (i >> 2) + 4 * n + (i & 3); }

struct Unit { int pm, pn, w; };
struct Gemm { const bf16_t* A; const bf16_t* Bt; int M, N, K, lda, ldb, rpg; size_t bgs; const bf16_t* A2 = nullptr; const bf16_t* Bt2 = nullptr; };

struct StaticOrder {
    int nM, nN, nwg, G, c;
    __host__ __device__ __forceinline__ void init(int M, int N, int G_, int c_) { nM = M / BM; nN = N / BM; nwg = nM * nN; G = G_; c = c_; }
    __host__ __device__ __forceinline__ bool next(int i, Unit& u) const {
        const long L = (long)i * G + c; if (L >= nwg) return false;
        int wgid = (int)L; { const int q = nwg / NXCD, r = nwg % NXCD, xcd = wgid % NXCD, off = wgid / NXCD; wgid = (xcd < r ? xcd * (q + 1) : r * (q + 1) + (xcd - r) * q) + off; }
        const int nig = WGM * nN, gid = wgid / nig, fm = gid * WGM, gsz = (nM - fm) < WGM ? (nM - fm) : WGM;
        u.pm = fm + ((wgid % nig) % gsz); u.pn = (wgid % nig) / gsz; u.w = 0; return true;
    }
};

__device__ __forceinline__ unsigned cvt_pk_bf16(float lo, float hi) { unsigned r; asm volatile("v_cvt_pk_bf16_f32 %0, %1, %2" : "=v"(r) : "v"(lo), "v"(hi)); return r; }
__device__ __forceinline__ float bf_lo(unsigned w) { return __uint_as_float(w << 16); }
__device__ __forceinline__ float bf_hi(unsigned w) { return __uint_as_float(w & 0xffff0000u); }
__device__ __forceinline__ float sigmoid_f(float x) { return __builtin_amdgcn_rcpf(1.0f + __builtin_amdgcn_exp2f(-1.4426950409f * x)); }
__device__ __forceinline__ float gelu_tanh(float x) { const float u = x + 0.044715f * x * x * x; return x * __builtin_amdgcn_rcpf(1.0f + __builtin_amdgcn_exp2f(-2.3022081985f * u)); }

template <class Epi, class Sched, bool ALIGN_EPI>
__device__ __forceinline__ void gemm_phase(PG8_LAS unsigned char* lds, const Gemm g, const Sched& S, const Epi& E) {
    int tid = threadIdx.x; asm volatile("" : "+v"(tid));
    const int wid = __builtin_amdgcn_readfirstlane(tid >> 6), lane = tid & 63, wr = wid >> 2, wc = wid & 3, fr = lane & 15, fq = lane >> 4;
    const int K = g.K, nt = K / BK;
    unsigned voffA[2], voffB[2];
#pragma unroll
    for (int i = 0; i < 2; ++i) { int R, C; stage_rc(tid * 16 + i * 8192, R, C); const int Rb = Epi::PERM ? ((R & ~31) + perm32(R & 31)) : R;
        voffA[i] = (unsigned)(R * g.lda + C) * 2u; voffB[i] = (unsigned)(Rb * g.ldb + C) * 2u; }
    const size_t kstep = (size_t)(BK * 2);
    const size_t hstepA = (size_t)HALF * g.lda * 2, hstepB = (size_t)HALF * g.ldb * 2;
    const size_t tstepA = 2 * hstepA, tstepB = 2 * hstepB;
    const unsigned ldsw = (unsigned)wid * 1024u;
    const int aoff = lds_byte(wr * 64 + fr, fq * 8), boff = lds_byte(wc * 32 + fr, fq * 8);
#define PG8_SA(b, h) (((b) * 2 + (h)) * HTB)
#define PG8_SB(b, h) ((4 + (b) * 2 + (h)) * HTB)
#define PG8_STAGE(bufoff, gbase, voff) do { _Pragma("unroll") for (int _i = 0; _i < 2; ++_i) \
        __builtin_amdgcn_global_load_lds((const unsigned*)((const char*)(gbase) + (voff)[_i]), (PG8_LAS unsigned*)(lds + (bufoff) + ldsw + _i * 8192), 16, 0, 0); } while (0)
#define PG8_LDA(dst, b, h) do { _Pragma("unroll") for (int m = 0; m < 4; ++m) _Pragma("unroll") for (int k = 0; k < 2; ++k) dst[m][k] = *(const PG8_LAS bf16x8*)(lds + PG8_SA(b, h) + aoff + m * 2048 + k * 1024); } while (0)
#define PG8_LDB(dst, b, h) do { _Pragma("unroll") for (int n = 0; n < 2; ++n) _Pragma("unroll") for (int k = 0; k < 2; ++k) dst[n][k] = *(const PG8_LAS bf16x8*)(lds + PG8_SB(b, h) + boff + n * 2048 + k * 1024); } while (0)
#define PG8_MMA(ai, bj, At, Bt) do { __builtin_amdgcn_s_setprio(1); _Pragma("unroll") for (int m = 0; m < 4; ++m) _Pragma("unroll") for (int n = 0; n < 2; ++n) _Pragma("unroll") for (int k = 0; k < 2; ++k) \
        acc[ai][bj][m][n] = __builtin_amdgcn_mfma_f32_16x16x32_bf16(Bt[n][k], At[m][k], acc[ai][bj][m][n], 0, 0, 0); __builtin_amdgcn_s_setprio(0); } while (0)
#define PG8_WAIT_V(n) asm volatile("s_waitcnt vmcnt(" #n ")" ::: "memory")
#define PG8_WAIT_L(n) asm volatile("s_waitcnt lgkmcnt(" #n ")" ::: "memory")
#define PG8_BAR __builtin_amdgcn_s_barrier()
#define PG8_SCHED __builtin_amdgcn_sched_barrier(0)
    Unit cur, nxt; int ui = 0;
    if (!S.next(0, cur)) return;
    f32x4 acc[2][2][4][2];
#pragma unroll
    for (int a = 0; a < 2; ++a)
#pragma unroll
        for (int b = 0; b < 2; ++b)
#pragma unroll
            for (int m = 0; m < 4; ++m)
#pragma unroll
                for (int n = 0; n < 2; ++n) acc[a][b][m][n] = (f32x4){0.f, 0.f, 0.f, 0.f};
    bf16x8 At[4][2], B0[2][2], B1[2][2];
    const char* cA = (const char*)(cur.w ? g.A2 : g.A) + (size_t)cur.pm * tstepA;
    const char* cB = (const char*)(cur.w ? g.Bt2 : g.Bt) + (size_t)(cur.pm / g.rpg) * g.bgs * 2 + (size_t)cur.pn * tstepB;
    PG8_STAGE(PG8_SB(0, 0), cB, voffB); PG8_STAGE(PG8_SB(0, 1), cB + hstepB, voffB); PG8_STAGE(PG8_SA(0, 0), cA, voffA); PG8_STAGE(PG8_SA(0, 1), cA + hstepA, voffA);
    if (wr == 1) PG8_BAR;
    PG8_WAIT_V(2); PG8_BAR;
    PG8_STAGE(PG8_SB(1, 0), cB + kstep, voffB); PG8_STAGE(PG8_SA(1, 0), cA + kstep, voffA); PG8_STAGE(PG8_SB(1, 1), cB + hstepB + kstep, voffB);
    PG8_WAIT_V(6); PG8_BAR;
    for (;;) {
        const bool has_next = S.next(ui + 1, nxt);
        const char* nA = has_next ? (const char*)(nxt.w ? g.A2 : g.A) + (size_t)nxt.pm * tstepA : cA;
        const char* nB = has_next ? (const char*)(nxt.w ? g.Bt2 : g.Bt) + (size_t)(nxt.pm / g.rpg) * g.bgs * 2 + (size_t)nxt.pn * tstepB : cB;
        for (int t = 0; t < nt; t += 2) {
            const bool last = (t == nt - 2);
            const char* a1 = cA + (size_t)(t + 1) * kstep;
            const char* a2 = last ? nA : cA + (size_t)(t + 2) * kstep; const char* b2 = last ? nB : cB + (size_t)(t + 2) * kstep;
            const char* a3 = a2 + kstep; const char* b3 = b2 + kstep;
            PG8_LDB(B0, 0, 0); PG8_LDB(B1, 0, 1); PG8_SCHED; PG8_LDA(At, 0, 0); PG8_STAGE(PG8_SA(1, 1), a1 + hstepA, voffA);
            PG8_WAIT_V(8); PG8_WAIT_L(0); PG8_BAR; PG8_MMA(0, 0, At, B0); PG8_MMA(0, 1, At, B1); PG8_BAR; PG8_SCHED;
            PG8_LDA(At, 0, 1); PG8_STAGE(PG8_SB(0, 0), b2, voffB); PG8_STAGE(PG8_SB(0, 1), b2 + hstepB, voffB); PG8_STAGE(PG8_SA(0, 0), a2, voffA);
            PG8_WAIT_V(8); PG8_WAIT_L(0); PG8_BAR; PG8_MMA(1, 0, At, B0); PG8_MMA(1, 1, At, B1); PG8_BAR; PG8_SCHED;
            PG8_LDB(B0, 1, 0); PG8_LDB(B1, 1, 1); PG8_SCHED; PG8_LDA(At, 1, 0); PG8_STAGE(PG8_SA(0, 1), a2 + hstepA, voffA);
            PG8_WAIT_V(8); PG8_WAIT_L(0); PG8_BAR; PG8_MMA(0, 0, At, B0); PG8_MMA(0, 1, At, B1); PG8_BAR; PG8_SCHED;
            PG8_LDA(At, 1, 1); PG8_STAGE(PG8_SB(1, 0), b3, voffB); PG8_STAGE(PG8_SB(1, 1), b3 + hstepB, voffB); PG8_STAGE(PG8_SA(1, 0), a3, voffA);
            PG8_WAIT_V(8); PG8_WAIT_L(0); PG8_BAR; PG8_MMA(1, 0, At, B0); PG8_MMA(1, 1, At, B1); PG8_BAR; PG8_SCHED;
        }
        if constexpr (ALIGN_EPI) { if (wr == 0) PG8_BAR; }
        E(acc, cur, wr, wc, fr, fq);
        if (!has_next) break;
#pragma unroll
        for (int a = 0; a < 2; ++a)
#pragma unroll
            for (int b = 0; b < 2; ++b)
#pragma unroll
                for (int m = 0; m < 4; ++m)
#pragma unroll
                    for (int n = 0; n < 2; ++n) acc[a][b][m][n] = (f32x4){0.f, 0.f, 0.f, 0.f};
        cur = nxt; cA = nA; cB = nB; ++ui;
        if constexpr (ALIGN_EPI) { if (wr == 1) PG8_BAR; }
    }
    PG8_WAIT_V(0);
    if constexpr (!ALIGN_EPI) { if (wr == 0) PG8_BAR; }
    PG8_BAR;
#undef PG8_SA
#undef PG8_SB
#undef PG8_STAGE
#undef PG8_LDA
#undef PG8_LDB
#undef PG8_MMA
#undef PG8_WAIT_V
#undef PG8_WAIT_L
#undef PG8_BAR
#undef PG8_SCHED
}
}
namespace attn_body {
using bf16=__hip_bfloat16;
using bf16x8=__attribute__((ext_vector_type(8)))short;
using s16x4=__attribute__((ext_vector_type(4)))short;
using f32x16=__attribute__((ext_vector_type(16)))float;
using f32x4v=__attribute__((ext_vector_type(4)))float;
using u32x4=__attribute__((ext_vector_type(4)))unsigned;
constexpr int BATCH=8,NHEAD=8,SEQ=2048,D=64,DM=NHEAD*D;
constexpr int NW=8,QBLK=32,QB=QBLK*NW,KVBLK=64,NQB=SEQ/QB;
__device__ __forceinline__ int crow(int r,int hi){return (r&3)+8*(r>>2)+4*hi;}
#define SBAR() __builtin_amdgcn_sched_barrier(0)
__device__ __forceinline__ void cmask(f32x16&p0,f32x16&p1,int jb,int qrel,int hi){
  const float NEG=-INFINITY; int kb=64*jb+4*hi;
  #pragma unroll
  for(int r=0;r<16;++r){int kv=kb+(r&3)+8*(r>>2); if(kv>qrel)p0[r]=NEG; if(kv+32>qrel)p1[r]=NEG;}
}
typedef __attribute__((address_space(3))) const float* lds_cfptr;
__device__ __forceinline__ void biasadd(f32x16&p0,f32x16&p1,int jb,int qrel,int hi,lds_cfptr bt){
  const int base=qrel-64*jb-4*hi;
  #pragma unroll
  for(int r4=0;r4<16;r4+=4){
    #pragma unroll
    for(int r=r4;r<r4+4;++r){int rel=base-((r&3)+8*(r>>2)); int i0=min(max(rel,0),127), i1=min(max(rel-32,0),127); p0[r]+=bt[i0]; p1[r]+=bt[i1];}
    asm volatile("s_waitcnt lgkmcnt(0)":"+v"(p0),"+v"(p1)::"memory"); }
}

constexpr int NSLOT=3, SLOTB=8192;
constexpr int LDS_K=0, LDS_V=NSLOT*SLOTB, LDS_WS=2*NSLOT*SLOTB, LDS_OST=LDS_WS+NW*64*4, LDS_KM=LDS_OST+NW*4096, LDS_BT=LDS_KM+7*64*4, LDS_BYTES=LDS_BT+128*4;
constexpr float C2=0.125f*1.4426950408889634f;
__device__ __forceinline__ void glds16(const void*gsrc,unsigned lds_dst){unsigned keep;
  asm volatile("s_mov_b32 %0, m0\n\ts_mov_b32 m0, %2\n\ts_nop 0\n\tglobal_load_lds_dwordx4 %1, off\n\ts_mov_b32 m0, %0":"=&s"(keep):"v"(gsrc),"s"(lds_dst):"memory");}
__device__ __forceinline__ float max3f(float a,float b,float c){float r;asm("v_max3_f32 %0, %1, %2, %3":"=v"(r):"v"(a),"v"(b),"v"(c));return r;}
__device__ __forceinline__ float max2f(float a,float b){float r;asm("v_max_f32_e32 %0, %1, %2":"=v"(r):"v"(a),"v"(b));return r;}
__device__ __forceinline__ float fadd_s(float a,float b){float r;asm("v_add_f32_e32 %0, %1, %2":"=v"(r):"v"(a),"v"(b));return r;}
__device__ __forceinline__ float fsub_s(float a,float b){float r;asm("v_sub_f32_e32 %0, %1, %2":"=v"(r):"v"(a),"v"(b));return r;}
typedef float f32x2_t __attribute__((ext_vector_type(2))); typedef __bf16 bf16x2_t __attribute__((ext_vector_type(2)));
__device__ __forceinline__ unsigned cvtpk_s(float lo,float hi){f32x2_t v={lo,hi};bf16x2_t b=__builtin_convertvector(v,bf16x2_t);return __builtin_bit_cast(unsigned,b);}
#define WAIT_BAR(N) asm volatile("s_waitcnt vmcnt(" #N ") lgkmcnt(0)\n\ts_barrier":::"memory")

__device__ __forceinline__ void qkt(f32x16&p0,f32x16&p1,const char*Kslot,const bf16x8*qr,int r32,int hi){
  const char*kb=Kslot+hi*1024+r32*16;
  #pragma unroll
  for(int d0=0;d0<4;++d0){
    const bf16x8 b0=*reinterpret_cast<const bf16x8*>(kb+d0*2048);
    const bf16x8 b1=*reinterpret_cast<const bf16x8*>(kb+d0*2048+512);
    if(d0==0){p0=__builtin_amdgcn_mfma_f32_32x32x16_bf16(b0,qr[0],(f32x16){},0,0,0);p1=__builtin_amdgcn_mfma_f32_32x32x16_bf16(b1,qr[0],(f32x16){},0,0,0);}
    else{p0=__builtin_amdgcn_mfma_f32_32x32x16_bf16(b0,qr[d0],p0,0,0,0);p1=__builtin_amdgcn_mfma_f32_32x32x16_bf16(b1,qr[d0],p1,0,0,0);}}
}
typedef __attribute__((address_space(3))) const char* lds_cptr;
typedef short v4i16_t __attribute__((ext_vector_type(4)));
__device__ __forceinline__ void kload8(bf16x8*kf,lds_cptr kp){
  kf[0]=*(const __attribute__((address_space(3))) bf16x8*)(kp);      kf[1]=*(const __attribute__((address_space(3))) bf16x8*)(kp+512);
  kf[2]=*(const __attribute__((address_space(3))) bf16x8*)(kp+2048); kf[3]=*(const __attribute__((address_space(3))) bf16x8*)(kp+2560);
  kf[4]=*(const __attribute__((address_space(3))) bf16x8*)(kp+4096); kf[5]=*(const __attribute__((address_space(3))) bf16x8*)(kp+4608);
  kf[6]=*(const __attribute__((address_space(3))) bf16x8*)(kp+6144); kf[7]=*(const __attribute__((address_space(3))) bf16x8*)(kp+6656);
}
__device__ __forceinline__ void kload2(bf16x8*kf,lds_cptr kp,int j){ kf[2*j]=*(const __attribute__((address_space(3))) bf16x8*)(kp+j*2048); kf[2*j+1]=*(const __attribute__((address_space(3))) bf16x8*)(kp+j*2048+512); }
__device__ __forceinline__ s16x4 vtr(lds_cptr p){ return __builtin_bit_cast(s16x4,__builtin_amdgcn_ds_read_tr16_b64_v4i16((__attribute__((address_space(3))) v4i16_t*)p)); }
__device__ __forceinline__ float rowmax(const f32x16&p0,const f32x16&p1){
  float a=max3f(p0[0],p0[1],p1[0]),b=max3f(p0[2],p0[3],p1[1]);a=max3f(a,p1[2],p1[3]);
  #pragma unroll
  for(int r=4;r<16;r+=4){a=max3f(a,p0[r],p0[r+1]);b=max3f(b,p0[r+2],p0[r+3]);a=max3f(a,p1[r],p1[r+1]);b=max3f(b,p1[r+2],p1[r+3]);}
  const float m=max2f(a,b);
  auto rr=__builtin_amdgcn_permlane32_swap(__float_as_uint(m),__float_as_uint(m),false,false);
  return max2f(__uint_as_float(rr[0]),__uint_as_float(rr[1]));
}
__device__ __forceinline__ void pv(f32x16*o,int vb,bf16x8 pa0,bf16x8 pa1,bf16x8 pa2,bf16x8 pa3){
  #pragma unroll
  for(int d0=0;d0<2;++d0){s16x4 lo[4],hi[4];
    #pragma unroll
    for(int ks=0;ks<4;++ks){
      asm volatile("ds_read_b64_tr_b16 %0,%1 offset:%c2":"=&v"(lo[ks]):"v"(vb),"i"(d0*4096+ks*1024):"memory");
      asm volatile("ds_read_b64_tr_b16 %0,%1 offset:%c2":"=&v"(hi[ks]):"v"(vb),"i"(d0*4096+ks*1024+512):"memory");}
    asm volatile("s_waitcnt lgkmcnt(0)":::"memory");SBAR();
    #define PK(k) (bf16x8){lo[k][0],lo[k][1],lo[k][2],lo[k][3],hi[k][0],hi[k][1],hi[k][2],hi[k][3]}
    o[d0]=__builtin_amdgcn_mfma_f32_32x32x16_bf16(pa0,PK(0),o[d0],0,0,0);
    o[d0]=__builtin_amdgcn_mfma_f32_32x32x16_bf16(pa1,PK(1),o[d0],0,0,0);
    o[d0]=__builtin_amdgcn_mfma_f32_32x32x16_bf16(pa2,PK(2),o[d0],0,0,0);
    o[d0]=__builtin_amdgcn_mfma_f32_32x32x16_bf16(pa3,PK(3),o[d0],0,0,0);
    #undef PK
  }
}

#ifndef ATTN_STORE16
#define ATTN_STORE16(p,v) (*(u32x4*)(p)=(v))
#endif
template<int THRL> __device__ __forceinline__ void attn_unit(int b,int h,int qb,const bf16*Q,const bf16*__restrict__ K,const bf16*__restrict__ V,bf16*O,char*shm,const float*kpart,const float*btab){
  int tid=threadIdx.x; asm volatile("":"+v"(tid));
  const int lane=tid&63,r32=lane&31,hi=lane>>5; const int wid=__builtin_amdgcn_readfirstlane(tid>>6);
  const long rowbase=(long)b*SEQ; const int q0=qb*QB;
  const bf16*Qw=Q+(rowbase+q0+wid*QBLK)*DM+h*D;
  const bf16*Kh=K+rowbase*DM+h*D,*Vh=V+rowbase*DM+h*D;
  const unsigned lds0=(unsigned)(uintptr_t)shm;
  float*wsf=(float*)(shm+LDS_WS)+wid*64;
  const bf16*ksrc=Kh+(long)lane*DM+wid*8;
  const bf16*vsrc=Vh+(long)(16*(wid&3)+(lane>>2))*DM+(wid>>2)*32+(lane&3)*8;
  const unsigned kdst=lds0+LDS_K+wid*1024, vdst=lds0+LDS_V+wid*1024;
  #define DMA_K(t,slot) glds16(ksrc+(long)(t)*KVBLK*DM,(unsigned)__builtin_amdgcn_readfirstlane(kdst+(slot)))
  #define DMA_V(t,slot) glds16(vsrc+(long)(t)*KVBLK*DM,(unsigned)__builtin_amdgcn_readfirstlane(vdst+(slot)))
  const int vb0=(int)(lds0+LDS_V)+((lane>>4)&1)*32+(lane&3)*8+(4*hi+((lane&15)>>2))*64;
  const char*Kbase=shm+LDS_K; bf16x8 kf[8];
  const lds_cptr shm3=(lds_cptr)shm; const lds_cptr kp0=shm3+LDS_K+hi*1024+r32*16; const lds_cptr vp0=shm3+LDS_V+((lane>>4)&1)*32+(lane&3)*8+(4*hi+((lane&15)>>2))*64;
  const lds_cfptr btl=(lds_cfptr)(shm3+LDS_BT);
  const int NT=(q0+QB)/KVBLK;
  DMA_K(0,0);DMA_V(0,0);DMA_K(1,SLOTB);
  bf16x8 qr[4];
  #pragma unroll
  for(int d0=0;d0<4;++d0)qr[d0]=*reinterpret_cast<const bf16x8*>(&Qw[(long)r32*DM+d0*16+hi*8]);
  { float*km=(float*)(shm+LDS_KM); float*bt=(float*)(shm+LDS_BT); int tq=tid; asm volatile("":"+v"(tq));
    if(tq<448){const int j=tq>>6,d=tq&63; float v=0.f; if(j<qb&&qb>3){const float*kp=kpart+((size_t)((b*NQB+j)*2)*512)+h*D+d; v=(kp[0]+kp[512])*(1.0f/256.0f);} km[tq]=v;}
    else if(tq<448+64){const int i=tq-448; bt[i]=btab[h*128+i]; bt[64+i]=btab[h*128+64+i];} }
  float mhat=0.f,l_reg=0.f;f32x16 o[2];o[0]=f32x16{};o[1]=f32x16{};
  const int qrel=wid*QBLK+r32;
  #define CMASK(P0,P1,t) do{int jb_=(t)-(NT-4);   \
    if(jb_>=-2 && 32*wid+31-64*jb_>=0 && 32*wid-64*jb_-63<=112)biasadd(P0,P1,jb_,qrel,hi,btl); if(jb_>=0 && 64*jb_+63>32*wid)cmask(P0,P1,jb_,qrel,hi);}while(0)
  bool resc=false;
  #define START(P0,P1,t) do{ float rm=rowmax(P0,P1); resc=false; const float nv_=MASKADD(t); rm=fadd_s(rm,nv_); \
    { const float dl=__builtin_fmaxf(rm,-1.0e4f); mhat=fadd_s(mhat,dl); const float cc_=fsub_s(nv_,dl); \
      _Pragma("unroll") for(int r=0;r<16;++r){P0[r]=fadd_s(P0[r],cc_);P1[r]=fadd_s(P1[r],cc_);} } \
    _Pragma("unroll") for(int r=0;r<16;++r)P0[r]=__builtin_amdgcn_exp2f(P0[r]); }while(0)
  #define RESC() do{ if(resc){ asm volatile("s_waitcnt lgkmcnt(0)":::"memory"); \
      _Pragma("unroll") for(int d_=0;d_<2;++d_) _Pragma("unroll") for(int r=0;r<16;++r)o[d_][r]*=wsf[crow(r,hi)]; } }while(0)
  f32x16 pA0,pA1,pB0,pB1;
  int sl_prev=0,sl_cur=0,sl_next=SLOTB;
  #define ROT() do{sl_prev=sl_cur;sl_cur=sl_next;sl_next=(sl_next==(NSLOT-1)*SLOTB)?0:sl_next+SLOTB;}while(0)
  DMA_K(2,2*SLOTB);
  WAIT_BAR(3);
  unsigned selbits=(1u<<qb)-1u;
  if(qb>3){ selbits=0u;
    const __attribute__((address_space(3))) float* km3=(const __attribute__((address_space(3))) float*)(shm3+LDS_KM);
    float qf[32];
    #pragma unroll
    for(int d0=0;d0<4;++d0){
      #pragma unroll
      for(int i=0;i<8;++i) qf[d0*8+i]=__uint_as_float(((unsigned)(unsigned short)qr[d0][i])<<16);}
    float gj[7];
    #pragma unroll
    for(int j=0;j<7;++j){ float s=0.f;
      if(j<qb){
        #pragma unroll
        for(int d0=0;d0<4;++d0){ const f32x4v k0=*(const __attribute__((address_space(3))) f32x4v*)(km3+j*64+d0*16+hi*8); const f32x4v k1=*(const __attribute__((address_space(3))) f32x4v*)(km3+j*64+d0*16+hi*8+4);
          s+=qf[d0*8+0]*k0[0]+qf[d0*8+1]*k0[1]+qf[d0*8+2]*k0[2]+qf[d0*8+3]*k0[3]+qf[d0*8+4]*k1[0]+qf[d0*8+5]*k1[1]+qf[d0*8+6]*k1[2]+qf[d0*8+7]*k1[3]; }
        auto rr=__builtin_amdgcn_permlane32_swap(__float_as_uint(s),__float_as_uint(s),false,false); s=__uint_as_float(rr[0])+__uint_as_float(rr[1]); }
      gj[j]=s; }
    #pragma unroll
    for(int j=0;j<7;++j){ int rank=0;
      #pragma unroll
      for(int k=0;k<7;++k){ if(k!=j){ const bool beats=(k<j)?(gj[k]>=gj[j]):(gj[k]>gj[j]); rank+=(k<qb&&beats)?1:0; } }
      if(j<qb&&rank<3)selbits|=(1u<<j); }
  }
  #define MASKADD(t) ((((t)>>2)<qb && !((selbits>>((t)>>2))&1u))?-1.0e30f:0.0f)
  qkt(pA0,pA1,Kbase,qr,r32,hi);asm volatile("s_nop 15\n\ts_nop 7":"+v"(pA0),"+v"(pA1));CMASK(pA0,pA1,0);
  START(pA0,pA1,0);
  _Pragma("unroll") for(int r=0;r<16;++r)pA1[r]=__builtin_amdgcn_exp2f(pA1[r]);
  WAIT_BAR(0);
  DMA_K(3,0);DMA_V(1,SLOTB);
  ROT();
  kload8(kf,kp0+sl_cur);
  WAIT_BAR(2);
  s16x4 vlo[8],vhi[8]; u32x4 pw0,pw1,pw2,pw3;
  #define PKW(P,B) cvtpk_s(P[B],P[B+1])
  #define PAF(k) __builtin_bit_cast(bf16x8,pw##k)
  #define VFR(i) (bf16x8){vlo[i][0],vlo[i][1],vlo[i][2],vlo[i][3],vhi[i][0],vhi[i][1],vhi[i][2],vhi[i][3]}
  #define PIN(x) asm volatile("":"+v"(x))
  #define MX3(a,b,c) __builtin_fmaxf(__builtin_fmaxf((a),(b)),(c))
  #define GAPA(MF,A0,A1,A2,A3,W0,W1,PW) do{ MF; sacc+=A0; sacc+=A1; sacc+=A2; sacc+=A3; PIN(sacc); W0; W1; PIN(PW); SBAR(); }while(0)
  #define EX(v) __builtin_amdgcn_exp2f(v)
  #define GAPB(MF,X,B) do{ MF; X[B]=EX(X[B]); X[B+1]=EX(X[B+1]); X[B+2]=EX(X[B+2]); X[B+3]=EX(X[B+3]); PIN(X); SBAR(); }while(0)
  #define VRD(i) do{ vlo[i]=vtr(vp_+(((i)>>2)*4096+((i)&3)*1024)); vhi[i]=vtr(vp_+(((i)>>2)*4096+((i)&3)*1024+512)); }while(0)
  #define KRD(G,j) do{ if(G){ kload2(kf,kp0+sl_next,j); SBAR(); } }while(0)
  #define STEP(C0,C1,P0,P1,t,GK,GV,GL) do{ SBAR(); \
    const lds_cptr vp_=vp0+sl_prev; \
    VRD(0); SBAR(); float sacc=(P0[0]+P0[1]); \
    GAPA(C0=__builtin_amdgcn_mfma_f32_32x32x16_bf16(kf[0],qr[0],(f32x16){},0,0,0), P0[2],P0[3],P0[4],P0[5],     pw0[0]=PKW(P0,0), pw0[1]=PKW(P0,2), pw0); \
    VRD(4); SBAR(); GAPA(C1=__builtin_amdgcn_mfma_f32_32x32x16_bf16(kf[1],qr[0],(f32x16){},0,0,0), P0[6],P0[7],P0[8],P0[9],     pw0[2]=PKW(P0,4), pw0[3]=PKW(P0,6), pw0); \
    VRD(1); SBAR(); GAPA(C0=__builtin_amdgcn_mfma_f32_32x32x16_bf16(kf[2],qr[1],C0,0,0,0),   P0[10],P0[11],P0[12],P0[13], pw1[0]=PKW(P0,8), pw1[1]=PKW(P0,10), pw1); \
    VRD(5); SBAR(); GAPA(C1=__builtin_amdgcn_mfma_f32_32x32x16_bf16(kf[3],qr[1],C1,0,0,0),   P0[14],P0[15],P1[0],P1[1],   pw1[2]=PKW(P0,12),pw1[3]=PKW(P0,14), pw1); \
    VRD(2); SBAR(); GAPA(C0=__builtin_amdgcn_mfma_f32_32x32x16_bf16(kf[4],qr[2],C0,0,0,0),   P1[2],P1[3],P1[4],P1[5],     pw2[0]=PKW(P1,0), pw2[1]=PKW(P1,2), pw2); \
    VRD(6); SBAR(); GAPA(C1=__builtin_amdgcn_mfma_f32_32x32x16_bf16(kf[5],qr[2],C1,0,0,0),   P1[6],P1[7],P1[8],P1[9],     pw2[2]=PKW(P1,4), pw2[3]=PKW(P1,6), pw2); \
    VRD(3); SBAR(); GAPA(C0=__builtin_amdgcn_mfma_f32_32x32x16_bf16(kf[6],qr[3],C0,0,0,0),   P1[10],P1[11],P1[12],P1[13], pw3[0]=PKW(P1,8), pw3[1]=PKW(P1,10), pw3); \
    VRD(7); SBAR(); GAPA(C1=__builtin_amdgcn_mfma_f32_32x32x16_bf16(kf[7],qr[3],C1,0,0,0),   P1[14],P1[15],0.f,0.f,       pw3[2]=PKW(P1,12),pw3[3]=PKW(P1,14), pw3); \
    l_reg+=sacc; \
    if(GK){DMA_K((t)+3,sl_cur);} if(GV){DMA_V((t)+1,sl_next);} \
    CMASK(C0,C1,t); \
    { float a=MX3(C0[0],C0[1],C1[0]),b=MX3(C0[2],C0[3],C1[1]); a=MX3(a,C1[2],C1[3]); \
      _Pragma("unroll") for(int r=4;r<16;r+=4){a=MX3(a,C0[r],C0[r+1]);b=MX3(b,C0[r+2],C0[r+3]);a=MX3(a,C1[r],C1[r+1]);b=MX3(b,C1[r+2],C1[r+3]);} \
      float rm=__builtin_fmaxf(a,b); { auto rr=__builtin_amdgcn_permlane32_swap(__float_as_uint(rm),__float_as_uint(rm),false,false); rm=__builtin_fmaxf(__uint_as_float(rr[0]),__uint_as_float(rr[1])); } \
      const float nv_=MASKADD(t)-mhat; rm+=nv_; float cc_=nv_; \
      resc=false; \
      if(__builtin_expect(__any(rm>(float)THRL),0)){ const float dl=__builtin_fmaxf(rm,0.f); mhat+=dl; cc_-=dl; \
        const float f=__builtin_amdgcn_exp2f(-dl); l_reg*=f; if(hi==0)wsf[r32]=f; resc=true; } \
      _Pragma("unroll") for(int r=0;r<16;++r){C0[r]+=cc_;C1[r]+=cc_;} } \
    SBAR(); \
    GAPB(o[0]=__builtin_amdgcn_mfma_f32_32x32x16_bf16(PAF(0),VFR(0),o[0],0,0,0), C0,0); \
    GAPB(o[1]=__builtin_amdgcn_mfma_f32_32x32x16_bf16(PAF(0),VFR(4),o[1],0,0,0), C0,4); \
    KRD(GL,0); GAPB(o[0]=__builtin_amdgcn_mfma_f32_32x32x16_bf16(PAF(1),VFR(1),o[0],0,0,0), C0,8); \
    KRD(GL,1); GAPB(o[1]=__builtin_amdgcn_mfma_f32_32x32x16_bf16(PAF(1),VFR(5),o[1],0,0,0), C0,12); \
    KRD(GL,2); GAPB(o[0]=__builtin_amdgcn_mfma_f32_32x32x16_bf16(PAF(2),VFR(2),o[0],0,0,0), C1,0); \
    KRD(GL,3); GAPB(o[1]=__builtin_amdgcn_mfma_f32_32x32x16_bf16(PAF(2),VFR(6),o[1],0,0,0), C1,4); \
    GAPB(o[0]=__builtin_amdgcn_mfma_f32_32x32x16_bf16(PAF(3),VFR(3),o[0],0,0,0), C1,8); \
    GAPB(o[1]=__builtin_amdgcn_mfma_f32_32x32x16_bf16(PAF(3),VFR(7),o[1],0,0,0), C1,12); \
    }while(0)
  int t=1;
  #undef CMASK
  #define CMASK(P0,P1,t) do{}while(0)
  for(;t+7<NT;t+=2){
    STEP(pB0,pB1,pA0,pA1,t,true,true,true);     WAIT_BAR(2); RESC(); ROT();
    STEP(pA0,pA1,pB0,pB1,t+1,true,true,true);   WAIT_BAR(2); RESC(); ROT();
  }
  #undef CMASK
  #define CMASK(P0,P1,t) do{int jb_=(t)-(NT-4);   \
    if(jb_>=-2 && 32*wid+31-64*jb_>=0 && 32*wid-64*jb_-63<=112)biasadd(P0,P1,jb_,qrel,hi,btl); if(jb_>=0 && 64*jb_+63>32*wid)cmask(P0,P1,jb_,qrel,hi);}while(0)
  #define ENDW(tt) do{ if((tt)+3<NT){WAIT_BAR(2);} else if((tt)+2<NT){WAIT_BAR(1);} else {WAIT_BAR(0);} }while(0)
  for(;t+1<NT;t+=2){
    STEP(pB0,pB1,pA0,pA1,t,(t+3<NT),(t+1<NT),(t+1<NT));       ENDW(t);   RESC(); ROT();
    STEP(pA0,pA1,pB0,pB1,t+1,(t+4<NT),(t+2<NT),(t+2<NT));     ENDW(t+1); RESC(); ROT();
  }
  STEP(pB0,pB1,pA0,pA1,NT-1,false,false,false); RESC();
  { float sacc=pB0[0]+pB0[1]; _Pragma("unroll") for(int r=2;r<16;++r)sacc+=pB0[r]; _Pragma("unroll") for(int r=0;r<16;++r)sacc+=pB1[r]; l_reg+=sacc;
    pw0=(u32x4){PKW(pB0,0),PKW(pB0,2),PKW(pB0,4),PKW(pB0,6)};pw1=(u32x4){PKW(pB0,8),PKW(pB0,10),PKW(pB0,12),PKW(pB0,14)};pw2=(u32x4){PKW(pB1,0),PKW(pB1,2),PKW(pB1,4),PKW(pB1,6)};pw3=(u32x4){PKW(pB1,8),PKW(pB1,10),PKW(pB1,12),PKW(pB1,14)};
    SBAR(); pv(o,vb0+sl_cur,PAF(0),PAF(1),PAF(2),PAF(3)); }
  #undef PKW
  #undef PAF
  #undef VFR
  #undef PIN
  #undef MX3
  #undef GAPA
  #undef GAPB
  #undef EX
  #undef VRD
  #undef KRD
  #undef STEP
  #undef ENDW
  #undef MASKADD
  {auto rr=__builtin_amdgcn_permlane32_swap(__float_as_uint(l_reg),__float_as_uint(l_reg),false,false);l_reg=__uint_as_float(rr[0])+__uint_as_float(rr[1]);}
  if(hi==0)wsf[32+r32]=l_reg;asm volatile("s_waitcnt lgkmcnt(0)":::"memory");
  float rli[16];
  #pragma unroll
  for(int r=0;r<16;++r)rli[r]=__builtin_amdgcn_rcpf(wsf[32+crow(r,hi)]);
  bf16*Ow=O+(rowbase+q0+wid*QBLK)*DM+h*D;
  { bf16*stg=(bf16*)(shm+LDS_OST)+wid*2048;
    #pragma unroll
    for(int r=0;r<16;++r){const int orow=crow(r,hi);
      #pragma unroll
      for(int d0=0;d0<2;++d0)stg[orow*64+d0*32+r32]=__float2bfloat16(o[d0][r]*rli[r]);}
    asm volatile("s_waitcnt lgkmcnt(0)":::"memory");
    #pragma unroll
    for(int i=0;i<4;++i){const int row=i*8+(lane>>3),ch=lane&7; const u32x4 v=*(const u32x4*)(stg+row*64+ch*8); ATTN_STORE16(Ow+(long)row*DM+ch*8,v);} }
  asm volatile("s_waitcnt lgkmcnt(0)\n\ts_barrier":::"memory");
  #undef DMA_K
  #undef DMA_V
  #undef CMASK
  #undef START
  #undef RESC
  #undef ROT
}
constexpr int ATTN_LDS_BYTES=LDS_BYTES;
#undef SBAR
#undef WAIT_BAR
}
constexpr int NWAVES = 8;
constexpr int PER_PHASE = 10;
constexpr int N_LAUNCHES = MK_N_LAUNCHES;

constexpr int BATCH = 8, SEQ = 2048, DMODEL = 1024, MTOK = BATCH * SEQ;
constexpr int INCOLS = 4096, SSMW = 512, NGRP = 32, CH = 32  , NCHUNK = SEQ / CH  , APK = 640  ;
constexpr int PQ = 2048, NEXP = 16384;
constexpr float RMS_EPS = 1e-6f;

constexpr size_t MiB = 1u << 20;
constexpr size_t WS_CTL = 0, CTL_ZERO_BYTES = 64 * 1024;
constexpr size_t WS_BIAS = 1 * MiB;
constexpr size_t WS_PW32 = 1 * MiB + 64 * 1024;
constexpr size_t WS_KPART = 1 * MiB + 128 * 1024;
constexpr size_t WS_KG = 2 * MiB;
constexpr size_t WS_SSQ1 = 3 * MiB;
constexpr size_t WS_WIN = 6 * MiB, WS_WQ = 14 * MiB, WS_WOUT = 18 * MiB, WS_WUS = 20 * MiB, WS_WUA = 21 * MiB, WS_WGLU = 22 * MiB, WS_KS = 22 * MiB + 512 * 1024;
constexpr size_t WS_WE = 23 * MiB;
constexpr size_t WS_BP = 32 * MiB;
constexpr size_t WS_AP = 52 * MiB;
constexpr size_t WS_E = 72 * MiB;
constexpr size_t WS_H = 80 * MiB;
constexpr size_t WS_YPRE = 80 * MiB, WS_YA = 96 * MiB, WS_XG = 80 * MiB;
constexpr size_t WS_Z = 96 * MiB, ZSTRIDE_B = 16 * MiB;
constexpr size_t WS_MRG = 128 * MiB;
constexpr size_t WS_PQ = 160 * MiB;
constexpr size_t WS_IDS = 224 * MiB, WS_GTS = 232 * MiB;
constexpr size_t WS_U16 = 32 * MiB, WS_V16 = 240 * MiB;
constexpr size_t WS_YB = 224 * MiB;
constexpr size_t WS_WPK = 128 * MiB, WS_RSTD1 = 4 * MiB, WS_Y16 = 160 * MiB;
constexpr size_t WS_END = 256 * MiB;
constexpr int CW_BAR = 1024;

constexpr int RING_OFF = 0, RING_BYTES = 131072;
constexpr int LDSCTL_OFF = RING_BYTES, MISC_OFF = LDSCTL_OFF + 320;
constexpr int LDS_BYTES = 147456;

#define GAS __attribute__((address_space(1)))
#define LAS __attribute__((address_space(3)))
typedef unsigned short bf16;
typedef unsigned v4u __attribute__((ext_vector_type(4)));
typedef float f32x4 __attribute__((ext_vector_type(4)));
typedef short bf16x8 __attribute__((ext_vector_type(8)));
typedef float f32x16 __attribute__((ext_vector_type(16)));
typedef __bf16 bf16x2_t __attribute__((ext_vector_type(2)));
typedef _Float16 h2_t __attribute__((ext_vector_type(2)));
typedef GAS unsigned gu32;
#define RLX_AGENT __ATOMIC_RELAXED, __HIP_MEMORY_SCOPE_AGENT
#define LDS_WAIT() asm volatile("s_waitcnt lgkmcnt(0)" ::: "memory")
#define VM_WAIT() asm volatile("s_waitcnt vmcnt(0)" ::: "memory")
__device__ __forceinline__ unsigned f2bf(float f) { unsigned u = __builtin_bit_cast(unsigned, f); return (u + 0x7fffu + ((u >> 16) & 1u)) >> 16; }
__device__ __forceinline__ unsigned pk2(float lo, float hi) { return f2bf(lo) | (f2bf(hi) << 16); }
using pg8::cvt_pk_bf16; using pg8::bf_lo; using pg8::bf_hi; using pg8::sigmoid_f; using pg8::gelu_tanh;

#define XB_TMO      128
#define XB_XCNT(j)  (256  + 64 * (j))
#define XB_XSUB(j)  (1280 + 64 * (j))
#define XB_XGEN(j)  (2304 + 64 * (j))
#define XB_TOP      3328
#define XB_TOPGEN   3392
#define XCD_BAR_WORDS 3456
#define XB_SPIN_CAP (1u << 18)
__device__ __forceinline__ unsigned xb_ld(unsigned* p)              { return __hip_atomic_load(p, __ATOMIC_RELAXED, __HIP_MEMORY_SCOPE_AGENT); }
__device__ __forceinline__ unsigned xb_add(unsigned* p, unsigned v) { return __hip_atomic_fetch_add(p, v, __ATOMIC_RELAXED, __HIP_MEMORY_SCOPE_AGENT); }
__device__ __forceinline__ unsigned xb_xcc_id() { return (unsigned)__builtin_amdgcn_s_getreg((3 << 11) | 20) & 0xFu; }
#define XB_SPIN(cond, bar) do { unsigned _sp = 0; while (cond) { __builtin_amdgcn_s_sleep(1); \
    if ((++_sp & 255u) == 0u) { if (xb_ld(&(bar)[XB_TMO])) break; if (_sp > XB_SPIN_CAP) { atomicAdd(&(bar)[XB_TMO], 1u); break; } } } } while (0)
struct XcdBarrier { unsigned* bar; unsigned x; volatile LAS unsigned* st; };
__device__ __forceinline__ XcdBarrier xcd_barrier_post(unsigned* bar, volatile LAS unsigned* st) {
    XcdBarrier b; b.bar = bar; b.x = xb_xcc_id(); b.st = st;
    if (threadIdx.x == 0) (void)xb_add(&bar[XB_XCNT(b.x)], 1u);
    return b;
}
__device__ __forceinline__ void xcd_barrier_complete(unsigned* bar, unsigned x, unsigned& nloc, unsigned& nx) {
    const unsigned G = gridDim.x * gridDim.y * gridDim.z;
    unsigned sum, cnt, mine, sp = 0u;
    for (;;) {
        sum = 0u; cnt = 0u; mine = 0u;
#pragma unroll
        for (unsigned j = 0; j < 16; ++j) { const unsigned c = xb_ld(&bar[XB_XCNT(j)]); sum += c; cnt += (c > 0u) ? 1u : 0u; mine = (j == x) ? c : mine; }
        if (sum == G) break;
        __builtin_amdgcn_s_sleep(1);
        if ((++sp & 255u) == 0u) { if (xb_ld(&bar[XB_TMO])) break; if (sp > XB_SPIN_CAP) { atomicAdd(&bar[XB_TMO], 1u); break; } }
    }
    nloc = mine > 0u ? mine : 1u; nx = cnt > 0u ? cnt : 1u;
}
__device__ __forceinline__ void xcd_barrier(const XcdBarrier& b) {
    asm volatile("s_waitcnt vmcnt(0)" ::: "memory");
    __syncthreads();
    if (threadIdx.x == 0) {
        unsigned* bar = b.bar;
        __builtin_amdgcn_s_waitcnt(0);
        unsigned nloc = b.st[0], nx = b.st[1];
        if (nloc == 0u) { xcd_barrier_complete(bar, b.x, nloc, nx); b.st[0] = nloc; b.st[1] = nx; }
        const unsigned old = xb_add(&bar[XB_XSUB(b.x)], 1u);
        const unsigned gen = old / nloc;
        if (old + 1u == (gen + 1u) * nloc) {
            __builtin_amdgcn_fence(__ATOMIC_RELEASE, "agent");
            asm volatile("s_waitcnt vmcnt(0)" ::: "memory");
            const unsigned og = xb_add(&bar[XB_TOP], 1u);
            const unsigned tg = og / nx;
            if (og + 1u == (tg + 1u) * nx) xb_add(&bar[XB_TOPGEN], 1u);
            else XB_SPIN(xb_ld(&bar[XB_TOPGEN]) == tg, bar);
            __builtin_amdgcn_fence(__ATOMIC_ACQUIRE, "agent");
            xb_add(&bar[XB_XGEN(b.x)], 1u);
            asm volatile("s_waitcnt vmcnt(0)" ::: "memory");
        } else {
            XB_SPIN(xb_ld(&bar[XB_XGEN(b.x)]) == gen, bar);
            __builtin_amdgcn_fence(__ATOMIC_ACQUIRE, "agent");
            asm volatile("s_waitcnt vmcnt(0)" ::: "memory");
        }
    }
    __syncthreads();
}

__device__ __forceinline__ float wave_sum(float v) {
#pragma unroll
    for (int o = 1; o < 64; o <<= 1) v += __shfl_xor(v, o);
    return v;
}

namespace pg8 {
struct EpiIn {
    static constexpr bool PERM = true;
    bf16_t* zbase; bf16_t* AP; float* kpart;
    __device__ __forceinline__ void operator()(const f32x4 (&acc)[2][2][4][2], const Unit& u, int wr, int wc, int fr, int fq) const {
        const int t = u.pn >> 1, colt = (u.pn & 1) * 256;
        const int row0 = u.pm * BM + wr * 64 + fr, col0 = colt + wc * 32 + 8 * fq;
        if (t == 0) {
#pragma unroll
            for (int ai = 0; ai < 2; ++ai)
#pragma unroll
                for (int m = 0; m < 4; ++m) { const int r = row0 + ai * HALF + m * 16, b = r >> 11, l = r & 2047;
#pragma unroll
                    for (int bj = 0; bj < 2; ++bj) { const int c = col0 + bj * HALF, g = c >> 4, hi0 = c & 15;
                        const f32x4 v0 = acc[ai][bj][m][0], v1 = acc[ai][bj][m][1];
                        u32x4 w; w.x = cvt_pk_bf16(v0[0], v0[1]); w.y = cvt_pk_bf16(v0[2], v0[3]); w.z = cvt_pk_bf16(v1[0], v1[1]); w.w = cvt_pk_bf16(v1[2], v1[3]);
                        *(u32x4*)(AP + (size_t)(g * 512 + b * 64 + (l >> 5)) * 640 + (l & 31) * 16 + hi0) = w; } }
        } else {
            bf16_t* base = zbase + (size_t)t * (16u * 1024u * 1024u / 2u);
            const float sc = (t == 1) ? 0.125f * 1.4426950408889634f : 1.0f;
#pragma unroll
            for (int ai = 0; ai < 2; ++ai)
#pragma unroll
                for (int m = 0; m < 4; ++m) { bf16_t* rowp = base + (size_t)(row0 + ai * HALF + m * 16) * 512 + col0;
#pragma unroll
                    for (int bj = 0; bj < 2; ++bj) { f32x4 v0 = acc[ai][bj][m][0], v1 = acc[ai][bj][m][1];
                        if (t >= 4) {
#pragma unroll
                            for (int e = 0; e < 4; ++e) { v0[e] = sigmoid_f(v0[e]); v1[e] = sigmoid_f(v1[e]); }
                        } else { v0 = v0 * sc; v1 = v1 * sc; }
                        u32x4 w; w.x = cvt_pk_bf16(v0[0], v0[1]); w.y = cvt_pk_bf16(v0[2], v0[3]); w.z = cvt_pk_bf16(v1[0], v1[1]); w.w = cvt_pk_bf16(v1[2], v1[3]);
                        *(u32x4*)(rowp + bj * HALF) = w; } }
            if (t == 2) {
#pragma unroll
                for (int bj = 0; bj < 2; ++bj)
#pragma unroll
                    for (int n = 0; n < 2; ++n) { f32x4 s = (f32x4){0.f, 0.f, 0.f, 0.f};
#pragma unroll
                        for (int ai = 0; ai < 2; ++ai)
#pragma unroll
                            for (int m = 0; m < 4; ++m) s += acc[ai][bj][m][n];
#pragma unroll
                        for (int e = 0; e < 4; ++e) { float x = s[e]; x += __shfl_xor(x, 1); x += __shfl_xor(x, 2); x += __shfl_xor(x, 4); x += __shfl_xor(x, 8); s[e] = x; }
                        if (fr == 0) *(f32x4*)(kpart + (size_t)(u.pm * 2 + wr) * 512 + col0 + bj * HALF + 4 * n) = s; }
            }
        }
    }
};
struct EpiE {
    static constexpr bool PERM = false;
    float* E;
    __device__ __forceinline__ void operator()(const f32x4 (&acc)[2][2][4][2], const Unit& u, int wr, int wc, int fr, int fq) const {
        const int row0 = u.pm * BM + wr * 64 + fr, col0 = wc * 32 + 4 * fq;
#pragma unroll
        for (int ai = 0; ai < 2; ++ai)
#pragma unroll
            for (int m = 0; m < 4; ++m) { float* rowp = E + (size_t)(row0 + ai * HALF + m * 16) * 128 + col0;
#pragma unroll
                for (int n = 0; n < 2; ++n) *(f32x4*)(rowp + n * 16) = acc[ai][0][m][n]; }
    }
};
struct EpiY {
    static constexpr bool PERM = true;
    bf16_t* Y;
    __device__ __forceinline__ void operator()(const f32x4 (&acc)[2][2][4][2], const Unit& u, int wr, int wc, int fr, int fq) const {
        const int row0 = u.pm * BM + wr * 64 + fr, col0 = u.pn * BM + wc * 32 + 8 * fq;
#pragma unroll
        for (int ai = 0; ai < 2; ++ai)
#pragma unroll
            for (int m = 0; m < 4; ++m) { const int r = row0 + ai * HALF + m * 16, g = r >> 9, b = (r >> 6) & 7, c = r & 63;
#pragma unroll
                for (int bj = 0; bj < 2; ++bj) { const int cc = col0 + bj * HALF, j = cc >> 4, ho0 = cc & 15;
                    f32x4 v0 = acc[ai][bj][m][0], v1 = acc[ai][bj][m][1];
#pragma unroll
                    for (int e = 0; e < 4; ++e) { v0[e] = gelu_tanh(v0[e]); v1[e] = gelu_tanh(v1[e]); }
                    u32x4 w; w.x = cvt_pk_bf16(v0[0], v0[1]); w.y = cvt_pk_bf16(v0[2], v0[3]); w.z = cvt_pk_bf16(v1[0], v1[1]); w.w = cvt_pk_bf16(v1[2], v1[3]);
                    *(u32x4*)(Y + (size_t)(b * 2048 + c * 32 + j) * 512 + g * 16 + ho0) = w; } }
    }
};
struct EpiGlu {
    static constexpr bool PERM = true;
    const bf16_t* Yp; bf16_t* Ya; const float* bias;
    __device__ __forceinline__ void operator()(const f32x4 (&acc)[2][2][4][2], const Unit& u, int wr, int wc, int fr, int fq) const {
        const int row0 = u.pm * BM + wr * 64 + fr, col0 = u.pn * BM + wc * 32 + 8 * fq;
        f32x4 bv[2][2];
#pragma unroll
        for (int bj = 0; bj < 2; ++bj)
#pragma unroll
            for (int n = 0; n < 2; ++n) bv[bj][n] = *(const f32x4*)(bias + col0 + bj * HALF + 4 * n);
#pragma unroll
        for (int ai = 0; ai < 2; ++ai)
#pragma unroll
            for (int m = 0; m < 4; ++m) { const size_t off = (size_t)(row0 + ai * HALF + m * 16) * 512 + col0;
#pragma unroll
                for (int bj = 0; bj < 2; ++bj) { const f32x4 z0 = acc[ai][bj][m][0] + bv[bj][0], z1 = acc[ai][bj][m][1] + bv[bj][1];
                    const u32x4 y = *(const u32x4*)(Yp + off + bj * HALF);
                    u32x4 w; w.x = cvt_pk_bf16(bf_lo(y.x) * sigmoid_f(z0[0]), bf_hi(y.x) * sigmoid_f(z0[1])); w.y = cvt_pk_bf16(bf_lo(y.y) * sigmoid_f(z0[2]), bf_hi(y.y) * sigmoid_f(z0[3]));
                    w.z = cvt_pk_bf16(bf_lo(y.z) * sigmoid_f(z1[0]), bf_hi(y.z) * sigmoid_f(z1[1])); w.w = cvt_pk_bf16(bf_lo(y.w) * sigmoid_f(z1[2]), bf_hi(y.w) * sigmoid_f(z1[3]));
                    *(u32x4*)(Ya + off + bj * HALF) = w; } }
    }
};
template <int ADD> struct EpiMrg {
    static constexpr bool PERM = true;
    const bf16_t* G0; bf16_t* Mrg;
    __device__ __forceinline__ void operator()(const f32x4 (&acc)[2][2][4][2], const Unit& u, int wr, int wc, int fr, int fq) const {
        const int row0 = u.pm * BM + wr * 64 + fr, cin = wc * 32 + 8 * fq;
        const bf16_t* gb = G0 + (size_t)(u.pn >> 1) * (16u * 1024u * 1024u / 2u) + (u.pn & 1) * 256 + cin;
#pragma unroll
        for (int ai = 0; ai < 2; ++ai)
#pragma unroll
            for (int m = 0; m < 4; ++m) { const int r = row0 + ai * HALF + m * 16;
#pragma unroll
                for (int bj = 0; bj < 2; ++bj) {
#if defined(ABL_NO_SSM) || defined(ABL_NO_ATT)
#if defined(ABL_NO_SSM)
                    constexpr bool kill = (ADD == 0);
#else
                    constexpr bool kill = (ADD == 1);
#endif
                    const f32x4 a0 = kill ? (f32x4){0.f, 0.f, 0.f, 0.f} : acc[ai][bj][m][0], a1 = kill ? (f32x4){0.f, 0.f, 0.f, 0.f} : acc[ai][bj][m][1];
#else
                    const f32x4 a0 = acc[ai][bj][m][0], a1 = acc[ai][bj][m][1];
#endif
                    const u32x4 gt = *(const u32x4*)(gb + (size_t)r * 512 + bj * HALF);
                    bf16_t* mp = Mrg + (size_t)r * 1024 + u.pn * BM + cin + bj * HALF;
                    float o[8] = { bf_lo(gt.x) * a0[0], bf_hi(gt.x) * a0[1], bf_lo(gt.y) * a0[2], bf_hi(gt.y) * a0[3], bf_lo(gt.z) * a1[0], bf_hi(gt.z) * a1[1], bf_lo(gt.w) * a1[2], bf_hi(gt.w) * a1[3] };
                    if (ADD) { const u32x4 p = *(const u32x4*)mp; o[0] += bf_lo(p.x); o[1] += bf_hi(p.x); o[2] += bf_lo(p.y); o[3] += bf_hi(p.y); o[4] += bf_lo(p.z); o[5] += bf_hi(p.z); o[6] += bf_lo(p.w); o[7] += bf_hi(p.w); }
                    u32x4 w; w.x = cvt_pk_bf16(o[0], o[1]); w.y = cvt_pk_bf16(o[2], o[3]); w.z = cvt_pk_bf16(o[4], o[5]); w.w = cvt_pk_bf16(o[6], o[7]);
                    *(u32x4*)mp = w; } }
    }
};
struct EpiMrgDual {
    static constexpr bool PERM = true;
    EpiMrg<0> a; EpiMrg<1> b;
    __device__ __forceinline__ void operator()(const f32x4 (&acc)[2][2][4][2], const Unit& u, int wr, int wc, int fr, int fq) const { if (u.w == 0) a(acc, u, wr, wc, fr, fq); else b(acc, u, wr, wc, fr, fq); }
};
struct EpiX1 {
    static constexpr bool PERM = true;
    const float* X; float* X1; bf16_t* XG; const float* g2; float* ssq;
    __device__ __forceinline__ void operator()(const f32x4 (&acc)[2][2][4][2], const Unit& u, int wr, int wc, int fr, int fq) const {
        const int row0 = u.pm * BM + wr * 64 + fr, col0 = u.pn * BM + wc * 32 + 8 * fq;
        f32x4 gv[2][2];
#pragma unroll
        for (int bj = 0; bj < 2; ++bj)
#pragma unroll
            for (int n = 0; n < 2; ++n) gv[bj][n] = *(const f32x4*)(g2 + col0 + bj * HALF + 4 * n);
#pragma unroll
        for (int ai = 0; ai < 2; ++ai)
#pragma unroll
            for (int m = 0; m < 4; ++m) { const int r = row0 + ai * HALF + m * 16; const size_t off = (size_t)r * 1024 + col0; float s = 0.f;
#pragma unroll
                for (int bj = 0; bj < 2; ++bj) {
                    #ifdef ABL_NO_MIX
                    const f32x4 x0 = *(const f32x4*)(X + off + bj * HALF), x1 = *(const f32x4*)(X + off + bj * HALF + 4);
#else
                    const f32x4 x0 = *(const f32x4*)(X + off + bj * HALF) + acc[ai][bj][m][0], x1 = *(const f32x4*)(X + off + bj * HALF + 4) + acc[ai][bj][m][1];
#endif
                    *(f32x4*)(X1 + off + bj * HALF) = x0; *(f32x4*)(X1 + off + bj * HALF + 4) = x1;
                    s += (x0[0] * x0[0] + x0[1] * x0[1]) + (x0[2] * x0[2] + x0[3] * x0[3]) + (x1[0] * x1[0] + x1[1] * x1[1]) + (x1[2] * x1[2] + x1[3] * x1[3]);
                    const f32x4 a = x0 * gv[bj][0], b = x1 * gv[bj][1];
                    u32x4 w; w.x = cvt_pk_bf16(a[0], a[1]); w.y = cvt_pk_bf16(a[2], a[3]); w.z = cvt_pk_bf16(b[0], b[1]); w.w = cvt_pk_bf16(b[2], b[3]);
                    *(u32x4*)(XG + off + bj * HALF) = w; }
                s += __shfl_xor(s, 16); s += __shfl_xor(s, 32);
                if (fq == 0) ssq[(size_t)r * 16 + u.pn * 4 + wc] = s; }
    }
};
struct EpiPlain {
    static constexpr bool PERM = true;
    bf16_t* O; int ldc;
    __device__ __forceinline__ void operator()(const f32x4 (&acc)[2][2][4][2], const Unit& u, int wr, int wc, int fr, int fq) const {
        const int row0 = u.pm * BM + wr * 64 + fr, col0 = u.pn * BM + wc * 32 + 8 * fq;
#pragma unroll
        for (int ai = 0; ai < 2; ++ai)
#pragma unroll
            for (int m = 0; m < 4; ++m) { bf16_t* rowp = O + (size_t)(row0 + ai * HALF + m * 16) * ldc + col0;
#pragma unroll
                for (int bj = 0; bj < 2; ++bj) { const f32x4 v0 = acc[ai][bj][m][0], v1 = acc[ai][bj][m][1];
                    u32x4 w; w.x = cvt_pk_bf16(v0[0], v0[1]); w.y = cvt_pk_bf16(v0[2], v0[3]); w.z = cvt_pk_bf16(v1[0], v1[1]); w.w = cvt_pk_bf16(v1[2], v1[3]);
                    *(u32x4*)(rowp + bj * HALF) = w; } }
    }
};
}
struct Frame {
    LAS unsigned char* lds;
    int tid, lane, wave, vcu, G;
};

__device__ __forceinline__ void p0_transpose_item(const float* W, int K, int N, bf16* WT, LAS float* scr, int item, int lane) {
    const int nblk = N / 32, kb = item / nblk, nb = item % nblk, k0 = 64 * kb, n0 = 32 * nb;
    float wv[32];
#pragma unroll
    for (int i = 0; i < 32; ++i) { const int kk = 2 * i + (lane >> 5); wv[i] = W[(size_t)(k0 + kk) * N + n0 + (lane & 31)]; }
#pragma unroll
    for (int i = 0; i < 32; ++i) { const int kk = 2 * i + (lane >> 5); scr[kk * 33 + (lane & 31)] = wv[i]; }
    LDS_WAIT(); asm volatile("" ::: "memory");
    const int c = lane & 7;
#pragma unroll
    for (int j = 0; j < 4; ++j) { const int n = (lane >> 3) + 8 * j; const LAS float* s = scr + (8 * c) * 33 + n;
        v4u o; o.x = pk2(s[0 * 33], s[1 * 33]); o.y = pk2(s[2 * 33], s[3 * 33]); o.z = pk2(s[4 * 33], s[5 * 33]); o.w = pk2(s[6 * 33], s[7 * 33]);
        *(GAS v4u*)(WT + (size_t)(n0 + n) * K + k0 + 8 * c) = o; }
    LDS_WAIT(); asm volatile("" ::: "memory");
}
__device__ __forceinline__ void rms_row_to_bf16(const float* xrow, const float* g, bf16* orow, int lane) {
    const GAS f32x4* xr = (const GAS f32x4*)xrow + lane; const GAS f32x4* gr = (const GAS f32x4*)g + lane;
    f32x4 v[4]; float s = 0.f;
#pragma unroll
    for (int j = 0; j < 4; ++j) { v[j] = xr[64 * j]; s += (v[j].x * v[j].x + v[j].y * v[j].y) + (v[j].z * v[j].z + v[j].w * v[j].w); }
    const float rstd = 1.0f / sqrtf(wave_sum(s) * (1.f / DMODEL) + RMS_EPS);
    GAS unsigned long long* o8 = (GAS unsigned long long*)orow + lane;
#pragma unroll
    for (int j = 0; j < 4; ++j) { const f32x4 gg = gr[64 * j];
        o8[64 * j] = (unsigned long long)pk2(v[j].x * rstd * gg.x, v[j].y * rstd * gg.y) | ((unsigned long long)pk2(v[j].z * rstd * gg.z, v[j].w * rstd * gg.w) << 32); }
}
__device__ __forceinline__ void rms_rows4_to_bf16(const float* x, const float* g, bf16* out, int m, int stride, int lane) {
    f32x4 v[4][4];
#pragma unroll
    for (int k = 0; k < 4; ++k) { const int mm = (m + k * stride < MTOK) ? m + k * stride : m; const GAS f32x4* xr = (const GAS f32x4*)(x + (size_t)mm * DMODEL) + lane;
#pragma unroll
        for (int j = 0; j < 4; ++j) v[k][j] = xr[64 * j]; }
    const GAS f32x4* gr = (const GAS f32x4*)g + lane; f32x4 gg[4];
#pragma unroll
    for (int j = 0; j < 4; ++j) gg[j] = gr[64 * j];
#pragma unroll
    for (int k = 0; k < 4; ++k) { if (m + k * stride >= MTOK) break; float s = 0.f;
#pragma unroll
        for (int j = 0; j < 4; ++j) s += (v[k][j].x * v[k][j].x + v[k][j].y * v[k][j].y) + (v[k][j].z * v[k][j].z + v[k][j].w * v[k][j].w);
        const float rstd = 1.0f / sqrtf(wave_sum(s) * (1.f / DMODEL) + RMS_EPS);
        GAS unsigned long long* o8 = (GAS unsigned long long*)(out + (size_t)(m + k * stride) * DMODEL) + lane;
#pragma unroll
        for (int j = 0; j < 4; ++j) o8[64 * j] = (unsigned long long)pk2(v[k][j].x * rstd * gg[j].x, v[k][j].y * rstd * gg[j].y) | ((unsigned long long)pk2(v[k][j].z * rstd * gg[j].z, v[k][j].w * rstd * gg[j].w) << 32); }
}
struct cpx { float r, i; };
__device__ __forceinline__ cpx cmul(cpx a, cpx b) { return cpx{a.r * b.r - a.i * b.i, a.r * b.i + a.i * b.r}; }
__device__ __forceinline__ cpx cpow_(float ar, float ai, float dt, int n) { const float e = expf(ar * dt * (float)n); const float ang = ai * dt * (float)n; return cpx{e * cosf(ang), e * sinf(ang)}; }
__device__ __forceinline__ void ssm_table_task(int g, int j, int lane, LAS float* scr, const float* a_re, const float* a_im, const float* log_dt, const float* b_re, const float* b_im,
                                               const float* c_re, const float* c_im, float* Kg, bf16* WE, bf16* BP, float* pw32) {
    const int p = lane;
    const float dt = expf(log_dt[g]), ar = a_re[g * 64 + p], ai = a_im[g * 64 + p];
#define pw(n) cpow_(ar, ai, dt, (n))
    const cpx lb = pw(1);
    const float den = ar * ar + ai * ai;
    const cpx coef = cpx{((lb.r - 1.f) * ar + lb.i * ai) / den, (lb.i * ar - (lb.r - 1.f) * ai) / den};
    const cpx pj = pw(j), pe = pw(31 - j), pv = pw(j + 1);
    unsigned wer[8], wei[8];
#pragma unroll
    for (int h2 = 0; h2 < 8; ++h2) { float er[2], ei[2];
#pragma unroll
        for (int q = 0; q < 2; ++q) { const int hi = 2 * h2 + q;
            const cpx bb = cmul(coef, cpx{b_re[(g * 64 + p) * 16 + hi], b_im[(g * 64 + p) * 16 + hi]});
            const cpx w = cmul(pj, bb); scr[(p * 16 + hi) * 2] = w.r; scr[(p * 16 + hi) * 2 + 1] = w.i;
            const cpx e = cmul(pe, bb); er[q] = e.r; ei[q] = e.i; }
        wer[h2] = pk2(er[0], er[1]); wei[h2] = pk2(ei[0], ei[1]); }
    { bf16* w0 = WE + ((size_t)(g * 256 + p) * 512 + j * 16); bf16* w1 = WE + ((size_t)(g * 256 + 64 + p) * 512 + j * 16);
      *(GAS v4u*)w0 = (v4u){wer[0], wer[1], wer[2], wer[3]}; *(GAS v4u*)(w0 + 8) = (v4u){wer[4], wer[5], wer[6], wer[7]};
      *(GAS v4u*)w1 = (v4u){wei[0], wei[1], wei[2], wei[3]}; *(GAS v4u*)(w1 + 8) = (v4u){wei[4], wei[5], wei[6], wei[7]};
      bf16* z0 = WE + ((size_t)(g * 256 + 128 + p) * 512 + j * 16); bf16* z1 = WE + ((size_t)(g * 256 + 192 + p) * 512 + j * 16); const v4u z = (v4u){0u, 0u, 0u, 0u};
      *(GAS v4u*)z0 = z; *(GAS v4u*)(z0 + 8) = z; *(GAS v4u*)z1 = z; *(GAS v4u*)(z1 + 8) = z; }
#pragma unroll 4
    for (int ho = 0; ho < 16; ++ho) { const cpx cv = cmul(cpx{c_re[(g * 16 + ho) * 64 + p], c_im[(g * 16 + ho) * 64 + p]}, pv);
        bf16* row = BP + ((size_t)(g * 512 + j * 16 + ho) * APK + 512);
        row[p] = (bf16)f2bf(cv.r); row[64 + p] = (bf16)f2bf(-cv.i); }
    if (j == 0) { const cpx p32 = pw(32); pw32[g * 128 + p] = p32.r; pw32[g * 128 + 64 + p] = p32.i; }
    LDS_WAIT(); asm volatile("" ::: "memory");
    { const int ho = lane >> 2, h4 = (lane & 3) * 4; float a0 = 0.f, a1 = 0.f, a2 = 0.f, a3 = 0.f;
      const float* cr = c_re + (g * 16 + ho) * 64; const float* ci = c_im + (g * 16 + ho) * 64;
#pragma unroll 4
      for (int pp = 0; pp < 64; ++pp) { const float r_ = cr[pp], i_ = ci[pp]; const LAS float* w = scr + (pp * 16 + h4) * 2;
          a0 += r_ * w[0] - i_ * w[1]; a1 += r_ * w[2] - i_ * w[3]; a2 += r_ * w[4] - i_ * w[5]; a3 += r_ * w[6] - i_ * w[7]; }
      *(GAS f32x4*)(Kg + ((size_t)(g * 32 + j) * 256 + ho * 16 + h4)) = (f32x4){a0, a1, a2, a3}; }
    LDS_WAIT(); asm volatile("" ::: "memory");
#undef pw
}

__device__ __forceinline__ float vmaxf(float a, float b) { float r; asm("v_max_f32_e32 %0, %1, %2" : "=v"(r) : "v"(a), "v"(b)); return r; }
__device__ __forceinline__ float vminf(float a, float b) { float r; asm("v_min_f32_e32 %0, %1, %2" : "=v"(r) : "v"(a), "v"(b)); return r; }
__device__ __forceinline__ float selhi(float lo, float hi) { float r; asm("v_cndmask_b32_e64 %0, %1, %2, %3" : "=v"(r) : "v"(lo), "v"(hi), "s"(0xFFFFFFFF00000000ull)); return r; }
#define CE_DESC(a, b) do { const float hi_ = vmaxf(a, b), lo_ = vminf(a, b); a = hi_; b = lo_; } while (0)
__device__ __forceinline__ void sort16_desc(float (&v)[16]) {
#pragma unroll
    for (int k = 2; k <= 16; k <<= 1)
#pragma unroll
        for (int j = k >> 1; j > 0; j >>= 1)
#pragma unroll
            for (int i = 0; i < 16; ++i) { const int l = i ^ j; if (l > i) { if ((i & k) == 0) CE_DESC(v[i], v[l]); else CE_DESC(v[l], v[i]); } }
}
__device__ __forceinline__ void bitonic_merge16_desc(float (&v)[16]) {
#pragma unroll
    for (int j = 8; j > 0; j >>= 1)
#pragma unroll
        for (int i = 0; i < 16; ++i) { const int l = i ^ j; if (l > i) CE_DESC(v[i], v[l]); }
}
__device__ __forceinline__ void merge_top16(float (&a)[16], const float (&b)[16]) {
#pragma unroll
    for (int i = 0; i < 16; ++i) a[i] = vmaxf(a[i], b[15 - i]);
    bitonic_merge16_desc(a);
}
__device__ __forceinline__ void merge_partner_top16(float (&a)[16]) {
    float p[16];
#pragma unroll
    for (int i = 0; i < 16; ++i) { const unsigned x = __float_as_uint(a[15 - i]); auto rr = __builtin_amdgcn_permlane32_swap(x, x, false, false); p[i] = selhi(__uint_as_float(rr[1]), __uint_as_float(rr[0])); }
#pragma unroll
    for (int i = 0; i < 16; ++i) a[i] = vmaxf(a[i], p[i]);
    bitonic_merge16_desc(a);
}
__device__ __forceinline__ void topk_half(int half, const bf16x8 (&qf)[8], int r32, int hi, const LAS unsigned char* ksl, float (&top)[16]) {
#pragma unroll 1
    for (int kt = 0; kt < 4; ++kt) {
        f32x16 acc = f32x16{};
        const int row = half * 128 + kt * 32 + r32; const LAS unsigned char* rp = ksl + row * 256; const int sw = row & 15;
#pragma unroll
        for (int ks = 0; ks < 8; ++ks) { const bf16x8 a = *(const LAS bf16x8*)(rp + (((2 * ks + hi) ^ sw) << 4));
            acc = __builtin_amdgcn_mfma_f32_32x32x16_bf16(a, qf[ks], acc, 0, 0, 0); }
        float grp[16];
#pragma unroll
        for (int r = 0; r < 16; ++r) { const unsigned key = (unsigned)(kt * 32 + (r & 3) + 8 * (r >> 2)) + 4u * (unsigned)hi; grp[r] = __uint_as_float((__float_as_uint(acc[r]) & ~127u) | key); }
        sort16_desc(grp);
        if (kt == 0) {
#pragma unroll
            for (int i = 0; i < 16; ++i) top[i] = grp[i];
        } else merge_top16(top, grp);
    }
    merge_partner_top16(top);
}
__device__ __forceinline__ void topk_task(int tt, int hd, int lane, LAS unsigned char* scr, const bf16* PQb, const LAS unsigned char* ksl, const float* ssq1, int* ids, float* gts, float* rstd1) {
    const int r32 = lane & 31, hi = lane >> 5; const bool hib = hi != 0;
    const int token = tt * 32 + r32;
    float v0_[16], v1_[16];
    bf16x8 qf0[8], qf1[8];
#pragma unroll
    for (int ks = 0; ks < 8; ++ks) { qf0[ks] = *(const GAS bf16x8*)(PQb + (size_t)token * PQ + hd * 256 + ks * 16 + hi * 8); qf1[ks] = *(const GAS bf16x8*)(PQb + (size_t)token * PQ + hd * 256 + 128 + ks * 16 + hi * 8); }
    topk_half(0, qf0, r32, hi, ksl, v0_);
    topk_half(1, qf1, r32, hi, ksl, v1_);
#define v_SEL(h, i) ((h) ? v1_[i] : v0_[i])
    LAS unsigned char* slot = scr + lane * 32;
    { v4u d0, d1;
#define PK4(h, k) ((__float_as_uint(v_SEL(h, 4 * (k))) & 127u) | ((__float_as_uint(v_SEL(h, 4 * (k) + 1)) & 127u) << 8) | ((__float_as_uint(v_SEL(h, 4 * (k) + 2)) & 127u) << 16) | ((__float_as_uint(v_SEL(h, 4 * (k) + 3)) & 127u) << 24))
      d0 = (v4u){PK4(0, 0), PK4(0, 1), PK4(0, 2), PK4(0, 3)}; d1 = (v4u){PK4(1, 0), PK4(1, 1), PK4(1, 2), PK4(1, 3)};
#undef PK4
      *(LAS v4u*)slot = d0; *(LAS v4u*)(slot + 16) = d1; }
    float a[16], b[16];
#pragma unroll
    for (int i = 0; i < 16; ++i) { a[i] = selhi(v0_[i], v1_[i]); b[i] = selhi(v1_[i], v0_[i]); }
    const unsigned obit = (unsigned)hi << 8;
#define CAND(i, j) __uint_as_float((__float_as_uint(a[i] + b[j]) & ~511u) | obit | (unsigned)(((i) << 4) | (j)))
    const float NEGBIG = -3.0e38f;
    float g0[16], g1[16];
#pragma unroll
    for (int j = 1; j < 16; ++j) g0[j - 1] = CAND(0, j);
    g0[15] = CAND(1, 2);
    g1[0] = CAND(1, 3); g1[1] = CAND(1, 4); g1[2] = CAND(1, 5); g1[3] = CAND(1, 6); g1[4] = CAND(1, 7); g1[5] = CAND(2, 3); g1[6] = CAND(2, 4);
    { const float c0 = CAND(0, 0), c1 = CAND(1, 1), c2 = CAND(2, 2), c3 = CAND(3, 3);
      g1[7] = selhi(c0, NEGBIG); g1[8] = selhi(c1, NEGBIG); g1[9] = selhi(c2, NEGBIG); g1[10] = selhi(c3, NEGBIG); }
#pragma unroll
    for (int i = 11; i < 16; ++i) g1[i] = NEGBIG;
#undef CAND
    sort16_desc(g0); sort16_desc(g1); merge_top16(g0, g1); merge_partner_top16(g0);
    float rstd;
    { const GAS f32x4* sp = (const GAS f32x4*)(ssq1 + (size_t)token * 16); const f32x4 s0 = sp[0], s1 = sp[1], s2 = sp[2], s3 = sp[3];
      const float ss = ((s0.x + s0.y) + (s0.z + s0.w)) + ((s1.x + s1.y) + (s1.z + s1.w)) + ((s2.x + s2.y) + (s2.z + s2.w)) + ((s3.x + s3.y) + (s3.z + s3.w));
      rstd = 1.0f / sqrtf(ss * (1.f / DMODEL) + RMS_EPS); }
    if (hd == 0 && !hib) rstd1[token] = rstd;
    float ex[16], esum = 0.f; const float sc = rstd * 1.4426950409f;
#pragma unroll
    for (int k = 0; k < 16; ++k) { ex[k] = __builtin_amdgcn_exp2f((g0[k] - g0[0]) * sc); esum += ex[k]; }
    const float inv = 1.0f / esum;
    int eid[8]; float gv[8];
#pragma unroll
    for (int k = 0; k < 8; ++k) { const float wv = selhi(g0[k], g0[8 + k]); const float ev = selhi(ex[k], ex[8 + k]);
        const unsigned tag = __float_as_uint(wv) & 511u, o = tag >> 8, i = (tag >> 4) & 15u, j = tag & 15u; const unsigned i1 = o ? j : i, i2 = o ? i : j;
        const unsigned k1 = slot[i1], k2 = slot[16 + i2];
        eid[k] = (int)(k1 * 128u + k2); gv[k] = ev * inv; }
    { int* ip = ids + (size_t)token * 128 + hd * 16 + 8 * hi; float* gp = gts + (size_t)token * 128 + hd * 16 + 8 * hi;
      *(GAS v4u*)ip = (v4u){(unsigned)eid[0], (unsigned)eid[1], (unsigned)eid[2], (unsigned)eid[3]}; *(GAS v4u*)(ip + 4) = (v4u){(unsigned)eid[4], (unsigned)eid[5], (unsigned)eid[6], (unsigned)eid[7]};
      *(GAS f32x4*)gp = (f32x4){gv[0], gv[1], gv[2], gv[3]}; *(GAS f32x4*)(gp + 4) = (f32x4){gv[4], gv[5], gv[6], gv[7]}; }
    LDS_WAIT(); asm volatile("" ::: "memory");
}


__device__ __forceinline__ float dot2bf(unsigned a, unsigned b, float c) { return __builtin_amdgcn_fdot2_f32_bf16(__builtin_bit_cast(bf16x2_t, a), __builtin_bit_cast(bf16x2_t, b), c, false); }
__device__ __forceinline__ h2_t fma_h2(unsigned v, h2_t w, h2_t acc) { return __builtin_elementwise_fma(__builtin_bit_cast(h2_t, v), w, acc); }
__device__ __forceinline__ unsigned fp8lo_bf(unsigned w, float sc) { return __builtin_bit_cast(unsigned, __builtin_amdgcn_cvt_scalef32_pk_bf16_fp8((int)w, sc, false)); }
__device__ __forceinline__ unsigned fp8hi_bf(unsigned w, float sc) { return __builtin_bit_cast(unsigned, __builtin_amdgcn_cvt_scalef32_pk_bf16_fp8((int)w, sc, true)); }
__device__ __forceinline__ h2_t fp8lo_h(unsigned w, float sc) { return __builtin_amdgcn_cvt_scalef32_pk_f16_fp8((int)w, sc, false); }
__device__ __forceinline__ h2_t fp8hi_h(unsigned w, float sc) { return __builtin_amdgcn_cvt_scalef32_pk_f16_fp8((int)w, sc, true); }
__device__ __forceinline__ unsigned pack_fp8x4(float a, float b, float c, float d) { int w = __builtin_amdgcn_cvt_pk_fp8_f32(a, b, 0, false); w = __builtin_amdgcn_cvt_pk_fp8_f32(c, d, w, true); return (unsigned)w; }
constexpr size_t V6B_OFF = 8u << 20;
constexpr float U8_SCALE = 64.0f, V8_SCALE = 5.656854f;
constexpr int PA_CAP = 456;
constexpr float X8_SCALE = 2.0f;
typedef int v8i_t __attribute__((ext_vector_type(8)));
typedef _Float16 v32h_t __attribute__((ext_vector_type(32)));
typedef unsigned v6u_t __attribute__((ext_vector_type(6)));
typedef unsigned v2u __attribute__((ext_vector_type(2)));
struct TokB { v8i_t b[8]; };
struct RowsA { const unsigned char* p0; const unsigned char* p1; };
__device__ __forceinline__ int pa_tok(unsigned tl, int tb, int nwg) { return ((tl < 4u) ? tb : nwg) + (int)(tl & 3u); }
__device__ __forceinline__ RowsA pa_rows(int b, int n, int lane, const LAS unsigned* list, const unsigned char* U6) {
    const int i0 = b * 16 + (lane >> 3), r8 = lane >> 3, ps = lane & 7;
    const unsigned e0 = list[i0 < n ? i0 : 0], e1 = list[i0 + 8 < n ? i0 + 8 : 0];
    RowsA R; R.p0 = U6 + (size_t)(e0 & 0x3fffu) * 768 + ((ps ^ r8) * 16); R.p1 = U6 + (size_t)(e1 & 0x3fffu) * 768 + ((ps ^ r8 ^ 1) * 16);
    return R;
}
template <int J> __device__ __forceinline__ void pa_dma(const RowsA& R, LAS unsigned char* ring) {
    __builtin_amdgcn_global_load_lds((const unsigned*)R.p0, (LAS unsigned*)(ring + J * (2048 - 128)), 16, J * 128, 0);
    __builtin_amdgcn_global_load_lds((const unsigned*)R.p1, (LAS unsigned*)(ring + J * (2048 - 128) + 1024), 16, J * 128, 0);
}
#define PA_VWAIT(n) asm volatile("s_waitcnt vmcnt(" #n ")" ::: "memory")
#define PA_LWAIT(n) asm volatile("s_waitcnt lgkmcnt(" #n ")" ::: "memory")
__device__ __forceinline__ int pa_uoff(int u, int r) { return (u >> 4) * 2048 + (r >> 3) * 1024 + (r & 7) * 128 + ((((u >> 1) & 7) ^ (r & 7) ^ (r >> 3)) << 4) + (u & 1) * 8; }
struct OpA { v2u d0, d1, d2; };
__device__ __forceinline__ OpA pa_rd(int m, const LAS unsigned char* ring, int r, int g) { const int u = 12 * m + 3 * g; OpA a;
    a.d0 = *(const LAS v2u*)(ring + pa_uoff(u, r)); a.d1 = *(const LAS v2u*)(ring + pa_uoff(u + 1, r)); a.d2 = *(const LAS v2u*)(ring + pa_uoff(u + 2, r)); return a; }
__device__ __forceinline__ f32x4 pa_mm(f32x4 acc, const OpA& a, const TokB& X, int m) {
    return __builtin_amdgcn_mfma_scale_f32_16x16x128_f8f6f4((v8i_t){(int)a.d0.x, (int)a.d0.y, (int)a.d1.x, (int)a.d1.y, (int)a.d2.x, (int)a.d2.y, 0, 0}, X.b[m], acc, 2, 2, 0, 0, 0, 0);
}
__device__ __forceinline__ void pa_flush(int n, const TokB& X, int lane, LAS unsigned* list, const LAS unsigned* gl, LAS unsigned char* ring, const unsigned char* U6, unsigned* wpk, int tb, int nwg) {
    if (n == 0) return;
    LDS_WAIT(); asm volatile("" ::: "memory");
    const int nb = (n + 15) >> 4;
    const int r = lane & 15, g = lane >> 4;
    RowsA cur = pa_rows(0, n, lane, list, U6), nxt = cur;
    pa_dma<0>(cur, ring); pa_dma<1>(cur, ring); pa_dma<2>(cur, ring); pa_dma<3>(cur, ring); pa_dma<4>(cur, ring); pa_dma<5>(cur, ring);
    for (int b = 0; b < nb; ++b) {
        f32x4 acc0 = {0.f, 0.f, 0.f, 0.f}, acc1 = {0.f, 0.f, 0.f, 0.f};
        OpA A0, A1;
        if (b + 1 < nb) {
            nxt = pa_rows(b + 1, n, lane, list, U6);
            PA_VWAIT(10); A0 = pa_rd(0, ring, r, g);
            PA_VWAIT(8);  A1 = pa_rd(1, ring, r, g); PA_LWAIT(3); acc0 = pa_mm(acc0, A0, X, 0);
            PA_VWAIT(6);  A0 = pa_rd(2, ring, r, g); PA_LWAIT(3); acc1 = pa_mm(acc1, A1, X, 1); pa_dma<0>(nxt, ring);
                          A1 = pa_rd(3, ring, r, g); PA_LWAIT(3); acc0 = pa_mm(acc0, A0, X, 2); pa_dma<1>(nxt, ring);
            PA_VWAIT(8);  A0 = pa_rd(4, ring, r, g); PA_LWAIT(3); acc1 = pa_mm(acc1, A1, X, 3); pa_dma<2>(nxt, ring);
            PA_VWAIT(8);  A1 = pa_rd(5, ring, r, g); PA_LWAIT(3); acc0 = pa_mm(acc0, A0, X, 4);
            PA_VWAIT(6);  A0 = pa_rd(6, ring, r, g); PA_LWAIT(3); acc1 = pa_mm(acc1, A1, X, 5); pa_dma<3>(nxt, ring);
                          A1 = pa_rd(7, ring, r, g); PA_LWAIT(3); acc0 = pa_mm(acc0, A0, X, 6); pa_dma<4>(nxt, ring);
                                                     PA_LWAIT(0); acc1 = pa_mm(acc1, A1, X, 7); pa_dma<5>(nxt, ring);
            cur = nxt;
        } else {
            PA_VWAIT(0);
            A0 = pa_rd(0, ring, r, g);
#pragma unroll
            for (int m = 0; m < 8; m += 2) { A1 = pa_rd(m + 1, ring, r, g); PA_LWAIT(3); acc0 = pa_mm(acc0, A0, X, m);
                if (m + 2 < 8) { A0 = pa_rd(m + 2, ring, r, g); PA_LWAIT(3); } else PA_LWAIT(0);
                acc1 = pa_mm(acc1, A1, X, m + 1); }
        }
        const f32x4 acc = acc0 + acc1;
        const int idx = b * 16 + r; const unsigned ent = list[idx], tl = ent >> 21, slot = (ent >> 14) & 127u;
        const int src = (int)((((unsigned)r >> 2) * 16u + tl) << 2);
        const float v0 = __int_as_float(__builtin_amdgcn_ds_bpermute(src, __float_as_int(acc.x))), v1 = __int_as_float(__builtin_amdgcn_ds_bpermute(src, __float_as_int(acc.y)));
        const float v2 = __int_as_float(__builtin_amdgcn_ds_bpermute(src, __float_as_int(acc.z))), v3 = __int_as_float(__builtin_amdgcn_ds_bpermute(src, __float_as_int(acc.w)));
        const float dv = (r & 2) ? ((r & 1) ? v3 : v2) : ((r & 1) ? v1 : v0);
        if (lane < 16 && idx < n) { const int t = pa_tok(tl, tb, nwg);
            const _Float16 wh = (_Float16)(__uint_as_float(gl[tl * 128 + slot]) * (1.0f / V8_SCALE) * gelu_tanh(dv * (1.0f / (U8_SCALE * X8_SCALE))));
            const unsigned pos = __hip_atomic_fetch_add((LAS unsigned*)(list + PA_CAP) + tl, 1u, __ATOMIC_RELAXED, __HIP_MEMORY_SCOPE_WAVEFRONT);
            wpk[(size_t)t * 128 + pos] = ((unsigned)__builtin_bit_cast(unsigned short, wh) << 16) | (ent & 0x3fffu); }
    }
    LDS_WAIT(); asm volatile("" ::: "memory");
}
__device__ __forceinline__ void peer_a_phase(int lane, int wave, int G, int vcu, const bf16* XG, const unsigned char* U6, const int* ids, const float* gts, const float* rstd1, unsigned* wpk, LAS unsigned char* lds, int emask) {
    (void)emask;
    LAS unsigned char* ring = lds + RING_OFF + wave * 16384;
    LAS unsigned* gl = (LAS unsigned*)(ring + 12288);
    LAS unsigned* list = (LAS unsigned*)(lds + MISC_OFF + 128 + wave * (464 * 4));
    for (int tile0 = vcu; tile0 < MTOK / 32; tile0 += 2 * G) {
        const int tile1 = tile0 + G; const bool has1 = tile1 < MTOK / 32;
        const int tb = tile0 * 32 + wave * 4, nwg = (has1 ? tile1 : tile0) * 32 + wave * 4;
        int id0[8], id1[8];
        if (lane < 8) list[PA_CAP + lane] = 0u;
#pragma unroll
        for (int k = 0; k < 8; ++k) { const bool ok = (k < 4) || has1; const int tc = pa_tok((unsigned)k, tb, nwg);
            gl[k * 128 + lane] = __float_as_uint(gts[(size_t)tc * 128 + lane]); gl[k * 128 + 64 + lane] = __float_as_uint(gts[(size_t)tc * 128 + 64 + lane]);
            id0[k] = ok ? ids[(size_t)tc * 128 + lane] : -1; id1[k] = ok ? ids[(size_t)tc * 128 + 64 + lane] : -1; }
#pragma unroll
        for (int p = 0; p < 4; ++p) { const int k = 2 * p + (lane >> 5), tc = pa_tok((unsigned)k, tb, nwg);
            typedef float v16f_t __attribute__((ext_vector_type(16)));
            const GAS v4u* xs = (const GAS v4u*)(XG + (size_t)tc * 1024 + 32 * (lane & 31));
            const v4u x0 = xs[0], x1 = xs[1], x2 = xs[2], x3 = xs[3];
            const float rs = rstd1[tc] * X8_SCALE;
            const unsigned w[16] = {x0.x, x0.y, x0.z, x0.w, x1.x, x1.y, x1.z, x1.w, x2.x, x2.y, x2.z, x2.w, x3.x, x3.y, x3.z, x3.w};
            float f[32];
#pragma unroll
            for (int i = 0; i < 16; ++i) { f[2 * i] = __uint_as_float(w[i] << 16) * rs; f[2 * i + 1] = __uint_as_float(w[i] & 0xffff0000u) * rs; }
            const v16f_t lo16 = {f[0], f[1], f[2], f[3], f[4], f[5], f[6], f[7], f[8], f[9], f[10], f[11], f[12], f[13], f[14], f[15]},
                         hi16 = {f[16], f[17], f[18], f[19], f[20], f[21], f[22], f[23], f[24], f[25], f[26], f[27], f[28], f[29], f[30], f[31]};
            v6u_t p6; asm volatile("s_nop 1\n\tv_cvt_scalef32_2xpk16_fp6_f32 %0, %1, %2, 1.0" : "=&v"(p6) : "v"(lo16), "v"(hi16));
            LAS v2u* dst = (LAS v2u*)(ring + k * 768 + 24 * (lane & 31)); dst[0] = (v2u){p6[0], p6[1]}; dst[1] = (v2u){p6[2], p6[3]}; dst[2] = (v2u){p6[4], p6[5]}; }
        LDS_WAIT(); asm volatile("" ::: "memory");
        TokB X;
#pragma unroll
        for (int m = 0; m < 8; ++m) { const LAS v2u* xp = (const LAS v2u*)(ring + (lane & 7) * 768 + m * 96 + (lane >> 4) * 24);
            const v2u d0 = xp[0], d1 = xp[1], d2 = xp[2];
            X.b[m] = (v8i_t){(int)d0.x, (int)d0.y, (int)d1.x, (int)d1.y, (int)d2.x, (int)d2.y, 0, 0}; }
        LDS_WAIT(); asm volatile("" ::: "memory");
        int n = 0;
        for (int part = 0; part < 8; ++part) {
#pragma unroll
            for (int k = 0; k < 8; ++k) {
                { const bool sel = (id0[k] >> 11) == part; const unsigned long long m = __ballot(sel);
                  const int pos = n + (int)__builtin_amdgcn_mbcnt_hi((unsigned)(m >> 32), __builtin_amdgcn_mbcnt_lo((unsigned)m, 0u));
                  if (sel) list[pos] = ((unsigned)k << 21) | ((unsigned)lane << 14) | (unsigned)id0[k]; n += __builtin_popcountll(m); }
                { const bool sel = (id1[k] >> 11) == part; const unsigned long long m = __ballot(sel);
                  const int pos = n + (int)__builtin_amdgcn_mbcnt_hi((unsigned)(m >> 32), __builtin_amdgcn_mbcnt_lo((unsigned)m, 0u));
                  if (sel) list[pos] = ((unsigned)k << 21) | ((unsigned)(64 + lane) << 14) | (unsigned)id1[k]; n += __builtin_popcountll(m); }
                if (n > PA_CAP - 128) { pa_flush(n, X, lane, list, gl, ring, U6, wpk, tb, nwg); n = 0; }
            }
        }
        pa_flush(n, X, lane, list, gl, ring, U6, wpk, tb, nwg);
    }
}
__device__ __forceinline__ void final_token(int t, int lane, const unsigned short* Y16, float* X1, const float* fg) {
    GAS f32x4* xp = (GAS f32x4*)(X1 + (size_t)t * 1024 + 8 * lane);
    f32x4 x0 = xp[0], x1 = xp[1], x2 = xp[128], x3 = xp[129];
    const v4u ya = *(const GAS v4u*)(Y16 + (size_t)t * 1024 + 8 * lane), yb = *(const GAS v4u*)(Y16 + (size_t)t * 1024 + 512 + 8 * lane);
    const unsigned yw[8] = {ya.x, ya.y, ya.z, ya.w, yb.x, yb.y, yb.z, yb.w};
    float y[16];
#pragma unroll
    for (int i = 0; i < 8; ++i) { const unsigned w = yw[i]; const h2_t h = __builtin_bit_cast(h2_t, w); y[2 * i] = (float)h[0]; y[2 * i + 1] = (float)h[1]; }
    x0 += (f32x4){y[0], y[1], y[2], y[3]}; x1 += (f32x4){y[4], y[5], y[6], y[7]}; x2 += (f32x4){y[8], y[9], y[10], y[11]}; x3 += (f32x4){y[12], y[13], y[14], y[15]};
    float ss = (x0.x * x0.x + x0.y * x0.y) + (x0.z * x0.z + x0.w * x0.w) + (x1.x * x1.x + x1.y * x1.y) + (x1.z * x1.z + x1.w * x1.w)
             + (x2.x * x2.x + x2.y * x2.y) + (x2.z * x2.z + x2.w * x2.w) + (x3.x * x3.x + x3.y * x3.y) + (x3.z * x3.z + x3.w * x3.w);
    const float rstd2 = 1.0f / sqrtf(wave_sum(ss) * (1.f / DMODEL) + RMS_EPS);
    const GAS f32x4* gp = (const GAS f32x4*)(fg + 8 * lane);
    xp[0] = x0 * rstd2 * gp[0]; xp[1] = x1 * rstd2 * gp[1]; xp[128] = x2 * rstd2 * gp[128]; xp[129] = x3 * rstd2 * gp[129];
}
#ifndef REP_0
#define REP_0 1
#endif
#ifndef REP_1
#define REP_1 1
#endif
#ifndef REP_2
#define REP_2 1
#endif
#ifndef REP_3
#define REP_3 1
#endif
#ifndef REP_4
#define REP_4 1
#endif
#ifndef REP_5
#define REP_5 1
#endif
#ifndef REP_6
#define REP_6 1
#endif
#ifndef REP_7
#define REP_7 1
#endif
#ifndef REP_8
#define REP_8 1
#endif
#ifndef REP_9
#define REP_9 1
#endif
#ifndef REP_10
#define REP_10 1
#endif
#ifndef REP_11
#define REP_11 1
#endif
__device__ __forceinline__ void pb_rows(v4u* Ra, v2u* Rb, const v4u w, const unsigned char* vbase, size_t vboff) {
    const unsigned pw[4] = {w.x, w.y, w.z, w.w};
#pragma unroll
    for (int i = 0; i < 4; ++i) { const size_t e = pw[i] & 0xffffu; Ra[i] = *(const GAS v4u*)(vbase + e * 256); Rb[i] = *(const GAS v2u*)(vbase + vboff + e * 128); }
}
__device__ __forceinline__ void pb_fma(h2_t (&acc)[16], const v4u* Ra, const v2u* Rb, const v4u w) {
    const unsigned pw[4] = {w.x, w.y, w.z, w.w};
#pragma unroll
    for (int i = 0; i < 4; ++i) { const unsigned p = pw[i], wb = (p & 0xffff0000u) | (p >> 16); const h2_t w2 = __builtin_bit_cast(h2_t, wb);
        const v4u ra = Ra[i]; const v2u rb = Rb[i]; const v6u_t x6 = {ra.x, ra.y, ra.z, ra.w, rb.x, rb.y};
        v32h_t h; asm("v_cvt_scalef32_pk32_f16_fp6 %0, %1, 1.0" : "=&v"(h) : "v"(x6));
#pragma unroll
        for (int j = 0; j < 16; ++j) { const h2_t hv = {h[2 * j], h[2 * j + 1]}; acc[j] = __builtin_elementwise_fma(hv, w2, acc[j]); } }
}
__device__ __forceinline__ void peer_b_phase(int lane, int wave, int G, int vcu, const unsigned char* V6s, const unsigned* wpk, unsigned short* Y16, float* X1, const float* fg, bool fin) {
    const int q = lane & 15;
    for (int tile0 = vcu; tile0 < MTOK / 32; tile0 += 2 * G) {
        const int tile1 = tile0 + G; const bool has1 = tile1 < MTOK / 32;
        const int tb = tile0 * 32 + wave * 4, nwg = (has1 ? tile1 : tile0) * 32 + wave * 4;
        for (int pass = 0; pass < 4; ++pass) { const int hc = pass >> 1, k = (lane >> 4) + 4 * (pass & 1);
            const int t = pa_tok((unsigned)k, tb, nwg);
            const unsigned* wrow = wpk + (size_t)t * 128;
            const unsigned char* vbase = V6s + (size_t)hc * NEXP * 256 + q * 16;
            const size_t vboff = V6B_OFF + (size_t)hc * NEXP * 128 + q * 8 - ((size_t)hc * NEXP * 256 + q * 16);
            h2_t acc[16];
#pragma unroll
            for (int j = 0; j < 16; ++j) acc[j] = (h2_t){(_Float16)0.f, (_Float16)0.f};
            v4u W[6], Ra[16]; v2u Rb[16];
#pragma unroll
            for (int u = 0; u < 6; ++u) W[u] = *(const GAS v4u*)(wrow + 4 * u);
#pragma unroll
            for (int u = 0; u < 4; ++u) pb_rows(Ra + 4 * u, Rb + 4 * u, W[u], vbase, vboff);
#pragma unroll
            for (int u = 0; u < 32; ++u) {
                pb_fma(acc, Ra + 4 * (u & 3), Rb + 4 * (u & 3), W[u % 6]);
                if (u + 4 < 32) pb_rows(Ra + 4 * (u & 3), Rb + 4 * (u & 3), W[(u + 4) % 6], vbase, vboff);
                if (u + 6 < 32) W[u % 6] = *(const GAS v4u*)(wrow + 4 * (u + 6));
            }
            GAS v4u* yout = (GAS v4u*)(Y16 + (size_t)t * 1024 + hc * 512 + q * 32);
#pragma unroll
            for (int j = 0; j < 4; ++j) yout[j] = (v4u){__builtin_bit_cast(unsigned, acc[4 * j]), __builtin_bit_cast(unsigned, acc[4 * j + 1]), __builtin_bit_cast(unsigned, acc[4 * j + 2]), __builtin_bit_cast(unsigned, acc[4 * j + 3])};
        }
        asm volatile("s_waitcnt vmcnt(0)" ::: "memory");
        if (fin) for (int kk = 0; kk < (has1 ? 8 : 4); ++kk) final_token(pa_tok((unsigned)kk, tb, nwg), lane, Y16, X1, fg);
    }
}
template <int NR> __device__ __forceinline__ void cvt_load(f32x4 (&q)[NR / 2][8], const float* table, int ex, int stride, int lane) {
#pragma unroll
    for (int k = 0; k < NR / 2; ++k) { const int e = ex + (2 * k + (lane >> 5)) * stride; const float* src = table + (size_t)(e < NEXP ? e : ex) * 1024 + 32 * (lane & 31);
#pragma unroll
        for (int j = 0; j < 8; ++j) q[k][j] = *(const GAS f32x4*)(src + 4 * j); }
}
template <int NR> __device__ __forceinline__ void cvt_store(const f32x4 (&q)[NR / 2][8], int ex, int stride, bool isv, int lane, unsigned char* U8, unsigned char* V8) {
    typedef float v16f_t __attribute__((ext_vector_type(16)));
#pragma unroll
    for (int k = 0; k < NR / 2; ++k) { const int e = ex + (2 * k + (lane >> 5)) * stride; if (e < NEXP) {
        if (!isv) {
            float f[32];
#pragma unroll
            for (int j = 0; j < 8; ++j) { const f32x4 t = q[k][j] * U8_SCALE; f[4 * j] = t.x; f[4 * j + 1] = t.y; f[4 * j + 2] = t.z; f[4 * j + 3] = t.w; }
            const v16f_t lo16 = {f[0], f[1], f[2], f[3], f[4], f[5], f[6], f[7], f[8], f[9], f[10], f[11], f[12], f[13], f[14], f[15]},
                         hi16 = {f[16], f[17], f[18], f[19], f[20], f[21], f[22], f[23], f[24], f[25], f[26], f[27], f[28], f[29], f[30], f[31]};
            v6u_t p6; asm volatile("s_nop 1\n\tv_cvt_scalef32_2xpk16_fp6_f32 %0, %1, %2, 1.0" : "=&v"(p6) : "v"(lo16), "v"(hi16));
            GAS v2u* dst = (GAS v2u*)(U8 + (size_t)e * 768 + 24 * (lane & 31)); dst[0] = (v2u){p6[0], p6[1]}; dst[1] = (v2u){p6[2], p6[3]}; dst[2] = (v2u){p6[4], p6[5]};
        } else {
            v32h_t h;
#pragma unroll
            for (int j = 0; j < 8; ++j) { const f32x4 t = q[k][j] * V8_SCALE; h[4 * j] = (_Float16)t.x; h[4 * j + 1] = (_Float16)t.y; h[4 * j + 2] = (_Float16)t.z; h[4 * j + 3] = (_Float16)t.w; }
            v6u_t p6; asm volatile("s_nop 1\n\tv_cvt_scalef32_pk32_fp6_f16 %0, %1, 1.0" : "=&v"(p6) : "v"(h));
            const size_t ro = (size_t)((lane & 31) >> 4) * NEXP + e;
            *(GAS v4u*)(V8 + ro * 256 + (lane & 15) * 16) = (v4u){p6[0], p6[1], p6[2], p6[3]}; *(GAS v2u*)(V8 + V6B_OFF + ro * 128 + (lane & 15) * 8) = (v2u){p6[4], p6[5]}; } } }
}
struct OnePanel { int pm, n; __device__ __forceinline__ bool next(int i, pg8::Unit& u) const { if (i >= n) return false; u.pm = pm; u.pn = i; u.w = 0; return true; } };
struct DualOrder { pg8::StaticOrder S; __device__ __forceinline__ bool next(int i, pg8::Unit& u) const { if (!S.next(i >> 1, u)) return false; u.w = i & 1; return true; } };
struct Args { const float* in[24]; float* out; unsigned char* ws; int ph_lo, ph_hi, li, pad; };
__global__ void __launch_bounds__(NWAVES * 64, 2) mk_fwd(Args args) {
    extern __shared__ __attribute__((aligned(16))) unsigned char lds[];
    Frame F;
    F.lds = (LAS unsigned char*)lds;
    volatile LAS unsigned* MISC = (volatile LAS unsigned*)(F.lds + MISC_OFF);
    F.tid = threadIdx.x; F.lane = F.tid & 63; F.wave = __builtin_amdgcn_readfirstlane(F.tid >> 6);
    F.G = gridDim.x; { const int bx = blockIdx.x; F.vcu = (F.G % 8 == 0) ? (bx % 8) * (F.G / 8) + bx / 8 : bx; }
    unsigned char* ws = args.ws;
    gu32* ctl = (gu32*)(ws + WS_CTL);
    for (int u = F.tid; u < (LDS_BYTES - LDSCTL_OFF) / 4; u += NWAVES * 64) ((LAS unsigned*)(F.lds + LDSCTL_OFF))[u] = 0u;
    __syncthreads();
    XcdBarrier bar; bar.bar = (unsigned*)(ctl + CW_BAR); bar.x = 0; bar.st = nullptr;
    if (N_LAUNCHES != PER_PHASE) bar = xcd_barrier_post((unsigned*)(ctl + CW_BAR), MISC + 8);
#define GRID_BAR() do { if (N_LAUNCHES != PER_PHASE) xcd_barrier(bar); } while (0)
    const int lo = args.ph_lo, hi = args.ph_hi;
#ifndef PH_MASK
#define PH_MASK 0xFFFF
#endif
#define IN(k) ((((PH_MASK) >> (k)) & 1) && lo <= (k) && (k) < hi)
#define BOTH(k) (IN(k) && IN((k) + 1))
    const int gw = F.vcu * NWAVES + F.wave, NGW = F.G * NWAVES;
    const int gtid = F.vcu * (NWAVES * 64) + F.tid, NTHR = F.G * NWAVES * 64;
    const float* x = args.in[0];
    bf16* Win_t = (bf16*)(ws + WS_WIN); bf16* Wq_t = (bf16*)(ws + WS_WQ); bf16* Wout_t = (bf16*)(ws + WS_WOUT); bf16* Wus_t = (bf16*)(ws + WS_WUS); bf16* Wua_t = (bf16*)(ws + WS_WUA);
    bf16* Wglu_t = (bf16*)(ws + WS_WGLU); bf16* KSb = (bf16*)(ws + WS_KS); bf16* WE = (bf16*)(ws + WS_WE); bf16* BP = (bf16*)(ws + WS_BP); bf16* AP = (bf16*)(ws + WS_AP);
    float* Eb = (float*)(ws + WS_E); bf16* Hb = (bf16*)(ws + WS_H); bf16* Ypre = (bf16*)(ws + WS_YPRE); bf16* Ya = (bf16*)(ws + WS_YA); bf16* XG = (bf16*)(ws + WS_XG);
    bf16* Zb = (bf16*)(ws + WS_Z); bf16* Qb = (bf16*)(ws + WS_Z + 1 * ZSTRIDE_B); bf16* Kb = (bf16*)(ws + WS_Z + 2 * ZSTRIDE_B); bf16* Vb = (bf16*)(ws + WS_Z + 3 * ZSTRIDE_B);
    bf16* GA = (bf16*)(ws + WS_Z + 4 * ZSTRIDE_B); bf16* GB = (bf16*)(ws + WS_Z + 6 * ZSTRIDE_B);
    bf16* Yb = (bf16*)(ws + WS_YB); bf16* Mrg = (bf16*)(ws + WS_MRG); bf16* PQb = (bf16*)(ws + WS_PQ); int* ids = (int*)(ws + WS_IDS); float* gts = (float*)(ws + WS_GTS);
    unsigned char* U8 = ws + WS_U16; unsigned char* V8 = ws + WS_V16; unsigned* wpk = (unsigned*)(ws + WS_WPK); float* rstd1 = (float*)(ws + WS_RSTD1); unsigned short* Y16 = (unsigned short*)(ws + WS_Y16);
    float* biasT = (float*)(ws + WS_BIAS); float* pw32 = (float*)(ws + WS_PW32); float* kpart = (float*)(ws + WS_KPART); float* Kg = (float*)(ws + WS_KG); float* ssq1 = (float*)(ws + WS_SSQ1);

    if (IN(0)) for (int rep_ = 0; rep_ < REP_0; ++rep_) {
        LAS float* scr = (LAS float*)(F.lds + RING_OFF + F.wave * 16384);
        constexpr int I_IN = (1024 / 64) * (4096 / 32), I_GLU = (512 / 64) * (512 / 32), I_UP = (512 / 64) * (1024 / 32), I_OUT = (1024 / 64) * (1024 / 32), I_Q = (1024 / 64) * (2048 / 32);
        constexpr int NITEMS = I_IN + I_GLU + 2 * I_UP + I_OUT + I_Q;
        for (int it = gw; it < NITEMS; it += NGW) {
            int r = it;
            if (r < I_IN) { p0_transpose_item(args.in[2], 1024, 4096, Win_t, scr, r, F.lane); continue; } r -= I_IN;
            if (r < I_GLU) { p0_transpose_item(args.in[11], 512, 512, Wglu_t, scr, r, F.lane); continue; } r -= I_GLU;
            if (r < I_UP) { p0_transpose_item(args.in[13], 512, 1024, Wus_t, scr, r, F.lane); continue; } r -= I_UP;
            if (r < I_UP) { p0_transpose_item(args.in[14], 512, 1024, Wua_t, scr, r, F.lane); continue; } r -= I_UP;
            if (r < I_OUT) { p0_transpose_item(args.in[16], 1024, 1024, Wout_t, scr, r, F.lane); continue; } r -= I_OUT;
            p0_transpose_item(args.in[18], 1024, 2048, Wq_t, scr, r, F.lane);
        }
        for (int it = gw; it < NGRP * CH; it += NGW)
            ssm_table_task(it >> 5, it & 31, F.lane, scr, args.in[3], args.in[4], args.in[5], args.in[6], args.in[7], args.in[8], args.in[9], Kg, WE, BP, pw32);
        for (int m = gw; m < MTOK; m += NGW * 4) rms_rows4_to_bf16(x, args.in[1], Hb, m, NGW, F.lane);
        for (int it = gw; it < 64; it += NGW) { const float* src = (it < 32 ? args.in[19] : args.in[20]) + (size_t)(it & 31) * 512 + 8 * F.lane;
            const f32x4 a = *(const GAS f32x4*)src, b = *(const GAS f32x4*)(src + 4);
            *(GAS v4u*)(KSb + (size_t)it * 512 + 8 * F.lane) = (v4u){pk2(a.x, a.y), pk2(a.z, a.w), pk2(b.x, b.y), pk2(b.z, b.w)}; }
        if (gw == 0) { for (int i = F.lane; i < 8 * 128; i += 64) { const int h = i >> 7, rel = i & 127; int bk;
                if (rel < 16) bk = rel; else { const float lg = logf((float)rel / 16.0f) / 2.0794415416798357f * 16.0f; bk = 16 + (int)lg; bk = bk < 0 ? 0 : (bk > 31 ? 31 : bk); }
                biasT[i] = (args.in[15][bk * 8 + h] - args.in[15][31 * 8 + h]) * 1.4426950408889634f; } }
        if (BOTH(0)) GRID_BAR();
    }

    if (IN(1)) for (int rep_ = 0; rep_ < REP_1; ++rep_) {
        const float* Dsk = args.in[10];
        for (int i0 = gtid; i0 < NGRP * 512 * 64; i0 += NTHR * 4) {
            f32x4 ka[4], kb[4];
#pragma unroll
            for (int q = 0; q < 4; ++q) { const int i = i0 + q * NTHR; const int ic = (i < NGRP * 512 * 64) ? i : i0; const int g = ic >> 15, m = (ic >> 6) & 511, k8 = ic & 63, j = m >> 4, ho = m & 15, jp = k8 >> 1, hi0 = (k8 & 1) * 8;
                const int lag = (jp <= j) ? j - jp : 0; const float* kp = Kg + ((size_t)(g * 32 + lag) * 256 + ho * 16 + hi0); ka[q] = *(const GAS f32x4*)kp; kb[q] = *(const GAS f32x4*)(kp + 4); }
#pragma unroll
            for (int q = 0; q < 4; ++q) { const int i = i0 + q * NTHR; if (i >= NGRP * 512 * 64) break; const int g = i >> 15, m = (i >> 6) & 511, k8 = i & 63, j = m >> 4, ho = m & 15, jp = k8 >> 1, hi0 = (k8 & 1) * 8;
                v4u o = (v4u){0u, 0u, 0u, 0u};
                if (jp <= j) { f32x4 a = ka[q], b = kb[q];
                    if (jp == j && (ho >> 3) == (hi0 >> 3)) { const float dv = Dsk[g * 16 + ho]; const int e = ho & 7;
                        a.x += (e == 0) ? dv : 0.f; a.y += (e == 1) ? dv : 0.f; a.z += (e == 2) ? dv : 0.f; a.w += (e == 3) ? dv : 0.f;
                        b.x += (e == 4) ? dv : 0.f; b.y += (e == 5) ? dv : 0.f; b.z += (e == 6) ? dv : 0.f; b.w += (e == 7) ? dv : 0.f; }
                    o = (v4u){pk2(a.x, a.y), pk2(a.z, a.w), pk2(b.x, b.y), pk2(b.z, b.w)}; }
                *(GAS v4u*)(BP + ((size_t)(g * 512 + m) * APK + k8 * 8)) = o; } }
        pg8::Gemm g{Hb, Win_t, MTOK, INCOLS, 1024, 1024, 1024, 1 << 30, 0};
        pg8::StaticOrder S; S.init(MTOK, INCOLS, F.G, (int)blockIdx.x);
        pg8::EpiIn E{Zb, AP, kpart};
        pg8::gemm_phase<pg8::EpiIn, pg8::StaticOrder, true>(F.lds + RING_OFF, g, S, E);
        if (BOTH(1)) GRID_BAR();
    }

    if (IN(2)) for (int rep_ = 0; rep_ < REP_2; ++rep_) {
        const int bx = (int)blockIdx.x;
        const bool shared = F.G < 4;
        const int nS = shared ? F.G : (F.G >= 256 ? 64 : F.G / 4), nA = shared ? F.G : F.G - nS;
        const bool inS = shared || bx < nS, inA = shared || bx >= nS; const int aidx = shared ? bx : bx - nS;
        if (inS) {
#pragma unroll 1
            for (int pm = bx; pm < MTOK / 256; pm += nS) {
                { pg8::Gemm g1{AP, WE, MTOK, 256, 512, APK, 512, 2, (size_t)256 * 512}; OnePanel S1{pm, 1}; pg8::EpiE E1{Eb};
                  pg8::gemm_phase<pg8::EpiE, OnePanel, true>(F.lds + RING_OFF, g1, S1, E1); }
                VM_WAIT(); __syncthreads();
                if (F.tid < 256) { const int gb = (pm >> 1) * 8 + (pm & 1) * 4 + (F.tid >> 6), g_ = gb >> 3, p = F.tid & 63; const size_t row0 = (size_t)gb * 64;
                    const float mr = pw32[g_ * 128 + p], mi = pw32[g_ * 128 + 64 + p]; float sr = 0.f, si = 0.f;
#pragma unroll 1
                    for (int c0 = 0; c0 < NCHUNK; c0 += 32) { float er[32], ei[32];
#pragma unroll
                        for (int c = 0; c < 32; ++c) { er[c] = Eb[(row0 + c0 + c) * 128 + p]; ei[c] = Eb[(row0 + c0 + c) * 128 + 64 + p]; }
#pragma unroll
                        for (int c = 0; c < 32; ++c) { bf16* ap = AP + (row0 + c0 + c) * APK + 512; ap[p] = (bf16)f2bf(sr); ap[64 + p] = (bf16)f2bf(si);
                            const float nr = mr * sr - mi * si + er[c], ni = mr * si + mi * sr + ei[c]; sr = nr; si = ni; } } }
                VM_WAIT(); __syncthreads();
                { pg8::Gemm g{AP, BP, MTOK, 512, APK, APK, APK, 2, (size_t)512 * APK}; OnePanel S3{pm, 2}; pg8::EpiY E{Ypre};
                  pg8::gemm_phase<pg8::EpiY, OnePanel, true>(F.lds + RING_OFF, g, S3, E); }
            }
        }
        if (inA) {
            static_assert(attn_body::ATTN_LDS_BYTES <= RING_BYTES, "attention LDS");
#pragma unroll 1
            for (int a = aidx; a < 192; a += nA) { const int ty = a >> 6, bh = a & 63;
#pragma unroll 1
                for (int i = 0; i < 4; ++i) { const int qb = (ty == 0) ? (i == 0 ? 7 : (i == 1 ? 2 : (i == 2 ? 0 : -1))) : (ty == 1) ? (i == 0 ? 6 : (i == 1 ? 4 : -1)) : (i == 0 ? 5 : (i == 1 ? 3 : (i == 2 ? 1 : -1)));
                    if (qb < 0) break;
                    attn_body::attn_unit<8>(bh >> 3, bh & 7, qb, (const attn_body::bf16*)Qb, (const attn_body::bf16*)Kb, (const attn_body::bf16*)Vb, (attn_body::bf16*)Yb, (char*)lds + RING_OFF, kpart, biasT); } }
        }
        if (BOTH(2)) GRID_BAR();
    }

    if (IN(3)) for (int rep_ = 0; rep_ < REP_3; ++rep_) {
        pg8::Gemm g{Ypre, Wglu_t, MTOK, 512, 512, 512, 512, 1 << 30, 0};
        pg8::StaticOrder S; S.init(MTOK, 512, F.G, (int)blockIdx.x);
        pg8::EpiGlu E{Ypre, Ya, args.in[12]};
        pg8::gemm_phase<pg8::EpiGlu, pg8::StaticOrder, true>(F.lds + RING_OFF, g, S, E);
        { const int nun = (MTOK / 256) * (512 / 256);
          const bool split = F.G >= 2 * nun; const int nconv = split ? nun : F.G, cidx = split ? ((int)blockIdx.x % nun) : (int)blockIdx.x;
          const int stride = nconv * NWAVES, step = stride * 4, ex0 = cidx * NWAVES + F.wave;
          const int ncall = (NEXP - ex0 + step - 1) / step;
          int c_lo = 0, c_hi = 2 * ncall;
          if (split) { const int cut = (2 * ncall * 3) / 4; if ((int)blockIdx.x < nun) c_lo = cut; else if ((int)blockIdx.x < 2 * nun) c_hi = cut; else c_hi = 0; }
          f32x4 qa[2][8], qb[2][8];
#define CV_TAB(c) ((c) < ncall ? args.in[21] : args.in[22])
#define CV_EX(c) (ex0 + ((c) < ncall ? (c) : (c) - ncall) * step)
          if (c_lo < c_hi) cvt_load<4>(qa, CV_TAB(c_lo), CV_EX(c_lo), stride, F.lane);
          for (int c = c_lo; c < c_hi; c += 2) {
              if (c + 1 < c_hi) cvt_load<4>(qb, CV_TAB(c + 1), CV_EX(c + 1), stride, F.lane);
              cvt_store<4>(qa, CV_EX(c), stride, c >= ncall, F.lane, U8, V8);
              if (c + 2 < c_hi) cvt_load<4>(qa, CV_TAB(c + 2), CV_EX(c + 2), stride, F.lane);
              if (c + 1 < c_hi) cvt_store<4>(qb, CV_EX(c + 1), stride, c + 1 >= ncall, F.lane, U8, V8);
          } }
#undef CV_TAB
#undef CV_EX
        if (BOTH(3)) GRID_BAR();
    }

    if (IN(4)) for (int rep_ = 0; rep_ < REP_4; ++rep_) {
        pg8::Gemm g{Ya, Wus_t, MTOK, 1024, 512, 512, 512, 1 << 30, 0, Yb, Wua_t};
        DualOrder S; S.S.init(MTOK, 1024, F.G, (int)blockIdx.x);
        pg8::EpiMrgDual E{pg8::EpiMrg<0>{GA, Mrg}, pg8::EpiMrg<1>{GB, Mrg}};
        pg8::gemm_phase<pg8::EpiMrgDual, DualOrder, true>(F.lds + RING_OFF, g, S, E);
        if (BOTH(4)) GRID_BAR();
    }

    if (IN(5)) for (int rep_ = 0; rep_ < REP_5; ++rep_) {
        pg8::Gemm g{Mrg, Wout_t, MTOK, 1024, 1024, 1024, 1024, 1 << 30, 0}; pg8::StaticOrder S; S.init(MTOK, 1024, F.G, (int)blockIdx.x);
        pg8::EpiX1 E{x, args.out, XG, args.in[17], ssq1};
        pg8::gemm_phase<pg8::EpiX1, pg8::StaticOrder, true>(F.lds + RING_OFF, g, S, E);
        if (BOTH(5)) GRID_BAR();
    }

    if (IN(6)) for (int rep_ = 0; rep_ < REP_6; ++rep_) {
        pg8::Gemm g{XG, Wq_t, MTOK, PQ, 1024, 1024, 1024, 1 << 30, 0}; pg8::StaticOrder S; S.init(MTOK, PQ, F.G, (int)blockIdx.x);
        pg8::EpiPlain E{PQb, PQ};
        pg8::gemm_phase<pg8::EpiPlain, pg8::StaticOrder, true>(F.lds + RING_OFF, g, S, E);
        if (BOTH(6)) GRID_BAR();
    }

    if (IN(7)) for (int rep_ = 0; rep_ < REP_7; ++rep_) {
        LAS unsigned char* scr = F.lds + RING_OFF + F.wave * 2048;
        LAS unsigned char* ksl = F.lds + RING_OFF + 16384;
        for (int c = F.tid; c < 256 * 16; c += NWAVES * 64) { const int row = c >> 4, ch = c & 15; *(LAS v4u*)(ksl + row * 256 + ((ch ^ (row & 15)) << 4)) = *(const GAS v4u*)(KSb + row * 128 + ch * 8); }
        __syncthreads();
        for (int it = gw; it < (MTOK / 32) * 8; it += NGW) topk_task(it >> 3, it & 7, F.lane, scr, PQb, ksl, ssq1, ids, gts, rstd1);
        if (BOTH(7)) { VM_WAIT(); __syncthreads(); }
    }

    if (IN(8)) for (int rep_ = 0; rep_ < REP_8; ++rep_) {
        peer_a_phase(F.lane, F.wave, F.G, F.vcu, XG, U8, ids, gts, rstd1, wpk, F.lds, 0xffff);
        if (BOTH(8)) { VM_WAIT(); __syncthreads(); }
    }
    if (IN(9)) for (int rep_ = 0; rep_ < REP_9; ++rep_) {
        peer_b_phase(F.lane, F.wave, F.G, F.vcu, V8, wpk, Y16, args.out, args.in[23], rep_ == REP_9 - 1);
    }
#undef IN
#undef BOTH
#undef GRID_BAR
}

extern "C" void kernel_launch(void* const* d_in, const int* in_sizes, int n_in, void* d_out, int out_size, void* d_ws, size_t ws_size, hipStream_t stream) {
    static int grid = 0;
    if (grid == 0) {
        if (n_in != 24 || in_sizes[0] != MTOK * DMODEL || out_size != MTOK * DMODEL || ws_size < WS_END) { fprintf(stderr, "kernel_launch: unexpected shapes (n_in %d, in0 %d, out %d, ws %zu); nothing launched\n", n_in, n_in > 0 ? in_sizes[0] : -1, out_size, ws_size); grid = -1; return; }
        int dev = 0, cus = 0, per_cu = 0;
        if (hipGetDevice(&dev) != hipSuccess || hipDeviceGetAttribute(&cus, hipDeviceAttributeMultiprocessorCount, dev) != hipSuccess) { grid = -1; return; }
        if (hipFuncSetAttribute((const void*)mk_fwd, hipFuncAttributeMaxDynamicSharedMemorySize, LDS_BYTES) != hipSuccess) { fprintf(stderr, "kernel_launch: hipFuncSetAttribute failed\n"); grid = -1; return; }
        if (hipOccupancyMaxActiveBlocksPerMultiprocessor(&per_cu, (const void*)mk_fwd, NWAVES * 64, LDS_BYTES) != hipSuccess || per_cu < 1) { fprintf(stderr, "kernel_launch: occupancy query says %d blocks per CU\n", per_cu); }
        (void)hipGetLastError();
        grid = cus;
    }
    if (grid < 0) return;
    if (N_LAUNCHES != PER_PHASE) { if (hipMemsetAsync((char*)d_ws + WS_CTL, 0, CTL_ZERO_BYTES, stream) != hipSuccess) return; }
    Args a{};
    for (int i = 0; i < 24; ++i) a.in[i] = (const float*)d_in[i];
    a.out = (float*)d_out; a.ws = (unsigned char*)d_ws; a.pad = 0;
    if (N_LAUNCHES == PER_PHASE) {
        for (int li = 0; li < PER_PHASE; ++li) { a.ph_lo = li; a.ph_hi = li + 1; a.li = li; hipLaunchKernelGGL(mk_fwd, dim3(grid), dim3(NWAVES * 64), LDS_BYTES, stream, a); }
    } else {
        a.ph_lo = 0; a.ph_hi = PER_PHASE; a.li = 0;
        hipLaunchKernelGGL(mk_fwd, dim3(grid), dim3(NWAVES * 64), LDS_BYTES, stream, a);
    }
}
```

```cpp
#include <hip/hip_runtime.h>
#include <hip/hip_bf16.h>
#include <cstdio>
#include <cstdint>
#include <cmath>

#ifndef MK_N_LAUNCHES
#define MK_N_LAUNCHES 1
#endif

namespace pg8 {
#define PG8_LAS __attribute__((address_space(3)))
typedef unsigned short bf16_t;
typedef short bf16x8 __attribute__((ext_vector_type(8)));
typedef float f32x4 __attribute__((ext_vector_type(4)));
typedef unsigned u32x4 __attribute__((ext_vector_type(4)));
constexpr int BM = 256, BK = 64, HALF = 128, HTB = HALF * BK * 2, STAGE_BYTES = 8 * HTB, NXCD = 8, WGM = 8;

__host__ __device__ __forceinline__ int lds_byte(int r, int c) { const int st = (r >> 4) * 2 + (c >> 5), rr = r & 15, cc = c & 31, ob = rr * 64 + cc * 2; return st * 1024 + (ob ^ (((ob >> 9) & 1) << 5)); }
__host__ __device__ __forceinline__ void stage_rc(int b, int& R, int& C) { const int st = b / 1024, sb = b % 1024, swz = sb ^ (((sb >> 9) & 1) << 5); R = (st >> 1) * 16 + swz / 64; C = (st & 1) * 32 + (swz % 64) / 2; }
__host__ __device__ __forceinline__ int perm32(int rho) { const int n = rho >> 4, i = rho & 15; return 8 * (i >> 2) + 4 * n + (i & 3); }

struct Unit { int pm, pn, w; };
struct Gemm { const bf16_t* A; const bf16_t* Bt; int M, N, K, lda, ldb, rpg; size_t bgs; const bf16_t* A2 = nullptr; const bf16_t* Bt2 = nullptr; };

struct StaticOrder {
    int nM, nN, nwg, G, c;
    __host__ __device__ __forceinline__ void init(int M, int N, int G_, int c_) { nM = M / BM; nN = N / BM; nwg = nM * nN; G = G_; c = c_; }
    __host__ __device__ __forceinline__ bool next(int i, Unit& u) const {
        const long L = (long)i * G + c; if (L >= nwg) return false;
        int wgid = (int)L; { const int q = nwg / NXCD, r = nwg % NXCD, xcd = wgid % NXCD, off = wgid / NXCD; wgid = (xcd < r ? xcd * (q + 1) : r * (q + 1) + (xcd - r) * q) + off; }
        const int nig = WGM * nN, gid = wgid / nig, fm = gid * WGM, gsz = (nM - fm) < WGM ? (nM - fm) : WGM;
        u.pm = fm + ((wgid % nig) % gsz); u.pn = (wgid % nig) / gsz; u.w = 0; return true;
    }
};

__device__ __forceinline__ unsigned cvt_pk_bf16(float lo, float hi) { unsigned r; asm volatile("v_cvt_pk_bf16_f32 %0, %1, %2" : "=v"(r) : "v"(lo), "v"(hi)); return r; }
__device__ __forceinline__ float bf_lo(unsigned w) { return __uint_as_float(w << 16); }
__device__ __forceinline__ float bf_hi(unsigned w) { return __uint_as_float(w & 0xffff0000u); }
__device__ __forceinline__ float sigmoid_f(float x) { return __builtin_amdgcn_rcpf(1.0f + __builtin_amdgcn_exp2f(-1.4426950409f * x)); }
__device__ __forceinline__ float gelu_tanh(float x) { const float u = x + 0.044715f * x * x * x; return x * __builtin_amdgcn_rcpf(1.0f + __builtin_amdgcn_exp2f(-2.3022081985f * u)); }

template <class Epi, class Sched, bool ALIGN_EPI>
__device__ __forceinline__ void gemm_phase(PG8_LAS unsigned char* lds, const Gemm g, const Sched& S, const Epi& E) {
    int tid = threadIdx.x; asm volatile("" : "+v"(tid));
    const int wid = __builtin_amdgcn_readfirstlane(tid >> 6), lane = tid & 63, wr = wid >> 2, wc = wid & 3, fr = lane & 15, fq = lane >> 4;
    const int K = g.K, nt = K / BK;
    unsigned voffA[2], voffB[2];
#pragma unroll
    for (int i = 0; i < 2; ++i) { int R, C; stage_rc(tid * 16 + i * 8192, R, C); const int Rb = Epi::PERM ? ((R & ~31) + perm32(R & 31)) : R;
        voffA[i] = (unsigned)(R * g.lda + C) * 2u; voffB[i] = (unsigned)(Rb * g.ldb + C) * 2u; }
    const size_t kstep = (size_t)(BK * 2);
    const size_t hstepA = (size_t)HALF * g.lda * 2, hstepB = (size_t)HALF * g.ldb * 2;
    const size_t tstepA = 2 * hstepA, tstepB = 2 * hstepB;
    const unsigned ldsw = (unsigned)wid * 1024u;
    const int aoff = lds_byte(wr * 64 + fr, fq * 8), boff = lds_byte(wc * 32 + fr, fq * 8);
#define PG8_SA(b, h) (((b) * 2 + (h)) * HTB)
#define PG8_SB(b, h) ((4 + (b) * 2 + (h)) * HTB)
#define PG8_STAGE(bufoff, gbase, voff) do { _Pragma("unroll") for (int _i = 0; _i < 2; ++_i) \
        __builtin_amdgcn_global_load_lds((const unsigned*)((const char*)(gbase) + (voff)[_i]), (PG8_LAS unsigned*)(lds + (bufoff) + ldsw + _i * 8192), 16, 0, 0); } while (0)
#define PG8_LDA(dst, b, h) do { _Pragma("unroll") for (int m = 0; m < 4; ++m) _Pragma("unroll") for (int k = 0; k < 2; ++k) dst[m][k] = *(const PG8_LAS bf16x8*)(lds + PG8_SA(b, h) + aoff + m * 2048 + k * 1024); } while (0)
#define PG8_LDB(dst, b, h) do { _Pragma("unroll") for (int n = 0; n < 2; ++n) _Pragma("unroll") for (int k = 0; k < 2; ++k) dst[n][k] = *(const PG8_LAS bf16x8*)(lds + PG8_SB(b, h) + boff + n * 2048 + k * 1024); } while (0)
#define PG8_MMA(ai, bj, At, Bt) do { __builtin_amdgcn_s_setprio(1); _Pragma("unroll") for (int m = 0; m < 4; ++m) _Pragma("unroll") for (int n = 0; n < 2; ++n) _Pragma("unroll") for (int k = 0; k < 2; ++k) \
        acc[ai][bj][m][n] = __builtin_amdgcn_mfma_f32_16x16x32_bf16(Bt[n][k], At[m][k], acc[ai][bj][m][n], 0, 0, 0); __builtin_amdgcn_s_setprio(0); } while (0)
#define PG8_WAIT_V(n) asm volatile("s_waitcnt vmcnt(" #n ")" ::: "memory")
#define PG8_WAIT_L(n) asm volatile("s_waitcnt lgkmcnt(" #n ")" ::: "memory")
#define PG8_BAR __builtin_amdgcn_s_barrier()
#define PG8_SCHED __builtin_amdgcn_sched_barrier(0)
    Unit cur, nxt; int ui = 0;
    if (!S.next(0, cur)) return;
    f32x4 acc[2][2][4][2];
#pragma unroll
    for (int a = 0; a < 2; ++a)
#pragma unroll
        for (int b = 0; b < 2; ++b)
#pragma unroll
            for (int m = 0; m < 4; ++m)
#pragma unroll
                for (int n = 0; n < 2; ++n) acc[a][b][m][n] = (f32x4){0.f, 0.f, 0.f, 0.f};
    bf16x8 At[4][2], B0[2][2], B1[2][2];
    const char* cA = (const char*)(cur.w ? g.A2 : g.A) + (size_t)cur.pm * tstepA;
    const char* cB = (const char*)(cur.w ? g.Bt2 : g.Bt) + (size_t)(cur.pm / g.rpg) * g.bgs * 2 + (size_t)cur.pn * tstepB;
    PG8_STAGE(PG8_SB(0, 0), cB, voffB); PG8_STAGE(PG8_SB(0, 1), cB + hstepB, voffB); PG8_STAGE(PG8_SA(0, 0), cA, voffA); PG8_STAGE(PG8_SA(0, 1), cA + hstepA, voffA);
    if (wr == 1) PG8_BAR;
    PG8_WAIT_V(2); PG8_BAR;
    PG8_STAGE(PG8_SB(1, 0), cB + kstep, voffB); PG8_STAGE(PG8_SA(1, 0), cA + kstep, voffA); PG8_STAGE(PG8_SB(1, 1), cB + hstepB + kstep, voffB);
    PG8_WAIT_V(6); PG8_BAR;
    for (;;) {
        const bool has_next = S.next(ui + 1, nxt);
        const char* nA = has_next ? (const char*)(nxt.w ? g.A2 : g.A) + (size_t)nxt.pm * tstepA : cA;
        const char* nB = has_next ? (const char*)(nxt.w ? g.Bt2 : g.Bt) + (size_t)(nxt.pm / g.rpg) * g.bgs * 2 + (size_t)nxt.pn * tstepB : cB;
        for (int t = 0; t < nt; t += 2) {
            const bool last = (t == nt - 2);
            const char* a1 = cA + (size_t)(t + 1) * kstep;
            const char* a2 = last ? nA : cA + (size_t)(t + 2) * kstep; const char* b2 = last ? nB : cB + (size_t)(t + 2) * kstep;
            const char* a3 = a2 + kstep; const char* b3 = b2 + kstep;
            PG8_LDB(B0, 0, 0); PG8_LDB(B1, 0, 1); PG8_SCHED; PG8_LDA(At, 0, 0); PG8_STAGE(PG8_SA(1, 1), a1 + hstepA, voffA);
            PG8_WAIT_V(8); PG8_WAIT_L(0); PG8_BAR; PG8_MMA(0, 0, At, B0); PG8_MMA(0, 1, At, B1); PG8_BAR; PG8_SCHED;
            PG8_LDA(At, 0, 1); PG8_STAGE(PG8_SB(0, 0), b2, voffB); PG8_STAGE(PG8_SB(0, 1), b2 + hstepB, voffB); PG8_STAGE(PG8_SA(0, 0), a2, voffA);
            PG8_WAIT_V(8); PG8_WAIT_L(0); PG8_BAR; PG8_MMA(1, 0, At, B0); PG8_MMA(1, 1, At, B1); PG8_BAR; PG8_SCHED;
            PG8_LDB(B0, 1, 0); PG8_LDB(B1, 1, 1); PG8_SCHED; PG8_LDA(At, 1, 0); PG8_STAGE(PG8_SA(0, 1), a2 + hstepA, voffA);
            PG8_WAIT_V(8); PG8_WAIT_L(0); PG8_BAR; PG8_MMA(0, 0, At, B0); PG8_MMA(0, 1, At, B1); PG8_BAR; PG8_SCHED;
            PG8_LDA(At, 1, 1); PG8_STAGE(PG8_SB(1, 0), b3, voffB); PG8_STAGE(PG8_SB(1, 1), b3 + hstepB, voffB); PG8_STAGE(PG8_SA(1, 0), a3, voffA);
            PG8_WAIT_V(8); PG8_WAIT_L(0); PG8_BAR; PG8_MMA(1, 0, At, B0); PG8_MMA(1, 1, At, B1); PG8_BAR; PG8_SCHED;
        }
        if constexpr (ALIGN_EPI) { if (wr == 0) PG8_BAR; }
        E(acc, cur, wr, wc, fr, fq);
        if (!has_next) break;
#pragma unroll
        for (int a = 0; a < 2; ++a)
#pragma unroll
            for (int b = 0; b < 2; ++b)
#pragma unroll
                for (int m = 0; m < 4; ++m)
#pragma unroll
                    for (int n = 0; n < 2; ++n) acc[a][b][m][n] = (f32x4){0.f, 0.f, 0.f, 0.f};
        cur = nxt; cA = nA; cB = nB; ++ui;
        if constexpr (ALIGN_EPI) { if (wr == 1) PG8_BAR; }
    }
    PG8_WAIT_V(0);
    if constexpr (!ALIGN_EPI) { if (wr == 0) PG8_BAR; }
    PG8_BAR;
#undef PG8_SA
#undef PG8_SB
#undef PG8_STAGE
#undef PG8_LDA
#undef PG8_LDB
#undef PG8_MMA
#undef PG8_WAIT_V
#undef PG8_WAIT_L
#undef PG8_BAR
#undef PG8_SCHED
}
}
namespace attn_body {
using bf16=__hip_bfloat16;
using bf16x8=__attribute__((ext_vector_type(8)))short;
using s16x4=__attribute__((ext_vector_type(4)))short;
using f32x16=__attribute__((ext_vector_type(16)))float;
using f32x4v=__attribute__((ext_vector_type(4)))float;
using u32x4=__attribute__((ext_vector_type(4)))unsigned;
constexpr int BATCH=8,NHEAD=8,SEQ=2048,D=64,DM=NHEAD*D;
constexpr int NW=8,QBLK=32,QB=QBLK*NW,KVBLK=64,NQB=SEQ/QB;
__device__ __forceinline__ int crow(int r,int hi){return (r&3)+8*(r>>2)+4*hi;}
#define SBAR() __builtin_amdgcn_sched_barrier(0)
__device__ __forceinline__ void cmask(f32x16&p0,f32x16&p1,int jb,int qrel,int hi){
  const float NEG=-INFINITY; int kb=64*jb+4*hi;
  #pragma unroll
  for(int r=0;r<16;++r){int kv=kb+(r&3)+8*(r>>2); if(kv>qrel)p0[r]=NEG; if(kv+32>qrel)p1[r]=NEG;}
}
typedef __attribute__((address_space(3))) const float* lds_cfptr;
__device__ __forceinline__ void biasadd(f32x16&p0,f32x16&p1,int jb,int qrel,int hi,lds_cfptr bt){
  const int base=qrel-64*jb-4*hi;
  #pragma unroll
  for(int r4=0;r4<16;r4+=4){
    #pragma unroll
    for(int r=r4;r<r4+4;++r){int rel=base-((r&3)+8*(r>>2)); int i0=min(max(rel,0),127), i1=min(max(rel-32,0),127); p0[r]+=bt[i0]; p1[r]+=bt[i1];}
    asm volatile("s_waitcnt lgkmcnt(0)":"+v"(p0),"+v"(p1)::"memory"); }
}

constexpr int NSLOT=3, SLOTB=8192;
constexpr int LDS_K=0, LDS_V=NSLOT*SLOTB, LDS_WS=2*NSLOT*SLOTB, LDS_OST=LDS_WS+NW*64*4, LDS_KM=LDS_OST+NW*4096, LDS_BT=LDS_KM+7*64*4, LDS_BYTES=LDS_BT+128*4;
constexpr float C2=0.125f*1.4426950408889634f;
__device__ __forceinline__ void glds16(const void*gsrc,unsigned lds_dst){unsigned keep;
  asm volatile("s_mov_b32 %0, m0\n\ts_mov_b32 m0, %2\n\ts_nop 0\n\tglobal_load_lds_dwordx4 %1, off\n\ts_mov_b32 m0, %0":"=&s"(keep):"v"(gsrc),"s"(lds_dst):"memory");}
__device__ __forceinline__ float max3f(float a,float b,float c){float r;asm("v_max3_f32 %0, %1, %2, %3":"=v"(r):"v"(a),"v"(b),"v"(c));return r;}
__device__ __forceinline__ float max2f(float a,float b){float r;asm("v_max_f32_e32 %0, %1, %2":"=v"(r):"v"(a),"v"(b));return r;}
__device__ __forceinline__ float fadd_s(float a,float b){float r;asm("v_add_f32_e32 %0, %1, %2":"=v"(r):"v"(a),"v"(b));return r;}
__device__ __forceinline__ float fsub_s(float a,float b){float r;asm("v_sub_f32_e32 %0, %1, %2":"=v"(r):"v"(a),"v"(b));return r;}
typedef float f32x2_t __attribute__((ext_vector_type(2))); typedef __bf16 bf16x2_t __attribute__((ext_vector_type(2)));
__device__ __forceinline__ unsigned cvtpk_s(float lo,float hi){f32x2_t v={lo,hi};bf16x2_t b=__builtin_convertvector(v,bf16x2_t);return __builtin_bit_cast(unsigned,b);}
#define WAIT_BAR(N) asm volatile("s_waitcnt vmcnt(" #N ") lgkmcnt(0)\n\ts_barrier":::"memory")

__device__ __forceinline__ void qkt(f32x16&p0,f32x16&p1,const char*Kslot,const bf16x8*qr,int r32,int hi){
  const char*kb=Kslot+hi*1024+r32*16;
  #pragma unroll
  for(int d0=0;d0<4;++d0){
    const bf16x8 b0=*reinterpret_cast<const bf16x8*>(kb+d0*2048);
    const bf16x8 b1=*reinterpret_cast<const bf16x8*>(kb+d0*2048+512);
    if(d0==0){p0=__builtin_amdgcn_mfma_f32_32x32x16_bf16(b0,qr[0],(f32x16){},0,0,0);p1=__builtin_amdgcn_mfma_f32_32x32x16_bf16(b1,qr[0],(f32x16){},0,0,0);}
    else{p0=__builtin_amdgcn_mfma_f32_32x32x16_bf16(b0,qr[d0],p0,0,0,0);p1=__builtin_amdgcn_mfma_f32_32x32x16_bf16(b1,qr[d0],p1,0,0,0);}}
}
typedef __attribute__((address_space(3))) const char* lds_cptr;
typedef short v4i16_t __attribute__((ext_vector_type(4)));
__device__ __forceinline__ void kload8(bf16x8*kf,lds_cptr kp){
  kf[0]=*(const __attribute__((address_space(3))) bf16x8*)(kp);      kf[1]=*(const __attribute__((address_space(3))) bf16x8*)(kp+512);
  kf[2]=*(const __attribute__((address_space(3))) bf16x8*)(kp+2048); kf[3]=*(const __attribute__((address_space(3))) bf16x8*)(kp+2560);
  kf[4]=*(const __attribute__((address_space(3))) bf16x8*)(kp+4096); kf[5]=*(const __attribute__((address_space(3))) bf16x8*)(kp+4608);
  kf[6]=*(const __attribute__((address_space(3))) bf16x8*)(kp+6144); kf[7]=*(const __attribute__((address_space(3))) bf16x8*)(kp+6656);
}
__device__ __forceinline__ void kload2(bf16x8*kf,lds_cptr kp,int j){ kf[2*j]=*(const __attribute__((address_space(3))) bf16x8*)(kp+j*2048); kf[2*j+1]=*(const __attribute__((address_space(3))) bf16x8*)(kp+j*2048+512); }
__device__ __forceinline__ s16x4 vtr(lds_cptr p){ return __builtin_bit_cast(s16x4,__builtin_amdgcn_ds_read_tr16_b64_v4i16((__attribute__((address_space(3))) v4i16_t*)p)); }
__device__ __forceinline__ float rowmax(const f32x16&p0,const f32x16&p1){
  float a=max3f(p0[0],p0[1],p1[0]),b=max3f(p0[2],p0[3],p1[1]);a=max3f(a,p1[2],p1[3]);
  #pragma unroll
  for(int r=4;r<16;r+=4){a=max3f(a,p0[r],p0[r+1]);b=max3f(b,p0[r+2],p0[r+3]);a=max3f(a,p1[r],p1[r+1]);b=max3f(b,p1[r+2],p1[r+3]);}
  const float m=max2f(a,b);
  auto rr=__builtin_amdgcn_permlane32_swap(__float_as_uint(m),__float_as_uint(m),false,false);
  return max2f(__uint_as_float(rr[0]),__uint_as_float(rr[1]));
}
__device__ __forceinline__ void pv(f32x16*o,int vb,bf16x8 pa0,bf16x8 pa1,bf16x8 pa2,bf16x8 pa3){
  #pragma unroll
  for(int d0=0;d0<2;++d0){s16x4 lo[4],hi[4];
    #pragma unroll
    for(int ks=0;ks<4;++ks){
      asm volatile("ds_read_b64_tr_b16 %0,%1 offset:%c2":"=&v"(lo[ks]):"v"(vb),"i"(d0*4096+ks*1024):"memory");
      asm volatile("ds_read_b64_tr_b16 %0,%1 offset:%c2":"=&v"(hi[ks]):"v"(vb),"i"(d0*4096+ks*1024+512):"memory");}
    asm volatile("s_waitcnt lgkmcnt(0)":::"memory");SBAR();
    #define PK(k) (bf16x8){lo[k][0],lo[k][1],lo[k][2],lo[k][3],hi[k][0],hi[k][1],hi[k][2],hi[k][3]}
    o[d0]=__builtin_amdgcn_mfma_f32_32x32x16_bf16(pa0,PK(0),o[d0],0,0,0);
    o[d0]=__builtin_amdgcn_mfma_f32_32x32x16_bf16(pa1,PK(1),o[d0],0,0,0);
    o[d0]=__builtin_amdgcn_mfma_f32_32x32x16_bf16(pa2,PK(2),o[d0],0,0,0);
    o[d0]=__builtin_amdgcn_mfma_f32_32x32x16_bf16(pa3,PK(3),o[d0],0,0,0);
    #undef PK
  }
}

#ifndef ATTN_STORE16
#define ATTN_STORE16(p,v) (*(u32x4*)(p)=(v))
#endif
template<int THRL> __device__ __forceinline__ void attn_unit(int b,int h,int qb,const bf16*Q,const bf16*__restrict__ K,const bf16*__restrict__ V,bf16*O,char*shm,const float*kpart,const float*btab){
  int tid=threadIdx.x; asm volatile("":"+v"(tid));
  const int lane=tid&63,r32=lane&31,hi=lane>>5; const int wid=__builtin_amdgcn_readfirstlane(tid>>6);
  const long rowbase=(long)b*SEQ; const int q0=qb*QB;
  const bf16*Qw=Q+(rowbase+q0+wid*QBLK)*DM+h*D;
  const bf16*Kh=K+rowbase*DM+h*D,*Vh=V+rowbase*DM+h*D;
  const unsigned lds0=(unsigned)(uintptr_t)shm;
  float*wsf=(float*)(shm+LDS_WS)+wid*64;
  const bf16*ksrc=Kh+(long)lane*DM+wid*8;
  const bf16*vsrc=Vh+(long)(16*(wid&3)+(lane>>2))*DM+(wid>>2)*32+(lane&3)*8;
  const unsigned kdst=lds0+LDS_K+wid*1024, vdst=lds0+LDS_V+wid*1024;
  #define DMA_K(t,slot) glds16(ksrc+(long)(t)*KVBLK*DM,(unsigned)__builtin_amdgcn_readfirstlane(kdst+(slot)))
  #define DMA_V(t,slot) glds16(vsrc+(long)(t)*KVBLK*DM,(unsigned)__builtin_amdgcn_readfirstlane(vdst+(slot)))
  const int vb0=(int)(lds0+LDS_V)+((lane>>4)&1)*32+(lane&3)*8+(4*hi+((lane&15)>>2))*64;
  const char*Kbase=shm+LDS_K; bf16x8 kf[8];
  const lds_cptr shm3=(lds_cptr)shm; const lds_cptr kp0=shm3+LDS_K+hi*1024+r32*16; const lds_cptr vp0=shm3+LDS_V+((lane>>4)&1)*32+(lane&3)*8+(4*hi+((lane&15)>>2))*64;
  const lds_cfptr btl=(lds_cfptr)(shm3+LDS_BT);
  const int NT=(q0+QB)/KVBLK;
  DMA_K(0,0);DMA_V(0,0);DMA_K(1,SLOTB);
  bf16x8 qr[4];
  #pragma unroll
  for(int d0=0;d0<4;++d0)qr[d0]=*reinterpret_cast<const bf16x8*>(&Qw[(long)r32*DM+d0*16+hi*8]);
  { float*km=(float*)(shm+LDS_KM); float*bt=(float*)(shm+LDS_BT); int tq=tid; asm volatile("":"+v"(tq));
    if(tq<448){const int j=tq>>6,d=tq&63; float v=0.f; if(j<qb&&qb>3){const float*kp=kpart+((size_t)((b*NQB+j)*2)*512)+h*D+d; v=(kp[0]+kp[512])*(1.0f/256.0f);} km[tq]=v;}
    else if(tq<448+64){const int i=tq-448; bt[i]=btab[h*128+i]; bt[64+i]=btab[h*128+64+i];} }
  float mhat=0.f,l_reg=0.f;f32x16 o[2];o[0]=f32x16{};o[1]=f32x16{};
  const int qrel=wid*QBLK+r32;
  #define CMASK(P0,P1,t) do{int jb_=(t)-(NT-4);   \
    if(jb_>=-2 && 32*wid+31-64*jb_>=0 && 32*wid-64*jb_-63<=112)biasadd(P0,P1,jb_,qrel,hi,btl); if(jb_>=0 && 64*jb_+63>32*wid)cmask(P0,P1,jb_,qrel,hi);}while(0)
  bool resc=false;
  #define START(P0,P1,t) do{ float rm=rowmax(P0,P1); resc=false; const float nv_=MASKADD(t); rm=fadd_s(rm,nv_); \
    { const float dl=__builtin_fmaxf(rm,-1.0e4f); mhat=fadd_s(mhat,dl); const float cc_=fsub_s(nv_,dl); \
      _Pragma("unroll") for(int r=0;r<16;++r){P0[r]=fadd_s(P0[r],cc_);P1[r]=fadd_s(P1[r],cc_);} } \
    _Pragma("unroll") for(int r=0;r<16;++r)P0[r]=__builtin_amdgcn_exp2f(P0[r]); }while(0)
  #define RESC() do{ if(resc){ asm volatile("s_waitcnt lgkmcnt(0)":::"memory"); \
      _Pragma("unroll") for(int d_=0;d_<2;++d_) _Pragma("unroll") for(int r=0;r<16;++r)o[d_][r]*=wsf[crow(r,hi)]; } }while(0)
  f32x16 pA0,pA1,pB0,pB1;
  int sl_prev=0,sl_cur=0,sl_next=SLOTB;
  #define ROT() do{sl_prev=sl_cur;sl_cur=sl_next;sl_next=(sl_next==(NSLOT-1)*SLOTB)?0:sl_next+SLOTB;}while(0)
  DMA_K(2,2*SLOTB);
  WAIT_BAR(3);
  unsigned selbits=(1u<<qb)-1u;
  if(qb>3){ selbits=0u;
    const __attribute__((address_space(3))) float* km3=(const __attribute__((address_space(3))) float*)(shm3+LDS_KM);
    float qf[32];
    #pragma unroll
    for(int d0=0;d0<4;++d0){
      #pragma unroll
      for(int i=0;i<8;++i) qf[d0*8+i]=__uint_as_float(((unsigned)(unsigned short)qr[d0][i])<<16);}
    float gj[7];
    #pragma unroll
    for(int j=0;j<7;++j){ float s=0.f;
      if(j<qb){
        #pragma unroll
        for(int d0=0;d0<4;++d0){ const f32x4v k0=*(const __attribute__((address_space(3))) f32x4v*)(km3+j*64+d0*16+hi*8); const f32x4v k1=*(const __attribute__((address_space(3))) f32x4v*)(km3+j*64+d0*16+hi*8+4);
          s+=qf[d0*8+0]*k0[0]+qf[d0*8+1]*k0[1]+qf[d0*8+2]*k0[2]+qf[d0*8+3]*k0[3]+qf[d0*8+4]*k1[0]+qf[d0*8+5]*k1[1]+qf[d0*8+6]*k1[2]+qf[d0*8+7]*k1[3]; }
        auto rr=__builtin_amdgcn_permlane32_swap(__float_as_uint(s),__float_as_uint(s),false,false); s=__uint_as_float(rr[0])+__uint_as_float(rr[1]); }
      gj[j]=s; }
    #pragma unroll
    for(int j=0;j<7;++j){ int rank=0;
      #pragma unroll
      for(int k=0;k<7;++k){ if(k!=j){ const bool beats=(k<j)?(gj[k]>=gj[j]):(gj[k]>gj[j]); rank+=(k<qb&&beats)?1:0; } }
      if(j<qb&&rank<3)selbits|=(1u<<j); }
  }
  #define MASKADD(t) ((((t)>>2)<qb && !((selbits>>((t)>>2))&1u))?-1.0e30f:0.0f)
  qkt(pA0,pA1,Kbase,qr,r32,hi);asm volatile("s_nop 15\n\ts_nop 7":"+v"(pA0),"+v"(pA1));CMASK(pA0,pA1,0);
  START(pA0,pA1,0);
  _Pragma("unroll") for(int r=0;r<16;++r)pA1[r]=__builtin_amdgcn_exp2f(pA1[r]);
  WAIT_BAR(0);
  DMA_K(3,0);DMA_V(1,SLOTB);
  ROT();
  kload8(kf,kp0+sl_cur);
  WAIT_BAR(2);
  s16x4 vlo[8],vhi[8]; u32x4 pw0,pw1,pw2,pw3;
  #define PKW(P,B) cvtpk_s(P[B],P[B+1])
  #define PAF(k) __builtin_bit_cast(bf16x8,pw##k)
  #define VFR(i) (bf16x8){vlo[i][0],vlo[i][1],vlo[i][2],vlo[i][3],vhi[i][0],vhi[i][1],vhi[i][2],vhi[i][3]}
  #define PIN(x) asm volatile("":"+v"(x))
  #define MX3(a,b,c) __builtin_fmaxf(__builtin_fmaxf((a),(b)),(c))
  #define GAPA(MF,A0,A1,A2,A3,W0,W1,PW) do{ MF; sacc+=A0; sacc+=A1; sacc+=A2; sacc+=A3; PIN(sacc); W0; W1; PIN(PW); SBAR(); }while(0)
  #define EX(v) __builtin_amdgcn_exp2f(v)
  #define GAPB(MF,X,B) do{ MF; X[B]=EX(X[B]); X[B+1]=EX(X[B+1]); X[B+2]=EX(X[B+2]); X[B+3]=EX(X[B+3]); PIN(X); SBAR(); }while(0)
  #define VRD(i) do{ vlo[i]=vtr(vp_+(((i)>>2)*4096+((i)&3)*1024)); vhi[i]=vtr(vp_+(((i)>>2)*4096+((i)&3)*1024+512)); }while(0)
  #define KRD(G,j) do{ if(G){ kload2(kf,kp0+sl_next,j); SBAR(); } }while(0)
  #define STEP(C0,C1,P0,P1,t,GK,GV,GL) do{ SBAR(); \
    const lds_cptr vp_=vp0+sl_prev; \
    VRD(0); SBAR(); float sacc=(P0[0]+P0[1]); \
    GAPA(C0=__builtin_amdgcn_mfma_f32_32x32x16_bf16(kf[0],qr[0],(f32x16){},0,0,0), P0[2],P0[3],P0[4],P0[5],     pw0[0]=PKW(P0,0), pw0[1]=PKW(P0,2), pw0); \
    VRD(4); SBAR(); GAPA(C1=__builtin_amdgcn_mfma_f32_32x32x16_bf16(kf[1],qr[0],(f32x16){},0,0,0), P0[6],P0[7],P0[8],P0[9],     pw0[2]=PKW(P0,4), pw0[3]=PKW(P0,6), pw0); \
    VRD(1); SBAR(); GAPA(C0=__builtin_amdgcn_mfma_f32_32x32x16_bf16(kf[2],qr[1],C0,0,0,0),   P0[10],P0[11],P0[12],P0[13], pw1[0]=PKW(P0,8), pw1[1]=PKW(P0,10), pw1); \
    VRD(5); SBAR(); GAPA(C1=__builtin_amdgcn_mfma_f32_32x32x16_bf16(kf[3],qr[1],C1,0,0,0),   P0[14],P0[15],P1[0],P1[1],   pw1[2]=PKW(P0,12),pw1[3]=PKW(P0,14), pw1); \
    VRD(2); SBAR(); GAPA(C0=__builtin_amdgcn_mfma_f32_32x32x16_bf16(kf[4],qr[2],C0,0,0,0),   P1[2],P1[3],P1[4],P1[5],     pw2[0]=PKW(P1,0), pw2[1]=PKW(P1,2), pw2); \
    VRD(6); SBAR(); GAPA(C1=__builtin_amdgcn_mfma_f32_32x32x16_bf16(kf[5],qr[2],C1,0,0,0),   P1[6],P1[7],P1[8],P1[9],     pw2[2]=PKW(P1,4), pw2[3]=PKW(P1,6), pw2); \
    VRD(3); SBAR(); GAPA(C0=__builtin_amdgcn_mfma_f32_32x32x16_bf16(kf[6],qr[3],C0,0,0,0),   P1[10],P1[11],P1[12],P1[13], pw3[0]=PKW(P1,8), pw3[1]=PKW(P1,10), pw3); \
    VRD(7); SBAR(); GAPA(C1=__builtin_amdgcn_mfma_f32_32x32x16_bf16(kf[7],qr[3],C1,0,0,0),   P1[14],P1[15],0.f,0.f,       pw3[2]=PKW(P1,12),pw3[3]=PKW(P1,14), pw3); \
    l_reg+=sacc; \
    if(GK){DMA_K((t)+3,sl_cur);} if(GV){DMA_V((t)+1,sl_next);} \
    CMASK(C0,C1,t); \
    { float a=MX3(C0[0],C0[1],C1[0]),b=MX3(C0[2],C0[3],C1[1]); a=MX3(a,C1[2],C1[3]); \
      _Pragma("unroll") for(int r=4;r<16;r+=4){a=MX3(a,C0[r],C0[r+1]);b=MX3(b,C0[r+2],C0[r+3]);a=MX3(a,C1[r],C1[r+1]);b=MX3(b,C1[r+2],C1[r+3]);} \
      float rm=__builtin_fmaxf(a,b); { auto rr=__builtin_amdgcn_permlane32_swap(__float_as_uint(rm),__float_as_uint(rm),false,false); rm=__builtin_fmaxf(__uint_as_float(rr[0]),__uint_as_float(rr[1])); } \
      const float nv_=MASKADD(t)-mhat; rm+=nv_; float cc_=nv_; \
      resc=false; \
      if(__builtin_expect(__any(rm>(float)THRL),0)){ const float dl=__builtin_fmaxf(rm,0.f); mhat+=dl; cc_-=dl; \
        const float f=__builtin_amdgcn_exp2f(-dl); l_reg*=f; if(hi==0)wsf[r32]=f; resc=true; } \
      _Pragma("unroll") for(int r=0;r<16;++r){C0[r]+=cc_;C1[r]+=cc_;} } \
    SBAR(); \
    GAPB(o[0]=__builtin_amdgcn_mfma_f32_32x32x16_bf16(PAF(0),VFR(0),o[0],0,0,0), C0,0); \
    GAPB(o[1]=__builtin_amdgcn_mfma_f32_32x32x16_bf16(PAF(0),VFR(4),o[1],0,0,0), C0,4); \
    KRD(GL,0); GAPB(o[0]=__builtin_amdgcn_mfma_f32_32x32x16_bf16(PAF(1),VFR(1),o[0],0,0,0), C0,8); \
    KRD(GL,1); GAPB(o[1]=__builtin_amdgcn_mfma_f32_32x32x16_bf16(PAF(1),VFR(5),o[1],0,0,0), C0,12); \
    KRD(GL,2); GAPB(o[0]=__builtin_amdgcn_mfma_f32_32x32x16_bf16(PAF(2),VFR(2),o[0],0,0,0), C1,0); \
    KRD(GL,3); GAPB(o[1]=__builtin_amdgcn_mfma_f32_32x32x16_bf16(PAF(2),VFR(6),o[1],0,0,0), C1,4); \
    GAPB(o[0]=__builtin_amdgcn_mfma_f32_32x32x16_bf16(PAF(3),VFR(3),o[0],0,0,0), C1,8); \
    GAPB(o[1]=__builtin_amdgcn_mfma_f32_32x32x16_bf16(PAF(3),VFR(7),o[1],0,0,0), C1,12); \
    }while(0)
  int t=1;
  #undef CMASK
  #define CMASK(P0,P1,t) do{}while(0)
  for(;t+7<NT;t+=2){
    STEP(pB0,pB1,pA0,pA1,t,true,true,true);     WAIT_BAR(2); RESC(); ROT();
    STEP(pA0,pA1,pB0,pB1,t+1,true,true,true);   WAIT_BAR(2); RESC(); ROT();
  }
  #undef CMASK
  #define CMASK(P0,P1,t) do{int jb_=(t)-(NT-4);   \
    if(jb_>=-2 && 32*wid+31-64*jb_>=0 && 32*wid-64*jb_-63<=112)biasadd(P0,P1,jb_,qrel,hi,btl); if(jb_>=0 && 64*jb_+63>32*wid)cmask(P0,P1,jb_,qrel,hi);}while(0)
  #define ENDW(tt) do{ if((tt)+3<NT){WAIT_BAR(2);} else if((tt)+2<NT){WAIT_BAR(1);} else {WAIT_BAR(0);} }while(0)
  for(;t+1<NT;t+=2){
    STEP(pB0,pB1,pA0,pA1,t,(t+3<NT),(t+1<NT),(t+1<NT));       ENDW(t);   RESC(); ROT();
    STEP(pA0,pA1,pB0,pB1,t+1,(t+4<NT),(t+2<NT),(t+2<NT));     ENDW(t+1); RESC(); ROT();
  }
  STEP(pB0,pB1,pA0,pA1,NT-1,false,false,false); RESC();
  { float sacc=pB0[0]+pB0[1]; _Pragma("unroll") for(int r=2;r<16;++r)sacc+=pB0[r]; _Pragma("unroll") for(int r=0;r<16;++r)sacc+=pB1[r]; l_reg+=sacc;
    pw0=(u32x4){PKW(pB0,0),PKW(pB0,2),PKW(pB0,4),PKW(pB0,6)};pw1=(u32x4){PKW(pB0,8),PKW(pB0,10),PKW(pB0,12),PKW(pB0,14)};pw2=(u32x4){PKW(pB1,0),PKW(pB1,2),PKW(pB1,4),PKW(pB1,6)};pw3=(u32x4){PKW(pB1,8),PKW(pB1,10),PKW(pB1,12),PKW(pB1,14)};
    SBAR(); pv(o,vb0+sl_cur,PAF(0),PAF(1),PAF(2),PAF(3)); }
  #undef PKW
  #undef PAF
  #undef VFR
  #undef PIN
  #undef MX3
  #undef GAPA
  #undef GAPB
  #undef EX
  #undef VRD
  #undef KRD
  #undef STEP
  #undef ENDW
  #undef MASKADD
  {auto rr=__builtin_amdgcn_permlane32_swap(__float_as_uint(l_reg),__float_as_uint(l_reg),false,false);l_reg=__uint_as_float(rr[0])+__uint_as_float(rr[1]);}
  if(hi==0)wsf[32+r32]=l_reg;asm volatile("s_waitcnt lgkmcnt(0)":::"memory");
  float rli[16];
  #pragma unroll
  for(int r=0;r<16;++r)rli[r]=__builtin_amdgcn_rcpf(wsf[32+crow(r,hi)]);
  bf16*Ow=O+(rowbase+q0+wid*QBLK)*DM+h*D;
  { bf16*stg=(bf16*)(shm+LDS_OST)+wid*2048;
    #pragma unroll
    for(int r=0;r<16;++r){const int orow=crow(r,hi);
      #pragma unroll
      for(int d0=0;d0<2;++d0)stg[orow*64+d0*32+r32]=__float2bfloat16(o[d0][r]*rli[r]);}
    asm volatile("s_waitcnt lgkmcnt(0)":::"memory");
    #pragma unroll
    for(int i=0;i<4;++i){const int row=i*8+(lane>>3),ch=lane&7; const u32x4 v=*(const u32x4*)(stg+row*64+ch*8); ATTN_STORE16(Ow+(long)row*DM+ch*8,v);} }
  asm volatile("s_waitcnt lgkmcnt(0)\n\ts_barrier":::"memory");
  #undef DMA_K
  #undef DMA_V
  #undef CMASK
  #undef START
  #undef RESC
  #undef ROT
}
constexpr int ATTN_LDS_BYTES=LDS_BYTES;
#undef SBAR
#undef WAIT_BAR
}
constexpr int NWAVES = 8;
constexpr int PER_PHASE = 10;
constexpr int N_LAUNCHES = MK_N_LAUNCHES;

constexpr int BATCH = 8, SEQ = 2048, DMODEL = 1024, MTOK = BATCH * SEQ;
constexpr int INCOLS = 4096, SSMW = 512, NGRP = 32, CH = 32  , NCHUNK = SEQ / CH  , APK = 640  ;
constexpr int PQ = 2048, NEXP = 16384;
constexpr float RMS_EPS = 1e-6f;

constexpr size_t MiB = 1u << 20;
constexpr size_t WS_CTL = 0, CTL_ZERO_BYTES = 64 * 1024;
constexpr size_t WS_BIAS = 1 * MiB;
constexpr size_t WS_PW32 = 1 * MiB + 64 * 1024;
constexpr size_t WS_KPART = 1 * MiB + 128 * 1024;
constexpr size_t WS_KG = 2 * MiB;
constexpr size_t WS_SSQ1 = 3 * MiB;
constexpr size_t WS_WIN = 6 * MiB, WS_WQ = 14 * MiB, WS_WOUT = 18 * MiB, WS_WUS = 20 * MiB, WS_WUA = 21 * MiB, WS_WGLU = 22 * MiB, WS_KS = 22 * MiB + 512 * 1024;
constexpr size_t WS_WE = 23 * MiB;
constexpr size_t WS_BP = 32 * MiB;
constexpr size_t WS_AP = 52 * MiB;
constexpr size_t WS_E = 72 * MiB;
constexpr size_t WS_H = 80 * MiB;
constexpr size_t WS_YPRE = 80 * MiB, WS_YA = 96 * MiB, WS_XG = 80 * MiB;
constexpr size_t WS_Z = 96 * MiB, ZSTRIDE_B = 16 * MiB;
constexpr size_t WS_MRG = 128 * MiB;
constexpr size_t WS_PQ = 160 * MiB;
constexpr size_t WS_IDS = 224 * MiB, WS_GTS = 232 * MiB;
constexpr size_t WS_U16 = 32 * MiB, WS_V16 = 240 * MiB;
constexpr size_t WS_YB = 224 * MiB;
constexpr size_t WS_WPK = 128 * MiB, WS_RSTD1 = 4 * MiB, WS_Y16 = 160 * MiB;
constexpr size_t WS_END = 256 * MiB;
constexpr int CW_BAR = 1024;

constexpr int RING_OFF = 0, RING_BYTES = 131072;
constexpr int LDSCTL_OFF = RING_BYTES, MISC_OFF = LDSCTL_OFF + 320;
constexpr int LDS_BYTES = 147456;

#define GAS __attribute__((address_space(1)))
#define LAS __attribute__((address_space(3)))
typedef unsigned short bf16;
typedef unsigned v4u __attribute__((ext_vector_type(4)));
typedef float f32x4 __attribute__((ext_vector_type(4)));
typedef short bf16x8 __attribute__((ext_vector_type(8)));
typedef float f32x16 __attribute__((ext_vector_type(16)));
typedef __bf16 bf16x2_t __attribute__((ext_vector_type(2)));
typedef _Float16 h2_t __attribute__((ext_vector_type(2)));
typedef GAS unsigned gu32;
#define RLX_AGENT __ATOMIC_RELAXED, __HIP_MEMORY_SCOPE_AGENT
#define LDS_WAIT() asm volatile("s_waitcnt lgkmcnt(0)" ::: "memory")
#define VM_WAIT() asm volatile("s_waitcnt vmcnt(0)" ::: "memory")
__device__ __forceinline__ unsigned f2bf(float f) { unsigned u = __builtin_bit_cast(unsigned, f); return (u + 0x7fffu + ((u >> 16) & 1u)) >> 16; }
__device__ __forceinline__ unsigned pk2(float lo, float hi) { return f2bf(lo) | (f2bf(hi) << 16); }
using pg8::cvt_pk_bf16; using pg8::bf_lo; using pg8::bf_hi; using pg8::sigmoid_f; using pg8::gelu_tanh;

#define XB_TMO      128
#define XB_XCNT(j)  (256  + 64 * (j))
#define XB_XSUB(j)  (1280 + 64 * (j))
#define XB_XGEN(j)  (2304 + 64 * (j))
#define XB_TOP      3328
#define XB_TOPGEN   3392
#define XCD_BAR_WORDS 3456
#define XB_SPIN_CAP (1u << 18)
__device__ __forceinline__ unsigned xb_ld(unsigned* p)              { return __hip_atomic_load(p, __ATOMIC_RELAXED, __HIP_MEMORY_SCOPE_AGENT); }
__device__ __forceinline__ unsigned xb_add(unsigned* p, unsigned v) { return __hip_atomic_fetch_add(p, v, __ATOMIC_RELAXED, __HIP_MEMORY_SCOPE_AGENT); }
__device__ __forceinline__ unsigned xb_xcc_id() { return (unsigned)__builtin_amdgcn_s_getreg((3 << 11) | 20) & 0xFu; }
#define XB_SPIN(cond, bar) do { unsigned _sp = 0; while (cond) { __builtin_amdgcn_s_sleep(1); \
    if ((++_sp & 255u) == 0u) { if (xb_ld(&(bar)[XB_TMO])) break; if (_sp > XB_SPIN_CAP) { atomicAdd(&(bar)[XB_TMO], 1u); break; } } } } while (0)
struct XcdBarrier { unsigned* bar; unsigned x; volatile LAS unsigned* st; };
__device__ __forceinline__ XcdBarrier xcd_barrier_post(unsigned* bar, volatile LAS unsigned* st) {
    XcdBarrier b; b.bar = bar; b.x = xb_xcc_id(); b.st = st;
    if (threadIdx.x == 0) (void)xb_add(&bar[XB_XCNT(b.x)], 1u);
    return b;
}
__device__ __forceinline__ void xcd_barrier_complete(unsigned* bar, unsigned x, unsigned& nloc, unsigned& nx) {
    const unsigned G = gridDim.x * gridDim.y * gridDim.z;
    unsigned sum, cnt, mine, sp = 0u;
    for (;;) {
        sum = 0u; cnt = 0u; mine = 0u;
#pragma unroll
        for (unsigned j = 0; j < 16; ++j) { const unsigned c = xb_ld(&bar[XB_XCNT(j)]); sum += c; cnt += (c > 0u) ? 1u : 0u; mine = (j == x) ? c : mine; }
        if (sum == G) break;
        __builtin_amdgcn_s_sleep(1);
        if ((++sp & 255u) == 0u) { if (xb_ld(&bar[XB_TMO])) break; if (sp > XB_SPIN_CAP) { atomicAdd(&bar[XB_TMO], 1u); break; } }
    }
    nloc = mine > 0u ? mine : 1u; nx = cnt > 0u ? cnt : 1u;
}
__device__ __forceinline__ void xcd_barrier(const XcdBarrier& b) {
    asm volatile("s_waitcnt vmcnt(0)" ::: "memory");
    __syncthreads();
    if (threadIdx.x == 0) {
        unsigned* bar = b.bar;
        __builtin_amdgcn_s_waitcnt(0);
        unsigned nloc = b.st[0], nx = b.st[1];
        if (nloc == 0u) { xcd_barrier_complete(bar, b.x, nloc, nx); b.st[0] = nloc; b.st[1] = nx; }
        const unsigned old = xb_add(&bar[XB_XSUB(b.x)], 1u);
        const unsigned gen = old / nloc;
        if (old + 1u == (gen + 1u) * nloc) {
            __builtin_amdgcn_fence(__ATOMIC_RELEASE, "agent");
            asm volatile("s_waitcnt vmcnt(0)" ::: "memory");
            const unsigned og = xb_add(&bar[XB_TOP], 1u);
            const unsigned tg = og / nx;
            if (og + 1u == (tg + 1u) * nx) xb_add(&bar[XB_TOPGEN], 1u);
            else XB_SPIN(xb_ld(&bar[XB_TOPGEN]) == tg, bar);
            __builtin_amdgcn_fence(__ATOMIC_ACQUIRE, "agent");
            xb_add(&bar[XB_XGEN(b.x)], 1u);
            asm volatile("s_waitcnt vmcnt(0)" ::: "memory");
        } else {
            XB_SPIN(xb_ld(&bar[XB_XGEN(b.x)]) == gen, bar);
            __builtin_amdgcn_fence(__ATOMIC_ACQUIRE, "agent");
            asm volatile("s_waitcnt vmcnt(0)" ::: "memory");
        }
    }
    __syncthreads();
}

__device__ __forceinline__ float wave_sum(float v) {
#pragma unroll
    for (int o = 1; o < 64; o <<= 1) v += __shfl_xor(v, o);
    return v;
}

namespace pg8 {
struct EpiIn {
    static constexpr bool PERM = true;
    bf16_t* zbase; bf16_t* AP; float* kpart;
    __device__ __forceinline__ void operator()(const f32x4 (&acc)[2][2][4][2], const Unit& u, int wr, int wc, int fr, int fq) const {
        const int t = u.pn >> 1, colt = (u.pn & 1) * 256;
        const int row0 = u.pm * BM + wr * 64 + fr, col0 = colt + wc * 32 + 8 * fq;
        if (t == 0) {
#pragma unroll
            for (int ai = 0; ai < 2; ++ai)
#pragma unroll
                for (int m = 0; m < 4; ++m) { const int r = row0 + ai * HALF + m * 16, b = r >> 11, l = r & 2047;
#pragma unroll
                    for (int bj = 0; bj < 2; ++bj) { const int c = col0 + bj * HALF, g = c >> 4, hi0 = c & 15;
                        const f32x4 v0 = acc[ai][bj][m][0], v1 = acc[ai][bj][m][1];
                        u32x4 w; w.x = cvt_pk_bf16(v0[0], v0[1]); w.y = cvt_pk_bf16(v0[2], v0[3]); w.z = cvt_pk_bf16(v1[0], v1[1]); w.w = cvt_pk_bf16(v1[2], v1[3]);
                        *(u32x4*)(AP + (size_t)(g * 512 + b * 64 + (l >> 5)) * 640 + (l & 31) * 16 + hi0) = w; } }
        } else {
            bf16_t* base = zbase + (size_t)t * (16u * 1024u * 1024u / 2u);
            const float sc = (t == 1) ? 0.125f * 1.4426950408889634f : 1.0f;
#pragma unroll
            for (int ai = 0; ai < 2; ++ai)
#pragma unroll
                for (int m = 0; m < 4; ++m) { bf16_t* rowp = base + (size_t)(row0 + ai * HALF + m * 16) * 512 + col0;
#pragma unroll
                    for (int bj = 0; bj < 2; ++bj) { f32x4 v0 = acc[ai][bj][m][0], v1 = acc[ai][bj][m][1];
                        if (t >= 4) {
#pragma unroll
                            for (int e = 0; e < 4; ++e) { v0[e] = sigmoid_f(v0[e]); v1[e] = sigmoid_f(v1[e]); }
                        } else { v0 = v0 * sc; v1 = v1 * sc; }
                        u32x4 w; w.x = cvt_pk_bf16(v0[0], v0[1]); w.y = cvt_pk_bf16(v0[2], v0[3]); w.z = cvt_pk_bf16(v1[0], v1[1]); w.w = cvt_pk_bf16(v1[2], v1[3]);
                        *(u32x4*)(rowp + bj * HALF) = w; } }
            if (t == 2) {
#pragma unroll
                for (int bj = 0; bj < 2; ++bj)
#pragma unroll
                    for (int n = 0; n < 2; ++n) { f32x4 s = (f32x4){0.f, 0.f, 0.f, 0.f};
#pragma unroll
                        for (int ai = 0; ai < 2; ++ai)
#pragma unroll
                            for (int m = 0; m < 4; ++m) s += acc[ai][bj][m][n];
#pragma unroll
                        for (int e = 0; e < 4; ++e) { float x = s[e]; x += __shfl_xor(x, 1); x += __shfl_xor(x, 2); x += __shfl_xor(x, 4); x += __shfl_xor(x, 8); s[e] = x; }
                        if (fr == 0) *(f32x4*)(kpart + (size_t)(u.pm * 2 + wr) * 512 + col0 + bj * HALF + 4 * n) = s; }
            }
        }
    }
};
struct EpiE {
    static constexpr bool PERM = false;
    float* E;
    __device__ __forceinline__ void operator()(const f32x4 (&acc)[2][2][4][2], const Unit& u, int wr, int wc, int fr, int fq) const {
        const int row0 = u.pm * BM + wr * 64 + fr, col0 = wc * 32 + 4 * fq;
#pragma unroll
        for (int ai = 0; ai < 2; ++ai)
#pragma unroll
            for (int m = 0; m < 4; ++m) { float* rowp = E + (size_t)(row0 + ai * HALF + m * 16) * 128 + col0;
#pragma unroll
                for (int n = 0; n < 2; ++n) *(f32x4*)(rowp + n * 16) = acc[ai][0][m][n]; }
    }
};
struct EpiY {
    static constexpr bool PERM = true;
    bf16_t* Y;
    __device__ __forceinline__ void operator()(const f32x4 (&acc)[2][2][4][2], const Unit& u, int wr, int wc, int fr, int fq) const {
        const int row0 = u.pm * BM + wr * 64 + fr, col0 = u.pn * BM + wc * 32 + 8 * fq;
#pragma unroll
        for (int ai = 0; ai < 2; ++ai)
#pragma unroll
            for (int m = 0; m < 4; ++m) { const int r = row0 + ai * HALF + m * 16, g = r >> 9, b = (r >> 6) & 7, c = r & 63;
#pragma unroll
                for (int bj = 0; bj < 2; ++bj) { const int cc = col0 + bj * HALF, j = cc >> 4, ho0 = cc & 15;
                    f32x4 v0 = acc[ai][bj][m][0], v1 = acc[ai][bj][m][1];
#pragma unroll
                    for (int e = 0; e < 4; ++e) { v0[e] = gelu_tanh(v0[e]); v1[e] = gelu_tanh(v1[e]); }
                    u32x4 w; w.x = cvt_pk_bf16(v0[0], v0[1]); w.y = cvt_pk_bf16(v0[2], v0[3]); w.z = cvt_pk_bf16(v1[0], v1[1]); w.w = cvt_pk_bf16(v1[2], v1[3]);
                    *(u32x4*)(Y + (size_t)(b * 2048 + c * 32 + j) * 512 + g * 16 + ho0) = w; } }
    }
};
struct EpiGlu {
    static constexpr bool PERM = true;
    const bf16_t* Yp; bf16_t* Ya; const float* bias;
    __device__ __forceinline__ void operator()(const f32x4 (&acc)[2][2][4][2], const Unit& u, int wr, int wc, int fr, int fq) const {
        const int row0 = u.pm * BM + wr * 64 + fr, col0 = u.pn * BM + wc * 32 + 8 * fq;
        f32x4 bv[2][2];
#pragma unroll
        for (int bj = 0; bj < 2; ++bj)
#pragma unroll
            for (int n = 0; n < 2; ++n) bv[bj][n] = *(const f32x4*)(bias + col0 + bj * HALF + 4 * n);
#pragma unroll
        for (int ai = 0; ai < 2; ++ai)
#pragma unroll
            for (int m = 0; m < 4; ++m) { const size_t off = (size_t)(row0 + ai * HALF + m * 16) * 512 + col0;
#pragma unroll
                for (int bj = 0; bj < 2; ++bj) { const f32x4 z0 = acc[ai][bj][m][0] + bv[bj][0], z1 = acc[ai][bj][m][1] + bv[bj][1];
                    const u32x4 y = *(const u32x4*)(Yp + off + bj * HALF);
                    u32x4 w; w.x = cvt_pk_bf16(bf_lo(y.x) * sigmoid_f(z0[0]), bf_hi(y.x) * sigmoid_f(z0[1])); w.y = cvt_pk_bf16(bf_lo(y.y) * sigmoid_f(z0[2]), bf_hi(y.y) * sigmoid_f(z0[3]));
                    w.z = cvt_pk_bf16(bf_lo(y.z) * sigmoid_f(z1[0]), bf_hi(y.z) * sigmoid_f(z1[1])); w.w = cvt_pk_bf16(bf_lo(y.w) * sigmoid_f(z1[2]), bf_hi(y.w) * sigmoid_f(z1[3]));
                    *(u32x4*)(Ya + off + bj * HALF) = w; } }
    }
};
template <int ADD> struct EpiMrg {
    static constexpr bool PERM = true;
    const bf16_t* G0; bf16_t* Mrg;
    __device__ __forceinline__ void operator()(const f32x4 (&acc)[2][2][4][2], const Unit& u, int wr, int wc, int fr, int fq) const {
        const int row0 = u.pm * BM + wr * 64 + fr, cin = wc * 32 + 8 * fq;
        const bf16_t* gb = G0 + (size_t)(u.pn >> 1) * (16u * 1024u * 1024u / 2u) + (u.pn & 1) * 256 + cin;
#pragma unroll
        for (int ai = 0; ai < 2; ++ai)
#pragma unroll
            for (int m = 0; m < 4; ++m) { const int r = row0 + ai * HALF + m * 16;
#pragma unroll
                for (int bj = 0; bj < 2; ++bj) {
#if defined(ABL_NO_SSM) || defined(ABL_NO_ATT)
#if defined(ABL_NO_SSM)
                    constexpr bool kill = (ADD == 0);
#else
                    constexpr bool kill = (ADD == 1);
#endif
                    const f32x4 a0 = kill ? (f32x4){0.f, 0.f, 0.f, 0.f} : acc[ai][bj][m][0], a1 = kill ? (f32x4){0.f, 0.f, 0.f, 0.f} : acc[ai][bj][m][1];
#else
                    const f32x4 a0 = acc[ai][bj][m][0], a1 = acc[ai][bj][m][1];
#endif
                    const u32x4 gt = *(const u32x4*)(gb + (size_t)r * 512 + bj * HALF);
                    bf16_t* mp = Mrg + (size_t)r * 1024 + u.pn * BM + cin + bj * HALF;
                    float o[8] = { bf_lo(gt.x) * a0[0], bf_hi(gt.x) * a0[1], bf_lo(gt.y) * a0[2], bf_hi(gt.y) * a0[3], bf_lo(gt.z) * a1[0], bf_hi(gt.z) * a1[1], bf_lo(gt.w) * a1[2], bf_hi(gt.w) * a1[3] };
                    if (ADD) { const u32x4 p = *(const u32x4*)mp; o[0] += bf_lo(p.x); o[1] += bf_hi(p.x); o[2] += bf_lo(p.y); o[3] += bf_hi(p.y); o[4] += bf_lo(p.z); o[5] += bf_hi(p.z); o[6] += bf_lo(p.w); o[7] += bf_hi(p.w); }
                    u32x4 w; w.x = cvt_pk_bf16(o[0], o[1]); w.y = cvt_pk_bf16(o[2], o[3]); w.z = cvt_pk_bf16(o[4], o[5]); w.w = cvt_pk_bf16(o[6], o[7]);
                    *(u32x4*)mp = w; } }
    }
};
struct EpiMrgDual {
    static constexpr bool PERM = true;
    EpiMrg<0> a; EpiMrg<1> b;
    __device__ __forceinline__ void operator()(const f32x4 (&acc)[2][2][4][2], const Unit& u, int wr, int wc, int fr, int fq) const { if (u.w == 0) a(acc, u, wr, wc, fr, fq); else b(acc, u, wr, wc, fr, fq); }
};
struct EpiX1 {
    static constexpr bool PERM = true;
    const float* X; float* X1; bf16_t* XG; const float* g2; float* ssq;
    __device__ __forceinline__ void operator()(const f32x4 (&acc)[2][2][4][2], const Unit& u, int wr, int wc, int fr, int fq) const {
        const int row0 = u.pm * BM + wr * 64 + fr, col0 = u.pn * BM + wc * 32 + 8 * fq;
        f32x4 gv[2][2];
#pragma unroll
        for (int bj = 0; bj < 2; ++bj)
#pragma unroll
            for (int n = 0; n < 2; ++n) gv[bj][n] = *(const f32x4*)(g2 + col0 + bj * HALF + 4 * n);
#pragma unroll
        for (int ai = 0; ai < 2; ++ai)
#pragma unroll
            for (int m = 0; m < 4; ++m) { const int r = row0 + ai * HALF + m * 16; const size_t off = (size_t)r * 1024 + col0; float s = 0.f;
#pragma unroll
                for (int bj = 0; bj < 2; ++bj) {
                    #ifdef ABL_NO_MIX
                    const f32x4 x0 = *(const f32x4*)(X + off + bj * HALF), x1 = *(const f32x4*)(X + off + bj * HALF + 4);
#else
                    const f32x4 x0 = *(const f32x4*)(X + off + bj * HALF) + acc[ai][bj][m][0], x1 = *(const f32x4*)(X + off + bj * HALF + 4) + acc[ai][bj][m][1];
#endif
                    *(f32x4*)(X1 + off + bj * HALF) = x0; *(f32x4*)(X1 + off + bj * HALF + 4) = x1;
                    s += (x0[0] * x0[0] + x0[1] * x0[1]) + (x0[2] * x0[2] + x0[3] * x0[3]) + (x1[0] * x1[0] + x1[1] * x1[1]) + (x1[2] * x1[2] + x1[3] * x1[3]);
                    const f32x4 a = x0 * gv[bj][0], b = x1 * gv[bj][1];
                    u32x4 w; w.x = cvt_pk_bf16(a[0], a[1]); w.y = cvt_pk_bf16(a[2], a[3]); w.z = cvt_pk_bf16(b[0], b[1]); w.w = cvt_pk_bf16(b[2], b[3]);
                    *(u32x4*)(XG + off + bj * HALF) = w; }
                s += __shfl_xor(s, 16); s += __shfl_xor(s, 32);
                if (fq == 0) ssq[(size_t)r * 16 + u.pn * 4 + wc] = s; }
    }
};
struct EpiPlain {
    static constexpr bool PERM = true;
    bf16_t* O; int ldc;
    __device__ __forceinline__ void operator()(const f32x4 (&acc)[2][2][4][2], const Unit& u, int wr, int wc, int fr, int fq) const {
        const int row0 = u.pm * BM + wr * 64 + fr, col0 = u.pn * BM + wc * 32 + 8 * fq;
#pragma unroll
        for (int ai = 0; ai < 2; ++ai)
#pragma unroll
            for (int m = 0; m < 4; ++m) { bf16_t* rowp = O + (size_t)(row0 + ai * HALF + m * 16) * ldc + col0;
#pragma unroll
                for (int bj = 0; bj < 2; ++bj) { const f32x4 v0 = acc[ai][bj][m][0], v1 = acc[ai][bj][m][1];
                    u32x4 w; w.x = cvt_pk_bf16(v0[0], v0[1]); w.y = cvt_pk_bf16(v0[2], v0[3]); w.z = cvt_pk_bf16(v1[0], v1[1]); w.w = cvt_pk_bf16(v1[2], v1[3]);
                    *(u32x4*)(rowp + bj * HALF) = w; } }
    }
};
}
struct Frame {
    LAS unsigned char* lds;
    int tid, lane, wave, vcu, G;
};

__device__ __forceinline__ void p0_transpose_item(const float* W, int K, int N, bf16* WT, LAS float* scr, int item, int lane) {
    const int nblk = N / 32, kb = item / nblk, nb = item % nblk, k0 = 64 * kb, n0 = 32 * nb;
    float wv[32];
#pragma unroll
    for (int i = 0; i < 32; ++i) { const int kk = 2 * i + (lane >> 5); wv[i] = W[(size_t)(k0 + kk) * N + n0 + (lane & 31)]; }
#pragma unroll
    for (int i = 0; i < 32; ++i) { const int kk = 2 * i + (lane >> 5); scr[kk * 33 + (lane & 31)] = wv[i]; }
    LDS_WAIT(); asm volatile("" ::: "memory");
    const int c = lane & 7;
#pragma unroll
    for (int j = 0; j < 4; ++j) { const int n = (lane >> 3) + 8 * j; const LAS float* s = scr + (8 * c) * 33 + n;
        v4u o; o.x = pk2(s[0 * 33], s[1 * 33]); o.y = pk2(s[2 * 33], s[3 * 33]); o.z = pk2(s[4 * 33], s[5 * 33]); o.w = pk2(s[6 * 33], s[7 * 33]);
        *(GAS v4u*)(WT + (size_t)(n0 + n) * K + k0 + 8 * c) = o; }
    LDS_WAIT(); asm volatile("" ::: "memory");
}
__device__ __forceinline__ void rms_row_to_bf16(const float* xrow, const float* g, bf16* orow, int lane) {
    const GAS f32x4* xr = (const GAS f32x4*)xrow + lane; const GAS f32x4* gr = (const GAS f32x4*)g + lane;
    f32x4 v[4]; float s = 0.f;
#pragma unroll
    for (int j = 0; j < 4; ++j) { v[j] = xr[64 * j]; s += (v[j].x * v[j].x + v[j].y * v[j].y) + (v[j].z * v[j].z + v[j].w * v[j].w); }
    const float rstd = 1.0f / sqrtf(wave_sum(s) * (1.f / DMODEL) + RMS_EPS);
    GAS unsigned long long* o8 = (GAS unsigned long long*)orow + lane;
#pragma unroll
    for (int j = 0; j < 4; ++j) { const f32x4 gg = gr[64 * j];
        o8[64 * j] = (unsigned long long)pk2(v[j].x * rstd * gg.x, v[j].y * rstd * gg.y) | ((unsigned long long)pk2(v[j].z * rstd * gg.z, v[j].w * rstd * gg.w) << 32); }
}
__device__ __forceinline__ void rms_rows4_to_bf16(const float* x, const float* g, bf16* out, int m, int stride, int lane) {
    f32x4 v[4][4];
#pragma unroll
    for (int k = 0; k < 4; ++k) { const int mm = (m + k * stride < MTOK) ? m + k * stride : m; const GAS f32x4* xr = (const GAS f32x4*)(x + (size_t)mm * DMODEL) + lane;
#pragma unroll
        for (int j = 0; j < 4; ++j) v[k][j] = xr[64 * j]; }
    const GAS f32x4* gr = (const GAS f32x4*)g + lane; f32x4 gg[4];
#pragma unroll
    for (int j = 0; j < 4; ++j) gg[j] = gr[64 * j];
#pragma unroll
    for (int k = 0; k < 4; ++k) { if (m + k * stride >= MTOK) break; float s = 0.f;
#pragma unroll
        for (int j = 0; j < 4; ++j) s += (v[k][j].x * v[k][j].x + v[k][j].y * v[k][j].y) + (v[k][j].z * v[k][j].z + v[k][j].w * v[k][j].w);
        const float rstd = 1.0f / sqrtf(wave_sum(s) * (1.f / DMODEL) + RMS_EPS);
        GAS unsigned long long* o8 = (GAS unsigned long long*)(out + (size_t)(m + k * stride) * DMODEL) + lane;
#pragma unroll
        for (int j = 0; j < 4; ++j) o8[64 * j] = (unsigned long long)pk2(v[k][j].x * rstd * gg[j].x, v[k][j].y * rstd * gg[j].y) | ((unsigned long long)pk2(v[k][j].z * rstd * gg[j].z, v[k][j].w * rstd * gg[j].w) << 32); }
}
struct cpx { float r, i; };
__device__ __forceinline__ cpx cmul(cpx a, cpx b) { return cpx{a.r * b.r - a.i * b.i, a.r * b.i + a.i * b.r}; }
__device__ __forceinline__ cpx cpow_(float ar, float ai, float dt, int n) { const float e = expf(ar * dt * (float)n); const float ang = ai * dt * (float)n; return cpx{e * cosf(ang), e * sinf(ang)}; }
__device__ __forceinline__ void ssm_table_task(int g, int j, int lane, LAS float* scr, const float* a_re, const float* a_im, const float* log_dt, const float* b_re, const float* b_im,
                                               const float* c_re, const float* c_im, float* Kg, bf16* WE, bf16* BP, float* pw32) {
    const int p = lane;
    const float dt = expf(log_dt[g]), ar = a_re[g * 64 + p], ai = a_im[g * 64 + p];
#define pw(n) cpow_(ar, ai, dt, (n))
    const cpx lb = pw(1);
    const float den = ar * ar + ai * ai;
    const cpx coef = cpx{((lb.r - 1.f) * ar + lb.i * ai) / den, (lb.i * ar - (lb.r - 1.f) * ai) / den};
    const cpx pj = pw(j), pe = pw(31 - j), pv = pw(j + 1);
    unsigned wer[8], wei[8];
#pragma unroll
    for (int h2 = 0; h2 < 8; ++h2) { float er[2], ei[2];
#pragma unroll
        for (int q = 0; q < 2; ++q) { const int hi = 2 * h2 + q;
            const cpx bb = cmul(coef, cpx{b_re[(g * 64 + p) * 16 + hi], b_im[(g * 64 + p) * 16 + hi]});
            const cpx w = cmul(pj, bb); scr[(p * 16 + hi) * 2] = w.r; scr[(p * 16 + hi) * 2 + 1] = w.i;
            const cpx e = cmul(pe, bb); er[q] = e.r; ei[q] = e.i; }
        wer[h2] = pk2(er[0], er[1]); wei[h2] = pk2(ei[0], ei[1]); }
    { bf16* w0 = WE + ((size_t)(g * 256 + p) * 512 + j * 16); bf16* w1 = WE + ((size_t)(g * 256 + 64 + p) * 512 + j * 16);
      *(GAS v4u*)w0 = (v4u){wer[0], wer[1], wer[2], wer[3]}; *(GAS v4u*)(w0 + 8) = (v4u){wer[4], wer[5], wer[6], wer[7]};
      *(GAS v4u*)w1 = (v4u){wei[0], wei[1], wei[2], wei[3]}; *(GAS v4u*)(w1 + 8) = (v4u){wei[4], wei[5], wei[6], wei[7]};
      bf16* z0 = WE + ((size_t)(g * 256 + 128 + p) * 512 + j * 16); bf16* z1 = WE + ((size_t)(g * 256 + 192 + p) * 512 + j * 16); const v4u z = (v4u){0u, 0u, 0u, 0u};
      *(GAS v4u*)z0 = z; *(GAS v4u*)(z0 + 8) = z; *(GAS v4u*)z1 = z; *(GAS v4u*)(z1 + 8) = z; }
#pragma unroll 4
    for (int ho = 0; ho < 16; ++ho) { const cpx cv = cmul(cpx{c_re[(g * 16 + ho) * 64 + p], c_im[(g * 16 + ho) * 64 + p]}, pv);
        bf16* row = BP + ((size_t)(g * 512 + j * 16 + ho) * APK + 512);
        row[p] = (bf16)f2bf(cv.r); row[64 + p] = (bf16)f2bf(-cv.i); }
    if (j == 0) { const cpx p32 = pw(32); pw32[g * 128 + p] = p32.r; pw32[g * 128 + 64 + p] = p32.i; }
    LDS_WAIT(); asm volatile("" ::: "memory");
    { const int ho = lane >> 2, h4 = (lane & 3) * 4; float a0 = 0.f, a1 = 0.f, a2 = 0.f, a3 = 0.f;
      const float* cr = c_re + (g * 16 + ho) * 64; const float* ci = c_im + (g * 16 + ho) * 64;
#pragma unroll 4
      for (int pp = 0; pp < 64; ++pp) { const float r_ = cr[pp], i_ = ci[pp]; const LAS float* w = scr + (pp * 16 + h4) * 2;
          a0 += r_ * w[0] - i_ * w[1]; a1 += r_ * w[2] - i_ * w[3]; a2 += r_ * w[4] - i_ * w[5]; a3 += r_ * w[6] - i_ * w[7]; }
      *(GAS f32x4*)(Kg + ((size_t)(g * 32 + j) * 256 + ho * 16 + h4)) = (f32x4){a0, a1, a2, a3}; }
    LDS_WAIT(); asm volatile("" ::: "memory");
#undef pw
}

__device__ __forceinline__ float vmaxf(float a, float b) { float r; asm("v_max_f32_e32 %0, %1, %2" : "=v"(r) : "v"(a), "v"(b)); return r; }
__device__ __forceinline__ float vminf(float a, float b) { float r; asm("v_min_f32_e32 %0, %1, %2" : "=v"(r) : "v"(a), "v"(b)); return r; }
__device__ __forceinline__ float selhi(float lo, float hi) { float r; asm("v_cndmask_b32_e64 %0, %1, %2, %3" : "=v"(r) : "v"(lo), "v"(hi), "s"(0xFFFFFFFF00000000ull)); return r; }
#define CE_DESC(a, b) do { const float hi_ = vmaxf(a, b), lo_ = vminf(a, b); a = hi_; b = lo_; } while (0)
__device__ __forceinline__ void sort16_desc(float (&v)[16]) {
#pragma unroll
    for (int k = 2; k <= 16; k <<= 1)
#pragma unroll
        for (int j = k >> 1; j > 0; j >>= 1)
#pragma unroll
            for (int i = 0; i < 16; ++i) { const int l = i ^ j; if (l > i) { if ((i & k) == 0) CE_DESC(v[i], v[l]); else CE_DESC(v[l], v[i]); } }
}
__device__ __forceinline__ void bitonic_merge16_desc(float (&v)[16]) {
#pragma unroll
    for (int j = 8; j > 0; j >>= 1)
#pragma unroll
        for (int i = 0; i < 16; ++i) { const int l = i ^ j; if (l > i) CE_DESC(v[i], v[l]); }
}
__device__ __forceinline__ void merge_top16(float (&a)[16], const float (&b)[16]) {
#pragma unroll
    for (int i = 0; i < 16; ++i) a[i] = vmaxf(a[i], b[15 - i]);
    bitonic_merge16_desc(a);
}
__device__ __forceinline__ void merge_partner_top16(float (&a)[16]) {
    float p[16];
#pragma unroll
    for (int i = 0; i < 16; ++i) { const unsigned x = __float_as_uint(a[15 - i]); auto rr = __builtin_amdgcn_permlane32_swap(x, x, false, false); p[i] = selhi(__uint_as_float(rr[1]), __uint_as_float(rr[0])); }
#pragma unroll
    for (int i = 0; i < 16; ++i) a[i] = vmaxf(a[i], p[i]);
    bitonic_merge16_desc(a);
}
__device__ __forceinline__ void topk_half(int half, const bf16x8 (&qf)[8], int r32, int hi, const LAS unsigned char* ksl, float (&top)[16]) {
#pragma unroll 1
    for (int kt = 0; kt < 4; ++kt) {
        f32x16 acc = f32x16{};
        const int row = half * 128 + kt * 32 + r32; const LAS unsigned char* rp = ksl + row * 256; const int sw = row & 15;
#pragma unroll
        for (int ks = 0; ks < 8; ++ks) { const bf16x8 a = *(const LAS bf16x8*)(rp + (((2 * ks + hi) ^ sw) << 4));
            acc = __builtin_amdgcn_mfma_f32_32x32x16_bf16(a, qf[ks], acc, 0, 0, 0); }
        float grp[16];
#pragma unroll
        for (int r = 0; r < 16; ++r) { const unsigned key = (unsigned)(kt * 32 + (r & 3) + 8 * (r >> 2)) + 4u * (unsigned)hi; grp[r] = __uint_as_float((__float_as_uint(acc[r]) & ~127u) | key); }
        sort16_desc(grp);
        if (kt == 0) {
#pragma unroll
            for (int i = 0; i < 16; ++i) top[i] = grp[i];
        } else merge_top16(top, grp);
    }
    merge_partner_top16(top);
}
__device__ __forceinline__ void topk_task(int tt, int hd, int lane, LAS unsigned char* scr, const bf16* PQb, const LAS unsigned char* ksl, const float* ssq1, int* ids, float* gts, float* rstd1) {
    const int r32 = lane & 31, hi = lane >> 5; const bool hib = hi != 0;
    const int token = tt * 32 + r32;
    float v0_[16], v1_[16];
    bf16x8 qf0[8], qf1[8];
#pragma unroll
    for (int ks = 0; ks < 8; ++ks) { qf0[ks] = *(const GAS bf16x8*)(PQb + (size_t)token * PQ + hd * 256 + ks * 16 + hi * 8); qf1[ks] = *(const GAS bf16x8*)(PQb + (size_t)token * PQ + hd * 256 + 128 + ks * 16 + hi * 8); }
    topk_half(0, qf0, r32, hi, ksl, v0_);
    topk_half(1, qf1, r32, hi, ksl, v1_);
#define v_SEL(h, i) ((h) ? v1_[i] : v0_[i])
    LAS unsigned char* slot = scr + lane * 32;
    { v4u d0, d1;
#define PK4(h, k) ((__float_as_uint(v_SEL(h, 4 * (k))) & 127u) | ((__float_as_uint(v_SEL(h, 4 * (k) + 1)) & 127u) << 8) | ((__float_as_uint(v_SEL(h, 4 * (k) + 2)) & 127u) << 16) | ((__float_as_uint(v_SEL(h, 4 * (k) + 3)) & 127u) << 24))
      d0 = (v4u){PK4(0, 0), PK4(0, 1), PK4(0, 2), PK4(0, 3)}; d1 = (v4u){PK4(1, 0), PK4(1, 1), PK4(1, 2), PK4(1, 3)};
#undef PK4
      *(LAS v4u*)slot = d0; *(LAS v4u*)(slot + 16) = d1; }
    float a[16], b[16];
#pragma unroll
    for (int i = 0; i < 16; ++i) { a[i] = selhi(v0_[i], v1_[i]); b[i] = selhi(v1_[i], v0_[i]); }
    const unsigned obit = (unsigned)hi << 8;
#define CAND(i, j) __uint_as_float((__float_as_uint(a[i] + b[j]) & ~511u) | obit | (unsigned)(((i) << 4) | (j)))
    const float NEGBIG = -3.0e38f;
    float g0[16], g1[16];
#pragma unroll
    for (int j = 1; j < 16; ++j) g0[j - 1] = CAND(0, j);
    g0[15] = CAND(1, 2);
    g1[0] = CAND(1, 3); g1[1] = CAND(1, 4); g1[2] = CAND(1, 5); g1[3] = CAND(1, 6); g1[4] = CAND(1, 7); g1[5] = CAND(2, 3); g1[6] = CAND(2, 4);
    { const float c0 = CAND(0, 0), c1 = CAND(1, 1), c2 = CAND(2, 2), c3 = CAND(3, 3);
      g1[7] = selhi(c0, NEGBIG); g1[8] = selhi(c1, NEGBIG); g1[9] = selhi(c2, NEGBIG); g1[10] = selhi(c3, NEGBIG); }
#pragma unroll
    for (int i = 11; i < 16; ++i) g1[i] = NEGBIG;
#undef CAND
    sort16_desc(g0); sort16_desc(g1); merge_top16(g0, g1); merge_partner_top16(g0);
    float rstd;
    { const GAS f32x4* sp = (const GAS f32x4*)(ssq1 + (size_t)token * 16); const f32x4 s0 = sp[0], s1 = sp[1], s2 = sp[2], s3 = sp[3];
      const float ss = ((s0.x + s0.y) + (s0.z + s0.w)) + ((s1.x + s1.y) + (s1.z + s1.w)) + ((s2.x + s2.y) + (s2.z + s2.w)) + ((s3.x + s3.y) + (s3.z + s3.w));
      rstd = 1.0f / sqrtf(ss * (1.f / DMODEL) + RMS_EPS); }
    if (hd == 0 && !hib) rstd1[token] = rstd;
    float ex[16], esum = 0.f; const float sc = rstd * 1.4426950409f;
#pragma unroll
    for (int k = 0; k < 16; ++k) { ex[k] = __builtin_amdgcn_exp2f((g0[k] - g0[0]) * sc); esum += ex[k]; }
    const float inv = 1.0f / esum;
    int eid[8]; float gv[8];
#pragma unroll
    for (int k = 0; k < 8; ++k) { const float wv = selhi(g0[k], g0[8 + k]); const float ev = selhi(ex[k], ex[8 + k]);
        const unsigned tag = __float_as_uint(wv) & 511u, o = tag >> 8, i = (tag >> 4) & 15u, j = tag & 15u; const unsigned i1 = o ? j : i, i2 = o ? i : j;
        const unsigned k1 = slot[i1], k2 = slot[16 + i2];
        eid[k] = (int)(k1 * 128u + k2); gv[k] = ev * inv; }
    { int* ip = ids + (size_t)token * 128 + hd * 16 + 8 * hi; float* gp = gts + (size_t)token * 128 + hd * 16 + 8 * hi;
      *(GAS v4u*)ip = (v4u){(unsigned)eid[0], (unsigned)eid[1], (unsigned)eid[2], (unsigned)eid[3]}; *(GAS v4u*)(ip + 4) = (v4u){(unsigned)eid[4], (unsigned)eid[5], (unsigned)eid[6], (unsigned)eid[7]};
      *(GAS f32x4*)gp = (f32x4){gv[0], gv[1], gv[2], gv[3]}; *(GAS f32x4*)(gp + 4) = (f32x4){gv[4], gv[5], gv[6], gv[7]}; }
    LDS_WAIT(); asm volatile("" ::: "memory");
}


__device__ __forceinline__ float dot2bf(unsigned a, unsigned b, float c) { return __builtin_amdgcn_fdot2_f32_bf16(__builtin_bit_cast(bf16x2_t, a), __builtin_bit_cast(bf16x2_t, b), c, false); }
__device__ __forceinline__ h2_t fma_h2(unsigned v, h2_t w, h2_t acc) { return __builtin_elementwise_fma(__builtin_bit_cast(h2_t, v), w, acc); }
__device__ __forceinline__ unsigned fp8lo_bf(unsigned w, float sc) { return __builtin_bit_cast(unsigned, __builtin_amdgcn_cvt_scalef32_pk_bf16_fp8((int)w, sc, false)); }
__device__ __forceinline__ unsigned fp8hi_bf(unsigned w, float sc) { return __builtin_bit_cast(unsigned, __builtin_amdgcn_cvt_scalef32_pk_bf16_fp8((int)w, sc, true)); }
__device__ __forceinline__ h2_t fp8lo_h(unsigned w, float sc) { return __builtin_amdgcn_cvt_scalef32_pk_f16_fp8((int)w, sc, false); }
__device__ __forceinline__ h2_t fp8hi_h(unsigned w, float sc) { return __builtin_amdgcn_cvt_scalef32_pk_f16_fp8((int)w, sc, true); }
__device__ __forceinline__ unsigned pack_fp8x4(float a, float b, float c, float d) { int w = __builtin_amdgcn_cvt_pk_fp8_f32(a, b, 0, false); w = __builtin_amdgcn_cvt_pk_fp8_f32(c, d, w, true); return (unsigned)w; }
constexpr size_t V6B_OFF = 8u << 20;
constexpr float U8_SCALE = 64.0f, V8_SCALE = 5.656854f;
constexpr int PA_CAP = 456;
constexpr float X8_SCALE = 2.0f;
typedef int v8i_t __attribute__((ext_vector_type(8)));
typedef _Float16 v32h_t __attribute__((ext_vector_type(32)));
typedef unsigned v6u_t __attribute__((ext_vector_type(6)));
typedef unsigned v2u __attribute__((ext_vector_type(2)));
struct TokB { v8i_t b[8]; };
struct RowsA { const unsigned char* p0; const unsigned char* p1; };
__device__ __forceinline__ int pa_tok(unsigned tl, int tb, int nwg) { return ((tl < 4u) ? tb : nwg) + (int)(tl & 3u); }
__device__ __forceinline__ RowsA pa_rows(int b, int n, int lane, const LAS unsigned* list, const unsigned char* U6) {
    const int i0 = b * 16 + (lane >> 3), r8 = lane >> 3, ps = lane & 7;
    const unsigned e0 = list[i0 < n ? i0 : 0], e1 = list[i0 + 8 < n ? i0 + 8 : 0];
    RowsA R; R.p0 = U6 + (size_t)(e0 & 0x3fffu) * 768 + ((ps ^ r8) * 16); R.p1 = U6 + (size_t)(e1 & 0x3fffu) * 768 + ((ps ^ r8 ^ 1) * 16);
    return R;
}
template <int J> __device__ __forceinline__ void pa_dma(const RowsA& R, LAS unsigned char* ring) {
    __builtin_amdgcn_global_load_lds((const unsigned*)R.p0, (LAS unsigned*)(ring + J * (2048 - 128)), 16, J * 128, 0);
    __builtin_amdgcn_global_load_lds((const unsigned*)R.p1, (LAS unsigned*)(ring + J * (2048 - 128) + 1024), 16, J * 128, 0);
}
#define PA_VWAIT(n) asm volatile("s_waitcnt vmcnt(" #n ")" ::: "memory")
#define PA_LWAIT(n) asm volatile("s_waitcnt lgkmcnt(" #n ")" ::: "memory")
__device__ __forceinline__ int pa_uoff(int u, int r) { return (u >> 4) * 2048 + (r >> 3) * 1024 + (r & 7) * 128 + ((((u >> 1) & 7) ^ (r & 7) ^ (r >> 3)) << 4) + (u & 1) * 8; }
struct OpA { v2u d0, d1, d2; };
__device__ __forceinline__ OpA pa_rd(int m, const LAS unsigned char* ring, int r, int g) { const int u = 12 * m + 3 * g; OpA a;
    a.d0 = *(const LAS v2u*)(ring + pa_uoff(u, r)); a.d1 = *(const LAS v2u*)(ring + pa_uoff(u + 1, r)); a.d2 = *(const LAS v2u*)(ring + pa_uoff(u + 2, r)); return a; }
__device__ __forceinline__ f32x4 pa_mm(f32x4 acc, const OpA& a, const TokB& X, int m) {
    return __builtin_amdgcn_mfma_scale_f32_16x16x128_f8f6f4((v8i_t){(int)a.d0.x, (int)a.d0.y, (int)a.d1.x, (int)a.d1.y, (int)a.d2.x, (int)a.d2.y, 0, 0}, X.b[m], acc, 2, 2, 0, 0, 0, 0);
}
__device__ __forceinline__ void pa_flush(int n, const TokB& X, int lane, LAS unsigned* list, const LAS unsigned* gl, LAS unsigned char* ring, const unsigned char* U6, unsigned* wpk, int tb, int nwg) {
    if (n == 0) return;
    LDS_WAIT(); asm volatile("" ::: "memory");
    const int nb = (n + 15) >> 4;
    const int r = lane & 15, g = lane >> 4;
    RowsA cur = pa_rows(0, n, lane, list, U6), nxt = cur;
    pa_dma<0>(cur, ring); pa_dma<1>(cur, ring); pa_dma<2>(cur, ring); pa_dma<3>(cur, ring); pa_dma<4>(cur, ring); pa_dma<5>(cur, ring);
    for (int b = 0; b < nb; ++b) {
        f32x4 acc0 = {0.f, 0.f, 0.f, 0.f}, acc1 = {0.f, 0.f, 0.f, 0.f};
        OpA A0, A1;
        if (b + 1 < nb) {
            nxt = pa_rows(b + 1, n, lane, list, U6);
            PA_VWAIT(10); A0 = pa_rd(0, ring, r, g);
            PA_VWAIT(8);  A1 = pa_rd(1, ring, r, g); PA_LWAIT(3); acc0 = pa_mm(acc0, A0, X, 0);
            PA_VWAIT(6);  A0 = pa_rd(2, ring, r, g); PA_LWAIT(3); acc1 = pa_mm(acc1, A1, X, 1); pa_dma<0>(nxt, ring);
                          A1 = pa_rd(3, ring, r, g); PA_LWAIT(3); acc0 = pa_mm(acc0, A0, X, 2); pa_dma<1>(nxt, ring);
            PA_VWAIT(8);  A0 = pa_rd(4, ring, r, g); PA_LWAIT(3); acc1 = pa_mm(acc1, A1, X, 3); pa_dma<2>(nxt, ring);
            PA_VWAIT(8);  A1 = pa_rd(5, ring, r, g); PA_LWAIT(3); acc0 = pa_mm(acc0, A0, X, 4);
            PA_VWAIT(6);  A0 = pa_rd(6, ring, r, g); PA_LWAIT(3); acc1 = pa_mm(acc1, A1, X, 5); pa_dma<3>(nxt, ring);
                          A1 = pa_rd(7, ring, r, g); PA_LWAIT(3); acc0 = pa_mm(acc0, A0, X, 6); pa_dma<4>(nxt, ring);
                                                     PA_LWAIT(0); acc1 = pa_mm(acc1, A1, X, 7); pa_dma<5>(nxt, ring);
            cur = nxt;
        } else {
            PA_VWAIT(0);
            A0 = pa_rd(0, ring, r, g);
#pragma unroll
            for (int m = 0; m < 8; m += 2) { A1 = pa_rd(m + 1, ring, r, g); PA_LWAIT(3); acc0 = pa_mm(acc0, A0, X, m);
                if (m + 2 < 8) { A0 = pa_rd(m + 2, ring, r, g); PA_LWAIT(3); } else PA_LWAIT(0);
                acc1 = pa_mm(acc1, A1, X, m + 1); }
        }
        const f32x4 acc = acc0 + acc1;
        const int idx = b * 16 + r; const unsigned ent = list[idx], tl = ent >> 21, slot = (ent >> 14) & 127u;
        const int src = (int)((((unsigned)r >> 2) * 16u + tl) << 2);
        const float v0 = __int_as_float(__builtin_amdgcn_ds_bpermute(src, __float_as_int(acc.x))), v1 = __int_as_float(__builtin_amdgcn_ds_bpermute(src, __float_as_int(acc.y)));
        const float v2 = __int_as_float(__builtin_amdgcn_ds_bpermute(src, __float_as_int(acc.z))), v3 = __int_as_float(__builtin_amdgcn_ds_bpermute(src, __float_as_int(acc.w)));
        const float dv = (r & 2) ? ((r & 1) ? v3 : v2) : ((r & 1) ? v1 : v0);
        if (lane < 16 && idx < n) { const int t = pa_tok(tl, tb, nwg);
            const _Float16 wh = (_Float16)(__uint_as_float(gl[tl * 128 + slot]) * (1.0f / V8_SCALE) * gelu_tanh(dv * (1.0f / (U8_SCALE * X8_SCALE))));
            const unsigned pos = __hip_atomic_fetch_add((LAS unsigned*)(list + PA_CAP) + tl, 1u, __ATOMIC_RELAXED, __HIP_MEMORY_SCOPE_WAVEFRONT);
            wpk[(size_t)t * 128 + pos] = ((unsigned)__builtin_bit_cast(unsigned short, wh) << 16) | (ent & 0x3fffu); }
    }
    LDS_WAIT(); asm volatile("" ::: "memory");
}
__device__ __forceinline__ void peer_a_phase(int lane, int wave, int G, int vcu, const bf16* XG, const unsigned char* U6, const int* ids, const float* gts, const float* rstd1, unsigned* wpk, LAS unsigned char* lds, int emask) {
    (void)emask;
    LAS unsigned char* ring = lds + RING_OFF + wave * 16384;
    LAS unsigned* gl = (LAS unsigned*)(ring + 12288);
    LAS unsigned* list = (LAS unsigned*)(lds + MISC_OFF + 128 + wave * (464 * 4));
    for (int tile0 = vcu; tile0 < MTOK / 32; tile0 += 2 * G) {
        const int tile1 = tile0 + G; const bool has1 = tile1 < MTOK / 32;
        const int tb = tile0 * 32 + wave * 4, nwg = (has1 ? tile1 : tile0) * 32 + wave * 4;
        int id0[8], id1[8];
        if (lane < 8) list[PA_CAP + lane] = 0u;
#pragma unroll
        for (int k = 0; k < 8; ++k) { const bool ok = (k < 4) || has1; const int tc = pa_tok((unsigned)k, tb, nwg);
            gl[k * 128 + lane] = __float_as_uint(gts[(size_t)tc * 128 + lane]); gl[k * 128 + 64 + lane] = __float_as_uint(gts[(size_t)tc * 128 + 64 + lane]);
            id0[k] = ok ? ids[(size_t)tc * 128 + lane] : -1; id1[k] = ok ? ids[(size_t)tc * 128 + 64 + lane] : -1; }
#pragma unroll
        for (int p = 0; p < 4; ++p) { const int k = 2 * p + (lane >> 5), tc = pa_tok((unsigned)k, tb, nwg);
            typedef float v16f_t __attribute__((ext_vector_type(16)));
            const GAS v4u* xs = (const GAS v4u*)(XG + (size_t)tc * 1024 + 32 * (lane & 31));
            const v4u x0 = xs[0], x1 = xs[1], x2 = xs[2], x3 = xs[3];
            const float rs = rstd1[tc] * X8_SCALE;
            const unsigned w[16] = {x0.x, x0.y, x0.z, x0.w, x1.x, x1.y, x1.z, x1.w, x2.x, x2.y, x2.z, x2.w, x3.x, x3.y, x3.z, x3.w};
            float f[32];
#pragma unroll
            for (int i = 0; i < 16; ++i) { f[2 * i] = __uint_as_float(w[i] << 16) * rs; f[2 * i + 1] = __uint_as_float(w[i] & 0xffff0000u) * rs; }
            const v16f_t lo16 = {f[0], f[1], f[2], f[3], f[4], f[5], f[6], f[7], f[8], f[9], f[10], f[11], f[12], f[13], f[14], f[15]},
                         hi16 = {f[16], f[17], f[18], f[19], f[20], f[21], f[22], f[23], f[24], f[25], f[26], f[27], f[28], f[29], f[30], f[31]};
            v6u_t p6; asm volatile("s_nop 1\n\tv_cvt_scalef32_2xpk16_fp6_f32 %0, %1, %2, 1.0" : "=&v"(p6) : "v"(lo16), "v"(hi16));
            LAS v2u* dst = (LAS v2u*)(ring + k * 768 + 24 * (lane & 31)); dst[0] = (v2u){p6[0], p6[1]}; dst[1] = (v2u){p6[2], p6[3]}; dst[2] = (v2u){p6[4], p6[5]}; }
        LDS_WAIT(); asm volatile("" ::: "memory");
        TokB X;
#pragma unroll
        for (int m = 0; m < 8; ++m) { const LAS v2u* xp = (const LAS v2u*)(ring + (lane & 7) * 768 + m * 96 + (lane >> 4) * 24);
            const v2u d0 = xp[0], d1 = xp[1], d2 = xp[2];
            X.b[m] = (v8i_t){(int)d0.x, (int)d0.y, (int)d1.x, (int)d1.y, (int)d2.x, (int)d2.y, 0, 0}; }
        LDS_WAIT(); asm volatile("" ::: "memory");
        int n = 0;
        for (int part = 0; part < 8; ++part) {
#pragma unroll
            for (int k = 0; k < 8; ++k) {
                { const bool sel = (id0[k] >> 11) == part; const unsigned long long m = __ballot(sel);
                  const int pos = n + (int)__builtin_amdgcn_mbcnt_hi((unsigned)(m >> 32), __builtin_amdgcn_mbcnt_lo((unsigned)m, 0u));
                  if (sel) list[pos] = ((unsigned)k << 21) | ((unsigned)lane << 14) | (unsigned)id0[k]; n += __builtin_popcountll(m); }
                { const bool sel = (id1[k] >> 11) == part; const unsigned long long m = __ballot(sel);
                  const int pos = n + (int)__builtin_amdgcn_mbcnt_hi((unsigned)(m >> 32), __builtin_amdgcn_mbcnt_lo((unsigned)m, 0u));
                  if (sel) list[pos] = ((unsigned)k << 21) | ((unsigned)(64 + lane) << 14) | (unsigned)id1[k]; n += __builtin_popcountll(m); }
                if (n > PA_CAP - 128) { pa_flush(n, X, lane, list, gl, ring, U6, wpk, tb, nwg); n = 0; }
            }
        }
        pa_flush(n, X, lane, list, gl, ring, U6, wpk, tb, nwg);
    }
}
__device__ __forceinline__ void final_token(int t, int lane, const unsigned short* Y16, float* X1, const float* fg) {
    GAS f32x4* xp = (GAS f32x4*)(X1 + (size_t)t * 1024 + 8 * lane);
    f32x4 x0 = xp[0], x1 = xp[1], x2 = xp[128], x3 = xp[129];
    const v4u ya = *(const GAS v4u*)(Y16 + (size_t)t * 1024 + 8 * lane), yb = *(const GAS v4u*)(Y16 + (size_t)t * 1024 + 512 + 8 * lane);
    const unsigned yw[8] = {ya.x, ya.y, ya.z, ya.w, yb.x, yb.y, yb.z, yb.w};
    float y[16];
#pragma unroll
    for (int i = 0; i < 8; ++i) { const unsigned w = yw[i]; const h2_t h = __builtin_bit_cast(h2_t, w); y[2 * i] = (float)h[0]; y[2 * i + 1] = (float)h[1]; }
    x0 += (f32x4){y[0], y[1], y[2], y[3]}; x1 += (f32x4){y[4], y[5], y[6], y[7]}; x2 += (f32x4){y[8], y[9], y[10], y[11]}; x3 += (f32x4){y[12], y[13], y[14], y[15]};
    float ss = (x0.x * x0.x + x0.y * x0.y) + (x0.z * x0.z + x0.w * x0.w) + (x1.x * x1.x + x1.y * x1.y) + (x1.z * x1.z + x1.w * x1.w)
             + (x2.x * x2.x + x2.y * x2.y) + (x2.z * x2.z + x2.w * x2.w) + (x3.x * x3.x + x3.y * x3.y) + (x3.z * x3.z + x3.w * x3.w);
    const float rstd2 = 1.0f / sqrtf(wave_sum(ss) * (1.f / DMODEL) + RMS_EPS);
    const GAS f32x4* gp = (const GAS f32x4*)(fg + 8 * lane);
    xp[0] = x0 * rstd2 * gp[0]; xp[1] = x1 * rstd2 * gp[1]; xp[128] = x2 * rstd2 * gp[128]; xp[129] = x3 * rstd2 * gp[129];
}
#ifndef REP_0
#define REP_0 1
#endif
#ifndef REP_1
#define REP_1 1
#endif
#ifndef REP_2
#define REP_2 1
#endif
#ifndef REP_3
#define REP_3 1
#endif
#ifndef REP_4
#define REP_4 1
#endif
#ifndef REP_5
#define REP_5 1
#endif
#ifndef REP_6
#define REP_6 1
#endif
#ifndef REP_7
#define REP_7 1
#endif
#ifndef REP_8
#define REP_8 1
#endif
#ifndef REP_9
#define REP_9 1
#endif
#ifndef REP_10
#define REP_10 1
#endif
#ifndef REP_11
#define REP_11 1
#endif
__device__ __forceinline__ void pb_rows(v4u* Ra, v2u* Rb, const v4u w, const unsigned char* vbase, size_t vboff) {
    const unsigned pw[4] = {w.x, w.y, w.z, w.w};
#pragma unroll
    for (int i = 0; i < 4; ++i) { const size_t e = pw[i] & 0xffffu; Ra[i] = *(const GAS v4u*)(vbase + e * 256); Rb[i] = *(const GAS v2u*)(vbase + vboff + e * 128); }
}
__device__ __forceinline__ void pb_fma(h2_t (&acc)[16], const v4u* Ra, const v2u* Rb, const v4u w) {
    const unsigned pw[4] = {w.x, w.y, w.z, w.w};
#pragma unroll
    for (int i = 0; i < 4; ++i) { const unsigned p = pw[i], wb = (p & 0xffff0000u) | (p >> 16); const h2_t w2 = __builtin_bit_cast(h2_t, wb);
        const v4u ra = Ra[i]; const v2u rb = Rb[i]; const v6u_t x6 = {ra.x, ra.y, ra.z, ra.w, rb.x, rb.y};
        v32h_t h; asm("v_cvt_scalef32_pk32_f16_fp6 %0, %1, 1.0" : "=&v"(h) : "v"(x6));
#pragma unroll
        for (int j = 0; j < 16; ++j) { const h2_t hv = {h[2 * j], h[2 * j + 1]}; acc[j] = __builtin_elementwise_fma(hv, w2, acc[j]); } }
}
__device__ __forceinline__ void peer_b_phase(int lane, int wave, int G, int vcu, const unsigned char* V6s, const unsigned* wpk, unsigned short* Y16, float* X1, const float* fg, bool fin) {
    const int q = lane & 15;
    for (int tile0 = vcu; tile0 < MTOK / 32; tile0 += 2 * G) {
        const int tile1 = tile0 + G; const bool has1 = tile1 < MTOK / 32;
        const int tb = tile0 * 32 + wave * 4, nwg = (has1 ? tile1 : tile0) * 32 + wave * 4;
        for (int pass = 0; pass < 4; ++pass) { const int hc = pass >> 1, k = (lane >> 4) + 4 * (pass & 1);
            const int t = pa_tok((unsigned)k, tb, nwg);
            const unsigned* wrow = wpk + (size_t)t * 128;
            const unsigned char* vbase = V6s + (size_t)hc * NEXP * 256 + q * 16;
            const size_t vboff = V6B_OFF + (size_t)hc * NEXP * 128 + q * 8 - ((size_t)hc * NEXP * 256 + q * 16);
            h2_t acc[16];
#pragma unroll
            for (int j = 0; j < 16; ++j) acc[j] = (h2_t){(_Float16)0.f, (_Float16)0.f};
            v4u W[6], Ra[16]; v2u Rb[16];
#pragma unroll
            for (int u = 0; u < 6; ++u) W[u] = *(const GAS v4u*)(wrow + 4 * u);
#pragma unroll
            for (int u = 0; u < 4; ++u) pb_rows(Ra + 4 * u, Rb + 4 * u, W[u], vbase, vboff);
#pragma unroll
            for (int u = 0; u < 32; ++u) {
                pb_fma(acc, Ra + 4 * (u & 3), Rb + 4 * (u & 3), W[u % 6]);
                if (u + 4 < 32) pb_rows(Ra + 4 * (u & 3), Rb + 4 * (u & 3), W[(u + 4) % 6], vbase, vboff);
                if (u + 6 < 32) W[u % 6] = *(const GAS v4u*)(wrow + 4 * (u + 6));
            }
            GAS v4u* yout = (GAS v4u*)(Y16 + (size_t)t * 1024 + hc * 512 + q * 32);
#pragma unroll
            for (int j = 0; j < 4; ++j) yout[j] = (v4u){__builtin_bit_cast(unsigned, acc[4 * j]), __builtin_bit_cast(unsigned, acc[4 * j + 1]), __builtin_bit_cast(unsigned, acc[4 * j + 2]), __builtin_bit_cast(unsigned, acc[4 * j + 3])};
        }
        asm volatile("s_waitcnt vmcnt(0)" ::: "memory");
        if (fin) for (int kk = 0; kk < (has1 ? 8 : 4); ++kk) final_token(pa_tok((unsigned)kk, tb, nwg), lane, Y16, X1, fg);
    }
}
template <int NR> __device__ __forceinline__ void cvt_load(f32x4 (&q)[NR / 2][8], const float* table, int ex, int stride, int lane) {
#pragma unroll
    for (int k = 0; k < NR / 2; ++k) { const int e = ex + (2 * k + (lane >> 5)) * stride; const float* src = table + (size_t)(e < NEXP ? e : ex) * 1024 + 32 * (lane & 31);
#pragma unroll
        for (int j = 0; j < 8; ++j) q[k][j] = *(const GAS f32x4*)(src + 4 * j); }
}
template <int NR> __device__ __forceinline__ void cvt_store(const f32x4 (&q)[NR / 2][8], int ex, int stride, bool isv, int lane, unsigned char* U8, unsigned char* V8) {
    typedef float v16f_t __attribute__((ext_vector_type(16)));
#pragma unroll
    for (int k = 0; k < NR / 2; ++k) { const int e = ex + (2 * k + (lane >> 5)) * stride; if (e < NEXP) {
        if (!isv) {
            float f[32];
#pragma unroll
            for (int j = 0; j < 8; ++j) { const f32x4 t = q[k][j] * U8_SCALE; f[4 * j] = t.x; f[4 * j + 1] = t.y; f[4 * j + 2] = t.z; f[4 * j + 3] = t.w; }
            const v16f_t lo16 = {f[0], f[1], f[2], f[3], f[4], f[5], f[6], f[7], f[8], f[9], f[10], f[11], f[12], f[13], f[14], f[15]},
                         hi16 = {f[16], f[17], f[18], f[19], f[20], f[21], f[22], f[23], f[24], f[25], f[26], f[27], f[28], f[29], f[30], f[31]};
            v6u_t p6; asm volatile("s_nop 1\n\tv_cvt_scalef32_2xpk16_fp6_f32 %0, %1, %2, 1.0" : "=&v"(p6) : "v"(lo16), "v"(hi16));
            GAS v2u* dst = (GAS v2u*)(U8 + (size_t)e * 768 + 24 * (lane & 31)); dst[0] = (v2u){p6[0], p6[1]}; dst[1] = (v2u){p6[2], p6[3]}; dst[2] = (v2u){p6[4], p6[5]};
        } else {
            v32h_t h;
#pragma unroll
            for (int j = 0; j < 8; ++j) { const f32x4 t = q[k][j] * V8_SCALE; h[4 * j] = (_Float16)t.x; h[4 * j + 1] = (_Float16)t.y; h[4 * j + 2] = (_Float16)t.z; h[4 * j + 3] = (_Float16)t.w; }
            v6u_t p6; asm volatile("s_nop 1\n\tv_cvt_scalef32_pk32_fp6_f16 %0, %1, 1.0" : "=&v"(p6) : "v"(h));
            const size_t ro = (size_t)((lane & 31) >> 4) * NEXP + e;
            *(GAS v4u*)(V8 + ro * 256 + (lane & 15) * 16) = (v4u){p6[0], p6[1], p6[2], p6[3]}; *(GAS v2u*)(V8 + V6B_OFF + ro * 128 + (lane & 15) * 8) = (v2u){p6[4], p6[5]}; } } }
}
struct OnePanel { int pm, n; __device__ __forceinline__ bool next(int i, pg8::Unit& u) const { if (i >= n) return false; u.pm = pm; u.pn = i; u.w = 0; return true; } };
struct DualOrder { pg8::StaticOrder S; __device__ __forceinline__ bool next(int i, pg8::Unit& u) const { if (!S.next(i >> 1, u)) return false; u.w = i & 1; return true; } };
struct Args { const float* in[24]; float* out; unsigned char* ws; int ph_lo, ph_hi, li, pad; };
__global__ void __launch_bounds__(NWAVES * 64, 2) mk_fwd(Args args) {
    extern __shared__ __attribute__((aligned(16))) unsigned char lds[];
    Frame F;
    F.lds = (LAS unsigned char*)lds;
    volatile LAS unsigned* MISC = (volatile LAS unsigned*)(F.lds + MISC_OFF);
    F.tid = threadIdx.x; F.lane = F.tid & 63; F.wave = __builtin_amdgcn_readfirstlane(F.tid >> 6);
    F.G = gridDim.x; { const int bx = blockIdx.x; F.vcu = (F.G % 8 == 0) ? (bx % 8) * (F.G / 8) + bx / 8 : bx; }
    unsigned char* ws = args.ws;
    gu32* ctl = (gu32*)(ws + WS_CTL);
    for (int u = F.tid; u < (LDS_BYTES - LDSCTL_OFF) / 4; u += NWAVES * 64) ((LAS unsigned*)(F.lds + LDSCTL_OFF))[u] = 0u;
    __syncthreads();
    XcdBarrier bar; bar.bar = (unsigned*)(ctl + CW_BAR); bar.x = 0; bar.st = nullptr;
    if (N_LAUNCHES != PER_PHASE) bar = xcd_barrier_post((unsigned*)(ctl + CW_BAR), MISC + 8);
#define GRID_BAR() do { if (N_LAUNCHES != PER_PHASE) xcd_barrier(bar); } while (0)
    const int lo = args.ph_lo, hi = args.ph_hi;
#ifndef PH_MASK
#define PH_MASK 0xFFFF
#endif
#define IN(k) ((((PH_MASK) >> (k)) & 1) && lo <= (k) && (k) < hi)
#define BOTH(k) (IN(k) && IN((k) + 1))
    const int gw = F.vcu * NWAVES + F.wave, NGW = F.G * NWAVES;
    const int gtid = F.vcu * (NWAVES * 64) + F.tid, NTHR = F.G * NWAVES * 64;
    const float* x = args.in[0];
    bf16* Win_t = (bf16*)(ws + WS_WIN); bf16* Wq_t = (bf16*)(ws + WS_WQ); bf16* Wout_t = (bf16*)(ws + WS_WOUT); bf16* Wus_t = (bf16*)(ws + WS_WUS); bf16* Wua_t = (bf16*)(ws + WS_WUA);
    bf16* Wglu_t = (bf16*)(ws + WS_WGLU); bf16* KSb = (bf16*)(ws + WS_KS); bf16* WE = (bf16*)(ws + WS_WE); bf16* BP = (bf16*)(ws + WS_BP); bf16* AP = (bf16*)(ws + WS_AP);
    float* Eb = (float*)(ws + WS_E); bf16* Hb = (bf16*)(ws + WS_H); bf16* Ypre = (bf16*)(ws + WS_YPRE); bf16* Ya = (bf16*)(ws + WS_YA); bf16* XG = (bf16*)(ws + WS_XG);
    bf16* Zb = (bf16*)(ws + WS_Z); bf16* Qb = (bf16*)(ws + WS_Z + 1 * ZSTRIDE_B); bf16* Kb = (bf16*)(ws + WS_Z + 2 * ZSTRIDE_B); bf16* Vb = (bf16*)(ws + WS_Z + 3 * ZSTRIDE_B);
    bf16* GA = (bf16*)(ws + WS_Z + 4 * ZSTRIDE_B); bf16* GB = (bf16*)(ws + WS_Z + 6 * ZSTRIDE_B);
    bf16* Yb = (bf16*)(ws + WS_YB); bf16* Mrg = (bf16*)(ws + WS_MRG); bf16* PQb = (bf16*)(ws + WS_PQ); int* ids = (int*)(ws + WS_IDS); float* gts = (float*)(ws + WS_GTS);
    unsigned char* U8 = ws + WS_U16; unsigned char* V8 = ws + WS_V16; unsigned* wpk = (unsigned*)(ws + WS_WPK); float* rstd1 = (float*)(ws + WS_RSTD1); unsigned short* Y16 = (unsigned short*)(ws + WS_Y16);
    float* biasT = (float*)(ws + WS_BIAS); float* pw32 = (float*)(ws + WS_PW32); float* kpart = (float*)(ws + WS_KPART); float* Kg = (float*)(ws + WS_KG); float* ssq1 = (float*)(ws + WS_SSQ1);

    if (IN(0)) for (int rep_ = 0; rep_ < REP_0; ++rep_) {
        LAS float* scr = (LAS float*)(F.lds + RING_OFF + F.wave * 16384);
        constexpr int I_IN = (1024 / 64) * (4096 / 32), I_GLU = (512 / 64) * (512 / 32), I_UP = (512 / 64) * (1024 / 32), I_OUT = (1024 / 64) * (1024 / 32), I_Q = (1024 / 64) * (2048 / 32);
        constexpr int NITEMS = I_IN + I_GLU + 2 * I_UP + I_OUT + I_Q;
        for (int it = gw; it < NITEMS; it += NGW) {
            int r = it;
            if (r < I_IN) { p0_transpose_item(args.in[2], 1024, 4096, Win_t, scr, r, F.lane); continue; } r -= I_IN;
            if (r < I_GLU) { p0_transpose_item(args.in[11], 512, 512, Wglu_t, scr, r, F.lane); continue; } r -= I_GLU;
            if (r < I_UP) { p0_transpose_item(args.in[13], 512, 1024, Wus_t, scr, r, F.lane); continue; } r -= I_UP;
            if (r < I_UP) { p0_transpose_item(args.in[14], 512, 1024, Wua_t, scr, r, F.lane); continue; } r -= I_UP;
            if (r < I_OUT) { p0_transpose_item(args.in[16], 1024, 1024, Wout_t, scr, r, F.lane); continue; } r -= I_OUT;
            p0_transpose_item(args.in[18], 1024, 2048, Wq_t, scr, r, F.lane);
        }
        for (int it = gw; it < NGRP * CH; it += NGW)
            ssm_table_task(it >> 5, it & 31, F.lane, scr, args.in[3], args.in[4], args.in[5], args.in[6], args.in[7], args.in[8], args.in[9], Kg, WE, BP, pw32);
        for (int m = gw; m < MTOK; m += NGW * 4) rms_rows4_to_bf16(x, args.in[1], Hb, m, NGW, F.lane);
        for (int it = gw; it < 64; it += NGW) { const float* src = (it < 32 ? args.in[19] : args.in[20]) + (size_t)(it & 31) * 512 + 8 * F.lane;
            const f32x4 a = *(const GAS f32x4*)src, b = *(const GAS f32x4*)(src + 4);
            *(GAS v4u*)(KSb + (size_t)it * 512 + 8 * F.lane) = (v4u){pk2(a.x, a.y), pk2(a.z, a.w), pk2(b.x, b.y), pk2(b.z, b.w)}; }
        if (gw == 0) { for (int i = F.lane; i < 8 * 128; i += 64) { const int h = i >> 7, rel = i & 127; int bk;
                if (rel < 16) bk = rel; else { const float lg = logf((float)rel / 16.0f) / 2.0794415416798357f * 16.0f; bk = 16 + (int)lg; bk = bk < 0 ? 0 : (bk > 31 ? 31 : bk); }
                biasT[i] = (args.in[15][bk * 8 + h] - args.in[15][31 * 8 + h]) * 1.4426950408889634f; } }
        if (BOTH(0)) GRID_BAR();
    }

    if (IN(1)) for (int rep_ = 0; rep_ < REP_1; ++rep_) {
        const float* Dsk = args.in[10];
        for (int i0 = gtid; i0 < NGRP * 512 * 64; i0 += NTHR * 4) {
            f32x4 ka[4], kb[4];
#pragma unroll
            for (int q = 0; q < 4; ++q) { const int i = i0 + q * NTHR; const int ic = (i < NGRP * 512 * 64) ? i : i0; const int g = ic >> 15, m = (ic >> 6) & 511, k8 = ic & 63, j = m >> 4, ho = m & 15, jp = k8 >> 1, hi0 = (k8 & 1) * 8;
                const int lag = (jp <= j) ? j - jp : 0; const float* kp = Kg + ((size_t)(g * 32 + lag) * 256 + ho * 16 + hi0); ka[q] = *(const GAS f32x4*)kp; kb[q] = *(const GAS f32x4*)(kp + 4); }
#pragma unroll
            for (int q = 0; q < 4; ++q) { const int i = i0 + q * NTHR; if (i >= NGRP * 512 * 64) break; const int g = i >> 15, m = (i >> 6) & 511, k8 = i & 63, j = m >> 4, ho = m & 15, jp = k8 >> 1, hi0 = (k8 & 1) * 8;
                v4u o = (v4u){0u, 0u, 0u, 0u};
                if (jp <= j) { f32x4 a = ka[q], b = kb[q];
                    if (jp == j && (ho >> 3) == (hi0 >> 3)) { const float dv = Dsk[g * 16 + ho]; const int e = ho & 7;
                        a.x += (e == 0) ? dv : 0.f; a.y += (e == 1) ? dv : 0.f; a.z += (e == 2) ? dv : 0.f; a.w += (e == 3) ? dv : 0.f;
                        b.x += (e == 4) ? dv : 0.f; b.y += (e == 5) ? dv : 0.f; b.z += (e == 6) ? dv : 0.f; b.w += (e == 7) ? dv : 0.f; }
                    o = (v4u){pk2(a.x, a.y), pk2(a.z, a.w), pk2(b.x, b.y), pk2(b.z, b.w)}; }
                *(GAS v4u*)(BP + ((size_t)(g * 512 + m) * APK + k8 * 8)) = o; } }
        pg8::Gemm g{Hb, Win_t, MTOK, INCOLS, 1024, 1024, 1024, 1 << 30, 0};
        pg8::StaticOrder S; S.init(MTOK, INCOLS, F.G, (int)blockIdx.x);
        pg8::EpiIn E{Zb, AP, kpart};
        pg8::gemm_phase<pg8::EpiIn, pg8::StaticOrder, true>(F.lds + RING_OFF, g, S, E);
        if (BOTH(1)) GRID_BAR();
    }

    if (IN(2)) for (int rep_ = 0; rep_ < REP_2; ++rep_) {
        const int bx = (int)blockIdx.x;
        const bool shared = F.G < 4;
        const int nS = shared ? F.G : (F.G >= 256 ? 64 : F.G / 4), nA = shared ? F.G : F.G - nS;
        const bool inS = shared || bx < nS, inA = shared || bx >= nS; const int aidx = shared ? bx : bx - nS;
        if (inS) {
#pragma unroll 1
            for (int pm = bx; pm < MTOK / 256; pm += nS) {
                { pg8::Gemm g1{AP, WE, MTOK, 256, 512, APK, 512, 2, (size_t)256 * 512}; OnePanel S1{pm, 1}; pg8::EpiE E1{Eb};
                  pg8::gemm_phase<pg8::EpiE, OnePanel, true>(F.lds + RING_OFF, g1, S1, E1); }
                VM_WAIT(); __syncthreads();
                if (F.tid < 256) { const int gb = (pm >> 1) * 8 + (pm & 1) * 4 + (F.tid >> 6), g_ = gb >> 3, p = F.tid & 63; const size_t row0 = (size_t)gb * 64;
                    const float mr = pw32[g_ * 128 + p], mi = pw32[g_ * 128 + 64 + p]; float sr = 0.f, si = 0.f;
#pragma unroll 1
                    for (int c0 = 0; c0 < NCHUNK; c0 += 32) { float er[32], ei[32];
#pragma unroll
                        for (int c = 0; c < 32; ++c) { er[c] = Eb[(row0 + c0 + c) * 128 + p]; ei[c] = Eb[(row0 + c0 + c) * 128 + 64 + p]; }
#pragma unroll
                        for (int c = 0; c < 32; ++c) { bf16* ap = AP + (row0 + c0 + c) * APK + 512; ap[p] = (bf16)f2bf(sr); ap[64 + p] = (bf16)f2bf(si);
                            const float nr = mr * sr - mi * si + er[c], ni = mr * si + mi * sr + ei[c]; sr = nr; si = ni; } } }
                VM_WAIT(); __syncthreads();
                { pg8::Gemm g{AP, BP, MTOK, 512, APK, APK, APK, 2, (size_t)512 * APK}; OnePanel S3{pm, 2}; pg8::EpiY E{Ypre};
                  pg8::gemm_phase<pg8::EpiY, OnePanel, true>(F.lds + RING_OFF, g, S3, E); }
            }
        }
        if (inA) {
            static_assert(attn_body::ATTN_LDS_BYTES <= RING_BYTES, "attention LDS");
#pragma unroll 1
            for (int a = aidx; a < 192; a += nA) { const int ty = a >> 6, bh = a & 63;
#pragma unroll 1
                for (int i = 0; i < 4; ++i) { const int qb = (ty == 0) ? (i == 0 ? 7 : (i == 1 ? 2 : (i == 2 ? 0 : -1))) : (ty == 1) ? (i == 0 ? 6 : (i == 1 ? 4 : -1)) : (i == 0 ? 5 : (i == 1 ? 3 : (i == 2 ? 1 : -1)));
                    if (qb < 0) break;
                    attn_body::attn_unit<8>(bh >> 3, bh & 7, qb, (const attn_body::bf16*)Qb, (const attn_body::bf16*)Kb, (const attn_body::bf16*)Vb, (attn_body::bf16*)Yb, (char*)lds + RING_OFF, kpart, biasT); } }
        }
        if (BOTH(2)) GRID_BAR();
    }

    if (IN(3)) for (int rep_ = 0; rep_ < REP_3; ++rep_) {
        pg8::Gemm g{Ypre, Wglu_t, MTOK, 512, 512, 512, 512, 1 << 30, 0};
        pg8::StaticOrder S; S.init(MTOK, 512, F.G, (int)blockIdx.x);
        pg8::EpiGlu E{Ypre, Ya, args.in[12]};
        pg8::gemm_phase<pg8::EpiGlu, pg8::StaticOrder, true>(F.lds + RING_OFF, g, S, E);
        { const int nun = (MTOK / 256) * (512 / 256);
          const bool split = F.G >= 2 * nun; const int nconv = split ? nun : F.G, cidx = split ? ((int)blockIdx.x % nun) : (int)blockIdx.x;
          const int stride = nconv * NWAVES, step = stride * 4, ex0 = cidx * NWAVES + F.wave;
          const int ncall = (NEXP - ex0 + step - 1) / step;
          int c_lo = 0, c_hi = 2 * ncall;
          if (split) { const int cut = (2 * ncall * 3) / 4; if ((int)blockIdx.x < nun) c_lo = cut; else if ((int)blockIdx.x < 2 * nun) c_hi = cut; else c_hi = 0; }
          f32x4 qa[2][8], qb[2][8];
#define CV_TAB(c) ((c) < ncall ? args.in[21] : args.in[22])
#define CV_EX(c) (ex0 + ((c) < ncall ? (c) : (c) - ncall) * step)
          if (c_lo < c_hi) cvt_load<4>(qa, CV_TAB(c_lo), CV_EX(c_lo), stride, F.lane);
          for (int c = c_lo; c < c_hi; c += 2) {
              if (c + 1 < c_hi) cvt_load<4>(qb, CV_TAB(c + 1), CV_EX(c + 1), stride, F.lane);
              cvt_store<4>(qa, CV_EX(c), stride, c >= ncall, F.lane, U8, V8);
              if (c + 2 < c_hi) cvt_load<4>(qa, CV_TAB(c + 2), CV_EX(c + 2), stride, F.lane);
              if (c + 1 < c_hi) cvt_store<4>(qb, CV_EX(c + 1), stride, c + 1 >= ncall, F.lane, U8, V8);
          } }
#undef CV_TAB
#undef CV_EX
        if (BOTH(3)) GRID_BAR();
    }

    if (IN(4)) for (int rep_ = 0; rep_ < REP_4; ++rep_) {
        pg8::Gemm g{Ya, Wus_t, MTOK, 1024, 512, 512, 512, 1 << 30, 0, Yb, Wua_t};
        DualOrder S; S.S.init(MTOK, 1024, F.G, (int)blockIdx.x);
        pg8::EpiMrgDual E{pg8::EpiMrg<0>{GA, Mrg}, pg8::EpiMrg<1>{GB, Mrg}};
        pg8::gemm_phase<pg8::EpiMrgDual, DualOrder, true>(F.lds + RING_OFF, g, S, E);
        if (BOTH(4)) GRID_BAR();
    }

    if (IN(5)) for (int rep_ = 0; rep_ < REP_5; ++rep_) {
        pg8::Gemm g{Mrg, Wout_t, MTOK, 1024, 1024, 1024, 1024, 1 << 30, 0}; pg8::StaticOrder S; S.init(MTOK, 1024, F.G, (int)blockIdx.x);
        pg8::EpiX1 E{x, args.out, XG, args.in[17], ssq1};
        pg8::gemm_phase<pg8::EpiX1, pg8::StaticOrder, true>(F.lds + RING_OFF, g, S, E);
        if (BOTH(5)) GRID_BAR();
    }

    if (IN(6)) for (int rep_ = 0; rep_ < REP_6; ++rep_) {
        pg8::Gemm g{XG, Wq_t, MTOK, PQ, 1024, 1024, 1024, 1 << 30, 0}; pg8::StaticOrder S; S.init(MTOK, PQ, F.G, (int)blockIdx.x);
        pg8::EpiPlain E{PQb, PQ};
        pg8::gemm_phase<pg8::EpiPlain, pg8::StaticOrder, true>(F.lds + RING_OFF, g, S, E);
        if (BOTH(6)) GRID_BAR();
    }

    if (IN(7)) for (int rep_ = 0; rep_ < REP_7; ++rep_) {
        LAS unsigned char* scr = F.lds + RING_OFF + F.wave * 2048;
        LAS unsigned char* ksl = F.lds + RING_OFF + 16384;
        for (int c = F.tid; c < 256 * 16; c += NWAVES * 64) { const int row = c >> 4, ch = c & 15; *(LAS v4u*)(ksl + row * 256 + ((ch ^ (row & 15)) << 4)) = *(const GAS v4u*)(KSb + row * 128 + ch * 8); }
        __syncthreads();
        for (int it = gw; it < (MTOK / 32) * 8; it += NGW) topk_task(it >> 3, it & 7, F.lane, scr, PQb, ksl, ssq1, ids, gts, rstd1);
        if (BOTH(7)) { VM_WAIT(); __syncthreads(); }
    }

    if (IN(8)) for (int rep_ = 0; rep_ < REP_8; ++rep_) {
        peer_a_phase(F.lane, F.wave, F.G, F.vcu, XG, U8, ids, gts, rstd1, wpk, F.lds, 0xffff);
        if (BOTH(8)) VM_WAIT();
    }
    if (IN(9)) for (int rep_ = 0; rep_ < REP_9; ++rep_) {
        peer_b_phase(F.lane, F.wave, F.G, F.vcu, V8, wpk, Y16, args.out, args.in[23], rep_ == REP_9 - 1);
    }
#undef IN
#undef BOTH
#undef GRID_BAR
}

extern "C" void kernel_launch(void* const* d_in, const int* in_sizes, int n_in, void* d_out, int out_size, void* d_ws, size_t ws_size, hipStream_t stream) {
    static int grid = 0;
    if (grid == 0) {
        if (n_in != 24 || in_sizes[0] != MTOK * DMODEL || out_size != MTOK * DMODEL || ws_size < WS_END) { fprintf(stderr, "kernel_launch: unexpected shapes (n_in %d, in0 %d, out %d, ws %zu); nothing launched\n", n_in, n_in > 0 ? in_sizes[0] : -1, out_size, ws_size); grid = -1; return; }
        int dev = 0, cus = 0, per_cu = 0;
        if (hipGetDevice(&dev) != hipSuccess || hipDeviceGetAttribute(&cus, hipDeviceAttributeMultiprocessorCount, dev) != hipSuccess) { grid = -1; return; }
        if (hipFuncSetAttribute((const void*)mk_fwd, hipFuncAttributeMaxDynamicSharedMemorySize, LDS_BYTES) != hipSuccess) { fprintf(stderr, "kernel_launch: hipFuncSetAttribute failed\n"); grid = -1; return; }
        if (hipOccupancyMaxActiveBlocksPerMultiprocessor(&per_cu, (const void*)mk_fwd, NWAVES * 64, LDS_BYTES) != hipSuccess || per_cu < 1) { fprintf(stderr, "kernel_launch: occupancy query says %d blocks per CU\n", per_cu); }
        (void)hipGetLastError();
        grid = cus;
    }
    if (grid < 0) return;
    if (N_LAUNCHES != PER_PHASE) { if (hipMemsetAsync((char*)d_ws + WS_CTL, 0, CTL_ZERO_BYTES, stream) != hipSuccess) return; }
    Args a{};
    for (int i = 0; i < 24; ++i) a.in[i] = (const float*)d_in[i];
    a.out = (float*)d_out; a.ws = (unsigned char*)d_ws; a.pad = 0;
    if (N_LAUNCHES == PER_PHASE) {
        for (int li = 0; li < PER_PHASE; ++li) { a.ph_lo = li; a.ph_hi = li + 1; a.li = li; hipLaunchKernelGGL(mk_fwd, dim3(grid), dim3(NWAVES * 64), LDS_BYTES, stream, a); }
    } else {
        a.ph_lo = 0; a.ph_hi = PER_PHASE; a.li = 0;
        hipLaunchKernelGGL(mk_fwd, dim3(grid), dim3(NWAVES * 64), LDS_BYTES, stream, a);
    }
}
```

```cpp
#include <hip/hip_runtime.h>
#include <hip/hip_bf16.h>
#include <cstdio>
#include <cstdint>
#include <cmath>

#ifndef MK_N_LAUNCHES
#define MK_N_LAUNCHES 1
#endif

namespace pg8 {
#define PG8_LAS __attribute__((address_space(3)))
typedef unsigned short bf16_t;
typedef short bf16x8 __attribute__((ext_vector_type(8)));
typedef float f32x4 __attribute__((ext_vector_type(4)));
typedef unsigned u32x4 __attribute__((ext_vector_type(4)));
constexpr int BM = 256, BK = 64, HALF = 128, HTB = HALF * BK * 2, STAGE_BYTES = 8 * HTB, NXCD = 8, WGM = 8;

__host__ __device__ __forceinline__ int lds_byte(int r, int c) { const int st = (r >> 4) * 2 + (c >> 5), rr = r & 15, cc = c & 31, ob = rr * 64 + cc * 2; return st * 1024 + (ob ^ (((ob >> 9) & 1) << 5)); }
__host__ __device__ __forceinline__ void stage_rc(int b, int& R, int& C) { const int st = b / 1024, sb = b % 1024, swz = sb ^ (((sb >> 9) & 1) << 5); R = (st >> 1) * 16 + swz / 64; C = (st & 1) * 32 + (swz % 64) / 2; }
__host__ __device__ __forceinline__ int perm32(int rho) { const int n = rho >> 4, i = rho & 15; return 8 * (i >> 2) + 4 * n + (i & 3); }

struct Unit { int pm, pn, w; };
struct Gemm { const bf16_t* A; const bf16_t* Bt; int M, N, K, lda, ldb, rpg; size_t bgs; const bf16_t* A2 = nullptr; const bf16_t* Bt2 = nullptr; };

struct StaticOrder {
    int nM, nN, nwg, G, c;
    __host__ __device__ __forceinline__ void init(int M, int N, int G_, int c_) { nM = M / BM; nN = N / BM; nwg = nM * nN; G = G_; c = c_; }
    __host__ __device__ __forceinline__ bool next(int i, Unit& u) const {
        const long L = (long)i * G + c; if (L >= nwg) return false;
        int wgid = (int)L; { const int q = nwg / NXCD, r = nwg % NXCD, xcd = wgid % NXCD, off = wgid / NXCD; wgid = (xcd < r ? xcd * (q + 1) : r * (q + 1) + (xcd - r) * q) + off; }
        const int nig = WGM * nN, gid = wgid / nig, fm = gid * WGM, gsz = (nM - fm) < WGM ? (nM - fm) : WGM;
        u.pm = fm + ((wgid % nig) % gsz); u.pn = (wgid % nig) / gsz; u.w = 0; return true;
    }
};

__device__ __forceinline__ unsigned cvt_pk_bf16(float lo, float hi) { unsigned r; asm volatile("v_cvt_pk_bf16_f32 %0, %1, %2" : "=v"(r) : "v"(lo), "v"(hi)); return r; }
__device__ __forceinline__ float bf_lo(unsigned w) { return __uint_as_float(w << 16); }
__device__ __forceinline__ float bf_hi(unsigned w) { return __uint_as_float(w & 0xffff0000u); }
__device__ __forceinline__ float sigmoid_f(float x) { return __builtin_amdgcn_rcpf(1.0f + __builtin_amdgcn_exp2f(-1.4426950409f * x)); }
__device__ __forceinline__ float gelu_tanh(float x) { const float u = x + 0.044715f * x * x * x; return x * __builtin_amdgcn_rcpf(1.0f + __builtin_amdgcn_exp2f(-2.3022081985f * u)); }

template <class Epi, class Sched, bool ALIGN_EPI>
__device__ __forceinline__ void gemm_phase(PG8_LAS unsigned char* lds, const Gemm g, const Sched& S, const Epi& E) {
    int tid = threadIdx.x; asm volatile("" : "+v"(tid));
    const int wid = __builtin_amdgcn_readfirstlane(tid >> 6), lane = tid & 63, wr = wid >> 2, wc = wid & 3, fr = lane & 15, fq = lane >> 4;
    const int K = g.K, nt = K / BK;
    unsigned voffA[2], voffB[2];
#pragma unroll
    for (int i = 0; i < 2; ++i) { int R, C; stage_rc(tid * 16 + i * 8192, R, C); const int Rb = Epi::PERM ? ((R & ~31) + perm32(R & 31)) : R;
        voffA[i] = (unsigned)(R * g.lda + C) * 2u; voffB[i] = (unsigned)(Rb * g.ldb + C) * 2u; }
    const size_t kstep = (size_t)(BK * 2);
    const size_t hstepA = (size_t)HALF * g.lda * 2, hstepB = (size_t)HALF * g.ldb * 2;
    const size_t tstepA = 2 * hstepA, tstepB = 2 * hstepB;
    const unsigned ldsw = (unsigned)wid * 1024u;
    const int aoff = lds_byte(wr * 64 + fr, fq * 8), boff = lds_byte(wc * 32 + fr, fq * 8);
#define PG8_SA(b, h) (((b) * 2 + (h)) * HTB)
#define PG8_SB(b, h) ((4 + (b) * 2 + (h)) * HTB)
#define PG8_STAGE(bufoff, gbase, voff) do { _Pragma("unroll") for (int _i = 0; _i < 2; ++_i) \
        __builtin_amdgcn_global_load_lds((const unsigned*)((const char*)(gbase) + (voff)[_i]), (PG8_LAS unsigned*)(lds + (bufoff) + ldsw + _i * 8192), 16, 0, 0); } while (0)
#define PG8_LDA(dst, b, h) do { _Pragma("unroll") for (int m = 0; m < 4; ++m) _Pragma("unroll") for (int k = 0; k < 2; ++k) dst[m][k] = *(const PG8_LAS bf16x8*)(lds + PG8_SA(b, h) + aoff + m * 2048 + k * 1024); } while (0)
#define PG8_LDB(dst, b, h) do { _Pragma("unroll") for (int n = 0; n < 2; ++n) _Pragma("unroll") for (int k = 0; k < 2; ++k) dst[n][k] = *(const PG8_LAS bf16x8*)(lds + PG8_SB(b, h) + boff + n * 2048 + k * 1024); } while (0)
#define PG8_MMA(ai, bj, At, Bt) do { __builtin_amdgcn_s_setprio(1); _Pragma("unroll") for (int m = 0; m < 4; ++m) _Pragma("unroll") for (int n = 0; n < 2; ++n) _Pragma("unroll") for (int k = 0; k < 2; ++k) \
        acc[ai][bj][m][n] = __builtin_amdgcn_mfma_f32_16x16x32_bf16(Bt[n][k], At[m][k], acc[ai][bj][m][n], 0, 0, 0); __builtin_amdgcn_s_setprio(0); } while (0)
#define PG8_WAIT_V(n) asm volatile("s_waitcnt vmcnt(" #n ")" ::: "memory")
#define PG8_WAIT_L(n) asm volatile("s_waitcnt lgkmcnt(" #n ")" ::: "memory")
#define PG8_BAR __builtin_amdgcn_s_barrier()
#define PG8_SCHED __builtin_amdgcn_sched_barrier(0)
    Unit cur, nxt; int ui = 0;
    if (!S.next(0, cur)) return;
    f32x4 acc[2][2][4][2];
#pragma unroll
    for (int a = 0; a < 2; ++a)
#pragma unroll
        for (int b = 0; b < 2; ++b)
#pragma unroll
            for (int m = 0; m < 4; ++m)
#pragma unroll
                for (int n = 0; n < 2; ++n) acc[a][b][m][n] = (f32x4){0.f, 0.f, 0.f, 0.f};
    bf16x8 At[4][2], B0[2][2], B1[2][2];
    const char* cA = (const char*)(cur.w ? g.A2 : g.A) + (size_t)cur.pm * tstepA;
    const char* cB = (const char*)(cur.w ? g.Bt2 : g.Bt) + (size_t)(cur.pm / g.rpg) * g.bgs * 2 + (size_t)cur.pn * tstepB;
    PG8_STAGE(PG8_SB(0, 0), cB, voffB); PG8_STAGE(PG8_SB(0, 1), cB + hstepB, voffB); PG8_STAGE(PG8_SA(0, 0), cA, voffA); PG8_STAGE(PG8_SA(0, 1), cA + hstepA, voffA);
    if (wr == 1) PG8_BAR;
    PG8_WAIT_V(2); PG8_BAR;
    PG8_STAGE(PG8_SB(1, 0), cB + kstep, voffB); PG8_STAGE(PG8_SA(1, 0), cA + kstep, voffA); PG8_STAGE(PG8_SB(1, 1), cB + hstepB + kstep, voffB);
    PG8_WAIT_V(6); PG8_BAR;
    for (;;) {
        const bool has_next = S.next(ui + 1, nxt);
        const char* nA = has_next ? (const char*)(nxt.w ? g.A2 : g.A) + (size_t)nxt.pm * tstepA : cA;
        const char* nB = has_next ? (const char*)(nxt.w ? g.Bt2 : g.Bt) + (size_t)(nxt.pm / g.rpg) * g.bgs * 2 + (size_t)nxt.pn * tstepB : cB;
        for (int t = 0; t < nt; t += 2) {
            const bool last = (t == nt - 2);
            const char* a1 = cA + (size_t)(t + 1) * kstep;
            const char* a2 = last ? nA : cA + (size_t)(t + 2) * kstep; const char* b2 = last ? nB : cB + (size_t)(t + 2) * kstep;
            const char* a3 = a2 + kstep; const char* b3 = b2 + kstep;
            PG8_LDB(B0, 0, 0); PG8_LDB(B1, 0, 1); PG8_SCHED; PG8_LDA(At, 0, 0); PG8_STAGE(PG8_SA(1, 1), a1 + hstepA, voffA);
            PG8_WAIT_V(8); PG8_WAIT_L(0); PG8_BAR; PG8_MMA(0, 0, At, B0); PG8_MMA(0, 1, At, B1); PG8_BAR; PG8_SCHED;
            PG8_LDA(At, 0, 1); PG8_STAGE(PG8_SB(0, 0), b2, voffB); PG8_STAGE(PG8_SB(0, 1), b2 + hstepB, voffB); PG8_STAGE(PG8_SA(0, 0), a2, voffA);
            PG8_WAIT_V(8); PG8_WAIT_L(0); PG8_BAR; PG8_MMA(1, 0, At, B0); PG8_MMA(1, 1, At, B1); PG8_BAR; PG8_SCHED;
            PG8_LDB(B0, 1, 0); PG8_LDB(B1, 1, 1); PG8_SCHED; PG8_LDA(At, 1, 0); PG8_STAGE(PG8_SA(0, 1), a2 + hstepA, voffA);
            PG8_WAIT_V(8); PG8_WAIT_L(0); PG8_BAR; PG8_MMA(0, 0, At, B0); PG8_MMA(0, 1, At, B1); PG8_BAR; PG8_SCHED;
            PG8_LDA(At, 1, 1); PG8_STAGE(PG8_SB(1, 0), b3, voffB); PG8_STAGE(PG8_SB(1, 1), b3 + hstepB, voffB); PG8_STAGE(PG8_SA(1, 0), a3, voffA);
            PG8_WAIT_V(8); PG8_WAIT_L(0); PG8_BAR; PG8_MMA(1, 0, At, B0); PG8_MMA(1, 1, At, B1); PG8_BAR; PG8_SCHED;
        }
        if constexpr (ALIGN_EPI) { if (wr == 0) PG8_BAR; }
        E(acc, cur, wr, wc, fr, fq);
        if (!has_next) break;
#pragma unroll
        for (int a = 0; a < 2; ++a)
#pragma unroll
            for (int b = 0; b < 2; ++b)
#pragma unroll
                for (int m = 0; m < 4; ++m)
#pragma unroll
                    for (int n = 0; n < 2; ++n) acc[a][b][m][n] = (f32x4){0.f, 0.f, 0.f, 0.f};
        cur = nxt; cA = nA; cB = nB; ++ui;
        if constexpr (ALIGN_EPI) { if (wr == 1) PG8_BAR; }
    }
    PG8_WAIT_V(0);
    if constexpr (!ALIGN_EPI) { if (wr == 0) PG8_BAR; }
    PG8_BAR;
#undef PG8_SA
#undef PG8_SB
#undef PG8_STAGE
#undef PG8_LDA
#undef PG8_LDB
#undef PG8_MMA
#undef PG8_WAIT_V
#undef PG8_WAIT_L
#undef PG8_BAR
#undef PG8_SCHED
}
}
namespace attn_body {
using bf16=__hip_bfloat16;
using bf16x8=__attribute__((ext_vector_type(8)))short;
using s16x4=__attribute__((ext_vector_type(4)))short;
using f32x16=__attribute__((ext_vector_type(16)))float;
using f32x4v=__attribute__((ext_vector_type(4)))float;
using u32x4=__attribute__((ext_vector_type(4)))unsigned;
constexpr int BATCH=8,NHEAD=8,SEQ=2048,D=64,DM=NHEAD*D;
constexpr int NW=8,QBLK=32,QB=QBLK*NW,KVBLK=64,NQB=SEQ/QB;
__device__ __forceinline__ int crow(int r,int hi){return (r&3)+8*(r>>2)+4*hi;}
#define SBAR() __builtin_amdgcn_sched_barrier(0)
__device__ __forceinline__ void cmask(f32x16&p0,f32x16&p1,int jb,int qrel,int hi){
  const float NEG=-INFINITY; int kb=64*jb+4*hi;
  #pragma unroll
  for(int r=0;r<16;++r){int kv=kb+(r&3)+8*(r>>2); if(kv>qrel)p0[r]=NEG; if(kv+32>qrel)p1[r]=NEG;}
}
typedef __attribute__((address_space(3))) const float* lds_cfptr;
__device__ __forceinline__ void biasadd(f32x16&p0,f32x16&p1,int jb,int qrel,int hi,lds_cfptr bt){
  const int base=qrel-64*jb-4*hi;
  #pragma unroll
  for(int r4=0;r4<16;r4+=4){
    #pragma unroll
    for(int r=r4;r<r4+4;++r){int rel=base-((r&3)+8*(r>>2)); int i0=min(max(rel,0),127), i1=min(max(rel-32,0),127); p0[r]+=bt[i0]; p1[r]+=bt[i1];}
    asm volatile("s_waitcnt lgkmcnt(0)":"+v"(p0),"+v"(p1)::"memory"); }
}

constexpr int NSLOT=3, SLOTB=8192;
constexpr int LDS_K=0, LDS_V=NSLOT*SLOTB, LDS_WS=2*NSLOT*SLOTB, LDS_OST=LDS_WS+NW*64*4, LDS_KM=LDS_OST+NW*4096, LDS_BT=LDS_KM+7*64*4, LDS_BYTES=LDS_BT+128*4;
constexpr float C2=0.125f*1.4426950408889634f;
__device__ __forceinline__ void glds16(const void*gsrc,unsigned lds_dst){unsigned keep;
  asm volatile("s_mov_b32 %0, m0\n\ts_mov_b32 m0, %2\n\ts_nop 0\n\tglobal_load_lds_dwordx4 %1, off\n\ts_mov_b32 m0, %0":"=&s"(keep):"v"(gsrc),"s"(lds_dst):"memory");}
__device__ __forceinline__ float max3f(float a,float b,float c){float r;asm("v_max3_f32 %0, %1, %2, %3":"=v"(r):"v"(a),"v"(b),"v"(c));return r;}
__device__ __forceinline__ float max2f(float a,float b){float r;asm("v_max_f32_e32 %0, %1, %2":"=v"(r):"v"(a),"v"(b));return r;}
__device__ __forceinline__ float fadd_s(float a,float b){float r;asm("v_add_f32_e32 %0, %1, %2":"=v"(r):"v"(a),"v"(b));return r;}
__device__ __forceinline__ float fsub_s(float a,float b){float r;asm("v_sub_f32_e32 %0, %1, %2":"=v"(r):"v"(a),"v"(b));return r;}
typedef float f32x2_t __attribute__((ext_vector_type(2))); typedef __bf16 bf16x2_t __attribute__((ext_vector_type(2)));
__device__ __forceinline__ unsigned cvtpk_s(float lo,float hi){f32x2_t v={lo,hi};bf16x2_t b=__builtin_convertvector(v,bf16x2_t);return __builtin_bit_cast(unsigned,b);}
#define WAIT_BAR(N) asm volatile("s_waitcnt vmcnt(" #N ") lgkmcnt(0)\n\ts_barrier":::"memory")

__device__ __forceinline__ void qkt(f32x16&p0,f32x16&p1,const char*Kslot,const bf16x8*qr,int r32,int hi){
  const char*kb=Kslot+hi*1024+r32*16;
  #pragma unroll
  for(int d0=0;d0<4;++d0){
    const bf16x8 b0=*reinterpret_cast<const bf16x8*>(kb+d0*2048);
    const bf16x8 b1=*reinterpret_cast<const bf16x8*>(kb+d0*2048+512);
    if(d0==0){p0=__builtin_amdgcn_mfma_f32_32x32x16_bf16(b0,qr[0],(f32x16){},0,0,0);p1=__builtin_amdgcn_mfma_f32_32x32x16_bf16(b1,qr[0],(f32x16){},0,0,0);}
    else{p0=__builtin_amdgcn_mfma_f32_32x32x16_bf16(b0,qr[d0],p0,0,0,0);p1=__builtin_amdgcn_mfma_f32_32x32x16_bf16(b1,qr[d0],p1,0,0,0);}}
}
typedef __attribute__((address_space(3))) const char* lds_cptr;
typedef short v4i16_t __attribute__((ext_vector_type(4)));
__device__ __forceinline__ void kload8(bf16x8*kf,lds_cptr kp){
  kf[0]=*(const __attribute__((address_space(3))) bf16x8*)(kp);      kf[1]=*(const __attribute__((address_space(3))) bf16x8*)(kp+512);
  kf[2]=*(const __attribute__((address_space(3))) bf16x8*)(kp+2048); kf[3]=*(const __attribute__((address_space(3))) bf16x8*)(kp+2560);
  kf[4]=*(const __attribute__((address_space(3))) bf16x8*)(kp+4096); kf[5]=*(const __attribute__((address_space(3))) bf16x8*)(kp+4608);
  kf[6]=*(const __attribute__((address_space(3))) bf16x8*)(kp+6144); kf[7]=*(const __attribute__((address_space(3))) bf16x8*)(kp+6656);
}
__device__ __forceinline__ void kload2(bf16x8*kf,lds_cptr kp,int j){ kf[2*j]=*(const __attribute__((address_space(3))) bf16x8*)(kp+j*2048); kf[2*j+1]=*(const __attribute__((address_space(3))) bf16x8*)(kp+j*2048+512); }
__device__ __forceinline__ s16x4 vtr(lds_cptr p){ return __builtin_bit_cast(s16x4,__builtin_amdgcn_ds_read_tr16_b64_v4i16((__attribute__((address_space(3))) v4i16_t*)p)); }
__device__ __forceinline__ float rowmax(const f32x16&p0,const f32x16&p1){
  float a=max3f(p0[0],p0[1],p1[0]),b=max3f(p0[2],p0[3],p1[1]);a=max3f(a,p1[2],p1[3]);
  #pragma unroll
  for(int r=4;r<16;r+=4){a=max3f(a,p0[r],p0[r+1]);b=max3f(b,p0[r+2],p0[r+3]);a=max3f(a,p1[r],p1[r+1]);b=max3f(b,p1[r+2],p1[r+3]);}
  const float m=max2f(a,b);
  auto rr=__builtin_amdgcn_permlane32_swap(__float_as_uint(m),__float_as_uint(m),false,false);
  return max2f(__uint_as_float(rr[0]),__uint_as_float(rr[1]));
}
__device__ __forceinline__ void pv(f32x16*o,int vb,bf16x8 pa0,bf16x8 pa1,bf16x8 pa2,bf16x8 pa3){
  #pragma unroll
  for(int d0=0;d0<2;++d0){s16x4 lo[4],hi[4];
    #pragma unroll
    for(int ks=0;ks<4;++ks){
      asm volatile("ds_read_b64_tr_b16 %0,%1 offset:%c2":"=&v"(lo[ks]):"v"(vb),"i"(d0*4096+ks*1024):"memory");
      asm volatile("ds_read_b64_tr_b16 %0,%1 offset:%c2":"=&v"(hi[ks]):"v"(vb),"i"(d0*4096+ks*1024+512):"memory");}
    asm volatile("s_waitcnt lgkmcnt(0)":::"memory");SBAR();
    #define PK(k) (bf16x8){lo[k][0],lo[k][1],lo[k][2],lo[k][3],hi[k][0],hi[k][1],hi[k][2],hi[k][3]}
    o[d0]=__builtin_amdgcn_mfma_f32_32x32x16_bf16(pa0,PK(0),o[d0],0,0,0);
    o[d0]=__builtin_amdgcn_mfma_f32_32x32x16_bf16(pa1,PK(1),o[d0],0,0,0);
    o[d0]=__builtin_amdgcn_mfma_f32_32x32x16_bf16(pa2,PK(2),o[d0],0,0,0);
    o[d0]=__builtin_amdgcn_mfma_f32_32x32x16_bf16(pa3,PK(3),o[d0],0,0,0);
    #undef PK
  }
}

#ifndef ATTN_STORE16
#define ATTN_STORE16(p,v) (*(u32x4*)(p)=(v))
#endif
template<int THRL> __device__ __forceinline__ void attn_unit(int b,int h,int qb,const bf16*Q,const bf16*__restrict__ K,const bf16*__restrict__ V,bf16*O,char*shm,const float*kpart,const float*btab){
  int tid=threadIdx.x; asm volatile("":"+v"(tid));
  const int lane=tid&63,r32=lane&31,hi=lane>>5; const int wid=__builtin_amdgcn_readfirstlane(tid>>6);
  const long rowbase=(long)b*SEQ; const int q0=qb*QB;
  const bf16*Qw=Q+(rowbase+q0+wid*QBLK)*DM+h*D;
  const bf16*Kh=K+rowbase*DM+h*D,*Vh=V+rowbase*DM+h*D;
  const unsigned lds0=(unsigned)(uintptr_t)shm;
  float*wsf=(float*)(shm+LDS_WS)+wid*64;
  const bf16*ksrc=Kh+(long)lane*DM+wid*8;
  const bf16*vsrc=Vh+(long)(16*(wid&3)+(lane>>2))*DM+(wid>>2)*32+(lane&3)*8;
  const unsigned kdst=lds0+LDS_K+wid*1024, vdst=lds0+LDS_V+wid*1024;
  #define DMA_K(t,slot) glds16(ksrc+(long)(t)*KVBLK*DM,(unsigned)__builtin_amdgcn_readfirstlane(kdst+(slot)))
  #define DMA_V(t,slot) glds16(vsrc+(long)(t)*KVBLK*DM,(unsigned)__builtin_amdgcn_readfirstlane(vdst+(slot)))
  const int vb0=(int)(lds0+LDS_V)+((lane>>4)&1)*32+(lane&3)*8+(4*hi+((lane&15)>>2))*64;
  const char*Kbase=shm+LDS_K; bf16x8 kf[8];
  const lds_cptr shm3=(lds_cptr)shm; const lds_cptr kp0=shm3+LDS_K+hi*1024+r32*16; const lds_cptr vp0=shm3+LDS_V+((lane>>4)&1)*32+(lane&3)*8+(4*hi+((lane&15)>>2))*64;
  const lds_cfptr btl=(lds_cfptr)(shm3+LDS_BT);
  const int NT=(q0+QB)/KVBLK;
  DMA_K(0,0);DMA_V(0,0);DMA_K(1,SLOTB);
  bf16x8 qr[4];
  #pragma unroll
  for(int d0=0;d0<4;++d0)qr[d0]=*reinterpret_cast<const bf16x8*>(&Qw[(long)r32*DM+d0*16+hi*8]);
  { float*km=(float*)(shm+LDS_KM); float*bt=(float*)(shm+LDS_BT); int tq=tid; asm volatile("":"+v"(tq));
    if(tq<448){const int j=tq>>6,d=tq&63; float v=0.f; if(j<qb&&qb>3){const float*kp=kpart+((size_t)((b*NQB+j)*2)*512)+h*D+d; v=(kp[0]+kp[512])*(1.0f/256.0f);} km[tq]=v;}
    else if(tq<448+64){const int i=tq-448; bt[i]=btab[h*128+i]; bt[64+i]=btab[h*128+64+i];} }
  float mhat=0.f,l_reg=0.f;f32x16 o[2];o[0]=f32x16{};o[1]=f32x16{};
  const int qrel=wid*QBLK+r32;
  #define CMASK(P0,P1,t) do{int jb_=(t)-(NT-4);   \
    if(jb_>=-2 && 32*wid+31-64*jb_>=0 && 32*wid-64*jb_-63<=112)biasadd(P0,P1,jb_,qrel,hi,btl); if(jb_>=0 && 64*jb_+63>32*wid)cmask(P0,P1,jb_,qrel,hi);}while(0)
  bool resc=false;
  #define START(P0,P1,t) do{ float rm=rowmax(P0,P1); resc=false; const float nv_=MASKADD(t); rm=fadd_s(rm,nv_); \
    { const float dl=__builtin_fmaxf(rm,-1.0e4f); mhat=fadd_s(mhat,dl); const float cc_=fsub_s(nv_,dl); \
      _Pragma("unroll") for(int r=0;r<16;++r){P0[r]=fadd_s(P0[r],cc_);P1[r]=fadd_s(P1[r],cc_);} } \
    _Pragma("unroll") for(int r=0;r<16;++r)P0[r]=__builtin_amdgcn_exp2f(P0[r]); }while(0)
  #define RESC() do{ if(resc){ asm volatile("s_waitcnt lgkmcnt(0)":::"memory"); \
      _Pragma("unroll") for(int d_=0;d_<2;++d_) _Pragma("unroll") for(int r=0;r<16;++r)o[d_][r]*=wsf[crow(r,hi)]; } }while(0)
  f32x16 pA0,pA1,pB0,pB1;
  int sl_prev=0,sl_cur=0,sl_next=SLOTB;
  #define ROT() do{sl_prev=sl_cur;sl_cur=sl_next;sl_next=(sl_next==(NSLOT-1)*SLOTB)?0:sl_next+SLOTB;}while(0)
  DMA_K(2,2*SLOTB);
  WAIT_BAR(3);
  unsigned selbits=(1u<<qb)-1u;
  if(qb>3){ selbits=0u;
    const __attribute__((address_space(3))) float* km3=(const __attribute__((address_space(3))) float*)(shm3+LDS_KM);
    float qf[32];
    #pragma unroll
    for(int d0=0;d0<4;++d0){
      #pragma unroll
      for(int i=0;i<8;++i) qf[d0*8+i]=__uint_as_float(((unsigned)(unsigned short)qr[d0][i])<<16);}
    float gj[7];
    #pragma unroll
    for(int j=0;j<7;++j){ float s=0.f;
      if(j<qb){
        #pragma unroll
        for(int d0=0;d0<4;++d0){ const f32x4v k0=*(const __attribute__((address_space(3))) f32x4v*)(km3+j*64+d0*16+hi*8); const f32x4v k1=*(const __attribute__((address_space(3))) f32x4v*)(km3+j*64+d0*16+hi*8+4);
          s+=qf[d0*8+0]*k0[0]+qf[d0*8+1]*k0[1]+qf[d0*8+2]*k0[2]+qf[d0*8+3]*k0[3]+qf[d0*8+4]*k1[0]+qf[d0*8+5]*k1[1]+qf[d0*8+6]*k1[2]+qf[d0*8+7]*k1[3]; }
        auto rr=__builtin_amdgcn_permlane32_swap(__float_as_uint(s),__float_as_uint(s),false,false); s=__uint_as_float(rr[0])+__uint_as_float(rr[1]); }
      gj[j]=s; }
    #pragma unroll
    for(int j=0;j<7;++j){ int rank=0;
      #pragma unroll
      for(int k=0;k<7;++k){ if(k!=j){ const bool beats=(k<j)?(gj[k]>=gj[j]):(gj[k]>gj[j]); rank+=(k<qb&&beats)?1:0; } }
      if(j<qb&&rank<3)selbits|=(1u<<j); }
  }
  #define MASKADD(t) ((((t)>>2)<qb && !((selbits>>((t)>>2))&1u))?-1.0e30f:0.0f)
  qkt(pA0,pA1,Kbase,qr,r32,hi);asm volatile("s_nop 15\n\ts_nop 7":"+v"(pA0),"+v"(pA1));CMASK(pA0,pA1,0);
  START(pA0,pA1,0);
  _Pragma("unroll") for(int r=0;r<16;++r)pA1[r]=__builtin_amdgcn_exp2f(pA1[r]);
  WAIT_BAR(0);
  DMA_K(3,0);DMA_V(1,SLOTB);
  ROT();
  kload8(kf,kp0+sl_cur);
  WAIT_BAR(2);
  s16x4 vlo[8],vhi[8]; u32x4 pw0,pw1,pw2,pw3;
  #define PKW(P,B) cvtpk_s(P[B],P[B+1])
  #define PAF(k) __builtin_bit_cast(bf16x8,pw##k)
  #define VFR(i) (bf16x8){vlo[i][0],vlo[i][1],vlo[i][2],vlo[i][3],vhi[i][0],vhi[i][1],vhi[i][2],vhi[i][3]}
  #define PIN(x) asm volatile("":"+v"(x))
  #define MX3(a,b,c) __builtin_fmaxf(__builtin_fmaxf((a),(b)),(c))
  #define GAPA(MF,A0,A1,A2,A3,W0,W1,PW) do{ MF; sacc+=A0; sacc+=A1; sacc+=A2; sacc+=A3; PIN(sacc); W0; W1; PIN(PW); SBAR(); }while(0)
  #define EX(v) __builtin_amdgcn_exp2f(v)
  #define GAPB(MF,X,B) do{ MF; X[B]=EX(X[B]); X[B+1]=EX(X[B+1]); X[B+2]=EX(X[B+2]); X[B+3]=EX(X[B+3]); PIN(X); SBAR(); }while(0)
  #define VRD(i) do{ vlo[i]=vtr(vp_+(((i)>>2)*4096+((i)&3)*1024)); vhi[i]=vtr(vp_+(((i)>>2)*4096+((i)&3)*1024+512)); }while(0)
  #define KRD(G,j) do{ if(G){ kload2(kf,kp0+sl_next,j); SBAR(); } }while(0)
  #define STEP(C0,C1,P0,P1,t,GK,GV,GL) do{ SBAR(); \
    const lds_cptr vp_=vp0+sl_prev; \
    VRD(0); SBAR(); float sacc=(P0[0]+P0[1]); \
    GAPA(C0=__builtin_amdgcn_mfma_f32_32x32x16_bf16(kf[0],qr[0],(f32x16){},0,0,0), P0[2],P0[3],P0[4],P0[5],     pw0[0]=PKW(P0,0), pw0[1]=PKW(P0,2), pw0); \
    VRD(4); SBAR(); GAPA(C1=__builtin_amdgcn_mfma_f32_32x32x16_bf16(kf[1],qr[0],(f32x16){},0,0,0), P0[6],P0[7],P0[8],P0[9],     pw0[2]=PKW(P0,4), pw0[3]=PKW(P0,6), pw0); \
    VRD(1); SBAR(); GAPA(C0=__builtin_amdgcn_mfma_f32_32x32x16_bf16(kf[2],qr[1],C0,0,0,0),   P0[10],P0[11],P0[12],P0[13], pw1[0]=PKW(P0,8), pw1[1]=PKW(P0,10), pw1); \
    VRD(5); SBAR(); GAPA(C1=__builtin_amdgcn_mfma_f32_32x32x16_bf16(kf[3],qr[1],C1,0,0,0),   P0[14],P0[15],P1[0],P1[1],   pw1[2]=PKW(P0,12),pw1[3]=PKW(P0,14), pw1); \
    VRD(2); SBAR(); GAPA(C0=__builtin_amdgcn_mfma_f32_32x32x16_bf16(kf[4],qr[2],C0,0,0,0),   P1[2],P1[3],P1[4],P1[5],     pw2[0]=PKW(P1,0), pw2[1]=PKW(P1,2), pw2); \
    VRD(6); SBAR(); GAPA(C1=__builtin_amdgcn_mfma_f32_32x32x16_bf16(kf[5],qr[2],C1,0,0,0),   P1[6],P1[7],P1[8],P1[9],     pw2[2]=PKW(P1,4), pw2[3]=PKW(P1,6), pw2); \
    VRD(3); SBAR(); GAPA(C0=__builtin_amdgcn_mfma_f32_32x32x16_bf16(kf[6],qr[3],C0,0,0,0),   P1[10],P1[11],P1[12],P1[13], pw3[0]=PKW(P1,8), pw3[1]=PKW(P1,10), pw3); \
    VRD(7); SBAR(); GAPA(C1=__builtin_amdgcn_mfma_f32_32x32x16_bf16(kf[7],qr[3],C1,0,0,0),   P1[14],P1[15],0.f,0.f,       pw3[2]=PKW(P1,12),pw3[3]=PKW(P1,14), pw3); \
    l_reg+=sacc; \
    if(GK){DMA_K((t)+3,sl_cur);} if(GV){DMA_V((t)+1,sl_next);} \
    CMASK(C0,C1,t); \
    { float a=MX3(C0[0],C0[1],C1[0]),b=MX3(C0[2],C0[3],C1[1]); a=MX3(a,C1[2],C1[3]); \
      _Pragma("unroll") for(int r=4;r<16;r+=4){a=MX3(a,C0[r],C0[r+1]);b=MX3(b,C0[r+2],C0[r+3]);a=MX3(a,C1[r],C1[r+1]);b=MX3(b,C1[r+2],C1[r+3]);} \
      float rm=__builtin_fmaxf(a,b); { auto rr=__builtin_amdgcn_permlane32_swap(__float_as_uint(rm),__float_as_uint(rm),false,false); rm=__builtin_fmaxf(__uint_as_float(rr[0]),__uint_as_float(rr[1])); } \
      const float nv_=MASKADD(t)-mhat; rm+=nv_; float cc_=nv_; \
      resc=false; \
      if(__builtin_expect(__any(rm>(float)THRL),0)){ const float dl=__builtin_fmaxf(rm,0.f); mhat+=dl; cc_-=dl; \
        const float f=__builtin_amdgcn_exp2f(-dl); l_reg*=f; if(hi==0)wsf[r32]=f; resc=true; } \
      _Pragma("unroll") for(int r=0;r<16;++r){C0[r]+=cc_;C1[r]+=cc_;} } \
    SBAR(); \
    GAPB(o[0]=__builtin_amdgcn_mfma_f32_32x32x16_bf16(PAF(0),VFR(0),o[0],0,0,0), C0,0); \
    GAPB(o[1]=__builtin_amdgcn_mfma_f32_32x32x16_bf16(PAF(0),VFR(4),o[1],0,0,0), C0,4); \
    KRD(GL,0); GAPB(o[0]=__builtin_amdgcn_mfma_f32_32x32x16_bf16(PAF(1),VFR(1),o[0],0,0,0), C0,8); \
    KRD(GL,1); GAPB(o[1]=__builtin_amdgcn_mfma_f32_32x32x16_bf16(PAF(1),VFR(5),o[1],0,0,0), C0,12); \
    KRD(GL,2); GAPB(o[0]=__builtin_amdgcn_mfma_f32_32x32x16_bf16(PAF(2),VFR(2),o[0],0,0,0), C1,0); \
    KRD(GL,3); GAPB(o[1]=__builtin_amdgcn_mfma_f32_32x32x16_bf16(PAF(2),VFR(6),o[1],0,0,0), C1,4); \
    GAPB(o[0]=__builtin_amdgcn_mfma_f32_32x32x16_bf16(PAF(3),VFR(3),o[0],0,0,0), C1,8); \
    GAPB(o[1]=__builtin_amdgcn_mfma_f32_32x32x16_bf16(PAF(3),VFR(7),o[1],0,0,0), C1,12); \
    }while(0)
  int t=1;
  #undef CMASK
  #define CMASK(P0,P1,t) do{}while(0)
  for(;t+7<NT;t+=2){
    STEP(pB0,pB1,pA0,pA1,t,true,true,true);     WAIT_BAR(2); RESC(); ROT();
    STEP(pA0,pA1,pB0,pB1,t+1,true,true,true);   WAIT_BAR(2); RESC(); ROT();
  }
  #undef CMASK
  #define CMASK(P0,P1,t) do{int jb_=(t)-(NT-4);   \
    if(jb_>=-2 && 32*wid+31-64*jb_>=0 && 32*wid-64*jb_-63<=112)biasadd(P0,P1,jb_,qrel,hi,btl); if(jb_>=0 && 64*jb_+63>32*wid)cmask(P0,P1,jb_,qrel,hi);}while(0)
  #define ENDW(tt) do{ if((tt)+3<NT){WAIT_BAR(2);} else if((tt)+2<NT){WAIT_BAR(1);} else {WAIT_BAR(0);} }while(0)
  for(;t+1<NT;t+=2){
    STEP(pB0,pB1,pA0,pA1,t,(t+3<NT),(t+1<NT),(t+1<NT));       ENDW(t);   RESC(); ROT();
    STEP(pA0,pA1,pB0,pB1,t+1,(t+4<NT),(t+2<NT),(t+2<NT));     ENDW(t+1); RESC(); ROT();
  }
  STEP(pB0,pB1,pA0,pA1,NT-1,false,false,false); RESC();
  { float sacc=pB0[0]+pB0[1]; _Pragma("unroll") for(int r=2;r<16;++r)sacc+=pB0[r]; _Pragma("unroll") for(int r=0;r<16;++r)sacc+=pB1[r]; l_reg+=sacc;
    pw0=(u32x4){PKW(pB0,0),PKW(pB0,2),PKW(pB0,4),PKW(pB0,6)};pw1=(u32x4){PKW(pB0,8),PKW(pB0,10),PKW(pB0,12),PKW(pB0,14)};pw2=(u32x4){PKW(pB1,0),PKW(pB1,2),PKW(pB1,4),PKW(pB1,6)};pw3=(u32x4){PKW(pB1,8),PKW(pB1,10),PKW(pB1,12),PKW(pB1,14)};
    SBAR(); pv(o,vb0+sl_cur,PAF(0),PAF(1),PAF(2),PAF(3)); }
  #undef PKW
  #undef PAF
  #undef VFR
  #undef PIN
  #undef MX3
  #undef GAPA
  #undef GAPB
  #undef EX
  #undef VRD
  #undef KRD
  #undef STEP
  #undef ENDW
  #undef MASKADD
  {auto rr=__builtin_amdgcn_permlane32_swap(__float_as_uint(l_reg),__float_as_uint(l_reg),false,false);l_reg=__uint_as_float(rr[0])+__uint_as_float(rr[1]);}
  if(hi==0)wsf[32+r32]=l_reg;asm volatile("s_waitcnt lgkmcnt(0)":::"memory");
  float rli[16];
  #pragma unroll
  for(int r=0;r<16;++r)rli[r]=__builtin_amdgcn_rcpf(wsf[32+crow(r,hi)]);
  bf16*Ow=O+(rowbase+q0+wid*QBLK)*DM+h*D;
  { bf16*stg=(bf16*)(shm+LDS_OST)+wid*2048;
    #pragma unroll
    for(int r=0;r<16;++r){const int orow=crow(r,hi);
      #pragma unroll
      for(int d0=0;d0<2;++d0)stg[orow*64+d0*32+r32]=__float2bfloat16(o[d0][r]*rli[r]);}
    asm volatile("s_waitcnt lgkmcnt(0)":::"memory");
    #pragma unroll
    for(int i=0;i<4;++i){const int row=i*8+(lane>>3),ch=lane&7; const u32x4 v=*(const u32x4*)(stg+row*64+ch*8); ATTN_STORE16(Ow+(long)row*DM+ch*8,v);} }
  asm volatile("s_waitcnt lgkmcnt(0)\n\ts_barrier":::"memory");
  #undef DMA_K
  #undef DMA_V
  #undef CMASK
  #undef START
  #undef RESC
  #undef ROT
}
constexpr int ATTN_LDS_BYTES=LDS_BYTES;
#undef SBAR
#undef WAIT_BAR
}
constexpr int NWAVES = 8;
constexpr int PER_PHASE = 10;
constexpr int N_LAUNCHES = MK_N_LAUNCHES;

constexpr int BATCH = 8, SEQ = 2048, DMODEL = 1024, MTOK = BATCH * SEQ;
constexpr int INCOLS = 4096, SSMW = 512, NGRP = 32, CH = 32  , NCHUNK = SEQ / CH  , APK = 640  ;
constexpr int PQ = 2048, NEXP = 16384;
constexpr float RMS_EPS = 1e-6f;

constexpr size_t MiB = 1u << 20;
constexpr size_t WS_CTL = 0, CTL_ZERO_BYTES = 64 * 1024;
constexpr size_t WS_BIAS = 1 * MiB;
constexpr size_t WS_PW32 = 1 * MiB + 64 * 1024;
constexpr size_t WS_KPART = 1 * MiB + 128 * 1024;
constexpr size_t WS_KG = 2 * MiB;
constexpr size_t WS_SSQ1 = 3 * MiB;
constexpr size_t WS_WIN = 6 * MiB, WS_WQ = 14 * MiB, WS_WOUT = 18 * MiB, WS_WUS = 20 * MiB, WS_WUA = 21 * MiB, WS_WGLU = 22 * MiB, WS_KS = 22 * MiB + 512 * 1024;
constexpr size_t WS_WE = 23 * MiB;
constexpr size_t WS_BP = 32 * MiB;
constexpr size_t WS_AP = 52 * MiB;
constexpr size_t WS_E = 72 * MiB;
constexpr size_t WS_H = 80 * MiB;
constexpr size_t WS_YPRE = 80 * MiB, WS_YA = 96 * MiB, WS_XG = 80 * MiB;
constexpr size_t WS_Z = 96 * MiB, ZSTRIDE_B = 16 * MiB;
constexpr size_t WS_MRG = 128 * MiB;
constexpr size_t WS_PQ = 160 * MiB;
constexpr size_t WS_IDS = 224 * MiB, WS_GTS = 232 * MiB;
constexpr size_t WS_U16 = 32 * MiB, WS_V16 = 240 * MiB;
constexpr size_t WS_YB = 224 * MiB;
constexpr size_t WS_WPK = 128 * MiB, WS_RSTD1 = 4 * MiB, WS_Y16 = 160 * MiB;
constexpr size_t WS_END = 256 * MiB;
constexpr int CW_BAR = 1024;

constexpr int RING_OFF = 0, RING_BYTES = 131072;
constexpr int LDSCTL_OFF = RING_BYTES, MISC_OFF = LDSCTL_OFF + 320;
constexpr int LDS_BYTES = 147456;

#define GAS __attribute__((address_space(1)))
#define LAS __attribute__((address_space(3)))
typedef unsigned short bf16;
typedef unsigned v4u __attribute__((ext_vector_type(4)));
typedef float f32x4 __attribute__((ext_vector_type(4)));
typedef short bf16x8 __attribute__((ext_vector_type(8)));
typedef float f32x16 __attribute__((ext_vector_type(16)));
typedef __bf16 bf16x2_t __attribute__((ext_vector_type(2)));
typedef _Float16 h2_t __attribute__((ext_vector_type(2)));
typedef GAS unsigned gu32;
#define RLX_AGENT __ATOMIC_RELAXED, __HIP_MEMORY_SCOPE_AGENT
#define LDS_WAIT() asm volatile("s_waitcnt lgkmcnt(0)" ::: "memory")
#define VM_WAIT() asm volatile("s_waitcnt vmcnt(0)" ::: "memory")
__device__ __forceinline__ unsigned f2bf(float f) { unsigned u = __builtin_bit_cast(unsigned, f); return (u + 0x7fffu + ((u >> 16) & 1u)) >> 16; }
__device__ __forceinline__ unsigned pk2(float lo, float hi) { return f2bf(lo) | (f2bf(hi) << 16); }
using pg8::cvt_pk_bf16; using pg8::bf_lo; using pg8::bf_hi; using pg8::sigmoid_f; using pg8::gelu_tanh;

#define XB_TMO      128
#define XB_XCNT(j)  (256  + 64 * (j))
#define XB_XSUB(j)  (1280 + 64 * (j))
#define XB_XGEN(j)  (2304 + 64 * (j))
#define XB_TOP      3328
#define XB_TOPGEN   3392
#define XCD_BAR_WORDS 3456
#define XB_SPIN_CAP (1u << 18)
__device__ __forceinline__ unsigned xb_ld(unsigned* p)              { return __hip_atomic_load(p, __ATOMIC_RELAXED, __HIP_MEMORY_SCOPE_AGENT); }
__device__ __forceinline__ unsigned xb_add(unsigned* p, unsigned v) { return __hip_atomic_fetch_add(p, v, __ATOMIC_RELAXED, __HIP_MEMORY_SCOPE_AGENT); }
__device__ __forceinline__ unsigned xb_xcc_id() { return (unsigned)__builtin_amdgcn_s_getreg((3 << 11) | 20) & 0xFu; }
#define XB_SPIN(cond, bar) do { unsigned _sp = 0; while (cond) { __builtin_amdgcn_s_sleep(1); \
    if ((++_sp & 255u) == 0u) { if (xb_ld(&(bar)[XB_TMO])) break; if (_sp > XB_SPIN_CAP) { atomicAdd(&(bar)[XB_TMO], 1u); break; } } } } while (0)
struct XcdBarrier { unsigned* bar; unsigned x; volatile LAS unsigned* st; };
__device__ __forceinline__ XcdBarrier xcd_barrier_post(unsigned* bar, volatile LAS unsigned* st) {
    XcdBarrier b; b.bar = bar; b.x = xb_xcc_id(); b.st = st;
    if (threadIdx.x == 0) (void)xb_add(&bar[XB_XCNT(b.x)], 1u);
    return b;
}
__device__ __forceinline__ void xcd_barrier_complete(unsigned* bar, unsigned x, unsigned& nloc, unsigned& nx) {
    const unsigned G = gridDim.x * gridDim.y * gridDim.z;
    unsigned sum, cnt, mine, sp = 0u;
    for (;;) {
        sum = 0u; cnt = 0u; mine = 0u;
#pragma unroll
        for (unsigned j = 0; j < 16; ++j) { const unsigned c = xb_ld(&bar[XB_XCNT(j)]); sum += c; cnt += (c > 0u) ? 1u : 0u; mine = (j == x) ? c : mine; }
        if (sum == G) break;
        __builtin_amdgcn_s_sleep(1);
        if ((++sp & 255u) == 0u) { if (xb_ld(&bar[XB_TMO])) break; if (sp > XB_SPIN_CAP) { atomicAdd(&bar[XB_TMO], 1u); break; } }
    }
    nloc = mine > 0u ? mine : 1u; nx = cnt > 0u ? cnt : 1u;
}
__device__ __forceinline__ void xcd_barrier(const XcdBarrier& b) {
    asm volatile("s_waitcnt vmcnt(0)" ::: "memory");
    __syncthreads();
    if (threadIdx.x == 0) {
        unsigned* bar = b.bar;
        __builtin_amdgcn_s_waitcnt(0);
        unsigned nloc = b.st[0], nx = b.st[1];
        if (nloc == 0u) { xcd_barrier_complete(bar, b.x, nloc, nx); b.st[0] = nloc; b.st[1] = nx; }
        const unsigned old = xb_add(&bar[XB_XSUB(b.x)], 1u);
        const unsigned gen = old / nloc;
        if (old + 1u == (gen + 1u) * nloc) {
            __builtin_amdgcn_fence(__ATOMIC_RELEASE, "agent");
            asm volatile("s_waitcnt vmcnt(0)" ::: "memory");
            const unsigned og = xb_add(&bar[XB_TOP], 1u);
            const unsigned tg = og / nx;
            if (og + 1u == (tg + 1u) * nx) xb_add(&bar[XB_TOPGEN], 1u);
            else XB_SPIN(xb_ld(&bar[XB_TOPGEN]) == tg, bar);
            __builtin_amdgcn_fence(__ATOMIC_ACQUIRE, "agent");
            xb_add(&bar[XB_XGEN(b.x)], 1u);
            asm volatile("s_waitcnt vmcnt(0)" ::: "memory");
        } else {
            XB_SPIN(xb_ld(&bar[XB_XGEN(b.x)]) == gen, bar);
            __builtin_amdgcn_fence(__ATOMIC_ACQUIRE, "agent");
            asm volatile("s_waitcnt vmcnt(0)" ::: "memory");
        }
    }
    __syncthreads();
}

__device__ __forceinline__ float wave_sum(float v) {
#pragma unroll
    for (int o = 1; o < 64; o <<= 1) v += __shfl_xor(v, o);
    return v;
}

namespace pg8 {
struct EpiIn {
    static constexpr bool PERM = true;
    bf16_t* zbase; bf16_t* AP; float* kpart;
    __device__ __forceinline__ void operator()(const f32x4 (&acc)[2][2][4][2], const Unit& u, int wr, int wc, int fr, int fq) const {
        const int t = u.pn >> 1, colt = (u.pn & 1) * 256;
        const int row0 = u.pm * BM + wr * 64 + fr, col0 = colt + wc * 32 + 8 * fq;
        if (t == 0) {
#pragma unroll
            for (int ai = 0; ai < 2; ++ai)
#pragma unroll
                for (int m = 0; m < 4; ++m) { const int r = row0 + ai * HALF + m * 16, b = r >> 11, l = r & 2047;
#pragma unroll
                    for (int bj = 0; bj < 2; ++bj) { const int c = col0 + bj * HALF, g = c >> 4, hi0 = c & 15;
                        const f32x4 v0 = acc[ai][bj][m][0], v1 = acc[ai][bj][m][1];
                        u32x4 w; w.x = cvt_pk_bf16(v0[0], v0[1]); w.y = cvt_pk_bf16(v0[2], v0[3]); w.z = cvt_pk_bf16(v1[0], v1[1]); w.w = cvt_pk_bf16(v1[2], v1[3]);
                        *(u32x4*)(AP + (size_t)(g * 512 + b * 64 + (l >> 5)) * 640 + (l & 31) * 16 + hi0) = w; } }
        } else {
            bf16_t* base = zbase + (size_t)t * (16u * 1024u * 1024u / 2u);
            const float sc = (t == 1) ? 0.125f * 1.4426950408889634f : 1.0f;
#pragma unroll
            for (int ai = 0; ai < 2; ++ai)
#pragma unroll
                for (int m = 0; m < 4; ++m) { bf16_t* rowp = base + (size_t)(row0 + ai * HALF + m * 16) * 512 + col0;
#pragma unroll
                    for (int bj = 0; bj < 2; ++bj) { f32x4 v0 = acc[ai][bj][m][0], v1 = acc[ai][bj][m][1];
                        if (t >= 4) {
#pragma unroll
                            for (int e = 0; e < 4; ++e) { v0[e] = sigmoid_f(v0[e]); v1[e] = sigmoid_f(v1[e]); }
                        } else { v0 = v0 * sc; v1 = v1 * sc; }
                        u32x4 w; w.x = cvt_pk_bf16(v0[0], v0[1]); w.y = cvt_pk_bf16(v0[2], v0[3]); w.z = cvt_pk_bf16(v1[0], v1[1]); w.w = cvt_pk_bf16(v1[2], v1[3]);
                        *(u32x4*)(rowp + bj * HALF) = w; } }
            if (t == 2) {
#pragma unroll
                for (int bj = 0; bj < 2; ++bj)
#pragma unroll
                    for (int n = 0; n < 2; ++n) { f32x4 s = (f32x4){0.f, 0.f, 0.f, 0.f};
#pragma unroll
                        for (int ai = 0; ai < 2; ++ai)
#pragma unroll
                            for (int m = 0; m < 4; ++m) s += acc[ai][bj][m][n];
#pragma unroll
                        for (int e = 0; e < 4; ++e) { float x = s[e]; x += __shfl_xor(x, 1); x += __shfl_xor(x, 2); x += __shfl_xor(x, 4); x += __shfl_xor(x, 8); s[e] = x; }
                        if (fr == 0) *(f32x4*)(kpart + (size_t)(u.pm * 2 + wr) * 512 + col0 + bj * HALF + 4 * n) = s; }
            }
        }
    }
};
struct EpiE {
    static constexpr bool PERM = false;
    float* E;
    __device__ __forceinline__ void operator()(const f32x4 (&acc)[2][2][4][2], const Unit& u, int wr, int wc, int fr, int fq) const {
        const int row0 = u.pm * BM + wr * 64 + fr, col0 = wc * 32 + 4 * fq;
#pragma unroll
        for (int ai = 0; ai < 2; ++ai)
#pragma unroll
            for (int m = 0; m < 4; ++m) { float* rowp = E + (size_t)(row0 + ai * HALF + m * 16) * 128 + col0;
#pragma unroll
                for (int n = 0; n < 2; ++n) *(f32x4*)(rowp + n * 16) = acc[ai][0][m][n]; }
    }
};
struct EpiY {
    static constexpr bool PERM = true;
    bf16_t* Y;
    __device__ __forceinline__ void operator()(const f32x4 (&acc)[2][2][4][2], const Unit& u, int wr, int wc, int fr, int fq) const {
        const int row0 = u.pm * BM + wr * 64 + fr, col0 = u.pn * BM + wc * 32 + 8 * fq;
#pragma unroll
        for (int ai = 0; ai < 2; ++ai)
#pragma unroll
            for (int m = 0; m < 4; ++m) { const int r = row0 + ai * HALF + m * 16, g = r >> 9, b = (r >> 6) & 7, c = r & 63;
#pragma unroll
                for (int bj = 0; bj < 2; ++bj) { const int cc = col0 + bj * HALF, j = cc >> 4, ho0 = cc & 15;
                    f32x4 v0 = acc[ai][bj][m][0], v1 = acc[ai][bj][m][1];
#pragma unroll
                    for (int e = 0; e < 4; ++e) { v0[e] = gelu_tanh(v0[e]); v1[e] = gelu_tanh(v1[e]); }
                    u32x4 w; w.x = cvt_pk_bf16(v0[0], v0[1]); w.y = cvt_pk_bf16(v0[2], v0[3]); w.z = cvt_pk_bf16(v1[0], v1[1]); w.w = cvt_pk_bf16(v1[2], v1[3]);
                    *(u32x4*)(Y + (size_t)(b * 2048 + c * 32 + j) * 512 + g * 16 + ho0) = w; } }
    }
};
struct EpiGlu {
    static constexpr bool PERM = true;
    const bf16_t* Yp; bf16_t* Ya; const float* bias;
    __device__ __forceinline__ void operator()(const f32x4 (&acc)[2][2][4][2], const Unit& u, int wr, int wc, int fr, int fq) const {
        const int row0 = u.pm * BM + wr * 64 + fr, col0 = u.pn * BM + wc * 32 + 8 * fq;
        f32x4 bv[2][2];
#pragma unroll
        for (int bj = 0; bj < 2; ++bj)
#pragma unroll
            for (int n = 0; n < 2; ++n) bv[bj][n] = *(const f32x4*)(bias + col0 + bj * HALF + 4 * n);
#pragma unroll
        for (int ai = 0; ai < 2; ++ai)
#pragma unroll
            for (int m = 0; m < 4; ++m) { const size_t off = (size_t)(row0 + ai * HALF + m * 16) * 512 + col0;
#pragma unroll
                for (int bj = 0; bj < 2; ++bj) { const f32x4 z0 = acc[ai][bj][m][0] + bv[bj][0], z1 = acc[ai][bj][m][1] + bv[bj][1];
                    const u32x4 y = *(const u32x4*)(Yp + off + bj * HALF);
                    u32x4 w; w.x = cvt_pk_bf16(bf_lo(y.x) * sigmoid_f(z0[0]), bf_hi(y.x) * sigmoid_f(z0[1])); w.y = cvt_pk_bf16(bf_lo(y.y) * sigmoid_f(z0[2]), bf_hi(y.y) * sigmoid_f(z0[3]));
                    w.z = cvt_pk_bf16(bf_lo(y.z) * sigmoid_f(z1[0]), bf_hi(y.z) * sigmoid_f(z1[1])); w.w = cvt_pk_bf16(bf_lo(y.w) * sigmoid_f(z1[2]), bf_hi(y.w) * sigmoid_f(z1[3]));
                    *(u32x4*)(Ya + off + bj * HALF) = w; } }
    }
};
template <int ADD> struct EpiMrg {
    static constexpr bool PERM = true;
    const bf16_t* G0; bf16_t* Mrg;
    __device__ __forceinline__ void operator()(const f32x4 (&acc)[2][2][4][2], const Unit& u, int wr, int wc, int fr, int fq) const {
        const int row0 = u.pm * BM + wr * 64 + fr, cin = wc * 32 + 8 * fq;
        const bf16_t* gb = G0 + (size_t)(u.pn >> 1) * (16u * 1024u * 1024u / 2u) + (u.pn & 1) * 256 + cin;
#pragma unroll
        for (int ai = 0; ai < 2; ++ai)
#pragma unroll
            for (int m = 0; m < 4; ++m) { const int r = row0 + ai * HALF + m * 16;
#pragma unroll
                for (int bj = 0; bj < 2; ++bj) {
#if defined(ABL_NO_SSM) || defined(ABL_NO_ATT)
#if defined(ABL_NO_SSM)
                    constexpr bool kill = (ADD == 0);
#else
                    constexpr bool kill = (ADD == 1);
#endif
                    const f32x4 a0 = kill ? (f32x4){0.f, 0.f, 0.f, 0.f} : acc[ai][bj][m][0], a1 = kill ? (f32x4){0.f, 0.f, 0.f, 0.f} : acc[ai][bj][m][1];
#else
                    const f32x4 a0 = acc[ai][bj][m][0], a1 = acc[ai][bj][m][1];
#endif
                    const u32x4 gt = *(const u32x4*)(gb + (size_t)r * 512 + bj * HALF);
                    bf16_t* mp = Mrg + (size_t)r * 1024 + u.pn * BM + cin + bj * HALF;
                    float o[8] = { bf_lo(gt.x) * a0[0], bf_hi(gt.x) * a0[1], bf_lo(gt.y) * a0[2], bf_hi(gt.y) * a0[3], bf_lo(gt.z) * a1[0], bf_hi(gt.z) * a1[1], bf_lo(gt.w) * a1[2], bf_hi(gt.w) * a1[3] };
                    if (ADD) { const u32x4 p = *(const u32x4*)mp; o[0] += bf_lo(p.x); o[1] += bf_hi(p.x); o[2] += bf_lo(p.y); o[3] += bf_hi(p.y); o[4] += bf_lo(p.z); o[5] += bf_hi(p.z); o[6] += bf_lo(p.w); o[7] += bf_hi(p.w); }
                    u32x4 w; w.x = cvt_pk_bf16(o[0], o[1]); w.y = cvt_pk_bf16(o[2], o[3]); w.z = cvt_pk_bf16(o[4], o[5]); w.w = cvt_pk_bf16(o[6], o[7]);
                    *(u32x4*)mp = w; } }
    }
};
struct EpiMrgDual {
    static constexpr bool PERM = true;
    EpiMrg<0> a; EpiMrg<1> b;
    __device__ __forceinline__ void operator()(const f32x4 (&acc)[2][2][4][2], const Unit& u, int wr, int wc, int fr, int fq) const { if (u.w == 0) a(acc, u, wr, wc, fr, fq); else b(acc, u, wr, wc, fr, fq); }
};
struct EpiX1 {
    static constexpr bool PERM = true;
    const float* X; float* X1; bf16_t* XG; const float* g2; float* ssq;
    __device__ __forceinline__ void operator()(const f32x4 (&acc)[2][2][4][2], const Unit& u, int wr, int wc, int fr, int fq) const {
        const int row0 = u.pm * BM + wr * 64 + fr, col0 = u.pn * BM + wc * 32 + 8 * fq;
        f32x4 gv[2][2];
#pragma unroll
        for (int bj = 0; bj < 2; ++bj)
#pragma unroll
            for (int n = 0; n < 2; ++n) gv[bj][n] = *(const f32x4*)(g2 + col0 + bj * HALF + 4 * n);
#pragma unroll
        for (int ai = 0; ai < 2; ++ai)
#pragma unroll
            for (int m = 0; m < 4; ++m) { const int r = row0 + ai * HALF + m * 16; const size_t off = (size_t)r * 1024 + col0; float s = 0.f;
#pragma unroll
                for (int bj = 0; bj < 2; ++bj) {
                    #ifdef ABL_NO_MIX
                    const f32x4 x0 = *(const f32x4*)(X + off + bj * HALF), x1 = *(const f32x4*)(X + off + bj * HALF + 4);
#else
                    const f32x4 x0 = *(const f32x4*)(X + off + bj * HALF) + acc[ai][bj][m][0], x1 = *(const f32x4*)(X + off + bj * HALF + 4) + acc[ai][bj][m][1];
#endif
                    *(f32x4*)(X1 + off + bj * HALF) = x0; *(f32x4*)(X1 + off + bj * HALF + 4) = x1;
                    s += (x0[0] * x0[0] + x0[1] * x0[1]) + (x0[2] * x0[2] + x0[3] * x0[3]) + (x1[0] * x1[0] + x1[1] * x1[1]) + (x1[2] * x1[2] + x1[3] * x1[3]);
                    const f32x4 a = x0 * gv[bj][0], b = x1 * gv[bj][1];
                    u32x4 w; w.x = cvt_pk_bf16(a[0], a[1]); w.y = cvt_pk_bf16(a[2], a[3]); w.z = cvt_pk_bf16(b[0], b[1]); w.w = cvt_pk_bf16(b[2], b[3]);
                    *(u32x4*)(XG + off + bj * HALF) = w; }
                s += __shfl_xor(s, 16); s += __shfl_xor(s, 32);
                if (fq == 0) ssq[(size_t)r * 16 + u.pn * 4 + wc] = s; }
    }
};
struct EpiPlain {
    static constexpr bool PERM = true;
    bf16_t* O; int ldc;
    __device__ __forceinline__ void operator()(const f32x4 (&acc)[2][2][4][2], const Unit& u, int wr, int wc, int fr, int fq) const {
        const int row0 = u.pm * BM + wr * 64 + fr, col0 = u.pn * BM + wc * 32 + 8 * fq;
#pragma unroll
        for (int ai = 0; ai < 2; ++ai)
#pragma unroll
            for (int m = 0; m < 4; ++m) { bf16_t* rowp = O + (size_t)(row0 + ai * HALF + m * 16) * ldc + col0;
#pragma unroll
                for (int bj = 0; bj < 2; ++bj) { const f32x4 v0 = acc[ai][bj][m][0], v1 = acc[ai][bj][m][1];
                    u32x4 w; w.x = cvt_pk_bf16(v0[0], v0[1]); w.y = cvt_pk_bf16(v0[2], v0[3]); w.z = cvt_pk_bf16(v1[0], v1[1]); w.w = cvt_pk_bf16(v1[2], v1[3]);
                    *(u32x4*)(rowp + bj * HALF) = w; } }
    }
};
}
struct Frame {
    LAS unsigned char* lds;
    int tid, lane, wave, vcu, G;
};

__device__ __forceinline__ void p0_transpose_item(const float* W, int K, int N, bf16* WT, LAS float* scr, int item, int lane) {
    const int nblk = N / 32, kb = item / nblk, nb = item % nblk, k0 = 64 * kb, n0 = 32 * nb;
    float wv[32];
#pragma unroll
    for (int i = 0; i < 32; ++i) { const int kk = 2 * i + (lane >> 5); wv[i] = W[(size_t)(k0 + kk) * N + n0 + (lane & 31)]; }
#pragma unroll
    for (int i = 0; i < 32; ++i) { const int kk = 2 * i + (lane >> 5); scr[kk * 33 + (lane & 31)] = wv[i]; }
    LDS_WAIT(); asm volatile("" ::: "memory");
    const int c = lane & 7;
#pragma unroll
    for (int j = 0; j < 4; ++j) { const int n = (lane >> 3) + 8 * j; const LAS float* s = scr + (8 * c) * 33 + n;
        v4u o; o.x = pk2(s[0 * 33], s[1 * 33]); o.y = pk2(s[2 * 33], s[3 * 33]); o.z = pk2(s[4 * 33], s[5 * 33]); o.w = pk2(s[6 * 33], s[7 * 33]);
        *(GAS v4u*)(WT + (size_t)(n0 + n) * K + k0 + 8 * c) = o; }
    LDS_WAIT(); asm volatile("" ::: "memory");
}
__device__ __forceinline__ void rms_row_to_bf16(const float* xrow, const float* g, bf16* orow, int lane) {
    const GAS f32x4* xr = (const GAS f32x4*)xrow + lane; const GAS f32x4* gr = (const GAS f32x4*)g + lane;
    f32x4 v[4]; float s = 0.f;
#pragma unroll
    for (int j = 0; j < 4; ++j) { v[j] = xr[64 * j]; s += (v[j].x * v[j].x + v[j].y * v[j].y) + (v[j].z * v[j].z + v[j].w * v[j].w); }
    const float rstd = 1.0f / sqrtf(wave_sum(s) * (1.f / DMODEL) + RMS_EPS);
    GAS unsigned long long* o8 = (GAS unsigned long long*)orow + lane;
#pragma unroll
    for (int j = 0; j < 4; ++j) { const f32x4 gg = gr[64 * j];
        o8[64 * j] = (unsigned long long)pk2(v[j].x * rstd * gg.x, v[j].y * rstd * gg.y) | ((unsigned long long)pk2(v[j].z * rstd * gg.z, v[j].w * rstd * gg.w) << 32); }
}
__device__ __forceinline__ void rms_rows4_to_bf16(const float* x, const float* g, bf16* out, int m, int stride, int lane) {
    f32x4 v[4][4];
#pragma unroll
    for (int k = 0; k < 4; ++k) { const int mm = (m + k * stride < MTOK) ? m + k * stride : m; const GAS f32x4* xr = (const GAS f32x4*)(x + (size_t)mm * DMODEL) + lane;
#pragma unroll
        for (int j = 0; j < 4; ++j) v[k][j] = xr[64 * j]; }
    const GAS f32x4* gr = (const GAS f32x4*)g + lane; f32x4 gg[4];
#pragma unroll
    for (int j = 0; j < 4; ++j) gg[j] = gr[64 * j];
#pragma unroll
    for (int k = 0; k < 4; ++k) { if (m + k * stride >= MTOK) break; float s = 0.f;
#pragma unroll
        for (int j = 0; j < 4; ++j) s += (v[k][j].x * v[k][j].x + v[k][j].y * v[k][j].y) + (v[k][j].z * v[k][j].z + v[k][j].w * v[k][j].w);
        const float rstd = 1.0f / sqrtf(wave_sum(s) * (1.f / DMODEL) + RMS_EPS);
        GAS unsigned long long* o8 = (GAS unsigned long long*)(out + (size_t)(m + k * stride) * DMODEL) + lane;
#pragma unroll
        for (int j = 0; j < 4; ++j) o8[64 * j] = (unsigned long long)pk2(v[k][j].x * rstd * gg[j].x, v[k][j].y * rstd * gg[j].y) | ((unsigned long long)pk2(v[k][j].z * rstd * gg[j].z, v[k][j].w * rstd * gg[j].w) << 32); }
}
struct cpx { float r, i; };
__device__ __forceinline__ cpx cmul(cpx a, cpx b) { return cpx{a.r * b.r - a.i * b.i, a.r * b.i + a.i * b.r}; }
__device__ __forceinline__ cpx cpow_(float ar, float ai, float dt, int n) { const float e = expf(ar * dt * (float)n); const float ang = ai * dt * (float)n; return cpx{e * cosf(ang), e * sinf(ang)}; }
__device__ __forceinline__ void ssm_table_task(int g, int j, int lane, LAS float* scr, const float* a_re, const float* a_im, const float* log_dt, const float* b_re, const float* b_im,
                                               const float* c_re, const float* c_im, float* Kg, bf16* WE, bf16* BP, float* pw32) {
    const int p = lane;
    const float dt = expf(log_dt[g]), ar = a_re[g * 64 + p], ai = a_im[g * 64 + p];
#define pw(n) cpow_(ar, ai, dt, (n))
    const cpx lb = pw(1);
    const float den = ar * ar + ai * ai;
    const cpx coef = cpx{((lb.r - 1.f) * ar + lb.i * ai) / den, (lb.i * ar - (lb.r - 1.f) * ai) / den};
    const cpx pj = pw(j), pe = pw(31 - j), pv = pw(j + 1);
    unsigned wer[8], wei[8];
#pragma unroll
    for (int h2 = 0; h2 < 8; ++h2) { float er[2], ei[2];
#pragma unroll
        for (int q = 0; q < 2; ++q) { const int hi = 2 * h2 + q;
            const cpx bb = cmul(coef, cpx{b_re[(g * 64 + p) * 16 + hi], b_im[(g * 64 + p) * 16 + hi]});
            const cpx w = cmul(pj, bb); scr[(p * 16 + hi) * 2] = w.r; scr[(p * 16 + hi) * 2 + 1] = w.i;
            const cpx e = cmul(pe, bb); er[q] = e.r; ei[q] = e.i; }
        wer[h2] = pk2(er[0], er[1]); wei[h2] = pk2(ei[0], ei[1]); }
    { bf16* w0 = WE + ((size_t)(g * 256 + p) * 512 + j * 16); bf16* w1 = WE + ((size_t)(g * 256 + 64 + p) * 512 + j * 16);
      *(GAS v4u*)w0 = (v4u){wer[0], wer[1], wer[2], wer[3]}; *(GAS v4u*)(w0 + 8) = (v4u){wer[4], wer[5], wer[6], wer[7]};
      *(GAS v4u*)w1 = (v4u){wei[0], wei[1], wei[2], wei[3]}; *(GAS v4u*)(w1 + 8) = (v4u){wei[4], wei[5], wei[6], wei[7]};
      bf16* z0 = WE + ((size_t)(g * 256 + 128 + p) * 512 + j * 16); bf16* z1 = WE + ((size_t)(g * 256 + 192 + p) * 512 + j * 16); const v4u z = (v4u){0u, 0u, 0u, 0u};
      *(GAS v4u*)z0 = z; *(GAS v4u*)(z0 + 8) = z; *(GAS v4u*)z1 = z; *(GAS v4u*)(z1 + 8) = z; }
#pragma unroll 4
    for (int ho = 0; ho < 16; ++ho) { const cpx cv = cmul(cpx{c_re[(g * 16 + ho) * 64 + p], c_im[(g * 16 + ho) * 64 + p]}, pv);
        bf16* row = BP + ((size_t)(g * 512 + j * 16 + ho) * APK + 512);
        row[p] = (bf16)f2bf(cv.r); row[64 + p] = (bf16)f2bf(-cv.i); }
    if (j == 0) { const cpx p32 = pw(32); pw32[g * 128 + p] = p32.r; pw32[g * 128 + 64 + p] = p32.i; }
    LDS_WAIT(); asm volatile("" ::: "memory");
    { const int ho = lane >> 2, h4 = (lane & 3) * 4; float a0 = 0.f, a1 = 0.f, a2 = 0.f, a3 = 0.f;
      const float* cr = c_re + (g * 16 + ho) * 64; const float* ci = c_im + (g * 16 + ho) * 64;
#pragma unroll 4
      for (int pp = 0; pp < 64; ++pp) { const float r_ = cr[pp], i_ = ci[pp]; const LAS float* w = scr + (pp * 16 + h4) * 2;
          a0 += r_ * w[0] - i_ * w[1]; a1 += r_ * w[2] - i_ * w[3]; a2 += r_ * w[4] - i_ * w[5]; a3 += r_ * w[6] - i_ * w[7]; }
      *(GAS f32x4*)(Kg + ((size_t)(g * 32 + j) * 256 + ho * 16 + h4)) = (f32x4){a0, a1, a2, a3}; }
    LDS_WAIT(); asm volatile("" ::: "memory");
#undef pw
}

__device__ __forceinline__ float vmaxf(float a, float b) { float r; asm("v_max_f32_e32 %0, %1, %2" : "=v"(r) : "v"(a), "v"(b)); return r; }
__device__ __forceinline__ float vminf(float a, float b) { float r; asm("v_min_f32_e32 %0, %1, %2" : "=v"(r) : "v"(a), "v"(b)); return r; }
__device__ __forceinline__ float selhi(float lo, float hi) { float r; asm("v_cndmask_b32_e64 %0, %1, %2, %3" : "=v"(r) : "v"(lo), "v"(hi), "s"(0xFFFFFFFF00000000ull)); return r; }
#define CE_DESC(a, b) do { const float hi_ = vmaxf(a, b), lo_ = vminf(a, b); a = hi_; b = lo_; } while (0)
__device__ __forceinline__ void sort16_desc(float (&v)[16]) {
#pragma unroll
    for (int k = 2; k <= 16; k <<= 1)
#pragma unroll
        for (int j = k >> 1; j > 0; j >>= 1)
#pragma unroll
            for (int i = 0; i < 16; ++i) { const int l = i ^ j; if (l > i) { if ((i & k) == 0) CE_DESC(v[i], v[l]); else CE_DESC(v[l], v[i]); } }
}
__device__ __forceinline__ void bitonic_merge16_desc(float (&v)[16]) {
#pragma unroll
    for (int j = 8; j > 0; j >>= 1)
#pragma unroll
        for (int i = 0; i < 16; ++i) { const int l = i ^ j; if (l > i) CE_DESC(v[i], v[l]); }
}
__device__ __forceinline__ void merge_top16(float (&a)[16], const float (&b)[16]) {
#pragma unroll
    for (int i = 0; i < 16; ++i) a[i] = vmaxf(a[i], b[15 - i]);
    bitonic_merge16_desc(a);
}
__device__ __forceinline__ void merge_partner_top16(float (&a)[16]) {
    float p[16];
#pragma unroll
    for (int i = 0; i < 16; ++i) { const unsigned x = __float_as_uint(a[15 - i]); auto rr = __builtin_amdgcn_permlane32_swap(x, x, false, false); p[i] = selhi(__uint_as_float(rr[1]), __uint_as_float(rr[0])); }
#pragma unroll
    for (int i = 0; i < 16; ++i) a[i] = vmaxf(a[i], p[i]);
    bitonic_merge16_desc(a);
}
__device__ __forceinline__ void topk_half(int half, const bf16x8 (&qf)[8], int r32, int hi, const LAS unsigned char* ksl, float (&top)[16]) {
#pragma unroll 1
    for (int kt = 0; kt < 4; ++kt) {
        f32x16 acc = f32x16{};
        const int row = half * 128 + kt * 32 + r32; const LAS unsigned char* rp = ksl + row * 256; const int sw = row & 15;
#pragma unroll
        for (int ks = 0; ks < 8; ++ks) { const bf16x8 a = *(const LAS bf16x8*)(rp + (((2 * ks + hi) ^ sw) << 4));
            acc = __builtin_amdgcn_mfma_f32_32x32x16_bf16(a, qf[ks], acc, 0, 0, 0); }
        float grp[16];
#pragma unroll
        for (int r = 0; r < 16; ++r) { const unsigned key = (unsigned)(kt * 32 + (r & 3) + 8 * (r >> 2)) + 4u * (unsigned)hi; grp[r] = __uint_as_float((__float_as_uint(acc[r]) & ~127u) | key); }
        sort16_desc(grp);
        if (kt == 0) {
#pragma unroll
            for (int i = 0; i < 16; ++i) top[i] = grp[i];
        } else merge_top16(top, grp);
    }
    merge_partner_top16(top);
}
__device__ __forceinline__ void topk_task(int tt, int hd, int lane, LAS unsigned char* scr, const bf16* PQb, const LAS unsigned char* ksl, const float* ssq1, int* ids, float* gts, float* rstd1) {
    const int r32 = lane & 31, hi = lane >> 5; const bool hib = hi != 0;
    const int token = tt * 32 + r32;
    float v0_[16], v1_[16];
    bf16x8 qf0[8], qf1[8];
#pragma unroll
    for (int ks = 0; ks < 8; ++ks) { qf0[ks] = *(const GAS bf16x8*)(PQb + (size_t)token * PQ + hd * 256 + ks * 16 + hi * 8); qf1[ks] = *(const GAS bf16x8*)(PQb + (size_t)token * PQ + hd * 256 + 128 + ks * 16 + hi * 8); }
    topk_half(0, qf0, r32, hi, ksl, v0_);
    topk_half(1, qf1, r32, hi, ksl, v1_);
#define v_SEL(h, i) ((h) ? v1_[i] : v0_[i])
    LAS unsigned char* slot = scr + lane * 32;
    { v4u d0, d1;
#define PK4(h, k) ((__float_as_uint(v_SEL(h, 4 * (k))) & 127u) | ((__float_as_uint(v_SEL(h, 4 * (k) + 1)) & 127u) << 8) | ((__float_as_uint(v_SEL(h, 4 * (k) + 2)) & 127u) << 16) | ((__float_as_uint(v_SEL(h, 4 * (k) + 3)) & 127u) << 24))
      d0 = (v4u){PK4(0, 0), PK4(0, 1), PK4(0, 2), PK4(0, 3)}; d1 = (v4u){PK4(1, 0), PK4(1, 1), PK4(1, 2), PK4(1, 3)};
#undef PK4
      *(LAS v4u*)slot = d0; *(LAS v4u*)(slot + 16) = d1; }
    float a[16], b[16];
#pragma unroll
    for (int i = 0; i < 16; ++i) { a[i] = selhi(v0_[i], v1_[i]); b[i] = selhi(v1_[i], v0_[i]); }
    const unsigned obit = (unsigned)hi << 8;
#define CAND(i, j) __uint_as_float((__float_as_uint(a[i] + b[j]) & ~511u) | obit | (unsigned)(((i) << 4) | (j)))
    const float NEGBIG = -3.0e38f;
    float g0[16], g1[16];
#pragma unroll
    for (int j = 1; j < 16; ++j) g0[j - 1] = CAND(0, j);
    g0[15] = CAND(1, 2);
    g1[0] = CAND(1, 3); g1[1] = CAND(1, 4); g1[2] = CAND(1, 5); g1[3] = CAND(1, 6); g1[4] = CAND(1, 7); g1[5] = CAND(2, 3); g1[6] = CAND(2, 4);
    { const float c0 = CAND(0, 0), c1 = CAND(1, 1), c2 = CAND(2, 2), c3 = CAND(3, 3);
      g1[7] = selhi(c0, NEGBIG); g1[8] = selhi(c1, NEGBIG); g1[9] = selhi(c2, NEGBIG); g1[10] = selhi(c3, NEGBIG); }
#pragma unroll
    for (int i = 11; i < 16; ++i) g1[i] = NEGBIG;
#undef CAND
    sort16_desc(g0); sort16_desc(g1); merge_top16(g0, g1); merge_partner_top16(g0);
    float rstd;
    { const GAS f32x4* sp = (const GAS f32x4*)(ssq1 + (size_t)token * 16); const f32x4 s0 = sp[0], s1 = sp[1], s2 = sp[2], s3 = sp[3];
      const float ss = ((s0.x + s0.y) + (s0.z + s0.w)) + ((s1.x + s1.y) + (s1.z + s1.w)) + ((s2.x + s2.y) + (s2.z + s2.w)) + ((s3.x + s3.y) + (s3.z + s3.w));
      rstd = 1.0f / sqrtf(ss * (1.f / DMODEL) + RMS_EPS); }
    if (hd == 0 && !hib) rstd1[token] = rstd;
    float ex[16], esum = 0.f; const float sc = rstd * 1.4426950409f;
#pragma unroll
    for (int k = 0; k < 16; ++k) { ex[k] = __builtin_amdgcn_exp2f((g0[k] - g0[0]) * sc); esum += ex[k]; }
    const float inv = 1.0f / esum;
    int eid[8]; float gv[8];
#pragma unroll
    for (int k = 0; k < 8; ++k) { const float wv = selhi(g0[k], g0[8 + k]); const float ev = selhi(ex[k], ex[8 + k]);
        const unsigned tag = __float_as_uint(wv) & 511u, o = tag >> 8, i = (tag >> 4) & 15u, j = tag & 15u; const unsigned i1 = o ? j : i, i2 = o ? i : j;
        const unsigned k1 = slot[i1], k2 = slot[16 + i2];
        eid[k] = (int)(k1 * 128u + k2); gv[k] = ev * inv; }
    { int* ip = ids + (size_t)token * 128 + hd * 16 + 8 * hi; float* gp = gts + (size_t)token * 128 + hd * 16 + 8 * hi;
      *(GAS v4u*)ip = (v4u){(unsigned)eid[0], (unsigned)eid[1], (unsigned)eid[2], (unsigned)eid[3]}; *(GAS v4u*)(ip + 4) = (v4u){(unsigned)eid[4], (unsigned)eid[5], (unsigned)eid[6], (unsigned)eid[7]};
      *(GAS f32x4*)gp = (f32x4){gv[0], gv[1], gv[2], gv[3]}; *(GAS f32x4*)(gp + 4) = (f32x4){gv[4], gv[5], gv[6], gv[7]}; }
    LDS_WAIT(); asm volatile("" ::: "memory");
}


__device__ __forceinline__ float dot2bf(unsigned a, unsigned b, float c) { return __builtin_amdgcn_fdot2_f32_bf16(__builtin_bit_cast(bf16x2_t, a), __builtin_bit_cast(bf16x2_t, b), c, false); }
__device__ __forceinline__ h2_t fma_h2(unsigned v, h2_t w, h2_t acc) { return __builtin_elementwise_fma(__builtin_bit_cast(h2_t, v), w, acc); }
__device__ __forceinline__ unsigned fp8lo_bf(unsigned w, float sc) { return __builtin_bit_cast(unsigned, __builtin_amdgcn_cvt_scalef32_pk_bf16_fp8((int)w, sc, false)); }
__device__ __forceinline__ unsigned fp8hi_bf(unsigned w, float sc) { return __builtin_bit_cast(unsigned, __builtin_amdgcn_cvt_scalef32_pk_bf16_fp8((int)w, sc, true)); }
__device__ __forceinline__ h2_t fp8lo_h(unsigned w, float sc) { return __builtin_amdgcn_cvt_scalef32_pk_f16_fp8((int)w, sc, false); }
__device__ __forceinline__ h2_t fp8hi_h(unsigned w, float sc) { return __builtin_amdgcn_cvt_scalef32_pk_f16_fp8((int)w, sc, true); }
__device__ __forceinline__ unsigned pack_fp8x4(float a, float b, float c, float d) { int w = __builtin_amdgcn_cvt_pk_fp8_f32(a, b, 0, false); w = __builtin_amdgcn_cvt_pk_fp8_f32(c, d, w, true); return (unsigned)w; }
constexpr size_t V6B_OFF = 8u << 20;
constexpr float U8_SCALE = 64.0f, V8_SCALE = 5.656854f;
constexpr int PA_CAP = 456;
constexpr float X8_SCALE = 2.0f;
typedef int v8i_t __attribute__((ext_vector_type(8)));
typedef _Float16 v32h_t __attribute__((ext_vector_type(32)));
typedef unsigned v6u_t __attribute__((ext_vector_type(6)));
typedef unsigned v2u __attribute__((ext_vector_type(2)));
struct TokB { v8i_t b[8]; };
struct RowsA { const unsigned char* p0; const unsigned char* p1; };
__device__ __forceinline__ int pa_tok(unsigned tl, int tb, int nwg) { return ((tl < 4u) ? tb : nwg) + (int)(tl & 3u); }
__device__ __forceinline__ RowsA pa_rows(int b, int n, int lane, const LAS unsigned* list, const unsigned char* U6) {
    const int i0 = b * 16 + (lane >> 3), r8 = lane >> 3, ps = lane & 7;
    const unsigned e0 = list[i0 < n ? i0 : 0], e1 = list[i0 + 8 < n ? i0 + 8 : 0];
    RowsA R; R.p0 = U6 + (size_t)(e0 & 0x3fffu) * 768 + ((ps ^ r8) * 16); R.p1 = U6 + (size_t)(e1 & 0x3fffu) * 768 + ((ps ^ r8 ^ 1) * 16);
    return R;
}
template <int J> __device__ __forceinline__ void pa_dma(const RowsA& R, LAS unsigned char* ring) {
    __builtin_amdgcn_global_load_lds((const unsigned*)R.p0, (LAS unsigned*)(ring + J * (2048 - 128)), 16, J * 128, 0);
    __builtin_amdgcn_global_load_lds((const unsigned*)R.p1, (LAS unsigned*)(ring + J * (2048 - 128) + 1024), 16, J * 128, 0);
}
#define PA_VWAIT(n) asm volatile("s_waitcnt vmcnt(" #n ")" ::: "memory")
#define PA_LWAIT(n) asm volatile("s_waitcnt lgkmcnt(" #n ")" ::: "memory")
__device__ __forceinline__ int pa_uoff(int u, int r) { return (u >> 4) * 2048 + (r >> 3) * 1024 + (r & 7) * 128 + ((((u >> 1) & 7) ^ (r & 7) ^ (r >> 3)) << 4) + (u & 1) * 8; }
struct OpA { v2u d0, d1, d2; };
__device__ __forceinline__ OpA pa_rd(int m, const LAS unsigned char* ring, int r, int g) { const int u = 12 * m + 3 * g; OpA a;
    a.d0 = *(const LAS v2u*)(ring + pa_uoff(u, r)); a.d1 = *(const LAS v2u*)(ring + pa_uoff(u + 1, r)); a.d2 = *(const LAS v2u*)(ring + pa_uoff(u + 2, r)); return a; }
__device__ __forceinline__ f32x4 pa_mm(f32x4 acc, const OpA& a, const TokB& X, int m) {
    return __builtin_amdgcn_mfma_scale_f32_16x16x128_f8f6f4((v8i_t){(int)a.d0.x, (int)a.d0.y, (int)a.d1.x, (int)a.d1.y, (int)a.d2.x, (int)a.d2.y, 0, 0}, X.b[m], acc, 2, 2, 0, 0, 0, 0);
}
__device__ __forceinline__ void pa_flush(int n, const TokB& X, int lane, LAS unsigned* list, const LAS unsigned* gl, LAS unsigned char* ring, const unsigned char* U6, unsigned* wpk, int tb, int nwg) {
    if (n == 0) return;
    LDS_WAIT(); asm volatile("" ::: "memory");
    const int nb = (n + 15) >> 4;
    const int r = lane & 15, g = lane >> 4;
    RowsA cur = pa_rows(0, n, lane, list, U6), nxt = cur;
    pa_dma<0>(cur, ring); pa_dma<1>(cur, ring); pa_dma<2>(cur, ring); pa_dma<3>(cur, ring); pa_dma<4>(cur, ring); pa_dma<5>(cur, ring);
    for (int b = 0; b < nb; ++b) {
        f32x4 acc0 = {0.f, 0.f, 0.f, 0.f}, acc1 = {0.f, 0.f, 0.f, 0.f};
        OpA A0, A1;
        if (b + 1 < nb) {
            nxt = pa_rows(b + 1, n, lane, list, U6);
            PA_VWAIT(10); A0 = pa_rd(0, ring, r, g);
            PA_VWAIT(8);  A1 = pa_rd(1, ring, r, g); PA_LWAIT(3); acc0 = pa_mm(acc0, A0, X, 0);
            PA_VWAIT(6);  A0 = pa_rd(2, ring, r, g); PA_LWAIT(3); acc1 = pa_mm(acc1, A1, X, 1); pa_dma<0>(nxt, ring);
                          A1 = pa_rd(3, ring, r, g); PA_LWAIT(3); acc0 = pa_mm(acc0, A0, X, 2); pa_dma<1>(nxt, ring);
            PA_VWAIT(8);  A0 = pa_rd(4, ring, r, g); PA_LWAIT(3); acc1 = pa_mm(acc1, A1, X, 3); pa_dma<2>(nxt, ring);
            PA_VWAIT(8);  A1 = pa_rd(5, ring, r, g); PA_LWAIT(3); acc0 = pa_mm(acc0, A0, X, 4);
            PA_VWAIT(6);  A0 = pa_rd(6, ring, r, g); PA_LWAIT(3); acc1 = pa_mm(acc1, A1, X, 5); pa_dma<3>(nxt, ring);
                          A1 = pa_rd(7, ring, r, g); PA_LWAIT(3); acc0 = pa_mm(acc0, A0, X, 6); pa_dma<4>(nxt, ring);
                                                     PA_LWAIT(0); acc1 = pa_mm(acc1, A1, X, 7); pa_dma<5>(nxt, ring);
            cur = nxt;
        } else {
            PA_VWAIT(0);
            A0 = pa_rd(0, ring, r, g);
#pragma unroll
            for (int m = 0; m < 8; m += 2) { A1 = pa_rd(m + 1, ring, r, g); PA_LWAIT(3); acc0 = pa_mm(acc0, A0, X, m);
                if (m + 2 < 8) { A0 = pa_rd(m + 2, ring, r, g); PA_LWAIT(3); } else PA_LWAIT(0);
                acc1 = pa_mm(acc1, A1, X, m + 1); }
        }
        const f32x4 acc = acc0 + acc1;
        const int idx = b * 16 + r; const unsigned ent = list[idx], tl = ent >> 21, slot = (ent >> 14) & 127u;
        const int src = (int)((((unsigned)r >> 2) * 16u + tl) << 2);
        const float v0 = __int_as_float(__builtin_amdgcn_ds_bpermute(src, __float_as_int(acc.x))), v1 = __int_as_float(__builtin_amdgcn_ds_bpermute(src, __float_as_int(acc.y)));
        const float v2 = __int_as_float(__builtin_amdgcn_ds_bpermute(src, __float_as_int(acc.z))), v3 = __int_as_float(__builtin_amdgcn_ds_bpermute(src, __float_as_int(acc.w)));
        const float dv = (r & 2) ? ((r & 1) ? v3 : v2) : ((r & 1) ? v1 : v0);
        if (lane < 16 && idx < n) { const int t = pa_tok(tl, tb, nwg);
            const _Float16 wh = (_Float16)(__uint_as_float(gl[tl * 128 + slot]) * (1.0f / V8_SCALE) * gelu_tanh(dv * (1.0f / (U8_SCALE * X8_SCALE))));
            const unsigned pos = __hip_atomic_fetch_add((LAS unsigned*)(list + PA_CAP) + tl, 1u, __ATOMIC_RELAXED, __HIP_MEMORY_SCOPE_WAVEFRONT);
            wpk[(size_t)t * 128 + pos] = ((unsigned)__builtin_bit_cast(unsigned short, wh) << 16) | (ent & 0x3fffu); }
    }
    LDS_WAIT(); asm volatile("" ::: "memory");
}
__device__ __forceinline__ void peer_a_phase(int lane, int wave, int G, int vcu, const bf16* XG, const unsigned char* U6, const int* ids, const float* gts, const float* rstd1, unsigned* wpk, LAS unsigned char* lds, int emask) {
    (void)emask;
    LAS unsigned char* ring = lds + RING_OFF + wave * 16384;
    LAS unsigned* gl = (LAS unsigned*)(ring + 12288);
    LAS unsigned* list = (LAS unsigned*)(lds + MISC_OFF + 128 + wave * (464 * 4));
    for (int tile0 = vcu; tile0 < MTOK / 32; tile0 += 2 * G) {
        const int tile1 = tile0 + G; const bool has1 = tile1 < MTOK / 32;
        const int tb = tile0 * 32 + wave * 4, nwg = (has1 ? tile1 : tile0) * 32 + wave * 4;
        int id0[8], id1[8];
        if (lane < 8) list[PA_CAP + lane] = 0u;
#pragma unroll
        for (int k = 0; k < 8; ++k) { const bool ok = (k < 4) || has1; const int tc = pa_tok((unsigned)k, tb, nwg);
            gl[k * 128 + lane] = __float_as_uint(gts[(size_t)tc * 128 + lane]); gl[k * 128 + 64 + lane] = __float_as_uint(gts[(size_t)tc * 128 + 64 + lane]);
            id0[k] = ok ? ids[(size_t)tc * 128 + lane] : -1; id1[k] = ok ? ids[(size_t)tc * 128 + 64 + lane] : -1; }
#pragma unroll
        for (int p = 0; p < 4; ++p) { const int k = 2 * p + (lane >> 5), tc = pa_tok((unsigned)k, tb, nwg);
            typedef float v16f_t __attribute__((ext_vector_type(16)));
            const GAS v4u* xs = (const GAS v4u*)(XG + (size_t)tc * 1024 + 32 * (lane & 31));
            const v4u x0 = xs[0], x1 = xs[1], x2 = xs[2], x3 = xs[3];
            const float rs = rstd1[tc] * X8_SCALE;
            const unsigned w[16] = {x0.x, x0.y, x0.z, x0.w, x1.x, x1.y, x1.z, x1.w, x2.x, x2.y, x2.z, x2.w, x3.x, x3.y, x3.z, x3.w};
            float f[32];
#pragma unroll
            for (int i = 0; i < 16; ++i) { f[2 * i] = __uint_as_float(w[i] << 16) * rs; f[2 * i + 1] = __uint_as_float(w[i] & 0xffff0000u) * rs; }
            const v16f_t lo16 = {f[0], f[1], f[2], f[3], f[4], f[5], f[6], f[7], f[8], f[9], f[10], f[11], f[12], f[13], f[14], f[15]},
                         hi16 = {f[16], f[17], f[18], f[19], f[20], f[21], f[22], f[23], f[24], f[25], f[26], f[27], f[28], f[29], f[30], f[31]};
            v6u_t p6; asm volatile("s_nop 1\n\tv_cvt_scalef32_2xpk16_fp6_f32 %0, %1, %2, 1.0" : "=&v"(p6) : "v"(lo16), "v"(hi16));
            LAS v2u* dst = (LAS v2u*)(ring + k * 768 + 24 * (lane & 31)); dst[0] = (v2u){p6[0], p6[1]}; dst[1] = (v2u){p6[2], p6[3]}; dst[2] = (v2u){p6[4], p6[5]}; }
        LDS_WAIT(); asm volatile("" ::: "memory");
        TokB X;
#pragma unroll
        for (int m = 0; m < 8; ++m) { const LAS v2u* xp = (const LAS v2u*)(ring + (lane & 7) * 768 + m * 96 + (lane >> 4) * 24);
            const v2u d0 = xp[0], d1 = xp[1], d2 = xp[2];
            X.b[m] = (v8i_t){(int)d0.x, (int)d0.y, (int)d1.x, (int)d1.y, (int)d2.x, (int)d2.y, 0, 0}; }
        LDS_WAIT(); asm volatile("" ::: "memory");
        int n = 0;
        for (int part = 0; part < 8; ++part) {
#pragma unroll
            for (int k = 0; k < 8; ++k) {
                { const bool sel = (id0[k] >> 11) == part; const unsigned long long m = __ballot(sel);
                  const int pos = n + (int)__builtin_amdgcn_mbcnt_hi((unsigned)(m >> 32), __builtin_amdgcn_mbcnt_lo((unsigned)m, 0u));
                  if (sel) list[pos] = ((unsigned)k << 21) | ((unsigned)lane << 14) | (unsigned)id0[k]; n += __builtin_popcountll(m); }
                { const bool sel = (id1[k] >> 11) == part; const unsigned long long m = __ballot(sel);
                  const int pos = n + (int)__builtin_amdgcn_mbcnt_hi((unsigned)(m >> 32), __builtin_amdgcn_mbcnt_lo((unsigned)m, 0u));
                  if (sel) list[pos] = ((unsigned)k << 21) | ((unsigned)(64 + lane) << 14) | (unsigned)id1[k]; n += __builtin_popcountll(m); }
                if (n > PA_CAP - 128) { pa_flush(n, X, lane, list, gl, ring, U6, wpk, tb, nwg); n = 0; }
            }
        }
        pa_flush(n, X, lane, list, gl, ring, U6, wpk, tb, nwg);
    }
}
__device__ __forceinline__ void final_token(int t, int lane, const unsigned short* Y16, float* X1, const float* fg) {
    GAS f32x4* xp = (GAS f32x4*)(X1 + (size_t)t * 1024 + 8 * lane);
    f32x4 x0 = xp[0], x1 = xp[1], x2 = xp[128], x3 = xp[129];
    const v4u ya = *(const GAS v4u*)(Y16 + (size_t)t * 1024 + 8 * lane), yb = *(const GAS v4u*)(Y16 + (size_t)t * 1024 + 512 + 8 * lane);
    const unsigned yw[8] = {ya.x, ya.y, ya.z, ya.w, yb.x, yb.y, yb.z, yb.w};
    float y[16];
#pragma unroll
    for (int i = 0; i < 8; ++i) { const unsigned w = yw[i]; const h2_t h = __builtin_bit_cast(h2_t, w); y[2 * i] = (float)h[0]; y[2 * i + 1] = (float)h[1]; }
    x0 += (f32x4){y[0], y[1], y[2], y[3]}; x1 += (f32x4){y[4], y[5], y[6], y[7]}; x2 += (f32x4){y[8], y[9], y[10], y[11]}; x3 += (f32x4){y[12], y[13], y[14], y[15]};
    float ss = (x0.x * x0.x + x0.y * x0.y) + (x0.z * x0.z + x0.w * x0.w) + (x1.x * x1.x + x1.y * x1.y) + (x1.z * x1.z + x1.w * x1.w)
             + (x2.x * x2.x + x2.y * x2.y) + (x2.z * x2.z + x2.w * x2.w) + (x3.x * x3.x + x3.y * x3.y) + (x3.z * x3.z + x3.w * x3.w);
    const float rstd2 = 1.0f / sqrtf(wave_sum(ss) * (1.f / DMODEL) + RMS_EPS);
    const GAS f32x4* gp = (const GAS f32x4*)(fg + 8 * lane);
    xp[0] = x0 * rstd2 * gp[0]; xp[1] = x1 * rstd2 * gp[1]; xp[128] = x2 * rstd2 * gp[128]; xp[129] = x3 * rstd2 * gp[129];
}
#ifndef REP_0
#define REP_0 1
#endif
#ifndef REP_1
#define REP_1 1
#endif
#ifndef REP_2
#define REP_2 1
#endif
#ifndef REP_3
#define REP_3 1
#endif
#ifndef REP_4
#define REP_4 1
#endif
#ifndef REP_5
#define REP_5 1
#endif
#ifndef REP_6
#define REP_6 1
#endif
#ifndef REP_7
#define REP_7 1
#endif
#ifndef REP_8
#define REP_8 1
#endif
#ifndef REP_9
#define REP_9 1
#endif
#ifndef REP_10
#define REP_10 1
#endif
#ifndef REP_11
#define REP_11 1
#endif
__device__ __forceinline__ void pb_rows(v4u* Ra, v2u* Rb, const v4u w, const unsigned char* vbase, size_t vboff) {
    const unsigned pw[4] = {w.x, w.y, w.z, w.w};
#pragma unroll
    for (int i = 0; i < 4; ++i) { const size_t e = pw[i] & 0xffffu; Ra[i] = *(const GAS v4u*)(vbase + e * 256); Rb[i] = *(const GAS v2u*)(vbase + vboff + e * 128); }
}
__device__ __forceinline__ void pb_fma(h2_t (&acc)[16], const v4u* Ra, const v2u* Rb, const v4u w) {
    const unsigned pw[4] = {w.x, w.y, w.z, w.w};
#pragma unroll
    for (int i = 0; i < 4; ++i) { const unsigned p = pw[i]; const h2_t pp = __builtin_bit_cast(h2_t, p); const _Float16 wv = pp[1]; const h2_t w2 = {wv, wv};
        const v4u ra = Ra[i]; const v2u rb = Rb[i]; const v6u_t x6 = {ra.x, ra.y, ra.z, ra.w, rb.x, rb.y};
        v32h_t h; asm("v_cvt_scalef32_pk32_f16_fp6 %0, %1, 1.0" : "=&v"(h) : "v"(x6));
#pragma unroll
        for (int j = 0; j < 16; ++j) { const h2_t hv = {h[2 * j], h[2 * j + 1]}; acc[j] = __builtin_elementwise_fma(hv, w2, acc[j]); } }
}
__device__ __forceinline__ void peer_b_phase(int lane, int wave, int G, int vcu, const unsigned char* V6s, const unsigned* wpk, unsigned short* Y16, float* X1, const float* fg, bool fin) {
    const int q = lane & 15;
    for (int tile0 = vcu; tile0 < MTOK / 32; tile0 += 2 * G) {
        const int tile1 = tile0 + G; const bool has1 = tile1 < MTOK / 32;
        const int tb = tile0 * 32 + wave * 4, nwg = (has1 ? tile1 : tile0) * 32 + wave * 4;
        for (int pass = 0; pass < 4; ++pass) { const int hc = pass >> 1, k = (lane >> 4) + 4 * (pass & 1);
            const int t = pa_tok((unsigned)k, tb, nwg);
            const unsigned* wrow = wpk + (size_t)t * 128;
            const unsigned char* vbase = V6s + (size_t)hc * NEXP * 256 + q * 16;
            const size_t vboff = V6B_OFF + (size_t)hc * NEXP * 128 + q * 8 - ((size_t)hc * NEXP * 256 + q * 16);
            h2_t acc[16];
#pragma unroll
            for (int j = 0; j < 16; ++j) acc[j] = (h2_t){(_Float16)0.f, (_Float16)0.f};
            v4u W[6], Ra[16]; v2u Rb[16];
#pragma unroll
            for (int u = 0; u < 6; ++u) W[u] = *(const GAS v4u*)(wrow + 4 * u);
#pragma unroll
            for (int u = 0; u < 4; ++u) pb_rows(Ra + 4 * u, Rb + 4 * u, W[u], vbase, vboff);
#pragma unroll
            for (int u = 0; u < 32; ++u) {
                pb_fma(acc, Ra + 4 * (u & 3), Rb + 4 * (u & 3), W[u % 6]);
                if (u + 4 < 32) pb_rows(Ra + 4 * (u & 3), Rb + 4 * (u & 3), W[(u + 4) % 6], vbase, vboff);
                if (u + 6 < 32) W[u % 6] = *(const GAS v4u*)(wrow + 4 * (u + 6));
            }
            GAS v4u* yout = (GAS v4u*)(Y16 + (size_t)t * 1024 + hc * 512 + q * 32);
#pragma unroll
            for (int j = 0; j < 4; ++j) yout[j] = (v4u){__builtin_bit_cast(unsigned, acc[4 * j]), __builtin_bit_cast(unsigned, acc[4 * j + 1]), __builtin_bit_cast(unsigned, acc[4 * j + 2]), __builtin_bit_cast(unsigned, acc[4 * j + 3])};
        }
        asm volatile("s_waitcnt vmcnt(0)" ::: "memory");
        if (fin) for (int kk = 0; kk < (has1 ? 8 : 4); ++kk) final_token(pa_tok((unsigned)kk, tb, nwg), lane, Y16, X1, fg);
    }
}
template <int NR> __device__ __forceinline__ void cvt_load(f32x4 (&q)[NR / 2][8], const float* table, int ex, int stride, int lane) {
#pragma unroll
    for (int k = 0; k < NR / 2; ++k) { const int e = ex + (2 * k + (lane >> 5)) * stride; const float* src = table + (size_t)(e < NEXP ? e : ex) * 1024 + 32 * (lane & 31);
#pragma unroll
        for (int j = 0; j < 8; ++j) q[k][j] = *(const GAS f32x4*)(src + 4 * j); }
}
template <int NR> __device__ __forceinline__ void cvt_store(const f32x4 (&q)[NR / 2][8], int ex, int stride, bool isv, int lane, unsigned char* U8, unsigned char* V8) {
    typedef float v16f_t __attribute__((ext_vector_type(16)));
#pragma unroll
    for (int k = 0; k < NR / 2; ++k) { const int e = ex + (2 * k + (lane >> 5)) * stride; if (e < NEXP) {
        if (!isv) {
            float f[32];
#pragma unroll
            for (int j = 0; j < 8; ++j) { const f32x4 t = q[k][j] * U8_SCALE; f[4 * j] = t.x; f[4 * j + 1] = t.y; f[4 * j + 2] = t.z; f[4 * j + 3] = t.w; }
            const v16f_t lo16 = {f[0], f[1], f[2], f[3], f[4], f[5], f[6], f[7], f[8], f[9], f[10], f[11], f[12], f[13], f[14], f[15]},
                         hi16 = {f[16], f[17], f[18], f[19], f[20], f[21], f[22], f[23], f[24], f[25], f[26], f[27], f[28], f[29], f[30], f[31]};
            v6u_t p6; asm volatile("s_nop 1\n\tv_cvt_scalef32_2xpk16_fp6_f32 %0, %1, %2, 1.0" : "=&v"(p6) : "v"(lo16), "v"(hi16));
            GAS v2u* dst = (GAS v2u*)(U8 + (size_t)e * 768 + 24 * (lane & 31)); dst[0] = (v2u){p6[0], p6[1]}; dst[1] = (v2u){p6[2], p6[3]}; dst[2] = (v2u){p6[4], p6[5]};
        } else {
            v32h_t h;
#pragma unroll
            for (int j = 0; j < 8; ++j) { const f32x4 t = q[k][j] * V8_SCALE; h[4 * j] = (_Float16)t.x; h[4 * j + 1] = (_Float16)t.y; h[4 * j + 2] = (_Float16)t.z; h[4 * j + 3] = (_Float16)t.w; }
            v6u_t p6; asm volatile("s_nop 1\n\tv_cvt_scalef32_pk32_fp6_f16 %0, %1, 1.0" : "=&v"(p6) : "v"(h));
            const size_t ro = (size_t)((lane & 31) >> 4) * NEXP + e;
            *(GAS v4u*)(V8 + ro * 256 + (lane & 15) * 16) = (v4u){p6[0], p6[1], p6[2], p6[3]}; *(GAS v2u*)(V8 + V6B_OFF + ro * 128 + (lane & 15) * 8) = (v2u){p6[4], p6[5]}; } } }
}
struct OnePanel { int pm, n; __device__ __forceinline__ bool next(int i, pg8::Unit& u) const { if (i >= n) return false; u.pm = pm; u.pn = i; u.w = 0; return true; } };
struct DualOrder { pg8::StaticOrder S; __device__ __forceinline__ bool next(int i, pg8::Unit& u) const { if (!S.next(i >> 1, u)) return false; u.w = i & 1; return true; } };
struct Args { const float* in[24]; float* out; unsigned char* ws; int ph_lo, ph_hi, li, pad; };
__global__ void __launch_bounds__(NWAVES * 64, 2) mk_fwd(Args args) {
    extern __shared__ __attribute__((aligned(16))) unsigned char lds[];
    Frame F;
    F.lds = (LAS unsigned char*)lds;
    volatile LAS unsigned* MISC = (volatile LAS unsigned*)(F.lds + MISC_OFF);
    F.tid = threadIdx.x; F.lane = F.tid & 63; F.wave = __builtin_amdgcn_readfirstlane(F.tid >> 6);
    F.G = gridDim.x; { const int bx = blockIdx.x; F.vcu = (F.G % 8 == 0) ? (bx % 8) * (F.G / 8) + bx / 8 : bx; }
    unsigned char* ws = args.ws;
    gu32* ctl = (gu32*)(ws + WS_CTL);
    for (int u = F.tid; u < (LDS_BYTES - LDSCTL_OFF) / 4; u += NWAVES * 64) ((LAS unsigned*)(F.lds + LDSCTL_OFF))[u] = 0u;
    __syncthreads();
    XcdBarrier bar; bar.bar = (unsigned*)(ctl + CW_BAR); bar.x = 0; bar.st = nullptr;
    if (N_LAUNCHES != PER_PHASE) bar = xcd_barrier_post((unsigned*)(ctl + CW_BAR), MISC + 8);
#define GRID_BAR() do { if (N_LAUNCHES != PER_PHASE) xcd_barrier(bar); } while (0)
    const int lo = args.ph_lo, hi = args.ph_hi;
#ifndef PH_MASK
#define PH_MASK 0xFFFF
#endif
#define IN(k) ((((PH_MASK) >> (k)) & 1) && lo <= (k) && (k) < hi)
#define BOTH(k) (IN(k) && IN((k) + 1))
    const int gw = F.vcu * NWAVES + F.wave, NGW = F.G * NWAVES;
    const int gtid = F.vcu * (NWAVES * 64) + F.tid, NTHR = F.G * NWAVES * 64;
    const float* x = args.in[0];
    bf16* Win_t = (bf16*)(ws + WS_WIN); bf16* Wq_t = (bf16*)(ws + WS_WQ); bf16* Wout_t = (bf16*)(ws + WS_WOUT); bf16* Wus_t = (bf16*)(ws + WS_WUS); bf16* Wua_t = (bf16*)(ws + WS_WUA);
    bf16* Wglu_t = (bf16*)(ws + WS_WGLU); bf16* KSb = (bf16*)(ws + WS_KS); bf16* WE = (bf16*)(ws + WS_WE); bf16* BP = (bf16*)(ws + WS_BP); bf16* AP = (bf16*)(ws + WS_AP);
    float* Eb = (float*)(ws + WS_E); bf16* Hb = (bf16*)(ws + WS_H); bf16* Ypre = (bf16*)(ws + WS_YPRE); bf16* Ya = (bf16*)(ws + WS_YA); bf16* XG = (bf16*)(ws + WS_XG);
    bf16* Zb = (bf16*)(ws + WS_Z); bf16* Qb = (bf16*)(ws + WS_Z + 1 * ZSTRIDE_B); bf16* Kb = (bf16*)(ws + WS_Z + 2 * ZSTRIDE_B); bf16* Vb = (bf16*)(ws + WS_Z + 3 * ZSTRIDE_B);
    bf16* GA = (bf16*)(ws + WS_Z + 4 * ZSTRIDE_B); bf16* GB = (bf16*)(ws + WS_Z + 6 * ZSTRIDE_B);
    bf16* Yb = (bf16*)(ws + WS_YB); bf16* Mrg = (bf16*)(ws + WS_MRG); bf16* PQb = (bf16*)(ws + WS_PQ); int* ids = (int*)(ws + WS_IDS); float* gts = (float*)(ws + WS_GTS);
    unsigned char* U8 = ws + WS_U16; unsigned char* V8 = ws + WS_V16; unsigned* wpk = (unsigned*)(ws + WS_WPK); float* rstd1 = (float*)(ws + WS_RSTD1); unsigned short* Y16 = (unsigned short*)(ws + WS_Y16);
    float* biasT = (float*)(ws + WS_BIAS); float* pw32 = (float*)(ws + WS_PW32); float* kpart = (float*)(ws + WS_KPART); float* Kg = (float*)(ws + WS_KG); float* ssq1 = (float*)(ws + WS_SSQ1);

    if (IN(0)) for (int rep_ = 0; rep_ < REP_0; ++rep_) {
        LAS float* scr = (LAS float*)(F.lds + RING_OFF + F.wave * 16384);
        constexpr int I_IN = (1024 / 64) * (4096 / 32), I_GLU = (512 / 64) * (512 / 32), I_UP = (512 / 64) * (1024 / 32), I_OUT = (1024 / 64) * (1024 / 32), I_Q = (1024 / 64) * (2048 / 32);
        constexpr int NITEMS = I_IN + I_GLU + 2 * I_UP + I_OUT + I_Q;
        for (int it = gw; it < NITEMS; it += NGW) {
            int r = it;
            if (r < I_IN) { p0_transpose_item(args.in[2], 1024, 4096, Win_t, scr, r, F.lane); continue; } r -= I_IN;
            if (r < I_GLU) { p0_transpose_item(args.in[11], 512, 512, Wglu_t, scr, r, F.lane); continue; } r -= I_GLU;
            if (r < I_UP) { p0_transpose_item(args.in[13], 512, 1024, Wus_t, scr, r, F.lane); continue; } r -= I_UP;
            if (r < I_UP) { p0_transpose_item(args.in[14], 512, 1024, Wua_t, scr, r, F.lane); continue; } r -= I_UP;
            if (r < I_OUT) { p0_transpose_item(args.in[16], 1024, 1024, Wout_t, scr, r, F.lane); continue; } r -= I_OUT;
            p0_transpose_item(args.in[18], 1024, 2048, Wq_t, scr, r, F.lane);
        }
        for (int it = gw; it < NGRP * CH; it += NGW)
            ssm_table_task(it >> 5, it & 31, F.lane, scr, args.in[3], args.in[4], args.in[5], args.in[6], args.in[7], args.in[8], args.in[9], Kg, WE, BP, pw32);
        for (int m = gw; m < MTOK; m += NGW * 4) rms_rows4_to_bf16(x, args.in[1], Hb, m, NGW, F.lane);
        for (int it = gw; it < 64; it += NGW) { const float* src = (it < 32 ? args.in[19] : args.in[20]) + (size_t)(it & 31) * 512 + 8 * F.lane;
            const f32x4 a = *(const GAS f32x4*)src, b = *(const GAS f32x4*)(src + 4);
            *(GAS v4u*)(KSb + (size_t)it * 512 + 8 * F.lane) = (v4u){pk2(a.x, a.y), pk2(a.z, a.w), pk2(b.x, b.y), pk2(b.z, b.w)}; }
        if (gw == 0) { for (int i = F.lane; i < 8 * 128; i += 64) { const int h = i >> 7, rel = i & 127; int bk;
                if (rel < 16) bk = rel; else { const float lg = logf((float)rel / 16.0f) / 2.0794415416798357f * 16.0f; bk = 16 + (int)lg; bk = bk < 0 ? 0 : (bk > 31 ? 31 : bk); }
                biasT[i] = (args.in[15][bk * 8 + h] - args.in[15][31 * 8 + h]) * 1.4426950408889634f; } }
        if (BOTH(0)) GRID_BAR();
    }

    if (IN(1)) for (int rep_ = 0; rep_ < REP_1; ++rep_) {
        const float* Dsk = args.in[10];
        for (int i0 = gtid; i0 < NGRP * 512 * 64; i0 += NTHR * 4) {
            f32x4 ka[4], kb[4];
#pragma unroll
            for (int q = 0; q < 4; ++q) { const int i = i0 + q * NTHR; const int ic = (i < NGRP * 512 * 64) ? i : i0; const int g = ic >> 15, m = (ic >> 6) & 511, k8 = ic & 63, j = m >> 4, ho = m & 15, jp = k8 >> 1, hi0 = (k8 & 1) * 8;
                const int lag = (jp <= j) ? j - jp : 0; const float* kp = Kg + ((size_t)(g * 32 + lag) * 256 + ho * 16 + hi0); ka[q] = *(const GAS f32x4*)kp; kb[q] = *(const GAS f32x4*)(kp + 4); }
#pragma unroll
            for (int q = 0; q < 4; ++q) { const int i = i0 + q * NTHR; if (i >= NGRP * 512 * 64) break; const int g = i >> 15, m = (i >> 6) & 511, k8 = i & 63, j = m >> 4, ho = m & 15, jp = k8 >> 1, hi0 = (k8 & 1) * 8;
                v4u o = (v4u){0u, 0u, 0u, 0u};
                if (jp <= j) { f32x4 a = ka[q], b = kb[q];
                    if (jp == j && (ho >> 3) == (hi0 >> 3)) { const float dv = Dsk[g * 16 + ho]; const int e = ho & 7;
                        a.x += (e == 0) ? dv : 0.f; a.y += (e == 1) ? dv : 0.f; a.z += (e == 2) ? dv : 0.f; a.w += (e == 3) ? dv : 0.f;
                        b.x += (e == 4) ? dv : 0.f; b.y += (e == 5) ? dv : 0.f; b.z += (e == 6) ? dv : 0.f; b.w += (e == 7) ? dv : 0.f; }
                    o = (v4u){pk2(a.x, a.y), pk2(a.z, a.w), pk2(b.x, b.y), pk2(b.z, b.w)}; }
                *(GAS v4u*)(BP + ((size_t)(g * 512 + m) * APK + k8 * 8)) = o; } }
        pg8::Gemm g{Hb, Win_t, MTOK, INCOLS, 1024, 1024, 1024, 1 << 30, 0};
        pg8::StaticOrder S; S.init(MTOK, INCOLS, F.G, (int)blockIdx.x);
        pg8::EpiIn E{Zb, AP, kpart};
        pg8::gemm_phase<pg8::EpiIn, pg8::StaticOrder, true>(F.lds + RING_OFF, g, S, E);
        if (BOTH(1)) GRID_BAR();
    }

    if (IN(2)) for (int rep_ = 0; rep_ < REP_2; ++rep_) {
        const int bx = (int)blockIdx.x;
        const bool shared = F.G < 4;
        const int nS = shared ? F.G : (F.G >= 256 ? 64 : F.G / 4), nA = shared ? F.G : F.G - nS;
        const bool inS = shared || bx < nS, inA = shared || bx >= nS; const int aidx = shared ? bx : bx - nS;
        if (inS) {
#pragma unroll 1
            for (int pm = bx; pm < MTOK / 256; pm += nS) {
                { pg8::Gemm g1{AP, WE, MTOK, 256, 512, APK, 512, 2, (size_t)256 * 512}; OnePanel S1{pm, 1}; pg8::EpiE E1{Eb};
                  pg8::gemm_phase<pg8::EpiE, OnePanel, true>(F.lds + RING_OFF, g1, S1, E1); }
                VM_WAIT(); __syncthreads();
                if (F.tid < 256) { const int gb = (pm >> 1) * 8 + (pm & 1) * 4 + (F.tid >> 6), g_ = gb >> 3, p = F.tid & 63; const size_t row0 = (size_t)gb * 64;
                    const float mr = pw32[g_ * 128 + p], mi = pw32[g_ * 128 + 64 + p]; float sr = 0.f, si = 0.f;
#pragma unroll 1
                    for (int c0 = 0; c0 < NCHUNK; c0 += 32) { float er[32], ei[32];
#pragma unroll
                        for (int c = 0; c < 32; ++c) { er[c] = Eb[(row0 + c0 + c) * 128 + p]; ei[c] = Eb[(row0 + c0 + c) * 128 + 64 + p]; }
#pragma unroll
                        for (int c = 0; c < 32; ++c) { bf16* ap = AP + (row0 + c0 + c) * APK + 512; ap[p] = (bf16)f2bf(sr); ap[64 + p] = (bf16)f2bf(si);
                            const float nr = mr * sr - mi * si + er[c], ni = mr * si + mi * sr + ei[c]; sr = nr; si = ni; } } }
                VM_WAIT(); __syncthreads();
                { pg8::Gemm g{AP, BP, MTOK, 512, APK, APK, APK, 2, (size_t)512 * APK}; OnePanel S3{pm, 2}; pg8::EpiY E{Ypre};
                  pg8::gemm_phase<pg8::EpiY, OnePanel, true>(F.lds + RING_OFF, g, S3, E); }
            }
        }
        if (inA) {
            static_assert(attn_body::ATTN_LDS_BYTES <= RING_BYTES, "attention LDS");
#pragma unroll 1
            for (int a = aidx; a < 192; a += nA) { const int ty = a >> 6, bh = a & 63;
#pragma unroll 1
                for (int i = 0; i < 4; ++i) { const int qb = (ty == 0) ? (i == 0 ? 7 : (i == 1 ? 2 : (i == 2 ? 0 : -1))) : (ty == 1) ? (i == 0 ? 6 : (i == 1 ? 4 : -1)) : (i == 0 ? 5 : (i == 1 ? 3 : (i == 2 ? 1 : -1)));
                    if (qb < 0) break;
                    attn_body::attn_unit<8>(bh >> 3, bh & 7, qb, (const attn_body::bf16*)Qb, (const attn_body::bf16*)Kb, (const attn_body::bf16*)Vb, (attn_body::bf16*)Yb, (char*)lds + RING_OFF, kpart, biasT); } }
        }
        if (BOTH(2)) GRID_BAR();
    }

    if (IN(3)) for (int rep_ = 0; rep_ < REP_3; ++rep_) {
        pg8::Gemm g{Ypre, Wglu_t, MTOK, 512, 512, 512, 512, 1 << 30, 0};
        pg8::StaticOrder S; S.init(MTOK, 512, F.G, (int)blockIdx.x);
        pg8::EpiGlu E{Ypre, Ya, args.in[12]};
        pg8::gemm_phase<pg8::EpiGlu, pg8::StaticOrder, true>(F.lds + RING_OFF, g, S, E);
        { const int nun = (MTOK / 256) * (512 / 256);
          const bool split = F.G >= 2 * nun; const int nconv = split ? nun : F.G, cidx = split ? ((int)blockIdx.x % nun) : (int)blockIdx.x;
          const int stride = nconv * NWAVES, step = stride * 4, ex0 = cidx * NWAVES + F.wave;
          const int ncall = (NEXP - ex0 + step - 1) / step;
          int c_lo = 0, c_hi = 2 * ncall;
          if (split) { const int cut = (2 * ncall * 3) / 4; if ((int)blockIdx.x < nun) c_lo = cut; else if ((int)blockIdx.x < 2 * nun) c_hi = cut; else c_hi = 0; }
          f32x4 qa[2][8], qb[2][8];
#define CV_TAB(c) ((c) < ncall ? args.in[21] : args.in[22])
#define CV_EX(c) (ex0 + ((c) < ncall ? (c) : (c) - ncall) * step)
          if (c_lo < c_hi) cvt_load<4>(qa, CV_TAB(c_lo), CV_EX(c_lo), stride, F.lane);
          for (int c = c_lo; c < c_hi; c += 2) {
              if (c + 1 < c_hi) cvt_load<4>(qb, CV_TAB(c + 1), CV_EX(c + 1), stride, F.lane);
              cvt_store<4>(qa, CV_EX(c), stride, c >= ncall, F.lane, U8, V8);
              if (c + 2 < c_hi) cvt_load<4>(qa, CV_TAB(c + 2), CV_EX(c + 2), stride, F.lane);
              if (c + 1 < c_hi) cvt_store<4>(qb, CV_EX(c + 1), stride, c + 1 >= ncall, F.lane, U8, V8);
          } }
#undef CV_TAB
#undef CV_EX
        if (BOTH(3)) GRID_BAR();
    }

    if (IN(4)) for (int rep_ = 0; rep_ < REP_4; ++rep_) {
        pg8::Gemm g{Ya, Wus_t, MTOK, 1024, 512, 512, 512, 1 << 30, 0, Yb, Wua_t};
        DualOrder S; S.S.init(MTOK, 1024, F.G, (int)blockIdx.x);
        pg8::EpiMrgDual E{pg8::EpiMrg<0>{GA, Mrg}, pg8::EpiMrg<1>{GB, Mrg}};
        pg8::gemm_phase<pg8::EpiMrgDual, DualOrder, true>(F.lds + RING_OFF, g, S, E);
        if (BOTH(4)) GRID_BAR();
    }

    if (IN(5)) for (int rep_ = 0; rep_ < REP_5; ++rep_) {
        pg8::Gemm g{Mrg, Wout_t, MTOK, 1024, 1024, 1024, 1024, 1 << 30, 0}; pg8::StaticOrder S; S.init(MTOK, 1024, F.G, (int)blockIdx.x);
        pg8::EpiX1 E{x, args.out, XG, args.in[17], ssq1};
        pg8::gemm_phase<pg8::EpiX1, pg8::StaticOrder, true>(F.lds + RING_OFF, g, S, E);
        if (BOTH(5)) GRID_BAR();
    }

    if (IN(6)) for (int rep_ = 0; rep_ < REP_6; ++rep_) {
        pg8::Gemm g{XG, Wq_t, MTOK, PQ, 1024, 1024, 1024, 1 << 30, 0}; pg8::StaticOrder S; S.init(MTOK, PQ, F.G, (int)blockIdx.x);
        pg8::EpiPlain E{PQb, PQ};
        pg8::gemm_phase<pg8::EpiPlain, pg8::StaticOrder, true>(F.lds + RING_OFF, g, S, E);
        if (BOTH(6)) GRID_BAR();
    }

    if (IN(7)) for (int rep_ = 0; rep_ < REP_7; ++rep_) {
        LAS unsigned char* scr = F.lds + RING_OFF + F.wave * 2048;
        LAS unsigned char* ksl = F.lds + RING_OFF + 16384;
        for (int c = F.tid; c < 256 * 16; c += NWAVES * 64) { const int row = c >> 4, ch = c & 15; *(LAS v4u*)(ksl + row * 256 + ((ch ^ (row & 15)) << 4)) = *(const GAS v4u*)(KSb + row * 128 + ch * 8); }
        __syncthreads();
        for (int it = gw; it < (MTOK / 32) * 8; it += NGW) topk_task(it >> 3, it & 7, F.lane, scr, PQb, ksl, ssq1, ids, gts, rstd1);
        if (BOTH(7)) { VM_WAIT(); __syncthreads(); }
    }

    if (IN(8)) for (int rep_ = 0; rep_ < REP_8; ++rep_) {
        peer_a_phase(F.lane, F.wave, F.G, F.vcu, XG, U8, ids, gts, rstd1, wpk, F.lds, 0xffff);
        if (BOTH(8)) VM_WAIT();
    }
    if (IN(9)) for (int rep_ = 0; rep_ < REP_9; ++rep_) {
        peer_b_phase(F.lane, F.wave, F.G, F.vcu, V8, wpk, Y16, args.out, args.in[23], rep_ == REP_9 - 1);
    }
#undef IN
#undef BOTH
#undef GRID_BAR
}

extern "C" void kernel_launch(void* const* d_in, const int* in_sizes, int n_in, void* d_out, int out_size, void* d_ws, size_t ws_size, hipStream_t stream) {
    static int grid = 0;
    if (grid == 0) {
        if (n_in != 24 || in_sizes[0] != MTOK * DMODEL || out_size != MTOK * DMODEL || ws_size < WS_END) { fprintf(stderr, "kernel_launch: unexpected shapes (n_in %d, in0 %d, out %d, ws %zu); nothing launched\n", n_in, n_in > 0 ? in_sizes[0] : -1, out_size, ws_size); grid = -1; return; }
        int dev = 0, cus = 0, per_cu = 0;
        if (hipGetDevice(&dev) != hipSuccess || hipDeviceGetAttribute(&cus, hipDeviceAttributeMultiprocessorCount, dev) != hipSuccess) { grid = -1; return; }
        if (hipFuncSetAttribute((const void*)mk_fwd, hipFuncAttributeMaxDynamicSharedMemorySize, LDS_BYTES) != hipSuccess) { fprintf(stderr, "kernel_launch: hipFuncSetAttribute failed\n"); grid = -1; return; }
        if (hipOccupancyMaxActiveBlocksPerMultiprocessor(&per_cu, (const void*)mk_fwd, NWAVES * 64, LDS_BYTES) != hipSuccess || per_cu < 1) { fprintf(stderr, "kernel_launch: occupancy query says %d blocks per CU\n", per_cu); }
        (void)hipGetLastError();
        grid = cus;
    }
    if (grid < 0) return;
    if (N_LAUNCHES != PER_PHASE) { if (hipMemsetAsync((char*)d_ws + WS_CTL, 0, CTL_ZERO_BYTES, stream) != hipSuccess) return; }
    Args a{};
    for (int i = 0; i < 24; ++i) a.in[i] = (const float*)d_in[i];
    a.out = (float*)d_out; a.ws = (unsigned char*)d_ws; a.pad = 0;
    if (N_LAUNCHES == PER_PHASE) {
        for (int li = 0; li < PER_PHASE; ++li) { a.ph_lo = li; a.ph_hi = li + 1; a.li = li; hipLaunchKernelGGL(mk_fwd, dim3(grid), dim3(NWAVES * 64), LDS_BYTES, stream, a); }
    } else {
        a.ph_lo = 0; a.ph_hi = PER_PHASE; a.li = 0;
        hipLaunchKernelGGL(mk_fwd, dim3(grid), dim3(NWAVES * 64), LDS_BYTES, stream, a);
    }
}
```

```cpp
#include <hip/hip_runtime.h>
#include <hip/hip_bf16.h>
#include <cstdio>
#include <cstdint>
#include <cmath>

#ifndef MK_N_LAUNCHES
#define MK_N_LAUNCHES 1
#endif

namespace pg8 {
#define PG8_LAS __attribute__((address_space(3)))
typedef unsigned short bf16_t;
typedef short bf16x8 __attribute__((ext_vector_type(8)));
typedef float f32x4 __attribute__((ext_vector_type(4)));
typedef unsigned u32x4 __attribute__((ext_vector_type(4)));
constexpr int BM = 256, BK = 64, HALF = 128, HTB = HALF * BK * 2, STAGE_BYTES = 8 * HTB, NXCD = 8, WGM = 8;

__host__ __device__ __forceinline__ int lds_byte(int r, int c) { const int st = (r >> 4) * 2 + (c >> 5), rr = r & 15, cc = c & 31, ob = rr * 64 + cc * 2; return st * 1024 + (ob ^ (((ob >> 9) & 1) << 5)); }
__host__ __device__ __forceinline__ void stage_rc(int b, int& R, int& C) { const int st = b / 1024, sb = b % 1024, swz = sb ^ (((sb >> 9) & 1) << 5); R = (st >> 1) * 16 + swz / 64; C = (st & 1) * 32 + (swz % 64) / 2; }
__host__ __device__ __forceinline__ int perm32(int rho) { const int n = rho >> 4, i = rho & 15; return 8 * (i >> 2) + 4 * n + (i & 3); }

struct Unit { int pm, pn, w; };
struct Gemm { const bf16_t* A; const bf16_t* Bt; int M, N, K, lda, ldb, rpg; size_t bgs; const bf16_t* A2 = nullptr; const bf16_t* Bt2 = nullptr; };

struct StaticOrder {
    int nM, nN, nwg, G, c;
    __host__ __device__ __forceinline__ void init(int M, int N, int G_, int c_) { nM = M / BM; nN = N / BM; nwg = nM * nN; G = G_; c = c_; }
    __host__ __device__ __forceinline__ bool next(int i, Unit& u) const {
        const long L = (long)i * G + c; if (L >= nwg) return false;
        int wgid = (int)L; { const int q = nwg / NXCD, r = nwg % NXCD, xcd = wgid % NXCD, off = wgid / NXCD; wgid = (xcd < r ? xcd * (q + 1) : r * (q + 1) + (xcd - r) * q) + off; }
        const int nig = WGM * nN, gid = wgid / nig, fm = gid * WGM, gsz = (nM - fm) < WGM ? (nM - fm) : WGM;
        u.pm = fm + ((wgid % nig) % gsz); u.pn = (wgid % nig) / gsz; u.w = 0; return true;
    }
};

__device__ __forceinline__ unsigned cvt_pk_bf16(float lo, float hi) { unsigned r; asm volatile("v_cvt_pk_bf16_f32 %0, %1, %2" : "=v"(r) : "v"(lo), "v"(hi)); return r; }
__device__ __forceinline__ float bf_lo(unsigned w) { return __uint_as_float(w << 16); }
__device__ __forceinline__ float bf_hi(unsigned w) { return __uint_as_float(w & 0xffff0000u); }
__device__ __forceinline__ float sigmoid_f(float x) { return __builtin_amdgcn_rcpf(1.0f + __builtin_amdgcn_exp2f(-1.4426950409f * x)); }
__device__ __forceinline__ float gelu_tanh(float x) { const float u = x + 0.044715f * x * x * x; return x * __builtin_amdgcn_rcpf(1.0f + __builtin_amdgcn_exp2f(-2.3022081985f * u)); }

template <class Epi, class Sched, bool ALIGN_EPI>
__device__ __forceinline__ void gemm_phase(PG8_LAS unsigned char* lds, const Gemm g, const Sched& S, const Epi& E) {
    int tid = threadIdx.x; asm volatile("" : "+v"(tid));
    const int wid = __builtin_amdgcn_readfirstlane(tid >> 6), lane = tid & 63, wr = wid >> 2, wc = wid & 3, fr = lane & 15, fq = lane >> 4;
    const int K = g.K, nt = K / BK;
    unsigned voffA[2], voffB[2];
#pragma unroll
    for (int i = 0; i < 2; ++i) { int R, C; stage_rc(tid * 16 + i * 8192, R, C); const int Rb = Epi::PERM ? ((R & ~31) + perm32(R & 31)) : R;
        voffA[i] = (unsigned)(R * g.lda + C) * 2u; voffB[i] = (unsigned)(Rb * g.ldb + C) * 2u; }
    const size_t kstep = (size_t)(BK * 2);
    const size_t hstepA = (size_t)HALF * g.lda * 2, hstepB = (size_t)HALF * g.ldb * 2;
    const size_t tstepA = 2 * hstepA, tstepB = 2 * hstepB;
    const unsigned ldsw = (unsigned)wid * 1024u;
    const int aoff = lds_byte(wr * 64 + fr, fq * 8), boff = lds_byte(wc * 32 + fr, fq * 8);
#define PG8_SA(b, h) (((b) * 2 + (h)) * HTB)
#define PG8_SB(b, h) ((4 + (b) * 2 + (h)) * HTB)
#define PG8_STAGE(bufoff, gbase, voff) do { _Pragma("unroll") for (int _i = 0; _i < 2; ++_i) \
        __builtin_amdgcn_global_load_lds((const unsigned*)((const char*)(gbase) + (voff)[_i]), (PG8_LAS unsigned*)(lds + (bufoff) + ldsw + _i * 8192), 16, 0, 0); } while (0)
#define PG8_LDA(dst, b, h) do { _Pragma("unroll") for (int m = 0; m < 4; ++m) _Pragma("unroll") for (int k = 0; k < 2; ++k) dst[m][k] = *(const PG8_LAS bf16x8*)(lds + PG8_SA(b, h) + aoff + m * 2048 + k * 1024); } while (0)
#define PG8_LDB(dst, b, h) do { _Pragma("unroll") for (int n = 0; n < 2; ++n) _Pragma("unroll") for (int k = 0; k < 2; ++k) dst[n][k] = *(const PG8_LAS bf16x8*)(lds + PG8_SB(b, h) + boff + n * 2048 + k * 1024); } while (0)
#define PG8_MMA(ai, bj, At, Bt) do { __builtin_amdgcn_s_setprio(1); _Pragma("unroll") for (int m = 0; m < 4; ++m) _Pragma("unroll") for (int n = 0; n < 2; ++n) _Pragma("unroll") for (int k = 0; k < 2; ++k) \
        acc[ai][bj][m][n] = __builtin_amdgcn_mfma_f32_16x16x32_bf16(Bt[n][k], At[m][k], acc[ai][bj][m][n], 0, 0, 0); __builtin_amdgcn_s_setprio(0); } while (0)
#define PG8_WAIT_V(n) asm volatile("s_waitcnt vmcnt(" #n ")" ::: "memory")
#define PG8_WAIT_L(n) asm volatile("s_waitcnt lgkmcnt(" #n ")" ::: "memory")
#define PG8_BAR __builtin_amdgcn_s_barrier()
#define PG8_SCHED __builtin_amdgcn_sched_barrier(0)
    Unit cur, nxt; int ui = 0;
    if (!S.next(0, cur)) return;
    f32x4 acc[2][2][4][2];
#pragma unroll
    for (int a = 0; a < 2; ++a)
#pragma unroll
        for (int b = 0; b < 2; ++b)
#pragma unroll
            for (int m = 0; m < 4; ++m)
#pragma unroll
                for (int n = 0; n < 2; ++n) acc[a][b][m][n] = (f32x4){0.f, 0.f, 0.f, 0.f};
    bf16x8 At[4][2], B0[2][2], B1[2][2];
    const char* cA = (const char*)(cur.w ? g.A2 : g.A) + (size_t)cur.pm * tstepA;
    const char* cB = (const char*)(cur.w ? g.Bt2 : g.Bt) + (size_t)(cur.pm / g.rpg) * g.bgs * 2 + (size_t)cur.pn * tstepB;
    PG8_STAGE(PG8_SB(0, 0), cB, voffB); PG8_STAGE(PG8_SB(0, 1), cB + hstepB, voffB); PG8_STAGE(PG8_SA(0, 0), cA, voffA); PG8_STAGE(PG8_SA(0, 1), cA + hstepA, voffA);
    if (wr == 1) PG8_BAR;
    PG8_WAIT_V(2); PG8_BAR;
    PG8_STAGE(PG8_SB(1, 0), cB + kstep, voffB); PG8_STAGE(PG8_SA(1, 0), cA + kstep, voffA); PG8_STAGE(PG8_SB(1, 1), cB + hstepB + kstep, voffB);
    PG8_WAIT_V(6); PG8_BAR;
    for (;;) {
        const bool has_next = S.next(ui + 1, nxt);
        const char* nA = has_next ? (const char*)(nxt.w ? g.A2 : g.A) + (size_t)nxt.pm * tstepA : cA;
        const char* nB = has_next ? (const char*)(nxt.w ? g.Bt2 : g.Bt) + (size_t)(nxt.pm / g.rpg) * g.bgs * 2 + (size_t)nxt.pn * tstepB : cB;
        for (int t = 0; t < nt; t += 2) {
            const bool last = (t == nt - 2);
            const char* a1 = cA + (size_t)(t + 1) * kstep;
            const char* a2 = last ? nA : cA + (size_t)(t + 2) * kstep; const char* b2 = last ? nB : cB + (size_t)(t + 2) * kstep;
            const char* a3 = a2 + kstep; const char* b3 = b2 + kstep;
            PG8_LDB(B0, 0, 0); PG8_LDB(B1, 0, 1); PG8_SCHED; PG8_LDA(At, 0, 0); PG8_STAGE(PG8_SA(1, 1), a1 + hstepA, voffA);
            PG8_WAIT_V(8); PG8_WAIT_L(0); PG8_BAR; PG8_MMA(0, 0, At, B0); PG8_MMA(0, 1, At, B1); PG8_BAR; PG8_SCHED;
            PG8_LDA(At, 0, 1); PG8_STAGE(PG8_SB(0, 0), b2, voffB); PG8_STAGE(PG8_SB(0, 1), b2 + hstepB, voffB); PG8_STAGE(PG8_SA(0, 0), a2, voffA);
            PG8_WAIT_V(8); PG8_WAIT_L(0); PG8_BAR; PG8_MMA(1, 0, At, B0); PG8_MMA(1, 1, At, B1); PG8_BAR; PG8_SCHED;
            PG8_LDB(B0, 1, 0); PG8_LDB(B1, 1, 1); PG8_SCHED; PG8_LDA(At, 1, 0); PG8_STAGE(PG8_SA(0, 1), a2 + hstepA, voffA);
            PG8_WAIT_V(8); PG8_WAIT_L(0); PG8_BAR; PG8_MMA(0, 0, At, B0); PG8_MMA(0, 1, At, B1); PG8_BAR; PG8_SCHED;
            PG8_LDA(At, 1, 1); PG8_STAGE(PG8_SB(1, 0), b3, voffB); PG8_STAGE(PG8_SB(1, 1), b3 + hstepB, voffB); PG8_STAGE(PG8_SA(1, 0), a3, voffA);
            PG8_WAIT_V(8); PG8_WAIT_L(0); PG8_BAR; PG8_MMA(1, 0, At, B0); PG8_MMA(1, 1, At, B1); PG8_BAR; PG8_SCHED;
        }
        if constexpr (ALIGN_EPI) { if (wr == 0) PG8_BAR; }
        E(acc, cur, wr, wc, fr, fq);
        if (!has_next) break;
#pragma unroll
        for (int a = 0; a < 2; ++a)
#pragma unroll
            for (int b = 0; b < 2; ++b)
#pragma unroll
                for (int m = 0; m < 4; ++m)
#pragma unroll
                    for (int n = 0; n < 2; ++n) acc[a][b][m][n] = (f32x4){0.f, 0.f, 0.f, 0.f};
        cur = nxt; cA = nA; cB = nB; ++ui;
        if constexpr (ALIGN_EPI) { if (wr == 1) PG8_BAR; }
    }
    PG8_WAIT_V(0);
    if constexpr (!ALIGN_EPI) { if (wr == 0) PG8_BAR; }
    PG8_BAR;
#undef PG8_SA
#undef PG8_SB
#undef PG8_STAGE
#undef PG8_LDA
#undef PG8_LDB
#undef PG8_MMA
#undef PG8_WAIT_V
#undef PG8_WAIT_L
#undef PG8_BAR
#undef PG8_SCHED
}
}
namespace attn_body {
using bf16=__hip_bfloat16;
using bf16x8=__attribute__((ext_vector_type(8)))short;
using s16x4=__attribute__((ext_vector_type(4)))short;
using f32x16=__attribute__((ext_vector_type(16)))float;
using f32x4v=__attribute__((ext_vector_type(4)))float;
using u32x4=__attribute__((ext_vector_type(4)))unsigned;
constexpr int BATCH=8,NHEAD=8,SEQ=2048,D=64,DM=NHEAD*D;
constexpr int NW=8,QBLK=32,QB=QBLK*NW,KVBLK=64,NQB=SEQ/QB;
__device__ __forceinline__ int crow(int r,int hi){return (r&3)+8*(r>>2)+4*hi;}
#define SBAR() __builtin_amdgcn_sched_barrier(0)
__device__ __forceinline__ void cmask(f32x16&p0,f32x16&p1,int jb,int qrel,int hi){
  const float NEG=-INFINITY; int kb=64*jb+4*hi;
  #pragma unroll
  for(int r=0;r<16;++r){int kv=kb+(r&3)+8*(r>>2); if(kv>qrel)p0[r]=NEG; if(kv+32>qrel)p1[r]=NEG;}
}
typedef __attribute__((address_space(3))) const float* lds_cfptr;
__device__ __forceinline__ void biasadd(f32x16&p0,f32x16&p1,int jb,int qrel,int hi,lds_cfptr bt){
  const int base=qrel-64*jb-4*hi;
  #pragma unroll
  for(int r4=0;r4<16;r4+=4){
    #pragma unroll
    for(int r=r4;r<r4+4;++r){int rel=base-((r&3)+8*(r>>2)); int i0=min(max(rel,0),127), i1=min(max(rel-32,0),127); p0[r]+=bt[i0]; p1[r]+=bt[i1];}
    asm volatile("s_waitcnt lgkmcnt(0)":"+v"(p0),"+v"(p1)::"memory"); }
}

constexpr int NSLOT=3, SLOTB=8192;
constexpr int LDS_K=0, LDS_V=NSLOT*SLOTB, LDS_WS=2*NSLOT*SLOTB, LDS_OST=LDS_WS+NW*64*4, LDS_KM=LDS_OST+NW*4096, LDS_BT=LDS_KM+7*64*4, LDS_BYTES=LDS_BT+128*4;
constexpr float C2=0.125f*1.4426950408889634f;
__device__ __forceinline__ void glds16(const void*gsrc,unsigned lds_dst){unsigned keep;
  asm volatile("s_mov_b32 %0, m0\n\ts_mov_b32 m0, %2\n\ts_nop 0\n\tglobal_load_lds_dwordx4 %1, off\n\ts_mov_b32 m0, %0":"=&s"(keep):"v"(gsrc),"s"(lds_dst):"memory");}
__device__ __forceinline__ float max3f(float a,float b,float c){float r;asm("v_max3_f32 %0, %1, %2, %3":"=v"(r):"v"(a),"v"(b),"v"(c));return r;}
__device__ __forceinline__ float max2f(float a,float b){float r;asm("v_max_f32_e32 %0, %1, %2":"=v"(r):"v"(a),"v"(b));return r;}
__device__ __forceinline__ float fadd_s(float a,float b){float r;asm("v_add_f32_e32 %0, %1, %2":"=v"(r):"v"(a),"v"(b));return r;}
__device__ __forceinline__ float fsub_s(float a,float b){float r;asm("v_sub_f32_e32 %0, %1, %2":"=v"(r):"v"(a),"v"(b));return r;}
typedef float f32x2_t __attribute__((ext_vector_type(2))); typedef __bf16 bf16x2_t __attribute__((ext_vector_type(2)));
__device__ __forceinline__ unsigned cvtpk_s(float lo,float hi){f32x2_t v={lo,hi};bf16x2_t b=__builtin_convertvector(v,bf16x2_t);return __builtin_bit_cast(unsigned,b);}
#define WAIT_BAR(N) asm volatile("s_waitcnt vmcnt(" #N ") lgkmcnt(0)\n\ts_barrier":::"memory")

__device__ __forceinline__ void qkt(f32x16&p0,f32x16&p1,const char*Kslot,const bf16x8*qr,int r32,int hi){
  const char*kb=Kslot+hi*1024+r32*16;
  #pragma unroll
  for(int d0=0;d0<4;++d0){
    const bf16x8 b0=*reinterpret_cast<const bf16x8*>(kb+d0*2048);
    const bf16x8 b1=*reinterpret_cast<const bf16x8*>(kb+d0*2048+512);
    if(d0==0){p0=__builtin_amdgcn_mfma_f32_32x32x16_bf16(b0,qr[0],(f32x16){},0,0,0);p1=__builtin_amdgcn_mfma_f32_32x32x16_bf16(b1,qr[0],(f32x16){},0,0,0);}
    else{p0=__builtin_amdgcn_mfma_f32_32x32x16_bf16(b0,qr[d0],p0,0,0,0);p1=__builtin_amdgcn_mfma_f32_32x32x16_bf16(b1,qr[d0],p1,0,0,0);}}
}
typedef __attribute__((address_space(3))) const char* lds_cptr;
typedef short v4i16_t __attribute__((ext_vector_type(4)));
__device__ __forceinline__ void kload8(bf16x8*kf,lds_cptr kp){
  kf[0]=*(const __attribute__((address_space(3))) bf16x8*)(kp);      kf[1]=*(const __attribute__((address_space(3))) bf16x8*)(kp+512);
  kf[2]=*(const __attribute__((address_space(3))) bf16x8*)(kp+2048); kf[3]=*(const __attribute__((address_space(3))) bf16x8*)(kp+2560);
  kf[4]=*(const __attribute__((address_space(3))) bf16x8*)(kp+4096); kf[5]=*(const __attribute__((address_space(3))) bf16x8*)(kp+4608);
  kf[6]=*(const __attribute__((address_space(3))) bf16x8*)(kp+6144); kf[7]=*(const __attribute__((address_space(3))) bf16x8*)(kp+6656);
}
__device__ __forceinline__ void kload2(bf16x8*kf,lds_cptr kp,int j){ kf[2*j]=*(const __attribute__((address_space(3))) bf16x8*)(kp+j*2048); kf[2*j+1]=*(const __attribute__((address_space(3))) bf16x8*)(kp+j*2048+512); }
__device__ __forceinline__ s16x4 vtr(lds_cptr p){ return __builtin_bit_cast(s16x4,__builtin_amdgcn_ds_read_tr16_b64_v4i16((__attribute__((address_space(3))) v4i16_t*)p)); }
__device__ __forceinline__ float rowmax(const f32x16&p0,const f32x16&p1){
  float a=max3f(p0[0],p0[1],p1[0]),b=max3f(p0[2],p0[3],p1[1]);a=max3f(a,p1[2],p1[3]);
  #pragma unroll
  for(int r=4;r<16;r+=4){a=max3f(a,p0[r],p0[r+1]);b=max3f(b,p0[r+2],p0[r+3]);a=max3f(a,p1[r],p1[r+1]);b=max3f(b,p1[r+2],p1[r+3]);}
  const float m=max2f(a,b);
  auto rr=__builtin_amdgcn_permlane32_swap(__float_as_uint(m),__float_as_uint(m),false,false);
  return max2f(__uint_as_float(rr[0]),__uint_as_float(rr[1]));
}
__device__ __forceinline__ void pv(f32x16*o,int vb,bf16x8 pa0,bf16x8 pa1,bf16x8 pa2,bf16x8 pa3){
  #pragma unroll
  for(int d0=0;d0<2;++d0){s16x4 lo[4],hi[4];
    #pragma unroll
    for(int ks=0;ks<4;++ks){
      asm volatile("ds_read_b64_tr_b16 %0,%1 offset:%c2":"=&v"(lo[ks]):"v"(vb),"i"(d0*4096+ks*1024):"memory");
      asm volatile("ds_read_b64_tr_b16 %0,%1 offset:%c2":"=&v"(hi[ks]):"v"(vb),"i"(d0*4096+ks*1024+512):"memory");}
    asm volatile("s_waitcnt lgkmcnt(0)":::"memory");SBAR();
    #define PK(k) (bf16x8){lo[k][0],lo[k][1],lo[k][2],lo[k][3],hi[k][0],hi[k][1],hi[k][2],hi[k][3]}
    o[d0]=__builtin_amdgcn_mfma_f32_32x32x16_bf16(pa0,PK(0),o[d0],0,0,0);
    o[d0]=__builtin_amdgcn_mfma_f32_32x32x16_bf16(pa1,PK(1),o[d0],0,0,0);
    o[d0]=__builtin_amdgcn_mfma_f32_32x32x16_bf16(pa2,PK(2),o[d0],0,0,0);
    o[d0]=__builtin_amdgcn_mfma_f32_32x32x16_bf16(pa3,PK(3),o[d0],0,0,0);
    #undef PK
  }
}

#ifndef ATTN_STORE16
#define ATTN_STORE16(p,v) (*(u32x4*)(p)=(v))
#endif
template<int THRL> __device__ __forceinline__ void attn_unit(int b,int h,int qb,const bf16*Q,const bf16*__restrict__ K,const bf16*__restrict__ V,bf16*O,char*shm,const float*kpart,const float*btab){
  int tid=threadIdx.x; asm volatile("":"+v"(tid));
  const int lane=tid&63,r32=lane&31,hi=lane>>5; const int wid=__builtin_amdgcn_readfirstlane(tid>>6);
  const long rowbase=(long)b*SEQ; const int q0=qb*QB;
  const bf16*Qw=Q+(rowbase+q0+wid*QBLK)*DM+h*D;
  const bf16*Kh=K+rowbase*DM+h*D,*Vh=V+rowbase*DM+h*D;
  const unsigned lds0=(unsigned)(uintptr_t)shm;
  float*wsf=(float*)(shm+LDS_WS)+wid*64;
  const bf16*ksrc=Kh+(long)lane*DM+wid*8;
  const bf16*vsrc=Vh+(long)(16*(wid&3)+(lane>>2))*DM+(wid>>2)*32+(lane&3)*8;
  const unsigned kdst=lds0+LDS_K+wid*1024, vdst=lds0+LDS_V+wid*1024;
  #define DMA_K(t,slot) glds16(ksrc+(long)(t)*KVBLK*DM,(unsigned)__builtin_amdgcn_readfirstlane(kdst+(slot)))
  #define DMA_V(t,slot) glds16(vsrc+(long)(t)*KVBLK*DM,(unsigned)__builtin_amdgcn_readfirstlane(vdst+(slot)))
  const int vb0=(int)(lds0+LDS_V)+((lane>>4)&1)*32+(lane&3)*8+(4*hi+((lane&15)>>2))*64;
  const char*Kbase=shm+LDS_K; bf16x8 kf[8];
  const lds_cptr shm3=(lds_cptr)shm; const lds_cptr kp0=shm3+LDS_K+hi*1024+r32*16; const lds_cptr vp0=shm3+LDS_V+((lane>>4)&1)*32+(lane&3)*8+(4*hi+((lane&15)>>2))*64;
  const lds_cfptr btl=(lds_cfptr)(shm3+LDS_BT);
  const int NT=(q0+QB)/KVBLK;
  DMA_K(0,0);DMA_V(0,0);DMA_K(1,SLOTB);
  bf16x8 qr[4];
  #pragma unroll
  for(int d0=0;d0<4;++d0)qr[d0]=*reinterpret_cast<const bf16x8*>(&Qw[(long)r32*DM+d0*16+hi*8]);
  { float*km=(float*)(shm+LDS_KM); float*bt=(float*)(shm+LDS_BT); int tq=tid; asm volatile("":"+v"(tq));
    if(tq<448){const int j=tq>>6,d=tq&63; float v=0.f; if(j<qb&&qb>3){const float*kp=kpart+((size_t)((b*NQB+j)*2)*512)+h*D+d; v=(kp[0]+kp[512])*(1.0f/256.0f);} km[tq]=v;}
    else if(tq<448+64){const int i=tq-448; bt[i]=btab[h*128+i]; bt[64+i]=btab[h*128+64+i];} }
  float mhat=0.f,l_reg=0.f;f32x16 o[2];o[0]=f32x16{};o[1]=f32x16{};
  const int qrel=wid*QBLK+r32;
  #define CMASK(P0,P1,t) do{int jb_=(t)-(NT-4);   \
    if(jb_>=-2 && 32*wid+31-64*jb_>=0 && 32*wid-64*jb_-63<=112)biasadd(P0,P1,jb_,qrel,hi,btl); if(jb_>=0 && 64*jb_+63>32*wid)cmask(P0,P1,jb_,qrel,hi);}while(0)
  bool resc=false;
  #define START(P0,P1,t) do{ float rm=rowmax(P0,P1); resc=false; const float nv_=MASKADD(t); rm=fadd_s(rm,nv_); \
    { const float dl=__builtin_fmaxf(rm,-1.0e4f); mhat=fadd_s(mhat,dl); const float cc_=fsub_s(nv_,dl); \
      _Pragma("unroll") for(int r=0;r<16;++r){P0[r]=fadd_s(P0[r],cc_);P1[r]=fadd_s(P1[r],cc_);} } \
    _Pragma("unroll") for(int r=0;r<16;++r)P0[r]=__builtin_amdgcn_exp2f(P0[r]); }while(0)
  #define RESC() do{ if(resc){ asm volatile("s_waitcnt lgkmcnt(0)":::"memory"); \
      _Pragma("unroll") for(int d_=0;d_<2;++d_) _Pragma("unroll") for(int r=0;r<16;++r)o[d_][r]*=wsf[crow(r,hi)]; } }while(0)
  f32x16 pA0,pA1,pB0,pB1;
  int sl_prev=0,sl_cur=0,sl_next=SLOTB;
  #define ROT() do{sl_prev=sl_cur;sl_cur=sl_next;sl_next=(sl_next==(NSLOT-1)*SLOTB)?0:sl_next+SLOTB;}while(0)
  DMA_K(2,2*SLOTB);
  WAIT_BAR(3);
  unsigned selbits=(1u<<qb)-1u;
  if(qb>3){ selbits=0u;
    const __attribute__((address_space(3))) float* km3=(const __attribute__((address_space(3))) float*)(shm3+LDS_KM);
    float qf[32];
    #pragma unroll
    for(int d0=0;d0<4;++d0){
      #pragma unroll
      for(int i=0;i<8;++i) qf[d0*8+i]=__uint_as_float(((unsigned)(unsigned short)qr[d0][i])<<16);}
    float gj[7];
    #pragma unroll
    for(int j=0;j<7;++j){ float s=0.f;
      if(j<qb){
        #pragma unroll
        for(int d0=0;d0<4;++d0){ const f32x4v k0=*(const __attribute__((address_space(3))) f32x4v*)(km3+j*64+d0*16+hi*8); const f32x4v k1=*(const __attribute__((address_space(3))) f32x4v*)(km3+j*64+d0*16+hi*8+4);
          s+=qf[d0*8+0]*k0[0]+qf[d0*8+1]*k0[1]+qf[d0*8+2]*k0[2]+qf[d0*8+3]*k0[3]+qf[d0*8+4]*k1[0]+qf[d0*8+5]*k1[1]+qf[d0*8+6]*k1[2]+qf[d0*8+7]*k1[3]; }
        auto rr=__builtin_amdgcn_permlane32_swap(__float_as_uint(s),__float_as_uint(s),false,false); s=__uint_as_float(rr[0])+__uint_as_float(rr[1]); }
      gj[j]=s; }
    #pragma unroll
    for(int j=0;j<7;++j){ int rank=0;
      #pragma unroll
      for(int k=0;k<7;++k){ if(k!=j){ const bool beats=(k<j)?(gj[k]>=gj[j]):(gj[k]>gj[j]); rank+=(k<qb&&beats)?1:0; } }
      if(j<qb&&rank<3)selbits|=(1u<<j); }
  }
  #define MASKADD(t) ((((t)>>2)<qb && !((selbits>>((t)>>2))&1u))?-1.0e30f:0.0f)
  qkt(pA0,pA1,Kbase,qr,r32,hi);asm volatile("s_nop 15\n\ts_nop 7":"+v"(pA0),"+v"(pA1));CMASK(pA0,pA1,0);
  START(pA0,pA1,0);
  _Pragma("unroll") for(int r=0;r<16;++r)pA1[r]=__builtin_amdgcn_exp2f(pA1[r]);
  WAIT_BAR(0);
  DMA_K(3,0);DMA_V(1,SLOTB);
  ROT();
  kload8(kf,kp0+sl_cur);
  WAIT_BAR(2);
  s16x4 vlo[8],vhi[8]; u32x4 pw0,pw1,pw2,pw3;
  #define PKW(P,B) cvtpk_s(P[B],P[B+1])
  #define PAF(k) __builtin_bit_cast(bf16x8,pw##k)
  #define VFR(i) (bf16x8){vlo[i][0],vlo[i][1],vlo[i][2],vlo[i][3],vhi[i][0],vhi[i][1],vhi[i][2],vhi[i][3]}
  #define PIN(x) asm volatile("":"+v"(x))
  #define MX3(a,b,c) __builtin_fmaxf(__builtin_fmaxf((a),(b)),(c))
  #define GAPA(MF,A0,A1,A2,A3,W0,W1,PW) do{ MF; sacc+=A0; sacc+=A1; sacc+=A2; sacc+=A3; PIN(sacc); W0; W1; PIN(PW); SBAR(); }while(0)
  #define EX(v) __builtin_amdgcn_exp2f(v)
  #define GAPB(MF,X,B) do{ MF; X[B]=EX(X[B]); X[B+1]=EX(X[B+1]); X[B+2]=EX(X[B+2]); X[B+3]=EX(X[B+3]); PIN(X); SBAR(); }while(0)
  #define VRD(i) do{ vlo[i]=vtr(vp_+(((i)>>2)*4096+((i)&3)*1024)); vhi[i]=vtr(vp_+(((i)>>2)*4096+((i)&3)*1024+512)); }while(0)
  #define KRD(G,j) do{ if(G){ kload2(kf,kp0+sl_next,j); SBAR(); } }while(0)
  #define STEP(C0,C1,P0,P1,t,GK,GV,GL) do{ SBAR(); \
    const lds_cptr vp_=vp0+sl_prev; \
    VRD(0); SBAR(); float sacc=(P0[0]+P0[1]); \
    GAPA(C0=__builtin_amdgcn_mfma_f32_32x32x16_bf16(kf[0],qr[0],(f32x16){},0,0,0), P0[2],P0[3],P0[4],P0[5],     pw0[0]=PKW(P0,0), pw0[1]=PKW(P0,2), pw0); \
    VRD(4); SBAR(); GAPA(C1=__builtin_amdgcn_mfma_f32_32x32x16_bf16(kf[1],qr[0],(f32x16){},0,0,0), P0[6],P0[7],P0[8],P0[9],     pw0[2]=PKW(P0,4), pw0[3]=PKW(P0,6), pw0); \
    VRD(1); SBAR(); GAPA(C0=__builtin_amdgcn_mfma_f32_32x32x16_bf16(kf[2],qr[1],C0,0,0,0),   P0[10],P0[11],P0[12],P0[13], pw1[0]=PKW(P0,8), pw1[1]=PKW(P0,10), pw1); \
    VRD(5); SBAR(); GAPA(C1=__builtin_amdgcn_mfma_f32_32x32x16_bf16(kf[3],qr[1],C1,0,0,0),   P0[14],P0[15],P1[0],P1[1],   pw1[2]=PKW(P0,12),pw1[3]=PKW(P0,14), pw1); \
    VRD(2); SBAR(); GAPA(C0=__builtin_amdgcn_mfma_f32_32x32x16_bf16(kf[4],qr[2],C0,0,0,0),   P1[2],P1[3],P1[4],P1[5],     pw2[0]=PKW(P1,0), pw2[1]=PKW(P1,2), pw2); \
    VRD(6); SBAR(); GAPA(C1=__builtin_amdgcn_mfma_f32_32x32x16_bf16(kf[5],qr[2],C1,0,0,0),   P1[6],P1[7],P1[8],P1[9],     pw2[2]=PKW(P1,4), pw2[3]=PKW(P1,6), pw2); \
    VRD(3); SBAR(); GAPA(C0=__builtin_amdgcn_mfma_f32_32x32x16_bf16(kf[6],qr[3],C0,0,0,0),   P1[10],P1[11],P1[12],P1[13], pw3[0]=PKW(P1,8), pw3[1]=PKW(P1,10), pw3); \
    VRD(7); SBAR(); GAPA(C1=__builtin_amdgcn_mfma_f32_32x32x16_bf16(kf[7],qr[3],C1,0,0,0),   P1[14],P1[15],0.f,0.f,       pw3[2]=PKW(P1,12),pw3[3]=PKW(P1,14), pw3); \
    l_reg+=sacc; \
    if(GK){DMA_K((t)+3,sl_cur);} if(GV){DMA_V((t)+1,sl_next);} \
    CMASK(C0,C1,t); \
    { float a=MX3(C0[0],C0[1],C1[0]),b=MX3(C0[2],C0[3],C1[1]); a=MX3(a,C1[2],C1[3]); \
      _Pragma("unroll") for(int r=4;r<16;r+=4){a=MX3(a,C0[r],C0[r+1]);b=MX3(b,C0[r+2],C0[r+3]);a=MX3(a,C1[r],C1[r+1]);b=MX3(b,C1[r+2],C1[r+3]);} \
      float rm=__builtin_fmaxf(a,b); { auto rr=__builtin_amdgcn_permlane32_swap(__float_as_uint(rm),__float_as_uint(rm),false,false); rm=__builtin_fmaxf(__uint_as_float(rr[0]),__uint_as_float(rr[1])); } \
      const float nv_=MASKADD(t)-mhat; rm+=nv_; float cc_=nv_; \
      resc=false; \
      if(__builtin_expect(__any(rm>(float)THRL),0)){ const float dl=__builtin_fmaxf(rm,0.f); mhat+=dl; cc_-=dl; \
        const float f=__builtin_amdgcn_exp2f(-dl); l_reg*=f; if(hi==0)wsf[r32]=f; resc=true; } \
      _Pragma("unroll") for(int r=0;r<16;++r){C0[r]+=cc_;C1[r]+=cc_;} } \
    SBAR(); \
    GAPB(o[0]=__builtin_amdgcn_mfma_f32_32x32x16_bf16(PAF(0),VFR(0),o[0],0,0,0), C0,0); \
    GAPB(o[1]=__builtin_amdgcn_mfma_f32_32x32x16_bf16(PAF(0),VFR(4),o[1],0,0,0), C0,4); \
    KRD(GL,0); GAPB(o[0]=__builtin_amdgcn_mfma_f32_32x32x16_bf16(PAF(1),VFR(1),o[0],0,0,0), C0,8); \
    KRD(GL,1); GAPB(o[1]=__builtin_amdgcn_mfma_f32_32x32x16_bf16(PAF(1),VFR(5),o[1],0,0,0), C0,12); \
    KRD(GL,2); GAPB(o[0]=__builtin_amdgcn_mfma_f32_32x32x16_bf16(PAF(2),VFR(2),o[0],0,0,0), C1,0); \
    KRD(GL,3); GAPB(o[1]=__builtin_amdgcn_mfma_f32_32x32x16_bf16(PAF(2),VFR(6),o[1],0,0,0), C1,4); \
    GAPB(o[0]=__builtin_amdgcn_mfma_f32_32x32x16_bf16(PAF(3),VFR(3),o[0],0,0,0), C1,8); \
    GAPB(o[1]=__builtin_amdgcn_mfma_f32_32x32x16_bf16(PAF(3),VFR(7),o[1],0,0,0), C1,12); \
    }while(0)
  int t=1;
  #undef CMASK
  #define CMASK(P0,P1,t) do{}while(0)
  for(;t+7<NT;t+=2){
    STEP(pB0,pB1,pA0,pA1,t,true,true,true);     WAIT_BAR(2); RESC(); ROT();
    STEP(pA0,pA1,pB0,pB1,t+1,true,true,true);   WAIT_BAR(2); RESC(); ROT();
  }
  #undef CMASK
  #define CMASK(P0,P1,t) do{int jb_=(t)-(NT-4);   \
    if(jb_>=-2 && 32*wid+31-64*jb_>=0 && 32*wid-64*jb_-63<=112)biasadd(P0,P1,jb_,qrel,hi,btl); if(jb_>=0 && 64*jb_+63>32*wid)cmask(P0,P1,jb_,qrel,hi);}while(0)
  #define ENDW(tt) do{ if((tt)+3<NT){WAIT_BAR(2);} else if((tt)+2<NT){WAIT_BAR(1);} else {WAIT_BAR(0);} }while(0)
  for(;t+1<NT;t+=2){
    STEP(pB0,pB1,pA0,pA1,t,(t+3<NT),(t+1<NT),(t+1<NT));       ENDW(t);   RESC(); ROT();
    STEP(pA0,pA1,pB0,pB1,t+1,(t+4<NT),(t+2<NT),(t+2<NT));     ENDW(t+1); RESC(); ROT();
  }
  STEP(pB0,pB1,pA0,pA1,NT-1,false,false,false); RESC();
  { float sacc=pB0[0]+pB0[1]; _Pragma("unroll") for(int r=2;r<16;++r)sacc+=pB0[r]; _Pragma("unroll") for(int r=0;r<16;++r)sacc+=pB1[r]; l_reg+=sacc;
    pw0=(u32x4){PKW(pB0,0),PKW(pB0,2),PKW(pB0,4),PKW(pB0,6)};pw1=(u32x4){PKW(pB0,8),PKW(pB0,10),PKW(pB0,12),PKW(pB0,14)};pw2=(u32x4){PKW(pB1,0),PKW(pB1,2),PKW(pB1,4),PKW(pB1,6)};pw3=(u32x4){PKW(pB1,8),PKW(pB1,10),PKW(pB1,12),PKW(pB1,14)};
    SBAR(); pv(o,vb0+sl_cur,PAF(0),PAF(1),PAF(2),PAF(3)); }
  #undef PKW
  #undef PAF
  #undef VFR
  #undef PIN
  #undef MX3
  #undef GAPA
  #undef GAPB
  #undef EX
  #undef VRD
  #undef KRD
  #undef STEP
  #undef ENDW
  #undef MASKADD
  {auto rr=__builtin_amdgcn_permlane32_swap(__float_as_uint(l_reg),__float_as_uint(l_reg),false,false);l_reg=__uint_as_float(rr[0])+__uint_as_float(rr[1]);}
  if(hi==0)wsf[32+r32]=l_reg;asm volatile("s_waitcnt lgkmcnt(0)":::"memory");
  float rli[16];
  #pragma unroll
  for(int r=0;r<16;++r)rli[r]=__builtin_amdgcn_rcpf(wsf[32+crow(r,hi)]);
  bf16*Ow=O+(rowbase+q0+wid*QBLK)*DM+h*D;
  { bf16*stg=(bf16*)(shm+LDS_OST)+wid*2048;
    #pragma unroll
    for(int r=0;r<16;++r){const int orow=crow(r,hi);
      #pragma unroll
      for(int d0=0;d0<2;++d0)stg[orow*64+d0*32+r32]=__float2bfloat16(o[d0][r]*rli[r]);}
    asm volatile("s_waitcnt lgkmcnt(0)":::"memory");
    #pragma unroll
    for(int i=0;i<4;++i){const int row=i*8+(lane>>3),ch=lane&7; const u32x4 v=*(const u32x4*)(stg+row*64+ch*8); ATTN_STORE16(Ow+(long)row*DM+ch*8,v);} }
  asm volatile("s_waitcnt lgkmcnt(0)\n\ts_barrier":::"memory");
  #undef DMA_K
  #undef DMA_V
  #undef CMASK
  #undef START
  #undef RESC
  #undef ROT
}
constexpr int ATTN_LDS_BYTES=LDS_BYTES;
#undef SBAR
#undef WAIT_BAR
}
constexpr int NWAVES = 8;
constexpr int PER_PHASE = 10;
constexpr int N_LAUNCHES = MK_N_LAUNCHES;

constexpr int BATCH = 8, SEQ = 2048, DMODEL = 1024, MTOK = BATCH * SEQ;
constexpr int INCOLS = 4096, SSMW = 512, NGRP = 32, CH = 32  , NCHUNK = SEQ / CH  , APK = 640  ;
constexpr int PQ = 2048, NEXP = 16384;
constexpr float RMS_EPS = 1e-6f;

constexpr size_t MiB = 1u << 20;
constexpr size_t WS_CTL = 0, CTL_ZERO_BYTES = 64 * 1024;
constexpr size_t WS_BIAS = 1 * MiB;
constexpr size_t WS_PW32 = 1 * MiB + 64 * 1024;
constexpr size_t WS_KPART = 1 * MiB + 128 * 1024;
constexpr size_t WS_KG = 2 * MiB;
constexpr size_t WS_SSQ1 = 3 * MiB;
constexpr size_t WS_WIN = 6 * MiB, WS_WQ = 14 * MiB, WS_WOUT = 18 * MiB, WS_WUS = 20 * MiB, WS_WUA = 21 * MiB, WS_WGLU = 22 * MiB, WS_KS = 22 * MiB + 512 * 1024;
constexpr size_t WS_WE = 23 * MiB;
constexpr size_t WS_BP = 32 * MiB;
constexpr size_t WS_AP = 52 * MiB;
constexpr size_t WS_E = 72 * MiB;
constexpr size_t WS_H = 80 * MiB;
constexpr size_t WS_YPRE = 80 * MiB, WS_YA = 96 * MiB, WS_XG = 80 * MiB;
constexpr size_t WS_Z = 96 * MiB, ZSTRIDE_B = 16 * MiB;
constexpr size_t WS_MRG = 128 * MiB;
constexpr size_t WS_PQ = 160 * MiB;
constexpr size_t WS_IDS = 224 * MiB, WS_GTS = 232 * MiB;
constexpr size_t WS_U16 = 32 * MiB, WS_V16 = 240 * MiB;
constexpr size_t WS_YB = 224 * MiB;
constexpr size_t WS_WPK = 128 * MiB, WS_RSTD1 = 4 * MiB, WS_Y16 = 160 * MiB;
constexpr size_t WS_END = 256 * MiB;
constexpr int CW_BAR = 1024;

constexpr int RING_OFF = 0, RING_BYTES = 131072;
constexpr int LDSCTL_OFF = RING_BYTES, MISC_OFF = LDSCTL_OFF + 320;
constexpr int LDS_BYTES = 147456;

#define GAS __attribute__((address_space(1)))
#define LAS __attribute__((address_space(3)))
typedef unsigned short bf16;
typedef unsigned v4u __attribute__((ext_vector_type(4)));
typedef float f32x4 __attribute__((ext_vector_type(4)));
typedef short bf16x8 __attribute__((ext_vector_type(8)));
typedef float f32x16 __attribute__((ext_vector_type(16)));
typedef __bf16 bf16x2_t __attribute__((ext_vector_type(2)));
typedef _Float16 h2_t __attribute__((ext_vector_type(2)));
typedef GAS unsigned gu32;
#define RLX_AGENT __ATOMIC_RELAXED, __HIP_MEMORY_SCOPE_AGENT
#define LDS_WAIT() asm volatile("s_waitcnt lgkmcnt(0)" ::: "memory")
#define VM_WAIT() asm volatile("s_waitcnt vmcnt(0)" ::: "memory")
__device__ __forceinline__ unsigned f2bf(float f) { unsigned u = __builtin_bit_cast(unsigned, f); return (u + 0x7fffu + ((u >> 16) & 1u)) >> 16; }
__device__ __forceinline__ unsigned pk2(float lo, float hi) { return f2bf(lo) | (f2bf(hi) << 16); }
using pg8::cvt_pk_bf16; using pg8::bf_lo; using pg8::bf_hi; using pg8::sigmoid_f; using pg8::gelu_tanh;

#define XB_TMO      128
#define XB_XCNT(j)  (256  + 64 * (j))
#define XB_XSUB(j)  (1280 + 64 * (j))
#define XB_XGEN(j)  (2304 + 64 * (j))
#define XB_TOP      3328
#define XB_TOPGEN   3392
#define XCD_BAR_WORDS 3456
#define XB_SPIN_CAP (1u << 18)
__device__ __forceinline__ unsigned xb_ld(unsigned* p)              { return __hip_atomic_load(p, __ATOMIC_RELAXED, __HIP_MEMORY_SCOPE_AGENT); }
__device__ __forceinline__ unsigned xb_add(unsigned* p, unsigned v) { return __hip_atomic_fetch_add(p, v, __ATOMIC_RELAXED, __HIP_MEMORY_SCOPE_AGENT); }
__device__ __forceinline__ unsigned xb_xcc_id() { return (unsigned)__builtin_amdgcn_s_getreg((3 << 11) | 20) & 0xFu; }
#define XB_SPIN(cond, bar) do { unsigned _sp = 0; while (cond) { __builtin_amdgcn_s_sleep(1); \
    if ((++_sp & 255u) == 0u) { if (xb_ld(&(bar)[XB_TMO])) break; if (_sp > XB_SPIN_CAP) { atomicAdd(&(bar)[XB_TMO], 1u); break; } } } } while (0)
struct XcdBarrier { unsigned* bar; unsigned x; volatile LAS unsigned* st; };
__device__ __forceinline__ XcdBarrier xcd_barrier_post(unsigned* bar, volatile LAS unsigned* st) {
    XcdBarrier b; b.bar = bar; b.x = xb_xcc_id(); b.st = st;
    if (threadIdx.x == 0) (void)xb_add(&bar[XB_XCNT(b.x)], 1u);
    return b;
}
__device__ __forceinline__ void xcd_barrier_complete(unsigned* bar, unsigned x, unsigned& nloc, unsigned& nx) {
    const unsigned G = gridDim.x * gridDim.y * gridDim.z;
    unsigned sum, cnt, mine, sp = 0u;
    for (;;) {
        sum = 0u; cnt = 0u; mine = 0u;
#pragma unroll
        for (unsigned j = 0; j < 16; ++j) { const unsigned c = xb_ld(&bar[XB_XCNT(j)]); sum += c; cnt += (c > 0u) ? 1u : 0u; mine = (j == x) ? c : mine; }
        if (sum == G) break;
        __builtin_amdgcn_s_sleep(1);
        if ((++sp & 255u) == 0u) { if (xb_ld(&bar[XB_TMO])) break; if (sp > XB_SPIN_CAP) { atomicAdd(&bar[XB_TMO], 1u); break; } }
    }
    nloc = mine > 0u ? mine : 1u; nx = cnt > 0u ? cnt : 1u;
}
__device__ __forceinline__ void xcd_barrier(const XcdBarrier& b) {
    asm volatile("s_waitcnt vmcnt(0)" ::: "memory");
    __syncthreads();
    if (threadIdx.x == 0) {
        unsigned* bar = b.bar;
        __builtin_amdgcn_s_waitcnt(0);
        unsigned nloc = b.st[0], nx = b.st[1];
        if (nloc == 0u) { xcd_barrier_complete(bar, b.x, nloc, nx); b.st[0] = nloc; b.st[1] = nx; }
        const unsigned old = xb_add(&bar[XB_XSUB(b.x)], 1u);
        const unsigned gen = old / nloc;
        if (old + 1u == (gen + 1u) * nloc) {
            __builtin_amdgcn_fence(__ATOMIC_RELEASE, "agent");
            asm volatile("s_waitcnt vmcnt(0)" ::: "memory");
            const unsigned og = xb_add(&bar[XB_TOP], 1u);
            const unsigned tg = og / nx;
            if (og + 1u == (tg + 1u) * nx) xb_add(&bar[XB_TOPGEN], 1u);
            else XB_SPIN(xb_ld(&bar[XB_TOPGEN]) == tg, bar);
            __builtin_amdgcn_fence(__ATOMIC_ACQUIRE, "agent");
            xb_add(&bar[XB_XGEN(b.x)], 1u);
            asm volatile("s_waitcnt vmcnt(0)" ::: "memory");
        } else {
            XB_SPIN(xb_ld(&bar[XB_XGEN(b.x)]) == gen, bar);
            __builtin_amdgcn_fence(__ATOMIC_ACQUIRE, "agent");
            asm volatile("s_waitcnt vmcnt(0)" ::: "memory");
        }
    }
    __syncthreads();
}

__device__ __forceinline__ float wave_sum(float v) {
#pragma unroll
    for (int o = 1; o < 64; o <<= 1) v += __shfl_xor(v, o);
    return v;
}

namespace pg8 {
struct EpiIn {
    static constexpr bool PERM = true;
    bf16_t* zbase; bf16_t* AP; float* kpart;
    __device__ __forceinline__ void operator()(const f32x4 (&acc)[2][2][4][2], const Unit& u, int wr, int wc, int fr, int fq) const {
        const int t = u.pn >> 1, colt = (u.pn & 1) * 256;
        const int row0 = u.pm * BM + wr * 64 + fr, col0 = colt + wc * 32 + 8 * fq;
        if (t == 0) {
#pragma unroll
            for (int ai = 0; ai < 2; ++ai)
#pragma unroll
                for (int m = 0; m < 4; ++m) { const int r = row0 + ai * HALF + m * 16, b = r >> 11, l = r & 2047;
#pragma unroll
                    for (int bj = 0; bj < 2; ++bj) { const int c = col0 + bj * HALF, g = c >> 4, hi0 = c & 15;
                        const f32x4 v0 = acc[ai][bj][m][0], v1 = acc[ai][bj][m][1];
                        u32x4 w; w.x = cvt_pk_bf16(v0[0], v0[1]); w.y = cvt_pk_bf16(v0[2], v0[3]); w.z = cvt_pk_bf16(v1[0], v1[1]); w.w = cvt_pk_bf16(v1[2], v1[3]);
                        *(u32x4*)(AP + (size_t)(g * 512 + b * 64 + (l >> 5)) * 640 + (l & 31) * 16 + hi0) = w; } }
        } else {
            bf16_t* base = zbase + (size_t)t * (16u * 1024u * 1024u / 2u);
            const float sc = (t == 1) ? 0.125f * 1.4426950408889634f : 1.0f;
#pragma unroll
            for (int ai = 0; ai < 2; ++ai)
#pragma unroll
                for (int m = 0; m < 4; ++m) { bf16_t* rowp = base + (size_t)(row0 + ai * HALF + m * 16) * 512 + col0;
#pragma unroll
                    for (int bj = 0; bj < 2; ++bj) { f32x4 v0 = acc[ai][bj][m][0], v1 = acc[ai][bj][m][1];
                        if (t >= 4) {
#pragma unroll
                            for (int e = 0; e < 4; ++e) { v0[e] = sigmoid_f(v0[e]); v1[e] = sigmoid_f(v1[e]); }
                        } else { v0 = v0 * sc; v1 = v1 * sc; }
                        u32x4 w; w.x = cvt_pk_bf16(v0[0], v0[1]); w.y = cvt_pk_bf16(v0[2], v0[3]); w.z = cvt_pk_bf16(v1[0], v1[1]); w.w = cvt_pk_bf16(v1[2], v1[3]);
                        *(u32x4*)(rowp + bj * HALF) = w; } }
            if (t == 2) {
#pragma unroll
                for (int bj = 0; bj < 2; ++bj)
#pragma unroll
                    for (int n = 0; n < 2; ++n) { f32x4 s = (f32x4){0.f, 0.f, 0.f, 0.f};
#pragma unroll
                        for (int ai = 0; ai < 2; ++ai)
#pragma unroll
                            for (int m = 0; m < 4; ++m) s += acc[ai][bj][m][n];
#pragma unroll
                        for (int e = 0; e < 4; ++e) { float x = s[e]; x += __shfl_xor(x, 1); x += __shfl_xor(x, 2); x += __shfl_xor(x, 4); x += __shfl_xor(x, 8); s[e] = x; }
                        if (fr == 0) *(f32x4*)(kpart + (size_t)(u.pm * 2 + wr) * 512 + col0 + bj * HALF + 4 * n) = s; }
            }
        }
    }
};
struct EpiE {
    static constexpr bool PERM = false;
    float* E;
    __device__ __forceinline__ void operator()(const f32x4 (&acc)[2][2][4][2], const Unit& u, int wr, int wc, int fr, int fq) const {
        const int row0 = u.pm * BM + wr * 64 + fr, col0 = wc * 32 + 4 * fq;
#pragma unroll
        for (int ai = 0; ai < 2; ++ai)
#pragma unroll
            for (int m = 0; m < 4; ++m) { float* rowp = E + (size_t)(row0 + ai * HALF + m * 16) * 128 + col0;
#pragma unroll
                for (int n = 0; n < 2; ++n) *(f32x4*)(rowp + n * 16) = acc[ai][0][m][n]; }
    }
};
struct EpiY {
    static constexpr bool PERM = true;
    bf16_t* Y;
    __device__ __forceinline__ void operator()(const f32x4 (&acc)[2][2][4][2], const Unit& u, int wr, int wc, int fr, int fq) const {
        const int row0 = u.pm * BM + wr * 64 + fr, col0 = u.pn * BM + wc * 32 + 8 * fq;
#pragma unroll
        for (int ai = 0; ai < 2; ++ai)
#pragma unroll
            for (int m = 0; m < 4; ++m) { const int r = row0 + ai * HALF + m * 16, g = r >> 9, b = (r >> 6) & 7, c = r & 63;
#pragma unroll
                for (int bj = 0; bj < 2; ++bj) { const int cc = col0 + bj * HALF, j = cc >> 4, ho0 = cc & 15;
                    f32x4 v0 = acc[ai][bj][m][0], v1 = acc[ai][bj][m][1];
#pragma unroll
                    for (int e = 0; e < 4; ++e) { v0[e] = gelu_tanh(v0[e]); v1[e] = gelu_tanh(v1[e]); }
                    u32x4 w; w.x = cvt_pk_bf16(v0[0], v0[1]); w.y = cvt_pk_bf16(v0[2], v0[3]); w.z = cvt_pk_bf16(v1[0], v1[1]); w.w = cvt_pk_bf16(v1[2], v1[3]);
                    *(u32x4*)(Y + (size_t)(b * 2048 + c * 32 + j) * 512 + g * 16 + ho0) = w; } }
    }
};
struct EpiGlu {
    static constexpr bool PERM = true;
    const bf16_t* Yp; bf16_t* Ya; const float* bias;
    __device__ __forceinline__ void operator()(const f32x4 (&acc)[2][2][4][2], const Unit& u, int wr, int wc, int fr, int fq) const {
        const int row0 = u.pm * BM + wr * 64 + fr, col0 = u.pn * BM + wc * 32 + 8 * fq;
        f32x4 bv[2][2];
#pragma unroll
        for (int bj = 0; bj < 2; ++bj)
#pragma unroll
            for (int n = 0; n < 2; ++n) bv[bj][n] = *(const f32x4*)(bias + col0 + bj * HALF + 4 * n);
#pragma unroll
        for (int ai = 0; ai < 2; ++ai)
#pragma unroll
            for (int m = 0; m < 4; ++m) { const size_t off = (size_t)(row0 + ai * HALF + m * 16) * 512 + col0;
#pragma unroll
                for (int bj = 0; bj < 2; ++bj) { const f32x4 z0 = acc[ai][bj][m][0] + bv[bj][0], z1 = acc[ai][bj][m][1] + bv[bj][1];
                    const u32x4 y = *(const u32x4*)(Yp + off + bj * HALF);
                    u32x4 w; w.x = cvt_pk_bf16(bf_lo(y.x) * sigmoid_f(z0[0]), bf_hi(y.x) * sigmoid_f(z0[1])); w.y = cvt_pk_bf16(bf_lo(y.y) * sigmoid_f(z0[2]), bf_hi(y.y) * sigmoid_f(z0[3]));
                    w.z = cvt_pk_bf16(bf_lo(y.z) * sigmoid_f(z1[0]), bf_hi(y.z) * sigmoid_f(z1[1])); w.w = cvt_pk_bf16(bf_lo(y.w) * sigmoid_f(z1[2]), bf_hi(y.w) * sigmoid_f(z1[3]));
                    *(u32x4*)(Ya + off + bj * HALF) = w; } }
    }
};
template <int ADD> struct EpiMrg {
    static constexpr bool PERM = true;
    const bf16_t* G0; bf16_t* Mrg;
    __device__ __forceinline__ void operator()(const f32x4 (&acc)[2][2][4][2], const Unit& u, int wr, int wc, int fr, int fq) const {
        const int row0 = u.pm * BM + wr * 64 + fr, cin = wc * 32 + 8 * fq;
        const bf16_t* gb = G0 + (size_t)(u.pn >> 1) * (16u * 1024u * 1024u / 2u) + (u.pn & 1) * 256 + cin;
#pragma unroll
        for (int ai = 0; ai < 2; ++ai)
#pragma unroll
            for (int m = 0; m < 4; ++m) { const int r = row0 + ai * HALF + m * 16;
#pragma unroll
                for (int bj = 0; bj < 2; ++bj) {
#if defined(ABL_NO_SSM) || defined(ABL_NO_ATT)
#if defined(ABL_NO_SSM)
                    constexpr bool kill = (ADD == 0);
#else
                    constexpr bool kill = (ADD == 1);
#endif
                    const f32x4 a0 = kill ? (f32x4){0.f, 0.f, 0.f, 0.f} : acc[ai][bj][m][0], a1 = kill ? (f32x4){0.f, 0.f, 0.f, 0.f} : acc[ai][bj][m][1];
#else
                    const f32x4 a0 = acc[ai][bj][m][0], a1 = acc[ai][bj][m][1];
#endif
                    const u32x4 gt = *(const u32x4*)(gb + (size_t)r * 512 + bj * HALF);
                    bf16_t* mp = Mrg + (size_t)r * 1024 + u.pn * BM + cin + bj * HALF;
                    float o[8] = { bf_lo(gt.x) * a0[0], bf_hi(gt.x) * a0[1], bf_lo(gt.y) * a0[2], bf_hi(gt.y) * a0[3], bf_lo(gt.z) * a1[0], bf_hi(gt.z) * a1[1], bf_lo(gt.w) * a1[2], bf_hi(gt.w) * a1[3] };
                    if (ADD) { const u32x4 p = *(const u32x4*)mp; o[0] += bf_lo(p.x); o[1] += bf_hi(p.x); o[2] += bf_lo(p.y); o[3] += bf_hi(p.y); o[4] += bf_lo(p.z); o[5] += bf_hi(p.z); o[6] += bf_lo(p.w); o[7] += bf_hi(p.w); }
                    u32x4 w; w.x = cvt_pk_bf16(o[0], o[1]); w.y = cvt_pk_bf16(o[2], o[3]); w.z = cvt_pk_bf16(o[4], o[5]); w.w = cvt_pk_bf16(o[6], o[7]);
                    *(u32x4*)mp = w; } }
    }
};
struct EpiMrgDual {
    static constexpr bool PERM = true;
    EpiMrg<0> a; EpiMrg<1> b;
    __device__ __forceinline__ void operator()(const f32x4 (&acc)[2][2][4][2], const Unit& u, int wr, int wc, int fr, int fq) const { if (u.w == 0) a(acc, u, wr, wc, fr, fq); else b(acc, u, wr, wc, fr, fq); }
};
struct EpiX1 {
    static constexpr bool PERM = true;
    const float* X; float* X1; bf16_t* XG; const float* g2; float* ssq;
    __device__ __forceinline__ void operator()(const f32x4 (&acc)[2][2][4][2], const Unit& u, int wr, int wc, int fr, int fq) const {
        const int row0 = u.pm * BM + wr * 64 + fr, col0 = u.pn * BM + wc * 32 + 8 * fq;
        f32x4 gv[2][2];
#pragma unroll
        for (int bj = 0; bj < 2; ++bj)
#pragma unroll
            for (int n = 0; n < 2; ++n) gv[bj][n] = *(const f32x4*)(g2 + col0 + bj * HALF + 4 * n);
#pragma unroll
        for (int ai = 0; ai < 2; ++ai)
#pragma unroll
            for (int m = 0; m < 4; ++m) { const int r = row0 + ai * HALF + m * 16; const size_t off = (size_t)r * 1024 + col0; float s = 0.f;
#pragma unroll
                for (int bj = 0; bj < 2; ++bj) {
                    #ifdef ABL_NO_MIX
                    const f32x4 x0 = *(const f32x4*)(X + off + bj * HALF), x1 = *(const f32x4*)(X + off + bj * HALF + 4);
#else
                    const f32x4 x0 = *(const f32x4*)(X + off + bj * HALF) + acc[ai][bj][m][0], x1 = *(const f32x4*)(X + off + bj * HALF + 4) + acc[ai][bj][m][1];
#endif
                    *(f32x4*)(X1 + off + bj * HALF) = x0; *(f32x4*)(X1 + off + bj * HALF + 4) = x1;
                    s += (x0[0] * x0[0] + x0[1] * x0[1]) + (x0[2] * x0[2] + x0[3] * x0[3]) + (x1[0] * x1[0] + x1[1] * x1[1]) + (x1[2] * x1[2] + x1[3] * x1[3]);
                    const f32x4 a = x0 * gv[bj][0], b = x1 * gv[bj][1];
                    u32x4 w; w.x = cvt_pk_bf16(a[0], a[1]); w.y = cvt_pk_bf16(a[2], a[3]); w.z = cvt_pk_bf16(b[0], b[1]); w.w = cvt_pk_bf16(b[2], b[3]);
                    *(u32x4*)(XG + off + bj * HALF) = w; }
                s += __shfl_xor(s, 16); s += __shfl_xor(s, 32);
                if (fq == 0) ssq[(size_t)r * 16 + u.pn * 4 + wc] = s; }
    }
};
struct EpiPlain {
    static constexpr bool PERM = true;
    bf16_t* O; int ldc;
    __device__ __forceinline__ void operator()(const f32x4 (&acc)[2][2][4][2], const Unit& u, int wr, int wc, int fr, int fq) const {
        const int row0 = u.pm * BM + wr * 64 + fr, col0 = u.pn * BM + wc * 32 + 8 * fq;
#pragma unroll
        for (int ai = 0; ai < 2; ++ai)
#pragma unroll
            for (int m = 0; m < 4; ++m) { bf16_t* rowp = O + (size_t)(row0 + ai * HALF + m * 16) * ldc + col0;
#pragma unroll
                for (int bj = 0; bj < 2; ++bj) { const f32x4 v0 = acc[ai][bj][m][0], v1 = acc[ai][bj][m][1];
                    u32x4 w; w.x = cvt_pk_bf16(v0[0], v0[1]); w.y = cvt_pk_bf16(v0[2], v0[3]); w.z = cvt_pk_bf16(v1[0], v1[1]); w.w = cvt_pk_bf16(v1[2], v1[3]);
                    *(u32x4*)(rowp + bj * HALF) = w; } }
    }
};
}
struct Frame {
    LAS unsigned char* lds;
    int tid, lane, wave, vcu, G;
};

__device__ __forceinline__ void p0_transpose_item(const float* W, int K, int N, bf16* WT, LAS float* scr, int item, int lane) {
    const int nblk = N / 32, kb = item / nblk, nb = item % nblk, k0 = 64 * kb, n0 = 32 * nb;
    float wv[32];
#pragma unroll
    for (int i = 0; i < 32; ++i) { const int kk = 2 * i + (lane >> 5); wv[i] = W[(size_t)(k0 + kk) * N + n0 + (lane & 31)]; }
#pragma unroll
    for (int i = 0; i < 32; ++i) { const int kk = 2 * i + (lane >> 5); scr[kk * 33 + (lane & 31)] = wv[i]; }
    LDS_WAIT(); asm volatile("" ::: "memory");
    const int c = lane & 7;
#pragma unroll
    for (int j = 0; j < 4; ++j) { const int n = (lane >> 3) + 8 * j; const LAS float* s = scr + (8 * c) * 33 + n;
        v4u o; o.x = pk2(s[0 * 33], s[1 * 33]); o.y = pk2(s[2 * 33], s[3 * 33]); o.z = pk2(s[4 * 33], s[5 * 33]); o.w = pk2(s[6 * 33], s[7 * 33]);
        *(GAS v4u*)(WT + (size_t)(n0 + n) * K + k0 + 8 * c) = o; }
    LDS_WAIT(); asm volatile("" ::: "memory");
}
__device__ __forceinline__ void rms_row_to_bf16(const float* xrow, const float* g, bf16* orow, int lane) {
    const GAS f32x4* xr = (const GAS f32x4*)xrow + lane; const GAS f32x4* gr = (const GAS f32x4*)g + lane;
    f32x4 v[4]; float s = 0.f;
#pragma unroll
    for (int j = 0; j < 4; ++j) { v[j] = xr[64 * j]; s += (v[j].x * v[j].x + v[j].y * v[j].y) + (v[j].z * v[j].z + v[j].w * v[j].w); }
    const float rstd = 1.0f / sqrtf(wave_sum(s) * (1.f / DMODEL) + RMS_EPS);
    GAS unsigned long long* o8 = (GAS unsigned long long*)orow + lane;
#pragma unroll
    for (int j = 0; j < 4; ++j) { const f32x4 gg = gr[64 * j];
        o8[64 * j] = (unsigned long long)pk2(v[j].x * rstd * gg.x, v[j].y * rstd * gg.y) | ((unsigned long long)pk2(v[j].z * rstd * gg.z, v[j].w * rstd * gg.w) << 32); }
}
__device__ __forceinline__ void rms_rows4_to_bf16(const float* x, const float* g, bf16* out, int m, int stride, int lane) {
    f32x4 v[4][4];
#pragma unroll
    for (int k = 0; k < 4; ++k) { const int mm = (m + k * stride < MTOK) ? m + k * stride : m; const GAS f32x4* xr = (const GAS f32x4*)(x + (size_t)mm * DMODEL) + lane;
#pragma unroll
        for (int j = 0; j < 4; ++j) v[k][j] = xr[64 * j]; }
    const GAS f32x4* gr = (const GAS f32x4*)g + lane; f32x4 gg[4];
#pragma unroll
    for (int j = 0; j < 4; ++j) gg[j] = gr[64 * j];
#pragma unroll
    for (int k = 0; k < 4; ++k) { if (m + k * stride >= MTOK) break; float s = 0.f;
#pragma unroll
        for (int j = 0; j < 4; ++j) s += (v[k][j].x * v[k][j].x + v[k][j].y * v[k][j].y) + (v[k][j].z * v[k][j].z + v[k][j].w * v[k][j].w);
        const float rstd = 1.0f / sqrtf(wave_sum(s) * (1.f / DMODEL) + RMS_EPS);
        GAS unsigned long long* o8 = (GAS unsigned long long*)(out + (size_t)(m + k * stride) * DMODEL) + lane;
#pragma unroll
        for (int j = 0; j < 4; ++j) o8[64 * j] = (unsigned long long)pk2(v[k][j].x * rstd * gg[j].x, v[k][j].y * rstd * gg[j].y) | ((unsigned long long)pk2(v[k][j].z * rstd * gg[j].z, v[k][j].w * rstd * gg[j].w) << 32); }
}
struct cpx { float r, i; };
__device__ __forceinline__ cpx cmul(cpx a, cpx b) { return cpx{a.r * b.r - a.i * b.i, a.r * b.i + a.i * b.r}; }
__device__ __forceinline__ cpx cpow_(float ar, float ai, float dt, int n) { const float e = expf(ar * dt * (float)n); const float ang = ai * dt * (float)n; return cpx{e * cosf(ang), e * sinf(ang)}; }
__device__ __forceinline__ void ssm_table_task(int g, int j, int lane, LAS float* scr, const float* a_re, const float* a_im, const float* log_dt, const float* b_re, const float* b_im,
                                               const float* c_re, const float* c_im, float* Kg, bf16* WE, bf16* BP, float* pw32) {
    const int p = lane;
    const float dt = expf(log_dt[g]), ar = a_re[g * 64 + p], ai = a_im[g * 64 + p];
#define pw(n) cpow_(ar, ai, dt, (n))
    const cpx lb = pw(1);
    const float den = ar * ar + ai * ai;
    const cpx coef = cpx{((lb.r - 1.f) * ar + lb.i * ai) / den, (lb.i * ar - (lb.r - 1.f) * ai) / den};
    const cpx pj = pw(j), pe = pw(31 - j), pv = pw(j + 1);
    unsigned wer[8], wei[8];
#pragma unroll
    for (int h2 = 0; h2 < 8; ++h2) { float er[2], ei[2];
#pragma unroll
        for (int q = 0; q < 2; ++q) { const int hi = 2 * h2 + q;
            const cpx bb = cmul(coef, cpx{b_re[(g * 64 + p) * 16 + hi], b_im[(g * 64 + p) * 16 + hi]});
            const cpx w = cmul(pj, bb); scr[(p * 16 + hi) * 2] = w.r; scr[(p * 16 + hi) * 2 + 1] = w.i;
            const cpx e = cmul(pe, bb); er[q] = e.r; ei[q] = e.i; }
        wer[h2] = pk2(er[0], er[1]); wei[h2] = pk2(ei[0], ei[1]); }
    { bf16* w0 = WE + ((size_t)(g * 256 + p) * 512 + j * 16); bf16* w1 = WE + ((size_t)(g * 256 + 64 + p) * 512 + j * 16);
      *(GAS v4u*)w0 = (v4u){wer[0], wer[1], wer[2], wer[3]}; *(GAS v4u*)(w0 + 8) = (v4u){wer[4], wer[5], wer[6], wer[7]};
      *(GAS v4u*)w1 = (v4u){wei[0], wei[1], wei[2], wei[3]}; *(GAS v4u*)(w1 + 8) = (v4u){wei[4], wei[5], wei[6], wei[7]};
      bf16* z0 = WE + ((size_t)(g * 256 + 128 + p) * 512 + j * 16); bf16* z1 = WE + ((size_t)(g * 256 + 192 + p) * 512 + j * 16); const v4u z = (v4u){0u, 0u, 0u, 0u};
      *(GAS v4u*)z0 = z; *(GAS v4u*)(z0 + 8) = z; *(GAS v4u*)z1 = z; *(GAS v4u*)(z1 + 8) = z; }
#pragma unroll 4
    for (int ho = 0; ho < 16; ++ho) { const cpx cv = cmul(cpx{c_re[(g * 16 + ho) * 64 + p], c_im[(g * 16 + ho) * 64 + p]}, pv);
        bf16* row = BP + ((size_t)(g * 512 + j * 16 + ho) * APK + 512);
        row[p] = (bf16)f2bf(cv.r); row[64 + p] = (bf16)f2bf(-cv.i); }
    if (j == 0) { const cpx p32 = pw(32); pw32[g * 128 + p] = p32.r; pw32[g * 128 + 64 + p] = p32.i; }
    LDS_WAIT(); asm volatile("" ::: "memory");
    { const int ho = lane >> 2, h4 = (lane & 3) * 4; float a0 = 0.f, a1 = 0.f, a2 = 0.f, a3 = 0.f;
      const float* cr = c_re + (g * 16 + ho) * 64; const float* ci = c_im + (g * 16 + ho) * 64;
#pragma unroll 4
      for (int pp = 0; pp < 64; ++pp) { const float r_ = cr[pp], i_ = ci[pp]; const LAS float* w = scr + (pp * 16 + h4) * 2;
          a0 += r_ * w[0] - i_ * w[1]; a1 += r_ * w[2] - i_ * w[3]; a2 += r_ * w[4] - i_ * w[5]; a3 += r_ * w[6] - i_ * w[7]; }
      *(GAS f32x4*)(Kg + ((size_t)(g * 32 + j) * 256 + ho * 16 + h4)) = (f32x4){a0, a1, a2, a3}; }
    LDS_WAIT(); asm volatile("" ::: "memory");
#undef pw
}

__device__ __forceinline__ float vmaxf(float a, float b) { float r; asm("v_max_f32_e32 %0, %1, %2" : "=v"(r) : "v"(a), "v"(b)); return r; }
__device__ __forceinline__ float vminf(float a, float b) { float r; asm("v_min_f32_e32 %0, %1, %2" : "=v"(r) : "v"(a), "v"(b)); return r; }
__device__ __forceinline__ float selhi(float lo, float hi) { float r; asm("v_cndmask_b32_e64 %0, %1, %2, %3" : "=v"(r) : "v"(lo), "v"(hi), "s"(0xFFFFFFFF00000000ull)); return r; }
#define CE_DESC(a, b) do { const float hi_ = vmaxf(a, b), lo_ = vminf(a, b); a = hi_; b = lo_; } while (0)
__device__ __forceinline__ void sort16_desc(float (&v)[16]) {
#pragma unroll
    for (int k = 2; k <= 16; k <<= 1)
#pragma unroll
        for (int j = k >> 1; j > 0; j >>= 1)
#pragma unroll
            for (int i = 0; i < 16; ++i) { const int l = i ^ j; if (l > i) { if ((i & k) == 0) CE_DESC(v[i], v[l]); else CE_DESC(v[l], v[i]); } }
}
__device__ __forceinline__ void bitonic_merge16_desc(float (&v)[16]) {
#pragma unroll
    for (int j = 8; j > 0; j >>= 1)
#pragma unroll
        for (int i = 0; i < 16; ++i) { const int l = i ^ j; if (l > i) CE_DESC(v[i], v[l]); }
}
__device__ __forceinline__ void merge_top16(float (&a)[16], const float (&b)[16]) {
#pragma unroll
    for (int i = 0; i < 16; ++i) a[i] = vmaxf(a[i], b[15 - i]);
    bitonic_merge16_desc(a);
}
__device__ __forceinline__ void merge_partner_top16(float (&a)[16]) {
    float p[16];
#pragma unroll
    for (int i = 0; i < 16; ++i) { const unsigned x = __float_as_uint(a[15 - i]); auto rr = __builtin_amdgcn_permlane32_swap(x, x, false, false); p[i] = selhi(__uint_as_float(rr[1]), __uint_as_float(rr[0])); }
#pragma unroll
    for (int i = 0; i < 16; ++i) a[i] = vmaxf(a[i], p[i]);
    bitonic_merge16_desc(a);
}
__device__ __forceinline__ void topk_half(int half, const bf16x8 (&qf)[8], int r32, int hi, const LAS unsigned char* ksl, float (&top)[16]) {
#pragma unroll 1
    for (int kt = 0; kt < 4; ++kt) {
        f32x16 acc = f32x16{};
        const int row = half * 128 + kt * 32 + r32; const LAS unsigned char* rp = ksl + row * 256; const int sw = row & 15;
#pragma unroll
        for (int ks = 0; ks < 8; ++ks) { const bf16x8 a = *(const LAS bf16x8*)(rp + (((2 * ks + hi) ^ sw) << 4));
            acc = __builtin_amdgcn_mfma_f32_32x32x16_bf16(a, qf[ks], acc, 0, 0, 0); }
        float grp[16];
#pragma unroll
        for (int r = 0; r < 16; ++r) { const unsigned key = (unsigned)(kt * 32 + (r & 3) + 8 * (r >> 2)) + 4u * (unsigned)hi; grp[r] = __uint_as_float((__float_as_uint(acc[r]) & ~127u) | key); }
        sort16_desc(grp);
        if (kt == 0) {
#pragma unroll
            for (int i = 0; i < 16; ++i) top[i] = grp[i];
        } else merge_top16(top, grp);
    }
    merge_partner_top16(top);
}
__device__ __forceinline__ void topk_task(int tt, int hd, int lane, LAS unsigned char* scr, const bf16* PQb, const LAS unsigned char* ksl, const float* ssq1, int* ids, float* gts, float* rstd1) {
    const int r32 = lane & 31, hi = lane >> 5; const bool hib = hi != 0;
    const int token = tt * 32 + r32;
    float v0_[16], v1_[16];
    bf16x8 qf0[8], qf1[8];
#pragma unroll
    for (int ks = 0; ks < 8; ++ks) { qf0[ks] = *(const GAS bf16x8*)(PQb + (size_t)token * PQ + hd * 256 + ks * 16 + hi * 8); qf1[ks] = *(const GAS bf16x8*)(PQb + (size_t)token * PQ + hd * 256 + 128 + ks * 16 + hi * 8); }
    topk_half(0, qf0, r32, hi, ksl, v0_);
    topk_half(1, qf1, r32, hi, ksl, v1_);
#define v_SEL(h, i) ((h) ? v1_[i] : v0_[i])
    LAS unsigned char* slot = scr + lane * 32;
    { v4u d0, d1;
#define PK4(h, k) ((__float_as_uint(v_SEL(h, 4 * (k))) & 127u) | ((__float_as_uint(v_SEL(h, 4 * (k) + 1)) & 127u) << 8) | ((__float_as_uint(v_SEL(h, 4 * (k) + 2)) & 127u) << 16) | ((__float_as_uint(v_SEL(h, 4 * (k) + 3)) & 127u) << 24))
      d0 = (v4u){PK4(0, 0), PK4(0, 1), PK4(0, 2), PK4(0, 3)}; d1 = (v4u){PK4(1, 0), PK4(1, 1), PK4(1, 2), PK4(1, 3)};
#undef PK4
      *(LAS v4u*)slot = d0; *(LAS v4u*)(slot + 16) = d1; }
    float a[16], b[16];
#pragma unroll
    for (int i = 0; i < 16; ++i) { a[i] = selhi(v0_[i], v1_[i]); b[i] = selhi(v1_[i], v0_[i]); }
    const unsigned obit = (unsigned)hi << 8;
#define CAND(i, j) __uint_as_float((__float_as_uint(a[i] + b[j]) & ~511u) | obit | (unsigned)(((i) << 4) | (j)))
    const float NEGBIG = -3.0e38f;
    float g0[16], g1[16];
#pragma unroll
    for (int j = 1; j < 16; ++j) g0[j - 1] = CAND(0, j);
    g0[15] = CAND(1, 2);
    g1[0] = CAND(1, 3); g1[1] = CAND(1, 4); g1[2] = CAND(1, 5); g1[3] = CAND(1, 6); g1[4] = CAND(1, 7); g1[5] = CAND(2, 3); g1[6] = CAND(2, 4);
    { const float c0 = CAND(0, 0), c1 = CAND(1, 1), c2 = CAND(2, 2), c3 = CAND(3, 3);
      g1[7] = selhi(c0, NEGBIG); g1[8] = selhi(c1, NEGBIG); g1[9] = selhi(c2, NEGBIG); g1[10] = selhi(c3, NEGBIG); }
#pragma unroll
    for (int i = 11; i < 16; ++i) g1[i] = NEGBIG;
#undef CAND
    sort16_desc(g0); sort16_desc(g1); merge_top16(g0, g1); merge_partner_top16(g0);
    float rstd;
    { const GAS f32x4* sp = (const GAS f32x4*)(ssq1 + (size_t)token * 16); const f32x4 s0 = sp[0], s1 = sp[1], s2 = sp[2], s3 = sp[3];
      const float ss = ((s0.x + s0.y) + (s0.z + s0.w)) + ((s1.x + s1.y) + (s1.z + s1.w)) + ((s2.x + s2.y) + (s2.z + s2.w)) + ((s3.x + s3.y) + (s3.z + s3.w));
      rstd = 1.0f / sqrtf(ss * (1.f / DMODEL) + RMS_EPS); }
    if (hd == 0 && !hib) rstd1[token] = rstd;
    float ex[16], esum = 0.f; const float sc = rstd * 1.4426950409f;
#pragma unroll
    for (int k = 0; k < 16; ++k) { ex[k] = __builtin_amdgcn_exp2f((g0[k] - g0[0]) * sc); esum += ex[k]; }
    const float inv = 1.0f / esum;
    int eid[8]; float gv[8];
#pragma unroll
    for (int k = 0; k < 8; ++k) { const float wv = selhi(g0[k], g0[8 + k]); const float ev = selhi(ex[k], ex[8 + k]);
        const unsigned tag = __float_as_uint(wv) & 511u, o = tag >> 8, i = (tag >> 4) & 15u, j = tag & 15u; const unsigned i1 = o ? j : i, i2 = o ? i : j;
        const unsigned k1 = slot[i1], k2 = slot[16 + i2];
        eid[k] = (int)(k1 * 128u + k2); gv[k] = ev * inv; }
    { int* ip = ids + (size_t)token * 128 + hd * 16 + 8 * hi; float* gp = gts + (size_t)token * 128 + hd * 16 + 8 * hi;
      *(GAS v4u*)ip = (v4u){(unsigned)eid[0], (unsigned)eid[1], (unsigned)eid[2], (unsigned)eid[3]}; *(GAS v4u*)(ip + 4) = (v4u){(unsigned)eid[4], (unsigned)eid[5], (unsigned)eid[6], (unsigned)eid[7]};
      *(GAS f32x4*)gp = (f32x4){gv[0], gv[1], gv[2], gv[3]}; *(GAS f32x4*)(gp + 4) = (f32x4){gv[4], gv[5], gv[6], gv[7]}; }
    LDS_WAIT(); asm volatile("" ::: "memory");
}


__device__ __forceinline__ float dot2bf(unsigned a, unsigned b, float c) { return __builtin_amdgcn_fdot2_f32_bf16(__builtin_bit_cast(bf16x2_t, a), __builtin_bit_cast(bf16x2_t, b), c, false); }
__device__ __forceinline__ h2_t fma_h2(unsigned v, h2_t w, h2_t acc) { return __builtin_elementwise_fma(__builtin_bit_cast(h2_t, v), w, acc); }
__device__ __forceinline__ unsigned fp8lo_bf(unsigned w, float sc) { return __builtin_bit_cast(unsigned, __builtin_amdgcn_cvt_scalef32_pk_bf16_fp8((int)w, sc, false)); }
__device__ __forceinline__ unsigned fp8hi_bf(unsigned w, float sc) { return __builtin_bit_cast(unsigned, __builtin_amdgcn_cvt_scalef32_pk_bf16_fp8((int)w, sc, true)); }
__device__ __forceinline__ h2_t fp8lo_h(unsigned w, float sc) { return __builtin_amdgcn_cvt_scalef32_pk_f16_fp8((int)w, sc, false); }
__device__ __forceinline__ h2_t fp8hi_h(unsigned w, float sc) { return __builtin_amdgcn_cvt_scalef32_pk_f16_fp8((int)w, sc, true); }
__device__ __forceinline__ unsigned pack_fp8x4(float a, float b, float c, float d) { int w = __builtin_amdgcn_cvt_pk_fp8_f32(a, b, 0, false); w = __builtin_amdgcn_cvt_pk_fp8_f32(c, d, w, true); return (unsigned)w; }
constexpr size_t V6B_OFF = 8u << 20;
constexpr float U8_SCALE = 64.0f, V8_SCALE = 5.656854f;
constexpr int PA_CAP = 456;
constexpr float X8_SCALE = 2.0f;
typedef int v8i_t __attribute__((ext_vector_type(8)));
typedef _Float16 v32h_t __attribute__((ext_vector_type(32)));
typedef unsigned v6u_t __attribute__((ext_vector_type(6)));
typedef unsigned v2u __attribute__((ext_vector_type(2)));
struct TokB { v8i_t b[8]; };
struct RowsA { const unsigned char* p0; const unsigned char* p1; };
__device__ __forceinline__ int pa_tok(unsigned tl, int tb, int nwg) { return ((tl < 4u) ? tb : nwg) + (int)(tl & 3u); }
__device__ __forceinline__ RowsA pa_rows(int b, int n, int lane, const LAS unsigned* list, const unsigned char* U6) {
    const int i0 = b * 16 + (lane >> 3), r8 = lane >> 3, ps = lane & 7;
    const unsigned e0 = list[i0 < n ? i0 : 0], e1 = list[i0 + 8 < n ? i0 + 8 : 0];
    RowsA R; R.p0 = U6 + (size_t)(e0 & 0x3fffu) * 768 + ((ps ^ r8) * 16); R.p1 = U6 + (size_t)(e1 & 0x3fffu) * 768 + ((ps ^ r8 ^ 1) * 16);
    return R;
}
template <int J> __device__ __forceinline__ void pa_dma(const RowsA& R, LAS unsigned char* ring) {
    __builtin_amdgcn_global_load_lds((const unsigned*)R.p0, (LAS unsigned*)(ring + J * (2048 - 128)), 16, J * 128, 0);
    __builtin_amdgcn_global_load_lds((const unsigned*)R.p1, (LAS unsigned*)(ring + J * (2048 - 128) + 1024), 16, J * 128, 0);
}
#define PA_VWAIT(n) asm volatile("s_waitcnt vmcnt(" #n ")" ::: "memory")
#define PA_LWAIT(n) asm volatile("s_waitcnt lgkmcnt(" #n ")" ::: "memory")
__device__ __forceinline__ int pa_uoff(int u, int r) { return (u >> 4) * 2048 + (r >> 3) * 1024 + (r & 7) * 128 + ((((u >> 1) & 7) ^ (r & 7) ^ (r >> 3)) << 4) + (u & 1) * 8; }
struct OpA { v2u d0, d1, d2; };
__device__ __forceinline__ OpA pa_rd(int m, const LAS unsigned char* ring, int r, int g) { const int u = 12 * m + 3 * g; OpA a;
    a.d0 = *(const LAS v2u*)(ring + pa_uoff(u, r)); a.d1 = *(const LAS v2u*)(ring + pa_uoff(u + 1, r)); a.d2 = *(const LAS v2u*)(ring + pa_uoff(u + 2, r)); return a; }
__device__ __forceinline__ f32x4 pa_mm(f32x4 acc, const OpA& a, const TokB& X, int m) {
    return __builtin_amdgcn_mfma_scale_f32_16x16x128_f8f6f4((v8i_t){(int)a.d0.x, (int)a.d0.y, (int)a.d1.x, (int)a.d1.y, (int)a.d2.x, (int)a.d2.y, 0, 0}, X.b[m], acc, 2, 2, 0, 0, 0, 0);
}
__device__ __forceinline__ void pa_flush(int n, const TokB& X, int lane, LAS unsigned* list, const LAS unsigned* gl, LAS unsigned char* ring, const unsigned char* U6, unsigned* wpk, int tb, int nwg) {
    if (n == 0) return;
    LDS_WAIT(); asm volatile("" ::: "memory");
    const int nb = (n + 15) >> 4;
    const int r = lane & 15, g = lane >> 4;
    RowsA cur = pa_rows(0, n, lane, list, U6), nxt = cur;
    pa_dma<0>(cur, ring); pa_dma<1>(cur, ring); pa_dma<2>(cur, ring); pa_dma<3>(cur, ring); pa_dma<4>(cur, ring); pa_dma<5>(cur, ring);
    for (int b = 0; b < nb; ++b) {
        f32x4 acc0 = {0.f, 0.f, 0.f, 0.f}, acc1 = {0.f, 0.f, 0.f, 0.f};
        OpA A0, A1;
        if (b + 1 < nb) {
            nxt = pa_rows(b + 1, n, lane, list, U6);
            PA_VWAIT(10); A0 = pa_rd(0, ring, r, g);
            PA_VWAIT(8);  A1 = pa_rd(1, ring, r, g); PA_LWAIT(3); acc0 = pa_mm(acc0, A0, X, 0);
            PA_VWAIT(6);  A0 = pa_rd(2, ring, r, g); PA_LWAIT(3); acc1 = pa_mm(acc1, A1, X, 1); pa_dma<0>(nxt, ring);
                          A1 = pa_rd(3, ring, r, g); PA_LWAIT(3); acc0 = pa_mm(acc0, A0, X, 2); pa_dma<1>(nxt, ring);
            PA_VWAIT(8);  A0 = pa_rd(4, ring, r, g); PA_LWAIT(3); acc1 = pa_mm(acc1, A1, X, 3); pa_dma<2>(nxt, ring);
            PA_VWAIT(8);  A1 = pa_rd(5, ring, r, g); PA_LWAIT(3); acc0 = pa_mm(acc0, A0, X, 4);
            PA_VWAIT(6);  A0 = pa_rd(6, ring, r, g); PA_LWAIT(3); acc1 = pa_mm(acc1, A1, X, 5); pa_dma<3>(nxt, ring);
                          A1 = pa_rd(7, ring, r, g); PA_LWAIT(3); acc0 = pa_mm(acc0, A0, X, 6); pa_dma<4>(nxt, ring);
                                                     PA_LWAIT(0); acc1 = pa_mm(acc1, A1, X, 7); pa_dma<5>(nxt, ring);
            cur = nxt;
        } else {
            PA_VWAIT(0);
            A0 = pa_rd(0, ring, r, g);
#pragma unroll
            for (int m = 0; m < 8; m += 2) { A1 = pa_rd(m + 1, ring, r, g); PA_LWAIT(3); acc0 = pa_mm(acc0, A0, X, m);
                if (m + 2 < 8) { A0 = pa_rd(m + 2, ring, r, g); PA_LWAIT(3); } else PA_LWAIT(0);
                acc1 = pa_mm(acc1, A1, X, m + 1); }
        }
        const f32x4 acc = acc0 + acc1;
        const int idx = b * 16 + r; const unsigned ent = list[idx], tl = ent >> 21, slot = (ent >> 14) & 127u;
        const int src = (int)((((unsigned)r >> 2) * 16u + tl) << 2);
        const float v0 = __int_as_float(__builtin_amdgcn_ds_bpermute(src, __float_as_int(acc.x))), v1 = __int_as_float(__builtin_amdgcn_ds_bpermute(src, __float_as_int(acc.y)));
        const float v2 = __int_as_float(__builtin_amdgcn_ds_bpermute(src, __float_as_int(acc.z))), v3 = __int_as_float(__builtin_amdgcn_ds_bpermute(src, __float_as_int(acc.w)));
        const float dv = (r & 2) ? ((r & 1) ? v3 : v2) : ((r & 1) ? v1 : v0);
        if (lane < 16 && idx < n) { const int t = pa_tok(tl, tb, nwg);
            const _Float16 wh = (_Float16)(__uint_as_float(gl[tl * 128 + slot]) * (1.0f / V8_SCALE) * gelu_tanh(dv * (1.0f / (U8_SCALE * X8_SCALE))));
            const unsigned pos = __hip_atomic_fetch_add((LAS unsigned*)(list + PA_CAP) + tl, 1u, __ATOMIC_RELAXED, __HIP_MEMORY_SCOPE_WAVEFRONT);
            wpk[(size_t)t * 128 + pos] = ((unsigned)__builtin_bit_cast(unsigned short, wh) << 16) | (ent & 0x3fffu); }
    }
    LDS_WAIT(); asm volatile("" ::: "memory");
}
__device__ __forceinline__ void peer_a_phase(int lane, int wave, int G, int vcu, const bf16* XG, const unsigned char* U6, const int* ids, const float* gts, const float* rstd1, unsigned* wpk, LAS unsigned char* lds, int emask) {
    (void)emask;
    LAS unsigned char* ring = lds + RING_OFF + wave * 16384;
    LAS unsigned* gl = (LAS unsigned*)(ring + 12288);
    LAS unsigned* list = (LAS unsigned*)(lds + MISC_OFF + 128 + wave * (464 * 4));
    for (int tile0 = vcu; tile0 < MTOK / 32; tile0 += 2 * G) {
        const int tile1 = tile0 + G; const bool has1 = tile1 < MTOK / 32;
        const int tb = tile0 * 32 + wave * 4, nwg = (has1 ? tile1 : tile0) * 32 + wave * 4;
        int id0[8], id1[8];
        if (lane < 8) list[PA_CAP + lane] = 0u;
#pragma unroll
        for (int k = 0; k < 8; ++k) { const bool ok = (k < 4) || has1; const int tc = pa_tok((unsigned)k, tb, nwg);
            gl[k * 128 + lane] = __float_as_uint(gts[(size_t)tc * 128 + lane]); gl[k * 128 + 64 + lane] = __float_as_uint(gts[(size_t)tc * 128 + 64 + lane]);
            id0[k] = ok ? ids[(size_t)tc * 128 + lane] : -1; id1[k] = ok ? ids[(size_t)tc * 128 + 64 + lane] : -1; }
#pragma unroll
        for (int p = 0; p < 4; ++p) { const int k = 2 * p + (lane >> 5), tc = pa_tok((unsigned)k, tb, nwg);
            typedef float v16f_t __attribute__((ext_vector_type(16)));
            const GAS v4u* xs = (const GAS v4u*)(XG + (size_t)tc * 1024 + 32 * (lane & 31));
            const v4u x0 = xs[0], x1 = xs[1], x2 = xs[2], x3 = xs[3];
            const float rs = rstd1[tc] * X8_SCALE;
            const unsigned w[16] = {x0.x, x0.y, x0.z, x0.w, x1.x, x1.y, x1.z, x1.w, x2.x, x2.y, x2.z, x2.w, x3.x, x3.y, x3.z, x3.w};
            float f[32];
#pragma unroll
            for (int i = 0; i < 16; ++i) { f[2 * i] = __uint_as_float(w[i] << 16) * rs; f[2 * i + 1] = __uint_as_float(w[i] & 0xffff0000u) * rs; }
            const v16f_t lo16 = {f[0], f[1], f[2], f[3], f[4], f[5], f[6], f[7], f[8], f[9], f[10], f[11], f[12], f[13], f[14], f[15]},
                         hi16 = {f[16], f[17], f[18], f[19], f[20], f[21], f[22], f[23], f[24], f[25], f[26], f[27], f[28], f[29], f[30], f[31]};
            v6u_t p6; asm volatile("s_nop 1\n\tv_cvt_scalef32_2xpk16_fp6_f32 %0, %1, %2, 1.0" : "=&v"(p6) : "v"(lo16), "v"(hi16));
            LAS v2u* dst = (LAS v2u*)(ring + k * 768 + 24 * (lane & 31)); dst[0] = (v2u){p6[0], p6[1]}; dst[1] = (v2u){p6[2], p6[3]}; dst[2] = (v2u){p6[4], p6[5]}; }
        LDS_WAIT(); asm volatile("" ::: "memory");
        TokB X;
#pragma unroll
        for (int m = 0; m < 8; ++m) { const LAS v2u* xp = (const LAS v2u*)(ring + (lane & 7) * 768 + m * 96 + (lane >> 4) * 24);
            const v2u d0 = xp[0], d1 = xp[1], d2 = xp[2];
            X.b[m] = (v8i_t){(int)d0.x, (int)d0.y, (int)d1.x, (int)d1.y, (int)d2.x, (int)d2.y, 0, 0}; }
        LDS_WAIT(); asm volatile("" ::: "memory");
        int n = 0;
        for (int part = 0; part < 8; ++part) {
#pragma unroll
            for (int k = 0; k < 8; ++k) {
                { const bool sel = (id0[k] >> 11) == part; const unsigned long long m = __ballot(sel);
                  const int pos = n + (int)__builtin_amdgcn_mbcnt_hi((unsigned)(m >> 32), __builtin_amdgcn_mbcnt_lo((unsigned)m, 0u));
                  if (sel) list[pos] = ((unsigned)k << 21) | ((unsigned)lane << 14) | (unsigned)id0[k]; n += __builtin_popcountll(m); }
                { const bool sel = (id1[k] >> 11) == part; const unsigned long long m = __ballot(sel);
                  const int pos = n + (int)__builtin_amdgcn_mbcnt_hi((unsigned)(m >> 32), __builtin_amdgcn_mbcnt_lo((unsigned)m, 0u));
                  if (sel) list[pos] = ((unsigned)k << 21) | ((unsigned)(64 + lane) << 14) | (unsigned)id1[k]; n += __builtin_popcountll(m); }
                if (n > PA_CAP - 128) { pa_flush(n, X, lane, list, gl, ring, U6, wpk, tb, nwg); n = 0; }
            }
        }
        pa_flush(n, X, lane, list, gl, ring, U6, wpk, tb, nwg);
    }
}
template <int NT> __device__ __forceinline__ void final_tokens(const int (&t)[NT], int lane, const unsigned short* Y16, float* X1, const float* fg) {
    f32x4 x0[NT], x1[NT], x2[NT], x3[NT]; v4u ya[NT], yb[NT];
#pragma unroll
    for (int n = 0; n < NT; ++n) { const GAS f32x4* xp = (const GAS f32x4*)(X1 + (size_t)t[n] * 1024 + 8 * lane); x0[n] = xp[0]; x1[n] = xp[1]; x2[n] = xp[128]; x3[n] = xp[129];
        ya[n] = *(const GAS v4u*)(Y16 + (size_t)t[n] * 1024 + 8 * lane); yb[n] = *(const GAS v4u*)(Y16 + (size_t)t[n] * 1024 + 512 + 8 * lane); }
    const GAS f32x4* gp = (const GAS f32x4*)(fg + 8 * lane); const f32x4 g0 = gp[0], g1 = gp[1], g2 = gp[128], g3 = gp[129];
#pragma unroll
    for (int n = 0; n < NT; ++n) {
        const unsigned yw[8] = {ya[n].x, ya[n].y, ya[n].z, ya[n].w, yb[n].x, yb[n].y, yb[n].z, yb[n].w};
        float y[16];
#pragma unroll
        for (int i = 0; i < 8; ++i) { const unsigned w = yw[i]; const h2_t h = __builtin_bit_cast(h2_t, w); y[2 * i] = (float)h[0]; y[2 * i + 1] = (float)h[1]; }
        const f32x4 a0 = x0[n] + (f32x4){y[0], y[1], y[2], y[3]}, a1 = x1[n] + (f32x4){y[4], y[5], y[6], y[7]}, a2 = x2[n] + (f32x4){y[8], y[9], y[10], y[11]}, a3 = x3[n] + (f32x4){y[12], y[13], y[14], y[15]};
        const float ss = (a0.x * a0.x + a0.y * a0.y) + (a0.z * a0.z + a0.w * a0.w) + (a1.x * a1.x + a1.y * a1.y) + (a1.z * a1.z + a1.w * a1.w)
                       + (a2.x * a2.x + a2.y * a2.y) + (a2.z * a2.z + a2.w * a2.w) + (a3.x * a3.x + a3.y * a3.y) + (a3.z * a3.z + a3.w * a3.w);
        const float rstd2 = 1.0f / sqrtf(wave_sum(ss) * (1.f / DMODEL) + RMS_EPS);
        GAS f32x4* xo = (GAS f32x4*)(X1 + (size_t)t[n] * 1024 + 8 * lane);
        xo[0] = a0 * rstd2 * g0; xo[1] = a1 * rstd2 * g1; xo[128] = a2 * rstd2 * g2; xo[129] = a3 * rstd2 * g3; }
}
#ifndef REP_0
#define REP_0 1
#endif
#ifndef REP_1
#define REP_1 1
#endif
#ifndef REP_2
#define REP_2 1
#endif
#ifndef REP_3
#define REP_3 1
#endif
#ifndef REP_4
#define REP_4 1
#endif
#ifndef REP_5
#define REP_5 1
#endif
#ifndef REP_6
#define REP_6 1
#endif
#ifndef REP_7
#define REP_7 1
#endif
#ifndef REP_8
#define REP_8 1
#endif
#ifndef REP_9
#define REP_9 1
#endif
#ifndef REP_10
#define REP_10 1
#endif
#ifndef REP_11
#define REP_11 1
#endif
__device__ __forceinline__ void pb_rows(v4u* Ra, v2u* Rb, const v4u w, const unsigned char* vbase, size_t vboff) {
    const unsigned pw[4] = {w.x, w.y, w.z, w.w};
#pragma unroll
    for (int i = 0; i < 4; ++i) { const size_t e = pw[i] & 0xffffu; Ra[i] = *(const GAS v4u*)(vbase + e * 256); Rb[i] = *(const GAS v2u*)(vbase + vboff + e * 128); }
}
__device__ __forceinline__ void pb_fma(h2_t (&acc)[16], const v4u* Ra, const v2u* Rb, const v4u w) {
    const unsigned pw[4] = {w.x, w.y, w.z, w.w};
#pragma unroll
    for (int i = 0; i < 4; ++i) { const unsigned p = pw[i]; const h2_t pp = __builtin_bit_cast(h2_t, p); const _Float16 wv = pp[1]; const h2_t w2 = {wv, wv};
        const v4u ra = Ra[i]; const v2u rb = Rb[i]; const v6u_t x6 = {ra.x, ra.y, ra.z, ra.w, rb.x, rb.y};
        v32h_t h; asm("v_cvt_scalef32_pk32_f16_fp6 %0, %1, 1.0" : "=&v"(h) : "v"(x6));
#pragma unroll
        for (int j = 0; j < 16; ++j) { const h2_t hv = {h[2 * j], h[2 * j + 1]}; acc[j] = __builtin_elementwise_fma(hv, w2, acc[j]); } }
}
__device__ __forceinline__ void peer_b_phase(int lane, int wave, int G, int vcu, const unsigned char* V6s, const unsigned* wpk, unsigned short* Y16, float* X1, const float* fg, bool fin) {
    const int q = lane & 15;
    for (int tile0 = vcu; tile0 < MTOK / 32; tile0 += 2 * G) {
        const int tile1 = tile0 + G; const bool has1 = tile1 < MTOK / 32;
        const int tb = tile0 * 32 + wave * 4, nwg = (has1 ? tile1 : tile0) * 32 + wave * 4;
        for (int pass = 0; pass < 4; ++pass) { const int hc = pass >> 1, k = (lane >> 4) + 4 * (pass & 1);
            const int t = pa_tok((unsigned)k, tb, nwg);
            const unsigned* wrow = wpk + (size_t)t * 128;
            const unsigned char* vbase = V6s + (size_t)hc * NEXP * 256 + q * 16;
            const size_t vboff = V6B_OFF + (size_t)hc * NEXP * 128 + q * 8 - ((size_t)hc * NEXP * 256 + q * 16);
            h2_t acc[16];
#pragma unroll
            for (int j = 0; j < 16; ++j) acc[j] = (h2_t){(_Float16)0.f, (_Float16)0.f};
            v4u W[6], Ra[16]; v2u Rb[16];
#pragma unroll
            for (int u = 0; u < 6; ++u) W[u] = *(const GAS v4u*)(wrow + 4 * u);
#pragma unroll
            for (int u = 0; u < 4; ++u) pb_rows(Ra + 4 * u, Rb + 4 * u, W[u], vbase, vboff);
#pragma unroll
            for (int u = 0; u < 32; ++u) {
                pb_fma(acc, Ra + 4 * (u & 3), Rb + 4 * (u & 3), W[u % 6]);
                if (u + 4 < 32) pb_rows(Ra + 4 * (u & 3), Rb + 4 * (u & 3), W[(u + 4) % 6], vbase, vboff);
                if (u + 6 < 32) W[u % 6] = *(const GAS v4u*)(wrow + 4 * (u + 6));
            }
            GAS v4u* yout = (GAS v4u*)(Y16 + (size_t)t * 1024 + hc * 512 + q * 32);
#pragma unroll
            for (int j = 0; j < 4; ++j) yout[j] = (v4u){__builtin_bit_cast(unsigned, acc[4 * j]), __builtin_bit_cast(unsigned, acc[4 * j + 1]), __builtin_bit_cast(unsigned, acc[4 * j + 2]), __builtin_bit_cast(unsigned, acc[4 * j + 3])};
        }
        asm volatile("s_waitcnt vmcnt(0)" ::: "memory");
        if (fin) { const int ta[4] = {tb, tb + 1, tb + 2, tb + 3}; final_tokens<4>(ta, lane, Y16, X1, fg);
            if (has1) { const int tc[4] = {nwg, nwg + 1, nwg + 2, nwg + 3}; final_tokens<4>(tc, lane, Y16, X1, fg); } }
    }
}
template <int NR> __device__ __forceinline__ void cvt_load(f32x4 (&q)[NR / 2][8], const float* table, int ex, int stride, int lane) {
#pragma unroll
    for (int k = 0; k < NR / 2; ++k) { const int e = ex + (2 * k + (lane >> 5)) * stride; const float* src = table + (size_t)(e < NEXP ? e : ex) * 1024 + 32 * (lane & 31);
#pragma unroll
        for (int j = 0; j < 8; ++j) q[k][j] = *(const GAS f32x4*)(src + 4 * j); }
}
template <int NR> __device__ __forceinline__ void cvt_store(const f32x4 (&q)[NR / 2][8], int ex, int stride, bool isv, int lane, unsigned char* U8, unsigned char* V8) {
    typedef float v16f_t __attribute__((ext_vector_type(16)));
#pragma unroll
    for (int k = 0; k < NR / 2; ++k) { const int e = ex + (2 * k + (lane >> 5)) * stride; if (e < NEXP) {
        if (!isv) {
            float f[32];
#pragma unroll
            for (int j = 0; j < 8; ++j) { const f32x4 t = q[k][j] * U8_SCALE; f[4 * j] = t.x; f[4 * j + 1] = t.y; f[4 * j + 2] = t.z; f[4 * j + 3] = t.w; }
            const v16f_t lo16 = {f[0], f[1], f[2], f[3], f[4], f[5], f[6], f[7], f[8], f[9], f[10], f[11], f[12], f[13], f[14], f[15]},
                         hi16 = {f[16], f[17], f[18], f[19], f[20], f[21], f[22], f[23], f[24], f[25], f[26], f[27], f[28], f[29], f[30], f[31]};
            v6u_t p6; asm volatile("s_nop 1\n\tv_cvt_scalef32_2xpk16_fp6_f32 %0, %1, %2, 1.0" : "=&v"(p6) : "v"(lo16), "v"(hi16));
            GAS v2u* dst = (GAS v2u*)(U8 + (size_t)e * 768 + 24 * (lane & 31)); dst[0] = (v2u){p6[0], p6[1]}; dst[1] = (v2u){p6[2], p6[3]}; dst[2] = (v2u){p6[4], p6[5]};
        } else {
            v32h_t h;
#pragma unroll
            for (int j = 0; j < 8; ++j) { const f32x4 t = q[k][j] * V8_SCALE; h[4 * j] = (_Float16)t.x; h[4 * j + 1] = (_Float16)t.y; h[4 * j + 2] = (_Float16)t.z; h[4 * j + 3] = (_Float16)t.w; }
            v6u_t p6; asm volatile("s_nop 1\n\tv_cvt_scalef32_pk32_fp6_f16 %0, %1, 1.0" : "=&v"(p6) : "v"(h));
            const size_t ro = (size_t)((lane & 31) >> 4) * NEXP + e;
            *(GAS v4u*)(V8 + ro * 256 + (lane & 15) * 16) = (v4u){p6[0], p6[1], p6[2], p6[3]}; *(GAS v2u*)(V8 + V6B_OFF + ro * 128 + (lane & 15) * 8) = (v2u){p6[4], p6[5]}; } } }
}
struct OnePanel { int pm, n; __device__ __forceinline__ bool next(int i, pg8::Unit& u) const { if (i >= n) return false; u.pm = pm; u.pn = i; u.w = 0; return true; } };
struct DualOrder { pg8::StaticOrder S; __device__ __forceinline__ bool next(int i, pg8::Unit& u) const { if (!S.next(i >> 1, u)) return false; u.w = i & 1; return true; } };
struct Args { const float* in[24]; float* out; unsigned char* ws; int ph_lo, ph_hi, li, pad; };
__global__ void __launch_bounds__(NWAVES * 64, 2) mk_fwd(Args args) {
    extern __shared__ __attribute__((aligned(16))) unsigned char lds[];
    Frame F;
    F.lds = (LAS unsigned char*)lds;
    volatile LAS unsigned* MISC = (volatile LAS unsigned*)(F.lds + MISC_OFF);
    F.tid = threadIdx.x; F.lane = F.tid & 63; F.wave = __builtin_amdgcn_readfirstlane(F.tid >> 6);
    F.G = gridDim.x; { const int bx = blockIdx.x; F.vcu = (F.G % 8 == 0) ? (bx % 8) * (F.G / 8) + bx / 8 : bx; }
    unsigned char* ws = args.ws;
    gu32* ctl = (gu32*)(ws + WS_CTL);
    for (int u = F.tid; u < (LDS_BYTES - LDSCTL_OFF) / 4; u += NWAVES * 64) ((LAS unsigned*)(F.lds + LDSCTL_OFF))[u] = 0u;
    __syncthreads();
    XcdBarrier bar; bar.bar = (unsigned*)(ctl + CW_BAR); bar.x = 0; bar.st = nullptr;
    if (N_LAUNCHES != PER_PHASE) bar = xcd_barrier_post((unsigned*)(ctl + CW_BAR), MISC + 8);
#define GRID_BAR() do { if (N_LAUNCHES != PER_PHASE) xcd_barrier(bar); } while (0)
    const int lo = args.ph_lo, hi = args.ph_hi;
#ifndef PH_MASK
#define PH_MASK 0xFFFF
#endif
#define IN(k) ((((PH_MASK) >> (k)) & 1) && lo <= (k) && (k) < hi)
#define BOTH(k) (IN(k) && IN((k) + 1))
    const int gw = F.vcu * NWAVES + F.wave, NGW = F.G * NWAVES;
    const int gtid = F.vcu * (NWAVES * 64) + F.tid, NTHR = F.G * NWAVES * 64;
    const float* x = args.in[0];
    bf16* Win_t = (bf16*)(ws + WS_WIN); bf16* Wq_t = (bf16*)(ws + WS_WQ); bf16* Wout_t = (bf16*)(ws + WS_WOUT); bf16* Wus_t = (bf16*)(ws + WS_WUS); bf16* Wua_t = (bf16*)(ws + WS_WUA);
    bf16* Wglu_t = (bf16*)(ws + WS_WGLU); bf16* KSb = (bf16*)(ws + WS_KS); bf16* WE = (bf16*)(ws + WS_WE); bf16* BP = (bf16*)(ws + WS_BP); bf16* AP = (bf16*)(ws + WS_AP);
    float* Eb = (float*)(ws + WS_E); bf16* Hb = (bf16*)(ws + WS_H); bf16* Ypre = (bf16*)(ws + WS_YPRE); bf16* Ya = (bf16*)(ws + WS_YA); bf16* XG = (bf16*)(ws + WS_XG);
    bf16* Zb = (bf16*)(ws + WS_Z); bf16* Qb = (bf16*)(ws + WS_Z + 1 * ZSTRIDE_B); bf16* Kb = (bf16*)(ws + WS_Z + 2 * ZSTRIDE_B); bf16* Vb = (bf16*)(ws + WS_Z + 3 * ZSTRIDE_B);
    bf16* GA = (bf16*)(ws + WS_Z + 4 * ZSTRIDE_B); bf16* GB = (bf16*)(ws + WS_Z + 6 * ZSTRIDE_B);
    bf16* Yb = (bf16*)(ws + WS_YB); bf16* Mrg = (bf16*)(ws + WS_MRG); bf16* PQb = (bf16*)(ws + WS_PQ); int* ids = (int*)(ws + WS_IDS); float* gts = (float*)(ws + WS_GTS);
    unsigned char* U8 = ws + WS_U16; unsigned char* V8 = ws + WS_V16; unsigned* wpk = (unsigned*)(ws + WS_WPK); float* rstd1 = (float*)(ws + WS_RSTD1); unsigned short* Y16 = (unsigned short*)(ws + WS_Y16);
    float* biasT = (float*)(ws + WS_BIAS); float* pw32 = (float*)(ws + WS_PW32); float* kpart = (float*)(ws + WS_KPART); float* Kg = (float*)(ws + WS_KG); float* ssq1 = (float*)(ws + WS_SSQ1);

    if (IN(0)) for (int rep_ = 0; rep_ < REP_0; ++rep_) {
        LAS float* scr = (LAS float*)(F.lds + RING_OFF + F.wave * 16384);
        constexpr int I_IN = (1024 / 64) * (4096 / 32), I_GLU = (512 / 64) * (512 / 32), I_UP = (512 / 64) * (1024 / 32), I_OUT = (1024 / 64) * (1024 / 32), I_Q = (1024 / 64) * (2048 / 32);
        constexpr int NITEMS = I_IN + I_GLU + 2 * I_UP + I_OUT + I_Q;
        for (int it = gw; it < NITEMS; it += NGW) {
            int r = it;
            if (r < I_IN) { p0_transpose_item(args.in[2], 1024, 4096, Win_t, scr, r, F.lane); continue; } r -= I_IN;
            if (r < I_GLU) { p0_transpose_item(args.in[11], 512, 512, Wglu_t, scr, r, F.lane); continue; } r -= I_GLU;
            if (r < I_UP) { p0_transpose_item(args.in[13], 512, 1024, Wus_t, scr, r, F.lane); continue; } r -= I_UP;
            if (r < I_UP) { p0_transpose_item(args.in[14], 512, 1024, Wua_t, scr, r, F.lane); continue; } r -= I_UP;
            if (r < I_OUT) { p0_transpose_item(args.in[16], 1024, 1024, Wout_t, scr, r, F.lane); continue; } r -= I_OUT;
            p0_transpose_item(args.in[18], 1024, 2048, Wq_t, scr, r, F.lane);
        }
        for (int it = gw; it < NGRP * CH; it += NGW)
            ssm_table_task(it >> 5, it & 31, F.lane, scr, args.in[3], args.in[4], args.in[5], args.in[6], args.in[7], args.in[8], args.in[9], Kg, WE, BP, pw32);
        for (int m = gw; m < MTOK; m += NGW * 4) rms_rows4_to_bf16(x, args.in[1], Hb, m, NGW, F.lane);
        for (int it = gw; it < 64; it += NGW) { const float* src = (it < 32 ? args.in[19] : args.in[20]) + (size_t)(it & 31) * 512 + 8 * F.lane;
            const f32x4 a = *(const GAS f32x4*)src, b = *(const GAS f32x4*)(src + 4);
            *(GAS v4u*)(KSb + (size_t)it * 512 + 8 * F.lane) = (v4u){pk2(a.x, a.y), pk2(a.z, a.w), pk2(b.x, b.y), pk2(b.z, b.w)}; }
        if (gw == 0) { for (int i = F.lane; i < 8 * 128; i += 64) { const int h = i >> 7, rel = i & 127; int bk;
                if (rel < 16) bk = rel; else { const float lg = logf((float)rel / 16.0f) / 2.0794415416798357f * 16.0f; bk = 16 + (int)lg; bk = bk < 0 ? 0 : (bk > 31 ? 31 : bk); }
                biasT[i] = (args.in[15][bk * 8 + h] - args.in[15][31 * 8 + h]) * 1.4426950408889634f; } }
        if (BOTH(0)) GRID_BAR();
    }

    if (IN(1)) for (int rep_ = 0; rep_ < REP_1; ++rep_) {
        const float* Dsk = args.in[10];
        for (int i0 = gtid; i0 < NGRP * 512 * 64; i0 += NTHR * 4) {
            f32x4 ka[4], kb[4];
#pragma unroll
            for (int q = 0; q < 4; ++q) { const int i = i0 + q * NTHR; const int ic = (i < NGRP * 512 * 64) ? i : i0; const int g = ic >> 15, m = (ic >> 6) & 511, k8 = ic & 63, j = m >> 4, ho = m & 15, jp = k8 >> 1, hi0 = (k8 & 1) * 8;
                const int lag = (jp <= j) ? j - jp : 0; const float* kp = Kg + ((size_t)(g * 32 + lag) * 256 + ho * 16 + hi0); ka[q] = *(const GAS f32x4*)kp; kb[q] = *(const GAS f32x4*)(kp + 4); }
#pragma unroll
            for (int q = 0; q < 4; ++q) { const int i = i0 + q * NTHR; if (i >= NGRP * 512 * 64) break; const int g = i >> 15, m = (i >> 6) & 511, k8 = i & 63, j = m >> 4, ho = m & 15, jp = k8 >> 1, hi0 = (k8 & 1) * 8;
                v4u o = (v4u){0u, 0u, 0u, 0u};
                if (jp <= j) { f32x4 a = ka[q], b = kb[q];
                    if (jp == j && (ho >> 3) == (hi0 >> 3)) { const float dv = Dsk[g * 16 + ho]; const int e = ho & 7;
                        a.x += (e == 0) ? dv : 0.f; a.y += (e == 1) ? dv : 0.f; a.z += (e == 2) ? dv : 0.f; a.w += (e == 3) ? dv : 0.f;
                        b.x += (e == 4) ? dv : 0.f; b.y += (e == 5) ? dv : 0.f; b.z += (e == 6) ? dv : 0.f; b.w += (e == 7) ? dv : 0.f; }
                    o = (v4u){pk2(a.x, a.y), pk2(a.z, a.w), pk2(b.x, b.y), pk2(b.z, b.w)}; }
                *(GAS v4u*)(BP + ((size_t)(g * 512 + m) * APK + k8 * 8)) = o; } }
        pg8::Gemm g{Hb, Win_t, MTOK, INCOLS, 1024, 1024, 1024, 1 << 30, 0};
        pg8::StaticOrder S; S.init(MTOK, INCOLS, F.G, (int)blockIdx.x);
        pg8::EpiIn E{Zb, AP, kpart};
        pg8::gemm_phase<pg8::EpiIn, pg8::StaticOrder, true>(F.lds + RING_OFF, g, S, E);
        if (BOTH(1)) GRID_BAR();
    }

    if (IN(2)) for (int rep_ = 0; rep_ < REP_2; ++rep_) {
        const int bx = (int)blockIdx.x;
        const bool shared = F.G < 4;
        const int nS = shared ? F.G : (F.G >= 256 ? 64 : F.G / 4), nA = shared ? F.G : F.G - nS;
        const bool inS = shared || bx < nS, inA = shared || bx >= nS; const int aidx = shared ? bx : bx - nS;
        if (inS) {
#pragma unroll 1
            for (int pm = bx; pm < MTOK / 256; pm += nS) {
                { pg8::Gemm g1{AP, WE, MTOK, 256, 512, APK, 512, 2, (size_t)256 * 512}; OnePanel S1{pm, 1}; pg8::EpiE E1{Eb};
                  pg8::gemm_phase<pg8::EpiE, OnePanel, true>(F.lds + RING_OFF, g1, S1, E1); }
                VM_WAIT(); __syncthreads();
                if (F.tid < 256) { const int gb = (pm >> 1) * 8 + (pm & 1) * 4 + (F.tid >> 6), g_ = gb >> 3, p = F.tid & 63; const size_t row0 = (size_t)gb * 64;
                    const float mr = pw32[g_ * 128 + p], mi = pw32[g_ * 128 + 64 + p]; float sr = 0.f, si = 0.f;
#pragma unroll 1
                    for (int c0 = 0; c0 < NCHUNK; c0 += 32) { float er[32], ei[32];
#pragma unroll
                        for (int c = 0; c < 32; ++c) { er[c] = Eb[(row0 + c0 + c) * 128 + p]; ei[c] = Eb[(row0 + c0 + c) * 128 + 64 + p]; }
#pragma unroll
                        for (int c = 0; c < 32; ++c) { bf16* ap = AP + (row0 + c0 + c) * APK + 512; ap[p] = (bf16)f2bf(sr); ap[64 + p] = (bf16)f2bf(si);
                            const float nr = mr * sr - mi * si + er[c], ni = mr * si + mi * sr + ei[c]; sr = nr; si = ni; } } }
                VM_WAIT(); __syncthreads();
                { pg8::Gemm g{AP, BP, MTOK, 512, APK, APK, APK, 2, (size_t)512 * APK}; OnePanel S3{pm, 2}; pg8::EpiY E{Ypre};
                  pg8::gemm_phase<pg8::EpiY, OnePanel, true>(F.lds + RING_OFF, g, S3, E); }
            }
        }
        if (inA) {
            static_assert(attn_body::ATTN_LDS_BYTES <= RING_BYTES, "attention LDS");
#pragma unroll 1
            for (int a = aidx; a < 192; a += nA) { const int ty = a >> 6, bh = a & 63;
#pragma unroll 1
                for (int i = 0; i < 4; ++i) { const int qb = (ty == 0) ? (i == 0 ? 7 : (i == 1 ? 2 : (i == 2 ? 0 : -1))) : (ty == 1) ? (i == 0 ? 6 : (i == 1 ? 4 : -1)) : (i == 0 ? 5 : (i == 1 ? 3 : (i == 2 ? 1 : -1)));
                    if (qb < 0) break;
                    attn_body::attn_unit<8>(bh >> 3, bh & 7, qb, (const attn_body::bf16*)Qb, (const attn_body::bf16*)Kb, (const attn_body::bf16*)Vb, (attn_body::bf16*)Yb, (char*)lds + RING_OFF, kpart, biasT); } }
        }
        if (BOTH(2)) GRID_BAR();
    }

    if (IN(3)) for (int rep_ = 0; rep_ < REP_3; ++rep_) {
        pg8::Gemm g{Ypre, Wglu_t, MTOK, 512, 512, 512, 512, 1 << 30, 0};
        pg8::StaticOrder S; S.init(MTOK, 512, F.G, (int)blockIdx.x);
        pg8::EpiGlu E{Ypre, Ya, args.in[12]};
        pg8::gemm_phase<pg8::EpiGlu, pg8::StaticOrder, true>(F.lds + RING_OFF, g, S, E);
        { const int nun = (MTOK / 256) * (512 / 256);
          const bool split = F.G >= 2 * nun; const int nconv = split ? nun : F.G, cidx = split ? ((int)blockIdx.x % nun) : (int)blockIdx.x;
          const int stride = nconv * NWAVES, step = stride * 4, ex0 = cidx * NWAVES + F.wave;
          const int ncall = (NEXP - ex0 + step - 1) / step;
          int c_lo = 0, c_hi = 2 * ncall;
          if (split) { const int cut = (2 * ncall * 3) / 4; if ((int)blockIdx.x < nun) c_lo = cut; else if ((int)blockIdx.x < 2 * nun) c_hi = cut; else c_hi = 0; }
          f32x4 qa[2][8], qb[2][8];
#define CV_TAB(c) ((c) < ncall ? args.in[21] : args.in[22])
#define CV_EX(c) (ex0 + ((c) < ncall ? (c) : (c) - ncall) * step)
          if (c_lo < c_hi) cvt_load<4>(qa, CV_TAB(c_lo), CV_EX(c_lo), stride, F.lane);
          for (int c = c_lo; c < c_hi; c += 2) {
              if (c + 1 < c_hi) cvt_load<4>(qb, CV_TAB(c + 1), CV_EX(c + 1), stride, F.lane);
              cvt_store<4>(qa, CV_EX(c), stride, c >= ncall, F.lane, U8, V8);
              if (c + 2 < c_hi) cvt_load<4>(qa, CV_TAB(c + 2), CV_EX(c + 2), stride, F.lane);
              if (c + 1 < c_hi) cvt_store<4>(qb, CV_EX(c + 1), stride, c + 1 >= ncall, F.lane, U8, V8);
          } }
#undef CV_TAB
#undef CV_EX
        if (BOTH(3)) GRID_BAR();
    }

    if (IN(4)) for (int rep_ = 0; rep_ < REP_4; ++rep_) {
        pg8::Gemm g{Ya, Wus_t, MTOK, 1024, 512, 512, 512, 1 << 30, 0, Yb, Wua_t};
        DualOrder S; S.S.init(MTOK, 1024, F.G, (int)blockIdx.x);
        pg8::EpiMrgDual E{pg8::EpiMrg<0>{GA, Mrg}, pg8::EpiMrg<1>{GB, Mrg}};
        pg8::gemm_phase<pg8::EpiMrgDual, DualOrder, true>(F.lds + RING_OFF, g, S, E);
        if (BOTH(4)) GRID_BAR();
    }

    if (IN(5)) for (int rep_ = 0; rep_ < REP_5; ++rep_) {
        pg8::Gemm g{Mrg, Wout_t, MTOK, 1024, 1024, 1024, 1024, 1 << 30, 0}; pg8::StaticOrder S; S.init(MTOK, 1024, F.G, (int)blockIdx.x);
        pg8::EpiX1 E{x, args.out, XG, args.in[17], ssq1};
        pg8::gemm_phase<pg8::EpiX1, pg8::StaticOrder, true>(F.lds + RING_OFF, g, S, E);
        if (BOTH(5)) GRID_BAR();
    }

    if (IN(6)) for (int rep_ = 0; rep_ < REP_6; ++rep_) {
        pg8::Gemm g{XG, Wq_t, MTOK, PQ, 1024, 1024, 1024, 1 << 30, 0}; pg8::StaticOrder S; S.init(MTOK, PQ, F.G, (int)blockIdx.x);
        pg8::EpiPlain E{PQb, PQ};
        pg8::gemm_phase<pg8::EpiPlain, pg8::StaticOrder, true>(F.lds + RING_OFF, g, S, E);
        if (BOTH(6)) GRID_BAR();
    }

    if (IN(7)) for (int rep_ = 0; rep_ < REP_7; ++rep_) {
        LAS unsigned char* scr = F.lds + RING_OFF + F.wave * 2048;
        LAS unsigned char* ksl = F.lds + RING_OFF + 16384;
        for (int c = F.tid; c < 256 * 16; c += NWAVES * 64) { const int row = c >> 4, ch = c & 15; *(LAS v4u*)(ksl + row * 256 + ((ch ^ (row & 15)) << 4)) = *(const GAS v4u*)(KSb + row * 128 + ch * 8); }
        __syncthreads();
        for (int it = gw; it < (MTOK / 32) * 8; it += NGW) topk_task(it >> 3, it & 7, F.lane, scr, PQb, ksl, ssq1, ids, gts, rstd1);
        if (BOTH(7)) { VM_WAIT(); __syncthreads(); }
    }

    if (IN(8)) for (int rep_ = 0; rep_ < REP_8; ++rep_) {
        peer_a_phase(F.lane, F.wave, F.G, F.vcu, XG, U8, ids, gts, rstd1, wpk, F.lds, 0xffff);
        if (BOTH(8)) VM_WAIT();
    }
    if (IN(9)) for (int rep_ = 0; rep_ < REP_9; ++rep_) {
        peer_b_phase(F.lane, F.wave, F.G, F.vcu, V8, wpk, Y16, args.out, args.in[23], rep_ == REP_9 - 1);
    }
#undef IN
#undef BOTH
#undef GRID_BAR
}

extern "C" void kernel_launch(void* const* d_in, const int* in_sizes, int n_in, void* d_out, int out_size, void* d_ws, size_t ws_size, hipStream_t stream) {
    static int grid = 0;
    if (grid == 0) {
        if (n_in != 24 || in_sizes[0] != MTOK * DMODEL || out_size != MTOK * DMODEL || ws_size < WS_END) { fprintf(stderr, "kernel_launch: unexpected shapes (n_in %d, in0 %d, out %d, ws %zu); nothing launched\n", n_in, n_in > 0 ? in_sizes[0] : -1, out_size, ws_size); grid = -1; return; }
        int dev = 0, cus = 0, per_cu = 0;
        if (hipGetDevice(&dev) != hipSuccess || hipDeviceGetAttribute(&cus, hipDeviceAttributeMultiprocessorCount, dev) != hipSuccess) { grid = -1; return; }
        if (hipFuncSetAttribute((const void*)mk_fwd, hipFuncAttributeMaxDynamicSharedMemorySize, LDS_BYTES) != hipSuccess) { fprintf(stderr, "kernel_launch: hipFuncSetAttribute failed\n"); grid = -1; return; }
        if (hipOccupancyMaxActiveBlocksPerMultiprocessor(&per_cu, (const void*)mk_fwd, NWAVES * 64, LDS_BYTES) != hipSuccess || per_cu < 1) { fprintf(stderr, "kernel_launch: occupancy query says %d blocks per CU\n", per_cu); }
        (void)hipGetLastError();
        grid = cus;
    }
    if (grid < 0) return;
    if (N_LAUNCHES != PER_PHASE) { if (hipMemsetAsync((char*)d_ws + WS_CTL, 0, CTL_ZERO_BYTES, stream) != hipSuccess) return; }
    Args a{};
    for (int i = 0; i < 24; ++i) a.in[i] = (const float*)d_in[i];
    a.out = (float*)d_out; a.ws = (unsigned char*)d_ws; a.pad = 0;
    if (N_LAUNCHES == PER_PHASE) {
        for (int li = 0; li < PER_PHASE; ++li) { a.ph_lo = li; a.ph_hi = li + 1; a.li = li; hipLaunchKernelGGL(mk_fwd, dim3(grid), dim3(NWAVES * 64), LDS_BYTES, stream, a); }
    } else {
        a.ph_lo = 0; a.ph_hi = PER_PHASE; a.li = 0;
        hipLaunchKernelGGL(mk_fwd, dim3(grid), dim3(NWAVES * 64), LDS_BYTES, stream, a);
    }
}
```

```cpp
#include <hip/hip_runtime.h>
#include <hip/hip_bf16.h>
#include <cstdio>
#include <cstdint>
#include <cmath>

#ifndef MK_N_LAUNCHES
#define MK_N_LAUNCHES 1
#endif

namespace pg8 {
#define PG8_LAS __attribute__((address_space(3)))
typedef unsigned short bf16_t;
typedef short bf16x8 __attribute__((ext_vector_type(8)));
typedef float f32x4 __attribute__((ext_vector_type(4)));
typedef unsigned u32x4 __attribute__((ext_vector_type(4)));
constexpr int BM = 256, BK = 64, HALF = 128, HTB = HALF * BK * 2, STAGE_BYTES = 8 * HTB, NXCD = 8, WGM = 8;

__host__ __device__ __forceinline__ int lds_byte(int r, int c) { const int st = (r >> 4) * 2 + (c >> 5), rr = r & 15, cc = c & 31, ob = rr * 64 + cc * 2; return st * 1024 + (ob ^ (((ob >> 9) & 1) << 5)); }
__host__ __device__ __forceinline__ void stage_rc(int b, int& R, int& C) { const int st = b / 1024, sb = b % 1024, swz = sb ^ (((sb >> 9) & 1) << 5); R = (st >> 1) * 16 + swz / 64; C = (st & 1) * 32 + (swz % 64) / 2; }
__host__ __device__ __forceinline__ int perm32(int rho) { const int n = rho >> 4, i = rho & 15; return 8 * (i >> 2) + 4 * n + (i & 3); }

struct Unit { int pm, pn, w; };
struct Gemm { const bf16_t* A; const bf16_t* Bt; int M, N, K, lda, ldb, rpg; size_t bgs; const bf16_t* A2 = nullptr; const bf16_t* Bt2 = nullptr; };

struct StaticOrder {
    int nM, nN, nwg, G, c;
    __host__ __device__ __forceinline__ void init(int M, int N, int G_, int c_) { nM = M / BM; nN = N / BM; nwg = nM * nN; G = G_; c = c_; }
    __host__ __device__ __forceinline__ bool next(int i, Unit& u) const {
        const long L = (long)i * G + c; if (L >= nwg) return false;
        int wgid = (int)L; { const int q = nwg / NXCD, r = nwg % NXCD, xcd = wgid % NXCD, off = wgid / NXCD; wgid = (xcd < r ? xcd * (q + 1) : r * (q + 1) + (xcd - r) * q) + off; }
        const int nig = WGM * nN, gid = wgid / nig, fm = gid * WGM, gsz = (nM - fm) < WGM ? (nM - fm) : WGM;
        u.pm = fm + ((wgid % nig) % gsz); u.pn = (wgid % nig) / gsz; u.w = 0; return true;
    }
};

__device__ __forceinline__ unsigned cvt_pk_bf16(float lo, float hi) { unsigned r; asm volatile("v_cvt_pk_bf16_f32 %0, %1, %2" : "=v"(r) : "v"(lo), "v"(hi)); return r; }
__device__ __forceinline__ float bf_lo(unsigned w) { return __uint_as_float(w << 16); }
__device__ __forceinline__ float bf_hi(unsigned w) { return __uint_as_float(w & 0xffff0000u); }
__device__ __forceinline__ float sigmoid_f(float x) { return __builtin_amdgcn_rcpf(1.0f + __builtin_amdgcn_exp2f(-1.4426950409f * x)); }
__device__ __forceinline__ float gelu_tanh(float x) { const float u = x + 0.044715f * x * x * x; return x * __builtin_amdgcn_rcpf(1.0f + __builtin_amdgcn_exp2f(-2.3022081985f * u)); }

template <class Epi, class Sched, bool ALIGN_EPI>
__device__ __forceinline__ void gemm_phase(PG8_LAS unsigned char* lds, const Gemm g, const Sched& S, const Epi& E) {
    int tid = threadIdx.x; asm volatile("" : "+v"(tid));
    const int wid = __builtin_amdgcn_readfirstlane(tid >> 6), lane = tid & 63, wr = wid >> 2, wc = wid & 3, fr = lane & 15, fq = lane >> 4;
    const int K = g.K, nt = K / BK;
    unsigned voffA[2], voffB[2];
#pragma unroll
    for (int i = 0; i < 2; ++i) { int R, C; stage_rc(tid * 16 + i * 8192, R, C); const int Rb = Epi::PERM ? ((R & ~31) + perm32(R & 31)) : R;
        voffA[i] = (unsigned)(R * g.lda + C) * 2u; voffB[i] = (unsigned)(Rb * g.ldb + C) * 2u; }
    const size_t kstep = (size_t)(BK * 2);
    const size_t hstepA = (size_t)HALF * g.lda * 2, hstepB = (size_t)HALF * g.ldb * 2;
    const size_t tstepA = 2 * hstepA, tstepB = 2 * hstepB;
    const unsigned ldsw = (unsigned)wid * 1024u;
    const int aoff = lds_byte(wr * 64 + fr, fq * 8), boff = lds_byte(wc * 32 + fr, fq * 8);
#define PG8_SA(b, h) (((b) * 2 + (h)) * HTB)
#define PG8_SB(b, h) ((4 + (b) * 2 + (h)) * HTB)
#define PG8_STAGE(bufoff, gbase, voff) do { _Pragma("unroll") for (int _i = 0; _i < 2; ++_i) \
        __builtin_amdgcn_global_load_lds((const unsigned*)((const char*)(gbase) + (voff)[_i]), (PG8_LAS unsigned*)(lds + (bufoff) + ldsw + _i * 8192), 16, 0, 0); } while (0)
#define PG8_LDA(dst, b, h) do { _Pragma("unroll") for (int m = 0; m < 4; ++m) _Pragma("unroll") for (int k = 0; k < 2; ++k) dst[m][k] = *(const PG8_LAS bf16x8*)(lds + PG8_SA(b, h) + aoff + m * 2048 + k * 1024); } while (0)
#define PG8_LDB(dst, b, h) do { _Pragma("unroll") for (int n = 0; n < 2; ++n) _Pragma("unroll") for (int k = 0; k < 2; ++k) dst[n][k] = *(const PG8_LAS bf16x8*)(lds + PG8_SB(b, h) + boff + n * 2048 + k * 1024); } while (0)
#define PG8_MMA(ai, bj, At, Bt) do { __builtin_amdgcn_s_setprio(1); _Pragma("unroll") for (int m = 0; m < 4; ++m) _Pragma("unroll") for (int n = 0; n < 2; ++n) _Pragma("unroll") for (int k = 0; k < 2; ++k) \
        acc[ai][bj][m][n] = __builtin_amdgcn_mfma_f32_16x16x32_bf16(Bt[n][k], At[m][k], acc[ai][bj][m][n], 0, 0, 0); __builtin_amdgcn_s_setprio(0); } while (0)
#define PG8_WAIT_V(n) asm volatile("s_waitcnt vmcnt(" #n ")" ::: "memory")
#define PG8_WAIT_L(n) asm volatile("s_waitcnt lgkmcnt(" #n ")" ::: "memory")
#define PG8_BAR __builtin_amdgcn_s_barrier()
#define PG8_SCHED __builtin_amdgcn_sched_barrier(0)
    Unit cur, nxt; int ui = 0;
    if (!S.next(0, cur)) return;
    f32x4 acc[2][2][4][2];
#pragma unroll
    for (int a = 0; a < 2; ++a)
#pragma unroll
        for (int b = 0; b < 2; ++b)
#pragma unroll
            for (int m = 0; m < 4; ++m)
#pragma unroll
                for (int n = 0; n < 2; ++n) acc[a][b][m][n] = (f32x4){0.f, 0.f, 0.f, 0.f};
    bf16x8 At[4][2], B0[2][2], B1[2][2];
    const char* cA = (const char*)(cur.w ? g.A2 : g.A) + (size_t)cur.pm * tstepA;
    const char* cB = (const char*)(cur.w ? g.Bt2 : g.Bt) + (size_t)(cur.pm / g.rpg) * g.bgs * 2 + (size_t)cur.pn * tstepB;
    PG8_STAGE(PG8_SB(0, 0), cB, voffB); PG8_STAGE(PG8_SB(0, 1), cB + hstepB, voffB); PG8_STAGE(PG8_SA(0, 0), cA, voffA); PG8_STAGE(PG8_SA(0, 1), cA + hstepA, voffA);
    if (wr == 1) PG8_BAR;
    PG8_WAIT_V(2); PG8_BAR;
    PG8_STAGE(PG8_SB(1, 0), cB + kstep, voffB); PG8_STAGE(PG8_SA(1, 0), cA + kstep, voffA); PG8_STAGE(PG8_SB(1, 1), cB + hstepB + kstep, voffB);
    PG8_WAIT_V(6); PG8_BAR;
    for (;;) {
        const bool has_next = S.next(ui + 1, nxt);
        const char* nA = has_next ? (const char*)(nxt.w ? g.A2 : g.A) + (size_t)nxt.pm * tstepA : cA;
        const char* nB = has_next ? (const char*)(nxt.w ? g.Bt2 : g.Bt) + (size_t)(nxt.pm / g.rpg) * g.bgs * 2 + (size_t)nxt.pn * tstepB : cB;
        for (int t = 0; t < nt; t += 2) {
            const bool last = (t == nt - 2);
            const char* a1 = cA + (size_t)(t + 1) * kstep;
            const char* a2 = last ? nA : cA + (size_t)(t + 2) * kstep; const char* b2 = last ? nB : cB + (size_t)(t + 2) * kstep;
            const char* a3 = a2 + kstep; const char* b3 = b2 + kstep;
            PG8_LDB(B0, 0, 0); PG8_LDB(B1, 0, 1); PG8_SCHED; PG8_LDA(At, 0, 0); PG8_STAGE(PG8_SA(1, 1), a1 + hstepA, voffA);
            PG8_WAIT_V(8); PG8_WAIT_L(0); PG8_BAR; PG8_MMA(0, 0, At, B0); PG8_MMA(0, 1, At, B1); PG8_BAR; PG8_SCHED;
            PG8_LDA(At, 0, 1); PG8_STAGE(PG8_SB(0, 0), b2, voffB); PG8_STAGE(PG8_SB(0, 1), b2 + hstepB, voffB); PG8_STAGE(PG8_SA(0, 0), a2, voffA);
            PG8_WAIT_V(8); PG8_WAIT_L(0); PG8_BAR; PG8_MMA(1, 0, At, B0); PG8_MMA(1, 1, At, B1); PG8_BAR; PG8_SCHED;
            PG8_LDB(B0, 1, 0); PG8_LDB(B1, 1, 1); PG8_SCHED; PG8_LDA(At, 1, 0); PG8_STAGE(PG8_SA(0, 1), a2 + hstepA, voffA);
            PG8_WAIT_V(8); PG8_WAIT_L(0); PG8_BAR; PG8_MMA(0, 0, At, B0); PG8_MMA(0, 1, At, B1); PG8_BAR; PG8_SCHED;
            PG8_LDA(At, 1, 1); PG8_STAGE(PG8_SB(1, 0), b3, voffB); PG8_STAGE(PG8_SB(1, 1), b3 + hstepB, voffB); PG8_STAGE(PG8_SA(1, 0), a3, voffA);
            PG8_WAIT_V(8); PG8_WAIT_L(0); PG8_BAR; PG8_MMA(1, 0, At, B0); PG8_MMA(1, 1, At, B1); PG8_BAR; PG8_SCHED;
        }
        if constexpr (ALIGN_EPI) { if (wr == 0) PG8_BAR; }
        E(acc, cur, wr, wc, fr, fq);
        if (!has_next) break;
#pragma unroll
        for (int a = 0; a < 2; ++a)
#pragma unroll
            for (int b = 0; b < 2; ++b)
#pragma unroll
                for (int m = 0; m < 4; ++m)
#pragma unroll
                    for (int n = 0; n < 2; ++n) acc[a][b][m][n] = (f32x4){0.f, 0.f, 0.f, 0.f};
        cur = nxt; cA = nA; cB = nB; ++ui;
        if constexpr (ALIGN_EPI) { if (wr == 1) PG8_BAR; }
    }
    PG8_WAIT_V(0);
    if constexpr (!ALIGN_EPI) { if (wr == 0) PG8_BAR; }
    PG8_BAR;
#undef PG8_SA
#undef PG8_SB
#undef PG8_STAGE
#undef PG8_LDA
#undef PG8_LDB
#undef PG8_MMA
#undef PG8_WAIT_V
#undef PG8_WAIT_L
#undef PG8_BAR
#undef PG8_SCHED
}
}
namespace attn_body {
using bf16=__hip_bfloat16;
using bf16x8=__attribute__((ext_vector_type(8)))short;
using s16x4=__attribute__((ext_vector_type(4)))short;
using f32x16=__attribute__((ext_vector_type(16)))float;
using f32x4v=__attribute__((ext_vector_type(4)))float;
using u32x4=__attribute__((ext_vector_type(4)))unsigned;
constexpr int BATCH=8,NHEAD=8,SEQ=2048,D=64,DM=NHEAD*D;
constexpr int NW=8,QBLK=32,QB=QBLK*NW,KVBLK=64,NQB=SEQ/QB;
__device__ __forceinline__ int crow(int r,int hi){return (r&3)+8*(r>>2)+4*hi;}
#define SBAR() __builtin_amdgcn_sched_barrier(0)
__device__ __forceinline__ void cmask(f32x16&p0,f32x16&p1,int jb,int qrel,int hi){
  const float NEG=-INFINITY; int kb=64*jb+4*hi;
  #pragma unroll
  for(int r=0;r<16;++r){int kv=kb+(r&3)+8*(r>>2); if(kv>qrel)p0[r]=NEG; if(kv+32>qrel)p1[r]=NEG;}
}
typedef __attribute__((address_space(3))) const float* lds_cfptr;
__device__ __forceinline__ void biasadd(f32x16&p0,f32x16&p1,int jb,int qrel,int hi,lds_cfptr bt){
  const int base=qrel-64*jb-4*hi;
  #pragma unroll
  for(int r4=0;r4<16;r4+=4){
    #pragma unroll
    for(int r=r4;r<r4+4;++r){int rel=base-((r&3)+8*(r>>2)); int i0=min(max(rel,0),127), i1=min(max(rel-32,0),127); p0[r]+=bt[i0]; p1[r]+=bt[i1];}
    asm volatile("s_waitcnt lgkmcnt(0)":"+v"(p0),"+v"(p1)::"memory"); }
}

constexpr int NSLOT=3, SLOTB=8192;
constexpr int LDS_K=0, LDS_V=NSLOT*SLOTB, LDS_WS=2*NSLOT*SLOTB, LDS_OST=LDS_WS+NW*64*4, LDS_KM=LDS_OST+NW*4096, LDS_BT=LDS_KM+7*64*4, LDS_BYTES=LDS_BT+128*4;
constexpr float C2=0.125f*1.4426950408889634f;
__device__ __forceinline__ void glds16(const void*gsrc,unsigned lds_dst){unsigned keep;
  asm volatile("s_mov_b32 %0, m0\n\ts_mov_b32 m0, %2\n\ts_nop 0\n\tglobal_load_lds_dwordx4 %1, off\n\ts_mov_b32 m0, %0":"=&s"(keep):"v"(gsrc),"s"(lds_dst):"memory");}
__device__ __forceinline__ float max3f(float a,float b,float c){float r;asm("v_max3_f32 %0, %1, %2, %3":"=v"(r):"v"(a),"v"(b),"v"(c));return r;}
__device__ __forceinline__ float max2f(float a,float b){float r;asm("v_max_f32_e32 %0, %1, %2":"=v"(r):"v"(a),"v"(b));return r;}
__device__ __forceinline__ float fadd_s(float a,float b){float r;asm("v_add_f32_e32 %0, %1, %2":"=v"(r):"v"(a),"v"(b));return r;}
__device__ __forceinline__ float fsub_s(float a,float b){float r;asm("v_sub_f32_e32 %0, %1, %2":"=v"(r):"v"(a),"v"(b));return r;}
typedef float f32x2_t __attribute__((ext_vector_type(2))); typedef __bf16 bf16x2_t __attribute__((ext_vector_type(2)));
__device__ __forceinline__ unsigned cvtpk_s(float lo,float hi){f32x2_t v={lo,hi};bf16x2_t b=__builtin_convertvector(v,bf16x2_t);return __builtin_bit_cast(unsigned,b);}
#define WAIT_BAR(N) asm volatile("s_waitcnt vmcnt(" #N ") lgkmcnt(0)\n\ts_barrier":::"memory")

__device__ __forceinline__ void qkt(f32x16&p0,f32x16&p1,const char*Kslot,const bf16x8*qr,int r32,int hi){
  const char*kb=Kslot+hi*1024+r32*16;
  #pragma unroll
  for(int d0=0;d0<4;++d0){
    const bf16x8 b0=*reinterpret_cast<const bf16x8*>(kb+d0*2048);
    const bf16x8 b1=*reinterpret_cast<const bf16x8*>(kb+d0*2048+512);
    if(d0==0){p0=__builtin_amdgcn_mfma_f32_32x32x16_bf16(b0,qr[0],(f32x16){},0,0,0);p1=__builtin_amdgcn_mfma_f32_32x32x16_bf16(b1,qr[0],(f32x16){},0,0,0);}
    else{p0=__builtin_amdgcn_mfma_f32_32x32x16_bf16(b0,qr[d0],p0,0,0,0);p1=__builtin_amdgcn_mfma_f32_32x32x16_bf16(b1,qr[d0],p1,0,0,0);}}
}
typedef __attribute__((address_space(3))) const char* lds_cptr;
typedef short v4i16_t __attribute__((ext_vector_type(4)));
__device__ __forceinline__ void kload8(bf16x8*kf,lds_cptr kp){
  kf[0]=*(const __attribute__((address_space(3))) bf16x8*)(kp);      kf[1]=*(const __attribute__((address_space(3))) bf16x8*)(kp+512);
  kf[2]=*(const __attribute__((address_space(3))) bf16x8*)(kp+2048); kf[3]=*(const __attribute__((address_space(3))) bf16x8*)(kp+2560);
  kf[4]=*(const __attribute__((address_space(3))) bf16x8*)(kp+4096); kf[5]=*(const __attribute__((address_space(3))) bf16x8*)(kp+4608);
  kf[6]=*(const __attribute__((address_space(3))) bf16x8*)(kp+6144); kf[7]=*(const __attribute__((address_space(3))) bf16x8*)(kp+6656);
}
__device__ __forceinline__ void kload2(bf16x8*kf,lds_cptr kp,int j){ kf[2*j]=*(const __attribute__((address_space(3))) bf16x8*)(kp+j*2048); kf[2*j+1]=*(const __attribute__((address_space(3))) bf16x8*)(kp+j*2048+512); }
__device__ __forceinline__ s16x4 vtr(lds_cptr p){ return __builtin_bit_cast(s16x4,__builtin_amdgcn_ds_read_tr16_b64_v4i16((__attribute__((address_space(3))) v4i16_t*)p)); }
__device__ __forceinline__ float rowmax(const f32x16&p0,const f32x16&p1){
  float a=max3f(p0[0],p0[1],p1[0]),b=max3f(p0[2],p0[3],p1[1]);a=max3f(a,p1[2],p1[3]);
  #pragma unroll
  for(int r=4;r<16;r+=4){a=max3f(a,p0[r],p0[r+1]);b=max3f(b,p0[r+2],p0[r+3]);a=max3f(a,p1[r],p1[r+1]);b=max3f(b,p1[r+2],p1[r+3]);}
  const float m=max2f(a,b);
  auto rr=__builtin_amdgcn_permlane32_swap(__float_as_uint(m),__float_as_uint(m),false,false);
  return max2f(__uint_as_float(rr[0]),__uint_as_float(rr[1]));
}
__device__ __forceinline__ void pv(f32x16*o,int vb,bf16x8 pa0,bf16x8 pa1,bf16x8 pa2,bf16x8 pa3){
  #pragma unroll
  for(int d0=0;d0<2;++d0){s16x4 lo[4],hi[4];
    #pragma unroll
    for(int ks=0;ks<4;++ks){
      asm volatile("ds_read_b64_tr_b16 %0,%1 offset:%c2":"=&v"(lo[ks]):"v"(vb),"i"(d0*4096+ks*1024):"memory");
      asm volatile("ds_read_b64_tr_b16 %0,%1 offset:%c2":"=&v"(hi[ks]):"v"(vb),"i"(d0*4096+ks*1024+512):"memory");}
    asm volatile("s_waitcnt lgkmcnt(0)":::"memory");SBAR();
    #define PK(k) (bf16x8){lo[k][0],lo[k][1],lo[k][2],lo[k][3],hi[k][0],hi[k][1],hi[k][2],hi[k][3]}
    o[d0]=__builtin_amdgcn_mfma_f32_32x32x16_bf16(pa0,PK(0),o[d0],0,0,0);
    o[d0]=__builtin_amdgcn_mfma_f32_32x32x16_bf16(pa1,PK(1),o[d0],0,0,0);
    o[d0]=__builtin_amdgcn_mfma_f32_32x32x16_bf16(pa2,PK(2),o[d0],0,0,0);
    o[d0]=__builtin_amdgcn_mfma_f32_32x32x16_bf16(pa3,PK(3),o[d0],0,0,0);
    #undef PK
  }
}

#ifndef ATTN_STORE16
#define ATTN_STORE16(p,v) (*(u32x4*)(p)=(v))
#endif
template<int THRL> __device__ __forceinline__ void attn_unit(int b,int h,int qb,const bf16*Q,const bf16*__restrict__ K,const bf16*__restrict__ V,bf16*O,char*shm,const float*kpart,const float*btab){
  int tid=threadIdx.x; asm volatile("":"+v"(tid));
  const int lane=tid&63,r32=lane&31,hi=lane>>5; const int wid=__builtin_amdgcn_readfirstlane(tid>>6);
  const long rowbase=(long)b*SEQ; const int q0=qb*QB;
  const bf16*Qw=Q+(rowbase+q0+wid*QBLK)*DM+h*D;
  const bf16*Kh=K+rowbase*DM+h*D,*Vh=V+rowbase*DM+h*D;
  const unsigned lds0=(unsigned)(uintptr_t)shm;
  float*wsf=(float*)(shm+LDS_WS)+wid*64;
  const bf16*ksrc=Kh+(long)lane*DM+wid*8;
  const bf16*vsrc=Vh+(long)(16*(wid&3)+(lane>>2))*DM+(wid>>2)*32+(lane&3)*8;
  const unsigned kdst=lds0+LDS_K+wid*1024, vdst=lds0+LDS_V+wid*1024;
  #define DMA_K(t,slot) glds16(ksrc+(long)(t)*KVBLK*DM,(unsigned)__builtin_amdgcn_readfirstlane(kdst+(slot)))
  #define DMA_V(t,slot) glds16(vsrc+(long)(t)*KVBLK*DM,(unsigned)__builtin_amdgcn_readfirstlane(vdst+(slot)))
  const int vb0=(int)(lds0+LDS_V)+((lane>>4)&1)*32+(lane&3)*8+(4*hi+((lane&15)>>2))*64;
  const char*Kbase=shm+LDS_K; bf16x8 kf[8];
  const lds_cptr shm3=(lds_cptr)shm; const lds_cptr kp0=shm3+LDS_K+hi*1024+r32*16; const lds_cptr vp0=shm3+LDS_V+((lane>>4)&1)*32+(lane&3)*8+(4*hi+((lane&15)>>2))*64;
  const lds_cfptr btl=(lds_cfptr)(shm3+LDS_BT);
  const int NT=(q0+QB)/KVBLK;
  DMA_K(0,0);DMA_V(0,0);DMA_K(1,SLOTB);
  bf16x8 qr[4];
  #pragma unroll
  for(int d0=0;d0<4;++d0)qr[d0]=*reinterpret_cast<const bf16x8*>(&Qw[(long)r32*DM+d0*16+hi*8]);
  { float*km=(float*)(shm+LDS_KM); float*bt=(float*)(shm+LDS_BT); int tq=tid; asm volatile("":"+v"(tq));
    if(tq<448){const int j=tq>>6,d=tq&63; float v=0.f; if(j<qb&&qb>3){const float*kp=kpart+((size_t)((b*NQB+j)*2)*512)+h*D+d; v=(kp[0]+kp[512])*(1.0f/256.0f);} km[tq]=v;}
    else if(tq<448+64){const int i=tq-448; bt[i]=btab[h*128+i]; bt[64+i]=btab[h*128+64+i];} }
  float mhat=0.f,l_reg=0.f;f32x16 o[2];o[0]=f32x16{};o[1]=f32x16{};
  const int qrel=wid*QBLK+r32;
  #define CMASK(P0,P1,t) do{int jb_=(t)-(NT-4);   \
    if(jb_>=-2 && 32*wid+31-64*jb_>=0 && 32*wid-64*jb_-63<=112)biasadd(P0,P1,jb_,qrel,hi,btl); if(jb_>=0 && 64*jb_+63>32*wid)cmask(P0,P1,jb_,qrel,hi);}while(0)
  bool resc=false;
  #define START(P0,P1,t) do{ float rm=rowmax(P0,P1); resc=false; const float nv_=MASKADD(t); rm=fadd_s(rm,nv_); \
    { const float dl=__builtin_fmaxf(rm,-1.0e4f); mhat=fadd_s(mhat,dl); const float cc_=fsub_s(nv_,dl); \
      _Pragma("unroll") for(int r=0;r<16;++r){P0[r]=fadd_s(P0[r],cc_);P1[r]=fadd_s(P1[r],cc_);} } \
    _Pragma("unroll") for(int r=0;r<16;++r)P0[r]=__builtin_amdgcn_exp2f(P0[r]); }while(0)
  #define RESC() do{ if(resc){ asm volatile("s_waitcnt lgkmcnt(0)":::"memory"); \
      _Pragma("unroll") for(int d_=0;d_<2;++d_) _Pragma("unroll") for(int r=0;r<16;++r)o[d_][r]*=wsf[crow(r,hi)]; } }while(0)
  f32x16 pA0,pA1,pB0,pB1;
  int sl_prev=0,sl_cur=0,sl_next=SLOTB;
  #define ROT() do{sl_prev=sl_cur;sl_cur=sl_next;sl_next=(sl_next==(NSLOT-1)*SLOTB)?0:sl_next+SLOTB;}while(0)
  DMA_K(2,2*SLOTB);
  WAIT_BAR(3);
  unsigned selbits=(1u<<qb)-1u;
  if(qb>3){ selbits=0u;
    const __attribute__((address_space(3))) float* km3=(const __attribute__((address_space(3))) float*)(shm3+LDS_KM);
    float qf[32];
    #pragma unroll
    for(int d0=0;d0<4;++d0){
      #pragma unroll
      for(int i=0;i<8;++i) qf[d0*8+i]=__uint_as_float(((unsigned)(unsigned short)qr[d0][i])<<16);}
    float gj[7];
    #pragma unroll
    for(int j=0;j<7;++j){ float s=0.f;
      if(j<qb){
        #pragma unroll
        for(int d0=0;d0<4;++d0){ const f32x4v k0=*(const __attribute__((address_space(3))) f32x4v*)(km3+j*64+d0*16+hi*8); const f32x4v k1=*(const __attribute__((address_space(3))) f32x4v*)(km3+j*64+d0*16+hi*8+4);
          s+=qf[d0*8+0]*k0[0]+qf[d0*8+1]*k0[1]+qf[d0*8+2]*k0[2]+qf[d0*8+3]*k0[3]+qf[d0*8+4]*k1[0]+qf[d0*8+5]*k1[1]+qf[d0*8+6]*k1[2]+qf[d0*8+7]*k1[3]; }
        auto rr=__builtin_amdgcn_permlane32_swap(__float_as_uint(s),__float_as_uint(s),false,false); s=__uint_as_float(rr[0])+__uint_as_float(rr[1]); }
      gj[j]=s; }
    #pragma unroll
    for(int j=0;j<7;++j){ int rank=0;
      #pragma unroll
      for(int k=0;k<7;++k){ if(k!=j){ const bool beats=(k<j)?(gj[k]>=gj[j]):(gj[k]>gj[j]); rank+=(k<qb&&beats)?1:0; } }
      if(j<qb&&rank<3)selbits|=(1u<<j); }
  }
  #define MASKADD(t) ((((t)>>2)<qb && !((selbits>>((t)>>2))&1u))?-1.0e30f:0.0f)
  qkt(pA0,pA1,Kbase,qr,r32,hi);asm volatile("s_nop 15\n\ts_nop 7":"+v"(pA0),"+v"(pA1));CMASK(pA0,pA1,0);
  START(pA0,pA1,0);
  _Pragma("unroll") for(int r=0;r<16;++r)pA1[r]=__builtin_amdgcn_exp2f(pA1[r]);
  WAIT_BAR(0);
  DMA_K(3,0);DMA_V(1,SLOTB);
  ROT();
  kload8(kf,kp0+sl_cur);
  WAIT_BAR(2);
  s16x4 vlo[8],vhi[8]; u32x4 pw0,pw1,pw2,pw3;
  #define PKW(P,B) cvtpk_s(P[B],P[B+1])
  #define PAF(k) __builtin_bit_cast(bf16x8,pw##k)
  #define VFR(i) (bf16x8){vlo[i][0],vlo[i][1],vlo[i][2],vlo[i][3],vhi[i][0],vhi[i][1],vhi[i][2],vhi[i][3]}
  #define PIN(x) asm volatile("":"+v"(x))
  #define MX3(a,b,c) __builtin_fmaxf(__builtin_fmaxf((a),(b)),(c))
  #define GAPA(MF,A0,A1,A2,A3,W0,W1,PW) do{ MF; sacc+=A0; sacc+=A1; sacc+=A2; sacc+=A3; PIN(sacc); W0; W1; PIN(PW); SBAR(); }while(0)
  #define EX(v) __builtin_amdgcn_exp2f(v)
  #define GAPB(MF,X,B) do{ MF; X[B]=EX(X[B]); X[B+1]=EX(X[B+1]); X[B+2]=EX(X[B+2]); X[B+3]=EX(X[B+3]); PIN(X); SBAR(); }while(0)
  #define VRD(i) do{ vlo[i]=vtr(vp_+(((i)>>2)*4096+((i)&3)*1024)); vhi[i]=vtr(vp_+(((i)>>2)*4096+((i)&3)*1024+512)); }while(0)
  #define KRD(G,j) do{ if(G){ kload2(kf,kp0+sl_next,j); SBAR(); } }while(0)
  #define STEP(C0,C1,P0,P1,t,GK,GV,GL) do{ SBAR(); \
    const lds_cptr vp_=vp0+sl_prev; \
    VRD(0); SBAR(); float sacc=(P0[0]+P0[1]); \
    GAPA(C0=__builtin_amdgcn_mfma_f32_32x32x16_bf16(kf[0],qr[0],(f32x16){},0,0,0), P0[2],P0[3],P0[4],P0[5],     pw0[0]=PKW(P0,0), pw0[1]=PKW(P0,2), pw0); \
    VRD(4); SBAR(); GAPA(C1=__builtin_amdgcn_mfma_f32_32x32x16_bf16(kf[1],qr[0],(f32x16){},0,0,0), P0[6],P0[7],P0[8],P0[9],     pw0[2]=PKW(P0,4), pw0[3]=PKW(P0,6), pw0); \
    VRD(1); SBAR(); GAPA(C0=__builtin_amdgcn_mfma_f32_32x32x16_bf16(kf[2],qr[1],C0,0,0,0),   P0[10],P0[11],P0[12],P0[13], pw1[0]=PKW(P0,8), pw1[1]=PKW(P0,10), pw1); \
    VRD(5); SBAR(); GAPA(C1=__builtin_amdgcn_mfma_f32_32x32x16_bf16(kf[3],qr[1],C1,0,0,0),   P0[14],P0[15],P1[0],P1[1],   pw1[2]=PKW(P0,12),pw1[3]=PKW(P0,14), pw1); \
    VRD(2); SBAR(); GAPA(C0=__builtin_amdgcn_mfma_f32_32x32x16_bf16(kf[4],qr[2],C0,0,0,0),   P1[2],P1[3],P1[4],P1[5],     pw2[0]=PKW(P1,0), pw2[1]=PKW(P1,2), pw2); \
    VRD(6); SBAR(); GAPA(C1=__builtin_amdgcn_mfma_f32_32x32x16_bf16(kf[5],qr[2],C1,0,0,0),   P1[6],P1[7],P1[8],P1[9],     pw2[2]=PKW(P1,4), pw2[3]=PKW(P1,6), pw2); \
    VRD(3); SBAR(); GAPA(C0=__builtin_amdgcn_mfma_f32_32x32x16_bf16(kf[6],qr[3],C0,0,0,0),   P1[10],P1[11],P1[12],P1[13], pw3[0]=PKW(P1,8), pw3[1]=PKW(P1,10), pw3); \
    VRD(7); SBAR(); GAPA(C1=__builtin_amdgcn_mfma_f32_32x32x16_bf16(kf[7],qr[3],C1,0,0,0),   P1[14],P1[15],0.f,0.f,       pw3[2]=PKW(P1,12),pw3[3]=PKW(P1,14), pw3); \
    l_reg+=sacc; \
    if(GK){DMA_K((t)+3,sl_cur);} if(GV){DMA_V((t)+1,sl_next);} \
    CMASK(C0,C1,t); \
    { float a=MX3(C0[0],C0[1],C1[0]),b=MX3(C0[2],C0[3],C1[1]); a=MX3(a,C1[2],C1[3]); \
      _Pragma("unroll") for(int r=4;r<16;r+=4){a=MX3(a,C0[r],C0[r+1]);b=MX3(b,C0[r+2],C0[r+3]);a=MX3(a,C1[r],C1[r+1]);b=MX3(b,C1[r+2],C1[r+3]);} \
      float rm=__builtin_fmaxf(a,b); { auto rr=__builtin_amdgcn_permlane32_swap(__float_as_uint(rm),__float_as_uint(rm),false,false); rm=__builtin_fmaxf(__uint_as_float(rr[0]),__uint_as_float(rr[1])); } \
      const float nv_=MASKADD(t)-mhat; rm+=nv_; float cc_=nv_; \
      resc=false; \
      if(__builtin_expect(__any(rm>(float)THRL),0)){ const float dl=__builtin_fmaxf(rm,0.f); mhat+=dl; cc_-=dl; \
        const float f=__builtin_amdgcn_exp2f(-dl); l_reg*=f; if(hi==0)wsf[r32]=f; resc=true; } \
      _Pragma("unroll") for(int r=0;r<16;++r){C0[r]+=cc_;C1[r]+=cc_;} } \
    SBAR(); \
    GAPB(o[0]=__builtin_amdgcn_mfma_f32_32x32x16_bf16(PAF(0),VFR(0),o[0],0,0,0), C0,0); \
    GAPB(o[1]=__builtin_amdgcn_mfma_f32_32x32x16_bf16(PAF(0),VFR(4),o[1],0,0,0), C0,4); \
    KRD(GL,0); GAPB(o[0]=__builtin_amdgcn_mfma_f32_32x32x16_bf16(PAF(1),VFR(1),o[0],0,0,0), C0,8); \
    KRD(GL,1); GAPB(o[1]=__builtin_amdgcn_mfma_f32_32x32x16_bf16(PAF(1),VFR(5),o[1],0,0,0), C0,12); \
    KRD(GL,2); GAPB(o[0]=__builtin_amdgcn_mfma_f32_32x32x16_bf16(PAF(2),VFR(2),o[0],0,0,0), C1,0); \
    KRD(GL,3); GAPB(o[1]=__builtin_amdgcn_mfma_f32_32x32x16_bf16(PAF(2),VFR(6),o[1],0,0,0), C1,4); \
    GAPB(o[0]=__builtin_amdgcn_mfma_f32_32x32x16_bf16(PAF(3),VFR(3),o[0],0,0,0), C1,8); \
    GAPB(o[1]=__builtin_amdgcn_mfma_f32_32x32x16_bf16(PAF(3),VFR(7),o[1],0,0,0), C1,12); \
    }while(0)
  int t=1;
  #undef CMASK
  #define CMASK(P0,P1,t) do{}while(0)
  for(;t+7<NT;t+=2){
    STEP(pB0,pB1,pA0,pA1,t,true,true,true);     WAIT_BAR(2); RESC(); ROT();
    STEP(pA0,pA1,pB0,pB1,t+1,true,true,true);   WAIT_BAR(2); RESC(); ROT();
  }
  #undef CMASK
  #define CMASK(P0,P1,t) do{int jb_=(t)-(NT-4);   \
    if(jb_>=-2 && 32*wid+31-64*jb_>=0 && 32*wid-64*jb_-63<=112)biasadd(P0,P1,jb_,qrel,hi,btl); if(jb_>=0 && 64*jb_+63>32*wid)cmask(P0,P1,jb_,qrel,hi);}while(0)
  #define ENDW(tt) do{ if((tt)+3<NT){WAIT_BAR(2);} else if((tt)+2<NT){WAIT_BAR(1);} else {WAIT_BAR(0);} }while(0)
  for(;t+1<NT;t+=2){
    STEP(pB0,pB1,pA0,pA1,t,(t+3<NT),(t+1<NT),(t+1<NT));       ENDW(t);   RESC(); ROT();
    STEP(pA0,pA1,pB0,pB1,t+1,(t+4<NT),(t+2<NT),(t+2<NT));     ENDW(t+1); RESC(); ROT();
  }
  STEP(pB0,pB1,pA0,pA1,NT-1,false,false,false); RESC();
  { float sacc=pB0[0]+pB0[1]; _Pragma("unroll") for(int r=2;r<16;++r)sacc+=pB0[r]; _Pragma("unroll") for(int r=0;r<16;++r)sacc+=pB1[r]; l_reg+=sacc;
    pw0=(u32x4){PKW(pB0,0),PKW(pB0,2),PKW(pB0,4),PKW(pB0,6)};pw1=(u32x4){PKW(pB0,8),PKW(pB0,10),PKW(pB0,12),PKW(pB0,14)};pw2=(u32x4){PKW(pB1,0),PKW(pB1,2),PKW(pB1,4),PKW(pB1,6)};pw3=(u32x4){PKW(pB1,8),PKW(pB1,10),PKW(pB1,12),PKW(pB1,14)};
    SBAR(); pv(o,vb0+sl_cur,PAF(0),PAF(1),PAF(2),PAF(3)); }
  #undef PKW
  #undef PAF
  #undef VFR
  #undef PIN
  #undef MX3
  #undef GAPA
  #undef GAPB
  #undef EX
  #undef VRD
  #undef KRD
  #undef STEP
  #undef ENDW
  #undef MASKADD
  {auto rr=__builtin_amdgcn_permlane32_swap(__float_as_uint(l_reg),__float_as_uint(l_reg),false,false);l_reg=__uint_as_float(rr[0])+__uint_as_float(rr[1]);}
  if(hi==0)wsf[32+r32]=l_reg;asm volatile("s_waitcnt lgkmcnt(0)":::"memory");
  float rli[16];
  #pragma unroll
  for(int r=0;r<16;++r)rli[r]=__builtin_amdgcn_rcpf(wsf[32+crow(r,hi)]);
  bf16*Ow=O+(rowbase+q0+wid*QBLK)*DM+h*D;
  { bf16*stg=(bf16*)(shm+LDS_OST)+wid*2048;
    #pragma unroll
    for(int r=0;r<16;++r){const int orow=crow(r,hi);
      #pragma unroll
      for(int d0=0;d0<2;++d0)stg[orow*64+d0*32+r32]=__float2bfloat16(o[d0][r]*rli[r]);}
    asm volatile("s_waitcnt lgkmcnt(0)":::"memory");
    #pragma unroll
    for(int i=0;i<4;++i){const int row=i*8+(lane>>3),ch=lane&7; const u32x4 v=*(const u32x4*)(stg+row*64+ch*8); ATTN_STORE16(Ow+(long)row*DM+ch*8,v);} }
  asm volatile("s_waitcnt lgkmcnt(0)\n\ts_barrier":::"memory");
  #undef DMA_K
  #undef DMA_V
  #undef CMASK
  #undef START
  #undef RESC
  #undef ROT
}
constexpr int ATTN_LDS_BYTES=LDS_BYTES;
#undef SBAR
#undef WAIT_BAR
}
constexpr int NWAVES = 8;
constexpr int PER_PHASE = 10;
constexpr int N_LAUNCHES = MK_N_LAUNCHES;

constexpr int BATCH = 8, SEQ = 2048, DMODEL = 1024, MTOK = BATCH * SEQ;
constexpr int INCOLS = 4096, SSMW = 512, NGRP = 32, CH = 32  , NCHUNK = SEQ / CH  , APK = 640  ;
constexpr int PQ = 2048, NEXP = 16384;
constexpr float RMS_EPS = 1e-6f;

constexpr size_t MiB = 1u << 20;
constexpr size_t WS_CTL = 0, CTL_ZERO_BYTES = 64 * 1024;
constexpr size_t WS_BIAS = 1 * MiB;
constexpr size_t WS_PW32 = 1 * MiB + 64 * 1024;
constexpr size_t WS_KPART = 1 * MiB + 128 * 1024;
constexpr size_t WS_KG = 2 * MiB;
constexpr size_t WS_SSQ1 = 3 * MiB;
constexpr size_t WS_WIN = 6 * MiB, WS_WQ = 14 * MiB, WS_WOUT = 18 * MiB, WS_WUS = 20 * MiB, WS_WUA = 21 * MiB, WS_WGLU = 22 * MiB, WS_KS = 22 * MiB + 512 * 1024;
constexpr size_t WS_WE = 23 * MiB;
constexpr size_t WS_BP = 32 * MiB;
constexpr size_t WS_AP = 52 * MiB;
constexpr size_t WS_E = 72 * MiB;
constexpr size_t WS_H = 80 * MiB;
constexpr size_t WS_YPRE = 80 * MiB, WS_YA = 96 * MiB, WS_XG = 80 * MiB;
constexpr size_t WS_Z = 96 * MiB, ZSTRIDE_B = 16 * MiB;
constexpr size_t WS_MRG = 128 * MiB;
constexpr size_t WS_PQ = 160 * MiB;
constexpr size_t WS_IDS = 224 * MiB, WS_GTS = 232 * MiB;
constexpr size_t WS_U16 = 32 * MiB, WS_V16 = 240 * MiB;
constexpr size_t WS_YB = 224 * MiB;
constexpr size_t WS_WPK = 128 * MiB, WS_RSTD1 = 4 * MiB, WS_Y16 = 160 * MiB;
constexpr size_t WS_END = 256 * MiB;
constexpr int CW_BAR = 1024;

constexpr int RING_OFF = 0, RING_BYTES = 131072;
constexpr int LDSCTL_OFF = RING_BYTES, MISC_OFF = LDSCTL_OFF + 320;
constexpr int LDS_BYTES = 147456;

#define GAS __attribute__((address_space(1)))
#define LAS __attribute__((address_space(3)))
typedef unsigned short bf16;
typedef unsigned v4u __attribute__((ext_vector_type(4)));
typedef float f32x4 __attribute__((ext_vector_type(4)));
typedef short bf16x8 __attribute__((ext_vector_type(8)));
typedef float f32x16 __attribute__((ext_vector_type(16)));
typedef __bf16 bf16x2_t __attribute__((ext_vector_type(2)));
typedef _Float16 h2_t __attribute__((ext_vector_type(2)));
typedef GAS unsigned gu32;
#define RLX_AGENT __ATOMIC_RELAXED, __HIP_MEMORY_SCOPE_AGENT
#define LDS_WAIT() asm volatile("s_waitcnt lgkmcnt(0)" ::: "memory")
#define VM_WAIT() asm volatile("s_waitcnt vmcnt(0)" ::: "memory")
__device__ __forceinline__ unsigned f2bf(float f) { unsigned u = __builtin_bit_cast(unsigned, f); return (u + 0x7fffu + ((u >> 16) & 1u)) >> 16; }
__device__ __forceinline__ unsigned pk2(float lo, float hi) { return f2bf(lo) | (f2bf(hi) << 16); }
using pg8::cvt_pk_bf16; using pg8::bf_lo; using pg8::bf_hi; using pg8::sigmoid_f; using pg8::gelu_tanh;

#define XB_TMO      128
#define XB_XCNT(j)  (256  + 64 * (j))
#define XB_XSUB(j)  (1280 + 64 * (j))
#define XB_XGEN(j)  (2304 + 64 * (j))
#define XB_TOP      3328
#define XB_TOPGEN   3392
#define XCD_BAR_WORDS 3456
#define XB_SPIN_CAP (1u << 18)
__device__ __forceinline__ unsigned xb_ld(unsigned* p)              { return __hip_atomic_load(p, __ATOMIC_RELAXED, __HIP_MEMORY_SCOPE_AGENT); }
__device__ __forceinline__ unsigned xb_add(unsigned* p, unsigned v) { return __hip_atomic_fetch_add(p, v, __ATOMIC_RELAXED, __HIP_MEMORY_SCOPE_AGENT); }
__device__ __forceinline__ unsigned xb_xcc_id() { return (unsigned)__builtin_amdgcn_s_getreg((3 << 11) | 20) & 0xFu; }
#define XB_SPIN(cond, bar) do { unsigned _sp = 0; while (cond) { __builtin_amdgcn_s_sleep(1); \
    if ((++_sp & 255u) == 0u) { if (xb_ld(&(bar)[XB_TMO])) break; if (_sp > XB_SPIN_CAP) { atomicAdd(&(bar)[XB_TMO], 1u); break; } } } } while (0)
struct XcdBarrier { unsigned* bar; unsigned x; volatile LAS unsigned* st; };
__device__ __forceinline__ XcdBarrier xcd_barrier_post(unsigned* bar, volatile LAS unsigned* st) {
    XcdBarrier b; b.bar = bar; b.x = xb_xcc_id(); b.st = st;
    if (threadIdx.x == 0) (void)xb_add(&bar[XB_XCNT(b.x)], 1u);
    return b;
}
__device__ __forceinline__ void xcd_barrier_complete(unsigned* bar, unsigned x, unsigned& nloc, unsigned& nx) {
    const unsigned G = gridDim.x * gridDim.y * gridDim.z;
    unsigned sum, cnt, mine, sp = 0u;
    for (;;) {
        sum = 0u; cnt = 0u; mine = 0u;
#pragma unroll
        for (unsigned j = 0; j < 16; ++j) { const unsigned c = xb_ld(&bar[XB_XCNT(j)]); sum += c; cnt += (c > 0u) ? 1u : 0u; mine = (j == x) ? c : mine; }
        if (sum == G) break;
        __builtin_amdgcn_s_sleep(1);
        if ((++sp & 255u) == 0u) { if (xb_ld(&bar[XB_TMO])) break; if (sp > XB_SPIN_CAP) { atomicAdd(&bar[XB_TMO], 1u); break; } }
    }
    nloc = mine > 0u ? mine : 1u; nx = cnt > 0u ? cnt : 1u;
}
__device__ __forceinline__ void xcd_barrier(const XcdBarrier& b) {
    asm volatile("s_waitcnt vmcnt(0)" ::: "memory");
    __syncthreads();
    if (threadIdx.x == 0) {
        unsigned* bar = b.bar;
        __builtin_amdgcn_s_waitcnt(0);
        unsigned nloc = b.st[0], nx = b.st[1];
        if (nloc == 0u) { xcd_barrier_complete(bar, b.x, nloc, nx); b.st[0] = nloc; b.st[1] = nx; }
        const unsigned old = xb_add(&bar[XB_XSUB(b.x)], 1u);
        const unsigned gen = old / nloc;
        if (old + 1u == (gen + 1u) * nloc) {
            __builtin_amdgcn_fence(__ATOMIC_RELEASE, "agent");
            asm volatile("s_waitcnt vmcnt(0)" ::: "memory");
            const unsigned og = xb_add(&bar[XB_TOP], 1u);
            const unsigned tg = og / nx;
            if (og + 1u == (tg + 1u) * nx) xb_add(&bar[XB_TOPGEN], 1u);
            else XB_SPIN(xb_ld(&bar[XB_TOPGEN]) == tg, bar);
            __builtin_amdgcn_fence(__ATOMIC_ACQUIRE, "agent");
            xb_add(&bar[XB_XGEN(b.x)], 1u);
            asm volatile("s_waitcnt vmcnt(0)" ::: "memory");
        } else {
            XB_SPIN(xb_ld(&bar[XB_XGEN(b.x)]) == gen, bar);
            __builtin_amdgcn_fence(__ATOMIC_ACQUIRE, "agent");
            asm volatile("s_waitcnt vmcnt(0)" ::: "memory");
        }
    }
    __syncthreads();
}

__device__ __forceinline__ float wave_sum(float v) {
#pragma unroll
    for (int o = 1; o < 64; o <<= 1) v += __shfl_xor(v, o);
    return v;
}

namespace pg8 {
struct EpiIn {
    static constexpr bool PERM = true;
    bf16_t* zbase; bf16_t* AP; float* kpart;
    __device__ __forceinline__ void operator()(const f32x4 (&acc)[2][2][4][2], const Unit& u, int wr, int wc, int fr, int fq) const {
        const int t = u.pn >> 1, colt = (u.pn & 1) * 256;
        const int row0 = u.pm * BM + wr * 64 + fr, col0 = colt + wc * 32 + 8 * fq;
        if (t == 0) {
#pragma unroll
            for (int ai = 0; ai < 2; ++ai)
#pragma unroll
                for (int m = 0; m < 4; ++m) { const int r = row0 + ai * HALF + m * 16, b = r >> 11, l = r & 2047;
#pragma unroll
                    for (int bj = 0; bj < 2; ++bj) { const int c = col0 + bj * HALF, g = c >> 4, hi0 = c & 15;
                        const f32x4 v0 = acc[ai][bj][m][0], v1 = acc[ai][bj][m][1];
                        u32x4 w; w.x = cvt_pk_bf16(v0[0], v0[1]); w.y = cvt_pk_bf16(v0[2], v0[3]); w.z = cvt_pk_bf16(v1[0], v1[1]); w.w = cvt_pk_bf16(v1[2], v1[3]);
                        *(u32x4*)(AP + (size_t)(g * 512 + b * 64 + (l >> 5)) * 640 + (l & 31) * 16 + hi0) = w; } }
        } else {
            bf16_t* base = zbase + (size_t)t * (16u * 1024u * 1024u / 2u);
            const float sc = (t == 1) ? 0.125f * 1.4426950408889634f : 1.0f;
#pragma unroll
            for (int ai = 0; ai < 2; ++ai)
#pragma unroll
                for (int m = 0; m < 4; ++m) { bf16_t* rowp = base + (size_t)(row0 + ai * HALF + m * 16) * 512 + col0;
#pragma unroll
                    for (int bj = 0; bj < 2; ++bj) { f32x4 v0 = acc[ai][bj][m][0], v1 = acc[ai][bj][m][1];
                        if (t >= 4) {
#pragma unroll
                            for (int e = 0; e < 4; ++e) { v0[e] = sigmoid_f(v0[e]); v1[e] = sigmoid_f(v1[e]); }
                        } else { v0 = v0 * sc; v1 = v1 * sc; }
                        u32x4 w; w.x = cvt_pk_bf16(v0[0], v0[1]); w.y = cvt_pk_bf16(v0[2], v0[3]); w.z = cvt_pk_bf16(v1[0], v1[1]); w.w = cvt_pk_bf16(v1[2], v1[3]);
                        *(u32x4*)(rowp + bj * HALF) = w; } }
            if (t == 2) {
#pragma unroll
                for (int bj = 0; bj < 2; ++bj)
#pragma unroll
                    for (int n = 0; n < 2; ++n) { f32x4 s = (f32x4){0.f, 0.f, 0.f, 0.f};
#pragma unroll
                        for (int ai = 0; ai < 2; ++ai)
#pragma unroll
                            for (int m = 0; m < 4; ++m) s += acc[ai][bj][m][n];
#pragma unroll
                        for (int e = 0; e < 4; ++e) { float x = s[e]; x += __shfl_xor(x, 1); x += __shfl_xor(x, 2); x += __shfl_xor(x, 4); x += __shfl_xor(x, 8); s[e] = x; }
                        if (fr == 0) *(f32x4*)(kpart + (size_t)(u.pm * 2 + wr) * 512 + col0 + bj * HALF + 4 * n) = s; }
            }
        }
    }
};
struct EpiE {
    static constexpr bool PERM = false;
    float* E;
    __device__ __forceinline__ void operator()(const f32x4 (&acc)[2][2][4][2], const Unit& u, int wr, int wc, int fr, int fq) const {
        const int row0 = u.pm * BM + wr * 64 + fr, col0 = wc * 32 + 4 * fq;
#pragma unroll
        for (int ai = 0; ai < 2; ++ai)
#pragma unroll
            for (int m = 0; m < 4; ++m) { float* rowp = E + (size_t)(row0 + ai * HALF + m * 16) * 128 + col0;
#pragma unroll
                for (int n = 0; n < 2; ++n) *(f32x4*)(rowp + n * 16) = acc[ai][0][m][n]; }
    }
};
struct EpiY {
    static constexpr bool PERM = true;
    bf16_t* Y;
    __device__ __forceinline__ void operator()(const f32x4 (&acc)[2][2][4][2], const Unit& u, int wr, int wc, int fr, int fq) const {
        const int row0 = u.pm * BM + wr * 64 + fr, col0 = u.pn * BM + wc * 32 + 8 * fq;
#pragma unroll
        for (int ai = 0; ai < 2; ++ai)
#pragma unroll
            for (int m = 0; m < 4; ++m) { const int r = row0 + ai * HALF + m * 16, g = r >> 9, b = (r >> 6) & 7, c = r & 63;
#pragma unroll
                for (int bj = 0; bj < 2; ++bj) { const int cc = col0 + bj * HALF, j = cc >> 4, ho0 = cc & 15;
                    f32x4 v0 = acc[ai][bj][m][0], v1 = acc[ai][bj][m][1];
#pragma unroll
                    for (int e = 0; e < 4; ++e) { v0[e] = gelu_tanh(v0[e]); v1[e] = gelu_tanh(v1[e]); }
                    u32x4 w; w.x = cvt_pk_bf16(v0[0], v0[1]); w.y = cvt_pk_bf16(v0[2], v0[3]); w.z = cvt_pk_bf16(v1[0], v1[1]); w.w = cvt_pk_bf16(v1[2], v1[3]);
                    *(u32x4*)(Y + (size_t)(b * 2048 + c * 32 + j) * 512 + g * 16 + ho0) = w; } }
    }
};
struct EpiGlu {
    static constexpr bool PERM = true;
    const bf16_t* Yp; bf16_t* Ya; const float* bias;
    __device__ __forceinline__ void operator()(const f32x4 (&acc)[2][2][4][2], const Unit& u, int wr, int wc, int fr, int fq) const {
        const int row0 = u.pm * BM + wr * 64 + fr, col0 = u.pn * BM + wc * 32 + 8 * fq;
        f32x4 bv[2][2];
#pragma unroll
        for (int bj = 0; bj < 2; ++bj)
#pragma unroll
            for (int n = 0; n < 2; ++n) bv[bj][n] = *(const f32x4*)(bias + col0 + bj * HALF + 4 * n);
#pragma unroll
        for (int ai = 0; ai < 2; ++ai)
#pragma unroll
            for (int m = 0; m < 4; ++m) { const size_t off = (size_t)(row0 + ai * HALF + m * 16) * 512 + col0;
#pragma unroll
                for (int bj = 0; bj < 2; ++bj) { const f32x4 z0 = acc[ai][bj][m][0] + bv[bj][0], z1 = acc[ai][bj][m][1] + bv[bj][1];
                    const u32x4 y = *(const u32x4*)(Yp + off + bj * HALF);
                    u32x4 w; w.x = cvt_pk_bf16(bf_lo(y.x) * sigmoid_f(z0[0]), bf_hi(y.x) * sigmoid_f(z0[1])); w.y = cvt_pk_bf16(bf_lo(y.y) * sigmoid_f(z0[2]), bf_hi(y.y) * sigmoid_f(z0[3]));
                    w.z = cvt_pk_bf16(bf_lo(y.z) * sigmoid_f(z1[0]), bf_hi(y.z) * sigmoid_f(z1[1])); w.w = cvt_pk_bf16(bf_lo(y.w) * sigmoid_f(z1[2]), bf_hi(y.w) * sigmoid_f(z1[3]));
                    *(u32x4*)(Ya + off + bj * HALF) = w; } }
    }
};
template <int ADD> struct EpiMrg {
    static constexpr bool PERM = true;
    const bf16_t* G0; bf16_t* Mrg;
    __device__ __forceinline__ void operator()(const f32x4 (&acc)[2][2][4][2], const Unit& u, int wr, int wc, int fr, int fq) const {
        const int row0 = u.pm * BM + wr * 64 + fr, cin = wc * 32 + 8 * fq;
        const bf16_t* gb = G0 + (size_t)(u.pn >> 1) * (16u * 1024u * 1024u / 2u) + (u.pn & 1) * 256 + cin;
#pragma unroll
        for (int ai = 0; ai < 2; ++ai)
#pragma unroll
            for (int m = 0; m < 4; ++m) { const int r = row0 + ai * HALF + m * 16;
#pragma unroll
                for (int bj = 0; bj < 2; ++bj) {
#if defined(ABL_NO_SSM) || defined(ABL_NO_ATT)
#if defined(ABL_NO_SSM)
                    constexpr bool kill = (ADD == 0);
#else
                    constexpr bool kill = (ADD == 1);
#endif
                    const f32x4 a0 = kill ? (f32x4){0.f, 0.f, 0.f, 0.f} : acc[ai][bj][m][0], a1 = kill ? (f32x4){0.f, 0.f, 0.f, 0.f} : acc[ai][bj][m][1];
#else
                    const f32x4 a0 = acc[ai][bj][m][0], a1 = acc[ai][bj][m][1];
#endif
                    const u32x4 gt = *(const u32x4*)(gb + (size_t)r * 512 + bj * HALF);
                    bf16_t* mp = Mrg + (size_t)r * 1024 + u.pn * BM + cin + bj * HALF;
                    float o[8] = { bf_lo(gt.x) * a0[0], bf_hi(gt.x) * a0[1], bf_lo(gt.y) * a0[2], bf_hi(gt.y) * a0[3], bf_lo(gt.z) * a1[0], bf_hi(gt.z) * a1[1], bf_lo(gt.w) * a1[2], bf_hi(gt.w) * a1[3] };
                    if (ADD) { const u32x4 p = *(const u32x4*)mp; o[0] += bf_lo(p.x); o[1] += bf_hi(p.x); o[2] += bf_lo(p.y); o[3] += bf_hi(p.y); o[4] += bf_lo(p.z); o[5] += bf_hi(p.z); o[6] += bf_lo(p.w); o[7] += bf_hi(p.w); }
                    u32x4 w; w.x = cvt_pk_bf16(o[0], o[1]); w.y = cvt_pk_bf16(o[2], o[3]); w.z = cvt_pk_bf16(o[4], o[5]); w.w = cvt_pk_bf16(o[6], o[7]);
                    *(u32x4*)mp = w; } }
    }
};
struct EpiMrgDual {
    static constexpr bool PERM = true;
    EpiMrg<0> a; EpiMrg<1> b;
    __device__ __forceinline__ void operator()(const f32x4 (&acc)[2][2][4][2], const Unit& u, int wr, int wc, int fr, int fq) const { if (u.w == 0) a(acc, u, wr, wc, fr, fq); else b(acc, u, wr, wc, fr, fq); }
};
struct EpiX1 {
    static constexpr bool PERM = true;
    const float* X; float* X1; bf16_t* XG; const float* g2; float* ssq;
    __device__ __forceinline__ void operator()(const f32x4 (&acc)[2][2][4][2], const Unit& u, int wr, int wc, int fr, int fq) const {
        const int row0 = u.pm * BM + wr * 64 + fr, col0 = u.pn * BM + wc * 32 + 8 * fq;
#pragma unroll
        for (int ai = 0; ai < 2; ++ai)
#pragma unroll
            for (int m = 0; m < 4; ++m) { const int r = row0 + ai * HALF + m * 16; const size_t off = (size_t)r * 1024 + col0; float s = 0.f;
#pragma unroll
                for (int bj = 0; bj < 2; ++bj) {
                    #ifdef ABL_NO_MIX
                    const f32x4 x0 = *(const f32x4*)(X + off + bj * HALF), x1 = *(const f32x4*)(X + off + bj * HALF + 4);
#else
                    const f32x4 x0 = *(const f32x4*)(X + off + bj * HALF) + acc[ai][bj][m][0], x1 = *(const f32x4*)(X + off + bj * HALF + 4) + acc[ai][bj][m][1];
#endif
                    s += (x0[0] * x0[0] + x0[1] * x0[1]) + (x0[2] * x0[2] + x0[3] * x0[3]) + (x1[0] * x1[0] + x1[1] * x1[1]) + (x1[2] * x1[2] + x1[3] * x1[3]);
                    u32x4 w; w.x = cvt_pk_bf16(x0[0], x0[1]); w.y = cvt_pk_bf16(x0[2], x0[3]); w.z = cvt_pk_bf16(x1[0], x1[1]); w.w = cvt_pk_bf16(x1[2], x1[3]);
                    *(u32x4*)(XG + off + bj * HALF) = w; }
                s += __shfl_xor(s, 16); s += __shfl_xor(s, 32);
                if (fq == 0) ssq[(size_t)r * 16 + u.pn * 4 + wc] = s; }
    }
};
struct EpiPlain {
    static constexpr bool PERM = true;
    bf16_t* O; int ldc;
    __device__ __forceinline__ void operator()(const f32x4 (&acc)[2][2][4][2], const Unit& u, int wr, int wc, int fr, int fq) const {
        const int row0 = u.pm * BM + wr * 64 + fr, col0 = u.pn * BM + wc * 32 + 8 * fq;
#pragma unroll
        for (int ai = 0; ai < 2; ++ai)
#pragma unroll
            for (int m = 0; m < 4; ++m) { bf16_t* rowp = O + (size_t)(row0 + ai * HALF + m * 16) * ldc + col0;
#pragma unroll
                for (int bj = 0; bj < 2; ++bj) { const f32x4 v0 = acc[ai][bj][m][0], v1 = acc[ai][bj][m][1];
                    u32x4 w; w.x = cvt_pk_bf16(v0[0], v0[1]); w.y = cvt_pk_bf16(v0[2], v0[3]); w.z = cvt_pk_bf16(v1[0], v1[1]); w.w = cvt_pk_bf16(v1[2], v1[3]);
                    *(u32x4*)(rowp + bj * HALF) = w; } }
    }
};
}
struct Frame {
    LAS unsigned char* lds;
    int tid, lane, wave, vcu, G;
};

__device__ __forceinline__ void p0_transpose_item(const float* W, int K, int N, bf16* WT, LAS float* scr, int item, int lane, const float* kscale = nullptr) {
    const int nblk = N / 32, kb = item / nblk, nb = item % nblk, k0 = 64 * kb, n0 = 32 * nb;
    float wv[32];
#pragma unroll
    for (int i = 0; i < 32; ++i) { const int kk = 2 * i + (lane >> 5); wv[i] = W[(size_t)(k0 + kk) * N + n0 + (lane & 31)]; }
    if (kscale) {
#pragma unroll
        for (int i = 0; i < 32; ++i) wv[i] *= kscale[k0 + 2 * i + (lane >> 5)]; }
#pragma unroll
    for (int i = 0; i < 32; ++i) { const int kk = 2 * i + (lane >> 5); scr[kk * 33 + (lane & 31)] = wv[i]; }
    LDS_WAIT(); asm volatile("" ::: "memory");
    const int c = lane & 7;
#pragma unroll
    for (int j = 0; j < 4; ++j) { const int n = (lane >> 3) + 8 * j; const LAS float* s = scr + (8 * c) * 33 + n;
        v4u o; o.x = pk2(s[0 * 33], s[1 * 33]); o.y = pk2(s[2 * 33], s[3 * 33]); o.z = pk2(s[4 * 33], s[5 * 33]); o.w = pk2(s[6 * 33], s[7 * 33]);
        *(GAS v4u*)(WT + (size_t)(n0 + n) * K + k0 + 8 * c) = o; }
    LDS_WAIT(); asm volatile("" ::: "memory");
}
__device__ __forceinline__ void rms_row_to_bf16(const float* xrow, const float* g, bf16* orow, int lane) {
    const GAS f32x4* xr = (const GAS f32x4*)xrow + lane; const GAS f32x4* gr = (const GAS f32x4*)g + lane;
    f32x4 v[4]; float s = 0.f;
#pragma unroll
    for (int j = 0; j < 4; ++j) { v[j] = xr[64 * j]; s += (v[j].x * v[j].x + v[j].y * v[j].y) + (v[j].z * v[j].z + v[j].w * v[j].w); }
    const float rstd = 1.0f / sqrtf(wave_sum(s) * (1.f / DMODEL) + RMS_EPS);
    GAS unsigned long long* o8 = (GAS unsigned long long*)orow + lane;
#pragma unroll
    for (int j = 0; j < 4; ++j) { const f32x4 gg = gr[64 * j];
        o8[64 * j] = (unsigned long long)pk2(v[j].x * rstd * gg.x, v[j].y * rstd * gg.y) | ((unsigned long long)pk2(v[j].z * rstd * gg.z, v[j].w * rstd * gg.w) << 32); }
}
__device__ __forceinline__ void rms_rows4_to_bf16(const float* x, const float* g, bf16* out, int m, int stride, int lane) {
    f32x4 v[4][4];
#pragma unroll
    for (int k = 0; k < 4; ++k) { const int mm = (m + k * stride < MTOK) ? m + k * stride : m; const GAS f32x4* xr = (const GAS f32x4*)(x + (size_t)mm * DMODEL) + lane;
#pragma unroll
        for (int j = 0; j < 4; ++j) v[k][j] = xr[64 * j]; }
    const GAS f32x4* gr = (const GAS f32x4*)g + lane; f32x4 gg[4];
#pragma unroll
    for (int j = 0; j < 4; ++j) gg[j] = gr[64 * j];
#pragma unroll
    for (int k = 0; k < 4; ++k) { if (m + k * stride >= MTOK) break; float s = 0.f;
#pragma unroll
        for (int j = 0; j < 4; ++j) s += (v[k][j].x * v[k][j].x + v[k][j].y * v[k][j].y) + (v[k][j].z * v[k][j].z + v[k][j].w * v[k][j].w);
        const float rstd = 1.0f / sqrtf(wave_sum(s) * (1.f / DMODEL) + RMS_EPS);
        GAS unsigned long long* o8 = (GAS unsigned long long*)(out + (size_t)(m + k * stride) * DMODEL) + lane;
#pragma unroll
        for (int j = 0; j < 4; ++j) o8[64 * j] = (unsigned long long)pk2(v[k][j].x * rstd * gg[j].x, v[k][j].y * rstd * gg[j].y) | ((unsigned long long)pk2(v[k][j].z * rstd * gg[j].z, v[k][j].w * rstd * gg[j].w) << 32); }
}
struct cpx { float r, i; };
__device__ __forceinline__ cpx cmul(cpx a, cpx b) { return cpx{a.r * b.r - a.i * b.i, a.r * b.i + a.i * b.r}; }
__device__ __forceinline__ cpx cpow_(float ar, float ai, float dt, int n) { const float e = expf(ar * dt * (float)n); const float ang = ai * dt * (float)n; return cpx{e * cosf(ang), e * sinf(ang)}; }
__device__ __forceinline__ void ssm_table_task(int g, int j, int lane, LAS float* scr, const float* a_re, const float* a_im, const float* log_dt, const float* b_re, const float* b_im,
                                               const float* c_re, const float* c_im, float* Kg, bf16* WE, bf16* BP, float* pw32) {
    const int p = lane;
    const float dt = expf(log_dt[g]), ar = a_re[g * 64 + p], ai = a_im[g * 64 + p];
#define pw(n) cpow_(ar, ai, dt, (n))
    const cpx lb = pw(1);
    const float den = ar * ar + ai * ai;
    const cpx coef = cpx{((lb.r - 1.f) * ar + lb.i * ai) / den, (lb.i * ar - (lb.r - 1.f) * ai) / den};
    const cpx pj = pw(j), pe = pw(31 - j), pv = pw(j + 1);
    unsigned wer[8], wei[8];
#pragma unroll
    for (int h2 = 0; h2 < 8; ++h2) { float er[2], ei[2];
#pragma unroll
        for (int q = 0; q < 2; ++q) { const int hi = 2 * h2 + q;
            const cpx bb = cmul(coef, cpx{b_re[(g * 64 + p) * 16 + hi], b_im[(g * 64 + p) * 16 + hi]});
            const cpx w = cmul(pj, bb); scr[(p * 16 + hi) * 2] = w.r; scr[(p * 16 + hi) * 2 + 1] = w.i;
            const cpx e = cmul(pe, bb); er[q] = e.r; ei[q] = e.i; }
        wer[h2] = pk2(er[0], er[1]); wei[h2] = pk2(ei[0], ei[1]); }
    { bf16* w0 = WE + ((size_t)(g * 256 + p) * 512 + j * 16); bf16* w1 = WE + ((size_t)(g * 256 + 64 + p) * 512 + j * 16);
      *(GAS v4u*)w0 = (v4u){wer[0], wer[1], wer[2], wer[3]}; *(GAS v4u*)(w0 + 8) = (v4u){wer[4], wer[5], wer[6], wer[7]};
      *(GAS v4u*)w1 = (v4u){wei[0], wei[1], wei[2], wei[3]}; *(GAS v4u*)(w1 + 8) = (v4u){wei[4], wei[5], wei[6], wei[7]};
      bf16* z0 = WE + ((size_t)(g * 256 + 128 + p) * 512 + j * 16); bf16* z1 = WE + ((size_t)(g * 256 + 192 + p) * 512 + j * 16); const v4u z = (v4u){0u, 0u, 0u, 0u};
      *(GAS v4u*)z0 = z; *(GAS v4u*)(z0 + 8) = z; *(GAS v4u*)z1 = z; *(GAS v4u*)(z1 + 8) = z; }
#pragma unroll 4
    for (int ho = 0; ho < 16; ++ho) { const cpx cv = cmul(cpx{c_re[(g * 16 + ho) * 64 + p], c_im[(g * 16 + ho) * 64 + p]}, pv);
        bf16* row = BP + ((size_t)(g * 512 + j * 16 + ho) * APK + 512);
        row[p] = (bf16)f2bf(cv.r); row[64 + p] = (bf16)f2bf(-cv.i); }
    if (j == 0) { const cpx p32 = pw(32); pw32[g * 128 + p] = p32.r; pw32[g * 128 + 64 + p] = p32.i; }
    LDS_WAIT(); asm volatile("" ::: "memory");
    { const int ho = lane >> 2, h4 = (lane & 3) * 4; float a0 = 0.f, a1 = 0.f, a2 = 0.f, a3 = 0.f;
      const float* cr = c_re + (g * 16 + ho) * 64; const float* ci = c_im + (g * 16 + ho) * 64;
#pragma unroll 4
      for (int pp = 0; pp < 64; ++pp) { const float r_ = cr[pp], i_ = ci[pp]; const LAS float* w = scr + (pp * 16 + h4) * 2;
          a0 += r_ * w[0] - i_ * w[1]; a1 += r_ * w[2] - i_ * w[3]; a2 += r_ * w[4] - i_ * w[5]; a3 += r_ * w[6] - i_ * w[7]; }
      *(GAS f32x4*)(Kg + ((size_t)(g * 32 + j) * 256 + ho * 16 + h4)) = (f32x4){a0, a1, a2, a3}; }
    LDS_WAIT(); asm volatile("" ::: "memory");
#undef pw
}

__device__ __forceinline__ float vmaxf(float a, float b) { float r; asm("v_max_f32_e32 %0, %1, %2" : "=v"(r) : "v"(a), "v"(b)); return r; }
__device__ __forceinline__ float vminf(float a, float b) { float r; asm("v_min_f32_e32 %0, %1, %2" : "=v"(r) : "v"(a), "v"(b)); return r; }
__device__ __forceinline__ float selhi(float lo, float hi) { float r; asm("v_cndmask_b32_e64 %0, %1, %2, %3" : "=v"(r) : "v"(lo), "v"(hi), "s"(0xFFFFFFFF00000000ull)); return r; }
#define CE_DESC(a, b) do { const float hi_ = vmaxf(a, b), lo_ = vminf(a, b); a = hi_; b = lo_; } while (0)
__device__ __forceinline__ void sort16_desc(float (&v)[16]) {
#pragma unroll
    for (int k = 2; k <= 16; k <<= 1)
#pragma unroll
        for (int j = k >> 1; j > 0; j >>= 1)
#pragma unroll
            for (int i = 0; i < 16; ++i) { const int l = i ^ j; if (l > i) { if ((i & k) == 0) CE_DESC(v[i], v[l]); else CE_DESC(v[l], v[i]); } }
}
__device__ __forceinline__ void bitonic_merge16_desc(float (&v)[16]) {
#pragma unroll
    for (int j = 8; j > 0; j >>= 1)
#pragma unroll
        for (int i = 0; i < 16; ++i) { const int l = i ^ j; if (l > i) CE_DESC(v[i], v[l]); }
}
__device__ __forceinline__ void merge_top16(float (&a)[16], const float (&b)[16]) {
#pragma unroll
    for (int i = 0; i < 16; ++i) a[i] = vmaxf(a[i], b[15 - i]);
    bitonic_merge16_desc(a);
}
__device__ __forceinline__ void merge_partner_top16(float (&a)[16]) {
    float p[16];
#pragma unroll
    for (int i = 0; i < 16; ++i) { const unsigned x = __float_as_uint(a[15 - i]); auto rr = __builtin_amdgcn_permlane32_swap(x, x, false, false); p[i] = selhi(__uint_as_float(rr[1]), __uint_as_float(rr[0])); }
#pragma unroll
    for (int i = 0; i < 16; ++i) a[i] = vmaxf(a[i], p[i]);
    bitonic_merge16_desc(a);
}
__device__ __forceinline__ void topk_half(int half, const bf16x8 (&qf)[8], int r32, int hi, const LAS unsigned char* ksl, float (&top)[16]) {
#pragma unroll 1
    for (int kt = 0; kt < 4; ++kt) {
        f32x16 acc = f32x16{};
        const int row = half * 128 + kt * 32 + r32; const LAS unsigned char* rp = ksl + row * 256; const int sw = row & 15;
#pragma unroll
        for (int ks = 0; ks < 8; ++ks) { const bf16x8 a = *(const LAS bf16x8*)(rp + (((2 * ks + hi) ^ sw) << 4));
            acc = __builtin_amdgcn_mfma_f32_32x32x16_bf16(a, qf[ks], acc, 0, 0, 0); }
        float grp[16];
#pragma unroll
        for (int r = 0; r < 16; ++r) { const unsigned key = (unsigned)(kt * 32 + (r & 3) + 8 * (r >> 2)) + 4u * (unsigned)hi; grp[r] = __uint_as_float((__float_as_uint(acc[r]) & ~127u) | key); }
        sort16_desc(grp);
        if (kt == 0) {
#pragma unroll
            for (int i = 0; i < 16; ++i) top[i] = grp[i];
        } else merge_top16(top, grp);
    }
    merge_partner_top16(top);
}
__device__ __forceinline__ void topk_task(int tt, int hd, int lane, LAS unsigned char* scr, const bf16* PQb, const LAS unsigned char* ksl, const float* ssq1, int* ids, float* gts, float* rstd1) {
    const int r32 = lane & 31, hi = lane >> 5; const bool hib = hi != 0;
    const int token = tt * 32 + r32;
    float v0_[16], v1_[16];
    bf16x8 qf0[8], qf1[8];
#pragma unroll
    for (int ks = 0; ks < 8; ++ks) { qf0[ks] = *(const GAS bf16x8*)(PQb + (size_t)token * PQ + hd * 256 + ks * 16 + hi * 8); qf1[ks] = *(const GAS bf16x8*)(PQb + (size_t)token * PQ + hd * 256 + 128 + ks * 16 + hi * 8); }
    topk_half(0, qf0, r32, hi, ksl, v0_);
    topk_half(1, qf1, r32, hi, ksl, v1_);
#define v_SEL(h, i) ((h) ? v1_[i] : v0_[i])
    LAS unsigned char* slot = scr + lane * 32;
    { v4u d0, d1;
#define PK4(h, k) ((__float_as_uint(v_SEL(h, 4 * (k))) & 127u) | ((__float_as_uint(v_SEL(h, 4 * (k) + 1)) & 127u) << 8) | ((__float_as_uint(v_SEL(h, 4 * (k) + 2)) & 127u) << 16) | ((__float_as_uint(v_SEL(h, 4 * (k) + 3)) & 127u) << 24))
      d0 = (v4u){PK4(0, 0), PK4(0, 1), PK4(0, 2), PK4(0, 3)}; d1 = (v4u){PK4(1, 0), PK4(1, 1), PK4(1, 2), PK4(1, 3)};
#undef PK4
      *(LAS v4u*)slot = d0; *(LAS v4u*)(slot + 16) = d1; }
    float a[16], b[16];
#pragma unroll
    for (int i = 0; i < 16; ++i) { a[i] = selhi(v0_[i], v1_[i]); b[i] = selhi(v1_[i], v0_[i]); }
    const unsigned obit = (unsigned)hi << 8;
#define CAND(i, j) __uint_as_float((__float_as_uint(a[i] + b[j]) & ~511u) | obit | (unsigned)(((i) << 4) | (j)))
    const float NEGBIG = -3.0e38f;
    float g0[16], g1[16];
#pragma unroll
    for (int j = 1; j < 16; ++j) g0[j - 1] = CAND(0, j);
    g0[15] = CAND(1, 2);
    g1[0] = CAND(1, 3); g1[1] = CAND(1, 4); g1[2] = CAND(1, 5); g1[3] = CAND(1, 6); g1[4] = CAND(1, 7); g1[5] = CAND(2, 3); g1[6] = CAND(2, 4);
    { const float c0 = CAND(0, 0), c1 = CAND(1, 1), c2 = CAND(2, 2), c3 = CAND(3, 3);
      g1[7] = selhi(c0, NEGBIG); g1[8] = selhi(c1, NEGBIG); g1[9] = selhi(c2, NEGBIG); g1[10] = selhi(c3, NEGBIG); }
#pragma unroll
    for (int i = 11; i < 16; ++i) g1[i] = NEGBIG;
#undef CAND
    sort16_desc(g0); sort16_desc(g1); merge_top16(g0, g1); merge_partner_top16(g0);
    float rstd;
    { const GAS f32x4* sp = (const GAS f32x4*)(ssq1 + (size_t)token * 16); const f32x4 s0 = sp[0], s1 = sp[1], s2 = sp[2], s3 = sp[3];
      const float ss = ((s0.x + s0.y) + (s0.z + s0.w)) + ((s1.x + s1.y) + (s1.z + s1.w)) + ((s2.x + s2.y) + (s2.z + s2.w)) + ((s3.x + s3.y) + (s3.z + s3.w));
      rstd = 1.0f / sqrtf(ss * (1.f / DMODEL) + RMS_EPS); }
    if (hd == 0 && !hib) rstd1[token] = rstd;
    float ex[16], esum = 0.f; const float sc = rstd * 1.4426950409f;
#pragma unroll
    for (int k = 0; k < 16; ++k) { ex[k] = __builtin_amdgcn_exp2f((g0[k] - g0[0]) * sc); esum += ex[k]; }
    const float inv = 1.0f / esum;
    int eid[8]; float gv[8];
#pragma unroll
    for (int k = 0; k < 8; ++k) { const float wv = selhi(g0[k], g0[8 + k]); const float ev = selhi(ex[k], ex[8 + k]);
        const unsigned tag = __float_as_uint(wv) & 511u, o = tag >> 8, i = (tag >> 4) & 15u, j = tag & 15u; const unsigned i1 = o ? j : i, i2 = o ? i : j;
        const unsigned k1 = slot[i1], k2 = slot[16 + i2];
        eid[k] = (int)(k1 * 128u + k2); gv[k] = ev * inv; }
    { int* ip = ids + (size_t)token * 128 + hd * 16 + 8 * hi; float* gp = gts + (size_t)token * 128 + hd * 16 + 8 * hi;
      *(GAS v4u*)ip = (v4u){(unsigned)eid[0], (unsigned)eid[1], (unsigned)eid[2], (unsigned)eid[3]}; *(GAS v4u*)(ip + 4) = (v4u){(unsigned)eid[4], (unsigned)eid[5], (unsigned)eid[6], (unsigned)eid[7]};
      *(GAS f32x4*)gp = (f32x4){gv[0], gv[1], gv[2], gv[3]}; *(GAS f32x4*)(gp + 4) = (f32x4){gv[4], gv[5], gv[6], gv[7]}; }
    LDS_WAIT(); asm volatile("" ::: "memory");
}


__device__ __forceinline__ float dot2bf(unsigned a, unsigned b, float c) { return __builtin_amdgcn_fdot2_f32_bf16(__builtin_bit_cast(bf16x2_t, a), __builtin_bit_cast(bf16x2_t, b), c, false); }
__device__ __forceinline__ h2_t fma_h2(unsigned v, h2_t w, h2_t acc) { return __builtin_elementwise_fma(__builtin_bit_cast(h2_t, v), w, acc); }
__device__ __forceinline__ unsigned fp8lo_bf(unsigned w, float sc) { return __builtin_bit_cast(unsigned, __builtin_amdgcn_cvt_scalef32_pk_bf16_fp8((int)w, sc, false)); }
__device__ __forceinline__ unsigned fp8hi_bf(unsigned w, float sc) { return __builtin_bit_cast(unsigned, __builtin_amdgcn_cvt_scalef32_pk_bf16_fp8((int)w, sc, true)); }
__device__ __forceinline__ h2_t fp8lo_h(unsigned w, float sc) { return __builtin_amdgcn_cvt_scalef32_pk_f16_fp8((int)w, sc, false); }
__device__ __forceinline__ h2_t fp8hi_h(unsigned w, float sc) { return __builtin_amdgcn_cvt_scalef32_pk_f16_fp8((int)w, sc, true); }
__device__ __forceinline__ unsigned pack_fp8x4(float a, float b, float c, float d) { int w = __builtin_amdgcn_cvt_pk_fp8_f32(a, b, 0, false); w = __builtin_amdgcn_cvt_pk_fp8_f32(c, d, w, true); return (unsigned)w; }
constexpr size_t V6B_OFF = 8u << 20;
constexpr float U8_SCALE = 64.0f, V8_SCALE = 5.656854f;
constexpr int PA_CAP = 456;
constexpr float X8_SCALE = 2.0f;
typedef int v8i_t __attribute__((ext_vector_type(8)));
typedef _Float16 v32h_t __attribute__((ext_vector_type(32)));
typedef unsigned v6u_t __attribute__((ext_vector_type(6)));
typedef unsigned v2u __attribute__((ext_vector_type(2)));
struct TokB { v8i_t b[8]; };
struct RowsA { const unsigned char* p0; const unsigned char* p1; };
__device__ __forceinline__ int pa_tok(unsigned tl, int tb, int nwg) { return ((tl < 4u) ? tb : nwg) + (int)(tl & 3u); }
__device__ __forceinline__ RowsA pa_rows(int b, int n, int lane, const LAS unsigned* list, const unsigned char* U6) {
    const int i0 = b * 16 + (lane >> 3), r8 = lane >> 3, ps = lane & 7;
    const unsigned e0 = list[i0 < n ? i0 : 0], e1 = list[i0 + 8 < n ? i0 + 8 : 0];
    RowsA R; R.p0 = U6 + (size_t)(e0 & 0x3fffu) * 768 + ((ps ^ r8) * 16); R.p1 = U6 + (size_t)(e1 & 0x3fffu) * 768 + ((ps ^ r8 ^ 1) * 16);
    return R;
}
template <int J> __device__ __forceinline__ void pa_dma(const RowsA& R, LAS unsigned char* ring) {
    __builtin_amdgcn_global_load_lds((const unsigned*)R.p0, (LAS unsigned*)(ring + J * (2048 - 128)), 16, J * 128, 0);
    __builtin_amdgcn_global_load_lds((const unsigned*)R.p1, (LAS unsigned*)(ring + J * (2048 - 128) + 1024), 16, J * 128, 0);
}
#define PA_VWAIT(n) asm volatile("s_waitcnt vmcnt(" #n ")" ::: "memory")
#define PA_LWAIT(n) asm volatile("s_waitcnt lgkmcnt(" #n ")" ::: "memory")
__device__ __forceinline__ int pa_uoff(int u, int r) { return (u >> 4) * 2048 + (r >> 3) * 1024 + (r & 7) * 128 + ((((u >> 1) & 7) ^ (r & 7) ^ (r >> 3)) << 4) + (u & 1) * 8; }
struct OpA { v2u d0, d1, d2; };
__device__ __forceinline__ OpA pa_rd(int m, const LAS unsigned char* ring, int r, int g) { const int u = 12 * m + 3 * g; OpA a;
    a.d0 = *(const LAS v2u*)(ring + pa_uoff(u, r)); a.d1 = *(const LAS v2u*)(ring + pa_uoff(u + 1, r)); a.d2 = *(const LAS v2u*)(ring + pa_uoff(u + 2, r)); return a; }
__device__ __forceinline__ f32x4 pa_mm(f32x4 acc, const OpA& a, const TokB& X, int m) {
    return __builtin_amdgcn_mfma_scale_f32_16x16x128_f8f6f4((v8i_t){(int)a.d0.x, (int)a.d0.y, (int)a.d1.x, (int)a.d1.y, (int)a.d2.x, (int)a.d2.y, 0, 0}, X.b[m], acc, 2, 2, 0, 0, 0, 0);
}
__device__ __forceinline__ void pa_flush(int n, const TokB& X, int lane, LAS unsigned* list, const LAS unsigned* gl, LAS unsigned char* ring, const unsigned char* U6, unsigned* wpk, int tb, int nwg) {
    if (n == 0) return;
    LDS_WAIT(); asm volatile("" ::: "memory");
    const int nb = (n + 15) >> 4;
    const int r = lane & 15, g = lane >> 4;
    RowsA cur = pa_rows(0, n, lane, list, U6), nxt = cur;
    pa_dma<0>(cur, ring); pa_dma<1>(cur, ring); pa_dma<2>(cur, ring); pa_dma<3>(cur, ring); pa_dma<4>(cur, ring); pa_dma<5>(cur, ring);
    for (int b = 0; b < nb; ++b) {
        f32x4 acc0 = {0.f, 0.f, 0.f, 0.f}, acc1 = {0.f, 0.f, 0.f, 0.f};
        OpA A0, A1;
        if (b + 1 < nb) {
            nxt = pa_rows(b + 1, n, lane, list, U6);
            PA_VWAIT(10); A0 = pa_rd(0, ring, r, g);
            PA_VWAIT(8);  A1 = pa_rd(1, ring, r, g); PA_LWAIT(3); acc0 = pa_mm(acc0, A0, X, 0);
            PA_VWAIT(6);  A0 = pa_rd(2, ring, r, g); PA_LWAIT(3); acc1 = pa_mm(acc1, A1, X, 1); pa_dma<0>(nxt, ring);
                          A1 = pa_rd(3, ring, r, g); PA_LWAIT(3); acc0 = pa_mm(acc0, A0, X, 2); pa_dma<1>(nxt, ring);
            PA_VWAIT(8);  A0 = pa_rd(4, ring, r, g); PA_LWAIT(3); acc1 = pa_mm(acc1, A1, X, 3); pa_dma<2>(nxt, ring);
            PA_VWAIT(8);  A1 = pa_rd(5, ring, r, g); PA_LWAIT(3); acc0 = pa_mm(acc0, A0, X, 4);
            PA_VWAIT(6);  A0 = pa_rd(6, ring, r, g); PA_LWAIT(3); acc1 = pa_mm(acc1, A1, X, 5); pa_dma<3>(nxt, ring);
                          A1 = pa_rd(7, ring, r, g); PA_LWAIT(3); acc0 = pa_mm(acc0, A0, X, 6); pa_dma<4>(nxt, ring);
                                                     PA_LWAIT(0); acc1 = pa_mm(acc1, A1, X, 7); pa_dma<5>(nxt, ring);
            cur = nxt;
        } else {
            PA_VWAIT(0);
            A0 = pa_rd(0, ring, r, g);
#pragma unroll
            for (int m = 0; m < 8; m += 2) { A1 = pa_rd(m + 1, ring, r, g); PA_LWAIT(3); acc0 = pa_mm(acc0, A0, X, m);
                if (m + 2 < 8) { A0 = pa_rd(m + 2, ring, r, g); PA_LWAIT(3); } else PA_LWAIT(0);
                acc1 = pa_mm(acc1, A1, X, m + 1); }
        }
        const f32x4 acc = acc0 + acc1;
        const int idx = b * 16 + r; const unsigned ent = list[idx], tl = ent >> 21, slot = (ent >> 14) & 127u;
        const int src = (int)((((unsigned)r >> 2) * 16u + tl) << 2);
        const float v0 = __int_as_float(__builtin_amdgcn_ds_bpermute(src, __float_as_int(acc.x))), v1 = __int_as_float(__builtin_amdgcn_ds_bpermute(src, __float_as_int(acc.y)));
        const float v2 = __int_as_float(__builtin_amdgcn_ds_bpermute(src, __float_as_int(acc.z))), v3 = __int_as_float(__builtin_amdgcn_ds_bpermute(src, __float_as_int(acc.w)));
        const float dv = (r & 2) ? ((r & 1) ? v3 : v2) : ((r & 1) ? v1 : v0);
        if (lane < 16 && idx < n) { const int t = pa_tok(tl, tb, nwg);
            const _Float16 wh = (_Float16)(__uint_as_float(gl[tl * 128 + slot]) * (1.0f / V8_SCALE) * gelu_tanh(dv * (1.0f / (U8_SCALE * X8_SCALE))));
            const unsigned pos = __hip_atomic_fetch_add((LAS unsigned*)(list + PA_CAP) + tl, 1u, __ATOMIC_RELAXED, __HIP_MEMORY_SCOPE_WAVEFRONT);
            wpk[(size_t)t * 128 + pos] = ((unsigned)__builtin_bit_cast(unsigned short, wh) << 16) | (ent & 0x3fffu); }
    }
    LDS_WAIT(); asm volatile("" ::: "memory");
}
__device__ __forceinline__ void peer_a_phase(int lane, int wave, int G, int vcu, const bf16* XG, const unsigned char* U6, const int* ids, const float* gts, const float* rstd1, unsigned* wpk, LAS unsigned char* lds, const float* g2) {
    LAS unsigned char* ring = lds + RING_OFF + wave * 16384;
    LAS unsigned* gl = (LAS unsigned*)(ring + 12288);
    LAS unsigned* list = (LAS unsigned*)(lds + MISC_OFF + 128 + wave * (464 * 4));
    for (int tile0 = vcu; tile0 < MTOK / 32; tile0 += 2 * G) {
        const int tile1 = tile0 + G; const bool has1 = tile1 < MTOK / 32;
        const int tb = tile0 * 32 + wave * 4, nwg = (has1 ? tile1 : tile0) * 32 + wave * 4;
        int id0[8], id1[8];
        if (lane < 8) list[PA_CAP + lane] = 0u;
#pragma unroll
        for (int k = 0; k < 8; ++k) { const bool ok = (k < 4) || has1; const int tc = pa_tok((unsigned)k, tb, nwg);
            gl[k * 128 + lane] = __float_as_uint(gts[(size_t)tc * 128 + lane]); gl[k * 128 + 64 + lane] = __float_as_uint(gts[(size_t)tc * 128 + 64 + lane]);
            id0[k] = ok ? ids[(size_t)tc * 128 + lane] : -1; id1[k] = ok ? ids[(size_t)tc * 128 + 64 + lane] : -1; }
#pragma unroll
        for (int p = 0; p < 4; ++p) { const int k = 2 * p + (lane >> 5), tc = pa_tok((unsigned)k, tb, nwg);
            typedef float v16f_t __attribute__((ext_vector_type(16)));
            const GAS v4u* xs = (const GAS v4u*)(XG + (size_t)tc * 1024 + 32 * (lane & 31));
            const v4u x0 = xs[0], x1 = xs[1], x2 = xs[2], x3 = xs[3];
            const float rs = rstd1[tc] * X8_SCALE;
            const unsigned w[16] = {x0.x, x0.y, x0.z, x0.w, x1.x, x1.y, x1.z, x1.w, x2.x, x2.y, x2.z, x2.w, x3.x, x3.y, x3.z, x3.w};
            float f[32];
#pragma unroll
            for (int i = 0; i < 8; ++i) { const f32x4 gq = *(const GAS f32x4*)(g2 + 32 * (lane & 31) + 4 * i);
                f[4 * i] = __uint_as_float(w[2 * i] << 16) * rs * gq.x; f[4 * i + 1] = __uint_as_float(w[2 * i] & 0xffff0000u) * rs * gq.y;
                f[4 * i + 2] = __uint_as_float(w[2 * i + 1] << 16) * rs * gq.z; f[4 * i + 3] = __uint_as_float(w[2 * i + 1] & 0xffff0000u) * rs * gq.w; }
            const v16f_t lo16 = {f[0], f[1], f[2], f[3], f[4], f[5], f[6], f[7], f[8], f[9], f[10], f[11], f[12], f[13], f[14], f[15]},
                         hi16 = {f[16], f[17], f[18], f[19], f[20], f[21], f[22], f[23], f[24], f[25], f[26], f[27], f[28], f[29], f[30], f[31]};
            v6u_t p6; asm volatile("s_nop 1\n\tv_cvt_scalef32_2xpk16_fp6_f32 %0, %1, %2, 1.0" : "=&v"(p6) : "v"(lo16), "v"(hi16));
            LAS v2u* dst = (LAS v2u*)(ring + k * 768 + 24 * (lane & 31)); dst[0] = (v2u){p6[0], p6[1]}; dst[1] = (v2u){p6[2], p6[3]}; dst[2] = (v2u){p6[4], p6[5]}; }
        LDS_WAIT(); asm volatile("" ::: "memory");
        TokB X;
#pragma unroll
        for (int m = 0; m < 8; ++m) { const LAS v2u* xp = (const LAS v2u*)(ring + (lane & 7) * 768 + m * 96 + (lane >> 4) * 24);
            const v2u d0 = xp[0], d1 = xp[1], d2 = xp[2];
            X.b[m] = (v8i_t){(int)d0.x, (int)d0.y, (int)d1.x, (int)d1.y, (int)d2.x, (int)d2.y, 0, 0}; }
        LDS_WAIT(); asm volatile("" ::: "memory");
        int n = 0;
        for (int part = 0; part < 8; ++part) {
#pragma unroll
            for (int k = 0; k < 8; ++k) {
                { const bool sel = (id0[k] >> 11) == part; const unsigned long long m = __ballot(sel);
                  const int pos = n + (int)__builtin_amdgcn_mbcnt_hi((unsigned)(m >> 32), __builtin_amdgcn_mbcnt_lo((unsigned)m, 0u));
                  if (sel) list[pos] = ((unsigned)k << 21) | ((unsigned)lane << 14) | (unsigned)id0[k]; n += __builtin_popcountll(m); }
                { const bool sel = (id1[k] >> 11) == part; const unsigned long long m = __ballot(sel);
                  const int pos = n + (int)__builtin_amdgcn_mbcnt_hi((unsigned)(m >> 32), __builtin_amdgcn_mbcnt_lo((unsigned)m, 0u));
                  if (sel) list[pos] = ((unsigned)k << 21) | ((unsigned)(64 + lane) << 14) | (unsigned)id1[k]; n += __builtin_popcountll(m); }
                if (n > PA_CAP - 128) { pa_flush(n, X, lane, list, gl, ring, U6, wpk, tb, nwg); n = 0; }
            }
        }
        pa_flush(n, X, lane, list, gl, ring, U6, wpk, tb, nwg);
    }
}
template <int NT> __device__ __forceinline__ void final_tokens(const int (&t)[NT], int lane, const unsigned short* Y16, const bf16* X1b, float* OUT, const float* fg) {
    v4u xa[NT], xb[NT], ya[NT], yb[NT];
#pragma unroll
    for (int n = 0; n < NT; ++n) { xa[n] = *(const GAS v4u*)(X1b + (size_t)t[n] * 1024 + 8 * lane); xb[n] = *(const GAS v4u*)(X1b + (size_t)t[n] * 1024 + 512 + 8 * lane);
        ya[n] = *(const GAS v4u*)(Y16 + (size_t)t[n] * 1024 + 8 * lane); yb[n] = *(const GAS v4u*)(Y16 + (size_t)t[n] * 1024 + 512 + 8 * lane); }
    const GAS f32x4* gp = (const GAS f32x4*)(fg + 8 * lane); const f32x4 g0 = gp[0], g1 = gp[1], g2 = gp[128], g3 = gp[129];
#pragma unroll
    for (int n = 0; n < NT; ++n) {
        const unsigned yw[8] = {ya[n].x, ya[n].y, ya[n].z, ya[n].w, yb[n].x, yb[n].y, yb[n].z, yb[n].w};
        float y[16];
#pragma unroll
        for (int i = 0; i < 8; ++i) { const unsigned w = yw[i]; const h2_t h = __builtin_bit_cast(h2_t, w); y[2 * i] = (float)h[0]; y[2 * i + 1] = (float)h[1]; }
        const unsigned xw[8] = {xa[n].x, xa[n].y, xa[n].z, xa[n].w, xb[n].x, xb[n].y, xb[n].z, xb[n].w};
        float xv[16];
#pragma unroll
        for (int i = 0; i < 8; ++i) { xv[2 * i] = __uint_as_float(xw[i] << 16); xv[2 * i + 1] = __uint_as_float(xw[i] & 0xffff0000u); }
        const f32x4 a0 = (f32x4){xv[0] + y[0], xv[1] + y[1], xv[2] + y[2], xv[3] + y[3]}, a1 = (f32x4){xv[4] + y[4], xv[5] + y[5], xv[6] + y[6], xv[7] + y[7]},
                    a2 = (f32x4){xv[8] + y[8], xv[9] + y[9], xv[10] + y[10], xv[11] + y[11]}, a3 = (f32x4){xv[12] + y[12], xv[13] + y[13], xv[14] + y[14], xv[15] + y[15]};
        const float ss = (a0.x * a0.x + a0.y * a0.y) + (a0.z * a0.z + a0.w * a0.w) + (a1.x * a1.x + a1.y * a1.y) + (a1.z * a1.z + a1.w * a1.w)
                       + (a2.x * a2.x + a2.y * a2.y) + (a2.z * a2.z + a2.w * a2.w) + (a3.x * a3.x + a3.y * a3.y) + (a3.z * a3.z + a3.w * a3.w);
        const float rstd2 = 1.0f / sqrtf(wave_sum(ss) * (1.f / DMODEL) + RMS_EPS);
        GAS f32x4* xo = (GAS f32x4*)(OUT + (size_t)t[n] * 1024 + 8 * lane);
        xo[0] = a0 * rstd2 * g0; xo[1] = a1 * rstd2 * g1; xo[128] = a2 * rstd2 * g2; xo[129] = a3 * rstd2 * g3; }
}
#ifndef REP_0
#define REP_0 1
#endif
#ifndef REP_1
#define REP_1 1
#endif
#ifndef REP_2
#define REP_2 1
#endif
#ifndef REP_3
#define REP_3 1
#endif
#ifndef REP_4
#define REP_4 1
#endif
#ifndef REP_5
#define REP_5 1
#endif
#ifndef REP_6
#define REP_6 1
#endif
#ifndef REP_7
#define REP_7 1
#endif
#ifndef REP_8
#define REP_8 1
#endif
#ifndef REP_9
#define REP_9 1
#endif
#ifndef REP_10
#define REP_10 1
#endif
#ifndef REP_11
#define REP_11 1
#endif
__device__ __forceinline__ void pb_rows(v4u* Ra, v2u* Rb, const v4u w, const unsigned char* vbase, size_t vboff) {
    const unsigned pw[4] = {w.x, w.y, w.z, w.w};
#pragma unroll
    for (int i = 0; i < 4; ++i) { const size_t e = pw[i] & 0xffffu; Ra[i] = *(const GAS v4u*)(vbase + e * 256); Rb[i] = *(const GAS v2u*)(vbase + vboff + e * 128); }
}
__device__ __forceinline__ void pb_fma(h2_t (&acc)[16], const v4u* Ra, const v2u* Rb, const v4u w) {
    const unsigned pw[4] = {w.x, w.y, w.z, w.w};
#pragma unroll
    for (int i = 0; i < 4; ++i) { const unsigned p = pw[i]; const h2_t pp = __builtin_bit_cast(h2_t, p); const _Float16 wv = pp[1]; const h2_t w2 = {wv, wv};
        const v4u ra = Ra[i]; const v2u rb = Rb[i]; const v6u_t x6 = {ra.x, ra.y, ra.z, ra.w, rb.x, rb.y};
        v32h_t h; asm("v_cvt_scalef32_pk32_f16_fp6 %0, %1, 1.0" : "=&v"(h) : "v"(x6));
#pragma unroll
        for (int j = 0; j < 16; ++j) { const h2_t hv = {h[2 * j], h[2 * j + 1]}; acc[j] = __builtin_elementwise_fma(hv, w2, acc[j]); } }
}
__device__ __forceinline__ void peer_b_phase(int lane, int wave, int G, int vcu, const unsigned char* V6s, const unsigned* wpk, unsigned short* Y16, const bf16* X1b, float* OUT, const float* fg, bool fin) {
    const int q = lane & 15;
    for (int tile0 = vcu; tile0 < MTOK / 32; tile0 += 2 * G) {
        const int tile1 = tile0 + G; const bool has1 = tile1 < MTOK / 32;
        const int tb = tile0 * 32 + wave * 4, nwg = (has1 ? tile1 : tile0) * 32 + wave * 4;
        for (int pass = 0; pass < 4; ++pass) { const int hc = pass >> 1, k = (lane >> 4) + 4 * (pass & 1);
            const int t = pa_tok((unsigned)k, tb, nwg);
            const unsigned* wrow = wpk + (size_t)t * 128;
            const unsigned char* vbase = V6s + (size_t)hc * NEXP * 256 + q * 16;
            const size_t vboff = V6B_OFF + (size_t)hc * NEXP * 128 + q * 8 - ((size_t)hc * NEXP * 256 + q * 16);
            h2_t acc[16];
#pragma unroll
            for (int j = 0; j < 16; ++j) acc[j] = (h2_t){(_Float16)0.f, (_Float16)0.f};
            v4u W[6], Ra[16]; v2u Rb[16];
#pragma unroll
            for (int u = 0; u < 6; ++u) W[u] = *(const GAS v4u*)(wrow + 4 * u);
#pragma unroll
            for (int u = 0; u < 4; ++u) pb_rows(Ra + 4 * u, Rb + 4 * u, W[u], vbase, vboff);
#pragma unroll
            for (int u = 0; u < 32; ++u) {
                pb_fma(acc, Ra + 4 * (u & 3), Rb + 4 * (u & 3), W[u % 6]);
                if (u + 4 < 32) pb_rows(Ra + 4 * (u & 3), Rb + 4 * (u & 3), W[(u + 4) % 6], vbase, vboff);
                if (u + 6 < 32) W[u % 6] = *(const GAS v4u*)(wrow + 4 * (u + 6));
            }
            GAS v4u* yout = (GAS v4u*)(Y16 + (size_t)t * 1024 + hc * 512 + q * 32);
#pragma unroll
            for (int j = 0; j < 4; ++j) yout[j] = (v4u){__builtin_bit_cast(unsigned, acc[4 * j]), __builtin_bit_cast(unsigned, acc[4 * j + 1]), __builtin_bit_cast(unsigned, acc[4 * j + 2]), __builtin_bit_cast(unsigned, acc[4 * j + 3])};
        }
        asm volatile("s_waitcnt vmcnt(0)" ::: "memory");
        if (fin) { const int ta[4] = {tb, tb + 1, tb + 2, tb + 3}; final_tokens<4>(ta, lane, Y16, X1b, OUT, fg);
            if (has1) { const int tc[4] = {nwg, nwg + 1, nwg + 2, nwg + 3}; final_tokens<4>(tc, lane, Y16, X1b, OUT, fg); } }
    }
}
template <int NR> __device__ __forceinline__ void cvt_load(f32x4 (&q)[NR / 2][8], const float* table, int ex, int stride, int lane) {
#pragma unroll
    for (int k = 0; k < NR / 2; ++k) { const int e = ex + (2 * k + (lane >> 5)) * stride; const float* src = table + (size_t)(e < NEXP ? e : ex) * 1024 + 32 * (lane & 31);
#pragma unroll
        for (int j = 0; j < 8; ++j) q[k][j] = *(const GAS f32x4*)(src + 4 * j); }
}
template <int NR> __device__ __forceinline__ void cvt_store(const f32x4 (&q)[NR / 2][8], int ex, int stride, bool isv, int lane, unsigned char* U8, unsigned char* V8) {
    typedef float v16f_t __attribute__((ext_vector_type(16)));
#pragma unroll
    for (int k = 0; k < NR / 2; ++k) { const int e = ex + (2 * k + (lane >> 5)) * stride; if (e < NEXP) {
        if (!isv) {
            float f[32];
#pragma unroll
            for (int j = 0; j < 8; ++j) { const f32x4 t = q[k][j] * U8_SCALE; f[4 * j] = t.x; f[4 * j + 1] = t.y; f[4 * j + 2] = t.z; f[4 * j + 3] = t.w; }
            const v16f_t lo16 = {f[0], f[1], f[2], f[3], f[4], f[5], f[6], f[7], f[8], f[9], f[10], f[11], f[12], f[13], f[14], f[15]},
                         hi16 = {f[16], f[17], f[18], f[19], f[20], f[21], f[22], f[23], f[24], f[25], f[26], f[27], f[28], f[29], f[30], f[31]};
            v6u_t p6; asm volatile("s_nop 1\n\tv_cvt_scalef32_2xpk16_fp6_f32 %0, %1, %2, 1.0" : "=&v"(p6) : "v"(lo16), "v"(hi16));
            GAS v2u* dst = (GAS v2u*)(U8 + (size_t)e * 768 + 24 * (lane & 31)); dst[0] = (v2u){p6[0], p6[1]}; dst[1] = (v2u){p6[2], p6[3]}; dst[2] = (v2u){p6[4], p6[5]};
        } else {
            v32h_t h;
#pragma unroll
            for (int j = 0; j < 8; ++j) { const f32x4 t = q[k][j] * V8_SCALE; h[4 * j] = (_Float16)t.x; h[4 * j + 1] = (_Float16)t.y; h[4 * j + 2] = (_Float16)t.z; h[4 * j + 3] = (_Float16)t.w; }
            v6u_t p6; asm volatile("s_nop 1\n\tv_cvt_scalef32_pk32_fp6_f16 %0, %1, 1.0" : "=&v"(p6) : "v"(h));
            const size_t ro = (size_t)((lane & 31) >> 4) * NEXP + e;
            *(GAS v4u*)(V8 + ro * 256 + (lane & 15) * 16) = (v4u){p6[0], p6[1], p6[2], p6[3]}; *(GAS v2u*)(V8 + V6B_OFF + ro * 128 + (lane & 15) * 8) = (v2u){p6[4], p6[5]}; } } }
}
struct OnePanel { int pm, n; __device__ __forceinline__ bool next(int i, pg8::Unit& u) const { if (i >= n) return false; u.pm = pm; u.pn = i; u.w = 0; return true; } };
struct DualOrder { pg8::StaticOrder S; __device__ __forceinline__ bool next(int i, pg8::Unit& u) const { if (!S.next(i >> 1, u)) return false; u.w = i & 1; return true; } };
struct Args { const float* in[24]; float* out; unsigned char* ws; int ph_lo, ph_hi, li, pad; };
__global__ void __launch_bounds__(NWAVES * 64, 2) mk_fwd(Args args) {
    extern __shared__ __attribute__((aligned(16))) unsigned char lds[];
    Frame F;
    F.lds = (LAS unsigned char*)lds;
    volatile LAS unsigned* MISC = (volatile LAS unsigned*)(F.lds + MISC_OFF);
    F.tid = threadIdx.x; F.lane = F.tid & 63; F.wave = __builtin_amdgcn_readfirstlane(F.tid >> 6);
    F.G = gridDim.x; { const int bx = blockIdx.x; F.vcu = (F.G % 8 == 0) ? (bx % 8) * (F.G / 8) + bx / 8 : bx; }
    unsigned char* ws = args.ws;
    gu32* ctl = (gu32*)(ws + WS_CTL);
    for (int u = F.tid; u < (LDS_BYTES - LDSCTL_OFF) / 4; u += NWAVES * 64) ((LAS unsigned*)(F.lds + LDSCTL_OFF))[u] = 0u;
    __syncthreads();
    XcdBarrier bar; bar.bar = (unsigned*)(ctl + CW_BAR); bar.x = 0; bar.st = nullptr;
    if (N_LAUNCHES != PER_PHASE) bar = xcd_barrier_post((unsigned*)(ctl + CW_BAR), MISC + 8);
#define GRID_BAR() do { if (N_LAUNCHES != PER_PHASE) xcd_barrier(bar); } while (0)
    const int lo = args.ph_lo, hi = args.ph_hi;
#ifndef PH_MASK
#define PH_MASK 0xFFFF
#endif
#define IN(k) ((((PH_MASK) >> (k)) & 1) && lo <= (k) && (k) < hi)
#define BOTH(k) (IN(k) && IN((k) + 1))
    const int gw = F.vcu * NWAVES + F.wave, NGW = F.G * NWAVES;
    const int gtid = F.vcu * (NWAVES * 64) + F.tid, NTHR = F.G * NWAVES * 64;
    const float* x = args.in[0];
    bf16* Win_t = (bf16*)(ws + WS_WIN); bf16* Wq_t = (bf16*)(ws + WS_WQ); bf16* Wout_t = (bf16*)(ws + WS_WOUT); bf16* Wus_t = (bf16*)(ws + WS_WUS); bf16* Wua_t = (bf16*)(ws + WS_WUA);
    bf16* Wglu_t = (bf16*)(ws + WS_WGLU); bf16* KSb = (bf16*)(ws + WS_KS); bf16* WE = (bf16*)(ws + WS_WE); bf16* BP = (bf16*)(ws + WS_BP); bf16* AP = (bf16*)(ws + WS_AP);
    float* Eb = (float*)(ws + WS_E); bf16* Hb = (bf16*)(ws + WS_H); bf16* Ypre = (bf16*)(ws + WS_YPRE); bf16* Ya = (bf16*)(ws + WS_YA); bf16* XG = (bf16*)(ws + WS_XG);
    bf16* Zb = (bf16*)(ws + WS_Z); bf16* Qb = (bf16*)(ws + WS_Z + 1 * ZSTRIDE_B); bf16* Kb = (bf16*)(ws + WS_Z + 2 * ZSTRIDE_B); bf16* Vb = (bf16*)(ws + WS_Z + 3 * ZSTRIDE_B);
    bf16* GA = (bf16*)(ws + WS_Z + 4 * ZSTRIDE_B); bf16* GB = (bf16*)(ws + WS_Z + 6 * ZSTRIDE_B);
    bf16* Yb = (bf16*)(ws + WS_YB); bf16* Mrg = (bf16*)(ws + WS_MRG); bf16* PQb = (bf16*)(ws + WS_PQ); int* ids = (int*)(ws + WS_IDS); float* gts = (float*)(ws + WS_GTS);
    unsigned char* U8 = ws + WS_U16; unsigned char* V8 = ws + WS_V16; unsigned* wpk = (unsigned*)(ws + WS_WPK); float* rstd1 = (float*)(ws + WS_RSTD1); unsigned short* Y16 = (unsigned short*)(ws + WS_Y16);
    float* biasT = (float*)(ws + WS_BIAS); float* pw32 = (float*)(ws + WS_PW32); float* kpart = (float*)(ws + WS_KPART); float* Kg = (float*)(ws + WS_KG); float* ssq1 = (float*)(ws + WS_SSQ1);

    if (IN(0)) for (int rep_ = 0; rep_ < REP_0; ++rep_) {
        LAS float* scr = (LAS float*)(F.lds + RING_OFF + F.wave * 16384);
        constexpr int I_IN = (1024 / 64) * (4096 / 32), I_GLU = (512 / 64) * (512 / 32), I_UP = (512 / 64) * (1024 / 32), I_OUT = (1024 / 64) * (1024 / 32), I_Q = (1024 / 64) * (2048 / 32);
        constexpr int NITEMS = I_IN + I_GLU + 2 * I_UP + I_OUT + I_Q;
        for (int it = gw; it < NITEMS; it += NGW) {
            int r = it;
            if (r < I_IN) { p0_transpose_item(args.in[2], 1024, 4096, Win_t, scr, r, F.lane); continue; } r -= I_IN;
            if (r < I_GLU) { p0_transpose_item(args.in[11], 512, 512, Wglu_t, scr, r, F.lane); continue; } r -= I_GLU;
            if (r < I_UP) { p0_transpose_item(args.in[13], 512, 1024, Wus_t, scr, r, F.lane); continue; } r -= I_UP;
            if (r < I_UP) { p0_transpose_item(args.in[14], 512, 1024, Wua_t, scr, r, F.lane); continue; } r -= I_UP;
            if (r < I_OUT) { p0_transpose_item(args.in[16], 1024, 1024, Wout_t, scr, r, F.lane); continue; } r -= I_OUT;
            p0_transpose_item(args.in[18], 1024, 2048, Wq_t, scr, r, F.lane, args.in[17]);
        }
        for (int it = gw; it < NGRP * CH; it += NGW)
            ssm_table_task(it >> 5, it & 31, F.lane, scr, args.in[3], args.in[4], args.in[5], args.in[6], args.in[7], args.in[8], args.in[9], Kg, WE, BP, pw32);
        for (int m = gw; m < MTOK; m += NGW * 4) rms_rows4_to_bf16(x, args.in[1], Hb, m, NGW, F.lane);
        for (int it = gw; it < 64; it += NGW) { const float* src = (it < 32 ? args.in[19] : args.in[20]) + (size_t)(it & 31) * 512 + 8 * F.lane;
            const f32x4 a = *(const GAS f32x4*)src, b = *(const GAS f32x4*)(src + 4);
            *(GAS v4u*)(KSb + (size_t)it * 512 + 8 * F.lane) = (v4u){pk2(a.x, a.y), pk2(a.z, a.w), pk2(b.x, b.y), pk2(b.z, b.w)}; }
        if (gw == 0) { for (int i = F.lane; i < 8 * 128; i += 64) { const int h = i >> 7, rel = i & 127; int bk;
                if (rel < 16) bk = rel; else { const float lg = logf((float)rel / 16.0f) / 2.0794415416798357f * 16.0f; bk = 16 + (int)lg; bk = bk < 0 ? 0 : (bk > 31 ? 31 : bk); }
                biasT[i] = (args.in[15][bk * 8 + h] - args.in[15][31 * 8 + h]) * 1.4426950408889634f; } }
        if (BOTH(0)) GRID_BAR();
    }

    if (IN(1)) for (int rep_ = 0; rep_ < REP_1; ++rep_) {
        const float* Dsk = args.in[10];
        for (int i0 = gtid; i0 < NGRP * 512 * 64; i0 += NTHR * 4) {
            f32x4 ka[4], kb[4];
#pragma unroll
            for (int q = 0; q < 4; ++q) { const int i = i0 + q * NTHR; const int ic = (i < NGRP * 512 * 64) ? i : i0; const int g = ic >> 15, m = (ic >> 6) & 511, k8 = ic & 63, j = m >> 4, ho = m & 15, jp = k8 >> 1, hi0 = (k8 & 1) * 8;
                const int lag = (jp <= j) ? j - jp : 0; const float* kp = Kg + ((size_t)(g * 32 + lag) * 256 + ho * 16 + hi0); ka[q] = *(const GAS f32x4*)kp; kb[q] = *(const GAS f32x4*)(kp + 4); }
#pragma unroll
            for (int q = 0; q < 4; ++q) { const int i = i0 + q * NTHR; if (i >= NGRP * 512 * 64) break; const int g = i >> 15, m = (i >> 6) & 511, k8 = i & 63, j = m >> 4, ho = m & 15, jp = k8 >> 1, hi0 = (k8 & 1) * 8;
                v4u o = (v4u){0u, 0u, 0u, 0u};
                if (jp <= j) { f32x4 a = ka[q], b = kb[q];
                    if (jp == j && (ho >> 3) == (hi0 >> 3)) { const float dv = Dsk[g * 16 + ho]; const int e = ho & 7;
                        a.x += (e == 0) ? dv : 0.f; a.y += (e == 1) ? dv : 0.f; a.z += (e == 2) ? dv : 0.f; a.w += (e == 3) ? dv : 0.f;
                        b.x += (e == 4) ? dv : 0.f; b.y += (e == 5) ? dv : 0.f; b.z += (e == 6) ? dv : 0.f; b.w += (e == 7) ? dv : 0.f; }
                    o = (v4u){pk2(a.x, a.y), pk2(a.z, a.w), pk2(b.x, b.y), pk2(b.z, b.w)}; }
                *(GAS v4u*)(BP + ((size_t)(g * 512 + m) * APK + k8 * 8)) = o; } }
        pg8::Gemm g{Hb, Win_t, MTOK, INCOLS, 1024, 1024, 1024, 1 << 30, 0};
        pg8::StaticOrder S; S.init(MTOK, INCOLS, F.G, (int)blockIdx.x);
        pg8::EpiIn E{Zb, AP, kpart};
        pg8::gemm_phase<pg8::EpiIn, pg8::StaticOrder, true>(F.lds + RING_OFF, g, S, E);
        if (BOTH(1)) GRID_BAR();
    }

    if (IN(2)) for (int rep_ = 0; rep_ < REP_2; ++rep_) {
        const int bx = (int)blockIdx.x;
        const bool shared = F.G < 4;
        const int nS = shared ? F.G : (F.G >= 256 ? 64 : F.G / 4), nA = shared ? F.G : F.G - nS;
        const bool inS = shared || bx < nS, inA = shared || bx >= nS; const int aidx = shared ? bx : bx - nS;
        if (inS) {
#pragma unroll 1
            for (int pm = bx; pm < MTOK / 256; pm += nS) {
                { pg8::Gemm g1{AP, WE, MTOK, 256, 512, APK, 512, 2, (size_t)256 * 512}; OnePanel S1{pm, 1}; pg8::EpiE E1{Eb};
                  pg8::gemm_phase<pg8::EpiE, OnePanel, true>(F.lds + RING_OFF, g1, S1, E1); }
                VM_WAIT(); __syncthreads();
                if (F.tid < 256) { const int gb = (pm >> 1) * 8 + (pm & 1) * 4 + (F.tid >> 6), g_ = gb >> 3, p = F.tid & 63; const size_t row0 = (size_t)gb * 64;
                    const float mr = pw32[g_ * 128 + p], mi = pw32[g_ * 128 + 64 + p]; float sr = 0.f, si = 0.f;
#pragma unroll 1
                    for (int c0 = 0; c0 < NCHUNK; c0 += 32) { float er[32], ei[32];
#pragma unroll
                        for (int c = 0; c < 32; ++c) { er[c] = Eb[(row0 + c0 + c) * 128 + p]; ei[c] = Eb[(row0 + c0 + c) * 128 + 64 + p]; }
#pragma unroll
                        for (int c = 0; c < 32; ++c) { bf16* ap = AP + (row0 + c0 + c) * APK + 512; ap[p] = (bf16)f2bf(sr); ap[64 + p] = (bf16)f2bf(si);
                            const float nr = mr * sr - mi * si + er[c], ni = mr * si + mi * sr + ei[c]; sr = nr; si = ni; } } }
                VM_WAIT(); __syncthreads();
                { pg8::Gemm g{AP, BP, MTOK, 512, APK, APK, APK, 2, (size_t)512 * APK}; OnePanel S3{pm, 2}; pg8::EpiY E{Ypre};
                  pg8::gemm_phase<pg8::EpiY, OnePanel, true>(F.lds + RING_OFF, g, S3, E); }
            }
        }
        if (inA) {
            static_assert(attn_body::ATTN_LDS_BYTES <= RING_BYTES, "attention LDS");
#pragma unroll 1
            for (int a = aidx; a < 192; a += nA) { const int ty = a >> 6, bh = a & 63;
#pragma unroll 1
                for (int i = 0; i < 4; ++i) { const int qb = (ty == 0) ? (i == 0 ? 7 : (i == 1 ? 2 : (i == 2 ? 0 : -1))) : (ty == 1) ? (i == 0 ? 6 : (i == 1 ? 4 : -1)) : (i == 0 ? 5 : (i == 1 ? 3 : (i == 2 ? 1 : -1)));
                    if (qb < 0) break;
                    attn_body::attn_unit<8>(bh >> 3, bh & 7, qb, (const attn_body::bf16*)Qb, (const attn_body::bf16*)Kb, (const attn_body::bf16*)Vb, (attn_body::bf16*)Yb, (char*)lds + RING_OFF, kpart, biasT); } }
        }
        if (BOTH(2)) GRID_BAR();
    }

    if (IN(3)) for (int rep_ = 0; rep_ < REP_3; ++rep_) {
        pg8::Gemm g{Ypre, Wglu_t, MTOK, 512, 512, 512, 512, 1 << 30, 0};
        pg8::StaticOrder S; S.init(MTOK, 512, F.G, (int)blockIdx.x);
        pg8::EpiGlu E{Ypre, Ya, args.in[12]};
        pg8::gemm_phase<pg8::EpiGlu, pg8::StaticOrder, true>(F.lds + RING_OFF, g, S, E);
        { const int nun = (MTOK / 256) * (512 / 256);
          const bool split = F.G >= 2 * nun; const int nconv = split ? nun : F.G, cidx = split ? ((int)blockIdx.x % nun) : (int)blockIdx.x;
          const int stride = nconv * NWAVES, step = stride * 4, ex0 = cidx * NWAVES + F.wave;
          const int ncall = (NEXP - ex0 + step - 1) / step;
          int c_lo = 0, c_hi = 2 * ncall;
          if (split) { const int cut = (2 * ncall * 3) / 4; if ((int)blockIdx.x < nun) c_lo = cut; else if ((int)blockIdx.x < 2 * nun) c_hi = cut; else c_hi = 0; }
          f32x4 qa[2][8], qb[2][8];
#define CV_TAB(c) ((c) < ncall ? args.in[21] : args.in[22])
#define CV_EX(c) (ex0 + ((c) < ncall ? (c) : (c) - ncall) * step)
          if (c_lo < c_hi) cvt_load<4>(qa, CV_TAB(c_lo), CV_EX(c_lo), stride, F.lane);
          for (int c = c_lo; c < c_hi; c += 2) {
              if (c + 1 < c_hi) cvt_load<4>(qb, CV_TAB(c + 1), CV_EX(c + 1), stride, F.lane);
              cvt_store<4>(qa, CV_EX(c), stride, c >= ncall, F.lane, U8, V8);
              if (c + 2 < c_hi) cvt_load<4>(qa, CV_TAB(c + 2), CV_EX(c + 2), stride, F.lane);
              if (c + 1 < c_hi) cvt_store<4>(qb, CV_EX(c + 1), stride, c + 1 >= ncall, F.lane, U8, V8);
          } }
#undef CV_TAB
#undef CV_EX
        if (BOTH(3)) GRID_BAR();
    }

    if (IN(4)) for (int rep_ = 0; rep_ < REP_4; ++rep_) {
        pg8::Gemm g{Ya, Wus_t, MTOK, 1024, 512, 512, 512, 1 << 30, 0, Yb, Wua_t};
        DualOrder S; S.S.init(MTOK, 1024, F.G, (int)blockIdx.x);
        pg8::EpiMrgDual E{pg8::EpiMrg<0>{GA, Mrg}, pg8::EpiMrg<1>{GB, Mrg}};
        pg8::gemm_phase<pg8::EpiMrgDual, DualOrder, true>(F.lds + RING_OFF, g, S, E);
        if (BOTH(4)) GRID_BAR();
    }

    if (IN(5)) for (int rep_ = 0; rep_ < REP_5; ++rep_) {
        pg8::Gemm g{Mrg, Wout_t, MTOK, 1024, 1024, 1024, 1024, 1 << 30, 0}; pg8::StaticOrder S; S.init(MTOK, 1024, F.G, (int)blockIdx.x);
        pg8::EpiX1 E{x, args.out, XG, args.in[17], ssq1};
        pg8::gemm_phase<pg8::EpiX1, pg8::StaticOrder, true>(F.lds + RING_OFF, g, S, E);
        if (BOTH(5)) GRID_BAR();
    }

    if (IN(6)) for (int rep_ = 0; rep_ < REP_6; ++rep_) {
        pg8::Gemm g{XG, Wq_t, MTOK, PQ, 1024, 1024, 1024, 1 << 30, 0}; pg8::StaticOrder S; S.init(MTOK, PQ, F.G, (int)blockIdx.x);
        pg8::EpiPlain E{PQb, PQ};
        pg8::gemm_phase<pg8::EpiPlain, pg8::StaticOrder, true>(F.lds + RING_OFF, g, S, E);
        if (BOTH(6)) GRID_BAR();
    }

    if (IN(7)) for (int rep_ = 0; rep_ < REP_7; ++rep_) {
        LAS unsigned char* scr = F.lds + RING_OFF + F.wave * 2048;
        LAS unsigned char* ksl = F.lds + RING_OFF + 16384;
        for (int c = F.tid; c < 256 * 16; c += NWAVES * 64) { const int row = c >> 4, ch = c & 15; *(LAS v4u*)(ksl + row * 256 + ((ch ^ (row & 15)) << 4)) = *(const GAS v4u*)(KSb + row * 128 + ch * 8); }
        __syncthreads();
        for (int it = gw; it < (MTOK / 32) * 8; it += NGW) topk_task(it >> 3, it & 7, F.lane, scr, PQb, ksl, ssq1, ids, gts, rstd1);
        if (BOTH(7)) { VM_WAIT(); __syncthreads(); }
    }

    if (IN(8)) for (int rep_ = 0; rep_ < REP_8; ++rep_) {
        peer_a_phase(F.lane, F.wave, F.G, F.vcu, XG, U8, ids, gts, rstd1, wpk, F.lds, args.in[17]);
        if (BOTH(8)) VM_WAIT();
    }
    if (IN(9)) for (int rep_ = 0; rep_ < REP_9; ++rep_) {
        peer_b_phase(F.lane, F.wave, F.G, F.vcu, V8, wpk, Y16, XG, args.out, args.in[23], rep_ == REP_9 - 1);
    }
#undef IN
#undef BOTH
#undef GRID_BAR
}

extern "C" void kernel_launch(void* const* d_in, const int* in_sizes, int n_in, void* d_out, int out_size, void* d_ws, size_t ws_size, hipStream_t stream) {
    static int grid = 0;
    if (grid == 0) {
        if (n_in != 24 || in_sizes[0] != MTOK * DMODEL || out_size != MTOK * DMODEL || ws_size < WS_END) { fprintf(stderr, "kernel_launch: unexpected shapes (n_in %d, in0 %d, out %d, ws %zu); nothing launched\n", n_in, n_in > 0 ? in_sizes[0] : -1, out_size, ws_size); grid = -1; return; }
        int dev = 0, cus = 0, per_cu = 0;
        if (hipGetDevice(&dev) != hipSuccess || hipDeviceGetAttribute(&cus, hipDeviceAttributeMultiprocessorCount, dev) != hipSuccess) { grid = -1; return; }
        if (hipFuncSetAttribute((const void*)mk_fwd, hipFuncAttributeMaxDynamicSharedMemorySize, LDS_BYTES) != hipSuccess) { fprintf(stderr, "kernel_launch: hipFuncSetAttribute failed\n"); grid = -1; return; }
        if (hipOccupancyMaxActiveBlocksPerMultiprocessor(&per_cu, (const void*)mk_fwd, NWAVES * 64, LDS_BYTES) != hipSuccess || per_cu < 1) { fprintf(stderr, "kernel_launch: occupancy query says %d blocks per CU\n", per_cu); }
        (void)hipGetLastError();
        grid = cus;
    }
    if (grid < 0) return;
    if (N_LAUNCHES != PER_PHASE) { if (hipMemsetAsync((char*)d_ws + WS_CTL, 0, CTL_ZERO_BYTES, stream) != hipSuccess) return; }
    Args a{};
    for (int i = 0; i < 24; ++i) a.in[i] = (const float*)d_in[i];
    a.out = (float*)d_out; a.ws = (unsigned char*)d_ws; a.pad = 0;
    if (N_LAUNCHES == PER_PHASE) {
        for (int li = 0; li < PER_PHASE; ++li) { a.ph_lo = li; a.ph_hi = li + 1; a.li = li; hipLaunchKernelGGL(mk_fwd, dim3(grid), dim3(NWAVES * 64), LDS_BYTES, stream, a); }
    } else {
        a.ph_lo = 0; a.ph_hi = PER_PHASE; a.li = 0;
        hipLaunchKernelGGL(mk_fwd, dim3(grid), dim3(NWAVES * 64), LDS_BYTES, stream, a);
    }
}
```

```cpp
#include <hip/hip_runtime.h>
#include <hip/hip_bf16.h>
#include <cstdio>
#include <cstdint>
#include <cmath>

#ifndef MK_N_LAUNCHES
#define MK_N_LAUNCHES 1
#endif

namespace pg8 {
#define PG8_LAS __attribute__((address_space(3)))
typedef unsigned short bf16_t;
typedef short bf16x8 __attribute__((ext_vector_type(8)));
typedef float f32x4 __attribute__((ext_vector_type(4)));
typedef unsigned u32x4 __attribute__((ext_vector_type(4)));
constexpr int BM = 256, BK = 64, HALF = 128, HTB = HALF * BK * 2, STAGE_BYTES = 8 * HTB, NXCD = 8, WGM = 8;

__host__ __device__ __forceinline__ int lds_byte(int r, int c) { const int st = (r >> 4) * 2 + (c >> 5), rr = r & 15, cc = c & 31, ob = rr * 64 + cc * 2; return st * 1024 + (ob ^ (((ob >> 9) & 1) << 5)); }
__host__ __device__ __forceinline__ void stage_rc(int b, int& R, int& C) { const int st = b / 1024, sb = b % 1024, swz = sb ^ (((sb >> 9) & 1) << 5); R = (st >> 1) * 16 + swz / 64; C = (st & 1) * 32 + (swz % 64) / 2; }
__host__ __device__ __forceinline__ int perm32(int rho) { const int n = rho >> 4, i = rho & 15; return 8 * (i >> 2) + 4 * n + (i & 3); }

struct Unit { int pm, pn, w; };
struct Gemm { const bf16_t* A; const bf16_t* Bt; int M, N, K, lda, ldb, rpg; size_t bgs; const bf16_t* A2 = nullptr; const bf16_t* Bt2 = nullptr; };

struct StaticOrder {
    int nM, nN, nwg, G, c;
    __host__ __device__ __forceinline__ void init(int M, int N, int G_, int c_) { nM = M / BM; nN = N / BM; nwg = nM * nN; G = G_; c = c_; }
    __host__ __device__ __forceinline__ bool next(int i, Unit& u) const {
        const long L = (long)i * G + c; if (L >= nwg) return false;
        int wgid = (int)L; { const int q = nwg / NXCD, r = nwg % NXCD, xcd = wgid % NXCD, off = wgid / NXCD; wgid = (xcd < r ? xcd * (q + 1) : r * (q + 1) + (xcd - r) * q) + off; }
        const int nig = WGM * nN, gid = wgid / nig, fm = gid * WGM, gsz = (nM - fm) < WGM ? (nM - fm) : WGM;
        u.pm = fm + ((wgid % nig) % gsz); u.pn = (wgid % nig) / gsz; u.w = 0; return true;
    }
};

__device__ __forceinline__ unsigned cvt_pk_bf16(float lo, float hi) { unsigned r; asm volatile("v_cvt_pk_bf16_f32 %0, %1, %2" : "=v"(r) : "v"(lo), "v"(hi)); return r; }
__device__ __forceinline__ float bf_lo(unsigned w) { return __uint_as_float(w << 16); }
__device__ __forceinline__ float bf_hi(unsigned w) { return __uint_as_float(w & 0xffff0000u); }
__device__ __forceinline__ float sigmoid_f(float x) { return __builtin_amdgcn_rcpf(1.0f + __builtin_amdgcn_exp2f(-1.4426950409f * x)); }
__device__ __forceinline__ float gelu_tanh(float x) { const float u = x + 0.044715f * x * x * x; return x * __builtin_amdgcn_rcpf(1.0f + __builtin_amdgcn_exp2f(-2.3022081985f * u)); }

template <class Epi, class Sched, bool ALIGN_EPI>
__device__ __forceinline__ void gemm_phase(PG8_LAS unsigned char* lds, const Gemm g, const Sched& S, const Epi& E) {
    int tid = threadIdx.x; asm volatile("" : "+v"(tid));
    const int wid = __builtin_amdgcn_readfirstlane(tid >> 6), lane = tid & 63, wr = wid >> 2, wc = wid & 3, fr = lane & 15, fq = lane >> 4;
    const int K = g.K, nt = K / BK;
    unsigned voffA[2], voffB[2];
#pragma unroll
    for (int i = 0; i < 2; ++i) { int R, C; stage_rc(tid * 16 + i * 8192, R, C); const int Rb = Epi::PERM ? ((R & ~31) + perm32(R & 31)) : R;
        voffA[i] = (unsigned)(R * g.lda + C) * 2u; voffB[i] = (unsigned)(Rb * g.ldb + C) * 2u; }
    const size_t kstep = (size_t)(BK * 2);
    const size_t hstepA = (size_t)HALF * g.lda * 2, hstepB = (size_t)HALF * g.ldb * 2;
    const size_t tstepA = 2 * hstepA, tstepB = 2 * hstepB;
    const unsigned ldsw = (unsigned)wid * 1024u;
    const int aoff = lds_byte(wr * 64 + fr, fq * 8), boff = lds_byte(wc * 32 + fr, fq * 8);
#define PG8_SA(b, h) (((b) * 2 + (h)) * HTB)
#define PG8_SB(b, h) ((4 + (b) * 2 + (h)) * HTB)
#define PG8_STAGE(bufoff, gbase, voff) do { _Pragma("unroll") for (int _i = 0; _i < 2; ++_i) \
        __builtin_amdgcn_global_load_lds((const unsigned*)((const char*)(gbase) + (voff)[_i]), (PG8_LAS unsigned*)(lds + (bufoff) + ldsw + _i * 8192), 16, 0, 0); } while (0)
#define PG8_LDA(dst, b, h) do { _Pragma("unroll") for (int m = 0; m < 4; ++m) _Pragma("unroll") for (int k = 0; k < 2; ++k) dst[m][k] = *(const PG8_LAS bf16x8*)(lds + PG8_SA(b, h) + aoff + m * 2048 + k * 1024); } while (0)
#define PG8_LDB(dst, b, h) do { _Pragma("unroll") for (int n = 0; n < 2; ++n) _Pragma("unroll") for (int k = 0; k < 2; ++k) dst[n][k] = *(const PG8_LAS bf16x8*)(lds + PG8_SB(b, h) + boff + n * 2048 + k * 1024); } while (0)
#define PG8_MMA(ai, bj, At, Bt) do { __builtin_amdgcn_s_setprio(1); _Pragma("unroll") for (int m = 0; m < 4; ++m) _Pragma("unroll") for (int n = 0; n < 2; ++n) _Pragma("unroll") for (int k = 0; k < 2; ++k) \
        acc[ai][bj][m][n] = __builtin_amdgcn_mfma_f32_16x16x32_bf16(Bt[n][k], At[m][k], acc[ai][bj][m][n], 0, 0, 0); __builtin_amdgcn_s_setprio(0); } while (0)
#define PG8_WAIT_V(n) asm volatile("s_waitcnt vmcnt(" #n ")" ::: "memory")
#define PG8_WAIT_L(n) asm volatile("s_waitcnt lgkmcnt(" #n ")" ::: "memory")
#define PG8_BAR __builtin_amdgcn_s_barrier()
#define PG8_SCHED __builtin_amdgcn_sched_barrier(0)
    Unit cur, nxt; int ui = 0;
    if (!S.next(0, cur)) return;
    f32x4 acc[2][2][4][2];
#pragma unroll
    for (int a = 0; a < 2; ++a)
#pragma unroll
        for (int b = 0; b < 2; ++b)
#pragma unroll
            for (int m = 0; m < 4; ++m)
#pragma unroll
                for (int n = 0; n < 2; ++n) acc[a][b][m][n] = (f32x4){0.f, 0.f, 0.f, 0.f};
    bf16x8 At[4][2], B0[2][2], B1[2][2];
    const char* cA = (const char*)(cur.w ? g.A2 : g.A) + (size_t)cur.pm * tstepA;
    const char* cB = (const char*)(cur.w ? g.Bt2 : g.Bt) + (size_t)(cur.pm / g.rpg) * g.bgs * 2 + (size_t)cur.pn * tstepB;
    PG8_STAGE(PG8_SB(0, 0), cB, voffB); PG8_STAGE(PG8_SB(0, 1), cB + hstepB, voffB); PG8_STAGE(PG8_SA(0, 0), cA, voffA); PG8_STAGE(PG8_SA(0, 1), cA + hstepA, voffA);
    if (wr == 1) PG8_BAR;
    PG8_WAIT_V(2); PG8_BAR;
    PG8_STAGE(PG8_SB(1, 0), cB + kstep, voffB); PG8_STAGE(PG8_SA(1, 0), cA + kstep, voffA); PG8_STAGE(PG8_SB(1, 1), cB + hstepB + kstep, voffB);
    PG8_WAIT_V(6); PG8_BAR;
    for (;;) {
        const bool has_next = S.next(ui + 1, nxt);
        const char* nA = has_next ? (const char*)(nxt.w ? g.A2 : g.A) + (size_t)nxt.pm * tstepA : cA;
        const char* nB = has_next ? (const char*)(nxt.w ? g.Bt2 : g.Bt) + (size_t)(nxt.pm / g.rpg) * g.bgs * 2 + (size_t)nxt.pn * tstepB : cB;
        for (int t = 0; t < nt; t += 2) {
            const bool last = (t == nt - 2);
            const char* a1 = cA + (size_t)(t + 1) * kstep;
            const char* a2 = last ? nA : cA + (size_t)(t + 2) * kstep; const char* b2 = last ? nB : cB + (size_t)(t + 2) * kstep;
            const char* a3 = a2 + kstep; const char* b3 = b2 + kstep;
            PG8_LDB(B0, 0, 0); PG8_LDB(B1, 0, 1); PG8_SCHED; PG8_LDA(At, 0, 0); PG8_STAGE(PG8_SA(1, 1), a1 + hstepA, voffA);
            PG8_WAIT_V(8); PG8_WAIT_L(0); PG8_BAR; PG8_MMA(0, 0, At, B0); PG8_MMA(0, 1, At, B1); PG8_BAR; PG8_SCHED;
            PG8_LDA(At, 0, 1); PG8_STAGE(PG8_SB(0, 0), b2, voffB); PG8_STAGE(PG8_SB(0, 1), b2 + hstepB, voffB); PG8_STAGE(PG8_SA(0, 0), a2, voffA);
            PG8_WAIT_V(8); PG8_WAIT_L(0); PG8_BAR; PG8_MMA(1, 0, At, B0); PG8_MMA(1, 1, At, B1); PG8_BAR; PG8_SCHED;
            PG8_LDB(B0, 1, 0); PG8_LDB(B1, 1, 1); PG8_SCHED; PG8_LDA(At, 1, 0); PG8_STAGE(PG8_SA(0, 1), a2 + hstepA, voffA);
            PG8_WAIT_V(8); PG8_WAIT_L(0); PG8_BAR; PG8_MMA(0, 0, At, B0); PG8_MMA(0, 1, At, B1); PG8_BAR; PG8_SCHED;
            PG8_LDA(At, 1, 1); PG8_STAGE(PG8_SB(1, 0), b3, voffB); PG8_STAGE(PG8_SB(1, 1), b3 + hstepB, voffB); PG8_STAGE(PG8_SA(1, 0), a3, voffA);
            PG8_WAIT_V(8); PG8_WAIT_L(0); PG8_BAR; PG8_MMA(1, 0, At, B0); PG8_MMA(1, 1, At, B1); PG8_BAR; PG8_SCHED;
        }
        if constexpr (ALIGN_EPI) { if (wr == 0) PG8_BAR; }
        bool keep = false;
        if constexpr (Epi::CHAIN) { if (cur.w == 0) { E.mid(acc, cur, wr, wc, fr, fq); keep = true; } else E(acc, cur, wr, wc, fr, fq); } else E(acc, cur, wr, wc, fr, fq);
        if (!has_next) break;
        if (!keep)
#pragma unroll
        for (int a = 0; a < 2; ++a)
#pragma unroll
            for (int b = 0; b < 2; ++b)
#pragma unroll
                for (int m = 0; m < 4; ++m)
#pragma unroll
                    for (int n = 0; n < 2; ++n) acc[a][b][m][n] = (f32x4){0.f, 0.f, 0.f, 0.f};
        cur = nxt; cA = nA; cB = nB; ++ui;
        if constexpr (ALIGN_EPI) { if (wr == 1) PG8_BAR; }
    }
    PG8_WAIT_V(0);
    if constexpr (!ALIGN_EPI) { if (wr == 0) PG8_BAR; }
    PG8_BAR;
#undef PG8_SA
#undef PG8_SB
#undef PG8_STAGE
#undef PG8_LDA
#undef PG8_LDB
#undef PG8_MMA
#undef PG8_WAIT_V
#undef PG8_WAIT_L
#undef PG8_BAR
#undef PG8_SCHED
}
}
namespace attn_body {
using bf16=__hip_bfloat16;
using bf16x8=__attribute__((ext_vector_type(8)))short;
using s16x4=__attribute__((ext_vector_type(4)))short;
using f32x16=__attribute__((ext_vector_type(16)))float;
using f32x4v=__attribute__((ext_vector_type(4)))float;
using u32x4=__attribute__((ext_vector_type(4)))unsigned;
constexpr int BATCH=8,NHEAD=8,SEQ=2048,D=64,DM=NHEAD*D;
constexpr int NW=8,QBLK=32,QB=QBLK*NW,KVBLK=64,NQB=SEQ/QB;
__device__ __forceinline__ int crow(int r,int hi){return (r&3)+8*(r>>2)+4*hi;}
#define SBAR() __builtin_amdgcn_sched_barrier(0)
__device__ __forceinline__ void cmask(f32x16&p0,f32x16&p1,int jb,int qrel,int hi){
  const float NEG=-INFINITY; int kb=64*jb+4*hi;
  #pragma unroll
  for(int r=0;r<16;++r){int kv=kb+(r&3)+8*(r>>2); if(kv>qrel)p0[r]=NEG; if(kv+32>qrel)p1[r]=NEG;}
}
typedef __attribute__((address_space(3))) const float* lds_cfptr;
__device__ __forceinline__ void biasadd(f32x16&p0,f32x16&p1,int jb,int qrel,int hi,lds_cfptr bt){
  const int base=qrel-64*jb-4*hi;
  #pragma unroll
  for(int r4=0;r4<16;r4+=4){
    #pragma unroll
    for(int r=r4;r<r4+4;++r){int rel=base-((r&3)+8*(r>>2)); int i0=min(max(rel,0),127), i1=min(max(rel-32,0),127); p0[r]+=bt[i0]; p1[r]+=bt[i1];}
    asm volatile("s_waitcnt lgkmcnt(0)":"+v"(p0),"+v"(p1)::"memory"); }
}

constexpr int NSLOT=3, SLOTB=8192;
constexpr int LDS_K=0, LDS_V=NSLOT*SLOTB, LDS_WS=2*NSLOT*SLOTB, LDS_OST=LDS_WS+NW*64*4, LDS_KM=LDS_OST+NW*4096, LDS_BT=LDS_KM+7*64*4, LDS_BYTES=LDS_BT+128*4;
constexpr float C2=0.125f*1.4426950408889634f;
__device__ __forceinline__ void glds16(const void*gsrc,unsigned lds_dst){unsigned keep;
  asm volatile("s_mov_b32 %0, m0\n\ts_mov_b32 m0, %2\n\ts_nop 0\n\tglobal_load_lds_dwordx4 %1, off\n\ts_mov_b32 m0, %0":"=&s"(keep):"v"(gsrc),"s"(lds_dst):"memory");}
__device__ __forceinline__ float max3f(float a,float b,float c){float r;asm("v_max3_f32 %0, %1, %2, %3":"=v"(r):"v"(a),"v"(b),"v"(c));return r;}
__device__ __forceinline__ float max2f(float a,float b){float r;asm("v_max_f32_e32 %0, %1, %2":"=v"(r):"v"(a),"v"(b));return r;}
__device__ __forceinline__ float fadd_s(float a,float b){float r;asm("v_add_f32_e32 %0, %1, %2":"=v"(r):"v"(a),"v"(b));return r;}
__device__ __forceinline__ float fsub_s(float a,float b){float r;asm("v_sub_f32_e32 %0, %1, %2":"=v"(r):"v"(a),"v"(b));return r;}
typedef float f32x2_t __attribute__((ext_vector_type(2))); typedef __bf16 bf16x2_t __attribute__((ext_vector_type(2)));
__device__ __forceinline__ unsigned cvtpk_s(float lo,float hi){f32x2_t v={lo,hi};bf16x2_t b=__builtin_convertvector(v,bf16x2_t);return __builtin_bit_cast(unsigned,b);}
#define WAIT_BAR(N) asm volatile("s_waitcnt vmcnt(" #N ") lgkmcnt(0)\n\ts_barrier":::"memory")

__device__ __forceinline__ void qkt(f32x16&p0,f32x16&p1,const char*Kslot,const bf16x8*qr,int r32,int hi){
  const char*kb=Kslot+hi*1024+r32*16;
  #pragma unroll
  for(int d0=0;d0<4;++d0){
    const bf16x8 b0=*reinterpret_cast<const bf16x8*>(kb+d0*2048);
    const bf16x8 b1=*reinterpret_cast<const bf16x8*>(kb+d0*2048+512);
    if(d0==0){p0=__builtin_amdgcn_mfma_f32_32x32x16_bf16(b0,qr[0],(f32x16){},0,0,0);p1=__builtin_amdgcn_mfma_f32_32x32x16_bf16(b1,qr[0],(f32x16){},0,0,0);}
    else{p0=__builtin_amdgcn_mfma_f32_32x32x16_bf16(b0,qr[d0],p0,0,0,0);p1=__builtin_amdgcn_mfma_f32_32x32x16_bf16(b1,qr[d0],p1,0,0,0);}}
}
typedef __attribute__((address_space(3))) const char* lds_cptr;
typedef short v4i16_t __attribute__((ext_vector_type(4)));
__device__ __forceinline__ void kload8(bf16x8*kf,lds_cptr kp){
  kf[0]=*(const __attribute__((address_space(3))) bf16x8*)(kp);      kf[1]=*(const __attribute__((address_space(3))) bf16x8*)(kp+512);
  kf[2]=*(const __attribute__((address_space(3))) bf16x8*)(kp+2048); kf[3]=*(const __attribute__((address_space(3))) bf16x8*)(kp+2560);
  kf[4]=*(const __attribute__((address_space(3))) bf16x8*)(kp+4096); kf[5]=*(const __attribute__((address_space(3))) bf16x8*)(kp+4608);
  kf[6]=*(const __attribute__((address_space(3))) bf16x8*)(kp+6144); kf[7]=*(const __attribute__((address_space(3))) bf16x8*)(kp+6656);
}
__device__ __forceinline__ void kload2(bf16x8*kf,lds_cptr kp,int j){ kf[2*j]=*(const __attribute__((address_space(3))) bf16x8*)(kp+j*2048); kf[2*j+1]=*(const __attribute__((address_space(3))) bf16x8*)(kp+j*2048+512); }
__device__ __forceinline__ s16x4 vtr(lds_cptr p){ return __builtin_bit_cast(s16x4,__builtin_amdgcn_ds_read_tr16_b64_v4i16((__attribute__((address_space(3))) v4i16_t*)p)); }
__device__ __forceinline__ float rowmax(const f32x16&p0,const f32x16&p1){
  float a=max3f(p0[0],p0[1],p1[0]),b=max3f(p0[2],p0[3],p1[1]);a=max3f(a,p1[2],p1[3]);
  #pragma unroll
  for(int r=4;r<16;r+=4){a=max3f(a,p0[r],p0[r+1]);b=max3f(b,p0[r+2],p0[r+3]);a=max3f(a,p1[r],p1[r+1]);b=max3f(b,p1[r+2],p1[r+3]);}
  const float m=max2f(a,b);
  auto rr=__builtin_amdgcn_permlane32_swap(__float_as_uint(m),__float_as_uint(m),false,false);
  return max2f(__uint_as_float(rr[0]),__uint_as_float(rr[1]));
}
__device__ __forceinline__ void pv(f32x16*o,int vb,bf16x8 pa0,bf16x8 pa1,bf16x8 pa2,bf16x8 pa3){
  #pragma unroll
  for(int d0=0;d0<2;++d0){s16x4 lo[4],hi[4];
    #pragma unroll
    for(int ks=0;ks<4;++ks){
      asm volatile("ds_read_b64_tr_b16 %0,%1 offset:%c2":"=&v"(lo[ks]):"v"(vb),"i"(d0*4096+ks*1024):"memory");
      asm volatile("ds_read_b64_tr_b16 %0,%1 offset:%c2":"=&v"(hi[ks]):"v"(vb),"i"(d0*4096+ks*1024+512):"memory");}
    asm volatile("s_waitcnt lgkmcnt(0)":::"memory");SBAR();
    #define PK(k) (bf16x8){lo[k][0],lo[k][1],lo[k][2],lo[k][3],hi[k][0],hi[k][1],hi[k][2],hi[k][3]}
    o[d0]=__builtin_amdgcn_mfma_f32_32x32x16_bf16(pa0,PK(0),o[d0],0,0,0);
    o[d0]=__builtin_amdgcn_mfma_f32_32x32x16_bf16(pa1,PK(1),o[d0],0,0,0);
    o[d0]=__builtin_amdgcn_mfma_f32_32x32x16_bf16(pa2,PK(2),o[d0],0,0,0);
    o[d0]=__builtin_amdgcn_mfma_f32_32x32x16_bf16(pa3,PK(3),o[d0],0,0,0);
    #undef PK
  }
}

#ifndef ATTN_STORE16
#define ATTN_STORE16(p,v) (*(u32x4*)(p)=(v))
#endif
template<int THRL> __device__ __forceinline__ void attn_unit(int b,int h,int qb,const bf16*Q,const bf16*__restrict__ K,const bf16*__restrict__ V,bf16*O,char*shm,const float*kpart,const float*btab){
  int tid=threadIdx.x; asm volatile("":"+v"(tid));
  const int lane=tid&63,r32=lane&31,hi=lane>>5; const int wid=__builtin_amdgcn_readfirstlane(tid>>6);
  const long rowbase=(long)b*SEQ; const int q0=qb*QB;
  const bf16*Qw=Q+(rowbase+q0+wid*QBLK)*DM+h*D;
  const bf16*Kh=K+rowbase*DM+h*D,*Vh=V+rowbase*DM+h*D;
  const unsigned lds0=(unsigned)(uintptr_t)shm;
  float*wsf=(float*)(shm+LDS_WS)+wid*64;
  const bf16*ksrc=Kh+(long)lane*DM+wid*8;
  const bf16*vsrc=Vh+(long)(16*(wid&3)+(lane>>2))*DM+(wid>>2)*32+(lane&3)*8;
  const unsigned kdst=lds0+LDS_K+wid*1024, vdst=lds0+LDS_V+wid*1024;
  #define DMA_K(t,slot) glds16(ksrc+(long)(t)*KVBLK*DM,(unsigned)__builtin_amdgcn_readfirstlane(kdst+(slot)))
  #define DMA_V(t,slot) glds16(vsrc+(long)(t)*KVBLK*DM,(unsigned)__builtin_amdgcn_readfirstlane(vdst+(slot)))
  const int vb0=(int)(lds0+LDS_V)+((lane>>4)&1)*32+(lane&3)*8+(4*hi+((lane&15)>>2))*64;
  const char*Kbase=shm+LDS_K; bf16x8 kf[8];
  const lds_cptr shm3=(lds_cptr)shm; const lds_cptr kp0=shm3+LDS_K+hi*1024+r32*16; const lds_cptr vp0=shm3+LDS_V+((lane>>4)&1)*32+(lane&3)*8+(4*hi+((lane&15)>>2))*64;
  const lds_cfptr btl=(lds_cfptr)(shm3+LDS_BT);
  const int NT=(q0+QB)/KVBLK;
  DMA_K(0,0);DMA_V(0,0);DMA_K(1,SLOTB);
  bf16x8 qr[4];
  #pragma unroll
  for(int d0=0;d0<4;++d0)qr[d0]=*reinterpret_cast<const bf16x8*>(&Qw[(long)r32*DM+d0*16+hi*8]);
  { float*km=(float*)(shm+LDS_KM); float*bt=(float*)(shm+LDS_BT); int tq=tid; asm volatile("":"+v"(tq));
    if(tq<448){const int j=tq>>6,d=tq&63; float v=0.f; if(j<qb&&qb>3){const float*kp=kpart+((size_t)((b*NQB+j)*2)*512)+h*D+d; v=(kp[0]+kp[512])*(1.0f/256.0f);} km[tq]=v;}
    else if(tq<448+64){const int i=tq-448; bt[i]=btab[h*128+i]; bt[64+i]=btab[h*128+64+i];} }
  float mhat=0.f,l_reg=0.f;f32x16 o[2];o[0]=f32x16{};o[1]=f32x16{};
  const int qrel=wid*QBLK+r32;
  #define CMASK(P0,P1,t) do{int jb_=(t)-(NT-4);   \
    if(jb_>=-2 && 32*wid+31-64*jb_>=0 && 32*wid-64*jb_-63<=112)biasadd(P0,P1,jb_,qrel,hi,btl); if(jb_>=0 && 64*jb_+63>32*wid)cmask(P0,P1,jb_,qrel,hi);}while(0)
  bool resc=false;
  #define START(P0,P1,t) do{ float rm=rowmax(P0,P1); resc=false; const float nv_=MASKADD(t); rm=fadd_s(rm,nv_); \
    { const float dl=__builtin_fmaxf(rm,-1.0e4f); mhat=fadd_s(mhat,dl); const float cc_=fsub_s(nv_,dl); \
      _Pragma("unroll") for(int r=0;r<16;++r){P0[r]=fadd_s(P0[r],cc_);P1[r]=fadd_s(P1[r],cc_);} } \
    _Pragma("unroll") for(int r=0;r<16;++r)P0[r]=__builtin_amdgcn_exp2f(P0[r]); }while(0)
  #define RESC() do{ if(resc){ asm volatile("s_waitcnt lgkmcnt(0)":::"memory"); \
      _Pragma("unroll") for(int d_=0;d_<2;++d_) _Pragma("unroll") for(int r=0;r<16;++r)o[d_][r]*=wsf[crow(r,hi)]; } }while(0)
  f32x16 pA0,pA1,pB0,pB1;
  int sl_prev=0,sl_cur=0,sl_next=SLOTB;
  #define ROT() do{sl_prev=sl_cur;sl_cur=sl_next;sl_next=(sl_next==(NSLOT-1)*SLOTB)?0:sl_next+SLOTB;}while(0)
  DMA_K(2,2*SLOTB);
  WAIT_BAR(3);
  unsigned selbits=(1u<<qb)-1u;
  if(qb>3){ selbits=0u;
    const __attribute__((address_space(3))) float* km3=(const __attribute__((address_space(3))) float*)(shm3+LDS_KM);
    float qf[32];
    #pragma unroll
    for(int d0=0;d0<4;++d0){
      #pragma unroll
      for(int i=0;i<8;++i) qf[d0*8+i]=__uint_as_float(((unsigned)(unsigned short)qr[d0][i])<<16);}
    float gj[7];
    #pragma unroll
    for(int j=0;j<7;++j){ float s=0.f;
      if(j<qb){
        #pragma unroll
        for(int d0=0;d0<4;++d0){ const f32x4v k0=*(const __attribute__((address_space(3))) f32x4v*)(km3+j*64+d0*16+hi*8); const f32x4v k1=*(const __attribute__((address_space(3))) f32x4v*)(km3+j*64+d0*16+hi*8+4);
          s+=qf[d0*8+0]*k0[0]+qf[d0*8+1]*k0[1]+qf[d0*8+2]*k0[2]+qf[d0*8+3]*k0[3]+qf[d0*8+4]*k1[0]+qf[d0*8+5]*k1[1]+qf[d0*8+6]*k1[2]+qf[d0*8+7]*k1[3]; }
        auto rr=__builtin_amdgcn_permlane32_swap(__float_as_uint(s),__float_as_uint(s),false,false); s=__uint_as_float(rr[0])+__uint_as_float(rr[1]); }
      gj[j]=s; }
    #pragma unroll
    for(int j=0;j<7;++j){ int rank=0;
      #pragma unroll
      for(int k=0;k<7;++k){ if(k!=j){ const bool beats=(k<j)?(gj[k]>=gj[j]):(gj[k]>gj[j]); rank+=(k<qb&&beats)?1:0; } }
      if(j<qb&&rank<3)selbits|=(1u<<j); }
  }
  #define MASKADD(t) ((((t)>>2)<qb && !((selbits>>((t)>>2))&1u))?-1.0e30f:0.0f)
  qkt(pA0,pA1,Kbase,qr,r32,hi);asm volatile("s_nop 15\n\ts_nop 7":"+v"(pA0),"+v"(pA1));CMASK(pA0,pA1,0);
  START(pA0,pA1,0);
  _Pragma("unroll") for(int r=0;r<16;++r)pA1[r]=__builtin_amdgcn_exp2f(pA1[r]);
  WAIT_BAR(0);
  DMA_K(3,0);DMA_V(1,SLOTB);
  ROT();
  kload8(kf,kp0+sl_cur);
  WAIT_BAR(2);
  s16x4 vlo[8],vhi[8]; u32x4 pw0,pw1,pw2,pw3;
  #define PKW(P,B) cvtpk_s(P[B],P[B+1])
  #define PAF(k) __builtin_bit_cast(bf16x8,pw##k)
  #define VFR(i) (bf16x8){vlo[i][0],vlo[i][1],vlo[i][2],vlo[i][3],vhi[i][0],vhi[i][1],vhi[i][2],vhi[i][3]}
  #define PIN(x) asm volatile("":"+v"(x))
  #define MX3(a,b,c) __builtin_fmaxf(__builtin_fmaxf((a),(b)),(c))
  #define GAPA(MF,A0,A1,A2,A3,W0,W1,PW) do{ MF; sacc+=A0; sacc+=A1; sacc+=A2; sacc+=A3; PIN(sacc); W0; W1; PIN(PW); SBAR(); }while(0)
  #define EX(v) __builtin_amdgcn_exp2f(v)
  #define GAPB(MF,X,B) do{ MF; X[B]=EX(X[B]); X[B+1]=EX(X[B+1]); X[B+2]=EX(X[B+2]); X[B+3]=EX(X[B+3]); PIN(X); SBAR(); }while(0)
  #define VRD(i) do{ vlo[i]=vtr(vp_+(((i)>>2)*4096+((i)&3)*1024)); vhi[i]=vtr(vp_+(((i)>>2)*4096+((i)&3)*1024+512)); }while(0)
  #define KRD(G,j) do{ if(G){ kload2(kf,kp0+sl_next,j); SBAR(); } }while(0)
  #define STEP(C0,C1,P0,P1,t,GK,GV,GL) do{ SBAR(); \
    const lds_cptr vp_=vp0+sl_prev; \
    VRD(0); SBAR(); float sacc=(P0[0]+P0[1]); \
    GAPA(C0=__builtin_amdgcn_mfma_f32_32x32x16_bf16(kf[0],qr[0],(f32x16){},0,0,0), P0[2],P0[3],P0[4],P0[5],     pw0[0]=PKW(P0,0), pw0[1]=PKW(P0,2), pw0); \
    VRD(4); SBAR(); GAPA(C1=__builtin_amdgcn_mfma_f32_32x32x16_bf16(kf[1],qr[0],(f32x16){},0,0,0), P0[6],P0[7],P0[8],P0[9],     pw0[2]=PKW(P0,4), pw0[3]=PKW(P0,6), pw0); \
    VRD(1); SBAR(); GAPA(C0=__builtin_amdgcn_mfma_f32_32x32x16_bf16(kf[2],qr[1],C0,0,0,0),   P0[10],P0[11],P0[12],P0[13], pw1[0]=PKW(P0,8), pw1[1]=PKW(P0,10), pw1); \
    VRD(5); SBAR(); GAPA(C1=__builtin_amdgcn_mfma_f32_32x32x16_bf16(kf[3],qr[1],C1,0,0,0),   P0[14],P0[15],P1[0],P1[1],   pw1[2]=PKW(P0,12),pw1[3]=PKW(P0,14), pw1); \
    VRD(2); SBAR(); GAPA(C0=__builtin_amdgcn_mfma_f32_32x32x16_bf16(kf[4],qr[2],C0,0,0,0),   P1[2],P1[3],P1[4],P1[5],     pw2[0]=PKW(P1,0), pw2[1]=PKW(P1,2), pw2); \
    VRD(6); SBAR(); GAPA(C1=__builtin_amdgcn_mfma_f32_32x32x16_bf16(kf[5],qr[2],C1,0,0,0),   P1[6],P1[7],P1[8],P1[9],     pw2[2]=PKW(P1,4), pw2[3]=PKW(P1,6), pw2); \
    VRD(3); SBAR(); GAPA(C0=__builtin_amdgcn_mfma_f32_32x32x16_bf16(kf[6],qr[3],C0,0,0,0),   P1[10],P1[11],P1[12],P1[13], pw3[0]=PKW(P1,8), pw3[1]=PKW(P1,10), pw3); \
    VRD(7); SBAR(); GAPA(C1=__builtin_amdgcn_mfma_f32_32x32x16_bf16(kf[7],qr[3],C1,0,0,0),   P1[14],P1[15],0.f,0.f,       pw3[2]=PKW(P1,12),pw3[3]=PKW(P1,14), pw3); \
    l_reg+=sacc; \
    if(GK){DMA_K((t)+3,sl_cur);} if(GV){DMA_V((t)+1,sl_next);} \
    CMASK(C0,C1,t); \
    { float a=MX3(C0[0],C0[1],C1[0]),b=MX3(C0[2],C0[3],C1[1]); a=MX3(a,C1[2],C1[3]); \
      _Pragma("unroll") for(int r=4;r<16;r+=4){a=MX3(a,C0[r],C0[r+1]);b=MX3(b,C0[r+2],C0[r+3]);a=MX3(a,C1[r],C1[r+1]);b=MX3(b,C1[r+2],C1[r+3]);} \
      float rm=__builtin_fmaxf(a,b); { auto rr=__builtin_amdgcn_permlane32_swap(__float_as_uint(rm),__float_as_uint(rm),false,false); rm=__builtin_fmaxf(__uint_as_float(rr[0]),__uint_as_float(rr[1])); } \
      const float nv_=MASKADD(t)-mhat; rm+=nv_; float cc_=nv_; \
      resc=false; \
      if(__builtin_expect(__any(rm>(float)THRL),0)){ const float dl=__builtin_fmaxf(rm,0.f); mhat+=dl; cc_-=dl; \
        const float f=__builtin_amdgcn_exp2f(-dl); l_reg*=f; if(hi==0)wsf[r32]=f; resc=true; } \
      _Pragma("unroll") for(int r=0;r<16;++r){C0[r]+=cc_;C1[r]+=cc_;} } \
    SBAR(); \
    GAPB(o[0]=__builtin_amdgcn_mfma_f32_32x32x16_bf16(PAF(0),VFR(0),o[0],0,0,0), C0,0); \
    GAPB(o[1]=__builtin_amdgcn_mfma_f32_32x32x16_bf16(PAF(0),VFR(4),o[1],0,0,0), C0,4); \
    KRD(GL,0); GAPB(o[0]=__builtin_amdgcn_mfma_f32_32x32x16_bf16(PAF(1),VFR(1),o[0],0,0,0), C0,8); \
    KRD(GL,1); GAPB(o[1]=__builtin_amdgcn_mfma_f32_32x32x16_bf16(PAF(1),VFR(5),o[1],0,0,0), C0,12); \
    KRD(GL,2); GAPB(o[0]=__builtin_amdgcn_mfma_f32_32x32x16_bf16(PAF(2),VFR(2),o[0],0,0,0), C1,0); \
    KRD(GL,3); GAPB(o[1]=__builtin_amdgcn_mfma_f32_32x32x16_bf16(PAF(2),VFR(6),o[1],0,0,0), C1,4); \
    GAPB(o[0]=__builtin_amdgcn_mfma_f32_32x32x16_bf16(PAF(3),VFR(3),o[0],0,0,0), C1,8); \
    GAPB(o[1]=__builtin_amdgcn_mfma_f32_32x32x16_bf16(PAF(3),VFR(7),o[1],0,0,0), C1,12); \
    }while(0)
  int t=1;
  #undef CMASK
  #define CMASK(P0,P1,t) do{}while(0)
  for(;t+7<NT;t+=2){
    STEP(pB0,pB1,pA0,pA1,t,true,true,true);     WAIT_BAR(2); RESC(); ROT();
    STEP(pA0,pA1,pB0,pB1,t+1,true,true,true);   WAIT_BAR(2); RESC(); ROT();
  }
  #undef CMASK
  #define CMASK(P0,P1,t) do{int jb_=(t)-(NT-4);   \
    if(jb_>=-2 && 32*wid+31-64*jb_>=0 && 32*wid-64*jb_-63<=112)biasadd(P0,P1,jb_,qrel,hi,btl); if(jb_>=0 && 64*jb_+63>32*wid)cmask(P0,P1,jb_,qrel,hi);}while(0)
  #define ENDW(tt) do{ if((tt)+3<NT){WAIT_BAR(2);} else if((tt)+2<NT){WAIT_BAR(1);} else {WAIT_BAR(0);} }while(0)
  for(;t+1<NT;t+=2){
    STEP(pB0,pB1,pA0,pA1,t,(t+3<NT),(t+1<NT),(t+1<NT));       ENDW(t);   RESC(); ROT();
    STEP(pA0,pA1,pB0,pB1,t+1,(t+4<NT),(t+2<NT),(t+2<NT));     ENDW(t+1); RESC(); ROT();
  }
  STEP(pB0,pB1,pA0,pA1,NT-1,false,false,false); RESC();
  { float sacc=pB0[0]+pB0[1]; _Pragma("unroll") for(int r=2;r<16;++r)sacc+=pB0[r]; _Pragma("unroll") for(int r=0;r<16;++r)sacc+=pB1[r]; l_reg+=sacc;
    pw0=(u32x4){PKW(pB0,0),PKW(pB0,2),PKW(pB0,4),PKW(pB0,6)};pw1=(u32x4){PKW(pB0,8),PKW(pB0,10),PKW(pB0,12),PKW(pB0,14)};pw2=(u32x4){PKW(pB1,0),PKW(pB1,2),PKW(pB1,4),PKW(pB1,6)};pw3=(u32x4){PKW(pB1,8),PKW(pB1,10),PKW(pB1,12),PKW(pB1,14)};
    SBAR(); pv(o,vb0+sl_cur,PAF(0),PAF(1),PAF(2),PAF(3)); }
  #undef PKW
  #undef PAF
  #undef VFR
  #undef PIN
  #undef MX3
  #undef GAPA
  #undef GAPB
  #undef EX
  #undef VRD
  #undef KRD
  #undef STEP
  #undef ENDW
  #undef MASKADD
  {auto rr=__builtin_amdgcn_permlane32_swap(__float_as_uint(l_reg),__float_as_uint(l_reg),false,false);l_reg=__uint_as_float(rr[0])+__uint_as_float(rr[1]);}
  if(hi==0)wsf[32+r32]=l_reg;asm volatile("s_waitcnt lgkmcnt(0)":::"memory");
  float rli[16];
  #pragma unroll
  for(int r=0;r<16;++r)rli[r]=__builtin_amdgcn_rcpf(wsf[32+crow(r,hi)]);
  bf16*Ow=O+(rowbase+q0+wid*QBLK)*DM+h*D;
  { bf16*stg=(bf16*)(shm+LDS_OST)+wid*2048;
    #pragma unroll
    for(int r=0;r<16;++r){const int orow=crow(r,hi);
      #pragma unroll
      for(int d0=0;d0<2;++d0)stg[orow*64+d0*32+r32]=__float2bfloat16(o[d0][r]*rli[r]);}
    asm volatile("s_waitcnt lgkmcnt(0)":::"memory");
    #pragma unroll
    for(int i=0;i<4;++i){const int row=i*8+(lane>>3),ch=lane&7; const u32x4 v=*(const u32x4*)(stg+row*64+ch*8); ATTN_STORE16(Ow+(long)row*DM+ch*8,v);} }
  asm volatile("s_waitcnt lgkmcnt(0)\n\ts_barrier":::"memory");
  #undef DMA_K
  #undef DMA_V
  #undef CMASK
  #undef START
  #undef RESC
  #undef ROT
}
constexpr int ATTN_LDS_BYTES=LDS_BYTES;
#undef SBAR
#undef WAIT_BAR
}
constexpr int NWAVES = 8;
constexpr int PER_PHASE = 10;
constexpr int N_LAUNCHES = MK_N_LAUNCHES;

constexpr int BATCH = 8, SEQ = 2048, DMODEL = 1024, MTOK = BATCH * SEQ;
constexpr int INCOLS = 4096, SSMW = 512, NGRP = 32, CH = 32  , NCHUNK = SEQ / CH  , APK = 640  ;
constexpr int PQ = 2048, NEXP = 16384;
constexpr float RMS_EPS = 1e-6f;

constexpr size_t MiB = 1u << 20;
constexpr size_t WS_CTL = 0, CTL_ZERO_BYTES = 64 * 1024;
constexpr size_t WS_BIAS = 1 * MiB;
constexpr size_t WS_PW32 = 1 * MiB + 64 * 1024;
constexpr size_t WS_KPART = 1 * MiB + 128 * 1024;
constexpr size_t WS_KG = 2 * MiB;
constexpr size_t WS_SSQ1 = 3 * MiB;
constexpr size_t WS_WIN = 6 * MiB, WS_WQ = 14 * MiB, WS_WOUT = 18 * MiB, WS_WUS = 20 * MiB, WS_WUA = 21 * MiB, WS_WGLU = 22 * MiB, WS_KS = 22 * MiB + 512 * 1024;
constexpr size_t WS_WE = 23 * MiB;
constexpr size_t WS_BP = 32 * MiB;
constexpr size_t WS_AP = 52 * MiB;
constexpr size_t WS_E = 72 * MiB;
constexpr size_t WS_H = 80 * MiB;
constexpr size_t WS_YPRE = 80 * MiB, WS_YA = 96 * MiB, WS_XG = 80 * MiB;
constexpr size_t WS_Z = 96 * MiB, ZSTRIDE_B = 16 * MiB;
constexpr size_t WS_MRG = 128 * MiB;
constexpr size_t WS_PQ = 160 * MiB;
constexpr size_t WS_IDS = 224 * MiB, WS_GTS = 232 * MiB;
constexpr size_t WS_U16 = 32 * MiB, WS_V16 = 240 * MiB;
constexpr size_t WS_YB = 224 * MiB;
constexpr size_t WS_WPK = 128 * MiB, WS_RSTD1 = 4 * MiB, WS_Y16 = 160 * MiB;
constexpr size_t WS_END = 256 * MiB;
constexpr int CW_BAR = 1024;

constexpr int RING_OFF = 0, RING_BYTES = 131072;
constexpr int LDSCTL_OFF = RING_BYTES, MISC_OFF = LDSCTL_OFF + 320;
constexpr int LDS_BYTES = 147456;

#define GAS __attribute__((address_space(1)))
#define LAS __attribute__((address_space(3)))
typedef unsigned short bf16;
typedef unsigned v4u __attribute__((ext_vector_type(4)));
typedef float f32x4 __attribute__((ext_vector_type(4)));
typedef short bf16x8 __attribute__((ext_vector_type(8)));
typedef float f32x16 __attribute__((ext_vector_type(16)));
typedef __bf16 bf16x2_t __attribute__((ext_vector_type(2)));
typedef _Float16 h2_t __attribute__((ext_vector_type(2)));
typedef GAS unsigned gu32;
#define RLX_AGENT __ATOMIC_RELAXED, __HIP_MEMORY_SCOPE_AGENT
#define LDS_WAIT() asm volatile("s_waitcnt lgkmcnt(0)" ::: "memory")
#define VM_WAIT() asm volatile("s_waitcnt vmcnt(0)" ::: "memory")
__device__ __forceinline__ unsigned f2bf(float f) { unsigned u = __builtin_bit_cast(unsigned, f); return (u + 0x7fffu + ((u >> 16) & 1u)) >> 16; }
__device__ __forceinline__ unsigned pk2(float lo, float hi) { return f2bf(lo) | (f2bf(hi) << 16); }
using pg8::cvt_pk_bf16; using pg8::bf_lo; using pg8::bf_hi; using pg8::sigmoid_f; using pg8::gelu_tanh;

#define XB_TMO      128
#define XB_XCNT(j)  (256  + 64 * (j))
#define XB_XSUB(j)  (1280 + 64 * (j))
#define XB_XGEN(j)  (2304 + 64 * (j))
#define XB_TOP      3328
#define XB_TOPGEN   3392
#define XCD_BAR_WORDS 3456
#define XB_SPIN_CAP (1u << 18)
__device__ __forceinline__ unsigned xb_ld(unsigned* p)              { return __hip_atomic_load(p, __ATOMIC_RELAXED, __HIP_MEMORY_SCOPE_AGENT); }
__device__ __forceinline__ unsigned xb_add(unsigned* p, unsigned v) { return __hip_atomic_fetch_add(p, v, __ATOMIC_RELAXED, __HIP_MEMORY_SCOPE_AGENT); }
__device__ __forceinline__ unsigned xb_xcc_id() { return (unsigned)__builtin_amdgcn_s_getreg((3 << 11) | 20) & 0xFu; }
#define XB_SPIN(cond, bar) do { unsigned _sp = 0; while (cond) { __builtin_amdgcn_s_sleep(1); \
    if ((++_sp & 255u) == 0u) { if (xb_ld(&(bar)[XB_TMO])) break; if (_sp > XB_SPIN_CAP) { atomicAdd(&(bar)[XB_TMO], 1u); break; } } } } while (0)
struct XcdBarrier { unsigned* bar; unsigned x; volatile LAS unsigned* st; };
__device__ __forceinline__ XcdBarrier xcd_barrier_post(unsigned* bar, volatile LAS unsigned* st) {
    XcdBarrier b; b.bar = bar; b.x = xb_xcc_id(); b.st = st;
    if (threadIdx.x == 0) (void)xb_add(&bar[XB_XCNT(b.x)], 1u);
    return b;
}
__device__ __forceinline__ void xcd_barrier_complete(unsigned* bar, unsigned x, unsigned& nloc, unsigned& nx) {
    const unsigned G = gridDim.x * gridDim.y * gridDim.z;
    unsigned sum, cnt, mine, sp = 0u;
    for (;;) {
        sum = 0u; cnt = 0u; mine = 0u;
#pragma unroll
        for (unsigned j = 0; j < 16; ++j) { const unsigned c = xb_ld(&bar[XB_XCNT(j)]); sum += c; cnt += (c > 0u) ? 1u : 0u; mine = (j == x) ? c : mine; }
        if (sum == G) break;
        __builtin_amdgcn_s_sleep(1);
        if ((++sp & 255u) == 0u) { if (xb_ld(&bar[XB_TMO])) break; if (sp > XB_SPIN_CAP) { atomicAdd(&bar[XB_TMO], 1u); break; } }
    }
    nloc = mine > 0u ? mine : 1u; nx = cnt > 0u ? cnt : 1u;
}
__device__ __forceinline__ void xcd_barrier(const XcdBarrier& b) {
    asm volatile("s_waitcnt vmcnt(0)" ::: "memory");
    __syncthreads();
    if (threadIdx.x == 0) {
        unsigned* bar = b.bar;
        __builtin_amdgcn_s_waitcnt(0);
        unsigned nloc = b.st[0], nx = b.st[1];
        if (nloc == 0u) { xcd_barrier_complete(bar, b.x, nloc, nx); b.st[0] = nloc; b.st[1] = nx; }
        const unsigned old = xb_add(&bar[XB_XSUB(b.x)], 1u);
        const unsigned gen = old / nloc;
        if (old + 1u == (gen + 1u) * nloc) {
            __builtin_amdgcn_fence(__ATOMIC_RELEASE, "agent");
            asm volatile("s_waitcnt vmcnt(0)" ::: "memory");
            const unsigned og = xb_add(&bar[XB_TOP], 1u);
            const unsigned tg = og / nx;
            if (og + 1u == (tg + 1u) * nx) xb_add(&bar[XB_TOPGEN], 1u);
            else XB_SPIN(xb_ld(&bar[XB_TOPGEN]) == tg, bar);
            __builtin_amdgcn_fence(__ATOMIC_ACQUIRE, "agent");
            xb_add(&bar[XB_XGEN(b.x)], 1u);
            asm volatile("s_waitcnt vmcnt(0)" ::: "memory");
        } else {
            XB_SPIN(xb_ld(&bar[XB_XGEN(b.x)]) == gen, bar);
            __builtin_amdgcn_fence(__ATOMIC_ACQUIRE, "agent");
            asm volatile("s_waitcnt vmcnt(0)" ::: "memory");
        }
    }
    __syncthreads();
}

__device__ __forceinline__ float wave_sum(float v) {
#pragma unroll
    for (int o = 1; o < 64; o <<= 1) v += __shfl_xor(v, o);
    return v;
}

namespace pg8 {
struct EpiIn {
    static constexpr bool PERM = true; static constexpr bool CHAIN = false;
    bf16_t* zbase; bf16_t* AP; float* kpart;
    __device__ __forceinline__ void operator()(const f32x4 (&acc)[2][2][4][2], const Unit& u, int wr, int wc, int fr, int fq) const {
        const int t = u.pn >> 1, colt = (u.pn & 1) * 256;
        const int row0 = u.pm * BM + wr * 64 + fr, col0 = colt + wc * 32 + 8 * fq;
        if (t == 0) {
#pragma unroll
            for (int ai = 0; ai < 2; ++ai)
#pragma unroll
                for (int m = 0; m < 4; ++m) { const int r = row0 + ai * HALF + m * 16, b = r >> 11, l = r & 2047;
#pragma unroll
                    for (int bj = 0; bj < 2; ++bj) { const int c = col0 + bj * HALF, g = c >> 4, hi0 = c & 15;
                        const f32x4 v0 = acc[ai][bj][m][0], v1 = acc[ai][bj][m][1];
                        u32x4 w; w.x = cvt_pk_bf16(v0[0], v0[1]); w.y = cvt_pk_bf16(v0[2], v0[3]); w.z = cvt_pk_bf16(v1[0], v1[1]); w.w = cvt_pk_bf16(v1[2], v1[3]);
                        *(u32x4*)(AP + (size_t)(g * 512 + b * 64 + (l >> 5)) * 640 + (l & 31) * 16 + hi0) = w; } }
        } else {
            bf16_t* base = zbase + (size_t)t * (16u * 1024u * 1024u / 2u);
            const float sc = (t == 1) ? 0.125f * 1.4426950408889634f : 1.0f;
#pragma unroll
            for (int ai = 0; ai < 2; ++ai)
#pragma unroll
                for (int m = 0; m < 4; ++m) { bf16_t* rowp = base + (size_t)(row0 + ai * HALF + m * 16) * 512 + col0;
#pragma unroll
                    for (int bj = 0; bj < 2; ++bj) { f32x4 v0 = acc[ai][bj][m][0], v1 = acc[ai][bj][m][1];
                        if (t >= 4) {
#pragma unroll
                            for (int e = 0; e < 4; ++e) { v0[e] = sigmoid_f(v0[e]); v1[e] = sigmoid_f(v1[e]); }
                        } else { v0 = v0 * sc; v1 = v1 * sc; }
                        u32x4 w; w.x = cvt_pk_bf16(v0[0], v0[1]); w.y = cvt_pk_bf16(v0[2], v0[3]); w.z = cvt_pk_bf16(v1[0], v1[1]); w.w = cvt_pk_bf16(v1[2], v1[3]);
                        *(u32x4*)(rowp + bj * HALF) = w; } }
            if (t == 2) {
#pragma unroll
                for (int bj = 0; bj < 2; ++bj)
#pragma unroll
                    for (int n = 0; n < 2; ++n) { f32x4 s = (f32x4){0.f, 0.f, 0.f, 0.f};
#pragma unroll
                        for (int ai = 0; ai < 2; ++ai)
#pragma unroll
                            for (int m = 0; m < 4; ++m) s += acc[ai][bj][m][n];
#pragma unroll
                        for (int e = 0; e < 4; ++e) { float x = s[e]; x += __shfl_xor(x, 1); x += __shfl_xor(x, 2); x += __shfl_xor(x, 4); x += __shfl_xor(x, 8); s[e] = x; }
                        if (fr == 0) *(f32x4*)(kpart + (size_t)(u.pm * 2 + wr) * 512 + col0 + bj * HALF + 4 * n) = s; }
            }
        }
    }
};
struct EpiE {
    static constexpr bool PERM = false; static constexpr bool CHAIN = false;
    float* E;
    __device__ __forceinline__ void operator()(const f32x4 (&acc)[2][2][4][2], const Unit& u, int wr, int wc, int fr, int fq) const {
        const int row0 = u.pm * BM + wr * 64 + fr, col0 = wc * 32 + 4 * fq;
#pragma unroll
        for (int ai = 0; ai < 2; ++ai)
#pragma unroll
            for (int m = 0; m < 4; ++m) { float* rowp = E + (size_t)(row0 + ai * HALF + m * 16) * 128 + col0;
#pragma unroll
                for (int n = 0; n < 2; ++n) *(f32x4*)(rowp + n * 16) = acc[ai][0][m][n]; }
    }
};
struct EpiY {
    static constexpr bool PERM = true; static constexpr bool CHAIN = false;
    bf16_t* Y;
    __device__ __forceinline__ void operator()(const f32x4 (&acc)[2][2][4][2], const Unit& u, int wr, int wc, int fr, int fq) const {
        const int row0 = u.pm * BM + wr * 64 + fr, col0 = u.pn * BM + wc * 32 + 8 * fq;
#pragma unroll
        for (int ai = 0; ai < 2; ++ai)
#pragma unroll
            for (int m = 0; m < 4; ++m) { const int r = row0 + ai * HALF + m * 16, g = r >> 9, b = (r >> 6) & 7, c = r & 63;
#pragma unroll
                for (int bj = 0; bj < 2; ++bj) { const int cc = col0 + bj * HALF, j = cc >> 4, ho0 = cc & 15;
                    f32x4 v0 = acc[ai][bj][m][0], v1 = acc[ai][bj][m][1];
#pragma unroll
                    for (int e = 0; e < 4; ++e) { v0[e] = gelu_tanh(v0[e]); v1[e] = gelu_tanh(v1[e]); }
                    u32x4 w; w.x = cvt_pk_bf16(v0[0], v0[1]); w.y = cvt_pk_bf16(v0[2], v0[3]); w.z = cvt_pk_bf16(v1[0], v1[1]); w.w = cvt_pk_bf16(v1[2], v1[3]);
                    *(u32x4*)(Y + (size_t)(b * 2048 + c * 32 + j) * 512 + g * 16 + ho0) = w; } }
    }
};
struct EpiGlu {
    static constexpr bool PERM = true; static constexpr bool CHAIN = false;
    const bf16_t* Yp; bf16_t* Ya; const float* bias;
    __device__ __forceinline__ void operator()(const f32x4 (&acc)[2][2][4][2], const Unit& u, int wr, int wc, int fr, int fq) const {
        const int row0 = u.pm * BM + wr * 64 + fr, col0 = u.pn * BM + wc * 32 + 8 * fq;
        f32x4 bv[2][2];
#pragma unroll
        for (int bj = 0; bj < 2; ++bj)
#pragma unroll
            for (int n = 0; n < 2; ++n) bv[bj][n] = *(const f32x4*)(bias + col0 + bj * HALF + 4 * n);
#pragma unroll
        for (int ai = 0; ai < 2; ++ai)
#pragma unroll
            for (int m = 0; m < 4; ++m) { const size_t off = (size_t)(row0 + ai * HALF + m * 16) * 512 + col0;
#pragma unroll
                for (int bj = 0; bj < 2; ++bj) { const f32x4 z0 = acc[ai][bj][m][0] + bv[bj][0], z1 = acc[ai][bj][m][1] + bv[bj][1];
                    const u32x4 y = *(const u32x4*)(Yp + off + bj * HALF);
                    u32x4 w; w.x = cvt_pk_bf16(bf_lo(y.x) * sigmoid_f(z0[0]), bf_hi(y.x) * sigmoid_f(z0[1])); w.y = cvt_pk_bf16(bf_lo(y.y) * sigmoid_f(z0[2]), bf_hi(y.y) * sigmoid_f(z0[3]));
                    w.z = cvt_pk_bf16(bf_lo(y.z) * sigmoid_f(z1[0]), bf_hi(y.z) * sigmoid_f(z1[1])); w.w = cvt_pk_bf16(bf_lo(y.w) * sigmoid_f(z1[2]), bf_hi(y.w) * sigmoid_f(z1[3]));
                    *(u32x4*)(Ya + off + bj * HALF) = w; } }
    }
};
template <int ADD> struct EpiMrg {
    static constexpr bool PERM = true; static constexpr bool CHAIN = false;
    const bf16_t* G0; bf16_t* Mrg;
    __device__ __forceinline__ void operator()(const f32x4 (&acc)[2][2][4][2], const Unit& u, int wr, int wc, int fr, int fq) const {
        const int row0 = u.pm * BM + wr * 64 + fr, cin = wc * 32 + 8 * fq;
        const bf16_t* gb = G0 + (size_t)(u.pn >> 1) * (16u * 1024u * 1024u / 2u) + (u.pn & 1) * 256 + cin;
#pragma unroll
        for (int ai = 0; ai < 2; ++ai)
#pragma unroll
            for (int m = 0; m < 4; ++m) { const int r = row0 + ai * HALF + m * 16;
#pragma unroll
                for (int bj = 0; bj < 2; ++bj) {
#if defined(ABL_NO_SSM) || defined(ABL_NO_ATT)
#if defined(ABL_NO_SSM)
                    constexpr bool kill = (ADD == 0);
#else
                    constexpr bool kill = (ADD == 1);
#endif
                    const f32x4 a0 = kill ? (f32x4){0.f, 0.f, 0.f, 0.f} : acc[ai][bj][m][0], a1 = kill ? (f32x4){0.f, 0.f, 0.f, 0.f} : acc[ai][bj][m][1];
#else
                    const f32x4 a0 = acc[ai][bj][m][0], a1 = acc[ai][bj][m][1];
#endif
                    const u32x4 gt = *(const u32x4*)(gb + (size_t)r * 512 + bj * HALF);
                    bf16_t* mp = Mrg + (size_t)r * 1024 + u.pn * BM + cin + bj * HALF;
                    float o[8] = { bf_lo(gt.x) * a0[0], bf_hi(gt.x) * a0[1], bf_lo(gt.y) * a0[2], bf_hi(gt.y) * a0[3], bf_lo(gt.z) * a1[0], bf_hi(gt.z) * a1[1], bf_lo(gt.w) * a1[2], bf_hi(gt.w) * a1[3] };
                    if (ADD) { const u32x4 p = *(const u32x4*)mp; o[0] += bf_lo(p.x); o[1] += bf_hi(p.x); o[2] += bf_lo(p.y); o[3] += bf_hi(p.y); o[4] += bf_lo(p.z); o[5] += bf_hi(p.z); o[6] += bf_lo(p.w); o[7] += bf_hi(p.w); }
                    u32x4 w; w.x = cvt_pk_bf16(o[0], o[1]); w.y = cvt_pk_bf16(o[2], o[3]); w.z = cvt_pk_bf16(o[4], o[5]); w.w = cvt_pk_bf16(o[6], o[7]);
                    *(u32x4*)mp = w; } }
    }
};
struct EpiMrgDual {
    static constexpr bool PERM = true; static constexpr bool CHAIN = true;
    EpiMrg<0> a; EpiMrg<1> b;
    __device__ __forceinline__ void mid(f32x4 (&acc)[2][2][4][2], const Unit& u, int wr, int wc, int fr, int fq) const {
        const int row0 = u.pm * BM + wr * 64 + fr, cin = wc * 32 + 8 * fq;
        const size_t goff = (size_t)(u.pn >> 1) * (16u * 1024u * 1024u / 2u) + (u.pn & 1) * 256 + cin;
#pragma unroll
        for (int ai = 0; ai < 2; ++ai)
#pragma unroll
            for (int m = 0; m < 4; ++m) { const int r = row0 + ai * HALF + m * 16;
#pragma unroll
                for (int bj = 0; bj < 2; ++bj) {
                    const u32x4 ga = *(const u32x4*)(a.G0 + goff + (size_t)r * 512 + bj * HALF), gb = *(const u32x4*)(b.G0 + goff + (size_t)r * 512 + bj * HALF);
                    const float sa[8] = { bf_lo(ga.x), bf_hi(ga.x), bf_lo(ga.y), bf_hi(ga.y), bf_lo(ga.z), bf_hi(ga.z), bf_lo(ga.w), bf_hi(ga.w) };
                    const float sb[8] = { bf_lo(gb.x), bf_hi(gb.x), bf_lo(gb.y), bf_hi(gb.y), bf_lo(gb.z), bf_hi(gb.z), bf_lo(gb.w), bf_hi(gb.w) };
#pragma unroll
                    for (int e = 0; e < 4; ++e) { acc[ai][bj][m][0][e] *= sa[e] * __builtin_amdgcn_rcpf(fmaxf(sb[e], 1e-30f)); acc[ai][bj][m][1][e] *= sa[4 + e] * __builtin_amdgcn_rcpf(fmaxf(sb[4 + e], 1e-30f)); } } }
    }
    __device__ __forceinline__ void operator()(const f32x4 (&acc)[2][2][4][2], const Unit& u, int wr, int wc, int fr, int fq) const {
        const int row0 = u.pm * BM + wr * 64 + fr, cin = wc * 32 + 8 * fq;
        const bf16_t* gb = b.G0 + (size_t)(u.pn >> 1) * (16u * 1024u * 1024u / 2u) + (u.pn & 1) * 256 + cin;
#pragma unroll
        for (int ai = 0; ai < 2; ++ai)
#pragma unroll
            for (int m = 0; m < 4; ++m) { const int r = row0 + ai * HALF + m * 16;
#pragma unroll
                for (int bj = 0; bj < 2; ++bj) { const f32x4 a0 = acc[ai][bj][m][0], a1 = acc[ai][bj][m][1];
                    const u32x4 gt = *(const u32x4*)(gb + (size_t)r * 512 + bj * HALF);
                    u32x4 w; w.x = cvt_pk_bf16(bf_lo(gt.x) * a0[0], bf_hi(gt.x) * a0[1]); w.y = cvt_pk_bf16(bf_lo(gt.y) * a0[2], bf_hi(gt.y) * a0[3]);
                    w.z = cvt_pk_bf16(bf_lo(gt.z) * a1[0], bf_hi(gt.z) * a1[1]); w.w = cvt_pk_bf16(bf_lo(gt.w) * a1[2], bf_hi(gt.w) * a1[3]);
                    *(u32x4*)(b.Mrg + (size_t)r * 1024 + u.pn * BM + cin + bj * HALF) = w; } }
    }
};
struct EpiX1 {
    static constexpr bool PERM = true; static constexpr bool CHAIN = false;
    const float* X; float* X1; bf16_t* XG; const float* g2; float* ssq;
    __device__ __forceinline__ void operator()(const f32x4 (&acc)[2][2][4][2], const Unit& u, int wr, int wc, int fr, int fq) const {
        const int row0 = u.pm * BM + wr * 64 + fr, col0 = u.pn * BM + wc * 32 + 8 * fq;
#pragma unroll
        for (int ai = 0; ai < 2; ++ai)
#pragma unroll
            for (int m = 0; m < 4; ++m) { const int r = row0 + ai * HALF + m * 16; const size_t off = (size_t)r * 1024 + col0; float s = 0.f;
#pragma unroll
                for (int bj = 0; bj < 2; ++bj) {
                    #ifdef ABL_NO_MIX
                    const f32x4 x0 = *(const f32x4*)(X + off + bj * HALF), x1 = *(const f32x4*)(X + off + bj * HALF + 4);
#else
                    const f32x4 x0 = *(const f32x4*)(X + off + bj * HALF) + acc[ai][bj][m][0], x1 = *(const f32x4*)(X + off + bj * HALF + 4) + acc[ai][bj][m][1];
#endif
                    s += (x0[0] * x0[0] + x0[1] * x0[1]) + (x0[2] * x0[2] + x0[3] * x0[3]) + (x1[0] * x1[0] + x1[1] * x1[1]) + (x1[2] * x1[2] + x1[3] * x1[3]);
                    u32x4 w; w.x = cvt_pk_bf16(x0[0], x0[1]); w.y = cvt_pk_bf16(x0[2], x0[3]); w.z = cvt_pk_bf16(x1[0], x1[1]); w.w = cvt_pk_bf16(x1[2], x1[3]);
                    *(u32x4*)(XG + off + bj * HALF) = w; }
                s += __shfl_xor(s, 16); s += __shfl_xor(s, 32);
                if (fq == 0) ssq[(size_t)r * 16 + u.pn * 4 + wc] = s; }
    }
};
struct EpiPlain {
    static constexpr bool PERM = true; static constexpr bool CHAIN = false;
    bf16_t* O; int ldc;
    __device__ __forceinline__ void operator()(const f32x4 (&acc)[2][2][4][2], const Unit& u, int wr, int wc, int fr, int fq) const {
        const int row0 = u.pm * BM + wr * 64 + fr, col0 = u.pn * BM + wc * 32 + 8 * fq;
#pragma unroll
        for (int ai = 0; ai < 2; ++ai)
#pragma unroll
            for (int m = 0; m < 4; ++m) { bf16_t* rowp = O + (size_t)(row0 + ai * HALF + m * 16) * ldc + col0;
#pragma unroll
                for (int bj = 0; bj < 2; ++bj) { const f32x4 v0 = acc[ai][bj][m][0], v1 = acc[ai][bj][m][1];
                    u32x4 w; w.x = cvt_pk_bf16(v0[0], v0[1]); w.y = cvt_pk_bf16(v0[2], v0[3]); w.z = cvt_pk_bf16(v1[0], v1[1]); w.w = cvt_pk_bf16(v1[2], v1[3]);
                    *(u32x4*)(rowp + bj * HALF) = w; } }
    }
};
}
struct Frame {
    LAS unsigned char* lds;
    int tid, lane, wave, vcu, G;
};

__device__ __forceinline__ void p0_transpose_item(const float* W, int K, int N, bf16* WT, LAS float* scr, int item, int lane, const float* kscale = nullptr) {
    const int nblk = N / 32, kb = item / nblk, nb = item % nblk, k0 = 64 * kb, n0 = 32 * nb;
    float wv[32];
#pragma unroll
    for (int i = 0; i < 32; ++i) { const int kk = 2 * i + (lane >> 5); wv[i] = W[(size_t)(k0 + kk) * N + n0 + (lane & 31)]; }
    if (kscale) {
#pragma unroll
        for (int i = 0; i < 32; ++i) wv[i] *= kscale[k0 + 2 * i + (lane >> 5)]; }
#pragma unroll
    for (int i = 0; i < 32; ++i) { const int kk = 2 * i + (lane >> 5); scr[kk * 33 + (lane & 31)] = wv[i]; }
    LDS_WAIT(); asm volatile("" ::: "memory");
    const int c = lane & 7;
#pragma unroll
    for (int j = 0; j < 4; ++j) { const int n = (lane >> 3) + 8 * j; const LAS float* s = scr + (8 * c) * 33 + n;
        v4u o; o.x = pk2(s[0 * 33], s[1 * 33]); o.y = pk2(s[2 * 33], s[3 * 33]); o.z = pk2(s[4 * 33], s[5 * 33]); o.w = pk2(s[6 * 33], s[7 * 33]);
        *(GAS v4u*)(WT + (size_t)(n0 + n) * K + k0 + 8 * c) = o; }
    LDS_WAIT(); asm volatile("" ::: "memory");
}
__device__ __forceinline__ void rms_row_to_bf16(const float* xrow, const float* g, bf16* orow, int lane) {
    const GAS f32x4* xr = (const GAS f32x4*)xrow + lane; const GAS f32x4* gr = (const GAS f32x4*)g + lane;
    f32x4 v[4]; float s = 0.f;
#pragma unroll
    for (int j = 0; j < 4; ++j) { v[j] = xr[64 * j]; s += (v[j].x * v[j].x + v[j].y * v[j].y) + (v[j].z * v[j].z + v[j].w * v[j].w); }
    const float rstd = 1.0f / sqrtf(wave_sum(s) * (1.f / DMODEL) + RMS_EPS);
    GAS unsigned long long* o8 = (GAS unsigned long long*)orow + lane;
#pragma unroll
    for (int j = 0; j < 4; ++j) { const f32x4 gg = gr[64 * j];
        o8[64 * j] = (unsigned long long)pk2(v[j].x * rstd * gg.x, v[j].y * rstd * gg.y) | ((unsigned long long)pk2(v[j].z * rstd * gg.z, v[j].w * rstd * gg.w) << 32); }
}
__device__ __forceinline__ void rms_rows4_to_bf16(const float* x, const float* g, bf16* out, int m, int stride, int lane) {
    f32x4 v[4][4];
#pragma unroll
    for (int k = 0; k < 4; ++k) { const int mm = (m + k * stride < MTOK) ? m + k * stride : m; const GAS f32x4* xr = (const GAS f32x4*)(x + (size_t)mm * DMODEL) + lane;
#pragma unroll
        for (int j = 0; j < 4; ++j) v[k][j] = xr[64 * j]; }
    const GAS f32x4* gr = (const GAS f32x4*)g + lane; f32x4 gg[4];
#pragma unroll
    for (int j = 0; j < 4; ++j) gg[j] = gr[64 * j];
#pragma unroll
    for (int k = 0; k < 4; ++k) { if (m + k * stride >= MTOK) break; float s = 0.f;
#pragma unroll
        for (int j = 0; j < 4; ++j) s += (v[k][j].x * v[k][j].x + v[k][j].y * v[k][j].y) + (v[k][j].z * v[k][j].z + v[k][j].w * v[k][j].w);
        const float rstd = 1.0f / sqrtf(wave_sum(s) * (1.f / DMODEL) + RMS_EPS);
        GAS unsigned long long* o8 = (GAS unsigned long long*)(out + (size_t)(m + k * stride) * DMODEL) + lane;
#pragma unroll
        for (int j = 0; j < 4; ++j) o8[64 * j] = (unsigned long long)pk2(v[k][j].x * rstd * gg[j].x, v[k][j].y * rstd * gg[j].y) | ((unsigned long long)pk2(v[k][j].z * rstd * gg[j].z, v[k][j].w * rstd * gg[j].w) << 32); }
}
struct cpx { float r, i; };
__device__ __forceinline__ cpx cmul(cpx a, cpx b) { return cpx{a.r * b.r - a.i * b.i, a.r * b.i + a.i * b.r}; }
__device__ __forceinline__ cpx cpow_(float ar, float ai, float dt, int n) { const float e = expf(ar * dt * (float)n); const float ang = ai * dt * (float)n; return cpx{e * cosf(ang), e * sinf(ang)}; }
__device__ __forceinline__ void ssm_table_task(int g, int j, int lane, LAS float* scr, const float* a_re, const float* a_im, const float* log_dt, const float* b_re, const float* b_im,
                                               const float* c_re, const float* c_im, float* Kg, bf16* WE, bf16* BP, float* pw32) {
    const int p = lane;
    const float dt = expf(log_dt[g]), ar = a_re[g * 64 + p], ai = a_im[g * 64 + p];
#define pw(n) cpow_(ar, ai, dt, (n))
    const cpx lb = pw(1);
    const float den = ar * ar + ai * ai;
    const cpx coef = cpx{((lb.r - 1.f) * ar + lb.i * ai) / den, (lb.i * ar - (lb.r - 1.f) * ai) / den};
    const cpx pj = pw(j), pe = pw(31 - j), pv = pw(j + 1);
    unsigned wer[8], wei[8];
#pragma unroll
    for (int h2 = 0; h2 < 8; ++h2) { float er[2], ei[2];
#pragma unroll
        for (int q = 0; q < 2; ++q) { const int hi = 2 * h2 + q;
            const cpx bb = cmul(coef, cpx{b_re[(g * 64 + p) * 16 + hi], b_im[(g * 64 + p) * 16 + hi]});
            const cpx w = cmul(pj, bb); scr[(p * 16 + hi) * 2] = w.r; scr[(p * 16 + hi) * 2 + 1] = w.i;
            const cpx e = cmul(pe, bb); er[q] = e.r; ei[q] = e.i; }
        wer[h2] = pk2(er[0], er[1]); wei[h2] = pk2(ei[0], ei[1]); }
    { bf16* w0 = WE + ((size_t)(g * 256 + p) * 512 + j * 16); bf16* w1 = WE + ((size_t)(g * 256 + 64 + p) * 512 + j * 16);
      *(GAS v4u*)w0 = (v4u){wer[0], wer[1], wer[2], wer[3]}; *(GAS v4u*)(w0 + 8) = (v4u){wer[4], wer[5], wer[6], wer[7]};
      *(GAS v4u*)w1 = (v4u){wei[0], wei[1], wei[2], wei[3]}; *(GAS v4u*)(w1 + 8) = (v4u){wei[4], wei[5], wei[6], wei[7]};
      bf16* z0 = WE + ((size_t)(g * 256 + 128 + p) * 512 + j * 16); bf16* z1 = WE + ((size_t)(g * 256 + 192 + p) * 512 + j * 16); const v4u z = (v4u){0u, 0u, 0u, 0u};
      *(GAS v4u*)z0 = z; *(GAS v4u*)(z0 + 8) = z; *(GAS v4u*)z1 = z; *(GAS v4u*)(z1 + 8) = z; }
#pragma unroll 4
    for (int ho = 0; ho < 16; ++ho) { const cpx cv = cmul(cpx{c_re[(g * 16 + ho) * 64 + p], c_im[(g * 16 + ho) * 64 + p]}, pv);
        bf16* row = BP + ((size_t)(g * 512 + j * 16 + ho) * APK + 512);
        row[p] = (bf16)f2bf(cv.r); row[64 + p] = (bf16)f2bf(-cv.i); }
    if (j == 0) { const cpx p32 = pw(32); pw32[g * 128 + p] = p32.r; pw32[g * 128 + 64 + p] = p32.i; }
    LDS_WAIT(); asm volatile("" ::: "memory");
    { const int ho = lane >> 2, h4 = (lane & 3) * 4; float a0 = 0.f, a1 = 0.f, a2 = 0.f, a3 = 0.f;
      const float* cr = c_re + (g * 16 + ho) * 64; const float* ci = c_im + (g * 16 + ho) * 64;
#pragma unroll 4
      for (int pp = 0; pp < 64; ++pp) { const float r_ = cr[pp], i_ = ci[pp]; const LAS float* w = scr + (pp * 16 + h4) * 2;
          a0 += r_ * w[0] - i_ * w[1]; a1 += r_ * w[2] - i_ * w[3]; a2 += r_ * w[4] - i_ * w[5]; a3 += r_ * w[6] - i_ * w[7]; }
      *(GAS f32x4*)(Kg + ((size_t)(g * 32 + j) * 256 + ho * 16 + h4)) = (f32x4){a0, a1, a2, a3}; }
    LDS_WAIT(); asm volatile("" ::: "memory");
#undef pw
}

__device__ __forceinline__ float vmaxf(float a, float b) { float r; asm("v_max_f32_e32 %0, %1, %2" : "=v"(r) : "v"(a), "v"(b)); return r; }
__device__ __forceinline__ float vminf(float a, float b) { float r; asm("v_min_f32_e32 %0, %1, %2" : "=v"(r) : "v"(a), "v"(b)); return r; }
__device__ __forceinline__ float selhi(float lo, float hi) { float r; asm("v_cndmask_b32_e64 %0, %1, %2, %3" : "=v"(r) : "v"(lo), "v"(hi), "s"(0xFFFFFFFF00000000ull)); return r; }
#define CE_DESC(a, b) do { const float hi_ = vmaxf(a, b), lo_ = vminf(a, b); a = hi_; b = lo_; } while (0)
__device__ __forceinline__ void sort16_desc(float (&v)[16]) {
#pragma unroll
    for (int k = 2; k <= 16; k <<= 1)
#pragma unroll
        for (int j = k >> 1; j > 0; j >>= 1)
#pragma unroll
            for (int i = 0; i < 16; ++i) { const int l = i ^ j; if (l > i) { if ((i & k) == 0) CE_DESC(v[i], v[l]); else CE_DESC(v[l], v[i]); } }
}
__device__ __forceinline__ void bitonic_merge16_desc(float (&v)[16]) {
#pragma unroll
    for (int j = 8; j > 0; j >>= 1)
#pragma unroll
        for (int i = 0; i < 16; ++i) { const int l = i ^ j; if (l > i) CE_DESC(v[i], v[l]); }
}
__device__ __forceinline__ void merge_top16(float (&a)[16], const float (&b)[16]) {
#pragma unroll
    for (int i = 0; i < 16; ++i) a[i] = vmaxf(a[i], b[15 - i]);
    bitonic_merge16_desc(a);
}
__device__ __forceinline__ void merge_partner_top16(float (&a)[16]) {
    float p[16];
#pragma unroll
    for (int i = 0; i < 16; ++i) { const unsigned x = __float_as_uint(a[15 - i]); auto rr = __builtin_amdgcn_permlane32_swap(x, x, false, false); p[i] = selhi(__uint_as_float(rr[1]), __uint_as_float(rr[0])); }
#pragma unroll
    for (int i = 0; i < 16; ++i) a[i] = vmaxf(a[i], p[i]);
    bitonic_merge16_desc(a);
}
__device__ __forceinline__ void topk_half(int half, const bf16x8 (&qf)[8], int r32, int hi, const LAS unsigned char* ksl, float (&top)[16]) {
#pragma unroll 1
    for (int kt = 0; kt < 4; ++kt) {
        f32x16 acc = f32x16{};
        const int row = half * 128 + kt * 32 + r32; const LAS unsigned char* rp = ksl + row * 256; const int sw = row & 15;
#pragma unroll
        for (int ks = 0; ks < 8; ++ks) { const bf16x8 a = *(const LAS bf16x8*)(rp + (((2 * ks + hi) ^ sw) << 4));
            acc = __builtin_amdgcn_mfma_f32_32x32x16_bf16(a, qf[ks], acc, 0, 0, 0); }
        float grp[16];
#pragma unroll
        for (int r = 0; r < 16; ++r) { const unsigned key = (unsigned)(kt * 32 + (r & 3) + 8 * (r >> 2)) + 4u * (unsigned)hi; grp[r] = __uint_as_float((__float_as_uint(acc[r]) & ~127u) | key); }
        sort16_desc(grp);
        if (kt == 0) {
#pragma unroll
            for (int i = 0; i < 16; ++i) top[i] = grp[i];
        } else merge_top16(top, grp);
    }
    merge_partner_top16(top);
}
__device__ __forceinline__ void topk_task(int tt, int hd, int lane, LAS unsigned char* scr, const bf16* PQb, const LAS unsigned char* ksl, const float* ssq1, int* ids, float* gts, float* rstd1) {
    const int r32 = lane & 31, hi = lane >> 5; const bool hib = hi != 0;
    const int token = tt * 32 + r32;
    float v0_[16], v1_[16];
    bf16x8 qf0[8], qf1[8];
#pragma unroll
    for (int ks = 0; ks < 8; ++ks) { qf0[ks] = *(const GAS bf16x8*)(PQb + (size_t)token * PQ + hd * 256 + ks * 16 + hi * 8); qf1[ks] = *(const GAS bf16x8*)(PQb + (size_t)token * PQ + hd * 256 + 128 + ks * 16 + hi * 8); }
    topk_half(0, qf0, r32, hi, ksl, v0_);
    topk_half(1, qf1, r32, hi, ksl, v1_);
#define v_SEL(h, i) ((h) ? v1_[i] : v0_[i])
    LAS unsigned char* slot = scr + lane * 32;
    { v4u d0, d1;
#define PK4(h, k) ((__float_as_uint(v_SEL(h, 4 * (k))) & 127u) | ((__float_as_uint(v_SEL(h, 4 * (k) + 1)) & 127u) << 8) | ((__float_as_uint(v_SEL(h, 4 * (k) + 2)) & 127u) << 16) | ((__float_as_uint(v_SEL(h, 4 * (k) + 3)) & 127u) << 24))
      d0 = (v4u){PK4(0, 0), PK4(0, 1), PK4(0, 2), PK4(0, 3)}; d1 = (v4u){PK4(1, 0), PK4(1, 1), PK4(1, 2), PK4(1, 3)};
#undef PK4
      *(LAS v4u*)slot = d0; *(LAS v4u*)(slot + 16) = d1; }
    float a[16], b[16];
#pragma unroll
    for (int i = 0; i < 16; ++i) { a[i] = selhi(v0_[i], v1_[i]); b[i] = selhi(v1_[i], v0_[i]); }
    const unsigned obit = (unsigned)hi << 8;
#define CAND(i, j) __uint_as_float((__float_as_uint(a[i] + b[j]) & ~511u) | obit | (unsigned)(((i) << 4) | (j)))
    const float NEGBIG = -3.0e38f;
    float g0[16], g1[16];
#pragma unroll
    for (int j = 1; j < 16; ++j) g0[j - 1] = CAND(0, j);
    g0[15] = CAND(1, 2);
    g1[0] = CAND(1, 3); g1[1] = CAND(1, 4); g1[2] = CAND(1, 5); g1[3] = CAND(1, 6); g1[4] = CAND(1, 7); g1[5] = CAND(2, 3); g1[6] = CAND(2, 4);
    { const float c0 = CAND(0, 0), c1 = CAND(1, 1), c2 = CAND(2, 2), c3 = CAND(3, 3);
      g1[7] = selhi(c0, NEGBIG); g1[8] = selhi(c1, NEGBIG); g1[9] = selhi(c2, NEGBIG); g1[10] = selhi(c3, NEGBIG); }
#pragma unroll
    for (int i = 11; i < 16; ++i) g1[i] = NEGBIG;
#undef CAND
    sort16_desc(g0); sort16_desc(g1); merge_top16(g0, g1); merge_partner_top16(g0);
    float rstd;
    { const GAS f32x4* sp = (const GAS f32x4*)(ssq1 + (size_t)token * 16); const f32x4 s0 = sp[0], s1 = sp[1], s2 = sp[2], s3 = sp[3];
      const float ss = ((s0.x + s0.y) + (s0.z + s0.w)) + ((s1.x + s1.y) + (s1.z + s1.w)) + ((s2.x + s2.y) + (s2.z + s2.w)) + ((s3.x + s3.y) + (s3.z + s3.w));
      rstd = 1.0f / sqrtf(ss * (1.f / DMODEL) + RMS_EPS); }
    if (hd == 0 && !hib) rstd1[token] = rstd;
    float ex[16], esum = 0.f; const float sc = rstd * 1.4426950409f;
#pragma unroll
    for (int k = 0; k < 16; ++k) { ex[k] = __builtin_amdgcn_exp2f((g0[k] - g0[0]) * sc); esum += ex[k]; }
    const float inv = 1.0f / esum;
    int eid[8]; float gv[8];
#pragma unroll
    for (int k = 0; k < 8; ++k) { const float wv = selhi(g0[k], g0[8 + k]); const float ev = selhi(ex[k], ex[8 + k]);
        const unsigned tag = __float_as_uint(wv) & 511u, o = tag >> 8, i = (tag >> 4) & 15u, j = tag & 15u; const unsigned i1 = o ? j : i, i2 = o ? i : j;
        const unsigned k1 = slot[i1], k2 = slot[16 + i2];
        eid[k] = (int)(k1 * 128u + k2); gv[k] = ev * inv; }
    { int* ip = ids + (size_t)token * 128 + hd * 16 + 8 * hi; float* gp = gts + (size_t)token * 128 + hd * 16 + 8 * hi;
      *(GAS v4u*)ip = (v4u){(unsigned)eid[0], (unsigned)eid[1], (unsigned)eid[2], (unsigned)eid[3]}; *(GAS v4u*)(ip + 4) = (v4u){(unsigned)eid[4], (unsigned)eid[5], (unsigned)eid[6], (unsigned)eid[7]};
      *(GAS f32x4*)gp = (f32x4){gv[0], gv[1], gv[2], gv[3]}; *(GAS f32x4*)(gp + 4) = (f32x4){gv[4], gv[5], gv[6], gv[7]}; }
    LDS_WAIT(); asm volatile("" ::: "memory");
}


__device__ __forceinline__ float dot2bf(unsigned a, unsigned b, float c) { return __builtin_amdgcn_fdot2_f32_bf16(__builtin_bit_cast(bf16x2_t, a), __builtin_bit_cast(bf16x2_t, b), c, false); }
__device__ __forceinline__ h2_t fma_h2(unsigned v, h2_t w, h2_t acc) { return __builtin_elementwise_fma(__builtin_bit_cast(h2_t, v), w, acc); }
__device__ __forceinline__ unsigned fp8lo_bf(unsigned w, float sc) { return __builtin_bit_cast(unsigned, __builtin_amdgcn_cvt_scalef32_pk_bf16_fp8((int)w, sc, false)); }
__device__ __forceinline__ unsigned fp8hi_bf(unsigned w, float sc) { return __builtin_bit_cast(unsigned, __builtin_amdgcn_cvt_scalef32_pk_bf16_fp8((int)w, sc, true)); }
__device__ __forceinline__ h2_t fp8lo_h(unsigned w, float sc) { return __builtin_amdgcn_cvt_scalef32_pk_f16_fp8((int)w, sc, false); }
__device__ __forceinline__ h2_t fp8hi_h(unsigned w, float sc) { return __builtin_amdgcn_cvt_scalef32_pk_f16_fp8((int)w, sc, true); }
__device__ __forceinline__ unsigned pack_fp8x4(float a, float b, float c, float d) { int w = __builtin_amdgcn_cvt_pk_fp8_f32(a, b, 0, false); w = __builtin_amdgcn_cvt_pk_fp8_f32(c, d, w, true); return (unsigned)w; }
constexpr size_t V6B_OFF = 8u << 20;
constexpr float U8_SCALE = 64.0f, V8_SCALE = 5.656854f;
constexpr int PA_CAP = 456;
constexpr float X8_SCALE = 2.0f;
typedef int v8i_t __attribute__((ext_vector_type(8)));
typedef _Float16 v32h_t __attribute__((ext_vector_type(32)));
typedef unsigned v6u_t __attribute__((ext_vector_type(6)));
typedef unsigned v2u __attribute__((ext_vector_type(2)));
struct TokB { v8i_t b[8]; };
struct RowsA { const unsigned char* p0; const unsigned char* p1; };
__device__ __forceinline__ int pa_tok(unsigned tl, int tb, int nwg) { return ((tl < 4u) ? tb : nwg) + (int)(tl & 3u); }
__device__ __forceinline__ RowsA pa_rows(int b, int n, int lane, const LAS unsigned* list, const unsigned char* U6) {
    const int i0 = b * 16 + (lane >> 3), r8 = lane >> 3, ps = lane & 7;
    const unsigned e0 = list[i0 < n ? i0 : 0], e1 = list[i0 + 8 < n ? i0 + 8 : 0];
    RowsA R; R.p0 = U6 + (size_t)(e0 & 0x3fffu) * 768 + ((ps ^ r8) * 16); R.p1 = U6 + (size_t)(e1 & 0x3fffu) * 768 + ((ps ^ r8 ^ 1) * 16);
    return R;
}
template <int J> __device__ __forceinline__ void pa_dma(const RowsA& R, LAS unsigned char* ring) {
    __builtin_amdgcn_global_load_lds((const unsigned*)R.p0, (LAS unsigned*)(ring + J * (2048 - 128)), 16, J * 128, 0);
    __builtin_amdgcn_global_load_lds((const unsigned*)R.p1, (LAS unsigned*)(ring + J * (2048 - 128) + 1024), 16, J * 128, 0);
}
#define PA_VWAIT(n) asm volatile("s_waitcnt vmcnt(" #n ")" ::: "memory")
#define PA_LWAIT(n) asm volatile("s_waitcnt lgkmcnt(" #n ")" ::: "memory")
__device__ __forceinline__ int pa_uoff(int u, int r) { return (u >> 4) * 2048 + (r >> 3) * 1024 + (r & 7) * 128 + ((((u >> 1) & 7) ^ (r & 7) ^ (r >> 3)) << 4) + (u & 1) * 8; }
struct OpA { v2u d0, d1, d2; };
__device__ __forceinline__ OpA pa_rd(int m, const LAS unsigned char* ring, int r, int g) { const int u = 12 * m + 3 * g; OpA a;
    a.d0 = *(const LAS v2u*)(ring + pa_uoff(u, r)); a.d1 = *(const LAS v2u*)(ring + pa_uoff(u + 1, r)); a.d2 = *(const LAS v2u*)(ring + pa_uoff(u + 2, r)); return a; }
__device__ __forceinline__ f32x4 pa_mm(f32x4 acc, const OpA& a, const TokB& X, int m) {
    return __builtin_amdgcn_mfma_scale_f32_16x16x128_f8f6f4((v8i_t){(int)a.d0.x, (int)a.d0.y, (int)a.d1.x, (int)a.d1.y, (int)a.d2.x, (int)a.d2.y, 0, 0}, X.b[m], acc, 2, 2, 0, 0, 0, 0);
}
__device__ __forceinline__ void pa_flush(int n, const TokB& X, int lane, LAS unsigned* list, const LAS unsigned* gl, LAS unsigned char* ring, const unsigned char* U6, unsigned* wpk, int tb, int nwg) {
    if (n == 0) return;
    LDS_WAIT(); asm volatile("" ::: "memory");
    const int nb = (n + 15) >> 4;
    const int r = lane & 15, g = lane >> 4;
    RowsA cur = pa_rows(0, n, lane, list, U6), nxt = cur;
    pa_dma<0>(cur, ring); pa_dma<1>(cur, ring); pa_dma<2>(cur, ring); pa_dma<3>(cur, ring); pa_dma<4>(cur, ring); pa_dma<5>(cur, ring);
    for (int b = 0; b < nb; ++b) {
        f32x4 acc0 = {0.f, 0.f, 0.f, 0.f}, acc1 = {0.f, 0.f, 0.f, 0.f};
        OpA A0, A1;
        if (b + 1 < nb) {
            nxt = pa_rows(b + 1, n, lane, list, U6);
            PA_VWAIT(10); A0 = pa_rd(0, ring, r, g);
            PA_VWAIT(8);  A1 = pa_rd(1, ring, r, g); PA_LWAIT(3); acc0 = pa_mm(acc0, A0, X, 0);
            PA_VWAIT(6);  A0 = pa_rd(2, ring, r, g); PA_LWAIT(3); acc1 = pa_mm(acc1, A1, X, 1); pa_dma<0>(nxt, ring);
                          A1 = pa_rd(3, ring, r, g); PA_LWAIT(3); acc0 = pa_mm(acc0, A0, X, 2); pa_dma<1>(nxt, ring);
            PA_VWAIT(8);  A0 = pa_rd(4, ring, r, g); PA_LWAIT(3); acc1 = pa_mm(acc1, A1, X, 3); pa_dma<2>(nxt, ring);
            PA_VWAIT(8);  A1 = pa_rd(5, ring, r, g); PA_LWAIT(3); acc0 = pa_mm(acc0, A0, X, 4);
            PA_VWAIT(6);  A0 = pa_rd(6, ring, r, g); PA_LWAIT(3); acc1 = pa_mm(acc1, A1, X, 5); pa_dma<3>(nxt, ring);
                          A1 = pa_rd(7, ring, r, g); PA_LWAIT(3); acc0 = pa_mm(acc0, A0, X, 6); pa_dma<4>(nxt, ring);
                                                     PA_LWAIT(0); acc1 = pa_mm(acc1, A1, X, 7); pa_dma<5>(nxt, ring);
            cur = nxt;
        } else {
            PA_VWAIT(0);
            A0 = pa_rd(0, ring, r, g);
#pragma unroll
            for (int m = 0; m < 8; m += 2) { A1 = pa_rd(m + 1, ring, r, g); PA_LWAIT(3); acc0 = pa_mm(acc0, A0, X, m);
                if (m + 2 < 8) { A0 = pa_rd(m + 2, ring, r, g); PA_LWAIT(3); } else PA_LWAIT(0);
                acc1 = pa_mm(acc1, A1, X, m + 1); }
        }
        const f32x4 acc = acc0 + acc1;
        const int idx = b * 16 + r; const unsigned ent = list[idx], tl = ent >> 21, slot = (ent >> 14) & 127u;
        const int src = (int)((((unsigned)r >> 2) * 16u + tl) << 2);
        const float v0 = __int_as_float(__builtin_amdgcn_ds_bpermute(src, __float_as_int(acc.x))), v1 = __int_as_float(__builtin_amdgcn_ds_bpermute(src, __float_as_int(acc.y)));
        const float v2 = __int_as_float(__builtin_amdgcn_ds_bpermute(src, __float_as_int(acc.z))), v3 = __int_as_float(__builtin_amdgcn_ds_bpermute(src, __float_as_int(acc.w)));
        const float dv = (r & 2) ? ((r & 1) ? v3 : v2) : ((r & 1) ? v1 : v0);
        if (lane < 16 && idx < n) { const int t = pa_tok(tl, tb, nwg);
            const _Float16 wh = (_Float16)(__uint_as_float(gl[tl * 128 + slot]) * (1.0f / V8_SCALE) * gelu_tanh(dv * (1.0f / (U8_SCALE * X8_SCALE))));
            const unsigned pos = __hip_atomic_fetch_add((LAS unsigned*)(list + PA_CAP) + tl, 1u, __ATOMIC_RELAXED, __HIP_MEMORY_SCOPE_WAVEFRONT);
            wpk[(size_t)t * 128 + pos] = ((unsigned)__builtin_bit_cast(unsigned short, wh) << 16) | (ent & 0x3fffu); }
    }
    LDS_WAIT(); asm volatile("" ::: "memory");
}
__device__ __forceinline__ void peer_a_phase(int lane, int wave, int G, int vcu, const bf16* XG, const unsigned char* U6, const int* ids, const float* gts, const float* rstd1, unsigned* wpk, LAS unsigned char* lds, const float* g2) {
    LAS unsigned char* ring = lds + RING_OFF + wave * 16384;
    LAS unsigned* gl = (LAS unsigned*)(ring + 12288);
    LAS unsigned* list = (LAS unsigned*)(lds + MISC_OFF + 128 + wave * (464 * 4));
    for (int tile0 = vcu; tile0 < MTOK / 32; tile0 += 2 * G) {
        const int tile1 = tile0 + G; const bool has1 = tile1 < MTOK / 32;
        const int tb = tile0 * 32 + wave * 4, nwg = (has1 ? tile1 : tile0) * 32 + wave * 4;
        int id0[8], id1[8];
        if (lane < 8) list[PA_CAP + lane] = 0u;
#pragma unroll
        for (int k = 0; k < 8; ++k) { const bool ok = (k < 4) || has1; const int tc = pa_tok((unsigned)k, tb, nwg);
            gl[k * 128 + lane] = __float_as_uint(gts[(size_t)tc * 128 + lane]); gl[k * 128 + 64 + lane] = __float_as_uint(gts[(size_t)tc * 128 + 64 + lane]);
            id0[k] = ok ? ids[(size_t)tc * 128 + lane] : -1; id1[k] = ok ? ids[(size_t)tc * 128 + 64 + lane] : -1; }
#pragma unroll
        for (int p = 0; p < 4; ++p) { const int k = 2 * p + (lane >> 5), tc = pa_tok((unsigned)k, tb, nwg);
            typedef float v16f_t __attribute__((ext_vector_type(16)));
            const GAS v4u* xs = (const GAS v4u*)(XG + (size_t)tc * 1024 + 32 * (lane & 31));
            const v4u x0 = xs[0], x1 = xs[1], x2 = xs[2], x3 = xs[3];
            const float rs = rstd1[tc] * X8_SCALE;
            const unsigned w[16] = {x0.x, x0.y, x0.z, x0.w, x1.x, x1.y, x1.z, x1.w, x2.x, x2.y, x2.z, x2.w, x3.x, x3.y, x3.z, x3.w};
            float f[32];
#pragma unroll
            for (int i = 0; i < 8; ++i) { const f32x4 gq = *(const GAS f32x4*)(g2 + 32 * (lane & 31) + 4 * i);
                f[4 * i] = __uint_as_float(w[2 * i] << 16) * rs * gq.x; f[4 * i + 1] = __uint_as_float(w[2 * i] & 0xffff0000u) * rs * gq.y;
                f[4 * i + 2] = __uint_as_float(w[2 * i + 1] << 16) * rs * gq.z; f[4 * i + 3] = __uint_as_float(w[2 * i + 1] & 0xffff0000u) * rs * gq.w; }
            const v16f_t lo16 = {f[0], f[1], f[2], f[3], f[4], f[5], f[6], f[7], f[8], f[9], f[10], f[11], f[12], f[13], f[14], f[15]},
                         hi16 = {f[16], f[17], f[18], f[19], f[20], f[21], f[22], f[23], f[24], f[25], f[26], f[27], f[28], f[29], f[30], f[31]};
            v6u_t p6; asm volatile("s_nop 1\n\tv_cvt_scalef32_2xpk16_fp6_f32 %0, %1, %2, 1.0" : "=&v"(p6) : "v"(lo16), "v"(hi16));
            LAS v2u* dst = (LAS v2u*)(ring + k * 768 + 24 * (lane & 31)); dst[0] = (v2u){p6[0], p6[1]}; dst[1] = (v2u){p6[2], p6[3]}; dst[2] = (v2u){p6[4], p6[5]}; }
        LDS_WAIT(); asm volatile("" ::: "memory");
        TokB X;
#pragma unroll
        for (int m = 0; m < 8; ++m) { const LAS v2u* xp = (const LAS v2u*)(ring + (lane & 7) * 768 + m * 96 + (lane >> 4) * 24);
            const v2u d0 = xp[0], d1 = xp[1], d2 = xp[2];
            X.b[m] = (v8i_t){(int)d0.x, (int)d0.y, (int)d1.x, (int)d1.y, (int)d2.x, (int)d2.y, 0, 0}; }
        LDS_WAIT(); asm volatile("" ::: "memory");
        int n = 0;
        for (int part = 0; part < 8; ++part) {
#pragma unroll
            for (int k = 0; k < 8; ++k) {
                { const bool sel = (id0[k] >> 11) == part; const unsigned long long m = __ballot(sel);
                  const int pos = n + (int)__builtin_amdgcn_mbcnt_hi((unsigned)(m >> 32), __builtin_amdgcn_mbcnt_lo((unsigned)m, 0u));
                  if (sel) list[pos] = ((unsigned)k << 21) | ((unsigned)lane << 14) | (unsigned)id0[k]; n += __builtin_popcountll(m); }
                { const bool sel = (id1[k] >> 11) == part; const unsigned long long m = __ballot(sel);
                  const int pos = n + (int)__builtin_amdgcn_mbcnt_hi((unsigned)(m >> 32), __builtin_amdgcn_mbcnt_lo((unsigned)m, 0u));
                  if (sel) list[pos] = ((unsigned)k << 21) | ((unsigned)(64 + lane) << 14) | (unsigned)id1[k]; n += __builtin_popcountll(m); }
                if (n > PA_CAP - 128) { pa_flush(n, X, lane, list, gl, ring, U6, wpk, tb, nwg); n = 0; }
            }
        }
        pa_flush(n, X, lane, list, gl, ring, U6, wpk, tb, nwg);
    }
}
template <int NT> __device__ __forceinline__ void final_tokens(const int (&t)[NT], int lane, const unsigned short* Y16, const bf16* X1b, float* OUT, const float* fg) {
    v4u xa[NT], xb[NT], ya[NT], yb[NT];
#pragma unroll
    for (int n = 0; n < NT; ++n) { xa[n] = *(const GAS v4u*)(X1b + (size_t)t[n] * 1024 + 8 * lane); xb[n] = *(const GAS v4u*)(X1b + (size_t)t[n] * 1024 + 512 + 8 * lane);
        ya[n] = *(const GAS v4u*)(Y16 + (size_t)t[n] * 1024 + 8 * lane); yb[n] = *(const GAS v4u*)(Y16 + (size_t)t[n] * 1024 + 512 + 8 * lane); }
    const GAS f32x4* gp = (const GAS f32x4*)(fg + 8 * lane); const f32x4 g0 = gp[0], g1 = gp[1], g2 = gp[128], g3 = gp[129];
#pragma unroll
    for (int n = 0; n < NT; ++n) {
        const unsigned yw[8] = {ya[n].x, ya[n].y, ya[n].z, ya[n].w, yb[n].x, yb[n].y, yb[n].z, yb[n].w};
        float y[16];
#pragma unroll
        for (int i = 0; i < 8; ++i) { const unsigned w = yw[i]; const h2_t h = __builtin_bit_cast(h2_t, w); y[2 * i] = (float)h[0]; y[2 * i + 1] = (float)h[1]; }
        const unsigned xw[8] = {xa[n].x, xa[n].y, xa[n].z, xa[n].w, xb[n].x, xb[n].y, xb[n].z, xb[n].w};
        float xv[16];
#pragma unroll
        for (int i = 0; i < 8; ++i) { xv[2 * i] = __uint_as_float(xw[i] << 16); xv[2 * i + 1] = __uint_as_float(xw[i] & 0xffff0000u); }
        const f32x4 a0 = (f32x4){xv[0] + y[0], xv[1] + y[1], xv[2] + y[2], xv[3] + y[3]}, a1 = (f32x4){xv[4] + y[4], xv[5] + y[5], xv[6] + y[6], xv[7] + y[7]},
                    a2 = (f32x4){xv[8] + y[8], xv[9] + y[9], xv[10] + y[10], xv[11] + y[11]}, a3 = (f32x4){xv[12] + y[12], xv[13] + y[13], xv[14] + y[14], xv[15] + y[15]};
        const float ss = (a0.x * a0.x + a0.y * a0.y) + (a0.z * a0.z + a0.w * a0.w) + (a1.x * a1.x + a1.y * a1.y) + (a1.z * a1.z + a1.w * a1.w)
                       + (a2.x * a2.x + a2.y * a2.y) + (a2.z * a2.z + a2.w * a2.w) + (a3.x * a3.x + a3.y * a3.y) + (a3.z * a3.z + a3.w * a3.w);
        const float rstd2 = 1.0f / sqrtf(wave_sum(ss) * (1.f / DMODEL) + RMS_EPS);
        GAS f32x4* xo = (GAS f32x4*)(OUT + (size_t)t[n] * 1024 + 8 * lane);
        xo[0] = a0 * rstd2 * g0; xo[1] = a1 * rstd2 * g1; xo[128] = a2 * rstd2 * g2; xo[129] = a3 * rstd2 * g3; }
}
#ifndef REP_0
#define REP_0 1
#endif
#ifndef REP_1
#define REP_1 1
#endif
#ifndef REP_2
#define REP_2 1
#endif
#ifndef REP_3
#define REP_3 1
#endif
#ifndef REP_4
#define REP_4 1
#endif
#ifndef REP_5
#define REP_5 1
#endif
#ifndef REP_6
#define REP_6 1
#endif
#ifndef REP_7
#define REP_7 1
#endif
#ifndef REP_8
#define REP_8 1
#endif
#ifndef REP_9
#define REP_9 1
#endif
#ifndef REP_10
#define REP_10 1
#endif
#ifndef REP_11
#define REP_11 1
#endif
__device__ __forceinline__ void pb_rows(v4u* Ra, v2u* Rb, const v4u w, const unsigned char* vbase, size_t vboff) {
    const unsigned pw[4] = {w.x, w.y, w.z, w.w};
#pragma unroll
    for (int i = 0; i < 4; ++i) { const size_t e = pw[i] & 0xffffu; Ra[i] = *(const GAS v4u*)(vbase + e * 256); Rb[i] = *(const GAS v2u*)(vbase + vboff + e * 128); }
}
__device__ __forceinline__ void pb_fma(h2_t (&acc)[16], const v4u* Ra, const v2u* Rb, const v4u w) {
    const unsigned pw[4] = {w.x, w.y, w.z, w.w};
#pragma unroll
    for (int i = 0; i < 4; ++i) { const unsigned p = pw[i]; const h2_t pp = __builtin_bit_cast(h2_t, p); const _Float16 wv = pp[1]; const h2_t w2 = {wv, wv};
        const v4u ra = Ra[i]; const v2u rb = Rb[i]; const v6u_t x6 = {ra.x, ra.y, ra.z, ra.w, rb.x, rb.y};
        v32h_t h; asm("v_cvt_scalef32_pk32_f16_fp6 %0, %1, 1.0" : "=&v"(h) : "v"(x6));
#pragma unroll
        for (int j = 0; j < 16; ++j) { const h2_t hv = {h[2 * j], h[2 * j + 1]}; acc[j] = __builtin_elementwise_fma(hv, w2, acc[j]); } }
}
__device__ __forceinline__ void peer_b_phase(int lane, int wave, int G, int vcu, const unsigned char* V6s, const unsigned* wpk, unsigned short* Y16, const bf16* X1b, float* OUT, const float* fg, bool fin) {
    const int q = lane & 15;
    for (int tile0 = vcu; tile0 < MTOK / 32; tile0 += 2 * G) {
        const int tile1 = tile0 + G; const bool has1 = tile1 < MTOK / 32;
        const int tb = tile0 * 32 + wave * 4, nwg = (has1 ? tile1 : tile0) * 32 + wave * 4;
        for (int pass = 0; pass < 4; ++pass) { const int hc = pass >> 1, k = (lane >> 4) + 4 * (pass & 1);
            const int t = pa_tok((unsigned)k, tb, nwg);
            const unsigned* wrow = wpk + (size_t)t * 128;
            const unsigned char* vbase = V6s + (size_t)hc * NEXP * 256 + q * 16;
            const size_t vboff = V6B_OFF + (size_t)hc * NEXP * 128 + q * 8 - ((size_t)hc * NEXP * 256 + q * 16);
            h2_t acc[16];
#pragma unroll
            for (int j = 0; j < 16; ++j) acc[j] = (h2_t){(_Float16)0.f, (_Float16)0.f};
            v4u W[6], Ra[16]; v2u Rb[16];
#pragma unroll
            for (int u = 0; u < 6; ++u) W[u] = *(const GAS v4u*)(wrow + 4 * u);
#pragma unroll
            for (int u = 0; u < 4; ++u) pb_rows(Ra + 4 * u, Rb + 4 * u, W[u], vbase, vboff);
#pragma unroll
            for (int u = 0; u < 32; ++u) {
                pb_fma(acc, Ra + 4 * (u & 3), Rb + 4 * (u & 3), W[u % 6]);
                if (u + 4 < 32) pb_rows(Ra + 4 * (u & 3), Rb + 4 * (u & 3), W[(u + 4) % 6], vbase, vboff);
                if (u + 6 < 32) W[u % 6] = *(const GAS v4u*)(wrow + 4 * (u + 6));
            }
            GAS v4u* yout = (GAS v4u*)(Y16 + (size_t)t * 1024 + hc * 512 + q * 32);
#pragma unroll
            for (int j = 0; j < 4; ++j) yout[j] = (v4u){__builtin_bit_cast(unsigned, acc[4 * j]), __builtin_bit_cast(unsigned, acc[4 * j + 1]), __builtin_bit_cast(unsigned, acc[4 * j + 2]), __builtin_bit_cast(unsigned, acc[4 * j + 3])};
        }
        asm volatile("s_waitcnt vmcnt(0)" ::: "memory");
        if (fin) { const int ta[4] = {tb, tb + 1, tb + 2, tb + 3}; final_tokens<4>(ta, lane, Y16, X1b, OUT, fg);
            if (has1) { const int tc[4] = {nwg, nwg + 1, nwg + 2, nwg + 3}; final_tokens<4>(tc, lane, Y16, X1b, OUT, fg); } }
    }
}
template <int NR> __device__ __forceinline__ void cvt_load(f32x4 (&q)[NR / 2][8], const float* table, int ex, int stride, int lane) {
#pragma unroll
    for (int k = 0; k < NR / 2; ++k) { const int e = ex + (2 * k + (lane >> 5)) * stride; const float* src = table + (size_t)(e < NEXP ? e : ex) * 1024 + 32 * (lane & 31);
#pragma unroll
        for (int j = 0; j < 8; ++j) q[k][j] = *(const GAS f32x4*)(src + 4 * j); }
}
template <int NR> __device__ __forceinline__ void cvt_store(const f32x4 (&q)[NR / 2][8], int ex, int stride, bool isv, int lane, unsigned char* U8, unsigned char* V8) {
    typedef float v16f_t __attribute__((ext_vector_type(16)));
#pragma unroll
    for (int k = 0; k < NR / 2; ++k) { const int e = ex + (2 * k + (lane >> 5)) * stride; if (e < NEXP) {
        if (!isv) {
            float f[32];
#pragma unroll
            for (int j = 0; j < 8; ++j) { const f32x4 t = q[k][j] * U8_SCALE; f[4 * j] = t.x; f[4 * j + 1] = t.y; f[4 * j + 2] = t.z; f[4 * j + 3] = t.w; }
            const v16f_t lo16 = {f[0], f[1], f[2], f[3], f[4], f[5], f[6], f[7], f[8], f[9], f[10], f[11], f[12], f[13], f[14], f[15]},
                         hi16 = {f[16], f[17], f[18], f[19], f[20], f[21], f[22], f[23], f[24], f[25], f[26], f[27], f[28], f[29], f[30], f[31]};
            v6u_t p6; asm volatile("s_nop 1\n\tv_cvt_scalef32_2xpk16_fp6_f32 %0, %1, %2, 1.0" : "=&v"(p6) : "v"(lo16), "v"(hi16));
            GAS v2u* dst = (GAS v2u*)(U8 + (size_t)e * 768 + 24 * (lane & 31)); dst[0] = (v2u){p6[0], p6[1]}; dst[1] = (v2u){p6[2], p6[3]}; dst[2] = (v2u){p6[4], p6[5]};
        } else {
            v32h_t h;
#pragma unroll
            for (int j = 0; j < 8; ++j) { const f32x4 t = q[k][j] * V8_SCALE; h[4 * j] = (_Float16)t.x; h[4 * j + 1] = (_Float16)t.y; h[4 * j + 2] = (_Float16)t.z; h[4 * j + 3] = (_Float16)t.w; }
            v6u_t p6; asm volatile("s_nop 1\n\tv_cvt_scalef32_pk32_fp6_f16 %0, %1, 1.0" : "=&v"(p6) : "v"(h));
            const size_t ro = (size_t)((lane & 31) >> 4) * NEXP + e;
            *(GAS v4u*)(V8 + ro * 256 + (lane & 15) * 16) = (v4u){p6[0], p6[1], p6[2], p6[3]}; *(GAS v2u*)(V8 + V6B_OFF + ro * 128 + (lane & 15) * 8) = (v2u){p6[4], p6[5]}; } } }
}
struct OnePanel { int pm, n; __device__ __forceinline__ bool next(int i, pg8::Unit& u) const { if (i >= n) return false; u.pm = pm; u.pn = i; u.w = 0; return true; } };
struct DualOrder { pg8::StaticOrder S; __device__ __forceinline__ bool next(int i, pg8::Unit& u) const { if (!S.next(i >> 1, u)) return false; u.w = i & 1; return true; } };
struct Args { const float* in[24]; float* out; unsigned char* ws; int ph_lo, ph_hi, li, pad; };
__global__ void __launch_bounds__(NWAVES * 64, 2) mk_fwd(Args args) {
    extern __shared__ __attribute__((aligned(16))) unsigned char lds[];
    Frame F;
    F.lds = (LAS unsigned char*)lds;
    volatile LAS unsigned* MISC = (volatile LAS unsigned*)(F.lds + MISC_OFF);
    F.tid = threadIdx.x; F.lane = F.tid & 63; F.wave = __builtin_amdgcn_readfirstlane(F.tid >> 6);
    F.G = gridDim.x; { const int bx = blockIdx.x; F.vcu = (F.G % 8 == 0) ? (bx % 8) * (F.G / 8) + bx / 8 : bx; }
    unsigned char* ws = args.ws;
    gu32* ctl = (gu32*)(ws + WS_CTL);
    for (int u = F.tid; u < (LDS_BYTES - LDSCTL_OFF) / 4; u += NWAVES * 64) ((LAS unsigned*)(F.lds + LDSCTL_OFF))[u] = 0u;
    __syncthreads();
    XcdBarrier bar; bar.bar = (unsigned*)(ctl + CW_BAR); bar.x = 0; bar.st = nullptr;
    if (N_LAUNCHES != PER_PHASE) bar = xcd_barrier_post((unsigned*)(ctl + CW_BAR), MISC + 8);
#define GRID_BAR() do { if (N_LAUNCHES != PER_PHASE) xcd_barrier(bar); } while (0)
    const int lo = args.ph_lo, hi = args.ph_hi;
#ifndef PH_MASK
#define PH_MASK 0xFFFF
#endif
#define IN(k) ((((PH_MASK) >> (k)) & 1) && lo <= (k) && (k) < hi)
#define BOTH(k) (IN(k) && IN((k) + 1))
    const int gw = F.vcu * NWAVES + F.wave, NGW = F.G * NWAVES;
    const int gtid = F.vcu * (NWAVES * 64) + F.tid, NTHR = F.G * NWAVES * 64;
    const float* x = args.in[0];
    bf16* Win_t = (bf16*)(ws + WS_WIN); bf16* Wq_t = (bf16*)(ws + WS_WQ); bf16* Wout_t = (bf16*)(ws + WS_WOUT); bf16* Wus_t = (bf16*)(ws + WS_WUS); bf16* Wua_t = (bf16*)(ws + WS_WUA);
    bf16* Wglu_t = (bf16*)(ws + WS_WGLU); bf16* KSb = (bf16*)(ws + WS_KS); bf16* WE = (bf16*)(ws + WS_WE); bf16* BP = (bf16*)(ws + WS_BP); bf16* AP = (bf16*)(ws + WS_AP);
    float* Eb = (float*)(ws + WS_E); bf16* Hb = (bf16*)(ws + WS_H); bf16* Ypre = (bf16*)(ws + WS_YPRE); bf16* Ya = (bf16*)(ws + WS_YA); bf16* XG = (bf16*)(ws + WS_XG);
    bf16* Zb = (bf16*)(ws + WS_Z); bf16* Qb = (bf16*)(ws + WS_Z + 1 * ZSTRIDE_B); bf16* Kb = (bf16*)(ws + WS_Z + 2 * ZSTRIDE_B); bf16* Vb = (bf16*)(ws + WS_Z + 3 * ZSTRIDE_B);
    bf16* GA = (bf16*)(ws + WS_Z + 4 * ZSTRIDE_B); bf16* GB = (bf16*)(ws + WS_Z + 6 * ZSTRIDE_B);
    bf16* Yb = (bf16*)(ws + WS_YB); bf16* Mrg = (bf16*)(ws + WS_MRG); bf16* PQb = (bf16*)(ws + WS_PQ); int* ids = (int*)(ws + WS_IDS); float* gts = (float*)(ws + WS_GTS);
    unsigned char* U8 = ws + WS_U16; unsigned char* V8 = ws + WS_V16; unsigned* wpk = (unsigned*)(ws + WS_WPK); float* rstd1 = (float*)(ws + WS_RSTD1); unsigned short* Y16 = (unsigned short*)(ws + WS_Y16);
    float* biasT = (float*)(ws + WS_BIAS); float* pw32 = (float*)(ws + WS_PW32); float* kpart = (float*)(ws + WS_KPART); float* Kg = (float*)(ws + WS_KG); float* ssq1 = (float*)(ws + WS_SSQ1);

    if (IN(0)) for (int rep_ = 0; rep_ < REP_0; ++rep_) {
        LAS float* scr = (LAS float*)(F.lds + RING_OFF + F.wave * 16384);
        constexpr int I_IN = (1024 / 64) * (4096 / 32), I_GLU = (512 / 64) * (512 / 32), I_UP = (512 / 64) * (1024 / 32), I_OUT = (1024 / 64) * (1024 / 32), I_Q = (1024 / 64) * (2048 / 32);
        constexpr int NITEMS = I_IN + I_GLU + 2 * I_UP + I_OUT + I_Q;
        for (int it = gw; it < NITEMS; it += NGW) {
            int r = it;
            if (r < I_IN) { p0_transpose_item(args.in[2], 1024, 4096, Win_t, scr, r, F.lane); continue; } r -= I_IN;
            if (r < I_GLU) { p0_transpose_item(args.in[11], 512, 512, Wglu_t, scr, r, F.lane); continue; } r -= I_GLU;
            if (r < I_UP) { p0_transpose_item(args.in[13], 512, 1024, Wus_t, scr, r, F.lane); continue; } r -= I_UP;
            if (r < I_UP) { p0_transpose_item(args.in[14], 512, 1024, Wua_t, scr, r, F.lane); continue; } r -= I_UP;
            if (r < I_OUT) { p0_transpose_item(args.in[16], 1024, 1024, Wout_t, scr, r, F.lane); continue; } r -= I_OUT;
            p0_transpose_item(args.in[18], 1024, 2048, Wq_t, scr, r, F.lane, args.in[17]);
        }
        for (int it = gw; it < NGRP * CH; it += NGW)
            ssm_table_task(it >> 5, it & 31, F.lane, scr, args.in[3], args.in[4], args.in[5], args.in[6], args.in[7], args.in[8], args.in[9], Kg, WE, BP, pw32);
        for (int m = gw; m < MTOK; m += NGW * 4) rms_rows4_to_bf16(x, args.in[1], Hb, m, NGW, F.lane);
        for (int it = gw; it < 64; it += NGW) { const float* src = (it < 32 ? args.in[19] : args.in[20]) + (size_t)(it & 31) * 512 + 8 * F.lane;
            const f32x4 a = *(const GAS f32x4*)src, b = *(const GAS f32x4*)(src + 4);
            *(GAS v4u*)(KSb + (size_t)it * 512 + 8 * F.lane) = (v4u){pk2(a.x, a.y), pk2(a.z, a.w), pk2(b.x, b.y), pk2(b.z, b.w)}; }
        if (gw == 0) { for (int i = F.lane; i < 8 * 128; i += 64) { const int h = i >> 7, rel = i & 127; int bk;
                if (rel < 16) bk = rel; else { const float lg = logf((float)rel / 16.0f) / 2.0794415416798357f * 16.0f; bk = 16 + (int)lg; bk = bk < 0 ? 0 : (bk > 31 ? 31 : bk); }
                biasT[i] = (args.in[15][bk * 8 + h] - args.in[15][31 * 8 + h]) * 1.4426950408889634f; } }
        if (BOTH(0)) GRID_BAR();
    }

    if (IN(1)) for (int rep_ = 0; rep_ < REP_1; ++rep_) {
        const float* Dsk = args.in[10];
        for (int i0 = gtid; i0 < NGRP * 512 * 64; i0 += NTHR * 4) {
            f32x4 ka[4], kb[4];
#pragma unroll
            for (int q = 0; q < 4; ++q) { const int i = i0 + q * NTHR; const int ic = (i < NGRP * 512 * 64) ? i : i0; const int g = ic >> 15, m = (ic >> 6) & 511, k8 = ic & 63, j = m >> 4, ho = m & 15, jp = k8 >> 1, hi0 = (k8 & 1) * 8;
                const int lag = (jp <= j) ? j - jp : 0; const float* kp = Kg + ((size_t)(g * 32 + lag) * 256 + ho * 16 + hi0); ka[q] = *(const GAS f32x4*)kp; kb[q] = *(const GAS f32x4*)(kp + 4); }
#pragma unroll
            for (int q = 0; q < 4; ++q) { const int i = i0 + q * NTHR; if (i >= NGRP * 512 * 64) break; const int g = i >> 15, m = (i >> 6) & 511, k8 = i & 63, j = m >> 4, ho = m & 15, jp = k8 >> 1, hi0 = (k8 & 1) * 8;
                v4u o = (v4u){0u, 0u, 0u, 0u};
                if (jp <= j) { f32x4 a = ka[q], b = kb[q];
                    if (jp == j && (ho >> 3) == (hi0 >> 3)) { const float dv = Dsk[g * 16 + ho]; const int e = ho & 7;
                        a.x += (e == 0) ? dv : 0.f; a.y += (e == 1) ? dv : 0.f; a.z += (e == 2) ? dv : 0.f; a.w += (e == 3) ? dv : 0.f;
                        b.x += (e == 4) ? dv : 0.f; b.y += (e == 5) ? dv : 0.f; b.z += (e == 6) ? dv : 0.f; b.w += (e == 7) ? dv : 0.f; }
                    o = (v4u){pk2(a.x, a.y), pk2(a.z, a.w), pk2(b.x, b.y), pk2(b.z, b.w)}; }
                *(GAS v4u*)(BP + ((size_t)(g * 512 + m) * APK + k8 * 8)) = o; } }
        pg8::Gemm g{Hb, Win_t, MTOK, INCOLS, 1024, 1024, 1024, 1 << 30, 0};
        pg8::StaticOrder S; S.init(MTOK, INCOLS, F.G, (int)blockIdx.x);
        pg8::EpiIn E{Zb, AP, kpart};
        pg8::gemm_phase<pg8::EpiIn, pg8::StaticOrder, true>(F.lds + RING_OFF, g, S, E);
        if (BOTH(1)) GRID_BAR();
    }

    if (IN(2)) for (int rep_ = 0; rep_ < REP_2; ++rep_) {
        const int bx = (int)blockIdx.x;
        const bool shared = F.G < 4;
        const int nS = shared ? F.G : (F.G >= 256 ? 64 : F.G / 4), nA = shared ? F.G : F.G - nS;
        const bool inS = shared || bx < nS, inA = shared || bx >= nS; const int aidx = shared ? bx : bx - nS;
        if (inS) {
#pragma unroll 1
            for (int pm = bx; pm < MTOK / 256; pm += nS) {
                { pg8::Gemm g1{AP, WE, MTOK, 256, 512, APK, 512, 2, (size_t)256 * 512}; OnePanel S1{pm, 1}; pg8::EpiE E1{Eb};
                  pg8::gemm_phase<pg8::EpiE, OnePanel, true>(F.lds + RING_OFF, g1, S1, E1); }
                VM_WAIT(); __syncthreads();
                if (F.tid < 256) { const int gb = (pm >> 1) * 8 + (pm & 1) * 4 + (F.tid >> 6), g_ = gb >> 3, p = F.tid & 63; const size_t row0 = (size_t)gb * 64;
                    const float mr = pw32[g_ * 128 + p], mi = pw32[g_ * 128 + 64 + p]; float sr = 0.f, si = 0.f;
#pragma unroll 1
                    for (int c0 = 0; c0 < NCHUNK; c0 += 32) { float er[32], ei[32];
#pragma unroll
                        for (int c = 0; c < 32; ++c) { er[c] = Eb[(row0 + c0 + c) * 128 + p]; ei[c] = Eb[(row0 + c0 + c) * 128 + 64 + p]; }
#pragma unroll
                        for (int c = 0; c < 32; ++c) { bf16* ap = AP + (row0 + c0 + c) * APK + 512; ap[p] = (bf16)f2bf(sr); ap[64 + p] = (bf16)f2bf(si);
                            const float nr = mr * sr - mi * si + er[c], ni = mr * si + mi * sr + ei[c]; sr = nr; si = ni; } } }
                VM_WAIT(); __syncthreads();
                { pg8::Gemm g{AP, BP, MTOK, 512, APK, APK, APK, 2, (size_t)512 * APK}; OnePanel S3{pm, 2}; pg8::EpiY E{Ypre};
                  pg8::gemm_phase<pg8::EpiY, OnePanel, true>(F.lds + RING_OFF, g, S3, E); }
            }
        }
        if (inA) {
            static_assert(attn_body::ATTN_LDS_BYTES <= RING_BYTES, "attention LDS");
#pragma unroll 1
            for (int a = aidx; a < 192; a += nA) { const int ty = a >> 6, bh = a & 63;
#pragma unroll 1
                for (int i = 0; i < 4; ++i) { const int qb = (ty == 0) ? (i == 0 ? 7 : (i == 1 ? 2 : (i == 2 ? 0 : -1))) : (ty == 1) ? (i == 0 ? 6 : (i == 1 ? 4 : -1)) : (i == 0 ? 5 : (i == 1 ? 3 : (i == 2 ? 1 : -1)));
                    if (qb < 0) break;
                    attn_body::attn_unit<8>(bh >> 3, bh & 7, qb, (const attn_body::bf16*)Qb, (const attn_body::bf16*)Kb, (const attn_body::bf16*)Vb, (attn_body::bf16*)Yb, (char*)lds + RING_OFF, kpart, biasT); } }
        }
        if (BOTH(2)) GRID_BAR();
    }

    if (IN(3)) for (int rep_ = 0; rep_ < REP_3; ++rep_) {
        pg8::Gemm g{Ypre, Wglu_t, MTOK, 512, 512, 512, 512, 1 << 30, 0};
        pg8::StaticOrder S; S.init(MTOK, 512, F.G, (int)blockIdx.x);
        pg8::EpiGlu E{Ypre, Ya, args.in[12]};
        pg8::gemm_phase<pg8::EpiGlu, pg8::StaticOrder, true>(F.lds + RING_OFF, g, S, E);
        { const int nun = (MTOK / 256) * (512 / 256);
          const bool split = F.G >= 2 * nun; const int nconv = split ? nun : F.G, cidx = split ? ((int)blockIdx.x % nun) : (int)blockIdx.x;
          const int stride = nconv * NWAVES, step = stride * 4, ex0 = cidx * NWAVES + F.wave;
          const int ncall = (NEXP - ex0 + step - 1) / step;
          int c_lo = 0, c_hi = 2 * ncall;
          if (split) { const int cut = (2 * ncall * 3) / 4; if ((int)blockIdx.x < nun) c_lo = cut; else if ((int)blockIdx.x < 2 * nun) c_hi = cut; else c_hi = 0; }
          f32x4 qa[2][8], qb[2][8];
#define CV_TAB(c) ((c) < ncall ? args.in[21] : args.in[22])
#define CV_EX(c) (ex0 + ((c) < ncall ? (c) : (c) - ncall) * step)
          if (c_lo < c_hi) cvt_load<4>(qa, CV_TAB(c_lo), CV_EX(c_lo), stride, F.lane);
          for (int c = c_lo; c < c_hi; c += 2) {
              if (c + 1 < c_hi) cvt_load<4>(qb, CV_TAB(c + 1), CV_EX(c + 1), stride, F.lane);
              cvt_store<4>(qa, CV_EX(c), stride, c >= ncall, F.lane, U8, V8);
              if (c + 2 < c_hi) cvt_load<4>(qa, CV_TAB(c + 2), CV_EX(c + 2), stride, F.lane);
              if (c + 1 < c_hi) cvt_store<4>(qb, CV_EX(c + 1), stride, c + 1 >= ncall, F.lane, U8, V8);
          } }
#undef CV_TAB
#undef CV_EX
        if (BOTH(3)) GRID_BAR();
    }

    if (IN(4)) for (int rep_ = 0; rep_ < REP_4; ++rep_) {
        pg8::Gemm g{Ya, Wus_t, MTOK, 1024, 512, 512, 512, 1 << 30, 0, Yb, Wua_t};
        DualOrder S; S.S.init(MTOK, 1024, F.G, (int)blockIdx.x);
        pg8::EpiMrgDual E{pg8::EpiMrg<0>{GA, Mrg}, pg8::EpiMrg<1>{GB, Mrg}};
        pg8::gemm_phase<pg8::EpiMrgDual, DualOrder, true>(F.lds + RING_OFF, g, S, E);
        if (BOTH(4)) GRID_BAR();
    }

    if (IN(5)) for (int rep_ = 0; rep_ < REP_5; ++rep_) {
        pg8::Gemm g{Mrg, Wout_t, MTOK, 1024, 1024, 1024, 1024, 1 << 30, 0}; pg8::StaticOrder S; S.init(MTOK, 1024, F.G, (int)blockIdx.x);
        pg8::EpiX1 E{x, args.out, XG, args.in[17], ssq1};
        pg8::gemm_phase<pg8::EpiX1, pg8::StaticOrder, true>(F.lds + RING_OFF, g, S, E);
        if (BOTH(5)) GRID_BAR();
    }

    if (IN(6)) for (int rep_ = 0; rep_ < REP_6; ++rep_) {
        pg8::Gemm g{XG, Wq_t, MTOK, PQ, 1024, 1024, 1024, 1 << 30, 0}; pg8::StaticOrder S; S.init(MTOK, PQ, F.G, (int)blockIdx.x);
        pg8::EpiPlain E{PQb, PQ};
        pg8::gemm_phase<pg8::EpiPlain, pg8::StaticOrder, true>(F.lds + RING_OFF, g, S, E);
        if (BOTH(6)) GRID_BAR();
    }

    if (IN(7)) for (int rep_ = 0; rep_ < REP_7; ++rep_) {
        LAS unsigned char* scr = F.lds + RING_OFF + F.wave * 2048;
        LAS unsigned char* ksl = F.lds + RING_OFF + 16384;
        for (int c = F.tid; c < 256 * 16; c += NWAVES * 64) { const int row = c >> 4, ch = c & 15; *(LAS v4u*)(ksl + row * 256 + ((ch ^ (row & 15)) << 4)) = *(const GAS v4u*)(KSb + row * 128 + ch * 8); }
        __syncthreads();
        for (int it = gw; it < (MTOK / 32) * 8; it += NGW) topk_task(it >> 3, it & 7, F.lane, scr, PQb, ksl, ssq1, ids, gts, rstd1);
        if (BOTH(7)) { VM_WAIT(); __syncthreads(); }
    }

    if (IN(8)) for (int rep_ = 0; rep_ < REP_8; ++rep_) {
        peer_a_phase(F.lane, F.wave, F.G, F.vcu, XG, U8, ids, gts, rstd1, wpk, F.lds, args.in[17]);
        if (BOTH(8)) VM_WAIT();
    }
    if (IN(9)) for (int rep_ = 0; rep_ < REP_9; ++rep_) {
        peer_b_phase(F.lane, F.wave, F.G, F.vcu, V8, wpk, Y16, XG, args.out, args.in[23], rep_ == REP_9 - 1);
    }
#undef IN
#undef BOTH
#undef GRID_BAR
}

extern "C" void kernel_launch(void* const* d_in, const int* in_sizes, int n_in, void* d_out, int out_size, void* d_ws, size_t ws_size, hipStream_t stream) {
    static int grid = 0;
    if (grid == 0) {
        if (n_in != 24 || in_sizes[0] != MTOK * DMODEL || out_size != MTOK * DMODEL || ws_size < WS_END) { fprintf(stderr, "kernel_launch: unexpected shapes (n_in %d, in0 %d, out %d, ws %zu); nothing launched\n", n_in, n_in > 0 ? in_sizes[0] : -1, out_size, ws_size); grid = -1; return; }
        int dev = 0, cus = 0, per_cu = 0;
        if (hipGetDevice(&dev) != hipSuccess || hipDeviceGetAttribute(&cus, hipDeviceAttributeMultiprocessorCount, dev) != hipSuccess) { grid = -1; return; }
        if (hipFuncSetAttribute((const void*)mk_fwd, hipFuncAttributeMaxDynamicSharedMemorySize, LDS_BYTES) != hipSuccess) { fprintf(stderr, "kernel_launch: hipFuncSetAttribute failed\n"); grid = -1; return; }
        if (hipOccupancyMaxActiveBlocksPerMultiprocessor(&per_cu, (const void*)mk_fwd, NWAVES * 64, LDS_BYTES) != hipSuccess || per_cu < 1) { fprintf(stderr, "kernel_launch: occupancy query says %d blocks per CU\n", per_cu); }
        (void)hipGetLastError();
        grid = cus;
    }
    if (grid < 0) return;
    if (N_LAUNCHES != PER_PHASE) { if (hipMemsetAsync((char*)d_ws + WS_CTL, 0, CTL_ZERO_BYTES, stream) != hipSuccess) return; }
    Args a{};
    for (int i = 0; i < 24; ++i) a.in[i] = (const float*)d_in[i];
    a.out = (float*)d_out; a.ws = (unsigned char*)d_ws; a.pad = 0;
    if (N_LAUNCHES == PER_PHASE) {
        for (int li = 0; li < PER_PHASE; ++li) { a.ph_lo = li; a.ph_hi = li + 1; a.li = li; hipLaunchKernelGGL(mk_fwd, dim3(grid), dim3(NWAVES * 64), LDS_BYTES, stream, a); }
    } else {
        a.ph_lo = 0; a.ph_hi = PER_PHASE; a.li = 0;
        hipLaunchKernelGGL(mk_fwd, dim3(grid), dim3(NWAVES * 64), LDS_BYTES, stream, a);
    }
}
```

```cpp
#include <hip/hip_runtime.h>
#include <hip/hip_bf16.h>
#include <cstdio>
#include <cstdint>
#include <cmath>

#ifndef MK_N_LAUNCHES
#define MK_N_LAUNCHES 1
#endif

namespace pg8 {
#define PG8_LAS __attribute__((address_space(3)))
typedef unsigned short bf16_t;
typedef short bf16x8 __attribute__((ext_vector_type(8)));
typedef float f32x4 __attribute__((ext_vector_type(4)));
typedef unsigned u32x4 __attribute__((ext_vector_type(4)));
constexpr int BM = 256, BK = 64, HALF = 128, HTB = HALF * BK * 2, STAGE_BYTES = 8 * HTB, NXCD = 8, WGM = 8;

__host__ __device__ __forceinline__ int lds_byte(int r, int c) { const int st = (r >> 4) * 2 + (c >> 5), rr = r & 15, cc = c & 31, ob = rr * 64 + cc * 2; return st * 1024 + (ob ^ (((ob >> 9) & 1) << 5)); }
__host__ __device__ __forceinline__ void stage_rc(int b, int& R, int& C) { const int st = b / 1024, sb = b % 1024, swz = sb ^ (((sb >> 9) & 1) << 5); R = (st >> 1) * 16 + swz / 64; C = (st & 1) * 32 + (swz % 64) / 2; }
__host__ __device__ __forceinline__ int perm32(int rho) { const int n = rho >> 4, i = rho & 15; return 8 * (i >> 2) + 4 * n + (i & 3); }

struct Unit { int pm, pn, w; };
struct Gemm { const bf16_t* A; const bf16_t* Bt; int M, N, K, lda, ldb, rpg; size_t bgs; const bf16_t* A2 = nullptr; const bf16_t* Bt2 = nullptr; };

struct StaticOrder {
    int nM, nN, nwg, G, c;
    __host__ __device__ __forceinline__ void init(int M, int N, int G_, int c_) { nM = M / BM; nN = N / BM; nwg = nM * nN; G = G_; c = c_; }
    __host__ __device__ __forceinline__ bool next(int i, Unit& u) const {
        const long L = (long)i * G + c; if (L >= nwg) return false;
        int wgid = (int)L; { const int q = nwg / NXCD, r = nwg % NXCD, xcd = wgid % NXCD, off = wgid / NXCD; wgid = (xcd < r ? xcd * (q + 1) : r * (q + 1) + (xcd - r) * q) + off; }
        const int nig = WGM * nN, gid = wgid / nig, fm = gid * WGM, gsz = (nM - fm) < WGM ? (nM - fm) : WGM;
        u.pm = fm + ((wgid % nig) % gsz); u.pn = (wgid % nig) / gsz; u.w = 0; return true;
    }
};

__device__ __forceinline__ unsigned cvt_pk_bf16(float lo, float hi) { unsigned r; asm volatile("v_cvt_pk_bf16_f32 %0, %1, %2" : "=v"(r) : "v"(lo), "v"(hi)); return r; }
__device__ __forceinline__ float bf_lo(unsigned w) { return __uint_as_float(w << 16); }
__device__ __forceinline__ float bf_hi(unsigned w) { return __uint_as_float(w & 0xffff0000u); }
__device__ __forceinline__ float sigmoid_f(float x) { return __builtin_amdgcn_rcpf(1.0f + __builtin_amdgcn_exp2f(-1.4426950409f * x)); }
__device__ __forceinline__ float gelu_tanh(float x) { const float u = x + 0.044715f * x * x * x; return x * __builtin_amdgcn_rcpf(1.0f + __builtin_amdgcn_exp2f(-2.3022081985f * u)); }

template <class Epi, class Sched, bool ALIGN_EPI>
__device__ __forceinline__ void gemm_phase(PG8_LAS unsigned char* lds, const Gemm g, const Sched& S, const Epi& E) {
    int tid = threadIdx.x; asm volatile("" : "+v"(tid));
    const int wid = __builtin_amdgcn_readfirstlane(tid >> 6), lane = tid & 63, wr = wid >> 2, wc = wid & 3, fr = lane & 15, fq = lane >> 4;
    const int K = g.K, nt = K / BK;
    unsigned voffA[2], voffB[2];
#pragma unroll
    for (int i = 0; i < 2; ++i) { int R, C; stage_rc(tid * 16 + i * 8192, R, C); const int Rb = Epi::PERM ? ((R & ~31) + perm32(R & 31)) : R;
        voffA[i] = (unsigned)(R * g.lda + C) * 2u; voffB[i] = (unsigned)(Rb * g.ldb + C) * 2u; }
    const size_t kstep = (size_t)(BK * 2);
    const size_t hstepA = (size_t)HALF * g.lda * 2, hstepB = (size_t)HALF * g.ldb * 2;
    const size_t tstepA = 2 * hstepA, tstepB = 2 * hstepB;
    const unsigned ldsw = (unsigned)wid * 1024u;
    const int aoff = lds_byte(wr * 64 + fr, fq * 8), boff = lds_byte(wc * 32 + fr, fq * 8);
#define PG8_SA(b, h) (((b) * 2 + (h)) * HTB)
#define PG8_SB(b, h) ((4 + (b) * 2 + (h)) * HTB)
#define PG8_STAGE(bufoff, gbase, voff) do { _Pragma("unroll") for (int _i = 0; _i < 2; ++_i) \
        __builtin_amdgcn_global_load_lds((const unsigned*)((const char*)(gbase) + (voff)[_i]), (PG8_LAS unsigned*)(lds + (bufoff) + ldsw + _i * 8192), 16, 0, 0); } while (0)
#define PG8_LDA(dst, b, h) do { _Pragma("unroll") for (int m = 0; m < 4; ++m) _Pragma("unroll") for (int k = 0; k < 2; ++k) dst[m][k] = *(const PG8_LAS bf16x8*)(lds + PG8_SA(b, h) + aoff + m * 2048 + k * 1024); } while (0)
#define PG8_LDB(dst, b, h) do { _Pragma("unroll") for (int n = 0; n < 2; ++n) _Pragma("unroll") for (int k = 0; k < 2; ++k) dst[n][k] = *(const PG8_LAS bf16x8*)(lds + PG8_SB(b, h) + boff + n * 2048 + k * 1024); } while (0)
#define PG8_MMA(ai, bj, At, Bt) do { __builtin_amdgcn_s_setprio(1); _Pragma("unroll") for (int m = 0; m < 4; ++m) _Pragma("unroll") for (int n = 0; n < 2; ++n) _Pragma("unroll") for (int k = 0; k < 2; ++k) \
        acc[ai][bj][m][n] = __builtin_amdgcn_mfma_f32_16x16x32_bf16(Bt[n][k], At[m][k], acc[ai][bj][m][n], 0, 0, 0); __builtin_amdgcn_s_setprio(0); } while (0)
#define PG8_WAIT_V(n) asm volatile("s_waitcnt vmcnt(" #n ")" ::: "memory")
#define PG8_WAIT_L(n) asm volatile("s_waitcnt lgkmcnt(" #n ")" ::: "memory")
#define PG8_BAR __builtin_amdgcn_s_barrier()
#define PG8_SCHED __builtin_amdgcn_sched_barrier(0)
    Unit cur, nxt; int ui = 0;
    if (!S.next(0, cur)) return;
    f32x4 acc[2][2][4][2];
#pragma unroll
    for (int a = 0; a < 2; ++a)
#pragma unroll
        for (int b = 0; b < 2; ++b)
#pragma unroll
            for (int m = 0; m < 4; ++m)
#pragma unroll
                for (int n = 0; n < 2; ++n) acc[a][b][m][n] = (f32x4){0.f, 0.f, 0.f, 0.f};
    bf16x8 At[4][2], B0[2][2], B1[2][2];
    const char* cA = (const char*)(cur.w ? g.A2 : g.A) + (size_t)cur.pm * tstepA;
    const char* cB = (const char*)(cur.w ? g.Bt2 : g.Bt) + (size_t)(cur.pm / g.rpg) * g.bgs * 2 + (size_t)cur.pn * tstepB;
    PG8_STAGE(PG8_SB(0, 0), cB, voffB); PG8_STAGE(PG8_SB(0, 1), cB + hstepB, voffB); PG8_STAGE(PG8_SA(0, 0), cA, voffA); PG8_STAGE(PG8_SA(0, 1), cA + hstepA, voffA);
    if (wr == 1) PG8_BAR;
    PG8_WAIT_V(2); PG8_BAR;
    PG8_STAGE(PG8_SB(1, 0), cB + kstep, voffB); PG8_STAGE(PG8_SA(1, 0), cA + kstep, voffA); PG8_STAGE(PG8_SB(1, 1), cB + hstepB + kstep, voffB);
    PG8_WAIT_V(6); PG8_BAR;
    for (;;) {
        const bool has_next = S.next(ui + 1, nxt);
        const char* nA = has_next ? (const char*)(nxt.w ? g.A2 : g.A) + (size_t)nxt.pm * tstepA : cA;
        const char* nB = has_next ? (const char*)(nxt.w ? g.Bt2 : g.Bt) + (size_t)(nxt.pm / g.rpg) * g.bgs * 2 + (size_t)nxt.pn * tstepB : cB;
        for (int t = 0; t < nt; t += 2) {
            const bool last = (t == nt - 2);
            const char* a1 = cA + (size_t)(t + 1) * kstep;
            const char* a2 = last ? nA : cA + (size_t)(t + 2) * kstep; const char* b2 = last ? nB : cB + (size_t)(t + 2) * kstep;
            const char* a3 = a2 + kstep; const char* b3 = b2 + kstep;
            PG8_LDB(B0, 0, 0); PG8_LDB(B1, 0, 1); PG8_SCHED; PG8_LDA(At, 0, 0); PG8_STAGE(PG8_SA(1, 1), a1 + hstepA, voffA);
            PG8_WAIT_V(8); PG8_WAIT_L(0); PG8_BAR; PG8_MMA(0, 0, At, B0); if constexpr (!Epi::HALFN) PG8_MMA(0, 1, At, B1); PG8_BAR; PG8_SCHED;
            PG8_LDA(At, 0, 1); PG8_STAGE(PG8_SB(0, 0), b2, voffB); PG8_STAGE(PG8_SB(0, 1), b2 + hstepB, voffB); PG8_STAGE(PG8_SA(0, 0), a2, voffA);
            PG8_WAIT_V(8); PG8_WAIT_L(0); PG8_BAR; PG8_MMA(1, 0, At, B0); if constexpr (!Epi::HALFN) PG8_MMA(1, 1, At, B1); PG8_BAR; PG8_SCHED;
            PG8_LDB(B0, 1, 0); PG8_LDB(B1, 1, 1); PG8_SCHED; PG8_LDA(At, 1, 0); PG8_STAGE(PG8_SA(0, 1), a2 + hstepA, voffA);
            PG8_WAIT_V(8); PG8_WAIT_L(0); PG8_BAR; PG8_MMA(0, 0, At, B0); if constexpr (!Epi::HALFN) PG8_MMA(0, 1, At, B1); PG8_BAR; PG8_SCHED;
            PG8_LDA(At, 1, 1); PG8_STAGE(PG8_SB(1, 0), b3, voffB); PG8_STAGE(PG8_SB(1, 1), b3 + hstepB, voffB); PG8_STAGE(PG8_SA(1, 0), a3, voffA);
            PG8_WAIT_V(8); PG8_WAIT_L(0); PG8_BAR; PG8_MMA(1, 0, At, B0); if constexpr (!Epi::HALFN) PG8_MMA(1, 1, At, B1); PG8_BAR; PG8_SCHED;
        }
        if constexpr (ALIGN_EPI) { if (wr == 0) PG8_BAR; }
        bool keep = false;
        if constexpr (Epi::CHAIN) { if (cur.w == 0) { E.mid(acc, cur, wr, wc, fr, fq); keep = true; } else E(acc, cur, wr, wc, fr, fq); } else E(acc, cur, wr, wc, fr, fq);
        if (!has_next) break;
        if (!keep)
#pragma unroll
        for (int a = 0; a < 2; ++a)
#pragma unroll
            for (int b = 0; b < 2; ++b)
#pragma unroll
                for (int m = 0; m < 4; ++m)
#pragma unroll
                    for (int n = 0; n < 2; ++n) acc[a][b][m][n] = (f32x4){0.f, 0.f, 0.f, 0.f};
        cur = nxt; cA = nA; cB = nB; ++ui;
        if constexpr (ALIGN_EPI) { if (wr == 1) PG8_BAR; }
    }
    PG8_WAIT_V(0);
    if constexpr (!ALIGN_EPI) { if (wr == 0) PG8_BAR; }
    PG8_BAR;
#undef PG8_SA
#undef PG8_SB
#undef PG8_STAGE
#undef PG8_LDA
#undef PG8_LDB
#undef PG8_MMA
#undef PG8_WAIT_V
#undef PG8_WAIT_L
#undef PG8_BAR
#undef PG8_SCHED
}
}
namespace attn_body {
using bf16=__hip_bfloat16;
using bf16x8=__attribute__((ext_vector_type(8)))short;
using s16x4=__attribute__((ext_vector_type(4)))short;
using f32x16=__attribute__((ext_vector_type(16)))float;
using f32x4v=__attribute__((ext_vector_type(4)))float;
using u32x4=__attribute__((ext_vector_type(4)))unsigned;
constexpr int BATCH=8,NHEAD=8,SEQ=2048,D=64,DM=NHEAD*D;
constexpr int NW=8,QBLK=32,QB=QBLK*NW,KVBLK=64,NQB=SEQ/QB;
__device__ __forceinline__ int crow(int r,int hi){return (r&3)+8*(r>>2)+4*hi;}
#define SBAR() __builtin_amdgcn_sched_barrier(0)
__device__ __forceinline__ void cmask(f32x16&p0,f32x16&p1,int jb,int qrel,int hi){
  const float NEG=-INFINITY; int kb=64*jb+4*hi;
  #pragma unroll
  for(int r=0;r<16;++r){int kv=kb+(r&3)+8*(r>>2); if(kv>qrel)p0[r]=NEG; if(kv+32>qrel)p1[r]=NEG;}
}
typedef __attribute__((address_space(3))) const float* lds_cfptr;
__device__ __forceinline__ void biasadd(f32x16&p0,f32x16&p1,int jb,int qrel,int hi,lds_cfptr bt){
  const int base=qrel-64*jb-4*hi;
  #pragma unroll
  for(int r4=0;r4<16;r4+=4){
    #pragma unroll
    for(int r=r4;r<r4+4;++r){int rel=base-((r&3)+8*(r>>2)); int i0=min(max(rel,0),127), i1=min(max(rel-32,0),127); p0[r]+=bt[i0]; p1[r]+=bt[i1];}
    asm volatile("s_waitcnt lgkmcnt(0)":"+v"(p0),"+v"(p1)::"memory"); }
}

constexpr int NSLOT=3, SLOTB=8192;
constexpr int LDS_K=0, LDS_V=NSLOT*SLOTB, LDS_WS=2*NSLOT*SLOTB, LDS_OST=LDS_WS+NW*64*4, LDS_KM=LDS_OST+NW*4096, LDS_BT=LDS_KM+7*64*4, LDS_BYTES=LDS_BT+128*4;
constexpr float C2=0.125f*1.4426950408889634f;
__device__ __forceinline__ void glds16(const void*gsrc,unsigned lds_dst){unsigned keep;
  asm volatile("s_mov_b32 %0, m0\n\ts_mov_b32 m0, %2\n\ts_nop 0\n\tglobal_load_lds_dwordx4 %1, off\n\ts_mov_b32 m0, %0":"=&s"(keep):"v"(gsrc),"s"(lds_dst):"memory");}
__device__ __forceinline__ float max3f(float a,float b,float c){float r;asm("v_max3_f32 %0, %1, %2, %3":"=v"(r):"v"(a),"v"(b),"v"(c));return r;}
__device__ __forceinline__ float max2f(float a,float b){float r;asm("v_max_f32_e32 %0, %1, %2":"=v"(r):"v"(a),"v"(b));return r;}
__device__ __forceinline__ float fadd_s(float a,float b){float r;asm("v_add_f32_e32 %0, %1, %2":"=v"(r):"v"(a),"v"(b));return r;}
__device__ __forceinline__ float fsub_s(float a,float b){float r;asm("v_sub_f32_e32 %0, %1, %2":"=v"(r):"v"(a),"v"(b));return r;}
typedef float f32x2_t __attribute__((ext_vector_type(2))); typedef __bf16 bf16x2_t __attribute__((ext_vector_type(2)));
__device__ __forceinline__ unsigned cvtpk_s(float lo,float hi){f32x2_t v={lo,hi};bf16x2_t b=__builtin_convertvector(v,bf16x2_t);return __builtin_bit_cast(unsigned,b);}
#define WAIT_BAR(N) asm volatile("s_waitcnt vmcnt(" #N ") lgkmcnt(0)\n\ts_barrier":::"memory")

__device__ __forceinline__ void qkt(f32x16&p0,f32x16&p1,const char*Kslot,const bf16x8*qr,int r32,int hi){
  const char*kb=Kslot+hi*1024+r32*16;
  #pragma unroll
  for(int d0=0;d0<4;++d0){
    const bf16x8 b0=*reinterpret_cast<const bf16x8*>(kb+d0*2048);
    const bf16x8 b1=*reinterpret_cast<const bf16x8*>(kb+d0*2048+512);
    if(d0==0){p0=__builtin_amdgcn_mfma_f32_32x32x16_bf16(b0,qr[0],(f32x16){},0,0,0);p1=__builtin_amdgcn_mfma_f32_32x32x16_bf16(b1,qr[0],(f32x16){},0,0,0);}
    else{p0=__builtin_amdgcn_mfma_f32_32x32x16_bf16(b0,qr[d0],p0,0,0,0);p1=__builtin_amdgcn_mfma_f32_32x32x16_bf16(b1,qr[d0],p1,0,0,0);}}
}
typedef __attribute__((address_space(3))) const char* lds_cptr;
typedef short v4i16_t __attribute__((ext_vector_type(4)));
__device__ __forceinline__ void kload8(bf16x8*kf,lds_cptr kp){
  kf[0]=*(const __attribute__((address_space(3))) bf16x8*)(kp);      kf[1]=*(const __attribute__((address_space(3))) bf16x8*)(kp+512);
  kf[2]=*(const __attribute__((address_space(3))) bf16x8*)(kp+2048); kf[3]=*(const __attribute__((address_space(3))) bf16x8*)(kp+2560);
  kf[4]=*(const __attribute__((address_space(3))) bf16x8*)(kp+4096); kf[5]=*(const __attribute__((address_space(3))) bf16x8*)(kp+4608);
  kf[6]=*(const __attribute__((address_space(3))) bf16x8*)(kp+6144); kf[7]=*(const __attribute__((address_space(3))) bf16x8*)(kp+6656);
}
__device__ __forceinline__ void kload2(bf16x8*kf,lds_cptr kp,int j){ kf[2*j]=*(const __attribute__((address_space(3))) bf16x8*)(kp+j*2048); kf[2*j+1]=*(const __attribute__((address_space(3))) bf16x8*)(kp+j*2048+512); }
__device__ __forceinline__ s16x4 vtr(lds_cptr p){ return __builtin_bit_cast(s16x4,__builtin_amdgcn_ds_read_tr16_b64_v4i16((__attribute__((address_space(3))) v4i16_t*)p)); }
__device__ __forceinline__ float rowmax(const f32x16&p0,const f32x16&p1){
  float a=max3f(p0[0],p0[1],p1[0]),b=max3f(p0[2],p0[3],p1[1]);a=max3f(a,p1[2],p1[3]);
  #pragma unroll
  for(int r=4;r<16;r+=4){a=max3f(a,p0[r],p0[r+1]);b=max3f(b,p0[r+2],p0[r+3]);a=max3f(a,p1[r],p1[r+1]);b=max3f(b,p1[r+2],p1[r+3]);}
  const float m=max2f(a,b);
  auto rr=__builtin_amdgcn_permlane32_swap(__float_as_uint(m),__float_as_uint(m),false,false);
  return max2f(__uint_as_float(rr[0]),__uint_as_float(rr[1]));
}
__device__ __forceinline__ void pv(f32x16*o,int vb,bf16x8 pa0,bf16x8 pa1,bf16x8 pa2,bf16x8 pa3){
  #pragma unroll
  for(int d0=0;d0<2;++d0){s16x4 lo[4],hi[4];
    #pragma unroll
    for(int ks=0;ks<4;++ks){
      asm volatile("ds_read_b64_tr_b16 %0,%1 offset:%c2":"=&v"(lo[ks]):"v"(vb),"i"(d0*4096+ks*1024):"memory");
      asm volatile("ds_read_b64_tr_b16 %0,%1 offset:%c2":"=&v"(hi[ks]):"v"(vb),"i"(d0*4096+ks*1024+512):"memory");}
    asm volatile("s_waitcnt lgkmcnt(0)":::"memory");SBAR();
    #define PK(k) (bf16x8){lo[k][0],lo[k][1],lo[k][2],lo[k][3],hi[k][0],hi[k][1],hi[k][2],hi[k][3]}
    o[d0]=__builtin_amdgcn_mfma_f32_32x32x16_bf16(pa0,PK(0),o[d0],0,0,0);
    o[d0]=__builtin_amdgcn_mfma_f32_32x32x16_bf16(pa1,PK(1),o[d0],0,0,0);
    o[d0]=__builtin_amdgcn_mfma_f32_32x32x16_bf16(pa2,PK(2),o[d0],0,0,0);
    o[d0]=__builtin_amdgcn_mfma_f32_32x32x16_bf16(pa3,PK(3),o[d0],0,0,0);
    #undef PK
  }
}

#ifndef ATTN_STORE16
#define ATTN_STORE16(p,v) (*(u32x4*)(p)=(v))
#endif
template<int THRL> __device__ __forceinline__ void attn_unit(int b,int h,int qb,const bf16*Q,const bf16*__restrict__ K,const bf16*__restrict__ V,bf16*O,char*shm,const float*kpart,const float*btab){
  int tid=threadIdx.x; asm volatile("":"+v"(tid));
  const int lane=tid&63,r32=lane&31,hi=lane>>5; const int wid=__builtin_amdgcn_readfirstlane(tid>>6);
  const long rowbase=(long)b*SEQ; const int q0=qb*QB;
  const bf16*Qw=Q+(rowbase+q0+wid*QBLK)*DM+h*D;
  const bf16*Kh=K+rowbase*DM+h*D,*Vh=V+rowbase*DM+h*D;
  const unsigned lds0=(unsigned)(uintptr_t)shm;
  float*wsf=(float*)(shm+LDS_WS)+wid*64;
  const bf16*ksrc=Kh+(long)lane*DM+wid*8;
  const bf16*vsrc=Vh+(long)(16*(wid&3)+(lane>>2))*DM+(wid>>2)*32+(lane&3)*8;
  const unsigned kdst=lds0+LDS_K+wid*1024, vdst=lds0+LDS_V+wid*1024;
  #define DMA_K(t,slot) glds16(ksrc+(long)(t)*KVBLK*DM,(unsigned)__builtin_amdgcn_readfirstlane(kdst+(slot)))
  #define DMA_V(t,slot) glds16(vsrc+(long)(t)*KVBLK*DM,(unsigned)__builtin_amdgcn_readfirstlane(vdst+(slot)))
  const int vb0=(int)(lds0+LDS_V)+((lane>>4)&1)*32+(lane&3)*8+(4*hi+((lane&15)>>2))*64;
  const char*Kbase=shm+LDS_K; bf16x8 kf[8];
  const lds_cptr shm3=(lds_cptr)shm; const lds_cptr kp0=shm3+LDS_K+hi*1024+r32*16; const lds_cptr vp0=shm3+LDS_V+((lane>>4)&1)*32+(lane&3)*8+(4*hi+((lane&15)>>2))*64;
  const lds_cfptr btl=(lds_cfptr)(shm3+LDS_BT);
  const int NT=(q0+QB)/KVBLK;
  DMA_K(0,0);DMA_V(0,0);DMA_K(1,SLOTB);
  bf16x8 qr[4];
  #pragma unroll
  for(int d0=0;d0<4;++d0)qr[d0]=*reinterpret_cast<const bf16x8*>(&Qw[(long)r32*DM+d0*16+hi*8]);
  { float*km=(float*)(shm+LDS_KM); float*bt=(float*)(shm+LDS_BT); int tq=tid; asm volatile("":"+v"(tq));
    if(tq<448){const int j=tq>>6,d=tq&63; float v=0.f; if(j<qb&&qb>3){const float*kp=kpart+((size_t)((b*NQB+j)*2)*512)+h*D+d; v=(kp[0]+kp[512])*(1.0f/256.0f);} km[tq]=v;}
    else if(tq<448+64){const int i=tq-448; bt[i]=btab[h*128+i]; bt[64+i]=btab[h*128+64+i];} }
  float mhat=0.f,l_reg=0.f;f32x16 o[2];o[0]=f32x16{};o[1]=f32x16{};
  const int qrel=wid*QBLK+r32;
  #define CMASK(P0,P1,t) do{int jb_=(t)-(NT-4);   \
    if(jb_>=-2 && 32*wid+31-64*jb_>=0 && 32*wid-64*jb_-63<=112)biasadd(P0,P1,jb_,qrel,hi,btl); if(jb_>=0 && 64*jb_+63>32*wid)cmask(P0,P1,jb_,qrel,hi);}while(0)
  bool resc=false;
  #define START(P0,P1,t) do{ float rm=rowmax(P0,P1); resc=false; const float nv_=MASKADD(t); rm=fadd_s(rm,nv_); \
    { const float dl=__builtin_fmaxf(rm,-1.0e4f); mhat=fadd_s(mhat,dl); const float cc_=fsub_s(nv_,dl); \
      _Pragma("unroll") for(int r=0;r<16;++r){P0[r]=fadd_s(P0[r],cc_);P1[r]=fadd_s(P1[r],cc_);} } \
    _Pragma("unroll") for(int r=0;r<16;++r)P0[r]=__builtin_amdgcn_exp2f(P0[r]); }while(0)
  #define RESC() do{ if(resc){ asm volatile("s_waitcnt lgkmcnt(0)":::"memory"); \
      _Pragma("unroll") for(int d_=0;d_<2;++d_) _Pragma("unroll") for(int r=0;r<16;++r)o[d_][r]*=wsf[crow(r,hi)]; } }while(0)
  f32x16 pA0,pA1,pB0,pB1;
  int sl_prev=0,sl_cur=0,sl_next=SLOTB;
  #define ROT() do{sl_prev=sl_cur;sl_cur=sl_next;sl_next=(sl_next==(NSLOT-1)*SLOTB)?0:sl_next+SLOTB;}while(0)
  DMA_K(2,2*SLOTB);
  WAIT_BAR(3);
  unsigned selbits=(1u<<qb)-1u;
  if(qb>3){ selbits=0u;
    const __attribute__((address_space(3))) float* km3=(const __attribute__((address_space(3))) float*)(shm3+LDS_KM);
    float qf[32];
    #pragma unroll
    for(int d0=0;d0<4;++d0){
      #pragma unroll
      for(int i=0;i<8;++i) qf[d0*8+i]=__uint_as_float(((unsigned)(unsigned short)qr[d0][i])<<16);}
    float gj[7];
    #pragma unroll
    for(int j=0;j<7;++j){ float s=0.f;
      if(j<qb){
        #pragma unroll
        for(int d0=0;d0<4;++d0){ const f32x4v k0=*(const __attribute__((address_space(3))) f32x4v*)(km3+j*64+d0*16+hi*8); const f32x4v k1=*(const __attribute__((address_space(3))) f32x4v*)(km3+j*64+d0*16+hi*8+4);
          s+=qf[d0*8+0]*k0[0]+qf[d0*8+1]*k0[1]+qf[d0*8+2]*k0[2]+qf[d0*8+3]*k0[3]+qf[d0*8+4]*k1[0]+qf[d0*8+5]*k1[1]+qf[d0*8+6]*k1[2]+qf[d0*8+7]*k1[3]; }
        auto rr=__builtin_amdgcn_permlane32_swap(__float_as_uint(s),__float_as_uint(s),false,false); s=__uint_as_float(rr[0])+__uint_as_float(rr[1]); }
      gj[j]=s; }
    #pragma unroll
    for(int j=0;j<7;++j){ int rank=0;
      #pragma unroll
      for(int k=0;k<7;++k){ if(k!=j){ const bool beats=(k<j)?(gj[k]>=gj[j]):(gj[k]>gj[j]); rank+=(k<qb&&beats)?1:0; } }
      if(j<qb&&rank<3)selbits|=(1u<<j); }
  }
  #define MASKADD(t) ((((t)>>2)<qb && !((selbits>>((t)>>2))&1u))?-1.0e30f:0.0f)
  qkt(pA0,pA1,Kbase,qr,r32,hi);asm volatile("s_nop 15\n\ts_nop 7":"+v"(pA0),"+v"(pA1));CMASK(pA0,pA1,0);
  START(pA0,pA1,0);
  _Pragma("unroll") for(int r=0;r<16;++r)pA1[r]=__builtin_amdgcn_exp2f(pA1[r]);
  WAIT_BAR(0);
  DMA_K(3,0);DMA_V(1,SLOTB);
  ROT();
  kload8(kf,kp0+sl_cur);
  WAIT_BAR(2);
  s16x4 vlo[8],vhi[8]; u32x4 pw0,pw1,pw2,pw3;
  #define PKW(P,B) cvtpk_s(P[B],P[B+1])
  #define PAF(k) __builtin_bit_cast(bf16x8,pw##k)
  #define VFR(i) (bf16x8){vlo[i][0],vlo[i][1],vlo[i][2],vlo[i][3],vhi[i][0],vhi[i][1],vhi[i][2],vhi[i][3]}
  #define PIN(x) asm volatile("":"+v"(x))
  #define MX3(a,b,c) __builtin_fmaxf(__builtin_fmaxf((a),(b)),(c))
  #define GAPA(MF,A0,A1,A2,A3,W0,W1,PW) do{ MF; sacc+=A0; sacc+=A1; sacc+=A2; sacc+=A3; PIN(sacc); W0; W1; PIN(PW); SBAR(); }while(0)
  #define EX(v) __builtin_amdgcn_exp2f(v)
  #define GAPB(MF,X,B) do{ MF; X[B]=EX(X[B]); X[B+1]=EX(X[B+1]); X[B+2]=EX(X[B+2]); X[B+3]=EX(X[B+3]); PIN(X); SBAR(); }while(0)
  #define VRD(i) do{ vlo[i]=vtr(vp_+(((i)>>2)*4096+((i)&3)*1024)); vhi[i]=vtr(vp_+(((i)>>2)*4096+((i)&3)*1024+512)); }while(0)
  #define KRD(G,j) do{ if(G){ kload2(kf,kp0+sl_next,j); SBAR(); } }while(0)
  #define STEP(C0,C1,P0,P1,t,GK,GV,GL) do{ SBAR(); \
    const lds_cptr vp_=vp0+sl_prev; \
    VRD(0); SBAR(); float sacc=(P0[0]+P0[1]); \
    GAPA(C0=__builtin_amdgcn_mfma_f32_32x32x16_bf16(kf[0],qr[0],(f32x16){},0,0,0), P0[2],P0[3],P0[4],P0[5],     pw0[0]=PKW(P0,0), pw0[1]=PKW(P0,2), pw0); \
    VRD(4); SBAR(); GAPA(C1=__builtin_amdgcn_mfma_f32_32x32x16_bf16(kf[1],qr[0],(f32x16){},0,0,0), P0[6],P0[7],P0[8],P0[9],     pw0[2]=PKW(P0,4), pw0[3]=PKW(P0,6), pw0); \
    VRD(1); SBAR(); GAPA(C0=__builtin_amdgcn_mfma_f32_32x32x16_bf16(kf[2],qr[1],C0,0,0,0),   P0[10],P0[11],P0[12],P0[13], pw1[0]=PKW(P0,8), pw1[1]=PKW(P0,10), pw1); \
    VRD(5); SBAR(); GAPA(C1=__builtin_amdgcn_mfma_f32_32x32x16_bf16(kf[3],qr[1],C1,0,0,0),   P0[14],P0[15],P1[0],P1[1],   pw1[2]=PKW(P0,12),pw1[3]=PKW(P0,14), pw1); \
    VRD(2); SBAR(); GAPA(C0=__builtin_amdgcn_mfma_f32_32x32x16_bf16(kf[4],qr[2],C0,0,0,0),   P1[2],P1[3],P1[4],P1[5],     pw2[0]=PKW(P1,0), pw2[1]=PKW(P1,2), pw2); \
    VRD(6); SBAR(); GAPA(C1=__builtin_amdgcn_mfma_f32_32x32x16_bf16(kf[5],qr[2],C1,0,0,0),   P1[6],P1[7],P1[8],P1[9],     pw2[2]=PKW(P1,4), pw2[3]=PKW(P1,6), pw2); \
    VRD(3); SBAR(); GAPA(C0=__builtin_amdgcn_mfma_f32_32x32x16_bf16(kf[6],qr[3],C0,0,0,0),   P1[10],P1[11],P1[12],P1[13], pw3[0]=PKW(P1,8), pw3[1]=PKW(P1,10), pw3); \
    VRD(7); SBAR(); GAPA(C1=__builtin_amdgcn_mfma_f32_32x32x16_bf16(kf[7],qr[3],C1,0,0,0),   P1[14],P1[15],0.f,0.f,       pw3[2]=PKW(P1,12),pw3[3]=PKW(P1,14), pw3); \
    l_reg+=sacc; \
    if(GK){DMA_K((t)+3,sl_cur);} if(GV){DMA_V((t)+1,sl_next);} \
    CMASK(C0,C1,t); \
    { float a=MX3(C0[0],C0[1],C1[0]),b=MX3(C0[2],C0[3],C1[1]); a=MX3(a,C1[2],C1[3]); \
      _Pragma("unroll") for(int r=4;r<16;r+=4){a=MX3(a,C0[r],C0[r+1]);b=MX3(b,C0[r+2],C0[r+3]);a=MX3(a,C1[r],C1[r+1]);b=MX3(b,C1[r+2],C1[r+3]);} \
      float rm=__builtin_fmaxf(a,b); { auto rr=__builtin_amdgcn_permlane32_swap(__float_as_uint(rm),__float_as_uint(rm),false,false); rm=__builtin_fmaxf(__uint_as_float(rr[0]),__uint_as_float(rr[1])); } \
      const float nv_=MASKADD(t)-mhat; rm+=nv_; float cc_=nv_; \
      resc=false; \
      if(__builtin_expect(__any(rm>(float)THRL),0)){ const float dl=__builtin_fmaxf(rm,0.f); mhat+=dl; cc_-=dl; \
        const float f=__builtin_amdgcn_exp2f(-dl); l_reg*=f; if(hi==0)wsf[r32]=f; resc=true; } \
      _Pragma("unroll") for(int r=0;r<16;++r){C0[r]+=cc_;C1[r]+=cc_;} } \
    SBAR(); \
    GAPB(o[0]=__builtin_amdgcn_mfma_f32_32x32x16_bf16(PAF(0),VFR(0),o[0],0,0,0), C0,0); \
    GAPB(o[1]=__builtin_amdgcn_mfma_f32_32x32x16_bf16(PAF(0),VFR(4),o[1],0,0,0), C0,4); \
    KRD(GL,0); GAPB(o[0]=__builtin_amdgcn_mfma_f32_32x32x16_bf16(PAF(1),VFR(1),o[0],0,0,0), C0,8); \
    KRD(GL,1); GAPB(o[1]=__builtin_amdgcn_mfma_f32_32x32x16_bf16(PAF(1),VFR(5),o[1],0,0,0), C0,12); \
    KRD(GL,2); GAPB(o[0]=__builtin_amdgcn_mfma_f32_32x32x16_bf16(PAF(2),VFR(2),o[0],0,0,0), C1,0); \
    KRD(GL,3); GAPB(o[1]=__builtin_amdgcn_mfma_f32_32x32x16_bf16(PAF(2),VFR(6),o[1],0,0,0), C1,4); \
    GAPB(o[0]=__builtin_amdgcn_mfma_f32_32x32x16_bf16(PAF(3),VFR(3),o[0],0,0,0), C1,8); \
    GAPB(o[1]=__builtin_amdgcn_mfma_f32_32x32x16_bf16(PAF(3),VFR(7),o[1],0,0,0), C1,12); \
    }while(0)
  int t=1;
  #undef CMASK
  #define CMASK(P0,P1,t) do{}while(0)
  for(;t+7<NT;t+=2){
    STEP(pB0,pB1,pA0,pA1,t,true,true,true);     WAIT_BAR(2); RESC(); ROT();
    STEP(pA0,pA1,pB0,pB1,t+1,true,true,true);   WAIT_BAR(2); RESC(); ROT();
  }
  #undef CMASK
  #define CMASK(P0,P1,t) do{int jb_=(t)-(NT-4);   \
    if(jb_>=-2 && 32*wid+31-64*jb_>=0 && 32*wid-64*jb_-63<=112)biasadd(P0,P1,jb_,qrel,hi,btl); if(jb_>=0 && 64*jb_+63>32*wid)cmask(P0,P1,jb_,qrel,hi);}while(0)
  #define ENDW(tt) do{ if((tt)+3<NT){WAIT_BAR(2);} else if((tt)+2<NT){WAIT_BAR(1);} else {WAIT_BAR(0);} }while(0)
  for(;t+1<NT;t+=2){
    STEP(pB0,pB1,pA0,pA1,t,(t+3<NT),(t+1<NT),(t+1<NT));       ENDW(t);   RESC(); ROT();
    STEP(pA0,pA1,pB0,pB1,t+1,(t+4<NT),(t+2<NT),(t+2<NT));     ENDW(t+1); RESC(); ROT();
  }
  STEP(pB0,pB1,pA0,pA1,NT-1,false,false,false); RESC();
  { float sacc=pB0[0]+pB0[1]; _Pragma("unroll") for(int r=2;r<16;++r)sacc+=pB0[r]; _Pragma("unroll") for(int r=0;r<16;++r)sacc+=pB1[r]; l_reg+=sacc;
    pw0=(u32x4){PKW(pB0,0),PKW(pB0,2),PKW(pB0,4),PKW(pB0,6)};pw1=(u32x4){PKW(pB0,8),PKW(pB0,10),PKW(pB0,12),PKW(pB0,14)};pw2=(u32x4){PKW(pB1,0),PKW(pB1,2),PKW(pB1,4),PKW(pB1,6)};pw3=(u32x4){PKW(pB1,8),PKW(pB1,10),PKW(pB1,12),PKW(pB1,14)};
    SBAR(); pv(o,vb0+sl_cur,PAF(0),PAF(1),PAF(2),PAF(3)); }
  #undef PKW
  #undef PAF
  #undef VFR
  #undef PIN
  #undef MX3
  #undef GAPA
  #undef GAPB
  #undef EX
  #undef VRD
  #undef KRD
  #undef STEP
  #undef ENDW
  #undef MASKADD
  {auto rr=__builtin_amdgcn_permlane32_swap(__float_as_uint(l_reg),__float_as_uint(l_reg),false,false);l_reg=__uint_as_float(rr[0])+__uint_as_float(rr[1]);}
  if(hi==0)wsf[32+r32]=l_reg;asm volatile("s_waitcnt lgkmcnt(0)":::"memory");
  float rli[16];
  #pragma unroll
  for(int r=0;r<16;++r)rli[r]=__builtin_amdgcn_rcpf(wsf[32+crow(r,hi)]);
  bf16*Ow=O+(rowbase+q0+wid*QBLK)*DM+h*D;
  { bf16*stg=(bf16*)(shm+LDS_OST)+wid*2048;
    #pragma unroll
    for(int r=0;r<16;++r){const int orow=crow(r,hi);
      #pragma unroll
      for(int d0=0;d0<2;++d0)stg[orow*64+d0*32+r32]=__float2bfloat16(o[d0][r]*rli[r]);}
    asm volatile("s_waitcnt lgkmcnt(0)":::"memory");
    #pragma unroll
    for(int i=0;i<4;++i){const int row=i*8+(lane>>3),ch=lane&7; const u32x4 v=*(const u32x4*)(stg+row*64+ch*8); ATTN_STORE16(Ow+(long)row*DM+ch*8,v);} }
  asm volatile("s_waitcnt lgkmcnt(0)\n\ts_barrier":::"memory");
  #undef DMA_K
  #undef DMA_V
  #undef CMASK
  #undef START
  #undef RESC
  #undef ROT
}
constexpr int ATTN_LDS_BYTES=LDS_BYTES;
#undef SBAR
#undef WAIT_BAR
}
constexpr int NWAVES = 8;
constexpr int PER_PHASE = 10;
constexpr int N_LAUNCHES = MK_N_LAUNCHES;

constexpr int BATCH = 8, SEQ = 2048, DMODEL = 1024, MTOK = BATCH * SEQ;
constexpr int INCOLS = 4096, SSMW = 512, NGRP = 32, CH = 32  , NCHUNK = SEQ / CH  , APK = 640  ;
constexpr int PQ = 2048, NEXP = 16384;
constexpr float RMS_EPS = 1e-6f;

constexpr size_t MiB = 1u << 20;
constexpr size_t WS_CTL = 0, CTL_ZERO_BYTES = 64 * 1024;
constexpr size_t WS_BIAS = 1 * MiB;
constexpr size_t WS_PW32 = 1 * MiB + 64 * 1024;
constexpr size_t WS_KPART = 1 * MiB + 128 * 1024;
constexpr size_t WS_KG = 2 * MiB;
constexpr size_t WS_SSQ1 = 3 * MiB;
constexpr size_t WS_WIN = 6 * MiB, WS_WQ = 14 * MiB, WS_WOUT = 18 * MiB, WS_WUS = 20 * MiB, WS_WUA = 21 * MiB, WS_WGLU = 22 * MiB, WS_KS = 22 * MiB + 512 * 1024;
constexpr size_t WS_WE = 23 * MiB;
constexpr size_t WS_BP = 32 * MiB;
constexpr size_t WS_AP = 52 * MiB;
constexpr size_t WS_E = 72 * MiB;
constexpr size_t WS_H = 80 * MiB;
constexpr size_t WS_YPRE = 80 * MiB, WS_YA = 96 * MiB, WS_XG = 80 * MiB;
constexpr size_t WS_Z = 96 * MiB, ZSTRIDE_B = 16 * MiB;
constexpr size_t WS_MRG = 128 * MiB;
constexpr size_t WS_PQ = 160 * MiB;
constexpr size_t WS_IDS = 224 * MiB, WS_GTS = 232 * MiB;
constexpr size_t WS_U16 = 32 * MiB, WS_V16 = 240 * MiB;
constexpr size_t WS_YB = 224 * MiB;
constexpr size_t WS_WPK = 128 * MiB, WS_RSTD1 = 4 * MiB, WS_Y16 = 160 * MiB;
constexpr size_t WS_END = 256 * MiB;
constexpr int CW_BAR = 1024;

constexpr int RING_OFF = 0, RING_BYTES = 131072;
constexpr int LDSCTL_OFF = RING_BYTES, MISC_OFF = LDSCTL_OFF + 320;
constexpr int GATE_OFF = 147456;
constexpr int LDS_BYTES = 163840;

#define GAS __attribute__((address_space(1)))
#define LAS __attribute__((address_space(3)))
typedef unsigned short bf16;
typedef unsigned v4u __attribute__((ext_vector_type(4)));
typedef float f32x4 __attribute__((ext_vector_type(4)));
typedef short bf16x8 __attribute__((ext_vector_type(8)));
typedef float f32x16 __attribute__((ext_vector_type(16)));
typedef __bf16 bf16x2_t __attribute__((ext_vector_type(2)));
typedef _Float16 h2_t __attribute__((ext_vector_type(2)));
typedef GAS unsigned gu32;
#define RLX_AGENT __ATOMIC_RELAXED, __HIP_MEMORY_SCOPE_AGENT
#define LDS_WAIT() asm volatile("s_waitcnt lgkmcnt(0)" ::: "memory")
#define VM_WAIT() asm volatile("s_waitcnt vmcnt(0)" ::: "memory")
__device__ __forceinline__ unsigned f2bf(float f) { unsigned u = __builtin_bit_cast(unsigned, f); return (u + 0x7fffu + ((u >> 16) & 1u)) >> 16; }
__device__ __forceinline__ unsigned pk2(float lo, float hi) { return f2bf(lo) | (f2bf(hi) << 16); }
namespace pg8 { typedef unsigned u32x2 __attribute__((ext_vector_type(2))); }
using pg8::cvt_pk_bf16; using pg8::bf_lo; using pg8::bf_hi; using pg8::sigmoid_f; using pg8::gelu_tanh;

#define XB_TMO      128
#define XB_XCNT(j)  (256  + 64 * (j))
#define XB_XSUB(j)  (1280 + 64 * (j))
#define XB_XGEN(j)  (2304 + 64 * (j))
#define XB_TOP      3328
#define XB_TOPGEN   3392
#define XCD_BAR_WORDS 3456
#define XB_SPIN_CAP (1u << 18)
__device__ __forceinline__ unsigned xb_ld(unsigned* p)              { return __hip_atomic_load(p, __ATOMIC_RELAXED, __HIP_MEMORY_SCOPE_AGENT); }
__device__ __forceinline__ unsigned xb_add(unsigned* p, unsigned v) { return __hip_atomic_fetch_add(p, v, __ATOMIC_RELAXED, __HIP_MEMORY_SCOPE_AGENT); }
__device__ __forceinline__ unsigned xb_xcc_id() { return (unsigned)__builtin_amdgcn_s_getreg((3 << 11) | 20) & 0xFu; }
#define XB_SPIN(cond, bar) do { unsigned _sp = 0; while (cond) { __builtin_amdgcn_s_sleep(1); \
    if ((++_sp & 255u) == 0u) { if (xb_ld(&(bar)[XB_TMO])) break; if (_sp > XB_SPIN_CAP) { atomicAdd(&(bar)[XB_TMO], 1u); break; } } } } while (0)
struct XcdBarrier { unsigned* bar; unsigned x; volatile LAS unsigned* st; };
__device__ __forceinline__ XcdBarrier xcd_barrier_post(unsigned* bar, volatile LAS unsigned* st) {
    XcdBarrier b; b.bar = bar; b.x = xb_xcc_id(); b.st = st;
    if (threadIdx.x == 0) (void)xb_add(&bar[XB_XCNT(b.x)], 1u);
    return b;
}
__device__ __forceinline__ void xcd_barrier_complete(unsigned* bar, unsigned x, unsigned& nloc, unsigned& nx) {
    const unsigned G = gridDim.x * gridDim.y * gridDim.z;
    unsigned sum, cnt, mine, sp = 0u;
    for (;;) {
        sum = 0u; cnt = 0u; mine = 0u;
#pragma unroll
        for (unsigned j = 0; j < 16; ++j) { const unsigned c = xb_ld(&bar[XB_XCNT(j)]); sum += c; cnt += (c > 0u) ? 1u : 0u; mine = (j == x) ? c : mine; }
        if (sum == G) break;
        __builtin_amdgcn_s_sleep(1);
        if ((++sp & 255u) == 0u) { if (xb_ld(&bar[XB_TMO])) break; if (sp > XB_SPIN_CAP) { atomicAdd(&bar[XB_TMO], 1u); break; } }
    }
    nloc = mine > 0u ? mine : 1u; nx = cnt > 0u ? cnt : 1u;
}
__device__ __forceinline__ void xcd_barrier(const XcdBarrier& b) {
    asm volatile("s_waitcnt vmcnt(0)" ::: "memory");
    __syncthreads();
    if (threadIdx.x == 0) {
        unsigned* bar = b.bar;
        __builtin_amdgcn_s_waitcnt(0);
        unsigned nloc = b.st[0], nx = b.st[1];
        if (nloc == 0u) { xcd_barrier_complete(bar, b.x, nloc, nx); b.st[0] = nloc; b.st[1] = nx; }
        const unsigned old = xb_add(&bar[XB_XSUB(b.x)], 1u);
        const unsigned gen = old / nloc;
        if (old + 1u == (gen + 1u) * nloc) {
            __builtin_amdgcn_fence(__ATOMIC_RELEASE, "agent");
            asm volatile("s_waitcnt vmcnt(0)" ::: "memory");
            const unsigned og = xb_add(&bar[XB_TOP], 1u);
            const unsigned tg = og / nx;
            if (og + 1u == (tg + 1u) * nx) xb_add(&bar[XB_TOPGEN], 1u);
            else XB_SPIN(xb_ld(&bar[XB_TOPGEN]) == tg, bar);
            __builtin_amdgcn_fence(__ATOMIC_ACQUIRE, "agent");
            xb_add(&bar[XB_XGEN(b.x)], 1u);
            asm volatile("s_waitcnt vmcnt(0)" ::: "memory");
        } else {
            XB_SPIN(xb_ld(&bar[XB_XGEN(b.x)]) == gen, bar);
            __builtin_amdgcn_fence(__ATOMIC_ACQUIRE, "agent");
            asm volatile("s_waitcnt vmcnt(0)" ::: "memory");
        }
    }
    __syncthreads();
}

__device__ __forceinline__ float wave_sum(float v) {
#pragma unroll
    for (int o = 1; o < 64; o <<= 1) v += __shfl_xor(v, o);
    return v;
}

namespace pg8 {
struct EpiIn {
    static constexpr bool PERM = true; static constexpr bool CHAIN = false; static constexpr bool HALFN = false;
    bf16_t* zbase; bf16_t* AP; float* kpart;
    __device__ __forceinline__ void operator()(const f32x4 (&acc)[2][2][4][2], const Unit& u, int wr, int wc, int fr, int fq) const {
        const int t = u.pn >> 1, colt = (u.pn & 1) * 256;
        const int row0 = u.pm * BM + wr * 64 + fr, col0 = colt + wc * 32 + 8 * fq;
        if (t == 0) {
#pragma unroll
            for (int ai = 0; ai < 2; ++ai)
#pragma unroll
                for (int m = 0; m < 4; ++m) { const int r = row0 + ai * HALF + m * 16, b = r >> 11, l = r & 2047;
#pragma unroll
                    for (int bj = 0; bj < 2; ++bj) { const int c = col0 + bj * HALF, g = c >> 4, hi0 = c & 15;
                        const f32x4 v0 = acc[ai][bj][m][0], v1 = acc[ai][bj][m][1];
                        u32x4 w; w.x = cvt_pk_bf16(v0[0], v0[1]); w.y = cvt_pk_bf16(v0[2], v0[3]); w.z = cvt_pk_bf16(v1[0], v1[1]); w.w = cvt_pk_bf16(v1[2], v1[3]);
                        *(u32x4*)(AP + (size_t)(g * 512 + b * 64 + (l >> 5)) * 640 + (l & 31) * 16 + hi0) = w; } }
        } else {
            bf16_t* base = zbase + (size_t)t * (16u * 1024u * 1024u / 2u);
            const float sc = (t == 1) ? 0.125f * 1.4426950408889634f : 1.0f;
#pragma unroll
            for (int ai = 0; ai < 2; ++ai)
#pragma unroll
                for (int m = 0; m < 4; ++m) { bf16_t* rowp = base + (size_t)(row0 + ai * HALF + m * 16) * 512 + col0;
#pragma unroll
                    for (int bj = 0; bj < 2; ++bj) { f32x4 v0 = acc[ai][bj][m][0], v1 = acc[ai][bj][m][1];
                        if (t >= 4) {
                            unsigned lo = 0u, hi = 0u;
#pragma unroll
                            for (int e = 0; e < 4; ++e) { lo = __builtin_amdgcn_cvt_pk_u8_f32(sigmoid_f(v0[e]) * 255.0f, e, lo); hi = __builtin_amdgcn_cvt_pk_u8_f32(sigmoid_f(v1[e]) * 255.0f, e, hi); }
                            *(u32x2*)((unsigned char*)base + (size_t)(row0 + ai * HALF + m * 16) * 512 + col0 + bj * HALF) = (u32x2){lo, hi};
                            continue;
                        } else { v0 = v0 * sc; v1 = v1 * sc; }
                        u32x4 w; w.x = cvt_pk_bf16(v0[0], v0[1]); w.y = cvt_pk_bf16(v0[2], v0[3]); w.z = cvt_pk_bf16(v1[0], v1[1]); w.w = cvt_pk_bf16(v1[2], v1[3]);
                        *(u32x4*)(rowp + bj * HALF) = w; } }
            if (t == 2) {
#pragma unroll
                for (int bj = 0; bj < 2; ++bj)
#pragma unroll
                    for (int n = 0; n < 2; ++n) { f32x4 s = (f32x4){0.f, 0.f, 0.f, 0.f};
#pragma unroll
                        for (int ai = 0; ai < 2; ++ai)
#pragma unroll
                            for (int m = 0; m < 4; ++m) s += acc[ai][bj][m][n];
#pragma unroll
                        for (int e = 0; e < 4; ++e) { float x = s[e]; x += __shfl_xor(x, 1); x += __shfl_xor(x, 2); x += __shfl_xor(x, 4); x += __shfl_xor(x, 8); s[e] = x; }
                        if (fr == 0) *(f32x4*)(kpart + (size_t)(u.pm * 2 + wr) * 512 + col0 + bj * HALF + 4 * n) = s; }
            }
        }
    }
};
struct EpiE {
    static constexpr bool PERM = false; static constexpr bool CHAIN = false; static constexpr bool HALFN = true;
    float* E;
    __device__ __forceinline__ void operator()(const f32x4 (&acc)[2][2][4][2], const Unit& u, int wr, int wc, int fr, int fq) const {
        const int row0 = u.pm * BM + wr * 64 + fr, col0 = wc * 32 + 4 * fq;
#pragma unroll
        for (int ai = 0; ai < 2; ++ai)
#pragma unroll
            for (int m = 0; m < 4; ++m) { float* rowp = E + (size_t)(row0 + ai * HALF + m * 16) * 128 + col0;
#pragma unroll
                for (int n = 0; n < 2; ++n) *(f32x4*)(rowp + n * 16) = acc[ai][0][m][n]; }
    }
};
struct EpiY {
    static constexpr bool PERM = true; static constexpr bool CHAIN = false; static constexpr bool HALFN = false;
    bf16_t* Y;
    __device__ __forceinline__ void operator()(const f32x4 (&acc)[2][2][4][2], const Unit& u, int wr, int wc, int fr, int fq) const {
        const int row0 = u.pm * BM + wr * 64 + fr, col0 = u.pn * BM + wc * 32 + 8 * fq;
#pragma unroll
        for (int ai = 0; ai < 2; ++ai)
#pragma unroll
            for (int m = 0; m < 4; ++m) { const int r = row0 + ai * HALF + m * 16, g = r >> 9, b = (r >> 6) & 7, c = r & 63;
#pragma unroll
                for (int bj = 0; bj < 2; ++bj) { const int cc = col0 + bj * HALF, j = cc >> 4, ho0 = cc & 15;
                    f32x4 v0 = acc[ai][bj][m][0], v1 = acc[ai][bj][m][1];
#pragma unroll
                    for (int e = 0; e < 4; ++e) { v0[e] = gelu_tanh(v0[e]); v1[e] = gelu_tanh(v1[e]); }
                    u32x4 w; w.x = cvt_pk_bf16(v0[0], v0[1]); w.y = cvt_pk_bf16(v0[2], v0[3]); w.z = cvt_pk_bf16(v1[0], v1[1]); w.w = cvt_pk_bf16(v1[2], v1[3]);
                    *(u32x4*)(Y + (size_t)(b * 2048 + c * 32 + j) * 512 + g * 16 + ho0) = w; } }
    }
};
struct EpiGlu {
    static constexpr bool PERM = true; static constexpr bool CHAIN = false; static constexpr bool HALFN = false;
    const bf16_t* Yp; bf16_t* Ya; const float* bias;
    __device__ __forceinline__ void operator()(const f32x4 (&acc)[2][2][4][2], const Unit& u, int wr, int wc, int fr, int fq) const {
        const int row0 = u.pm * BM + wr * 64 + fr, col0 = u.pn * BM + wc * 32 + 8 * fq;
        f32x4 bv[2][2];
#pragma unroll
        for (int bj = 0; bj < 2; ++bj)
#pragma unroll
            for (int n = 0; n < 2; ++n) bv[bj][n] = *(const f32x4*)(bias + col0 + bj * HALF + 4 * n);
#pragma unroll
        for (int ai = 0; ai < 2; ++ai) {
            u32x4 yv[4][2];
#pragma unroll
            for (int m = 0; m < 4; ++m)
#pragma unroll
                for (int bj = 0; bj < 2; ++bj) yv[m][bj] = *(const u32x4*)(Yp + (size_t)(row0 + ai * HALF + m * 16) * 512 + col0 + bj * HALF);
#pragma unroll
            for (int m = 0; m < 4; ++m) { const size_t off = (size_t)(row0 + ai * HALF + m * 16) * 512 + col0;
#pragma unroll
                for (int bj = 0; bj < 2; ++bj) { const f32x4 z0 = acc[ai][bj][m][0] + bv[bj][0], z1 = acc[ai][bj][m][1] + bv[bj][1];
                    const u32x4 y = yv[m][bj];
                    u32x4 w; w.x = cvt_pk_bf16(bf_lo(y.x) * sigmoid_f(z0[0]), bf_hi(y.x) * sigmoid_f(z0[1])); w.y = cvt_pk_bf16(bf_lo(y.y) * sigmoid_f(z0[2]), bf_hi(y.y) * sigmoid_f(z0[3]));
                    w.z = cvt_pk_bf16(bf_lo(y.z) * sigmoid_f(z1[0]), bf_hi(y.z) * sigmoid_f(z1[1])); w.w = cvt_pk_bf16(bf_lo(y.w) * sigmoid_f(z1[2]), bf_hi(y.w) * sigmoid_f(z1[3]));
                    *(u32x4*)(Ya + off + bj * HALF) = w; } } }
    }
};
template <int ADD> struct EpiMrg {
    static constexpr bool PERM = true; static constexpr bool CHAIN = false; static constexpr bool HALFN = false;
    const bf16_t* G0; bf16_t* Mrg;
    __device__ __forceinline__ void operator()(const f32x4 (&acc)[2][2][4][2], const Unit& u, int wr, int wc, int fr, int fq) const {
        const int row0 = u.pm * BM + wr * 64 + fr, cin = wc * 32 + 8 * fq;
        const bf16_t* gb = G0 + (size_t)(u.pn >> 1) * (16u * 1024u * 1024u / 2u) + (u.pn & 1) * 256 + cin;
#pragma unroll
        for (int ai = 0; ai < 2; ++ai)
#pragma unroll
            for (int m = 0; m < 4; ++m) { const int r = row0 + ai * HALF + m * 16;
#pragma unroll
                for (int bj = 0; bj < 2; ++bj) {
#if defined(ABL_NO_SSM) || defined(ABL_NO_ATT)
#if defined(ABL_NO_SSM)
                    constexpr bool kill = (ADD == 0);
#else
                    constexpr bool kill = (ADD == 1);
#endif
                    const f32x4 a0 = kill ? (f32x4){0.f, 0.f, 0.f, 0.f} : acc[ai][bj][m][0], a1 = kill ? (f32x4){0.f, 0.f, 0.f, 0.f} : acc[ai][bj][m][1];
#else
                    const f32x4 a0 = acc[ai][bj][m][0], a1 = acc[ai][bj][m][1];
#endif
                    const u32x4 gt = *(const u32x4*)(gb + (size_t)r * 512 + bj * HALF);
                    bf16_t* mp = Mrg + (size_t)r * 1024 + u.pn * BM + cin + bj * HALF;
                    float o[8] = { bf_lo(gt.x) * a0[0], bf_hi(gt.x) * a0[1], bf_lo(gt.y) * a0[2], bf_hi(gt.y) * a0[3], bf_lo(gt.z) * a1[0], bf_hi(gt.z) * a1[1], bf_lo(gt.w) * a1[2], bf_hi(gt.w) * a1[3] };
                    if (ADD) { const u32x4 p = *(const u32x4*)mp; o[0] += bf_lo(p.x); o[1] += bf_hi(p.x); o[2] += bf_lo(p.y); o[3] += bf_hi(p.y); o[4] += bf_lo(p.z); o[5] += bf_hi(p.z); o[6] += bf_lo(p.w); o[7] += bf_hi(p.w); }
                    u32x4 w; w.x = cvt_pk_bf16(o[0], o[1]); w.y = cvt_pk_bf16(o[2], o[3]); w.z = cvt_pk_bf16(o[4], o[5]); w.w = cvt_pk_bf16(o[6], o[7]);
                    *(u32x4*)mp = w; } }
    }
};
struct EpiMrgDual {
    static constexpr bool PERM = true; static constexpr bool CHAIN = true; static constexpr bool HALFN = false;
    EpiMrg<0> a; EpiMrg<1> b;
    __device__ __forceinline__ void mid(f32x4 (&acc)[2][2][4][2], const Unit& u, int wr, int wc, int fr, int fq) const {
        const int row0 = u.pm * BM + wr * 64 + fr, cin = wc * 32 + 8 * fq;
        const size_t goff = (size_t)(u.pn >> 1) * (16u * 1024u * 1024u) + (u.pn & 1) * 256 + cin;
        u32x2 gav[2][4][2], gbv[2][4][2];
#pragma unroll
        for (int ai = 0; ai < 2; ++ai)
#pragma unroll
            for (int m = 0; m < 4; ++m)
#pragma unroll
                for (int bj = 0; bj < 2; ++bj) { const size_t o = goff + (size_t)(row0 + ai * HALF + m * 16) * 512 + bj * HALF;
                    gav[ai][m][bj] = *(const u32x2*)((const unsigned char*)a.G0 + o); gbv[ai][m][bj] = *(const u32x2*)((const unsigned char*)b.G0 + o); }
#pragma unroll
        for (int ai = 0; ai < 2; ++ai)
#pragma unroll
            for (int m = 0; m < 4; ++m) {
#pragma unroll
                for (int bj = 0; bj < 2; ++bj) {
                    const u32x2 ga = gav[ai][m][bj], gb = gbv[ai][m][bj];
                    float sa[8], sb[8];
#pragma unroll
                    for (int e = 0; e < 4; ++e) { sa[e] = (float)((ga.x >> (8 * e)) & 255u); sa[4 + e] = (float)((ga.y >> (8 * e)) & 255u); sb[e] = (float)((gb.x >> (8 * e)) & 255u); sb[4 + e] = (float)((gb.y >> (8 * e)) & 255u); }
#pragma unroll
                    for (int e = 0; e < 4; ++e) { acc[ai][bj][m][0][e] *= sa[e] * __builtin_amdgcn_rcpf(fmaxf(sb[e], 0.5f)); acc[ai][bj][m][1][e] *= sa[4 + e] * __builtin_amdgcn_rcpf(fmaxf(sb[4 + e], 0.5f)); } } }
    }
    __device__ __forceinline__ void operator()(const f32x4 (&acc)[2][2][4][2], const Unit& u, int wr, int wc, int fr, int fq) const {
        const int row0 = u.pm * BM + wr * 64 + fr, cin = wc * 32 + 8 * fq;
        const unsigned char* gb = (const unsigned char*)b.G0 + (size_t)(u.pn >> 1) * (16u * 1024u * 1024u) + (u.pn & 1) * 256 + cin;
        u32x2 gv[2][4][2];
#pragma unroll
        for (int ai = 0; ai < 2; ++ai)
#pragma unroll
            for (int m = 0; m < 4; ++m)
#pragma unroll
                for (int bj = 0; bj < 2; ++bj) gv[ai][m][bj] = *(const u32x2*)(gb + (size_t)(row0 + ai * HALF + m * 16) * 512 + bj * HALF);
#pragma unroll
        for (int ai = 0; ai < 2; ++ai)
#pragma unroll
            for (int m = 0; m < 4; ++m) { const int r = row0 + ai * HALF + m * 16;
#pragma unroll
                for (int bj = 0; bj < 2; ++bj) { const f32x4 a0 = acc[ai][bj][m][0] * (1.0f / 255.0f), a1 = acc[ai][bj][m][1] * (1.0f / 255.0f);
                    const u32x2 gt = gv[ai][m][bj];
                    float g[8];
#pragma unroll
                    for (int e = 0; e < 4; ++e) { g[e] = fmaxf((float)((gt.x >> (8 * e)) & 255u), 0.5f); g[4 + e] = fmaxf((float)((gt.y >> (8 * e)) & 255u), 0.5f); }
                    u32x4 w; w.x = cvt_pk_bf16(g[0] * a0[0], g[1] * a0[1]); w.y = cvt_pk_bf16(g[2] * a0[2], g[3] * a0[3]);
                    w.z = cvt_pk_bf16(g[4] * a1[0], g[5] * a1[1]); w.w = cvt_pk_bf16(g[6] * a1[2], g[7] * a1[3]);
                    *(u32x4*)(b.Mrg + (size_t)r * 1024 + u.pn * BM + cin + bj * HALF) = w; } }
    }
};
struct EpiX1 {
    static constexpr bool PERM = true; static constexpr bool CHAIN = false; static constexpr bool HALFN = false;
    const float* X; float* X1; bf16_t* XG; const float* g2; float* ssq;
    __device__ __forceinline__ void operator()(const f32x4 (&acc)[2][2][4][2], const Unit& u, int wr, int wc, int fr, int fq) const {
        const int row0 = u.pm * BM + wr * 64 + fr, col0 = u.pn * BM + wc * 32 + 8 * fq;
#pragma unroll
        for (int ai = 0; ai < 2; ++ai) {
            f32x4 xv[4][2][2];
#pragma unroll
            for (int m = 0; m < 4; ++m)
#pragma unroll
                for (int bj = 0; bj < 2; ++bj) { const float* xp = X + (size_t)(row0 + ai * HALF + m * 16) * 1024 + col0 + bj * HALF; xv[m][bj][0] = *(const f32x4*)xp; xv[m][bj][1] = *(const f32x4*)(xp + 4); }
#pragma unroll
            for (int m = 0; m < 4; ++m) { const int r = row0 + ai * HALF + m * 16; const size_t off = (size_t)r * 1024 + col0; float s = 0.f;
#pragma unroll
                for (int bj = 0; bj < 2; ++bj) {
                    const f32x4 x0 = xv[m][bj][0] + acc[ai][bj][m][0], x1 = xv[m][bj][1] + acc[ai][bj][m][1];
                    s += (x0[0] * x0[0] + x0[1] * x0[1]) + (x0[2] * x0[2] + x0[3] * x0[3]) + (x1[0] * x1[0] + x1[1] * x1[1]) + (x1[2] * x1[2] + x1[3] * x1[3]);
                    u32x4 w; w.x = cvt_pk_bf16(x0[0], x0[1]); w.y = cvt_pk_bf16(x0[2], x0[3]); w.z = cvt_pk_bf16(x1[0], x1[1]); w.w = cvt_pk_bf16(x1[2], x1[3]);
                    *(u32x4*)(XG + off + bj * HALF) = w; }
                s += __shfl_xor(s, 16); s += __shfl_xor(s, 32);
                if (fq == 0) ssq[(size_t)r * 16 + u.pn * 4 + wc] = s; } }
    }
};
struct EpiPlain {
    static constexpr bool PERM = true; static constexpr bool CHAIN = false; static constexpr bool HALFN = false;
    bf16_t* O; int ldc;
    __device__ __forceinline__ void operator()(const f32x4 (&acc)[2][2][4][2], const Unit& u, int wr, int wc, int fr, int fq) const {
        const int row0 = u.pm * BM + wr * 64 + fr, col0 = u.pn * BM + wc * 32 + 8 * fq;
#pragma unroll
        for (int ai = 0; ai < 2; ++ai)
#pragma unroll
            for (int m = 0; m < 4; ++m) { bf16_t* rowp = O + (size_t)(row0 + ai * HALF + m * 16) * ldc + col0;
#pragma unroll
                for (int bj = 0; bj < 2; ++bj) { const f32x4 v0 = acc[ai][bj][m][0], v1 = acc[ai][bj][m][1];
                    u32x4 w; w.x = cvt_pk_bf16(v0[0], v0[1]); w.y = cvt_pk_bf16(v0[2], v0[3]); w.z = cvt_pk_bf16(v1[0], v1[1]); w.w = cvt_pk_bf16(v1[2], v1[3]);
                    *(u32x4*)(rowp + bj * HALF) = w; } }
    }
};
}
struct Frame {
    LAS unsigned char* lds;
    int tid, lane, wave, vcu, G;
};

__device__ __forceinline__ void p0_transpose_item(const float* W, int K, int N, bf16* WT, LAS float* scr, int item, int lane, const float* kscale = nullptr) {
    const int nblk = N / 32, kb = item / nblk, nb = item % nblk, k0 = 64 * kb, n0 = 32 * nb;
    f32x4 wv[8];
#pragma unroll
    for (int i = 0; i < 8; ++i) { const int kk = 8 * i + (lane >> 3); wv[i] = *(const GAS f32x4*)(W + (size_t)(k0 + kk) * N + n0 + 4 * (lane & 7)); }
    if (kscale) {
#pragma unroll
        for (int i = 0; i < 8; ++i) wv[i] = wv[i] * kscale[k0 + 8 * i + (lane >> 3)]; }
#pragma unroll
    for (int i = 0; i < 8; ++i) { const int kk = 8 * i + (lane >> 3); LAS float* d = scr + kk * 33 + 4 * (lane & 7); d[0] = wv[i].x; d[1] = wv[i].y; d[2] = wv[i].z; d[3] = wv[i].w; }
    LDS_WAIT(); asm volatile("" ::: "memory");
    const int c = lane & 7;
#pragma unroll
    for (int j = 0; j < 4; ++j) { const int n = (lane >> 3) + 8 * j; const LAS float* s = scr + (8 * c) * 33 + n;
        v4u o; o.x = pk2(s[0 * 33], s[1 * 33]); o.y = pk2(s[2 * 33], s[3 * 33]); o.z = pk2(s[4 * 33], s[5 * 33]); o.w = pk2(s[6 * 33], s[7 * 33]);
        *(GAS v4u*)(WT + (size_t)(n0 + n) * K + k0 + 8 * c) = o; }
    LDS_WAIT(); asm volatile("" ::: "memory");
}
__device__ __forceinline__ void rms_row_to_bf16(const float* xrow, const float* g, bf16* orow, int lane) {
    const GAS f32x4* xr = (const GAS f32x4*)xrow + lane; const GAS f32x4* gr = (const GAS f32x4*)g + lane;
    f32x4 v[4]; float s = 0.f;
#pragma unroll
    for (int j = 0; j < 4; ++j) { v[j] = xr[64 * j]; s += (v[j].x * v[j].x + v[j].y * v[j].y) + (v[j].z * v[j].z + v[j].w * v[j].w); }
    const float rstd = 1.0f / sqrtf(wave_sum(s) * (1.f / DMODEL) + RMS_EPS);
    GAS unsigned long long* o8 = (GAS unsigned long long*)orow + lane;
#pragma unroll
    for (int j = 0; j < 4; ++j) { const f32x4 gg = gr[64 * j];
        o8[64 * j] = (unsigned long long)pk2(v[j].x * rstd * gg.x, v[j].y * rstd * gg.y) | ((unsigned long long)pk2(v[j].z * rstd * gg.z, v[j].w * rstd * gg.w) << 32); }
}
__device__ __forceinline__ void rms_rows4_to_bf16(const float* x, const float* g, bf16* out, int m, int stride, int lane) {
    f32x4 v[4][4];
#pragma unroll
    for (int k = 0; k < 4; ++k) { const int mm = (m + k * stride < MTOK) ? m + k * stride : m; const GAS f32x4* xr = (const GAS f32x4*)(x + (size_t)mm * DMODEL) + lane;
#pragma unroll
        for (int j = 0; j < 4; ++j) v[k][j] = xr[64 * j]; }
    const GAS f32x4* gr = (const GAS f32x4*)g + lane; f32x4 gg[4];
#pragma unroll
    for (int j = 0; j < 4; ++j) gg[j] = gr[64 * j];
#pragma unroll
    for (int k = 0; k < 4; ++k) { if (m + k * stride >= MTOK) break; float s = 0.f;
#pragma unroll
        for (int j = 0; j < 4; ++j) s += (v[k][j].x * v[k][j].x + v[k][j].y * v[k][j].y) + (v[k][j].z * v[k][j].z + v[k][j].w * v[k][j].w);
        const float rstd = 1.0f / sqrtf(wave_sum(s) * (1.f / DMODEL) + RMS_EPS);
        GAS unsigned long long* o8 = (GAS unsigned long long*)(out + (size_t)(m + k * stride) * DMODEL) + lane;
#pragma unroll
        for (int j = 0; j < 4; ++j) o8[64 * j] = (unsigned long long)pk2(v[k][j].x * rstd * gg[j].x, v[k][j].y * rstd * gg[j].y) | ((unsigned long long)pk2(v[k][j].z * rstd * gg[j].z, v[k][j].w * rstd * gg[j].w) << 32); }
}
struct cpx { float r, i; };
__device__ __forceinline__ cpx cmul(cpx a, cpx b) { return cpx{a.r * b.r - a.i * b.i, a.r * b.i + a.i * b.r}; }
__device__ __forceinline__ cpx cpow_(float ar, float ai, float dt, int n) { const float e = expf(ar * dt * (float)n); const float ang = ai * dt * (float)n; return cpx{e * cosf(ang), e * sinf(ang)}; }
__device__ __forceinline__ void ssm_table_task(int g, int j, int lane, LAS float* scr, const float* a_re, const float* a_im, const float* log_dt, const float* b_re, const float* b_im,
                                               const float* c_re, const float* c_im, float* Kg, bf16* WE, bf16* BP, float* pw32) {
    const int p = lane;
    const float dt = expf(log_dt[g]), ar = a_re[g * 64 + p], ai = a_im[g * 64 + p];
#define pw(n) cpow_(ar, ai, dt, (n))
    const cpx lb = pw(1);
    const float den = ar * ar + ai * ai;
    const cpx coef = cpx{((lb.r - 1.f) * ar + lb.i * ai) / den, (lb.i * ar - (lb.r - 1.f) * ai) / den};
    const cpx pj = pw(j), pe = pw(31 - j), pv = pw(j + 1);
    unsigned wer[8], wei[8];
#pragma unroll
    for (int h2 = 0; h2 < 8; ++h2) { float er[2], ei[2];
#pragma unroll
        for (int q = 0; q < 2; ++q) { const int hi = 2 * h2 + q;
            const cpx bb = cmul(coef, cpx{b_re[(g * 64 + p) * 16 + hi], b_im[(g * 64 + p) * 16 + hi]});
            const cpx w = cmul(pj, bb); scr[(p * 16 + hi) * 2] = w.r; scr[(p * 16 + hi) * 2 + 1] = w.i;
            const cpx e = cmul(pe, bb); er[q] = e.r; ei[q] = e.i; }
        wer[h2] = pk2(er[0], er[1]); wei[h2] = pk2(ei[0], ei[1]); }
    { bf16* w0 = WE + ((size_t)(g * 256 + p) * 512 + j * 16); bf16* w1 = WE + ((size_t)(g * 256 + 64 + p) * 512 + j * 16);
      *(GAS v4u*)w0 = (v4u){wer[0], wer[1], wer[2], wer[3]}; *(GAS v4u*)(w0 + 8) = (v4u){wer[4], wer[5], wer[6], wer[7]};
      *(GAS v4u*)w1 = (v4u){wei[0], wei[1], wei[2], wei[3]}; *(GAS v4u*)(w1 + 8) = (v4u){wei[4], wei[5], wei[6], wei[7]};
      bf16* z0 = WE + ((size_t)(g * 256 + 128 + p) * 512 + j * 16); bf16* z1 = WE + ((size_t)(g * 256 + 192 + p) * 512 + j * 16); const v4u z = (v4u){0u, 0u, 0u, 0u};
      *(GAS v4u*)z0 = z; *(GAS v4u*)(z0 + 8) = z; *(GAS v4u*)z1 = z; *(GAS v4u*)(z1 + 8) = z; }
#pragma unroll 4
    for (int ho = 0; ho < 16; ++ho) { const cpx cv = cmul(cpx{c_re[(g * 16 + ho) * 64 + p], c_im[(g * 16 + ho) * 64 + p]}, pv);
        bf16* row = BP + ((size_t)(g * 512 + j * 16 + ho) * APK + 512);
        row[p] = (bf16)f2bf(cv.r); row[64 + p] = (bf16)f2bf(-cv.i); }
    if (j == 0) { const cpx p32 = pw(32); pw32[g * 128 + p] = p32.r; pw32[g * 128 + 64 + p] = p32.i; }
    LDS_WAIT(); asm volatile("" ::: "memory");
    { const int ho = lane >> 2, h4 = (lane & 3) * 4; float a0 = 0.f, a1 = 0.f, a2 = 0.f, a3 = 0.f;
      const float* cr = c_re + (g * 16 + ho) * 64; const float* ci = c_im + (g * 16 + ho) * 64;
#pragma unroll 4
      for (int pp = 0; pp < 64; ++pp) { const float r_ = cr[pp], i_ = ci[pp]; const LAS float* w = scr + (pp * 16 + h4) * 2;
          a0 += r_ * w[0] - i_ * w[1]; a1 += r_ * w[2] - i_ * w[3]; a2 += r_ * w[4] - i_ * w[5]; a3 += r_ * w[6] - i_ * w[7]; }
      *(GAS f32x4*)(Kg + ((size_t)(g * 32 + j) * 256 + ho * 16 + h4)) = (f32x4){a0, a1, a2, a3}; }
    LDS_WAIT(); asm volatile("" ::: "memory");
#undef pw
}

__device__ __forceinline__ float vmaxf(float a, float b) { float r; asm("v_max_f32_e32 %0, %1, %2" : "=v"(r) : "v"(a), "v"(b)); return r; }
__device__ __forceinline__ float vminf(float a, float b) { float r; asm("v_min_f32_e32 %0, %1, %2" : "=v"(r) : "v"(a), "v"(b)); return r; }
__device__ __forceinline__ float selhi(float lo, float hi) { float r; asm("v_cndmask_b32_e64 %0, %1, %2, %3" : "=v"(r) : "v"(lo), "v"(hi), "s"(0xFFFFFFFF00000000ull)); return r; }
#define CE_DESC(a, b) do { const float hi_ = vmaxf(a, b), lo_ = vminf(a, b); a = hi_; b = lo_; } while (0)
__device__ __forceinline__ void sort16_desc(float (&v)[16]) {
#pragma unroll
    for (int k = 2; k <= 16; k <<= 1)
#pragma unroll
        for (int j = k >> 1; j > 0; j >>= 1)
#pragma unroll
            for (int i = 0; i < 16; ++i) { const int l = i ^ j; if (l > i) { if ((i & k) == 0) CE_DESC(v[i], v[l]); else CE_DESC(v[l], v[i]); } }
}
__device__ __forceinline__ void bitonic_merge16_desc(float (&v)[16]) {
#pragma unroll
    for (int j = 8; j > 0; j >>= 1)
#pragma unroll
        for (int i = 0; i < 16; ++i) { const int l = i ^ j; if (l > i) CE_DESC(v[i], v[l]); }
}
__device__ __forceinline__ void merge_top16(float (&a)[16], const float (&b)[16]) {
#pragma unroll
    for (int i = 0; i < 16; ++i) a[i] = vmaxf(a[i], b[15 - i]);
    bitonic_merge16_desc(a);
}
__device__ __forceinline__ void merge_partner_top16(float (&a)[16]) {
    float p[16];
#pragma unroll
    for (int i = 0; i < 16; ++i) { const unsigned x = __float_as_uint(a[15 - i]); auto rr = __builtin_amdgcn_permlane32_swap(x, x, false, false); p[i] = selhi(__uint_as_float(rr[1]), __uint_as_float(rr[0])); }
#pragma unroll
    for (int i = 0; i < 16; ++i) a[i] = vmaxf(a[i], p[i]);
    bitonic_merge16_desc(a);
}
__device__ __forceinline__ void topk_half(int half, const bf16x8 (&qf)[8], int r32, int hi, const LAS unsigned char* ksl, float (&top)[16]) {
#pragma unroll 1
    for (int kt = 0; kt < 4; ++kt) {
        f32x16 acc = f32x16{};
        const int row = half * 128 + kt * 32 + r32; const LAS unsigned char* rp = ksl + row * 256; const int sw = row & 15;
#pragma unroll
        for (int ks = 0; ks < 8; ++ks) { const bf16x8 a = *(const LAS bf16x8*)(rp + (((2 * ks + hi) ^ sw) << 4));
            acc = __builtin_amdgcn_mfma_f32_32x32x16_bf16(a, qf[ks], acc, 0, 0, 0); }
        float grp[16];
#pragma unroll
        for (int r = 0; r < 16; ++r) { const unsigned key = (unsigned)(kt * 32 + (r & 3) + 8 * (r >> 2)) + 4u * (unsigned)hi; grp[r] = __uint_as_float((__float_as_uint(acc[r]) & ~127u) | key); }
        sort16_desc(grp);
        if (kt == 0) {
#pragma unroll
            for (int i = 0; i < 16; ++i) top[i] = grp[i];
        } else merge_top16(top, grp);
    }
    merge_partner_top16(top);
}
__device__ __forceinline__ void topk_task(int tt, int hd, int lane, LAS unsigned char* scr, const bf16* PQb, const LAS unsigned char* ksl, const float* ssq1, int* ids, float* gts, float* rstd1) {
    const int r32 = lane & 31, hi = lane >> 5; const bool hib = hi != 0;
    const int token = tt * 32 + r32;
    float v0_[16], v1_[16];
    bf16x8 qf0[8], qf1[8];
#pragma unroll
    for (int ks = 0; ks < 8; ++ks) { qf0[ks] = *(const GAS bf16x8*)(PQb + (size_t)token * PQ + hd * 256 + ks * 16 + hi * 8); qf1[ks] = *(const GAS bf16x8*)(PQb + (size_t)token * PQ + hd * 256 + 128 + ks * 16 + hi * 8); }
    topk_half(0, qf0, r32, hi, ksl, v0_);
    topk_half(1, qf1, r32, hi, ksl, v1_);
#define v_SEL(h, i) ((h) ? v1_[i] : v0_[i])
    LAS unsigned char* slot = scr + lane * 32;
    { v4u d0, d1;
#define PK4(h, k) ((__float_as_uint(v_SEL(h, 4 * (k))) & 127u) | ((__float_as_uint(v_SEL(h, 4 * (k) + 1)) & 127u) << 8) | ((__float_as_uint(v_SEL(h, 4 * (k) + 2)) & 127u) << 16) | ((__float_as_uint(v_SEL(h, 4 * (k) + 3)) & 127u) << 24))
      d0 = (v4u){PK4(0, 0), PK4(0, 1), PK4(0, 2), PK4(0, 3)}; d1 = (v4u){PK4(1, 0), PK4(1, 1), PK4(1, 2), PK4(1, 3)};
#undef PK4
      *(LAS v4u*)slot = d0; *(LAS v4u*)(slot + 16) = d1; }
    float a[16], b[16];
#pragma unroll
    for (int i = 0; i < 16; ++i) { a[i] = selhi(v0_[i], v1_[i]); b[i] = selhi(v1_[i], v0_[i]); }
    const unsigned obit = (unsigned)hi << 8;
#define CAND(i, j) __uint_as_float((__float_as_uint(a[i] + b[j]) & ~511u) | obit | (unsigned)(((i) << 4) | (j)))
    const float NEGBIG = -3.0e38f;
    float g0[16], g1[16];
#pragma unroll
    for (int j = 1; j < 16; ++j) g0[j - 1] = CAND(0, j);
    g0[15] = CAND(1, 2);
    g1[0] = CAND(1, 3); g1[1] = CAND(1, 4); g1[2] = CAND(1, 5); g1[3] = CAND(1, 6); g1[4] = CAND(1, 7); g1[5] = CAND(2, 3); g1[6] = CAND(2, 4);
    { const float c0 = CAND(0, 0), c1 = CAND(1, 1), c2 = CAND(2, 2), c3 = CAND(3, 3);
      g1[7] = selhi(c0, NEGBIG); g1[8] = selhi(c1, NEGBIG); g1[9] = selhi(c2, NEGBIG); g1[10] = selhi(c3, NEGBIG); }
#pragma unroll
    for (int i = 11; i < 16; ++i) g1[i] = NEGBIG;
#undef CAND
    sort16_desc(g0); sort16_desc(g1); merge_top16(g0, g1); merge_partner_top16(g0);
    float rstd;
    { const GAS f32x4* sp = (const GAS f32x4*)(ssq1 + (size_t)token * 16); const f32x4 s0 = sp[0], s1 = sp[1], s2 = sp[2], s3 = sp[3];
      const float ss = ((s0.x + s0.y) + (s0.z + s0.w)) + ((s1.x + s1.y) + (s1.z + s1.w)) + ((s2.x + s2.y) + (s2.z + s2.w)) + ((s3.x + s3.y) + (s3.z + s3.w));
      rstd = 1.0f / sqrtf(ss * (1.f / DMODEL) + RMS_EPS); }
    if (hd == 0 && !hib) rstd1[token] = rstd;
    float ex[16], esum = 0.f; const float sc = rstd * 1.4426950409f;
#pragma unroll
    for (int k = 0; k < 16; ++k) { ex[k] = __builtin_amdgcn_exp2f((g0[k] - g0[0]) * sc); esum += ex[k]; }
    const float inv = 1.0f / esum;
    int eid[8]; float gv[8];
#pragma unroll
    for (int k = 0; k < 8; ++k) { const float wv = selhi(g0[k], g0[8 + k]); const float ev = selhi(ex[k], ex[8 + k]);
        const unsigned tag = __float_as_uint(wv) & 511u, o = tag >> 8, i = (tag >> 4) & 15u, j = tag & 15u; const unsigned i1 = o ? j : i, i2 = o ? i : j;
        const unsigned k1 = slot[i1], k2 = slot[16 + i2];
        eid[k] = (int)(k1 * 128u + k2); gv[k] = ev * inv; }
    { int* ip = ids + (size_t)token * 128 + hd * 16 + 8 * hi; (void)gts;
      unsigned pk[8];
#pragma unroll
      for (int k = 0; k < 8; ++k) { const _Float16 gh = (_Float16)gv[k]; pk[k] = ((unsigned)__builtin_bit_cast(unsigned short, gh) << 16) | (unsigned)eid[k]; }
      *(GAS v4u*)ip = (v4u){pk[0], pk[1], pk[2], pk[3]}; *(GAS v4u*)(ip + 4) = (v4u){pk[4], pk[5], pk[6], pk[7]}; }
    LDS_WAIT(); asm volatile("" ::: "memory");
}


__device__ __forceinline__ float dot2bf(unsigned a, unsigned b, float c) { return __builtin_amdgcn_fdot2_f32_bf16(__builtin_bit_cast(bf16x2_t, a), __builtin_bit_cast(bf16x2_t, b), c, false); }
__device__ __forceinline__ h2_t fma_h2(unsigned v, h2_t w, h2_t acc) { return __builtin_elementwise_fma(__builtin_bit_cast(h2_t, v), w, acc); }
__device__ __forceinline__ unsigned fp8lo_bf(unsigned w, float sc) { return __builtin_bit_cast(unsigned, __builtin_amdgcn_cvt_scalef32_pk_bf16_fp8((int)w, sc, false)); }
__device__ __forceinline__ unsigned fp8hi_bf(unsigned w, float sc) { return __builtin_bit_cast(unsigned, __builtin_amdgcn_cvt_scalef32_pk_bf16_fp8((int)w, sc, true)); }
__device__ __forceinline__ h2_t fp8lo_h(unsigned w, float sc) { return __builtin_amdgcn_cvt_scalef32_pk_f16_fp8((int)w, sc, false); }
__device__ __forceinline__ h2_t fp8hi_h(unsigned w, float sc) { return __builtin_amdgcn_cvt_scalef32_pk_f16_fp8((int)w, sc, true); }
__device__ __forceinline__ unsigned pack_fp8x4(float a, float b, float c, float d) { int w = __builtin_amdgcn_cvt_pk_fp8_f32(a, b, 0, false); w = __builtin_amdgcn_cvt_pk_fp8_f32(c, d, w, true); return (unsigned)w; }
constexpr size_t V6B_OFF = 8u << 20;
constexpr float U8_SCALE = 64.0f, V8_SCALE = 5.656854f;
constexpr int PA_CAP = 456;
constexpr float X8_SCALE = 2.0f;
typedef int v8i_t __attribute__((ext_vector_type(8)));
typedef _Float16 v32h_t __attribute__((ext_vector_type(32)));
typedef unsigned v6u_t __attribute__((ext_vector_type(6)));
typedef unsigned v2u __attribute__((ext_vector_type(2)));
struct TokB { v8i_t b[8]; };
struct RowsA { const unsigned char* p0; const unsigned char* p1; };
__device__ __forceinline__ int pa_tok(unsigned tl, int tb, int nwg) { return ((tl < 4u) ? tb : nwg) + (int)(tl & 3u); }
__device__ __forceinline__ RowsA pa_rows(int b, int n, int lane, const LAS unsigned* list, const unsigned char* U6) {
    const int i0 = b * 16 + (lane >> 3), r8 = lane >> 3, ps = lane & 7;
    const unsigned e0 = list[i0 < n ? i0 : 0], e1 = list[i0 + 8 < n ? i0 + 8 : 0];
    RowsA R; R.p0 = U6 + (size_t)(e0 & 0x3fffu) * 512 + ((ps ^ r8) * 16); R.p1 = U6 + (size_t)(e1 & 0x3fffu) * 512 + ((ps ^ r8 ^ 2) * 16);
    return R;
}
template <int J> __device__ __forceinline__ void pa_dma(const RowsA& R, LAS unsigned char* ring) {
    __builtin_amdgcn_global_load_lds((const unsigned*)R.p0, (LAS unsigned*)(ring + J * (2048 - 128)), 16, J * 128, 0);
    __builtin_amdgcn_global_load_lds((const unsigned*)R.p1, (LAS unsigned*)(ring + J * (2048 - 128) + 1024), 16, J * 128, 0);
}
#define PA_VWAIT(n) asm volatile("s_waitcnt vmcnt(" #n ")" ::: "memory")
#define PA_LWAIT(n) asm volatile("s_waitcnt lgkmcnt(" #n ")" ::: "memory")
struct OpA { v4u d; };
__device__ __forceinline__ OpA pa_rd(int m, const LAS unsigned char* ring, int r, int g) { OpA a;
    a.d = *(const LAS v4u*)(ring + (m >> 1) * 2048 + (r >> 3) * 1024 + (r & 7) * 128 + (((4 * (m & 1) + g) ^ (r & 7) ^ ((r >> 3) << 1)) << 4)); return a; }
__device__ __forceinline__ f32x4 pa_mm(f32x4 acc, const OpA& a, const TokB& X, int m) {
    return __builtin_amdgcn_mfma_scale_f32_16x16x128_f8f6f4((v8i_t){(int)a.d.x, (int)a.d.y, (int)a.d.z, (int)a.d.w, 0, 0, 0, 0}, X.b[m], acc, 4, 2, 0, 0, 0, 0);
}
__device__ __forceinline__ void pa_flush(int n, const TokB& X, int lane, LAS unsigned* list, const LAS unsigned short* gl, LAS unsigned char* ring, const unsigned char* U6, unsigned* wpk, int tb, int nwg) {
    if (n == 0) return;
    LDS_WAIT(); asm volatile("" ::: "memory");
    const int nb = (n + 15) >> 4;
    const int r = lane & 15, g = lane >> 4;
    { const RowsA R0 = pa_rows(0, n, lane, list, U6); pa_dma<0>(R0, ring); pa_dma<1>(R0, ring); pa_dma<2>(R0, ring); pa_dma<3>(R0, ring);
      if (nb > 1) { const RowsA R1 = pa_rows(1, n, lane, list, U6); pa_dma<0>(R1, ring + 8192); pa_dma<1>(R1, ring + 8192); pa_dma<2>(R1, ring + 8192); pa_dma<3>(R1, ring + 8192); } }
    for (int b = 0; b < nb; b += 4) {
        f32x4 acc[4];
#pragma unroll
        for (int j = 0; j < 4; ++j) { const int bb = b + j; acc[j] = (f32x4){0.f, 0.f, 0.f, 0.f};
          if (bb < nb) {
            LAS unsigned char* buf = ring + (j & 1) * 8192;
            if (bb + 1 >= nb) PA_VWAIT(0); else if (j < 2 && b > 0) PA_VWAIT(9); else PA_VWAIT(8);
            const OpA A0 = pa_rd(0, buf, r, g), A1 = pa_rd(1, buf, r, g), A2 = pa_rd(2, buf, r, g), A3 = pa_rd(3, buf, r, g);
            const OpA A4 = pa_rd(4, buf, r, g), A5 = pa_rd(5, buf, r, g), A6 = pa_rd(6, buf, r, g), A7 = pa_rd(7, buf, r, g);
            if (bb + 2 < nb) { const RowsA R2 = pa_rows(bb + 2, n, lane, list, U6); PA_LWAIT(0); pa_dma<0>(R2, buf); pa_dma<1>(R2, buf); pa_dma<2>(R2, buf); pa_dma<3>(R2, buf); }
            else PA_LWAIT(0);
            f32x4 a0 = {0.f, 0.f, 0.f, 0.f}, a1 = {0.f, 0.f, 0.f, 0.f};
            a0 = pa_mm(a0, A0, X, 0); a1 = pa_mm(a1, A1, X, 1); a0 = pa_mm(a0, A2, X, 2); a1 = pa_mm(a1, A3, X, 3);
            a0 = pa_mm(a0, A4, X, 4); a1 = pa_mm(a1, A5, X, 5); a0 = pa_mm(a0, A6, X, 6); a1 = pa_mm(a1, A7, X, 7);
            acc[j] = a0 + a1; } }
        const int idx = b * 16 + lane, idc = idx < n ? idx : n - 1; const unsigned ent = list[idc], tl = ent >> 21, slot = (ent >> 14) & 127u;
        const int src = (int)((((unsigned)r >> 2) * 16u + tl) << 2);
        float sel[4];
#pragma unroll
        for (int i = 0; i < 4; ++i) {
            const float t0 = __int_as_float(__builtin_amdgcn_ds_bpermute(src, __float_as_int(acc[0][i]))), t1 = __int_as_float(__builtin_amdgcn_ds_bpermute(src, __float_as_int(acc[1][i])));
            const float t2 = __int_as_float(__builtin_amdgcn_ds_bpermute(src, __float_as_int(acc[2][i]))), t3 = __int_as_float(__builtin_amdgcn_ds_bpermute(src, __float_as_int(acc[3][i])));
            sel[i] = (g & 2) ? ((g & 1) ? t3 : t2) : ((g & 1) ? t1 : t0); }
        const float dv = (r & 2) ? ((r & 1) ? sel[3] : sel[2]) : ((r & 1) ? sel[1] : sel[0]);
        if (idx < n) { const int t = pa_tok(tl, tb, nwg);
            const _Float16 wh = (_Float16)((float)__builtin_bit_cast(_Float16, gl[tl * 128 + slot]) * (1.0f / V8_SCALE) * gelu_tanh(dv * (1.0f / (U8_SCALE * X8_SCALE))));
            unsigned pos; { const unsigned la = (unsigned)(size_t)(list + PA_CAP) + tl * 4u, one = 1u;
                asm volatile("ds_add_rtn_u32 %0, %1, %2\n\ts_waitcnt lgkmcnt(0)" : "=v"(pos) : "v"(la), "v"(one) : "memory"); }
            wpk[(size_t)t * 128 + pos] = ((unsigned)__builtin_bit_cast(unsigned short, wh) << 16) | (ent & 0x3fffu); }
    }
    LDS_WAIT(); asm volatile("" ::: "memory");
}
__device__ __forceinline__ void peer_a_phase(int lane, int wave, int G, int vcu, const bf16* XG, const unsigned char* U6, const int* ids, const float* gts, const float* rstd1, unsigned* wpk, LAS unsigned char* lds, const float* g2) {
    LAS unsigned char* ring = lds + RING_OFF + wave * 16384;
    LAS unsigned short* gl = (LAS unsigned short*)(lds + GATE_OFF + wave * 2048);
    LAS unsigned* list = (LAS unsigned*)(lds + MISC_OFF + 128 + wave * (464 * 4));
    for (int tile0 = vcu; tile0 < MTOK / 32; tile0 += 2 * G) {
        const int tile1 = tile0 + G; const bool has1 = tile1 < MTOK / 32;
        const int tb = tile0 * 32 + wave * 4, nwg = (has1 ? tile1 : tile0) * 32 + wave * 4;
        int id0[8], id1[8];
        if (lane < 8) list[PA_CAP + lane] = 0u;
#pragma unroll
        for (int k = 0; k < 8; ++k) { const bool ok = (k < 4) || has1; const int tc = pa_tok((unsigned)k, tb, nwg);
            { const unsigned p0 = (unsigned)ids[(size_t)tc * 128 + lane], p1 = (unsigned)ids[(size_t)tc * 128 + 64 + lane]; (void)gts;
              const unsigned short h0 = (unsigned short)(p0 >> 16), h1 = (unsigned short)(p1 >> 16);
              gl[k * 128 + lane] = h0; gl[k * 128 + 64 + lane] = h1;
              id0[k] = ok ? (int)(p0 & 0x3fffu) : -1; id1[k] = ok ? (int)(p1 & 0x3fffu) : -1; } }
#pragma unroll
        for (int p = 0; p < 4; ++p) { const int k = 2 * p + (lane >> 5), tc = pa_tok((unsigned)k, tb, nwg);
            typedef float v16f_t __attribute__((ext_vector_type(16)));
            const GAS v4u* xs = (const GAS v4u*)(XG + (size_t)tc * 1024 + 32 * (lane & 31));
            const v4u x0 = xs[0], x1 = xs[1], x2 = xs[2], x3 = xs[3];
            const float rs = rstd1[tc] * X8_SCALE;
            const unsigned w[16] = {x0.x, x0.y, x0.z, x0.w, x1.x, x1.y, x1.z, x1.w, x2.x, x2.y, x2.z, x2.w, x3.x, x3.y, x3.z, x3.w};
            float f[32];
#pragma unroll
            for (int i = 0; i < 8; ++i) { const f32x4 gq = *(const GAS f32x4*)(g2 + 32 * (lane & 31) + 4 * i);
                f[4 * i] = __uint_as_float(w[2 * i] << 16) * rs * gq.x; f[4 * i + 1] = __uint_as_float(w[2 * i] & 0xffff0000u) * rs * gq.y;
                f[4 * i + 2] = __uint_as_float(w[2 * i + 1] << 16) * rs * gq.z; f[4 * i + 3] = __uint_as_float(w[2 * i + 1] & 0xffff0000u) * rs * gq.w; }
            v32h_t hx;
#pragma unroll
            for (int i = 0; i < 32; ++i) hx[i] = (_Float16)f[i];
            v6u_t p6; asm volatile("s_nop 1\n\tv_cvt_scalef32_pk32_fp6_f16 %0, %1, 1.0" : "=&v"(p6) : "v"(hx));
            LAS v2u* dst = (LAS v2u*)(ring + k * 768 + 24 * (lane & 31)); dst[0] = (v2u){p6[0], p6[1]}; dst[1] = (v2u){p6[2], p6[3]}; dst[2] = (v2u){p6[4], p6[5]}; }
        LDS_WAIT(); asm volatile("" ::: "memory");
        TokB X;
#pragma unroll
        for (int m = 0; m < 8; ++m) { const LAS v2u* xp = (const LAS v2u*)(ring + (lane & 7) * 768 + m * 96 + (lane >> 4) * 24);
            const v2u d0 = xp[0], d1 = xp[1], d2 = xp[2];
            X.b[m] = (v8i_t){(int)d0.x, (int)d0.y, (int)d1.x, (int)d1.y, (int)d2.x, (int)d2.y, 0, 0}; }
        LDS_WAIT(); asm volatile("" ::: "memory");
        int n = 0;
        for (int part = 0; part < 8; ++part) {
#pragma unroll
            for (int k = 0; k < 8; ++k) {
                { const bool sel = (id0[k] >> 11) == part; const unsigned long long m = __ballot(sel);
                  const int pos = n + (int)__builtin_amdgcn_mbcnt_hi((unsigned)(m >> 32), __builtin_amdgcn_mbcnt_lo((unsigned)m, 0u));
                  if (sel) list[pos] = ((unsigned)k << 21) | ((unsigned)lane << 14) | (unsigned)id0[k]; n += __builtin_popcountll(m); }
                { const bool sel = (id1[k] >> 11) == part; const unsigned long long m = __ballot(sel);
                  const int pos = n + (int)__builtin_amdgcn_mbcnt_hi((unsigned)(m >> 32), __builtin_amdgcn_mbcnt_lo((unsigned)m, 0u));
                  if (sel) list[pos] = ((unsigned)k << 21) | ((unsigned)(64 + lane) << 14) | (unsigned)id1[k]; n += __builtin_popcountll(m); }
                if (n > PA_CAP - 128) { pa_flush(n, X, lane, list, gl, ring, U6, wpk, tb, nwg); n = 0; }
            }
        }
        pa_flush(n, X, lane, list, gl, ring, U6, wpk, tb, nwg);
    }
}
template <int NT> __device__ __forceinline__ void final_tokens(const int (&t)[NT], int lane, const unsigned short* Y16, const bf16* X1b, float* OUT, const float* fg) {
    v4u xa[NT], xb[NT], ya[NT], yb[NT];
#pragma unroll
    for (int n = 0; n < NT; ++n) { xa[n] = *(const GAS v4u*)(X1b + (size_t)t[n] * 1024 + 8 * lane); xb[n] = *(const GAS v4u*)(X1b + (size_t)t[n] * 1024 + 512 + 8 * lane);
        ya[n] = *(const GAS v4u*)(Y16 + (size_t)t[n] * 1024 + 8 * lane); yb[n] = *(const GAS v4u*)(Y16 + (size_t)t[n] * 1024 + 512 + 8 * lane); }
    const GAS f32x4* gp = (const GAS f32x4*)(fg + 8 * lane); const f32x4 g0 = gp[0], g1 = gp[1], g2 = gp[128], g3 = gp[129];
#pragma unroll
    for (int n = 0; n < NT; ++n) {
        const unsigned yw[8] = {ya[n].x, ya[n].y, ya[n].z, ya[n].w, yb[n].x, yb[n].y, yb[n].z, yb[n].w};
        float y[16];
#pragma unroll
        for (int i = 0; i < 8; ++i) { const unsigned w = yw[i]; const h2_t h = __builtin_bit_cast(h2_t, w); y[2 * i] = (float)h[0]; y[2 * i + 1] = (float)h[1]; }
        const unsigned xw[8] = {xa[n].x, xa[n].y, xa[n].z, xa[n].w, xb[n].x, xb[n].y, xb[n].z, xb[n].w};
        float xv[16];
#pragma unroll
        for (int i = 0; i < 8; ++i) { xv[2 * i] = __uint_as_float(xw[i] << 16); xv[2 * i + 1] = __uint_as_float(xw[i] & 0xffff0000u); }
        const f32x4 a0 = (f32x4){xv[0] + y[0], xv[1] + y[1], xv[2] + y[2], xv[3] + y[3]}, a1 = (f32x4){xv[4] + y[4], xv[5] + y[5], xv[6] + y[6], xv[7] + y[7]},
                    a2 = (f32x4){xv[8] + y[8], xv[9] + y[9], xv[10] + y[10], xv[11] + y[11]}, a3 = (f32x4){xv[12] + y[12], xv[13] + y[13], xv[14] + y[14], xv[15] + y[15]};
        const float ss = (a0.x * a0.x + a0.y * a0.y) + (a0.z * a0.z + a0.w * a0.w) + (a1.x * a1.x + a1.y * a1.y) + (a1.z * a1.z + a1.w * a1.w)
                       + (a2.x * a2.x + a2.y * a2.y) + (a2.z * a2.z + a2.w * a2.w) + (a3.x * a3.x + a3.y * a3.y) + (a3.z * a3.z + a3.w * a3.w);
        const float rstd2 = 1.0f / sqrtf(wave_sum(ss) * (1.f / DMODEL) + RMS_EPS);
        GAS f32x4* xo = (GAS f32x4*)(OUT + (size_t)t[n] * 1024 + 8 * lane);
        xo[0] = a0 * rstd2 * g0; xo[1] = a1 * rstd2 * g1; xo[128] = a2 * rstd2 * g2; xo[129] = a3 * rstd2 * g3; }
}
#ifndef REP_0
#define REP_0 1
#endif
#ifndef REP_1
#define REP_1 1
#endif
#ifndef REP_2
#define REP_2 1
#endif
#ifndef REP_3
#define REP_3 1
#endif
#ifndef REP_4
#define REP_4 1
#endif
#ifndef REP_5
#define REP_5 1
#endif
#ifndef REP_6
#define REP_6 1
#endif
#ifndef REP_7
#define REP_7 1
#endif
#ifndef REP_8
#define REP_8 1
#endif
#ifndef REP_9
#define REP_9 1
#endif
#ifndef REP_10
#define REP_10 1
#endif
#ifndef REP_11
#define REP_11 1
#endif
__device__ __forceinline__ void pb_rows2(v4u* R, unsigned w0, unsigned w1, const unsigned char* vbase) {
    const unsigned char* p0 = vbase + (size_t)(w0 & 0xffffu) * 384; const unsigned char* p1 = vbase + (size_t)(w1 & 0xffffu) * 384;
    R[0] = *(const GAS v4u*)p0; R[1] = *(const GAS v4u*)(p0 + 128); R[2] = *(const GAS v4u*)(p0 + 256);
    R[3] = *(const GAS v4u*)p1; R[4] = *(const GAS v4u*)(p1 + 128); R[5] = *(const GAS v4u*)(p1 + 256);
}
__device__ __forceinline__ void pb_fma1(h2_t (&acc)[32], v4u p0, v4u p1, v4u p2, unsigned p) {
    const h2_t pp = __builtin_bit_cast(h2_t, p); const _Float16 wv = pp[1]; const h2_t w2 = {wv, wv};
    { const v6u_t xa = {p0.x, p0.y, p0.z, p0.w, p1.x, p1.y};
      v32h_t h; asm("v_cvt_scalef32_pk32_f16_fp6 %0, %1, 1.0" : "=&v"(h) : "v"(xa));
#pragma unroll
      for (int j = 0; j < 16; ++j) { const h2_t hv = {h[2 * j], h[2 * j + 1]}; acc[j] = __builtin_elementwise_fma(hv, w2, acc[j]); } }
    { const v6u_t xb = {p1.z, p1.w, p2.x, p2.y, p2.z, p2.w};
      v32h_t h; asm("v_cvt_scalef32_pk32_f16_fp6 %0, %1, 1.0" : "=&v"(h) : "v"(xb));
#pragma unroll
      for (int j = 0; j < 16; ++j) { const h2_t hv = {h[2 * j], h[2 * j + 1]}; acc[16 + j] = __builtin_elementwise_fma(hv, w2, acc[16 + j]); } }
}
__device__ __forceinline__ unsigned pb_w(const v4u (&W)[4], int row) { const v4u w = W[(row >> 2) & 3]; const int e = row & 3; return e == 0 ? w.x : e == 1 ? w.y : e == 2 ? w.z : w.w; }
__device__ __forceinline__ void peer_b_phase(int lane, int wave, int G, int vcu, const unsigned char* V6s, const unsigned* wpk, unsigned short* Y16, const bf16* X1b, float* OUT, const float* fg, bool fin) {
    const int k = lane >> 3, q = lane & 7;
    for (int tile0 = vcu; tile0 < MTOK / 32; tile0 += 2 * G) {
        const int tile1 = tile0 + G; const bool has1 = tile1 < MTOK / 32;
        const int tb = tile0 * 32 + wave * 4, nwg = (has1 ? tile1 : tile0) * 32 + wave * 4;
        const int t = pa_tok((unsigned)k, tb, nwg);
        const unsigned* wrow = wpk + (size_t)t * 128;
        for (int hc = 0; hc < 2; ++hc) {
            const unsigned char* vbase = V6s + (size_t)hc * NEXP * 384 + q * 16;
            h2_t acc[32];
#pragma unroll
            for (int j = 0; j < 32; ++j) acc[j] = (h2_t){(_Float16)0.f, (_Float16)0.f};
            v4u W[4], R[18];
#pragma unroll
            for (int u = 0; u < 4; ++u) W[u] = *(const GAS v4u*)(wrow + 4 * u);
#pragma unroll
            for (int u = 0; u < 3; ++u) pb_rows2(R + 6 * u, pb_w(W, 2 * u), pb_w(W, 2 * u + 1), vbase);
#pragma unroll
            for (int u = 0; u < 64; ++u) { const int s = (u % 3) * 6;
                pb_fma1(acc, R[s], R[s + 1], R[s + 2], pb_w(W, 2 * u)); pb_fma1(acc, R[s + 3], R[s + 4], R[s + 5], pb_w(W, 2 * u + 1));
                __builtin_amdgcn_s_setprio(2);
                if (u + 3 < 64) pb_rows2(R + s, pb_w(W, 2 * (u + 3)), pb_w(W, 2 * (u + 3) + 1), vbase);
                if ((u & 1) && (u >> 1) + 4 < 32) W[(u >> 1) & 3] = *(const GAS v4u*)(wrow + 4 * ((u >> 1) + 4));
                __builtin_amdgcn_s_setprio(0);
                __builtin_amdgcn_sched_barrier(0);
            }
            GAS v4u* yout = (GAS v4u*)(Y16 + (size_t)t * 1024 + hc * 512 + q * 64);
#pragma unroll
            for (int j = 0; j < 8; ++j) yout[j] = (v4u){__builtin_bit_cast(unsigned, acc[4 * j]), __builtin_bit_cast(unsigned, acc[4 * j + 1]), __builtin_bit_cast(unsigned, acc[4 * j + 2]), __builtin_bit_cast(unsigned, acc[4 * j + 3])};
        }
        asm volatile("s_waitcnt vmcnt(0)" ::: "memory");
        if (fin) { const int ta[4] = {tb, tb + 1, tb + 2, tb + 3}; final_tokens<4>(ta, lane, Y16, X1b, OUT, fg);
            if (has1) { const int tc[4] = {nwg, nwg + 1, nwg + 2, nwg + 3}; final_tokens<4>(tc, lane, Y16, X1b, OUT, fg); } }
    }
}
template <int NR> __device__ __forceinline__ void cvt_load(f32x4 (&q)[NR / 2][8], const float* table, int ex, int stride, int lane) {
#pragma unroll
    for (int k = 0; k < NR / 2; ++k) { const int e = ex + (2 * k + (lane >> 5)) * stride; const float* src = table + (size_t)(e < NEXP ? e : ex) * 1024 + 32 * (lane & 31);
#pragma unroll
        for (int j = 0; j < 8; ++j) q[k][j] = *(const GAS f32x4*)(src + 4 * j); }
}
template <int NR> __device__ __forceinline__ void cvt_store(const f32x4 (&q)[NR / 2][8], int ex, int stride, bool isv, int lane, unsigned char* U8, unsigned char* V8) {
    typedef float v16f_t __attribute__((ext_vector_type(16)));
#pragma unroll
    for (int k = 0; k < NR / 2; ++k) { const int e = ex + (2 * k + (lane >> 5)) * stride; if (e < NEXP) {
        if (!isv) {
            v4u p4 = {0u, 0u, 0u, 0u};
#pragma unroll
            for (int j = 0; j < 4; ++j) { const f32x4 t0 = q[k][2 * j] * U8_SCALE, t1 = q[k][2 * j + 1] * U8_SCALE; unsigned w = 0u;
                w = __builtin_amdgcn_cvt_scalef32_pk_fp4_f32(w, t0.x, t0.y, 1.0f, 0); w = __builtin_amdgcn_cvt_scalef32_pk_fp4_f32(w, t0.z, t0.w, 1.0f, 1);
                w = __builtin_amdgcn_cvt_scalef32_pk_fp4_f32(w, t1.x, t1.y, 1.0f, 2); w = __builtin_amdgcn_cvt_scalef32_pk_fp4_f32(w, t1.z, t1.w, 1.0f, 3); p4[j] = w; }
            *(GAS v4u*)(U8 + (size_t)e * 512 + 16 * (lane & 31)) = p4;
        } else {
            v32h_t h;
#pragma unroll
            for (int j = 0; j < 8; ++j) { const f32x4 t = q[k][j] * V8_SCALE; h[4 * j] = (_Float16)t.x; h[4 * j + 1] = (_Float16)t.y; h[4 * j + 2] = (_Float16)t.z; h[4 * j + 3] = (_Float16)t.w; }
            v6u_t p6; asm volatile("s_nop 1\n\tv_cvt_scalef32_pk32_fp6_f16 %0, %1, 1.0" : "=&v"(p6) : "v"(h));
            unsigned char* ln = V8 + ((size_t)((lane & 31) >> 4) * NEXP + e) * 384 + ((lane & 15) >> 1) * 16;
            if ((lane & 1) == 0) { *(GAS v4u*)ln = (v4u){p6[0], p6[1], p6[2], p6[3]}; *(GAS v2u*)(ln + 128) = (v2u){p6[4], p6[5]}; }
            else { *(GAS v2u*)(ln + 128 + 8) = (v2u){p6[0], p6[1]}; *(GAS v4u*)(ln + 256) = (v4u){p6[2], p6[3], p6[4], p6[5]}; } } } }
}
struct OnePanel { int pm, n; __device__ __forceinline__ bool next(int i, pg8::Unit& u) const { if (i >= n) return false; u.pm = pm; u.pn = i; u.w = 0; return true; } };
struct DualOrder { pg8::StaticOrder S; __device__ __forceinline__ bool next(int i, pg8::Unit& u) const { if (!S.next(i >> 1, u)) return false; u.w = i & 1; return true; } };
struct Args { const float* in[24]; float* out; unsigned char* ws; int ph_lo, ph_hi, li, pad; };
__global__ void __launch_bounds__(NWAVES * 64, 2) mk_fwd(Args args) {
    extern __shared__ __attribute__((aligned(16))) unsigned char lds[];
    Frame F;
    F.lds = (LAS unsigned char*)lds;
    volatile LAS unsigned* MISC = (volatile LAS unsigned*)(F.lds + MISC_OFF);
    F.tid = threadIdx.x; F.lane = F.tid & 63; F.wave = __builtin_amdgcn_readfirstlane(F.tid >> 6);
    F.G = gridDim.x; { const int bx = blockIdx.x; F.vcu = (F.G % 8 == 0) ? (bx % 8) * (F.G / 8) + bx / 8 : bx; }
    unsigned char* ws = args.ws;
    gu32* ctl = (gu32*)(ws + WS_CTL);
    for (int u = F.tid; u < (LDS_BYTES - LDSCTL_OFF) / 4; u += NWAVES * 64) ((LAS unsigned*)(F.lds + LDSCTL_OFF))[u] = 0u;
    __syncthreads();
    XcdBarrier bar; bar.bar = (unsigned*)(ctl + CW_BAR); bar.x = 0; bar.st = nullptr;
    if (N_LAUNCHES != PER_PHASE) bar = xcd_barrier_post((unsigned*)(ctl + CW_BAR), MISC + 8);
#define GRID_BAR() do { if (N_LAUNCHES != PER_PHASE) xcd_barrier(bar); } while (0)
    const int lo = args.ph_lo, hi = args.ph_hi;
#ifndef PH_MASK
#define PH_MASK 0xFFFF
#endif
#define IN(k) ((((PH_MASK) >> (k)) & 1) && lo <= (k) && (k) < hi)
#define BOTH(k) (IN(k) && IN((k) + 1))
    const int gw = F.vcu * NWAVES + F.wave, NGW = F.G * NWAVES;
    const int gtid = F.vcu * (NWAVES * 64) + F.tid, NTHR = F.G * NWAVES * 64;
    const float* x = args.in[0];
    bf16* Win_t = (bf16*)(ws + WS_WIN); bf16* Wq_t = (bf16*)(ws + WS_WQ); bf16* Wout_t = (bf16*)(ws + WS_WOUT); bf16* Wus_t = (bf16*)(ws + WS_WUS); bf16* Wua_t = (bf16*)(ws + WS_WUA);
    bf16* Wglu_t = (bf16*)(ws + WS_WGLU); bf16* KSb = (bf16*)(ws + WS_KS); bf16* WE = (bf16*)(ws + WS_WE); bf16* BP = (bf16*)(ws + WS_BP); bf16* AP = (bf16*)(ws + WS_AP);
    float* Eb = (float*)(ws + WS_E); bf16* Hb = (bf16*)(ws + WS_H); bf16* Ypre = (bf16*)(ws + WS_YPRE); bf16* Ya = (bf16*)(ws + WS_YA); bf16* XG = (bf16*)(ws + WS_XG);
    bf16* Zb = (bf16*)(ws + WS_Z); bf16* Qb = (bf16*)(ws + WS_Z + 1 * ZSTRIDE_B); bf16* Kb = (bf16*)(ws + WS_Z + 2 * ZSTRIDE_B); bf16* Vb = (bf16*)(ws + WS_Z + 3 * ZSTRIDE_B);
    bf16* GA = (bf16*)(ws + WS_Z + 4 * ZSTRIDE_B); bf16* GB = (bf16*)(ws + WS_Z + 6 * ZSTRIDE_B);
    bf16* Yb = (bf16*)(ws + WS_YB); bf16* Mrg = (bf16*)(ws + WS_MRG); bf16* PQb = (bf16*)(ws + WS_PQ); int* ids = (int*)(ws + WS_IDS); float* gts = (float*)(ws + WS_GTS);
    unsigned char* U8 = ws + WS_U16; unsigned char* V8 = ws + WS_V16; unsigned* wpk = (unsigned*)(ws + WS_WPK); float* rstd1 = (float*)(ws + WS_RSTD1); unsigned short* Y16 = (unsigned short*)(ws + WS_Y16);
    float* biasT = (float*)(ws + WS_BIAS); float* pw32 = (float*)(ws + WS_PW32); float* kpart = (float*)(ws + WS_KPART); float* Kg = (float*)(ws + WS_KG); float* ssq1 = (float*)(ws + WS_SSQ1);

    if (IN(0)) for (int rep_ = 0; rep_ < REP_0; ++rep_) {
        LAS float* scr = (LAS float*)(F.lds + RING_OFF + F.wave * 16384);
        constexpr int I_IN = (1024 / 64) * (4096 / 32), I_GLU = (512 / 64) * (512 / 32), I_UP = (512 / 64) * (1024 / 32), I_OUT = (1024 / 64) * (1024 / 32), I_Q = (1024 / 64) * (2048 / 32);
        constexpr int NITEMS = I_IN + I_GLU + 2 * I_UP + I_OUT + I_Q;
        const bool tsplit = NGW >= 2 * NGRP * CH;
        for (int it = tsplit ? gw - NGRP * CH : gw; it < NITEMS; it += tsplit ? NGW - NGRP * CH : NGW) {
            if (it < 0) break;
            int r = it;
            if (r < I_IN) { p0_transpose_item(args.in[2], 1024, 4096, Win_t, scr, r, F.lane); continue; } r -= I_IN;
            if (r < I_GLU) { p0_transpose_item(args.in[11], 512, 512, Wglu_t, scr, r, F.lane); continue; } r -= I_GLU;
            if (r < I_UP) { p0_transpose_item(args.in[13], 512, 1024, Wus_t, scr, r, F.lane); continue; } r -= I_UP;
            if (r < I_UP) { p0_transpose_item(args.in[14], 512, 1024, Wua_t, scr, r, F.lane); continue; } r -= I_UP;
            if (r < I_OUT) { p0_transpose_item(args.in[16], 1024, 1024, Wout_t, scr, r, F.lane); continue; } r -= I_OUT;
            p0_transpose_item(args.in[18], 1024, 2048, Wq_t, scr, r, F.lane, args.in[17]);
        }
        for (int it = gw; it < NGRP * CH; it += NGW)
            ssm_table_task(it >> 5, it & 31, F.lane, scr, args.in[3], args.in[4], args.in[5], args.in[6], args.in[7], args.in[8], args.in[9], Kg, WE, BP, pw32);
        for (int m = gw; m < MTOK; m += NGW * 4) rms_rows4_to_bf16(x, args.in[1], Hb, m, NGW, F.lane);
        for (int it = gw; it < 64; it += NGW) { const float* src = (it < 32 ? args.in[19] : args.in[20]) + (size_t)(it & 31) * 512 + 8 * F.lane;
            const f32x4 a = *(const GAS f32x4*)src, b = *(const GAS f32x4*)(src + 4);
            *(GAS v4u*)(KSb + (size_t)it * 512 + 8 * F.lane) = (v4u){pk2(a.x, a.y), pk2(a.z, a.w), pk2(b.x, b.y), pk2(b.z, b.w)}; }
        if (gw == 0) { for (int i = F.lane; i < 8 * 128; i += 64) { const int h = i >> 7, rel = i & 127; int bk;
                if (rel < 16) bk = rel; else { const float lg = logf((float)rel / 16.0f) / 2.0794415416798357f * 16.0f; bk = 16 + (int)lg; bk = bk < 0 ? 0 : (bk > 31 ? 31 : bk); }
                biasT[i] = (args.in[15][bk * 8 + h] - args.in[15][31 * 8 + h]) * 1.4426950408889634f; } }
        if (BOTH(0)) GRID_BAR();
    }

    if (IN(1)) for (int rep_ = 0; rep_ < REP_1; ++rep_) {
        const float* Dsk = args.in[10];
        for (int i0 = gtid; i0 < NGRP * 512 * 64; i0 += NTHR * 4) {
            f32x4 ka[4], kb[4];
#pragma unroll
            for (int q = 0; q < 4; ++q) { const int i = i0 + q * NTHR; const int ic = (i < NGRP * 512 * 64) ? i : i0; const int g = ic >> 15, m = (ic >> 6) & 511, k8 = ic & 63, j = m >> 4, ho = m & 15, jp = k8 >> 1, hi0 = (k8 & 1) * 8;
                const int lag = (jp <= j) ? j - jp : 0; const float* kp = Kg + ((size_t)(g * 32 + lag) * 256 + ho * 16 + hi0); ka[q] = *(const GAS f32x4*)kp; kb[q] = *(const GAS f32x4*)(kp + 4); }
#pragma unroll
            for (int q = 0; q < 4; ++q) { const int i = i0 + q * NTHR; if (i >= NGRP * 512 * 64) break; const int g = i >> 15, m = (i >> 6) & 511, k8 = i & 63, j = m >> 4, ho = m & 15, jp = k8 >> 1, hi0 = (k8 & 1) * 8;
                v4u o = (v4u){0u, 0u, 0u, 0u};
                if (jp <= j) { f32x4 a = ka[q], b = kb[q];
                    if (jp == j && (ho >> 3) == (hi0 >> 3)) { const float dv = Dsk[g * 16 + ho]; const int e = ho & 7;
                        a.x += (e == 0) ? dv : 0.f; a.y += (e == 1) ? dv : 0.f; a.z += (e == 2) ? dv : 0.f; a.w += (e == 3) ? dv : 0.f;
                        b.x += (e == 4) ? dv : 0.f; b.y += (e == 5) ? dv : 0.f; b.z += (e == 6) ? dv : 0.f; b.w += (e == 7) ? dv : 0.f; }
                    o = (v4u){pk2(a.x, a.y), pk2(a.z, a.w), pk2(b.x, b.y), pk2(b.z, b.w)}; }
                *(GAS v4u*)(BP + ((size_t)(g * 512 + m) * APK + k8 * 8)) = o; } }
        pg8::Gemm g{Hb, Win_t, MTOK, INCOLS, 1024, 1024, 1024, 1 << 30, 0};
        pg8::StaticOrder S; S.init(MTOK, INCOLS, F.G, (int)blockIdx.x);
        pg8::EpiIn E{Zb, AP, kpart};
        pg8::gemm_phase<pg8::EpiIn, pg8::StaticOrder, true>(F.lds + RING_OFF, g, S, E);
        if (BOTH(1)) GRID_BAR();
    }

    if (IN(2)) for (int rep_ = 0; rep_ < REP_2; ++rep_) {
        const int bx = (int)blockIdx.x;
        const bool shared = F.G < 4;
        const int nS = shared ? F.G : (F.G >= 256 ? 64 : F.G / 4), nA = shared ? F.G : F.G - nS;
        const bool inS = shared || bx < nS, inA = shared || bx >= nS; const int aidx = shared ? bx : bx - nS;
        if (inS) {
#pragma unroll 1
            for (int pm = bx; pm < MTOK / 256; pm += nS) {
                { pg8::Gemm g1{AP, WE, MTOK, 256, 512, APK, 512, 2, (size_t)256 * 512}; OnePanel S1{pm, 1}; pg8::EpiE E1{Eb};
                  pg8::gemm_phase<pg8::EpiE, OnePanel, true>(F.lds + RING_OFF, g1, S1, E1); }
                VM_WAIT(); __syncthreads();
                if (F.tid < 256) { const int gb = (pm >> 1) * 8 + (pm & 1) * 4 + (F.tid >> 6), g_ = gb >> 3, p = F.tid & 63; const size_t row0 = (size_t)gb * 64;
                    const float mr = pw32[g_ * 128 + p], mi = pw32[g_ * 128 + 64 + p]; float sr = 0.f, si = 0.f;
#pragma unroll 1
                    for (int c0 = 0; c0 < NCHUNK; c0 += 32) { float er[32], ei[32];
#pragma unroll
                        for (int c = 0; c < 32; ++c) { er[c] = Eb[(row0 + c0 + c) * 128 + p]; ei[c] = Eb[(row0 + c0 + c) * 128 + 64 + p]; }
#pragma unroll
                        for (int c = 0; c < 32; ++c) { bf16* ap = AP + (row0 + c0 + c) * APK + 512; ap[p] = (bf16)f2bf(sr); ap[64 + p] = (bf16)f2bf(si);
                            const float nr = mr * sr - mi * si + er[c], ni = mr * si + mi * sr + ei[c]; sr = nr; si = ni; } } }
                VM_WAIT(); __syncthreads();
                { pg8::Gemm g{AP, BP, MTOK, 512, APK, APK, APK, 2, (size_t)512 * APK}; OnePanel S3{pm, 2}; pg8::EpiY E{Ypre};
                  pg8::gemm_phase<pg8::EpiY, OnePanel, true>(F.lds + RING_OFF, g, S3, E); }
            }
            if (!shared && nS == 64) { VM_WAIT(); __syncthreads();
                attn_body::attn_unit<8>(bx >> 3, bx & 7, 1, (const attn_body::bf16*)Qb, (const attn_body::bf16*)Kb, (const attn_body::bf16*)Vb, (attn_body::bf16*)Yb, (char*)lds + RING_OFF, kpart, biasT);
                attn_body::attn_unit<8>(bx >> 3, bx & 7, 0, (const attn_body::bf16*)Qb, (const attn_body::bf16*)Kb, (const attn_body::bf16*)Vb, (attn_body::bf16*)Yb, (char*)lds + RING_OFF, kpart, biasT); }
        }
        if (inA) {
            static_assert(attn_body::ATTN_LDS_BYTES <= RING_BYTES, "attention LDS");
#pragma unroll 1
            for (int a = aidx; a < 192; a += nA) { const int ty = a >> 6, bh = a & 63;
#pragma unroll 1
                for (int i = 0; i < 4; ++i) { const bool give = !shared && nS == 64;
                    const int qb = give ? ((i >= 2) ? -1 : (ty == 0) ? (i == 0 ? 7 : 2) : (ty == 1) ? (i == 0 ? 6 : 3) : (i == 0 ? 5 : 4))
                                        : (ty == 0) ? (i == 0 ? 7 : (i == 1 ? 2 : (i == 2 ? 0 : -1))) : (ty == 1) ? (i == 0 ? 6 : (i == 1 ? 4 : -1)) : (i == 0 ? 5 : (i == 1 ? 3 : (i == 2 ? 1 : -1)));
                    if (qb < 0) break;
                    attn_body::attn_unit<8>(bh >> 3, bh & 7, qb, (const attn_body::bf16*)Qb, (const attn_body::bf16*)Kb, (const attn_body::bf16*)Vb, (attn_body::bf16*)Yb, (char*)lds + RING_OFF, kpart, biasT); } }
        }
        if (BOTH(2)) GRID_BAR();
    }

    if (IN(3)) for (int rep_ = 0; rep_ < REP_3; ++rep_) {
        pg8::Gemm g{Ypre, Wglu_t, MTOK, 512, 512, 512, 512, 1 << 30, 0};
        pg8::StaticOrder S; S.init(MTOK, 512, F.G, (int)blockIdx.x);
        pg8::EpiGlu E{Ypre, Ya, args.in[12]};
        pg8::gemm_phase<pg8::EpiGlu, pg8::StaticOrder, true>(F.lds + RING_OFF, g, S, E);
        { const int nun = (MTOK / 256) * (512 / 256);
          const bool split = F.G >= 2 * nun; const int nconv = split ? nun : F.G, cidx = split ? ((int)blockIdx.x % nun) : (int)blockIdx.x;
          const int stride = nconv * NWAVES, step = stride * 4, ex0 = cidx * NWAVES + F.wave;
          const int ncall = (NEXP - ex0 + step - 1) / step;
          int c_lo = 0, c_hi = 2 * ncall;
          if (split) { const int cut = (2 * ncall * 3) / 4; if ((int)blockIdx.x < nun) c_lo = cut; else if ((int)blockIdx.x < 2 * nun) c_hi = cut; else c_hi = 0; }
          f32x4 qa[2][8], qb[2][8];
#define CV_TAB(c) ((c) < ncall ? args.in[21] : args.in[22])
#define CV_EX(c) (ex0 + ((c) < ncall ? (c) : (c) - ncall) * step)
          if (c_lo < c_hi) cvt_load<4>(qa, CV_TAB(c_lo), CV_EX(c_lo), stride, F.lane);
          for (int c = c_lo; c < c_hi; c += 2) {
              if (c + 1 < c_hi) cvt_load<4>(qb, CV_TAB(c + 1), CV_EX(c + 1), stride, F.lane);
              cvt_store<4>(qa, CV_EX(c), stride, c >= ncall, F.lane, U8, V8);
              if (c + 2 < c_hi) cvt_load<4>(qa, CV_TAB(c + 2), CV_EX(c + 2), stride, F.lane);
              if (c + 1 < c_hi) cvt_store<4>(qb, CV_EX(c + 1), stride, c + 1 >= ncall, F.lane, U8, V8);
          } }
#undef CV_TAB
#undef CV_EX
        if (BOTH(3)) GRID_BAR();
    }

    if (IN(4)) for (int rep_ = 0; rep_ < REP_4; ++rep_) {
        pg8::Gemm g{Ya, Wus_t, MTOK, 1024, 512, 512, 512, 1 << 30, 0, Yb, Wua_t};
        DualOrder S; S.S.init(MTOK, 1024, F.G, (int)blockIdx.x);
        pg8::EpiMrgDual E{pg8::EpiMrg<0>{GA, Mrg}, pg8::EpiMrg<1>{GB, Mrg}};
        pg8::gemm_phase<pg8::EpiMrgDual, DualOrder, true>(F.lds + RING_OFF, g, S, E);
        if (BOTH(4)) GRID_BAR();
    }

    if (IN(5)) for (int rep_ = 0; rep_ < REP_5; ++rep_) {
        pg8::Gemm g{Mrg, Wout_t, MTOK, 1024, 1024, 1024, 1024, 1 << 30, 0}; pg8::StaticOrder S; S.init(MTOK, 1024, F.G, (int)blockIdx.x);
        pg8::EpiX1 E{x, args.out, XG, args.in[17], ssq1};
        pg8::gemm_phase<pg8::EpiX1, pg8::StaticOrder, true>(F.lds + RING_OFF, g, S, E);
        if (BOTH(5)) GRID_BAR();
    }

    if (IN(6)) for (int rep_ = 0; rep_ < REP_6; ++rep_) {
        pg8::Gemm g{XG, Wq_t, MTOK, PQ, 1024, 1024, 1024, 1 << 30, 0}; pg8::StaticOrder S; S.init(MTOK, PQ, F.G, (int)blockIdx.x);
        pg8::EpiPlain E{PQb, PQ};
        pg8::gemm_phase<pg8::EpiPlain, pg8::StaticOrder, true>(F.lds + RING_OFF, g, S, E);
        if (BOTH(6)) GRID_BAR();
    }

    if (IN(7)) for (int rep_ = 0; rep_ < REP_7; ++rep_) {
        LAS unsigned char* scr = F.lds + RING_OFF + F.wave * 2048;
        LAS unsigned char* ksl = F.lds + RING_OFF + 16384;
        for (int c = F.tid; c < 256 * 16; c += NWAVES * 64) { const int row = c >> 4, ch = c & 15; *(LAS v4u*)(ksl + row * 256 + ((ch ^ (row & 15)) << 4)) = *(const GAS v4u*)(KSb + row * 128 + ch * 8); }
        __syncthreads();
        for (int it = gw; it < (MTOK / 32) * 8; it += NGW) topk_task(it >> 3, it & 7, F.lane, scr, PQb, ksl, ssq1, ids, gts, rstd1);
        if (BOTH(7)) { VM_WAIT(); __syncthreads(); }
    }

    if (IN(8)) for (int rep_ = 0; rep_ < REP_8; ++rep_) {
        peer_a_phase(F.lane, F.wave, F.G, F.vcu, XG, U8, ids, gts, rstd1, wpk, F.lds, args.in[17]);
        if (BOTH(8)) VM_WAIT();
    }
    if (IN(9)) for (int rep_ = 0; rep_ < REP_9; ++rep_) {
        peer_b_phase(F.lane, F.wave, F.G, F.vcu, V8, wpk, Y16, XG, args.out, args.in[23], rep_ == REP_9 - 1);
    }
#undef IN
#undef BOTH
#undef GRID_BAR
}

extern "C" void kernel_launch(void* const* d_in, const int* in_sizes, int n_in, void* d_out, int out_size, void* d_ws, size_t ws_size, hipStream_t stream) {
    static int grid = 0;
    if (grid == 0) {
        if (n_in != 24 || in_sizes[0] != MTOK * DMODEL || out_size != MTOK * DMODEL || ws_size < WS_END) { fprintf(stderr, "kernel_launch: unexpected shapes (n_in %d, in0 %d, out %d, ws %zu); nothing launched\n", n_in, n_in > 0 ? in_sizes[0] : -1, out_size, ws_size); grid = -1; return; }
        int dev = 0, cus = 0, per_cu = 0;
        if (hipGetDevice(&dev) != hipSuccess || hipDeviceGetAttribute(&cus, hipDeviceAttributeMultiprocessorCount, dev) != hipSuccess) { grid = -1; return; }
        if (hipFuncSetAttribute((const void*)mk_fwd, hipFuncAttributeMaxDynamicSharedMemorySize, LDS_BYTES) != hipSuccess) { fprintf(stderr, "kernel_launch: hipFuncSetAttribute failed\n"); grid = -1; return; }
        if (hipOccupancyMaxActiveBlocksPerMultiprocessor(&per_cu, (const void*)mk_fwd, NWAVES * 64, LDS_BYTES) != hipSuccess || per_cu < 1) { fprintf(stderr, "kernel_launch: occupancy query says %d blocks per CU\n", per_cu); }
        (void)hipGetLastError();
        grid = cus;
    }
    if (grid < 0) return;
    if (N_LAUNCHES != PER_PHASE) { if (hipMemsetAsync((char*)d_ws + WS_CTL, 0, CTL_ZERO_BYTES, stream) != hipSuccess) return; }
    Args a{};
    for (int i = 0; i < 24; ++i) a.in[i] = (const float*)d_in[i];
    a.out = (float*)d_out; a.ws = (unsigned char*)d_ws; a.pad = 0;
    if (N_LAUNCHES == PER_PHASE) {
        for (int li = 0; li < PER_PHASE; ++li) { a.ph_lo = li; a.ph_hi = li + 1; a.li = li; hipLaunchKernelGGL(mk_fwd, dim3(grid), dim3(NWAVES * 64), LDS_BYTES, stream, a); }
    } else {
        a.ph_lo = 0; a.ph_hi = PER_PHASE; a.li = 0;
        hipLaunchKernelGGL(mk_fwd, dim3(grid), dim3(NWAVES * 64), LDS_BYTES, stream, a);
    }
}
```
